# Optimizing an MI355X kernel written in HIP

```python
import jax, jax.numpy as jnp
from jax import lax
import numpy as np

D_MODEL = 1024
BATCH = 8
SEQ = 4096
DEPTH = 1

HG_HEADS = 4
HG_DK = 128
HG_DV = 128
HG_WIDTH = HG_HEADS * HG_DK
HG_CHUNK = 64

ATT_HEADS = 8
ATT_GROUPS = 2
ATT_HEAD_DIM = 64
ATT_REP = ATT_HEADS // ATT_GROUPS
ATT_WIDTH = ATT_HEADS * ATT_HEAD_DIM
ATT_KV_WIDTH = ATT_GROUPS * ATT_HEAD_DIM
IDX_HEADS = 8
IDX_DIM = 64
IDX_TOPK_MAX = 256
Q_BLOCK = 128

PEER_HEADS = 8
PEER_NKEYS = 128
PEER_NEXP = PEER_NKEYS * PEER_NKEYS
PEER_DKEY = 256
PEER_TOPK = 16
PEER_TOK_BLOCK = 128

RMS_EPS = 1e-6

IN_SPLIT = (HG_WIDTH, HG_WIDTH, HG_WIDTH, HG_WIDTH,
            ATT_WIDTH, ATT_KV_WIDTH, ATT_KV_WIDTH,
            IDX_HEADS * IDX_DIM, IDX_DIM, IDX_HEADS,
            D_MODEL, D_MODEL)
IN_WIDTH = 4 * HG_WIDTH + ATT_WIDTH + 2 * ATT_KV_WIDTH + IDX_HEADS * IDX_DIM + IDX_DIM + IDX_HEADS + 2 * D_MODEL

kernel_name = 'hybrid_hgrn2_dsa_peer_block'


def rmsnorm(x, g):
    xf = x.astype(jnp.float32)
    y = xf * lax.rsqrt(jnp.mean(xf * xf, axis=-1, keepdims=True) + RMS_EPS)
    return (y * g.astype(jnp.float32)).astype(x.dtype)


def alibi_slopes(n_heads):
    return jnp.exp2(-8.0 * (jnp.arange(n_heads, dtype=jnp.float32) + 1.0) / n_heads)


def hgrn2_mix(q, f_pre, i, g, lb, onorm_g):
    B, S, _ = q.shape
    C = HG_CHUNK
    N = S // C
    dt = q.dtype

    def heads(t):
        return t.astype(jnp.float32).reshape(B, N, C, HG_HEADS, -1).transpose(0, 3, 1, 2, 4)

    lbf = lb.astype(jnp.float32).reshape(HG_HEADS, 1, 1, HG_DK)
    qh = jax.nn.silu(heads(q))
    f = lbf + (1.0 - lbf) * jax.nn.sigmoid(heads(f_pre))
    kh = 1.0 - f
    vh = heads(i)
    b = jnp.cumsum(jnp.log(f), axis=3)
    b_mid = b[:, :, :, C // 2 - 1:C // 2]
    b_last = b[:, :, :, -1:]
    A = jnp.einsum('bhncd,bhnsd->bhncs', qh * jnp.exp(b - b_mid), kh * jnp.exp(b_mid - b))
    causal = jnp.tril(jnp.ones((C, C), dtype=bool))
    A = jnp.where(causal, A, 0.0)
    o = jnp.einsum('bhncs,bhnse->bhnce', A, vh)
    dS = jnp.einsum('bhnsd,bhnse->bhnde', kh * jnp.exp(b_last - b), vh)
    decay = jnp.exp(b_last[:, :, :, 0])

    def step(S_prev, inp):
        dec, ds = inp
        return dec[..., None] * S_prev + ds, S_prev

    S0 = jnp.zeros((B, HG_HEADS, HG_DK, HG_DV), jnp.float32)
    _, S_before = lax.scan(step, S0, (jnp.moveaxis(decay, 2, 0), jnp.moveaxis(dS, 2, 0)))
    S_before = jnp.moveaxis(S_before, 0, 2)
    o = o + jnp.einsum('bhncd,bhnde->bhnce', qh * jnp.exp(b), S_before)
    o = rmsnorm(o, onorm_g) * jax.nn.silu(heads(g))
    return o.transpose(0, 2, 3, 1, 4).reshape(B, S, HG_WIDTH).astype(dt)


def dsa_mix(q, k, v, q_idx, k_idx, w_idx):
    B, S = q.shape[0], q.shape[1]
    topk = min(IDX_TOPK_MAX, S // 4)
    nb = S // Q_BLOCK
    slopes = alibi_slopes(ATT_HEADS).reshape(ATT_GROUPS, ATT_REP)
    kpos = jnp.arange(S)
    idx_scale = (IDX_DIM ** -0.5) * (IDX_HEADS ** -0.5)
    att_scale = ATT_HEAD_DIM ** -0.5

    def to_blocks(t):
        return jnp.moveaxis(t.reshape(B, nb, Q_BLOCK, *t.shape[2:]), 1, 0)

    def block(args):
        qb, qib, wb, t0 = args
        tpos = t0 + jnp.arange(Q_BLOCK)
        s = jnp.einsum('bqhd,bsd->bqhs', qib, k_idx)
        I = jnp.einsum('bqh,bqhs->bqs', wb, jax.nn.relu(s)).astype(jnp.float32) * idx_scale
        causal = kpos[None, :] <= tpos[:, None]
        I = jnp.where(causal[None], I, -jnp.inf)
        _, sel = lax.top_k(I, topk)
        valid = sel <= tpos[None, :, None]
        kg = jax.vmap(lambda kk, ii: kk[ii])(k, sel)
        vg = jax.vmap(lambda vv, ii: vv[ii])(v, sel)
        qg = qb.reshape(B, Q_BLOCK, ATT_GROUPS, ATT_REP, ATT_HEAD_DIM)
        sc = jnp.einsum('bqgrd,bqkgd->bqgrk', qg, kg).astype(jnp.float32) * att_scale
        dist = (tpos[None, :, None] - sel).astype(jnp.float32)
        sc = sc - slopes[None, None, :, :, None] * dist[:, :, None, None, :]
        sc = jnp.where(valid[:, :, None, None, :], sc, -jnp.inf)
        p = jax.nn.softmax(sc, axis=-1).astype(vg.dtype)
        o = jnp.einsum('bqgrk,bqkgd->bqgrd', p, vg)
        return o.reshape(B, Q_BLOCK, ATT_WIDTH)

    out = lax.map(block, (to_blocks(q), to_blocks(q_idx), to_blocks(w_idx),
                          jnp.arange(nb, dtype=jnp.int32) * Q_BLOCK))
    return jnp.moveaxis(out, 0, 1).reshape(B, S, ATT_WIDTH)


def peer_ffn(h, wq, subkeys, u, vtab):
    B, S, D = h.shape
    T = B * S
    hf = h.reshape(T, D)
    qry = (hf @ wq).reshape(T, PEER_HEADS, 2, PEER_DKEY // 2)
    sc = jnp.einsum('thpd,hpnd->thpn', qry, subkeys).astype(jnp.float32)
    s1, i1 = lax.top_k(sc[:, :, 0], PEER_TOPK)
    s2, i2 = lax.top_k(sc[:, :, 1], PEER_TOPK)
    cand = (s1[..., :, None] + s2[..., None, :]).reshape(T, PEER_HEADS, PEER_TOPK * PEER_TOPK)
    cidx = (i1[..., :, None] * PEER_NKEYS + i2[..., None, :]).reshape(T, PEER_HEADS, PEER_TOPK * PEER_TOPK)
    top_s, pos = lax.top_k(cand, PEER_TOPK)
    eidx = jnp.take_along_axis(cidx, pos, axis=-1)
    gates = jax.nn.softmax(top_s, axis=-1).astype(h.dtype)
    nb = T // PEER_TOK_BLOCK

    def block(args):
        xb, eb, gb = args
        a = jax.nn.gelu(jnp.einsum('td,thkd->thk', xb, u[eb]), approximate=False)
        return jnp.einsum('thk,thkd->td', gb * a, vtab[eb])

    out = lax.map(block, (hf.reshape(nb, PEER_TOK_BLOCK, D),
                          eidx.reshape(nb, PEER_TOK_BLOCK, PEER_HEADS, PEER_TOPK),
                          gates.reshape(nb, PEER_TOK_BLOCK, PEER_HEADS, PEER_TOPK)))
    return out.reshape(B, S, D)


def setup_inputs(seed: int = 0) -> dict:
    key = jax.random.key(seed)
    ks = jax.random.split(key, 18)
    n = jax.random.normal
    L, D = DEPTH, D_MODEL
    f32 = jnp.float32
    return {
        'x': n(ks[0], (BATCH, SEQ, D), f32),
        'c': n(ks[1], (BATCH, D), f32),
        'w_ada': n(ks[2], (L, D, 6 * D), f32) * (0.5 * D ** -0.5),
        'b_ada': n(ks[3], (L, 6 * D), f32) * 0.01,
        'norm1_g': 1.0 + 0.02 * n(ks[4], (L, D), f32),
        'norm2_g': 1.0 + 0.02 * n(ks[5], (L, D), f32),
        'w_in': n(ks[6], (L, D, IN_WIDTH), f32) * D ** -0.5,
        'hg_lb': 0.1 * n(ks[7], (L + 1, HG_WIDTH), f32),
        'hg_onorm_g': 1.0 + 0.02 * n(ks[8], (L, HG_DV), f32),
        'q_norm_g': 1.0 + 0.02 * n(ks[9], (L, ATT_HEAD_DIM), f32),
        'k_norm_g': 1.0 + 0.02 * n(ks[10], (L, ATT_HEAD_DIM), f32),
        'w_a': n(ks[11], (L, HG_WIDTH, D), f32) * HG_WIDTH ** -0.5,
        'w_b': n(ks[12], (L, ATT_WIDTH, D), f32) * ATT_WIDTH ** -0.5,
        'w_out': n(ks[13], (L, D, D), f32) * D ** -0.5,
        'peer_wq': n(ks[14], (L, D, PEER_HEADS * PEER_DKEY), f32) * D ** -0.5,
        'peer_subkeys': n(ks[15], (L, PEER_HEADS, 2, PEER_NKEYS, PEER_DKEY // 2), f32) * (PEER_DKEY // 2) ** -0.5,
        'peer_u': n(ks[16], (L, PEER_NEXP, D), f32) * D ** -0.5,
        'peer_v': n(ks[17], (L, PEER_NEXP, D), f32),
    }


def reference(x, c, w_ada, b_ada, norm1_g, norm2_g, w_in, hg_lb, hg_onorm_g, q_norm_g, k_norm_g,
              w_a, w_b, w_out, peer_wq, peer_subkeys, peer_u, peer_v):
    B, S, D = x.shape
    lb_all = jnp.cumsum(jax.nn.softmax(hg_lb.astype(jnp.float32), axis=0), axis=0)
    split_at = [int(v) for v in np.cumsum(np.array(IN_SPLIT))[:-1]]
    cs = jax.nn.silu(c)
    for l in range(DEPTH):
        mod = cs @ w_ada[l] + b_ada[l]
        sh1, sc1, g1, sh2, sc2, g2 = jnp.split(mod, 6, axis=-1)
        h = rmsnorm(x, norm1_g[l]) * (1.0 + sc1[:, None]) + sh1[:, None]
        proj = h @ w_in[l]
        hq, hfp, hi, hg, aq, ak, av, iq, ik, iw, ga, gb = jnp.split(proj, split_at, axis=-1)
        ya = hgrn2_mix(hq, hfp, hi, hg, lb_all[l], hg_onorm_g[l])
        q = rmsnorm(aq.reshape(B, S, ATT_HEADS, ATT_HEAD_DIM), q_norm_g[l])
        k = rmsnorm(ak.reshape(B, S, ATT_GROUPS, ATT_HEAD_DIM), k_norm_g[l])
        v = av.reshape(B, S, ATT_GROUPS, ATT_HEAD_DIM)
        yb = dsa_mix(q, k, v, iq.reshape(B, S, IDX_HEADS, IDX_DIM), ik, iw)
        merged = jax.nn.sigmoid(ga) * (ya @ w_a[l]) + jax.nn.sigmoid(gb) * (yb @ w_b[l])
        x = x + g1[:, None] * (merged @ w_out[l])
        h2 = rmsnorm(x, norm2_g[l]) * (1.0 + sc2[:, None]) + sh2[:, None]
        x = x + g2[:, None] * peer_ffn(h2, peer_wq[l], peer_subkeys[l], peer_u[l], peer_v[l])
    return x
```

```cpp
#include <hip/hip_runtime.h>
#include <hip/hip_cooperative_groups.h>
#include <cstdio>
#include <cstdint>
namespace cg = cooperative_groups;

namespace pg8 {
#define PG8_LAS __attribute__((address_space(3)))
typedef unsigned short bf16_t;
typedef short bf16x8 __attribute__((ext_vector_type(8)));
typedef float f32x4 __attribute__((ext_vector_type(4)));
typedef unsigned u32x4 __attribute__((ext_vector_type(4)));
constexpr int BM = 256, BK = 64, HALF = 128, HTB = HALF * BK * 2  , STAGE_BYTES = 8 * HTB, NXCD = 8, WGM = 8;

__host__ __device__ __forceinline__ int lds_byte(int r, int c) { const int st = (r >> 4) * 2 + (c >> 5), rr = r & 15, cc = c & 31, ob = rr * 64 + cc * 2; return st * 1024 + (ob ^ (((ob >> 9) & 1) << 5)); }
__host__ __device__ __forceinline__ void stage_rc(int b, int& R, int& C) { const int st = b / 1024, sb = b % 1024, swz = sb ^ (((sb >> 9) & 1) << 5); R = (st >> 1) * 16 + swz / 64; C = (st & 1) * 32 + (swz % 64) / 2; }
__host__ __device__ __forceinline__ int perm32(int rho) { const int n = rho >> 4, i = rho & 15; return 8 * (i >> 2) + 4 * n + (i & 3); }

struct Unit { int pm, pn, ko, pass; };
struct Gemm { const bf16_t* A; const bf16_t* Bt; int M, N, K, lda, ldb; };

template <bool TWOPASS_ORDER = false>
struct StaticOrderT {
    int nM, nN, nwg, G, c;
    __host__ __device__ void init(int M, int N, int G_, int c_) { nM = M / BM; nN = N / BM; nwg = nM * nN; G = G_; c = c_; }
    __host__ __device__ bool next(int i, Unit& u) const {
        const long L = (long)(TWOPASS_ORDER ? (i >> 1) : i) * G + c; if (L >= nwg) return false;
        u.pass = TWOPASS_ORDER ? (i & 1) : 0; u.ko = TWOPASS_ORDER ? (i & 1) * 512 : 0;
        int wgid = (int)L; { const int q = nwg / NXCD, r = nwg % NXCD, xcd = wgid % NXCD, off = wgid / NXCD; wgid = (xcd < r ? xcd * (q + 1) : r * (q + 1) + (xcd - r) * q) + off; }
        const int nig = WGM * nN, gid = wgid / nig, fm = gid * WGM, gsz = (nM - fm) < WGM ? (nM - fm) : WGM;
        u.pm = fm + ((wgid % nig) % gsz); u.pn = (wgid % nig) / gsz; return true;
    }
    __device__ __forceinline__ void a_ready(const Unit&) const {}
    __device__ __forceinline__ void done(const Unit&) const {}
};
typedef StaticOrderT<false> StaticOrder;

__device__ __forceinline__ unsigned cvt_pk_bf16(float lo, float hi) { unsigned r; asm volatile("v_cvt_pk_bf16_f32 %0, %1, %2" : "=v"(r) : "v"(lo), "v"(hi)); return r; }

template <class Epi, class Sched, bool ALIGN_EPI = false, bool SP2 = false>
__device__ __forceinline__ void gemm_phase(PG8_LAS unsigned char* lds, const Gemm g, const Sched& S, const Epi& E) {
    const int tid = threadIdx.x, wid = __builtin_amdgcn_readfirstlane(tid >> 6), lane = tid & 63, wr = wid >> 2, wc = wid & 3, fr = lane & 15, fq = lane >> 4;
    const int K = g.K, nt = K / BK;
    unsigned voffA[2], voffB[2];
#pragma unroll
    for (int i = 0; i < 2; ++i) { int R, C; stage_rc(tid * 16 + i * 8192, R, C); const int Rb = Epi::PERM ? ((R & ~31) + perm32(R & 31)) : R;
        voffA[i] = (unsigned)(R * g.lda + C) * 2u; voffB[i] = (unsigned)(Rb * g.ldb + C) * 2u; }
    const size_t kstep = (size_t)(BK * 2);
    const size_t hstepA = (size_t)HALF * g.lda * 2, hstepB = (size_t)HALF * g.ldb * 2;
    const size_t tstepA = 2 * hstepA, tstepB = 2 * hstepB;
    const unsigned ldsw = (unsigned)wid * 1024u;
    const int aoff = lds_byte(wr * 64 + fr, fq * 8), boff = lds_byte(wc * 32 + fr, fq * 8);
#define PG8_SA(b, h) (((b) * 2 + (h)) * HTB)
#define PG8_SB(b, h) ((4 + (b) * 2 + (h)) * HTB)
#define PG8_STAGE(bufoff, gbase, voff) do { _Pragma("unroll") for (int _i = 0; _i < 2; ++_i) \
        __builtin_amdgcn_global_load_lds((const unsigned*)((const char*)(gbase) + (voff)[_i]), (PG8_LAS unsigned*)(lds + (bufoff) + ldsw + _i * 8192), 16, 0, 0); } while (0)
#define PG8_LDA(dst, b, h) do { _Pragma("unroll") for (int m = 0; m < 4; ++m) _Pragma("unroll") for (int k = 0; k < 2; ++k) dst[m][k] = *(const PG8_LAS bf16x8*)(lds + PG8_SA(b, h) + aoff + m * 2048 + k * 1024); } while (0)
#define PG8_LDB(dst, b, h) do { _Pragma("unroll") for (int n = 0; n < 2; ++n) _Pragma("unroll") for (int k = 0; k < 2; ++k) dst[n][k] = *(const PG8_LAS bf16x8*)(lds + PG8_SB(b, h) + boff + n * 2048 + k * 1024); } while (0)
#define PG8_MMA(ai, bj, At, Bt) do { __builtin_amdgcn_s_setprio(1); _Pragma("unroll") for (int m = 0; m < 4; ++m) _Pragma("unroll") for (int n = 0; n < 2; ++n) _Pragma("unroll") for (int k = 0; k < 2; ++k) \
        acc[ai][bj][m][n] = __builtin_amdgcn_mfma_f32_16x16x32_bf16(Bt[n][k], At[m][k], acc[ai][bj][m][n], 0, 0, 0); __builtin_amdgcn_s_setprio(0); } while (0)
#define PG8_WAIT_V(n) asm volatile("s_waitcnt vmcnt(" #n ")" ::: "memory")
#define PG8_WAIT_L(n) asm volatile("s_waitcnt lgkmcnt(" #n ")" ::: "memory")
#define PG8_BAR __builtin_amdgcn_s_barrier()
#define PG8_SCHED __builtin_amdgcn_sched_barrier(0)
    Unit cur, nxt; int ui = 0;
    if (!S.next(0, cur)) return;
    f32x4 acc[2][2][4][2];
#pragma unroll
    for (int a = 0; a < 2; ++a)
#pragma unroll
        for (int b = 0; b < 2; ++b)
#pragma unroll
            for (int m = 0; m < 4; ++m)
#pragma unroll
                for (int n = 0; n < 2; ++n) acc[a][b][m][n] = (f32x4){0.f, 0.f, 0.f, 0.f};
    bf16x8 At[4][2], B0[2][2], B1[2][2];
    const char* cA = (const char*)g.A + (size_t)cur.pm * tstepA + (size_t)cur.ko * 2; const char* cB = (const char*)g.Bt + (size_t)cur.pn * tstepB + (size_t)cur.ko * 2;
    S.a_ready(cur);
    if constexpr (SP2) {
        PG8_STAGE(PG8_SB(0, 0), cB, voffB); PG8_STAGE(PG8_SB(0, 1), cB + hstepB, voffB); PG8_STAGE(PG8_SA(0, 0), cA, voffA); PG8_STAGE(PG8_SA(0, 1), cA + hstepA, voffA);
        if (wr == 1) PG8_BAR;
        PG8_WAIT_V(2); PG8_BAR;
        PG8_STAGE(PG8_SB(1, 0), cB + kstep, voffB); PG8_STAGE(PG8_SA(1, 0), cA + kstep, voffA); PG8_STAGE(PG8_SB(1, 1), cB + hstepB + kstep, voffB);
        PG8_WAIT_V(6); PG8_BAR;
    } else {
        PG8_STAGE(PG8_SB(0, 0), cB, voffB); PG8_STAGE(PG8_SA(0, 0), cA, voffA); PG8_STAGE(PG8_SB(0, 1), cB + hstepB, voffB); PG8_STAGE(PG8_SA(0, 1), cA + hstepA, voffA);
        if (wr == 1) PG8_BAR;
        PG8_WAIT_V(4); PG8_BAR;
        PG8_STAGE(PG8_SB(1, 0), cB + kstep, voffB); PG8_STAGE(PG8_SA(1, 0), cA + kstep, voffA); PG8_STAGE(PG8_SB(1, 1), cB + hstepB + kstep, voffB);
        PG8_WAIT_V(6); PG8_BAR;
    }
    for (;;) {
        const bool has_next = S.next(ui + 1, nxt);
        const char* nA = has_next ? (const char*)g.A + (size_t)nxt.pm * tstepA + (size_t)nxt.ko * 2 : cA; const char* nB = has_next ? (const char*)g.Bt + (size_t)nxt.pn * tstepB + (size_t)nxt.ko * 2 : cB;
        for (int t = 0; t < nt; t += 2) {
            const bool last = (t == nt - 2);
            const char* a1 = cA + (size_t)(t + 1) * kstep;
            const char* a2 = last ? nA : cA + (size_t)(t + 2) * kstep; const char* b2 = last ? nB : cB + (size_t)(t + 2) * kstep;
            const char* a3 = a2 + kstep; const char* b3 = b2 + kstep;
            if (last && has_next) S.a_ready(nxt);
            if constexpr (SP2) {
            PG8_LDB(B0, 0, 0); PG8_LDB(B1, 0, 1); PG8_SCHED; PG8_LDA(At, 0, 0); PG8_STAGE(PG8_SA(1, 1), a1 + hstepA, voffA);
            PG8_WAIT_V(8); PG8_WAIT_L(0); PG8_BAR; PG8_MMA(0, 0, At, B0); PG8_MMA(0, 1, At, B1); PG8_BAR; PG8_SCHED;
            PG8_LDA(At, 0, 1); PG8_STAGE(PG8_SB(0, 0), b2, voffB); PG8_STAGE(PG8_SB(0, 1), b2 + hstepB, voffB); PG8_STAGE(PG8_SA(0, 0), a2, voffA);
            PG8_WAIT_V(8); PG8_WAIT_L(0); PG8_BAR; PG8_MMA(1, 0, At, B0); PG8_MMA(1, 1, At, B1); PG8_BAR; PG8_SCHED;
            PG8_LDB(B0, 1, 0); PG8_LDB(B1, 1, 1); PG8_SCHED; PG8_LDA(At, 1, 0); PG8_STAGE(PG8_SA(0, 1), a2 + hstepA, voffA);
            PG8_WAIT_V(8); PG8_WAIT_L(0); PG8_BAR; PG8_MMA(0, 0, At, B0); PG8_MMA(0, 1, At, B1); PG8_BAR; PG8_SCHED;
            PG8_LDA(At, 1, 1); PG8_STAGE(PG8_SB(1, 0), b3, voffB); PG8_STAGE(PG8_SB(1, 1), b3 + hstepB, voffB); PG8_STAGE(PG8_SA(1, 0), a3, voffA);
            PG8_WAIT_V(8); PG8_WAIT_L(0); PG8_BAR; PG8_MMA(1, 0, At, B0); PG8_MMA(1, 1, At, B1); PG8_BAR; PG8_SCHED;
            } else {
            PG8_LDB(B0, 0, 0); PG8_SCHED; PG8_LDA(At, 0, 0); PG8_STAGE(PG8_SA(1, 1), a1 + hstepA, voffA);
            PG8_WAIT_L(8); PG8_BAR; PG8_WAIT_L(0); PG8_MMA(0, 0, At, B0); PG8_BAR; PG8_SCHED;
            PG8_LDB(B1, 0, 1); PG8_STAGE(PG8_SB(0, 0), b2, voffB);
            PG8_BAR; PG8_WAIT_L(0); PG8_MMA(0, 1, At, B1); PG8_BAR;
            PG8_LDA(At, 0, 1); PG8_STAGE(PG8_SA(0, 0), a2, voffA);
            PG8_BAR; PG8_WAIT_L(0); PG8_MMA(1, 0, At, B0); PG8_BAR; PG8_SCHED;
            PG8_STAGE(PG8_SB(0, 1), b2 + hstepB, voffB);
            PG8_WAIT_V(6); PG8_BAR; PG8_MMA(1, 1, At, B1); PG8_BAR;
            PG8_LDB(B0, 1, 0); PG8_SCHED; PG8_LDA(At, 1, 0); PG8_STAGE(PG8_SA(0, 1), a2 + hstepA, voffA);
            PG8_WAIT_L(8); PG8_BAR; PG8_WAIT_L(0); PG8_MMA(0, 0, At, B0); PG8_BAR; PG8_SCHED;
            PG8_LDB(B1, 1, 1); PG8_STAGE(PG8_SB(1, 0), b3, voffB);
            PG8_BAR; PG8_WAIT_L(0); PG8_MMA(0, 1, At, B1); PG8_BAR;
            PG8_LDA(At, 1, 1); PG8_STAGE(PG8_SA(1, 0), a3, voffA);
            PG8_BAR; PG8_WAIT_L(0); PG8_MMA(1, 0, At, B0); PG8_BAR; PG8_SCHED;
            PG8_STAGE(PG8_SB(1, 1), b3 + hstepB, voffB);
            PG8_WAIT_V(6); PG8_BAR; PG8_MMA(1, 1, At, B1); PG8_BAR;
            }
        }
        if constexpr (ALIGN_EPI) { if (wr == 0) PG8_BAR; }
        if constexpr (!Epi::AFTER_DRAIN) { E(acc, cur, wr, wc, fr, fq); S.done(cur); }
        const bool keep_acc = Epi::TWOPASS && (cur.pass == 0);
        if (!has_next) break;
        if (!keep_acc) {
#pragma unroll
        for (int a = 0; a < 2; ++a)
#pragma unroll
            for (int b = 0; b < 2; ++b)
#pragma unroll
                for (int m = 0; m < 4; ++m)
#pragma unroll
                    for (int n = 0; n < 2; ++n) acc[a][b][m][n] = (f32x4){0.f, 0.f, 0.f, 0.f};
        }
        cur = nxt; cA = nA; cB = nB; ++ui;
        if constexpr (ALIGN_EPI) { if (wr == 1) PG8_BAR; }
    }
    PG8_WAIT_V(0);
    if constexpr (!ALIGN_EPI) { if (wr == 0) PG8_BAR; }
    PG8_BAR;
    if constexpr (Epi::AFTER_DRAIN) { E.fused(acc, cur, wr, wc, fr, fq, lds, wid, lane); S.done(cur); }
#undef PG8_SA
#undef PG8_SB
#undef PG8_STAGE
#undef PG8_LDA
#undef PG8_LDB
#undef PG8_MMA
#undef PG8_WAIT_V
#undef PG8_WAIT_L
#undef PG8_BAR
#undef PG8_SCHED
}
}


constexpr int NWAVES = 8, NTHREADS = 512;
constexpr int BATCH = 8, SEQ = 4096, T = BATCH * SEQ, DM = 1024;
constexpr int INW = 5448;
constexpr int NPROJ = 5632;
constexpr int LD_HG = 2048, LD_ATT = 768, LD_IDX = 640, LD_GATE = 2048;
constexpr int TOPK = 256;
constexpr int NEXP = 16384;
constexpr float RMS_EPS = 1e-6f;

constexpr size_t MiB = 1u << 20;
constexpr size_t WS_CTL = 0;
constexpr size_t WS_MOD = MiB / 4;
constexpr size_t WS_MODP = MiB / 2;
constexpr size_t WS_WIN = 2 * MiB;
constexpr size_t WS_WAB = 13 * MiB;
constexpr size_t WS_WOUT = 15 * MiB;
constexpr size_t WS_WQ = 17 * MiB;
constexpr size_t WS_SK = 21 * MiB;
constexpr size_t WS_U = 22 * MiB;
constexpr size_t WS_V = 54 * MiB;
constexpr size_t WS_H = 86 * MiB;
constexpr size_t WS_HG = 150 * MiB;
constexpr size_t WS_ATT = 278 * MiB;
constexpr size_t WS_IDX = 326 * MiB;
constexpr size_t WS_GATE = 366 * MiB;
constexpr size_t WS_SEL = 494 * MiB;
constexpr size_t WS_END = 510 * MiB;
constexpr size_t WS_MERGED = WS_HG;
constexpr size_t WS_Q = 214 * MiB;
constexpr size_t WS_EIDX = WS_HG;
constexpr size_t WS_GATES = WS_HG + 16 * MiB;

constexpr int LDS_BYTES = 147456;

typedef unsigned short bf16;
typedef unsigned v4u __attribute__((ext_vector_type(4)));
typedef unsigned v2u __attribute__((ext_vector_type(2)));
typedef float f32x4 __attribute__((ext_vector_type(4)));
typedef float f32x2 __attribute__((ext_vector_type(2)));
typedef short bf16x8 __attribute__((ext_vector_type(8)));
#define LAS __attribute__((address_space(3)))

struct Params {
    const float *x, *c, *w_ada, *b_ada, *norm1_g, *norm2_g, *w_in, *hg_lb, *hg_onorm_g, *q_norm_g, *k_norm_g,
                *w_a, *w_b, *w_out, *peer_wq, *peer_subkeys, *peer_u, *peer_v;
    float* out; unsigned char* ws; int ph_lo, ph_hi;
};

__device__ __forceinline__ unsigned f2bf(float f) { unsigned u = __builtin_bit_cast(unsigned, f); return (u + 0x7fffu + ((u >> 16) & 1u)) >> 16; }
__device__ __forceinline__ unsigned pk2(float lo, float hi) { return f2bf(lo) | (f2bf(hi) << 16); }
__device__ __forceinline__ float bf2f(unsigned u16v) { return __builtin_bit_cast(float, u16v << 16); }
__device__ __forceinline__ float bflo(unsigned w) { return __builtin_bit_cast(float, w << 16); }
__device__ __forceinline__ float bfhi(unsigned w) { return __builtin_bit_cast(float, w & 0xffff0000u); }
__device__ __forceinline__ float sigmoidf_(float x) { return 1.f / (1.f + __expf(-x)); }
__device__ __forceinline__ float siluf_(float x) { return x / (1.f + __expf(-x)); }
__device__ __forceinline__ float wave_sum(float v) {
#pragma unroll
    for (int o = 1; o < 64; o <<= 1) v += __shfl_xor(v, o);
    return v;
}
__device__ __forceinline__ float wave_max(float v) {
#pragma unroll
    for (int o = 1; o < 64; o <<= 1) v = fmaxf(v, __shfl_xor(v, o));
    return v;
}
#define LDS_WAIT() asm volatile("s_waitcnt lgkmcnt(0)" ::: "memory")

struct EpiProj {
    static constexpr bool PERM = true, AFTER_DRAIN = false, TWOPASS = false;
    bf16 *HG, *ATT, *IDX, *GATE;
    __device__ __forceinline__ void operator()(const pg8::f32x4 (&acc)[2][2][4][2], const pg8::Unit& u, int wr, int wc, int fr, int fq) const {
        const int pn = u.pn; bf16* base; int ldc, colt, ncols;
        if (pn < 8) { base = HG; ldc = LD_HG; colt = pn * 256; ncols = LD_HG; }
        else if (pn < 11) { base = ATT; ldc = LD_ATT; colt = (pn - 8) * 256; ncols = LD_ATT; }
        else if (pn < 14) { base = IDX; ldc = LD_IDX; colt = (pn - 11) * 256; ncols = LD_IDX; }
        else { base = GATE; ldc = LD_GATE; colt = (pn - 14) * 256; ncols = LD_GATE; }
        const int row0 = u.pm * 256 + wr * 64 + fr, col0 = colt + wc * 32 + 8 * fq;
#pragma unroll
        for (int ai = 0; ai < 2; ++ai)
#pragma unroll
            for (int m = 0; m < 4; ++m) { bf16* rowp = base + (size_t)(row0 + ai * 128 + m * 16) * ldc + col0;
#pragma unroll
                for (int bj = 0; bj < 2; ++bj) { const pg8::f32x4 v0 = acc[ai][bj][m][0], v1 = acc[ai][bj][m][1];
                    v4u w; w.x = pk2(v0[0], v0[1]); w.y = pk2(v0[2], v0[3]); w.z = pk2(v1[0], v1[1]); w.w = pk2(v1[2], v1[3]);
                    if (col0 + bj * 128 < ncols) *(v4u*)(rowp + bj * 128) = w; } }
    }
};
struct EpiMerged {
    static constexpr bool PERM = true, AFTER_DRAIN = false, TWOPASS = true;
    const bf16* GATE; bf16* O;
    __device__ __forceinline__ void operator()(pg8::f32x4 (&acc)[2][2][4][2], const pg8::Unit& u, int wr, int wc, int fr, int fq) const {
        const int row0 = u.pm * 256 + wr * 64 + fr, col0 = u.pn * 256 + wc * 32 + 8 * fq;
        if (u.pass == 0) {
#pragma unroll
            for (int ai = 0; ai < 2; ++ai)
#pragma unroll
                for (int m = 0; m < 4; ++m) { const bf16* rowp = GATE + (size_t)(row0 + ai * 128 + m * 16) * LD_GATE + col0;
#pragma unroll
                    for (int bj = 0; bj < 2; ++bj) { const v4u a = *(const v4u*)(rowp + bj * 128), b = *(const v4u*)(rowp + 1024 + bj * 128);
                        float r[8];
#pragma unroll
                        for (int i = 0; i < 4; ++i) { const float a0 = bflo(a[i]), a1 = bfhi(a[i]), b0 = bflo(b[i]), b1 = bfhi(b[i]);
                            r[2 * i] = (1.f + __expf(-b0)) / (1.f + __expf(-a0)); r[2 * i + 1] = (1.f + __expf(-b1)) / (1.f + __expf(-a1)); }
#pragma unroll
                        for (int i = 0; i < 4; ++i) { acc[ai][bj][m][0][i] *= r[i]; acc[ai][bj][m][1][i] *= r[4 + i]; } } }
        } else {
#pragma unroll
            for (int ai = 0; ai < 2; ++ai)
#pragma unroll
                for (int m = 0; m < 4; ++m) { const size_t ro = (size_t)(row0 + ai * 128 + m * 16);
#pragma unroll
                    for (int bj = 0; bj < 2; ++bj) { const v4u b = *(const v4u*)(GATE + ro * LD_GATE + 1024 + col0 + bj * 128);
                        const pg8::f32x4 v0 = acc[ai][bj][m][0], v1 = acc[ai][bj][m][1];
                        float s[8];
#pragma unroll
                        for (int i = 0; i < 4; ++i) { s[2 * i] = sigmoidf_(bflo(b[i])); s[2 * i + 1] = sigmoidf_(bfhi(b[i])); }
                        v4u w; w.x = pk2(v0[0] * s[0], v0[1] * s[1]); w.y = pk2(v0[2] * s[2], v0[3] * s[3]); w.z = pk2(v1[0] * s[4], v1[1] * s[5]); w.w = pk2(v1[2] * s[6], v1[3] * s[7]);
                        *(v4u*)(O + ro * 1024 + col0 + bj * 128) = w; } }
        }
    }
};
struct EpiResid {
    static constexpr bool PERM = true, AFTER_DRAIN = false, TWOPASS = false;
    const float* X; const float* G1  ; float* O;
    __device__ __forceinline__ void operator()(const pg8::f32x4 (&acc)[2][2][4][2], const pg8::Unit& u, int wr, int wc, int fr, int fq) const {
        const int row0 = u.pm * 256 + wr * 64 + fr, col0 = u.pn * 256 + wc * 32 + 8 * fq;
        const int b = (u.pm * 256) / SEQ;
        f32x4 g[2][2];
#pragma unroll
        for (int bj = 0; bj < 2; ++bj)
#pragma unroll
            for (int n = 0; n < 2; ++n) g[bj][n] = *(const f32x4*)(G1 + (size_t)b * 6144 + col0 + bj * 128 + 4 * n);
#pragma unroll
        for (int ai = 0; ai < 2; ++ai)
#pragma unroll
            for (int m = 0; m < 4; ++m) { const size_t ro = (size_t)(row0 + ai * 128 + m * 16) * DM + col0;
#pragma unroll
                for (int bj = 0; bj < 2; ++bj)
#pragma unroll
                    for (int n = 0; n < 2; ++n) { const f32x4 xv = *(const f32x4*)(X + ro + bj * 128 + 4 * n);
                        *(f32x4*)(O + ro + bj * 128 + 4 * n) = xv + g[bj][n] * acc[ai][bj][m][n]; } }
    }
};
struct EpiStore {
    static constexpr bool PERM = true, AFTER_DRAIN = false, TWOPASS = false;
    bf16* O; int ldc;
    __device__ __forceinline__ void operator()(const pg8::f32x4 (&acc)[2][2][4][2], const pg8::Unit& u, int wr, int wc, int fr, int fq) const {
        const int row0 = u.pm * 256 + wr * 64 + fr, col0 = u.pn * 256 + wc * 32 + 8 * fq;
#pragma unroll
        for (int ai = 0; ai < 2; ++ai)
#pragma unroll
            for (int m = 0; m < 4; ++m) { bf16* rowp = O + (size_t)(row0 + ai * 128 + m * 16) * ldc + col0;
#pragma unroll
                for (int bj = 0; bj < 2; ++bj) { const pg8::f32x4 v0 = acc[ai][bj][m][0], v1 = acc[ai][bj][m][1];
                    v4u w; w.x = pk2(v0[0], v0[1]); w.y = pk2(v0[2], v0[3]); w.z = pk2(v1[0], v1[1]); w.w = pk2(v1[2], v1[3]);
                    *(v4u*)(rowp + bj * 128) = w; } }
    }
};

template <int MODE> __device__ __forceinline__ int srcmap(int np) { if (MODE == 1) return np < 3400 ? np : (np >= 3584 ? np - 184 : -1); return np; }
template <int MODE>
__device__ __forceinline__ void transpose_item(const float* W, int N, bf16* WT, int ldw, int koff, float* scr, int kb, int nb, int lane) {
    const int k0 = 64 * kb, n0 = 32 * nb;
    const int sc = srcmap<MODE>(n0 + (lane & 31));
#pragma unroll 8
    for (int i = 0; i < 32; ++i) { const int kk = 2 * i + (lane >> 5); scr[kk * 33 + (lane & 31)] = (sc >= 0) ? W[(size_t)(k0 + kk) * N + sc] : 0.f; }
    LDS_WAIT(); __builtin_amdgcn_wave_barrier();
    const int c = lane & 7;
#pragma unroll
    for (int j = 0; j < 4; ++j) { const int n = (lane >> 3) + 8 * j; const float* s = scr + (8 * c) * 33 + n;
        v4u o; o.x = pk2(s[0 * 33], s[1 * 33]); o.y = pk2(s[2 * 33], s[3 * 33]); o.z = pk2(s[4 * 33], s[5 * 33]); o.w = pk2(s[6 * 33], s[7 * 33]);
        *(v4u*)(WT + (size_t)(n0 + n) * ldw + koff + k0 + 8 * c) = o; }
    LDS_WAIT(); __builtin_amdgcn_wave_barrier();
}
__device__ __forceinline__ void convert_plain(const float* src, bf16* dst, size_t n, size_t gtid, size_t nth) {
    const size_t n8 = n / 8;
    for (size_t i = gtid; i < n8; i += nth) { const f32x4 a = ((const f32x4*)src)[2 * i], b = ((const f32x4*)src)[2 * i + 1];
        v4u o; o.x = pk2(a[0], a[1]); o.y = pk2(a[2], a[3]); o.z = pk2(b[0], b[1]); o.w = pk2(b[2], b[3]); ((v4u*)dst)[i] = o; }
}
__device__ __forceinline__ void phase0(const Params& p, unsigned char* lds) {
    const int tid = threadIdx.x, wave = tid >> 6, lane = tid & 63, G = gridDim.x;
    const int gw = blockIdx.x * NWAVES + wave, NGW = G * NWAVES;
    float* scr = (float*)(lds + wave * 16384);
    unsigned char* ws = p.ws;
    constexpr int I_IN = 16 * (NPROJ / 32), I_A = 8 * 32, I_O = 16 * 32, I_Q = 16 * 64;
    constexpr int NT = I_IN + 2 * I_A + I_O + I_Q;
    for (int it = gw; it < NT; it += NGW) {
        int r = it;
        if (r < I_IN) { transpose_item<1>(p.w_in, INW, (bf16*)(ws + WS_WIN), 1024, 0, scr, r / (NPROJ / 32), r % (NPROJ / 32), lane); continue; } r -= I_IN;
        if (r < I_A) { transpose_item<0>(p.w_a, 1024, (bf16*)(ws + WS_WAB), 1024, 0, scr, r / 32, r % 32, lane); continue; } r -= I_A;
        if (r < I_A) { transpose_item<0>(p.w_b, 1024, (bf16*)(ws + WS_WAB), 1024, 512, scr, r / 32, r % 32, lane); continue; } r -= I_A;
        if (r < I_O) { transpose_item<0>(p.w_out, 1024, (bf16*)(ws + WS_WOUT), 1024, 0, scr, r / 32, r % 32, lane); continue; } r -= I_O;
        transpose_item<0>(p.peer_wq, 2048, (bf16*)(ws + WS_WQ), 1024, 0, scr, r / 64, r % 64, lane);
    }
    for (int it = gw; it < 96 * 8; it += NGW) {
        const int cgp = it % 96, ks = it / 96, col = cgp * 64 + lane, k0 = ks * 128;
#pragma unroll
        for (int i = 0; i < 16; ++i) { const int e = i * 64 + lane, b = e >> 7, k = e & 127; scr[e] = siluf_(p.c[b * 1024 + k0 + k]); }
        LDS_WAIT(); __builtin_amdgcn_wave_barrier();
        float acc[8];
#pragma unroll
        for (int b = 0; b < 8; ++b) acc[b] = 0.f;
#pragma unroll 4
        for (int k = 0; k < 128; ++k) { const float w = p.w_ada[(size_t)(k0 + k) * 6144 + col];
#pragma unroll
            for (int b = 0; b < 8; ++b) acc[b] += scr[b * 128 + k] * w; }
        float* mp = (float*)(ws + WS_MODP) + (size_t)ks * 8 * 6144 + col;
#pragma unroll
        for (int b = 0; b < 8; ++b) mp[b * 6144] = acc[b];
        LDS_WAIT(); __builtin_amdgcn_wave_barrier();
    }
    const size_t gtid = (size_t)blockIdx.x * NTHREADS + tid, nth = (size_t)G * NTHREADS;
    convert_plain(p.peer_subkeys, (bf16*)(ws + WS_SK), (size_t)16 * 128 * 128, gtid, nth);
    convert_plain(p.peer_u, (bf16*)(ws + WS_U), (size_t)NEXP * DM, gtid, nth);
    convert_plain(p.peer_v, (bf16*)(ws + WS_V), (size_t)NEXP * DM, gtid, nth);
}

template <bool FIRST>
__device__ __forceinline__ void normmod_phase(const Params& p, unsigned char* lds, const float* src, bf16* dst, const float* gvec, int shift_off, int scale_off) {
    const int tid = threadIdx.x, wave = tid >> 6, lane = tid & 63, G = gridDim.x;
    unsigned char* ws = p.ws;
    float* A = (float*)lds;
    float* Bv = A + 1024;
    const float* MODP = (const float*)(ws + WS_MODP);
    float* MOD = (float*)(ws + WS_MOD);
    if (FIRST) {
        for (int e = blockIdx.x * NTHREADS + tid; e < 8 * 6144; e += G * NTHREADS) { const int col = e % 6144; float s = p.b_ada[col];
#pragma unroll
            for (int ks = 0; ks < 8; ++ks) s += MODP[(size_t)ks * 8 * 6144 + e];
            MOD[e] = s; }
    }
    int curb = -1;
    for (int chunk = blockIdx.x; chunk < T / 128; chunk += G) {
        const int b = (chunk * 128) / SEQ;
        if (b != curb) {
            __syncthreads();
            for (int col = tid; col < 1024; col += NTHREADS) {
                float sc, sh;
                if (FIRST) { sc = p.b_ada[scale_off + col]; sh = p.b_ada[shift_off + col];
#pragma unroll
                    for (int ks = 0; ks < 8; ++ks) { sc += MODP[(size_t)(ks * 8 + b) * 6144 + scale_off + col]; sh += MODP[(size_t)(ks * 8 + b) * 6144 + shift_off + col]; } }
                else { sc = MOD[b * 6144 + scale_off + col]; sh = MOD[b * 6144 + shift_off + col]; }
                A[col] = gvec[col] * (1.f + sc); Bv[col] = sh; }
            __syncthreads(); curb = b;
        }
        for (int r = wave; r < 128; r += NWAVES) {
            const size_t row = (size_t)chunk * 128 + r;
            const f32x4* xr = (const f32x4*)(src + row * DM) + lane;
            f32x4 v[4]; float s = 0.f;
#pragma unroll
            for (int j = 0; j < 4; ++j) { v[j] = xr[64 * j]; s += (v[j][0] * v[j][0] + v[j][1] * v[j][1]) + (v[j][2] * v[j][2] + v[j][3] * v[j][3]); }
            const float rstd = rsqrtf(wave_sum(s) * (1.f / DM) + RMS_EPS);
            v2u* o8 = (v2u*)(dst + row * DM) + lane;
#pragma unroll
            for (int j = 0; j < 4; ++j) { const int c0 = 4 * lane + 256 * j; const f32x4 a = *(const f32x4*)(A + c0), sh = *(const f32x4*)(Bv + c0);
                v2u o; o.x = pk2(v[j][0] * rstd * a[0] + sh[0], v[j][1] * rstd * a[1] + sh[1]); o.y = pk2(v[j][2] * rstd * a[2] + sh[2], v[j][3] * rstd * a[3] + sh[3]);
                o8[64 * j] = o; }
        }
    }
    __syncthreads();
}

__device__ __forceinline__ void hgrn_item(const Params& p, unsigned char* lds, int item) {
    const int b = item >> 2, h = item & 3;
    const int tid = threadIdx.x, w = tid >> 6, lane = tid & 63;
    unsigned char* ws = p.ws;
    const bf16* HG = (const bf16*)(ws + WS_HG);
    bf16* YA = (bf16*)(ws + WS_H);
    float* sq = (float*)lds;
    float* sf = sq + 16 * 128;
    float* sk = sf + 16 * 128;
    float* red = sk + 16 * 128;
    const int stok = tid >> 5, sd4 = (tid & 31) * 4;
    float lb[4], og[4];
#pragma unroll
    for (int i = 0; i < 4; ++i) { const float a0 = p.hg_lb[h * 128 + sd4 + i], a1 = p.hg_lb[512 + h * 128 + sd4 + i]; lb[i] = 1.f / (1.f + __expf(a1 - a0)); og[i] = p.hg_onorm_g[sd4 + i]; }
    float S0[16], S1[16];
#pragma unroll
    for (int i = 0; i < 16; ++i) { S0[i] = 0.f; S1[i] = 0.f; }
    for (int chunk = 0; chunk < SEQ / 16; ++chunk) {
        const size_t row0 = (size_t)b * SEQ + chunk * 16;
        { const bf16* rp = HG + (row0 + stok) * LD_HG + h * 128 + sd4;
          const v2u qv = *(const v2u*)rp, fv = *(const v2u*)(rp + 512);
          const float qq[4] = {bflo(qv.x), bfhi(qv.x), bflo(qv.y), bfhi(qv.y)}, ff[4] = {bflo(fv.x), bfhi(fv.x), bflo(fv.y), bfhi(fv.y)};
          f32x4 q4, f4, k4;
#pragma unroll
          for (int i = 0; i < 4; ++i) { q4[i] = siluf_(qq[i]); const float f = lb[i] + (1.f - lb[i]) * sigmoidf_(ff[i]); f4[i] = f; k4[i] = 1.f - f; }
          *(f32x4*)(sq + stok * 128 + sd4) = q4; *(f32x4*)(sf + stok * 128 + sd4) = f4; *(f32x4*)(sk + stok * 128 + sd4) = k4; }
        unsigned vv[16];
#pragma unroll
        for (int tk = 0; tk < 16; ++tk) vv[tk] = *(const unsigned*)(HG + (row0 + tk) * LD_HG + 1024 + h * 128 + 2 * lane);
        __syncthreads();
#pragma unroll 2
        for (int tk = 0; tk < 16; ++tk) {
            const float v0 = bflo(vv[tk]), v1 = bfhi(vv[tk]);
            float o0 = 0.f, o1 = 0.f;
#pragma unroll
            for (int i4 = 0; i4 < 4; ++i4) {
                const f32x4 q4 = *(const f32x4*)(sq + tk * 128 + w * 16 + i4 * 4), f4 = *(const f32x4*)(sf + tk * 128 + w * 16 + i4 * 4), k4 = *(const f32x4*)(sk + tk * 128 + w * 16 + i4 * 4);
#pragma unroll
                for (int i = 0; i < 4; ++i) { const int d = i4 * 4 + i;
                    S0[d] = f4[i] * S0[d] + k4[i] * v0; S1[d] = f4[i] * S1[d] + k4[i] * v1;
                    o0 += q4[i] * S0[d]; o1 += q4[i] * S1[d]; }
            }
            *(f32x2*)(red + (tk * 8 + w) * 128 + 2 * lane) = (f32x2){o0, o1};
        }
        __syncthreads();
        { f32x4 o = {0.f, 0.f, 0.f, 0.f};
#pragma unroll
          for (int ww = 0; ww < 8; ++ww) o += *(const f32x4*)(red + (stok * 8 + ww) * 128 + sd4);
          float ss = (o[0] * o[0] + o[1] * o[1]) + (o[2] * o[2] + o[3] * o[3]);
#pragma unroll
          for (int off = 1; off < 32; off <<= 1) ss += __shfl_xor(ss, off);
          const float rstd = rsqrtf(ss * (1.f / 128.f) + RMS_EPS);
          const v2u gv = *(const v2u*)(HG + (row0 + stok) * LD_HG + 1536 + h * 128 + sd4);
          const float gg[4] = {bflo(gv.x), bfhi(gv.x), bflo(gv.y), bfhi(gv.y)};
          float y[4];
#pragma unroll
          for (int i = 0; i < 4; ++i) y[i] = o[i] * rstd * og[i] * siluf_(gg[i]);
          v2u ov; ov.x = pk2(y[0], y[1]); ov.y = pk2(y[2], y[3]);
          *(v2u*)(YA + (row0 + stok) * 1024 + h * 128 + sd4) = ov; }
    }
    __syncthreads();
}

__device__ __forceinline__ unsigned f16key(float x) {
    x = x + 0.f;
    const _Float16 hx = (_Float16)x; const unsigned short bits = __builtin_bit_cast(unsigned short, hx);
    return (bits & 0x8000u) ? (unsigned)(unsigned short)(~bits) : (unsigned)(bits | 0x8000u);
}
__device__ __forceinline__ void find_bin(const unsigned* hist, int K, int lane, int& bin, int& rem) {
    const v4u hv = *(const v4u*)(hist + 4 * lane);
    const unsigned c = hv.x + hv.y + hv.z + hv.w;
    unsigned suf = c;
#pragma unroll
    for (int o = 1; o < 64; o <<= 1) { const unsigned t = __shfl_down(suf, o); if (lane + o < 64) suf += t; }
    const unsigned above = suf - c;
    const bool mine = (above < (unsigned)K) && ((unsigned)K <= suf);
    int mybin = 0, myrem = 0;
    if (mine) { unsigned ca = above; const unsigned hh[4] = {hv.x, hv.y, hv.z, hv.w}; bool found = false;
#pragma unroll
        for (int i = 3; i >= 0; --i) { if (!found) { if (ca + hh[i] >= (unsigned)K) { mybin = 4 * lane + i; myrem = K - (int)ca; found = true; } else ca += hh[i]; } } }
    const unsigned long long m = __ballot(mine);
    const int src = (int)__builtin_ctzll(m | (1ull << 63));
    bin = __shfl(mybin, src); rem = __shfl(myrem, src);
}
__device__ __forceinline__ void dsa1_item(const Params& p, unsigned char* lds, int item) {
    const int b = item >> 8, q0 = (item & 255) * 16;
    const int tid = threadIdx.x, w = tid >> 6, lane = tid & 63, fr = lane & 15, fq = lane >> 4;
    unsigned char* ws = p.ws;
    const bf16* IDX = (const bf16*)(ws + WS_IDX);
    unsigned short* SEL = (unsigned short*)(ws + WS_SEL);
    unsigned short* Ik = (unsigned short*)lds;
    unsigned* hist = (unsigned*)(lds + 131072) + w * 256;
    const size_t rowb = (size_t)b * SEQ;
    bf16x8 Af[8][2];
    { const bf16* rp = IDX + (rowb + q0 + fr) * LD_IDX + fq * 8;
#pragma unroll
      for (int h = 0; h < 8; ++h) { Af[h][0] = *(const bf16x8*)(rp + h * 64); Af[h][1] = *(const bf16x8*)(rp + h * 64 + 32); } }
    float wv[4][8];
    const float idx_scale = 0.125f * 0.35355339059327373f;
#pragma unroll
    for (int r = 0; r < 4; ++r) { const v4u wq = *(const v4u*)(IDX + (rowb + q0 + fq * 4 + r) * LD_IDX + 576);
#pragma unroll
        for (int i = 0; i < 4; ++i) { wv[r][2 * i] = bflo(wq[i]) * idx_scale; wv[r][2 * i + 1] = bfhi(wq[i]) * idx_scale; } }
    const int ntiles = (q0 >> 4) + 1;
    for (int kt = w; kt < ntiles; kt += NWAVES) {
        const bf16* kp = IDX + (rowb + kt * 16 + fr) * LD_IDX + 512 + fq * 8;
        const bf16x8 B0 = *(const bf16x8*)kp, B1 = *(const bf16x8*)(kp + 32);
        float I[4] = {0.f, 0.f, 0.f, 0.f};
#pragma unroll
        for (int h = 0; h < 8; ++h) { pg8::f32x4 a = {0.f, 0.f, 0.f, 0.f};
            a = __builtin_amdgcn_mfma_f32_16x16x32_bf16(Af[h][0], B0, a, 0, 0, 0);
            a = __builtin_amdgcn_mfma_f32_16x16x32_bf16(Af[h][1], B1, a, 0, 0, 0);
#pragma unroll
            for (int r = 0; r < 4; ++r) I[r] += wv[r][h] * fmaxf(a[r], 0.f); }
#pragma unroll
        for (int r = 0; r < 4; ++r) Ik[(fq * 4 + r) * 4096 + kt * 16 + fr] = (unsigned short)f16key(I[r]);
    }
    __syncthreads();
    for (int qq = w; qq < 16; qq += NWAVES) {
        const int t = q0 + qq, n = t + 1;
        unsigned short* so = SEL + (rowb + t) * TOPK;
        const unsigned short* keys = Ik + qq * 4096;
        if (n <= TOPK) { for (int j = lane; j < n; j += 64) so[j] = (unsigned short)j; }
        else {
            int b1, rem1, b2, rem2;
            *(v4u*)(hist + 4 * lane) = (v4u){0u, 0u, 0u, 0u};
            LDS_WAIT(); __builtin_amdgcn_wave_barrier();
            for (int j = lane; j < n; j += 64) atomicAdd(&hist[keys[j] >> 8], 1u);
            LDS_WAIT(); __builtin_amdgcn_wave_barrier();
            find_bin(hist, TOPK, lane, b1, rem1);
            __builtin_amdgcn_wave_barrier();
            *(v4u*)(hist + 4 * lane) = (v4u){0u, 0u, 0u, 0u};
            LDS_WAIT(); __builtin_amdgcn_wave_barrier();
            for (int j = lane; j < n; j += 64) { const unsigned k = keys[j]; if ((int)(k >> 8) == b1) atomicAdd(&hist[k & 255u], 1u); }
            LDS_WAIT(); __builtin_amdgcn_wave_barrier();
            find_bin(hist, rem1, lane, b2, rem2);
            const unsigned thr = ((unsigned)b1 << 8) | (unsigned)b2;
            int base = 0, eqtaken = 0;
            const unsigned long long lt = (lane == 0) ? 0ull : (~0ull >> (64 - lane));
            for (int j0 = 0; j0 < n; j0 += 64) {
                const int j = j0 + lane; const bool valid = j < n; const unsigned k = valid ? (unsigned)keys[j] : 0u;
                const bool gt = valid && k > thr, eq = valid && k == thr;
                const unsigned long long meq = __ballot(eq);
                const int erank = __popcll(meq & lt) + eqtaken;
                const bool take = gt || (eq && erank < rem2);
                const unsigned long long mt = __ballot(take);
                if (take) so[base + __popcll(mt & lt)] = (unsigned short)j;
                base += __popcll(mt); eqtaken += __popcll(meq);
            }
        }
    }
    __syncthreads();
}

__device__ __forceinline__ void dsa2_query(const Params& p, unsigned char* ldsw, int b, int t, int lane) {
    unsigned char* ws = p.ws;
    const bf16* ATT = (const bf16*)(ws + WS_ATT);
    const unsigned short* SEL = (const unsigned short*)(ws + WS_SEL);
    bf16* YB = (bf16*)(ws + WS_H);
    float* qk = (float*)ldsw;
    float* pj = qk + 512;
    int* sl = (int*)(pj + 2048);
    const size_t rowb = (size_t)b * SEQ;
    const bf16* qrow = ATT + (rowb + t) * LD_ATT;
    const float qg = p.q_norm_g[lane], kg = p.k_norm_g[lane];
#pragma unroll
    for (int h = 0; h < 8; ++h) { const float x = bf2f(qrow[h * 64 + lane]); const float ss = wave_sum(x * x);
        qk[h * 64 + lane] = x * rsqrtf(ss * (1.f / 64.f) + RMS_EPS) * qg * 0.125f * kg; }
    const int cnt = (t + 1 < TOPK) ? (t + 1) : TOPK;
#pragma unroll
    for (int jj = 0; jj < 4; ++jj) { const int j = jj * 64 + lane; sl[j] = (j < cnt) ? (int)SEL[(rowb + t) * TOPK + j] : 0; }
    LDS_WAIT(); __builtin_amdgcn_wave_barrier();
#pragma unroll 1
    for (int jj = 0; jj < 4; ++jj) {
        const int j = jj * 64 + lane; const bool valid = j < cnt; const int s = sl[j];
        const bf16* krow = ATT + (rowb + s) * LD_ATT + 512;
        const float dist = (float)(t - s);
#pragma unroll 1
        for (int g = 0; g < 2; ++g) {
            float acc[4] = {0.f, 0.f, 0.f, 0.f}, ss = 0.f;
#pragma unroll 2
            for (int c = 0; c < 8; ++c) { const v4u kv = *(const v4u*)(krow + g * 64 + c * 8);
                float kf[8];
#pragma unroll
                for (int i = 0; i < 4; ++i) { kf[2 * i] = bflo(kv[i]); kf[2 * i + 1] = bfhi(kv[i]); }
#pragma unroll
                for (int i = 0; i < 8; ++i) ss += kf[i] * kf[i];
#pragma unroll
                for (int hh = 0; hh < 4; ++hh) { const f32x4 qa = *(const f32x4*)(qk + (g * 4 + hh) * 64 + c * 8), qb = *(const f32x4*)(qk + (g * 4 + hh) * 64 + c * 8 + 4);
                    acc[hh] += (qa[0] * kf[0] + qa[1] * kf[1]) + (qa[2] * kf[2] + qa[3] * kf[3]) + (qb[0] * kf[4] + qb[1] * kf[5]) + (qb[2] * kf[6] + qb[3] * kf[7]); } }
            const float rstd = rsqrtf(ss * (1.f / 64.f) + RMS_EPS);
            f32x4 sv;
#pragma unroll
            for (int hh = 0; hh < 4; ++hh) { const float slope = exp2f(-(float)(g * 4 + hh + 1));
                sv[hh] = valid ? (acc[hh] * rstd - slope * dist) : -INFINITY; }
            *(f32x4*)(pj + j * 8 + g * 4) = sv;
        }
    }
    LDS_WAIT(); __builtin_amdgcn_wave_barrier();
#pragma unroll 1
    for (int h = 0; h < 8; ++h) {
        float sc4[4];
#pragma unroll
        for (int jj = 0; jj < 4; ++jj) sc4[jj] = pj[(jj * 64 + lane) * 8 + h];
        float m = fmaxf(fmaxf(sc4[0], sc4[1]), fmaxf(sc4[2], sc4[3])); m = wave_max(m);
        float e[4], l = 0.f;
#pragma unroll
        for (int jj = 0; jj < 4; ++jj) { e[jj] = __expf(sc4[jj] - m); l += e[jj]; }
        l = wave_sum(l); const float inv = 1.f / l;
#pragma unroll
        for (int jj = 0; jj < 4; ++jj) pj[(jj * 64 + lane) * 8 + h] = e[jj] * inv;
    }
    LDS_WAIT(); __builtin_amdgcn_wave_barrier();
#pragma unroll
    for (int g = 0; g < 2; ++g) {
        float o[4] = {0.f, 0.f, 0.f, 0.f};
        const bf16* vb = ATT + rowb * LD_ATT + 640 + g * 64 + lane;
#pragma unroll 4
        for (int j = 0; j < cnt; ++j) { const int s = sl[j]; const float v = bf2f(vb[(size_t)s * LD_ATT]); const f32x4 pp = *(const f32x4*)(pj + j * 8 + g * 4);
            o[0] += pp[0] * v; o[1] += pp[1] * v; o[2] += pp[2] * v; o[3] += pp[3] * v; }
#pragma unroll
        for (int hh = 0; hh < 4; ++hh) YB[(rowb + t) * 1024 + 512 + (g * 4 + hh) * 64 + lane] = (bf16)f2bf(o[hh]);
    }
    LDS_WAIT(); __builtin_amdgcn_wave_barrier();
}

__device__ __forceinline__ void cand_ab(int l, int& a, int& b) {
    if (l < 16) { a = 0; b = l; } else if (l < 24) { a = 1; b = l - 16; } else if (l < 29) { a = 2; b = l - 24; } else if (l < 33) { a = 3; b = l - 29; }
    else if (l < 36) { a = 4; b = l - 33; } else if (l < 38) { a = 5; b = l - 36; } else if (l < 40) { a = 6; b = l - 38; } else if (l < 42) { a = 7; b = l - 40; }
    else { a = 8 + (l - 42); b = 0; }
}
__device__ __forceinline__ void peer_route_item(const Params& p, unsigned char* ldsw, int tg, int h, int lane) {
    unsigned char* ws = p.ws;
    const bf16* Q = (const bf16*)(ws + WS_Q);
    const bf16* SK = (const bf16*)(ws + WS_SK);
    int* EIDX = (int*)(ws + WS_EIDX);
    float* GATES = (float*)(ws + WS_GATES);
    float* sc = (float*)ldsw;
    float* ts = sc + 2048;
    int* ti = (int*)(ts + 512);
    float* cv = (float*)(ti + 512);
    float* os = cv + 64;
    const int fr = lane & 15, fq = lane >> 4;
    for (int pp = 0; pp < 2; ++pp) {
        bf16x8 Af[4];
        { const bf16* rp = Q + (size_t)(tg * 16 + fr) * 2048 + h * 256 + pp * 128 + fq * 8;
#pragma unroll
          for (int ks = 0; ks < 4; ++ks) Af[ks] = *(const bf16x8*)(rp + ks * 32); }
#pragma unroll
        for (int kt = 0; kt < 8; ++kt) {
            const bf16* kp = SK + (size_t)((h * 2 + pp) * 128 + kt * 16 + fr) * 128 + fq * 8;
            pg8::f32x4 a = {0.f, 0.f, 0.f, 0.f};
#pragma unroll
            for (int ks = 0; ks < 4; ++ks) a = __builtin_amdgcn_mfma_f32_16x16x32_bf16(Af[ks], *(const bf16x8*)(kp + ks * 32), a, 0, 0, 0);
#pragma unroll
            for (int r = 0; r < 4; ++r) sc[(fq * 4 + r) * 128 + kt * 16 + fr] = a[r];
        }
        LDS_WAIT(); __builtin_amdgcn_wave_barrier();
        for (int tok = 0; tok < 16; ++tok) {
            const float v0 = sc[tok * 128 + lane], v1 = sc[tok * 128 + 64 + lane];
            int r0 = 0, r1 = 0;
#pragma unroll 8
            for (int i = 0; i < 128; i += 4) { const f32x4 x = *(const f32x4*)(sc + tok * 128 + i);
#pragma unroll
                for (int c = 0; c < 4; ++c) { const int idx = i + c;
                    r0 += (x[c] > v0 || (x[c] == v0 && idx < lane)) ? 1 : 0;
                    r1 += (x[c] > v1 || (x[c] == v1 && idx < lane + 64)) ? 1 : 0; } }
            if (r0 < 16) { ts[(pp * 16 + tok) * 16 + r0] = v0; ti[(pp * 16 + tok) * 16 + r0] = lane; }
            if (r1 < 16) { ts[(pp * 16 + tok) * 16 + r1] = v1; ti[(pp * 16 + tok) * 16 + r1] = lane + 64; }
        }
        LDS_WAIT(); __builtin_amdgcn_wave_barrier();
    }
    int ca, cb; cand_ab(lane < 50 ? lane : 0, ca, cb);
    const int flat = ca * 16 + cb;
    for (int tok = 0; tok < 16; ++tok) {
        const float val = (lane < 50) ? ts[(0 * 16 + tok) * 16 + ca] + ts[(1 * 16 + tok) * 16 + cb] : -INFINITY;
        cv[lane] = val;
        LDS_WAIT(); __builtin_amdgcn_wave_barrier();
        int rank = 0;
        for (int l2 = 0; l2 < 50; ++l2) { const float x = cv[l2]; int a2, b2; cand_ab(l2, a2, b2); const int f2 = a2 * 16 + b2;
            rank += (x > val || (x == val && f2 < flat)) ? 1 : 0; }
        const size_t ob = ((size_t)(tg * 16 + tok) * 8 + h) * 16;
        if (lane < 50 && rank < 16) { os[rank] = val; EIDX[ob + rank] = ti[(0 * 16 + tok) * 16 + ca] * 128 + ti[(1 * 16 + tok) * 16 + cb]; }
        LDS_WAIT(); __builtin_amdgcn_wave_barrier();
        { const float v = os[lane & 15]; float m = v;
#pragma unroll
          for (int o = 1; o < 16; o <<= 1) m = fmaxf(m, __shfl_xor(m, o));
          const float e = __expf(v - m); float l = e;
#pragma unroll
          for (int o = 1; o < 16; o <<= 1) l += __shfl_xor(l, o);
          if (lane < 16) GATES[ob + lane] = e / l; }
        LDS_WAIT(); __builtin_amdgcn_wave_barrier();
    }
}

__device__ __forceinline__ void peer_token(const Params& p, int tok, int lane) {
    unsigned char* ws = p.ws;
    const bf16* H2 = (const bf16*)(ws + WS_H);
    const bf16* U = (const bf16*)(ws + WS_U);
    const bf16* V = (const bf16*)(ws + WS_V);
    const int* EIDX = (const int*)(ws + WS_EIDX);
    const float* GATES = (const float*)(ws + WS_GATES);
    const float* MOD = (const float*)(ws + WS_MOD);
    float hv[16];
    { const v4u a = *(const v4u*)(H2 + (size_t)tok * DM + lane * 8), b = *(const v4u*)(H2 + (size_t)tok * DM + 512 + lane * 8);
#pragma unroll
      for (int i = 0; i < 4; ++i) { hv[2 * i] = bflo(a[i]); hv[2 * i + 1] = bfhi(a[i]); hv[8 + 2 * i] = bflo(b[i]); hv[8 + 2 * i + 1] = bfhi(b[i]); } }
    float acc[16];
#pragma unroll
    for (int i = 0; i < 16; ++i) acc[i] = 0.f;
#pragma unroll 4
    for (int e = 0; e < 128; ++e) {
        const int idx = EIDX[(size_t)tok * 128 + e]; const float g = GATES[(size_t)tok * 128 + e];
        const bf16* ur = U + (size_t)idx * DM + lane * 8; const bf16* vr = V + (size_t)idx * DM + lane * 8;
        const v4u u0 = *(const v4u*)ur, u1 = *(const v4u*)(ur + 512), v0 = *(const v4u*)vr, v1 = *(const v4u*)(vr + 512);
        float d = 0.f;
#pragma unroll
        for (int i = 0; i < 4; ++i) { d += hv[2 * i] * bflo(u0[i]) + hv[2 * i + 1] * bfhi(u0[i]); d += hv[8 + 2 * i] * bflo(u1[i]) + hv[8 + 2 * i + 1] * bfhi(u1[i]); }
        d = wave_sum(d);
        const float a = 0.5f * d * (1.f + erff(d * 0.70710678118654752f)) * g;
#pragma unroll
        for (int i = 0; i < 4; ++i) { acc[2 * i] += a * bflo(v0[i]); acc[2 * i + 1] += a * bfhi(v0[i]); acc[8 + 2 * i] += a * bflo(v1[i]); acc[8 + 2 * i + 1] += a * bfhi(v1[i]); }
    }
    const int b = tok / SEQ;
    const float* g2 = MOD + (size_t)b * 6144 + 5 * 1024;
    float* orow = p.out + (size_t)tok * DM;
#pragma unroll
    for (int hf = 0; hf < 2; ++hf)
#pragma unroll
        for (int q4 = 0; q4 < 2; ++q4) { const int c0 = hf * 512 + lane * 8 + q4 * 4; const f32x4 xv = *(const f32x4*)(orow + c0), gv = *(const f32x4*)(g2 + c0);
            f32x4 o;
#pragma unroll
            for (int i = 0; i < 4; ++i) o[i] = xv[i] + gv[i] * acc[hf * 8 + q4 * 4 + i];
            *(f32x4*)(orow + c0) = o; }
}

constexpr int NPHASE = 11;
__global__ void __launch_bounds__(NTHREADS, 2) mega(Params p) {
    extern __shared__ __attribute__((aligned(16))) unsigned char lds[];
    cg::grid_group grid = cg::this_grid();
    const int lo = p.ph_lo, hi = p.ph_hi;
    const int tid = threadIdx.x, wave = tid >> 6, lane = tid & 63, G = gridDim.x;
    unsigned char* ws = p.ws;
#ifndef ONLYPH
#define IN(k) (lo <= (k) && (k) < hi)
#else
#define IN(k) ((k) == ONLYPH && lo <= (k) && (k) < hi)
#endif
#define SEAM(k) do { if (IN((k) + 1)) grid.sync(); } while (0)
    if (IN(0)) { phase0(p, lds); SEAM(0); }
    if (IN(1)) { normmod_phase<true>(p, lds, p.x, (bf16*)(ws + WS_H), p.norm1_g, 0, 1024); SEAM(1); }
    if (IN(2)) {
        pg8::Gemm g{(const bf16*)(ws + WS_H), (const bf16*)(ws + WS_WIN), T, NPROJ, 1024, 1024, 1024}; pg8::StaticOrder S; S.init(T, NPROJ, G, (int)blockIdx.x);
        EpiProj E{(bf16*)(ws + WS_HG), (bf16*)(ws + WS_ATT), (bf16*)(ws + WS_IDX), (bf16*)(ws + WS_GATE)};
        pg8::gemm_phase<EpiProj, pg8::StaticOrder, true, true>((PG8_LAS unsigned char*)lds, g, S, E);
        SEAM(2);
    }
    if (IN(3)) {
        if ((int)blockIdx.x < 32) { hgrn_item(p, lds, (int)blockIdx.x); }
        else { for (int it = (int)blockIdx.x - 32; it < BATCH * (SEQ / 16); it += G - 32) dsa1_item(p, lds, it); }
        SEAM(3);
    }
    if (IN(4)) {
        for (int qi = blockIdx.x * NWAVES + wave; qi < T; qi += G * NWAVES) dsa2_query(p, lds + wave * 16384, qi / SEQ, qi % SEQ, lane);
        SEAM(4);
    }
    if (IN(5)) {
        pg8::Gemm g{(const bf16*)(ws + WS_H), (const bf16*)(ws + WS_WAB), T, 1024, 512, 1024, 1024}; pg8::StaticOrderT<true> S; S.init(T, 1024, G, (int)blockIdx.x);
        EpiMerged E{(const bf16*)(ws + WS_GATE), (bf16*)(ws + WS_MERGED)};
        pg8::gemm_phase<EpiMerged, pg8::StaticOrderT<true>, true, true>((PG8_LAS unsigned char*)lds, g, S, E);
        SEAM(5);
    }
    if (IN(6)) {
        pg8::Gemm g{(const bf16*)(ws + WS_MERGED), (const bf16*)(ws + WS_WOUT), T, 1024, 1024, 1024, 1024}; pg8::StaticOrder S; S.init(T, 1024, G, (int)blockIdx.x);
        EpiResid E{p.x, (const float*)(ws + WS_MOD) + 2048, p.out};
        pg8::gemm_phase<EpiResid, pg8::StaticOrder, true, true>((PG8_LAS unsigned char*)lds, g, S, E);
        SEAM(6);
    }
    if (IN(7)) { normmod_phase<false>(p, lds, p.out, (bf16*)(ws + WS_H), p.norm2_g, 3 * 1024, 4 * 1024); SEAM(7); }
    if (IN(8)) {
        pg8::Gemm g{(const bf16*)(ws + WS_H), (const bf16*)(ws + WS_WQ), T, 2048, 1024, 1024, 1024}; pg8::StaticOrder S; S.init(T, 2048, G, (int)blockIdx.x);
        EpiStore E{(bf16*)(ws + WS_Q), 2048};
        pg8::gemm_phase<EpiStore, pg8::StaticOrder, true, true>((PG8_LAS unsigned char*)lds, g, S, E);
        SEAM(8);
    }
    if (IN(9)) {
        for (int it = blockIdx.x * NWAVES + wave; it < (T / 16) * 8; it += G * NWAVES) peer_route_item(p, lds + wave * 16384, it >> 3, it & 7, lane);
        SEAM(9);
    }
    if (IN(10)) {
        for (int tok = blockIdx.x * NWAVES + wave; tok < T; tok += G * NWAVES) peer_token(p, tok, lane);
    }
#undef IN
#undef SEAM
}

#ifndef ONE_LAUNCH
#define ONE_LAUNCH 0
#endif
extern "C" void kernel_launch(void* const* d_in, const int* in_sizes, int n_in, void* d_out, int out_size, void* d_ws, size_t ws_size, hipStream_t stream) {
    static int grid = 0;
    if (grid == 0) {
        if (n_in != 18 || out_size != T * DM || ws_size < WS_END) { fprintf(stderr, "kernel_launch: unexpected shapes (n_in %d, out %d, ws %zu)\n", n_in, out_size, ws_size); grid = -1; return; }
        int dev = 0, cus = 0, per_cu = 0;
        if (hipGetDevice(&dev) != hipSuccess || hipDeviceGetAttribute(&cus, hipDeviceAttributeMultiprocessorCount, dev) != hipSuccess) { grid = -1; return; }
        if (hipFuncSetAttribute((const void*)mega, hipFuncAttributeMaxDynamicSharedMemorySize, LDS_BYTES) != hipSuccess) { fprintf(stderr, "kernel_launch: hipFuncSetAttribute failed\n"); grid = -1; return; }
        if (hipOccupancyMaxActiveBlocksPerMultiprocessor(&per_cu, (const void*)mega, NTHREADS, LDS_BYTES) != hipSuccess || per_cu < 1) { fprintf(stderr, "kernel_launch: occupancy query says %d\n", per_cu); grid = -1; return; }
        (void)hipGetLastError();
        grid = cus;
        if (grid < 64) { grid = -1; return; }
    }
    if (grid < 0) return;
    Params p{};
    const float** pp = (const float**)&p;
    for (int i = 0; i < 18; ++i) pp[i] = (const float*)d_in[i];
    p.out = (float*)d_out; p.ws = (unsigned char*)d_ws;
#if ONE_LAUNCH
    p.ph_lo = 0; p.ph_hi = NPHASE;
    void* args[] = {&p};
    hipError_t e = hipLaunchCooperativeKernel((const void*)mega, dim3(grid), dim3(NTHREADS), args, LDS_BYTES, stream);
    if (e != hipSuccess) fprintf(stderr, "cooperative launch failed: %s (grid %d)\n", hipGetErrorString(e), grid);
#else
    for (int k = 0; k < NPHASE; ++k) { p.ph_lo = k; p.ph_hi = k + 1; hipLaunchKernelGGL(mega, dim3(grid), dim3(NTHREADS), LDS_BYTES, stream, p); }
#endif
}
```

```cpp
#include <hip/hip_runtime.h>
#include <hip/hip_cooperative_groups.h>
#include <cstdio>
#include <cstdint>
namespace cg = cooperative_groups;

namespace pg8 {
#define PG8_LAS __attribute__((address_space(3)))
typedef unsigned short bf16_t;
typedef short bf16x8 __attribute__((ext_vector_type(8)));
typedef float f32x4 __attribute__((ext_vector_type(4)));
typedef unsigned u32x4 __attribute__((ext_vector_type(4)));
constexpr int BM = 256, BK = 64, HALF = 128, HTB = HALF * BK * 2  , STAGE_BYTES = 8 * HTB, NXCD = 8, WGM = 8;

__host__ __device__ __forceinline__ int lds_byte(int r, int c) { const int st = (r >> 4) * 2 + (c >> 5), rr = r & 15, cc = c & 31, ob = rr * 64 + cc * 2; return st * 1024 + (ob ^ (((ob >> 9) & 1) << 5)); }
__host__ __device__ __forceinline__ void stage_rc(int b, int& R, int& C) { const int st = b / 1024, sb = b % 1024, swz = sb ^ (((sb >> 9) & 1) << 5); R = (st >> 1) * 16 + swz / 64; C = (st & 1) * 32 + (swz % 64) / 2; }
__host__ __device__ __forceinline__ int perm32(int rho) { const int n = rho >> 4, i = rho & 15; return 8 * (i >> 2) + 4 * n + (i & 3); }

struct Unit { int pm, pn, ko, pass; };
struct Gemm { const bf16_t* A; const bf16_t* Bt; int M, N, K, lda, ldb; };
typedef float f32x16 __attribute__((ext_vector_type(16)));
typedef f32x16 AccW[2][2][2];
__device__ __forceinline__ f32x4 acc_get(const AccW& A, int ai, int bj, int m, int n) { const int s_ = ((m & 1) * 2 + n) * 4; const f32x16& w = A[ai][bj][m >> 1]; return (f32x4){w[s_], w[s_ + 1], w[s_ + 2], w[s_ + 3]}; }
__device__ __forceinline__ void acc_set(AccW& A, int ai, int bj, int m, int n, f32x4 v) { const int s_ = ((m & 1) * 2 + n) * 4; f32x16& w = A[ai][bj][m >> 1]; w[s_] = v[0]; w[s_ + 1] = v[1]; w[s_ + 2] = v[2]; w[s_ + 3] = v[3]; }

template <bool TWOPASS_ORDER = false>
struct StaticOrderT {
    int nM, nN, nwg, G, c, kpass;
    __host__ __device__ void init(int M, int N, int G_, int c_, int kpass_ = 512) { nM = M / BM; nN = N / BM; nwg = nM * nN; G = G_; c = c_; kpass = kpass_; }
    __host__ __device__ bool next(int i, Unit& u) const {
        const long L = (long)(TWOPASS_ORDER ? (i >> 1) : i) * G + c; if (L >= nwg) return false;
        u.pass = TWOPASS_ORDER ? (i & 1) : 0; u.ko = TWOPASS_ORDER ? (i & 1) * kpass : 0;
        int wgid = (int)L; { const int q = nwg / NXCD, r = nwg % NXCD, xcd = wgid % NXCD, off = wgid / NXCD; wgid = (xcd < r ? xcd * (q + 1) : r * (q + 1) + (xcd - r) * q) + off; }
        const int nig = WGM * nN, gid = wgid / nig, fm = gid * WGM, gsz = (nM - fm) < WGM ? (nM - fm) : WGM;
        u.pm = fm + ((wgid % nig) % gsz); u.pn = (wgid % nig) / gsz; return true;
    }
    __device__ __forceinline__ void a_ready(const Unit&) const {}
    __device__ __forceinline__ void done(const Unit&) const {}
};
typedef StaticOrderT<false> StaticOrder;

__device__ __forceinline__ unsigned cvt_pk_bf16(float lo, float hi) { unsigned r; asm volatile("v_cvt_pk_bf16_f32 %0, %1, %2" : "=v"(r) : "v"(lo), "v"(hi)); return r; }

template <class Epi, class Sched, bool ALIGN_EPI = false, bool SP2 = false, int F8SCALE = 0>
__device__ __forceinline__ void gemm_phase(PG8_LAS unsigned char* lds, const Gemm g, const Sched& S, const Epi& E) {
    const int tid = threadIdx.x, wid = __builtin_amdgcn_readfirstlane(tid >> 6), lane = tid & 63, wr = wid >> 2, wc = wid & 3, fr = lane & 15, fq = lane >> 4;
    const int K = g.K, nt = K / BK;
    unsigned voffA[2], voffB[2];
#pragma unroll
    for (int i = 0; i < 2; ++i) { int R, C; stage_rc(tid * 16 + i * 8192, R, C); const int Rb = Epi::PERM ? ((R & ~31) + perm32(R & 31)) : R;
        voffA[i] = (unsigned)(R * g.lda + C) * 2u; voffB[i] = (unsigned)(Rb * g.ldb + C) * 2u; }
    const size_t kstep = (size_t)(BK * 2);
    const size_t hstepA = (size_t)HALF * g.lda * 2, hstepB = (size_t)HALF * g.ldb * 2;
    const size_t tstepA = 2 * hstepA, tstepB = 2 * hstepB;
    const unsigned ldsw = (unsigned)wid * 1024u;
    const int aoff = lds_byte(wr * 64 + fr, fq * 8), boff = lds_byte(wc * 32 + fr, fq * 8);
#define PG8_SA(b, h) (((b) * 2 + (h)) * HTB)
#define PG8_SB(b, h) ((4 + (b) * 2 + (h)) * HTB)
#define PG8_STAGE(bufoff, gbase, voff) do { _Pragma("unroll") for (int _i = 0; _i < 2; ++_i) \
        __builtin_amdgcn_global_load_lds((const unsigned*)((const char*)(gbase) + (voff)[_i]), (PG8_LAS unsigned*)(lds + (bufoff) + ldsw + _i * 8192), 16, 0, 0); } while (0)
#define PG8_LDA(dst, b, h) do { _Pragma("unroll") for (int m = 0; m < 4; ++m) { if constexpr (F8SCALE != 0) { \
        PG8_F8(dst)[m].lo = *(const PG8_LAS v4i_f*)(lds + PG8_SA(b, h) + aoff + m * 2048); PG8_F8(dst)[m].hi = *(const PG8_LAS v4i_f*)(lds + PG8_SA(b, h) + aoff + m * 2048 + 1024); } \
        else { _Pragma("unroll") for (int k = 0; k < 2; ++k) dst[m][k] = *(const PG8_LAS bf16x8*)(lds + PG8_SA(b, h) + aoff + m * 2048 + k * 1024); } } } while (0)
#define PG8_LDB(dst, b, h) do { _Pragma("unroll") for (int n = 0; n < 2; ++n) { if constexpr (F8SCALE != 0) { \
        PG8_F8(dst)[n].lo = *(const PG8_LAS v4i_f*)(lds + PG8_SB(b, h) + boff + n * 2048); PG8_F8(dst)[n].hi = *(const PG8_LAS v4i_f*)(lds + PG8_SB(b, h) + boff + n * 2048 + 1024); } \
        else { _Pragma("unroll") for (int k = 0; k < 2; ++k) dst[n][k] = *(const PG8_LAS bf16x8*)(lds + PG8_SB(b, h) + boff + n * 2048 + k * 1024); } } } while (0)
#define PG8_MMA(ai, bj, At, Bt) do { __builtin_amdgcn_s_setprio(1); _Pragma("unroll") for (int m = 0; m < 4; ++m) _Pragma("unroll") for (int n = 0; n < 2; ++n) { \
        f32x4 _c = acc_get(accw, ai, bj, m, n); \
        if constexpr (F8SCALE != 0) { _c = __builtin_amdgcn_mfma_scale_f32_16x16x128_f8f6f4(PG8_F8(Bt)[n], PG8_F8(At)[m], _c, 0, 0, 0, 0x7f7f7f7f, 0, F8SCALE * 0x01010101); } \
        else { _Pragma("unroll") for (int k = 0; k < 2; ++k) _c = __builtin_amdgcn_mfma_f32_16x16x32_bf16(Bt[n][k], At[m][k], _c, 0, 0, 0); } \
        acc_set(accw, ai, bj, m, n, _c); } \
        __builtin_amdgcn_s_setprio(0); } while (0)
#define PG8_WAIT_V(n) asm volatile("s_waitcnt vmcnt(" #n ")" ::: "memory")
#define PG8_WAIT_L(n) asm volatile("s_waitcnt lgkmcnt(" #n ")" ::: "memory")
#define PG8_BAR __builtin_amdgcn_s_barrier()
#define PG8_SCHED __builtin_amdgcn_sched_barrier(0)
    Unit cur, nxt; int ui = 0;
    if (!S.next(0, cur)) return;
    typedef int v4i_f __attribute__((ext_vector_type(4))); typedef int v8i_f __attribute__((ext_vector_type(8))); typedef f32x16 f32x16_f;
    AccW accw;
#pragma unroll
    for (int a = 0; a < 2; ++a)
#pragma unroll
        for (int b = 0; b < 2; ++b)
#pragma unroll
            for (int mp = 0; mp < 2; ++mp)
#pragma unroll
                for (int i = 0; i < 16; ++i) accw[a][b][mp][i] = 0.f;
    bf16x8 At[4][2], B0[2][2], B1[2][2];
    v8i_f At8[4], B08[2], B18[2];
#define PG8_F8(x) x##8
    const char* cA = (const char*)g.A + (size_t)cur.pm * tstepA + (size_t)cur.ko * 2; const char* cB = (const char*)g.Bt + (size_t)cur.pn * tstepB + (size_t)cur.ko * 2;
    S.a_ready(cur);
    if constexpr (SP2) {
        PG8_STAGE(PG8_SB(0, 0), cB, voffB); PG8_STAGE(PG8_SB(0, 1), cB + hstepB, voffB); PG8_STAGE(PG8_SA(0, 0), cA, voffA); PG8_STAGE(PG8_SA(0, 1), cA + hstepA, voffA);
        if (wr == 1) PG8_BAR;
        PG8_WAIT_V(2); PG8_BAR;
        PG8_STAGE(PG8_SB(1, 0), cB + kstep, voffB); PG8_STAGE(PG8_SA(1, 0), cA + kstep, voffA); PG8_STAGE(PG8_SB(1, 1), cB + hstepB + kstep, voffB);
        PG8_WAIT_V(6); PG8_BAR;
    } else {
        PG8_STAGE(PG8_SB(0, 0), cB, voffB); PG8_STAGE(PG8_SA(0, 0), cA, voffA); PG8_STAGE(PG8_SB(0, 1), cB + hstepB, voffB); PG8_STAGE(PG8_SA(0, 1), cA + hstepA, voffA);
        if (wr == 1) PG8_BAR;
        PG8_WAIT_V(4); PG8_BAR;
        PG8_STAGE(PG8_SB(1, 0), cB + kstep, voffB); PG8_STAGE(PG8_SA(1, 0), cA + kstep, voffA); PG8_STAGE(PG8_SB(1, 1), cB + hstepB + kstep, voffB);
        PG8_WAIT_V(6); PG8_BAR;
    }
    for (;;) {
        const bool has_next = S.next(ui + 1, nxt);
        const char* nA = has_next ? (const char*)g.A + (size_t)nxt.pm * tstepA + (size_t)nxt.ko * 2 : cA; const char* nB = has_next ? (const char*)g.Bt + (size_t)nxt.pn * tstepB + (size_t)nxt.ko * 2 : cB;
        for (int t = 0; t < nt; t += 2) {
            const bool last = (t == nt - 2);
            const char* a1 = cA + (size_t)(t + 1) * kstep;
            const char* a2 = last ? nA : cA + (size_t)(t + 2) * kstep; const char* b2 = last ? nB : cB + (size_t)(t + 2) * kstep;
            const char* a3 = a2 + kstep; const char* b3 = b2 + kstep;
            if (last && has_next) S.a_ready(nxt);
            if constexpr (SP2) {
            PG8_LDB(B0, 0, 0); PG8_LDB(B1, 0, 1); PG8_SCHED; PG8_LDA(At, 0, 0); PG8_STAGE(PG8_SA(1, 1), a1 + hstepA, voffA);
            PG8_WAIT_V(8); PG8_WAIT_L(0); PG8_BAR; PG8_MMA(0, 0, At, B0); PG8_MMA(0, 1, At, B1); PG8_BAR; PG8_SCHED;
            PG8_LDA(At, 0, 1); PG8_STAGE(PG8_SB(0, 0), b2, voffB); PG8_STAGE(PG8_SB(0, 1), b2 + hstepB, voffB); PG8_STAGE(PG8_SA(0, 0), a2, voffA);
            PG8_WAIT_V(8); PG8_WAIT_L(0); PG8_BAR; PG8_MMA(1, 0, At, B0); PG8_MMA(1, 1, At, B1); PG8_BAR; PG8_SCHED;
            PG8_LDB(B0, 1, 0); PG8_LDB(B1, 1, 1); PG8_SCHED; PG8_LDA(At, 1, 0); PG8_STAGE(PG8_SA(0, 1), a2 + hstepA, voffA);
            PG8_WAIT_V(8); PG8_WAIT_L(0); PG8_BAR; PG8_MMA(0, 0, At, B0); PG8_MMA(0, 1, At, B1); PG8_BAR; PG8_SCHED;
            PG8_LDA(At, 1, 1); PG8_STAGE(PG8_SB(1, 0), b3, voffB); PG8_STAGE(PG8_SB(1, 1), b3 + hstepB, voffB); PG8_STAGE(PG8_SA(1, 0), a3, voffA);
            PG8_WAIT_V(8); PG8_WAIT_L(0); PG8_BAR; PG8_MMA(1, 0, At, B0); PG8_MMA(1, 1, At, B1); PG8_BAR; PG8_SCHED;
            } else {
            PG8_LDB(B0, 0, 0); PG8_SCHED; PG8_LDA(At, 0, 0); PG8_STAGE(PG8_SA(1, 1), a1 + hstepA, voffA);
            PG8_WAIT_L(8); PG8_BAR; PG8_WAIT_L(0); PG8_MMA(0, 0, At, B0); PG8_BAR; PG8_SCHED;
            PG8_LDB(B1, 0, 1); PG8_STAGE(PG8_SB(0, 0), b2, voffB);
            PG8_BAR; PG8_WAIT_L(0); PG8_MMA(0, 1, At, B1); PG8_BAR;
            PG8_LDA(At, 0, 1); PG8_STAGE(PG8_SA(0, 0), a2, voffA);
            PG8_BAR; PG8_WAIT_L(0); PG8_MMA(1, 0, At, B0); PG8_BAR; PG8_SCHED;
            PG8_STAGE(PG8_SB(0, 1), b2 + hstepB, voffB);
            PG8_WAIT_V(6); PG8_BAR; PG8_MMA(1, 1, At, B1); PG8_BAR;
            PG8_LDB(B0, 1, 0); PG8_SCHED; PG8_LDA(At, 1, 0); PG8_STAGE(PG8_SA(0, 1), a2 + hstepA, voffA);
            PG8_WAIT_L(8); PG8_BAR; PG8_WAIT_L(0); PG8_MMA(0, 0, At, B0); PG8_BAR; PG8_SCHED;
            PG8_LDB(B1, 1, 1); PG8_STAGE(PG8_SB(1, 0), b3, voffB);
            PG8_BAR; PG8_WAIT_L(0); PG8_MMA(0, 1, At, B1); PG8_BAR;
            PG8_LDA(At, 1, 1); PG8_STAGE(PG8_SA(1, 0), a3, voffA);
            PG8_BAR; PG8_WAIT_L(0); PG8_MMA(1, 0, At, B0); PG8_BAR; PG8_SCHED;
            PG8_STAGE(PG8_SB(1, 1), b3 + hstepB, voffB);
            PG8_WAIT_V(6); PG8_BAR; PG8_MMA(1, 1, At, B1); PG8_BAR;
            }
        }
        if constexpr (ALIGN_EPI) { if (wr == 0) PG8_BAR; }
        if constexpr (!Epi::AFTER_DRAIN) { E(accw, cur, wr, wc, fr, fq); S.done(cur); }
        const bool keep_acc = Epi::TWOPASS && (cur.pass == 0);
        if (!has_next) break;
        if (!keep_acc) {
#pragma unroll
            for (int a = 0; a < 2; ++a)
#pragma unroll
                for (int b = 0; b < 2; ++b)
#pragma unroll
                    for (int mp = 0; mp < 2; ++mp)
#pragma unroll
                        for (int i = 0; i < 16; ++i) accw[a][b][mp][i] = 0.f;
        }
        cur = nxt; cA = nA; cB = nB; ++ui;
        if constexpr (ALIGN_EPI) { if (wr == 1) PG8_BAR; }
    }
    PG8_WAIT_V(0);
    if constexpr (!ALIGN_EPI) { if (wr == 0) PG8_BAR; }
    PG8_BAR;

#undef PG8_SA
#undef PG8_SB
#undef PG8_STAGE
#undef PG8_LDA
#undef PG8_LDB
#undef PG8_MMA
#undef PG8_F8
#undef PG8_WAIT_V
#undef PG8_WAIT_L
#undef PG8_BAR
#undef PG8_SCHED
}
}


constexpr int NWAVES = 8, NTHREADS = 512;
constexpr int BATCH = 8, SEQ = 4096, T = BATCH * SEQ, DM = 1024;
constexpr int INW = 5448;
constexpr int NPROJ = 5632;
constexpr int LD_HG = 2048, LD_ATT = 768, LD_IDX = 640, LD_GATE = 2048;
constexpr int TOPK = 256;
constexpr int NEXP = 16384;
constexpr float RMS_EPS = 1e-6f;

constexpr size_t MiB = 1u << 20;
constexpr size_t WS_CTL = 0;
constexpr size_t WS_MOD = MiB / 4;
constexpr size_t WS_MODP = MiB / 2;
constexpr size_t WS_WIN = 2 * MiB;
constexpr size_t WS_WQ = 17 * MiB;
constexpr size_t WS_SK = 21 * MiB;
constexpr size_t WS_U = 22 * MiB;
constexpr size_t WS_US = 30 * MiB;
constexpr size_t WS_V = 38 * MiB;
constexpr size_t WS_VS = 46 * MiB;
constexpr size_t WS_K8 = 48 * MiB;
constexpr size_t WS_QHI = 52 * MiB;
constexpr size_t WS_QLO = 68 * MiB;
constexpr size_t WS_WAB8 = 31 * MiB;
constexpr size_t WS_WOUT8 = 32 * MiB;
constexpr size_t WS_WIN8 = 33 * MiB;
constexpr size_t WS_H8 = 48 * MiB;
constexpr size_t WS_H = 86 * MiB;
constexpr size_t WS_HG = 150 * MiB;
constexpr size_t WS_ATT = 278 * MiB;
constexpr size_t WS_IDX = 326 * MiB;
constexpr size_t WS_GATE = 366 * MiB;
constexpr size_t WS_SEL = 494 * MiB;
constexpr size_t WS_END = 510 * MiB;
constexpr size_t WS_MERGED = WS_HG;
constexpr size_t WS_Q = 214 * MiB;
constexpr int H4_NT = 2;
constexpr size_t WS_H4D = 366 * MiB;
constexpr size_t WS_H4S = 416 * MiB;

constexpr int LDS_BYTES = 163840;

typedef unsigned short bf16;
typedef unsigned v4u __attribute__((ext_vector_type(4)));
typedef unsigned v2u __attribute__((ext_vector_type(2)));
typedef float f32x4 __attribute__((ext_vector_type(4)));
typedef float f32x2 __attribute__((ext_vector_type(2)));
typedef short bf16x8 __attribute__((ext_vector_type(8)));
#define LAS __attribute__((address_space(3)))

struct Params {
    const float *x, *c, *w_ada, *b_ada, *norm1_g, *norm2_g, *w_in, *hg_lb, *hg_onorm_g, *q_norm_g, *k_norm_g,
                *w_a, *w_b, *w_out, *peer_wq, *peer_subkeys, *peer_u, *peer_v;
    float* out; unsigned char* ws; int ph_lo, ph_hi;
};

typedef __bf16 bf16x2_hw __attribute__((ext_vector_type(2)));
__device__ __forceinline__ unsigned pk2(float lo, float hi) { const f32x2 v = {lo, hi}; const bf16x2_hw b = __builtin_convertvector(v, bf16x2_hw); return __builtin_bit_cast(unsigned, b); }
__device__ __forceinline__ unsigned f2bf(float f) { return pk2(f, 0.f) & 0xffffu; }
__device__ __forceinline__ float bf2f(unsigned u16v) { return __builtin_bit_cast(float, u16v << 16); }
__device__ __forceinline__ float bflo(unsigned w) { return __builtin_bit_cast(float, w << 16); }
__device__ __forceinline__ float bfhi(unsigned w) { return __builtin_bit_cast(float, w & 0xffff0000u); }
__device__ __forceinline__ float sigmoidf_(float x) { return __builtin_amdgcn_rcpf(1.f + __expf(-x)); }
__device__ __forceinline__ float siluf_(float x) { return x * __builtin_amdgcn_rcpf(1.f + __expf(-x)); }
__device__ __forceinline__ float wave_sum(float v) {
#pragma unroll
    for (int o = 1; o < 64; o <<= 1) v += __shfl_xor(v, o);
    return v;
}
__device__ __forceinline__ float wave_max(float v) {
#pragma unroll
    for (int o = 1; o < 64; o <<= 1) v = fmaxf(v, __shfl_xor(v, o));
    return v;
}
#define LDS_WAIT() asm volatile("s_waitcnt lgkmcnt(0)" ::: "memory")
__device__ __forceinline__ unsigned pk4_fp8(float a, float b, float c, float d) { int w = __builtin_amdgcn_cvt_pk_fp8_f32(a, b, 0, false); w = __builtin_amdgcn_cvt_pk_fp8_f32(c, d, w, true); return (unsigned)w; }

__host__ __device__ __forceinline__ int proj_tile_bf16(int i) { return i < 2 ? i + 2 : i + 6; }
__host__ __device__ __forceinline__ int proj_tile_fp8(int i) { return i < 2 ? i : (i < 6 ? i + 2 : i + 8); }
struct EpiProj {
    static constexpr bool PERM = true, AFTER_DRAIN = false, TWOPASS = false;
    bf16 *HG, *ATT, *IDX, *GATE; int f8;
    __device__ __forceinline__ void operator()(pg8::AccW& acc, const pg8::Unit& u, int wr, int wc, int fr, int fq) const {
        const int pn = f8 ? proj_tile_fp8(u.pn) : proj_tile_bf16(u.pn); bf16* base; int ldc, colt, ncols;
        if (pn < 8) { base = HG; ldc = LD_HG; colt = pn * 256; ncols = LD_HG; }
        else if (pn < 11) { base = ATT; ldc = LD_ATT; colt = (pn - 8) * 256; ncols = LD_ATT; }
        else if (pn < 14) { base = IDX; ldc = LD_IDX; colt = (pn - 11) * 256; ncols = LD_IDX; }
        else { base = GATE; ldc = LD_GATE; colt = (pn - 14) * 256; ncols = LD_GATE; }
        const int row0 = u.pm * 256 + wr * 64 + fr, col0 = colt + wc * 32 + 8 * fq;
#pragma unroll
        for (int ai = 0; ai < 2; ++ai)
#pragma unroll
            for (int m = 0; m < 4; ++m) { bf16* rowp = base + (size_t)(row0 + ai * 128 + m * 16) * ldc + col0;
#pragma unroll
                for (int bj = 0; bj < 2; ++bj) { const pg8::f32x4 v0 = pg8::acc_get(acc, ai, bj, m, 0), v1 = pg8::acc_get(acc, ai, bj, m, 1);
                    v4u w; w.x = pk2(v0[0], v0[1]); w.y = pk2(v0[2], v0[3]); w.z = pk2(v1[0], v1[1]); w.w = pk2(v1[2], v1[3]);
                    if (col0 + bj * 128 < ncols) *(v4u*)(rowp + bj * 128) = w; } }
    }
};
struct EpiMerged {
    static constexpr bool PERM = true, AFTER_DRAIN = false, TWOPASS = true;
    const bf16* GATE; bf16* O;
    __device__ __forceinline__ void operator()(pg8::AccW& acc, const pg8::Unit& u, int wr, int wc, int fr, int fq) const {
        const int row0 = u.pm * 256 + wr * 64 + fr, col0 = u.pn * 256 + wc * 32 + 8 * fq;
        if (u.pass == 0) {
#pragma unroll
            for (int ai = 0; ai < 2; ++ai)
#pragma unroll
                for (int m = 0; m < 4; ++m) { const bf16* rowp = GATE + (size_t)(row0 + ai * 128 + m * 16) * LD_GATE + col0;
#pragma unroll
                    for (int bj = 0; bj < 2; ++bj) { const v4u a = *(const v4u*)(rowp + bj * 128), b = *(const v4u*)(rowp + 1024 + bj * 128);
                        float r[8];
#pragma unroll
                        for (int i = 0; i < 4; ++i) { const float a0 = bflo(a[i]), a1 = bfhi(a[i]), b0 = bflo(b[i]), b1 = bfhi(b[i]);
                            r[2 * i] = (1.f + __expf(-b0)) * __builtin_amdgcn_rcpf(1.f + __expf(-a0)); r[2 * i + 1] = (1.f + __expf(-b1)) * __builtin_amdgcn_rcpf(1.f + __expf(-a1)); }
                        { pg8::f32x4 c0 = pg8::acc_get(acc, ai, bj, m, 0), c1 = pg8::acc_get(acc, ai, bj, m, 1);
#pragma unroll
                          for (int i = 0; i < 4; ++i) { c0[i] *= r[i]; c1[i] *= r[4 + i]; }
                          pg8::acc_set(acc, ai, bj, m, 0, c0); pg8::acc_set(acc, ai, bj, m, 1, c1); } } }
        } else {
#pragma unroll
            for (int ai = 0; ai < 2; ++ai)
#pragma unroll
                for (int m = 0; m < 4; ++m) { const size_t ro = (size_t)(row0 + ai * 128 + m * 16);
#pragma unroll
                    for (int bj = 0; bj < 2; ++bj) { const v4u b = *(const v4u*)(GATE + ro * LD_GATE + 1024 + col0 + bj * 128);
                        const pg8::f32x4 v0 = pg8::acc_get(acc, ai, bj, m, 0), v1 = pg8::acc_get(acc, ai, bj, m, 1);
                        float s[8];
#pragma unroll
                        for (int i = 0; i < 4; ++i) { s[2 * i] = sigmoidf_(bflo(b[i])); s[2 * i + 1] = sigmoidf_(bfhi(b[i])); }
                        v2u w; w.x = pk4_fp8(4.f * v0[0] * s[0], 4.f * v0[1] * s[1], 4.f * v0[2] * s[2], 4.f * v0[3] * s[3]); w.y = pk4_fp8(4.f * v1[0] * s[4], 4.f * v1[1] * s[5], 4.f * v1[2] * s[6], 4.f * v1[3] * s[7]);
                        *(v2u*)((unsigned char*)O + ro * 1024 + col0 + bj * 128) = w; } }
        }
    }
};
struct EpiResid {
    static constexpr bool PERM = true, AFTER_DRAIN = false, TWOPASS = false;
    const float* X; const float* G1  ; float* O;
    __device__ __forceinline__ void operator()(pg8::AccW& acc, const pg8::Unit& u, int wr, int wc, int fr, int fq) const {
        const int row0 = u.pm * 256 + wr * 64 + fr, col0 = u.pn * 256 + wc * 32 + 8 * fq;
        const int b = (u.pm * 256) / SEQ;
        f32x4 g[2][2];
#pragma unroll
        for (int bj = 0; bj < 2; ++bj)
#pragma unroll
            for (int n = 0; n < 2; ++n) g[bj][n] = *(const f32x4*)(G1 + (size_t)b * 6144 + col0 + bj * 128 + 4 * n);
#pragma unroll
        for (int ai = 0; ai < 2; ++ai)
#pragma unroll
            for (int m = 0; m < 4; ++m) { const size_t ro = (size_t)(row0 + ai * 128 + m * 16) * DM + col0;
#pragma unroll
                for (int bj = 0; bj < 2; ++bj)
#pragma unroll
                    for (int n = 0; n < 2; ++n) { const f32x4 xv = *(const f32x4*)(X + ro + bj * 128 + 4 * n);
                        *(f32x4*)(O + ro + bj * 128 + 4 * n) = xv + g[bj][n] * pg8::acc_get(acc, ai, bj, m, n); } }
    }
};
struct EpiStore {
    static constexpr bool PERM = true, AFTER_DRAIN = false, TWOPASS = false;
    bf16* O; int ldc;
    __device__ __forceinline__ void operator()(pg8::AccW& acc, const pg8::Unit& u, int wr, int wc, int fr, int fq) const {
        const int row0 = u.pm * 256 + wr * 64 + fr, col0 = u.pn * 256 + wc * 32 + 8 * fq;
#pragma unroll
        for (int ai = 0; ai < 2; ++ai)
#pragma unroll
            for (int m = 0; m < 4; ++m) { bf16* rowp = O + (size_t)(row0 + ai * 128 + m * 16) * ldc + col0;
#pragma unroll
                for (int bj = 0; bj < 2; ++bj) { const pg8::f32x4 v0 = pg8::acc_get(acc, ai, bj, m, 0), v1 = pg8::acc_get(acc, ai, bj, m, 1);
                    v4u w; w.x = pk2(v0[0], v0[1]); w.y = pk2(v0[2], v0[3]); w.z = pk2(v1[0], v1[1]); w.w = pk2(v1[2], v1[3]);
                    *(v4u*)(rowp + bj * 128) = w; } }
    }
};

template <int MODE> __device__ __forceinline__ int srcmap(int np) {
    if (MODE == 2) np = proj_tile_bf16(np >> 8) * 256 + (np & 255);
    if (MODE == 3) np = proj_tile_fp8(np >> 8) * 256 + (np & 255);
    if (MODE >= 1) return np < 3400 ? np : (np >= 3584 ? np - 184 : -1);
    return np; }
template <int MODE>
__device__ __forceinline__ void transpose_item(const float* W, int N, bf16* WT, int ldw, int koff, float* scr, int kb, int nb, int lane) {
    const int k0 = 64 * kb, n0 = 32 * nb;
    const int sc = srcmap<MODE>(n0 + (lane & 31));
#pragma unroll 8
    for (int i = 0; i < 32; ++i) { const int kk = 2 * i + (lane >> 5); scr[kk * 33 + (lane & 31)] = (sc >= 0) ? W[(size_t)(k0 + kk) * N + sc] : 0.f; }
    LDS_WAIT(); __builtin_amdgcn_wave_barrier();
    const int c = lane & 7;
#pragma unroll
    for (int j = 0; j < 4; ++j) { const int n = (lane >> 3) + 8 * j; const float* s = scr + (8 * c) * 33 + n;
        v4u o; o.x = pk2(s[0 * 33], s[1 * 33]); o.y = pk2(s[2 * 33], s[3 * 33]); o.z = pk2(s[4 * 33], s[5 * 33]); o.w = pk2(s[6 * 33], s[7 * 33]);
        *(v4u*)(WT + (size_t)(n0 + n) * ldw + koff + k0 + 8 * c) = o; }
    LDS_WAIT(); __builtin_amdgcn_wave_barrier();
}
template <int MODE> __device__ __forceinline__ int srcmap(int np);
template <int MODE = 0>
__device__ __forceinline__ void transpose_item8(const float* W, int N, unsigned char* WT, int ldw, int koff, float scale, float* scr, int kb, int nb, int lane) {
    const int k0 = 64 * kb, n0 = 32 * nb;
    const int sc = srcmap<MODE>(n0 + (lane & 31));
#pragma unroll 8
    for (int i = 0; i < 32; ++i) { const int kk = 2 * i + (lane >> 5); scr[kk * 33 + (lane & 31)] = (sc >= 0) ? W[(size_t)(k0 + kk) * N + sc] * scale : 0.f; }
    LDS_WAIT(); __builtin_amdgcn_wave_barrier();
    const int c = lane & 3;
#pragma unroll
    for (int j = 0; j < 2; ++j) { const int n = (lane >> 2) + 16 * j; const float* sp = scr + (16 * c) * 33 + n;
        v4u o;
#pragma unroll
        for (int q = 0; q < 4; ++q) o[q] = pk4_fp8(sp[(4 * q) * 33], sp[(4 * q + 1) * 33], sp[(4 * q + 2) * 33], sp[(4 * q + 3) * 33]);
        *(v4u*)(WT + (size_t)(n0 + n) * ldw + koff + k0 + 16 * c) = o; }
    LDS_WAIT(); __builtin_amdgcn_wave_barrier();
}
__device__ __forceinline__ void convert_plain(const float* src, bf16* dst, size_t n, size_t gtid, size_t nth) {
    const size_t n8 = n / 8;
    for (size_t i = gtid; i < n8; i += nth) { const f32x4 a = ((const f32x4*)src)[2 * i], b = ((const f32x4*)src)[2 * i + 1];
        v4u o; o.x = pk2(a[0], a[1]); o.y = pk2(a[2], a[3]); o.z = pk2(b[0], b[1]); o.w = pk2(b[2], b[3]); ((v4u*)dst)[i] = o; }
}
__device__ __forceinline__ void convert_fp8(const float* src, unsigned char* dst, size_t n, float scale, size_t gtid, size_t nth) {
    const size_t n16 = n / 16;
    for (size_t i = gtid; i < n16; i += nth) { const f32x4* sp = (const f32x4*)src + 4 * i; const f32x4 a = sp[0] * scale, b = sp[1] * scale, c = sp[2] * scale, d = sp[3] * scale;
        v4u o; o.x = pk4_fp8(a[0], a[1], a[2], a[3]); o.y = pk4_fp8(b[0], b[1], b[2], b[3]); o.z = pk4_fp8(c[0], c[1], c[2], c[3]); o.w = pk4_fp8(d[0], d[1], d[2], d[3]); ((v4u*)dst)[i] = o; }
}
template <bool KKMAJOR>
__device__ __forceinline__ void convert_mxfp4(const float* src, unsigned char* dst, unsigned char* scl, size_t nrows, size_t gtid, size_t nth) {
    const size_t nblk = nrows * 32;
    for (size_t i = gtid; i < nblk; i += nth) {
        const size_t row = i >> 5; const int blk = (int)(i & 31);
        const f32x4* sp = (const f32x4*)(src + row * 1024 + blk * 32);
        f32x4 v[8]; float amax = 0.f;
#pragma unroll
        for (int j = 0; j < 8; ++j) { v[j] = sp[j]; amax = fmaxf(fmaxf(fmaxf(fabsf(v[j][0]), fabsf(v[j][1])), fmaxf(fabsf(v[j][2]), fabsf(v[j][3]))), amax); }
        int e = (int)((__builtin_bit_cast(unsigned, amax) >> 23) & 0xffu) - 127 - 2;
        if (e < -126) e = -126;
        const float inv = __builtin_bit_cast(float, (unsigned)(127 - e) << 23);
        unsigned w[4] = {0u, 0u, 0u, 0u};
#pragma unroll
        for (int j = 0; j < 8; j += 2) { unsigned t = 0u;
            t = __builtin_amdgcn_cvt_scalef32_pk_fp4_f32(t, v[j][0] * inv, v[j][1] * inv, 1.0f, 0);
            t = __builtin_amdgcn_cvt_scalef32_pk_fp4_f32(t, v[j][2] * inv, v[j][3] * inv, 1.0f, 1);
            t = __builtin_amdgcn_cvt_scalef32_pk_fp4_f32(t, v[j + 1][0] * inv, v[j + 1][1] * inv, 1.0f, 2);
            t = __builtin_amdgcn_cvt_scalef32_pk_fp4_f32(t, v[j + 1][2] * inv, v[j + 1][3] * inv, 1.0f, 3);
            w[j >> 1] = t; }
        *(v4u*)(dst + row * 512 + blk * 16) = (v4u){w[0], w[1], w[2], w[3]};
        scl[row * 32 + (KKMAJOR ? ((blk & 3) * 8 + (blk >> 2)) : blk)] = (unsigned char)(e + 127);
    }
}
__device__ __forceinline__ void phase0(const Params& p, unsigned char* lds) {
    const int tid = threadIdx.x, wave = tid >> 6, lane = tid & 63, G = gridDim.x;
    const int gw = blockIdx.x * NWAVES + wave, NGW = G * NWAVES;
    float* scr = (float*)(lds + wave * 16384);
    unsigned char* ws = p.ws;
    constexpr int I_IN = 16 * (2048 / 32), I_IN8 = 16 * (3584 / 32), I_A = 8 * 32, I_O = 16 * 32, I_Q = 16 * 64;
    constexpr int NT = I_IN + I_IN8 + 2 * I_A + I_O + I_Q;
    for (int it = gw; it < NT; it += NGW) {
        int r = it;
        if (r < I_IN) { transpose_item<2>(p.w_in, INW, (bf16*)(ws + WS_WIN), 1024, 0, scr, r / 64, r % 64, lane); continue; } r -= I_IN;
        if (r < I_IN8) { transpose_item8<3>(p.w_in, INW, ws + WS_WIN8, 1024, 0, 32.f, scr, r / 112, r % 112, lane); continue; } r -= I_IN8;
        if (r < I_A) { transpose_item8(p.w_a, 1024, ws + WS_WAB8, 1024, 0, 32.f, scr, r / 32, r % 32, lane); continue; } r -= I_A;
        if (r < I_A) { transpose_item8(p.w_b, 1024, ws + WS_WAB8, 1024, 512, 4.f, scr, r / 32, r % 32, lane); continue; } r -= I_A;
        if (r < I_O) { transpose_item8(p.w_out, 1024, ws + WS_WOUT8, 1024, 0, 32.f, scr, r / 32, r % 32, lane); continue; } r -= I_O;
        transpose_item<0>(p.peer_wq, 2048, (bf16*)(ws + WS_WQ), 1024, 0, scr, r / 64, r % 64, lane);
    }
    for (int it = gw; it < 96 * 8; it += NGW) {
        const int cgp = it % 96, ks = it / 96, col = cgp * 64 + lane, k0 = ks * 128;
#pragma unroll
        for (int i = 0; i < 16; ++i) { const int e = i * 64 + lane, b = e >> 7, k = e & 127; scr[e] = siluf_(p.c[b * 1024 + k0 + k]); }
        LDS_WAIT(); __builtin_amdgcn_wave_barrier();
        float acc[8];
#pragma unroll
        for (int b = 0; b < 8; ++b) acc[b] = 0.f;
#pragma unroll 4
        for (int k = 0; k < 128; ++k) { const float w = p.w_ada[(size_t)(k0 + k) * 6144 + col];
#pragma unroll
            for (int b = 0; b < 8; ++b) acc[b] += scr[b * 128 + k] * w; }
        float* mp = (float*)(ws + WS_MODP) + (size_t)ks * 8 * 6144 + col;
#pragma unroll
        for (int b = 0; b < 8; ++b) mp[b * 6144] = acc[b];
        LDS_WAIT(); __builtin_amdgcn_wave_barrier();
    }
    const size_t gtid = (size_t)blockIdx.x * NTHREADS + tid, nth = (size_t)G * NTHREADS;
    convert_plain(p.peer_subkeys, (bf16*)(ws + WS_SK), (size_t)16 * 128 * 128, gtid, nth);
    convert_mxfp4<true>(p.peer_u, ws + WS_U, ws + WS_US, (size_t)NEXP, gtid, nth);
    convert_mxfp4<false>(p.peer_v, ws + WS_V, ws + WS_VS, (size_t)NEXP, gtid, nth);
}

template <bool FIRST>
__device__ __forceinline__ void normmod_phase(const Params& p, unsigned char* lds, const float* src, bf16* dst, const float* gvec, int shift_off, int scale_off) {
    const int tid = threadIdx.x, wave = tid >> 6, lane = tid & 63, G = gridDim.x;
    unsigned char* ws = p.ws;
    float* A = (float*)lds;
    float* Bv = A + 1024;
    const float* MODP = (const float*)(ws + WS_MODP);
    float* MOD = (float*)(ws + WS_MOD);
    if (FIRST) {
        for (int e = blockIdx.x * NTHREADS + tid; e < 8 * 6144; e += G * NTHREADS) { const int col = e % 6144; float s = p.b_ada[col];
#pragma unroll
            for (int ks = 0; ks < 8; ++ks) s += MODP[(size_t)ks * 8 * 6144 + e];
            MOD[e] = s; }
    }
    int curb = -1;
    for (int chunk = blockIdx.x; chunk < T / 128; chunk += G) {
        const int b = (chunk * 128) / SEQ;
        if (b != curb) {
            __syncthreads();
            for (int col = tid; col < 1024; col += NTHREADS) {
                float sc, sh;
                if (FIRST) { sc = p.b_ada[scale_off + col]; sh = p.b_ada[shift_off + col];
#pragma unroll
                    for (int ks = 0; ks < 8; ++ks) { sc += MODP[(size_t)(ks * 8 + b) * 6144 + scale_off + col]; sh += MODP[(size_t)(ks * 8 + b) * 6144 + shift_off + col]; } }
                else { sc = MOD[b * 6144 + scale_off + col]; sh = MOD[b * 6144 + shift_off + col]; }
                A[col] = gvec[col] * (1.f + sc); Bv[col] = sh; }
            __syncthreads(); curb = b;
        }
        for (int r = wave; r < 128; r += NWAVES) {
            const size_t row = (size_t)chunk * 128 + r;
            const f32x4* xr = (const f32x4*)(src + row * DM) + lane;
            f32x4 v[4]; float s = 0.f;
#pragma unroll
            for (int j = 0; j < 4; ++j) { v[j] = xr[64 * j]; s += (v[j][0] * v[j][0] + v[j][1] * v[j][1]) + (v[j][2] * v[j][2] + v[j][3] * v[j][3]); }
            const float rstd = rsqrtf(wave_sum(s) * (1.f / DM) + RMS_EPS);
            v2u* o8 = (v2u*)(dst + row * DM) + lane;
#pragma unroll
            for (int j = 0; j < 4; ++j) { const int c0 = 4 * lane + 256 * j; const f32x4 a = *(const f32x4*)(A + c0), sh = *(const f32x4*)(Bv + c0);
                v2u o; o.x = pk2(v[j][0] * rstd * a[0] + sh[0], v[j][1] * rstd * a[1] + sh[1]); o.y = pk2(v[j][2] * rstd * a[2] + sh[2], v[j][3] * rstd * a[3] + sh[3]);
                o8[64 * j] = o;
                if (FIRST) *(unsigned*)(ws + WS_H8 + row * DM + c0) = pk4_fp8(v[j][0] * rstd * a[0] + sh[0], v[j][1] * rstd * a[1] + sh[1], v[j][2] * rstd * a[2] + sh[2], v[j][3] * rstd * a[3] + sh[3]);
                if (!FIRST) { float* st = (float*)(lds + 8192) + wave * 1056;
                    const float y0 = v[j][0] * rstd * a[0] + sh[0], y1 = v[j][1] * rstd * a[1] + sh[1], y2 = v[j][2] * rstd * a[2] + sh[2], y3 = v[j][3] * rstd * a[3] + sh[3];
                    const int pc = c0 + (c0 >> 5); st[pc] = y0; st[pc + 1] = y1; st[pc + 2] = y2; st[pc + 3] = y3; } }
            if (!FIRST) {
                const float* st = (const float*)(lds + 8192) + wave * 1056;
                LDS_WAIT(); __builtin_amdgcn_wave_barrier();
                if (lane < 32) {
                    float x[32];
#pragma unroll
                    for (int k = 0; k < 32; ++k) x[k] = st[lane * 33 + k];
#pragma unroll
                    for (int t = 0; t < H4_NT; ++t) {
                        float amax = 0.f;
#pragma unroll
                        for (int k = 0; k < 32; ++k) amax = fmaxf(amax, fabsf(x[k]));
                        int e = (int)((__builtin_bit_cast(unsigned, amax) >> 23) & 0xffu) - 127 - 2; if (e < -126) e = -126;
                        const float inv = __builtin_bit_cast(float, (unsigned)(127 - e) << 23), sc = __builtin_bit_cast(float, (unsigned)(127 + e) << 23);
                        unsigned w[4];
#pragma unroll
                        for (int r = 0; r < 4; ++r) { unsigned tw = 0u;
                            tw = __builtin_amdgcn_cvt_scalef32_pk_fp4_f32(tw, x[8 * r] * inv, x[8 * r + 1] * inv, 1.0f, 0);
                            tw = __builtin_amdgcn_cvt_scalef32_pk_fp4_f32(tw, x[8 * r + 2] * inv, x[8 * r + 3] * inv, 1.0f, 1);
                            tw = __builtin_amdgcn_cvt_scalef32_pk_fp4_f32(tw, x[8 * r + 4] * inv, x[8 * r + 5] * inv, 1.0f, 2);
                            tw = __builtin_amdgcn_cvt_scalef32_pk_fp4_f32(tw, x[8 * r + 6] * inv, x[8 * r + 7] * inv, 1.0f, 3);
                            w[r] = tw;
                            const f32x2 d0 = __builtin_amdgcn_cvt_scalef32_pk_f32_fp4(tw, 1.0f, 0), d1 = __builtin_amdgcn_cvt_scalef32_pk_f32_fp4(tw, 1.0f, 1), d2 = __builtin_amdgcn_cvt_scalef32_pk_f32_fp4(tw, 1.0f, 2), d3 = __builtin_amdgcn_cvt_scalef32_pk_f32_fp4(tw, 1.0f, 3);
                            x[8 * r] -= d0[0] * sc; x[8 * r + 1] -= d0[1] * sc; x[8 * r + 2] -= d1[0] * sc; x[8 * r + 3] -= d1[1] * sc;
                            x[8 * r + 4] -= d2[0] * sc; x[8 * r + 5] -= d2[1] * sc; x[8 * r + 6] -= d3[0] * sc; x[8 * r + 7] -= d3[1] * sc; }
                        *(v4u*)(ws + WS_H4D + (row * H4_NT + t) * 512 + lane * 16) = (v4u){w[0], w[1], w[2], w[3]};
                        *(ws + WS_H4S + (row * H4_NT + t) * 32 + (lane & 3) * 8 + (lane >> 2)) = (unsigned char)(e + 127);
                    }
                }
                LDS_WAIT(); __builtin_amdgcn_wave_barrier();
            }
        }
    }
    __syncthreads();
}

constexpr int HGL_QT = 0, HGL_KT = 17408, HGL_QE = 34816, HGL_KLT = 52224, HGL_VT = 70656, HGL_AM = 89088, HGL_DEC = 98304, HGL_TOT = 98816, HGL_SSQ = 100864;
constexpr int HG_LDR = 136;
constexpr int HG_LDC = 72;
__device__ __forceinline__ void hgrn_item(const Params& p, unsigned char* lds, int item) {
    const int b = item >> 2, h = item & 3;
    const int tid = threadIdx.x, w = tid >> 6, lane = tid & 63, fr = lane & 15, fq = lane >> 4;
    unsigned char* ws = p.ws;
    const bf16* HG = (const bf16*)(ws + WS_HG);
    bf16* YA = (bf16*)(ws + WS_H);
    bf16* QT = (bf16*)(lds + HGL_QT); bf16* KT = (bf16*)(lds + HGL_KT); bf16* QE = (bf16*)(lds + HGL_QE);
    bf16* KLT = (bf16*)(lds + HGL_KLT); bf16* VT = (bf16*)(lds + HGL_VT); bf16* AM = (bf16*)(lds + HGL_AM);
    float* DEC = (float*)(lds + HGL_DEC); float* TOT = (float*)(lds + HGL_TOT); float* SSQ = (float*)(lds + HGL_SSQ);
    const int pd = tid & 127, pq = tid >> 7;
    float lbv; { const float a0 = p.hg_lb[h * 128 + pd], a1 = p.hg_lb[512 + h * 128 + pd]; lbv = 1.f / (1.f + __expf(a1 - a0)); }
    const int e0 = w * 16;
    const float ogv = p.hg_onorm_g[e0 + fr];
    pg8::f32x4 S[8];
#pragma unroll
    for (int i = 0; i < 8; ++i) S[i] = (pg8::f32x4){0.f, 0.f, 0.f, 0.f};
    const size_t rowb = (size_t)b * SEQ;
    unsigned short rq[16], rf[16], rv[16];
    { const bf16* gp = HG + (rowb + pq * 16) * LD_HG + h * 128 + pd;
#pragma unroll
      for (int i = 0; i < 16; ++i) { rq[i] = gp[(size_t)i * LD_HG]; rf[i] = gp[(size_t)i * LD_HG + 512]; rv[i] = gp[(size_t)i * LD_HG + 1024]; } }
    for (int chunk = 0; chunk < SEQ / 64; ++chunk) {
        const size_t row0 = rowb + (size_t)chunk * 64;
        float fq_[16], kq_[16], cs[16];
        float run = 0.f;
#pragma unroll
        for (int i = 0; i < 16; ++i) { const float f = lbv + (1.f - lbv) * sigmoidf_(bf2f(rf[i])); kq_[i] = 1.f - f; run += __logf(f); cs[i] = run; fq_[i] = siluf_(bf2f(rq[i])); }
        TOT[pq * 128 + pd] = run;
        { v4u v0, v1;
          v0.x = rv[0] | ((unsigned)rv[1] << 16); v0.y = rv[2] | ((unsigned)rv[3] << 16); v0.z = rv[4] | ((unsigned)rv[5] << 16); v0.w = rv[6] | ((unsigned)rv[7] << 16);
          v1.x = rv[8] | ((unsigned)rv[9] << 16); v1.y = rv[10] | ((unsigned)rv[11] << 16); v1.z = rv[12] | ((unsigned)rv[13] << 16); v1.w = rv[14] | ((unsigned)rv[15] << 16);
          *(v4u*)(VT + pd * HG_LDC + pq * 16) = v0; *(v4u*)(VT + pd * HG_LDC + pq * 16 + 8) = v1; }
        unsigned short rg[16];
#pragma unroll
        for (int i = 0; i < 16; ++i) rg[i] = HG[(row0 + (i >> 2) * 16 + fq * 4 + (i & 3)) * LD_HG + 1536 + h * 128 + e0 + fr];
        if (chunk + 1 < SEQ / 64) { const bf16* gp = HG + (row0 + 64 + pq * 16) * LD_HG + h * 128 + pd;
#pragma unroll
            for (int i = 0; i < 16; ++i) { rq[i] = gp[(size_t)i * LD_HG]; rf[i] = gp[(size_t)i * LD_HG + 512]; rv[i] = gp[(size_t)i * LD_HG + 1024]; } }
        __syncthreads();
        const float t0 = TOT[pd], t1 = TOT[128 + pd], t2 = TOT[256 + pd], t3 = TOT[384 + pd];
        const float base = (pq > 0 ? t0 : 0.f) + (pq > 1 ? t1 : 0.f) + (pq > 2 ? t2 : 0.f);
        const float bmid = t0 + t1, blast = (t0 + t1) + (t2 + t3);
        const float emid = __expf(bmid), elm = __expf(blast - bmid);
        if (pq == 0) DEC[pd] = __expf(blast);
        { unsigned klp[8];
#pragma unroll
          for (int i = 0; i < 16; ++i) { const float bb = base + cs[i]; const float E1 = __expf(bb - bmid), R1 = __builtin_amdgcn_rcpf(E1);
              const float qtv = fq_[i] * E1, ktv = kq_[i] * R1, qev = qtv * emid, klv = ktv * elm;
              const int srow = pq * 16 + i;
              QT[srow * HG_LDR + pd] = (bf16)f2bf(qtv); KT[srow * HG_LDR + pd] = (bf16)f2bf(ktv); QE[srow * HG_LDR + pd] = (bf16)f2bf(qev);
              if (i & 1) klp[i >> 1] |= f2bf(klv) << 16; else klp[i >> 1] = f2bf(klv); }
          *(v4u*)(KLT + pd * HG_LDC + pq * 16) = (v4u){klp[0], klp[1], klp[2], klp[3]}; *(v4u*)(KLT + pd * HG_LDC + pq * 16 + 8) = (v4u){klp[4], klp[5], klp[6], klp[7]}; }
        __syncthreads();
#pragma unroll
        for (int tt = 0; tt < 2; ++tt) { const int id = w + 8 * tt, rt = id >> 2, ct = id & 3;
            pg8::f32x4 a = {0.f, 0.f, 0.f, 0.f};
            if (ct <= rt) {
#pragma unroll
                for (int ks = 0; ks < 4; ++ks) { const bf16x8 af = *(const bf16x8*)(QT + (rt * 16 + fr) * HG_LDR + ks * 32 + fq * 8), bfv = *(const bf16x8*)(KT + (ct * 16 + fr) * HG_LDR + ks * 32 + fq * 8);
                    a = __builtin_amdgcn_mfma_f32_16x16x32_bf16(af, bfv, a, 0, 0, 0); } }
#pragma unroll
            for (int r = 0; r < 4; ++r) { const int c = rt * 16 + fq * 4 + r, sidx = ct * 16 + fr; AM[c * HG_LDC + sidx] = (bf16)((sidx <= c) ? f2bf(a[r]) : 0u); } }
        __syncthreads();
        const bf16x8 vb0 = *(const bf16x8*)(VT + (e0 + fr) * HG_LDC + fq * 8), vb1 = *(const bf16x8*)(VT + (e0 + fr) * HG_LDC + 32 + fq * 8);
        bf16x8 sb[4];
#pragma unroll
        for (int ks = 0; ks < 4; ++ks) { v4u t; t.x = pk2(S[2 * ks][0], S[2 * ks][1]); t.y = pk2(S[2 * ks][2], S[2 * ks][3]); t.z = pk2(S[2 * ks + 1][0], S[2 * ks + 1][1]); t.w = pk2(S[2 * ks + 1][2], S[2 * ks + 1][3]); sb[ks] = __builtin_bit_cast(bf16x8, t); }
        pg8::f32x4 o[4];
#pragma unroll
        for (int rt = 0; rt < 4; ++rt) { pg8::f32x4 a = {0.f, 0.f, 0.f, 0.f};
            a = __builtin_amdgcn_mfma_f32_16x16x32_bf16(*(const bf16x8*)(AM + (rt * 16 + fr) * HG_LDC + fq * 8), vb0, a, 0, 0, 0);
            a = __builtin_amdgcn_mfma_f32_16x16x32_bf16(*(const bf16x8*)(AM + (rt * 16 + fr) * HG_LDC + 32 + fq * 8), vb1, a, 0, 0, 0);
#pragma unroll
            for (int ks = 0; ks < 4; ++ks) { const v2u lo = *(const v2u*)(QE + (rt * 16 + fr) * HG_LDR + ks * 32 + fq * 4), hi = *(const v2u*)(QE + (rt * 16 + fr) * HG_LDR + ks * 32 + 16 + fq * 4);
                const v4u t = {lo.x, lo.y, hi.x, hi.y};
                a = __builtin_amdgcn_mfma_f32_16x16x32_bf16(__builtin_bit_cast(bf16x8, t), sb[ks], a, 0, 0, 0); }
            o[rt] = a; }
#pragma unroll
        for (int dt = 0; dt < 8; ++dt) { const f32x4 dc = *(const f32x4*)(DEC + dt * 16 + fq * 4);
            pg8::f32x4 a = S[dt]; a[0] *= dc[0]; a[1] *= dc[1]; a[2] *= dc[2]; a[3] *= dc[3];
            a = __builtin_amdgcn_mfma_f32_16x16x32_bf16(*(const bf16x8*)(KLT + (dt * 16 + fr) * HG_LDC + fq * 8), vb0, a, 0, 0, 0);
            a = __builtin_amdgcn_mfma_f32_16x16x32_bf16(*(const bf16x8*)(KLT + (dt * 16 + fr) * HG_LDC + 32 + fq * 8), vb1, a, 0, 0, 0);
            S[dt] = a; }
#pragma unroll
        for (int rt = 0; rt < 4; ++rt)
#pragma unroll
            for (int r = 0; r < 4; ++r) { float x = o[rt][r] * o[rt][r];
                x += __shfl_xor(x, 1); x += __shfl_xor(x, 2); x += __shfl_xor(x, 4); x += __shfl_xor(x, 8);
                if (fr == 0) SSQ[w * 64 + rt * 16 + fq * 4 + r] = x; }
        __syncthreads();
        float tot = 0.f;
#pragma unroll
        for (int ww = 0; ww < 8; ++ww) tot += SSQ[ww * 64 + lane];
        const float rstd_l = rsqrtf(tot * (1.f / 128.f) + RMS_EPS);
#pragma unroll
        for (int rt = 0; rt < 4; ++rt)
#pragma unroll
            for (int r = 0; r < 4; ++r) { const int c = rt * 16 + fq * 4 + r; const float rs = __shfl(rstd_l, c);
                const float y = o[rt][r] * rs * ogv * siluf_(bf2f(rg[rt * 4 + r]));
                ((unsigned char*)YA)[(row0 + c) * 1024 + h * 128 + e0 + fr] = (unsigned char)(__builtin_amdgcn_cvt_pk_fp8_f32(y, 0.f, 0, false) & 0xff); }
    }
    __syncthreads();
}

__device__ __forceinline__ unsigned f16key(float x) {
    x = x + 0.f;
    const _Float16 hx = (_Float16)x; const unsigned short bits = __builtin_bit_cast(unsigned short, hx);
    return (bits & 0x8000u) ? (unsigned)(unsigned short)(~bits) : (unsigned)(bits | 0x8000u);
}
__device__ __forceinline__ void find_bin(const unsigned* hist, int K, int lane, int& bin, int& rem) {
    const v4u hv = *(const v4u*)(hist + 4 * lane);
    const unsigned c = hv.x + hv.y + hv.z + hv.w;
    unsigned suf = c;
#pragma unroll
    for (int o = 1; o < 64; o <<= 1) { const unsigned t = __shfl_down(suf, o); if (lane + o < 64) suf += t; }
    const unsigned above = suf - c;
    const bool mine = (above < (unsigned)K) && ((unsigned)K <= suf);
    int mybin = 0, myrem = 0;
    if (mine) { unsigned ca = above; const unsigned hh[4] = {hv.x, hv.y, hv.z, hv.w}; bool found = false;
#pragma unroll
        for (int i = 3; i >= 0; --i) { if (!found) { if (ca + hh[i] >= (unsigned)K) { mybin = 4 * lane + i; myrem = K - (int)ca; found = true; } else ca += hh[i]; } } }
    const unsigned long long m = __ballot(mine);
    const int src = (int)__builtin_ctzll(m | (1ull << 63));
    bin = __shfl(mybin, src); rem = __shfl(myrem, src);
}
__device__ __forceinline__ void dsa1_item(const Params& p, unsigned char* lds, int item) {
    const int b = item >> 8, q0 = (item & 255) * 16;
    const int tid = threadIdx.x, w = tid >> 6, lane = tid & 63, fr = lane & 15, fq = lane >> 4;
    unsigned char* ws = p.ws;
    const bf16* IDX = (const bf16*)(ws + WS_IDX);
    unsigned short* SEL = (unsigned short*)(ws + WS_SEL);
    unsigned short* Ik = (unsigned short*)lds;
    unsigned* hist1 = (unsigned*)(lds + 131072);
    unsigned* hist = (unsigned*)(lds + 131072 + 16384) + w * 256;
    const size_t rowb = (size_t)b * SEQ;
    *(v4u*)(hist1 + tid * 4) = (v4u){0u, 0u, 0u, 0u}; *(v4u*)(hist1 + 2048 + tid * 4) = (v4u){0u, 0u, 0u, 0u};
    bf16x8 Af[8][2];
    { const bf16* rp = IDX + (rowb + q0 + fr) * LD_IDX + fq * 8;
#pragma unroll
      for (int h = 0; h < 8; ++h) { Af[h][0] = *(const bf16x8*)(rp + h * 64); Af[h][1] = *(const bf16x8*)(rp + h * 64 + 32); } }
    const float idx_scale = 0.5f * 0.125f * 0.35355339059327373f;
    bf16x8 Aw[2];
    { float wa[8];
      { const v4u wq = *(const v4u*)(IDX + (rowb + q0 + fr) * LD_IDX + 576);
#pragma unroll
        for (int i = 0; i < 4; ++i) { wa[2 * i] = bflo(wq[i]) * idx_scale; wa[2 * i + 1] = bfhi(wq[i]) * idx_scale; } }
#pragma unroll
      for (int ks = 0; ks < 2; ++ks) { float cq[8];
#pragma unroll
          for (int j = 0; j < 8; ++j) cq[j] = 0.f;
#pragma unroll
          for (int h = 0; h < 8; ++h)
#pragma unroll
              for (int j = 0; j < 8; ++j) cq[j] += wa[h] * bf2f((unsigned)(unsigned short)Af[h][ks][j]);
          const v4u t = {pk2(cq[0], cq[1]), pk2(cq[2], cq[3]), pk2(cq[4], cq[5]), pk2(cq[6], cq[7])};
          Aw[ks] = __builtin_bit_cast(bf16x8, t); } }
    float wv[4][8];
#pragma unroll
    for (int r = 0; r < 4; ++r) { const v4u wq = *(const v4u*)(IDX + (rowb + q0 + fq * 4 + r) * LD_IDX + 576);
#pragma unroll
        for (int i = 0; i < 4; ++i) { wv[r][2 * i] = bflo(wq[i]) * idx_scale; wv[r][2 * i + 1] = bfhi(wq[i]) * idx_scale; } }
    const int ntiles = (q0 >> 4) + 1;
    __syncthreads();
    bf16x8 B0 = Aw[0], B1 = Aw[1];
    if (w < ntiles) { const bf16* kp = IDX + (rowb + w * 16 + fr) * LD_IDX + 512 + fq * 8; B0 = *(const bf16x8*)kp; B1 = *(const bf16x8*)(kp + 32); }
    for (int kt = w; kt < ntiles; kt += NWAVES) {
        bf16x8 nB0 = B0, nB1 = B1;
        if (kt + NWAVES < ntiles) { const bf16* kp = IDX + (rowb + (kt + NWAVES) * 16 + fr) * LD_IDX + 512 + fq * 8; nB0 = *(const bf16x8*)kp; nB1 = *(const bf16x8*)(kp + 32); }
        pg8::f32x4 lin = {0.f, 0.f, 0.f, 0.f};
        lin = __builtin_amdgcn_mfma_f32_16x16x32_bf16(Aw[0], B0, lin, 0, 0, 0);
        lin = __builtin_amdgcn_mfma_f32_16x16x32_bf16(Aw[1], B1, lin, 0, 0, 0);
        float I[4] = {lin[0], lin[1], lin[2], lin[3]};
#pragma unroll
        for (int h = 0; h < 8; ++h) { pg8::f32x4 a = {0.f, 0.f, 0.f, 0.f};
            a = __builtin_amdgcn_mfma_f32_16x16x32_bf16(Af[h][0], B0, a, 0, 0, 0);
            a = __builtin_amdgcn_mfma_f32_16x16x32_bf16(Af[h][1], B1, a, 0, 0, 0);
#pragma unroll
            for (int r = 0; r < 4; ++r) I[r] = __builtin_fmaf(wv[r][h], __builtin_fabsf(a[r]), I[r]); }
        const int kidx = kt * 16 + fr;
#pragma unroll
        for (int r = 0; r < 4; ++r) { const unsigned key = f16key(I[r]); Ik[(fq * 4 + r) * 4096 + kidx] = (unsigned short)key;
            if (kidx <= q0 + fq * 4 + r) atomicAdd(&hist1[(fq * 4 + r) * 256 + (key >> 8)], 1u); }
        B0 = nB0; B1 = nB1;
    }
    __syncthreads();
    for (int qq = w; qq < 16; qq += NWAVES) {
        const int t = q0 + qq, n = t + 1;
        unsigned short* so = SEL + (rowb + t) * TOPK;
        const unsigned short* keys = Ik + qq * 4096;
        if (n <= TOPK) { for (int j = lane; j < n; j += 64) so[j] = (unsigned short)j; }
        else {
            int b1, rem1, b2, rem2;
            find_bin(hist1 + qq * 256, TOPK, lane, b1, rem1);
            *(v4u*)(hist + 4 * lane) = (v4u){0u, 0u, 0u, 0u};
            LDS_WAIT(); __builtin_amdgcn_wave_barrier();
            for (int j = lane; j < n; j += 64) { const unsigned k = keys[j]; if ((int)(k >> 8) == b1) atomicAdd(&hist[k & 255u], 1u); }
            LDS_WAIT(); __builtin_amdgcn_wave_barrier();
            find_bin(hist, rem1, lane, b2, rem2);
            const unsigned thr = ((unsigned)b1 << 8) | (unsigned)b2;
            int base = 0, eqtaken = 0;
            const unsigned long long lt = (lane == 0) ? 0ull : (~0ull >> (64 - lane));
            for (int j0 = 0; j0 < n; j0 += 64) {
                const int j = j0 + lane; const bool valid = j < n; const unsigned k = valid ? (unsigned)keys[j] : 0u;
                const bool gt = valid && k > thr, eq = valid && k == thr;
                const unsigned long long meq = __ballot(eq);
                const int erank = __popcll(meq & lt) + eqtaken;
                const bool take = gt || (eq && erank < rem2);
                const unsigned long long mt = __ballot(take);
                if (take) so[base + __popcll(mt & lt)] = (unsigned short)j;
                base += __popcll(mt); eqtaken += __popcll(meq);
            }
        }
    }
    __syncthreads();
}

__device__ __forceinline__ void qknorm_token(const Params& p, int tok, int lane) {
    const bf16* row = (const bf16*)(p.ws + WS_ATT) + (size_t)tok * LD_ATT;
    const int c8 = (lane & 7) * 8;
    { const v4u qv = *(const v4u*)(row + lane * 8);
      float x[8]; float ss = 0.f;
#pragma unroll
      for (int i = 0; i < 4; ++i) { x[2 * i] = bflo(qv[i]); x[2 * i + 1] = bfhi(qv[i]); ss += x[2 * i] * x[2 * i] + x[2 * i + 1] * x[2 * i + 1]; }
      ss += __shfl_xor(ss, 1); ss += __shfl_xor(ss, 2); ss += __shfl_xor(ss, 4);
      const float rs = rsqrtf(ss * (1.f / 64.f) + RMS_EPS) * (0.125f * 1.4426950408889634f);
#pragma unroll
      for (int i = 0; i < 8; ++i) x[i] = x[i] * rs * p.q_norm_g[c8 + i];
      v2u hw, lw;
      hw.x = pk4_fp8(x[0], x[1], x[2], x[3]); hw.y = pk4_fp8(x[4], x[5], x[6], x[7]);
      { const f32x2 d0 = __builtin_amdgcn_cvt_pk_f32_fp8((int)hw.x, false), d1 = __builtin_amdgcn_cvt_pk_f32_fp8((int)hw.x, true), d2 = __builtin_amdgcn_cvt_pk_f32_fp8((int)hw.y, false), d3 = __builtin_amdgcn_cvt_pk_f32_fp8((int)hw.y, true);
        lw.x = pk4_fp8(x[0] - d0[0], x[1] - d0[1], x[2] - d1[0], x[3] - d1[1]); lw.y = pk4_fp8(x[4] - d2[0], x[5] - d2[1], x[6] - d3[0], x[7] - d3[1]); }
      *(v2u*)(p.ws + WS_QHI + (size_t)tok * 512 + lane * 8) = hw; *(v2u*)(p.ws + WS_QLO + (size_t)tok * 512 + lane * 8) = lw; }
    { const v4u kv = *(const v4u*)(row + 512 + (lane & 15) * 8);
      float x[8]; float ss = 0.f;
#pragma unroll
      for (int i = 0; i < 4; ++i) { x[2 * i] = bflo(kv[i]); x[2 * i + 1] = bfhi(kv[i]); ss += x[2 * i] * x[2 * i] + x[2 * i + 1] * x[2 * i + 1]; }
      ss += __shfl_xor(ss, 1); ss += __shfl_xor(ss, 2); ss += __shfl_xor(ss, 4);
      const float rs = rsqrtf(ss * (1.f / 64.f) + RMS_EPS);
#pragma unroll
      for (int i = 0; i < 8; ++i) x[i] = x[i] * rs * p.k_norm_g[c8 + i];
      v2u o; o.x = pk4_fp8(x[0], x[1], x[2], x[3]); o.y = pk4_fp8(x[4], x[5], x[6], x[7]);
      if (lane < 16) *(v2u*)(p.ws + WS_K8 + (size_t)tok * 128 + lane * 8) = o; }
}

typedef short v4i16_t __attribute__((ext_vector_type(4)));
__device__ __forceinline__ v4i16_t vtr16(const bf16* ldsp) { return __builtin_amdgcn_ds_read_tr16_b64_v4i16((LAS v4i16_t*)ldsp); }
__device__ __forceinline__ void dsa2_query(const Params& p, unsigned char* ldsw, int b, int t, int lane) {
    unsigned char* ws = p.ws;
    const bf16* ATT = (const bf16*)(ws + WS_ATT);
    const unsigned short* SEL = (const unsigned short*)(ws + WS_SEL);
    bf16* YB = (bf16*)(ws + WS_H);
    unsigned short* sl = (unsigned short*)ldsw;
    float* df = (float*)(ldsw + 512);
    bf16* Vl = (bf16*)(ldsw + 1536);
    const int fr = lane & 15, fq = lane >> 4;
    const size_t rowb = (size_t)b * SEQ;
    const int cnt = (t + 1 < TOPK) ? (t + 1) : TOPK;
    { v2u sv = *(const v2u*)(SEL + (rowb + t) * TOPK + lane * 4);
      const int j0 = lane * 4;
      if (j0 >= cnt) sv.x = 0u; else if (j0 + 1 >= cnt) sv.x &= 0xffffu;
      if (j0 + 2 >= cnt) sv.y = 0u; else if (j0 + 3 >= cnt) sv.y &= 0xffffu;
      *(v2u*)(sl + lane * 4) = sv;
      f32x4 d4; d4[0] = (j0 < cnt) ? (float)(t - (int)(sv.x & 0xffffu)) : INFINITY; d4[1] = (j0 + 1 < cnt) ? (float)(t - (int)(sv.x >> 16)) : INFINITY;
      d4[2] = (j0 + 2 < cnt) ? (float)(t - (int)(sv.y & 0xffffu)) : INFINITY; d4[3] = (j0 + 3 < cnt) ? (float)(t - (int)(sv.y >> 16)) : INFINITY;
      *(f32x4*)(df + lane * 4) = d4; }
    LDS_WAIT(); __builtin_amdgcn_wave_barrier();
    const unsigned char* K8 = ws + WS_K8;
    long qhA[2] = {0, 0}, qhB[2] = {0, 0}, qlA[2] = {0, 0}, qlB[2] = {0, 0};
    if (fr < 8) { const v4u qh = *(const v4u*)(ws + WS_QHI + (rowb + t) * 512 + fr * 64 + fq * 16), ql = *(const v4u*)(ws + WS_QLO + (rowb + t) * 512 + fr * 64 + fq * 16);
        const long hA = (long)(((unsigned long long)qh.y << 32) | qh.x), hB = (long)(((unsigned long long)qh.w << 32) | qh.z), lA = (long)(((unsigned long long)ql.y << 32) | ql.x), lB = (long)(((unsigned long long)ql.w << 32) | ql.z);
        if (fr < 4) { qhA[0] = hA; qhB[0] = hB; qlA[0] = lA; qlB[0] = lB; } else { qhA[1] = hA; qhB[1] = hB; qlA[1] = lA; qlB[1] = lB; } }
    pg8::f32x4 sc[16];
    v4u vv[16];
    { v4u kf[16];
#pragma unroll
      for (int half = 0; half < 2; ++half) {
#pragma unroll
          for (int kt = 0; kt < 8; ++kt) { const int s = sl[(half * 8 + kt) * 16 + fr]; const unsigned char* kp = K8 + (rowb + s) * 128 + fq * 16;
              kf[2 * kt] = *(const v4u*)kp; kf[2 * kt + 1] = *(const v4u*)(kp + 64); }
          if (half == 1) {
#pragma unroll
              for (int i = 0; i < 8; ++i) { const int s = sl[i * 8 + (lane >> 3)]; vv[i] = *(const v4u*)(ATT + (rowb + s) * LD_ATT + 640 + (lane & 7) * 8); } }
          __builtin_amdgcn_sched_barrier(0);
#pragma unroll
          for (int kt = 0; kt < 8; ++kt) { pg8::f32x4 a = {0.f, 0.f, 0.f, 0.f};
#pragma unroll
              for (int gg = 0; gg < 2; ++gg) { const v4u kv = kf[2 * kt + gg];
                  const long kA = (long)(((unsigned long long)kv.y << 32) | kv.x), kB = (long)(((unsigned long long)kv.w << 32) | kv.z);
                  a = __builtin_amdgcn_mfma_f32_16x16x32_fp8_fp8(kA, qhA[gg], a, 0, 0, 0); a = __builtin_amdgcn_mfma_f32_16x16x32_fp8_fp8(kB, qhB[gg], a, 0, 0, 0);
                  a = __builtin_amdgcn_mfma_f32_16x16x32_fp8_fp8(kA, qlA[gg], a, 0, 0, 0); a = __builtin_amdgcn_mfma_f32_16x16x32_fp8_fp8(kB, qlB[gg], a, 0, 0, 0); }
              sc[half * 8 + kt] = a; }
          __builtin_amdgcn_sched_barrier(0);
      } }
    const float slope = exp2f(-(float)((fr & 7) + 1)) * 1.4426950408889634f;
    float m = -INFINITY;
#pragma unroll
    for (int kt = 0; kt < 16; ++kt) { const f32x4 d4 = *(const f32x4*)(df + kt * 16 + fq * 4);
#pragma unroll
        for (int r = 0; r < 4; ++r) { const float x = sc[kt][r] - slope * d4[r]; sc[kt][r] = x; m = fmaxf(m, x); } }
    m = fmaxf(m, __shfl_xor(m, 16)); m = fmaxf(m, __shfl_xor(m, 32));
    float l = 0.f;
#pragma unroll
    for (int kt = 0; kt < 16; ++kt)
#pragma unroll
        for (int r = 0; r < 4; ++r) { const float e = __builtin_amdgcn_exp2f(sc[kt][r] - m); sc[kt][r] = e; l += e; }
    l += __shfl_xor(l, 16); l += __shfl_xor(l, 32);
    const float inv = 1.f / l;
#pragma unroll 1
    for (int g = 0; g < 2; ++g) {
        if (g == 1) {
#pragma unroll
            for (int i = 0; i < 8; ++i) { const int s = sl[i * 8 + (lane >> 3)]; vv[i] = *(const v4u*)(ATT + (rowb + s) * LD_ATT + 640 + 64 + (lane & 7) * 8); } }
#pragma unroll
        for (int i = 8; i < 16; ++i) { const int s = sl[i * 8 + (lane >> 3)]; vv[i] = *(const v4u*)(ATT + (rowb + s) * LD_ATT + 640 + g * 64 + (lane & 7) * 8); }
        pg8::f32x4 o[4];
#pragma unroll
        for (int dt = 0; dt < 4; ++dt) o[dt] = (pg8::f32x4){0.f, 0.f, 0.f, 0.f};
#pragma unroll
        for (int ch = 0; ch < 4; ++ch) {
            LDS_WAIT(); __builtin_amdgcn_wave_barrier();
#pragma unroll
            for (int i = 0; i < 8; ++i) *(v4u*)(Vl + (i * 8 + (lane >> 3)) * 80 + (lane & 7) * 8) = vv[(ch & 1) * 8 + i];
            if (ch < 2) {
#pragma unroll
                for (int i = 0; i < 8; ++i) { const int s = sl[((ch + 2) * 8 + i) * 8 + (lane >> 3)]; vv[(ch & 1) * 8 + i] = *(const v4u*)(ATT + (rowb + s) * LD_ATT + 640 + g * 64 + (lane & 7) * 8); } }
            LDS_WAIT(); __builtin_amdgcn_wave_barrier();
#pragma unroll
            for (int k2 = 0; k2 < 2; ++k2) { const int kt0 = ch * 4 + 2 * k2;
                v4u pw; pw.x = pk2(sc[kt0][0], sc[kt0][1]); pw.y = pk2(sc[kt0][2], sc[kt0][3]); pw.z = pk2(sc[kt0 + 1][0], sc[kt0 + 1][1]); pw.w = pk2(sc[kt0 + 1][2], sc[kt0 + 1][3]);
                const bf16x8 pb = __builtin_bit_cast(bf16x8, pw);
#pragma unroll
                for (int dt = 0; dt < 4; ++dt) { const bf16* vp = Vl + ((2 * k2) * 16 + fq * 4 + (fr >> 2)) * 80 + dt * 16 + (fr & 3) * 4;
                    const v4i16_t lo = vtr16(vp), hi = vtr16(vp + 16 * 80);
                    const bf16x8 af = {lo[0], lo[1], lo[2], lo[3], hi[0], hi[1], hi[2], hi[3]};
                    o[dt] = __builtin_amdgcn_mfma_f32_16x16x32_bf16(af, pb, o[dt], 0, 0, 0); } }
        }
        if (fr < 8 && (fr >> 2) == g) {
#pragma unroll
            for (int dt = 0; dt < 4; ++dt) { const float i8 = inv * 8.f;
                *(unsigned*)((unsigned char*)YB + (rowb + t) * 1024 + 512 + fr * 64 + dt * 16 + fq * 4) = pk4_fp8(o[dt][0] * i8, o[dt][1] * i8, o[dt][2] * i8, o[dt][3] * i8); } }
    }
    LDS_WAIT(); __builtin_amdgcn_wave_barrier();
}

#define INS16(L, x) do { _Pragma("unroll") for (int _i = 15; _i >= 1; --_i) L[_i] = __builtin_amdgcn_fmed3f(L[_i - 1], L[_i], (x)); L[0] = fmaxf(L[0], (x)); } while (0)
__device__ __forceinline__ float f_andor(float v, unsigned keepmask, unsigned orv) { return __builtin_bit_cast(float, (__builtin_bit_cast(unsigned, v) & keepmask) | orv); }
__device__ __forceinline__ void peer_route_item(const Params& p, unsigned char* ldsw, int tg, int h, int lane, int* EIDX, float* GATES) {
    unsigned char* ws = p.ws;
    const bf16* Q = (const bf16*)(ws + WS_Q);
    const bf16* SK = (const bf16*)(ws + WS_SK);
    float* sc = (float*)ldsw;
    const int fr = lane & 15, fq = lane >> 4;
#pragma unroll 1
    for (int pp = 0; pp < 2; ++pp) {
        bf16x8 Af[4], Bf[32];
        { const bf16* rp = Q + (size_t)(tg * 16 + fr) * 2048 + h * 256 + pp * 128 + fq * 8;
#pragma unroll
          for (int ks = 0; ks < 4; ++ks) Af[ks] = *(const bf16x8*)(rp + ks * 32); }
#pragma unroll
        for (int kt = 0; kt < 8; ++kt) { const bf16* kp = SK + (size_t)((h * 2 + pp) * 128 + kt * 16 + fr) * 128 + fq * 8;
#pragma unroll
            for (int ks = 0; ks < 4; ++ks) Bf[kt * 4 + ks] = *(const bf16x8*)(kp + ks * 32); }
        __builtin_amdgcn_sched_barrier(0);
#pragma unroll
        for (int kt = 0; kt < 8; ++kt) {
            pg8::f32x4 a = {0.f, 0.f, 0.f, 0.f};
#pragma unroll
            for (int ks = 0; ks < 4; ++ks) a = __builtin_amdgcn_mfma_f32_16x16x32_bf16(Af[ks], Bf[kt * 4 + ks], a, 0, 0, 0);
#pragma unroll
            for (int r = 0; r < 4; ++r) sc[(pp * 16 + fq * 4 + r) * 132 + kt * 16 + fr] = f_andor(a[r], ~127u, (unsigned)(kt * 16 + fr));
        }
    }
    LDS_WAIT(); __builtin_amdgcn_wave_barrier();
    float L[16];
#pragma unroll
    for (int i = 0; i < 16; ++i) L[i] = -INFINITY;
    { const float* sp = sc + (lane & 31) * 132 + (lane >> 5) * 64;
#pragma unroll 4
      for (int i = 0; i < 16; ++i) { const f32x4 x = *(const f32x4*)(sp + 4 * i); INS16(L, x[0]); INS16(L, x[1]); INS16(L, x[2]); INS16(L, x[3]); } }
    { float O[16];
#pragma unroll
      for (int i = 0; i < 16; ++i) O[i] = __shfl_xor(L[i], 32);
#pragma unroll
      for (int i = 0; i < 16; ++i) INS16(L, O[i]); }
    LDS_WAIT(); __builtin_amdgcn_wave_barrier();
    float* lst = sc;
    if (lane < 32) {
#pragma unroll
        for (int i = 0; i < 4; ++i) *(f32x4*)(lst + lane * 16 + 4 * i) = (f32x4){L[4 * i], L[4 * i + 1], L[4 * i + 2], L[4 * i + 3]}; }
    LDS_WAIT(); __builtin_amdgcn_wave_barrier();
    const int tok = lane & 15;
    float s1[16], s2[16];
#pragma unroll
    for (int i = 0; i < 4; ++i) { const f32x4 a = *(const f32x4*)(lst + tok * 16 + 4 * i), b = *(const f32x4*)(lst + (16 + tok) * 16 + 4 * i);
#pragma unroll
        for (int c = 0; c < 4; ++c) { s1[4 * i + c] = f_andor(a[c], ~127u, 0u); s2[4 * i + c] = f_andor(b[c], ~127u, 0u); } }
    float M[16];
#pragma unroll
    for (int i = 0; i < 16; ++i) M[i] = -INFINITY;
#pragma unroll
    for (int a = 0; a < 16; ++a)
#pragma unroll
        for (int b = 0; b < 16; ++b)
            if ((a + 1) * (b + 1) <= 16) { const float key = f_andor(s1[a] + s2[b], ~255u, (unsigned)(a * 16 + b)); INS16(M, key); }
    const float mx = f_andor(M[0], ~255u, 0u);
    float e[16], sum = 0.f; int ei[16];
    const unsigned* lb = (const unsigned*)lst;
#pragma unroll
    for (int i = 0; i < 16; ++i) { const unsigned bits = __builtin_bit_cast(unsigned, M[i]); const int flat = bits & 255u;
        e[i] = __expf(f_andor(M[i], ~255u, 0u) - mx); sum += e[i];
        ei[i] = (int)(lb[tok * 16 + (flat >> 4)] & 127u) * 128 + (int)(lb[(16 + tok) * 16 + (flat & 15)] & 127u); }
    const float inv = 1.f / sum;
    if (lane < 16) {
        const size_t ob = ((size_t)tok * 8 + h) * 16;
#pragma unroll
        for (int i = 0; i < 4; ++i) { *(v4u*)(EIDX + ob + 4 * i) = (v4u){(unsigned)ei[4 * i], (unsigned)ei[4 * i + 1], (unsigned)ei[4 * i + 2], (unsigned)ei[4 * i + 3]};
            *(f32x4*)(GATES + ob + 4 * i) = (f32x4){e[4 * i] * inv, e[4 * i + 1] * inv, e[4 * i + 2] * inv, e[4 * i + 3] * inv}; }
    }
    LDS_WAIT(); __builtin_amdgcn_wave_barrier();
}

__device__ __forceinline__ float gelu_erf(float x) { return 0.5f * x * (1.f + erff(x * 0.70710678118654752f)); }
typedef int v8i_t __attribute__((ext_vector_type(8)));
template <int OPSEL> __device__ __forceinline__ pg8::f32x4 mx_dot(v8i_t a, int sa, v8i_t b, int sb, pg8::f32x4 c) {
    return __builtin_amdgcn_mfma_scale_f32_16x16x128_f8f6f4(a, b, c, 4  , 4  , OPSEL, sa, OPSEL, sb);
}
__device__ __forceinline__ void peer_token(const Params& p, unsigned char* ldsw, int tok, int lane, const int* EIDX, const float* GATES, bool dry = false) {
    unsigned char* ws = p.ws;
    const unsigned char* V8 = ws + WS_V; const unsigned char* V8S = ws + WS_VS;
    const float* MOD = (const float*)(ws + WS_MOD);
    const int fr = lane & 15, fq = lane >> 4;
    typedef v8i_t v8i;
    v4u A4[H4_NT][8]; v2u As[H4_NT];
#pragma unroll
    for (int t = 0; t < H4_NT; ++t) { const unsigned char* hp = ws + WS_H4D + ((size_t)tok * H4_NT + t) * 512 + fq * 16;
        As[t] = *(const v2u*)(ws + WS_H4S + ((size_t)tok * H4_NT + t) * 32 + fq * 8);
#pragma unroll
        for (int kk = 0; kk < 8; ++kk) A4[t][kk] = *(const v4u*)(hp + kk * 64); }
    int* pe = (int*)ldsw; float* pa = (float*)(ldsw + 512);
    const unsigned char* U4 = ws + WS_U; const unsigned char* U4S = ws + WS_US;
#pragma unroll 2
    for (int ct = 0; ct < 8; ++ct) {
        const int eic = EIDX[ct * 16 + fr]; const float gt = GATES[ct * 16 + fr];
        const unsigned char* ur = U4 + (size_t)eic * 512 + fq * 16;
        const v2u us = *(const v2u*)(U4S + (size_t)eic * 32 + fq * 8);
        pg8::f32x4 ah = {0.f, 0.f, 0.f, 0.f};
#pragma unroll
        for (int kk = 0; kk < 8; ++kk) { const v4u bu = *(const v4u*)(ur + kk * 64);
            const v8i bb = {(int)bu.x, (int)bu.y, (int)bu.z, (int)bu.w, 0, 0, 0, 0};
            const int sb = (int)((kk < 4) ? us.x : us.y);
#pragma unroll
            for (int t = 0; t < H4_NT; ++t) { const v8i aa = {(int)A4[t][kk].x, (int)A4[t][kk].y, (int)A4[t][kk].z, (int)A4[t][kk].w, 0, 0, 0, 0}; const int sa = (int)((kk < 4) ? As[t].x : As[t].y);
                if ((kk & 3) == 0) ah = mx_dot<0>(aa, sa, bb, sb, ah); else if ((kk & 3) == 1) ah = mx_dot<1>(aa, sa, bb, sb, ah); else if ((kk & 3) == 2) ah = mx_dot<2>(aa, sa, bb, sb, ah); else ah = mx_dot<3>(aa, sa, bb, sb, ah); } }
        const float dot = ah[0];
        if (fq == 0) { pe[ct * 16 + fr] = eic; pa[ct * 16 + fr] = gelu_erf(dot) * gt; }
    }
    __builtin_amdgcn_sched_barrier(0);
    const int hl = lane >> 5, bl = lane & 31;
    float acc[32];
#pragma unroll
    for (int i = 0; i < 32; ++i) acc[i] = 0.f;
    LDS_WAIT(); __builtin_amdgcn_wave_barrier();
#pragma unroll 1
    for (int ct = 0; ct < 16; ++ct)
#pragma unroll
        for (int jp = 0; jp < 4; ++jp) {
            const int idx = pe[ct * 8 + 2 * jp + hl]; const float a = pa[ct * 8 + 2 * jp + hl];
            const v4u vv = *(const v4u*)(V8 + (size_t)idx * 512 + bl * 16);
            const unsigned sbyte = V8S[(size_t)idx * 32 + bl];
            const float as = a * __builtin_bit_cast(float, sbyte << 23);
#pragma unroll
            for (int w4 = 0; w4 < 4; ++w4) { const unsigned wd = vv[w4];
                const f32x2 d0 = __builtin_amdgcn_cvt_scalef32_pk_f32_fp4(wd, 1.0f, 0), d1 = __builtin_amdgcn_cvt_scalef32_pk_f32_fp4(wd, 1.0f, 1), d2 = __builtin_amdgcn_cvt_scalef32_pk_f32_fp4(wd, 1.0f, 2), d3 = __builtin_amdgcn_cvt_scalef32_pk_f32_fp4(wd, 1.0f, 3);
                acc[8 * w4] += as * d0[0]; acc[8 * w4 + 1] += as * d0[1]; acc[8 * w4 + 2] += as * d1[0]; acc[8 * w4 + 3] += as * d1[1];
                acc[8 * w4 + 4] += as * d2[0]; acc[8 * w4 + 5] += as * d2[1]; acc[8 * w4 + 6] += as * d3[0]; acc[8 * w4 + 7] += as * d3[1]; }
        }
    LDS_WAIT(); __builtin_amdgcn_wave_barrier();
    float accs[16];
#pragma unroll
    for (int i = 0; i < 16; ++i) { const float lo = acc[i] + __shfl_xor(acc[i], 32), hi2 = acc[16 + i] + __shfl_xor(acc[16 + i], 32); accs[i] = hl ? hi2 : lo; }
    const int b = tok / SEQ;
    const int col0 = bl * 32 + hl * 16;
    const float* g2 = MOD + (size_t)b * 6144 + 5 * 1024 + col0;
    float* orow = p.out + (size_t)tok * DM + col0;
#pragma unroll
    for (int q4 = 0; q4 < 4; ++q4) { const f32x4 xv = *(const f32x4*)(orow + 4 * q4), gv = *(const f32x4*)(g2 + 4 * q4);
        f32x4 o;
#pragma unroll
        for (int i = 0; i < 4; ++i) o[i] = xv[i] + (dry ? 0.f : gv[i] * accs[4 * q4 + i]);
        if (dry) { asm volatile("" :: "v"(accs[4 * q4]), "v"(accs[4 * q4 + 1]), "v"(accs[4 * q4 + 2]), "v"(accs[4 * q4 + 3])); }
        *(f32x4*)(orow + 4 * q4) = o; }
}

#define XB_TMO      128
#define XB_XCNT(j)  (256  + 64 * (j))
#define XB_XSUB(j)  (1280 + 64 * (j))
#define XB_XGEN(j)  (2304 + 64 * (j))
#define XB_TOP      3328
#define XB_TOPGEN   3392
#define XCD_BAR_WORDS 3456
#define XB_SPIN_CAP (1u << 18)

__device__ __forceinline__ unsigned xb_ld(unsigned* p)              { return __hip_atomic_load(p, __ATOMIC_RELAXED, __HIP_MEMORY_SCOPE_AGENT); }
__device__ __forceinline__ unsigned xb_add(unsigned* p, unsigned v) { return __hip_atomic_fetch_add(p, v, __ATOMIC_RELAXED, __HIP_MEMORY_SCOPE_AGENT); }
__device__ __forceinline__ unsigned xb_xcc_id() { return (unsigned)__builtin_amdgcn_s_getreg((3 << 11) | 20) & 0xFu; }
#define XB_SPIN(cond, bar) do { unsigned _sp = 0; while (cond) { __builtin_amdgcn_s_sleep(1); \
    if ((++_sp & 255u) == 0u) { if (xb_ld(&(bar)[XB_TMO])) break; if (_sp > XB_SPIN_CAP) { atomicAdd(&(bar)[XB_TMO], 1u); break; } } } } while (0)

struct XcdBarrier {
    unsigned* bar; unsigned x;
    volatile LAS unsigned* st;
};

__device__ __forceinline__ XcdBarrier xcd_barrier_post(unsigned* bar, volatile LAS unsigned* st) {
    XcdBarrier b; b.bar = bar; b.x = xb_xcc_id(); b.st = st;
    if (threadIdx.x == 0) (void)xb_add(&bar[XB_XCNT(b.x)], 1u);
    return b;
}
__device__ __forceinline__ void xcd_barrier_complete(unsigned* bar, unsigned x, unsigned& nloc, unsigned& nx) {
    const unsigned G = gridDim.x * gridDim.y * gridDim.z;
    unsigned sum, cnt, mine, sp = 0u;
    for (;;) {
        sum = 0u; cnt = 0u; mine = 0u;
#pragma unroll
        for (unsigned j = 0; j < 16; ++j) { const unsigned c = xb_ld(&bar[XB_XCNT(j)]); sum += c; cnt += (c > 0u) ? 1u : 0u; mine = (j == x) ? c : mine; }
        if (sum == G) break;
        __builtin_amdgcn_s_sleep(1);
        if ((++sp & 255u) == 0u) { if (xb_ld(&bar[XB_TMO])) break; if (sp > XB_SPIN_CAP) { atomicAdd(&bar[XB_TMO], 1u); break; } }
    }
    nloc = mine > 0u ? mine : 1u; nx = cnt > 0u ? cnt : 1u;
}

__device__ __forceinline__ void xcd_barrier(const XcdBarrier& b) {
    asm volatile("s_waitcnt vmcnt(0)" ::: "memory");
    __syncthreads();
    if (threadIdx.x == 0) {
        unsigned* bar = b.bar;
        __builtin_amdgcn_s_waitcnt(0);
        unsigned nloc = b.st[0], nx = b.st[1];
        if (nloc == 0u) { xcd_barrier_complete(bar, b.x, nloc, nx); b.st[0] = nloc; b.st[1] = nx; }
        const unsigned old = xb_add(&bar[XB_XSUB(b.x)], 1u);
        const unsigned gen = old / nloc;
        if (old + 1u == (gen + 1u) * nloc) {
            __builtin_amdgcn_fence(__ATOMIC_RELEASE, "agent");
            asm volatile("s_waitcnt vmcnt(0)" ::: "memory");
            const unsigned og = xb_add(&bar[XB_TOP], 1u);
            const unsigned tg = og / nx;
            if (og + 1u == (tg + 1u) * nx) xb_add(&bar[XB_TOPGEN], 1u);
            else XB_SPIN(xb_ld(&bar[XB_TOPGEN]) == tg, bar);
            __builtin_amdgcn_fence(__ATOMIC_ACQUIRE, "agent");
            xb_add(&bar[XB_XGEN(b.x)], 1u);
            asm volatile("s_waitcnt vmcnt(0)" ::: "memory");
        } else {
            XB_SPIN(xb_ld(&bar[XB_XGEN(b.x)]) == gen, bar);
            __builtin_amdgcn_fence(__ATOMIC_ACQUIRE, "agent");
            asm volatile("s_waitcnt vmcnt(0)" ::: "memory");
        }
    }
    __syncthreads();
}

constexpr int NPHASE = 11;
__global__ void __launch_bounds__(NTHREADS, 2) mega(Params p) {
    extern __shared__ __attribute__((aligned(16))) unsigned char lds[];
    cg::grid_group grid = cg::this_grid();
    const int lo = p.ph_lo, hi = p.ph_hi;
    const int tid = threadIdx.x, wave = tid >> 6, lane = tid & 63, G = gridDim.x;
    unsigned char* ws = p.ws;
#ifndef ONLYPH
#define IN(k) (lo <= (k) && (k) < hi)
#else
#define IN(k) ((k) == ONLYPH && lo <= (k) && (k) < hi)
#endif
    volatile LAS unsigned* xb_st = (volatile LAS unsigned*)((LAS unsigned char*)lds + (LDS_BYTES - 16));
    if (tid < 4) xb_st[tid] = 0u;
    __syncthreads();
    XcdBarrier xbar; xbar.bar = (unsigned*)(ws + WS_CTL); xbar.x = 0; xbar.st = xb_st;
    if (hi - lo > 1) xbar = xcd_barrier_post((unsigned*)(ws + WS_CTL), xb_st);
    if (lo < -1) grid.sync();
#define SEAM(k) do { if (IN((k) + 1)) xcd_barrier(xbar); } while (0)
#ifndef REPMASK
#define REPMASK 0
#endif
#define NREP(k) (((REPMASK >> (k)) & 1) ? 2 : 1)
    if (IN(0)) { for (int rep = 0; rep < NREP(0); ++rep) phase0(p, lds); SEAM(0); }
    if (IN(1)) { for (int rep = 0; rep < NREP(1); ++rep) normmod_phase<true>(p, lds, p.x, (bf16*)(ws + WS_H), p.norm1_g, 0, 1024); SEAM(1); }
    if (IN(2)) {
        { pg8::Gemm g{(const bf16*)(ws + WS_H8), (const bf16*)(ws + WS_WIN8), T, 3584, 512, 512, 512}; pg8::StaticOrder S; S.init(T, 3584, G, (int)blockIdx.x);
          EpiProj E{(bf16*)(ws + WS_HG), (bf16*)(ws + WS_ATT), (bf16*)(ws + WS_IDX), (bf16*)(ws + WS_GATE), 1};
          pg8::gemm_phase<EpiProj, pg8::StaticOrder, true, true, 122>((PG8_LAS unsigned char*)lds, g, S, E); }
        { pg8::Gemm g{(const bf16*)(ws + WS_H), (const bf16*)(ws + WS_WIN), T, 2048, 1024, 1024, 1024}; pg8::StaticOrder S; S.init(T, 2048, G, (int)blockIdx.x);
          EpiProj E{(bf16*)(ws + WS_HG), (bf16*)(ws + WS_ATT), (bf16*)(ws + WS_IDX), (bf16*)(ws + WS_GATE), 0};
          pg8::gemm_phase<EpiProj, pg8::StaticOrder, true, true>((PG8_LAS unsigned char*)lds, g, S, E); }
        SEAM(2);
    }
    if (IN(3)) {
        for (int tok = (int)blockIdx.x * NWAVES + wave; tok < T; tok += G * NWAVES) qknorm_token(p, tok, lane);
        SEAM(3);
    }
    if (IN(4)) {
        if ((int)blockIdx.x < 32) hgrn_item(p, lds, (int)blockIdx.x);
        {
            unsigned* qctr = (unsigned*)(ws + WS_CTL + 32768);
            volatile LAS unsigned* qslot = (volatile LAS unsigned*)((LAS unsigned char*)lds + (LDS_BYTES - 32));
            for (;;) {
                if (tid == 0) *qslot = __hip_atomic_fetch_add(qctr, 1u, __ATOMIC_RELAXED, __HIP_MEMORY_SCOPE_AGENT);
                __syncthreads();
                const unsigned c = *qslot;
                __syncthreads();
                if (c >= (unsigned)(BATCH * (SEQ / 16))) break;
                const int b = (int)(c & 7u), qblk = (SEQ / 16 - 1) - (int)(c >> 3), it = b * (SEQ / 16) + qblk, q0 = qblk * 16;
                dsa1_item(p, lds, it);
#pragma unroll 1
                for (int k2 = 0; k2 < 2; ++k2) dsa2_query(p, lds + wave * 16384, b, q0 + wave + 8 * k2, lane);
                __syncthreads();
            }
        }
        SEAM(4);
    }
    if (IN(5)) {
        pg8::Gemm g{(const bf16*)(ws + WS_H), (const bf16*)(ws + WS_WAB8), T, 1024, 256, 512, 512}; pg8::StaticOrderT<true> S; S.init(T, 1024, G, (int)blockIdx.x, 256);
        EpiMerged E{(const bf16*)(ws + WS_GATE), (bf16*)(ws + WS_MERGED)};
        for (int rep = 0; rep < NREP(5); ++rep) pg8::gemm_phase<EpiMerged, pg8::StaticOrderT<true>, true, true, 122>((PG8_LAS unsigned char*)lds, g, S, E);
        SEAM(5);
    }
    if (IN(6)) {
        pg8::Gemm g{(const bf16*)(ws + WS_MERGED), (const bf16*)(ws + WS_WOUT8), T, 1024, 512, 512, 512}; pg8::StaticOrder S; S.init(T, 1024, G, (int)blockIdx.x);
        EpiResid E{p.x, (const float*)(ws + WS_MOD) + 2048, p.out};
        for (int rep = 0; rep < NREP(6); ++rep) pg8::gemm_phase<EpiResid, pg8::StaticOrder, true, true, 120>((PG8_LAS unsigned char*)lds, g, S, E);
        SEAM(6);
    }
    if (IN(7)) { for (int rep = 0; rep < NREP(7); ++rep) normmod_phase<false>(p, lds, p.out, (bf16*)(ws + WS_H), p.norm2_g, 3 * 1024, 4 * 1024); SEAM(7); }
    if (IN(8)) {
        pg8::Gemm g{(const bf16*)(ws + WS_H), (const bf16*)(ws + WS_WQ), T, 2048, 1024, 1024, 1024}; pg8::StaticOrder S; S.init(T, 2048, G, (int)blockIdx.x);
        EpiStore E{(bf16*)(ws + WS_Q), 2048};
        for (int rep = 0; rep < NREP(8); ++rep) pg8::gemm_phase<EpiStore, pg8::StaticOrder, true, true>((PG8_LAS unsigned char*)lds, g, S, E);
        SEAM(8);
    }
    if (IN(9)) {
        int* eL = (int*)(lds + 8 * 16896); float* gL = (float*)(lds + 8 * 16896 + 8192);
        for (int tg = blockIdx.x; tg < T / 16; tg += G) {
            peer_route_item(p, lds + wave * 16896, tg, wave, lane, eL, gL);
            __syncthreads();
#pragma unroll 1
            for (int k2 = 0; k2 < 2; ++k2) { const int tl = wave + 8 * k2; peer_token(p, lds + 8 * 16896 + 16384 + wave * 1024, tg * 16 + tl, lane, eL + tl * 128, gL + tl * 128); }
            __syncthreads();
        }
    }
#undef IN
#undef SEAM
}

#ifndef ONE_LAUNCH
#define ONE_LAUNCH 1
#endif
extern "C" void kernel_launch(void* const* d_in, const int* in_sizes, int n_in, void* d_out, int out_size, void* d_ws, size_t ws_size, hipStream_t stream) {
    static int grid = 0;
    if (grid == 0) {
        if (n_in != 18 || out_size != T * DM || ws_size < WS_END) { fprintf(stderr, "kernel_launch: unexpected shapes (n_in %d, out %d, ws %zu)\n", n_in, out_size, ws_size); grid = -1; return; }
        int dev = 0, cus = 0, per_cu = 0;
        if (hipGetDevice(&dev) != hipSuccess || hipDeviceGetAttribute(&cus, hipDeviceAttributeMultiprocessorCount, dev) != hipSuccess) { grid = -1; return; }
        if (hipFuncSetAttribute((const void*)mega, hipFuncAttributeMaxDynamicSharedMemorySize, LDS_BYTES) != hipSuccess) { fprintf(stderr, "kernel_launch: hipFuncSetAttribute failed\n"); grid = -1; return; }
        if (hipOccupancyMaxActiveBlocksPerMultiprocessor(&per_cu, (const void*)mega, NTHREADS, LDS_BYTES) != hipSuccess || per_cu < 1) { fprintf(stderr, "kernel_launch: occupancy query says %d\n", per_cu); grid = -1; return; }
        (void)hipGetLastError();
        grid = cus;
        if (grid < 64) { grid = -1; return; }
    }
    if (grid < 0) return;
    Params p{};
    const float** pp = (const float**)&p;
    for (int i = 0; i < 18; ++i) pp[i] = (const float*)d_in[i];
    p.out = (float*)d_out; p.ws = (unsigned char*)d_ws;
#if ONE_LAUNCH
    if (hipMemsetAsync((char*)d_ws + WS_CTL, 0, 65536, stream) != hipSuccess) { fprintf(stderr, "kernel_launch: memset failed\n"); return; }
    p.ph_lo = 0; p.ph_hi = NPHASE;
    void* args[] = {&p};
    hipError_t e = hipLaunchCooperativeKernel((const void*)mega, dim3(grid), dim3(NTHREADS), args, LDS_BYTES, stream);
    if (e != hipSuccess) fprintf(stderr, "cooperative launch failed: %s (grid %d)\n", hipGetErrorString(e), grid);
#else
    for (int k = 0; k < NPHASE; ++k) { p.ph_lo = k; p.ph_hi = k + 1; hipLaunchKernelGGL(mega, dim3(grid), dim3(NTHREADS), LDS_BYTES, stream, p); }
#endif
}
```

```cpp
#include <hip/hip_runtime.h>
#include <hip/hip_cooperative_groups.h>
#include <cstdio>
#include <cstdint>
namespace cg = cooperative_groups;

namespace pg8 {
#define PG8_LAS __attribute__((address_space(3)))
typedef unsigned short bf16_t;
typedef short bf16x8 __attribute__((ext_vector_type(8)));
typedef float f32x4 __attribute__((ext_vector_type(4)));
typedef unsigned u32x4 __attribute__((ext_vector_type(4)));
constexpr int BM = 256, BK = 64, HALF = 128, HTB = HALF * BK * 2  , STAGE_BYTES = 8 * HTB, NXCD = 8, WGM = 8;

__host__ __device__ __forceinline__ int lds_byte(int r, int c) { const int st = (r >> 4) * 2 + (c >> 5), rr = r & 15, cc = c & 31, ob = rr * 64 + cc * 2; return st * 1024 + (ob ^ (((ob >> 9) & 1) << 5)); }
__host__ __device__ __forceinline__ void stage_rc(int b, int& R, int& C) { const int st = b / 1024, sb = b % 1024, swz = sb ^ (((sb >> 9) & 1) << 5); R = (st >> 1) * 16 + swz / 64; C = (st & 1) * 32 + (swz % 64) / 2; }
__host__ __device__ __forceinline__ int perm32(int rho) { const int n = rho >> 4, i = rho & 15; return 8 * (i >> 2) + 4 * n + (i & 3); }

struct Unit { int pm, pn, ko, pass; };
struct Gemm { const bf16_t* A; const bf16_t* Bt; int M, N, K, lda, ldb; };
typedef float f32x16 __attribute__((ext_vector_type(16)));
typedef f32x16 AccW[2][2][2];
__device__ __forceinline__ f32x4 acc_get(const AccW& A, int ai, int bj, int m, int n) { const int s_ = ((m & 1) * 2 + n) * 4; const f32x16& w = A[ai][bj][m >> 1]; return (f32x4){w[s_], w[s_ + 1], w[s_ + 2], w[s_ + 3]}; }
__device__ __forceinline__ void acc_set(AccW& A, int ai, int bj, int m, int n, f32x4 v) { const int s_ = ((m & 1) * 2 + n) * 4; f32x16& w = A[ai][bj][m >> 1]; w[s_] = v[0]; w[s_ + 1] = v[1]; w[s_ + 2] = v[2]; w[s_ + 3] = v[3]; }

template <bool TWOPASS_ORDER = false>
struct StaticOrderT {
    int nM, nN, nwg, G, c, kpass;
    __host__ __device__ void init(int M, int N, int G_, int c_, int kpass_ = 512) { nM = M / BM; nN = N / BM; nwg = nM * nN; G = G_; c = c_; kpass = kpass_; }
    __host__ __device__ bool next(int i, Unit& u) const {
        const long L = (long)(TWOPASS_ORDER ? (i >> 1) : i) * G + c; if (L >= nwg) return false;
        u.pass = TWOPASS_ORDER ? (i & 1) : 0; u.ko = TWOPASS_ORDER ? (i & 1) * kpass : 0;
        int wgid = (int)L; { const int q = nwg / NXCD, r = nwg % NXCD, xcd = wgid % NXCD, off = wgid / NXCD; wgid = (xcd < r ? xcd * (q + 1) : r * (q + 1) + (xcd - r) * q) + off; }
        const int nig = WGM * nN, gid = wgid / nig, fm = gid * WGM, gsz = (nM - fm) < WGM ? (nM - fm) : WGM;
        u.pm = fm + ((wgid % nig) % gsz); u.pn = (wgid % nig) / gsz; return true;
    }
    __device__ __forceinline__ void a_ready(const Unit&) const {}
    __device__ __forceinline__ void done(const Unit&) const {}
};
typedef StaticOrderT<false> StaticOrder;

__device__ __forceinline__ unsigned cvt_pk_bf16(float lo, float hi) { unsigned r; asm volatile("v_cvt_pk_bf16_f32 %0, %1, %2" : "=v"(r) : "v"(lo), "v"(hi)); return r; }

template <class Epi, class Sched, bool ALIGN_EPI = false, bool SP2 = false, int F8SCALE = 0>
__device__ __forceinline__ void gemm_phase(PG8_LAS unsigned char* lds, const Gemm g, const Sched& S, const Epi& E) {
    const int tid = threadIdx.x, wid = __builtin_amdgcn_readfirstlane(tid >> 6), lane = tid & 63, wr = wid >> 2, wc = wid & 3, fr = lane & 15, fq = lane >> 4;
    const int K = g.K, nt = K / BK;
    unsigned voffA[2], voffB[2];
#pragma unroll
    for (int i = 0; i < 2; ++i) { int R, C; stage_rc(tid * 16 + i * 8192, R, C); const int Rb = Epi::PERM ? ((R & ~31) + perm32(R & 31)) : R;
        voffA[i] = (unsigned)(R * g.lda + C) * 2u; voffB[i] = (unsigned)(Rb * g.ldb + C) * 2u; }
    const size_t kstep = (size_t)(BK * 2);
    const size_t hstepA = (size_t)HALF * g.lda * 2, hstepB = (size_t)HALF * g.ldb * 2;
    const size_t tstepA = 2 * hstepA, tstepB = 2 * hstepB;
    const unsigned ldsw = (unsigned)wid * 1024u;
    const int aoff = lds_byte(wr * 64 + fr, fq * 8), boff = lds_byte(wc * 32 + fr, fq * 8);
#define PG8_SA(b, h) (((b) * 2 + (h)) * HTB)
#define PG8_SB(b, h) ((4 + (b) * 2 + (h)) * HTB)
#define PG8_STAGE(bufoff, gbase, voff) do { _Pragma("unroll") for (int _i = 0; _i < 2; ++_i) \
        __builtin_amdgcn_global_load_lds((const unsigned*)((const char*)(gbase) + (voff)[_i]), (PG8_LAS unsigned*)(lds + (bufoff) + ldsw + _i * 8192), 16, 0, 0); } while (0)
#define PG8_LDA(dst, b, h) do { _Pragma("unroll") for (int m = 0; m < 4; ++m) { if constexpr (F8SCALE != 0) { \
        PG8_F8(dst)[m].lo = *(const PG8_LAS v4i_f*)(lds + PG8_SA(b, h) + aoff + m * 2048); PG8_F8(dst)[m].hi = *(const PG8_LAS v4i_f*)(lds + PG8_SA(b, h) + aoff + m * 2048 + 1024); } \
        else { _Pragma("unroll") for (int k = 0; k < 2; ++k) dst[m][k] = *(const PG8_LAS bf16x8*)(lds + PG8_SA(b, h) + aoff + m * 2048 + k * 1024); } } } while (0)
#define PG8_LDB(dst, b, h) do { _Pragma("unroll") for (int n = 0; n < 2; ++n) { if constexpr (F8SCALE != 0) { \
        PG8_F8(dst)[n].lo = *(const PG8_LAS v4i_f*)(lds + PG8_SB(b, h) + boff + n * 2048); PG8_F8(dst)[n].hi = *(const PG8_LAS v4i_f*)(lds + PG8_SB(b, h) + boff + n * 2048 + 1024); } \
        else { _Pragma("unroll") for (int k = 0; k < 2; ++k) dst[n][k] = *(const PG8_LAS bf16x8*)(lds + PG8_SB(b, h) + boff + n * 2048 + k * 1024); } } } while (0)
#define PG8_MMA(ai, bj, At, Bt) do { __builtin_amdgcn_s_setprio(1); _Pragma("unroll") for (int m = 0; m < 4; ++m) _Pragma("unroll") for (int n = 0; n < 2; ++n) { \
        f32x4 _c = acc_get(accw, ai, bj, m, n); \
        if constexpr (F8SCALE != 0) { _c = __builtin_amdgcn_mfma_scale_f32_16x16x128_f8f6f4(PG8_F8(Bt)[n], PG8_F8(At)[m], _c, 0, 0, 0, 0x7f7f7f7f, 0, F8SCALE * 0x01010101); } \
        else { _Pragma("unroll") for (int k = 0; k < 2; ++k) _c = __builtin_amdgcn_mfma_f32_16x16x32_bf16(Bt[n][k], At[m][k], _c, 0, 0, 0); } \
        acc_set(accw, ai, bj, m, n, _c); } \
        __builtin_amdgcn_s_setprio(0); } while (0)
#define PG8_WAIT_V(n) asm volatile("s_waitcnt vmcnt(" #n ")" ::: "memory")
#define PG8_WAIT_L(n) asm volatile("s_waitcnt lgkmcnt(" #n ")" ::: "memory")
#define PG8_BAR __builtin_amdgcn_s_barrier()
#define PG8_SCHED __builtin_amdgcn_sched_barrier(0)
    Unit cur, nxt; int ui = 0;
    if (!S.next(0, cur)) return;
    typedef int v4i_f __attribute__((ext_vector_type(4))); typedef int v8i_f __attribute__((ext_vector_type(8))); typedef f32x16 f32x16_f;
    AccW accw;
#pragma unroll
    for (int a = 0; a < 2; ++a)
#pragma unroll
        for (int b = 0; b < 2; ++b)
#pragma unroll
            for (int mp = 0; mp < 2; ++mp)
#pragma unroll
                for (int i = 0; i < 16; ++i) accw[a][b][mp][i] = 0.f;
    bf16x8 At[4][2], B0[2][2], B1[2][2];
    v8i_f At8[4], B08[2], B18[2];
#define PG8_F8(x) x##8
    const char* cA = (const char*)g.A + (size_t)cur.pm * tstepA + (size_t)cur.ko * 2; const char* cB = (const char*)g.Bt + (size_t)cur.pn * tstepB + (size_t)cur.ko * 2;
    S.a_ready(cur);
    if constexpr (SP2) {
        PG8_STAGE(PG8_SB(0, 0), cB, voffB); PG8_STAGE(PG8_SB(0, 1), cB + hstepB, voffB); PG8_STAGE(PG8_SA(0, 0), cA, voffA); PG8_STAGE(PG8_SA(0, 1), cA + hstepA, voffA);
        if (wr == 1) PG8_BAR;
        PG8_WAIT_V(2); PG8_BAR;
        PG8_STAGE(PG8_SB(1, 0), cB + kstep, voffB); PG8_STAGE(PG8_SA(1, 0), cA + kstep, voffA); PG8_STAGE(PG8_SB(1, 1), cB + hstepB + kstep, voffB);
        PG8_WAIT_V(6); PG8_BAR;
    } else {
        PG8_STAGE(PG8_SB(0, 0), cB, voffB); PG8_STAGE(PG8_SA(0, 0), cA, voffA); PG8_STAGE(PG8_SB(0, 1), cB + hstepB, voffB); PG8_STAGE(PG8_SA(0, 1), cA + hstepA, voffA);
        if (wr == 1) PG8_BAR;
        PG8_WAIT_V(4); PG8_BAR;
        PG8_STAGE(PG8_SB(1, 0), cB + kstep, voffB); PG8_STAGE(PG8_SA(1, 0), cA + kstep, voffA); PG8_STAGE(PG8_SB(1, 1), cB + hstepB + kstep, voffB);
        PG8_WAIT_V(6); PG8_BAR;
    }
    for (;;) {
        const bool has_next = S.next(ui + 1, nxt);
        const char* nA = has_next ? (const char*)g.A + (size_t)nxt.pm * tstepA + (size_t)nxt.ko * 2 : cA; const char* nB = has_next ? (const char*)g.Bt + (size_t)nxt.pn * tstepB + (size_t)nxt.ko * 2 : cB;
        for (int t = 0; t < nt; t += 2) {
            const bool last = (t == nt - 2);
            const char* a1 = cA + (size_t)(t + 1) * kstep;
            const char* a2 = last ? nA : cA + (size_t)(t + 2) * kstep; const char* b2 = last ? nB : cB + (size_t)(t + 2) * kstep;
            const char* a3 = a2 + kstep; const char* b3 = b2 + kstep;
            if (last && has_next) S.a_ready(nxt);
            if constexpr (SP2) {
            PG8_LDB(B0, 0, 0); PG8_LDB(B1, 0, 1); PG8_SCHED; PG8_LDA(At, 0, 0); PG8_STAGE(PG8_SA(1, 1), a1 + hstepA, voffA);
            PG8_WAIT_V(8); PG8_WAIT_L(0); PG8_BAR; PG8_MMA(0, 0, At, B0); PG8_MMA(0, 1, At, B1); PG8_BAR; PG8_SCHED;
            PG8_LDA(At, 0, 1); PG8_STAGE(PG8_SB(0, 0), b2, voffB); PG8_STAGE(PG8_SB(0, 1), b2 + hstepB, voffB); PG8_STAGE(PG8_SA(0, 0), a2, voffA);
            PG8_WAIT_V(8); PG8_WAIT_L(0); PG8_BAR; PG8_MMA(1, 0, At, B0); PG8_MMA(1, 1, At, B1); PG8_BAR; PG8_SCHED;
            PG8_LDB(B0, 1, 0); PG8_LDB(B1, 1, 1); PG8_SCHED; PG8_LDA(At, 1, 0); PG8_STAGE(PG8_SA(0, 1), a2 + hstepA, voffA);
            PG8_WAIT_V(8); PG8_WAIT_L(0); PG8_BAR; PG8_MMA(0, 0, At, B0); PG8_MMA(0, 1, At, B1); PG8_BAR; PG8_SCHED;
            PG8_LDA(At, 1, 1); PG8_STAGE(PG8_SB(1, 0), b3, voffB); PG8_STAGE(PG8_SB(1, 1), b3 + hstepB, voffB); PG8_STAGE(PG8_SA(1, 0), a3, voffA);
            PG8_WAIT_V(8); PG8_WAIT_L(0); PG8_BAR; PG8_MMA(1, 0, At, B0); PG8_MMA(1, 1, At, B1); PG8_BAR; PG8_SCHED;
            } else {
            PG8_LDB(B0, 0, 0); PG8_SCHED; PG8_LDA(At, 0, 0); PG8_STAGE(PG8_SA(1, 1), a1 + hstepA, voffA);
            PG8_WAIT_L(8); PG8_BAR; PG8_WAIT_L(0); PG8_MMA(0, 0, At, B0); PG8_BAR; PG8_SCHED;
            PG8_LDB(B1, 0, 1); PG8_STAGE(PG8_SB(0, 0), b2, voffB);
            PG8_BAR; PG8_WAIT_L(0); PG8_MMA(0, 1, At, B1); PG8_BAR;
            PG8_LDA(At, 0, 1); PG8_STAGE(PG8_SA(0, 0), a2, voffA);
            PG8_BAR; PG8_WAIT_L(0); PG8_MMA(1, 0, At, B0); PG8_BAR; PG8_SCHED;
            PG8_STAGE(PG8_SB(0, 1), b2 + hstepB, voffB);
            PG8_WAIT_V(6); PG8_BAR; PG8_MMA(1, 1, At, B1); PG8_BAR;
            PG8_LDB(B0, 1, 0); PG8_SCHED; PG8_LDA(At, 1, 0); PG8_STAGE(PG8_SA(0, 1), a2 + hstepA, voffA);
            PG8_WAIT_L(8); PG8_BAR; PG8_WAIT_L(0); PG8_MMA(0, 0, At, B0); PG8_BAR; PG8_SCHED;
            PG8_LDB(B1, 1, 1); PG8_STAGE(PG8_SB(1, 0), b3, voffB);
            PG8_BAR; PG8_WAIT_L(0); PG8_MMA(0, 1, At, B1); PG8_BAR;
            PG8_LDA(At, 1, 1); PG8_STAGE(PG8_SA(1, 0), a3, voffA);
            PG8_BAR; PG8_WAIT_L(0); PG8_MMA(1, 0, At, B0); PG8_BAR; PG8_SCHED;
            PG8_STAGE(PG8_SB(1, 1), b3 + hstepB, voffB);
            PG8_WAIT_V(6); PG8_BAR; PG8_MMA(1, 1, At, B1); PG8_BAR;
            }
        }
        if constexpr (ALIGN_EPI) { if (wr == 0) PG8_BAR; }
        if constexpr (!Epi::AFTER_DRAIN) { E(accw, cur, wr, wc, fr, fq); S.done(cur); }
        const bool keep_acc = Epi::TWOPASS && (cur.pass == 0);
        if (!has_next) break;
        if (!keep_acc) {
#pragma unroll
            for (int a = 0; a < 2; ++a)
#pragma unroll
                for (int b = 0; b < 2; ++b)
#pragma unroll
                    for (int mp = 0; mp < 2; ++mp)
#pragma unroll
                        for (int i = 0; i < 16; ++i) accw[a][b][mp][i] = 0.f;
        }
        cur = nxt; cA = nA; cB = nB; ++ui;
        if constexpr (ALIGN_EPI) { if (wr == 1) PG8_BAR; }
    }
    PG8_WAIT_V(0);
    if constexpr (!ALIGN_EPI) { if (wr == 0) PG8_BAR; }
    PG8_BAR;

#undef PG8_SA
#undef PG8_SB
#undef PG8_STAGE
#undef PG8_LDA
#undef PG8_LDB
#undef PG8_MMA
#undef PG8_F8
#undef PG8_WAIT_V
#undef PG8_WAIT_L
#undef PG8_BAR
#undef PG8_SCHED
}
}


constexpr int NWAVES = 8, NTHREADS = 512;
constexpr int BATCH = 8, SEQ = 4096, T = BATCH * SEQ, DM = 1024;
constexpr int INW = 5448;
constexpr int NPROJ = 5632;
constexpr int LD_HG = 2048, LD_ATT = 768, LD_IDX = 640, LD_GATE = 2048;
constexpr int TOPK = 256;
constexpr int NEXP = 16384;
constexpr float RMS_EPS = 1e-6f;

constexpr size_t MiB = 1u << 20;
constexpr size_t WS_CTL = 0;
constexpr size_t WS_MOD = MiB / 4;
constexpr size_t WS_MODP = MiB / 2;
constexpr size_t WS_WIN = 2 * MiB;
constexpr size_t WS_WQ = 17 * MiB;
constexpr size_t WS_SK = 21 * MiB;
constexpr size_t WS_U = 22 * MiB;
constexpr size_t WS_US = 30 * MiB;
constexpr size_t WS_V = 38 * MiB;
constexpr size_t WS_VS = 46 * MiB;
constexpr size_t WS_K8 = 48 * MiB;
constexpr size_t WS_QHI = 52 * MiB;
constexpr size_t WS_QLO = 68 * MiB;
constexpr size_t WS_WAB8 = 31 * MiB;
constexpr size_t WS_WOUT8 = 32 * MiB;
constexpr size_t WS_WIN8 = 33 * MiB;
constexpr size_t WS_H8 = 48 * MiB;
constexpr size_t WS_H = 86 * MiB;
constexpr size_t WS_HG = 150 * MiB;
constexpr size_t WS_ATT = 278 * MiB;
constexpr size_t WS_IDX = 326 * MiB;
constexpr size_t WS_GATE = 366 * MiB;
constexpr size_t WS_SEL = 494 * MiB;
constexpr size_t WS_END = 510 * MiB;
constexpr size_t WS_MERGED = WS_HG;
constexpr size_t WS_Q = 214 * MiB;
constexpr int H4_NT = 2;
constexpr size_t WS_H4D = 366 * MiB;
constexpr size_t WS_H4S = 416 * MiB;

constexpr int LDS_BYTES = 163840;

typedef unsigned short bf16;
typedef unsigned v4u __attribute__((ext_vector_type(4)));
typedef unsigned v2u __attribute__((ext_vector_type(2)));
typedef float f32x4 __attribute__((ext_vector_type(4)));
typedef float f32x2 __attribute__((ext_vector_type(2)));
typedef short bf16x8 __attribute__((ext_vector_type(8)));
#define LAS __attribute__((address_space(3)))

struct Params {
    const float *x, *c, *w_ada, *b_ada, *norm1_g, *norm2_g, *w_in, *hg_lb, *hg_onorm_g, *q_norm_g, *k_norm_g,
                *w_a, *w_b, *w_out, *peer_wq, *peer_subkeys, *peer_u, *peer_v;
    float* out; unsigned char* ws; int ph_lo, ph_hi;
};

typedef __bf16 bf16x2_hw __attribute__((ext_vector_type(2)));
__device__ __forceinline__ unsigned pk2(float lo, float hi) { const f32x2 v = {lo, hi}; const bf16x2_hw b = __builtin_convertvector(v, bf16x2_hw); return __builtin_bit_cast(unsigned, b); }
__device__ __forceinline__ unsigned f2bf(float f) { return pk2(f, 0.f) & 0xffffu; }
__device__ __forceinline__ float bf2f(unsigned u16v) { return __builtin_bit_cast(float, u16v << 16); }
__device__ __forceinline__ float bflo(unsigned w) { return __builtin_bit_cast(float, w << 16); }
__device__ __forceinline__ float bfhi(unsigned w) { return __builtin_bit_cast(float, w & 0xffff0000u); }
__device__ __forceinline__ float sigmoidf_(float x) { return __builtin_amdgcn_rcpf(1.f + __expf(-x)); }
__device__ __forceinline__ float siluf_(float x) { return x * __builtin_amdgcn_rcpf(1.f + __expf(-x)); }
__device__ __forceinline__ float wave_sum(float v) {
#pragma unroll
    for (int o = 1; o < 64; o <<= 1) v += __shfl_xor(v, o);
    return v;
}
__device__ __forceinline__ float wave_max(float v) {
#pragma unroll
    for (int o = 1; o < 64; o <<= 1) v = fmaxf(v, __shfl_xor(v, o));
    return v;
}
#define LDS_WAIT() asm volatile("s_waitcnt lgkmcnt(0)" ::: "memory")
__device__ __forceinline__ unsigned pk4_fp8(float a, float b, float c, float d) { int w = __builtin_amdgcn_cvt_pk_fp8_f32(a, b, 0, false); w = __builtin_amdgcn_cvt_pk_fp8_f32(c, d, w, true); return (unsigned)w; }

__host__ __device__ __forceinline__ int proj_tile_bf16(int i) { return i < 2 ? i + 2 : i + 6; }
__host__ __device__ __forceinline__ int proj_tile_fp8(int i) { return i < 2 ? i : (i < 6 ? i + 2 : i + 8); }
struct EpiProj {
    static constexpr bool PERM = true, AFTER_DRAIN = false, TWOPASS = false;
    bf16 *HG, *ATT, *IDX, *GATE; int f8;
    __device__ __forceinline__ void operator()(pg8::AccW& acc, const pg8::Unit& u, int wr, int wc, int fr, int fq) const {
        const int pn = f8 ? proj_tile_fp8(u.pn) : proj_tile_bf16(u.pn); bf16* base; int ldc, colt, ncols;
        if (pn < 8) { base = HG; ldc = LD_HG; colt = pn * 256; ncols = LD_HG; }
        else if (pn < 11) { base = ATT; ldc = LD_ATT; colt = (pn - 8) * 256; ncols = LD_ATT; }
        else if (pn < 14) { base = IDX; ldc = LD_IDX; colt = (pn - 11) * 256; ncols = LD_IDX; }
        else { base = GATE; ldc = LD_GATE; colt = (pn - 14) * 256; ncols = LD_GATE; }
        const int row0 = u.pm * 256 + wr * 64 + fr, col0 = colt + wc * 32 + 8 * fq;
#pragma unroll
        for (int ai = 0; ai < 2; ++ai)
#pragma unroll
            for (int m = 0; m < 4; ++m) { bf16* rowp = base + (size_t)(row0 + ai * 128 + m * 16) * ldc + col0;
#pragma unroll
                for (int bj = 0; bj < 2; ++bj) { const pg8::f32x4 v0 = pg8::acc_get(acc, ai, bj, m, 0), v1 = pg8::acc_get(acc, ai, bj, m, 1);
                    v4u w; w.x = pk2(v0[0], v0[1]); w.y = pk2(v0[2], v0[3]); w.z = pk2(v1[0], v1[1]); w.w = pk2(v1[2], v1[3]);
                    if (col0 + bj * 128 < ncols) *(v4u*)(rowp + bj * 128) = w; } }
    }
};
struct EpiMerged {
    static constexpr bool PERM = true, AFTER_DRAIN = false, TWOPASS = true;
    const bf16* GATE; bf16* O;
    __device__ __forceinline__ void operator()(pg8::AccW& acc, const pg8::Unit& u, int wr, int wc, int fr, int fq) const {
        const int row0 = u.pm * 256 + wr * 64 + fr, col0 = u.pn * 256 + wc * 32 + 8 * fq;
        if (u.pass == 0) {
#pragma unroll
            for (int ai = 0; ai < 2; ++ai)
#pragma unroll
                for (int m = 0; m < 4; ++m) { const bf16* rowp = GATE + (size_t)(row0 + ai * 128 + m * 16) * LD_GATE + col0;
#pragma unroll
                    for (int bj = 0; bj < 2; ++bj) { const v4u a = *(const v4u*)(rowp + bj * 128), b = *(const v4u*)(rowp + 1024 + bj * 128);
                        float r[8];
#pragma unroll
                        for (int i = 0; i < 4; ++i) { const float a0 = bflo(a[i]), a1 = bfhi(a[i]), b0 = bflo(b[i]), b1 = bfhi(b[i]);
                            r[2 * i] = (1.f + __expf(-b0)) * __builtin_amdgcn_rcpf(1.f + __expf(-a0)); r[2 * i + 1] = (1.f + __expf(-b1)) * __builtin_amdgcn_rcpf(1.f + __expf(-a1)); }
                        { pg8::f32x4 c0 = pg8::acc_get(acc, ai, bj, m, 0), c1 = pg8::acc_get(acc, ai, bj, m, 1);
#pragma unroll
                          for (int i = 0; i < 4; ++i) { c0[i] *= r[i]; c1[i] *= r[4 + i]; }
                          pg8::acc_set(acc, ai, bj, m, 0, c0); pg8::acc_set(acc, ai, bj, m, 1, c1); } } }
        } else {
#pragma unroll
            for (int ai = 0; ai < 2; ++ai)
#pragma unroll
                for (int m = 0; m < 4; ++m) { const size_t ro = (size_t)(row0 + ai * 128 + m * 16);
#pragma unroll
                    for (int bj = 0; bj < 2; ++bj) { const v4u b = *(const v4u*)(GATE + ro * LD_GATE + 1024 + col0 + bj * 128);
                        const pg8::f32x4 v0 = pg8::acc_get(acc, ai, bj, m, 0), v1 = pg8::acc_get(acc, ai, bj, m, 1);
                        float s[8];
#pragma unroll
                        for (int i = 0; i < 4; ++i) { s[2 * i] = sigmoidf_(bflo(b[i])); s[2 * i + 1] = sigmoidf_(bfhi(b[i])); }
                        v2u w; w.x = pk4_fp8(4.f * v0[0] * s[0], 4.f * v0[1] * s[1], 4.f * v0[2] * s[2], 4.f * v0[3] * s[3]); w.y = pk4_fp8(4.f * v1[0] * s[4], 4.f * v1[1] * s[5], 4.f * v1[2] * s[6], 4.f * v1[3] * s[7]);
                        *(v2u*)((unsigned char*)O + ro * 1024 + col0 + bj * 128) = w; } }
        }
    }
};
struct EpiResid {
    static constexpr bool PERM = true, AFTER_DRAIN = false, TWOPASS = false;
    const float* X; const float* G1  ; float* O;
    __device__ __forceinline__ void operator()(pg8::AccW& acc, const pg8::Unit& u, int wr, int wc, int fr, int fq) const {
        const int row0 = u.pm * 256 + wr * 64 + fr, col0 = u.pn * 256 + wc * 32 + 8 * fq;
        const int b = (u.pm * 256) / SEQ;
        f32x4 g[2][2];
#pragma unroll
        for (int bj = 0; bj < 2; ++bj)
#pragma unroll
            for (int n = 0; n < 2; ++n) g[bj][n] = *(const f32x4*)(G1 + (size_t)b * 6144 + col0 + bj * 128 + 4 * n);
#pragma unroll
        for (int ai = 0; ai < 2; ++ai)
#pragma unroll
            for (int m = 0; m < 4; ++m) { const size_t ro = (size_t)(row0 + ai * 128 + m * 16) * DM + col0;
#pragma unroll
                for (int bj = 0; bj < 2; ++bj)
#pragma unroll
                    for (int n = 0; n < 2; ++n) { const f32x4 xv = *(const f32x4*)(X + ro + bj * 128 + 4 * n);
                        *(f32x4*)(O + ro + bj * 128 + 4 * n) = xv + g[bj][n] * pg8::acc_get(acc, ai, bj, m, n); } }
    }
};
struct EpiStore {
    static constexpr bool PERM = true, AFTER_DRAIN = false, TWOPASS = false;
    bf16* O; int ldc;
    __device__ __forceinline__ void operator()(pg8::AccW& acc, const pg8::Unit& u, int wr, int wc, int fr, int fq) const {
        const int row0 = u.pm * 256 + wr * 64 + fr, col0 = u.pn * 256 + wc * 32 + 8 * fq;
#pragma unroll
        for (int ai = 0; ai < 2; ++ai)
#pragma unroll
            for (int m = 0; m < 4; ++m) { bf16* rowp = O + (size_t)(row0 + ai * 128 + m * 16) * ldc + col0;
#pragma unroll
                for (int bj = 0; bj < 2; ++bj) { const pg8::f32x4 v0 = pg8::acc_get(acc, ai, bj, m, 0), v1 = pg8::acc_get(acc, ai, bj, m, 1);
                    v4u w; w.x = pk2(v0[0], v0[1]); w.y = pk2(v0[2], v0[3]); w.z = pk2(v1[0], v1[1]); w.w = pk2(v1[2], v1[3]);
                    *(v4u*)(rowp + bj * 128) = w; } }
    }
};

template <int MODE> __device__ __forceinline__ int srcmap(int np) {
    if (MODE == 2) np = proj_tile_bf16(np >> 8) * 256 + (np & 255);
    if (MODE == 3) np = proj_tile_fp8(np >> 8) * 256 + (np & 255);
    if (MODE >= 1) return np < 3400 ? np : (np >= 3584 ? np - 184 : -1);
    return np; }
template <int MODE>
__device__ __forceinline__ void transpose_item(const float* W, int N, bf16* WT, int ldw, int koff, float* scr, int kb, int nb, int lane) {
    const int k0 = 64 * kb, n0 = 32 * nb;
    const int sc = srcmap<MODE>(n0 + (lane & 31));
#pragma unroll 8
    for (int i = 0; i < 32; ++i) { const int kk = 2 * i + (lane >> 5); scr[kk * 33 + (lane & 31)] = (sc >= 0) ? W[(size_t)(k0 + kk) * N + sc] : 0.f; }
    LDS_WAIT(); __builtin_amdgcn_wave_barrier();
    const int c = lane & 7;
#pragma unroll
    for (int j = 0; j < 4; ++j) { const int n = (lane >> 3) + 8 * j; const float* s = scr + (8 * c) * 33 + n;
        v4u o; o.x = pk2(s[0 * 33], s[1 * 33]); o.y = pk2(s[2 * 33], s[3 * 33]); o.z = pk2(s[4 * 33], s[5 * 33]); o.w = pk2(s[6 * 33], s[7 * 33]);
        *(v4u*)(WT + (size_t)(n0 + n) * ldw + koff + k0 + 8 * c) = o; }
    LDS_WAIT(); __builtin_amdgcn_wave_barrier();
}
template <int MODE> __device__ __forceinline__ int srcmap(int np);
template <int MODE = 0>
__device__ __forceinline__ void transpose_item8(const float* W, int N, unsigned char* WT, int ldw, int koff, float scale, float* scr, int kb, int nb, int lane) {
    const int k0 = 64 * kb, n0 = 32 * nb;
    const int sc = srcmap<MODE>(n0 + (lane & 31));
#pragma unroll 8
    for (int i = 0; i < 32; ++i) { const int kk = 2 * i + (lane >> 5); scr[kk * 33 + (lane & 31)] = (sc >= 0) ? W[(size_t)(k0 + kk) * N + sc] * scale : 0.f; }
    LDS_WAIT(); __builtin_amdgcn_wave_barrier();
    const int c = lane & 3;
#pragma unroll
    for (int j = 0; j < 2; ++j) { const int n = (lane >> 2) + 16 * j; const float* sp = scr + (16 * c) * 33 + n;
        v4u o;
#pragma unroll
        for (int q = 0; q < 4; ++q) o[q] = pk4_fp8(sp[(4 * q) * 33], sp[(4 * q + 1) * 33], sp[(4 * q + 2) * 33], sp[(4 * q + 3) * 33]);
        *(v4u*)(WT + (size_t)(n0 + n) * ldw + koff + k0 + 16 * c) = o; }
    LDS_WAIT(); __builtin_amdgcn_wave_barrier();
}
__device__ __forceinline__ void convert_plain(const float* src, bf16* dst, size_t n, size_t gtid, size_t nth) {
    const size_t n8 = n / 8;
    for (size_t i = gtid; i < n8; i += nth) { const f32x4 a = ((const f32x4*)src)[2 * i], b = ((const f32x4*)src)[2 * i + 1];
        v4u o; o.x = pk2(a[0], a[1]); o.y = pk2(a[2], a[3]); o.z = pk2(b[0], b[1]); o.w = pk2(b[2], b[3]); ((v4u*)dst)[i] = o; }
}
__device__ __forceinline__ void convert_fp8(const float* src, unsigned char* dst, size_t n, float scale, size_t gtid, size_t nth) {
    const size_t n16 = n / 16;
    for (size_t i = gtid; i < n16; i += nth) { const f32x4* sp = (const f32x4*)src + 4 * i; const f32x4 a = sp[0] * scale, b = sp[1] * scale, c = sp[2] * scale, d = sp[3] * scale;
        v4u o; o.x = pk4_fp8(a[0], a[1], a[2], a[3]); o.y = pk4_fp8(b[0], b[1], b[2], b[3]); o.z = pk4_fp8(c[0], c[1], c[2], c[3]); o.w = pk4_fp8(d[0], d[1], d[2], d[3]); ((v4u*)dst)[i] = o; }
}
template <bool KKMAJOR>
__device__ __forceinline__ void convert_mxfp4(const float* src, unsigned char* dst, unsigned char* scl, size_t nrows, size_t gtid, size_t nth) {
    const size_t nblk = nrows * 32;
    for (size_t i = gtid; i < nblk; i += nth) {
        const size_t row = i >> 5; const int blk = (int)(i & 31);
        const f32x4* sp = (const f32x4*)(src + row * 1024 + blk * 32);
        f32x4 v[8]; float amax = 0.f;
#pragma unroll
        for (int j = 0; j < 8; ++j) { v[j] = sp[j]; amax = fmaxf(fmaxf(fmaxf(fabsf(v[j][0]), fabsf(v[j][1])), fmaxf(fabsf(v[j][2]), fabsf(v[j][3]))), amax); }
        int e = (int)((__builtin_bit_cast(unsigned, amax) >> 23) & 0xffu) - 127 - 2;
        if (e < -126) e = -126;
        const float inv = __builtin_bit_cast(float, (unsigned)(127 - e) << 23);
        unsigned w[4] = {0u, 0u, 0u, 0u};
#pragma unroll
        for (int j = 0; j < 8; j += 2) { unsigned t = 0u;
            t = __builtin_amdgcn_cvt_scalef32_pk_fp4_f32(t, v[j][0] * inv, v[j][1] * inv, 1.0f, 0);
            t = __builtin_amdgcn_cvt_scalef32_pk_fp4_f32(t, v[j][2] * inv, v[j][3] * inv, 1.0f, 1);
            t = __builtin_amdgcn_cvt_scalef32_pk_fp4_f32(t, v[j + 1][0] * inv, v[j + 1][1] * inv, 1.0f, 2);
            t = __builtin_amdgcn_cvt_scalef32_pk_fp4_f32(t, v[j + 1][2] * inv, v[j + 1][3] * inv, 1.0f, 3);
            w[j >> 1] = t; }
        *(v4u*)(dst + row * 512 + blk * 16) = (v4u){w[0], w[1], w[2], w[3]};
        scl[row * 32 + (KKMAJOR ? ((blk & 3) * 8 + (blk >> 2)) : blk)] = (unsigned char)(e + 127);
    }
}
__device__ __forceinline__ void phase0(const Params& p, unsigned char* lds) {
    const int tid = threadIdx.x, wave = tid >> 6, lane = tid & 63, G = gridDim.x;
    const int gw = blockIdx.x * NWAVES + wave, NGW = G * NWAVES;
    float* scr = (float*)(lds + wave * 16384);
    unsigned char* ws = p.ws;
    constexpr int I_IN = 16 * (2048 / 32), I_IN8 = 16 * (3584 / 32), I_A = 8 * 32, I_O = 16 * 32, I_Q = 16 * 64;
    constexpr int NT = I_IN + I_IN8 + 2 * I_A + I_O + I_Q;
    for (int it = gw; it < NT; it += NGW) {
        int r = it;
        if (r < I_IN) { transpose_item<2>(p.w_in, INW, (bf16*)(ws + WS_WIN), 1024, 0, scr, r / 64, r % 64, lane); continue; } r -= I_IN;
        if (r < I_IN8) { transpose_item8<3>(p.w_in, INW, ws + WS_WIN8, 1024, 0, 32.f, scr, r / 112, r % 112, lane); continue; } r -= I_IN8;
        if (r < I_A) { transpose_item8(p.w_a, 1024, ws + WS_WAB8, 1024, 0, 32.f, scr, r / 32, r % 32, lane); continue; } r -= I_A;
        if (r < I_A) { transpose_item8(p.w_b, 1024, ws + WS_WAB8, 1024, 512, 4.f, scr, r / 32, r % 32, lane); continue; } r -= I_A;
        if (r < I_O) { transpose_item8(p.w_out, 1024, ws + WS_WOUT8, 1024, 0, 32.f, scr, r / 32, r % 32, lane); continue; } r -= I_O;
        transpose_item<0>(p.peer_wq, 2048, (bf16*)(ws + WS_WQ), 1024, 0, scr, r / 64, r % 64, lane);
    }
    for (int it = gw; it < 96 * 8; it += NGW) {
        const int cgp = it % 96, ks = it / 96, col = cgp * 64 + lane, k0 = ks * 128;
#pragma unroll
        for (int i = 0; i < 16; ++i) { const int e = i * 64 + lane, b = e >> 7, k = e & 127; scr[e] = siluf_(p.c[b * 1024 + k0 + k]); }
        LDS_WAIT(); __builtin_amdgcn_wave_barrier();
        float acc[8];
#pragma unroll
        for (int b = 0; b < 8; ++b) acc[b] = 0.f;
#pragma unroll 4
        for (int k = 0; k < 128; ++k) { const float w = p.w_ada[(size_t)(k0 + k) * 6144 + col];
#pragma unroll
            for (int b = 0; b < 8; ++b) acc[b] += scr[b * 128 + k] * w; }
        float* mp = (float*)(ws + WS_MODP) + (size_t)ks * 8 * 6144 + col;
#pragma unroll
        for (int b = 0; b < 8; ++b) mp[b * 6144] = acc[b];
        LDS_WAIT(); __builtin_amdgcn_wave_barrier();
    }
    const size_t gtid = (size_t)blockIdx.x * NTHREADS + tid, nth = (size_t)G * NTHREADS;
    convert_plain(p.peer_subkeys, (bf16*)(ws + WS_SK), (size_t)16 * 128 * 128, gtid, nth);
    convert_mxfp4<true>(p.peer_u, ws + WS_U, ws + WS_US, (size_t)NEXP, gtid, nth);
    convert_mxfp4<false>(p.peer_v, ws + WS_V, ws + WS_VS, (size_t)NEXP, gtid, nth);
}

template <bool FIRST>
__device__ __forceinline__ void normmod_phase(const Params& p, unsigned char* lds, const float* src, bf16* dst, const float* gvec, int shift_off, int scale_off) {
    const int tid = threadIdx.x, wave = tid >> 6, lane = tid & 63, G = gridDim.x;
    unsigned char* ws = p.ws;
    float* A = (float*)lds;
    float* Bv = A + 1024;
    const float* MODP = (const float*)(ws + WS_MODP);
    float* MOD = (float*)(ws + WS_MOD);
    if (FIRST) {
        for (int e = blockIdx.x * NTHREADS + tid; e < 8 * 6144; e += G * NTHREADS) { const int col = e % 6144; float s = p.b_ada[col];
#pragma unroll
            for (int ks = 0; ks < 8; ++ks) s += MODP[(size_t)ks * 8 * 6144 + e];
            MOD[e] = s; }
    }
    int curb = -1;
    for (int chunk = blockIdx.x; chunk < T / 128; chunk += G) {
        const int b = (chunk * 128) / SEQ;
        if (b != curb) {
            __syncthreads();
            for (int col = tid; col < 1024; col += NTHREADS) {
                float sc, sh;
                if (FIRST) { sc = p.b_ada[scale_off + col]; sh = p.b_ada[shift_off + col];
#pragma unroll
                    for (int ks = 0; ks < 8; ++ks) { sc += MODP[(size_t)(ks * 8 + b) * 6144 + scale_off + col]; sh += MODP[(size_t)(ks * 8 + b) * 6144 + shift_off + col]; } }
                else { sc = MOD[b * 6144 + scale_off + col]; sh = MOD[b * 6144 + shift_off + col]; }
                A[col] = gvec[col] * (1.f + sc); Bv[col] = sh; }
            __syncthreads(); curb = b;
        }
        for (int r = wave; r < 128; r += NWAVES) {
            const size_t row = (size_t)chunk * 128 + r;
            const f32x4* xr = (const f32x4*)(src + row * DM) + lane;
            f32x4 v[4]; float s = 0.f;
#pragma unroll
            for (int j = 0; j < 4; ++j) { v[j] = xr[64 * j]; s += (v[j][0] * v[j][0] + v[j][1] * v[j][1]) + (v[j][2] * v[j][2] + v[j][3] * v[j][3]); }
            const float rstd = rsqrtf(wave_sum(s) * (1.f / DM) + RMS_EPS);
            v2u* o8 = (v2u*)(dst + row * DM) + lane;
#pragma unroll
            for (int j = 0; j < 4; ++j) { const int c0 = 4 * lane + 256 * j; const f32x4 a = *(const f32x4*)(A + c0), sh = *(const f32x4*)(Bv + c0);
                v2u o; o.x = pk2(v[j][0] * rstd * a[0] + sh[0], v[j][1] * rstd * a[1] + sh[1]); o.y = pk2(v[j][2] * rstd * a[2] + sh[2], v[j][3] * rstd * a[3] + sh[3]);
                o8[64 * j] = o;
                if (FIRST) *(unsigned*)(ws + WS_H8 + row * DM + c0) = pk4_fp8(v[j][0] * rstd * a[0] + sh[0], v[j][1] * rstd * a[1] + sh[1], v[j][2] * rstd * a[2] + sh[2], v[j][3] * rstd * a[3] + sh[3]);
                if (!FIRST) { float* st = (float*)(lds + 8192) + wave * 1056;
                    const float y0 = v[j][0] * rstd * a[0] + sh[0], y1 = v[j][1] * rstd * a[1] + sh[1], y2 = v[j][2] * rstd * a[2] + sh[2], y3 = v[j][3] * rstd * a[3] + sh[3];
                    const int pc = c0 + (c0 >> 5); st[pc] = y0; st[pc + 1] = y1; st[pc + 2] = y2; st[pc + 3] = y3; } }
            if (!FIRST) {
                const float* st = (const float*)(lds + 8192) + wave * 1056;
                LDS_WAIT(); __builtin_amdgcn_wave_barrier();
                if (lane < 32) {
                    float x[32];
#pragma unroll
                    for (int k = 0; k < 32; ++k) x[k] = st[lane * 33 + k];
#pragma unroll
                    for (int t = 0; t < H4_NT; ++t) {
                        float amax = 0.f;
#pragma unroll
                        for (int k = 0; k < 32; ++k) amax = fmaxf(amax, fabsf(x[k]));
                        int e = (int)((__builtin_bit_cast(unsigned, amax) >> 23) & 0xffu) - 127 - 2; if (e < -126) e = -126;
                        const float inv = __builtin_bit_cast(float, (unsigned)(127 - e) << 23), sc = __builtin_bit_cast(float, (unsigned)(127 + e) << 23);
                        unsigned w[4];
#pragma unroll
                        for (int r = 0; r < 4; ++r) { unsigned tw = 0u;
                            tw = __builtin_amdgcn_cvt_scalef32_pk_fp4_f32(tw, x[8 * r] * inv, x[8 * r + 1] * inv, 1.0f, 0);
                            tw = __builtin_amdgcn_cvt_scalef32_pk_fp4_f32(tw, x[8 * r + 2] * inv, x[8 * r + 3] * inv, 1.0f, 1);
                            tw = __builtin_amdgcn_cvt_scalef32_pk_fp4_f32(tw, x[8 * r + 4] * inv, x[8 * r + 5] * inv, 1.0f, 2);
                            tw = __builtin_amdgcn_cvt_scalef32_pk_fp4_f32(tw, x[8 * r + 6] * inv, x[8 * r + 7] * inv, 1.0f, 3);
                            w[r] = tw;
                            const f32x2 d0 = __builtin_amdgcn_cvt_scalef32_pk_f32_fp4(tw, 1.0f, 0), d1 = __builtin_amdgcn_cvt_scalef32_pk_f32_fp4(tw, 1.0f, 1), d2 = __builtin_amdgcn_cvt_scalef32_pk_f32_fp4(tw, 1.0f, 2), d3 = __builtin_amdgcn_cvt_scalef32_pk_f32_fp4(tw, 1.0f, 3);
                            x[8 * r] -= d0[0] * sc; x[8 * r + 1] -= d0[1] * sc; x[8 * r + 2] -= d1[0] * sc; x[8 * r + 3] -= d1[1] * sc;
                            x[8 * r + 4] -= d2[0] * sc; x[8 * r + 5] -= d2[1] * sc; x[8 * r + 6] -= d3[0] * sc; x[8 * r + 7] -= d3[1] * sc; }
                        *(v4u*)(ws + WS_H4D + (row * H4_NT + t) * 512 + lane * 16) = (v4u){w[0], w[1], w[2], w[3]};
                        *(ws + WS_H4S + (row * H4_NT + t) * 32 + (lane & 3) * 8 + (lane >> 2)) = (unsigned char)(e + 127);
                    }
                }
                LDS_WAIT(); __builtin_amdgcn_wave_barrier();
            }
        }
    }
    __syncthreads();
}

constexpr int HGL_QT = 0, HGL_KT = 17408, HGL_QE = 34816, HGL_KLT = 52224, HGL_VT = 70656, HGL_AM = 89088, HGL_DEC = 98304, HGL_TOT = 98816, HGL_SSQ = 100864;
constexpr int HG_LDR = 136;
constexpr int HG_LDC = 72;
__device__ __forceinline__ void hgrn_item(const Params& p, unsigned char* lds, int item) {
    const int b = item >> 2, h = item & 3;
    const int tid = threadIdx.x, w = tid >> 6, lane = tid & 63, fr = lane & 15, fq = lane >> 4;
    unsigned char* ws = p.ws;
    const bf16* HG = (const bf16*)(ws + WS_HG);
    bf16* YA = (bf16*)(ws + WS_H);
    bf16* QT = (bf16*)(lds + HGL_QT); bf16* KT = (bf16*)(lds + HGL_KT); bf16* QE = (bf16*)(lds + HGL_QE);
    bf16* KLT = (bf16*)(lds + HGL_KLT); bf16* VT = (bf16*)(lds + HGL_VT); bf16* AM = (bf16*)(lds + HGL_AM);
    float* DEC = (float*)(lds + HGL_DEC); float* TOT = (float*)(lds + HGL_TOT); float* SSQ = (float*)(lds + HGL_SSQ);
    const int pd = tid & 127, pq = tid >> 7;
    float lbv; { const float a0 = p.hg_lb[h * 128 + pd], a1 = p.hg_lb[512 + h * 128 + pd]; lbv = 1.f / (1.f + __expf(a1 - a0)); }
    const int e0 = w * 16;
    const float ogv = p.hg_onorm_g[e0 + fr];
    pg8::f32x4 S[8];
#pragma unroll
    for (int i = 0; i < 8; ++i) S[i] = (pg8::f32x4){0.f, 0.f, 0.f, 0.f};
    const size_t rowb = (size_t)b * SEQ;
    unsigned short rq[16], rf[16], rv[16];
    { const bf16* gp = HG + (rowb + pq * 16) * LD_HG + h * 128 + pd;
#pragma unroll
      for (int i = 0; i < 16; ++i) { rq[i] = gp[(size_t)i * LD_HG]; rf[i] = gp[(size_t)i * LD_HG + 512]; rv[i] = gp[(size_t)i * LD_HG + 1024]; } }
    for (int chunk = 0; chunk < SEQ / 64; ++chunk) {
        const size_t row0 = rowb + (size_t)chunk * 64;
        float fq_[16], kq_[16], cs[16];
        float run = 0.f;
#pragma unroll
        for (int i = 0; i < 16; ++i) { const float f = lbv + (1.f - lbv) * sigmoidf_(bf2f(rf[i])); kq_[i] = 1.f - f; run += __logf(f); cs[i] = run; fq_[i] = siluf_(bf2f(rq[i])); }
        TOT[pq * 128 + pd] = run;
        { v4u v0, v1;
          v0.x = rv[0] | ((unsigned)rv[1] << 16); v0.y = rv[2] | ((unsigned)rv[3] << 16); v0.z = rv[4] | ((unsigned)rv[5] << 16); v0.w = rv[6] | ((unsigned)rv[7] << 16);
          v1.x = rv[8] | ((unsigned)rv[9] << 16); v1.y = rv[10] | ((unsigned)rv[11] << 16); v1.z = rv[12] | ((unsigned)rv[13] << 16); v1.w = rv[14] | ((unsigned)rv[15] << 16);
          *(v4u*)(VT + pd * HG_LDC + pq * 16) = v0; *(v4u*)(VT + pd * HG_LDC + pq * 16 + 8) = v1; }
        unsigned short rg[16];
#pragma unroll
        for (int i = 0; i < 16; ++i) rg[i] = HG[(row0 + (i >> 2) * 16 + fq * 4 + (i & 3)) * LD_HG + 1536 + h * 128 + e0 + fr];
        if (chunk + 1 < SEQ / 64) { const bf16* gp = HG + (row0 + 64 + pq * 16) * LD_HG + h * 128 + pd;
#pragma unroll
            for (int i = 0; i < 16; ++i) { rq[i] = gp[(size_t)i * LD_HG]; rf[i] = gp[(size_t)i * LD_HG + 512]; rv[i] = gp[(size_t)i * LD_HG + 1024]; } }
        __syncthreads();
        const float t0 = TOT[pd], t1 = TOT[128 + pd], t2 = TOT[256 + pd], t3 = TOT[384 + pd];
        const float base = (pq > 0 ? t0 : 0.f) + (pq > 1 ? t1 : 0.f) + (pq > 2 ? t2 : 0.f);
        const float bmid = t0 + t1, blast = (t0 + t1) + (t2 + t3);
        const float emid = __expf(bmid), elm = __expf(blast - bmid);
        if (pq == 0) DEC[pd] = __expf(blast);
        { unsigned klp[8];
#pragma unroll
          for (int i = 0; i < 16; ++i) { const float bb = base + cs[i]; const float E1 = __expf(bb - bmid), R1 = __builtin_amdgcn_rcpf(E1);
              const float qtv = fq_[i] * E1, ktv = kq_[i] * R1, qev = qtv * emid, klv = ktv * elm;
              const int srow = pq * 16 + i;
              QT[srow * HG_LDR + pd] = (bf16)f2bf(qtv); KT[srow * HG_LDR + pd] = (bf16)f2bf(ktv); QE[srow * HG_LDR + pd] = (bf16)f2bf(qev);
              if (i & 1) klp[i >> 1] |= f2bf(klv) << 16; else klp[i >> 1] = f2bf(klv); }
          *(v4u*)(KLT + pd * HG_LDC + pq * 16) = (v4u){klp[0], klp[1], klp[2], klp[3]}; *(v4u*)(KLT + pd * HG_LDC + pq * 16 + 8) = (v4u){klp[4], klp[5], klp[6], klp[7]}; }
        __syncthreads();
#pragma unroll
        for (int tt = 0; tt < 2; ++tt) { const int id = w + 8 * tt, rt = id >> 2, ct = id & 3;
            pg8::f32x4 a = {0.f, 0.f, 0.f, 0.f};
            if (ct <= rt) {
#pragma unroll
                for (int ks = 0; ks < 4; ++ks) { const bf16x8 af = *(const bf16x8*)(QT + (rt * 16 + fr) * HG_LDR + ks * 32 + fq * 8), bfv = *(const bf16x8*)(KT + (ct * 16 + fr) * HG_LDR + ks * 32 + fq * 8);
                    a = __builtin_amdgcn_mfma_f32_16x16x32_bf16(af, bfv, a, 0, 0, 0); } }
#pragma unroll
            for (int r = 0; r < 4; ++r) { const int c = rt * 16 + fq * 4 + r, sidx = ct * 16 + fr; AM[c * HG_LDC + sidx] = (bf16)((sidx <= c) ? f2bf(a[r]) : 0u); } }
        __syncthreads();
        const bf16x8 vb0 = *(const bf16x8*)(VT + (e0 + fr) * HG_LDC + fq * 8), vb1 = *(const bf16x8*)(VT + (e0 + fr) * HG_LDC + 32 + fq * 8);
        bf16x8 sb[4];
#pragma unroll
        for (int ks = 0; ks < 4; ++ks) { v4u t; t.x = pk2(S[2 * ks][0], S[2 * ks][1]); t.y = pk2(S[2 * ks][2], S[2 * ks][3]); t.z = pk2(S[2 * ks + 1][0], S[2 * ks + 1][1]); t.w = pk2(S[2 * ks + 1][2], S[2 * ks + 1][3]); sb[ks] = __builtin_bit_cast(bf16x8, t); }
        pg8::f32x4 o[4];
#pragma unroll
        for (int rt = 0; rt < 4; ++rt) { pg8::f32x4 a = {0.f, 0.f, 0.f, 0.f};
            a = __builtin_amdgcn_mfma_f32_16x16x32_bf16(*(const bf16x8*)(AM + (rt * 16 + fr) * HG_LDC + fq * 8), vb0, a, 0, 0, 0);
            a = __builtin_amdgcn_mfma_f32_16x16x32_bf16(*(const bf16x8*)(AM + (rt * 16 + fr) * HG_LDC + 32 + fq * 8), vb1, a, 0, 0, 0);
#pragma unroll
            for (int ks = 0; ks < 4; ++ks) { const v2u lo = *(const v2u*)(QE + (rt * 16 + fr) * HG_LDR + ks * 32 + fq * 4), hi = *(const v2u*)(QE + (rt * 16 + fr) * HG_LDR + ks * 32 + 16 + fq * 4);
                const v4u t = {lo.x, lo.y, hi.x, hi.y};
                a = __builtin_amdgcn_mfma_f32_16x16x32_bf16(__builtin_bit_cast(bf16x8, t), sb[ks], a, 0, 0, 0); }
            o[rt] = a; }
#pragma unroll
        for (int dt = 0; dt < 8; ++dt) { const f32x4 dc = *(const f32x4*)(DEC + dt * 16 + fq * 4);
            pg8::f32x4 a = S[dt]; a[0] *= dc[0]; a[1] *= dc[1]; a[2] *= dc[2]; a[3] *= dc[3];
            a = __builtin_amdgcn_mfma_f32_16x16x32_bf16(*(const bf16x8*)(KLT + (dt * 16 + fr) * HG_LDC + fq * 8), vb0, a, 0, 0, 0);
            a = __builtin_amdgcn_mfma_f32_16x16x32_bf16(*(const bf16x8*)(KLT + (dt * 16 + fr) * HG_LDC + 32 + fq * 8), vb1, a, 0, 0, 0);
            S[dt] = a; }
#pragma unroll
        for (int rt = 0; rt < 4; ++rt)
#pragma unroll
            for (int r = 0; r < 4; ++r) { float x = o[rt][r] * o[rt][r];
                x += __shfl_xor(x, 1); x += __shfl_xor(x, 2); x += __shfl_xor(x, 4); x += __shfl_xor(x, 8);
                if (fr == 0) SSQ[w * 64 + rt * 16 + fq * 4 + r] = x; }
        __syncthreads();
        float tot = 0.f;
#pragma unroll
        for (int ww = 0; ww < 8; ++ww) tot += SSQ[ww * 64 + lane];
        const float rstd_l = rsqrtf(tot * (1.f / 128.f) + RMS_EPS);
#pragma unroll
        for (int rt = 0; rt < 4; ++rt)
#pragma unroll
            for (int r = 0; r < 4; ++r) { const int c = rt * 16 + fq * 4 + r; const float rs = __shfl(rstd_l, c);
                const float y = o[rt][r] * rs * ogv * siluf_(bf2f(rg[rt * 4 + r]));
                ((unsigned char*)YA)[(row0 + c) * 1024 + h * 128 + e0 + fr] = (unsigned char)(__builtin_amdgcn_cvt_pk_fp8_f32(y, 0.f, 0, false) & 0xff); }
    }
    __syncthreads();
}

__device__ __forceinline__ unsigned f16key(float x) {
    x = x + 0.f;
    const _Float16 hx = (_Float16)x; const unsigned short bits = __builtin_bit_cast(unsigned short, hx);
    return (bits & 0x8000u) ? (unsigned)(unsigned short)(~bits) : (unsigned)(bits | 0x8000u);
}
__device__ __forceinline__ void find_bin(const unsigned* hist, int K, int lane, int& bin, int& rem) {
    const v4u hv = *(const v4u*)(hist + 4 * lane);
    const unsigned c = hv.x + hv.y + hv.z + hv.w;
    unsigned suf = c;
#pragma unroll
    for (int o = 1; o < 64; o <<= 1) { const unsigned t = __shfl_down(suf, o); if (lane + o < 64) suf += t; }
    const unsigned above = suf - c;
    const bool mine = (above < (unsigned)K) && ((unsigned)K <= suf);
    int mybin = 0, myrem = 0;
    if (mine) { unsigned ca = above; const unsigned hh[4] = {hv.x, hv.y, hv.z, hv.w}; bool found = false;
#pragma unroll
        for (int i = 3; i >= 0; --i) { if (!found) { if (ca + hh[i] >= (unsigned)K) { mybin = 4 * lane + i; myrem = K - (int)ca; found = true; } else ca += hh[i]; } } }
    const unsigned long long m = __ballot(mine);
    const int src = (int)__builtin_ctzll(m | (1ull << 63));
    bin = __shfl(mybin, src); rem = __shfl(myrem, src);
}
__device__ __forceinline__ void dsa1_item(const Params& p, unsigned char* lds, int item) {
    const int b = item >> 8, q0 = (item & 255) * 16;
    const int tid = threadIdx.x, w = tid >> 6, lane = tid & 63, fr = lane & 15, fq = lane >> 4;
    unsigned char* ws = p.ws;
    const bf16* IDX = (const bf16*)(ws + WS_IDX);
    unsigned short* SEL = (unsigned short*)(ws + WS_SEL);
    unsigned short* Ik = (unsigned short*)lds;
    unsigned* hist1 = (unsigned*)(lds + 131072);
    unsigned* hist = (unsigned*)(lds + 131072 + 16384) + w * 256;
    const size_t rowb = (size_t)b * SEQ;
    *(v4u*)(hist1 + tid * 4) = (v4u){0u, 0u, 0u, 0u}; *(v4u*)(hist1 + 2048 + tid * 4) = (v4u){0u, 0u, 0u, 0u};
    bf16x8 Af[8][2];
    { const bf16* rp = IDX + (rowb + q0 + fr) * LD_IDX + fq * 8;
#pragma unroll
      for (int h = 0; h < 8; ++h) { Af[h][0] = *(const bf16x8*)(rp + h * 64); Af[h][1] = *(const bf16x8*)(rp + h * 64 + 32); } }
    const float idx_scale = 0.5f * 0.125f * 0.35355339059327373f;
    bf16x8 Aw[2];
    { float wa[8];
      { const v4u wq = *(const v4u*)(IDX + (rowb + q0 + fr) * LD_IDX + 576);
#pragma unroll
        for (int i = 0; i < 4; ++i) { wa[2 * i] = bflo(wq[i]) * idx_scale; wa[2 * i + 1] = bfhi(wq[i]) * idx_scale; } }
#pragma unroll
      for (int ks = 0; ks < 2; ++ks) { float cq[8];
#pragma unroll
          for (int j = 0; j < 8; ++j) cq[j] = 0.f;
#pragma unroll
          for (int h = 0; h < 8; ++h)
#pragma unroll
              for (int j = 0; j < 8; ++j) cq[j] += wa[h] * bf2f((unsigned)(unsigned short)Af[h][ks][j]);
          const v4u t = {pk2(cq[0], cq[1]), pk2(cq[2], cq[3]), pk2(cq[4], cq[5]), pk2(cq[6], cq[7])};
          Aw[ks] = __builtin_bit_cast(bf16x8, t); } }
    float wv[4][8];
#pragma unroll
    for (int r = 0; r < 4; ++r) { const v4u wq = *(const v4u*)(IDX + (rowb + q0 + fq * 4 + r) * LD_IDX + 576);
#pragma unroll
        for (int i = 0; i < 4; ++i) { wv[r][2 * i] = bflo(wq[i]) * idx_scale; wv[r][2 * i + 1] = bfhi(wq[i]) * idx_scale; } }
    const int ntiles = (q0 >> 4) + 1;
    __syncthreads();
    bf16x8 B0 = Aw[0], B1 = Aw[1];
    if (w < ntiles) { const bf16* kp = IDX + (rowb + w * 16 + fr) * LD_IDX + 512 + fq * 8; B0 = *(const bf16x8*)kp; B1 = *(const bf16x8*)(kp + 32); }
    for (int kt = w; kt < ntiles; kt += NWAVES) {
        bf16x8 nB0 = B0, nB1 = B1;
        if (kt + NWAVES < ntiles) { const bf16* kp = IDX + (rowb + (kt + NWAVES) * 16 + fr) * LD_IDX + 512 + fq * 8; nB0 = *(const bf16x8*)kp; nB1 = *(const bf16x8*)(kp + 32); }
        pg8::f32x4 lin = {0.f, 0.f, 0.f, 0.f};
        lin = __builtin_amdgcn_mfma_f32_16x16x32_bf16(Aw[0], B0, lin, 0, 0, 0);
        lin = __builtin_amdgcn_mfma_f32_16x16x32_bf16(Aw[1], B1, lin, 0, 0, 0);
        float I[4] = {lin[0], lin[1], lin[2], lin[3]};
#pragma unroll
        for (int h = 0; h < 8; ++h) { pg8::f32x4 a = {0.f, 0.f, 0.f, 0.f};
            a = __builtin_amdgcn_mfma_f32_16x16x32_bf16(Af[h][0], B0, a, 0, 0, 0);
            a = __builtin_amdgcn_mfma_f32_16x16x32_bf16(Af[h][1], B1, a, 0, 0, 0);
#pragma unroll
            for (int r = 0; r < 4; ++r) I[r] = __builtin_fmaf(wv[r][h], __builtin_fabsf(a[r]), I[r]); }
        const int kidx = kt * 16 + fr;
#pragma unroll
        for (int r = 0; r < 4; ++r) { const unsigned key = f16key(I[r]); Ik[(fq * 4 + r) * 4096 + kidx] = (unsigned short)key;
            if (kidx <= q0 + fq * 4 + r) atomicAdd(&hist1[(fq * 4 + r) * 256 + (key >> 8)], 1u); }
        B0 = nB0; B1 = nB1;
    }
    __syncthreads();
    for (int qq = w; qq < 16; qq += NWAVES) {
        const int t = q0 + qq, n = t + 1;
        unsigned short* so = SEL + (rowb + t) * TOPK;
        const unsigned short* keys = Ik + qq * 4096;
        if (n <= TOPK) { for (int j = lane; j < n; j += 64) so[j] = (unsigned short)j; }
        else {
            int b1, rem1, b2, rem2;
            find_bin(hist1 + qq * 256, TOPK, lane, b1, rem1);
            *(v4u*)(hist + 4 * lane) = (v4u){0u, 0u, 0u, 0u};
            LDS_WAIT(); __builtin_amdgcn_wave_barrier();
            for (int j = lane; j < n; j += 64) { const unsigned k = keys[j]; if ((int)(k >> 8) == b1) atomicAdd(&hist[k & 255u], 1u); }
            LDS_WAIT(); __builtin_amdgcn_wave_barrier();
            find_bin(hist, rem1, lane, b2, rem2);
            const unsigned thr = ((unsigned)b1 << 8) | (unsigned)b2;
            int base = 0, eqtaken = 0;
            const unsigned long long lt = (lane == 0) ? 0ull : (~0ull >> (64 - lane));
            for (int j0 = 0; j0 < n; j0 += 64) {
                const int j = j0 + lane; const bool valid = j < n; const unsigned k = valid ? (unsigned)keys[j] : 0u;
                const bool gt = valid && k > thr, eq = valid && k == thr;
                const unsigned long long meq = __ballot(eq);
                const int erank = __popcll(meq & lt) + eqtaken;
                const bool take = gt || (eq && erank < rem2);
                const unsigned long long mt = __ballot(take);
                if (take) so[base + __popcll(mt & lt)] = (unsigned short)j;
                base += __popcll(mt); eqtaken += __popcll(meq);
            }
        }
    }
    __syncthreads();
}

__device__ __forceinline__ void qknorm_token(const Params& p, int tok, int lane) {
    const bf16* row = (const bf16*)(p.ws + WS_ATT) + (size_t)tok * LD_ATT;
    const int c8 = (lane & 7) * 8;
    { const v4u qv = *(const v4u*)(row + lane * 8);
      float x[8]; float ss = 0.f;
#pragma unroll
      for (int i = 0; i < 4; ++i) { x[2 * i] = bflo(qv[i]); x[2 * i + 1] = bfhi(qv[i]); ss += x[2 * i] * x[2 * i] + x[2 * i + 1] * x[2 * i + 1]; }
      ss += __shfl_xor(ss, 1); ss += __shfl_xor(ss, 2); ss += __shfl_xor(ss, 4);
      const float rs = rsqrtf(ss * (1.f / 64.f) + RMS_EPS) * (0.125f * 1.4426950408889634f);
#pragma unroll
      for (int i = 0; i < 8; ++i) x[i] = x[i] * rs * p.q_norm_g[c8 + i];
      v2u hw, lw;
      hw.x = pk4_fp8(x[0], x[1], x[2], x[3]); hw.y = pk4_fp8(x[4], x[5], x[6], x[7]);
      { const f32x2 d0 = __builtin_amdgcn_cvt_pk_f32_fp8((int)hw.x, false), d1 = __builtin_amdgcn_cvt_pk_f32_fp8((int)hw.x, true), d2 = __builtin_amdgcn_cvt_pk_f32_fp8((int)hw.y, false), d3 = __builtin_amdgcn_cvt_pk_f32_fp8((int)hw.y, true);
        lw.x = pk4_fp8(x[0] - d0[0], x[1] - d0[1], x[2] - d1[0], x[3] - d1[1]); lw.y = pk4_fp8(x[4] - d2[0], x[5] - d2[1], x[6] - d3[0], x[7] - d3[1]); }
      *(v2u*)(p.ws + WS_QHI + (size_t)tok * 512 + lane * 8) = hw; *(v2u*)(p.ws + WS_QLO + (size_t)tok * 512 + lane * 8) = lw; }
    { const v4u kv = *(const v4u*)(row + 512 + (lane & 15) * 8);
      float x[8]; float ss = 0.f;
#pragma unroll
      for (int i = 0; i < 4; ++i) { x[2 * i] = bflo(kv[i]); x[2 * i + 1] = bfhi(kv[i]); ss += x[2 * i] * x[2 * i] + x[2 * i + 1] * x[2 * i + 1]; }
      ss += __shfl_xor(ss, 1); ss += __shfl_xor(ss, 2); ss += __shfl_xor(ss, 4);
      const float rs = rsqrtf(ss * (1.f / 64.f) + RMS_EPS);
#pragma unroll
      for (int i = 0; i < 8; ++i) x[i] = x[i] * rs * p.k_norm_g[c8 + i];
      v2u o; o.x = pk4_fp8(x[0], x[1], x[2], x[3]); o.y = pk4_fp8(x[4], x[5], x[6], x[7]);
      if (lane < 16) *(v2u*)(p.ws + WS_K8 + (size_t)tok * 128 + lane * 8) = o; }
}

typedef short v4i16_t __attribute__((ext_vector_type(4)));
__device__ __forceinline__ v4i16_t vtr16(const bf16* ldsp) { return __builtin_amdgcn_ds_read_tr16_b64_v4i16((LAS v4i16_t*)ldsp); }
__device__ __forceinline__ void dsa2_query(const Params& p, unsigned char* ldsw, int b, int t, int lane) {
    unsigned char* ws = p.ws;
    const bf16* ATT = (const bf16*)(ws + WS_ATT);
    const unsigned short* SEL = (const unsigned short*)(ws + WS_SEL);
    bf16* YB = (bf16*)(ws + WS_H);
    unsigned short* sl = (unsigned short*)ldsw;
    float* df = (float*)(ldsw + 512);
    bf16* Vl = (bf16*)(ldsw + 1536);
    const int fr = lane & 15, fq = lane >> 4;
    const size_t rowb = (size_t)b * SEQ;
    const int cnt = (t + 1 < TOPK) ? (t + 1) : TOPK;
    { v2u sv = *(const v2u*)(SEL + (rowb + t) * TOPK + lane * 4);
      const int j0 = lane * 4;
      if (j0 >= cnt) sv.x = 0u; else if (j0 + 1 >= cnt) sv.x &= 0xffffu;
      if (j0 + 2 >= cnt) sv.y = 0u; else if (j0 + 3 >= cnt) sv.y &= 0xffffu;
      *(v2u*)(sl + lane * 4) = sv;
      f32x4 d4; d4[0] = (j0 < cnt) ? (float)(t - (int)(sv.x & 0xffffu)) : INFINITY; d4[1] = (j0 + 1 < cnt) ? (float)(t - (int)(sv.x >> 16)) : INFINITY;
      d4[2] = (j0 + 2 < cnt) ? (float)(t - (int)(sv.y & 0xffffu)) : INFINITY; d4[3] = (j0 + 3 < cnt) ? (float)(t - (int)(sv.y >> 16)) : INFINITY;
      *(f32x4*)(df + lane * 4) = d4; }
    LDS_WAIT(); __builtin_amdgcn_wave_barrier();
    const unsigned char* K8 = ws + WS_K8;
    long qhA[2] = {0, 0}, qhB[2] = {0, 0}, qlA[2] = {0, 0}, qlB[2] = {0, 0};
    if (fr < 8) { const v4u qh = *(const v4u*)(ws + WS_QHI + (rowb + t) * 512 + fr * 64 + fq * 16), ql = *(const v4u*)(ws + WS_QLO + (rowb + t) * 512 + fr * 64 + fq * 16);
        const long hA = (long)(((unsigned long long)qh.y << 32) | qh.x), hB = (long)(((unsigned long long)qh.w << 32) | qh.z), lA = (long)(((unsigned long long)ql.y << 32) | ql.x), lB = (long)(((unsigned long long)ql.w << 32) | ql.z);
        if (fr < 4) { qhA[0] = hA; qhB[0] = hB; qlA[0] = lA; qlB[0] = lB; } else { qhA[1] = hA; qhB[1] = hB; qlA[1] = lA; qlB[1] = lB; } }
    pg8::f32x4 sc[16];
    v4u vv[16];
    { v4u kf[16];
#pragma unroll
      for (int half = 0; half < 2; ++half) {
#pragma unroll
          for (int kt = 0; kt < 8; ++kt) { const int s = sl[(half * 8 + kt) * 16 + fr]; const unsigned char* kp = K8 + (rowb + s) * 128 + fq * 16;
              kf[2 * kt] = *(const v4u*)kp; kf[2 * kt + 1] = *(const v4u*)(kp + 64); }
          if (half == 1) {
#pragma unroll
              for (int i = 0; i < 8; ++i) { const int s = sl[i * 8 + (lane >> 3)]; vv[i] = *(const v4u*)(ATT + (rowb + s) * LD_ATT + 640 + (lane & 7) * 8); } }
          __builtin_amdgcn_sched_barrier(0);
#pragma unroll
          for (int kt = 0; kt < 8; ++kt) { pg8::f32x4 a = {0.f, 0.f, 0.f, 0.f};
#pragma unroll
              for (int gg = 0; gg < 2; ++gg) { const v4u kv = kf[2 * kt + gg];
                  const long kA = (long)(((unsigned long long)kv.y << 32) | kv.x), kB = (long)(((unsigned long long)kv.w << 32) | kv.z);
                  a = __builtin_amdgcn_mfma_f32_16x16x32_fp8_fp8(kA, qhA[gg], a, 0, 0, 0); a = __builtin_amdgcn_mfma_f32_16x16x32_fp8_fp8(kB, qhB[gg], a, 0, 0, 0);
                  a = __builtin_amdgcn_mfma_f32_16x16x32_fp8_fp8(kA, qlA[gg], a, 0, 0, 0); a = __builtin_amdgcn_mfma_f32_16x16x32_fp8_fp8(kB, qlB[gg], a, 0, 0, 0); }
              sc[half * 8 + kt] = a; }
          __builtin_amdgcn_sched_barrier(0);
      } }
    const float slope = exp2f(-(float)((fr & 7) + 1)) * 1.4426950408889634f;
    float m = -INFINITY;
#pragma unroll
    for (int kt = 0; kt < 16; ++kt) { const f32x4 d4 = *(const f32x4*)(df + kt * 16 + fq * 4);
#pragma unroll
        for (int r = 0; r < 4; ++r) { const float x = sc[kt][r] - slope * d4[r]; sc[kt][r] = x; m = fmaxf(m, x); } }
    m = fmaxf(m, __shfl_xor(m, 16)); m = fmaxf(m, __shfl_xor(m, 32));
    float l = 0.f;
#pragma unroll
    for (int kt = 0; kt < 16; ++kt)
#pragma unroll
        for (int r = 0; r < 4; ++r) { const float e = __builtin_amdgcn_exp2f(sc[kt][r] - m); sc[kt][r] = e; l += e; }
    l += __shfl_xor(l, 16); l += __shfl_xor(l, 32);
    const float inv = 1.f / l;
#pragma unroll 1
    for (int g = 0; g < 2; ++g) {
        if (g == 1) {
#pragma unroll
            for (int i = 0; i < 8; ++i) { const int s = sl[i * 8 + (lane >> 3)]; vv[i] = *(const v4u*)(ATT + (rowb + s) * LD_ATT + 640 + 64 + (lane & 7) * 8); } }
#pragma unroll
        for (int i = 8; i < 16; ++i) { const int s = sl[i * 8 + (lane >> 3)]; vv[i] = *(const v4u*)(ATT + (rowb + s) * LD_ATT + 640 + g * 64 + (lane & 7) * 8); }
        pg8::f32x4 o[4];
#pragma unroll
        for (int dt = 0; dt < 4; ++dt) o[dt] = (pg8::f32x4){0.f, 0.f, 0.f, 0.f};
#pragma unroll
        for (int ch = 0; ch < 4; ++ch) {
            LDS_WAIT(); __builtin_amdgcn_wave_barrier();
#pragma unroll
            for (int i = 0; i < 8; ++i) *(v4u*)(Vl + (i * 8 + (lane >> 3)) * 80 + (lane & 7) * 8) = vv[(ch & 1) * 8 + i];
            if (ch < 2) {
#pragma unroll
                for (int i = 0; i < 8; ++i) { const int s = sl[((ch + 2) * 8 + i) * 8 + (lane >> 3)]; vv[(ch & 1) * 8 + i] = *(const v4u*)(ATT + (rowb + s) * LD_ATT + 640 + g * 64 + (lane & 7) * 8); } }
            LDS_WAIT(); __builtin_amdgcn_wave_barrier();
#pragma unroll
            for (int k2 = 0; k2 < 2; ++k2) { const int kt0 = ch * 4 + 2 * k2;
                v4u pw; pw.x = pk2(sc[kt0][0], sc[kt0][1]); pw.y = pk2(sc[kt0][2], sc[kt0][3]); pw.z = pk2(sc[kt0 + 1][0], sc[kt0 + 1][1]); pw.w = pk2(sc[kt0 + 1][2], sc[kt0 + 1][3]);
                const bf16x8 pb = __builtin_bit_cast(bf16x8, pw);
#pragma unroll
                for (int dt = 0; dt < 4; ++dt) { const bf16* vp = Vl + ((2 * k2) * 16 + fq * 4 + (fr >> 2)) * 80 + dt * 16 + (fr & 3) * 4;
                    const v4i16_t lo = vtr16(vp), hi = vtr16(vp + 16 * 80);
                    const bf16x8 af = {lo[0], lo[1], lo[2], lo[3], hi[0], hi[1], hi[2], hi[3]};
                    o[dt] = __builtin_amdgcn_mfma_f32_16x16x32_bf16(af, pb, o[dt], 0, 0, 0); } }
        }
        if (fr < 8 && (fr >> 2) == g) {
#pragma unroll
            for (int dt = 0; dt < 4; ++dt) { const float i8 = inv * 8.f;
                *(unsigned*)((unsigned char*)YB + (rowb + t) * 1024 + 512 + fr * 64 + dt * 16 + fq * 4) = pk4_fp8(o[dt][0] * i8, o[dt][1] * i8, o[dt][2] * i8, o[dt][3] * i8); } }
    }
    LDS_WAIT(); __builtin_amdgcn_wave_barrier();
}

#define INS16(L, x) do { _Pragma("unroll") for (int _i = 15; _i >= 1; --_i) L[_i] = __builtin_amdgcn_fmed3f(L[_i - 1], L[_i], (x)); L[0] = fmaxf(L[0], (x)); } while (0)
__device__ __forceinline__ float f_andor(float v, unsigned keepmask, unsigned orv) { return __builtin_bit_cast(float, (__builtin_bit_cast(unsigned, v) & keepmask) | orv); }
__device__ __forceinline__ void peer_route_item(const Params& p, unsigned char* ldsw, int tg, int h, int lane, int* EIDX, float* GATES) {
    unsigned char* ws = p.ws;
    const bf16* Q = (const bf16*)(ws + WS_Q);
    const bf16* SK = (const bf16*)(ws + WS_SK);
    float* sc = (float*)ldsw;
    const int fr = lane & 15, fq = lane >> 4;
#pragma unroll 1
    for (int pp = 0; pp < 2; ++pp) {
        bf16x8 Af[4], Bf[32];
        { const bf16* rp = Q + (size_t)(tg * 16 + fr) * 2048 + h * 256 + pp * 128 + fq * 8;
#pragma unroll
          for (int ks = 0; ks < 4; ++ks) Af[ks] = *(const bf16x8*)(rp + ks * 32); }
#pragma unroll
        for (int kt = 0; kt < 8; ++kt) { const bf16* kp = SK + (size_t)((h * 2 + pp) * 128 + kt * 16 + fr) * 128 + fq * 8;
#pragma unroll
            for (int ks = 0; ks < 4; ++ks) Bf[kt * 4 + ks] = *(const bf16x8*)(kp + ks * 32); }
        __builtin_amdgcn_sched_barrier(0);
#pragma unroll
        for (int kt = 0; kt < 8; ++kt) {
            pg8::f32x4 a = {0.f, 0.f, 0.f, 0.f};
#pragma unroll
            for (int ks = 0; ks < 4; ++ks) a = __builtin_amdgcn_mfma_f32_16x16x32_bf16(Af[ks], Bf[kt * 4 + ks], a, 0, 0, 0);
#pragma unroll
            for (int r = 0; r < 4; ++r) sc[(pp * 16 + fq * 4 + r) * 132 + kt * 16 + fr] = f_andor(a[r], ~127u, (unsigned)(kt * 16 + fr));
        }
    }
    LDS_WAIT(); __builtin_amdgcn_wave_barrier();
    float L[16];
#pragma unroll
    for (int i = 0; i < 16; ++i) L[i] = -INFINITY;
    { const float* sp = sc + (lane & 31) * 132 + (lane >> 5) * 64;
#pragma unroll 4
      for (int i = 0; i < 16; ++i) { const f32x4 x = *(const f32x4*)(sp + 4 * i); INS16(L, x[0]); INS16(L, x[1]); INS16(L, x[2]); INS16(L, x[3]); } }
    { float O[16];
#pragma unroll
      for (int i = 0; i < 16; ++i) O[i] = __shfl_xor(L[i], 32);
#pragma unroll
      for (int i = 0; i < 16; ++i) INS16(L, O[i]); }
    LDS_WAIT(); __builtin_amdgcn_wave_barrier();
    float* lst = sc;
    if (lane < 32) {
#pragma unroll
        for (int i = 0; i < 4; ++i) *(f32x4*)(lst + lane * 16 + 4 * i) = (f32x4){L[4 * i], L[4 * i + 1], L[4 * i + 2], L[4 * i + 3]}; }
    LDS_WAIT(); __builtin_amdgcn_wave_barrier();
    const int tok = lane & 15;
    float s1[16], s2[16];
#pragma unroll
    for (int i = 0; i < 4; ++i) { const f32x4 a = *(const f32x4*)(lst + tok * 16 + 4 * i), b = *(const f32x4*)(lst + (16 + tok) * 16 + 4 * i);
#pragma unroll
        for (int c = 0; c < 4; ++c) { s1[4 * i + c] = f_andor(a[c], ~127u, 0u); s2[4 * i + c] = f_andor(b[c], ~127u, 0u); } }
    float M[16];
#pragma unroll
    for (int i = 0; i < 16; ++i) M[i] = -INFINITY;
#pragma unroll
    for (int a = 0; a < 16; ++a)
#pragma unroll
        for (int b = 0; b < 16; ++b)
            if ((a + 1) * (b + 1) <= 16) { const float key = f_andor(s1[a] + s2[b], ~255u, (unsigned)(a * 16 + b)); INS16(M, key); }
    const float mx = f_andor(M[0], ~255u, 0u);
    float e[16], sum = 0.f; int ei[16];
    const unsigned* lb = (const unsigned*)lst;
#pragma unroll
    for (int i = 0; i < 16; ++i) { const unsigned bits = __builtin_bit_cast(unsigned, M[i]); const int flat = bits & 255u;
        e[i] = __expf(f_andor(M[i], ~255u, 0u) - mx); sum += e[i];
        ei[i] = (int)(lb[tok * 16 + (flat >> 4)] & 127u) * 128 + (int)(lb[(16 + tok) * 16 + (flat & 15)] & 127u); }
    const float inv = 1.f / sum;
    if (lane < 16) {
        const size_t ob = ((size_t)tok * 8 + h) * 16;
#pragma unroll
        for (int i = 0; i < 4; ++i) { *(v4u*)(EIDX + ob + 4 * i) = (v4u){(unsigned)ei[4 * i], (unsigned)ei[4 * i + 1], (unsigned)ei[4 * i + 2], (unsigned)ei[4 * i + 3]};
            *(f32x4*)(GATES + ob + 4 * i) = (f32x4){e[4 * i] * inv, e[4 * i + 1] * inv, e[4 * i + 2] * inv, e[4 * i + 3] * inv}; }
    }
    LDS_WAIT(); __builtin_amdgcn_wave_barrier();
}

__device__ __forceinline__ float gelu_erf(float x) { return 0.5f * x * (1.f + erff(x * 0.70710678118654752f)); }
typedef int v8i_t __attribute__((ext_vector_type(8)));
template <int OPSEL> __device__ __forceinline__ pg8::f32x4 mx_dot(v8i_t a, int sa, v8i_t b, int sb, pg8::f32x4 c) {
    return __builtin_amdgcn_mfma_scale_f32_16x16x128_f8f6f4(a, b, c, 4  , 4  , OPSEL, sa, OPSEL, sb);
}
__device__ __forceinline__ void peer_token(const Params& p, unsigned char* ldsw, int tok, int lane, const int* EIDX, const float* GATES, bool dry = false) {
    unsigned char* ws = p.ws;
    const unsigned char* V8 = ws + WS_V; const unsigned char* V8S = ws + WS_VS;
    const float* MOD = (const float*)(ws + WS_MOD);
    const int fr = lane & 15, fq = lane >> 4;
    typedef v8i_t v8i;
    v4u A4[H4_NT][8]; v2u As[H4_NT];
#pragma unroll
    for (int t = 0; t < H4_NT; ++t) { const unsigned char* hp = ws + WS_H4D + ((size_t)tok * H4_NT + t) * 512 + fq * 16;
        As[t] = *(const v2u*)(ws + WS_H4S + ((size_t)tok * H4_NT + t) * 32 + fq * 8);
#pragma unroll
        for (int kk = 0; kk < 8; ++kk) A4[t][kk] = *(const v4u*)(hp + kk * 64); }
    int* pe = (int*)ldsw; float* pa = (float*)(ldsw + 512);
    const unsigned char* U4 = ws + WS_U; const unsigned char* U4S = ws + WS_US;
#pragma unroll 2
    for (int ct = 0; ct < 8; ++ct) {
        const int eic = EIDX[ct * 16 + fr]; const float gt = GATES[ct * 16 + fr];
        const unsigned char* ur = U4 + (size_t)eic * 512 + fq * 16;
        const v2u us = *(const v2u*)(U4S + (size_t)eic * 32 + fq * 8);
        pg8::f32x4 ah = {0.f, 0.f, 0.f, 0.f};
#pragma unroll
        for (int kk = 0; kk < 8; ++kk) { const v4u bu = *(const v4u*)(ur + kk * 64);
            const v8i bb = {(int)bu.x, (int)bu.y, (int)bu.z, (int)bu.w, 0, 0, 0, 0};
            const int sb = (int)((kk < 4) ? us.x : us.y);
#pragma unroll
            for (int t = 0; t < H4_NT; ++t) { const v8i aa = {(int)A4[t][kk].x, (int)A4[t][kk].y, (int)A4[t][kk].z, (int)A4[t][kk].w, 0, 0, 0, 0}; const int sa = (int)((kk < 4) ? As[t].x : As[t].y);
                if ((kk & 3) == 0) ah = mx_dot<0>(aa, sa, bb, sb, ah); else if ((kk & 3) == 1) ah = mx_dot<1>(aa, sa, bb, sb, ah); else if ((kk & 3) == 2) ah = mx_dot<2>(aa, sa, bb, sb, ah); else ah = mx_dot<3>(aa, sa, bb, sb, ah); } }
        const float dot = ah[0];
        if (fq == 0) { pe[ct * 16 + fr] = eic; pa[ct * 16 + fr] = gelu_erf(dot) * gt; }
    }
    __builtin_amdgcn_sched_barrier(0);
    const int hl = lane >> 5, bl = lane & 31;
    float acc[32];
#pragma unroll
    for (int i = 0; i < 32; ++i) acc[i] = 0.f;
    LDS_WAIT(); __builtin_amdgcn_wave_barrier();
#pragma unroll 1
    for (int ct = 0; ct < 16; ++ct)
#pragma unroll
        for (int jp = 0; jp < 4; ++jp) {
            const int idx = pe[ct * 8 + 2 * jp + hl]; const float a = pa[ct * 8 + 2 * jp + hl];
            const v4u vv = *(const v4u*)(V8 + (size_t)idx * 512 + bl * 16);
            const unsigned sbyte = V8S[(size_t)idx * 32 + bl];
            const float as = a * __builtin_bit_cast(float, sbyte << 23);
#pragma unroll
            for (int w4 = 0; w4 < 4; ++w4) { const unsigned wd = vv[w4];
                const f32x2 d0 = __builtin_amdgcn_cvt_scalef32_pk_f32_fp4(wd, 1.0f, 0), d1 = __builtin_amdgcn_cvt_scalef32_pk_f32_fp4(wd, 1.0f, 1), d2 = __builtin_amdgcn_cvt_scalef32_pk_f32_fp4(wd, 1.0f, 2), d3 = __builtin_amdgcn_cvt_scalef32_pk_f32_fp4(wd, 1.0f, 3);
                acc[8 * w4] += as * d0[0]; acc[8 * w4 + 1] += as * d0[1]; acc[8 * w4 + 2] += as * d1[0]; acc[8 * w4 + 3] += as * d1[1];
                acc[8 * w4 + 4] += as * d2[0]; acc[8 * w4 + 5] += as * d2[1]; acc[8 * w4 + 6] += as * d3[0]; acc[8 * w4 + 7] += as * d3[1]; }
        }
    LDS_WAIT(); __builtin_amdgcn_wave_barrier();
    float accs[16];
#pragma unroll
    for (int i = 0; i < 16; ++i) { const float lo = acc[i] + __shfl_xor(acc[i], 32), hi2 = acc[16 + i] + __shfl_xor(acc[16 + i], 32); accs[i] = hl ? hi2 : lo; }
    const int b = tok / SEQ;
    const int col0 = bl * 32 + hl * 16;
    const float* g2 = MOD + (size_t)b * 6144 + 5 * 1024 + col0;
    float* orow = p.out + (size_t)tok * DM + col0;
#pragma unroll
    for (int q4 = 0; q4 < 4; ++q4) { const f32x4 xv = *(const f32x4*)(orow + 4 * q4), gv = *(const f32x4*)(g2 + 4 * q4);
        f32x4 o;
#pragma unroll
        for (int i = 0; i < 4; ++i) o[i] = xv[i] + (dry ? 0.f : gv[i] * accs[4 * q4 + i]);
        if (dry) { asm volatile("" :: "v"(accs[4 * q4]), "v"(accs[4 * q4 + 1]), "v"(accs[4 * q4 + 2]), "v"(accs[4 * q4 + 3])); }
        *(f32x4*)(orow + 4 * q4) = o; }
}

#define XB_TMO      128
#define XB_XCNT(j)  (256  + 64 * (j))
#define XB_XSUB(j)  (1280 + 64 * (j))
#define XB_XGEN(j)  (2304 + 64 * (j))
#define XB_TOP      3328
#define XB_TOPGEN   3392
#define XCD_BAR_WORDS 3456
#define XB_SPIN_CAP (1u << 18)

__device__ __forceinline__ unsigned xb_ld(unsigned* p)              { return __hip_atomic_load(p, __ATOMIC_RELAXED, __HIP_MEMORY_SCOPE_AGENT); }
__device__ __forceinline__ unsigned xb_add(unsigned* p, unsigned v) { return __hip_atomic_fetch_add(p, v, __ATOMIC_RELAXED, __HIP_MEMORY_SCOPE_AGENT); }
__device__ __forceinline__ unsigned xb_xcc_id() { return (unsigned)__builtin_amdgcn_s_getreg((3 << 11) | 20) & 0xFu; }
#define XB_SPIN(cond, bar) do { unsigned _sp = 0; while (cond) { __builtin_amdgcn_s_sleep(1); \
    if ((++_sp & 255u) == 0u) { if (xb_ld(&(bar)[XB_TMO])) break; if (_sp > XB_SPIN_CAP) { atomicAdd(&(bar)[XB_TMO], 1u); break; } } } } while (0)

struct XcdBarrier {
    unsigned* bar; unsigned x;
    volatile LAS unsigned* st;
};

__device__ __forceinline__ XcdBarrier xcd_barrier_post(unsigned* bar, volatile LAS unsigned* st) {
    XcdBarrier b; b.bar = bar; b.x = xb_xcc_id(); b.st = st;
    if (threadIdx.x == 0) (void)xb_add(&bar[XB_XCNT(b.x)], 1u);
    return b;
}
__device__ __forceinline__ void xcd_barrier_complete(unsigned* bar, unsigned x, unsigned& nloc, unsigned& nx) {
    const unsigned G = gridDim.x * gridDim.y * gridDim.z;
    unsigned sum, cnt, mine, sp = 0u;
    for (;;) {
        sum = 0u; cnt = 0u; mine = 0u;
#pragma unroll
        for (unsigned j = 0; j < 16; ++j) { const unsigned c = xb_ld(&bar[XB_XCNT(j)]); sum += c; cnt += (c > 0u) ? 1u : 0u; mine = (j == x) ? c : mine; }
        if (sum == G) break;
        __builtin_amdgcn_s_sleep(1);
        if ((++sp & 255u) == 0u) { if (xb_ld(&bar[XB_TMO])) break; if (sp > XB_SPIN_CAP) { atomicAdd(&bar[XB_TMO], 1u); break; } }
    }
    nloc = mine > 0u ? mine : 1u; nx = cnt > 0u ? cnt : 1u;
}

__device__ __forceinline__ void xcd_barrier(const XcdBarrier& b) {
    asm volatile("s_waitcnt vmcnt(0)" ::: "memory");
    __syncthreads();
    if (threadIdx.x == 0) {
        unsigned* bar = b.bar;
        __builtin_amdgcn_s_waitcnt(0);
        unsigned nloc = b.st[0], nx = b.st[1];
        if (nloc == 0u) { xcd_barrier_complete(bar, b.x, nloc, nx); b.st[0] = nloc; b.st[1] = nx; }
        const unsigned old = xb_add(&bar[XB_XSUB(b.x)], 1u);
        const unsigned gen = old / nloc;
        if (old + 1u == (gen + 1u) * nloc) {
            __builtin_amdgcn_fence(__ATOMIC_RELEASE, "agent");
            asm volatile("s_waitcnt vmcnt(0)" ::: "memory");
            const unsigned og = xb_add(&bar[XB_TOP], 1u);
            const unsigned tg = og / nx;
            if (og + 1u == (tg + 1u) * nx) xb_add(&bar[XB_TOPGEN], 1u);
            else XB_SPIN(xb_ld(&bar[XB_TOPGEN]) == tg, bar);
            __builtin_amdgcn_fence(__ATOMIC_ACQUIRE, "agent");
            xb_add(&bar[XB_XGEN(b.x)], 1u);
            asm volatile("s_waitcnt vmcnt(0)" ::: "memory");
        } else {
            XB_SPIN(xb_ld(&bar[XB_XGEN(b.x)]) == gen, bar);
            __builtin_amdgcn_fence(__ATOMIC_ACQUIRE, "agent");
            asm volatile("s_waitcnt vmcnt(0)" ::: "memory");
        }
    }
    __syncthreads();
}

constexpr int NPHASE = 11;
__global__ void __launch_bounds__(NTHREADS, 2) mega(Params p) {
    extern __shared__ __attribute__((aligned(16))) unsigned char lds[];
    cg::grid_group grid = cg::this_grid();
    const int lo = p.ph_lo, hi = p.ph_hi;
    const int tid = threadIdx.x, wave = tid >> 6, lane = tid & 63, G = gridDim.x;
    unsigned char* ws = p.ws;
#ifndef ONLYPH
#define IN(k) (lo <= (k) && (k) < hi)
#else
#define IN(k) ((k) == ONLYPH && lo <= (k) && (k) < hi)
#endif
    volatile LAS unsigned* xb_st = (volatile LAS unsigned*)((LAS unsigned char*)lds + (LDS_BYTES - 16));
    if (tid < 4) xb_st[tid] = 0u;
    __syncthreads();
    XcdBarrier xbar; xbar.bar = (unsigned*)(ws + WS_CTL); xbar.x = 0; xbar.st = xb_st;
    if (hi - lo > 1) xbar = xcd_barrier_post((unsigned*)(ws + WS_CTL), xb_st);
    if (lo < -1) grid.sync();
#define SEAM(k) do { if (IN((k) + 1)) xcd_barrier(xbar); } while (0)
#ifndef REPMASK
#define REPMASK 0
#endif
#define NREP(k) (((REPMASK >> (k)) & 1) ? 2 : 1)
    if (IN(0)) { for (int rep = 0; rep < NREP(0); ++rep) phase0(p, lds); SEAM(0); }
    if (IN(1)) { for (int rep = 0; rep < NREP(1); ++rep) normmod_phase<true>(p, lds, p.x, (bf16*)(ws + WS_H), p.norm1_g, 0, 1024); SEAM(1); }
    if (IN(2)) {
        { pg8::Gemm g{(const bf16*)(ws + WS_H8), (const bf16*)(ws + WS_WIN8), T, 3584, 512, 512, 512}; pg8::StaticOrder S; S.init(T, 3584, G, (int)blockIdx.x);
          EpiProj E{(bf16*)(ws + WS_HG), (bf16*)(ws + WS_ATT), (bf16*)(ws + WS_IDX), (bf16*)(ws + WS_GATE), 1};
          pg8::gemm_phase<EpiProj, pg8::StaticOrder, true, true, 122>((PG8_LAS unsigned char*)lds, g, S, E); }
        { pg8::Gemm g{(const bf16*)(ws + WS_H), (const bf16*)(ws + WS_WIN), T, 2048, 1024, 1024, 1024}; pg8::StaticOrder S; S.init(T, 2048, G, (int)blockIdx.x);
          EpiProj E{(bf16*)(ws + WS_HG), (bf16*)(ws + WS_ATT), (bf16*)(ws + WS_IDX), (bf16*)(ws + WS_GATE), 0};
          pg8::gemm_phase<EpiProj, pg8::StaticOrder, true, true>((PG8_LAS unsigned char*)lds, g, S, E); }
        SEAM(2);
    }
    if (IN(3)) {
        for (int tok = (int)blockIdx.x * NWAVES + wave; tok < T; tok += G * NWAVES) qknorm_token(p, tok, lane);
        SEAM(3);
    }
    if (IN(4)) {
        if ((int)blockIdx.x < 32) hgrn_item(p, lds, (int)blockIdx.x);
        {
            unsigned* qctr = (unsigned*)(ws + WS_CTL + 32768);
            volatile LAS unsigned* qslot = (volatile LAS unsigned*)((LAS unsigned char*)lds + (LDS_BYTES - 32));
            int qsel = (int)(blockIdx.x & 7u), tried = 0;
            for (;;) {
                if (tid == 0) { unsigned c;
                    for (;;) { c = __hip_atomic_fetch_add(qctr + qsel * 64, 1u, __ATOMIC_RELAXED, __HIP_MEMORY_SCOPE_AGENT); if (c < (unsigned)(SEQ / 16) || tried >= 7) break; qsel = (qsel + 1) & 7; ++tried; }
                    *qslot = (c < (unsigned)(SEQ / 16)) ? (((unsigned)qsel << 16) | c) : 0xffffffffu; }
                __syncthreads();
                const unsigned c = *qslot;
                __syncthreads();
                if (c == 0xffffffffu) break;
                const int b = (int)(c >> 16), qblk = (SEQ / 16 - 1) - (int)(c & 0xffffu), it = b * (SEQ / 16) + qblk, q0 = qblk * 16;
                dsa1_item(p, lds, it);
#pragma unroll 1
                for (int k2 = 0; k2 < 2; ++k2) dsa2_query(p, lds + wave * 16384, b, q0 + wave + 8 * k2, lane);
                __syncthreads();
            }
        }
        SEAM(4);
    }
    if (IN(5)) {
        pg8::Gemm g{(const bf16*)(ws + WS_H), (const bf16*)(ws + WS_WAB8), T, 1024, 256, 512, 512}; pg8::StaticOrderT<true> S; S.init(T, 1024, G, (int)blockIdx.x, 256);
        EpiMerged E{(const bf16*)(ws + WS_GATE), (bf16*)(ws + WS_MERGED)};
        for (int rep = 0; rep < NREP(5); ++rep) pg8::gemm_phase<EpiMerged, pg8::StaticOrderT<true>, true, true, 122>((PG8_LAS unsigned char*)lds, g, S, E);
        SEAM(5);
    }
    if (IN(6)) {
        pg8::Gemm g{(const bf16*)(ws + WS_MERGED), (const bf16*)(ws + WS_WOUT8), T, 1024, 512, 512, 512}; pg8::StaticOrder S; S.init(T, 1024, G, (int)blockIdx.x);
        EpiResid E{p.x, (const float*)(ws + WS_MOD) + 2048, p.out};
        for (int rep = 0; rep < NREP(6); ++rep) pg8::gemm_phase<EpiResid, pg8::StaticOrder, true, true, 120>((PG8_LAS unsigned char*)lds, g, S, E);
        SEAM(6);
    }
    if (IN(7)) { for (int rep = 0; rep < NREP(7); ++rep) normmod_phase<false>(p, lds, p.out, (bf16*)(ws + WS_H), p.norm2_g, 3 * 1024, 4 * 1024); SEAM(7); }
    if (IN(8)) {
        pg8::Gemm g{(const bf16*)(ws + WS_H), (const bf16*)(ws + WS_WQ), T, 2048, 1024, 1024, 1024}; pg8::StaticOrder S; S.init(T, 2048, G, (int)blockIdx.x);
        EpiStore E{(bf16*)(ws + WS_Q), 2048};
        for (int rep = 0; rep < NREP(8); ++rep) pg8::gemm_phase<EpiStore, pg8::StaticOrder, true, true>((PG8_LAS unsigned char*)lds, g, S, E);
        SEAM(8);
    }
    if (IN(9)) {
        int* eL = (int*)(lds + 8 * 16896); float* gL = (float*)(lds + 8 * 16896 + 8192);
        for (int tg = blockIdx.x; tg < T / 16; tg += G) {
            peer_route_item(p, lds + wave * 16896, tg, wave, lane, eL, gL);
            __syncthreads();
#pragma unroll 1
            for (int k2 = 0; k2 < 2; ++k2) { const int tl = wave + 8 * k2; peer_token(p, lds + 8 * 16896 + 16384 + wave * 1024, tg * 16 + tl, lane, eL + tl * 128, gL + tl * 128); }
            __syncthreads();
        }
    }
#undef IN
#undef SEAM
}

#ifndef ONE_LAUNCH
#define ONE_LAUNCH 1
#endif
extern "C" void kernel_launch(void* const* d_in, const int* in_sizes, int n_in, void* d_out, int out_size, void* d_ws, size_t ws_size, hipStream_t stream) {
    static int grid = 0;
    if (grid == 0) {
        if (n_in != 18 || out_size != T * DM || ws_size < WS_END) { fprintf(stderr, "kernel_launch: unexpected shapes (n_in %d, out %d, ws %zu)\n", n_in, out_size, ws_size); grid = -1; return; }
        int dev = 0, cus = 0, per_cu = 0;
        if (hipGetDevice(&dev) != hipSuccess || hipDeviceGetAttribute(&cus, hipDeviceAttributeMultiprocessorCount, dev) != hipSuccess) { grid = -1; return; }
        if (hipFuncSetAttribute((const void*)mega, hipFuncAttributeMaxDynamicSharedMemorySize, LDS_BYTES) != hipSuccess) { fprintf(stderr, "kernel_launch: hipFuncSetAttribute failed\n"); grid = -1; return; }
        if (hipOccupancyMaxActiveBlocksPerMultiprocessor(&per_cu, (const void*)mega, NTHREADS, LDS_BYTES) != hipSuccess || per_cu < 1) { fprintf(stderr, "kernel_launch: occupancy query says %d\n", per_cu); grid = -1; return; }
        (void)hipGetLastError();
        grid = cus;
        if (grid < 64) { grid = -1; return; }
    }
    if (grid < 0) return;
    Params p{};
    const float** pp = (const float**)&p;
    for (int i = 0; i < 18; ++i) pp[i] = (const float*)d_in[i];
    p.out = (float*)d_out; p.ws = (unsigned char*)d_ws;
#if ONE_LAUNCH
    if (hipMemsetAsync((char*)d_ws + WS_CTL, 0, 65536, stream) != hipSuccess) { fprintf(stderr, "kernel_launch: memset failed\n"); return; }
    p.ph_lo = 0; p.ph_hi = NPHASE;
    void* args[] = {&p};
    hipError_t e = hipLaunchCooperativeKernel((const void*)mega, dim3(grid), dim3(NTHREADS), args, LDS_BYTES, stream);
    if (e != hipSuccess) fprintf(stderr, "cooperative launch failed: %s (grid %d)\n", hipGetErrorString(e), grid);
#else
    for (int k = 0; k < NPHASE; ++k) { p.ph_lo = k; p.ph_hi = k + 1; hipLaunchKernelGGL(mega, dim3(grid), dim3(NTHREADS), LDS_BYTES, stream, p); }
#endif
}
```

```cpp
#include <hip/hip_runtime.h>
#include <hip/hip_cooperative_groups.h>
#include <cstdio>
#include <cstdint>
namespace cg = cooperative_groups;

namespace pg8 {
#define PG8_LAS __attribute__((address_space(3)))
typedef unsigned short bf16_t;
typedef short bf16x8 __attribute__((ext_vector_type(8)));
typedef float f32x4 __attribute__((ext_vector_type(4)));
typedef unsigned u32x4 __attribute__((ext_vector_type(4)));
constexpr int BM = 256, BK = 64, HALF = 128, HTB = HALF * BK * 2  , STAGE_BYTES = 8 * HTB, NXCD = 8, WGM = 8;

__host__ __device__ __forceinline__ int lds_byte(int r, int c) { const int st = (r >> 4) * 2 + (c >> 5), rr = r & 15, cc = c & 31, ob = rr * 64 + cc * 2; return st * 1024 + (ob ^ (((ob >> 9) & 1) << 5)); }
__host__ __device__ __forceinline__ void stage_rc(int b, int& R, int& C) { const int st = b / 1024, sb = b % 1024, swz = sb ^ (((sb >> 9) & 1) << 5); R = (st >> 1) * 16 + swz / 64; C = (st & 1) * 32 + (swz % 64) / 2; }
__host__ __device__ __forceinline__ int perm32(int rho) { const int n = rho >> 4, i = rho & 15; return 8 * (i >> 2) + 4 * n + (i & 3); }

struct Unit { int pm, pn, ko, pass; };
struct Gemm { const bf16_t* A; const bf16_t* Bt; int M, N, K, lda, ldb; };
typedef float f32x16 __attribute__((ext_vector_type(16)));
typedef f32x16 AccW[2][2][2];
__device__ __forceinline__ f32x4 acc_get(const AccW& A, int ai, int bj, int m, int n) { const int s_ = ((m & 1) * 2 + n) * 4; const f32x16& w = A[ai][bj][m >> 1]; return (f32x4){w[s_], w[s_ + 1], w[s_ + 2], w[s_ + 3]}; }
__device__ __forceinline__ void acc_set(AccW& A, int ai, int bj, int m, int n, f32x4 v) { const int s_ = ((m & 1) * 2 + n) * 4; f32x16& w = A[ai][bj][m >> 1]; w[s_] = v[0]; w[s_ + 1] = v[1]; w[s_ + 2] = v[2]; w[s_ + 3] = v[3]; }

template <bool TWOPASS_ORDER = false>
struct StaticOrderT {
    int nM, nN, nwg, G, c, kpass;
    __host__ __device__ void init(int M, int N, int G_, int c_, int kpass_ = 512) { nM = M / BM; nN = N / BM; nwg = nM * nN; G = G_; c = c_; kpass = kpass_; }
    __host__ __device__ bool next(int i, Unit& u) const {
        const long L = (long)(TWOPASS_ORDER ? (i >> 1) : i) * G + c; if (L >= nwg) return false;
        u.pass = TWOPASS_ORDER ? (i & 1) : 0; u.ko = TWOPASS_ORDER ? (i & 1) * kpass : 0;
        int wgid = (int)L; { const int q = nwg / NXCD, r = nwg % NXCD, xcd = wgid % NXCD, off = wgid / NXCD; wgid = (xcd < r ? xcd * (q + 1) : r * (q + 1) + (xcd - r) * q) + off; }
        const int nig = WGM * nN, gid = wgid / nig, fm = gid * WGM, gsz = (nM - fm) < WGM ? (nM - fm) : WGM;
        u.pm = fm + ((wgid % nig) % gsz); u.pn = (wgid % nig) / gsz; return true;
    }
    __device__ __forceinline__ void a_ready(const Unit&) const {}
    __device__ __forceinline__ void done(const Unit&) const {}
};
typedef StaticOrderT<false> StaticOrder;

__device__ __forceinline__ unsigned cvt_pk_bf16(float lo, float hi) { unsigned r; asm volatile("v_cvt_pk_bf16_f32 %0, %1, %2" : "=v"(r) : "v"(lo), "v"(hi)); return r; }

template <class Epi, class Sched, bool ALIGN_EPI = false, bool SP2 = false, int F8SCALE = 0>
__device__ __forceinline__ void gemm_phase(PG8_LAS unsigned char* lds, const Gemm g, const Sched& S, const Epi& E) {
    const int tid = threadIdx.x, wid = __builtin_amdgcn_readfirstlane(tid >> 6), lane = tid & 63, wr = wid >> 2, wc = wid & 3, fr = lane & 15, fq = lane >> 4;
    const int K = g.K, nt = K / BK;
    unsigned voffA[2], voffB[2];
#pragma unroll
    for (int i = 0; i < 2; ++i) { int R, C; stage_rc(tid * 16 + i * 8192, R, C); const int Rb = Epi::PERM ? ((R & ~31) + perm32(R & 31)) : R;
        voffA[i] = (unsigned)(R * g.lda + C) * 2u; voffB[i] = (unsigned)(Rb * g.ldb + C) * 2u; }
    const size_t kstep = (size_t)(BK * 2);
    const size_t hstepA = (size_t)HALF * g.lda * 2, hstepB = (size_t)HALF * g.ldb * 2;
    const size_t tstepA = 2 * hstepA, tstepB = 2 * hstepB;
    const unsigned ldsw = (unsigned)wid * 1024u;
    const int aoff = lds_byte(wr * 64 + fr, fq * 8), boff = lds_byte(wc * 32 + fr, fq * 8);
#define PG8_SA(b, h) (((b) * 2 + (h)) * HTB)
#define PG8_SB(b, h) ((4 + (b) * 2 + (h)) * HTB)
#define PG8_STAGE(bufoff, gbase, voff) do { _Pragma("unroll") for (int _i = 0; _i < 2; ++_i) \
        __builtin_amdgcn_global_load_lds((const unsigned*)((const char*)(gbase) + (voff)[_i]), (PG8_LAS unsigned*)(lds + (bufoff) + ldsw + _i * 8192), 16, 0, 0); } while (0)
#define PG8_LDA(dst, b, h) do { _Pragma("unroll") for (int m = 0; m < 4; ++m) { if constexpr (F8SCALE != 0) { \
        PG8_F8(dst)[m].lo = *(const PG8_LAS v4i_f*)(lds + PG8_SA(b, h) + aoff + m * 2048); PG8_F8(dst)[m].hi = *(const PG8_LAS v4i_f*)(lds + PG8_SA(b, h) + aoff + m * 2048 + 1024); } \
        else { _Pragma("unroll") for (int k = 0; k < 2; ++k) dst[m][k] = *(const PG8_LAS bf16x8*)(lds + PG8_SA(b, h) + aoff + m * 2048 + k * 1024); } } } while (0)
#define PG8_LDB(dst, b, h) do { _Pragma("unroll") for (int n = 0; n < 2; ++n) { if constexpr (F8SCALE != 0) { \
        PG8_F8(dst)[n].lo = *(const PG8_LAS v4i_f*)(lds + PG8_SB(b, h) + boff + n * 2048); PG8_F8(dst)[n].hi = *(const PG8_LAS v4i_f*)(lds + PG8_SB(b, h) + boff + n * 2048 + 1024); } \
        else { _Pragma("unroll") for (int k = 0; k < 2; ++k) dst[n][k] = *(const PG8_LAS bf16x8*)(lds + PG8_SB(b, h) + boff + n * 2048 + k * 1024); } } } while (0)
#define PG8_MMA(ai, bj, At, Bt) do { __builtin_amdgcn_s_setprio(1); _Pragma("unroll") for (int m = 0; m < 4; ++m) _Pragma("unroll") for (int n = 0; n < 2; ++n) { \
        f32x4 _c = acc_get(accw, ai, bj, m, n); \
        if constexpr (F8SCALE != 0) { _c = __builtin_amdgcn_mfma_scale_f32_16x16x128_f8f6f4(PG8_F8(Bt)[n], PG8_F8(At)[m], _c, 0, 0, 0, 0x7f7f7f7f, 0, F8SCALE * 0x01010101); } \
        else { _Pragma("unroll") for (int k = 0; k < 2; ++k) _c = __builtin_amdgcn_mfma_f32_16x16x32_bf16(Bt[n][k], At[m][k], _c, 0, 0, 0); } \
        acc_set(accw, ai, bj, m, n, _c); } \
        __builtin_amdgcn_s_setprio(0); } while (0)
#define PG8_WAIT_V(n) asm volatile("s_waitcnt vmcnt(" #n ")" ::: "memory")
#define PG8_WAIT_L(n) asm volatile("s_waitcnt lgkmcnt(" #n ")" ::: "memory")
#define PG8_BAR __builtin_amdgcn_s_barrier()
#define PG8_SCHED __builtin_amdgcn_sched_barrier(0)
    Unit cur, nxt; int ui = 0;
    if (!S.next(0, cur)) return;
    typedef int v4i_f __attribute__((ext_vector_type(4))); typedef int v8i_f __attribute__((ext_vector_type(8))); typedef f32x16 f32x16_f;
    AccW accw;
#pragma unroll
    for (int a = 0; a < 2; ++a)
#pragma unroll
        for (int b = 0; b < 2; ++b)
#pragma unroll
            for (int mp = 0; mp < 2; ++mp)
#pragma unroll
                for (int i = 0; i < 16; ++i) accw[a][b][mp][i] = 0.f;
    bf16x8 At[4][2], B0[2][2], B1[2][2];
    v8i_f At8[4], B08[2], B18[2];
#define PG8_F8(x) x##8
    const char* cA = (const char*)g.A + (size_t)cur.pm * tstepA + (size_t)cur.ko * 2; const char* cB = (const char*)g.Bt + (size_t)cur.pn * tstepB + (size_t)cur.ko * 2;
    S.a_ready(cur);
    if constexpr (SP2) {
        PG8_STAGE(PG8_SB(0, 0), cB, voffB); PG8_STAGE(PG8_SB(0, 1), cB + hstepB, voffB); PG8_STAGE(PG8_SA(0, 0), cA, voffA); PG8_STAGE(PG8_SA(0, 1), cA + hstepA, voffA);
        if (wr == 1) PG8_BAR;
        PG8_WAIT_V(2); PG8_BAR;
        PG8_STAGE(PG8_SB(1, 0), cB + kstep, voffB); PG8_STAGE(PG8_SA(1, 0), cA + kstep, voffA); PG8_STAGE(PG8_SB(1, 1), cB + hstepB + kstep, voffB);
        PG8_WAIT_V(6); PG8_BAR;
    } else {
        PG8_STAGE(PG8_SB(0, 0), cB, voffB); PG8_STAGE(PG8_SA(0, 0), cA, voffA); PG8_STAGE(PG8_SB(0, 1), cB + hstepB, voffB); PG8_STAGE(PG8_SA(0, 1), cA + hstepA, voffA);
        if (wr == 1) PG8_BAR;
        PG8_WAIT_V(4); PG8_BAR;
        PG8_STAGE(PG8_SB(1, 0), cB + kstep, voffB); PG8_STAGE(PG8_SA(1, 0), cA + kstep, voffA); PG8_STAGE(PG8_SB(1, 1), cB + hstepB + kstep, voffB);
        PG8_WAIT_V(6); PG8_BAR;
    }
    for (;;) {
        const bool has_next = S.next(ui + 1, nxt);
        const char* nA = has_next ? (const char*)g.A + (size_t)nxt.pm * tstepA + (size_t)nxt.ko * 2 : cA; const char* nB = has_next ? (const char*)g.Bt + (size_t)nxt.pn * tstepB + (size_t)nxt.ko * 2 : cB;
        for (int t = 0; t < nt; t += 2) {
            const bool last = (t == nt - 2);
            const char* a1 = cA + (size_t)(t + 1) * kstep;
            const char* a2 = last ? nA : cA + (size_t)(t + 2) * kstep; const char* b2 = last ? nB : cB + (size_t)(t + 2) * kstep;
            const char* a3 = a2 + kstep; const char* b3 = b2 + kstep;
            if (last && has_next) S.a_ready(nxt);
            if constexpr (SP2) {
            PG8_LDB(B0, 0, 0); PG8_LDB(B1, 0, 1); PG8_SCHED; PG8_LDA(At, 0, 0); PG8_STAGE(PG8_SA(1, 1), a1 + hstepA, voffA);
            PG8_WAIT_V(8); PG8_WAIT_L(0); PG8_BAR; PG8_MMA(0, 0, At, B0); PG8_MMA(0, 1, At, B1); PG8_BAR; PG8_SCHED;
            PG8_LDA(At, 0, 1); PG8_STAGE(PG8_SB(0, 0), b2, voffB); PG8_STAGE(PG8_SB(0, 1), b2 + hstepB, voffB); PG8_STAGE(PG8_SA(0, 0), a2, voffA);
            PG8_WAIT_V(8); PG8_WAIT_L(0); PG8_BAR; PG8_MMA(1, 0, At, B0); PG8_MMA(1, 1, At, B1); PG8_BAR; PG8_SCHED;
            PG8_LDB(B0, 1, 0); PG8_LDB(B1, 1, 1); PG8_SCHED; PG8_LDA(At, 1, 0); PG8_STAGE(PG8_SA(0, 1), a2 + hstepA, voffA);
            PG8_WAIT_V(8); PG8_WAIT_L(0); PG8_BAR; PG8_MMA(0, 0, At, B0); PG8_MMA(0, 1, At, B1); PG8_BAR; PG8_SCHED;
            PG8_LDA(At, 1, 1); PG8_STAGE(PG8_SB(1, 0), b3, voffB); PG8_STAGE(PG8_SB(1, 1), b3 + hstepB, voffB); PG8_STAGE(PG8_SA(1, 0), a3, voffA);
            PG8_WAIT_V(8); PG8_WAIT_L(0); PG8_BAR; PG8_MMA(1, 0, At, B0); PG8_MMA(1, 1, At, B1); PG8_BAR; PG8_SCHED;
            } else {
            PG8_LDB(B0, 0, 0); PG8_SCHED; PG8_LDA(At, 0, 0); PG8_STAGE(PG8_SA(1, 1), a1 + hstepA, voffA);
            PG8_WAIT_L(8); PG8_BAR; PG8_WAIT_L(0); PG8_MMA(0, 0, At, B0); PG8_BAR; PG8_SCHED;
            PG8_LDB(B1, 0, 1); PG8_STAGE(PG8_SB(0, 0), b2, voffB);
            PG8_BAR; PG8_WAIT_L(0); PG8_MMA(0, 1, At, B1); PG8_BAR;
            PG8_LDA(At, 0, 1); PG8_STAGE(PG8_SA(0, 0), a2, voffA);
            PG8_BAR; PG8_WAIT_L(0); PG8_MMA(1, 0, At, B0); PG8_BAR; PG8_SCHED;
            PG8_STAGE(PG8_SB(0, 1), b2 + hstepB, voffB);
            PG8_WAIT_V(6); PG8_BAR; PG8_MMA(1, 1, At, B1); PG8_BAR;
            PG8_LDB(B0, 1, 0); PG8_SCHED; PG8_LDA(At, 1, 0); PG8_STAGE(PG8_SA(0, 1), a2 + hstepA, voffA);
            PG8_WAIT_L(8); PG8_BAR; PG8_WAIT_L(0); PG8_MMA(0, 0, At, B0); PG8_BAR; PG8_SCHED;
            PG8_LDB(B1, 1, 1); PG8_STAGE(PG8_SB(1, 0), b3, voffB);
            PG8_BAR; PG8_WAIT_L(0); PG8_MMA(0, 1, At, B1); PG8_BAR;
            PG8_LDA(At, 1, 1); PG8_STAGE(PG8_SA(1, 0), a3, voffA);
            PG8_BAR; PG8_WAIT_L(0); PG8_MMA(1, 0, At, B0); PG8_BAR; PG8_SCHED;
            PG8_STAGE(PG8_SB(1, 1), b3 + hstepB, voffB);
            PG8_WAIT_V(6); PG8_BAR; PG8_MMA(1, 1, At, B1); PG8_BAR;
            }
        }
        if constexpr (ALIGN_EPI) { if (wr == 0) PG8_BAR; }
        if constexpr (!Epi::AFTER_DRAIN) { E(accw, cur, wr, wc, fr, fq); S.done(cur); }
        const bool keep_acc = Epi::TWOPASS && (cur.pass == 0);
        if (!has_next) break;
        if (!keep_acc) {
#pragma unroll
            for (int a = 0; a < 2; ++a)
#pragma unroll
                for (int b = 0; b < 2; ++b)
#pragma unroll
                    for (int mp = 0; mp < 2; ++mp)
#pragma unroll
                        for (int i = 0; i < 16; ++i) accw[a][b][mp][i] = 0.f;
        }
        cur = nxt; cA = nA; cB = nB; ++ui;
        if constexpr (ALIGN_EPI) { if (wr == 1) PG8_BAR; }
    }
    PG8_WAIT_V(0);
    if constexpr (!ALIGN_EPI) { if (wr == 0) PG8_BAR; }
    PG8_BAR;

#undef PG8_SA
#undef PG8_SB
#undef PG8_STAGE
#undef PG8_LDA
#undef PG8_LDB
#undef PG8_MMA
#undef PG8_F8
#undef PG8_WAIT_V
#undef PG8_WAIT_L
#undef PG8_BAR
#undef PG8_SCHED
}
}


constexpr int NWAVES = 8, NTHREADS = 512;
constexpr int BATCH = 8, SEQ = 4096, T = BATCH * SEQ, DM = 1024;
constexpr int INW = 5448;
constexpr int NPROJ = 5632;
constexpr int LD_HG = 2048, LD_ATT = 768, LD_IDX = 640, LD_GATE = 2048;
constexpr int TOPK = 256;
constexpr int NEXP = 16384;
constexpr float RMS_EPS = 1e-6f;

constexpr size_t MiB = 1u << 20;
constexpr size_t WS_CTL = 0;
constexpr size_t WS_MOD = MiB / 4;
constexpr size_t WS_MODP = MiB / 2;
constexpr size_t WS_WIN = 2 * MiB;
constexpr size_t WS_WQ = 17 * MiB;
constexpr size_t WS_SK = 21 * MiB;
constexpr size_t WS_U = 22 * MiB;
constexpr size_t WS_US = 30 * MiB;
constexpr size_t WS_V = 38 * MiB;
constexpr size_t WS_VS = 46 * MiB;
constexpr size_t WS_K8 = 48 * MiB;
constexpr size_t WS_QHI = 52 * MiB;
constexpr size_t WS_QLO = 68 * MiB;
constexpr size_t WS_WAB8 = 31 * MiB;
constexpr size_t WS_WOUT8 = 32 * MiB;
constexpr size_t WS_WIN8 = 33 * MiB;
constexpr size_t WS_H8 = 48 * MiB;
constexpr size_t WS_H = 86 * MiB;
constexpr size_t WS_HG = 150 * MiB;
constexpr size_t WS_ATT = 278 * MiB;
constexpr size_t WS_IDX = 326 * MiB;
constexpr size_t WS_GATE = 366 * MiB;
constexpr size_t WS_SEL = 494 * MiB;
constexpr size_t WS_END = 510 * MiB;
constexpr size_t WS_MERGED = WS_HG;
constexpr size_t WS_Q = 214 * MiB;
constexpr int H4_NT = 2;
constexpr size_t WS_H4D = 366 * MiB;
constexpr size_t WS_H4S = 416 * MiB;

constexpr int LDS_BYTES = 163840;

typedef unsigned short bf16;
typedef unsigned v4u __attribute__((ext_vector_type(4)));
typedef unsigned v2u __attribute__((ext_vector_type(2)));
typedef float f32x4 __attribute__((ext_vector_type(4)));
typedef float f32x2 __attribute__((ext_vector_type(2)));
typedef short bf16x8 __attribute__((ext_vector_type(8)));
#define LAS __attribute__((address_space(3)))

struct Params {
    const float *x, *c, *w_ada, *b_ada, *norm1_g, *norm2_g, *w_in, *hg_lb, *hg_onorm_g, *q_norm_g, *k_norm_g,
                *w_a, *w_b, *w_out, *peer_wq, *peer_subkeys, *peer_u, *peer_v;
    float* out; unsigned char* ws; int ph_lo, ph_hi;
};

typedef __bf16 bf16x2_hw __attribute__((ext_vector_type(2)));
__device__ __forceinline__ unsigned pk2(float lo, float hi) { const f32x2 v = {lo, hi}; const bf16x2_hw b = __builtin_convertvector(v, bf16x2_hw); return __builtin_bit_cast(unsigned, b); }
__device__ __forceinline__ unsigned f2bf(float f) { return pk2(f, 0.f) & 0xffffu; }
__device__ __forceinline__ float bf2f(unsigned u16v) { return __builtin_bit_cast(float, u16v << 16); }
__device__ __forceinline__ float bflo(unsigned w) { return __builtin_bit_cast(float, w << 16); }
__device__ __forceinline__ float bfhi(unsigned w) { return __builtin_bit_cast(float, w & 0xffff0000u); }
__device__ __forceinline__ float sigmoidf_(float x) { return __builtin_amdgcn_rcpf(1.f + __expf(-x)); }
__device__ __forceinline__ float siluf_(float x) { return x * __builtin_amdgcn_rcpf(1.f + __expf(-x)); }
__device__ __forceinline__ float wave_sum(float v) {
#pragma unroll
    for (int o = 1; o < 64; o <<= 1) v += __shfl_xor(v, o);
    return v;
}
__device__ __forceinline__ float wave_max(float v) {
#pragma unroll
    for (int o = 1; o < 64; o <<= 1) v = fmaxf(v, __shfl_xor(v, o));
    return v;
}
#define LDS_WAIT() asm volatile("s_waitcnt lgkmcnt(0)" ::: "memory")
__device__ __forceinline__ unsigned pk4_fp8(float a, float b, float c, float d) { int w = __builtin_amdgcn_cvt_pk_fp8_f32(a, b, 0, false); w = __builtin_amdgcn_cvt_pk_fp8_f32(c, d, w, true); return (unsigned)w; }

__host__ __device__ __forceinline__ int proj_tile_bf16(int i) { return i < 2 ? i + 2 : i + 6; }
__host__ __device__ __forceinline__ int proj_tile_fp8(int i) { return i < 2 ? i : (i < 6 ? i + 2 : i + 8); }
struct EpiProj {
    static constexpr bool PERM = true, AFTER_DRAIN = false, TWOPASS = false;
    bf16 *HG, *ATT, *IDX, *GATE; int f8;
    __device__ __forceinline__ void operator()(pg8::AccW& acc, const pg8::Unit& u, int wr, int wc, int fr, int fq) const {
        const int pn = f8 ? proj_tile_fp8(u.pn) : proj_tile_bf16(u.pn); bf16* base; int ldc, colt, ncols;
        if (pn < 8) { base = HG; ldc = LD_HG; colt = pn * 256; ncols = LD_HG; }
        else if (pn < 11) { base = ATT; ldc = LD_ATT; colt = (pn - 8) * 256; ncols = LD_ATT; }
        else if (pn < 14) { base = IDX; ldc = LD_IDX; colt = (pn - 11) * 256; ncols = LD_IDX; }
        else { base = GATE; ldc = LD_GATE; colt = (pn - 14) * 256; ncols = LD_GATE; }
        const int row0 = u.pm * 256 + wr * 64 + fr, col0 = colt + wc * 32 + 8 * fq;
#pragma unroll
        for (int ai = 0; ai < 2; ++ai)
#pragma unroll
            for (int m = 0; m < 4; ++m) { bf16* rowp = base + (size_t)(row0 + ai * 128 + m * 16) * ldc + col0;
#pragma unroll
                for (int bj = 0; bj < 2; ++bj) { const pg8::f32x4 v0 = pg8::acc_get(acc, ai, bj, m, 0), v1 = pg8::acc_get(acc, ai, bj, m, 1);
                    v4u w; w.x = pk2(v0[0], v0[1]); w.y = pk2(v0[2], v0[3]); w.z = pk2(v1[0], v1[1]); w.w = pk2(v1[2], v1[3]);
                    if (col0 + bj * 128 < ncols) *(v4u*)(rowp + bj * 128) = w; } }
    }
};
struct EpiMerged {
    static constexpr bool PERM = true, AFTER_DRAIN = false, TWOPASS = true;
    const bf16* GATE; bf16* O;
    __device__ __forceinline__ void operator()(pg8::AccW& acc, const pg8::Unit& u, int wr, int wc, int fr, int fq) const {
        const int row0 = u.pm * 256 + wr * 64 + fr, col0 = u.pn * 256 + wc * 32 + 8 * fq;
        if (u.pass == 0) {
#pragma unroll
            for (int ai = 0; ai < 2; ++ai)
#pragma unroll
                for (int m = 0; m < 4; ++m) { const bf16* rowp = GATE + (size_t)(row0 + ai * 128 + m * 16) * LD_GATE + col0;
#pragma unroll
                    for (int bj = 0; bj < 2; ++bj) { const v4u a = *(const v4u*)(rowp + bj * 128), b = *(const v4u*)(rowp + 1024 + bj * 128);
                        float r[8];
#pragma unroll
                        for (int i = 0; i < 4; ++i) { const float a0 = bflo(a[i]), a1 = bfhi(a[i]), b0 = bflo(b[i]), b1 = bfhi(b[i]);
                            r[2 * i] = (1.f + __expf(-b0)) * __builtin_amdgcn_rcpf(1.f + __expf(-a0)); r[2 * i + 1] = (1.f + __expf(-b1)) * __builtin_amdgcn_rcpf(1.f + __expf(-a1)); }
                        { pg8::f32x4 c0 = pg8::acc_get(acc, ai, bj, m, 0), c1 = pg8::acc_get(acc, ai, bj, m, 1);
#pragma unroll
                          for (int i = 0; i < 4; ++i) { c0[i] *= r[i]; c1[i] *= r[4 + i]; }
                          pg8::acc_set(acc, ai, bj, m, 0, c0); pg8::acc_set(acc, ai, bj, m, 1, c1); } } }
        } else {
#pragma unroll
            for (int ai = 0; ai < 2; ++ai)
#pragma unroll
                for (int m = 0; m < 4; ++m) { const size_t ro = (size_t)(row0 + ai * 128 + m * 16);
#pragma unroll
                    for (int bj = 0; bj < 2; ++bj) { const v4u b = *(const v4u*)(GATE + ro * LD_GATE + 1024 + col0 + bj * 128);
                        const pg8::f32x4 v0 = pg8::acc_get(acc, ai, bj, m, 0), v1 = pg8::acc_get(acc, ai, bj, m, 1);
                        float s[8];
#pragma unroll
                        for (int i = 0; i < 4; ++i) { s[2 * i] = sigmoidf_(bflo(b[i])); s[2 * i + 1] = sigmoidf_(bfhi(b[i])); }
                        v2u w; w.x = pk4_fp8(4.f * v0[0] * s[0], 4.f * v0[1] * s[1], 4.f * v0[2] * s[2], 4.f * v0[3] * s[3]); w.y = pk4_fp8(4.f * v1[0] * s[4], 4.f * v1[1] * s[5], 4.f * v1[2] * s[6], 4.f * v1[3] * s[7]);
                        *(v2u*)((unsigned char*)O + ro * 1024 + col0 + bj * 128) = w; } }
        }
    }
};
struct EpiResid {
    static constexpr bool PERM = true, AFTER_DRAIN = false, TWOPASS = false;
    const float* X; const float* G1  ; float* O;
    __device__ __forceinline__ void operator()(pg8::AccW& acc, const pg8::Unit& u, int wr, int wc, int fr, int fq) const {
        const int row0 = u.pm * 256 + wr * 64 + fr, col0 = u.pn * 256 + wc * 32 + 8 * fq;
        const int b = (u.pm * 256) / SEQ;
        f32x4 g[2][2];
#pragma unroll
        for (int bj = 0; bj < 2; ++bj)
#pragma unroll
            for (int n = 0; n < 2; ++n) g[bj][n] = *(const f32x4*)(G1 + (size_t)b * 6144 + col0 + bj * 128 + 4 * n);
#pragma unroll
        for (int ai = 0; ai < 2; ++ai)
#pragma unroll
            for (int m = 0; m < 4; ++m) { const size_t ro = (size_t)(row0 + ai * 128 + m * 16) * DM + col0;
#pragma unroll
                for (int bj = 0; bj < 2; ++bj)
#pragma unroll
                    for (int n = 0; n < 2; ++n) { const f32x4 xv = *(const f32x4*)(X + ro + bj * 128 + 4 * n);
                        *(f32x4*)(O + ro + bj * 128 + 4 * n) = xv + g[bj][n] * pg8::acc_get(acc, ai, bj, m, n); } }
    }
};
struct EpiStore {
    static constexpr bool PERM = true, AFTER_DRAIN = false, TWOPASS = false;
    bf16* O; int ldc;
    __device__ __forceinline__ void operator()(pg8::AccW& acc, const pg8::Unit& u, int wr, int wc, int fr, int fq) const {
        const int row0 = u.pm * 256 + wr * 64 + fr, col0 = u.pn * 256 + wc * 32 + 8 * fq;
#pragma unroll
        for (int ai = 0; ai < 2; ++ai)
#pragma unroll
            for (int m = 0; m < 4; ++m) { bf16* rowp = O + (size_t)(row0 + ai * 128 + m * 16) * ldc + col0;
#pragma unroll
                for (int bj = 0; bj < 2; ++bj) { const pg8::f32x4 v0 = pg8::acc_get(acc, ai, bj, m, 0), v1 = pg8::acc_get(acc, ai, bj, m, 1);
                    v4u w; w.x = pk2(v0[0], v0[1]); w.y = pk2(v0[2], v0[3]); w.z = pk2(v1[0], v1[1]); w.w = pk2(v1[2], v1[3]);
                    *(v4u*)(rowp + bj * 128) = w; } }
    }
};

template <int MODE> __device__ __forceinline__ int srcmap(int np) {
    if (MODE == 2) np = proj_tile_bf16(np >> 8) * 256 + (np & 255);
    if (MODE == 3) np = proj_tile_fp8(np >> 8) * 256 + (np & 255);
    if (MODE >= 1) return np < 3400 ? np : (np >= 3584 ? np - 184 : -1);
    return np; }
template <int MODE>
__device__ __forceinline__ void transpose_item(const float* W, int N, bf16* WT, int ldw, int koff, float* scr, int kb, int nb, int lane) {
    const int k0 = 64 * kb, n0 = 32 * nb;
    const int sc = srcmap<MODE>(n0 + (lane & 31));
#pragma unroll 8
    for (int i = 0; i < 32; ++i) { const int kk = 2 * i + (lane >> 5); scr[kk * 33 + (lane & 31)] = (sc >= 0) ? W[(size_t)(k0 + kk) * N + sc] : 0.f; }
    LDS_WAIT(); __builtin_amdgcn_wave_barrier();
    const int c = lane & 7;
#pragma unroll
    for (int j = 0; j < 4; ++j) { const int n = (lane >> 3) + 8 * j; const float* s = scr + (8 * c) * 33 + n;
        v4u o; o.x = pk2(s[0 * 33], s[1 * 33]); o.y = pk2(s[2 * 33], s[3 * 33]); o.z = pk2(s[4 * 33], s[5 * 33]); o.w = pk2(s[6 * 33], s[7 * 33]);
        *(v4u*)(WT + (size_t)(n0 + n) * ldw + koff + k0 + 8 * c) = o; }
    LDS_WAIT(); __builtin_amdgcn_wave_barrier();
}
template <int MODE> __device__ __forceinline__ int srcmap(int np);
template <int MODE = 0>
__device__ __forceinline__ void transpose_item8(const float* W, int N, unsigned char* WT, int ldw, int koff, float scale, float* scr, int kb, int nb, int lane) {
    const int k0 = 64 * kb, n0 = 32 * nb;
    const int sc = srcmap<MODE>(n0 + (lane & 31));
#pragma unroll 8
    for (int i = 0; i < 32; ++i) { const int kk = 2 * i + (lane >> 5); scr[kk * 33 + (lane & 31)] = (sc >= 0) ? W[(size_t)(k0 + kk) * N + sc] * scale : 0.f; }
    LDS_WAIT(); __builtin_amdgcn_wave_barrier();
    const int c = lane & 3;
#pragma unroll
    for (int j = 0; j < 2; ++j) { const int n = (lane >> 2) + 16 * j; const float* sp = scr + (16 * c) * 33 + n;
        v4u o;
#pragma unroll
        for (int q = 0; q < 4; ++q) o[q] = pk4_fp8(sp[(4 * q) * 33], sp[(4 * q + 1) * 33], sp[(4 * q + 2) * 33], sp[(4 * q + 3) * 33]);
        *(v4u*)(WT + (size_t)(n0 + n) * ldw + koff + k0 + 16 * c) = o; }
    LDS_WAIT(); __builtin_amdgcn_wave_barrier();
}
__device__ __forceinline__ void convert_plain(const float* src, bf16* dst, size_t n, size_t gtid, size_t nth) {
    const size_t n8 = n / 8;
    for (size_t i = gtid; i < n8; i += nth) { const f32x4 a = ((const f32x4*)src)[2 * i], b = ((const f32x4*)src)[2 * i + 1];
        v4u o; o.x = pk2(a[0], a[1]); o.y = pk2(a[2], a[3]); o.z = pk2(b[0], b[1]); o.w = pk2(b[2], b[3]); ((v4u*)dst)[i] = o; }
}
__device__ __forceinline__ void convert_fp8(const float* src, unsigned char* dst, size_t n, float scale, size_t gtid, size_t nth) {
    const size_t n16 = n / 16;
    for (size_t i = gtid; i < n16; i += nth) { const f32x4* sp = (const f32x4*)src + 4 * i; const f32x4 a = sp[0] * scale, b = sp[1] * scale, c = sp[2] * scale, d = sp[3] * scale;
        v4u o; o.x = pk4_fp8(a[0], a[1], a[2], a[3]); o.y = pk4_fp8(b[0], b[1], b[2], b[3]); o.z = pk4_fp8(c[0], c[1], c[2], c[3]); o.w = pk4_fp8(d[0], d[1], d[2], d[3]); ((v4u*)dst)[i] = o; }
}
template <bool KKMAJOR>
__device__ __forceinline__ void convert_mxfp4(const float* src, unsigned char* dst, unsigned char* scl, size_t nrows, size_t gtid, size_t nth) {
    const size_t nblk = nrows * 32;
    for (size_t i = gtid; i < nblk; i += nth) {
        const size_t row = i >> 5; const int blk = (int)(i & 31);
        const f32x4* sp = (const f32x4*)(src + row * 1024 + blk * 32);
        f32x4 v[8]; float amax = 0.f;
#pragma unroll
        for (int j = 0; j < 8; ++j) { v[j] = sp[j]; amax = fmaxf(fmaxf(fmaxf(fabsf(v[j][0]), fabsf(v[j][1])), fmaxf(fabsf(v[j][2]), fabsf(v[j][3]))), amax); }
        int e = (int)((__builtin_bit_cast(unsigned, amax) >> 23) & 0xffu) - 127 - 2;
        if (e < -126) e = -126;
        const float inv = __builtin_bit_cast(float, (unsigned)(127 - e) << 23);
        unsigned w[4] = {0u, 0u, 0u, 0u};
#pragma unroll
        for (int j = 0; j < 8; j += 2) { unsigned t = 0u;
            t = __builtin_amdgcn_cvt_scalef32_pk_fp4_f32(t, v[j][0] * inv, v[j][1] * inv, 1.0f, 0);
            t = __builtin_amdgcn_cvt_scalef32_pk_fp4_f32(t, v[j][2] * inv, v[j][3] * inv, 1.0f, 1);
            t = __builtin_amdgcn_cvt_scalef32_pk_fp4_f32(t, v[j + 1][0] * inv, v[j + 1][1] * inv, 1.0f, 2);
            t = __builtin_amdgcn_cvt_scalef32_pk_fp4_f32(t, v[j + 1][2] * inv, v[j + 1][3] * inv, 1.0f, 3);
            w[j >> 1] = t; }
        *(v4u*)(dst + row * 512 + blk * 16) = (v4u){w[0], w[1], w[2], w[3]};
        scl[row * 32 + (KKMAJOR ? ((blk & 3) * 8 + (blk >> 2)) : blk)] = (unsigned char)(e + 127);
    }
}
__device__ __forceinline__ void phase0(const Params& p, unsigned char* lds) {
    const int tid = threadIdx.x, wave = tid >> 6, lane = tid & 63, G = gridDim.x;
    const int gw = blockIdx.x * NWAVES + wave, NGW = G * NWAVES;
    float* scr = (float*)(lds + wave * 16384);
    unsigned char* ws = p.ws;
    constexpr int I_IN = 16 * (2048 / 32), I_IN8 = 16 * (3584 / 32), I_A = 8 * 32, I_O = 16 * 32, I_Q = 16 * 64;
    constexpr int NT = I_IN + I_IN8 + 2 * I_A + I_O + I_Q;
    for (int it = gw; it < NT; it += NGW) {
        int r = it;
        if (r < I_IN) { transpose_item<2>(p.w_in, INW, (bf16*)(ws + WS_WIN), 1024, 0, scr, r / 64, r % 64, lane); continue; } r -= I_IN;
        if (r < I_IN8) { transpose_item8<3>(p.w_in, INW, ws + WS_WIN8, 1024, 0, 32.f, scr, r / 112, r % 112, lane); continue; } r -= I_IN8;
        if (r < I_A) { transpose_item8(p.w_a, 1024, ws + WS_WAB8, 1024, 0, 32.f, scr, r / 32, r % 32, lane); continue; } r -= I_A;
        if (r < I_A) { transpose_item8(p.w_b, 1024, ws + WS_WAB8, 1024, 512, 4.f, scr, r / 32, r % 32, lane); continue; } r -= I_A;
        if (r < I_O) { transpose_item8(p.w_out, 1024, ws + WS_WOUT8, 1024, 0, 32.f, scr, r / 32, r % 32, lane); continue; } r -= I_O;
        transpose_item<0>(p.peer_wq, 2048, (bf16*)(ws + WS_WQ), 1024, 0, scr, r / 64, r % 64, lane);
    }
    for (int it = gw; it < 96 * 8; it += NGW) {
        const int cgp = it % 96, ks = it / 96, col = cgp * 64 + lane, k0 = ks * 128;
#pragma unroll
        for (int i = 0; i < 16; ++i) { const int e = i * 64 + lane, b = e >> 7, k = e & 127; scr[e] = siluf_(p.c[b * 1024 + k0 + k]); }
        LDS_WAIT(); __builtin_amdgcn_wave_barrier();
        float acc[8];
#pragma unroll
        for (int b = 0; b < 8; ++b) acc[b] = 0.f;
#pragma unroll 4
        for (int k = 0; k < 128; ++k) { const float w = p.w_ada[(size_t)(k0 + k) * 6144 + col];
#pragma unroll
            for (int b = 0; b < 8; ++b) acc[b] += scr[b * 128 + k] * w; }
        float* mp = (float*)(ws + WS_MODP) + (size_t)ks * 8 * 6144 + col;
#pragma unroll
        for (int b = 0; b < 8; ++b) mp[b * 6144] = acc[b];
        LDS_WAIT(); __builtin_amdgcn_wave_barrier();
    }
    const size_t gtid = (size_t)blockIdx.x * NTHREADS + tid, nth = (size_t)G * NTHREADS;
    convert_plain(p.peer_subkeys, (bf16*)(ws + WS_SK), (size_t)16 * 128 * 128, gtid, nth);
    convert_mxfp4<true>(p.peer_u, ws + WS_U, ws + WS_US, (size_t)NEXP, gtid, nth);
    convert_mxfp4<false>(p.peer_v, ws + WS_V, ws + WS_VS, (size_t)NEXP, gtid, nth);
}

template <bool FIRST>
__device__ __forceinline__ void normmod_phase(const Params& p, unsigned char* lds, const float* src, bf16* dst, const float* gvec, int shift_off, int scale_off) {
    const int tid = threadIdx.x, wave = tid >> 6, lane = tid & 63, G = gridDim.x;
    unsigned char* ws = p.ws;
    float* A = (float*)lds;
    float* Bv = A + 1024;
    const float* MODP = (const float*)(ws + WS_MODP);
    float* MOD = (float*)(ws + WS_MOD);
    if (FIRST) {
        for (int e = blockIdx.x * NTHREADS + tid; e < 8 * 6144; e += G * NTHREADS) { const int col = e % 6144; float s = p.b_ada[col];
#pragma unroll
            for (int ks = 0; ks < 8; ++ks) s += MODP[(size_t)ks * 8 * 6144 + e];
            MOD[e] = s; }
    }
    int curb = -1;
    for (int chunk = blockIdx.x; chunk < T / 128; chunk += G) {
        const int b = (chunk * 128) / SEQ;
        if (b != curb) {
            __syncthreads();
            for (int col = tid; col < 1024; col += NTHREADS) {
                float sc, sh;
                if (FIRST) { sc = p.b_ada[scale_off + col]; sh = p.b_ada[shift_off + col];
#pragma unroll
                    for (int ks = 0; ks < 8; ++ks) { sc += MODP[(size_t)(ks * 8 + b) * 6144 + scale_off + col]; sh += MODP[(size_t)(ks * 8 + b) * 6144 + shift_off + col]; } }
                else { sc = MOD[b * 6144 + scale_off + col]; sh = MOD[b * 6144 + shift_off + col]; }
                A[col] = gvec[col] * (1.f + sc); Bv[col] = sh; }
            __syncthreads(); curb = b;
        }
        for (int r = wave; r < 128; r += NWAVES) {
            const size_t row = (size_t)chunk * 128 + r;
            const f32x4* xr = (const f32x4*)(src + row * DM) + lane;
            f32x4 v[4]; float s = 0.f;
#pragma unroll
            for (int j = 0; j < 4; ++j) { v[j] = xr[64 * j]; s += (v[j][0] * v[j][0] + v[j][1] * v[j][1]) + (v[j][2] * v[j][2] + v[j][3] * v[j][3]); }
            const float rstd = rsqrtf(wave_sum(s) * (1.f / DM) + RMS_EPS);
            v2u* o8 = (v2u*)(dst + row * DM) + lane;
#pragma unroll
            for (int j = 0; j < 4; ++j) { const int c0 = 4 * lane + 256 * j; const f32x4 a = *(const f32x4*)(A + c0), sh = *(const f32x4*)(Bv + c0);
                v2u o; o.x = pk2(v[j][0] * rstd * a[0] + sh[0], v[j][1] * rstd * a[1] + sh[1]); o.y = pk2(v[j][2] * rstd * a[2] + sh[2], v[j][3] * rstd * a[3] + sh[3]);
                o8[64 * j] = o;
                if (FIRST) *(unsigned*)(ws + WS_H8 + row * DM + c0) = pk4_fp8(v[j][0] * rstd * a[0] + sh[0], v[j][1] * rstd * a[1] + sh[1], v[j][2] * rstd * a[2] + sh[2], v[j][3] * rstd * a[3] + sh[3]);
                if (!FIRST) { float* st = (float*)(lds + 8192) + wave * 1056;
                    const float y0 = v[j][0] * rstd * a[0] + sh[0], y1 = v[j][1] * rstd * a[1] + sh[1], y2 = v[j][2] * rstd * a[2] + sh[2], y3 = v[j][3] * rstd * a[3] + sh[3];
                    const int pc = c0 + (c0 >> 5); st[pc] = y0; st[pc + 1] = y1; st[pc + 2] = y2; st[pc + 3] = y3; } }
            if (!FIRST) {
                const float* st = (const float*)(lds + 8192) + wave * 1056;
                LDS_WAIT(); __builtin_amdgcn_wave_barrier();
                if (lane < 32) {
                    float x[32];
#pragma unroll
                    for (int k = 0; k < 32; ++k) x[k] = st[lane * 33 + k];
#pragma unroll
                    for (int t = 0; t < H4_NT; ++t) {
                        float amax = 0.f;
#pragma unroll
                        for (int k = 0; k < 32; ++k) amax = fmaxf(amax, fabsf(x[k]));
                        int e = (int)((__builtin_bit_cast(unsigned, amax) >> 23) & 0xffu) - 127 - 2; if (e < -126) e = -126;
                        const float inv = __builtin_bit_cast(float, (unsigned)(127 - e) << 23), sc = __builtin_bit_cast(float, (unsigned)(127 + e) << 23);
                        unsigned w[4];
#pragma unroll
                        for (int r = 0; r < 4; ++r) { unsigned tw = 0u;
                            tw = __builtin_amdgcn_cvt_scalef32_pk_fp4_f32(tw, x[8 * r] * inv, x[8 * r + 1] * inv, 1.0f, 0);
                            tw = __builtin_amdgcn_cvt_scalef32_pk_fp4_f32(tw, x[8 * r + 2] * inv, x[8 * r + 3] * inv, 1.0f, 1);
                            tw = __builtin_amdgcn_cvt_scalef32_pk_fp4_f32(tw, x[8 * r + 4] * inv, x[8 * r + 5] * inv, 1.0f, 2);
                            tw = __builtin_amdgcn_cvt_scalef32_pk_fp4_f32(tw, x[8 * r + 6] * inv, x[8 * r + 7] * inv, 1.0f, 3);
                            w[r] = tw;
                            const f32x2 d0 = __builtin_amdgcn_cvt_scalef32_pk_f32_fp4(tw, 1.0f, 0), d1 = __builtin_amdgcn_cvt_scalef32_pk_f32_fp4(tw, 1.0f, 1), d2 = __builtin_amdgcn_cvt_scalef32_pk_f32_fp4(tw, 1.0f, 2), d3 = __builtin_amdgcn_cvt_scalef32_pk_f32_fp4(tw, 1.0f, 3);
                            x[8 * r] -= d0[0] * sc; x[8 * r + 1] -= d0[1] * sc; x[8 * r + 2] -= d1[0] * sc; x[8 * r + 3] -= d1[1] * sc;
                            x[8 * r + 4] -= d2[0] * sc; x[8 * r + 5] -= d2[1] * sc; x[8 * r + 6] -= d3[0] * sc; x[8 * r + 7] -= d3[1] * sc; }
                        *(v4u*)(ws + WS_H4D + (row * H4_NT + t) * 512 + lane * 16) = (v4u){w[0], w[1], w[2], w[3]};
                        *(ws + WS_H4S + (row * H4_NT + t) * 32 + (lane & 3) * 8 + (lane >> 2)) = (unsigned char)(e + 127);
                    }
                }
                LDS_WAIT(); __builtin_amdgcn_wave_barrier();
            }
        }
    }
    __syncthreads();
}

constexpr int HGL_QT = 0, HGL_KT = 17408, HGL_QE = 34816, HGL_KLT = 52224, HGL_VT = 70656, HGL_AM = 89088, HGL_DEC = 98304, HGL_TOT = 98816, HGL_SSQ = 100864;
constexpr int HG_LDR = 136;
constexpr int HG_LDC = 72;
__device__ __forceinline__ void hgrn_item(const Params& p, unsigned char* lds, int item) {
    const int b = item >> 2, h = item & 3;
    const int tid = threadIdx.x, w = tid >> 6, lane = tid & 63, fr = lane & 15, fq = lane >> 4;
    unsigned char* ws = p.ws;
    const bf16* HG = (const bf16*)(ws + WS_HG);
    bf16* YA = (bf16*)(ws + WS_H);
    bf16* QT = (bf16*)(lds + HGL_QT); bf16* KT = (bf16*)(lds + HGL_KT); bf16* QE = (bf16*)(lds + HGL_QE);
    bf16* KLT = (bf16*)(lds + HGL_KLT); bf16* VT = (bf16*)(lds + HGL_VT); bf16* AM = (bf16*)(lds + HGL_AM);
    float* DEC = (float*)(lds + HGL_DEC); float* TOT = (float*)(lds + HGL_TOT); float* SSQ = (float*)(lds + HGL_SSQ);
    const int pd = tid & 127, pq = tid >> 7;
    float lbv; { const float a0 = p.hg_lb[h * 128 + pd], a1 = p.hg_lb[512 + h * 128 + pd]; lbv = 1.f / (1.f + __expf(a1 - a0)); }
    const int e0 = w * 16;
    const float ogv = p.hg_onorm_g[e0 + fr];
    pg8::f32x4 S[8];
#pragma unroll
    for (int i = 0; i < 8; ++i) S[i] = (pg8::f32x4){0.f, 0.f, 0.f, 0.f};
    const size_t rowb = (size_t)b * SEQ;
    unsigned short rq[16], rf[16], rv[16];
    { const bf16* gp = HG + (rowb + pq * 16) * LD_HG + h * 128 + pd;
#pragma unroll
      for (int i = 0; i < 16; ++i) { rq[i] = gp[(size_t)i * LD_HG]; rf[i] = gp[(size_t)i * LD_HG + 512]; rv[i] = gp[(size_t)i * LD_HG + 1024]; } }
    for (int chunk = 0; chunk < SEQ / 64; ++chunk) {
        const size_t row0 = rowb + (size_t)chunk * 64;
        float fq_[16], kq_[16], cs[16];
        float run = 0.f;
#pragma unroll
        for (int i = 0; i < 16; ++i) { const float f = lbv + (1.f - lbv) * sigmoidf_(bf2f(rf[i])); kq_[i] = 1.f - f; run += __logf(f); cs[i] = run; fq_[i] = siluf_(bf2f(rq[i])); }
        TOT[pq * 128 + pd] = run;
        { v4u v0, v1;
          v0.x = rv[0] | ((unsigned)rv[1] << 16); v0.y = rv[2] | ((unsigned)rv[3] << 16); v0.z = rv[4] | ((unsigned)rv[5] << 16); v0.w = rv[6] | ((unsigned)rv[7] << 16);
          v1.x = rv[8] | ((unsigned)rv[9] << 16); v1.y = rv[10] | ((unsigned)rv[11] << 16); v1.z = rv[12] | ((unsigned)rv[13] << 16); v1.w = rv[14] | ((unsigned)rv[15] << 16);
          *(v4u*)(VT + pd * HG_LDC + pq * 16) = v0; *(v4u*)(VT + pd * HG_LDC + pq * 16 + 8) = v1; }
        unsigned short rg[16];
#pragma unroll
        for (int i = 0; i < 16; ++i) rg[i] = HG[(row0 + (i >> 2) * 16 + fq * 4 + (i & 3)) * LD_HG + 1536 + h * 128 + e0 + fr];
        if (chunk + 1 < SEQ / 64) { const bf16* gp = HG + (row0 + 64 + pq * 16) * LD_HG + h * 128 + pd;
#pragma unroll
            for (int i = 0; i < 16; ++i) { rq[i] = gp[(size_t)i * LD_HG]; rf[i] = gp[(size_t)i * LD_HG + 512]; rv[i] = gp[(size_t)i * LD_HG + 1024]; } }
        __syncthreads();
        const float t0 = TOT[pd], t1 = TOT[128 + pd], t2 = TOT[256 + pd], t3 = TOT[384 + pd];
        const float base = (pq > 0 ? t0 : 0.f) + (pq > 1 ? t1 : 0.f) + (pq > 2 ? t2 : 0.f);
        const float bmid = t0 + t1, blast = (t0 + t1) + (t2 + t3);
        const float emid = __expf(bmid), elm = __expf(blast - bmid);
        if (pq == 0) DEC[pd] = __expf(blast);
        { unsigned klp[8];
#pragma unroll
          for (int i = 0; i < 16; ++i) { const float bb = base + cs[i]; const float E1 = __expf(bb - bmid), R1 = __builtin_amdgcn_rcpf(E1);
              const float qtv = fq_[i] * E1, ktv = kq_[i] * R1, qev = qtv * emid, klv = ktv * elm;
              const int srow = pq * 16 + i;
              QT[srow * HG_LDR + pd] = (bf16)f2bf(qtv); KT[srow * HG_LDR + pd] = (bf16)f2bf(ktv); QE[srow * HG_LDR + pd] = (bf16)f2bf(qev);
              if (i & 1) klp[i >> 1] |= f2bf(klv) << 16; else klp[i >> 1] = f2bf(klv); }
          *(v4u*)(KLT + pd * HG_LDC + pq * 16) = (v4u){klp[0], klp[1], klp[2], klp[3]}; *(v4u*)(KLT + pd * HG_LDC + pq * 16 + 8) = (v4u){klp[4], klp[5], klp[6], klp[7]}; }
        __syncthreads();
#pragma unroll
        for (int tt = 0; tt < 2; ++tt) { const int id = w + 8 * tt, rt = id >> 2, ct = id & 3;
            pg8::f32x4 a = {0.f, 0.f, 0.f, 0.f};
            if (ct <= rt) {
#pragma unroll
                for (int ks = 0; ks < 4; ++ks) { const bf16x8 af = *(const bf16x8*)(QT + (rt * 16 + fr) * HG_LDR + ks * 32 + fq * 8), bfv = *(const bf16x8*)(KT + (ct * 16 + fr) * HG_LDR + ks * 32 + fq * 8);
                    a = __builtin_amdgcn_mfma_f32_16x16x32_bf16(af, bfv, a, 0, 0, 0); } }
#pragma unroll
            for (int r = 0; r < 4; ++r) { const int c = rt * 16 + fq * 4 + r, sidx = ct * 16 + fr; AM[c * HG_LDC + sidx] = (bf16)((sidx <= c) ? f2bf(a[r]) : 0u); } }
        __syncthreads();
        const bf16x8 vb0 = *(const bf16x8*)(VT + (e0 + fr) * HG_LDC + fq * 8), vb1 = *(const bf16x8*)(VT + (e0 + fr) * HG_LDC + 32 + fq * 8);
        bf16x8 sb[4];
#pragma unroll
        for (int ks = 0; ks < 4; ++ks) { v4u t; t.x = pk2(S[2 * ks][0], S[2 * ks][1]); t.y = pk2(S[2 * ks][2], S[2 * ks][3]); t.z = pk2(S[2 * ks + 1][0], S[2 * ks + 1][1]); t.w = pk2(S[2 * ks + 1][2], S[2 * ks + 1][3]); sb[ks] = __builtin_bit_cast(bf16x8, t); }
        pg8::f32x4 o[4];
#pragma unroll
        for (int rt = 0; rt < 4; ++rt) { pg8::f32x4 a = {0.f, 0.f, 0.f, 0.f};
            a = __builtin_amdgcn_mfma_f32_16x16x32_bf16(*(const bf16x8*)(AM + (rt * 16 + fr) * HG_LDC + fq * 8), vb0, a, 0, 0, 0);
            a = __builtin_amdgcn_mfma_f32_16x16x32_bf16(*(const bf16x8*)(AM + (rt * 16 + fr) * HG_LDC + 32 + fq * 8), vb1, a, 0, 0, 0);
#pragma unroll
            for (int ks = 0; ks < 4; ++ks) { const v2u lo = *(const v2u*)(QE + (rt * 16 + fr) * HG_LDR + ks * 32 + fq * 4), hi = *(const v2u*)(QE + (rt * 16 + fr) * HG_LDR + ks * 32 + 16 + fq * 4);
                const v4u t = {lo.x, lo.y, hi.x, hi.y};
                a = __builtin_amdgcn_mfma_f32_16x16x32_bf16(__builtin_bit_cast(bf16x8, t), sb[ks], a, 0, 0, 0); }
            o[rt] = a; }
#pragma unroll
        for (int dt = 0; dt < 8; ++dt) { const f32x4 dc = *(const f32x4*)(DEC + dt * 16 + fq * 4);
            pg8::f32x4 a = S[dt]; a[0] *= dc[0]; a[1] *= dc[1]; a[2] *= dc[2]; a[3] *= dc[3];
            a = __builtin_amdgcn_mfma_f32_16x16x32_bf16(*(const bf16x8*)(KLT + (dt * 16 + fr) * HG_LDC + fq * 8), vb0, a, 0, 0, 0);
            a = __builtin_amdgcn_mfma_f32_16x16x32_bf16(*(const bf16x8*)(KLT + (dt * 16 + fr) * HG_LDC + 32 + fq * 8), vb1, a, 0, 0, 0);
            S[dt] = a; }
#pragma unroll
        for (int rt = 0; rt < 4; ++rt)
#pragma unroll
            for (int r = 0; r < 4; ++r) { float x = o[rt][r] * o[rt][r];
                x += __shfl_xor(x, 1); x += __shfl_xor(x, 2); x += __shfl_xor(x, 4); x += __shfl_xor(x, 8);
                if (fr == 0) SSQ[w * 64 + rt * 16 + fq * 4 + r] = x; }
        __syncthreads();
        float tot = 0.f;
#pragma unroll
        for (int ww = 0; ww < 8; ++ww) tot += SSQ[ww * 64 + lane];
        const float rstd_l = rsqrtf(tot * (1.f / 128.f) + RMS_EPS);
#pragma unroll
        for (int rt = 0; rt < 4; ++rt)
#pragma unroll
            for (int r = 0; r < 4; ++r) { const int c = rt * 16 + fq * 4 + r; const float rs = __shfl(rstd_l, c);
                const float y = o[rt][r] * rs * ogv * siluf_(bf2f(rg[rt * 4 + r]));
                ((unsigned char*)YA)[(row0 + c) * 1024 + h * 128 + e0 + fr] = (unsigned char)(__builtin_amdgcn_cvt_pk_fp8_f32(y, 0.f, 0, false) & 0xff); }
    }
    __syncthreads();
}

__device__ __forceinline__ unsigned f16key(float x) {
    x = x + 0.f;
    const _Float16 hx = (_Float16)x; const unsigned short bits = __builtin_bit_cast(unsigned short, hx);
    return (bits & 0x8000u) ? (unsigned)(unsigned short)(~bits) : (unsigned)(bits | 0x8000u);
}
__device__ __forceinline__ void find_bin(const unsigned* hist, int K, int lane, int& bin, int& rem) {
    const v4u hv = *(const v4u*)(hist + 4 * lane);
    const unsigned c = hv.x + hv.y + hv.z + hv.w;
    unsigned suf = c;
#pragma unroll
    for (int o = 1; o < 64; o <<= 1) { const unsigned t = __shfl_down(suf, o); if (lane + o < 64) suf += t; }
    const unsigned above = suf - c;
    const bool mine = (above < (unsigned)K) && ((unsigned)K <= suf);
    int mybin = 0, myrem = 0;
    if (mine) { unsigned ca = above; const unsigned hh[4] = {hv.x, hv.y, hv.z, hv.w}; bool found = false;
#pragma unroll
        for (int i = 3; i >= 0; --i) { if (!found) { if (ca + hh[i] >= (unsigned)K) { mybin = 4 * lane + i; myrem = K - (int)ca; found = true; } else ca += hh[i]; } } }
    const unsigned long long m = __ballot(mine);
    const int src = (int)__builtin_ctzll(m | (1ull << 63));
    bin = __shfl(mybin, src); rem = __shfl(myrem, src);
}
__device__ __forceinline__ void dsa1_item(const Params& p, unsigned char* lds, int item) {
    const int b = item >> 8, q0 = (item & 255) * 16;
    const int tid = threadIdx.x, w = tid >> 6, lane = tid & 63, fr = lane & 15, fq = lane >> 4;
    unsigned char* ws = p.ws;
    const bf16* IDX = (const bf16*)(ws + WS_IDX);
    unsigned short* Ik = (unsigned short*)lds;
    unsigned* hist1 = (unsigned*)(lds + 131072);
    unsigned* hist = (unsigned*)(lds + 131072 + 16384) + w * 256;
    const size_t rowb = (size_t)b * SEQ;
    *(v4u*)(hist1 + tid * 4) = (v4u){0u, 0u, 0u, 0u}; *(v4u*)(hist1 + 2048 + tid * 4) = (v4u){0u, 0u, 0u, 0u};
    bf16x8 Af[8][2];
    { const bf16* rp = IDX + (rowb + q0 + fr) * LD_IDX + fq * 8;
#pragma unroll
      for (int h = 0; h < 8; ++h) { Af[h][0] = *(const bf16x8*)(rp + h * 64); Af[h][1] = *(const bf16x8*)(rp + h * 64 + 32); } }
    const float idx_scale = 0.5f * 0.125f * 0.35355339059327373f;
    bf16x8 Aw[2];
    { float wa[8];
      { const v4u wq = *(const v4u*)(IDX + (rowb + q0 + fr) * LD_IDX + 576);
#pragma unroll
        for (int i = 0; i < 4; ++i) { wa[2 * i] = bflo(wq[i]) * idx_scale; wa[2 * i + 1] = bfhi(wq[i]) * idx_scale; } }
#pragma unroll
      for (int ks = 0; ks < 2; ++ks) { float cq[8];
#pragma unroll
          for (int j = 0; j < 8; ++j) cq[j] = 0.f;
#pragma unroll
          for (int h = 0; h < 8; ++h)
#pragma unroll
              for (int j = 0; j < 8; ++j) cq[j] += wa[h] * bf2f((unsigned)(unsigned short)Af[h][ks][j]);
          const v4u t = {pk2(cq[0], cq[1]), pk2(cq[2], cq[3]), pk2(cq[4], cq[5]), pk2(cq[6], cq[7])};
          Aw[ks] = __builtin_bit_cast(bf16x8, t); } }
    float wv[4][8];
#pragma unroll
    for (int r = 0; r < 4; ++r) { const v4u wq = *(const v4u*)(IDX + (rowb + q0 + fq * 4 + r) * LD_IDX + 576);
#pragma unroll
        for (int i = 0; i < 4; ++i) { wv[r][2 * i] = bflo(wq[i]) * idx_scale; wv[r][2 * i + 1] = bfhi(wq[i]) * idx_scale; } }
    const int ntiles = (q0 >> 4) + 1;
    __syncthreads();
    bf16x8 B0 = Aw[0], B1 = Aw[1];
    if (w < ntiles) { const bf16* kp = IDX + (rowb + w * 16 + fr) * LD_IDX + 512 + fq * 8; B0 = *(const bf16x8*)kp; B1 = *(const bf16x8*)(kp + 32); }
    for (int kt = w; kt < ntiles; kt += NWAVES) {
        bf16x8 nB0 = B0, nB1 = B1;
        if (kt + NWAVES < ntiles) { const bf16* kp = IDX + (rowb + (kt + NWAVES) * 16 + fr) * LD_IDX + 512 + fq * 8; nB0 = *(const bf16x8*)kp; nB1 = *(const bf16x8*)(kp + 32); }
        pg8::f32x4 lin = {0.f, 0.f, 0.f, 0.f};
        lin = __builtin_amdgcn_mfma_f32_16x16x32_bf16(Aw[0], B0, lin, 0, 0, 0);
        lin = __builtin_amdgcn_mfma_f32_16x16x32_bf16(Aw[1], B1, lin, 0, 0, 0);
        float I[4] = {lin[0], lin[1], lin[2], lin[3]};
#pragma unroll
        for (int h = 0; h < 8; ++h) { pg8::f32x4 a = {0.f, 0.f, 0.f, 0.f};
            a = __builtin_amdgcn_mfma_f32_16x16x32_bf16(Af[h][0], B0, a, 0, 0, 0);
            a = __builtin_amdgcn_mfma_f32_16x16x32_bf16(Af[h][1], B1, a, 0, 0, 0);
#pragma unroll
            for (int r = 0; r < 4; ++r) I[r] = __builtin_fmaf(wv[r][h], __builtin_fabsf(a[r]), I[r]); }
        const int kidx = kt * 16 + fr;
#pragma unroll
        for (int r = 0; r < 4; ++r) { const unsigned key = f16key(I[r]); Ik[(fq * 4 + r) * 4096 + kidx] = (unsigned short)key;
            if (kidx <= q0 + fq * 4 + r) atomicAdd(&hist1[(fq * 4 + r) * 256 + (key >> 8)], 1u); }
        B0 = nB0; B1 = nB1;
    }
    __syncthreads();
    for (int qq = w; qq < 16; qq += NWAVES) {
        const int t = q0 + qq, n = t + 1;
        unsigned short* so = (unsigned short*)(hist1 + qq * 256);
        const unsigned short* keys = Ik + qq * 4096;
        if (n <= TOPK) { for (int j = lane; j < n; j += 64) so[j] = (unsigned short)j; }
        else {
            int b1, rem1, b2, rem2;
            find_bin(hist1 + qq * 256, TOPK, lane, b1, rem1);
            *(v4u*)(hist + 4 * lane) = (v4u){0u, 0u, 0u, 0u};
            LDS_WAIT(); __builtin_amdgcn_wave_barrier();
            for (int j = lane; j < n; j += 64) { const unsigned k = keys[j]; if ((int)(k >> 8) == b1) atomicAdd(&hist[k & 255u], 1u); }
            LDS_WAIT(); __builtin_amdgcn_wave_barrier();
            find_bin(hist, rem1, lane, b2, rem2);
            const unsigned thr = ((unsigned)b1 << 8) | (unsigned)b2;
            int base = 0, eqtaken = 0;
            const unsigned long long lt = (lane == 0) ? 0ull : (~0ull >> (64 - lane));
            for (int j0 = 0; j0 < n; j0 += 64) {
                const int j = j0 + lane; const bool valid = j < n; const unsigned k = valid ? (unsigned)keys[j] : 0u;
                const bool gt = valid && k > thr, eq = valid && k == thr;
                const unsigned long long meq = __ballot(eq);
                const int erank = __popcll(meq & lt) + eqtaken;
                const bool take = gt || (eq && erank < rem2);
                const unsigned long long mt = __ballot(take);
                if (take) so[base + __popcll(mt & lt)] = (unsigned short)j;
                base += __popcll(mt); eqtaken += __popcll(meq);
            }
        }
    }
    __syncthreads();
}

__device__ __forceinline__ void qknorm_token(const Params& p, int tok, int lane) {
    const bf16* row = (const bf16*)(p.ws + WS_ATT) + (size_t)tok * LD_ATT;
    const int c8 = (lane & 7) * 8;
    { const v4u qv = *(const v4u*)(row + lane * 8);
      float x[8]; float ss = 0.f;
#pragma unroll
      for (int i = 0; i < 4; ++i) { x[2 * i] = bflo(qv[i]); x[2 * i + 1] = bfhi(qv[i]); ss += x[2 * i] * x[2 * i] + x[2 * i + 1] * x[2 * i + 1]; }
      ss += __shfl_xor(ss, 1); ss += __shfl_xor(ss, 2); ss += __shfl_xor(ss, 4);
      const float rs = rsqrtf(ss * (1.f / 64.f) + RMS_EPS) * (0.125f * 1.4426950408889634f);
#pragma unroll
      for (int i = 0; i < 8; ++i) x[i] = x[i] * rs * p.q_norm_g[c8 + i];
      v2u hw, lw;
      hw.x = pk4_fp8(x[0], x[1], x[2], x[3]); hw.y = pk4_fp8(x[4], x[5], x[6], x[7]);
      { const f32x2 d0 = __builtin_amdgcn_cvt_pk_f32_fp8((int)hw.x, false), d1 = __builtin_amdgcn_cvt_pk_f32_fp8((int)hw.x, true), d2 = __builtin_amdgcn_cvt_pk_f32_fp8((int)hw.y, false), d3 = __builtin_amdgcn_cvt_pk_f32_fp8((int)hw.y, true);
        lw.x = pk4_fp8(x[0] - d0[0], x[1] - d0[1], x[2] - d1[0], x[3] - d1[1]); lw.y = pk4_fp8(x[4] - d2[0], x[5] - d2[1], x[6] - d3[0], x[7] - d3[1]); }
      *(v2u*)(p.ws + WS_QHI + (size_t)tok * 512 + lane * 8) = hw; *(v2u*)(p.ws + WS_QLO + (size_t)tok * 512 + lane * 8) = lw; }
    { const v4u kv = *(const v4u*)(row + 512 + (lane & 15) * 8);
      float x[8]; float ss = 0.f;
#pragma unroll
      for (int i = 0; i < 4; ++i) { x[2 * i] = bflo(kv[i]); x[2 * i + 1] = bfhi(kv[i]); ss += x[2 * i] * x[2 * i] + x[2 * i + 1] * x[2 * i + 1]; }
      ss += __shfl_xor(ss, 1); ss += __shfl_xor(ss, 2); ss += __shfl_xor(ss, 4);
      const float rs = rsqrtf(ss * (1.f / 64.f) + RMS_EPS);
#pragma unroll
      for (int i = 0; i < 8; ++i) x[i] = x[i] * rs * p.k_norm_g[c8 + i];
      v2u o; o.x = pk4_fp8(x[0], x[1], x[2], x[3]); o.y = pk4_fp8(x[4], x[5], x[6], x[7]);
      if (lane < 16) *(v2u*)(p.ws + WS_K8 + (size_t)tok * 128 + lane * 8) = o; }
}

typedef short v4i16_t __attribute__((ext_vector_type(4)));
__device__ __forceinline__ v4i16_t vtr16(const bf16* ldsp) { return __builtin_amdgcn_ds_read_tr16_b64_v4i16((LAS v4i16_t*)ldsp); }
__device__ __forceinline__ void dsa2_query(const Params& p, unsigned char* ldsw, const unsigned short* sel, int b, int t, int lane) {
    unsigned char* ws = p.ws;
    const bf16* ATT = (const bf16*)(ws + WS_ATT);
    bf16* YB = (bf16*)(ws + WS_H);
    unsigned short* sl = (unsigned short*)ldsw;
    float* df = (float*)(ldsw + 512);
    bf16* Vl = (bf16*)(ldsw + 1536);
    const int fr = lane & 15, fq = lane >> 4;
    const size_t rowb = (size_t)b * SEQ;
    const int cnt = (t + 1 < TOPK) ? (t + 1) : TOPK;
    { v2u sv = *(const v2u*)(sel + lane * 4);
      const int j0 = lane * 4;
      if (j0 >= cnt) sv.x = 0u; else if (j0 + 1 >= cnt) sv.x &= 0xffffu;
      if (j0 + 2 >= cnt) sv.y = 0u; else if (j0 + 3 >= cnt) sv.y &= 0xffffu;
      *(v2u*)(sl + lane * 4) = sv;
      f32x4 d4; d4[0] = (j0 < cnt) ? (float)(t - (int)(sv.x & 0xffffu)) : INFINITY; d4[1] = (j0 + 1 < cnt) ? (float)(t - (int)(sv.x >> 16)) : INFINITY;
      d4[2] = (j0 + 2 < cnt) ? (float)(t - (int)(sv.y & 0xffffu)) : INFINITY; d4[3] = (j0 + 3 < cnt) ? (float)(t - (int)(sv.y >> 16)) : INFINITY;
      *(f32x4*)(df + lane * 4) = d4; }
    LDS_WAIT(); __builtin_amdgcn_wave_barrier();
    const unsigned char* K8 = ws + WS_K8;
    long qhA[2] = {0, 0}, qhB[2] = {0, 0}, qlA[2] = {0, 0}, qlB[2] = {0, 0};
    if (fr < 8) { const v4u qh = *(const v4u*)(ws + WS_QHI + (rowb + t) * 512 + fr * 64 + fq * 16), ql = *(const v4u*)(ws + WS_QLO + (rowb + t) * 512 + fr * 64 + fq * 16);
        const long hA = (long)(((unsigned long long)qh.y << 32) | qh.x), hB = (long)(((unsigned long long)qh.w << 32) | qh.z), lA = (long)(((unsigned long long)ql.y << 32) | ql.x), lB = (long)(((unsigned long long)ql.w << 32) | ql.z);
        if (fr < 4) { qhA[0] = hA; qhB[0] = hB; qlA[0] = lA; qlB[0] = lB; } else { qhA[1] = hA; qhB[1] = hB; qlA[1] = lA; qlB[1] = lB; } }
    pg8::f32x4 sc[16];
    v4u vv[16];
    { v4u kf[16];
#pragma unroll
      for (int half = 0; half < 2; ++half) {
#pragma unroll
          for (int kt = 0; kt < 8; ++kt) { const int s = sl[(half * 8 + kt) * 16 + fr]; const unsigned char* kp = K8 + (rowb + s) * 128 + fq * 16;
              kf[2 * kt] = *(const v4u*)kp; kf[2 * kt + 1] = *(const v4u*)(kp + 64); }
          if (half == 1) {
#pragma unroll
              for (int i = 0; i < 8; ++i) { const int s = sl[i * 8 + (lane >> 3)]; vv[i] = *(const v4u*)(ATT + (rowb + s) * LD_ATT + 640 + (lane & 7) * 8); } }
          __builtin_amdgcn_sched_barrier(0);
#pragma unroll
          for (int kt = 0; kt < 8; ++kt) { pg8::f32x4 a = {0.f, 0.f, 0.f, 0.f};
#pragma unroll
              for (int gg = 0; gg < 2; ++gg) { const v4u kv = kf[2 * kt + gg];
                  const long kA = (long)(((unsigned long long)kv.y << 32) | kv.x), kB = (long)(((unsigned long long)kv.w << 32) | kv.z);
                  a = __builtin_amdgcn_mfma_f32_16x16x32_fp8_fp8(kA, qhA[gg], a, 0, 0, 0); a = __builtin_amdgcn_mfma_f32_16x16x32_fp8_fp8(kB, qhB[gg], a, 0, 0, 0);
                  a = __builtin_amdgcn_mfma_f32_16x16x32_fp8_fp8(kA, qlA[gg], a, 0, 0, 0); a = __builtin_amdgcn_mfma_f32_16x16x32_fp8_fp8(kB, qlB[gg], a, 0, 0, 0); }
              sc[half * 8 + kt] = a; }
          __builtin_amdgcn_sched_barrier(0);
      } }
    const float slope = exp2f(-(float)((fr & 7) + 1)) * 1.4426950408889634f;
    float m = -INFINITY;
#pragma unroll
    for (int kt = 0; kt < 16; ++kt) { const f32x4 d4 = *(const f32x4*)(df + kt * 16 + fq * 4);
#pragma unroll
        for (int r = 0; r < 4; ++r) { const float x = sc[kt][r] - slope * d4[r]; sc[kt][r] = x; m = fmaxf(m, x); } }
    m = fmaxf(m, __shfl_xor(m, 16)); m = fmaxf(m, __shfl_xor(m, 32));
    float l = 0.f;
#pragma unroll
    for (int kt = 0; kt < 16; ++kt)
#pragma unroll
        for (int r = 0; r < 4; ++r) { const float e = __builtin_amdgcn_exp2f(sc[kt][r] - m); sc[kt][r] = e; l += e; }
    l += __shfl_xor(l, 16); l += __shfl_xor(l, 32);
    const float inv = 1.f / l;
#pragma unroll 1
    for (int g = 0; g < 2; ++g) {
        if (g == 1) {
#pragma unroll
            for (int i = 0; i < 8; ++i) { const int s = sl[i * 8 + (lane >> 3)]; vv[i] = *(const v4u*)(ATT + (rowb + s) * LD_ATT + 640 + 64 + (lane & 7) * 8); } }
#pragma unroll
        for (int i = 8; i < 16; ++i) { const int s = sl[i * 8 + (lane >> 3)]; vv[i] = *(const v4u*)(ATT + (rowb + s) * LD_ATT + 640 + g * 64 + (lane & 7) * 8); }
        pg8::f32x4 o[4];
#pragma unroll
        for (int dt = 0; dt < 4; ++dt) o[dt] = (pg8::f32x4){0.f, 0.f, 0.f, 0.f};
#pragma unroll
        for (int ch = 0; ch < 4; ++ch) {
            LDS_WAIT(); __builtin_amdgcn_wave_barrier();
#pragma unroll
            for (int i = 0; i < 8; ++i) *(v4u*)(Vl + (i * 8 + (lane >> 3)) * 80 + (lane & 7) * 8) = vv[(ch & 1) * 8 + i];
            if (ch < 2) {
#pragma unroll
                for (int i = 0; i < 8; ++i) { const int s = sl[((ch + 2) * 8 + i) * 8 + (lane >> 3)]; vv[(ch & 1) * 8 + i] = *(const v4u*)(ATT + (rowb + s) * LD_ATT + 640 + g * 64 + (lane & 7) * 8); } }
            LDS_WAIT(); __builtin_amdgcn_wave_barrier();
#pragma unroll
            for (int k2 = 0; k2 < 2; ++k2) { const int kt0 = ch * 4 + 2 * k2;
                v4u pw; pw.x = pk2(sc[kt0][0], sc[kt0][1]); pw.y = pk2(sc[kt0][2], sc[kt0][3]); pw.z = pk2(sc[kt0 + 1][0], sc[kt0 + 1][1]); pw.w = pk2(sc[kt0 + 1][2], sc[kt0 + 1][3]);
                const bf16x8 pb = __builtin_bit_cast(bf16x8, pw);
#pragma unroll
                for (int dt = 0; dt < 4; ++dt) { const bf16* vp = Vl + ((2 * k2) * 16 + fq * 4 + (fr >> 2)) * 80 + dt * 16 + (fr & 3) * 4;
                    const v4i16_t lo = vtr16(vp), hi = vtr16(vp + 16 * 80);
                    const bf16x8 af = {lo[0], lo[1], lo[2], lo[3], hi[0], hi[1], hi[2], hi[3]};
                    o[dt] = __builtin_amdgcn_mfma_f32_16x16x32_bf16(af, pb, o[dt], 0, 0, 0); } }
        }
        if (fr < 8 && (fr >> 2) == g) {
#pragma unroll
            for (int dt = 0; dt < 4; ++dt) { const float i8 = inv * 8.f;
                *(unsigned*)((unsigned char*)YB + (rowb + t) * 1024 + 512 + fr * 64 + dt * 16 + fq * 4) = pk4_fp8(o[dt][0] * i8, o[dt][1] * i8, o[dt][2] * i8, o[dt][3] * i8); } }
    }
    LDS_WAIT(); __builtin_amdgcn_wave_barrier();
}

#define INS16(L, x) do { _Pragma("unroll") for (int _i = 15; _i >= 1; --_i) L[_i] = __builtin_amdgcn_fmed3f(L[_i - 1], L[_i], (x)); L[0] = fmaxf(L[0], (x)); } while (0)
__device__ __forceinline__ float f_andor(float v, unsigned keepmask, unsigned orv) { return __builtin_bit_cast(float, (__builtin_bit_cast(unsigned, v) & keepmask) | orv); }
__device__ __forceinline__ void peer_route_item(const Params& p, unsigned char* ldsw, int tg, int h, int lane, int* EIDX, float* GATES) {
    unsigned char* ws = p.ws;
    const bf16* Q = (const bf16*)(ws + WS_Q);
    const bf16* SK = (const bf16*)(ws + WS_SK);
    float* sc = (float*)ldsw;
    const int fr = lane & 15, fq = lane >> 4;
#pragma unroll 1
    for (int pp = 0; pp < 2; ++pp) {
        bf16x8 Af[4], Bf[32];
        { const bf16* rp = Q + (size_t)(tg * 16 + fr) * 2048 + h * 256 + pp * 128 + fq * 8;
#pragma unroll
          for (int ks = 0; ks < 4; ++ks) Af[ks] = *(const bf16x8*)(rp + ks * 32); }
#pragma unroll
        for (int kt = 0; kt < 8; ++kt) { const bf16* kp = SK + (size_t)((h * 2 + pp) * 128 + kt * 16 + fr) * 128 + fq * 8;
#pragma unroll
            for (int ks = 0; ks < 4; ++ks) Bf[kt * 4 + ks] = *(const bf16x8*)(kp + ks * 32); }
        __builtin_amdgcn_sched_barrier(0);
#pragma unroll
        for (int kt = 0; kt < 8; ++kt) {
            pg8::f32x4 a = {0.f, 0.f, 0.f, 0.f};
#pragma unroll
            for (int ks = 0; ks < 4; ++ks) a = __builtin_amdgcn_mfma_f32_16x16x32_bf16(Af[ks], Bf[kt * 4 + ks], a, 0, 0, 0);
#pragma unroll
            for (int r = 0; r < 4; ++r) sc[(pp * 16 + fq * 4 + r) * 132 + kt * 16 + fr] = f_andor(a[r], ~127u, (unsigned)(kt * 16 + fr));
        }
    }
    LDS_WAIT(); __builtin_amdgcn_wave_barrier();
    float L[16];
#pragma unroll
    for (int i = 0; i < 16; ++i) L[i] = -INFINITY;
    { const float* sp = sc + (lane & 31) * 132 + (lane >> 5) * 64;
#pragma unroll 4
      for (int i = 0; i < 16; ++i) { const f32x4 x = *(const f32x4*)(sp + 4 * i); INS16(L, x[0]); INS16(L, x[1]); INS16(L, x[2]); INS16(L, x[3]); } }
    { float O[16];
#pragma unroll
      for (int i = 0; i < 16; ++i) O[i] = __shfl_xor(L[i], 32);
#pragma unroll
      for (int i = 0; i < 16; ++i) INS16(L, O[i]); }
    LDS_WAIT(); __builtin_amdgcn_wave_barrier();
    float* lst = sc;
    if (lane < 32) {
#pragma unroll
        for (int i = 0; i < 4; ++i) *(f32x4*)(lst + lane * 16 + 4 * i) = (f32x4){L[4 * i], L[4 * i + 1], L[4 * i + 2], L[4 * i + 3]}; }
    LDS_WAIT(); __builtin_amdgcn_wave_barrier();
    const int tok = lane & 15;
    float s1[16], s2[16];
#pragma unroll
    for (int i = 0; i < 4; ++i) { const f32x4 a = *(const f32x4*)(lst + tok * 16 + 4 * i), b = *(const f32x4*)(lst + (16 + tok) * 16 + 4 * i);
#pragma unroll
        for (int c = 0; c < 4; ++c) { s1[4 * i + c] = f_andor(a[c], ~127u, 0u); s2[4 * i + c] = f_andor(b[c], ~127u, 0u); } }
    float M[16];
#pragma unroll
    for (int i = 0; i < 16; ++i) M[i] = -INFINITY;
#pragma unroll
    for (int a = 0; a < 16; ++a)
#pragma unroll
        for (int b = 0; b < 16; ++b)
            if ((a + 1) * (b + 1) <= 16) { const float key = f_andor(s1[a] + s2[b], ~255u, (unsigned)(a * 16 + b)); INS16(M, key); }
    const float mx = f_andor(M[0], ~255u, 0u);
    float e[16], sum = 0.f; int ei[16];
    const unsigned* lb = (const unsigned*)lst;
#pragma unroll
    for (int i = 0; i < 16; ++i) { const unsigned bits = __builtin_bit_cast(unsigned, M[i]); const int flat = bits & 255u;
        e[i] = __expf(f_andor(M[i], ~255u, 0u) - mx); sum += e[i];
        ei[i] = (int)(lb[tok * 16 + (flat >> 4)] & 127u) * 128 + (int)(lb[(16 + tok) * 16 + (flat & 15)] & 127u); }
    const float inv = 1.f / sum;
    if (lane < 16) {
        const size_t ob = ((size_t)tok * 8 + h) * 16;
#pragma unroll
        for (int i = 0; i < 4; ++i) { *(v4u*)(EIDX + ob + 4 * i) = (v4u){(unsigned)ei[4 * i], (unsigned)ei[4 * i + 1], (unsigned)ei[4 * i + 2], (unsigned)ei[4 * i + 3]};
            *(f32x4*)(GATES + ob + 4 * i) = (f32x4){e[4 * i] * inv, e[4 * i + 1] * inv, e[4 * i + 2] * inv, e[4 * i + 3] * inv}; }
    }
    LDS_WAIT(); __builtin_amdgcn_wave_barrier();
}

__device__ __forceinline__ float gelu_erf(float x) { return 0.5f * x * (1.f + erff(x * 0.70710678118654752f)); }
typedef int v8i_t __attribute__((ext_vector_type(8)));
template <int OPSEL> __device__ __forceinline__ pg8::f32x4 mx_dot(v8i_t a, int sa, v8i_t b, int sb, pg8::f32x4 c) {
    return __builtin_amdgcn_mfma_scale_f32_16x16x128_f8f6f4(a, b, c, 4  , 4  , OPSEL, sa, OPSEL, sb);
}
__device__ __forceinline__ void peer_token(const Params& p, unsigned char* ldsw, int tok, int lane, const int* EIDX, const float* GATES, bool dry = false) {
    unsigned char* ws = p.ws;
    const unsigned char* V8 = ws + WS_V; const unsigned char* V8S = ws + WS_VS;
    const float* MOD = (const float*)(ws + WS_MOD);
    const int fr = lane & 15, fq = lane >> 4;
    typedef v8i_t v8i;
    v4u A4[H4_NT][8]; v2u As[H4_NT];
#pragma unroll
    for (int t = 0; t < H4_NT; ++t) { const unsigned char* hp = ws + WS_H4D + ((size_t)tok * H4_NT + t) * 512 + fq * 16;
        As[t] = *(const v2u*)(ws + WS_H4S + ((size_t)tok * H4_NT + t) * 32 + fq * 8);
#pragma unroll
        for (int kk = 0; kk < 8; ++kk) A4[t][kk] = *(const v4u*)(hp + kk * 64); }
    int* pe = (int*)ldsw; float* pa = (float*)(ldsw + 512);
    const unsigned char* U4 = ws + WS_U; const unsigned char* U4S = ws + WS_US;
#pragma unroll 2
    for (int ct = 0; ct < 8; ++ct) {
        const int eic = EIDX[ct * 16 + fr]; const float gt = GATES[ct * 16 + fr];
        const unsigned char* ur = U4 + (size_t)eic * 512 + fq * 16;
        const v2u us = *(const v2u*)(U4S + (size_t)eic * 32 + fq * 8);
        pg8::f32x4 ah = {0.f, 0.f, 0.f, 0.f};
#pragma unroll
        for (int kk = 0; kk < 8; ++kk) { const v4u bu = *(const v4u*)(ur + kk * 64);
            const v8i bb = {(int)bu.x, (int)bu.y, (int)bu.z, (int)bu.w, 0, 0, 0, 0};
            const int sb = (int)((kk < 4) ? us.x : us.y);
#pragma unroll
            for (int t = 0; t < H4_NT; ++t) { const v8i aa = {(int)A4[t][kk].x, (int)A4[t][kk].y, (int)A4[t][kk].z, (int)A4[t][kk].w, 0, 0, 0, 0}; const int sa = (int)((kk < 4) ? As[t].x : As[t].y);
                if ((kk & 3) == 0) ah = mx_dot<0>(aa, sa, bb, sb, ah); else if ((kk & 3) == 1) ah = mx_dot<1>(aa, sa, bb, sb, ah); else if ((kk & 3) == 2) ah = mx_dot<2>(aa, sa, bb, sb, ah); else ah = mx_dot<3>(aa, sa, bb, sb, ah); } }
        const float dot = ah[0];
        if (fq == 0) { pe[ct * 16 + fr] = eic; pa[ct * 16 + fr] = gelu_erf(dot) * gt; }
    }
    __builtin_amdgcn_sched_barrier(0);
    const int hl = lane >> 5, bl = lane & 31;
    float acc[32];
#pragma unroll
    for (int i = 0; i < 32; ++i) acc[i] = 0.f;
    LDS_WAIT(); __builtin_amdgcn_wave_barrier();
#pragma unroll 1
    for (int ct = 0; ct < 16; ++ct)
#pragma unroll
        for (int jp = 0; jp < 4; ++jp) {
            const int idx = pe[ct * 8 + 2 * jp + hl]; const float a = pa[ct * 8 + 2 * jp + hl];
            const v4u vv = *(const v4u*)(V8 + (size_t)idx * 512 + bl * 16);
            const unsigned sbyte = V8S[(size_t)idx * 32 + bl];
            const float as = a * __builtin_bit_cast(float, sbyte << 23);
#pragma unroll
            for (int w4 = 0; w4 < 4; ++w4) { const unsigned wd = vv[w4];
                const f32x2 d0 = __builtin_amdgcn_cvt_scalef32_pk_f32_fp4(wd, 1.0f, 0), d1 = __builtin_amdgcn_cvt_scalef32_pk_f32_fp4(wd, 1.0f, 1), d2 = __builtin_amdgcn_cvt_scalef32_pk_f32_fp4(wd, 1.0f, 2), d3 = __builtin_amdgcn_cvt_scalef32_pk_f32_fp4(wd, 1.0f, 3);
                acc[8 * w4] += as * d0[0]; acc[8 * w4 + 1] += as * d0[1]; acc[8 * w4 + 2] += as * d1[0]; acc[8 * w4 + 3] += as * d1[1];
                acc[8 * w4 + 4] += as * d2[0]; acc[8 * w4 + 5] += as * d2[1]; acc[8 * w4 + 6] += as * d3[0]; acc[8 * w4 + 7] += as * d3[1]; }
        }
    LDS_WAIT(); __builtin_amdgcn_wave_barrier();
    float accs[16];
#pragma unroll
    for (int i = 0; i < 16; ++i) { const float lo = acc[i] + __shfl_xor(acc[i], 32), hi2 = acc[16 + i] + __shfl_xor(acc[16 + i], 32); accs[i] = hl ? hi2 : lo; }
    const int b = tok / SEQ;
    const int col0 = bl * 32 + hl * 16;
    const float* g2 = MOD + (size_t)b * 6144 + 5 * 1024 + col0;
    float* orow = p.out + (size_t)tok * DM + col0;
#pragma unroll
    for (int q4 = 0; q4 < 4; ++q4) { const f32x4 xv = *(const f32x4*)(orow + 4 * q4), gv = *(const f32x4*)(g2 + 4 * q4);
        f32x4 o;
#pragma unroll
        for (int i = 0; i < 4; ++i) o[i] = xv[i] + (dry ? 0.f : gv[i] * accs[4 * q4 + i]);
        if (dry) { asm volatile("" :: "v"(accs[4 * q4]), "v"(accs[4 * q4 + 1]), "v"(accs[4 * q4 + 2]), "v"(accs[4 * q4 + 3])); }
        *(f32x4*)(orow + 4 * q4) = o; }
}

#define XB_TMO      128
#define XB_XCNT(j)  (256  + 64 * (j))
#define XB_XSUB(j)  (1280 + 64 * (j))
#define XB_XGEN(j)  (2304 + 64 * (j))
#define XB_TOP      3328
#define XB_TOPGEN   3392
#define XCD_BAR_WORDS 3456
#define XB_SPIN_CAP (1u << 18)

__device__ __forceinline__ unsigned xb_ld(unsigned* p)              { return __hip_atomic_load(p, __ATOMIC_RELAXED, __HIP_MEMORY_SCOPE_AGENT); }
__device__ __forceinline__ unsigned xb_add(unsigned* p, unsigned v) { return __hip_atomic_fetch_add(p, v, __ATOMIC_RELAXED, __HIP_MEMORY_SCOPE_AGENT); }
__device__ __forceinline__ unsigned xb_xcc_id() { return (unsigned)__builtin_amdgcn_s_getreg((3 << 11) | 20) & 0xFu; }
#define XB_SPIN(cond, bar) do { unsigned _sp = 0; while (cond) { __builtin_amdgcn_s_sleep(1); \
    if ((++_sp & 255u) == 0u) { if (xb_ld(&(bar)[XB_TMO])) break; if (_sp > XB_SPIN_CAP) { atomicAdd(&(bar)[XB_TMO], 1u); break; } } } } while (0)

struct XcdBarrier {
    unsigned* bar; unsigned x;
    volatile LAS unsigned* st;
};

__device__ __forceinline__ XcdBarrier xcd_barrier_post(unsigned* bar, volatile LAS unsigned* st) {
    XcdBarrier b; b.bar = bar; b.x = xb_xcc_id(); b.st = st;
    if (threadIdx.x == 0) (void)xb_add(&bar[XB_XCNT(b.x)], 1u);
    return b;
}
__device__ __forceinline__ void xcd_barrier_complete(unsigned* bar, unsigned x, unsigned& nloc, unsigned& nx) {
    const unsigned G = gridDim.x * gridDim.y * gridDim.z;
    unsigned sum, cnt, mine, sp = 0u;
    for (;;) {
        sum = 0u; cnt = 0u; mine = 0u;
#pragma unroll
        for (unsigned j = 0; j < 16; ++j) { const unsigned c = xb_ld(&bar[XB_XCNT(j)]); sum += c; cnt += (c > 0u) ? 1u : 0u; mine = (j == x) ? c : mine; }
        if (sum == G) break;
        __builtin_amdgcn_s_sleep(1);
        if ((++sp & 255u) == 0u) { if (xb_ld(&bar[XB_TMO])) break; if (sp > XB_SPIN_CAP) { atomicAdd(&bar[XB_TMO], 1u); break; } }
    }
    nloc = mine > 0u ? mine : 1u; nx = cnt > 0u ? cnt : 1u;
}

__device__ __forceinline__ void xcd_barrier(const XcdBarrier& b) {
    asm volatile("s_waitcnt vmcnt(0)" ::: "memory");
    __syncthreads();
    if (threadIdx.x == 0) {
        unsigned* bar = b.bar;
        __builtin_amdgcn_s_waitcnt(0);
        unsigned nloc = b.st[0], nx = b.st[1];
        if (nloc == 0u) { xcd_barrier_complete(bar, b.x, nloc, nx); b.st[0] = nloc; b.st[1] = nx; }
        const unsigned old = xb_add(&bar[XB_XSUB(b.x)], 1u);
        const unsigned gen = old / nloc;
        if (old + 1u == (gen + 1u) * nloc) {
            __builtin_amdgcn_fence(__ATOMIC_RELEASE, "agent");
            asm volatile("s_waitcnt vmcnt(0)" ::: "memory");
            const unsigned og = xb_add(&bar[XB_TOP], 1u);
            const unsigned tg = og / nx;
            if (og + 1u == (tg + 1u) * nx) xb_add(&bar[XB_TOPGEN], 1u);
            else XB_SPIN(xb_ld(&bar[XB_TOPGEN]) == tg, bar);
            __builtin_amdgcn_fence(__ATOMIC_ACQUIRE, "agent");
            xb_add(&bar[XB_XGEN(b.x)], 1u);
            asm volatile("s_waitcnt vmcnt(0)" ::: "memory");
        } else {
            XB_SPIN(xb_ld(&bar[XB_XGEN(b.x)]) == gen, bar);
            __builtin_amdgcn_fence(__ATOMIC_ACQUIRE, "agent");
            asm volatile("s_waitcnt vmcnt(0)" ::: "memory");
        }
    }
    __syncthreads();
}

constexpr int NPHASE = 11;
__global__ void __launch_bounds__(NTHREADS, 2) mega(Params p) {
    extern __shared__ __attribute__((aligned(16))) unsigned char lds[];
    cg::grid_group grid = cg::this_grid();
    const int lo = p.ph_lo, hi = p.ph_hi;
    const int tid = threadIdx.x, wave = tid >> 6, lane = tid & 63, G = gridDim.x;
    unsigned char* ws = p.ws;
#ifndef ONLYPH
#define IN(k) (lo <= (k) && (k) < hi)
#else
#define IN(k) ((k) == ONLYPH && lo <= (k) && (k) < hi)
#endif
    volatile LAS unsigned* xb_st = (volatile LAS unsigned*)((LAS unsigned char*)lds + (LDS_BYTES - 16));
    if (tid < 4) xb_st[tid] = 0u;
    __syncthreads();
    XcdBarrier xbar; xbar.bar = (unsigned*)(ws + WS_CTL); xbar.x = 0; xbar.st = xb_st;
    if (hi - lo > 1) xbar = xcd_barrier_post((unsigned*)(ws + WS_CTL), xb_st);
    if (lo < -1) grid.sync();
#define SEAM(k) do { if (IN((k) + 1)) xcd_barrier(xbar); } while (0)
#ifndef REPMASK
#define REPMASK 0
#endif
#define NREP(k) (((REPMASK >> (k)) & 1) ? 2 : 1)
    if (IN(0)) { for (int rep = 0; rep < NREP(0); ++rep) phase0(p, lds); SEAM(0); }
    if (IN(1)) { for (int rep = 0; rep < NREP(1); ++rep) normmod_phase<true>(p, lds, p.x, (bf16*)(ws + WS_H), p.norm1_g, 0, 1024); SEAM(1); }
    if (IN(2)) {
        { pg8::Gemm g{(const bf16*)(ws + WS_H8), (const bf16*)(ws + WS_WIN8), T, 3584, 512, 512, 512}; pg8::StaticOrder S; S.init(T, 3584, G, (int)blockIdx.x);
          EpiProj E{(bf16*)(ws + WS_HG), (bf16*)(ws + WS_ATT), (bf16*)(ws + WS_IDX), (bf16*)(ws + WS_GATE), 1};
          pg8::gemm_phase<EpiProj, pg8::StaticOrder, true, true, 122>((PG8_LAS unsigned char*)lds, g, S, E); }
        { pg8::Gemm g{(const bf16*)(ws + WS_H), (const bf16*)(ws + WS_WIN), T, 2048, 1024, 1024, 1024}; pg8::StaticOrder S; S.init(T, 2048, G, (int)blockIdx.x);
          EpiProj E{(bf16*)(ws + WS_HG), (bf16*)(ws + WS_ATT), (bf16*)(ws + WS_IDX), (bf16*)(ws + WS_GATE), 0};
          pg8::gemm_phase<EpiProj, pg8::StaticOrder, true, true>((PG8_LAS unsigned char*)lds, g, S, E); }
        SEAM(2);
    }
    if (IN(3)) {
        for (int tok = (int)blockIdx.x * NWAVES + wave; tok < T; tok += G * NWAVES) qknorm_token(p, tok, lane);
        SEAM(3);
    }
    if (IN(4)) {
        if ((int)blockIdx.x < 32) hgrn_item(p, lds, (int)blockIdx.x);
        {
            unsigned* qctr = (unsigned*)(ws + WS_CTL + 32768);
            volatile LAS unsigned* qslot = (volatile LAS unsigned*)((LAS unsigned char*)lds + (LDS_BYTES - 32));
            int qsel = (int)(blockIdx.x & 7u), tried = 0;
            for (;;) {
                if (tid == 0) { unsigned c;
                    for (;;) { c = __hip_atomic_fetch_add(qctr + qsel * 64, 1u, __ATOMIC_RELAXED, __HIP_MEMORY_SCOPE_AGENT); if (c < (unsigned)(SEQ / 16) || tried >= 7) break; qsel = (qsel + 1) & 7; ++tried; }
                    *qslot = (c < (unsigned)(SEQ / 16)) ? (((unsigned)qsel << 16) | c) : 0xffffffffu; }
                __syncthreads();
                const unsigned c = *qslot;
                __syncthreads();
                if (c == 0xffffffffu) break;
                const int b = (int)(c >> 16), qblk = (SEQ / 16 - 1) - (int)(c & 0xffffu), it = b * (SEQ / 16) + qblk, q0 = qblk * 16;
                dsa1_item(p, lds, it);
#pragma unroll 1
                for (int k2 = 0; k2 < 2; ++k2) dsa2_query(p, lds + wave * 16384, (const unsigned short*)(lds + 131072 + (wave + 8 * k2) * 1024), b, q0 + wave + 8 * k2, lane);
                __syncthreads();
            }
        }
        SEAM(4);
    }
    if (IN(5)) {
        pg8::Gemm g{(const bf16*)(ws + WS_H), (const bf16*)(ws + WS_WAB8), T, 1024, 256, 512, 512}; pg8::StaticOrderT<true> S; S.init(T, 1024, G, (int)blockIdx.x, 256);
        EpiMerged E{(const bf16*)(ws + WS_GATE), (bf16*)(ws + WS_MERGED)};
        for (int rep = 0; rep < NREP(5); ++rep) pg8::gemm_phase<EpiMerged, pg8::StaticOrderT<true>, true, true, 122>((PG8_LAS unsigned char*)lds, g, S, E);
        SEAM(5);
    }
    if (IN(6)) {
        pg8::Gemm g{(const bf16*)(ws + WS_MERGED), (const bf16*)(ws + WS_WOUT8), T, 1024, 512, 512, 512}; pg8::StaticOrder S; S.init(T, 1024, G, (int)blockIdx.x);
        EpiResid E{p.x, (const float*)(ws + WS_MOD) + 2048, p.out};
        for (int rep = 0; rep < NREP(6); ++rep) pg8::gemm_phase<EpiResid, pg8::StaticOrder, true, true, 120>((PG8_LAS unsigned char*)lds, g, S, E);
        SEAM(6);
    }
    if (IN(7)) { for (int rep = 0; rep < NREP(7); ++rep) normmod_phase<false>(p, lds, p.out, (bf16*)(ws + WS_H), p.norm2_g, 3 * 1024, 4 * 1024); SEAM(7); }
    if (IN(8)) {
        pg8::Gemm g{(const bf16*)(ws + WS_H), (const bf16*)(ws + WS_WQ), T, 2048, 1024, 1024, 1024}; pg8::StaticOrder S; S.init(T, 2048, G, (int)blockIdx.x);
        EpiStore E{(bf16*)(ws + WS_Q), 2048};
        for (int rep = 0; rep < NREP(8); ++rep) pg8::gemm_phase<EpiStore, pg8::StaticOrder, true, true>((PG8_LAS unsigned char*)lds, g, S, E);
        SEAM(8);
    }
    if (IN(9)) {
        int* eL = (int*)(lds + 8 * 16896); float* gL = (float*)(lds + 8 * 16896 + 8192);
        for (int tg = blockIdx.x; tg < T / 16; tg += G) {
            peer_route_item(p, lds + wave * 16896, tg, wave, lane, eL, gL);
            __syncthreads();
#pragma unroll 1
            for (int k2 = 0; k2 < 2; ++k2) { const int tl = wave + 8 * k2; peer_token(p, lds + 8 * 16896 + 16384 + wave * 1024, tg * 16 + tl, lane, eL + tl * 128, gL + tl * 128); }
            __syncthreads();
        }
    }
#undef IN
#undef SEAM
}

#ifndef ONE_LAUNCH
#define ONE_LAUNCH 1
#endif
extern "C" void kernel_launch(void* const* d_in, const int* in_sizes, int n_in, void* d_out, int out_size, void* d_ws, size_t ws_size, hipStream_t stream) {
    static int grid = 0;
    if (grid == 0) {
        if (n_in != 18 || out_size != T * DM || ws_size < WS_END) { fprintf(stderr, "kernel_launch: unexpected shapes (n_in %d, out %d, ws %zu)\n", n_in, out_size, ws_size); grid = -1; return; }
        int dev = 0, cus = 0, per_cu = 0;
        if (hipGetDevice(&dev) != hipSuccess || hipDeviceGetAttribute(&cus, hipDeviceAttributeMultiprocessorCount, dev) != hipSuccess) { grid = -1; return; }
        if (hipFuncSetAttribute((const void*)mega, hipFuncAttributeMaxDynamicSharedMemorySize, LDS_BYTES) != hipSuccess) { fprintf(stderr, "kernel_launch: hipFuncSetAttribute failed\n"); grid = -1; return; }
        if (hipOccupancyMaxActiveBlocksPerMultiprocessor(&per_cu, (const void*)mega, NTHREADS, LDS_BYTES) != hipSuccess || per_cu < 1) { fprintf(stderr, "kernel_launch: occupancy query says %d\n", per_cu); grid = -1; return; }
        (void)hipGetLastError();
        grid = cus;
        if (grid < 64) { grid = -1; return; }
    }
    if (grid < 0) return;
    Params p{};
    const float** pp = (const float**)&p;
    for (int i = 0; i < 18; ++i) pp[i] = (const float*)d_in[i];
    p.out = (float*)d_out; p.ws = (unsigned char*)d_ws;
#if ONE_LAUNCH
    if (hipMemsetAsync((char*)d_ws + WS_CTL, 0, 65536, stream) != hipSuccess) { fprintf(stderr, "kernel_launch: memset failed\n"); return; }
    p.ph_lo = 0; p.ph_hi = NPHASE;
    void* args[] = {&p};
    hipError_t e = hipLaunchCooperativeKernel((const void*)mega, dim3(grid), dim3(NTHREADS), args, LDS_BYTES, stream);
    if (e != hipSuccess) fprintf(stderr, "cooperative launch failed: %s (grid %d)\n", hipGetErrorString(e), grid);
#else
    for (int k = 0; k < NPHASE; ++k) { p.ph_lo = k; p.ph_hi = k + 1; hipLaunchKernelGGL(mega, dim3(grid), dim3(NTHREADS), LDS_BYTES, stream, p); }
#endif
}
```

```cpp
#include <hip/hip_runtime.h>
#include <hip/hip_cooperative_groups.h>
#include <cstdio>
#include <cstdint>
namespace cg = cooperative_groups;

namespace pg8 {
#define PG8_LAS __attribute__((address_space(3)))
typedef unsigned short bf16_t;
typedef short bf16x8 __attribute__((ext_vector_type(8)));
typedef float f32x4 __attribute__((ext_vector_type(4)));
typedef unsigned u32x4 __attribute__((ext_vector_type(4)));
constexpr int BM = 256, BK = 64, HALF = 128, HTB = HALF * BK * 2  , STAGE_BYTES = 8 * HTB, NXCD = 8, WGM = 8;

__host__ __device__ __forceinline__ int lds_byte(int r, int c) { const int st = (r >> 4) * 2 + (c >> 5), rr = r & 15, cc = c & 31, ob = rr * 64 + cc * 2; return st * 1024 + (ob ^ (((ob >> 9) & 1) << 5)); }
__host__ __device__ __forceinline__ void stage_rc(int b, int& R, int& C) { const int st = b / 1024, sb = b % 1024, swz = sb ^ (((sb >> 9) & 1) << 5); R = (st >> 1) * 16 + swz / 64; C = (st & 1) * 32 + (swz % 64) / 2; }
__host__ __device__ __forceinline__ int perm32(int rho) { const int n = rho >> 4, i = rho & 15; return 8 * (i >> 2) + 4 * n + (i & 3); }

struct Unit { int pm, pn, ko, pass; };
struct Gemm { const bf16_t* A; const bf16_t* Bt; int M, N, K, lda, ldb; };
typedef float f32x16 __attribute__((ext_vector_type(16)));
typedef f32x16 AccW[2][2][2];
__device__ __forceinline__ f32x4 acc_get(const AccW& A, int ai, int bj, int m, int n) { const int s_ = ((m & 1) * 2 + n) * 4; const f32x16& w = A[ai][bj][m >> 1]; return (f32x4){w[s_], w[s_ + 1], w[s_ + 2], w[s_ + 3]}; }
__device__ __forceinline__ void acc_set(AccW& A, int ai, int bj, int m, int n, f32x4 v) { const int s_ = ((m & 1) * 2 + n) * 4; f32x16& w = A[ai][bj][m >> 1]; w[s_] = v[0]; w[s_ + 1] = v[1]; w[s_ + 2] = v[2]; w[s_ + 3] = v[3]; }

template <bool TWOPASS_ORDER = false>
struct StaticOrderT {
    int nM, nN, nwg, G, c, kpass;
    __host__ __device__ void init(int M, int N, int G_, int c_, int kpass_ = 512) { nM = M / BM; nN = N / BM; nwg = nM * nN; G = G_; c = c_; kpass = kpass_; }
    __host__ __device__ bool next(int i, Unit& u) const {
        const long L = (long)(TWOPASS_ORDER ? (i >> 1) : i) * G + c; if (L >= nwg) return false;
        u.pass = TWOPASS_ORDER ? (i & 1) : 0; u.ko = TWOPASS_ORDER ? (i & 1) * kpass : 0;
        int wgid = (int)L; { const int q = nwg / NXCD, r = nwg % NXCD, xcd = wgid % NXCD, off = wgid / NXCD; wgid = (xcd < r ? xcd * (q + 1) : r * (q + 1) + (xcd - r) * q) + off; }
        const int nig = WGM * nN, gid = wgid / nig, fm = gid * WGM, gsz = (nM - fm) < WGM ? (nM - fm) : WGM;
        u.pm = fm + ((wgid % nig) % gsz); u.pn = (wgid % nig) / gsz; return true;
    }
    __device__ __forceinline__ void a_ready(const Unit&) const {}
    __device__ __forceinline__ void done(const Unit&) const {}
};
typedef StaticOrderT<false> StaticOrder;

__device__ __forceinline__ unsigned cvt_pk_bf16(float lo, float hi) { unsigned r; asm volatile("v_cvt_pk_bf16_f32 %0, %1, %2" : "=v"(r) : "v"(lo), "v"(hi)); return r; }

template <class Epi, class Sched, bool ALIGN_EPI = false, bool SP2 = false, int F8SCALE = 0>
__device__ __forceinline__ void gemm_phase(PG8_LAS unsigned char* lds, const Gemm g, const Sched& S, const Epi& E) {
    const int tid = threadIdx.x, wid = __builtin_amdgcn_readfirstlane(tid >> 6), lane = tid & 63, wr = wid >> 2, wc = wid & 3, fr = lane & 15, fq = lane >> 4;
    const int K = g.K, nt = K / BK;
    unsigned voffA[2], voffB[2];
#pragma unroll
    for (int i = 0; i < 2; ++i) { int R, C; stage_rc(tid * 16 + i * 8192, R, C); const int Rb = Epi::PERM ? ((R & ~31) + perm32(R & 31)) : R;
        voffA[i] = (unsigned)(R * g.lda + C) * 2u; voffB[i] = (unsigned)(Rb * g.ldb + C) * 2u; }
    const size_t kstep = (size_t)(BK * 2);
    const size_t hstepA = (size_t)HALF * g.lda * 2, hstepB = (size_t)HALF * g.ldb * 2;
    const size_t tstepA = 2 * hstepA, tstepB = 2 * hstepB;
    const unsigned ldsw = (unsigned)wid * 1024u;
    const int aoff = lds_byte(wr * 64 + fr, fq * 8), boff = lds_byte(wc * 32 + fr, fq * 8);
#define PG8_SA(b, h) (((b) * 2 + (h)) * HTB)
#define PG8_SB(b, h) ((4 + (b) * 2 + (h)) * HTB)
#define PG8_STAGE(bufoff, gbase, voff) do { _Pragma("unroll") for (int _i = 0; _i < 2; ++_i) \
        __builtin_amdgcn_global_load_lds((const unsigned*)((const char*)(gbase) + (voff)[_i]), (PG8_LAS unsigned*)(lds + (bufoff) + ldsw + _i * 8192), 16, 0, 0); } while (0)
#define PG8_LDA(dst, b, h) do { _Pragma("unroll") for (int m = 0; m < 4; ++m) { if constexpr (F8SCALE != 0) { \
        PG8_F8(dst)[m].lo = *(const PG8_LAS v4i_f*)(lds + PG8_SA(b, h) + aoff + m * 2048); PG8_F8(dst)[m].hi = *(const PG8_LAS v4i_f*)(lds + PG8_SA(b, h) + aoff + m * 2048 + 1024); } \
        else { _Pragma("unroll") for (int k = 0; k < 2; ++k) dst[m][k] = *(const PG8_LAS bf16x8*)(lds + PG8_SA(b, h) + aoff + m * 2048 + k * 1024); } } } while (0)
#define PG8_LDB(dst, b, h) do { _Pragma("unroll") for (int n = 0; n < 2; ++n) { if constexpr (F8SCALE != 0) { \
        PG8_F8(dst)[n].lo = *(const PG8_LAS v4i_f*)(lds + PG8_SB(b, h) + boff + n * 2048); PG8_F8(dst)[n].hi = *(const PG8_LAS v4i_f*)(lds + PG8_SB(b, h) + boff + n * 2048 + 1024); } \
        else { _Pragma("unroll") for (int k = 0; k < 2; ++k) dst[n][k] = *(const PG8_LAS bf16x8*)(lds + PG8_SB(b, h) + boff + n * 2048 + k * 1024); } } } while (0)
#define PG8_MMA(ai, bj, At, Bt) do { __builtin_amdgcn_s_setprio(1); _Pragma("unroll") for (int m = 0; m < 4; ++m) _Pragma("unroll") for (int n = 0; n < 2; ++n) { \
        f32x4 _c = acc_get(accw, ai, bj, m, n); \
        if constexpr (F8SCALE != 0) { _c = __builtin_amdgcn_mfma_scale_f32_16x16x128_f8f6f4(PG8_F8(Bt)[n], PG8_F8(At)[m], _c, 0, 0, 0, 0x7f7f7f7f, 0, F8SCALE * 0x01010101); } \
        else { _Pragma("unroll") for (int k = 0; k < 2; ++k) _c = __builtin_amdgcn_mfma_f32_16x16x32_bf16(Bt[n][k], At[m][k], _c, 0, 0, 0); } \
        acc_set(accw, ai, bj, m, n, _c); } \
        __builtin_amdgcn_s_setprio(0); } while (0)
#define PG8_WAIT_V(n) asm volatile("s_waitcnt vmcnt(" #n ")" ::: "memory")
#define PG8_WAIT_L(n) asm volatile("s_waitcnt lgkmcnt(" #n ")" ::: "memory")
#define PG8_BAR __builtin_amdgcn_s_barrier()
#define PG8_SCHED __builtin_amdgcn_sched_barrier(0)
    Unit cur, nxt; int ui = 0;
    if (!S.next(0, cur)) return;
    typedef int v4i_f __attribute__((ext_vector_type(4))); typedef int v8i_f __attribute__((ext_vector_type(8))); typedef f32x16 f32x16_f;
    AccW accw;
#pragma unroll
    for (int a = 0; a < 2; ++a)
#pragma unroll
        for (int b = 0; b < 2; ++b)
#pragma unroll
            for (int mp = 0; mp < 2; ++mp)
#pragma unroll
                for (int i = 0; i < 16; ++i) accw[a][b][mp][i] = 0.f;
    bf16x8 At[4][2], B0[2][2], B1[2][2];
    v8i_f At8[4], B08[2], B18[2];
#define PG8_F8(x) x##8
    const char* cA = (const char*)g.A + (size_t)cur.pm * tstepA + (size_t)cur.ko * 2; const char* cB = (const char*)g.Bt + (size_t)cur.pn * tstepB + (size_t)cur.ko * 2;
    S.a_ready(cur);
    if constexpr (SP2) {
        PG8_STAGE(PG8_SB(0, 0), cB, voffB); PG8_STAGE(PG8_SB(0, 1), cB + hstepB, voffB); PG8_STAGE(PG8_SA(0, 0), cA, voffA); PG8_STAGE(PG8_SA(0, 1), cA + hstepA, voffA);
        if (wr == 1) PG8_BAR;
        PG8_WAIT_V(2); PG8_BAR;
        PG8_STAGE(PG8_SB(1, 0), cB + kstep, voffB); PG8_STAGE(PG8_SA(1, 0), cA + kstep, voffA); PG8_STAGE(PG8_SB(1, 1), cB + hstepB + kstep, voffB);
        PG8_WAIT_V(6); PG8_BAR;
    } else {
        PG8_STAGE(PG8_SB(0, 0), cB, voffB); PG8_STAGE(PG8_SA(0, 0), cA, voffA); PG8_STAGE(PG8_SB(0, 1), cB + hstepB, voffB); PG8_STAGE(PG8_SA(0, 1), cA + hstepA, voffA);
        if (wr == 1) PG8_BAR;
        PG8_WAIT_V(4); PG8_BAR;
        PG8_STAGE(PG8_SB(1, 0), cB + kstep, voffB); PG8_STAGE(PG8_SA(1, 0), cA + kstep, voffA); PG8_STAGE(PG8_SB(1, 1), cB + hstepB + kstep, voffB);
        PG8_WAIT_V(6); PG8_BAR;
    }
    for (;;) {
        const bool has_next = S.next(ui + 1, nxt);
        const char* nA = has_next ? (const char*)g.A + (size_t)nxt.pm * tstepA + (size_t)nxt.ko * 2 : cA; const char* nB = has_next ? (const char*)g.Bt + (size_t)nxt.pn * tstepB + (size_t)nxt.ko * 2 : cB;
        for (int t = 0; t < nt; t += 2) {
            const bool last = (t == nt - 2);
            const char* a1 = cA + (size_t)(t + 1) * kstep;
            const char* a2 = last ? nA : cA + (size_t)(t + 2) * kstep; const char* b2 = last ? nB : cB + (size_t)(t + 2) * kstep;
            const char* a3 = a2 + kstep; const char* b3 = b2 + kstep;
            if (last && has_next) S.a_ready(nxt);
            if constexpr (SP2) {
            PG8_LDB(B0, 0, 0); PG8_LDB(B1, 0, 1); PG8_SCHED; PG8_LDA(At, 0, 0); PG8_STAGE(PG8_SA(1, 1), a1 + hstepA, voffA);
            PG8_WAIT_V(8); PG8_WAIT_L(0); PG8_BAR; PG8_MMA(0, 0, At, B0); PG8_MMA(0, 1, At, B1); PG8_BAR; PG8_SCHED;
            PG8_LDA(At, 0, 1); PG8_STAGE(PG8_SB(0, 0), b2, voffB); PG8_STAGE(PG8_SB(0, 1), b2 + hstepB, voffB); PG8_STAGE(PG8_SA(0, 0), a2, voffA);
            PG8_WAIT_V(8); PG8_WAIT_L(0); PG8_BAR; PG8_MMA(1, 0, At, B0); PG8_MMA(1, 1, At, B1); PG8_BAR; PG8_SCHED;
            PG8_LDB(B0, 1, 0); PG8_LDB(B1, 1, 1); PG8_SCHED; PG8_LDA(At, 1, 0); PG8_STAGE(PG8_SA(0, 1), a2 + hstepA, voffA);
            PG8_WAIT_V(8); PG8_WAIT_L(0); PG8_BAR; PG8_MMA(0, 0, At, B0); PG8_MMA(0, 1, At, B1); PG8_BAR; PG8_SCHED;
            PG8_LDA(At, 1, 1); PG8_STAGE(PG8_SB(1, 0), b3, voffB); PG8_STAGE(PG8_SB(1, 1), b3 + hstepB, voffB); PG8_STAGE(PG8_SA(1, 0), a3, voffA);
            PG8_WAIT_V(8); PG8_WAIT_L(0); PG8_BAR; PG8_MMA(1, 0, At, B0); PG8_MMA(1, 1, At, B1); PG8_BAR; PG8_SCHED;
            } else {
            PG8_LDB(B0, 0, 0); PG8_SCHED; PG8_LDA(At, 0, 0); PG8_STAGE(PG8_SA(1, 1), a1 + hstepA, voffA);
            PG8_WAIT_L(8); PG8_BAR; PG8_WAIT_L(0); PG8_MMA(0, 0, At, B0); PG8_BAR; PG8_SCHED;
            PG8_LDB(B1, 0, 1); PG8_STAGE(PG8_SB(0, 0), b2, voffB);
            PG8_BAR; PG8_WAIT_L(0); PG8_MMA(0, 1, At, B1); PG8_BAR;
            PG8_LDA(At, 0, 1); PG8_STAGE(PG8_SA(0, 0), a2, voffA);
            PG8_BAR; PG8_WAIT_L(0); PG8_MMA(1, 0, At, B0); PG8_BAR; PG8_SCHED;
            PG8_STAGE(PG8_SB(0, 1), b2 + hstepB, voffB);
            PG8_WAIT_V(6); PG8_BAR; PG8_MMA(1, 1, At, B1); PG8_BAR;
            PG8_LDB(B0, 1, 0); PG8_SCHED; PG8_LDA(At, 1, 0); PG8_STAGE(PG8_SA(0, 1), a2 + hstepA, voffA);
            PG8_WAIT_L(8); PG8_BAR; PG8_WAIT_L(0); PG8_MMA(0, 0, At, B0); PG8_BAR; PG8_SCHED;
            PG8_LDB(B1, 1, 1); PG8_STAGE(PG8_SB(1, 0), b3, voffB);
            PG8_BAR; PG8_WAIT_L(0); PG8_MMA(0, 1, At, B1); PG8_BAR;
            PG8_LDA(At, 1, 1); PG8_STAGE(PG8_SA(1, 0), a3, voffA);
            PG8_BAR; PG8_WAIT_L(0); PG8_MMA(1, 0, At, B0); PG8_BAR; PG8_SCHED;
            PG8_STAGE(PG8_SB(1, 1), b3 + hstepB, voffB);
            PG8_WAIT_V(6); PG8_BAR; PG8_MMA(1, 1, At, B1); PG8_BAR;
            }
        }
        if constexpr (ALIGN_EPI) { if (wr == 0) PG8_BAR; }
        if constexpr (!Epi::AFTER_DRAIN) { E(accw, cur, wr, wc, fr, fq); S.done(cur); }
        const bool keep_acc = Epi::TWOPASS && (cur.pass == 0);
        if (!has_next) break;
        if (!keep_acc) {
#pragma unroll
            for (int a = 0; a < 2; ++a)
#pragma unroll
                for (int b = 0; b < 2; ++b)
#pragma unroll
                    for (int mp = 0; mp < 2; ++mp)
#pragma unroll
                        for (int i = 0; i < 16; ++i) accw[a][b][mp][i] = 0.f;
        }
        cur = nxt; cA = nA; cB = nB; ++ui;
        if constexpr (ALIGN_EPI) { if (wr == 1) PG8_BAR; }
    }
    PG8_WAIT_V(0);
    if constexpr (!ALIGN_EPI) { if (wr == 0) PG8_BAR; }
    PG8_BAR;

#undef PG8_SA
#undef PG8_SB
#undef PG8_STAGE
#undef PG8_LDA
#undef PG8_LDB
#undef PG8_MMA
#undef PG8_F8
#undef PG8_WAIT_V
#undef PG8_WAIT_L
#undef PG8_BAR
#undef PG8_SCHED
}
}


constexpr int NWAVES = 8, NTHREADS = 512;
constexpr int BATCH = 8, SEQ = 4096, T = BATCH * SEQ, DM = 1024;
constexpr int INW = 5448;
constexpr int NPROJ = 5632;
constexpr int LD_HG = 2048, LD_ATT = 768, LD_IDX = 640, LD_GATE = 2048;
constexpr int TOPK = 256;
constexpr int NEXP = 16384;
constexpr float RMS_EPS = 1e-6f;

constexpr size_t MiB = 1u << 20;
constexpr size_t WS_CTL = 0;
constexpr size_t WS_MOD = MiB / 4;
constexpr size_t WS_MODP = MiB / 2;
constexpr size_t WS_WIN = 2 * MiB;
constexpr size_t WS_WQ = 17 * MiB;
constexpr size_t WS_SK = 21 * MiB;
constexpr size_t WS_U = 22 * MiB;
constexpr size_t WS_US = 30 * MiB;
constexpr size_t WS_V = 38 * MiB;
constexpr size_t WS_VS = 46 * MiB;
constexpr size_t WS_K8 = 48 * MiB;
constexpr size_t WS_QHI = 52 * MiB;
constexpr size_t WS_QLO = 68 * MiB;
constexpr size_t WS_WAB8 = 31 * MiB;
constexpr size_t WS_WOUT8 = 32 * MiB;
constexpr size_t WS_WIN8 = 33 * MiB;
constexpr size_t WS_H8 = 48 * MiB;
constexpr size_t WS_H = 86 * MiB;
constexpr size_t WS_HG = 150 * MiB;
constexpr size_t WS_ATT = 278 * MiB;
constexpr size_t WS_IDX = 326 * MiB;
constexpr size_t WS_GATE = 366 * MiB;
constexpr size_t WS_SEL = 494 * MiB;
constexpr size_t WS_EIDX = 48 * MiB;
constexpr size_t WS_PGATE = 64 * MiB;
constexpr size_t WS_END = 510 * MiB;
constexpr size_t WS_MERGED = WS_HG;
constexpr size_t WS_Q = 214 * MiB;
constexpr int H4_NT = 2;
constexpr size_t WS_H4D = 366 * MiB;
constexpr size_t WS_H4S = 416 * MiB;

constexpr int LDS_BYTES = 163840;

typedef unsigned short bf16;
typedef unsigned v4u __attribute__((ext_vector_type(4)));
typedef unsigned v2u __attribute__((ext_vector_type(2)));
typedef float f32x4 __attribute__((ext_vector_type(4)));
typedef float f32x2 __attribute__((ext_vector_type(2)));
typedef short bf16x8 __attribute__((ext_vector_type(8)));
#define LAS __attribute__((address_space(3)))

struct Params {
    const float *x, *c, *w_ada, *b_ada, *norm1_g, *norm2_g, *w_in, *hg_lb, *hg_onorm_g, *q_norm_g, *k_norm_g,
                *w_a, *w_b, *w_out, *peer_wq, *peer_subkeys, *peer_u, *peer_v;
    float* out; unsigned char* ws; int ph_lo, ph_hi;
};

typedef __bf16 bf16x2_hw __attribute__((ext_vector_type(2)));
__device__ __forceinline__ unsigned pk2(float lo, float hi) { const f32x2 v = {lo, hi}; const bf16x2_hw b = __builtin_convertvector(v, bf16x2_hw); return __builtin_bit_cast(unsigned, b); }
__device__ __forceinline__ unsigned f2bf(float f) { return pk2(f, 0.f) & 0xffffu; }
__device__ __forceinline__ float bf2f(unsigned u16v) { return __builtin_bit_cast(float, u16v << 16); }
__device__ __forceinline__ float bflo(unsigned w) { return __builtin_bit_cast(float, w << 16); }
__device__ __forceinline__ float bfhi(unsigned w) { return __builtin_bit_cast(float, w & 0xffff0000u); }
__device__ __forceinline__ float sigmoidf_(float x) { return __builtin_amdgcn_rcpf(1.f + __expf(-x)); }
__device__ __forceinline__ float siluf_(float x) { return x * __builtin_amdgcn_rcpf(1.f + __expf(-x)); }
__device__ __forceinline__ float wave_sum(float v) {
#pragma unroll
    for (int o = 1; o < 64; o <<= 1) v += __shfl_xor(v, o);
    return v;
}
__device__ __forceinline__ float wave_max(float v) {
#pragma unroll
    for (int o = 1; o < 64; o <<= 1) v = fmaxf(v, __shfl_xor(v, o));
    return v;
}
#define LDS_WAIT() asm volatile("s_waitcnt lgkmcnt(0)" ::: "memory")
__device__ __forceinline__ unsigned pk4_fp8(float a, float b, float c, float d) { int w = __builtin_amdgcn_cvt_pk_fp8_f32(a, b, 0, false); w = __builtin_amdgcn_cvt_pk_fp8_f32(c, d, w, true); return (unsigned)w; }

__host__ __device__ __forceinline__ int proj_tile_bf16(int i) { return i < 2 ? i + 2 : i + 6; }
__host__ __device__ __forceinline__ int proj_tile_fp8(int i) { return i < 2 ? i : (i < 6 ? i + 2 : i + 8); }
struct EpiProj {
    static constexpr bool PERM = true, AFTER_DRAIN = false, TWOPASS = false;
    bf16 *HG, *ATT, *IDX, *GATE; int f8;
    __device__ __forceinline__ void operator()(pg8::AccW& acc, const pg8::Unit& u, int wr, int wc, int fr, int fq) const {
        const int pn = f8 ? proj_tile_fp8(u.pn) : proj_tile_bf16(u.pn); bf16* base; int ldc, colt, ncols;
        if (pn < 8) { base = HG; ldc = LD_HG; colt = pn * 256; ncols = LD_HG; }
        else if (pn < 11) { base = ATT; ldc = LD_ATT; colt = (pn - 8) * 256; ncols = LD_ATT; }
        else if (pn < 14) { base = IDX; ldc = LD_IDX; colt = (pn - 11) * 256; ncols = LD_IDX; }
        else { base = GATE; ldc = LD_GATE; colt = (pn - 14) * 256; ncols = LD_GATE; }
        const int row0 = u.pm * 256 + wr * 64 + fr, col0 = colt + wc * 32 + 8 * fq;
#pragma unroll
        for (int ai = 0; ai < 2; ++ai)
#pragma unroll
            for (int m = 0; m < 4; ++m) { bf16* rowp = base + (size_t)(row0 + ai * 128 + m * 16) * ldc + col0;
#pragma unroll
                for (int bj = 0; bj < 2; ++bj) { const pg8::f32x4 v0 = pg8::acc_get(acc, ai, bj, m, 0), v1 = pg8::acc_get(acc, ai, bj, m, 1);
                    v4u w; w.x = pk2(v0[0], v0[1]); w.y = pk2(v0[2], v0[3]); w.z = pk2(v1[0], v1[1]); w.w = pk2(v1[2], v1[3]);
                    if (col0 + bj * 128 < ncols) *(v4u*)(rowp + bj * 128) = w; } }
    }
};
struct EpiMerged {
    static constexpr bool PERM = true, AFTER_DRAIN = false, TWOPASS = true;
    const bf16* GATE; bf16* O;
    __device__ __forceinline__ void operator()(pg8::AccW& acc, const pg8::Unit& u, int wr, int wc, int fr, int fq) const {
        const int row0 = u.pm * 256 + wr * 64 + fr, col0 = u.pn * 256 + wc * 32 + 8 * fq;
        if (u.pass == 0) {
#pragma unroll
            for (int ai = 0; ai < 2; ++ai)
#pragma unroll
                for (int m = 0; m < 4; ++m) { const bf16* rowp = GATE + (size_t)(row0 + ai * 128 + m * 16) * LD_GATE + col0;
#pragma unroll
                    for (int bj = 0; bj < 2; ++bj) { const v4u a = *(const v4u*)(rowp + bj * 128), b = *(const v4u*)(rowp + 1024 + bj * 128);
                        float r[8];
#pragma unroll
                        for (int i = 0; i < 4; ++i) { const float a0 = bflo(a[i]), a1 = bfhi(a[i]), b0 = bflo(b[i]), b1 = bfhi(b[i]);
                            r[2 * i] = (1.f + __expf(-b0)) * __builtin_amdgcn_rcpf(1.f + __expf(-a0)); r[2 * i + 1] = (1.f + __expf(-b1)) * __builtin_amdgcn_rcpf(1.f + __expf(-a1)); }
                        { pg8::f32x4 c0 = pg8::acc_get(acc, ai, bj, m, 0), c1 = pg8::acc_get(acc, ai, bj, m, 1);
#pragma unroll
                          for (int i = 0; i < 4; ++i) { c0[i] *= r[i]; c1[i] *= r[4 + i]; }
                          pg8::acc_set(acc, ai, bj, m, 0, c0); pg8::acc_set(acc, ai, bj, m, 1, c1); } } }
        } else {
#pragma unroll
            for (int ai = 0; ai < 2; ++ai)
#pragma unroll
                for (int m = 0; m < 4; ++m) { const size_t ro = (size_t)(row0 + ai * 128 + m * 16);
#pragma unroll
                    for (int bj = 0; bj < 2; ++bj) { const v4u b = *(const v4u*)(GATE + ro * LD_GATE + 1024 + col0 + bj * 128);
                        const pg8::f32x4 v0 = pg8::acc_get(acc, ai, bj, m, 0), v1 = pg8::acc_get(acc, ai, bj, m, 1);
                        float s[8];
#pragma unroll
                        for (int i = 0; i < 4; ++i) { s[2 * i] = sigmoidf_(bflo(b[i])); s[2 * i + 1] = sigmoidf_(bfhi(b[i])); }
                        v2u w; w.x = pk4_fp8(4.f * v0[0] * s[0], 4.f * v0[1] * s[1], 4.f * v0[2] * s[2], 4.f * v0[3] * s[3]); w.y = pk4_fp8(4.f * v1[0] * s[4], 4.f * v1[1] * s[5], 4.f * v1[2] * s[6], 4.f * v1[3] * s[7]);
                        *(v2u*)((unsigned char*)O + ro * 1024 + col0 + bj * 128) = w; } }
        }
    }
};
struct EpiResid {
    static constexpr bool PERM = true, AFTER_DRAIN = false, TWOPASS = false;
    const float* X; const float* G1  ; float* O;
    __device__ __forceinline__ void operator()(pg8::AccW& acc, const pg8::Unit& u, int wr, int wc, int fr, int fq) const {
        const int row0 = u.pm * 256 + wr * 64 + fr, col0 = u.pn * 256 + wc * 32 + 8 * fq;
        const int b = (u.pm * 256) / SEQ;
        f32x4 g[2][2];
#pragma unroll
        for (int bj = 0; bj < 2; ++bj)
#pragma unroll
            for (int n = 0; n < 2; ++n) g[bj][n] = *(const f32x4*)(G1 + (size_t)b * 6144 + col0 + bj * 128 + 4 * n);
#pragma unroll
        for (int ai = 0; ai < 2; ++ai)
#pragma unroll
            for (int m = 0; m < 4; ++m) { const size_t ro = (size_t)(row0 + ai * 128 + m * 16) * DM + col0;
#pragma unroll
                for (int bj = 0; bj < 2; ++bj)
#pragma unroll
                    for (int n = 0; n < 2; ++n) { const f32x4 xv = *(const f32x4*)(X + ro + bj * 128 + 4 * n);
                        *(f32x4*)(O + ro + bj * 128 + 4 * n) = xv + g[bj][n] * pg8::acc_get(acc, ai, bj, m, n); } }
    }
};
struct EpiStore {
    static constexpr bool PERM = true, AFTER_DRAIN = false, TWOPASS = false;
    bf16* O; int ldc;
    __device__ __forceinline__ void operator()(pg8::AccW& acc, const pg8::Unit& u, int wr, int wc, int fr, int fq) const {
        const int row0 = u.pm * 256 + wr * 64 + fr, col0 = u.pn * 256 + wc * 32 + 8 * fq;
#pragma unroll
        for (int ai = 0; ai < 2; ++ai)
#pragma unroll
            for (int m = 0; m < 4; ++m) { bf16* rowp = O + (size_t)(row0 + ai * 128 + m * 16) * ldc + col0;
#pragma unroll
                for (int bj = 0; bj < 2; ++bj) { const pg8::f32x4 v0 = pg8::acc_get(acc, ai, bj, m, 0), v1 = pg8::acc_get(acc, ai, bj, m, 1);
                    v4u w; w.x = pk2(v0[0], v0[1]); w.y = pk2(v0[2], v0[3]); w.z = pk2(v1[0], v1[1]); w.w = pk2(v1[2], v1[3]);
                    *(v4u*)(rowp + bj * 128) = w; } }
    }
};

template <int MODE> __device__ __forceinline__ int srcmap(int np) {
    if (MODE == 2) np = proj_tile_bf16(np >> 8) * 256 + (np & 255);
    if (MODE == 3) np = proj_tile_fp8(np >> 8) * 256 + (np & 255);
    if (MODE >= 1) return np < 3400 ? np : (np >= 3584 ? np - 184 : -1);
    return np; }
template <int MODE>
__device__ __forceinline__ void transpose_item(const float* W, int N, bf16* WT, int ldw, int koff, float* scr, int kb, int nb, int lane) {
    const int k0 = 64 * kb, n0 = 32 * nb;
    const int sc = srcmap<MODE>(n0 + (lane & 31));
#pragma unroll 8
    for (int i = 0; i < 32; ++i) { const int kk = 2 * i + (lane >> 5); scr[kk * 33 + (lane & 31)] = (sc >= 0) ? W[(size_t)(k0 + kk) * N + sc] : 0.f; }
    LDS_WAIT(); __builtin_amdgcn_wave_barrier();
    const int c = lane & 7;
#pragma unroll
    for (int j = 0; j < 4; ++j) { const int n = (lane >> 3) + 8 * j; const float* s = scr + (8 * c) * 33 + n;
        v4u o; o.x = pk2(s[0 * 33], s[1 * 33]); o.y = pk2(s[2 * 33], s[3 * 33]); o.z = pk2(s[4 * 33], s[5 * 33]); o.w = pk2(s[6 * 33], s[7 * 33]);
        *(v4u*)(WT + (size_t)(n0 + n) * ldw + koff + k0 + 8 * c) = o; }
    LDS_WAIT(); __builtin_amdgcn_wave_barrier();
}
template <int MODE> __device__ __forceinline__ int srcmap(int np);
template <int MODE = 0>
__device__ __forceinline__ void transpose_item8(const float* W, int N, unsigned char* WT, int ldw, int koff, float scale, float* scr, int kb, int nb, int lane) {
    const int k0 = 64 * kb, n0 = 32 * nb;
    const int sc = srcmap<MODE>(n0 + (lane & 31));
#pragma unroll 8
    for (int i = 0; i < 32; ++i) { const int kk = 2 * i + (lane >> 5); scr[kk * 33 + (lane & 31)] = (sc >= 0) ? W[(size_t)(k0 + kk) * N + sc] * scale : 0.f; }
    LDS_WAIT(); __builtin_amdgcn_wave_barrier();
    const int c = lane & 3;
#pragma unroll
    for (int j = 0; j < 2; ++j) { const int n = (lane >> 2) + 16 * j; const float* sp = scr + (16 * c) * 33 + n;
        v4u o;
#pragma unroll
        for (int q = 0; q < 4; ++q) o[q] = pk4_fp8(sp[(4 * q) * 33], sp[(4 * q + 1) * 33], sp[(4 * q + 2) * 33], sp[(4 * q + 3) * 33]);
        *(v4u*)(WT + (size_t)(n0 + n) * ldw + koff + k0 + 16 * c) = o; }
    LDS_WAIT(); __builtin_amdgcn_wave_barrier();
}
__device__ __forceinline__ void convert_plain(const float* src, bf16* dst, size_t n, size_t gtid, size_t nth) {
    const size_t n8 = n / 8;
    for (size_t i = gtid; i < n8; i += nth) { const f32x4 a = ((const f32x4*)src)[2 * i], b = ((const f32x4*)src)[2 * i + 1];
        v4u o; o.x = pk2(a[0], a[1]); o.y = pk2(a[2], a[3]); o.z = pk2(b[0], b[1]); o.w = pk2(b[2], b[3]); ((v4u*)dst)[i] = o; }
}
__device__ __forceinline__ void convert_fp8(const float* src, unsigned char* dst, size_t n, float scale, size_t gtid, size_t nth) {
    const size_t n16 = n / 16;
    for (size_t i = gtid; i < n16; i += nth) { const f32x4* sp = (const f32x4*)src + 4 * i; const f32x4 a = sp[0] * scale, b = sp[1] * scale, c = sp[2] * scale, d = sp[3] * scale;
        v4u o; o.x = pk4_fp8(a[0], a[1], a[2], a[3]); o.y = pk4_fp8(b[0], b[1], b[2], b[3]); o.z = pk4_fp8(c[0], c[1], c[2], c[3]); o.w = pk4_fp8(d[0], d[1], d[2], d[3]); ((v4u*)dst)[i] = o; }
}
template <bool KKMAJOR>
__device__ __forceinline__ void convert_mxfp4(const float* src, unsigned char* dst, unsigned char* scl, size_t nrows, size_t gtid, size_t nth) {
    const size_t nblk = nrows * 32;
    for (size_t i = gtid; i < nblk; i += nth) {
        const size_t row = i >> 5; const int blk = (int)(i & 31);
        const f32x4* sp = (const f32x4*)(src + row * 1024 + blk * 32);
        f32x4 v[8]; float amax = 0.f;
#pragma unroll
        for (int j = 0; j < 8; ++j) { v[j] = sp[j]; amax = fmaxf(fmaxf(fmaxf(fabsf(v[j][0]), fabsf(v[j][1])), fmaxf(fabsf(v[j][2]), fabsf(v[j][3]))), amax); }
        int e = (int)((__builtin_bit_cast(unsigned, amax) >> 23) & 0xffu) - 127 - 2;
        if (e < -126) e = -126;
        const float inv = __builtin_bit_cast(float, (unsigned)(127 - e) << 23);
        unsigned w[4] = {0u, 0u, 0u, 0u};
#pragma unroll
        for (int j = 0; j < 8; j += 2) { unsigned t = 0u;
            t = __builtin_amdgcn_cvt_scalef32_pk_fp4_f32(t, v[j][0] * inv, v[j][1] * inv, 1.0f, 0);
            t = __builtin_amdgcn_cvt_scalef32_pk_fp4_f32(t, v[j][2] * inv, v[j][3] * inv, 1.0f, 1);
            t = __builtin_amdgcn_cvt_scalef32_pk_fp4_f32(t, v[j + 1][0] * inv, v[j + 1][1] * inv, 1.0f, 2);
            t = __builtin_amdgcn_cvt_scalef32_pk_fp4_f32(t, v[j + 1][2] * inv, v[j + 1][3] * inv, 1.0f, 3);
            w[j >> 1] = t; }
        *(v4u*)(dst + row * 512 + blk * 16) = (v4u){w[0], w[1], w[2], w[3]};
        scl[row * 32 + (KKMAJOR ? ((blk & 3) * 8 + (blk >> 2)) : blk)] = (unsigned char)(e + 127);
    }
}
__device__ __forceinline__ void convert_rowfp4(const float* src, unsigned char* dst, _Float16* scl, int row, int lane) {
    const f32x4* sp = (const f32x4*)(src + (size_t)row * 1024 + lane * 16);
    f32x4 v[4]; float amax = 0.f;
#pragma unroll
    for (int j = 0; j < 4; ++j) { v[j] = sp[j]; amax = fmaxf(fmaxf(fmaxf(fabsf(v[j][0]), fabsf(v[j][1])), fmaxf(fabsf(v[j][2]), fabsf(v[j][3]))), amax); }
    amax = wave_max(amax);
    _Float16 sh = (_Float16)(amax * (1.f / 6.f));
    float sf = (float)sh; if (!(sf > 0.f)) { sf = 1.f; sh = (_Float16)1.f; }
    const float inv = 1.f / sf;
    unsigned w[2];
#pragma unroll
    for (int j = 0; j < 2; ++j) { unsigned t = 0u;
        t = __builtin_amdgcn_cvt_scalef32_pk_fp4_f32(t, v[2 * j][0] * inv, v[2 * j][1] * inv, 1.0f, 0);
        t = __builtin_amdgcn_cvt_scalef32_pk_fp4_f32(t, v[2 * j][2] * inv, v[2 * j][3] * inv, 1.0f, 1);
        t = __builtin_amdgcn_cvt_scalef32_pk_fp4_f32(t, v[2 * j + 1][0] * inv, v[2 * j + 1][1] * inv, 1.0f, 2);
        t = __builtin_amdgcn_cvt_scalef32_pk_fp4_f32(t, v[2 * j + 1][2] * inv, v[2 * j + 1][3] * inv, 1.0f, 3);
        w[j] = t; }
    *(v2u*)(dst + (size_t)row * 512 + lane * 8) = (v2u){w[0], w[1]};
    if (lane == 0) scl[row] = sh;
}
__device__ __forceinline__ void phase0(const Params& p, unsigned char* lds) {
    const int tid = threadIdx.x, wave = tid >> 6, lane = tid & 63, G = gridDim.x;
    const int gw = blockIdx.x * NWAVES + wave, NGW = G * NWAVES;
    float* scr = (float*)(lds + wave * 16384);
    unsigned char* ws = p.ws;
    constexpr int I_IN = 16 * (2048 / 32), I_IN8 = 16 * (3584 / 32), I_A = 8 * 32, I_O = 16 * 32, I_Q = 16 * 64;
    constexpr int NT = I_IN + I_IN8 + 2 * I_A + I_O + I_Q;
    for (int it = gw; it < NT; it += NGW) {
        int r = it;
        if (r < I_IN) { transpose_item<2>(p.w_in, INW, (bf16*)(ws + WS_WIN), 1024, 0, scr, r / 64, r % 64, lane); continue; } r -= I_IN;
        if (r < I_IN8) { transpose_item8<3>(p.w_in, INW, ws + WS_WIN8, 1024, 0, 32.f, scr, r / 112, r % 112, lane); continue; } r -= I_IN8;
        if (r < I_A) { transpose_item8(p.w_a, 1024, ws + WS_WAB8, 1024, 0, 32.f, scr, r / 32, r % 32, lane); continue; } r -= I_A;
        if (r < I_A) { transpose_item8(p.w_b, 1024, ws + WS_WAB8, 1024, 512, 4.f, scr, r / 32, r % 32, lane); continue; } r -= I_A;
        if (r < I_O) { transpose_item8(p.w_out, 1024, ws + WS_WOUT8, 1024, 0, 32.f, scr, r / 32, r % 32, lane); continue; } r -= I_O;
        transpose_item<0>(p.peer_wq, 2048, (bf16*)(ws + WS_WQ), 1024, 0, scr, r / 64, r % 64, lane);
    }
    for (int it = gw; it < 96 * 8; it += NGW) {
        const int cgp = it % 96, ks = it / 96, col = cgp * 64 + lane, k0 = ks * 128;
#pragma unroll
        for (int i = 0; i < 16; ++i) { const int e = i * 64 + lane, b = e >> 7, k = e & 127; scr[e] = siluf_(p.c[b * 1024 + k0 + k]); }
        LDS_WAIT(); __builtin_amdgcn_wave_barrier();
        float acc[8];
#pragma unroll
        for (int b = 0; b < 8; ++b) acc[b] = 0.f;
#pragma unroll 4
        for (int k = 0; k < 128; ++k) { const float w = p.w_ada[(size_t)(k0 + k) * 6144 + col];
#pragma unroll
            for (int b = 0; b < 8; ++b) acc[b] += scr[b * 128 + k] * w; }
        float* mp = (float*)(ws + WS_MODP) + (size_t)ks * 8 * 6144 + col;
#pragma unroll
        for (int b = 0; b < 8; ++b) mp[b * 6144] = acc[b];
        LDS_WAIT(); __builtin_amdgcn_wave_barrier();
    }
    const size_t gtid = (size_t)blockIdx.x * NTHREADS + tid, nth = (size_t)G * NTHREADS;
    convert_plain(p.peer_subkeys, (bf16*)(ws + WS_SK), (size_t)16 * 128 * 128, gtid, nth);
    for (int it = gw; it < 2 * NEXP; it += NGW) {
        if (it < NEXP) convert_rowfp4(p.peer_u, ws + WS_U, (_Float16*)(ws + WS_US), it, lane);
        else convert_rowfp4(p.peer_v, ws + WS_V, (_Float16*)(ws + WS_VS), it - NEXP, lane);
    }
}

template <bool FIRST>
__device__ __forceinline__ void normmod_phase(const Params& p, unsigned char* lds, const float* src, bf16* dst, const float* gvec, int shift_off, int scale_off) {
    const int tid = threadIdx.x, wave = tid >> 6, lane = tid & 63, G = gridDim.x;
    unsigned char* ws = p.ws;
    float* A = (float*)lds;
    float* Bv = A + 1024;
    const float* MODP = (const float*)(ws + WS_MODP);
    float* MOD = (float*)(ws + WS_MOD);
    if (FIRST) {
        for (int e = blockIdx.x * NTHREADS + tid; e < 8 * 6144; e += G * NTHREADS) { const int col = e % 6144; float s = p.b_ada[col];
#pragma unroll
            for (int ks = 0; ks < 8; ++ks) s += MODP[(size_t)ks * 8 * 6144 + e];
            MOD[e] = s; }
    }
    int curb = -1;
    for (int chunk = blockIdx.x; chunk < T / 128; chunk += G) {
        const int b = (chunk * 128) / SEQ;
        if (b != curb) {
            __syncthreads();
            for (int col = tid; col < 1024; col += NTHREADS) {
                float sc, sh;
                if (FIRST) { sc = p.b_ada[scale_off + col]; sh = p.b_ada[shift_off + col];
#pragma unroll
                    for (int ks = 0; ks < 8; ++ks) { sc += MODP[(size_t)(ks * 8 + b) * 6144 + scale_off + col]; sh += MODP[(size_t)(ks * 8 + b) * 6144 + shift_off + col]; } }
                else { sc = MOD[b * 6144 + scale_off + col]; sh = MOD[b * 6144 + shift_off + col]; }
                A[col] = gvec[col] * (1.f + sc); Bv[col] = sh; }
            __syncthreads(); curb = b;
        }
        for (int r = wave; r < 128; r += NWAVES) {
            const size_t row = (size_t)chunk * 128 + r;
            const f32x4* xr = (const f32x4*)(src + row * DM) + lane;
            f32x4 v[4]; float s = 0.f;
#pragma unroll
            for (int j = 0; j < 4; ++j) { v[j] = xr[64 * j]; s += (v[j][0] * v[j][0] + v[j][1] * v[j][1]) + (v[j][2] * v[j][2] + v[j][3] * v[j][3]); }
            const float rstd = rsqrtf(wave_sum(s) * (1.f / DM) + RMS_EPS);
            v2u* o8 = (v2u*)(dst + row * DM) + lane;
#pragma unroll
            for (int j = 0; j < 4; ++j) { const int c0 = 4 * lane + 256 * j; const f32x4 a = *(const f32x4*)(A + c0), sh = *(const f32x4*)(Bv + c0);
                v2u o; o.x = pk2(v[j][0] * rstd * a[0] + sh[0], v[j][1] * rstd * a[1] + sh[1]); o.y = pk2(v[j][2] * rstd * a[2] + sh[2], v[j][3] * rstd * a[3] + sh[3]);
                o8[64 * j] = o;
                if (FIRST) *(unsigned*)(ws + WS_H8 + row * DM + c0) = pk4_fp8(v[j][0] * rstd * a[0] + sh[0], v[j][1] * rstd * a[1] + sh[1], v[j][2] * rstd * a[2] + sh[2], v[j][3] * rstd * a[3] + sh[3]);
                if (!FIRST) { float* st = (float*)(lds + 8192) + wave * 1056;
                    const float y0 = v[j][0] * rstd * a[0] + sh[0], y1 = v[j][1] * rstd * a[1] + sh[1], y2 = v[j][2] * rstd * a[2] + sh[2], y3 = v[j][3] * rstd * a[3] + sh[3];
                    const int pc = c0 + (c0 >> 5); st[pc] = y0; st[pc + 1] = y1; st[pc + 2] = y2; st[pc + 3] = y3; } }
            if (!FIRST) {
                const float* st = (const float*)(lds + 8192) + wave * 1056;
                LDS_WAIT(); __builtin_amdgcn_wave_barrier();
                if (lane < 32) {
                    float x[32];
#pragma unroll
                    for (int k = 0; k < 32; ++k) x[k] = st[lane * 33 + k];
#pragma unroll
                    for (int t = 0; t < H4_NT; ++t) {
                        float amax = 0.f;
#pragma unroll
                        for (int k = 0; k < 32; ++k) amax = fmaxf(amax, fabsf(x[k]));
                        int e = (int)((__builtin_bit_cast(unsigned, amax) >> 23) & 0xffu) - 127 - 2; if (e < -126) e = -126;
                        const float inv = __builtin_bit_cast(float, (unsigned)(127 - e) << 23), sc = __builtin_bit_cast(float, (unsigned)(127 + e) << 23);
                        unsigned w[4];
#pragma unroll
                        for (int r = 0; r < 4; ++r) { unsigned tw = 0u;
                            tw = __builtin_amdgcn_cvt_scalef32_pk_fp4_f32(tw, x[8 * r] * inv, x[8 * r + 1] * inv, 1.0f, 0);
                            tw = __builtin_amdgcn_cvt_scalef32_pk_fp4_f32(tw, x[8 * r + 2] * inv, x[8 * r + 3] * inv, 1.0f, 1);
                            tw = __builtin_amdgcn_cvt_scalef32_pk_fp4_f32(tw, x[8 * r + 4] * inv, x[8 * r + 5] * inv, 1.0f, 2);
                            tw = __builtin_amdgcn_cvt_scalef32_pk_fp4_f32(tw, x[8 * r + 6] * inv, x[8 * r + 7] * inv, 1.0f, 3);
                            w[r] = tw;
                            const f32x2 d0 = __builtin_amdgcn_cvt_scalef32_pk_f32_fp4(tw, 1.0f, 0), d1 = __builtin_amdgcn_cvt_scalef32_pk_f32_fp4(tw, 1.0f, 1), d2 = __builtin_amdgcn_cvt_scalef32_pk_f32_fp4(tw, 1.0f, 2), d3 = __builtin_amdgcn_cvt_scalef32_pk_f32_fp4(tw, 1.0f, 3);
                            x[8 * r] -= d0[0] * sc; x[8 * r + 1] -= d0[1] * sc; x[8 * r + 2] -= d1[0] * sc; x[8 * r + 3] -= d1[1] * sc;
                            x[8 * r + 4] -= d2[0] * sc; x[8 * r + 5] -= d2[1] * sc; x[8 * r + 6] -= d3[0] * sc; x[8 * r + 7] -= d3[1] * sc; }
                        *(v4u*)(ws + WS_H4D + (row * H4_NT + t) * 512 + lane * 16) = (v4u){w[0], w[1], w[2], w[3]};
                        *(ws + WS_H4S + (row * H4_NT + t) * 32 + (lane & 3) * 8 + (lane >> 2)) = (unsigned char)(e + 127);
                    }
                }
                LDS_WAIT(); __builtin_amdgcn_wave_barrier();
            }
        }
    }
    __syncthreads();
}

constexpr int HGL_QT = 0, HGL_KT = 17408, HGL_QE = 34816, HGL_KLT = 52224, HGL_VT = 70656, HGL_AM = 89088, HGL_DEC = 98304, HGL_TOT = 98816, HGL_SSQ = 100864;
constexpr int HG_LDR = 136;
constexpr int HG_LDC = 72;
__device__ __forceinline__ void hgrn_item(const Params& p, unsigned char* lds, int item) {
    const int b = item >> 2, h = item & 3;
    const int tid = threadIdx.x, w = tid >> 6, lane = tid & 63, fr = lane & 15, fq = lane >> 4;
    unsigned char* ws = p.ws;
    const bf16* HG = (const bf16*)(ws + WS_HG);
    bf16* YA = (bf16*)(ws + WS_H);
    bf16* QT = (bf16*)(lds + HGL_QT); bf16* KT = (bf16*)(lds + HGL_KT); bf16* QE = (bf16*)(lds + HGL_QE);
    bf16* KLT = (bf16*)(lds + HGL_KLT); bf16* VT = (bf16*)(lds + HGL_VT); bf16* AM = (bf16*)(lds + HGL_AM);
    float* DEC = (float*)(lds + HGL_DEC); float* TOT = (float*)(lds + HGL_TOT); float* SSQ = (float*)(lds + HGL_SSQ);
    const int pd = tid & 127, pq = tid >> 7;
    float lbv; { const float a0 = p.hg_lb[h * 128 + pd], a1 = p.hg_lb[512 + h * 128 + pd]; lbv = 1.f / (1.f + __expf(a1 - a0)); }
    const int e0 = w * 16;
    const float ogv = p.hg_onorm_g[e0 + fr];
    pg8::f32x4 S[8];
#pragma unroll
    for (int i = 0; i < 8; ++i) S[i] = (pg8::f32x4){0.f, 0.f, 0.f, 0.f};
    const size_t rowb = (size_t)b * SEQ;
    unsigned short rq[16], rf[16], rv[16];
    { const bf16* gp = HG + (rowb + pq * 16) * LD_HG + h * 128 + pd;
#pragma unroll
      for (int i = 0; i < 16; ++i) { rq[i] = gp[(size_t)i * LD_HG]; rf[i] = gp[(size_t)i * LD_HG + 512]; rv[i] = gp[(size_t)i * LD_HG + 1024]; } }
    for (int chunk = 0; chunk < SEQ / 64; ++chunk) {
        const size_t row0 = rowb + (size_t)chunk * 64;
        float fq_[16], kq_[16], cs[16];
        float run = 0.f;
#pragma unroll
        for (int i = 0; i < 16; ++i) { const float f = lbv + (1.f - lbv) * sigmoidf_(bf2f(rf[i])); kq_[i] = 1.f - f; run += __logf(f); cs[i] = run; fq_[i] = siluf_(bf2f(rq[i])); }
        TOT[pq * 128 + pd] = run;
        { v4u v0, v1;
          v0.x = rv[0] | ((unsigned)rv[1] << 16); v0.y = rv[2] | ((unsigned)rv[3] << 16); v0.z = rv[4] | ((unsigned)rv[5] << 16); v0.w = rv[6] | ((unsigned)rv[7] << 16);
          v1.x = rv[8] | ((unsigned)rv[9] << 16); v1.y = rv[10] | ((unsigned)rv[11] << 16); v1.z = rv[12] | ((unsigned)rv[13] << 16); v1.w = rv[14] | ((unsigned)rv[15] << 16);
          *(v4u*)(VT + pd * HG_LDC + pq * 16) = v0; *(v4u*)(VT + pd * HG_LDC + pq * 16 + 8) = v1; }
        unsigned short rg[16];
#pragma unroll
        for (int i = 0; i < 16; ++i) rg[i] = HG[(row0 + (i >> 2) * 16 + fq * 4 + (i & 3)) * LD_HG + 1536 + h * 128 + e0 + fr];
        if (chunk + 1 < SEQ / 64) { const bf16* gp = HG + (row0 + 64 + pq * 16) * LD_HG + h * 128 + pd;
#pragma unroll
            for (int i = 0; i < 16; ++i) { rq[i] = gp[(size_t)i * LD_HG]; rf[i] = gp[(size_t)i * LD_HG + 512]; rv[i] = gp[(size_t)i * LD_HG + 1024]; } }
        __syncthreads();
        const float t0 = TOT[pd], t1 = TOT[128 + pd], t2 = TOT[256 + pd], t3 = TOT[384 + pd];
        const float base = (pq > 0 ? t0 : 0.f) + (pq > 1 ? t1 : 0.f) + (pq > 2 ? t2 : 0.f);
        const float bmid = t0 + t1, blast = (t0 + t1) + (t2 + t3);
        const float emid = __expf(bmid), elm = __expf(blast - bmid);
        if (pq == 0) DEC[pd] = __expf(blast);
        { unsigned klp[8];
#pragma unroll
          for (int i = 0; i < 16; ++i) { const float bb = base + cs[i]; const float E1 = __expf(bb - bmid), R1 = __builtin_amdgcn_rcpf(E1);
              const float qtv = fq_[i] * E1, ktv = kq_[i] * R1, qev = qtv * emid, klv = ktv * elm;
              const int srow = pq * 16 + i;
              QT[srow * HG_LDR + pd] = (bf16)f2bf(qtv); KT[srow * HG_LDR + pd] = (bf16)f2bf(ktv); QE[srow * HG_LDR + pd] = (bf16)f2bf(qev);
              if (i & 1) klp[i >> 1] |= f2bf(klv) << 16; else klp[i >> 1] = f2bf(klv); }
          *(v4u*)(KLT + pd * HG_LDC + pq * 16) = (v4u){klp[0], klp[1], klp[2], klp[3]}; *(v4u*)(KLT + pd * HG_LDC + pq * 16 + 8) = (v4u){klp[4], klp[5], klp[6], klp[7]}; }
        __syncthreads();
#pragma unroll
        for (int tt = 0; tt < 2; ++tt) { const int id = w + 8 * tt, rt = id >> 2, ct = id & 3;
            pg8::f32x4 a = {0.f, 0.f, 0.f, 0.f};
            if (ct <= rt) {
#pragma unroll
                for (int ks = 0; ks < 4; ++ks) { const bf16x8 af = *(const bf16x8*)(QT + (rt * 16 + fr) * HG_LDR + ks * 32 + fq * 8), bfv = *(const bf16x8*)(KT + (ct * 16 + fr) * HG_LDR + ks * 32 + fq * 8);
                    a = __builtin_amdgcn_mfma_f32_16x16x32_bf16(af, bfv, a, 0, 0, 0); } }
#pragma unroll
            for (int r = 0; r < 4; ++r) { const int c = rt * 16 + fq * 4 + r, sidx = ct * 16 + fr; AM[c * HG_LDC + sidx] = (bf16)((sidx <= c) ? f2bf(a[r]) : 0u); } }
        __syncthreads();
        const bf16x8 vb0 = *(const bf16x8*)(VT + (e0 + fr) * HG_LDC + fq * 8), vb1 = *(const bf16x8*)(VT + (e0 + fr) * HG_LDC + 32 + fq * 8);
        bf16x8 sb[4];
#pragma unroll
        for (int ks = 0; ks < 4; ++ks) { v4u t; t.x = pk2(S[2 * ks][0], S[2 * ks][1]); t.y = pk2(S[2 * ks][2], S[2 * ks][3]); t.z = pk2(S[2 * ks + 1][0], S[2 * ks + 1][1]); t.w = pk2(S[2 * ks + 1][2], S[2 * ks + 1][3]); sb[ks] = __builtin_bit_cast(bf16x8, t); }
        pg8::f32x4 o[4];
#pragma unroll
        for (int rt = 0; rt < 4; ++rt) { pg8::f32x4 a = {0.f, 0.f, 0.f, 0.f};
            a = __builtin_amdgcn_mfma_f32_16x16x32_bf16(*(const bf16x8*)(AM + (rt * 16 + fr) * HG_LDC + fq * 8), vb0, a, 0, 0, 0);
            a = __builtin_amdgcn_mfma_f32_16x16x32_bf16(*(const bf16x8*)(AM + (rt * 16 + fr) * HG_LDC + 32 + fq * 8), vb1, a, 0, 0, 0);
#pragma unroll
            for (int ks = 0; ks < 4; ++ks) { const v2u lo = *(const v2u*)(QE + (rt * 16 + fr) * HG_LDR + ks * 32 + fq * 4), hi = *(const v2u*)(QE + (rt * 16 + fr) * HG_LDR + ks * 32 + 16 + fq * 4);
                const v4u t = {lo.x, lo.y, hi.x, hi.y};
                a = __builtin_amdgcn_mfma_f32_16x16x32_bf16(__builtin_bit_cast(bf16x8, t), sb[ks], a, 0, 0, 0); }
            o[rt] = a; }
#pragma unroll
        for (int dt = 0; dt < 8; ++dt) { const f32x4 dc = *(const f32x4*)(DEC + dt * 16 + fq * 4);
            pg8::f32x4 a = S[dt]; a[0] *= dc[0]; a[1] *= dc[1]; a[2] *= dc[2]; a[3] *= dc[3];
            a = __builtin_amdgcn_mfma_f32_16x16x32_bf16(*(const bf16x8*)(KLT + (dt * 16 + fr) * HG_LDC + fq * 8), vb0, a, 0, 0, 0);
            a = __builtin_amdgcn_mfma_f32_16x16x32_bf16(*(const bf16x8*)(KLT + (dt * 16 + fr) * HG_LDC + 32 + fq * 8), vb1, a, 0, 0, 0);
            S[dt] = a; }
#pragma unroll
        for (int rt = 0; rt < 4; ++rt)
#pragma unroll
            for (int r = 0; r < 4; ++r) { float x = o[rt][r] * o[rt][r];
                x += __shfl_xor(x, 1); x += __shfl_xor(x, 2); x += __shfl_xor(x, 4); x += __shfl_xor(x, 8);
                if (fr == 0) SSQ[w * 64 + rt * 16 + fq * 4 + r] = x; }
        __syncthreads();
        float tot = 0.f;
#pragma unroll
        for (int ww = 0; ww < 8; ++ww) tot += SSQ[ww * 64 + lane];
        const float rstd_l = rsqrtf(tot * (1.f / 128.f) + RMS_EPS);
#pragma unroll
        for (int rt = 0; rt < 4; ++rt)
#pragma unroll
            for (int r = 0; r < 4; ++r) { const int c = rt * 16 + fq * 4 + r; const float rs = __shfl(rstd_l, c);
                const float y = o[rt][r] * rs * ogv * siluf_(bf2f(rg[rt * 4 + r]));
                ((unsigned char*)YA)[(row0 + c) * 1024 + h * 128 + e0 + fr] = (unsigned char)(__builtin_amdgcn_cvt_pk_fp8_f32(y, 0.f, 0, false) & 0xff); }
    }
    __syncthreads();
}

__device__ __forceinline__ unsigned f16key(float x) {
    x = x + 0.f;
    const _Float16 hx = (_Float16)x; const unsigned short bits = __builtin_bit_cast(unsigned short, hx);
    return (bits & 0x8000u) ? (unsigned)(unsigned short)(~bits) : (unsigned)(bits | 0x8000u);
}
__device__ __forceinline__ void find_bin(const unsigned* hist, int K, int lane, int& bin, int& rem) {
    const v4u hv = *(const v4u*)(hist + 4 * lane);
    const unsigned c = hv.x + hv.y + hv.z + hv.w;
    unsigned suf = c;
#pragma unroll
    for (int o = 1; o < 64; o <<= 1) { const unsigned t = __shfl_down(suf, o); if (lane + o < 64) suf += t; }
    const unsigned above = suf - c;
    const bool mine = (above < (unsigned)K) && ((unsigned)K <= suf);
    int mybin = 0, myrem = 0;
    if (mine) { unsigned ca = above; const unsigned hh[4] = {hv.x, hv.y, hv.z, hv.w}; bool found = false;
#pragma unroll
        for (int i = 3; i >= 0; --i) { if (!found) { if (ca + hh[i] >= (unsigned)K) { mybin = 4 * lane + i; myrem = K - (int)ca; found = true; } else ca += hh[i]; } } }
    const unsigned long long m = __ballot(mine);
    const int src = (int)__builtin_ctzll(m | (1ull << 63));
    bin = __shfl(mybin, src); rem = __shfl(myrem, src);
}
__device__ __forceinline__ void dsa1_item(const Params& p, unsigned char* lds, int item) {
    const int b = item >> 8, q0 = (item & 255) * 16;
    const int tid = threadIdx.x, w = tid >> 6, lane = tid & 63, fr = lane & 15, fq = lane >> 4;
    unsigned char* ws = p.ws;
    const bf16* IDX = (const bf16*)(ws + WS_IDX);
    unsigned short* Ik = (unsigned short*)lds;
    unsigned* hist1 = (unsigned*)(lds + 131072);
    unsigned* hist = (unsigned*)(lds + 131072 + 16384) + w * 256;
    const size_t rowb = (size_t)b * SEQ;
    *(v4u*)(hist1 + tid * 4) = (v4u){0u, 0u, 0u, 0u}; *(v4u*)(hist1 + 2048 + tid * 4) = (v4u){0u, 0u, 0u, 0u};
    bf16x8 Af[8][2];
    { const bf16* rp = IDX + (rowb + q0 + fr) * LD_IDX + fq * 8;
#pragma unroll
      for (int h = 0; h < 8; ++h) { Af[h][0] = *(const bf16x8*)(rp + h * 64); Af[h][1] = *(const bf16x8*)(rp + h * 64 + 32); } }
    const float idx_scale = 0.5f * 0.125f * 0.35355339059327373f;
    bf16x8 Aw[2];
    { float wa[8];
      { const v4u wq = *(const v4u*)(IDX + (rowb + q0 + fr) * LD_IDX + 576);
#pragma unroll
        for (int i = 0; i < 4; ++i) { wa[2 * i] = bflo(wq[i]) * idx_scale; wa[2 * i + 1] = bfhi(wq[i]) * idx_scale; } }
#pragma unroll
      for (int ks = 0; ks < 2; ++ks) { float cq[8];
#pragma unroll
          for (int j = 0; j < 8; ++j) cq[j] = 0.f;
#pragma unroll
          for (int h = 0; h < 8; ++h)
#pragma unroll
              for (int j = 0; j < 8; ++j) cq[j] += wa[h] * bf2f((unsigned)(unsigned short)Af[h][ks][j]);
          const v4u t = {pk2(cq[0], cq[1]), pk2(cq[2], cq[3]), pk2(cq[4], cq[5]), pk2(cq[6], cq[7])};
          Aw[ks] = __builtin_bit_cast(bf16x8, t); } }
    float wv[4][8];
#pragma unroll
    for (int r = 0; r < 4; ++r) { const v4u wq = *(const v4u*)(IDX + (rowb + q0 + fq * 4 + r) * LD_IDX + 576);
#pragma unroll
        for (int i = 0; i < 4; ++i) { wv[r][2 * i] = bflo(wq[i]) * idx_scale; wv[r][2 * i + 1] = bfhi(wq[i]) * idx_scale; } }
    const int ntiles = (q0 >> 4) + 1;
    __syncthreads();
    bf16x8 B0 = Aw[0], B1 = Aw[1];
    if (w < ntiles) { const bf16* kp = IDX + (rowb + w * 16 + fr) * LD_IDX + 512 + fq * 8; B0 = *(const bf16x8*)kp; B1 = *(const bf16x8*)(kp + 32); }
    for (int kt = w; kt < ntiles; kt += NWAVES) {
        bf16x8 nB0 = B0, nB1 = B1;
        if (kt + NWAVES < ntiles) { const bf16* kp = IDX + (rowb + (kt + NWAVES) * 16 + fr) * LD_IDX + 512 + fq * 8; nB0 = *(const bf16x8*)kp; nB1 = *(const bf16x8*)(kp + 32); }
        pg8::f32x4 lin = {0.f, 0.f, 0.f, 0.f};
        lin = __builtin_amdgcn_mfma_f32_16x16x32_bf16(Aw[0], B0, lin, 0, 0, 0);
        lin = __builtin_amdgcn_mfma_f32_16x16x32_bf16(Aw[1], B1, lin, 0, 0, 0);
        float I[4] = {lin[0], lin[1], lin[2], lin[3]};
#pragma unroll
        for (int h = 0; h < 8; ++h) { pg8::f32x4 a = {0.f, 0.f, 0.f, 0.f};
            a = __builtin_amdgcn_mfma_f32_16x16x32_bf16(Af[h][0], B0, a, 0, 0, 0);
            a = __builtin_amdgcn_mfma_f32_16x16x32_bf16(Af[h][1], B1, a, 0, 0, 0);
#pragma unroll
            for (int r = 0; r < 4; ++r) I[r] = __builtin_fmaf(wv[r][h], __builtin_fabsf(a[r]), I[r]); }
        const int kidx = kt * 16 + fr;
#pragma unroll
        for (int r = 0; r < 4; ++r) { const unsigned key = f16key(I[r]); Ik[(fq * 4 + r) * 4096 + kidx] = (unsigned short)key;
            if (kidx <= q0 + fq * 4 + r) atomicAdd(&hist1[(fq * 4 + r) * 256 + (key >> 8)], 1u); }
        B0 = nB0; B1 = nB1;
    }
    __syncthreads();
    for (int qq = w; qq < 16; qq += NWAVES) {
        const int t = q0 + qq, n = t + 1;
        unsigned short* so = (unsigned short*)(hist1 + qq * 256);
        const unsigned short* keys = Ik + qq * 4096;
        if (n <= TOPK) { for (int j = lane; j < n; j += 64) so[j] = (unsigned short)j; }
        else {
            int b1, rem1, b2, rem2;
            find_bin(hist1 + qq * 256, TOPK, lane, b1, rem1);
            *(v4u*)(hist + 4 * lane) = (v4u){0u, 0u, 0u, 0u};
            LDS_WAIT(); __builtin_amdgcn_wave_barrier();
            for (int j = lane; j < n; j += 64) { const unsigned k = keys[j]; if ((int)(k >> 8) == b1) atomicAdd(&hist[k & 255u], 1u); }
            LDS_WAIT(); __builtin_amdgcn_wave_barrier();
            find_bin(hist, rem1, lane, b2, rem2);
            const unsigned thr = ((unsigned)b1 << 8) | (unsigned)b2;
            int base = 0, eqtaken = 0;
            const unsigned long long lt = (lane == 0) ? 0ull : (~0ull >> (64 - lane));
            for (int j0 = 0; j0 < n; j0 += 64) {
                const int j = j0 + lane; const bool valid = j < n; const unsigned k = valid ? (unsigned)keys[j] : 0u;
                const bool gt = valid && k > thr, eq = valid && k == thr;
                const unsigned long long meq = __ballot(eq);
                const int erank = __popcll(meq & lt) + eqtaken;
                const bool take = gt || (eq && erank < rem2);
                const unsigned long long mt = __ballot(take);
                if (take) so[base + __popcll(mt & lt)] = (unsigned short)j;
                base += __popcll(mt); eqtaken += __popcll(meq);
            }
        }
    }
    __syncthreads();
}

__device__ __forceinline__ void qknorm_token(const Params& p, int tok, int lane) {
    const bf16* row = (const bf16*)(p.ws + WS_ATT) + (size_t)tok * LD_ATT;
    const int c8 = (lane & 7) * 8;
    { const v4u qv = *(const v4u*)(row + lane * 8);
      float x[8]; float ss = 0.f;
#pragma unroll
      for (int i = 0; i < 4; ++i) { x[2 * i] = bflo(qv[i]); x[2 * i + 1] = bfhi(qv[i]); ss += x[2 * i] * x[2 * i] + x[2 * i + 1] * x[2 * i + 1]; }
      ss += __shfl_xor(ss, 1); ss += __shfl_xor(ss, 2); ss += __shfl_xor(ss, 4);
      const float rs = rsqrtf(ss * (1.f / 64.f) + RMS_EPS) * (0.125f * 1.4426950408889634f);
#pragma unroll
      for (int i = 0; i < 8; ++i) x[i] = x[i] * rs * p.q_norm_g[c8 + i];
      v2u hw, lw;
      hw.x = pk4_fp8(x[0], x[1], x[2], x[3]); hw.y = pk4_fp8(x[4], x[5], x[6], x[7]);
      { const f32x2 d0 = __builtin_amdgcn_cvt_pk_f32_fp8((int)hw.x, false), d1 = __builtin_amdgcn_cvt_pk_f32_fp8((int)hw.x, true), d2 = __builtin_amdgcn_cvt_pk_f32_fp8((int)hw.y, false), d3 = __builtin_amdgcn_cvt_pk_f32_fp8((int)hw.y, true);
        lw.x = pk4_fp8(x[0] - d0[0], x[1] - d0[1], x[2] - d1[0], x[3] - d1[1]); lw.y = pk4_fp8(x[4] - d2[0], x[5] - d2[1], x[6] - d3[0], x[7] - d3[1]); }
      *(v2u*)(p.ws + WS_QHI + (size_t)tok * 512 + lane * 8) = hw; *(v2u*)(p.ws + WS_QLO + (size_t)tok * 512 + lane * 8) = lw; }
    { const v4u kv = *(const v4u*)(row + 512 + (lane & 15) * 8);
      float x[8]; float ss = 0.f;
#pragma unroll
      for (int i = 0; i < 4; ++i) { x[2 * i] = bflo(kv[i]); x[2 * i + 1] = bfhi(kv[i]); ss += x[2 * i] * x[2 * i] + x[2 * i + 1] * x[2 * i + 1]; }
      ss += __shfl_xor(ss, 1); ss += __shfl_xor(ss, 2); ss += __shfl_xor(ss, 4);
      const float rs = rsqrtf(ss * (1.f / 64.f) + RMS_EPS);
#pragma unroll
      for (int i = 0; i < 8; ++i) x[i] = x[i] * rs * p.k_norm_g[c8 + i];
      v2u o; o.x = pk4_fp8(x[0], x[1], x[2], x[3]); o.y = pk4_fp8(x[4], x[5], x[6], x[7]);
      if (lane < 16) *(v2u*)(p.ws + WS_K8 + (size_t)tok * 128 + lane * 8) = o; }
}

typedef short v4i16_t __attribute__((ext_vector_type(4)));
__device__ __forceinline__ v4i16_t vtr16(const bf16* ldsp) { return __builtin_amdgcn_ds_read_tr16_b64_v4i16((LAS v4i16_t*)ldsp); }
__device__ __forceinline__ void dsa2_query(const Params& p, unsigned char* ldsw, const unsigned short* sel, int b, int t, int lane) {
    unsigned char* ws = p.ws;
    const bf16* ATT = (const bf16*)(ws + WS_ATT);
    bf16* YB = (bf16*)(ws + WS_H);
    unsigned short* sl = (unsigned short*)ldsw;
    float* df = (float*)(ldsw + 512);
    bf16* Vl = (bf16*)(ldsw + 1536);
    const int fr = lane & 15, fq = lane >> 4;
    const size_t rowb = (size_t)b * SEQ;
    const int cnt = (t + 1 < TOPK) ? (t + 1) : TOPK;
    { v2u sv = *(const v2u*)(sel + lane * 4);
      const int j0 = lane * 4;
      if (j0 >= cnt) sv.x = 0u; else if (j0 + 1 >= cnt) sv.x &= 0xffffu;
      if (j0 + 2 >= cnt) sv.y = 0u; else if (j0 + 3 >= cnt) sv.y &= 0xffffu;
      *(v2u*)(sl + lane * 4) = sv;
      f32x4 d4; d4[0] = (j0 < cnt) ? (float)(t - (int)(sv.x & 0xffffu)) : INFINITY; d4[1] = (j0 + 1 < cnt) ? (float)(t - (int)(sv.x >> 16)) : INFINITY;
      d4[2] = (j0 + 2 < cnt) ? (float)(t - (int)(sv.y & 0xffffu)) : INFINITY; d4[3] = (j0 + 3 < cnt) ? (float)(t - (int)(sv.y >> 16)) : INFINITY;
      *(f32x4*)(df + lane * 4) = d4; }
    LDS_WAIT(); __builtin_amdgcn_wave_barrier();
    const unsigned char* K8 = ws + WS_K8;
    long qhA[2] = {0, 0}, qhB[2] = {0, 0}, qlA[2] = {0, 0}, qlB[2] = {0, 0};
    if (fr < 8) { const v4u qh = *(const v4u*)(ws + WS_QHI + (rowb + t) * 512 + fr * 64 + fq * 16), ql = *(const v4u*)(ws + WS_QLO + (rowb + t) * 512 + fr * 64 + fq * 16);
        const long hA = (long)(((unsigned long long)qh.y << 32) | qh.x), hB = (long)(((unsigned long long)qh.w << 32) | qh.z), lA = (long)(((unsigned long long)ql.y << 32) | ql.x), lB = (long)(((unsigned long long)ql.w << 32) | ql.z);
        if (fr < 4) { qhA[0] = hA; qhB[0] = hB; qlA[0] = lA; qlB[0] = lB; } else { qhA[1] = hA; qhB[1] = hB; qlA[1] = lA; qlB[1] = lB; } }
    pg8::f32x4 sc[16];
    v4u vv[16];
    { v4u kf[16];
#pragma unroll
      for (int half = 0; half < 2; ++half) {
#pragma unroll
          for (int kt = 0; kt < 8; ++kt) { const int s = sl[(half * 8 + kt) * 16 + fr]; const unsigned char* kp = K8 + (rowb + s) * 128 + fq * 16;
              kf[2 * kt] = *(const v4u*)kp; kf[2 * kt + 1] = *(const v4u*)(kp + 64); }
          if (half == 1) {
#pragma unroll
              for (int i = 0; i < 8; ++i) { const int s = sl[i * 8 + (lane >> 3)]; vv[i] = *(const v4u*)(ATT + (rowb + s) * LD_ATT + 640 + (lane & 7) * 8); } }
          __builtin_amdgcn_sched_barrier(0);
#pragma unroll
          for (int kt = 0; kt < 8; ++kt) { pg8::f32x4 a = {0.f, 0.f, 0.f, 0.f};
#pragma unroll
              for (int gg = 0; gg < 2; ++gg) { const v4u kv = kf[2 * kt + gg];
                  const long kA = (long)(((unsigned long long)kv.y << 32) | kv.x), kB = (long)(((unsigned long long)kv.w << 32) | kv.z);
                  a = __builtin_amdgcn_mfma_f32_16x16x32_fp8_fp8(kA, qhA[gg], a, 0, 0, 0); a = __builtin_amdgcn_mfma_f32_16x16x32_fp8_fp8(kB, qhB[gg], a, 0, 0, 0);
                  a = __builtin_amdgcn_mfma_f32_16x16x32_fp8_fp8(kA, qlA[gg], a, 0, 0, 0); a = __builtin_amdgcn_mfma_f32_16x16x32_fp8_fp8(kB, qlB[gg], a, 0, 0, 0); }
              sc[half * 8 + kt] = a; }
          __builtin_amdgcn_sched_barrier(0);
      } }
    const float slope = exp2f(-(float)((fr & 7) + 1)) * 1.4426950408889634f;
    float m = -INFINITY;
#pragma unroll
    for (int kt = 0; kt < 16; ++kt) { const f32x4 d4 = *(const f32x4*)(df + kt * 16 + fq * 4);
#pragma unroll
        for (int r = 0; r < 4; ++r) { const float x = sc[kt][r] - slope * d4[r]; sc[kt][r] = x; m = fmaxf(m, x); } }
    m = fmaxf(m, __shfl_xor(m, 16)); m = fmaxf(m, __shfl_xor(m, 32));
    float l = 0.f;
#pragma unroll
    for (int kt = 0; kt < 16; ++kt)
#pragma unroll
        for (int r = 0; r < 4; ++r) { const float e = __builtin_amdgcn_exp2f(sc[kt][r] - m); sc[kt][r] = e; l += e; }
    l += __shfl_xor(l, 16); l += __shfl_xor(l, 32);
    const float inv = 1.f / l;
#pragma unroll 1
    for (int g = 0; g < 2; ++g) {
        if (g == 1) {
#pragma unroll
            for (int i = 0; i < 8; ++i) { const int s = sl[i * 8 + (lane >> 3)]; vv[i] = *(const v4u*)(ATT + (rowb + s) * LD_ATT + 640 + 64 + (lane & 7) * 8); } }
#pragma unroll
        for (int i = 8; i < 16; ++i) { const int s = sl[i * 8 + (lane >> 3)]; vv[i] = *(const v4u*)(ATT + (rowb + s) * LD_ATT + 640 + g * 64 + (lane & 7) * 8); }
        pg8::f32x4 o[4];
#pragma unroll
        for (int dt = 0; dt < 4; ++dt) o[dt] = (pg8::f32x4){0.f, 0.f, 0.f, 0.f};
#pragma unroll
        for (int ch = 0; ch < 4; ++ch) {
            LDS_WAIT(); __builtin_amdgcn_wave_barrier();
#pragma unroll
            for (int i = 0; i < 8; ++i) *(v4u*)(Vl + (i * 8 + (lane >> 3)) * 80 + (lane & 7) * 8) = vv[(ch & 1) * 8 + i];
            if (ch < 2) {
#pragma unroll
                for (int i = 0; i < 8; ++i) { const int s = sl[((ch + 2) * 8 + i) * 8 + (lane >> 3)]; vv[(ch & 1) * 8 + i] = *(const v4u*)(ATT + (rowb + s) * LD_ATT + 640 + g * 64 + (lane & 7) * 8); } }
            LDS_WAIT(); __builtin_amdgcn_wave_barrier();
#pragma unroll
            for (int k2 = 0; k2 < 2; ++k2) { const int kt0 = ch * 4 + 2 * k2;
                v4u pw; pw.x = pk2(sc[kt0][0], sc[kt0][1]); pw.y = pk2(sc[kt0][2], sc[kt0][3]); pw.z = pk2(sc[kt0 + 1][0], sc[kt0 + 1][1]); pw.w = pk2(sc[kt0 + 1][2], sc[kt0 + 1][3]);
                const bf16x8 pb = __builtin_bit_cast(bf16x8, pw);
#pragma unroll
                for (int dt = 0; dt < 4; ++dt) { const bf16* vp = Vl + ((2 * k2) * 16 + fq * 4 + (fr >> 2)) * 80 + dt * 16 + (fr & 3) * 4;
                    const v4i16_t lo = vtr16(vp), hi = vtr16(vp + 16 * 80);
                    const bf16x8 af = {lo[0], lo[1], lo[2], lo[3], hi[0], hi[1], hi[2], hi[3]};
                    o[dt] = __builtin_amdgcn_mfma_f32_16x16x32_bf16(af, pb, o[dt], 0, 0, 0); } }
        }
        if (fr < 8 && (fr >> 2) == g) {
#pragma unroll
            for (int dt = 0; dt < 4; ++dt) { const float i8 = inv * 8.f;
                *(unsigned*)((unsigned char*)YB + (rowb + t) * 1024 + 512 + fr * 64 + dt * 16 + fq * 4) = pk4_fp8(o[dt][0] * i8, o[dt][1] * i8, o[dt][2] * i8, o[dt][3] * i8); } }
    }
    LDS_WAIT(); __builtin_amdgcn_wave_barrier();
}

#define INS16(L, x) do { _Pragma("unroll") for (int _i = 15; _i >= 1; --_i) L[_i] = __builtin_amdgcn_fmed3f(L[_i - 1], L[_i], (x)); L[0] = fmaxf(L[0], (x)); } while (0)
__device__ __forceinline__ float f_andor(float v, unsigned keepmask, unsigned orv) { return __builtin_bit_cast(float, (__builtin_bit_cast(unsigned, v) & keepmask) | orv); }
__device__ __forceinline__ void peer_route_item(const Params& p, unsigned char* ldsw, int tg, int h, int lane, int* EIDX, float* GATES) {
    unsigned char* ws = p.ws;
    const bf16* Q = (const bf16*)(ws + WS_Q);
    const bf16* SK = (const bf16*)(ws + WS_SK);
    float* sc = (float*)ldsw;
    const int fr = lane & 15, fq = lane >> 4;
#pragma unroll 1
    for (int pp = 0; pp < 2; ++pp) {
        bf16x8 Af[4], Bf[32];
        { const bf16* rp = Q + (size_t)(tg * 16 + fr) * 2048 + h * 256 + pp * 128 + fq * 8;
#pragma unroll
          for (int ks = 0; ks < 4; ++ks) Af[ks] = *(const bf16x8*)(rp + ks * 32); }
#pragma unroll
        for (int kt = 0; kt < 8; ++kt) { const bf16* kp = SK + (size_t)((h * 2 + pp) * 128 + kt * 16 + fr) * 128 + fq * 8;
#pragma unroll
            for (int ks = 0; ks < 4; ++ks) Bf[kt * 4 + ks] = *(const bf16x8*)(kp + ks * 32); }
        __builtin_amdgcn_sched_barrier(0);
#pragma unroll
        for (int kt = 0; kt < 8; ++kt) {
            pg8::f32x4 a = {0.f, 0.f, 0.f, 0.f};
#pragma unroll
            for (int ks = 0; ks < 4; ++ks) a = __builtin_amdgcn_mfma_f32_16x16x32_bf16(Af[ks], Bf[kt * 4 + ks], a, 0, 0, 0);
#pragma unroll
            for (int r = 0; r < 4; ++r) sc[(pp * 16 + fq * 4 + r) * 132 + kt * 16 + fr] = f_andor(a[r], ~127u, (unsigned)(kt * 16 + fr));
        }
    }
    LDS_WAIT(); __builtin_amdgcn_wave_barrier();
    float L[16];
#pragma unroll
    for (int i = 0; i < 16; ++i) L[i] = -INFINITY;
    { const float* sp = sc + (lane & 31) * 132 + (lane >> 5) * 64;
#pragma unroll 4
      for (int i = 0; i < 16; ++i) { const f32x4 x = *(const f32x4*)(sp + 4 * i); INS16(L, x[0]); INS16(L, x[1]); INS16(L, x[2]); INS16(L, x[3]); } }
    { float O[16];
#pragma unroll
      for (int i = 0; i < 16; ++i) O[i] = __shfl_xor(L[i], 32);
#pragma unroll
      for (int i = 0; i < 16; ++i) INS16(L, O[i]); }
    LDS_WAIT(); __builtin_amdgcn_wave_barrier();
    float* lst = sc;
    if (lane < 32) {
#pragma unroll
        for (int i = 0; i < 4; ++i) *(f32x4*)(lst + lane * 16 + 4 * i) = (f32x4){L[4 * i], L[4 * i + 1], L[4 * i + 2], L[4 * i + 3]}; }
    LDS_WAIT(); __builtin_amdgcn_wave_barrier();
    const int tok = lane & 15;
    float s1[16], s2[16];
#pragma unroll
    for (int i = 0; i < 4; ++i) { const f32x4 a = *(const f32x4*)(lst + tok * 16 + 4 * i), b = *(const f32x4*)(lst + (16 + tok) * 16 + 4 * i);
#pragma unroll
        for (int c = 0; c < 4; ++c) { s1[4 * i + c] = f_andor(a[c], ~127u, 0u); s2[4 * i + c] = f_andor(b[c], ~127u, 0u); } }
    float M[16];
#pragma unroll
    for (int i = 0; i < 16; ++i) M[i] = -INFINITY;
#pragma unroll
    for (int a = 0; a < 16; ++a)
#pragma unroll
        for (int b = 0; b < 16; ++b)
            if ((a + 1) * (b + 1) <= 16) { const float key = f_andor(s1[a] + s2[b], ~255u, (unsigned)(a * 16 + b)); INS16(M, key); }
    const float mx = f_andor(M[0], ~255u, 0u);
    float e[16], sum = 0.f; int ei[16];
    const unsigned* lb = (const unsigned*)lst;
#pragma unroll
    for (int i = 0; i < 16; ++i) { const unsigned bits = __builtin_bit_cast(unsigned, M[i]); const int flat = bits & 255u;
        e[i] = __expf(f_andor(M[i], ~255u, 0u) - mx); sum += e[i];
        ei[i] = (int)(lb[tok * 16 + (flat >> 4)] & 127u) * 128 + (int)(lb[(16 + tok) * 16 + (flat & 15)] & 127u); }
    const float inv = 1.f / sum;
    if (lane < 16) {
        const size_t ob = ((size_t)tok * 8 + h) * 16;
#pragma unroll
        for (int i = 0; i < 4; ++i) { *(v4u*)(EIDX + ob + 4 * i) = (v4u){(unsigned)ei[4 * i], (unsigned)ei[4 * i + 1], (unsigned)ei[4 * i + 2], (unsigned)ei[4 * i + 3]};
            *(f32x4*)(GATES + ob + 4 * i) = (f32x4){e[4 * i] * inv, e[4 * i + 1] * inv, e[4 * i + 2] * inv, e[4 * i + 3] * inv}; }
    }
    LDS_WAIT(); __builtin_amdgcn_wave_barrier();
}

__device__ __forceinline__ float gelu_erf(float x) { return 0.5f * x * (1.f + erff(x * 0.70710678118654752f)); }
typedef int v8i_t __attribute__((ext_vector_type(8)));
template <int OPSEL> __device__ __forceinline__ pg8::f32x4 mx_dot(v8i_t a, int sa, v8i_t b, int sb, pg8::f32x4 c) {
    return __builtin_amdgcn_mfma_scale_f32_16x16x128_f8f6f4(a, b, c, 4  , 4  , OPSEL, sa, OPSEL, sb);
}
__device__ __forceinline__ void peer_token(const Params& p, unsigned char* ldsw, const _Float16* usL, const _Float16* vsL, int tok, int lane, const v2u nxt_e, const v2u nxt_g, int buf) {
    unsigned char* ws = p.ws;
    const unsigned char* V8 = ws + WS_V;
    const float* MOD = (const float*)(ws + WS_MOD);
    const int fr = lane & 15, fq = lane >> 4;
    typedef v8i_t v8i;
    const int* EIDX = (const int*)(ldsw + buf * 1024); const float* GATES = (const float*)(ldsw + buf * 1024 + 512);
    v4u A4[H4_NT][8]; v2u As[H4_NT];
#pragma unroll
    for (int t = 0; t < H4_NT; ++t) { const unsigned char* hp = ws + WS_H4D + ((size_t)tok * H4_NT + t) * 512 + fq * 16;
        As[t] = *(const v2u*)(ws + WS_H4S + ((size_t)tok * H4_NT + t) * 32 + fq * 8);
#pragma unroll
        for (int kk = 0; kk < 8; ++kk) A4[t][kk] = *(const v4u*)(hp + kk * 64); }
    int* pe = (int*)(ldsw + 2048); float* pa = (float*)(ldsw + 2048 + 512);
    const unsigned char* U4 = ws + WS_U;
#pragma unroll 2
    for (int ct = 0; ct < 8; ++ct) {
        const int eic = EIDX[ct * 16 + fr]; const float gt = GATES[ct * 16 + fr];
        const unsigned char* ur = U4 + (size_t)eic * 512 + fq * 16;
        pg8::f32x4 ah = {0.f, 0.f, 0.f, 0.f};
#pragma unroll
        for (int kk = 0; kk < 8; ++kk) { const v4u bu = *(const v4u*)(ur + kk * 64);
            const v8i bb = {(int)bu.x, (int)bu.y, (int)bu.z, (int)bu.w, 0, 0, 0, 0};
            const int sb = 0x7f7f7f7f;
#pragma unroll
            for (int t = 0; t < H4_NT; ++t) { const v8i aa = {(int)A4[t][kk].x, (int)A4[t][kk].y, (int)A4[t][kk].z, (int)A4[t][kk].w, 0, 0, 0, 0}; const int sa = (int)((kk < 4) ? As[t].x : As[t].y);
                if ((kk & 3) == 0) ah = mx_dot<0>(aa, sa, bb, sb, ah); else if ((kk & 3) == 1) ah = mx_dot<1>(aa, sa, bb, sb, ah); else if ((kk & 3) == 2) ah = mx_dot<2>(aa, sa, bb, sb, ah); else ah = mx_dot<3>(aa, sa, bb, sb, ah); } }
        const float dot = ah[0] * (float)usL[eic];
        if (fq == 0) { pe[ct * 16 + fr] = eic; pa[ct * 16 + fr] = gelu_erf(dot) * gt * (float)vsL[eic]; }
    }
    __builtin_amdgcn_sched_barrier(0);
    { int* ne = (int*)(ldsw + (buf ^ 1) * 1024); float* ng = (float*)(ldsw + (buf ^ 1) * 1024 + 512);
      *(v2u*)(ne + 2 * lane) = nxt_e; *(v2u*)(ng + 2 * lane) = nxt_g; }
    const int hl = lane >> 5, bl = lane & 31;
    float acc[32];
#pragma unroll
    for (int i = 0; i < 32; ++i) acc[i] = 0.f;
    LDS_WAIT(); __builtin_amdgcn_wave_barrier();
#pragma unroll 1
    for (int ct = 0; ct < 16; ++ct)
#pragma unroll
        for (int jp = 0; jp < 4; ++jp) {
            const int idx = pe[ct * 8 + 2 * jp + hl]; const float as = pa[ct * 8 + 2 * jp + hl];
            const v4u vv = *(const v4u*)(V8 + (size_t)idx * 512 + bl * 16);
#pragma unroll
            for (int w4 = 0; w4 < 4; ++w4) { const unsigned wd = vv[w4];
                const f32x2 d0 = __builtin_amdgcn_cvt_scalef32_pk_f32_fp4(wd, 1.0f, 0), d1 = __builtin_amdgcn_cvt_scalef32_pk_f32_fp4(wd, 1.0f, 1), d2 = __builtin_amdgcn_cvt_scalef32_pk_f32_fp4(wd, 1.0f, 2), d3 = __builtin_amdgcn_cvt_scalef32_pk_f32_fp4(wd, 1.0f, 3);
                acc[8 * w4] += as * d0[0]; acc[8 * w4 + 1] += as * d0[1]; acc[8 * w4 + 2] += as * d1[0]; acc[8 * w4 + 3] += as * d1[1];
                acc[8 * w4 + 4] += as * d2[0]; acc[8 * w4 + 5] += as * d2[1]; acc[8 * w4 + 6] += as * d3[0]; acc[8 * w4 + 7] += as * d3[1]; }
        }
    LDS_WAIT(); __builtin_amdgcn_wave_barrier();
    float accs[16];
#pragma unroll
    for (int i = 0; i < 16; ++i) { const float lo = acc[i] + __shfl_xor(acc[i], 32), hi2 = acc[16 + i] + __shfl_xor(acc[16 + i], 32); accs[i] = hl ? hi2 : lo; }
    const int b = tok / SEQ;
    const int col0 = bl * 32 + hl * 16;
    const float* g2 = MOD + (size_t)b * 6144 + 5 * 1024 + col0;
    float* orow = p.out + (size_t)tok * DM + col0;
#pragma unroll
    for (int q4 = 0; q4 < 4; ++q4) { const f32x4 xv = *(const f32x4*)(orow + 4 * q4), gv = *(const f32x4*)(g2 + 4 * q4);
        f32x4 o;
#pragma unroll
        for (int i = 0; i < 4; ++i) o[i] = xv[i] + gv[i] * accs[4 * q4 + i];
        *(f32x4*)(orow + 4 * q4) = o; }
}

#define XB_TMO      128
#define XB_XCNT(j)  (256  + 64 * (j))
#define XB_XSUB(j)  (1280 + 64 * (j))
#define XB_XGEN(j)  (2304 + 64 * (j))
#define XB_TOP      3328
#define XB_TOPGEN   3392
#define XCD_BAR_WORDS 3456
#define XB_SPIN_CAP (1u << 18)

__device__ __forceinline__ unsigned xb_ld(unsigned* p)              { return __hip_atomic_load(p, __ATOMIC_RELAXED, __HIP_MEMORY_SCOPE_AGENT); }
__device__ __forceinline__ unsigned xb_add(unsigned* p, unsigned v) { return __hip_atomic_fetch_add(p, v, __ATOMIC_RELAXED, __HIP_MEMORY_SCOPE_AGENT); }
__device__ __forceinline__ unsigned xb_xcc_id() { return (unsigned)__builtin_amdgcn_s_getreg((3 << 11) | 20) & 0xFu; }
#define XB_SPIN(cond, bar) do { unsigned _sp = 0; while (cond) { __builtin_amdgcn_s_sleep(1); \
    if ((++_sp & 255u) == 0u) { if (xb_ld(&(bar)[XB_TMO])) break; if (_sp > XB_SPIN_CAP) { atomicAdd(&(bar)[XB_TMO], 1u); break; } } } } while (0)

struct XcdBarrier {
    unsigned* bar; unsigned x;
    volatile LAS unsigned* st;
};

__device__ __forceinline__ XcdBarrier xcd_barrier_post(unsigned* bar, volatile LAS unsigned* st) {
    XcdBarrier b; b.bar = bar; b.x = xb_xcc_id(); b.st = st;
    if (threadIdx.x == 0) (void)xb_add(&bar[XB_XCNT(b.x)], 1u);
    return b;
}
__device__ __forceinline__ void xcd_barrier_complete(unsigned* bar, unsigned x, unsigned& nloc, unsigned& nx) {
    const unsigned G = gridDim.x * gridDim.y * gridDim.z;
    unsigned sum, cnt, mine, sp = 0u;
    for (;;) {
        sum = 0u; cnt = 0u; mine = 0u;
#pragma unroll
        for (unsigned j = 0; j < 16; ++j) { const unsigned c = xb_ld(&bar[XB_XCNT(j)]); sum += c; cnt += (c > 0u) ? 1u : 0u; mine = (j == x) ? c : mine; }
        if (sum == G) break;
        __builtin_amdgcn_s_sleep(1);
        if ((++sp & 255u) == 0u) { if (xb_ld(&bar[XB_TMO])) break; if (sp > XB_SPIN_CAP) { atomicAdd(&bar[XB_TMO], 1u); break; } }
    }
    nloc = mine > 0u ? mine : 1u; nx = cnt > 0u ? cnt : 1u;
}

__device__ __forceinline__ void xcd_barrier(const XcdBarrier& b) {
    asm volatile("s_waitcnt vmcnt(0)" ::: "memory");
    __syncthreads();
    if (threadIdx.x == 0) {
        unsigned* bar = b.bar;
        __builtin_amdgcn_s_waitcnt(0);
        unsigned nloc = b.st[0], nx = b.st[1];
        if (nloc == 0u) { xcd_barrier_complete(bar, b.x, nloc, nx); b.st[0] = nloc; b.st[1] = nx; }
        const unsigned old = xb_add(&bar[XB_XSUB(b.x)], 1u);
        const unsigned gen = old / nloc;
        if (old + 1u == (gen + 1u) * nloc) {
            __builtin_amdgcn_fence(__ATOMIC_RELEASE, "agent");
            asm volatile("s_waitcnt vmcnt(0)" ::: "memory");
            const unsigned og = xb_add(&bar[XB_TOP], 1u);
            const unsigned tg = og / nx;
            if (og + 1u == (tg + 1u) * nx) xb_add(&bar[XB_TOPGEN], 1u);
            else XB_SPIN(xb_ld(&bar[XB_TOPGEN]) == tg, bar);
            __builtin_amdgcn_fence(__ATOMIC_ACQUIRE, "agent");
            xb_add(&bar[XB_XGEN(b.x)], 1u);
            asm volatile("s_waitcnt vmcnt(0)" ::: "memory");
        } else {
            XB_SPIN(xb_ld(&bar[XB_XGEN(b.x)]) == gen, bar);
            __builtin_amdgcn_fence(__ATOMIC_ACQUIRE, "agent");
            asm volatile("s_waitcnt vmcnt(0)" ::: "memory");
        }
    }
    __syncthreads();
}

constexpr int NPHASE = 11;
__global__ void __launch_bounds__(NTHREADS, 2) mega(Params p) {
    extern __shared__ __attribute__((aligned(16))) unsigned char lds[];
    cg::grid_group grid = cg::this_grid();
    const int lo = p.ph_lo, hi = p.ph_hi;
    const int tid = threadIdx.x, wave = tid >> 6, lane = tid & 63, G = gridDim.x;
    unsigned char* ws = p.ws;
#ifndef ONLYPH
#define IN(k) (lo <= (k) && (k) < hi)
#else
#define IN(k) ((k) == ONLYPH && lo <= (k) && (k) < hi)
#endif
    volatile LAS unsigned* xb_st = (volatile LAS unsigned*)((LAS unsigned char*)lds + (LDS_BYTES - 16));
    if (tid < 4) xb_st[tid] = 0u;
    __syncthreads();
    XcdBarrier xbar; xbar.bar = (unsigned*)(ws + WS_CTL); xbar.x = 0; xbar.st = xb_st;
    if (hi - lo > 1) xbar = xcd_barrier_post((unsigned*)(ws + WS_CTL), xb_st);
    if (lo < -1) grid.sync();
#define SEAM(k) do { if (IN((k) + 1)) xcd_barrier(xbar); } while (0)
#ifndef REPMASK
#define REPMASK 0
#endif
#define NREP(k) (((REPMASK >> (k)) & 1) ? 2 : 1)
    if (IN(0)) { for (int rep = 0; rep < NREP(0); ++rep) phase0(p, lds); SEAM(0); }
    if (IN(1)) { for (int rep = 0; rep < NREP(1); ++rep) normmod_phase<true>(p, lds, p.x, (bf16*)(ws + WS_H), p.norm1_g, 0, 1024); SEAM(1); }
    if (IN(2)) {
        { pg8::Gemm g{(const bf16*)(ws + WS_H8), (const bf16*)(ws + WS_WIN8), T, 3584, 512, 512, 512}; pg8::StaticOrder S; S.init(T, 3584, G, (int)blockIdx.x);
          EpiProj E{(bf16*)(ws + WS_HG), (bf16*)(ws + WS_ATT), (bf16*)(ws + WS_IDX), (bf16*)(ws + WS_GATE), 1};
          pg8::gemm_phase<EpiProj, pg8::StaticOrder, true, true, 122>((PG8_LAS unsigned char*)lds, g, S, E); }
        { pg8::Gemm g{(const bf16*)(ws + WS_H), (const bf16*)(ws + WS_WIN), T, 2048, 1024, 1024, 1024}; pg8::StaticOrder S; S.init(T, 2048, G, (int)blockIdx.x);
          EpiProj E{(bf16*)(ws + WS_HG), (bf16*)(ws + WS_ATT), (bf16*)(ws + WS_IDX), (bf16*)(ws + WS_GATE), 0};
          pg8::gemm_phase<EpiProj, pg8::StaticOrder, true, true>((PG8_LAS unsigned char*)lds, g, S, E); }
        SEAM(2);
    }
    if (IN(3)) {
        for (int tok = (int)blockIdx.x * NWAVES + wave; tok < T; tok += G * NWAVES) qknorm_token(p, tok, lane);
        SEAM(3);
    }
    if (IN(4)) {
        if ((int)blockIdx.x < 32) hgrn_item(p, lds, (int)blockIdx.x);
        {
            unsigned* qctr = (unsigned*)(ws + WS_CTL + 32768);
            volatile LAS unsigned* qslot = (volatile LAS unsigned*)((LAS unsigned char*)lds + (LDS_BYTES - 32));
            int qsel = (int)(blockIdx.x & 7u), tried = 0;
            for (;;) {
                if (tid == 0) { unsigned c;
                    for (;;) { c = __hip_atomic_fetch_add(qctr + qsel * 64, 1u, __ATOMIC_RELAXED, __HIP_MEMORY_SCOPE_AGENT); if (c < (unsigned)(SEQ / 16) || tried >= 7) break; qsel = (qsel + 1) & 7; ++tried; }
                    *qslot = (c < (unsigned)(SEQ / 16)) ? (((unsigned)qsel << 16) | c) : 0xffffffffu; }
                __syncthreads();
                const unsigned c = *qslot;
                __syncthreads();
                if (c == 0xffffffffu) break;
                const int b = (int)(c >> 16), qblk = (SEQ / 16 - 1) - (int)(c & 0xffffu), it = b * (SEQ / 16) + qblk, q0 = qblk * 16;
                dsa1_item(p, lds, it);
#pragma unroll 1
                for (int k2 = 0; k2 < 2; ++k2) dsa2_query(p, lds + wave * 16384, (const unsigned short*)(lds + 131072 + (wave + 8 * k2) * 1024), b, q0 + wave + 8 * k2, lane);
                __syncthreads();
            }
        }
        SEAM(4);
    }
    if (IN(5)) {
        pg8::Gemm g{(const bf16*)(ws + WS_H), (const bf16*)(ws + WS_WAB8), T, 1024, 256, 512, 512}; pg8::StaticOrderT<true> S; S.init(T, 1024, G, (int)blockIdx.x, 256);
        EpiMerged E{(const bf16*)(ws + WS_GATE), (bf16*)(ws + WS_MERGED)};
        for (int rep = 0; rep < NREP(5); ++rep) pg8::gemm_phase<EpiMerged, pg8::StaticOrderT<true>, true, true, 122>((PG8_LAS unsigned char*)lds, g, S, E);
        SEAM(5);
    }
    if (IN(6)) {
        pg8::Gemm g{(const bf16*)(ws + WS_MERGED), (const bf16*)(ws + WS_WOUT8), T, 1024, 512, 512, 512}; pg8::StaticOrder S; S.init(T, 1024, G, (int)blockIdx.x);
        EpiResid E{p.x, (const float*)(ws + WS_MOD) + 2048, p.out};
        for (int rep = 0; rep < NREP(6); ++rep) pg8::gemm_phase<EpiResid, pg8::StaticOrder, true, true, 120>((PG8_LAS unsigned char*)lds, g, S, E);
        SEAM(6);
    }
    if (IN(7)) { for (int rep = 0; rep < NREP(7); ++rep) normmod_phase<false>(p, lds, p.out, (bf16*)(ws + WS_H), p.norm2_g, 3 * 1024, 4 * 1024); SEAM(7); }
    if (IN(8)) {
        pg8::Gemm g{(const bf16*)(ws + WS_H), (const bf16*)(ws + WS_WQ), T, 2048, 1024, 1024, 1024}; pg8::StaticOrder S; S.init(T, 2048, G, (int)blockIdx.x);
        EpiStore E{(bf16*)(ws + WS_Q), 2048};
        for (int rep = 0; rep < NREP(8); ++rep) pg8::gemm_phase<EpiStore, pg8::StaticOrder, true, true>((PG8_LAS unsigned char*)lds, g, S, E);
        SEAM(8);
    }
    if (IN(9)) {
        int* eG = (int*)(ws + WS_EIDX); float* gG = (float*)(ws + WS_PGATE);
        for (int tg = blockIdx.x; tg < T / 16; tg += G) peer_route_item(p, lds + wave * 16896, tg, wave, lane, eG + (size_t)tg * 2048, gG + (size_t)tg * 2048);
        asm volatile("s_waitcnt vmcnt(0)" ::: "memory");
        __syncthreads();
        _Float16* usL = (_Float16*)lds; _Float16* vsL = (_Float16*)(lds + 32768);
        for (int i = tid; i < NEXP / 8; i += NTHREADS) { ((v4u*)usL)[i] = ((const v4u*)(ws + WS_US))[i]; ((v4u*)vsL)[i] = ((const v4u*)(ws + WS_VS))[i]; }
        unsigned char* ldsw = lds + 65536 + wave * 3072;
        int ntok = 0;
        for (int tg = blockIdx.x; tg < T / 16; tg += G) ntok += 2;
        auto tok_of = [&](int j) { return ((int)blockIdx.x + (j >> 1) * G) * 16 + wave + 8 * (j & 1); };
        auto ld_lists = [&](int tok, v2u& e, v2u& g) {
            const unsigned* ep = (const unsigned*)(eG + (size_t)tok * 128 + 2 * lane); const unsigned* gp = (const unsigned*)(gG + (size_t)tok * 128 + 2 * lane);
            e.x = __hip_atomic_load(ep, __ATOMIC_RELAXED, __HIP_MEMORY_SCOPE_AGENT); e.y = __hip_atomic_load(ep + 1, __ATOMIC_RELAXED, __HIP_MEMORY_SCOPE_AGENT);
            g.x = __hip_atomic_load(gp, __ATOMIC_RELAXED, __HIP_MEMORY_SCOPE_AGENT); g.y = __hip_atomic_load(gp + 1, __ATOMIC_RELAXED, __HIP_MEMORY_SCOPE_AGENT); };
        if (ntok > 0) { v2u e0, g0; ld_lists(tok_of(0), e0, g0); *(v2u*)((int*)ldsw + 2 * lane) = e0; *(v2u*)((float*)(ldsw + 512) + 2 * lane) = g0; }
        __syncthreads();
#pragma unroll 1
        for (int j = 0; j < ntok; ++j) {
            v2u ne = {0u, 0u}, ng = {0u, 0u};
            if (j + 1 < ntok) ld_lists(tok_of(j + 1), ne, ng);
            peer_token(p, ldsw, usL, vsL, tok_of(j), lane, ne, ng, j & 1);
            LDS_WAIT(); __builtin_amdgcn_wave_barrier();
        }
    }
#undef IN
#undef SEAM
}

#ifndef ONE_LAUNCH
#define ONE_LAUNCH 1
#endif
extern "C" void kernel_launch(void* const* d_in, const int* in_sizes, int n_in, void* d_out, int out_size, void* d_ws, size_t ws_size, hipStream_t stream) {
    static int grid = 0;
    if (grid == 0) {
        if (n_in != 18 || out_size != T * DM || ws_size < WS_END) { fprintf(stderr, "kernel_launch: unexpected shapes (n_in %d, out %d, ws %zu)\n", n_in, out_size, ws_size); grid = -1; return; }
        int dev = 0, cus = 0, per_cu = 0;
        if (hipGetDevice(&dev) != hipSuccess || hipDeviceGetAttribute(&cus, hipDeviceAttributeMultiprocessorCount, dev) != hipSuccess) { grid = -1; return; }
        if (hipFuncSetAttribute((const void*)mega, hipFuncAttributeMaxDynamicSharedMemorySize, LDS_BYTES) != hipSuccess) { fprintf(stderr, "kernel_launch: hipFuncSetAttribute failed\n"); grid = -1; return; }
        if (hipOccupancyMaxActiveBlocksPerMultiprocessor(&per_cu, (const void*)mega, NTHREADS, LDS_BYTES) != hipSuccess || per_cu < 1) { fprintf(stderr, "kernel_launch: occupancy query says %d\n", per_cu); grid = -1; return; }
        (void)hipGetLastError();
        grid = cus;
        if (grid < 64) { grid = -1; return; }
    }
    if (grid < 0) return;
    Params p{};
    const float** pp = (const float**)&p;
    for (int i = 0; i < 18; ++i) pp[i] = (const float*)d_in[i];
    p.out = (float*)d_out; p.ws = (unsigned char*)d_ws;
#if ONE_LAUNCH
    if (hipMemsetAsync((char*)d_ws + WS_CTL, 0, 65536, stream) != hipSuccess) { fprintf(stderr, "kernel_launch: memset failed\n"); return; }
    p.ph_lo = 0; p.ph_hi = NPHASE;
    void* args[] = {&p};
    hipError_t e = hipLaunchCooperativeKernel((const void*)mega, dim3(grid), dim3(NTHREADS), args, LDS_BYTES, stream);
    if (e != hipSuccess) fprintf(stderr, "cooperative launch failed: %s (grid %d)\n", hipGetErrorString(e), grid);
#else
    for (int k = 0; k < NPHASE; ++k) { p.ph_lo = k; p.ph_hi = k + 1; hipLaunchKernelGGL(mega, dim3(grid), dim3(NTHREADS), LDS_BYTES, stream, p); }
#endif
}
```

```cpp
#include <hip/hip_runtime.h>
#include <hip/hip_cooperative_groups.h>
#include <cstdio>
#include <cstdint>
namespace cg = cooperative_groups;

namespace pg8 {
#define PG8_LAS __attribute__((address_space(3)))
typedef unsigned short bf16_t;
typedef short bf16x8 __attribute__((ext_vector_type(8)));
typedef float f32x4 __attribute__((ext_vector_type(4)));
typedef unsigned u32x4 __attribute__((ext_vector_type(4)));
constexpr int BM = 256, BK = 64, HALF = 128, HTB = HALF * BK * 2  , STAGE_BYTES = 8 * HTB, NXCD = 8, WGM = 8;

__host__ __device__ __forceinline__ int lds_byte(int r, int c) { const int st = (r >> 4) * 2 + (c >> 5), rr = r & 15, cc = c & 31, ob = rr * 64 + cc * 2; return st * 1024 + (ob ^ (((ob >> 9) & 1) << 5)); }
__host__ __device__ __forceinline__ void stage_rc(int b, int& R, int& C) { const int st = b / 1024, sb = b % 1024, swz = sb ^ (((sb >> 9) & 1) << 5); R = (st >> 1) * 16 + swz / 64; C = (st & 1) * 32 + (swz % 64) / 2; }
__host__ __device__ __forceinline__ int perm32(int rho) { const int n = rho >> 4, i = rho & 15; return 8 * (i >> 2) + 4 * n + (i & 3); }

struct Unit { int pm, pn, ko, pass; };
struct Gemm { const bf16_t* A; const bf16_t* Bt; int M, N, K, lda, ldb; };
typedef float f32x16 __attribute__((ext_vector_type(16)));
typedef f32x16 AccW[2][2][2];
__device__ __forceinline__ f32x4 acc_get(const AccW& A, int ai, int bj, int m, int n) { const int s_ = ((m & 1) * 2 + n) * 4; const f32x16& w = A[ai][bj][m >> 1]; return (f32x4){w[s_], w[s_ + 1], w[s_ + 2], w[s_ + 3]}; }
__device__ __forceinline__ void acc_set(AccW& A, int ai, int bj, int m, int n, f32x4 v) { const int s_ = ((m & 1) * 2 + n) * 4; f32x16& w = A[ai][bj][m >> 1]; w[s_] = v[0]; w[s_ + 1] = v[1]; w[s_ + 2] = v[2]; w[s_ + 3] = v[3]; }

template <bool TWOPASS_ORDER = false>
struct StaticOrderT {
    int nM, nN, nwg, G, c, kpass;
    __host__ __device__ void init(int M, int N, int G_, int c_, int kpass_ = 512) { nM = M / BM; nN = N / BM; nwg = nM * nN; G = G_; c = c_; kpass = kpass_; }
    __host__ __device__ bool next(int i, Unit& u) const {
        const long L = (long)(TWOPASS_ORDER ? (i >> 1) : i) * G + c; if (L >= nwg) return false;
        u.pass = TWOPASS_ORDER ? (i & 1) : 0; u.ko = TWOPASS_ORDER ? (i & 1) * kpass : 0;
        int wgid = (int)L; { const int q = nwg / NXCD, r = nwg % NXCD, xcd = wgid % NXCD, off = wgid / NXCD; wgid = (xcd < r ? xcd * (q + 1) : r * (q + 1) + (xcd - r) * q) + off; }
        const int nig = WGM * nN, gid = wgid / nig, fm = gid * WGM, gsz = (nM - fm) < WGM ? (nM - fm) : WGM;
        u.pm = fm + ((wgid % nig) % gsz); u.pn = (wgid % nig) / gsz; return true;
    }
    __device__ __forceinline__ void a_ready(const Unit&) const {}
    __device__ __forceinline__ void done(const Unit&) const {}
};
typedef StaticOrderT<false> StaticOrder;

__device__ __forceinline__ unsigned cvt_pk_bf16(float lo, float hi) { unsigned r; asm volatile("v_cvt_pk_bf16_f32 %0, %1, %2" : "=v"(r) : "v"(lo), "v"(hi)); return r; }

template <class Epi, class Sched, bool ALIGN_EPI = false, bool SP2 = false, int F8SCALE = 0>
__device__ __forceinline__ void gemm_phase(PG8_LAS unsigned char* lds, const Gemm g, const Sched& S, const Epi& E) {
    const int tid = threadIdx.x, wid = __builtin_amdgcn_readfirstlane(tid >> 6), lane = tid & 63, wr = wid >> 2, wc = wid & 3, fr = lane & 15, fq = lane >> 4;
    const int K = g.K, nt = K / BK;
    unsigned voffA[2], voffB[2];
#pragma unroll
    for (int i = 0; i < 2; ++i) { int R, C; stage_rc(tid * 16 + i * 8192, R, C); const int Rb = Epi::PERM ? ((R & ~31) + perm32(R & 31)) : R;
        voffA[i] = (unsigned)(R * g.lda + C) * 2u; voffB[i] = (unsigned)(Rb * g.ldb + C) * 2u; }
    const size_t kstep = (size_t)(BK * 2);
    const size_t hstepA = (size_t)HALF * g.lda * 2, hstepB = (size_t)HALF * g.ldb * 2;
    const size_t tstepA = 2 * hstepA, tstepB = 2 * hstepB;
    const unsigned ldsw = (unsigned)wid * 1024u;
    const int aoff = lds_byte(wr * 64 + fr, fq * 8), boff = lds_byte(wc * 32 + fr, fq * 8);
#define PG8_SA(b, h) (((b) * 2 + (h)) * HTB)
#define PG8_SB(b, h) ((4 + (b) * 2 + (h)) * HTB)
#define PG8_STAGE(bufoff, gbase, voff) do { _Pragma("unroll") for (int _i = 0; _i < 2; ++_i) \
        __builtin_amdgcn_global_load_lds((const unsigned*)((const char*)(gbase) + (voff)[_i]), (PG8_LAS unsigned*)(lds + (bufoff) + ldsw + _i * 8192), 16, 0, 0); } while (0)
#define PG8_LDA(dst, b, h) do { _Pragma("unroll") for (int m = 0; m < 4; ++m) { if constexpr (F8SCALE != 0) { \
        PG8_F8(dst)[m].lo = *(const PG8_LAS v4i_f*)(lds + PG8_SA(b, h) + aoff + m * 2048); PG8_F8(dst)[m].hi = *(const PG8_LAS v4i_f*)(lds + PG8_SA(b, h) + aoff + m * 2048 + 1024); } \
        else { _Pragma("unroll") for (int k = 0; k < 2; ++k) dst[m][k] = *(const PG8_LAS bf16x8*)(lds + PG8_SA(b, h) + aoff + m * 2048 + k * 1024); } } } while (0)
#define PG8_LDB(dst, b, h) do { _Pragma("unroll") for (int n = 0; n < 2; ++n) { if constexpr (F8SCALE != 0) { \
        PG8_F8(dst)[n].lo = *(const PG8_LAS v4i_f*)(lds + PG8_SB(b, h) + boff + n * 2048); PG8_F8(dst)[n].hi = *(const PG8_LAS v4i_f*)(lds + PG8_SB(b, h) + boff + n * 2048 + 1024); } \
        else { _Pragma("unroll") for (int k = 0; k < 2; ++k) dst[n][k] = *(const PG8_LAS bf16x8*)(lds + PG8_SB(b, h) + boff + n * 2048 + k * 1024); } } } while (0)
#define PG8_MMA(ai, bj, At, Bt) do { __builtin_amdgcn_s_setprio(1); _Pragma("unroll") for (int m = 0; m < 4; ++m) _Pragma("unroll") for (int n = 0; n < 2; ++n) { \
        f32x4 _c = acc_get(accw, ai, bj, m, n); \
        if constexpr (F8SCALE != 0) { _c = __builtin_amdgcn_mfma_scale_f32_16x16x128_f8f6f4(PG8_F8(Bt)[n], PG8_F8(At)[m], _c, 0, 0, 0, 0x7f7f7f7f, 0, F8SCALE * 0x01010101); } \
        else { _Pragma("unroll") for (int k = 0; k < 2; ++k) _c = __builtin_amdgcn_mfma_f32_16x16x32_bf16(Bt[n][k], At[m][k], _c, 0, 0, 0); } \
        acc_set(accw, ai, bj, m, n, _c); } \
        __builtin_amdgcn_s_setprio(0); } while (0)
#define PG8_WAIT_V(n) asm volatile("s_waitcnt vmcnt(" #n ")" ::: "memory")
#define PG8_WAIT_L(n) asm volatile("s_waitcnt lgkmcnt(" #n ")" ::: "memory")
#define PG8_BAR __builtin_amdgcn_s_barrier()
#define PG8_SCHED __builtin_amdgcn_sched_barrier(0)
    Unit cur, nxt; int ui = 0;
    if (!S.next(0, cur)) return;
    typedef int v4i_f __attribute__((ext_vector_type(4))); typedef int v8i_f __attribute__((ext_vector_type(8))); typedef f32x16 f32x16_f;
    AccW accw;
#pragma unroll
    for (int a = 0; a < 2; ++a)
#pragma unroll
        for (int b = 0; b < 2; ++b)
#pragma unroll
            for (int mp = 0; mp < 2; ++mp)
#pragma unroll
                for (int i = 0; i < 16; ++i) accw[a][b][mp][i] = 0.f;
    bf16x8 At[4][2], B0[2][2], B1[2][2];
    v8i_f At8[4], B08[2], B18[2];
#define PG8_F8(x) x##8
    const char* cA = (const char*)g.A + (size_t)cur.pm * tstepA + (size_t)cur.ko * 2; const char* cB = (const char*)g.Bt + (size_t)cur.pn * tstepB + (size_t)cur.ko * 2;
    S.a_ready(cur);
    if constexpr (SP2) {
        PG8_STAGE(PG8_SB(0, 0), cB, voffB); PG8_STAGE(PG8_SB(0, 1), cB + hstepB, voffB); PG8_STAGE(PG8_SA(0, 0), cA, voffA); PG8_STAGE(PG8_SA(0, 1), cA + hstepA, voffA);
        if (wr == 1) PG8_BAR;
        PG8_WAIT_V(2); PG8_BAR;
        PG8_STAGE(PG8_SB(1, 0), cB + kstep, voffB); PG8_STAGE(PG8_SA(1, 0), cA + kstep, voffA); PG8_STAGE(PG8_SB(1, 1), cB + hstepB + kstep, voffB);
        PG8_WAIT_V(6); PG8_BAR;
    } else {
        PG8_STAGE(PG8_SB(0, 0), cB, voffB); PG8_STAGE(PG8_SA(0, 0), cA, voffA); PG8_STAGE(PG8_SB(0, 1), cB + hstepB, voffB); PG8_STAGE(PG8_SA(0, 1), cA + hstepA, voffA);
        if (wr == 1) PG8_BAR;
        PG8_WAIT_V(4); PG8_BAR;
        PG8_STAGE(PG8_SB(1, 0), cB + kstep, voffB); PG8_STAGE(PG8_SA(1, 0), cA + kstep, voffA); PG8_STAGE(PG8_SB(1, 1), cB + hstepB + kstep, voffB);
        PG8_WAIT_V(6); PG8_BAR;
    }
    for (;;) {
        const bool has_next = S.next(ui + 1, nxt);
        const char* nA = has_next ? (const char*)g.A + (size_t)nxt.pm * tstepA + (size_t)nxt.ko * 2 : cA; const char* nB = has_next ? (const char*)g.Bt + (size_t)nxt.pn * tstepB + (size_t)nxt.ko * 2 : cB;
        for (int t = 0; t < nt; t += 2) {
            const bool last = (t == nt - 2);
            const char* a1 = cA + (size_t)(t + 1) * kstep;
            const char* a2 = last ? nA : cA + (size_t)(t + 2) * kstep; const char* b2 = last ? nB : cB + (size_t)(t + 2) * kstep;
            const char* a3 = a2 + kstep; const char* b3 = b2 + kstep;
            if (last && has_next) S.a_ready(nxt);
            if constexpr (SP2) {
            PG8_LDB(B0, 0, 0); PG8_LDB(B1, 0, 1); PG8_SCHED; PG8_LDA(At, 0, 0); PG8_STAGE(PG8_SA(1, 1), a1 + hstepA, voffA);
            PG8_WAIT_V(8); PG8_WAIT_L(0); PG8_BAR; PG8_MMA(0, 0, At, B0); PG8_MMA(0, 1, At, B1); PG8_BAR; PG8_SCHED;
            PG8_LDA(At, 0, 1); PG8_STAGE(PG8_SB(0, 0), b2, voffB); PG8_STAGE(PG8_SB(0, 1), b2 + hstepB, voffB); PG8_STAGE(PG8_SA(0, 0), a2, voffA);
            PG8_WAIT_V(8); PG8_WAIT_L(0); PG8_BAR; PG8_MMA(1, 0, At, B0); PG8_MMA(1, 1, At, B1); PG8_BAR; PG8_SCHED;
            PG8_LDB(B0, 1, 0); PG8_LDB(B1, 1, 1); PG8_SCHED; PG8_LDA(At, 1, 0); PG8_STAGE(PG8_SA(0, 1), a2 + hstepA, voffA);
            PG8_WAIT_V(8); PG8_WAIT_L(0); PG8_BAR; PG8_MMA(0, 0, At, B0); PG8_MMA(0, 1, At, B1); PG8_BAR; PG8_SCHED;
            PG8_LDA(At, 1, 1); PG8_STAGE(PG8_SB(1, 0), b3, voffB); PG8_STAGE(PG8_SB(1, 1), b3 + hstepB, voffB); PG8_STAGE(PG8_SA(1, 0), a3, voffA);
            PG8_WAIT_V(8); PG8_WAIT_L(0); PG8_BAR; PG8_MMA(1, 0, At, B0); PG8_MMA(1, 1, At, B1); PG8_BAR; PG8_SCHED;
            } else {
            PG8_LDB(B0, 0, 0); PG8_SCHED; PG8_LDA(At, 0, 0); PG8_STAGE(PG8_SA(1, 1), a1 + hstepA, voffA);
            PG8_WAIT_L(8); PG8_BAR; PG8_WAIT_L(0); PG8_MMA(0, 0, At, B0); PG8_BAR; PG8_SCHED;
            PG8_LDB(B1, 0, 1); PG8_STAGE(PG8_SB(0, 0), b2, voffB);
            PG8_BAR; PG8_WAIT_L(0); PG8_MMA(0, 1, At, B1); PG8_BAR;
            PG8_LDA(At, 0, 1); PG8_STAGE(PG8_SA(0, 0), a2, voffA);
            PG8_BAR; PG8_WAIT_L(0); PG8_MMA(1, 0, At, B0); PG8_BAR; PG8_SCHED;
            PG8_STAGE(PG8_SB(0, 1), b2 + hstepB, voffB);
            PG8_WAIT_V(6); PG8_BAR; PG8_MMA(1, 1, At, B1); PG8_BAR;
            PG8_LDB(B0, 1, 0); PG8_SCHED; PG8_LDA(At, 1, 0); PG8_STAGE(PG8_SA(0, 1), a2 + hstepA, voffA);
            PG8_WAIT_L(8); PG8_BAR; PG8_WAIT_L(0); PG8_MMA(0, 0, At, B0); PG8_BAR; PG8_SCHED;
            PG8_LDB(B1, 1, 1); PG8_STAGE(PG8_SB(1, 0), b3, voffB);
            PG8_BAR; PG8_WAIT_L(0); PG8_MMA(0, 1, At, B1); PG8_BAR;
            PG8_LDA(At, 1, 1); PG8_STAGE(PG8_SA(1, 0), a3, voffA);
            PG8_BAR; PG8_WAIT_L(0); PG8_MMA(1, 0, At, B0); PG8_BAR; PG8_SCHED;
            PG8_STAGE(PG8_SB(1, 1), b3 + hstepB, voffB);
            PG8_WAIT_V(6); PG8_BAR; PG8_MMA(1, 1, At, B1); PG8_BAR;
            }
        }
        if constexpr (ALIGN_EPI) { if (wr == 0) PG8_BAR; }
        if constexpr (!Epi::AFTER_DRAIN) { E(accw, cur, wr, wc, fr, fq); S.done(cur); }
        const bool keep_acc = Epi::TWOPASS && (cur.pass == 0);
        if (!has_next) break;
        if (!keep_acc) {
#pragma unroll
            for (int a = 0; a < 2; ++a)
#pragma unroll
                for (int b = 0; b < 2; ++b)
#pragma unroll
                    for (int mp = 0; mp < 2; ++mp)
#pragma unroll
                        for (int i = 0; i < 16; ++i) accw[a][b][mp][i] = 0.f;
        }
        cur = nxt; cA = nA; cB = nB; ++ui;
        if constexpr (ALIGN_EPI) { if (wr == 1) PG8_BAR; }
    }
    PG8_WAIT_V(0);
    if constexpr (!ALIGN_EPI) { if (wr == 0) PG8_BAR; }
    PG8_BAR;

#undef PG8_SA
#undef PG8_SB
#undef PG8_STAGE
#undef PG8_LDA
#undef PG8_LDB
#undef PG8_MMA
#undef PG8_F8
#undef PG8_WAIT_V
#undef PG8_WAIT_L
#undef PG8_BAR
#undef PG8_SCHED
}
}


constexpr int NWAVES = 8, NTHREADS = 512;
constexpr int BATCH = 8, SEQ = 4096, T = BATCH * SEQ, DM = 1024;
constexpr int INW = 5448;
constexpr int NPROJ = 5632;
constexpr int LD_HG = 2048, LD_ATT = 768, LD_IDX = 640, LD_GATE = 2048;
constexpr int TOPK = 256;
constexpr int NEXP = 16384;
constexpr float RMS_EPS = 1e-6f;

constexpr size_t MiB = 1u << 20;
constexpr size_t WS_CTL = 0;
constexpr size_t WS_MOD = MiB / 4;
constexpr size_t WS_MODP = MiB / 2;
constexpr size_t WS_WIN = 2 * MiB;
constexpr size_t WS_WQ = 17 * MiB;
constexpr size_t WS_SK = 21 * MiB;
constexpr size_t WS_U = 22 * MiB;
constexpr size_t WS_US = 30 * MiB;
constexpr size_t WS_V = 38 * MiB;
constexpr size_t WS_VS = 46 * MiB;
constexpr size_t WS_K8 = 48 * MiB;
constexpr size_t WS_QHI = 52 * MiB;
constexpr size_t WS_QLO = 68 * MiB;
constexpr size_t WS_WAB8 = 31 * MiB;
constexpr size_t WS_WOUT8 = 32 * MiB;
constexpr size_t WS_WIN8 = 33 * MiB;
constexpr size_t WS_H8 = 48 * MiB;
constexpr size_t WS_H = 86 * MiB;
constexpr size_t WS_HG = 150 * MiB;
constexpr size_t WS_ATT = 278 * MiB;
constexpr size_t WS_IDX = 326 * MiB;
constexpr size_t WS_GATE = 366 * MiB;
constexpr size_t WS_SEL = 494 * MiB;
constexpr size_t WS_EIDX = 48 * MiB;
constexpr size_t WS_PGATE = 64 * MiB;
constexpr size_t WS_END = 510 * MiB;
constexpr size_t WS_MERGED = WS_HG;
constexpr size_t WS_Q = 214 * MiB;
constexpr int H4_NT = 2;
constexpr size_t WS_H4D = 366 * MiB;
constexpr size_t WS_H4S = 416 * MiB;

constexpr int LDS_BYTES = 163840;

typedef unsigned short bf16;
typedef unsigned v4u __attribute__((ext_vector_type(4)));
typedef unsigned v2u __attribute__((ext_vector_type(2)));
typedef float f32x4 __attribute__((ext_vector_type(4)));
typedef float f32x2 __attribute__((ext_vector_type(2)));
typedef short bf16x8 __attribute__((ext_vector_type(8)));
#define LAS __attribute__((address_space(3)))

struct Params {
    const float *x, *c, *w_ada, *b_ada, *norm1_g, *norm2_g, *w_in, *hg_lb, *hg_onorm_g, *q_norm_g, *k_norm_g,
                *w_a, *w_b, *w_out, *peer_wq, *peer_subkeys, *peer_u, *peer_v;
    float* out; unsigned char* ws; int ph_lo, ph_hi;
};

typedef __bf16 bf16x2_hw __attribute__((ext_vector_type(2)));
__device__ __forceinline__ unsigned pk2(float lo, float hi) { const f32x2 v = {lo, hi}; const bf16x2_hw b = __builtin_convertvector(v, bf16x2_hw); return __builtin_bit_cast(unsigned, b); }
__device__ __forceinline__ unsigned f2bf(float f) { return pk2(f, 0.f) & 0xffffu; }
__device__ __forceinline__ float bf2f(unsigned u16v) { return __builtin_bit_cast(float, u16v << 16); }
__device__ __forceinline__ float bflo(unsigned w) { return __builtin_bit_cast(float, w << 16); }
__device__ __forceinline__ float bfhi(unsigned w) { return __builtin_bit_cast(float, w & 0xffff0000u); }
__device__ __forceinline__ float sigmoidf_(float x) { return __builtin_amdgcn_rcpf(1.f + __expf(-x)); }
__device__ __forceinline__ float siluf_(float x) { return x * __builtin_amdgcn_rcpf(1.f + __expf(-x)); }
__device__ __forceinline__ float wave_sum(float v) {
#pragma unroll
    for (int o = 1; o < 64; o <<= 1) v += __shfl_xor(v, o);
    return v;
}
__device__ __forceinline__ float wave_max(float v) {
#pragma unroll
    for (int o = 1; o < 64; o <<= 1) v = fmaxf(v, __shfl_xor(v, o));
    return v;
}
#define LDS_WAIT() asm volatile("s_waitcnt lgkmcnt(0)" ::: "memory")
__device__ __forceinline__ unsigned pk4_fp8(float a, float b, float c, float d) { int w = __builtin_amdgcn_cvt_pk_fp8_f32(a, b, 0, false); w = __builtin_amdgcn_cvt_pk_fp8_f32(c, d, w, true); return (unsigned)w; }

__host__ __device__ __forceinline__ int proj_tile_bf16(int i) { return i < 2 ? i + 2 : i + 6; }
__host__ __device__ __forceinline__ int proj_tile_fp8(int i) { return i < 2 ? i : (i < 6 ? i + 2 : i + 8); }
struct EpiProj {
    static constexpr bool PERM = true, AFTER_DRAIN = false, TWOPASS = false;
    bf16 *HG, *ATT, *IDX, *GATE; int f8;
    __device__ __forceinline__ void operator()(pg8::AccW& acc, const pg8::Unit& u, int wr, int wc, int fr, int fq) const {
        const int pn = f8 ? proj_tile_fp8(u.pn) : proj_tile_bf16(u.pn); bf16* base; int ldc, colt, ncols;
        if (pn < 8) { base = HG; ldc = LD_HG; colt = pn * 256; ncols = LD_HG; }
        else if (pn < 11) { base = ATT; ldc = LD_ATT; colt = (pn - 8) * 256; ncols = LD_ATT; }
        else if (pn < 14) { base = IDX; ldc = LD_IDX; colt = (pn - 11) * 256; ncols = LD_IDX; }
        else { base = GATE; ldc = LD_GATE; colt = (pn - 14) * 256; ncols = LD_GATE; }
        const int row0 = u.pm * 256 + wr * 64 + fr, col0 = colt + wc * 32 + 8 * fq;
#pragma unroll
        for (int ai = 0; ai < 2; ++ai)
#pragma unroll
            for (int m = 0; m < 4; ++m) { bf16* rowp = base + (size_t)(row0 + ai * 128 + m * 16) * ldc + col0;
#pragma unroll
                for (int bj = 0; bj < 2; ++bj) { const pg8::f32x4 v0 = pg8::acc_get(acc, ai, bj, m, 0), v1 = pg8::acc_get(acc, ai, bj, m, 1);
                    v4u w; w.x = pk2(v0[0], v0[1]); w.y = pk2(v0[2], v0[3]); w.z = pk2(v1[0], v1[1]); w.w = pk2(v1[2], v1[3]);
                    if (col0 + bj * 128 < ncols) *(v4u*)(rowp + bj * 128) = w; } }
    }
};
struct EpiMerged {
    static constexpr bool PERM = true, AFTER_DRAIN = false, TWOPASS = true;
    const bf16* GATE; bf16* O;
    __device__ __forceinline__ void operator()(pg8::AccW& acc, const pg8::Unit& u, int wr, int wc, int fr, int fq) const {
        const int row0 = u.pm * 256 + wr * 64 + fr, col0 = u.pn * 256 + wc * 32 + 8 * fq;
        if (u.pass == 0) {
#pragma unroll
            for (int ai = 0; ai < 2; ++ai)
#pragma unroll
                for (int m = 0; m < 4; ++m) { const bf16* rowp = GATE + (size_t)(row0 + ai * 128 + m * 16) * LD_GATE + col0;
#pragma unroll
                    for (int bj = 0; bj < 2; ++bj) { const v4u a = *(const v4u*)(rowp + bj * 128), b = *(const v4u*)(rowp + 1024 + bj * 128);
                        float r[8];
#pragma unroll
                        for (int i = 0; i < 4; ++i) { const float a0 = bflo(a[i]), a1 = bfhi(a[i]), b0 = bflo(b[i]), b1 = bfhi(b[i]);
                            r[2 * i] = (1.f + __expf(-b0)) * __builtin_amdgcn_rcpf(1.f + __expf(-a0)); r[2 * i + 1] = (1.f + __expf(-b1)) * __builtin_amdgcn_rcpf(1.f + __expf(-a1)); }
                        { pg8::f32x4 c0 = pg8::acc_get(acc, ai, bj, m, 0), c1 = pg8::acc_get(acc, ai, bj, m, 1);
#pragma unroll
                          for (int i = 0; i < 4; ++i) { c0[i] *= r[i]; c1[i] *= r[4 + i]; }
                          pg8::acc_set(acc, ai, bj, m, 0, c0); pg8::acc_set(acc, ai, bj, m, 1, c1); } } }
        } else {
#pragma unroll
            for (int ai = 0; ai < 2; ++ai)
#pragma unroll
                for (int m = 0; m < 4; ++m) { const size_t ro = (size_t)(row0 + ai * 128 + m * 16);
#pragma unroll
                    for (int bj = 0; bj < 2; ++bj) { const v4u b = *(const v4u*)(GATE + ro * LD_GATE + 1024 + col0 + bj * 128);
                        const pg8::f32x4 v0 = pg8::acc_get(acc, ai, bj, m, 0), v1 = pg8::acc_get(acc, ai, bj, m, 1);
                        float s[8];
#pragma unroll
                        for (int i = 0; i < 4; ++i) { s[2 * i] = sigmoidf_(bflo(b[i])); s[2 * i + 1] = sigmoidf_(bfhi(b[i])); }
                        v2u w; w.x = pk4_fp8(4.f * v0[0] * s[0], 4.f * v0[1] * s[1], 4.f * v0[2] * s[2], 4.f * v0[3] * s[3]); w.y = pk4_fp8(4.f * v1[0] * s[4], 4.f * v1[1] * s[5], 4.f * v1[2] * s[6], 4.f * v1[3] * s[7]);
                        *(v2u*)((unsigned char*)O + ro * 1024 + col0 + bj * 128) = w; } }
        }
    }
};
struct EpiResid {
    static constexpr bool PERM = true, AFTER_DRAIN = false, TWOPASS = false;
    const float* X; const float* G1  ; float* O;
    __device__ __forceinline__ void operator()(pg8::AccW& acc, const pg8::Unit& u, int wr, int wc, int fr, int fq) const {
        const int row0 = u.pm * 256 + wr * 64 + fr, col0 = u.pn * 256 + wc * 32 + 8 * fq;
        const int b = (u.pm * 256) / SEQ;
        f32x4 g[2][2];
#pragma unroll
        for (int bj = 0; bj < 2; ++bj)
#pragma unroll
            for (int n = 0; n < 2; ++n) g[bj][n] = *(const f32x4*)(G1 + (size_t)b * 6144 + col0 + bj * 128 + 4 * n);
#pragma unroll
        for (int ai = 0; ai < 2; ++ai)
#pragma unroll
            for (int m = 0; m < 4; ++m) { const size_t ro = (size_t)(row0 + ai * 128 + m * 16) * DM + col0;
#pragma unroll
                for (int bj = 0; bj < 2; ++bj)
#pragma unroll
                    for (int n = 0; n < 2; ++n) { const f32x4 xv = *(const f32x4*)(X + ro + bj * 128 + 4 * n);
                        *(f32x4*)(O + ro + bj * 128 + 4 * n) = xv + g[bj][n] * pg8::acc_get(acc, ai, bj, m, n); } }
    }
};
struct EpiStore {
    static constexpr bool PERM = true, AFTER_DRAIN = false, TWOPASS = false;
    bf16* O; int ldc;
    __device__ __forceinline__ void operator()(pg8::AccW& acc, const pg8::Unit& u, int wr, int wc, int fr, int fq) const {
        const int row0 = u.pm * 256 + wr * 64 + fr, col0 = u.pn * 256 + wc * 32 + 8 * fq;
#pragma unroll
        for (int ai = 0; ai < 2; ++ai)
#pragma unroll
            for (int m = 0; m < 4; ++m) { bf16* rowp = O + (size_t)(row0 + ai * 128 + m * 16) * ldc + col0;
#pragma unroll
                for (int bj = 0; bj < 2; ++bj) { const pg8::f32x4 v0 = pg8::acc_get(acc, ai, bj, m, 0), v1 = pg8::acc_get(acc, ai, bj, m, 1);
                    v4u w; w.x = pk2(v0[0], v0[1]); w.y = pk2(v0[2], v0[3]); w.z = pk2(v1[0], v1[1]); w.w = pk2(v1[2], v1[3]);
                    *(v4u*)(rowp + bj * 128) = w; } }
    }
};

template <int MODE> __device__ __forceinline__ int srcmap(int np) {
    if (MODE == 2) np = proj_tile_bf16(np >> 8) * 256 + (np & 255);
    if (MODE == 3) np = proj_tile_fp8(np >> 8) * 256 + (np & 255);
    if (MODE >= 1) return np < 3400 ? np : (np >= 3584 ? np - 184 : -1);
    return np; }
template <int MODE>
__device__ __forceinline__ void transpose_item(const float* W, int N, bf16* WT, int ldw, int koff, float* scr, int kb, int nb, int lane) {
    const int k0 = 64 * kb, n0 = 32 * nb;
    const int sc = srcmap<MODE>(n0 + (lane & 31));
#pragma unroll 8
    for (int i = 0; i < 32; ++i) { const int kk = 2 * i + (lane >> 5); scr[kk * 33 + (lane & 31)] = (sc >= 0) ? W[(size_t)(k0 + kk) * N + sc] : 0.f; }
    LDS_WAIT(); __builtin_amdgcn_wave_barrier();
    const int c = lane & 7;
#pragma unroll
    for (int j = 0; j < 4; ++j) { const int n = (lane >> 3) + 8 * j; const float* s = scr + (8 * c) * 33 + n;
        v4u o; o.x = pk2(s[0 * 33], s[1 * 33]); o.y = pk2(s[2 * 33], s[3 * 33]); o.z = pk2(s[4 * 33], s[5 * 33]); o.w = pk2(s[6 * 33], s[7 * 33]);
        *(v4u*)(WT + (size_t)(n0 + n) * ldw + koff + k0 + 8 * c) = o; }
    LDS_WAIT(); __builtin_amdgcn_wave_barrier();
}
template <int MODE> __device__ __forceinline__ int srcmap(int np);
template <int MODE = 0>
__device__ __forceinline__ void transpose_item8(const float* W, int N, unsigned char* WT, int ldw, int koff, float scale, float* scr, int kb, int nb, int lane) {
    const int k0 = 64 * kb, n0 = 32 * nb;
    const int sc = srcmap<MODE>(n0 + (lane & 31));
#pragma unroll 8
    for (int i = 0; i < 32; ++i) { const int kk = 2 * i + (lane >> 5); scr[kk * 33 + (lane & 31)] = (sc >= 0) ? W[(size_t)(k0 + kk) * N + sc] * scale : 0.f; }
    LDS_WAIT(); __builtin_amdgcn_wave_barrier();
    const int c = lane & 3;
#pragma unroll
    for (int j = 0; j < 2; ++j) { const int n = (lane >> 2) + 16 * j; const float* sp = scr + (16 * c) * 33 + n;
        v4u o;
#pragma unroll
        for (int q = 0; q < 4; ++q) o[q] = pk4_fp8(sp[(4 * q) * 33], sp[(4 * q + 1) * 33], sp[(4 * q + 2) * 33], sp[(4 * q + 3) * 33]);
        *(v4u*)(WT + (size_t)(n0 + n) * ldw + koff + k0 + 16 * c) = o; }
    LDS_WAIT(); __builtin_amdgcn_wave_barrier();
}
__device__ __forceinline__ void convert_plain(const float* src, bf16* dst, size_t n, size_t gtid, size_t nth) {
    const size_t n8 = n / 8;
    for (size_t i = gtid; i < n8; i += nth) { const f32x4 a = ((const f32x4*)src)[2 * i], b = ((const f32x4*)src)[2 * i + 1];
        v4u o; o.x = pk2(a[0], a[1]); o.y = pk2(a[2], a[3]); o.z = pk2(b[0], b[1]); o.w = pk2(b[2], b[3]); ((v4u*)dst)[i] = o; }
}
__device__ __forceinline__ void convert_fp8(const float* src, unsigned char* dst, size_t n, float scale, size_t gtid, size_t nth) {
    const size_t n16 = n / 16;
    for (size_t i = gtid; i < n16; i += nth) { const f32x4* sp = (const f32x4*)src + 4 * i; const f32x4 a = sp[0] * scale, b = sp[1] * scale, c = sp[2] * scale, d = sp[3] * scale;
        v4u o; o.x = pk4_fp8(a[0], a[1], a[2], a[3]); o.y = pk4_fp8(b[0], b[1], b[2], b[3]); o.z = pk4_fp8(c[0], c[1], c[2], c[3]); o.w = pk4_fp8(d[0], d[1], d[2], d[3]); ((v4u*)dst)[i] = o; }
}
template <bool KKMAJOR>
__device__ __forceinline__ void convert_mxfp4(const float* src, unsigned char* dst, unsigned char* scl, size_t nrows, size_t gtid, size_t nth) {
    const size_t nblk = nrows * 32;
    for (size_t i = gtid; i < nblk; i += nth) {
        const size_t row = i >> 5; const int blk = (int)(i & 31);
        const f32x4* sp = (const f32x4*)(src + row * 1024 + blk * 32);
        f32x4 v[8]; float amax = 0.f;
#pragma unroll
        for (int j = 0; j < 8; ++j) { v[j] = sp[j]; amax = fmaxf(fmaxf(fmaxf(fabsf(v[j][0]), fabsf(v[j][1])), fmaxf(fabsf(v[j][2]), fabsf(v[j][3]))), amax); }
        int e = (int)((__builtin_bit_cast(unsigned, amax) >> 23) & 0xffu) - 127 - 2;
        if (e < -126) e = -126;
        const float inv = __builtin_bit_cast(float, (unsigned)(127 - e) << 23);
        unsigned w[4] = {0u, 0u, 0u, 0u};
#pragma unroll
        for (int j = 0; j < 8; j += 2) { unsigned t = 0u;
            t = __builtin_amdgcn_cvt_scalef32_pk_fp4_f32(t, v[j][0] * inv, v[j][1] * inv, 1.0f, 0);
            t = __builtin_amdgcn_cvt_scalef32_pk_fp4_f32(t, v[j][2] * inv, v[j][3] * inv, 1.0f, 1);
            t = __builtin_amdgcn_cvt_scalef32_pk_fp4_f32(t, v[j + 1][0] * inv, v[j + 1][1] * inv, 1.0f, 2);
            t = __builtin_amdgcn_cvt_scalef32_pk_fp4_f32(t, v[j + 1][2] * inv, v[j + 1][3] * inv, 1.0f, 3);
            w[j >> 1] = t; }
        *(v4u*)(dst + row * 512 + blk * 16) = (v4u){w[0], w[1], w[2], w[3]};
        scl[row * 32 + (KKMAJOR ? ((blk & 3) * 8 + (blk >> 2)) : blk)] = (unsigned char)(e + 127);
    }
}
__device__ __forceinline__ void convert_rowfp4(const float* src, unsigned char* dst, _Float16* scl, int row, int lane) {
    const f32x4* sp = (const f32x4*)(src + (size_t)row * 1024 + lane * 16);
    f32x4 v[4]; float amax = 0.f;
#pragma unroll
    for (int j = 0; j < 4; ++j) { v[j] = sp[j]; amax = fmaxf(fmaxf(fmaxf(fabsf(v[j][0]), fabsf(v[j][1])), fmaxf(fabsf(v[j][2]), fabsf(v[j][3]))), amax); }
    amax = wave_max(amax);
    _Float16 sh = (_Float16)(amax * (1.f / 6.f));
    float sf = (float)sh; if (!(sf > 0.f)) { sf = 1.f; sh = (_Float16)1.f; }
    const float inv = 1.f / sf;
    unsigned w[2];
#pragma unroll
    for (int j = 0; j < 2; ++j) { unsigned t = 0u;
        t = __builtin_amdgcn_cvt_scalef32_pk_fp4_f32(t, v[2 * j][0] * inv, v[2 * j][1] * inv, 1.0f, 0);
        t = __builtin_amdgcn_cvt_scalef32_pk_fp4_f32(t, v[2 * j][2] * inv, v[2 * j][3] * inv, 1.0f, 1);
        t = __builtin_amdgcn_cvt_scalef32_pk_fp4_f32(t, v[2 * j + 1][0] * inv, v[2 * j + 1][1] * inv, 1.0f, 2);
        t = __builtin_amdgcn_cvt_scalef32_pk_fp4_f32(t, v[2 * j + 1][2] * inv, v[2 * j + 1][3] * inv, 1.0f, 3);
        w[j] = t; }
    *(v2u*)(dst + (size_t)row * 512 + lane * 8) = (v2u){w[0], w[1]};
    if (lane == 0) scl[row] = sh;
}
__device__ __forceinline__ void phase0(const Params& p, unsigned char* lds) {
    const int tid = threadIdx.x, wave = tid >> 6, lane = tid & 63, G = gridDim.x;
    const int gw = blockIdx.x * NWAVES + wave, NGW = G * NWAVES;
    float* scr = (float*)(lds + wave * 16384);
    unsigned char* ws = p.ws;
    constexpr int I_IN = 16 * (2048 / 32), I_IN8 = 16 * (3584 / 32), I_A = 8 * 32, I_O = 16 * 32, I_Q = 16 * 64;
    constexpr int NT = I_IN + I_IN8 + 2 * I_A + I_O + I_Q;
    for (int it = gw; it < NT; it += NGW) {
        int r = it;
        if (r < I_IN) { transpose_item<2>(p.w_in, INW, (bf16*)(ws + WS_WIN), 1024, 0, scr, r / 64, r % 64, lane); continue; } r -= I_IN;
        if (r < I_IN8) { transpose_item8<3>(p.w_in, INW, ws + WS_WIN8, 1024, 0, 32.f, scr, r / 112, r % 112, lane); continue; } r -= I_IN8;
        if (r < I_A) { transpose_item8(p.w_a, 1024, ws + WS_WAB8, 1024, 0, 32.f, scr, r / 32, r % 32, lane); continue; } r -= I_A;
        if (r < I_A) { transpose_item8(p.w_b, 1024, ws + WS_WAB8, 1024, 512, 4.f, scr, r / 32, r % 32, lane); continue; } r -= I_A;
        if (r < I_O) { transpose_item8(p.w_out, 1024, ws + WS_WOUT8, 1024, 0, 32.f, scr, r / 32, r % 32, lane); continue; } r -= I_O;
        transpose_item<0>(p.peer_wq, 2048, (bf16*)(ws + WS_WQ), 1024, 0, scr, r / 64, r % 64, lane);
    }
    for (int it = gw; it < 96 * 8; it += NGW) {
        const int cgp = it % 96, ks = it / 96, col = cgp * 64 + lane, k0 = ks * 128;
#pragma unroll
        for (int i = 0; i < 16; ++i) { const int e = i * 64 + lane, b = e >> 7, k = e & 127; scr[e] = siluf_(p.c[b * 1024 + k0 + k]); }
        LDS_WAIT(); __builtin_amdgcn_wave_barrier();
        float acc[8];
#pragma unroll
        for (int b = 0; b < 8; ++b) acc[b] = 0.f;
#pragma unroll 4
        for (int k = 0; k < 128; ++k) { const float w = p.w_ada[(size_t)(k0 + k) * 6144 + col];
#pragma unroll
            for (int b = 0; b < 8; ++b) acc[b] += scr[b * 128 + k] * w; }
        float* mp = (float*)(ws + WS_MODP) + (size_t)ks * 8 * 6144 + col;
#pragma unroll
        for (int b = 0; b < 8; ++b) mp[b * 6144] = acc[b];
        LDS_WAIT(); __builtin_amdgcn_wave_barrier();
    }
    const size_t gtid = (size_t)blockIdx.x * NTHREADS + tid, nth = (size_t)G * NTHREADS;
    convert_plain(p.peer_subkeys, (bf16*)(ws + WS_SK), (size_t)16 * 128 * 128, gtid, nth);
    for (int it = gw; it < 2 * NEXP; it += NGW) {
        if (it < NEXP) convert_rowfp4(p.peer_u, ws + WS_U, (_Float16*)(ws + WS_US), it, lane);
        else convert_rowfp4(p.peer_v, ws + WS_V, (_Float16*)(ws + WS_VS), it - NEXP, lane);
    }
}

template <bool FIRST>
__device__ __forceinline__ void normmod_phase(const Params& p, unsigned char* lds, const float* src, bf16* dst, const float* gvec, int shift_off, int scale_off) {
    const int tid = threadIdx.x, wave = tid >> 6, lane = tid & 63, G = gridDim.x;
    unsigned char* ws = p.ws;
    float* A = (float*)lds;
    float* Bv = A + 1024;
    const float* MODP = (const float*)(ws + WS_MODP);
    float* MOD = (float*)(ws + WS_MOD);
    if (FIRST) {
        for (int e = blockIdx.x * NTHREADS + tid; e < 8 * 6144; e += G * NTHREADS) { const int col = e % 6144; float s = p.b_ada[col];
#pragma unroll
            for (int ks = 0; ks < 8; ++ks) s += MODP[(size_t)ks * 8 * 6144 + e];
            MOD[e] = s; }
    }
    int curb = -1;
    for (int chunk = blockIdx.x; chunk < T / 128; chunk += G) {
        const int b = (chunk * 128) / SEQ;
        if (b != curb) {
            __syncthreads();
            for (int col = tid; col < 1024; col += NTHREADS) {
                float sc, sh;
                if (FIRST) { sc = p.b_ada[scale_off + col]; sh = p.b_ada[shift_off + col];
#pragma unroll
                    for (int ks = 0; ks < 8; ++ks) { sc += MODP[(size_t)(ks * 8 + b) * 6144 + scale_off + col]; sh += MODP[(size_t)(ks * 8 + b) * 6144 + shift_off + col]; } }
                else { sc = MOD[b * 6144 + scale_off + col]; sh = MOD[b * 6144 + shift_off + col]; }
                A[col] = gvec[col] * (1.f + sc); Bv[col] = sh; }
            __syncthreads(); curb = b;
        }
        for (int r = wave; r < 128; r += NWAVES) {
            const size_t row = (size_t)chunk * 128 + r;
            const f32x4* xr = (const f32x4*)(src + row * DM) + lane;
            f32x4 v[4]; float s = 0.f;
#pragma unroll
            for (int j = 0; j < 4; ++j) { v[j] = xr[64 * j]; s += (v[j][0] * v[j][0] + v[j][1] * v[j][1]) + (v[j][2] * v[j][2] + v[j][3] * v[j][3]); }
            const float rstd = rsqrtf(wave_sum(s) * (1.f / DM) + RMS_EPS);
            v2u* o8 = (v2u*)(dst + row * DM) + lane;
#pragma unroll
            for (int j = 0; j < 4; ++j) { const int c0 = 4 * lane + 256 * j; const f32x4 a = *(const f32x4*)(A + c0), sh = *(const f32x4*)(Bv + c0);
                v2u o; o.x = pk2(v[j][0] * rstd * a[0] + sh[0], v[j][1] * rstd * a[1] + sh[1]); o.y = pk2(v[j][2] * rstd * a[2] + sh[2], v[j][3] * rstd * a[3] + sh[3]);
                o8[64 * j] = o;
                if (FIRST) *(unsigned*)(ws + WS_H8 + row * DM + c0) = pk4_fp8(v[j][0] * rstd * a[0] + sh[0], v[j][1] * rstd * a[1] + sh[1], v[j][2] * rstd * a[2] + sh[2], v[j][3] * rstd * a[3] + sh[3]);
                if (!FIRST) { float* st = (float*)(lds + 8192) + wave * 1056;
                    const float y0 = v[j][0] * rstd * a[0] + sh[0], y1 = v[j][1] * rstd * a[1] + sh[1], y2 = v[j][2] * rstd * a[2] + sh[2], y3 = v[j][3] * rstd * a[3] + sh[3];
                    const int pc = c0 + (c0 >> 5); st[pc] = y0; st[pc + 1] = y1; st[pc + 2] = y2; st[pc + 3] = y3; } }
            if (!FIRST) {
                const float* st = (const float*)(lds + 8192) + wave * 1056;
                LDS_WAIT(); __builtin_amdgcn_wave_barrier();
                if (lane < 32) {
                    float x[32];
#pragma unroll
                    for (int k = 0; k < 32; ++k) x[k] = st[lane * 33 + k];
#pragma unroll
                    for (int t = 0; t < H4_NT; ++t) {
                        float amax = 0.f;
#pragma unroll
                        for (int k = 0; k < 32; ++k) amax = fmaxf(amax, fabsf(x[k]));
                        int e = (int)((__builtin_bit_cast(unsigned, amax) >> 23) & 0xffu) - 127 - 2; if (e < -126) e = -126;
                        const float inv = __builtin_bit_cast(float, (unsigned)(127 - e) << 23), sc = __builtin_bit_cast(float, (unsigned)(127 + e) << 23);
                        unsigned w[4];
#pragma unroll
                        for (int r = 0; r < 4; ++r) { unsigned tw = 0u;
                            tw = __builtin_amdgcn_cvt_scalef32_pk_fp4_f32(tw, x[8 * r] * inv, x[8 * r + 1] * inv, 1.0f, 0);
                            tw = __builtin_amdgcn_cvt_scalef32_pk_fp4_f32(tw, x[8 * r + 2] * inv, x[8 * r + 3] * inv, 1.0f, 1);
                            tw = __builtin_amdgcn_cvt_scalef32_pk_fp4_f32(tw, x[8 * r + 4] * inv, x[8 * r + 5] * inv, 1.0f, 2);
                            tw = __builtin_amdgcn_cvt_scalef32_pk_fp4_f32(tw, x[8 * r + 6] * inv, x[8 * r + 7] * inv, 1.0f, 3);
                            w[r] = tw;
                            const f32x2 d0 = __builtin_amdgcn_cvt_scalef32_pk_f32_fp4(tw, 1.0f, 0), d1 = __builtin_amdgcn_cvt_scalef32_pk_f32_fp4(tw, 1.0f, 1), d2 = __builtin_amdgcn_cvt_scalef32_pk_f32_fp4(tw, 1.0f, 2), d3 = __builtin_amdgcn_cvt_scalef32_pk_f32_fp4(tw, 1.0f, 3);
                            x[8 * r] -= d0[0] * sc; x[8 * r + 1] -= d0[1] * sc; x[8 * r + 2] -= d1[0] * sc; x[8 * r + 3] -= d1[1] * sc;
                            x[8 * r + 4] -= d2[0] * sc; x[8 * r + 5] -= d2[1] * sc; x[8 * r + 6] -= d3[0] * sc; x[8 * r + 7] -= d3[1] * sc; }
                        *(v4u*)(ws + WS_H4D + (row * H4_NT + t) * 512 + lane * 16) = (v4u){w[0], w[1], w[2], w[3]};
                        *(ws + WS_H4S + (row * H4_NT + t) * 32 + (lane & 3) * 8 + (lane >> 2)) = (unsigned char)(e + 127);
                    }
                }
                LDS_WAIT(); __builtin_amdgcn_wave_barrier();
            }
        }
    }
    __syncthreads();
}

constexpr int HGL_QT = 0, HGL_KT = 17408, HGL_QE = 34816, HGL_KLT = 52224, HGL_VT = 70656, HGL_AM = 89088, HGL_DEC = 98304, HGL_TOT = 98816, HGL_SSQ = 100864;
constexpr int HG_LDR = 136;
constexpr int HG_LDC = 72;
__device__ __forceinline__ void hgrn_item(const Params& p, unsigned char* lds, int item) {
    const int b = item >> 2, h = item & 3;
    const int tid = threadIdx.x, w = tid >> 6, lane = tid & 63, fr = lane & 15, fq = lane >> 4;
    unsigned char* ws = p.ws;
    const bf16* HG = (const bf16*)(ws + WS_HG);
    bf16* YA = (bf16*)(ws + WS_H);
    bf16* QT = (bf16*)(lds + HGL_QT); bf16* KT = (bf16*)(lds + HGL_KT); bf16* QE = (bf16*)(lds + HGL_QE);
    bf16* KLT = (bf16*)(lds + HGL_KLT); bf16* VT = (bf16*)(lds + HGL_VT); bf16* AM = (bf16*)(lds + HGL_AM);
    float* DEC = (float*)(lds + HGL_DEC); float* TOT = (float*)(lds + HGL_TOT); float* SSQ = (float*)(lds + HGL_SSQ);
    const int pd = tid & 127, pq = tid >> 7;
    float lbv; { const float a0 = p.hg_lb[h * 128 + pd], a1 = p.hg_lb[512 + h * 128 + pd]; lbv = 1.f / (1.f + __expf(a1 - a0)); }
    const int e0 = w * 16;
    const float ogv = p.hg_onorm_g[e0 + fr];
    pg8::f32x4 S[8];
#pragma unroll
    for (int i = 0; i < 8; ++i) S[i] = (pg8::f32x4){0.f, 0.f, 0.f, 0.f};
    const size_t rowb = (size_t)b * SEQ;
    unsigned short rq[16], rf[16], rv[16];
    { const bf16* gp = HG + (rowb + pq * 16) * LD_HG + h * 128 + pd;
#pragma unroll
      for (int i = 0; i < 16; ++i) { rq[i] = gp[(size_t)i * LD_HG]; rf[i] = gp[(size_t)i * LD_HG + 512]; rv[i] = gp[(size_t)i * LD_HG + 1024]; } }
    for (int chunk = 0; chunk < SEQ / 64; ++chunk) {
        const size_t row0 = rowb + (size_t)chunk * 64;
        float fq_[16], kq_[16], cs[16];
        float run = 0.f;
#pragma unroll
        for (int i = 0; i < 16; ++i) { const float f = lbv + (1.f - lbv) * sigmoidf_(bf2f(rf[i])); kq_[i] = 1.f - f; run += __logf(f); cs[i] = run; fq_[i] = siluf_(bf2f(rq[i])); }
        TOT[pq * 128 + pd] = run;
        { v4u v0, v1;
          v0.x = rv[0] | ((unsigned)rv[1] << 16); v0.y = rv[2] | ((unsigned)rv[3] << 16); v0.z = rv[4] | ((unsigned)rv[5] << 16); v0.w = rv[6] | ((unsigned)rv[7] << 16);
          v1.x = rv[8] | ((unsigned)rv[9] << 16); v1.y = rv[10] | ((unsigned)rv[11] << 16); v1.z = rv[12] | ((unsigned)rv[13] << 16); v1.w = rv[14] | ((unsigned)rv[15] << 16);
          *(v4u*)(VT + pd * HG_LDC + pq * 16) = v0; *(v4u*)(VT + pd * HG_LDC + pq * 16 + 8) = v1; }
        unsigned short rg[16];
#pragma unroll
        for (int i = 0; i < 16; ++i) rg[i] = HG[(row0 + (i >> 2) * 16 + fq * 4 + (i & 3)) * LD_HG + 1536 + h * 128 + e0 + fr];
        if (chunk + 1 < SEQ / 64) { const bf16* gp = HG + (row0 + 64 + pq * 16) * LD_HG + h * 128 + pd;
#pragma unroll
            for (int i = 0; i < 16; ++i) { rq[i] = gp[(size_t)i * LD_HG]; rf[i] = gp[(size_t)i * LD_HG + 512]; rv[i] = gp[(size_t)i * LD_HG + 1024]; } }
        __syncthreads();
        const float t0 = TOT[pd], t1 = TOT[128 + pd], t2 = TOT[256 + pd], t3 = TOT[384 + pd];
        const float base = (pq > 0 ? t0 : 0.f) + (pq > 1 ? t1 : 0.f) + (pq > 2 ? t2 : 0.f);
        const float bmid = t0 + t1, blast = (t0 + t1) + (t2 + t3);
        const float emid = __expf(bmid), elm = __expf(blast - bmid);
        if (pq == 0) DEC[pd] = __expf(blast);
        { unsigned klp[8];
#pragma unroll
          for (int i = 0; i < 16; ++i) { const float bb = base + cs[i]; const float E1 = __expf(bb - bmid), R1 = __builtin_amdgcn_rcpf(E1);
              const float qtv = fq_[i] * E1, ktv = kq_[i] * R1, qev = qtv * emid, klv = ktv * elm;
              const int srow = pq * 16 + i;
              QT[srow * HG_LDR + pd] = (bf16)f2bf(qtv); KT[srow * HG_LDR + pd] = (bf16)f2bf(ktv); QE[srow * HG_LDR + pd] = (bf16)f2bf(qev);
              if (i & 1) klp[i >> 1] |= f2bf(klv) << 16; else klp[i >> 1] = f2bf(klv); }
          *(v4u*)(KLT + pd * HG_LDC + pq * 16) = (v4u){klp[0], klp[1], klp[2], klp[3]}; *(v4u*)(KLT + pd * HG_LDC + pq * 16 + 8) = (v4u){klp[4], klp[5], klp[6], klp[7]}; }
        __syncthreads();
#pragma unroll
        for (int tt = 0; tt < 2; ++tt) { const int id = w + 8 * tt, rt = id >> 2, ct = id & 3;
            pg8::f32x4 a = {0.f, 0.f, 0.f, 0.f};
            if (ct <= rt) {
#pragma unroll
                for (int ks = 0; ks < 4; ++ks) { const bf16x8 af = *(const bf16x8*)(QT + (rt * 16 + fr) * HG_LDR + ks * 32 + fq * 8), bfv = *(const bf16x8*)(KT + (ct * 16 + fr) * HG_LDR + ks * 32 + fq * 8);
                    a = __builtin_amdgcn_mfma_f32_16x16x32_bf16(af, bfv, a, 0, 0, 0); } }
#pragma unroll
            for (int r = 0; r < 4; ++r) { const int c = rt * 16 + fq * 4 + r, sidx = ct * 16 + fr; AM[c * HG_LDC + sidx] = (bf16)((sidx <= c) ? f2bf(a[r]) : 0u); } }
        __syncthreads();
        const bf16x8 vb0 = *(const bf16x8*)(VT + (e0 + fr) * HG_LDC + fq * 8), vb1 = *(const bf16x8*)(VT + (e0 + fr) * HG_LDC + 32 + fq * 8);
        bf16x8 sb[4];
#pragma unroll
        for (int ks = 0; ks < 4; ++ks) { v4u t; t.x = pk2(S[2 * ks][0], S[2 * ks][1]); t.y = pk2(S[2 * ks][2], S[2 * ks][3]); t.z = pk2(S[2 * ks + 1][0], S[2 * ks + 1][1]); t.w = pk2(S[2 * ks + 1][2], S[2 * ks + 1][3]); sb[ks] = __builtin_bit_cast(bf16x8, t); }
        pg8::f32x4 o[4];
#pragma unroll
        for (int rt = 0; rt < 4; ++rt) { pg8::f32x4 a = {0.f, 0.f, 0.f, 0.f};
            a = __builtin_amdgcn_mfma_f32_16x16x32_bf16(*(const bf16x8*)(AM + (rt * 16 + fr) * HG_LDC + fq * 8), vb0, a, 0, 0, 0);
            a = __builtin_amdgcn_mfma_f32_16x16x32_bf16(*(const bf16x8*)(AM + (rt * 16 + fr) * HG_LDC + 32 + fq * 8), vb1, a, 0, 0, 0);
#pragma unroll
            for (int ks = 0; ks < 4; ++ks) { const v2u lo = *(const v2u*)(QE + (rt * 16 + fr) * HG_LDR + ks * 32 + fq * 4), hi = *(const v2u*)(QE + (rt * 16 + fr) * HG_LDR + ks * 32 + 16 + fq * 4);
                const v4u t = {lo.x, lo.y, hi.x, hi.y};
                a = __builtin_amdgcn_mfma_f32_16x16x32_bf16(__builtin_bit_cast(bf16x8, t), sb[ks], a, 0, 0, 0); }
            o[rt] = a; }
#pragma unroll
        for (int dt = 0; dt < 8; ++dt) { const f32x4 dc = *(const f32x4*)(DEC + dt * 16 + fq * 4);
            pg8::f32x4 a = S[dt]; a[0] *= dc[0]; a[1] *= dc[1]; a[2] *= dc[2]; a[3] *= dc[3];
            a = __builtin_amdgcn_mfma_f32_16x16x32_bf16(*(const bf16x8*)(KLT + (dt * 16 + fr) * HG_LDC + fq * 8), vb0, a, 0, 0, 0);
            a = __builtin_amdgcn_mfma_f32_16x16x32_bf16(*(const bf16x8*)(KLT + (dt * 16 + fr) * HG_LDC + 32 + fq * 8), vb1, a, 0, 0, 0);
            S[dt] = a; }
#pragma unroll
        for (int rt = 0; rt < 4; ++rt)
#pragma unroll
            for (int r = 0; r < 4; ++r) { float x = o[rt][r] * o[rt][r];
                x += __shfl_xor(x, 1); x += __shfl_xor(x, 2); x += __shfl_xor(x, 4); x += __shfl_xor(x, 8);
                if (fr == 0) SSQ[w * 64 + rt * 16 + fq * 4 + r] = x; }
        __syncthreads();
        float tot = 0.f;
#pragma unroll
        for (int ww = 0; ww < 8; ++ww) tot += SSQ[ww * 64 + lane];
        const float rstd_l = rsqrtf(tot * (1.f / 128.f) + RMS_EPS);
#pragma unroll
        for (int rt = 0; rt < 4; ++rt)
#pragma unroll
            for (int r = 0; r < 4; ++r) { const int c = rt * 16 + fq * 4 + r; const float rs = __shfl(rstd_l, c);
                const float y = o[rt][r] * rs * ogv * siluf_(bf2f(rg[rt * 4 + r]));
                ((unsigned char*)YA)[(row0 + c) * 1024 + h * 128 + e0 + fr] = (unsigned char)(__builtin_amdgcn_cvt_pk_fp8_f32(y, 0.f, 0, false) & 0xff); }
    }
    __syncthreads();
}

__device__ __forceinline__ unsigned f16key(float x) {
    x = x + 0.f;
    const _Float16 hx = (_Float16)x; const unsigned short bits = __builtin_bit_cast(unsigned short, hx);
    return (bits & 0x8000u) ? (unsigned)(unsigned short)(~bits) : (unsigned)(bits | 0x8000u);
}
__device__ __forceinline__ void find_bin(const unsigned* hist, int K, int lane, int& bin, int& rem) {
    const v4u hv = *(const v4u*)(hist + 4 * lane);
    const unsigned c = hv.x + hv.y + hv.z + hv.w;
    unsigned suf = c;
#pragma unroll
    for (int o = 1; o < 64; o <<= 1) { const unsigned t = __shfl_down(suf, o); if (lane + o < 64) suf += t; }
    const unsigned above = suf - c;
    const bool mine = (above < (unsigned)K) && ((unsigned)K <= suf);
    int mybin = 0, myrem = 0;
    if (mine) { unsigned ca = above; const unsigned hh[4] = {hv.x, hv.y, hv.z, hv.w}; bool found = false;
#pragma unroll
        for (int i = 3; i >= 0; --i) { if (!found) { if (ca + hh[i] >= (unsigned)K) { mybin = 4 * lane + i; myrem = K - (int)ca; found = true; } else ca += hh[i]; } } }
    const unsigned long long m = __ballot(mine);
    const int src = (int)__builtin_ctzll(m | (1ull << 63));
    bin = __shfl(mybin, src); rem = __shfl(myrem, src);
}
__device__ __forceinline__ void dsa1_item(const Params& p, unsigned char* lds, int item) {
    const int b = item >> 8, q0 = (item & 255) * 16;
    const int tid = threadIdx.x, w = tid >> 6, lane = tid & 63, fr = lane & 15, fq = lane >> 4;
    unsigned char* ws = p.ws;
    const bf16* IDX = (const bf16*)(ws + WS_IDX);
    unsigned short* Ik = (unsigned short*)lds;
    unsigned* hist1 = (unsigned*)(lds + 131072);
    unsigned* hist = (unsigned*)(lds + 131072 + 16384) + w * 256;
    const size_t rowb = (size_t)b * SEQ;
    *(v4u*)(hist1 + tid * 4) = (v4u){0u, 0u, 0u, 0u}; *(v4u*)(hist1 + 2048 + tid * 4) = (v4u){0u, 0u, 0u, 0u};
    bf16x8 Af[8][2];
    { const bf16* rp = IDX + (rowb + q0 + fr) * LD_IDX + fq * 8;
#pragma unroll
      for (int h = 0; h < 8; ++h) { Af[h][0] = *(const bf16x8*)(rp + h * 64); Af[h][1] = *(const bf16x8*)(rp + h * 64 + 32); } }
    const float idx_scale = 0.5f * 0.125f * 0.35355339059327373f;
    bf16x8 Aw[2];
    { float wa[8];
      { const v4u wq = *(const v4u*)(IDX + (rowb + q0 + fr) * LD_IDX + 576);
#pragma unroll
        for (int i = 0; i < 4; ++i) { wa[2 * i] = bflo(wq[i]) * idx_scale; wa[2 * i + 1] = bfhi(wq[i]) * idx_scale; } }
#pragma unroll
      for (int ks = 0; ks < 2; ++ks) { float cq[8];
#pragma unroll
          for (int j = 0; j < 8; ++j) cq[j] = 0.f;
#pragma unroll
          for (int h = 0; h < 8; ++h)
#pragma unroll
              for (int j = 0; j < 8; ++j) cq[j] += wa[h] * bf2f((unsigned)(unsigned short)Af[h][ks][j]);
          const v4u t = {pk2(cq[0], cq[1]), pk2(cq[2], cq[3]), pk2(cq[4], cq[5]), pk2(cq[6], cq[7])};
          Aw[ks] = __builtin_bit_cast(bf16x8, t); } }
    float wv[4][8];
#pragma unroll
    for (int r = 0; r < 4; ++r) { const v4u wq = *(const v4u*)(IDX + (rowb + q0 + fq * 4 + r) * LD_IDX + 576);
#pragma unroll
        for (int i = 0; i < 4; ++i) { wv[r][2 * i] = bflo(wq[i]) * idx_scale; wv[r][2 * i + 1] = bfhi(wq[i]) * idx_scale; } }
    const int ntiles = (q0 >> 4) + 1;
    __syncthreads();
    bf16x8 B0 = Aw[0], B1 = Aw[1];
    if (w < ntiles) { const bf16* kp = IDX + (rowb + w * 16 + fr) * LD_IDX + 512 + fq * 8; B0 = *(const bf16x8*)kp; B1 = *(const bf16x8*)(kp + 32); }
    for (int kt = w; kt < ntiles; kt += NWAVES) {
        bf16x8 nB0 = B0, nB1 = B1;
        if (kt + NWAVES < ntiles) { const bf16* kp = IDX + (rowb + (kt + NWAVES) * 16 + fr) * LD_IDX + 512 + fq * 8; nB0 = *(const bf16x8*)kp; nB1 = *(const bf16x8*)(kp + 32); }
        pg8::f32x4 lin = {0.f, 0.f, 0.f, 0.f};
        lin = __builtin_amdgcn_mfma_f32_16x16x32_bf16(Aw[0], B0, lin, 0, 0, 0);
        lin = __builtin_amdgcn_mfma_f32_16x16x32_bf16(Aw[1], B1, lin, 0, 0, 0);
        float I[4] = {lin[0], lin[1], lin[2], lin[3]};
#pragma unroll
        for (int h = 0; h < 8; ++h) { pg8::f32x4 a = {0.f, 0.f, 0.f, 0.f};
            a = __builtin_amdgcn_mfma_f32_16x16x32_bf16(Af[h][0], B0, a, 0, 0, 0);
            a = __builtin_amdgcn_mfma_f32_16x16x32_bf16(Af[h][1], B1, a, 0, 0, 0);
#pragma unroll
            for (int r = 0; r < 4; ++r) I[r] = __builtin_fmaf(wv[r][h], __builtin_fabsf(a[r]), I[r]); }
        const int kidx = kt * 16 + fr;
#pragma unroll
        for (int r = 0; r < 4; ++r) { const unsigned key = f16key(I[r]); Ik[(fq * 4 + r) * 4096 + kidx] = (unsigned short)key;
            if (kidx <= q0 + fq * 4 + r) atomicAdd(&hist1[(fq * 4 + r) * 256 + (key >> 8)], 1u); }
        B0 = nB0; B1 = nB1;
    }
    __syncthreads();
    for (int qq = w; qq < 16; qq += NWAVES) {
        const int t = q0 + qq, n = t + 1;
        unsigned short* so = (unsigned short*)(hist1 + qq * 256);
        const unsigned short* keys = Ik + qq * 4096;
        if (n <= TOPK) { for (int j = lane; j < n; j += 64) so[j] = (unsigned short)j; }
        else {
            int b1, rem1, b2, rem2;
            find_bin(hist1 + qq * 256, TOPK, lane, b1, rem1);
            *(v4u*)(hist + 4 * lane) = (v4u){0u, 0u, 0u, 0u};
            LDS_WAIT(); __builtin_amdgcn_wave_barrier();
            for (int j = lane; j < n; j += 64) { const unsigned k = keys[j]; if ((int)(k >> 8) == b1) atomicAdd(&hist[k & 255u], 1u); }
            LDS_WAIT(); __builtin_amdgcn_wave_barrier();
            find_bin(hist, rem1, lane, b2, rem2);
            const unsigned thr = ((unsigned)b1 << 8) | (unsigned)b2;
            int base = 0, eqtaken = 0;
            const unsigned long long lt = (lane == 0) ? 0ull : (~0ull >> (64 - lane));
            for (int j0 = 0; j0 < n; j0 += 64) {
                const int j = j0 + lane; const bool valid = j < n; const unsigned k = valid ? (unsigned)keys[j] : 0u;
                const bool gt = valid && k > thr, eq = valid && k == thr;
                const unsigned long long meq = __ballot(eq);
                const int erank = __popcll(meq & lt) + eqtaken;
                const bool take = gt || (eq && erank < rem2);
                const unsigned long long mt = __ballot(take);
                if (take) so[base + __popcll(mt & lt)] = (unsigned short)j;
                base += __popcll(mt); eqtaken += __popcll(meq);
            }
        }
    }
    __syncthreads();
}

__device__ __forceinline__ void qknorm_token(const Params& p, int tok, int lane) {
    const bf16* row = (const bf16*)(p.ws + WS_ATT) + (size_t)tok * LD_ATT;
    const int c8 = (lane & 7) * 8;
    { const v4u qv = *(const v4u*)(row + lane * 8);
      float x[8]; float ss = 0.f;
#pragma unroll
      for (int i = 0; i < 4; ++i) { x[2 * i] = bflo(qv[i]); x[2 * i + 1] = bfhi(qv[i]); ss += x[2 * i] * x[2 * i] + x[2 * i + 1] * x[2 * i + 1]; }
      ss += __shfl_xor(ss, 1); ss += __shfl_xor(ss, 2); ss += __shfl_xor(ss, 4);
      const float rs = rsqrtf(ss * (1.f / 64.f) + RMS_EPS) * (0.125f * 1.4426950408889634f);
#pragma unroll
      for (int i = 0; i < 8; ++i) x[i] = x[i] * rs * p.q_norm_g[c8 + i];
      v2u hw, lw;
      hw.x = pk4_fp8(x[0], x[1], x[2], x[3]); hw.y = pk4_fp8(x[4], x[5], x[6], x[7]);
      { const f32x2 d0 = __builtin_amdgcn_cvt_pk_f32_fp8((int)hw.x, false), d1 = __builtin_amdgcn_cvt_pk_f32_fp8((int)hw.x, true), d2 = __builtin_amdgcn_cvt_pk_f32_fp8((int)hw.y, false), d3 = __builtin_amdgcn_cvt_pk_f32_fp8((int)hw.y, true);
        lw.x = pk4_fp8(x[0] - d0[0], x[1] - d0[1], x[2] - d1[0], x[3] - d1[1]); lw.y = pk4_fp8(x[4] - d2[0], x[5] - d2[1], x[6] - d3[0], x[7] - d3[1]); }
      *(v2u*)(p.ws + WS_QHI + (size_t)tok * 512 + lane * 8) = hw; *(v2u*)(p.ws + WS_QLO + (size_t)tok * 512 + lane * 8) = lw; }
    { const v4u kv = *(const v4u*)(row + 512 + (lane & 15) * 8);
      float x[8]; float ss = 0.f;
#pragma unroll
      for (int i = 0; i < 4; ++i) { x[2 * i] = bflo(kv[i]); x[2 * i + 1] = bfhi(kv[i]); ss += x[2 * i] * x[2 * i] + x[2 * i + 1] * x[2 * i + 1]; }
      ss += __shfl_xor(ss, 1); ss += __shfl_xor(ss, 2); ss += __shfl_xor(ss, 4);
      const float rs = rsqrtf(ss * (1.f / 64.f) + RMS_EPS);
#pragma unroll
      for (int i = 0; i < 8; ++i) x[i] = x[i] * rs * p.k_norm_g[c8 + i];
      v2u o; o.x = pk4_fp8(x[0], x[1], x[2], x[3]); o.y = pk4_fp8(x[4], x[5], x[6], x[7]);
      if (lane < 16) *(v2u*)(p.ws + WS_K8 + (size_t)tok * 128 + lane * 8) = o; }
}

typedef short v4i16_t __attribute__((ext_vector_type(4)));
__device__ __forceinline__ v4i16_t vtr16(const bf16* ldsp) { return __builtin_amdgcn_ds_read_tr16_b64_v4i16((LAS v4i16_t*)ldsp); }
__device__ __forceinline__ void dsa2_query(const Params& p, unsigned char* ldsw, const unsigned short* sel, int b, int t, int lane) {
    unsigned char* ws = p.ws;
    const bf16* ATT = (const bf16*)(ws + WS_ATT);
    bf16* YB = (bf16*)(ws + WS_H);
    unsigned short* sl = (unsigned short*)ldsw;
    float* df = (float*)(ldsw + 512);
    bf16* Vl = (bf16*)(ldsw + 1536);
    const int fr = lane & 15, fq = lane >> 4;
    const size_t rowb = (size_t)b * SEQ;
    const int cnt = (t + 1 < TOPK) ? (t + 1) : TOPK;
    { v2u sv = *(const v2u*)(sel + lane * 4);
      const int j0 = lane * 4;
      if (j0 >= cnt) sv.x = 0u; else if (j0 + 1 >= cnt) sv.x &= 0xffffu;
      if (j0 + 2 >= cnt) sv.y = 0u; else if (j0 + 3 >= cnt) sv.y &= 0xffffu;
      *(v2u*)(sl + lane * 4) = sv;
      f32x4 d4; d4[0] = (j0 < cnt) ? (float)(t - (int)(sv.x & 0xffffu)) : INFINITY; d4[1] = (j0 + 1 < cnt) ? (float)(t - (int)(sv.x >> 16)) : INFINITY;
      d4[2] = (j0 + 2 < cnt) ? (float)(t - (int)(sv.y & 0xffffu)) : INFINITY; d4[3] = (j0 + 3 < cnt) ? (float)(t - (int)(sv.y >> 16)) : INFINITY;
      *(f32x4*)(df + lane * 4) = d4; }
    LDS_WAIT(); __builtin_amdgcn_wave_barrier();
    const unsigned char* K8 = ws + WS_K8;
    long qhA[2] = {0, 0}, qhB[2] = {0, 0}, qlA[2] = {0, 0}, qlB[2] = {0, 0};
    if (fr < 8) { const v4u qh = *(const v4u*)(ws + WS_QHI + (rowb + t) * 512 + fr * 64 + fq * 16), ql = *(const v4u*)(ws + WS_QLO + (rowb + t) * 512 + fr * 64 + fq * 16);
        const long hA = (long)(((unsigned long long)qh.y << 32) | qh.x), hB = (long)(((unsigned long long)qh.w << 32) | qh.z), lA = (long)(((unsigned long long)ql.y << 32) | ql.x), lB = (long)(((unsigned long long)ql.w << 32) | ql.z);
        if (fr < 4) { qhA[0] = hA; qhB[0] = hB; qlA[0] = lA; qlB[0] = lB; } else { qhA[1] = hA; qhB[1] = hB; qlA[1] = lA; qlB[1] = lB; } }
    pg8::f32x4 sc[16];
    v4u vv[16];
    { v4u kf[16];
#pragma unroll
      for (int half = 0; half < 2; ++half) {
#pragma unroll
          for (int kt = 0; kt < 8; ++kt) { const int s = sl[(half * 8 + kt) * 16 + fr]; const unsigned char* kp = K8 + (rowb + s) * 128 + fq * 16;
              kf[2 * kt] = *(const v4u*)kp; kf[2 * kt + 1] = *(const v4u*)(kp + 64); }
          if (half == 1) {
#pragma unroll
              for (int i = 0; i < 8; ++i) { const int s = sl[i * 8 + (lane >> 3)]; vv[i] = *(const v4u*)(ATT + (rowb + s) * LD_ATT + 640 + (lane & 7) * 8); } }
          __builtin_amdgcn_sched_barrier(0);
#pragma unroll
          for (int kt = 0; kt < 8; ++kt) { pg8::f32x4 a = {0.f, 0.f, 0.f, 0.f};
#pragma unroll
              for (int gg = 0; gg < 2; ++gg) { const v4u kv = kf[2 * kt + gg];
                  const long kA = (long)(((unsigned long long)kv.y << 32) | kv.x), kB = (long)(((unsigned long long)kv.w << 32) | kv.z);
                  a = __builtin_amdgcn_mfma_f32_16x16x32_fp8_fp8(kA, qhA[gg], a, 0, 0, 0); a = __builtin_amdgcn_mfma_f32_16x16x32_fp8_fp8(kB, qhB[gg], a, 0, 0, 0);
                  a = __builtin_amdgcn_mfma_f32_16x16x32_fp8_fp8(kA, qlA[gg], a, 0, 0, 0); a = __builtin_amdgcn_mfma_f32_16x16x32_fp8_fp8(kB, qlB[gg], a, 0, 0, 0); }
              sc[half * 8 + kt] = a; }
          __builtin_amdgcn_sched_barrier(0);
      } }
    const float slope = exp2f(-(float)((fr & 7) + 1)) * 1.4426950408889634f;
    float m = -INFINITY;
#pragma unroll
    for (int kt = 0; kt < 16; ++kt) { const f32x4 d4 = *(const f32x4*)(df + kt * 16 + fq * 4);
#pragma unroll
        for (int r = 0; r < 4; ++r) { const float x = sc[kt][r] - slope * d4[r]; sc[kt][r] = x; m = fmaxf(m, x); } }
    m = fmaxf(m, __shfl_xor(m, 16)); m = fmaxf(m, __shfl_xor(m, 32));
    float l = 0.f;
#pragma unroll
    for (int kt = 0; kt < 16; ++kt)
#pragma unroll
        for (int r = 0; r < 4; ++r) { const float e = __builtin_amdgcn_exp2f(sc[kt][r] - m); sc[kt][r] = e; l += e; }
    l += __shfl_xor(l, 16); l += __shfl_xor(l, 32);
    const float inv = 1.f / l;
#pragma unroll 1
    for (int g = 0; g < 2; ++g) {
        if (g == 1) {
#pragma unroll
            for (int i = 0; i < 8; ++i) { const int s = sl[i * 8 + (lane >> 3)]; vv[i] = *(const v4u*)(ATT + (rowb + s) * LD_ATT + 640 + 64 + (lane & 7) * 8); } }
#pragma unroll
        for (int i = 8; i < 16; ++i) { const int s = sl[i * 8 + (lane >> 3)]; vv[i] = *(const v4u*)(ATT + (rowb + s) * LD_ATT + 640 + g * 64 + (lane & 7) * 8); }
        pg8::f32x4 o[4];
#pragma unroll
        for (int dt = 0; dt < 4; ++dt) o[dt] = (pg8::f32x4){0.f, 0.f, 0.f, 0.f};
#pragma unroll
        for (int ch = 0; ch < 4; ++ch) {
            LDS_WAIT(); __builtin_amdgcn_wave_barrier();
#pragma unroll
            for (int i = 0; i < 8; ++i) *(v4u*)(Vl + (i * 8 + (lane >> 3)) * 80 + (lane & 7) * 8) = vv[(ch & 1) * 8 + i];
            if (ch < 2) {
#pragma unroll
                for (int i = 0; i < 8; ++i) { const int s = sl[((ch + 2) * 8 + i) * 8 + (lane >> 3)]; vv[(ch & 1) * 8 + i] = *(const v4u*)(ATT + (rowb + s) * LD_ATT + 640 + g * 64 + (lane & 7) * 8); } }
            LDS_WAIT(); __builtin_amdgcn_wave_barrier();
#pragma unroll
            for (int k2 = 0; k2 < 2; ++k2) { const int kt0 = ch * 4 + 2 * k2;
                v4u pw; pw.x = pk2(sc[kt0][0], sc[kt0][1]); pw.y = pk2(sc[kt0][2], sc[kt0][3]); pw.z = pk2(sc[kt0 + 1][0], sc[kt0 + 1][1]); pw.w = pk2(sc[kt0 + 1][2], sc[kt0 + 1][3]);
                const bf16x8 pb = __builtin_bit_cast(bf16x8, pw);
#pragma unroll
                for (int dt = 0; dt < 4; ++dt) { const bf16* vp = Vl + ((2 * k2) * 16 + fq * 4 + (fr >> 2)) * 80 + dt * 16 + (fr & 3) * 4;
                    const v4i16_t lo = vtr16(vp), hi = vtr16(vp + 16 * 80);
                    const bf16x8 af = {lo[0], lo[1], lo[2], lo[3], hi[0], hi[1], hi[2], hi[3]};
                    o[dt] = __builtin_amdgcn_mfma_f32_16x16x32_bf16(af, pb, o[dt], 0, 0, 0); } }
        }
        if (fr < 8 && (fr >> 2) == g) {
#pragma unroll
            for (int dt = 0; dt < 4; ++dt) { const float i8 = inv * 8.f;
                *(unsigned*)((unsigned char*)YB + (rowb + t) * 1024 + 512 + fr * 64 + dt * 16 + fq * 4) = pk4_fp8(o[dt][0] * i8, o[dt][1] * i8, o[dt][2] * i8, o[dt][3] * i8); } }
    }
    LDS_WAIT(); __builtin_amdgcn_wave_barrier();
}

#define INS16(L, x) do { _Pragma("unroll") for (int _i = 15; _i >= 1; --_i) L[_i] = __builtin_amdgcn_fmed3f(L[_i - 1], L[_i], (x)); L[0] = fmaxf(L[0], (x)); } while (0)
__device__ __forceinline__ float f_andor(float v, unsigned keepmask, unsigned orv) { return __builtin_bit_cast(float, (__builtin_bit_cast(unsigned, v) & keepmask) | orv); }
__device__ __forceinline__ void peer_route_item(const Params& p, unsigned char* ldsw, int tg, int h, int lane, int* EIDX, float* GATES) {
    unsigned char* ws = p.ws;
    const bf16* Q = (const bf16*)(ws + WS_Q);
    const bf16* SK = (const bf16*)(ws + WS_SK);
    float* sc = (float*)ldsw;
    const int fr = lane & 15, fq = lane >> 4;
#pragma unroll 1
    for (int pp = 0; pp < 2; ++pp) {
        bf16x8 Af[4], Bf[32];
        { const bf16* rp = Q + (size_t)(tg * 16 + fr) * 2048 + h * 256 + pp * 128 + fq * 8;
#pragma unroll
          for (int ks = 0; ks < 4; ++ks) Af[ks] = *(const bf16x8*)(rp + ks * 32); }
#pragma unroll
        for (int kt = 0; kt < 8; ++kt) { const bf16* kp = SK + (size_t)((h * 2 + pp) * 128 + kt * 16 + fr) * 128 + fq * 8;
#pragma unroll
            for (int ks = 0; ks < 4; ++ks) Bf[kt * 4 + ks] = *(const bf16x8*)(kp + ks * 32); }
        __builtin_amdgcn_sched_barrier(0);
#pragma unroll
        for (int kt = 0; kt < 8; ++kt) {
            pg8::f32x4 a = {0.f, 0.f, 0.f, 0.f};
#pragma unroll
            for (int ks = 0; ks < 4; ++ks) a = __builtin_amdgcn_mfma_f32_16x16x32_bf16(Af[ks], Bf[kt * 4 + ks], a, 0, 0, 0);
#pragma unroll
            for (int r = 0; r < 4; ++r) sc[(pp * 16 + fq * 4 + r) * 132 + kt * 16 + fr] = f_andor(a[r], ~127u, (unsigned)(kt * 16 + fr));
        }
    }
    LDS_WAIT(); __builtin_amdgcn_wave_barrier();
    float L[16];
#pragma unroll
    for (int i = 0; i < 16; ++i) L[i] = -INFINITY;
    { const float* sp = sc + (lane & 31) * 132 + (lane >> 5) * 64;
#pragma unroll 4
      for (int i = 0; i < 16; ++i) { const f32x4 x = *(const f32x4*)(sp + 4 * i); INS16(L, x[0]); INS16(L, x[1]); INS16(L, x[2]); INS16(L, x[3]); } }
    { float O[16];
#pragma unroll
      for (int i = 0; i < 16; ++i) O[i] = __shfl_xor(L[i], 32);
#pragma unroll
      for (int i = 0; i < 16; ++i) INS16(L, O[i]); }
    LDS_WAIT(); __builtin_amdgcn_wave_barrier();
    float* lst = sc;
    if (lane < 32) {
#pragma unroll
        for (int i = 0; i < 4; ++i) *(f32x4*)(lst + lane * 16 + 4 * i) = (f32x4){L[4 * i], L[4 * i + 1], L[4 * i + 2], L[4 * i + 3]}; }
    LDS_WAIT(); __builtin_amdgcn_wave_barrier();
    const int tok = lane & 15;
    float s1[16], s2[16];
#pragma unroll
    for (int i = 0; i < 4; ++i) { const f32x4 a = *(const f32x4*)(lst + tok * 16 + 4 * i), b = *(const f32x4*)(lst + (16 + tok) * 16 + 4 * i);
#pragma unroll
        for (int c = 0; c < 4; ++c) { s1[4 * i + c] = f_andor(a[c], ~127u, 0u); s2[4 * i + c] = f_andor(b[c], ~127u, 0u); } }
    float M[16];
#pragma unroll
    for (int i = 0; i < 16; ++i) M[i] = -INFINITY;
#pragma unroll
    for (int a = 0; a < 16; ++a)
#pragma unroll
        for (int b = 0; b < 16; ++b)
            if ((a + 1) * (b + 1) <= 16) { const float key = f_andor(s1[a] + s2[b], ~255u, (unsigned)(a * 16 + b)); INS16(M, key); }
    const float mx = f_andor(M[0], ~255u, 0u);
    float e[16], sum = 0.f; int ei[16];
    const unsigned* lb = (const unsigned*)lst;
#pragma unroll
    for (int i = 0; i < 16; ++i) { const unsigned bits = __builtin_bit_cast(unsigned, M[i]); const int flat = bits & 255u;
        e[i] = __expf(f_andor(M[i], ~255u, 0u) - mx); sum += e[i];
        ei[i] = (int)(lb[tok * 16 + (flat >> 4)] & 127u) * 128 + (int)(lb[(16 + tok) * 16 + (flat & 15)] & 127u); }
    const float inv = 1.f / sum;
    if (lane < 16) {
        const size_t ob = ((size_t)tok * 8 + h) * 16;
#pragma unroll
        for (int i = 0; i < 4; ++i) { *(v4u*)(EIDX + ob + 4 * i) = (v4u){(unsigned)ei[4 * i], (unsigned)ei[4 * i + 1], (unsigned)ei[4 * i + 2], (unsigned)ei[4 * i + 3]};
            *(f32x4*)(GATES + ob + 4 * i) = (f32x4){e[4 * i] * inv, e[4 * i + 1] * inv, e[4 * i + 2] * inv, e[4 * i + 3] * inv}; }
    }
    LDS_WAIT(); __builtin_amdgcn_wave_barrier();
}

__device__ __forceinline__ float gelu_erf(float x) { return 0.5f * x * (1.f + erff(x * 0.70710678118654752f)); }
typedef int v8i_t __attribute__((ext_vector_type(8)));
template <int OPSEL> __device__ __forceinline__ pg8::f32x4 mx_dot(v8i_t a, int sa, v8i_t b, int sb, pg8::f32x4 c) {
    return __builtin_amdgcn_mfma_scale_f32_16x16x128_f8f6f4(a, b, c, 4  , 4  , OPSEL, sa, OPSEL, sb);
}
__device__ __forceinline__ void peer_token(const Params& p, unsigned char* ldsw, const _Float16* usL, const _Float16* vsL, unsigned char* tile, int tok, int lane, const v2u nxt_e, const v2u nxt_g, int buf) {
    unsigned char* ws = p.ws;
    const unsigned char* V8 = ws + WS_V;
    const float* MOD = (const float*)(ws + WS_MOD);
    const int fr = lane & 15, fq = lane >> 4;
    typedef v8i_t v8i;
    const int* EIDX = (const int*)(ldsw + buf * 1024); const float* GATES = (const float*)(ldsw + buf * 1024 + 512);
    v4u A4[H4_NT][8]; v2u As[H4_NT];
#pragma unroll
    for (int t = 0; t < H4_NT; ++t) { const unsigned char* hp = ws + WS_H4D + ((size_t)tok * H4_NT + t) * 512 + fq * 16;
        As[t] = *(const v2u*)(ws + WS_H4S + ((size_t)tok * H4_NT + t) * 32 + fq * 8);
#pragma unroll
        for (int kk = 0; kk < 8; ++kk) A4[t][kk] = *(const v4u*)(hp + kk * 64); }
    int* pe = (int*)(ldsw + 2048); float* pa = (float*)(ldsw + 2048 + 512);
    const unsigned char* U4 = ws + WS_U;
    const int gr = lane >> 3, gs = lane & 7;
    const int rdbase = (fr >> 3) * 1024 + (fr & 7) * 128, slotA = (fq ^ (fr & 7) ^ (fr >> 3)) & 7;
    v4u G[8];
#define U_LOADS(CT) do { const int e0_ = EIDX[(CT) * 16 + gr], e1_ = EIDX[(CT) * 16 + 8 + gr]; \
        const unsigned char* p0_ = U4 + (size_t)e0_ * 512 + ((gs ^ gr) & 7) * 16; const unsigned char* p1_ = U4 + (size_t)e1_ * 512 + ((gs ^ gr ^ 1) & 7) * 16; \
        _Pragma("unroll") for (int kk = 0; kk < 8; ++kk) G[kk] = *(const v4u*)(((kk & 1) ? p1_ : p0_) + (kk >> 1) * 128); } while (0)
    U_LOADS(0);
#pragma unroll 1
    for (int ct = 0; ct < 8; ++ct) {
        const int eic = EIDX[ct * 16 + fr]; const float gt = GATES[ct * 16 + fr];
#pragma unroll
        for (int kk = 0; kk < 8; ++kk) *(v4u*)(tile + kk * 1024 + lane * 16) = G[kk];
        __builtin_amdgcn_sched_barrier(0);
        U_LOADS((ct + 1) & 7);
        __builtin_amdgcn_sched_barrier(0);
        LDS_WAIT(); __builtin_amdgcn_wave_barrier();
        v4u Bt[8];
#pragma unroll
        for (int j = 0; j < 8; ++j) Bt[j] = *(const v4u*)(tile + (j >> 1) * 2048 + rdbase + (((j & 1) ? (slotA ^ 4) : slotA) * 16));
        LDS_WAIT(); __builtin_amdgcn_wave_barrier();
        pg8::f32x4 ah = {0.f, 0.f, 0.f, 0.f};
#pragma unroll
        for (int kk = 0; kk < 8; ++kk) { const v4u bu = Bt[kk];
            const v8i bb = {(int)bu.x, (int)bu.y, (int)bu.z, (int)bu.w, 0, 0, 0, 0};
            const int sb = 0x7f7f7f7f;
#pragma unroll
            for (int t = 0; t < H4_NT; ++t) { const v8i aa = {(int)A4[t][kk].x, (int)A4[t][kk].y, (int)A4[t][kk].z, (int)A4[t][kk].w, 0, 0, 0, 0}; const int sa = (int)((kk < 4) ? As[t].x : As[t].y);
                if ((kk & 3) == 0) ah = mx_dot<0>(aa, sa, bb, sb, ah); else if ((kk & 3) == 1) ah = mx_dot<1>(aa, sa, bb, sb, ah); else if ((kk & 3) == 2) ah = mx_dot<2>(aa, sa, bb, sb, ah); else ah = mx_dot<3>(aa, sa, bb, sb, ah); } }
        const float dot = ah[0] * (float)usL[eic];
        if (fq == 0) { pe[ct * 16 + fr] = eic; pa[ct * 16 + fr] = gelu_erf(dot) * gt * (float)vsL[eic]; }
    }
    asm volatile("" :: "v"(G[0]), "v"(G[1]), "v"(G[2]), "v"(G[3]), "v"(G[4]), "v"(G[5]), "v"(G[6]), "v"(G[7]));
#undef U_LOADS
    __builtin_amdgcn_sched_barrier(0);
    { int* ne = (int*)(ldsw + (buf ^ 1) * 1024); float* ng = (float*)(ldsw + (buf ^ 1) * 1024 + 512);
      *(v2u*)(ne + 2 * lane) = nxt_e; *(v2u*)(ng + 2 * lane) = nxt_g; }
    const int hl = lane >> 5, bl = lane & 31;
    float acc[32];
#pragma unroll
    for (int i = 0; i < 32; ++i) acc[i] = 0.f;
    LDS_WAIT(); __builtin_amdgcn_wave_barrier();
#pragma unroll 1
    for (int ct = 0; ct < 16; ++ct)
#pragma unroll
        for (int jp = 0; jp < 4; ++jp) {
            const int idx = pe[ct * 8 + 2 * jp + hl]; const float as = pa[ct * 8 + 2 * jp + hl];
            const v4u vv = *(const v4u*)(V8 + (size_t)idx * 512 + bl * 16);
#pragma unroll
            for (int w4 = 0; w4 < 4; ++w4) { const unsigned wd = vv[w4];
                const f32x2 d0 = __builtin_amdgcn_cvt_scalef32_pk_f32_fp4(wd, 1.0f, 0), d1 = __builtin_amdgcn_cvt_scalef32_pk_f32_fp4(wd, 1.0f, 1), d2 = __builtin_amdgcn_cvt_scalef32_pk_f32_fp4(wd, 1.0f, 2), d3 = __builtin_amdgcn_cvt_scalef32_pk_f32_fp4(wd, 1.0f, 3);
                acc[8 * w4] += as * d0[0]; acc[8 * w4 + 1] += as * d0[1]; acc[8 * w4 + 2] += as * d1[0]; acc[8 * w4 + 3] += as * d1[1];
                acc[8 * w4 + 4] += as * d2[0]; acc[8 * w4 + 5] += as * d2[1]; acc[8 * w4 + 6] += as * d3[0]; acc[8 * w4 + 7] += as * d3[1]; }
        }
    LDS_WAIT(); __builtin_amdgcn_wave_barrier();
    float accs[16];
#pragma unroll
    for (int i = 0; i < 16; ++i) { const float lo = acc[i] + __shfl_xor(acc[i], 32), hi2 = acc[16 + i] + __shfl_xor(acc[16 + i], 32); accs[i] = hl ? hi2 : lo; }
    const int b = tok / SEQ;
    const int col0 = bl * 32 + hl * 16;
    const float* g2 = MOD + (size_t)b * 6144 + 5 * 1024 + col0;
    float* orow = p.out + (size_t)tok * DM + col0;
#pragma unroll
    for (int q4 = 0; q4 < 4; ++q4) { const f32x4 xv = *(const f32x4*)(orow + 4 * q4), gv = *(const f32x4*)(g2 + 4 * q4);
        f32x4 o;
#pragma unroll
        for (int i = 0; i < 4; ++i) o[i] = xv[i] + gv[i] * accs[4 * q4 + i];
        *(f32x4*)(orow + 4 * q4) = o; }
}

#define XB_TMO      128
#define XB_XCNT(j)  (256  + 64 * (j))
#define XB_XSUB(j)  (1280 + 64 * (j))
#define XB_XGEN(j)  (2304 + 64 * (j))
#define XB_TOP      3328
#define XB_TOPGEN   3392
#define XCD_BAR_WORDS 3456
#define XB_SPIN_CAP (1u << 18)

__device__ __forceinline__ unsigned xb_ld(unsigned* p)              { return __hip_atomic_load(p, __ATOMIC_RELAXED, __HIP_MEMORY_SCOPE_AGENT); }
__device__ __forceinline__ unsigned xb_add(unsigned* p, unsigned v) { return __hip_atomic_fetch_add(p, v, __ATOMIC_RELAXED, __HIP_MEMORY_SCOPE_AGENT); }
__device__ __forceinline__ unsigned xb_xcc_id() { return (unsigned)__builtin_amdgcn_s_getreg((3 << 11) | 20) & 0xFu; }
#define XB_SPIN(cond, bar) do { unsigned _sp = 0; while (cond) { __builtin_amdgcn_s_sleep(1); \
    if ((++_sp & 255u) == 0u) { if (xb_ld(&(bar)[XB_TMO])) break; if (_sp > XB_SPIN_CAP) { atomicAdd(&(bar)[XB_TMO], 1u); break; } } } } while (0)

struct XcdBarrier {
    unsigned* bar; unsigned x;
    volatile LAS unsigned* st;
};

__device__ __forceinline__ XcdBarrier xcd_barrier_post(unsigned* bar, volatile LAS unsigned* st) {
    XcdBarrier b; b.bar = bar; b.x = xb_xcc_id(); b.st = st;
    if (threadIdx.x == 0) (void)xb_add(&bar[XB_XCNT(b.x)], 1u);
    return b;
}
__device__ __forceinline__ void xcd_barrier_complete(unsigned* bar, unsigned x, unsigned& nloc, unsigned& nx) {
    const unsigned G = gridDim.x * gridDim.y * gridDim.z;
    unsigned sum, cnt, mine, sp = 0u;
    for (;;) {
        sum = 0u; cnt = 0u; mine = 0u;
#pragma unroll
        for (unsigned j = 0; j < 16; ++j) { const unsigned c = xb_ld(&bar[XB_XCNT(j)]); sum += c; cnt += (c > 0u) ? 1u : 0u; mine = (j == x) ? c : mine; }
        if (sum == G) break;
        __builtin_amdgcn_s_sleep(1);
        if ((++sp & 255u) == 0u) { if (xb_ld(&bar[XB_TMO])) break; if (sp > XB_SPIN_CAP) { atomicAdd(&bar[XB_TMO], 1u); break; } }
    }
    nloc = mine > 0u ? mine : 1u; nx = cnt > 0u ? cnt : 1u;
}

__device__ __forceinline__ void xcd_barrier(const XcdBarrier& b) {
    asm volatile("s_waitcnt vmcnt(0)" ::: "memory");
    __syncthreads();
    if (threadIdx.x == 0) {
        unsigned* bar = b.bar;
        __builtin_amdgcn_s_waitcnt(0);
        unsigned nloc = b.st[0], nx = b.st[1];
        if (nloc == 0u) { xcd_barrier_complete(bar, b.x, nloc, nx); b.st[0] = nloc; b.st[1] = nx; }
        const unsigned old = xb_add(&bar[XB_XSUB(b.x)], 1u);
        const unsigned gen = old / nloc;
        if (old + 1u == (gen + 1u) * nloc) {
            __builtin_amdgcn_fence(__ATOMIC_RELEASE, "agent");
            asm volatile("s_waitcnt vmcnt(0)" ::: "memory");
            const unsigned og = xb_add(&bar[XB_TOP], 1u);
            const unsigned tg = og / nx;
            if (og + 1u == (tg + 1u) * nx) xb_add(&bar[XB_TOPGEN], 1u);
            else XB_SPIN(xb_ld(&bar[XB_TOPGEN]) == tg, bar);
            __builtin_amdgcn_fence(__ATOMIC_ACQUIRE, "agent");
            xb_add(&bar[XB_XGEN(b.x)], 1u);
            asm volatile("s_waitcnt vmcnt(0)" ::: "memory");
        } else {
            XB_SPIN(xb_ld(&bar[XB_XGEN(b.x)]) == gen, bar);
            __builtin_amdgcn_fence(__ATOMIC_ACQUIRE, "agent");
            asm volatile("s_waitcnt vmcnt(0)" ::: "memory");
        }
    }
    __syncthreads();
}

constexpr int NPHASE = 11;
__global__ void __launch_bounds__(NTHREADS, 2) mega(Params p) {
    extern __shared__ __attribute__((aligned(16))) unsigned char lds[];
    cg::grid_group grid = cg::this_grid();
    const int lo = p.ph_lo, hi = p.ph_hi;
    const int tid = threadIdx.x, wave = tid >> 6, lane = tid & 63, G = gridDim.x;
    unsigned char* ws = p.ws;
#ifndef ONLYPH
#define IN(k) (lo <= (k) && (k) < hi)
#else
#define IN(k) ((k) == ONLYPH && lo <= (k) && (k) < hi)
#endif
    volatile LAS unsigned* xb_st = (volatile LAS unsigned*)((LAS unsigned char*)lds + (LDS_BYTES - 16));
    if (tid < 4) xb_st[tid] = 0u;
    __syncthreads();
    XcdBarrier xbar; xbar.bar = (unsigned*)(ws + WS_CTL); xbar.x = 0; xbar.st = xb_st;
    if (hi - lo > 1) xbar = xcd_barrier_post((unsigned*)(ws + WS_CTL), xb_st);
    if (lo < -1) grid.sync();
#define SEAM(k) do { if (IN((k) + 1)) xcd_barrier(xbar); } while (0)
#ifndef REPMASK
#define REPMASK 0
#endif
#define NREP(k) (((REPMASK >> (k)) & 1) ? 2 : 1)
    if (IN(0)) { for (int rep = 0; rep < NREP(0); ++rep) phase0(p, lds); SEAM(0); }
    if (IN(1)) { for (int rep = 0; rep < NREP(1); ++rep) normmod_phase<true>(p, lds, p.x, (bf16*)(ws + WS_H), p.norm1_g, 0, 1024); SEAM(1); }
    if (IN(2)) {
        { pg8::Gemm g{(const bf16*)(ws + WS_H8), (const bf16*)(ws + WS_WIN8), T, 3584, 512, 512, 512}; pg8::StaticOrder S; S.init(T, 3584, G, (int)blockIdx.x);
          EpiProj E{(bf16*)(ws + WS_HG), (bf16*)(ws + WS_ATT), (bf16*)(ws + WS_IDX), (bf16*)(ws + WS_GATE), 1};
          pg8::gemm_phase<EpiProj, pg8::StaticOrder, true, true, 122>((PG8_LAS unsigned char*)lds, g, S, E); }
        { pg8::Gemm g{(const bf16*)(ws + WS_H), (const bf16*)(ws + WS_WIN), T, 2048, 1024, 1024, 1024}; pg8::StaticOrder S; S.init(T, 2048, G, (int)blockIdx.x);
          EpiProj E{(bf16*)(ws + WS_HG), (bf16*)(ws + WS_ATT), (bf16*)(ws + WS_IDX), (bf16*)(ws + WS_GATE), 0};
          pg8::gemm_phase<EpiProj, pg8::StaticOrder, true, true>((PG8_LAS unsigned char*)lds, g, S, E); }
        SEAM(2);
    }
    if (IN(3)) {
        for (int tok = (int)blockIdx.x * NWAVES + wave; tok < T; tok += G * NWAVES) qknorm_token(p, tok, lane);
        SEAM(3);
    }
    if (IN(4)) {
        if ((int)blockIdx.x < 32) hgrn_item(p, lds, (int)blockIdx.x);
        {
            unsigned* qctr = (unsigned*)(ws + WS_CTL + 32768);
            volatile LAS unsigned* qslot = (volatile LAS unsigned*)((LAS unsigned char*)lds + (LDS_BYTES - 32));
            int qsel = (int)(blockIdx.x & 7u), tried = 0;
            for (;;) {
                if (tid == 0) { unsigned c;
                    for (;;) { c = __hip_atomic_fetch_add(qctr + qsel * 64, 1u, __ATOMIC_RELAXED, __HIP_MEMORY_SCOPE_AGENT); if (c < (unsigned)(SEQ / 16) || tried >= 7) break; qsel = (qsel + 1) & 7; ++tried; }
                    *qslot = (c < (unsigned)(SEQ / 16)) ? (((unsigned)qsel << 16) | c) : 0xffffffffu; }
                __syncthreads();
                const unsigned c = *qslot;
                __syncthreads();
                if (c == 0xffffffffu) break;
                const int b = (int)(c >> 16), qblk = (SEQ / 16 - 1) - (int)(c & 0xffffu), it = b * (SEQ / 16) + qblk, q0 = qblk * 16;
                dsa1_item(p, lds, it);
#pragma unroll 1
                for (int k2 = 0; k2 < 2; ++k2) dsa2_query(p, lds + wave * 16384, (const unsigned short*)(lds + 131072 + (wave + 8 * k2) * 1024), b, q0 + wave + 8 * k2, lane);
                __syncthreads();
            }
        }
        SEAM(4);
    }
    if (IN(5)) {
        pg8::Gemm g{(const bf16*)(ws + WS_H), (const bf16*)(ws + WS_WAB8), T, 1024, 256, 512, 512}; pg8::StaticOrderT<true> S; S.init(T, 1024, G, (int)blockIdx.x, 256);
        EpiMerged E{(const bf16*)(ws + WS_GATE), (bf16*)(ws + WS_MERGED)};
        for (int rep = 0; rep < NREP(5); ++rep) pg8::gemm_phase<EpiMerged, pg8::StaticOrderT<true>, true, true, 122>((PG8_LAS unsigned char*)lds, g, S, E);
        SEAM(5);
    }
    if (IN(6)) {
        pg8::Gemm g{(const bf16*)(ws + WS_MERGED), (const bf16*)(ws + WS_WOUT8), T, 1024, 512, 512, 512}; pg8::StaticOrder S; S.init(T, 1024, G, (int)blockIdx.x);
        EpiResid E{p.x, (const float*)(ws + WS_MOD) + 2048, p.out};
        for (int rep = 0; rep < NREP(6); ++rep) pg8::gemm_phase<EpiResid, pg8::StaticOrder, true, true, 120>((PG8_LAS unsigned char*)lds, g, S, E);
        SEAM(6);
    }
    if (IN(7)) { for (int rep = 0; rep < NREP(7); ++rep) normmod_phase<false>(p, lds, p.out, (bf16*)(ws + WS_H), p.norm2_g, 3 * 1024, 4 * 1024); SEAM(7); }
    if (IN(8)) {
        pg8::Gemm g{(const bf16*)(ws + WS_H), (const bf16*)(ws + WS_WQ), T, 2048, 1024, 1024, 1024}; pg8::StaticOrder S; S.init(T, 2048, G, (int)blockIdx.x);
        EpiStore E{(bf16*)(ws + WS_Q), 2048};
        for (int rep = 0; rep < NREP(8); ++rep) pg8::gemm_phase<EpiStore, pg8::StaticOrder, true, true>((PG8_LAS unsigned char*)lds, g, S, E);
        SEAM(8);
    }
    if (IN(9)) {
        int* eG = (int*)(ws + WS_EIDX); float* gG = (float*)(ws + WS_PGATE);
        for (int tg = blockIdx.x; tg < T / 16; tg += G) peer_route_item(p, lds + wave * 16896, tg, wave, lane, eG + (size_t)tg * 2048, gG + (size_t)tg * 2048);
        asm volatile("s_waitcnt vmcnt(0)" ::: "memory");
        __syncthreads();
        _Float16* usL = (_Float16*)lds; _Float16* vsL = (_Float16*)(lds + 32768);
        for (int i = tid; i < NEXP / 8; i += NTHREADS) { ((v4u*)usL)[i] = ((const v4u*)(ws + WS_US))[i]; ((v4u*)vsL)[i] = ((const v4u*)(ws + WS_VS))[i]; }
        unsigned char* ldsw = lds + 65536 + wave * 3072;
        int ntok = 0;
        for (int tg = blockIdx.x; tg < T / 16; tg += G) ntok += 2;
        auto tok_of = [&](int j) { return ((int)blockIdx.x + (j >> 1) * G) * 16 + wave + 8 * (j & 1); };
        auto ld_lists = [&](int tok, v2u& e, v2u& g) {
            const unsigned* ep = (const unsigned*)(eG + (size_t)tok * 128 + 2 * lane); const unsigned* gp = (const unsigned*)(gG + (size_t)tok * 128 + 2 * lane);
            e.x = __hip_atomic_load(ep, __ATOMIC_RELAXED, __HIP_MEMORY_SCOPE_AGENT); e.y = __hip_atomic_load(ep + 1, __ATOMIC_RELAXED, __HIP_MEMORY_SCOPE_AGENT);
            g.x = __hip_atomic_load(gp, __ATOMIC_RELAXED, __HIP_MEMORY_SCOPE_AGENT); g.y = __hip_atomic_load(gp + 1, __ATOMIC_RELAXED, __HIP_MEMORY_SCOPE_AGENT); };
        if (ntok > 0) { v2u e0, g0; ld_lists(tok_of(0), e0, g0); *(v2u*)((int*)ldsw + 2 * lane) = e0; *(v2u*)((float*)(ldsw + 512) + 2 * lane) = g0; }
        __syncthreads();
#pragma unroll 1
        for (int j = 0; j < ntok; ++j) {
            v2u ne = {0u, 0u}, ng = {0u, 0u};
            if (j + 1 < ntok) ld_lists(tok_of(j + 1), ne, ng);
            peer_token(p, ldsw, usL, vsL, lds + 90112 + wave * 8192, tok_of(j), lane, ne, ng, j & 1);
            LDS_WAIT(); __builtin_amdgcn_wave_barrier();
        }
    }
#undef IN
#undef SEAM
}

#ifndef ONE_LAUNCH
#define ONE_LAUNCH 1
#endif
extern "C" void kernel_launch(void* const* d_in, const int* in_sizes, int n_in, void* d_out, int out_size, void* d_ws, size_t ws_size, hipStream_t stream) {
    static int grid = 0;
    if (grid == 0) {
        if (n_in != 18 || out_size != T * DM || ws_size < WS_END) { fprintf(stderr, "kernel_launch: unexpected shapes (n_in %d, out %d, ws %zu)\n", n_in, out_size, ws_size); grid = -1; return; }
        int dev = 0, cus = 0, per_cu = 0;
        if (hipGetDevice(&dev) != hipSuccess || hipDeviceGetAttribute(&cus, hipDeviceAttributeMultiprocessorCount, dev) != hipSuccess) { grid = -1; return; }
        if (hipFuncSetAttribute((const void*)mega, hipFuncAttributeMaxDynamicSharedMemorySize, LDS_BYTES) != hipSuccess) { fprintf(stderr, "kernel_launch: hipFuncSetAttribute failed\n"); grid = -1; return; }
        if (hipOccupancyMaxActiveBlocksPerMultiprocessor(&per_cu, (const void*)mega, NTHREADS, LDS_BYTES) != hipSuccess || per_cu < 1) { fprintf(stderr, "kernel_launch: occupancy query says %d\n", per_cu); grid = -1; return; }
        (void)hipGetLastError();
        grid = cus;
        if (grid < 64) { grid = -1; return; }
    }
    if (grid < 0) return;
    Params p{};
    const float** pp = (const float**)&p;
    for (int i = 0; i < 18; ++i) pp[i] = (const float*)d_in[i];
    p.out = (float*)d_out; p.ws = (unsigned char*)d_ws;
#if ONE_LAUNCH
    if (hipMemsetAsync((char*)d_ws + WS_CTL, 0, 65536, stream) != hipSuccess) { fprintf(stderr, "kernel_launch: memset failed\n"); return; }
    p.ph_lo = 0; p.ph_hi = NPHASE;
    void* args[] = {&p};
    hipError_t e = hipLaunchCooperativeKernel((const void*)mega, dim3(grid), dim3(NTHREADS), args, LDS_BYTES, stream);
    if (e != hipSuccess) fprintf(stderr, "cooperative launch failed: %s (grid %d)\n", hipGetErrorString(e), grid);
#else
    for (int k = 0; k < NPHASE; ++k) { p.ph_lo = k; p.ph_hi = k + 1; hipLaunchKernelGGL(mega, dim3(grid), dim3(NTHREADS), LDS_BYTES, stream, p); }
#endif
}
```

```cpp
#include <hip/hip_runtime.h>
#include <hip/hip_cooperative_groups.h>
#include <cstdio>
#include <cstdint>
namespace cg = cooperative_groups;

namespace pg8 {
#define PG8_LAS __attribute__((address_space(3)))
typedef unsigned short bf16_t;
typedef short bf16x8 __attribute__((ext_vector_type(8)));
typedef float f32x4 __attribute__((ext_vector_type(4)));
typedef unsigned u32x4 __attribute__((ext_vector_type(4)));
constexpr int BM = 256, BK = 64, HALF = 128, HTB = HALF * BK * 2  , STAGE_BYTES = 8 * HTB, NXCD = 8, WGM = 8;

__host__ __device__ __forceinline__ int lds_byte(int r, int c) { const int st = (r >> 4) * 2 + (c >> 5), rr = r & 15, cc = c & 31, ob = rr * 64 + cc * 2; return st * 1024 + (ob ^ (((ob >> 9) & 1) << 5)); }
__host__ __device__ __forceinline__ void stage_rc(int b, int& R, int& C) { const int st = b / 1024, sb = b % 1024, swz = sb ^ (((sb >> 9) & 1) << 5); R = (st >> 1) * 16 + swz / 64; C = (st & 1) * 32 + (swz % 64) / 2; }
__host__ __device__ __forceinline__ int perm32(int rho) { const int n = rho >> 4, i = rho & 15; return 8 * (i >> 2) + 4 * n + (i & 3); }

struct Unit { int pm, pn, ko, pass; };
struct Gemm { const bf16_t* A; const bf16_t* Bt; int M, N, K, lda, ldb; };
typedef float f32x16 __attribute__((ext_vector_type(16)));
typedef f32x16 AccW[2][2][2];
__device__ __forceinline__ f32x4 acc_get(const AccW& A, int ai, int bj, int m, int n) { const int s_ = ((m & 1) * 2 + n) * 4; const f32x16& w = A[ai][bj][m >> 1]; return (f32x4){w[s_], w[s_ + 1], w[s_ + 2], w[s_ + 3]}; }
__device__ __forceinline__ void acc_set(AccW& A, int ai, int bj, int m, int n, f32x4 v) { const int s_ = ((m & 1) * 2 + n) * 4; f32x16& w = A[ai][bj][m >> 1]; w[s_] = v[0]; w[s_ + 1] = v[1]; w[s_ + 2] = v[2]; w[s_ + 3] = v[3]; }

template <bool TWOPASS_ORDER = false>
struct StaticOrderT {
    int nM, nN, nwg, G, c, kpass;
    __host__ __device__ void init(int M, int N, int G_, int c_, int kpass_ = 512) { nM = M / BM; nN = N / BM; nwg = nM * nN; G = G_; c = c_; kpass = kpass_; }
    __host__ __device__ bool next(int i, Unit& u) const {
        const long L = (long)(TWOPASS_ORDER ? (i >> 1) : i) * G + c; if (L >= nwg) return false;
        u.pass = TWOPASS_ORDER ? (i & 1) : 0; u.ko = TWOPASS_ORDER ? (i & 1) * kpass : 0;
        int wgid = (int)L; { const int q = nwg / NXCD, r = nwg % NXCD, xcd = wgid % NXCD, off = wgid / NXCD; wgid = (xcd < r ? xcd * (q + 1) : r * (q + 1) + (xcd - r) * q) + off; }
        const int nig = WGM * nN, gid = wgid / nig, fm = gid * WGM, gsz = (nM - fm) < WGM ? (nM - fm) : WGM;
        u.pm = fm + ((wgid % nig) % gsz); u.pn = (wgid % nig) / gsz; return true;
    }
    __device__ __forceinline__ void a_ready(const Unit&) const {}
    __device__ __forceinline__ void done(const Unit&) const {}
};
typedef StaticOrderT<false> StaticOrder;

__device__ __forceinline__ unsigned cvt_pk_bf16(float lo, float hi) { unsigned r; asm volatile("v_cvt_pk_bf16_f32 %0, %1, %2" : "=v"(r) : "v"(lo), "v"(hi)); return r; }

template <class Epi, class Sched, bool ALIGN_EPI = false, bool SP2 = false, int F8SCALE = 0>
__device__ __forceinline__ void gemm_phase(PG8_LAS unsigned char* lds, const Gemm g, const Sched& S, const Epi& E) {
    const int tid = threadIdx.x, wid = __builtin_amdgcn_readfirstlane(tid >> 6), lane = tid & 63, wr = wid >> 2, wc = wid & 3, fr = lane & 15, fq = lane >> 4;
    const int K = g.K, nt = K / BK;
    unsigned voffA[2], voffB[2];
#pragma unroll
    for (int i = 0; i < 2; ++i) { int R, C; stage_rc(tid * 16 + i * 8192, R, C); const int Rb = Epi::PERM ? ((R & ~31) + perm32(R & 31)) : R;
        voffA[i] = (unsigned)(R * g.lda + C) * 2u; voffB[i] = (unsigned)(Rb * g.ldb + C) * 2u; }
    const size_t kstep = (size_t)(BK * 2);
    const size_t hstepA = (size_t)HALF * g.lda * 2, hstepB = (size_t)HALF * g.ldb * 2;
    const size_t tstepA = 2 * hstepA, tstepB = 2 * hstepB;
    const unsigned ldsw = (unsigned)wid * 1024u;
    const int aoff = lds_byte(wr * 64 + fr, fq * 8), boff = lds_byte(wc * 32 + fr, fq * 8);
#define PG8_SA(b, h) (((b) * 2 + (h)) * HTB)
#define PG8_SB(b, h) ((4 + (b) * 2 + (h)) * HTB)
#define PG8_STAGE(bufoff, gbase, voff) do { _Pragma("unroll") for (int _i = 0; _i < 2; ++_i) \
        __builtin_amdgcn_global_load_lds((const unsigned*)((const char*)(gbase) + (voff)[_i]), (PG8_LAS unsigned*)(lds + (bufoff) + ldsw + _i * 8192), 16, 0, 0); } while (0)
#define PG8_LDA(dst, b, h) do { _Pragma("unroll") for (int m = 0; m < 4; ++m) { if constexpr (F8SCALE != 0) { \
        PG8_F8(dst)[m].lo = *(const PG8_LAS v4i_f*)(lds + PG8_SA(b, h) + aoff + m * 2048); PG8_F8(dst)[m].hi = *(const PG8_LAS v4i_f*)(lds + PG8_SA(b, h) + aoff + m * 2048 + 1024); } \
        else { _Pragma("unroll") for (int k = 0; k < 2; ++k) dst[m][k] = *(const PG8_LAS bf16x8*)(lds + PG8_SA(b, h) + aoff + m * 2048 + k * 1024); } } } while (0)
#define PG8_LDB(dst, b, h) do { _Pragma("unroll") for (int n = 0; n < 2; ++n) { if constexpr (F8SCALE != 0) { \
        PG8_F8(dst)[n].lo = *(const PG8_LAS v4i_f*)(lds + PG8_SB(b, h) + boff + n * 2048); PG8_F8(dst)[n].hi = *(const PG8_LAS v4i_f*)(lds + PG8_SB(b, h) + boff + n * 2048 + 1024); } \
        else { _Pragma("unroll") for (int k = 0; k < 2; ++k) dst[n][k] = *(const PG8_LAS bf16x8*)(lds + PG8_SB(b, h) + boff + n * 2048 + k * 1024); } } } while (0)
#define PG8_MMA(ai, bj, At, Bt) do { __builtin_amdgcn_s_setprio(1); _Pragma("unroll") for (int m = 0; m < 4; ++m) _Pragma("unroll") for (int n = 0; n < 2; ++n) { \
        f32x4 _c = acc_get(accw, ai, bj, m, n); \
        if constexpr (F8SCALE != 0) { _c = __builtin_amdgcn_mfma_scale_f32_16x16x128_f8f6f4(PG8_F8(Bt)[n], PG8_F8(At)[m], _c, 0, 0, 0, 0x7f7f7f7f, 0, F8SCALE * 0x01010101); } \
        else { _Pragma("unroll") for (int k = 0; k < 2; ++k) _c = __builtin_amdgcn_mfma_f32_16x16x32_bf16(Bt[n][k], At[m][k], _c, 0, 0, 0); } \
        acc_set(accw, ai, bj, m, n, _c); } \
        __builtin_amdgcn_s_setprio(0); } while (0)
#define PG8_WAIT_V(n) asm volatile("s_waitcnt vmcnt(" #n ")" ::: "memory")
#define PG8_WAIT_L(n) asm volatile("s_waitcnt lgkmcnt(" #n ")" ::: "memory")
#define PG8_BAR __builtin_amdgcn_s_barrier()
#define PG8_SCHED __builtin_amdgcn_sched_barrier(0)
    Unit cur, nxt; int ui = 0;
    if (!S.next(0, cur)) return;
    typedef int v4i_f __attribute__((ext_vector_type(4))); typedef int v8i_f __attribute__((ext_vector_type(8))); typedef f32x16 f32x16_f;
    AccW accw;
#pragma unroll
    for (int a = 0; a < 2; ++a)
#pragma unroll
        for (int b = 0; b < 2; ++b)
#pragma unroll
            for (int mp = 0; mp < 2; ++mp)
#pragma unroll
                for (int i = 0; i < 16; ++i) accw[a][b][mp][i] = 0.f;
    bf16x8 At[4][2], B0[2][2], B1[2][2];
    v8i_f At8[4], B08[2], B18[2];
#define PG8_F8(x) x##8
    const char* cA = (const char*)g.A + (size_t)cur.pm * tstepA + (size_t)cur.ko * 2; const char* cB = (const char*)g.Bt + (size_t)cur.pn * tstepB + (size_t)cur.ko * 2;
    S.a_ready(cur);
    if constexpr (SP2) {
        PG8_STAGE(PG8_SB(0, 0), cB, voffB); PG8_STAGE(PG8_SB(0, 1), cB + hstepB, voffB); PG8_STAGE(PG8_SA(0, 0), cA, voffA); PG8_STAGE(PG8_SA(0, 1), cA + hstepA, voffA);
        if (wr == 1) PG8_BAR;
        PG8_WAIT_V(2); PG8_BAR;
        PG8_STAGE(PG8_SB(1, 0), cB + kstep, voffB); PG8_STAGE(PG8_SA(1, 0), cA + kstep, voffA); PG8_STAGE(PG8_SB(1, 1), cB + hstepB + kstep, voffB);
        PG8_WAIT_V(6); PG8_BAR;
    } else {
        PG8_STAGE(PG8_SB(0, 0), cB, voffB); PG8_STAGE(PG8_SA(0, 0), cA, voffA); PG8_STAGE(PG8_SB(0, 1), cB + hstepB, voffB); PG8_STAGE(PG8_SA(0, 1), cA + hstepA, voffA);
        if (wr == 1) PG8_BAR;
        PG8_WAIT_V(4); PG8_BAR;
        PG8_STAGE(PG8_SB(1, 0), cB + kstep, voffB); PG8_STAGE(PG8_SA(1, 0), cA + kstep, voffA); PG8_STAGE(PG8_SB(1, 1), cB + hstepB + kstep, voffB);
        PG8_WAIT_V(6); PG8_BAR;
    }
    for (;;) {
        const bool has_next = S.next(ui + 1, nxt);
        const char* nA = has_next ? (const char*)g.A + (size_t)nxt.pm * tstepA + (size_t)nxt.ko * 2 : cA; const char* nB = has_next ? (const char*)g.Bt + (size_t)nxt.pn * tstepB + (size_t)nxt.ko * 2 : cB;
        for (int t = 0; t < nt; t += 2) {
            const bool last = (t == nt - 2);
            const char* a1 = cA + (size_t)(t + 1) * kstep;
            const char* a2 = last ? nA : cA + (size_t)(t + 2) * kstep; const char* b2 = last ? nB : cB + (size_t)(t + 2) * kstep;
            const char* a3 = a2 + kstep; const char* b3 = b2 + kstep;
            if (last && has_next) S.a_ready(nxt);
            if constexpr (SP2) {
            PG8_LDB(B0, 0, 0); PG8_LDB(B1, 0, 1); PG8_SCHED; PG8_LDA(At, 0, 0); PG8_STAGE(PG8_SA(1, 1), a1 + hstepA, voffA);
            PG8_WAIT_V(8); PG8_WAIT_L(0); PG8_BAR; PG8_MMA(0, 0, At, B0); PG8_MMA(0, 1, At, B1); PG8_BAR; PG8_SCHED;
            PG8_LDA(At, 0, 1); PG8_STAGE(PG8_SB(0, 0), b2, voffB); PG8_STAGE(PG8_SB(0, 1), b2 + hstepB, voffB); PG8_STAGE(PG8_SA(0, 0), a2, voffA);
            PG8_WAIT_V(8); PG8_WAIT_L(0); PG8_BAR; PG8_MMA(1, 0, At, B0); PG8_MMA(1, 1, At, B1); PG8_BAR; PG8_SCHED;
            PG8_LDB(B0, 1, 0); PG8_LDB(B1, 1, 1); PG8_SCHED; PG8_LDA(At, 1, 0); PG8_STAGE(PG8_SA(0, 1), a2 + hstepA, voffA);
            PG8_WAIT_V(8); PG8_WAIT_L(0); PG8_BAR; PG8_MMA(0, 0, At, B0); PG8_MMA(0, 1, At, B1); PG8_BAR; PG8_SCHED;
            PG8_LDA(At, 1, 1); PG8_STAGE(PG8_SB(1, 0), b3, voffB); PG8_STAGE(PG8_SB(1, 1), b3 + hstepB, voffB); PG8_STAGE(PG8_SA(1, 0), a3, voffA);
            PG8_WAIT_V(8); PG8_WAIT_L(0); PG8_BAR; PG8_MMA(1, 0, At, B0); PG8_MMA(1, 1, At, B1); PG8_BAR; PG8_SCHED;
            } else {
            PG8_LDB(B0, 0, 0); PG8_SCHED; PG8_LDA(At, 0, 0); PG8_STAGE(PG8_SA(1, 1), a1 + hstepA, voffA);
            PG8_WAIT_L(8); PG8_BAR; PG8_WAIT_L(0); PG8_MMA(0, 0, At, B0); PG8_BAR; PG8_SCHED;
            PG8_LDB(B1, 0, 1); PG8_STAGE(PG8_SB(0, 0), b2, voffB);
            PG8_BAR; PG8_WAIT_L(0); PG8_MMA(0, 1, At, B1); PG8_BAR;
            PG8_LDA(At, 0, 1); PG8_STAGE(PG8_SA(0, 0), a2, voffA);
            PG8_BAR; PG8_WAIT_L(0); PG8_MMA(1, 0, At, B0); PG8_BAR; PG8_SCHED;
            PG8_STAGE(PG8_SB(0, 1), b2 + hstepB, voffB);
            PG8_WAIT_V(6); PG8_BAR; PG8_MMA(1, 1, At, B1); PG8_BAR;
            PG8_LDB(B0, 1, 0); PG8_SCHED; PG8_LDA(At, 1, 0); PG8_STAGE(PG8_SA(0, 1), a2 + hstepA, voffA);
            PG8_WAIT_L(8); PG8_BAR; PG8_WAIT_L(0); PG8_MMA(0, 0, At, B0); PG8_BAR; PG8_SCHED;
            PG8_LDB(B1, 1, 1); PG8_STAGE(PG8_SB(1, 0), b3, voffB);
            PG8_BAR; PG8_WAIT_L(0); PG8_MMA(0, 1, At, B1); PG8_BAR;
            PG8_LDA(At, 1, 1); PG8_STAGE(PG8_SA(1, 0), a3, voffA);
            PG8_BAR; PG8_WAIT_L(0); PG8_MMA(1, 0, At, B0); PG8_BAR; PG8_SCHED;
            PG8_STAGE(PG8_SB(1, 1), b3 + hstepB, voffB);
            PG8_WAIT_V(6); PG8_BAR; PG8_MMA(1, 1, At, B1); PG8_BAR;
            }
        }
        if constexpr (ALIGN_EPI) { if (wr == 0) PG8_BAR; }
        if constexpr (!Epi::AFTER_DRAIN) { E(accw, cur, wr, wc, fr, fq); S.done(cur); }
        const bool keep_acc = Epi::TWOPASS && (cur.pass == 0);
        if (!has_next) break;
        if (!keep_acc) {
#pragma unroll
            for (int a = 0; a < 2; ++a)
#pragma unroll
                for (int b = 0; b < 2; ++b)
#pragma unroll
                    for (int mp = 0; mp < 2; ++mp)
#pragma unroll
                        for (int i = 0; i < 16; ++i) accw[a][b][mp][i] = 0.f;
        }
        cur = nxt; cA = nA; cB = nB; ++ui;
        if constexpr (ALIGN_EPI) { if (wr == 1) PG8_BAR; }
    }
    PG8_WAIT_V(0);
    if constexpr (!ALIGN_EPI) { if (wr == 0) PG8_BAR; }
    PG8_BAR;

#undef PG8_SA
#undef PG8_SB
#undef PG8_STAGE
#undef PG8_LDA
#undef PG8_LDB
#undef PG8_MMA
#undef PG8_F8
#undef PG8_WAIT_V
#undef PG8_WAIT_L
#undef PG8_BAR
#undef PG8_SCHED
}
}


constexpr int NWAVES = 8, NTHREADS = 512;
constexpr int BATCH = 8, SEQ = 4096, T = BATCH * SEQ, DM = 1024;
constexpr int INW = 5448;
constexpr int NPROJ = 5632;
constexpr int LD_HG = 2048, LD_ATT = 768, LD_IDX = 640, LD_GATE = 2048;
constexpr int TOPK = 256;
constexpr int NEXP = 16384;
constexpr float RMS_EPS = 1e-6f;

constexpr size_t MiB = 1u << 20;
constexpr size_t WS_CTL = 0;
constexpr size_t WS_MOD = MiB / 4;
constexpr size_t WS_MODP = MiB / 2;
constexpr size_t WS_WIN = 2 * MiB;
constexpr size_t WS_WQ = 17 * MiB;
constexpr size_t WS_SK = 21 * MiB;
constexpr size_t WS_U = 22 * MiB;
constexpr size_t WS_US = 30 * MiB;
constexpr size_t WS_V = 38 * MiB;
constexpr size_t WS_VS = 46 * MiB;
constexpr size_t WS_K8 = 48 * MiB;
constexpr size_t WS_QHI = 52 * MiB;
constexpr size_t WS_QLO = 68 * MiB;
constexpr size_t WS_WAB8 = 31 * MiB;
constexpr size_t WS_WOUT8 = 32 * MiB;
constexpr size_t WS_WIN8 = 33 * MiB;
constexpr size_t WS_H8 = 48 * MiB;
constexpr size_t WS_H = 86 * MiB;
constexpr size_t WS_HG = 150 * MiB;
constexpr size_t WS_ATT = 278 * MiB;
constexpr size_t WS_IDX = 326 * MiB;
constexpr size_t WS_GATE = 366 * MiB;
constexpr size_t WS_SEL = 494 * MiB;
constexpr size_t WS_EIDX = 48 * MiB;
constexpr size_t WS_PGATE = 64 * MiB;
constexpr size_t WS_END = 510 * MiB;
constexpr size_t WS_HQC = 494 * MiB;
constexpr size_t WS_HOL = 118 * MiB;
constexpr size_t WS_HSB = 2 * MiB;
constexpr size_t WS_MERGED = WS_HG;
constexpr size_t WS_Q = 214 * MiB;
constexpr int H4_NT = 2;
constexpr size_t WS_H4D = 366 * MiB;
constexpr size_t WS_H4S = 416 * MiB;

constexpr int LDS_BYTES = 163840;

typedef unsigned short bf16;
typedef unsigned v4u __attribute__((ext_vector_type(4)));
typedef unsigned v2u __attribute__((ext_vector_type(2)));
typedef float f32x4 __attribute__((ext_vector_type(4)));
typedef float f32x2 __attribute__((ext_vector_type(2)));
typedef short bf16x8 __attribute__((ext_vector_type(8)));
#define LAS __attribute__((address_space(3)))

struct Params {
    const float *x, *c, *w_ada, *b_ada, *norm1_g, *norm2_g, *w_in, *hg_lb, *hg_onorm_g, *q_norm_g, *k_norm_g,
                *w_a, *w_b, *w_out, *peer_wq, *peer_subkeys, *peer_u, *peer_v;
    float* out; unsigned char* ws; int ph_lo, ph_hi;
};

typedef __bf16 bf16x2_hw __attribute__((ext_vector_type(2)));
__device__ __forceinline__ unsigned pk2(float lo, float hi) { const f32x2 v = {lo, hi}; const bf16x2_hw b = __builtin_convertvector(v, bf16x2_hw); return __builtin_bit_cast(unsigned, b); }
__device__ __forceinline__ unsigned f2bf(float f) { return pk2(f, 0.f) & 0xffffu; }
__device__ __forceinline__ float bf2f(unsigned u16v) { return __builtin_bit_cast(float, u16v << 16); }
__device__ __forceinline__ float bflo(unsigned w) { return __builtin_bit_cast(float, w << 16); }
__device__ __forceinline__ float bfhi(unsigned w) { return __builtin_bit_cast(float, w & 0xffff0000u); }
__device__ __forceinline__ float sigmoidf_(float x) { return __builtin_amdgcn_rcpf(1.f + __expf(-x)); }
__device__ __forceinline__ float siluf_(float x) { return x * __builtin_amdgcn_rcpf(1.f + __expf(-x)); }
__device__ __forceinline__ float wave_sum(float v) {
#pragma unroll
    for (int o = 1; o < 64; o <<= 1) v += __shfl_xor(v, o);
    return v;
}
__device__ __forceinline__ float wave_max(float v) {
#pragma unroll
    for (int o = 1; o < 64; o <<= 1) v = fmaxf(v, __shfl_xor(v, o));
    return v;
}
#define LDS_WAIT() asm volatile("s_waitcnt lgkmcnt(0)" ::: "memory")
__device__ __forceinline__ unsigned pk4_fp8(float a, float b, float c, float d) { int w = __builtin_amdgcn_cvt_pk_fp8_f32(a, b, 0, false); w = __builtin_amdgcn_cvt_pk_fp8_f32(c, d, w, true); return (unsigned)w; }

__host__ __device__ __forceinline__ int proj_tile_bf16(int i) { return i < 2 ? i + 2 : i + 6; }
__host__ __device__ __forceinline__ int proj_tile_fp8(int i) { return i < 2 ? i : (i < 6 ? i + 2 : i + 8); }
struct EpiProj {
    static constexpr bool PERM = true, AFTER_DRAIN = false, TWOPASS = false;
    bf16 *HG, *ATT, *IDX, *GATE; int f8;
    __device__ __forceinline__ void operator()(pg8::AccW& acc, const pg8::Unit& u, int wr, int wc, int fr, int fq) const {
        const int pn = f8 ? proj_tile_fp8(u.pn) : proj_tile_bf16(u.pn); bf16* base; int ldc, colt, ncols;
        if (pn < 8) { base = HG; ldc = LD_HG; colt = pn * 256; ncols = LD_HG; }
        else if (pn < 11) { base = ATT; ldc = LD_ATT; colt = (pn - 8) * 256; ncols = LD_ATT; }
        else if (pn < 14) { base = IDX; ldc = LD_IDX; colt = (pn - 11) * 256; ncols = LD_IDX; }
        else { base = GATE; ldc = LD_GATE; colt = (pn - 14) * 256; ncols = LD_GATE; }
        const int row0 = u.pm * 256 + wr * 64 + fr, col0 = colt + wc * 32 + 8 * fq;
#pragma unroll
        for (int ai = 0; ai < 2; ++ai)
#pragma unroll
            for (int m = 0; m < 4; ++m) { bf16* rowp = base + (size_t)(row0 + ai * 128 + m * 16) * ldc + col0;
#pragma unroll
                for (int bj = 0; bj < 2; ++bj) { const pg8::f32x4 v0 = pg8::acc_get(acc, ai, bj, m, 0), v1 = pg8::acc_get(acc, ai, bj, m, 1);
                    v4u w; w.x = pk2(v0[0], v0[1]); w.y = pk2(v0[2], v0[3]); w.z = pk2(v1[0], v1[1]); w.w = pk2(v1[2], v1[3]);
                    if (col0 + bj * 128 < ncols) *(v4u*)(rowp + bj * 128) = w; } }
    }
};
struct EpiMerged {
    static constexpr bool PERM = true, AFTER_DRAIN = false, TWOPASS = true;
    const bf16* GATE; bf16* O;
    __device__ __forceinline__ void operator()(pg8::AccW& acc, const pg8::Unit& u, int wr, int wc, int fr, int fq) const {
        const int row0 = u.pm * 256 + wr * 64 + fr, col0 = u.pn * 256 + wc * 32 + 8 * fq;
        if (u.pass == 0) {
#pragma unroll
            for (int ai = 0; ai < 2; ++ai)
#pragma unroll
                for (int m = 0; m < 4; ++m) { const bf16* rowp = GATE + (size_t)(row0 + ai * 128 + m * 16) * LD_GATE + col0;
#pragma unroll
                    for (int bj = 0; bj < 2; ++bj) { const v4u a = *(const v4u*)(rowp + bj * 128), b = *(const v4u*)(rowp + 1024 + bj * 128);
                        float r[8];
#pragma unroll
                        for (int i = 0; i < 4; ++i) { const float a0 = bflo(a[i]), a1 = bfhi(a[i]), b0 = bflo(b[i]), b1 = bfhi(b[i]);
                            r[2 * i] = (1.f + __expf(-b0)) * __builtin_amdgcn_rcpf(1.f + __expf(-a0)); r[2 * i + 1] = (1.f + __expf(-b1)) * __builtin_amdgcn_rcpf(1.f + __expf(-a1)); }
                        { pg8::f32x4 c0 = pg8::acc_get(acc, ai, bj, m, 0), c1 = pg8::acc_get(acc, ai, bj, m, 1);
#pragma unroll
                          for (int i = 0; i < 4; ++i) { c0[i] *= r[i]; c1[i] *= r[4 + i]; }
                          pg8::acc_set(acc, ai, bj, m, 0, c0); pg8::acc_set(acc, ai, bj, m, 1, c1); } } }
        } else {
#pragma unroll
            for (int ai = 0; ai < 2; ++ai)
#pragma unroll
                for (int m = 0; m < 4; ++m) { const size_t ro = (size_t)(row0 + ai * 128 + m * 16);
#pragma unroll
                    for (int bj = 0; bj < 2; ++bj) { const v4u b = *(const v4u*)(GATE + ro * LD_GATE + 1024 + col0 + bj * 128);
                        const pg8::f32x4 v0 = pg8::acc_get(acc, ai, bj, m, 0), v1 = pg8::acc_get(acc, ai, bj, m, 1);
                        float s[8];
#pragma unroll
                        for (int i = 0; i < 4; ++i) { s[2 * i] = sigmoidf_(bflo(b[i])); s[2 * i + 1] = sigmoidf_(bfhi(b[i])); }
                        v2u w; w.x = pk4_fp8(4.f * v0[0] * s[0], 4.f * v0[1] * s[1], 4.f * v0[2] * s[2], 4.f * v0[3] * s[3]); w.y = pk4_fp8(4.f * v1[0] * s[4], 4.f * v1[1] * s[5], 4.f * v1[2] * s[6], 4.f * v1[3] * s[7]);
                        *(v2u*)((unsigned char*)O + ro * 1024 + col0 + bj * 128) = w; } }
        }
    }
};
struct EpiResid {
    static constexpr bool PERM = true, AFTER_DRAIN = false, TWOPASS = false;
    const float* X; const float* G1  ; float* O;
    __device__ __forceinline__ void operator()(pg8::AccW& acc, const pg8::Unit& u, int wr, int wc, int fr, int fq) const {
        const int row0 = u.pm * 256 + wr * 64 + fr, col0 = u.pn * 256 + wc * 32 + 8 * fq;
        const int b = (u.pm * 256) / SEQ;
        f32x4 g[2][2];
#pragma unroll
        for (int bj = 0; bj < 2; ++bj)
#pragma unroll
            for (int n = 0; n < 2; ++n) g[bj][n] = *(const f32x4*)(G1 + (size_t)b * 6144 + col0 + bj * 128 + 4 * n);
#pragma unroll
        for (int ai = 0; ai < 2; ++ai)
#pragma unroll
            for (int m = 0; m < 4; ++m) { const size_t ro = (size_t)(row0 + ai * 128 + m * 16) * DM + col0;
#pragma unroll
                for (int bj = 0; bj < 2; ++bj)
#pragma unroll
                    for (int n = 0; n < 2; ++n) { const f32x4 xv = *(const f32x4*)(X + ro + bj * 128 + 4 * n);
                        *(f32x4*)(O + ro + bj * 128 + 4 * n) = xv + g[bj][n] * pg8::acc_get(acc, ai, bj, m, n); } }
    }
};
struct EpiStore {
    static constexpr bool PERM = true, AFTER_DRAIN = false, TWOPASS = false;
    bf16* O; int ldc;
    __device__ __forceinline__ void operator()(pg8::AccW& acc, const pg8::Unit& u, int wr, int wc, int fr, int fq) const {
        const int row0 = u.pm * 256 + wr * 64 + fr, col0 = u.pn * 256 + wc * 32 + 8 * fq;
#pragma unroll
        for (int ai = 0; ai < 2; ++ai)
#pragma unroll
            for (int m = 0; m < 4; ++m) { bf16* rowp = O + (size_t)(row0 + ai * 128 + m * 16) * ldc + col0;
#pragma unroll
                for (int bj = 0; bj < 2; ++bj) { const pg8::f32x4 v0 = pg8::acc_get(acc, ai, bj, m, 0), v1 = pg8::acc_get(acc, ai, bj, m, 1);
                    v4u w; w.x = pk2(v0[0], v0[1]); w.y = pk2(v0[2], v0[3]); w.z = pk2(v1[0], v1[1]); w.w = pk2(v1[2], v1[3]);
                    *(v4u*)(rowp + bj * 128) = w; } }
    }
};

template <int MODE> __device__ __forceinline__ int srcmap(int np) {
    if (MODE == 2) np = proj_tile_bf16(np >> 8) * 256 + (np & 255);
    if (MODE == 3) np = proj_tile_fp8(np >> 8) * 256 + (np & 255);
    if (MODE >= 1) return np < 3400 ? np : (np >= 3584 ? np - 184 : -1);
    return np; }
template <int MODE>
__device__ __forceinline__ void transpose_item(const float* W, int N, bf16* WT, int ldw, int koff, float* scr, int kb, int nb, int lane) {
    const int k0 = 64 * kb, n0 = 32 * nb;
    const int sc = srcmap<MODE>(n0 + (lane & 31));
#pragma unroll 8
    for (int i = 0; i < 32; ++i) { const int kk = 2 * i + (lane >> 5); scr[kk * 33 + (lane & 31)] = (sc >= 0) ? W[(size_t)(k0 + kk) * N + sc] : 0.f; }
    LDS_WAIT(); __builtin_amdgcn_wave_barrier();
    const int c = lane & 7;
#pragma unroll
    for (int j = 0; j < 4; ++j) { const int n = (lane >> 3) + 8 * j; const float* s = scr + (8 * c) * 33 + n;
        v4u o; o.x = pk2(s[0 * 33], s[1 * 33]); o.y = pk2(s[2 * 33], s[3 * 33]); o.z = pk2(s[4 * 33], s[5 * 33]); o.w = pk2(s[6 * 33], s[7 * 33]);
        *(v4u*)(WT + (size_t)(n0 + n) * ldw + koff + k0 + 8 * c) = o; }
    LDS_WAIT(); __builtin_amdgcn_wave_barrier();
}
template <int MODE> __device__ __forceinline__ int srcmap(int np);
template <int MODE = 0>
__device__ __forceinline__ void transpose_item8(const float* W, int N, unsigned char* WT, int ldw, int koff, float scale, float* scr, int kb, int nb, int lane) {
    const int k0 = 64 * kb, n0 = 32 * nb;
    const int sc = srcmap<MODE>(n0 + (lane & 31));
#pragma unroll 8
    for (int i = 0; i < 32; ++i) { const int kk = 2 * i + (lane >> 5); scr[kk * 33 + (lane & 31)] = (sc >= 0) ? W[(size_t)(k0 + kk) * N + sc] * scale : 0.f; }
    LDS_WAIT(); __builtin_amdgcn_wave_barrier();
    const int c = lane & 3;
#pragma unroll
    for (int j = 0; j < 2; ++j) { const int n = (lane >> 2) + 16 * j; const float* sp = scr + (16 * c) * 33 + n;
        v4u o;
#pragma unroll
        for (int q = 0; q < 4; ++q) o[q] = pk4_fp8(sp[(4 * q) * 33], sp[(4 * q + 1) * 33], sp[(4 * q + 2) * 33], sp[(4 * q + 3) * 33]);
        *(v4u*)(WT + (size_t)(n0 + n) * ldw + koff + k0 + 16 * c) = o; }
    LDS_WAIT(); __builtin_amdgcn_wave_barrier();
}
__device__ __forceinline__ void convert_plain(const float* src, bf16* dst, size_t n, size_t gtid, size_t nth) {
    const size_t n8 = n / 8;
    for (size_t i = gtid; i < n8; i += nth) { const f32x4 a = ((const f32x4*)src)[2 * i], b = ((const f32x4*)src)[2 * i + 1];
        v4u o; o.x = pk2(a[0], a[1]); o.y = pk2(a[2], a[3]); o.z = pk2(b[0], b[1]); o.w = pk2(b[2], b[3]); ((v4u*)dst)[i] = o; }
}
__device__ __forceinline__ void convert_fp8(const float* src, unsigned char* dst, size_t n, float scale, size_t gtid, size_t nth) {
    const size_t n16 = n / 16;
    for (size_t i = gtid; i < n16; i += nth) { const f32x4* sp = (const f32x4*)src + 4 * i; const f32x4 a = sp[0] * scale, b = sp[1] * scale, c = sp[2] * scale, d = sp[3] * scale;
        v4u o; o.x = pk4_fp8(a[0], a[1], a[2], a[3]); o.y = pk4_fp8(b[0], b[1], b[2], b[3]); o.z = pk4_fp8(c[0], c[1], c[2], c[3]); o.w = pk4_fp8(d[0], d[1], d[2], d[3]); ((v4u*)dst)[i] = o; }
}
template <bool KKMAJOR>
__device__ __forceinline__ void convert_mxfp4(const float* src, unsigned char* dst, unsigned char* scl, size_t nrows, size_t gtid, size_t nth) {
    const size_t nblk = nrows * 32;
    for (size_t i = gtid; i < nblk; i += nth) {
        const size_t row = i >> 5; const int blk = (int)(i & 31);
        const f32x4* sp = (const f32x4*)(src + row * 1024 + blk * 32);
        f32x4 v[8]; float amax = 0.f;
#pragma unroll
        for (int j = 0; j < 8; ++j) { v[j] = sp[j]; amax = fmaxf(fmaxf(fmaxf(fabsf(v[j][0]), fabsf(v[j][1])), fmaxf(fabsf(v[j][2]), fabsf(v[j][3]))), amax); }
        int e = (int)((__builtin_bit_cast(unsigned, amax) >> 23) & 0xffu) - 127 - 2;
        if (e < -126) e = -126;
        const float inv = __builtin_bit_cast(float, (unsigned)(127 - e) << 23);
        unsigned w[4] = {0u, 0u, 0u, 0u};
#pragma unroll
        for (int j = 0; j < 8; j += 2) { unsigned t = 0u;
            t = __builtin_amdgcn_cvt_scalef32_pk_fp4_f32(t, v[j][0] * inv, v[j][1] * inv, 1.0f, 0);
            t = __builtin_amdgcn_cvt_scalef32_pk_fp4_f32(t, v[j][2] * inv, v[j][3] * inv, 1.0f, 1);
            t = __builtin_amdgcn_cvt_scalef32_pk_fp4_f32(t, v[j + 1][0] * inv, v[j + 1][1] * inv, 1.0f, 2);
            t = __builtin_amdgcn_cvt_scalef32_pk_fp4_f32(t, v[j + 1][2] * inv, v[j + 1][3] * inv, 1.0f, 3);
            w[j >> 1] = t; }
        *(v4u*)(dst + row * 512 + blk * 16) = (v4u){w[0], w[1], w[2], w[3]};
        scl[row * 32 + (KKMAJOR ? ((blk & 3) * 8 + (blk >> 2)) : blk)] = (unsigned char)(e + 127);
    }
}
__device__ __forceinline__ void convert_rowfp4(const float* src, unsigned char* dst, _Float16* scl, int row, int lane) {
    const f32x4* sp = (const f32x4*)(src + (size_t)row * 1024 + lane * 16);
    f32x4 v[4]; float amax = 0.f;
#pragma unroll
    for (int j = 0; j < 4; ++j) { v[j] = sp[j]; amax = fmaxf(fmaxf(fmaxf(fabsf(v[j][0]), fabsf(v[j][1])), fmaxf(fabsf(v[j][2]), fabsf(v[j][3]))), amax); }
    amax = wave_max(amax);
    _Float16 sh = (_Float16)(amax * (1.f / 6.f));
    float sf = (float)sh; if (!(sf > 0.f)) { sf = 1.f; sh = (_Float16)1.f; }
    const float inv = 1.f / sf;
    unsigned w[2];
#pragma unroll
    for (int j = 0; j < 2; ++j) { unsigned t = 0u;
        t = __builtin_amdgcn_cvt_scalef32_pk_fp4_f32(t, v[2 * j][0] * inv, v[2 * j][1] * inv, 1.0f, 0);
        t = __builtin_amdgcn_cvt_scalef32_pk_fp4_f32(t, v[2 * j][2] * inv, v[2 * j][3] * inv, 1.0f, 1);
        t = __builtin_amdgcn_cvt_scalef32_pk_fp4_f32(t, v[2 * j + 1][0] * inv, v[2 * j + 1][1] * inv, 1.0f, 2);
        t = __builtin_amdgcn_cvt_scalef32_pk_fp4_f32(t, v[2 * j + 1][2] * inv, v[2 * j + 1][3] * inv, 1.0f, 3);
        w[j] = t; }
    *(v2u*)(dst + (size_t)row * 512 + lane * 8) = (v2u){w[0], w[1]};
    if (lane == 0) scl[row] = sh;
}
__device__ __forceinline__ void phase0(const Params& p, unsigned char* lds) {
    const int tid = threadIdx.x, wave = tid >> 6, lane = tid & 63, G = gridDim.x;
    const int gw = blockIdx.x * NWAVES + wave, NGW = G * NWAVES;
    float* scr = (float*)(lds + wave * 16384);
    unsigned char* ws = p.ws;
    constexpr int I_IN = 16 * (2048 / 32), I_IN8 = 16 * (3584 / 32), I_A = 8 * 32, I_O = 16 * 32, I_Q = 16 * 64;
    constexpr int NT = I_IN + I_IN8 + 2 * I_A + I_O + I_Q;
    for (int it = gw; it < NT; it += NGW) {
        int r = it;
        if (r < I_IN) { transpose_item<2>(p.w_in, INW, (bf16*)(ws + WS_WIN), 1024, 0, scr, r / 64, r % 64, lane); continue; } r -= I_IN;
        if (r < I_IN8) { transpose_item8<3>(p.w_in, INW, ws + WS_WIN8, 1024, 0, 32.f, scr, r / 112, r % 112, lane); continue; } r -= I_IN8;
        if (r < I_A) { transpose_item8(p.w_a, 1024, ws + WS_WAB8, 1024, 0, 32.f, scr, r / 32, r % 32, lane); continue; } r -= I_A;
        if (r < I_A) { transpose_item8(p.w_b, 1024, ws + WS_WAB8, 1024, 512, 4.f, scr, r / 32, r % 32, lane); continue; } r -= I_A;
        if (r < I_O) { transpose_item8(p.w_out, 1024, ws + WS_WOUT8, 1024, 0, 32.f, scr, r / 32, r % 32, lane); continue; } r -= I_O;
        transpose_item<0>(p.peer_wq, 2048, (bf16*)(ws + WS_WQ), 1024, 0, scr, r / 64, r % 64, lane);
    }
    for (int it = gw; it < 96 * 8; it += NGW) {
        const int cgp = it % 96, ks = it / 96, col = cgp * 64 + lane, k0 = ks * 128;
#pragma unroll
        for (int i = 0; i < 16; ++i) { const int e = i * 64 + lane, b = e >> 7, k = e & 127; scr[e] = siluf_(p.c[b * 1024 + k0 + k]); }
        LDS_WAIT(); __builtin_amdgcn_wave_barrier();
        float acc[8];
#pragma unroll
        for (int b = 0; b < 8; ++b) acc[b] = 0.f;
#pragma unroll 4
        for (int k = 0; k < 128; ++k) { const float w = p.w_ada[(size_t)(k0 + k) * 6144 + col];
#pragma unroll
            for (int b = 0; b < 8; ++b) acc[b] += scr[b * 128 + k] * w; }
        float* mp = (float*)(ws + WS_MODP) + (size_t)ks * 8 * 6144 + col;
#pragma unroll
        for (int b = 0; b < 8; ++b) mp[b * 6144] = acc[b];
        LDS_WAIT(); __builtin_amdgcn_wave_barrier();
    }
    const size_t gtid = (size_t)blockIdx.x * NTHREADS + tid, nth = (size_t)G * NTHREADS;
    convert_plain(p.peer_subkeys, (bf16*)(ws + WS_SK), (size_t)16 * 128 * 128, gtid, nth);
    for (int it = gw; it < 2 * NEXP; it += NGW) {
        if (it < NEXP) convert_rowfp4(p.peer_u, ws + WS_U, (_Float16*)(ws + WS_US), it, lane);
        else convert_rowfp4(p.peer_v, ws + WS_V, (_Float16*)(ws + WS_VS), it - NEXP, lane);
    }
}

template <bool FIRST>
__device__ __forceinline__ void normmod_phase(const Params& p, unsigned char* lds, const float* src, bf16* dst, const float* gvec, int shift_off, int scale_off) {
    const int tid = threadIdx.x, wave = tid >> 6, lane = tid & 63, G = gridDim.x;
    unsigned char* ws = p.ws;
    float* A = (float*)lds;
    float* Bv = A + 1024;
    const float* MODP = (const float*)(ws + WS_MODP);
    float* MOD = (float*)(ws + WS_MOD);
    if (FIRST) {
        for (int e = blockIdx.x * NTHREADS + tid; e < 8 * 6144; e += G * NTHREADS) { const int col = e % 6144; float s = p.b_ada[col];
#pragma unroll
            for (int ks = 0; ks < 8; ++ks) s += MODP[(size_t)ks * 8 * 6144 + e];
            MOD[e] = s; }
    }
    int curb = -1;
    for (int chunk = blockIdx.x; chunk < T / 128; chunk += G) {
        const int b = (chunk * 128) / SEQ;
        if (b != curb) {
            __syncthreads();
            for (int col = tid; col < 1024; col += NTHREADS) {
                float sc, sh;
                if (FIRST) { sc = p.b_ada[scale_off + col]; sh = p.b_ada[shift_off + col];
#pragma unroll
                    for (int ks = 0; ks < 8; ++ks) { sc += MODP[(size_t)(ks * 8 + b) * 6144 + scale_off + col]; sh += MODP[(size_t)(ks * 8 + b) * 6144 + shift_off + col]; } }
                else { sc = MOD[b * 6144 + scale_off + col]; sh = MOD[b * 6144 + shift_off + col]; }
                A[col] = gvec[col] * (1.f + sc); Bv[col] = sh; }
            __syncthreads(); curb = b;
        }
        for (int r = wave; r < 128; r += NWAVES) {
            const size_t row = (size_t)chunk * 128 + r;
            const f32x4* xr = (const f32x4*)(src + row * DM) + lane;
            f32x4 v[4]; float s = 0.f;
#pragma unroll
            for (int j = 0; j < 4; ++j) { v[j] = xr[64 * j]; s += (v[j][0] * v[j][0] + v[j][1] * v[j][1]) + (v[j][2] * v[j][2] + v[j][3] * v[j][3]); }
            const float rstd = rsqrtf(wave_sum(s) * (1.f / DM) + RMS_EPS);
            v2u* o8 = (v2u*)(dst + row * DM) + lane;
#pragma unroll
            for (int j = 0; j < 4; ++j) { const int c0 = 4 * lane + 256 * j; const f32x4 a = *(const f32x4*)(A + c0), sh = *(const f32x4*)(Bv + c0);
                v2u o; o.x = pk2(v[j][0] * rstd * a[0] + sh[0], v[j][1] * rstd * a[1] + sh[1]); o.y = pk2(v[j][2] * rstd * a[2] + sh[2], v[j][3] * rstd * a[3] + sh[3]);
                o8[64 * j] = o;
                if (FIRST) *(unsigned*)(ws + WS_H8 + row * DM + c0) = pk4_fp8(v[j][0] * rstd * a[0] + sh[0], v[j][1] * rstd * a[1] + sh[1], v[j][2] * rstd * a[2] + sh[2], v[j][3] * rstd * a[3] + sh[3]);
                if (!FIRST) { float* st = (float*)(lds + 8192) + wave * 1056;
                    const float y0 = v[j][0] * rstd * a[0] + sh[0], y1 = v[j][1] * rstd * a[1] + sh[1], y2 = v[j][2] * rstd * a[2] + sh[2], y3 = v[j][3] * rstd * a[3] + sh[3];
                    const int pc = c0 + (c0 >> 5); st[pc] = y0; st[pc + 1] = y1; st[pc + 2] = y2; st[pc + 3] = y3; } }
            if (!FIRST) {
                const float* st = (const float*)(lds + 8192) + wave * 1056;
                LDS_WAIT(); __builtin_amdgcn_wave_barrier();
                if (lane < 32) {
                    float x[32];
#pragma unroll
                    for (int k = 0; k < 32; ++k) x[k] = st[lane * 33 + k];
#pragma unroll
                    for (int t = 0; t < H4_NT; ++t) {
                        float amax = 0.f;
#pragma unroll
                        for (int k = 0; k < 32; ++k) amax = fmaxf(amax, fabsf(x[k]));
                        int e = (int)((__builtin_bit_cast(unsigned, amax) >> 23) & 0xffu) - 127 - 2; if (e < -126) e = -126;
                        const float inv = __builtin_bit_cast(float, (unsigned)(127 - e) << 23), sc = __builtin_bit_cast(float, (unsigned)(127 + e) << 23);
                        unsigned w[4];
#pragma unroll
                        for (int r = 0; r < 4; ++r) { unsigned tw = 0u;
                            tw = __builtin_amdgcn_cvt_scalef32_pk_fp4_f32(tw, x[8 * r] * inv, x[8 * r + 1] * inv, 1.0f, 0);
                            tw = __builtin_amdgcn_cvt_scalef32_pk_fp4_f32(tw, x[8 * r + 2] * inv, x[8 * r + 3] * inv, 1.0f, 1);
                            tw = __builtin_amdgcn_cvt_scalef32_pk_fp4_f32(tw, x[8 * r + 4] * inv, x[8 * r + 5] * inv, 1.0f, 2);
                            tw = __builtin_amdgcn_cvt_scalef32_pk_fp4_f32(tw, x[8 * r + 6] * inv, x[8 * r + 7] * inv, 1.0f, 3);
                            w[r] = tw;
                            const f32x2 d0 = __builtin_amdgcn_cvt_scalef32_pk_f32_fp4(tw, 1.0f, 0), d1 = __builtin_amdgcn_cvt_scalef32_pk_f32_fp4(tw, 1.0f, 1), d2 = __builtin_amdgcn_cvt_scalef32_pk_f32_fp4(tw, 1.0f, 2), d3 = __builtin_amdgcn_cvt_scalef32_pk_f32_fp4(tw, 1.0f, 3);
                            x[8 * r] -= d0[0] * sc; x[8 * r + 1] -= d0[1] * sc; x[8 * r + 2] -= d1[0] * sc; x[8 * r + 3] -= d1[1] * sc;
                            x[8 * r + 4] -= d2[0] * sc; x[8 * r + 5] -= d2[1] * sc; x[8 * r + 6] -= d3[0] * sc; x[8 * r + 7] -= d3[1] * sc; }
                        *(v4u*)(ws + WS_H4D + (row * H4_NT + t) * 512 + lane * 16) = (v4u){w[0], w[1], w[2], w[3]};
                        *(ws + WS_H4S + (row * H4_NT + t) * 32 + (lane & 3) * 8 + (lane >> 2)) = (unsigned char)(e + 127);
                    }
                }
                LDS_WAIT(); __builtin_amdgcn_wave_barrier();
            }
        }
    }
    __syncthreads();
}

constexpr int HGL_QT = 0, HGL_KT = 17408, HGL_QE = 34816, HGL_KLT = 52224, HGL_VT = 70656, HGL_AM = 89088, HGL_DEC = 98304, HGL_TOT = 98816, HGL_SSQ = 100864;
constexpr int HG_LDR = 136;
constexpr int HG_LDC = 72;
template <int half>
__device__ __forceinline__ void hgrn_item(const Params& p, unsigned char* lds, int item) {
    const int b = item >> 2, h = item & 3;
    const int tid = threadIdx.x, w = tid >> 6, lane = tid & 63, fr = lane & 15, fq = lane >> 4;
    unsigned char* ws = p.ws;
    const bf16* HG = (const bf16*)(ws + WS_HG);
    bf16* YA = (bf16*)(ws + WS_H);
    bf16* QT = (bf16*)(lds + HGL_QT); bf16* KT = (bf16*)(lds + HGL_KT); bf16* QE = (bf16*)(lds + HGL_QE);
    bf16* KLT = (bf16*)(lds + HGL_KLT); bf16* VT = (bf16*)(lds + HGL_VT); bf16* AM = (bf16*)(lds + HGL_AM);
    float* DEC = (float*)(lds + HGL_DEC); float* TOT = (float*)(lds + HGL_TOT); float* SSQ = (float*)(lds + HGL_SSQ);
    const int pd = tid & 127, pq = tid >> 7;
    float lbv; { const float a0 = p.hg_lb[h * 128 + pd], a1 = p.hg_lb[512 + h * 128 + pd]; lbv = 1.f / (1.f + __expf(a1 - a0)); }
    const int e0 = w * 16;
    const float ogv = p.hg_onorm_g[e0 + fr];
    pg8::f32x4 S[8];
#pragma unroll
    for (int i = 0; i < 8; ++i) S[i] = (pg8::f32x4){0.f, 0.f, 0.f, 0.f};
    const size_t rowb = (size_t)b * SEQ;
    const int c0 = half * 32;
    bf16* QCg = (bf16*)(ws + WS_HQC) + (size_t)item * 2048 * 128; float* OLg = (float*)(ws + WS_HOL) + (size_t)item * 32 * 8 * 4 * 256;
    float cum = 1.f;
    unsigned short rq[16], rf[16], rv[16];
    { const bf16* gp = HG + (rowb + (size_t)c0 * 64 + pq * 16) * LD_HG + h * 128 + pd;
#pragma unroll
      for (int i = 0; i < 16; ++i) { rq[i] = gp[(size_t)i * LD_HG]; rf[i] = gp[(size_t)i * LD_HG + 512]; rv[i] = gp[(size_t)i * LD_HG + 1024]; } }
    for (int chunk = c0; chunk < c0 + 32; ++chunk) {
        const size_t row0 = rowb + (size_t)chunk * 64;
        float fq_[16], kq_[16], cs[16];
        float run = 0.f;
#pragma unroll
        for (int i = 0; i < 16; ++i) { const float f = lbv + (1.f - lbv) * sigmoidf_(bf2f(rf[i])); kq_[i] = 1.f - f; run += __logf(f); cs[i] = run; fq_[i] = siluf_(bf2f(rq[i])); }
        TOT[pq * 128 + pd] = run;
        { v4u v0, v1;
          v0.x = rv[0] | ((unsigned)rv[1] << 16); v0.y = rv[2] | ((unsigned)rv[3] << 16); v0.z = rv[4] | ((unsigned)rv[5] << 16); v0.w = rv[6] | ((unsigned)rv[7] << 16);
          v1.x = rv[8] | ((unsigned)rv[9] << 16); v1.y = rv[10] | ((unsigned)rv[11] << 16); v1.z = rv[12] | ((unsigned)rv[13] << 16); v1.w = rv[14] | ((unsigned)rv[15] << 16);
          *(v4u*)(VT + pd * HG_LDC + pq * 16) = v0; *(v4u*)(VT + pd * HG_LDC + pq * 16 + 8) = v1; }
        unsigned short rg[16];
#pragma unroll
        for (int i = 0; i < 16; ++i) rg[i] = half ? (unsigned short)0 : HG[(row0 + (i >> 2) * 16 + fq * 4 + (i & 3)) * LD_HG + 1536 + h * 128 + e0 + fr];
        if (chunk + 1 < c0 + 32) { const bf16* gp = HG + (row0 + 64 + pq * 16) * LD_HG + h * 128 + pd;
#pragma unroll
            for (int i = 0; i < 16; ++i) { rq[i] = gp[(size_t)i * LD_HG]; rf[i] = gp[(size_t)i * LD_HG + 512]; rv[i] = gp[(size_t)i * LD_HG + 1024]; } }
        __syncthreads();
        const float t0 = TOT[pd], t1 = TOT[128 + pd], t2 = TOT[256 + pd], t3 = TOT[384 + pd];
        const float base = (pq > 0 ? t0 : 0.f) + (pq > 1 ? t1 : 0.f) + (pq > 2 ? t2 : 0.f);
        const float bmid = t0 + t1, blast = (t0 + t1) + (t2 + t3);
        const float emid = __expf(bmid), elm = __expf(blast - bmid);
        if (pq == 0) DEC[pd] = __expf(blast);
        { unsigned klp[8];
#pragma unroll
          for (int i = 0; i < 16; ++i) { const float bb = base + cs[i]; const float E1 = __expf(bb - bmid), R1 = __builtin_amdgcn_rcpf(E1);
              const float qtv = fq_[i] * E1, ktv = kq_[i] * R1, qev = qtv * emid, klv = ktv * elm;
              const int srow = pq * 16 + i;
              QT[srow * HG_LDR + pd] = (bf16)f2bf(qtv); KT[srow * HG_LDR + pd] = (bf16)f2bf(ktv); QE[srow * HG_LDR + pd] = (bf16)f2bf(qev);
              if (half) QCg[((size_t)(chunk - 32) * 64 + srow) * 128 + pd] = (bf16)f2bf(qev * cum);
              if (i & 1) klp[i >> 1] |= f2bf(klv) << 16; else klp[i >> 1] = f2bf(klv); }
          *(v4u*)(KLT + pd * HG_LDC + pq * 16) = (v4u){klp[0], klp[1], klp[2], klp[3]}; *(v4u*)(KLT + pd * HG_LDC + pq * 16 + 8) = (v4u){klp[4], klp[5], klp[6], klp[7]}; }
        cum *= __expf(blast);
        __syncthreads();
#pragma unroll
        for (int tt = 0; tt < 2; ++tt) { const int id = w + 8 * tt, rt = id >> 2, ct = id & 3;
            pg8::f32x4 a = {0.f, 0.f, 0.f, 0.f};
            if (ct <= rt) {
#pragma unroll
                for (int ks = 0; ks < 4; ++ks) { const bf16x8 af = *(const bf16x8*)(QT + (rt * 16 + fr) * HG_LDR + ks * 32 + fq * 8), bfv = *(const bf16x8*)(KT + (ct * 16 + fr) * HG_LDR + ks * 32 + fq * 8);
                    a = __builtin_amdgcn_mfma_f32_16x16x32_bf16(af, bfv, a, 0, 0, 0); } }
#pragma unroll
            for (int r = 0; r < 4; ++r) { const int c = rt * 16 + fq * 4 + r, sidx = ct * 16 + fr; AM[c * HG_LDC + sidx] = (bf16)((sidx <= c) ? f2bf(a[r]) : 0u); } }
        __syncthreads();
        const bf16x8 vb0 = *(const bf16x8*)(VT + (e0 + fr) * HG_LDC + fq * 8), vb1 = *(const bf16x8*)(VT + (e0 + fr) * HG_LDC + 32 + fq * 8);
        bf16x8 sb[4];
#pragma unroll
        for (int ks = 0; ks < 4; ++ks) { v4u t; t.x = pk2(S[2 * ks][0], S[2 * ks][1]); t.y = pk2(S[2 * ks][2], S[2 * ks][3]); t.z = pk2(S[2 * ks + 1][0], S[2 * ks + 1][1]); t.w = pk2(S[2 * ks + 1][2], S[2 * ks + 1][3]); sb[ks] = __builtin_bit_cast(bf16x8, t); }
        pg8::f32x4 o[4];
#pragma unroll
        for (int rt = 0; rt < 4; ++rt) { pg8::f32x4 a = {0.f, 0.f, 0.f, 0.f};
            a = __builtin_amdgcn_mfma_f32_16x16x32_bf16(*(const bf16x8*)(AM + (rt * 16 + fr) * HG_LDC + fq * 8), vb0, a, 0, 0, 0);
            a = __builtin_amdgcn_mfma_f32_16x16x32_bf16(*(const bf16x8*)(AM + (rt * 16 + fr) * HG_LDC + 32 + fq * 8), vb1, a, 0, 0, 0);
#pragma unroll
            for (int ks = 0; ks < 4; ++ks) { const v2u lo = *(const v2u*)(QE + (rt * 16 + fr) * HG_LDR + ks * 32 + fq * 4), hi = *(const v2u*)(QE + (rt * 16 + fr) * HG_LDR + ks * 32 + 16 + fq * 4);
                const v4u t = {lo.x, lo.y, hi.x, hi.y};
                a = __builtin_amdgcn_mfma_f32_16x16x32_bf16(__builtin_bit_cast(bf16x8, t), sb[ks], a, 0, 0, 0); }
            o[rt] = a; }
#pragma unroll
        for (int dt = 0; dt < 8; ++dt) { const f32x4 dc = *(const f32x4*)(DEC + dt * 16 + fq * 4);
            pg8::f32x4 a = S[dt]; a[0] *= dc[0]; a[1] *= dc[1]; a[2] *= dc[2]; a[3] *= dc[3];
            a = __builtin_amdgcn_mfma_f32_16x16x32_bf16(*(const bf16x8*)(KLT + (dt * 16 + fr) * HG_LDC + fq * 8), vb0, a, 0, 0, 0);
            a = __builtin_amdgcn_mfma_f32_16x16x32_bf16(*(const bf16x8*)(KLT + (dt * 16 + fr) * HG_LDC + 32 + fq * 8), vb1, a, 0, 0, 0);
            S[dt] = a; }
        if (half) {
#pragma unroll
            for (int rt = 0; rt < 4; ++rt) *(pg8::f32x4*)(OLg + ((((size_t)(chunk - 32)) * 8 + w) * 4 + rt) * 256 + lane * 4) = o[rt];
            __syncthreads();
            continue;
        }
#pragma unroll
        for (int rt = 0; rt < 4; ++rt)
#pragma unroll
            for (int r = 0; r < 4; ++r) { float x = o[rt][r] * o[rt][r];
                x += __shfl_xor(x, 1); x += __shfl_xor(x, 2); x += __shfl_xor(x, 4); x += __shfl_xor(x, 8);
                if (fr == 0) SSQ[w * 64 + rt * 16 + fq * 4 + r] = x; }
        __syncthreads();
        float tot = 0.f;
#pragma unroll
        for (int ww = 0; ww < 8; ++ww) tot += SSQ[ww * 64 + lane];
        const float rstd_l = rsqrtf(tot * (1.f / 128.f) + RMS_EPS);
#pragma unroll
        for (int rt = 0; rt < 4; ++rt)
#pragma unroll
            for (int r = 0; r < 4; ++r) { const int c = rt * 16 + fq * 4 + r; const float rs = __shfl(rstd_l, c);
                const float y = o[rt][r] * rs * ogv * siluf_(bf2f(rg[rt * 4 + r]));
                ((unsigned char*)YA)[(row0 + c) * 1024 + h * 128 + e0 + fr] = (unsigned char)(__builtin_amdgcn_cvt_pk_fp8_f32(y, 0.f, 0, false) & 0xff); }
    }
    if (!half) {
#pragma unroll
        for (int ks = 0; ks < 4; ++ks) { v4u t; t.x = pk2(S[2 * ks][0], S[2 * ks][1]); t.y = pk2(S[2 * ks][2], S[2 * ks][3]); t.z = pk2(S[2 * ks + 1][0], S[2 * ks + 1][1]); t.w = pk2(S[2 * ks + 1][2], S[2 * ks + 1][3]);
            *(v4u*)(ws + WS_HSB + ((((size_t)item * 8 + w) * 4 + ks) * 64 + lane) * 16) = t; }
    }
    __syncthreads();
}
__device__ __forceinline__ void hgrn_fix(const Params& p, unsigned char* lds, int item, int c) {
    const int b = item >> 2, h = item & 3;
    const int tid = threadIdx.x, w = tid >> 6, lane = tid & 63, fr = lane & 15, fq = lane >> 4;
    unsigned char* ws = p.ws;
    const bf16* HG = (const bf16*)(ws + WS_HG);
    bf16* YA = (bf16*)(ws + WS_H);
    float* SSQ = (float*)(lds + HGL_SSQ);
    const bf16* QCg = (const bf16*)(ws + WS_HQC) + (size_t)item * 2048 * 128; const float* OLg = (const float*)(ws + WS_HOL) + (size_t)item * 32 * 8 * 4 * 256;
    const int e0 = w * 16;
    const float ogv = p.hg_onorm_g[e0 + fr];
    const size_t row0 = (size_t)b * SEQ + (size_t)(32 + c) * 64;
    bf16x8 sb[4];
#pragma unroll
    for (int ks = 0; ks < 4; ++ks) sb[ks] = __builtin_bit_cast(bf16x8, *(const v4u*)(ws + WS_HSB + ((((size_t)item * 8 + w) * 4 + ks) * 64 + lane) * 16));
    unsigned short rg[16];
#pragma unroll
    for (int i = 0; i < 16; ++i) rg[i] = HG[(row0 + (i >> 2) * 16 + fq * 4 + (i & 3)) * LD_HG + 1536 + h * 128 + e0 + fr];
    pg8::f32x4 o[4];
#pragma unroll
    for (int rt = 0; rt < 4; ++rt) { pg8::f32x4 a = *(const pg8::f32x4*)(OLg + ((((size_t)c) * 8 + w) * 4 + rt) * 256 + lane * 4);
#pragma unroll
        for (int ks = 0; ks < 4; ++ks) { const bf16* qr = QCg + ((size_t)c * 64 + rt * 16 + fr) * 128 + ks * 32;
            const v2u lo = *(const v2u*)(qr + fq * 4), hi = *(const v2u*)(qr + 16 + fq * 4);
            const v4u t = {lo.x, lo.y, hi.x, hi.y};
            a = __builtin_amdgcn_mfma_f32_16x16x32_bf16(__builtin_bit_cast(bf16x8, t), sb[ks], a, 0, 0, 0); }
        o[rt] = a; }
#pragma unroll
    for (int rt = 0; rt < 4; ++rt)
#pragma unroll
        for (int r = 0; r < 4; ++r) { float x = o[rt][r] * o[rt][r];
            x += __shfl_xor(x, 1); x += __shfl_xor(x, 2); x += __shfl_xor(x, 4); x += __shfl_xor(x, 8);
            if (fr == 0) SSQ[w * 64 + rt * 16 + fq * 4 + r] = x; }
    __syncthreads();
    float tot = 0.f;
#pragma unroll
    for (int ww = 0; ww < 8; ++ww) tot += SSQ[ww * 64 + lane];
    const float rstd_l = rsqrtf(tot * (1.f / 128.f) + RMS_EPS);
#pragma unroll
    for (int rt = 0; rt < 4; ++rt)
#pragma unroll
        for (int r = 0; r < 4; ++r) { const int cc = rt * 16 + fq * 4 + r; const float rs = __shfl(rstd_l, cc);
            const float y = o[rt][r] * rs * ogv * siluf_(bf2f(rg[rt * 4 + r]));
            ((unsigned char*)YA)[(row0 + cc) * 1024 + h * 128 + e0 + fr] = (unsigned char)(__builtin_amdgcn_cvt_pk_fp8_f32(y, 0.f, 0, false) & 0xff); }
    __syncthreads();
}

__device__ __forceinline__ unsigned f16key(float x) {
    x = x + 0.f;
    const _Float16 hx = (_Float16)x; const unsigned short bits = __builtin_bit_cast(unsigned short, hx);
    return (bits & 0x8000u) ? (unsigned)(unsigned short)(~bits) : (unsigned)(bits | 0x8000u);
}
__device__ __forceinline__ void find_bin(const unsigned* hist, int K, int lane, int& bin, int& rem) {
    const v4u hv = *(const v4u*)(hist + 4 * lane);
    const unsigned c = hv.x + hv.y + hv.z + hv.w;
    unsigned suf = c;
#pragma unroll
    for (int o = 1; o < 64; o <<= 1) { const unsigned t = __shfl_down(suf, o); if (lane + o < 64) suf += t; }
    const unsigned above = suf - c;
    const bool mine = (above < (unsigned)K) && ((unsigned)K <= suf);
    int mybin = 0, myrem = 0;
    if (mine) { unsigned ca = above; const unsigned hh[4] = {hv.x, hv.y, hv.z, hv.w}; bool found = false;
#pragma unroll
        for (int i = 3; i >= 0; --i) { if (!found) { if (ca + hh[i] >= (unsigned)K) { mybin = 4 * lane + i; myrem = K - (int)ca; found = true; } else ca += hh[i]; } } }
    const unsigned long long m = __ballot(mine);
    const int src = (int)__builtin_ctzll(m | (1ull << 63));
    bin = __shfl(mybin, src); rem = __shfl(myrem, src);
}
__device__ __forceinline__ void dsa1_item(const Params& p, unsigned char* lds, int item) {
    const int b = item >> 8, q0 = (item & 255) * 16;
    const int tid = threadIdx.x, w = tid >> 6, lane = tid & 63, fr = lane & 15, fq = lane >> 4;
    unsigned char* ws = p.ws;
    const bf16* IDX = (const bf16*)(ws + WS_IDX);
    unsigned short* Ik = (unsigned short*)lds;
    unsigned* hist1 = (unsigned*)(lds + 131072);
    unsigned* hist = (unsigned*)(lds + 131072 + 16384) + w * 256;
    const size_t rowb = (size_t)b * SEQ;
    *(v4u*)(hist1 + tid * 4) = (v4u){0u, 0u, 0u, 0u}; *(v4u*)(hist1 + 2048 + tid * 4) = (v4u){0u, 0u, 0u, 0u};
    bf16x8 Af[8][2];
    { const bf16* rp = IDX + (rowb + q0 + fr) * LD_IDX + fq * 8;
#pragma unroll
      for (int h = 0; h < 8; ++h) { Af[h][0] = *(const bf16x8*)(rp + h * 64); Af[h][1] = *(const bf16x8*)(rp + h * 64 + 32); } }
    const float idx_scale = 0.5f * 0.125f * 0.35355339059327373f;
    bf16x8 Aw[2];
    { float wa[8];
      { const v4u wq = *(const v4u*)(IDX + (rowb + q0 + fr) * LD_IDX + 576);
#pragma unroll
        for (int i = 0; i < 4; ++i) { wa[2 * i] = bflo(wq[i]) * idx_scale; wa[2 * i + 1] = bfhi(wq[i]) * idx_scale; } }
#pragma unroll
      for (int ks = 0; ks < 2; ++ks) { float cq[8];
#pragma unroll
          for (int j = 0; j < 8; ++j) cq[j] = 0.f;
#pragma unroll
          for (int h = 0; h < 8; ++h)
#pragma unroll
              for (int j = 0; j < 8; ++j) cq[j] += wa[h] * bf2f((unsigned)(unsigned short)Af[h][ks][j]);
          const v4u t = {pk2(cq[0], cq[1]), pk2(cq[2], cq[3]), pk2(cq[4], cq[5]), pk2(cq[6], cq[7])};
          Aw[ks] = __builtin_bit_cast(bf16x8, t); } }
    float wv[4][8];
#pragma unroll
    for (int r = 0; r < 4; ++r) { const v4u wq = *(const v4u*)(IDX + (rowb + q0 + fq * 4 + r) * LD_IDX + 576);
#pragma unroll
        for (int i = 0; i < 4; ++i) { wv[r][2 * i] = bflo(wq[i]) * idx_scale; wv[r][2 * i + 1] = bfhi(wq[i]) * idx_scale; } }
    const int ntiles = (q0 >> 4) + 1;
    __syncthreads();
    bf16x8 B0 = Aw[0], B1 = Aw[1];
    if (w < ntiles) { const bf16* kp = IDX + (rowb + w * 16 + fr) * LD_IDX + 512 + fq * 8; B0 = *(const bf16x8*)kp; B1 = *(const bf16x8*)(kp + 32); }
    for (int kt = w; kt < ntiles; kt += NWAVES) {
        bf16x8 nB0 = B0, nB1 = B1;
        if (kt + NWAVES < ntiles) { const bf16* kp = IDX + (rowb + (kt + NWAVES) * 16 + fr) * LD_IDX + 512 + fq * 8; nB0 = *(const bf16x8*)kp; nB1 = *(const bf16x8*)(kp + 32); }
        pg8::f32x4 lin = {0.f, 0.f, 0.f, 0.f};
        lin = __builtin_amdgcn_mfma_f32_16x16x32_bf16(Aw[0], B0, lin, 0, 0, 0);
        lin = __builtin_amdgcn_mfma_f32_16x16x32_bf16(Aw[1], B1, lin, 0, 0, 0);
        float I[4] = {lin[0], lin[1], lin[2], lin[3]};
#pragma unroll
        for (int h = 0; h < 8; ++h) { pg8::f32x4 a = {0.f, 0.f, 0.f, 0.f};
            a = __builtin_amdgcn_mfma_f32_16x16x32_bf16(Af[h][0], B0, a, 0, 0, 0);
            a = __builtin_amdgcn_mfma_f32_16x16x32_bf16(Af[h][1], B1, a, 0, 0, 0);
#pragma unroll
            for (int r = 0; r < 4; ++r) I[r] = __builtin_fmaf(wv[r][h], __builtin_fabsf(a[r]), I[r]); }
        const int kidx = kt * 16 + fr;
#pragma unroll
        for (int r = 0; r < 4; ++r) { const unsigned key = f16key(I[r]); Ik[(fq * 4 + r) * 4096 + kidx] = (unsigned short)key;
            if (kidx <= q0 + fq * 4 + r) atomicAdd(&hist1[(fq * 4 + r) * 256 + (key >> 8)], 1u); }
        B0 = nB0; B1 = nB1;
    }
    __syncthreads();
    for (int qq = w; qq < 16; qq += NWAVES) {
        const int t = q0 + qq, n = t + 1;
        unsigned short* so = (unsigned short*)(hist1 + qq * 256);
        const unsigned short* keys = Ik + qq * 4096;
        if (n <= TOPK) { for (int j = lane; j < n; j += 64) so[j] = (unsigned short)j; }
        else {
            int b1, rem1, b2, rem2;
            find_bin(hist1 + qq * 256, TOPK, lane, b1, rem1);
            *(v4u*)(hist + 4 * lane) = (v4u){0u, 0u, 0u, 0u};
            LDS_WAIT(); __builtin_amdgcn_wave_barrier();
            for (int j = lane; j < n; j += 64) { const unsigned k = keys[j]; if ((int)(k >> 8) == b1) atomicAdd(&hist[k & 255u], 1u); }
            LDS_WAIT(); __builtin_amdgcn_wave_barrier();
            find_bin(hist, rem1, lane, b2, rem2);
            const unsigned thr = ((unsigned)b1 << 8) | (unsigned)b2;
            int base = 0, eqtaken = 0;
            const unsigned long long lt = (lane == 0) ? 0ull : (~0ull >> (64 - lane));
            for (int j0 = 0; j0 < n; j0 += 64) {
                const int j = j0 + lane; const bool valid = j < n; const unsigned k = valid ? (unsigned)keys[j] : 0u;
                const bool gt = valid && k > thr, eq = valid && k == thr;
                const unsigned long long meq = __ballot(eq);
                const int erank = __popcll(meq & lt) + eqtaken;
                const bool take = gt || (eq && erank < rem2);
                const unsigned long long mt = __ballot(take);
                if (take) so[base + __popcll(mt & lt)] = (unsigned short)j;
                base += __popcll(mt); eqtaken += __popcll(meq);
            }
        }
    }
    __syncthreads();
}

__device__ __forceinline__ void qknorm_token(const Params& p, int tok, int lane) {
    const bf16* row = (const bf16*)(p.ws + WS_ATT) + (size_t)tok * LD_ATT;
    const int c8 = (lane & 7) * 8;
    { const v4u qv = *(const v4u*)(row + lane * 8);
      float x[8]; float ss = 0.f;
#pragma unroll
      for (int i = 0; i < 4; ++i) { x[2 * i] = bflo(qv[i]); x[2 * i + 1] = bfhi(qv[i]); ss += x[2 * i] * x[2 * i] + x[2 * i + 1] * x[2 * i + 1]; }
      ss += __shfl_xor(ss, 1); ss += __shfl_xor(ss, 2); ss += __shfl_xor(ss, 4);
      const float rs = rsqrtf(ss * (1.f / 64.f) + RMS_EPS) * (0.125f * 1.4426950408889634f);
#pragma unroll
      for (int i = 0; i < 8; ++i) x[i] = x[i] * rs * p.q_norm_g[c8 + i];
      v2u hw, lw;
      hw.x = pk4_fp8(x[0], x[1], x[2], x[3]); hw.y = pk4_fp8(x[4], x[5], x[6], x[7]);
      { const f32x2 d0 = __builtin_amdgcn_cvt_pk_f32_fp8((int)hw.x, false), d1 = __builtin_amdgcn_cvt_pk_f32_fp8((int)hw.x, true), d2 = __builtin_amdgcn_cvt_pk_f32_fp8((int)hw.y, false), d3 = __builtin_amdgcn_cvt_pk_f32_fp8((int)hw.y, true);
        lw.x = pk4_fp8(x[0] - d0[0], x[1] - d0[1], x[2] - d1[0], x[3] - d1[1]); lw.y = pk4_fp8(x[4] - d2[0], x[5] - d2[1], x[6] - d3[0], x[7] - d3[1]); }
      *(v2u*)(p.ws + WS_QHI + (size_t)tok * 512 + lane * 8) = hw; *(v2u*)(p.ws + WS_QLO + (size_t)tok * 512 + lane * 8) = lw; }
    { const v4u kv = *(const v4u*)(row + 512 + (lane & 15) * 8);
      float x[8]; float ss = 0.f;
#pragma unroll
      for (int i = 0; i < 4; ++i) { x[2 * i] = bflo(kv[i]); x[2 * i + 1] = bfhi(kv[i]); ss += x[2 * i] * x[2 * i] + x[2 * i + 1] * x[2 * i + 1]; }
      ss += __shfl_xor(ss, 1); ss += __shfl_xor(ss, 2); ss += __shfl_xor(ss, 4);
      const float rs = rsqrtf(ss * (1.f / 64.f) + RMS_EPS);
#pragma unroll
      for (int i = 0; i < 8; ++i) x[i] = x[i] * rs * p.k_norm_g[c8 + i];
      v2u o; o.x = pk4_fp8(x[0], x[1], x[2], x[3]); o.y = pk4_fp8(x[4], x[5], x[6], x[7]);
      if (lane < 16) *(v2u*)(p.ws + WS_K8 + (size_t)tok * 128 + lane * 8) = o; }
}

typedef short v4i16_t __attribute__((ext_vector_type(4)));
__device__ __forceinline__ v4i16_t vtr16(const bf16* ldsp) { return __builtin_amdgcn_ds_read_tr16_b64_v4i16((LAS v4i16_t*)ldsp); }
__device__ __forceinline__ void dsa2_query(const Params& p, unsigned char* ldsw, const unsigned short* sel, int b, int t, int lane) {
    unsigned char* ws = p.ws;
    const bf16* ATT = (const bf16*)(ws + WS_ATT);
    bf16* YB = (bf16*)(ws + WS_H);
    unsigned short* sl = (unsigned short*)ldsw;
    float* df = (float*)(ldsw + 512);
    bf16* Vl = (bf16*)(ldsw + 1536);
    const int fr = lane & 15, fq = lane >> 4;
    const size_t rowb = (size_t)b * SEQ;
    const int cnt = (t + 1 < TOPK) ? (t + 1) : TOPK;
    { v2u sv = *(const v2u*)(sel + lane * 4);
      const int j0 = lane * 4;
      if (j0 >= cnt) sv.x = 0u; else if (j0 + 1 >= cnt) sv.x &= 0xffffu;
      if (j0 + 2 >= cnt) sv.y = 0u; else if (j0 + 3 >= cnt) sv.y &= 0xffffu;
      *(v2u*)(sl + lane * 4) = sv;
      f32x4 d4; d4[0] = (j0 < cnt) ? (float)(t - (int)(sv.x & 0xffffu)) : INFINITY; d4[1] = (j0 + 1 < cnt) ? (float)(t - (int)(sv.x >> 16)) : INFINITY;
      d4[2] = (j0 + 2 < cnt) ? (float)(t - (int)(sv.y & 0xffffu)) : INFINITY; d4[3] = (j0 + 3 < cnt) ? (float)(t - (int)(sv.y >> 16)) : INFINITY;
      *(f32x4*)(df + lane * 4) = d4; }
    LDS_WAIT(); __builtin_amdgcn_wave_barrier();
    const unsigned char* K8 = ws + WS_K8;
    long qhA[2] = {0, 0}, qhB[2] = {0, 0}, qlA[2] = {0, 0}, qlB[2] = {0, 0};
    if (fr < 8) { const v4u qh = *(const v4u*)(ws + WS_QHI + (rowb + t) * 512 + fr * 64 + fq * 16), ql = *(const v4u*)(ws + WS_QLO + (rowb + t) * 512 + fr * 64 + fq * 16);
        const long hA = (long)(((unsigned long long)qh.y << 32) | qh.x), hB = (long)(((unsigned long long)qh.w << 32) | qh.z), lA = (long)(((unsigned long long)ql.y << 32) | ql.x), lB = (long)(((unsigned long long)ql.w << 32) | ql.z);
        if (fr < 4) { qhA[0] = hA; qhB[0] = hB; qlA[0] = lA; qlB[0] = lB; } else { qhA[1] = hA; qhB[1] = hB; qlA[1] = lA; qlB[1] = lB; } }
    pg8::f32x4 sc[16];
    v4u vv[16];
    { v4u kf[16];
#pragma unroll
      for (int half = 0; half < 2; ++half) {
#pragma unroll
          for (int kt = 0; kt < 8; ++kt) { const int s = sl[(half * 8 + kt) * 16 + fr]; const unsigned char* kp = K8 + (rowb + s) * 128 + fq * 16;
              kf[2 * kt] = *(const v4u*)kp; kf[2 * kt + 1] = *(const v4u*)(kp + 64); }
          if (half == 1) {
#pragma unroll
              for (int i = 0; i < 8; ++i) { const int s = sl[i * 8 + (lane >> 3)]; vv[i] = *(const v4u*)(ATT + (rowb + s) * LD_ATT + 640 + (lane & 7) * 8); } }
          __builtin_amdgcn_sched_barrier(0);
#pragma unroll
          for (int kt = 0; kt < 8; ++kt) { pg8::f32x4 a = {0.f, 0.f, 0.f, 0.f};
#pragma unroll
              for (int gg = 0; gg < 2; ++gg) { const v4u kv = kf[2 * kt + gg];
                  const long kA = (long)(((unsigned long long)kv.y << 32) | kv.x), kB = (long)(((unsigned long long)kv.w << 32) | kv.z);
                  a = __builtin_amdgcn_mfma_f32_16x16x32_fp8_fp8(kA, qhA[gg], a, 0, 0, 0); a = __builtin_amdgcn_mfma_f32_16x16x32_fp8_fp8(kB, qhB[gg], a, 0, 0, 0);
                  a = __builtin_amdgcn_mfma_f32_16x16x32_fp8_fp8(kA, qlA[gg], a, 0, 0, 0); a = __builtin_amdgcn_mfma_f32_16x16x32_fp8_fp8(kB, qlB[gg], a, 0, 0, 0); }
              sc[half * 8 + kt] = a; }
          __builtin_amdgcn_sched_barrier(0);
      } }
    const float slope = exp2f(-(float)((fr & 7) + 1)) * 1.4426950408889634f;
    float m = -INFINITY;
#pragma unroll
    for (int kt = 0; kt < 16; ++kt) { const f32x4 d4 = *(const f32x4*)(df + kt * 16 + fq * 4);
#pragma unroll
        for (int r = 0; r < 4; ++r) { const float x = sc[kt][r] - slope * d4[r]; sc[kt][r] = x; m = fmaxf(m, x); } }
    m = fmaxf(m, __shfl_xor(m, 16)); m = fmaxf(m, __shfl_xor(m, 32));
    float l = 0.f;
#pragma unroll
    for (int kt = 0; kt < 16; ++kt)
#pragma unroll
        for (int r = 0; r < 4; ++r) { const float e = __builtin_amdgcn_exp2f(sc[kt][r] - m); sc[kt][r] = e; l += e; }
    l += __shfl_xor(l, 16); l += __shfl_xor(l, 32);
    const float inv = 1.f / l;
#pragma unroll 1
    for (int g = 0; g < 2; ++g) {
        if (g == 1) {
#pragma unroll
            for (int i = 0; i < 8; ++i) { const int s = sl[i * 8 + (lane >> 3)]; vv[i] = *(const v4u*)(ATT + (rowb + s) * LD_ATT + 640 + 64 + (lane & 7) * 8); } }
#pragma unroll
        for (int i = 8; i < 16; ++i) { const int s = sl[i * 8 + (lane >> 3)]; vv[i] = *(const v4u*)(ATT + (rowb + s) * LD_ATT + 640 + g * 64 + (lane & 7) * 8); }
        pg8::f32x4 o[4];
#pragma unroll
        for (int dt = 0; dt < 4; ++dt) o[dt] = (pg8::f32x4){0.f, 0.f, 0.f, 0.f};
#pragma unroll
        for (int ch = 0; ch < 4; ++ch) {
            LDS_WAIT(); __builtin_amdgcn_wave_barrier();
#pragma unroll
            for (int i = 0; i < 8; ++i) *(v4u*)(Vl + (i * 8 + (lane >> 3)) * 80 + (lane & 7) * 8) = vv[(ch & 1) * 8 + i];
            if (ch < 2) {
#pragma unroll
                for (int i = 0; i < 8; ++i) { const int s = sl[((ch + 2) * 8 + i) * 8 + (lane >> 3)]; vv[(ch & 1) * 8 + i] = *(const v4u*)(ATT + (rowb + s) * LD_ATT + 640 + g * 64 + (lane & 7) * 8); } }
            LDS_WAIT(); __builtin_amdgcn_wave_barrier();
#pragma unroll
            for (int k2 = 0; k2 < 2; ++k2) { const int kt0 = ch * 4 + 2 * k2;
                v4u pw; pw.x = pk2(sc[kt0][0], sc[kt0][1]); pw.y = pk2(sc[kt0][2], sc[kt0][3]); pw.z = pk2(sc[kt0 + 1][0], sc[kt0 + 1][1]); pw.w = pk2(sc[kt0 + 1][2], sc[kt0 + 1][3]);
                const bf16x8 pb = __builtin_bit_cast(bf16x8, pw);
#pragma unroll
                for (int dt = 0; dt < 4; ++dt) { const bf16* vp = Vl + ((2 * k2) * 16 + fq * 4 + (fr >> 2)) * 80 + dt * 16 + (fr & 3) * 4;
                    const v4i16_t lo = vtr16(vp), hi = vtr16(vp + 16 * 80);
                    const bf16x8 af = {lo[0], lo[1], lo[2], lo[3], hi[0], hi[1], hi[2], hi[3]};
                    o[dt] = __builtin_amdgcn_mfma_f32_16x16x32_bf16(af, pb, o[dt], 0, 0, 0); } }
        }
        if (fr < 8 && (fr >> 2) == g) {
#pragma unroll
            for (int dt = 0; dt < 4; ++dt) { const float i8 = inv * 8.f;
                *(unsigned*)((unsigned char*)YB + (rowb + t) * 1024 + 512 + fr * 64 + dt * 16 + fq * 4) = pk4_fp8(o[dt][0] * i8, o[dt][1] * i8, o[dt][2] * i8, o[dt][3] * i8); } }
    }
    LDS_WAIT(); __builtin_amdgcn_wave_barrier();
}

#define INS16(L, x) do { _Pragma("unroll") for (int _i = 15; _i >= 1; --_i) L[_i] = __builtin_amdgcn_fmed3f(L[_i - 1], L[_i], (x)); L[0] = fmaxf(L[0], (x)); } while (0)
__device__ __forceinline__ float f_andor(float v, unsigned keepmask, unsigned orv) { return __builtin_bit_cast(float, (__builtin_bit_cast(unsigned, v) & keepmask) | orv); }
__device__ __forceinline__ void peer_route_item(const Params& p, unsigned char* ldsw, int tg, int h, int lane, int* EIDX, float* GATES) {
    unsigned char* ws = p.ws;
    const bf16* Q = (const bf16*)(ws + WS_Q);
    const bf16* SK = (const bf16*)(ws + WS_SK);
    float* sc = (float*)ldsw;
    const int fr = lane & 15, fq = lane >> 4;
#pragma unroll 1
    for (int pp = 0; pp < 2; ++pp) {
        bf16x8 Af[4], Bf[32];
        { const bf16* rp = Q + (size_t)(tg * 16 + fr) * 2048 + h * 256 + pp * 128 + fq * 8;
#pragma unroll
          for (int ks = 0; ks < 4; ++ks) Af[ks] = *(const bf16x8*)(rp + ks * 32); }
#pragma unroll
        for (int kt = 0; kt < 8; ++kt) { const bf16* kp = SK + (size_t)((h * 2 + pp) * 128 + kt * 16 + fr) * 128 + fq * 8;
#pragma unroll
            for (int ks = 0; ks < 4; ++ks) Bf[kt * 4 + ks] = *(const bf16x8*)(kp + ks * 32); }
        __builtin_amdgcn_sched_barrier(0);
#pragma unroll
        for (int kt = 0; kt < 8; ++kt) {
            pg8::f32x4 a = {0.f, 0.f, 0.f, 0.f};
#pragma unroll
            for (int ks = 0; ks < 4; ++ks) a = __builtin_amdgcn_mfma_f32_16x16x32_bf16(Af[ks], Bf[kt * 4 + ks], a, 0, 0, 0);
#pragma unroll
            for (int r = 0; r < 4; ++r) sc[(pp * 16 + fq * 4 + r) * 132 + kt * 16 + fr] = f_andor(a[r], ~127u, (unsigned)(kt * 16 + fr));
        }
    }
    LDS_WAIT(); __builtin_amdgcn_wave_barrier();
    float L[16];
#pragma unroll
    for (int i = 0; i < 16; ++i) L[i] = -INFINITY;
    { const float* sp = sc + (lane & 31) * 132 + (lane >> 5) * 64;
#pragma unroll 4
      for (int i = 0; i < 16; ++i) { const f32x4 x = *(const f32x4*)(sp + 4 * i); INS16(L, x[0]); INS16(L, x[1]); INS16(L, x[2]); INS16(L, x[3]); } }
    { float O[16];
#pragma unroll
      for (int i = 0; i < 16; ++i) O[i] = __shfl_xor(L[i], 32);
#pragma unroll
      for (int i = 0; i < 16; ++i) INS16(L, O[i]); }
    LDS_WAIT(); __builtin_amdgcn_wave_barrier();
    float* lst = sc;
    if (lane < 32) {
#pragma unroll
        for (int i = 0; i < 4; ++i) *(f32x4*)(lst + lane * 16 + 4 * i) = (f32x4){L[4 * i], L[4 * i + 1], L[4 * i + 2], L[4 * i + 3]}; }
    LDS_WAIT(); __builtin_amdgcn_wave_barrier();
    const int tok = lane & 15;
    float s1[16], s2[16];
#pragma unroll
    for (int i = 0; i < 4; ++i) { const f32x4 a = *(const f32x4*)(lst + tok * 16 + 4 * i), b = *(const f32x4*)(lst + (16 + tok) * 16 + 4 * i);
#pragma unroll
        for (int c = 0; c < 4; ++c) { s1[4 * i + c] = f_andor(a[c], ~127u, 0u); s2[4 * i + c] = f_andor(b[c], ~127u, 0u); } }
    float M[16];
#pragma unroll
    for (int i = 0; i < 16; ++i) M[i] = -INFINITY;
#pragma unroll
    for (int a = 0; a < 16; ++a)
#pragma unroll
        for (int b = 0; b < 16; ++b)
            if ((a + 1) * (b + 1) <= 16) { const float key = f_andor(s1[a] + s2[b], ~255u, (unsigned)(a * 16 + b)); INS16(M, key); }
    const float mx = f_andor(M[0], ~255u, 0u);
    float e[16], sum = 0.f; int ei[16];
    const unsigned* lb = (const unsigned*)lst;
#pragma unroll
    for (int i = 0; i < 16; ++i) { const unsigned bits = __builtin_bit_cast(unsigned, M[i]); const int flat = bits & 255u;
        e[i] = __expf(f_andor(M[i], ~255u, 0u) - mx); sum += e[i];
        ei[i] = (int)(lb[tok * 16 + (flat >> 4)] & 127u) * 128 + (int)(lb[(16 + tok) * 16 + (flat & 15)] & 127u); }
    const float inv = 1.f / sum;
    if (lane < 16) {
        const size_t ob = ((size_t)tok * 8 + h) * 16;
#pragma unroll
        for (int i = 0; i < 4; ++i) { *(v4u*)(EIDX + ob + 4 * i) = (v4u){(unsigned)ei[4 * i], (unsigned)ei[4 * i + 1], (unsigned)ei[4 * i + 2], (unsigned)ei[4 * i + 3]};
            *(f32x4*)(GATES + ob + 4 * i) = (f32x4){e[4 * i] * inv, e[4 * i + 1] * inv, e[4 * i + 2] * inv, e[4 * i + 3] * inv}; }
    }
    LDS_WAIT(); __builtin_amdgcn_wave_barrier();
}

__device__ __forceinline__ float gelu_erf(float x) { return 0.5f * x * (1.f + erff(x * 0.70710678118654752f)); }
typedef int v8i_t __attribute__((ext_vector_type(8)));
template <int OPSEL> __device__ __forceinline__ pg8::f32x4 mx_dot(v8i_t a, int sa, v8i_t b, int sb, pg8::f32x4 c) {
    return __builtin_amdgcn_mfma_scale_f32_16x16x128_f8f6f4(a, b, c, 4  , 4  , OPSEL, sa, OPSEL, sb);
}
__device__ __forceinline__ void peer_token(const Params& p, unsigned char* ldsw, const _Float16* usL, const _Float16* vsL, unsigned char* tile, int tok, int lane, const v2u nxt_e, const v2u nxt_g, int buf) {
    unsigned char* ws = p.ws;
    const unsigned char* V8 = ws + WS_V;
    const float* MOD = (const float*)(ws + WS_MOD);
    const int fr = lane & 15, fq = lane >> 4;
    typedef v8i_t v8i;
    const int* EIDX = (const int*)(ldsw + buf * 1024); const float* GATES = (const float*)(ldsw + buf * 1024 + 512);
    v4u A4[H4_NT][8]; v2u As[H4_NT];
#pragma unroll
    for (int t = 0; t < H4_NT; ++t) { const unsigned char* hp = ws + WS_H4D + ((size_t)tok * H4_NT + t) * 512 + fq * 16;
        As[t] = *(const v2u*)(ws + WS_H4S + ((size_t)tok * H4_NT + t) * 32 + fq * 8);
#pragma unroll
        for (int kk = 0; kk < 8; ++kk) A4[t][kk] = *(const v4u*)(hp + kk * 64); }
    int* pe = (int*)(ldsw + 2048); float* pa = (float*)(ldsw + 2048 + 512);
    const unsigned char* U4 = ws + WS_U;
    const int gr = lane >> 3, gs = lane & 7;
    const int rdbase = (fr >> 3) * 1024 + (fr & 7) * 128, slotA = (fq ^ (fr & 7) ^ (fr >> 3)) & 7;
    v4u G[8];
#define U_LOADS(CT) do { const int e0_ = EIDX[(CT) * 16 + gr], e1_ = EIDX[(CT) * 16 + 8 + gr]; \
        const unsigned char* p0_ = U4 + (size_t)e0_ * 512 + ((gs ^ gr) & 7) * 16; const unsigned char* p1_ = U4 + (size_t)e1_ * 512 + ((gs ^ gr ^ 1) & 7) * 16; \
        _Pragma("unroll") for (int kk = 0; kk < 8; ++kk) G[kk] = *(const v4u*)(((kk & 1) ? p1_ : p0_) + (kk >> 1) * 128); } while (0)
    U_LOADS(0);
#pragma unroll 1
    for (int ct = 0; ct < 8; ++ct) {
        const int eic = EIDX[ct * 16 + fr]; const float gt = GATES[ct * 16 + fr];
#pragma unroll
        for (int kk = 0; kk < 8; ++kk) *(v4u*)(tile + kk * 1024 + lane * 16) = G[kk];
        __builtin_amdgcn_sched_barrier(0);
        U_LOADS((ct + 1) & 7);
        __builtin_amdgcn_sched_barrier(0);
        LDS_WAIT(); __builtin_amdgcn_wave_barrier();
        v4u Bt[8];
#pragma unroll
        for (int j = 0; j < 8; ++j) Bt[j] = *(const v4u*)(tile + (j >> 1) * 2048 + rdbase + (((j & 1) ? (slotA ^ 4) : slotA) * 16));
        LDS_WAIT(); __builtin_amdgcn_wave_barrier();
        pg8::f32x4 ah = {0.f, 0.f, 0.f, 0.f};
#pragma unroll
        for (int kk = 0; kk < 8; ++kk) { const v4u bu = Bt[kk];
            const v8i bb = {(int)bu.x, (int)bu.y, (int)bu.z, (int)bu.w, 0, 0, 0, 0};
            const int sb = 0x7f7f7f7f;
#pragma unroll
            for (int t = 0; t < H4_NT; ++t) { const v8i aa = {(int)A4[t][kk].x, (int)A4[t][kk].y, (int)A4[t][kk].z, (int)A4[t][kk].w, 0, 0, 0, 0}; const int sa = (int)((kk < 4) ? As[t].x : As[t].y);
                if ((kk & 3) == 0) ah = mx_dot<0>(aa, sa, bb, sb, ah); else if ((kk & 3) == 1) ah = mx_dot<1>(aa, sa, bb, sb, ah); else if ((kk & 3) == 2) ah = mx_dot<2>(aa, sa, bb, sb, ah); else ah = mx_dot<3>(aa, sa, bb, sb, ah); } }
        const float dot = ah[0] * (float)usL[eic];
        if (fq == 0) { pe[ct * 16 + fr] = eic; pa[ct * 16 + fr] = gelu_erf(dot) * gt * (float)vsL[eic]; }
    }
    asm volatile("" :: "v"(G[0]), "v"(G[1]), "v"(G[2]), "v"(G[3]), "v"(G[4]), "v"(G[5]), "v"(G[6]), "v"(G[7]));
#undef U_LOADS
    __builtin_amdgcn_sched_barrier(0);
    { int* ne = (int*)(ldsw + (buf ^ 1) * 1024); float* ng = (float*)(ldsw + (buf ^ 1) * 1024 + 512);
      *(v2u*)(ne + 2 * lane) = nxt_e; *(v2u*)(ng + 2 * lane) = nxt_g; }
    const int hl = lane >> 5, bl = lane & 31;
    float acc[32];
#pragma unroll
    for (int i = 0; i < 32; ++i) acc[i] = 0.f;
    LDS_WAIT(); __builtin_amdgcn_wave_barrier();
#pragma unroll 1
    for (int ct = 0; ct < 16; ++ct)
#pragma unroll
        for (int jp = 0; jp < 4; ++jp) {
            const int idx = pe[ct * 8 + 2 * jp + hl]; const float as = pa[ct * 8 + 2 * jp + hl];
            const v4u vv = *(const v4u*)(V8 + (size_t)idx * 512 + bl * 16);
#pragma unroll
            for (int w4 = 0; w4 < 4; ++w4) { const unsigned wd = vv[w4];
                const f32x2 d0 = __builtin_amdgcn_cvt_scalef32_pk_f32_fp4(wd, 1.0f, 0), d1 = __builtin_amdgcn_cvt_scalef32_pk_f32_fp4(wd, 1.0f, 1), d2 = __builtin_amdgcn_cvt_scalef32_pk_f32_fp4(wd, 1.0f, 2), d3 = __builtin_amdgcn_cvt_scalef32_pk_f32_fp4(wd, 1.0f, 3);
                acc[8 * w4] += as * d0[0]; acc[8 * w4 + 1] += as * d0[1]; acc[8 * w4 + 2] += as * d1[0]; acc[8 * w4 + 3] += as * d1[1];
                acc[8 * w4 + 4] += as * d2[0]; acc[8 * w4 + 5] += as * d2[1]; acc[8 * w4 + 6] += as * d3[0]; acc[8 * w4 + 7] += as * d3[1]; }
        }
    LDS_WAIT(); __builtin_amdgcn_wave_barrier();
    float accs[16];
#pragma unroll
    for (int i = 0; i < 16; ++i) { const float lo = acc[i] + __shfl_xor(acc[i], 32), hi2 = acc[16 + i] + __shfl_xor(acc[16 + i], 32); accs[i] = hl ? hi2 : lo; }
    const int b = tok / SEQ;
    const int col0 = bl * 32 + hl * 16;
    const float* g2 = MOD + (size_t)b * 6144 + 5 * 1024 + col0;
    float* orow = p.out + (size_t)tok * DM + col0;
#pragma unroll
    for (int q4 = 0; q4 < 4; ++q4) { const f32x4 xv = *(const f32x4*)(orow + 4 * q4), gv = *(const f32x4*)(g2 + 4 * q4);
        f32x4 o;
#pragma unroll
        for (int i = 0; i < 4; ++i) o[i] = xv[i] + gv[i] * accs[4 * q4 + i];
        *(f32x4*)(orow + 4 * q4) = o; }
}

#define XB_TMO      128
#define XB_XCNT(j)  (256  + 64 * (j))
#define XB_XSUB(j)  (1280 + 64 * (j))
#define XB_XGEN(j)  (2304 + 64 * (j))
#define XB_TOP      3328
#define XB_TOPGEN   3392
#define XCD_BAR_WORDS 3456
#define XB_SPIN_CAP (1u << 18)

__device__ __forceinline__ unsigned xb_ld(unsigned* p)              { return __hip_atomic_load(p, __ATOMIC_RELAXED, __HIP_MEMORY_SCOPE_AGENT); }
__device__ __forceinline__ unsigned xb_add(unsigned* p, unsigned v) { return __hip_atomic_fetch_add(p, v, __ATOMIC_RELAXED, __HIP_MEMORY_SCOPE_AGENT); }
__device__ __forceinline__ unsigned xb_xcc_id() { return (unsigned)__builtin_amdgcn_s_getreg((3 << 11) | 20) & 0xFu; }
#define XB_SPIN(cond, bar) do { unsigned _sp = 0; while (cond) { __builtin_amdgcn_s_sleep(1); \
    if ((++_sp & 255u) == 0u) { if (xb_ld(&(bar)[XB_TMO])) break; if (_sp > XB_SPIN_CAP) { atomicAdd(&(bar)[XB_TMO], 1u); break; } } } } while (0)

struct XcdBarrier {
    unsigned* bar; unsigned x;
    volatile LAS unsigned* st;
};

__device__ __forceinline__ XcdBarrier xcd_barrier_post(unsigned* bar, volatile LAS unsigned* st) {
    XcdBarrier b; b.bar = bar; b.x = xb_xcc_id(); b.st = st;
    if (threadIdx.x == 0) (void)xb_add(&bar[XB_XCNT(b.x)], 1u);
    return b;
}
__device__ __forceinline__ void xcd_barrier_complete(unsigned* bar, unsigned x, unsigned& nloc, unsigned& nx) {
    const unsigned G = gridDim.x * gridDim.y * gridDim.z;
    unsigned sum, cnt, mine, sp = 0u;
    for (;;) {
        sum = 0u; cnt = 0u; mine = 0u;
#pragma unroll
        for (unsigned j = 0; j < 16; ++j) { const unsigned c = xb_ld(&bar[XB_XCNT(j)]); sum += c; cnt += (c > 0u) ? 1u : 0u; mine = (j == x) ? c : mine; }
        if (sum == G) break;
        __builtin_amdgcn_s_sleep(1);
        if ((++sp & 255u) == 0u) { if (xb_ld(&bar[XB_TMO])) break; if (sp > XB_SPIN_CAP) { atomicAdd(&bar[XB_TMO], 1u); break; } }
    }
    nloc = mine > 0u ? mine : 1u; nx = cnt > 0u ? cnt : 1u;
}

__device__ __forceinline__ void xcd_barrier(const XcdBarrier& b) {
    asm volatile("s_waitcnt vmcnt(0)" ::: "memory");
    __syncthreads();
    if (threadIdx.x == 0) {
        unsigned* bar = b.bar;
        __builtin_amdgcn_s_waitcnt(0);
        unsigned nloc = b.st[0], nx = b.st[1];
        if (nloc == 0u) { xcd_barrier_complete(bar, b.x, nloc, nx); b.st[0] = nloc; b.st[1] = nx; }
        const unsigned old = xb_add(&bar[XB_XSUB(b.x)], 1u);
        const unsigned gen = old / nloc;
        if (old + 1u == (gen + 1u) * nloc) {
            __builtin_amdgcn_fence(__ATOMIC_RELEASE, "agent");
            asm volatile("s_waitcnt vmcnt(0)" ::: "memory");
            const unsigned og = xb_add(&bar[XB_TOP], 1u);
            const unsigned tg = og / nx;
            if (og + 1u == (tg + 1u) * nx) xb_add(&bar[XB_TOPGEN], 1u);
            else XB_SPIN(xb_ld(&bar[XB_TOPGEN]) == tg, bar);
            __builtin_amdgcn_fence(__ATOMIC_ACQUIRE, "agent");
            xb_add(&bar[XB_XGEN(b.x)], 1u);
            asm volatile("s_waitcnt vmcnt(0)" ::: "memory");
        } else {
            XB_SPIN(xb_ld(&bar[XB_XGEN(b.x)]) == gen, bar);
            __builtin_amdgcn_fence(__ATOMIC_ACQUIRE, "agent");
            asm volatile("s_waitcnt vmcnt(0)" ::: "memory");
        }
    }
    __syncthreads();
}

constexpr int NPHASE = 11;
__global__ void __launch_bounds__(NTHREADS, 2) mega(Params p) {
    extern __shared__ __attribute__((aligned(16))) unsigned char lds[];
    cg::grid_group grid = cg::this_grid();
    const int lo = p.ph_lo, hi = p.ph_hi;
    const int tid = threadIdx.x, wave = tid >> 6, lane = tid & 63, G = gridDim.x;
    unsigned char* ws = p.ws;
#ifndef ONLYPH
#define IN(k) (lo <= (k) && (k) < hi)
#else
#define IN(k) ((k) == ONLYPH && lo <= (k) && (k) < hi)
#endif
    volatile LAS unsigned* xb_st = (volatile LAS unsigned*)((LAS unsigned char*)lds + (LDS_BYTES - 16));
    if (tid < 4) xb_st[tid] = 0u;
    __syncthreads();
    XcdBarrier xbar; xbar.bar = (unsigned*)(ws + WS_CTL); xbar.x = 0; xbar.st = xb_st;
    if (hi - lo > 1) xbar = xcd_barrier_post((unsigned*)(ws + WS_CTL), xb_st);
    if (lo < -1) grid.sync();
#define SEAM(k) do { if (IN((k) + 1)) xcd_barrier(xbar); } while (0)
#ifndef REPMASK
#define REPMASK 0
#endif
#define NREP(k) (((REPMASK >> (k)) & 1) ? 2 : 1)
    if (IN(0)) { for (int rep = 0; rep < NREP(0); ++rep) phase0(p, lds); SEAM(0); }
    if (IN(1)) { for (int rep = 0; rep < NREP(1); ++rep) normmod_phase<true>(p, lds, p.x, (bf16*)(ws + WS_H), p.norm1_g, 0, 1024); SEAM(1); }
    if (IN(2)) {
        { pg8::Gemm g{(const bf16*)(ws + WS_H8), (const bf16*)(ws + WS_WIN8), T, 3584, 512, 512, 512}; pg8::StaticOrder S; S.init(T, 3584, G, (int)blockIdx.x);
          EpiProj E{(bf16*)(ws + WS_HG), (bf16*)(ws + WS_ATT), (bf16*)(ws + WS_IDX), (bf16*)(ws + WS_GATE), 1};
          pg8::gemm_phase<EpiProj, pg8::StaticOrder, true, true, 122>((PG8_LAS unsigned char*)lds, g, S, E); }
        { pg8::Gemm g{(const bf16*)(ws + WS_H), (const bf16*)(ws + WS_WIN), T, 2048, 1024, 1024, 1024}; pg8::StaticOrder S; S.init(T, 2048, G, (int)blockIdx.x);
          EpiProj E{(bf16*)(ws + WS_HG), (bf16*)(ws + WS_ATT), (bf16*)(ws + WS_IDX), (bf16*)(ws + WS_GATE), 0};
          pg8::gemm_phase<EpiProj, pg8::StaticOrder, true, true>((PG8_LAS unsigned char*)lds, g, S, E); }
        SEAM(2);
    }
    if (IN(3)) {
        for (int tok = (int)blockIdx.x * NWAVES + wave; tok < T; tok += G * NWAVES) qknorm_token(p, tok, lane);
        SEAM(3);
    }
    if (IN(4)) {
        if ((int)blockIdx.x < 32) hgrn_item<0>(p, lds, (int)blockIdx.x); else if ((int)blockIdx.x < 64) hgrn_item<1>(p, lds, (int)blockIdx.x - 32);
        {
            unsigned* qctr = (unsigned*)(ws + WS_CTL + 32768);
            volatile LAS unsigned* qslot = (volatile LAS unsigned*)((LAS unsigned char*)lds + (LDS_BYTES - 32));
            int qsel = (int)(blockIdx.x & 7u), tried = 0;
            for (;;) {
                if (tid == 0) { unsigned c;
                    for (;;) { c = __hip_atomic_fetch_add(qctr + qsel * 64, 1u, __ATOMIC_RELAXED, __HIP_MEMORY_SCOPE_AGENT); if (c < (unsigned)(SEQ / 16) || tried >= 7) break; qsel = (qsel + 1) & 7; ++tried; }
                    *qslot = (c < (unsigned)(SEQ / 16)) ? (((unsigned)qsel << 16) | c) : 0xffffffffu; }
                __syncthreads();
                const unsigned c = *qslot;
                __syncthreads();
                if (c == 0xffffffffu) break;
                const int b = (int)(c >> 16), qblk = (SEQ / 16 - 1) - (int)(c & 0xffffu), it = b * (SEQ / 16) + qblk, q0 = qblk * 16;
                dsa1_item(p, lds, it);
#pragma unroll 1
                for (int k2 = 0; k2 < 2; ++k2) dsa2_query(p, lds + wave * 16384, (const unsigned short*)(lds + 131072 + (wave + 8 * k2) * 1024), b, q0 + wave + 8 * k2, lane);
                __syncthreads();
            }
        }
        if (hi - lo > 1) xcd_barrier(xbar);
        for (int u = blockIdx.x; u < 32 * 32; u += G) hgrn_fix(p, lds, u >> 5, u & 31);
        SEAM(4);
    }
    if (IN(5)) {
        pg8::Gemm g{(const bf16*)(ws + WS_H), (const bf16*)(ws + WS_WAB8), T, 1024, 256, 512, 512}; pg8::StaticOrderT<true> S; S.init(T, 1024, G, (int)blockIdx.x, 256);
        EpiMerged E{(const bf16*)(ws + WS_GATE), (bf16*)(ws + WS_MERGED)};
        for (int rep = 0; rep < NREP(5); ++rep) pg8::gemm_phase<EpiMerged, pg8::StaticOrderT<true>, true, true, 122>((PG8_LAS unsigned char*)lds, g, S, E);
        SEAM(5);
    }
    if (IN(6)) {
        pg8::Gemm g{(const bf16*)(ws + WS_MERGED), (const bf16*)(ws + WS_WOUT8), T, 1024, 512, 512, 512}; pg8::StaticOrder S; S.init(T, 1024, G, (int)blockIdx.x);
        EpiResid E{p.x, (const float*)(ws + WS_MOD) + 2048, p.out};
        for (int rep = 0; rep < NREP(6); ++rep) pg8::gemm_phase<EpiResid, pg8::StaticOrder, true, true, 120>((PG8_LAS unsigned char*)lds, g, S, E);
        SEAM(6);
    }
    if (IN(7)) { for (int rep = 0; rep < NREP(7); ++rep) normmod_phase<false>(p, lds, p.out, (bf16*)(ws + WS_H), p.norm2_g, 3 * 1024, 4 * 1024); SEAM(7); }
    if (IN(8)) {
        pg8::Gemm g{(const bf16*)(ws + WS_H), (const bf16*)(ws + WS_WQ), T, 2048, 1024, 1024, 1024}; pg8::StaticOrder S; S.init(T, 2048, G, (int)blockIdx.x);
        EpiStore E{(bf16*)(ws + WS_Q), 2048};
        for (int rep = 0; rep < NREP(8); ++rep) pg8::gemm_phase<EpiStore, pg8::StaticOrder, true, true>((PG8_LAS unsigned char*)lds, g, S, E);
        SEAM(8);
    }
    if (IN(9)) {
        int* eG = (int*)(ws + WS_EIDX); float* gG = (float*)(ws + WS_PGATE);
        for (int tg = blockIdx.x; tg < T / 16; tg += G) peer_route_item(p, lds + wave * 16896, tg, wave, lane, eG + (size_t)tg * 2048, gG + (size_t)tg * 2048);
        asm volatile("s_waitcnt vmcnt(0)" ::: "memory");
        __syncthreads();
        _Float16* usL = (_Float16*)lds; _Float16* vsL = (_Float16*)(lds + 32768);
        for (int i = tid; i < NEXP / 8; i += NTHREADS) { ((v4u*)usL)[i] = ((const v4u*)(ws + WS_US))[i]; ((v4u*)vsL)[i] = ((const v4u*)(ws + WS_VS))[i]; }
        unsigned char* ldsw = lds + 65536 + wave * 3072;
        int ntok = 0;
        for (int tg = blockIdx.x; tg < T / 16; tg += G) ntok += 2;
        auto tok_of = [&](int j) { return ((int)blockIdx.x + (j >> 1) * G) * 16 + wave + 8 * (j & 1); };
        auto ld_lists = [&](int tok, v2u& e, v2u& g) {
            const unsigned* ep = (const unsigned*)(eG + (size_t)tok * 128 + 2 * lane); const unsigned* gp = (const unsigned*)(gG + (size_t)tok * 128 + 2 * lane);
            e.x = __hip_atomic_load(ep, __ATOMIC_RELAXED, __HIP_MEMORY_SCOPE_AGENT); e.y = __hip_atomic_load(ep + 1, __ATOMIC_RELAXED, __HIP_MEMORY_SCOPE_AGENT);
            g.x = __hip_atomic_load(gp, __ATOMIC_RELAXED, __HIP_MEMORY_SCOPE_AGENT); g.y = __hip_atomic_load(gp + 1, __ATOMIC_RELAXED, __HIP_MEMORY_SCOPE_AGENT); };
        if (ntok > 0) { v2u e0, g0; ld_lists(tok_of(0), e0, g0); *(v2u*)((int*)ldsw + 2 * lane) = e0; *(v2u*)((float*)(ldsw + 512) + 2 * lane) = g0; }
        __syncthreads();
#pragma unroll 1
        for (int j = 0; j < ntok; ++j) {
            v2u ne = {0u, 0u}, ng = {0u, 0u};
            if (j + 1 < ntok) ld_lists(tok_of(j + 1), ne, ng);
            peer_token(p, ldsw, usL, vsL, lds + 90112 + wave * 8192, tok_of(j), lane, ne, ng, j & 1);
            LDS_WAIT(); __builtin_amdgcn_wave_barrier();
        }
    }
#undef IN
#undef SEAM
}

#ifndef ONE_LAUNCH
#define ONE_LAUNCH 1
#endif
extern "C" void kernel_launch(void* const* d_in, const int* in_sizes, int n_in, void* d_out, int out_size, void* d_ws, size_t ws_size, hipStream_t stream) {
    static int grid = 0;
    if (grid == 0) {
        if (n_in != 18 || out_size != T * DM || ws_size < WS_END) { fprintf(stderr, "kernel_launch: unexpected shapes (n_in %d, out %d, ws %zu)\n", n_in, out_size, ws_size); grid = -1; return; }
        int dev = 0, cus = 0, per_cu = 0;
        if (hipGetDevice(&dev) != hipSuccess || hipDeviceGetAttribute(&cus, hipDeviceAttributeMultiprocessorCount, dev) != hipSuccess) { grid = -1; return; }
        if (hipFuncSetAttribute((const void*)mega, hipFuncAttributeMaxDynamicSharedMemorySize, LDS_BYTES) != hipSuccess) { fprintf(stderr, "kernel_launch: hipFuncSetAttribute failed\n"); grid = -1; return; }
        if (hipOccupancyMaxActiveBlocksPerMultiprocessor(&per_cu, (const void*)mega, NTHREADS, LDS_BYTES) != hipSuccess || per_cu < 1) { fprintf(stderr, "kernel_launch: occupancy query says %d\n", per_cu); grid = -1; return; }
        (void)hipGetLastError();
        grid = cus;
        if (grid < 64) { grid = -1; return; }
    }
    if (grid < 0) return;
    Params p{};
    const float** pp = (const float**)&p;
    for (int i = 0; i < 18; ++i) pp[i] = (const float*)d_in[i];
    p.out = (float*)d_out; p.ws = (unsigned char*)d_ws;
#if ONE_LAUNCH
    if (hipMemsetAsync((char*)d_ws + WS_CTL, 0, 65536, stream) != hipSuccess) { fprintf(stderr, "kernel_launch: memset failed\n"); return; }
    p.ph_lo = 0; p.ph_hi = NPHASE;
    void* args[] = {&p};
    hipError_t e = hipLaunchCooperativeKernel((const void*)mega, dim3(grid), dim3(NTHREADS), args, LDS_BYTES, stream);
    if (e != hipSuccess) fprintf(stderr, "cooperative launch failed: %s (grid %d)\n", hipGetErrorString(e), grid);
#else
    for (int k = 0; k < NPHASE; ++k) { p.ph_lo = k; p.ph_hi = k + 1; hipLaunchKernelGGL(mega, dim3(grid), dim3(NTHREADS), LDS_BYTES, stream, p); }
#endif
}
```

```cpp
#include <hip/hip_runtime.h>
#include <hip/hip_cooperative_groups.h>
#include <cstdio>
#include <cstdint>
namespace cg = cooperative_groups;

namespace pg8 {
#define PG8_LAS __attribute__((address_space(3)))
typedef unsigned short bf16_t;
typedef short bf16x8 __attribute__((ext_vector_type(8)));
typedef float f32x4 __attribute__((ext_vector_type(4)));
typedef unsigned u32x4 __attribute__((ext_vector_type(4)));
constexpr int BM = 256, BK = 64, HALF = 128, HTB = HALF * BK * 2  , STAGE_BYTES = 8 * HTB, NXCD = 8, WGM = 8;

__host__ __device__ __forceinline__ int lds_byte(int r, int c) { const int st = (r >> 4) * 2 + (c >> 5), rr = r & 15, cc = c & 31, ob = rr * 64 + cc * 2; return st * 1024 + (ob ^ (((ob >> 9) & 1) << 5)); }
__host__ __device__ __forceinline__ void stage_rc(int b, int& R, int& C) { const int st = b / 1024, sb = b % 1024, swz = sb ^ (((sb >> 9) & 1) << 5); R = (st >> 1) * 16 + swz / 64; C = (st & 1) * 32 + (swz % 64) / 2; }
__host__ __device__ __forceinline__ int perm32(int rho) { const int n = rho >> 4, i = rho & 15; return 8 * (i >> 2) + 4 * n + (i & 3); }

struct Unit { int pm, pn, ko, pass; };
struct Gemm { const bf16_t* A; const bf16_t* Bt; int M, N, K, lda, ldb; };
typedef float f32x16 __attribute__((ext_vector_type(16)));
typedef f32x16 AccW[2][2][2];
__device__ __forceinline__ f32x4 acc_get(const AccW& A, int ai, int bj, int m, int n) { const int s_ = ((m & 1) * 2 + n) * 4; const f32x16& w = A[ai][bj][m >> 1]; return (f32x4){w[s_], w[s_ + 1], w[s_ + 2], w[s_ + 3]}; }
__device__ __forceinline__ void acc_set(AccW& A, int ai, int bj, int m, int n, f32x4 v) { const int s_ = ((m & 1) * 2 + n) * 4; f32x16& w = A[ai][bj][m >> 1]; w[s_] = v[0]; w[s_ + 1] = v[1]; w[s_ + 2] = v[2]; w[s_ + 3] = v[3]; }

template <bool TWOPASS_ORDER = false>
struct StaticOrderT {
    int nM, nN, nwg, G, c, kpass;
    __host__ __device__ void init(int M, int N, int G_, int c_, int kpass_ = 512) { nM = M / BM; nN = N / BM; nwg = nM * nN; G = G_; c = c_; kpass = kpass_; }
    __host__ __device__ bool next(int i, Unit& u) const {
        const long L = (long)(TWOPASS_ORDER ? (i >> 1) : i) * G + c; if (L >= nwg) return false;
        u.pass = TWOPASS_ORDER ? (i & 1) : 0; u.ko = TWOPASS_ORDER ? (i & 1) * kpass : 0;
        int wgid = (int)L; { const int q = nwg / NXCD, r = nwg % NXCD, xcd = wgid % NXCD, off = wgid / NXCD; wgid = (xcd < r ? xcd * (q + 1) : r * (q + 1) + (xcd - r) * q) + off; }
        const int nig = WGM * nN, gid = wgid / nig, fm = gid * WGM, gsz = (nM - fm) < WGM ? (nM - fm) : WGM;
        u.pm = fm + ((wgid % nig) % gsz); u.pn = (wgid % nig) / gsz; return true;
    }
    __device__ __forceinline__ void a_ready(const Unit&) const {}
    __device__ __forceinline__ void done(const Unit&) const {}
};
typedef StaticOrderT<false> StaticOrder;

__device__ __forceinline__ unsigned cvt_pk_bf16(float lo, float hi) { unsigned r; asm volatile("v_cvt_pk_bf16_f32 %0, %1, %2" : "=v"(r) : "v"(lo), "v"(hi)); return r; }

template <class Epi, class Sched, bool ALIGN_EPI = false, bool SP2 = false, int F8SCALE = 0>
__device__ __forceinline__ void gemm_phase(PG8_LAS unsigned char* lds, const Gemm g, const Sched& S, const Epi& E) {
    const int tid = threadIdx.x, wid = __builtin_amdgcn_readfirstlane(tid >> 6), lane = tid & 63, wr = wid >> 2, wc = wid & 3, fr = lane & 15, fq = lane >> 4;
    const int K = g.K, nt = K / BK;
    unsigned voffA[2], voffB[2];
#pragma unroll
    for (int i = 0; i < 2; ++i) { int R, C; stage_rc(tid * 16 + i * 8192, R, C); const int Rb = Epi::PERM ? ((R & ~31) + perm32(R & 31)) : R;
        voffA[i] = (unsigned)(R * g.lda + C) * 2u; voffB[i] = (unsigned)(Rb * g.ldb + C) * 2u; }
    const size_t kstep = (size_t)(BK * 2);
    const size_t hstepA = (size_t)HALF * g.lda * 2, hstepB = (size_t)HALF * g.ldb * 2;
    const size_t tstepA = 2 * hstepA, tstepB = 2 * hstepB;
    const unsigned ldsw = (unsigned)wid * 1024u;
    const int aoff = lds_byte(wr * 64 + fr, fq * 8), boff = lds_byte(wc * 32 + fr, fq * 8);
#define PG8_SA(b, h) (((b) * 2 + (h)) * HTB)
#define PG8_SB(b, h) ((4 + (b) * 2 + (h)) * HTB)
#define PG8_STAGE(bufoff, gbase, voff) do { _Pragma("unroll") for (int _i = 0; _i < 2; ++_i) \
        __builtin_amdgcn_global_load_lds((const unsigned*)((const char*)(gbase) + (voff)[_i]), (PG8_LAS unsigned*)(lds + (bufoff) + ldsw + _i * 8192), 16, 0, 0); } while (0)
#define PG8_LDA(dst, b, h) do { _Pragma("unroll") for (int m = 0; m < 4; ++m) { if constexpr (F8SCALE != 0) { \
        PG8_F8(dst)[m].lo = *(const PG8_LAS v4i_f*)(lds + PG8_SA(b, h) + aoff + m * 2048); PG8_F8(dst)[m].hi = *(const PG8_LAS v4i_f*)(lds + PG8_SA(b, h) + aoff + m * 2048 + 1024); } \
        else { _Pragma("unroll") for (int k = 0; k < 2; ++k) dst[m][k] = *(const PG8_LAS bf16x8*)(lds + PG8_SA(b, h) + aoff + m * 2048 + k * 1024); } } } while (0)
#define PG8_LDB(dst, b, h) do { _Pragma("unroll") for (int n = 0; n < 2; ++n) { if constexpr (F8SCALE != 0) { \
        PG8_F8(dst)[n].lo = *(const PG8_LAS v4i_f*)(lds + PG8_SB(b, h) + boff + n * 2048); PG8_F8(dst)[n].hi = *(const PG8_LAS v4i_f*)(lds + PG8_SB(b, h) + boff + n * 2048 + 1024); } \
        else { _Pragma("unroll") for (int k = 0; k < 2; ++k) dst[n][k] = *(const PG8_LAS bf16x8*)(lds + PG8_SB(b, h) + boff + n * 2048 + k * 1024); } } } while (0)
#define PG8_MMA(ai, bj, At, Bt) do { __builtin_amdgcn_s_setprio(1); _Pragma("unroll") for (int m = 0; m < 4; ++m) _Pragma("unroll") for (int n = 0; n < 2; ++n) { \
        f32x4 _c = acc_get(accw, ai, bj, m, n); \
        if constexpr (F8SCALE != 0) { _c = __builtin_amdgcn_mfma_scale_f32_16x16x128_f8f6f4(PG8_F8(Bt)[n], PG8_F8(At)[m], _c, 0, 0, 0, 0x7f7f7f7f, 0, F8SCALE * 0x01010101); } \
        else { _Pragma("unroll") for (int k = 0; k < 2; ++k) _c = __builtin_amdgcn_mfma_f32_16x16x32_bf16(Bt[n][k], At[m][k], _c, 0, 0, 0); } \
        acc_set(accw, ai, bj, m, n, _c); } \
        __builtin_amdgcn_s_setprio(0); } while (0)
#define PG8_WAIT_V(n) asm volatile("s_waitcnt vmcnt(" #n ")" ::: "memory")
#define PG8_WAIT_L(n) asm volatile("s_waitcnt lgkmcnt(" #n ")" ::: "memory")
#define PG8_BAR __builtin_amdgcn_s_barrier()
#define PG8_SCHED __builtin_amdgcn_sched_barrier(0)
    Unit cur, nxt; int ui = 0;
    if (!S.next(0, cur)) return;
    typedef int v4i_f __attribute__((ext_vector_type(4))); typedef int v8i_f __attribute__((ext_vector_type(8))); typedef f32x16 f32x16_f;
    AccW accw;
#pragma unroll
    for (int a = 0; a < 2; ++a)
#pragma unroll
        for (int b = 0; b < 2; ++b)
#pragma unroll
            for (int mp = 0; mp < 2; ++mp)
#pragma unroll
                for (int i = 0; i < 16; ++i) accw[a][b][mp][i] = 0.f;
    bf16x8 At[4][2], B0[2][2], B1[2][2];
    v8i_f At8[4], B08[2], B18[2];
#define PG8_F8(x) x##8
    const char* cA = (const char*)g.A + (size_t)cur.pm * tstepA + (size_t)cur.ko * 2; const char* cB = (const char*)g.Bt + (size_t)cur.pn * tstepB + (size_t)cur.ko * 2;
    S.a_ready(cur);
    if constexpr (SP2) {
        PG8_STAGE(PG8_SB(0, 0), cB, voffB); PG8_STAGE(PG8_SB(0, 1), cB + hstepB, voffB); PG8_STAGE(PG8_SA(0, 0), cA, voffA); PG8_STAGE(PG8_SA(0, 1), cA + hstepA, voffA);
        if (wr == 1) PG8_BAR;
        PG8_WAIT_V(2); PG8_BAR;
        PG8_STAGE(PG8_SB(1, 0), cB + kstep, voffB); PG8_STAGE(PG8_SA(1, 0), cA + kstep, voffA); PG8_STAGE(PG8_SB(1, 1), cB + hstepB + kstep, voffB);
        PG8_WAIT_V(6); PG8_BAR;
    } else {
        PG8_STAGE(PG8_SB(0, 0), cB, voffB); PG8_STAGE(PG8_SA(0, 0), cA, voffA); PG8_STAGE(PG8_SB(0, 1), cB + hstepB, voffB); PG8_STAGE(PG8_SA(0, 1), cA + hstepA, voffA);
        if (wr == 1) PG8_BAR;
        PG8_WAIT_V(4); PG8_BAR;
        PG8_STAGE(PG8_SB(1, 0), cB + kstep, voffB); PG8_STAGE(PG8_SA(1, 0), cA + kstep, voffA); PG8_STAGE(PG8_SB(1, 1), cB + hstepB + kstep, voffB);
        PG8_WAIT_V(6); PG8_BAR;
    }
    for (;;) {
        const bool has_next = S.next(ui + 1, nxt);
        const char* nA = has_next ? (const char*)g.A + (size_t)nxt.pm * tstepA + (size_t)nxt.ko * 2 : cA; const char* nB = has_next ? (const char*)g.Bt + (size_t)nxt.pn * tstepB + (size_t)nxt.ko * 2 : cB;
        for (int t = 0; t < nt; t += 2) {
            const bool last = (t == nt - 2);
            const char* a1 = cA + (size_t)(t + 1) * kstep;
            const char* a2 = last ? nA : cA + (size_t)(t + 2) * kstep; const char* b2 = last ? nB : cB + (size_t)(t + 2) * kstep;
            const char* a3 = a2 + kstep; const char* b3 = b2 + kstep;
            if (last && has_next) S.a_ready(nxt);
            if constexpr (SP2) {
            PG8_LDB(B0, 0, 0); PG8_LDB(B1, 0, 1); PG8_SCHED; PG8_LDA(At, 0, 0); PG8_STAGE(PG8_SA(1, 1), a1 + hstepA, voffA);
            PG8_WAIT_V(8); PG8_WAIT_L(0); PG8_BAR; PG8_MMA(0, 0, At, B0); PG8_MMA(0, 1, At, B1); PG8_BAR; PG8_SCHED;
            PG8_LDA(At, 0, 1); PG8_STAGE(PG8_SB(0, 0), b2, voffB); PG8_STAGE(PG8_SB(0, 1), b2 + hstepB, voffB); PG8_STAGE(PG8_SA(0, 0), a2, voffA);
            PG8_WAIT_V(8); PG8_WAIT_L(0); PG8_BAR; PG8_MMA(1, 0, At, B0); PG8_MMA(1, 1, At, B1); PG8_BAR; PG8_SCHED;
            PG8_LDB(B0, 1, 0); PG8_LDB(B1, 1, 1); PG8_SCHED; PG8_LDA(At, 1, 0); PG8_STAGE(PG8_SA(0, 1), a2 + hstepA, voffA);
            PG8_WAIT_V(8); PG8_WAIT_L(0); PG8_BAR; PG8_MMA(0, 0, At, B0); PG8_MMA(0, 1, At, B1); PG8_BAR; PG8_SCHED;
            PG8_LDA(At, 1, 1); PG8_STAGE(PG8_SB(1, 0), b3, voffB); PG8_STAGE(PG8_SB(1, 1), b3 + hstepB, voffB); PG8_STAGE(PG8_SA(1, 0), a3, voffA);
            PG8_WAIT_V(8); PG8_WAIT_L(0); PG8_BAR; PG8_MMA(1, 0, At, B0); PG8_MMA(1, 1, At, B1); PG8_BAR; PG8_SCHED;
            } else {
            PG8_LDB(B0, 0, 0); PG8_SCHED; PG8_LDA(At, 0, 0); PG8_STAGE(PG8_SA(1, 1), a1 + hstepA, voffA);
            PG8_WAIT_L(8); PG8_BAR; PG8_WAIT_L(0); PG8_MMA(0, 0, At, B0); PG8_BAR; PG8_SCHED;
            PG8_LDB(B1, 0, 1); PG8_STAGE(PG8_SB(0, 0), b2, voffB);
            PG8_BAR; PG8_WAIT_L(0); PG8_MMA(0, 1, At, B1); PG8_BAR;
            PG8_LDA(At, 0, 1); PG8_STAGE(PG8_SA(0, 0), a2, voffA);
            PG8_BAR; PG8_WAIT_L(0); PG8_MMA(1, 0, At, B0); PG8_BAR; PG8_SCHED;
            PG8_STAGE(PG8_SB(0, 1), b2 + hstepB, voffB);
            PG8_WAIT_V(6); PG8_BAR; PG8_MMA(1, 1, At, B1); PG8_BAR;
            PG8_LDB(B0, 1, 0); PG8_SCHED; PG8_LDA(At, 1, 0); PG8_STAGE(PG8_SA(0, 1), a2 + hstepA, voffA);
            PG8_WAIT_L(8); PG8_BAR; PG8_WAIT_L(0); PG8_MMA(0, 0, At, B0); PG8_BAR; PG8_SCHED;
            PG8_LDB(B1, 1, 1); PG8_STAGE(PG8_SB(1, 0), b3, voffB);
            PG8_BAR; PG8_WAIT_L(0); PG8_MMA(0, 1, At, B1); PG8_BAR;
            PG8_LDA(At, 1, 1); PG8_STAGE(PG8_SA(1, 0), a3, voffA);
            PG8_BAR; PG8_WAIT_L(0); PG8_MMA(1, 0, At, B0); PG8_BAR; PG8_SCHED;
            PG8_STAGE(PG8_SB(1, 1), b3 + hstepB, voffB);
            PG8_WAIT_V(6); PG8_BAR; PG8_MMA(1, 1, At, B1); PG8_BAR;
            }
        }
        if constexpr (ALIGN_EPI) { if (wr == 0) PG8_BAR; }
        if constexpr (!Epi::AFTER_DRAIN) { E(accw, cur, wr, wc, fr, fq); S.done(cur); }
        const bool keep_acc = Epi::TWOPASS && (cur.pass == 0);
        if (!has_next) break;
        if (!keep_acc) {
#pragma unroll
            for (int a = 0; a < 2; ++a)
#pragma unroll
                for (int b = 0; b < 2; ++b)
#pragma unroll
                    for (int mp = 0; mp < 2; ++mp)
#pragma unroll
                        for (int i = 0; i < 16; ++i) accw[a][b][mp][i] = 0.f;
        }
        cur = nxt; cA = nA; cB = nB; ++ui;
        if constexpr (ALIGN_EPI) { if (wr == 1) PG8_BAR; }
    }
    PG8_WAIT_V(0);
    if constexpr (!ALIGN_EPI) { if (wr == 0) PG8_BAR; }
    PG8_BAR;

#undef PG8_SA
#undef PG8_SB
#undef PG8_STAGE
#undef PG8_LDA
#undef PG8_LDB
#undef PG8_MMA
#undef PG8_F8
#undef PG8_WAIT_V
#undef PG8_WAIT_L
#undef PG8_BAR
#undef PG8_SCHED
}
}


constexpr int NWAVES = 8, NTHREADS = 512;
constexpr int BATCH = 8, SEQ = 4096, T = BATCH * SEQ, DM = 1024;
constexpr int INW = 5448;
constexpr int NPROJ = 5632;
constexpr int LD_HG = 2048, LD_ATT = 768, LD_IDX = 640, LD_GATE = 2048;
constexpr int TOPK = 256;
constexpr int NEXP = 16384;
constexpr float RMS_EPS = 1e-6f;

constexpr size_t MiB = 1u << 20;
constexpr size_t WS_CTL = 0;
constexpr size_t WS_MOD = MiB / 4;
constexpr size_t WS_MODP = MiB / 2;
constexpr size_t WS_WIN = 2 * MiB;
constexpr size_t WS_WQ = 17 * MiB;
constexpr size_t WS_SK = 21 * MiB;
constexpr size_t WS_U = 22 * MiB;
constexpr size_t WS_US = 30 * MiB;
constexpr size_t WS_V = 38 * MiB;
constexpr size_t WS_VS = 46 * MiB;
constexpr size_t WS_K8 = 48 * MiB;
constexpr size_t WS_QHI = 52 * MiB;
constexpr size_t WS_QLO = 68 * MiB;
constexpr size_t WS_WAB8 = 31 * MiB;
constexpr size_t WS_WOUT8 = 32 * MiB;
constexpr size_t WS_WIN8 = 33 * MiB;
constexpr size_t WS_H8 = 48 * MiB;
constexpr size_t WS_H = 86 * MiB;
constexpr size_t WS_HG = 150 * MiB;
constexpr size_t WS_ATT = 278 * MiB;
constexpr size_t WS_IDX = 326 * MiB;
constexpr size_t WS_GATE = 366 * MiB;
constexpr size_t WS_SEL = 494 * MiB;
constexpr size_t WS_EIDX = 48 * MiB;
constexpr size_t WS_PGATE = 64 * MiB;
constexpr size_t WS_END = 510 * MiB;
constexpr size_t WS_HQC = 494 * MiB;
constexpr size_t WS_HOL = 118 * MiB;
constexpr size_t WS_HSB = 2 * MiB;
constexpr size_t WS_MERGED = WS_HG;
constexpr size_t WS_Q = 214 * MiB;
constexpr int H4_NT = 2;
constexpr size_t WS_H4D = 366 * MiB;
constexpr size_t WS_H4S = 416 * MiB;

constexpr int LDS_BYTES = 163840;

typedef unsigned short bf16;
typedef unsigned v4u __attribute__((ext_vector_type(4)));
typedef unsigned v2u __attribute__((ext_vector_type(2)));
typedef float f32x4 __attribute__((ext_vector_type(4)));
typedef float f32x2 __attribute__((ext_vector_type(2)));
typedef short bf16x8 __attribute__((ext_vector_type(8)));
#define LAS __attribute__((address_space(3)))

struct Params {
    const float *x, *c, *w_ada, *b_ada, *norm1_g, *norm2_g, *w_in, *hg_lb, *hg_onorm_g, *q_norm_g, *k_norm_g,
                *w_a, *w_b, *w_out, *peer_wq, *peer_subkeys, *peer_u, *peer_v;
    float* out; unsigned char* ws; int ph_lo, ph_hi;
};

typedef __bf16 bf16x2_hw __attribute__((ext_vector_type(2)));
__device__ __forceinline__ unsigned pk2(float lo, float hi) { const f32x2 v = {lo, hi}; const bf16x2_hw b = __builtin_convertvector(v, bf16x2_hw); return __builtin_bit_cast(unsigned, b); }
__device__ __forceinline__ unsigned f2bf(float f) { return pk2(f, 0.f) & 0xffffu; }
__device__ __forceinline__ float bf2f(unsigned u16v) { return __builtin_bit_cast(float, u16v << 16); }
__device__ __forceinline__ float bflo(unsigned w) { return __builtin_bit_cast(float, w << 16); }
__device__ __forceinline__ float bfhi(unsigned w) { return __builtin_bit_cast(float, w & 0xffff0000u); }
__device__ __forceinline__ float sigmoidf_(float x) { return __builtin_amdgcn_rcpf(1.f + __expf(-x)); }
__device__ __forceinline__ float siluf_(float x) { return x * __builtin_amdgcn_rcpf(1.f + __expf(-x)); }
__device__ __forceinline__ float wave_sum(float v) {
#pragma unroll
    for (int o = 1; o < 64; o <<= 1) v += __shfl_xor(v, o);
    return v;
}
__device__ __forceinline__ float wave_max(float v) {
#pragma unroll
    for (int o = 1; o < 64; o <<= 1) v = fmaxf(v, __shfl_xor(v, o));
    return v;
}
#define LDS_WAIT() asm volatile("s_waitcnt lgkmcnt(0)" ::: "memory")
__device__ __forceinline__ unsigned pk4_fp8(float a, float b, float c, float d) { int w = __builtin_amdgcn_cvt_pk_fp8_f32(a, b, 0, false); w = __builtin_amdgcn_cvt_pk_fp8_f32(c, d, w, true); return (unsigned)w; }

__host__ __device__ __forceinline__ int proj_tile_bf16(int i) { return i < 2 ? i + 2 : i + 6; }
__host__ __device__ __forceinline__ int proj_tile_fp8(int i) { return i < 2 ? i : (i < 6 ? i + 2 : i + 8); }
struct EpiProj {
    static constexpr bool PERM = true, AFTER_DRAIN = false, TWOPASS = false;
    bf16 *HG, *ATT, *IDX, *GATE; int f8;
    __device__ __forceinline__ void operator()(pg8::AccW& acc, const pg8::Unit& u, int wr, int wc, int fr, int fq) const {
        const int pn = f8 ? proj_tile_fp8(u.pn) : proj_tile_bf16(u.pn); bf16* base; int ldc, colt, ncols;
        if (pn < 8) { base = HG; ldc = LD_HG; colt = pn * 256; ncols = LD_HG; }
        else if (pn < 11) { base = ATT; ldc = LD_ATT; colt = (pn - 8) * 256; ncols = LD_ATT; }
        else if (pn < 14) { base = IDX; ldc = LD_IDX; colt = (pn - 11) * 256; ncols = LD_IDX; }
        else { base = GATE; ldc = LD_GATE; colt = (pn - 14) * 256; ncols = LD_GATE; }
        const int row0 = u.pm * 256 + wr * 64 + fr, col0 = colt + wc * 32 + 8 * fq;
#pragma unroll
        for (int ai = 0; ai < 2; ++ai)
#pragma unroll
            for (int m = 0; m < 4; ++m) { bf16* rowp = base + (size_t)(row0 + ai * 128 + m * 16) * ldc + col0;
#pragma unroll
                for (int bj = 0; bj < 2; ++bj) { const pg8::f32x4 v0 = pg8::acc_get(acc, ai, bj, m, 0), v1 = pg8::acc_get(acc, ai, bj, m, 1);
                    v4u w; w.x = pk2(v0[0], v0[1]); w.y = pk2(v0[2], v0[3]); w.z = pk2(v1[0], v1[1]); w.w = pk2(v1[2], v1[3]);
                    if (col0 + bj * 128 < ncols) *(v4u*)(rowp + bj * 128) = w; } }
    }
};
struct EpiMerged {
    static constexpr bool PERM = true, AFTER_DRAIN = false, TWOPASS = true;
    const bf16* GATE; bf16* O;
    __device__ __forceinline__ void operator()(pg8::AccW& acc, const pg8::Unit& u, int wr, int wc, int fr, int fq) const {
        const int row0 = u.pm * 256 + wr * 64 + fr, col0 = u.pn * 256 + wc * 32 + 8 * fq;
        if (u.pass == 0) {
#pragma unroll
            for (int ai = 0; ai < 2; ++ai)
#pragma unroll
                for (int m = 0; m < 4; ++m) { const bf16* rowp = GATE + (size_t)(row0 + ai * 128 + m * 16) * LD_GATE + col0;
#pragma unroll
                    for (int bj = 0; bj < 2; ++bj) { const v4u a = *(const v4u*)(rowp + bj * 128), b = *(const v4u*)(rowp + 1024 + bj * 128);
                        float r[8];
#pragma unroll
                        for (int i = 0; i < 4; ++i) { const float a0 = bflo(a[i]), a1 = bfhi(a[i]), b0 = bflo(b[i]), b1 = bfhi(b[i]);
                            r[2 * i] = (1.f + __expf(-b0)) * __builtin_amdgcn_rcpf(1.f + __expf(-a0)); r[2 * i + 1] = (1.f + __expf(-b1)) * __builtin_amdgcn_rcpf(1.f + __expf(-a1)); }
                        { pg8::f32x4 c0 = pg8::acc_get(acc, ai, bj, m, 0), c1 = pg8::acc_get(acc, ai, bj, m, 1);
#pragma unroll
                          for (int i = 0; i < 4; ++i) { c0[i] *= r[i]; c1[i] *= r[4 + i]; }
                          pg8::acc_set(acc, ai, bj, m, 0, c0); pg8::acc_set(acc, ai, bj, m, 1, c1); } } }
        } else {
#pragma unroll
            for (int ai = 0; ai < 2; ++ai)
#pragma unroll
                for (int m = 0; m < 4; ++m) { const size_t ro = (size_t)(row0 + ai * 128 + m * 16);
#pragma unroll
                    for (int bj = 0; bj < 2; ++bj) { const v4u b = *(const v4u*)(GATE + ro * LD_GATE + 1024 + col0 + bj * 128);
                        const pg8::f32x4 v0 = pg8::acc_get(acc, ai, bj, m, 0), v1 = pg8::acc_get(acc, ai, bj, m, 1);
                        float s[8];
#pragma unroll
                        for (int i = 0; i < 4; ++i) { s[2 * i] = sigmoidf_(bflo(b[i])); s[2 * i + 1] = sigmoidf_(bfhi(b[i])); }
                        v2u w; w.x = pk4_fp8(4.f * v0[0] * s[0], 4.f * v0[1] * s[1], 4.f * v0[2] * s[2], 4.f * v0[3] * s[3]); w.y = pk4_fp8(4.f * v1[0] * s[4], 4.f * v1[1] * s[5], 4.f * v1[2] * s[6], 4.f * v1[3] * s[7]);
                        *(v2u*)((unsigned char*)O + ro * 1024 + col0 + bj * 128) = w; } }
        }
    }
};
struct EpiResid {
    static constexpr bool PERM = true, AFTER_DRAIN = false, TWOPASS = false;
    const float* X; const float* G1  ; float* O;
    __device__ __forceinline__ void operator()(pg8::AccW& acc, const pg8::Unit& u, int wr, int wc, int fr, int fq) const {
        const int row0 = u.pm * 256 + wr * 64 + fr, col0 = u.pn * 256 + wc * 32 + 8 * fq;
        const int b = (u.pm * 256) / SEQ;
        f32x4 g[2][2];
#pragma unroll
        for (int bj = 0; bj < 2; ++bj)
#pragma unroll
            for (int n = 0; n < 2; ++n) g[bj][n] = *(const f32x4*)(G1 + (size_t)b * 6144 + col0 + bj * 128 + 4 * n);
#pragma unroll
        for (int ai = 0; ai < 2; ++ai)
#pragma unroll
            for (int m = 0; m < 4; ++m) { const size_t ro = (size_t)(row0 + ai * 128 + m * 16) * DM + col0;
#pragma unroll
                for (int bj = 0; bj < 2; ++bj)
#pragma unroll
                    for (int n = 0; n < 2; ++n) { const f32x4 xv = *(const f32x4*)(X + ro + bj * 128 + 4 * n);
                        *(f32x4*)(O + ro + bj * 128 + 4 * n) = xv + g[bj][n] * pg8::acc_get(acc, ai, bj, m, n); } }
    }
};
struct EpiStore {
    static constexpr bool PERM = true, AFTER_DRAIN = false, TWOPASS = false;
    bf16* O; int ldc;
    __device__ __forceinline__ void operator()(pg8::AccW& acc, const pg8::Unit& u, int wr, int wc, int fr, int fq) const {
        const int row0 = u.pm * 256 + wr * 64 + fr, col0 = u.pn * 256 + wc * 32 + 8 * fq;
#pragma unroll
        for (int ai = 0; ai < 2; ++ai)
#pragma unroll
            for (int m = 0; m < 4; ++m) { bf16* rowp = O + (size_t)(row0 + ai * 128 + m * 16) * ldc + col0;
#pragma unroll
                for (int bj = 0; bj < 2; ++bj) { const pg8::f32x4 v0 = pg8::acc_get(acc, ai, bj, m, 0), v1 = pg8::acc_get(acc, ai, bj, m, 1);
                    v4u w; w.x = pk2(v0[0], v0[1]); w.y = pk2(v0[2], v0[3]); w.z = pk2(v1[0], v1[1]); w.w = pk2(v1[2], v1[3]);
                    *(v4u*)(rowp + bj * 128) = w; } }
    }
};

template <int MODE> __device__ __forceinline__ int srcmap(int np) {
    if (MODE == 2) np = proj_tile_bf16(np >> 8) * 256 + (np & 255);
    if (MODE == 3) np = proj_tile_fp8(np >> 8) * 256 + (np & 255);
    if (MODE >= 1) return np < 3400 ? np : (np >= 3584 ? np - 184 : -1);
    return np; }
template <int MODE>
__device__ __forceinline__ void transpose_item(const float* W, int N, bf16* WT, int ldw, int koff, float* scr, int kb, int nb, int lane) {
    const int k0 = 64 * kb, n0 = 32 * nb;
    const int sc = srcmap<MODE>(n0 + (lane & 31));
#pragma unroll 8
    for (int i = 0; i < 32; ++i) { const int kk = 2 * i + (lane >> 5); scr[kk * 33 + (lane & 31)] = (sc >= 0) ? W[(size_t)(k0 + kk) * N + sc] : 0.f; }
    LDS_WAIT(); __builtin_amdgcn_wave_barrier();
    const int c = lane & 7;
#pragma unroll
    for (int j = 0; j < 4; ++j) { const int n = (lane >> 3) + 8 * j; const float* s = scr + (8 * c) * 33 + n;
        v4u o; o.x = pk2(s[0 * 33], s[1 * 33]); o.y = pk2(s[2 * 33], s[3 * 33]); o.z = pk2(s[4 * 33], s[5 * 33]); o.w = pk2(s[6 * 33], s[7 * 33]);
        *(v4u*)(WT + (size_t)(n0 + n) * ldw + koff + k0 + 8 * c) = o; }
    LDS_WAIT(); __builtin_amdgcn_wave_barrier();
}
template <int MODE> __device__ __forceinline__ int srcmap(int np);
template <int MODE = 0>
__device__ __forceinline__ void transpose_item8(const float* W, int N, unsigned char* WT, int ldw, int koff, float scale, float* scr, int kb, int nb, int lane) {
    const int k0 = 64 * kb, n0 = 32 * nb;
    const int sc = srcmap<MODE>(n0 + (lane & 31));
#pragma unroll 8
    for (int i = 0; i < 32; ++i) { const int kk = 2 * i + (lane >> 5); scr[kk * 33 + (lane & 31)] = (sc >= 0) ? W[(size_t)(k0 + kk) * N + sc] * scale : 0.f; }
    LDS_WAIT(); __builtin_amdgcn_wave_barrier();
    const int c = lane & 3;
#pragma unroll
    for (int j = 0; j < 2; ++j) { const int n = (lane >> 2) + 16 * j; const float* sp = scr + (16 * c) * 33 + n;
        v4u o;
#pragma unroll
        for (int q = 0; q < 4; ++q) o[q] = pk4_fp8(sp[(4 * q) * 33], sp[(4 * q + 1) * 33], sp[(4 * q + 2) * 33], sp[(4 * q + 3) * 33]);
        *(v4u*)(WT + (size_t)(n0 + n) * ldw + koff + k0 + 16 * c) = o; }
    LDS_WAIT(); __builtin_amdgcn_wave_barrier();
}
__device__ __forceinline__ void convert_plain(const float* src, bf16* dst, size_t n, size_t gtid, size_t nth) {
    const size_t n8 = n / 8;
    for (size_t i = gtid; i < n8; i += nth) { const f32x4 a = ((const f32x4*)src)[2 * i], b = ((const f32x4*)src)[2 * i + 1];
        v4u o; o.x = pk2(a[0], a[1]); o.y = pk2(a[2], a[3]); o.z = pk2(b[0], b[1]); o.w = pk2(b[2], b[3]); ((v4u*)dst)[i] = o; }
}
__device__ __forceinline__ void convert_fp8(const float* src, unsigned char* dst, size_t n, float scale, size_t gtid, size_t nth) {
    const size_t n16 = n / 16;
    for (size_t i = gtid; i < n16; i += nth) { const f32x4* sp = (const f32x4*)src + 4 * i; const f32x4 a = sp[0] * scale, b = sp[1] * scale, c = sp[2] * scale, d = sp[3] * scale;
        v4u o; o.x = pk4_fp8(a[0], a[1], a[2], a[3]); o.y = pk4_fp8(b[0], b[1], b[2], b[3]); o.z = pk4_fp8(c[0], c[1], c[2], c[3]); o.w = pk4_fp8(d[0], d[1], d[2], d[3]); ((v4u*)dst)[i] = o; }
}
template <bool KKMAJOR>
__device__ __forceinline__ void convert_mxfp4(const float* src, unsigned char* dst, unsigned char* scl, size_t nrows, size_t gtid, size_t nth) {
    const size_t nblk = nrows * 32;
    for (size_t i = gtid; i < nblk; i += nth) {
        const size_t row = i >> 5; const int blk = (int)(i & 31);
        const f32x4* sp = (const f32x4*)(src + row * 1024 + blk * 32);
        f32x4 v[8]; float amax = 0.f;
#pragma unroll
        for (int j = 0; j < 8; ++j) { v[j] = sp[j]; amax = fmaxf(fmaxf(fmaxf(fabsf(v[j][0]), fabsf(v[j][1])), fmaxf(fabsf(v[j][2]), fabsf(v[j][3]))), amax); }
        int e = (int)((__builtin_bit_cast(unsigned, amax) >> 23) & 0xffu) - 127 - 2;
        if (e < -126) e = -126;
        const float inv = __builtin_bit_cast(float, (unsigned)(127 - e) << 23);
        unsigned w[4] = {0u, 0u, 0u, 0u};
#pragma unroll
        for (int j = 0; j < 8; j += 2) { unsigned t = 0u;
            t = __builtin_amdgcn_cvt_scalef32_pk_fp4_f32(t, v[j][0] * inv, v[j][1] * inv, 1.0f, 0);
            t = __builtin_amdgcn_cvt_scalef32_pk_fp4_f32(t, v[j][2] * inv, v[j][3] * inv, 1.0f, 1);
            t = __builtin_amdgcn_cvt_scalef32_pk_fp4_f32(t, v[j + 1][0] * inv, v[j + 1][1] * inv, 1.0f, 2);
            t = __builtin_amdgcn_cvt_scalef32_pk_fp4_f32(t, v[j + 1][2] * inv, v[j + 1][3] * inv, 1.0f, 3);
            w[j >> 1] = t; }
        *(v4u*)(dst + row * 512 + blk * 16) = (v4u){w[0], w[1], w[2], w[3]};
        scl[row * 32 + (KKMAJOR ? ((blk & 3) * 8 + (blk >> 2)) : blk)] = (unsigned char)(e + 127);
    }
}
__device__ __forceinline__ void convert_rowfp4(const float* src, unsigned char* dst, _Float16* scl, int row, int lane) {
    const f32x4* sp = (const f32x4*)(src + (size_t)row * 1024 + lane * 16);
    f32x4 v[4]; float amax = 0.f;
#pragma unroll
    for (int j = 0; j < 4; ++j) { v[j] = sp[j]; amax = fmaxf(fmaxf(fmaxf(fabsf(v[j][0]), fabsf(v[j][1])), fmaxf(fabsf(v[j][2]), fabsf(v[j][3]))), amax); }
    amax = wave_max(amax);
    _Float16 sh = (_Float16)(amax * (1.f / 6.f));
    float sf = (float)sh; if (!(sf > 0.f)) { sf = 1.f; sh = (_Float16)1.f; }
    const float inv = 1.f / sf;
    unsigned w[2];
#pragma unroll
    for (int j = 0; j < 2; ++j) { unsigned t = 0u;
        t = __builtin_amdgcn_cvt_scalef32_pk_fp4_f32(t, v[2 * j][0] * inv, v[2 * j][1] * inv, 1.0f, 0);
        t = __builtin_amdgcn_cvt_scalef32_pk_fp4_f32(t, v[2 * j][2] * inv, v[2 * j][3] * inv, 1.0f, 1);
        t = __builtin_amdgcn_cvt_scalef32_pk_fp4_f32(t, v[2 * j + 1][0] * inv, v[2 * j + 1][1] * inv, 1.0f, 2);
        t = __builtin_amdgcn_cvt_scalef32_pk_fp4_f32(t, v[2 * j + 1][2] * inv, v[2 * j + 1][3] * inv, 1.0f, 3);
        w[j] = t; }
    *(v2u*)(dst + (size_t)row * 512 + lane * 8) = (v2u){w[0], w[1]};
    if (lane == 0) scl[row] = sh;
}
__device__ __forceinline__ void phase0(const Params& p, unsigned char* lds) {
    const int tid = threadIdx.x, wave = tid >> 6, lane = tid & 63, G = gridDim.x;
    const int gw = blockIdx.x * NWAVES + wave, NGW = G * NWAVES;
    float* scr = (float*)(lds + wave * 16384);
    unsigned char* ws = p.ws;
    constexpr int I_IN = 16 * (2048 / 32), I_IN8 = 16 * (3584 / 32), I_A = 8 * 32, I_O = 16 * 32, I_Q = 16 * 64;
    constexpr int NT = I_IN + I_IN8 + 2 * I_A + I_O + I_Q;
    for (int it = gw; it < NT; it += NGW) {
        int r = it;
        if (r < I_IN) { transpose_item<2>(p.w_in, INW, (bf16*)(ws + WS_WIN), 1024, 0, scr, r / 64, r % 64, lane); continue; } r -= I_IN;
        if (r < I_IN8) { transpose_item8<3>(p.w_in, INW, ws + WS_WIN8, 1024, 0, 32.f, scr, r / 112, r % 112, lane); continue; } r -= I_IN8;
        if (r < I_A) { transpose_item8(p.w_a, 1024, ws + WS_WAB8, 1024, 0, 32.f, scr, r / 32, r % 32, lane); continue; } r -= I_A;
        if (r < I_A) { transpose_item8(p.w_b, 1024, ws + WS_WAB8, 1024, 512, 4.f, scr, r / 32, r % 32, lane); continue; } r -= I_A;
        if (r < I_O) { transpose_item8(p.w_out, 1024, ws + WS_WOUT8, 1024, 0, 32.f, scr, r / 32, r % 32, lane); continue; } r -= I_O;
        transpose_item<0>(p.peer_wq, 2048, (bf16*)(ws + WS_WQ), 1024, 0, scr, r / 64, r % 64, lane);
    }
    for (int it = gw; it < 96 * 8; it += NGW) {
        const int cgp = it % 96, ks = it / 96, col = cgp * 64 + lane, k0 = ks * 128;
#pragma unroll
        for (int i = 0; i < 16; ++i) { const int e = i * 64 + lane, b = e >> 7, k = e & 127; scr[e] = siluf_(p.c[b * 1024 + k0 + k]); }
        LDS_WAIT(); __builtin_amdgcn_wave_barrier();
        float acc[8];
#pragma unroll
        for (int b = 0; b < 8; ++b) acc[b] = 0.f;
#pragma unroll 4
        for (int k = 0; k < 128; ++k) { const float w = p.w_ada[(size_t)(k0 + k) * 6144 + col];
#pragma unroll
            for (int b = 0; b < 8; ++b) acc[b] += scr[b * 128 + k] * w; }
        float* mp = (float*)(ws + WS_MODP) + (size_t)ks * 8 * 6144 + col;
#pragma unroll
        for (int b = 0; b < 8; ++b) mp[b * 6144] = acc[b];
        LDS_WAIT(); __builtin_amdgcn_wave_barrier();
    }
    const size_t gtid = (size_t)blockIdx.x * NTHREADS + tid, nth = (size_t)G * NTHREADS;
    convert_plain(p.peer_subkeys, (bf16*)(ws + WS_SK), (size_t)16 * 128 * 128, gtid, nth);
    for (int it = gw; it < 2 * NEXP; it += NGW) {
        if (it < NEXP) convert_rowfp4(p.peer_u, ws + WS_U, (_Float16*)(ws + WS_US), it, lane);
        else convert_rowfp4(p.peer_v, ws + WS_V, (_Float16*)(ws + WS_VS), it - NEXP, lane);
    }
}

template <bool FIRST>
__device__ __forceinline__ void normmod_phase(const Params& p, unsigned char* lds, const float* src, bf16* dst, const float* gvec, int shift_off, int scale_off) {
    const int tid = threadIdx.x, wave = tid >> 6, lane = tid & 63, G = gridDim.x;
    unsigned char* ws = p.ws;
    float* A = (float*)lds;
    float* Bv = A + 1024;
    const float* MODP = (const float*)(ws + WS_MODP);
    float* MOD = (float*)(ws + WS_MOD);
    if (FIRST) {
        for (int e = blockIdx.x * NTHREADS + tid; e < 8 * 6144; e += G * NTHREADS) { const int col = e % 6144; float s = p.b_ada[col];
#pragma unroll
            for (int ks = 0; ks < 8; ++ks) s += MODP[(size_t)ks * 8 * 6144 + e];
            MOD[e] = s; }
    }
    int curb = -1;
    for (int chunk = blockIdx.x; chunk < T / 128; chunk += G) {
        const int b = (chunk * 128) / SEQ;
        if (b != curb) {
            __syncthreads();
            for (int col = tid; col < 1024; col += NTHREADS) {
                float sc, sh;
                if (FIRST) { sc = p.b_ada[scale_off + col]; sh = p.b_ada[shift_off + col];
#pragma unroll
                    for (int ks = 0; ks < 8; ++ks) { sc += MODP[(size_t)(ks * 8 + b) * 6144 + scale_off + col]; sh += MODP[(size_t)(ks * 8 + b) * 6144 + shift_off + col]; } }
                else { sc = MOD[b * 6144 + scale_off + col]; sh = MOD[b * 6144 + shift_off + col]; }
                A[col] = gvec[col] * (1.f + sc); Bv[col] = sh; }
            __syncthreads(); curb = b;
        }
        for (int r = wave; r < 128; r += NWAVES) {
            const size_t row = (size_t)chunk * 128 + r;
            const f32x4* xr = (const f32x4*)(src + row * DM) + lane;
            f32x4 v[4]; float s = 0.f;
#pragma unroll
            for (int j = 0; j < 4; ++j) { v[j] = xr[64 * j]; s += (v[j][0] * v[j][0] + v[j][1] * v[j][1]) + (v[j][2] * v[j][2] + v[j][3] * v[j][3]); }
            const float rstd = rsqrtf(wave_sum(s) * (1.f / DM) + RMS_EPS);
            v2u* o8 = (v2u*)(dst + row * DM) + lane;
#pragma unroll
            for (int j = 0; j < 4; ++j) { const int c0 = 4 * lane + 256 * j; const f32x4 a = *(const f32x4*)(A + c0), sh = *(const f32x4*)(Bv + c0);
                v2u o; o.x = pk2(v[j][0] * rstd * a[0] + sh[0], v[j][1] * rstd * a[1] + sh[1]); o.y = pk2(v[j][2] * rstd * a[2] + sh[2], v[j][3] * rstd * a[3] + sh[3]);
                o8[64 * j] = o;
                if (FIRST) *(unsigned*)(ws + WS_H8 + row * DM + c0) = pk4_fp8(v[j][0] * rstd * a[0] + sh[0], v[j][1] * rstd * a[1] + sh[1], v[j][2] * rstd * a[2] + sh[2], v[j][3] * rstd * a[3] + sh[3]);
                if (!FIRST) { float* st = (float*)(lds + 8192) + wave * 1056;
                    const float y0 = v[j][0] * rstd * a[0] + sh[0], y1 = v[j][1] * rstd * a[1] + sh[1], y2 = v[j][2] * rstd * a[2] + sh[2], y3 = v[j][3] * rstd * a[3] + sh[3];
                    const int pc = c0 + (c0 >> 5); st[pc] = y0; st[pc + 1] = y1; st[pc + 2] = y2; st[pc + 3] = y3; } }
            if (!FIRST) {
                const float* st = (const float*)(lds + 8192) + wave * 1056;
                LDS_WAIT(); __builtin_amdgcn_wave_barrier();
                if (lane < 32) {
                    float x[32];
#pragma unroll
                    for (int k = 0; k < 32; ++k) x[k] = st[lane * 33 + k];
#pragma unroll
                    for (int t = 0; t < H4_NT; ++t) {
                        float amax = 0.f;
#pragma unroll
                        for (int k = 0; k < 32; ++k) amax = fmaxf(amax, fabsf(x[k]));
                        int e = (int)((__builtin_bit_cast(unsigned, amax) >> 23) & 0xffu) - 127 - 2; if (e < -126) e = -126;
                        const float inv = __builtin_bit_cast(float, (unsigned)(127 - e) << 23), sc = __builtin_bit_cast(float, (unsigned)(127 + e) << 23);
                        unsigned w[4];
#pragma unroll
                        for (int r = 0; r < 4; ++r) { unsigned tw = 0u;
                            tw = __builtin_amdgcn_cvt_scalef32_pk_fp4_f32(tw, x[8 * r] * inv, x[8 * r + 1] * inv, 1.0f, 0);
                            tw = __builtin_amdgcn_cvt_scalef32_pk_fp4_f32(tw, x[8 * r + 2] * inv, x[8 * r + 3] * inv, 1.0f, 1);
                            tw = __builtin_amdgcn_cvt_scalef32_pk_fp4_f32(tw, x[8 * r + 4] * inv, x[8 * r + 5] * inv, 1.0f, 2);
                            tw = __builtin_amdgcn_cvt_scalef32_pk_fp4_f32(tw, x[8 * r + 6] * inv, x[8 * r + 7] * inv, 1.0f, 3);
                            w[r] = tw;
                            const f32x2 d0 = __builtin_amdgcn_cvt_scalef32_pk_f32_fp4(tw, 1.0f, 0), d1 = __builtin_amdgcn_cvt_scalef32_pk_f32_fp4(tw, 1.0f, 1), d2 = __builtin_amdgcn_cvt_scalef32_pk_f32_fp4(tw, 1.0f, 2), d3 = __builtin_amdgcn_cvt_scalef32_pk_f32_fp4(tw, 1.0f, 3);
                            x[8 * r] -= d0[0] * sc; x[8 * r + 1] -= d0[1] * sc; x[8 * r + 2] -= d1[0] * sc; x[8 * r + 3] -= d1[1] * sc;
                            x[8 * r + 4] -= d2[0] * sc; x[8 * r + 5] -= d2[1] * sc; x[8 * r + 6] -= d3[0] * sc; x[8 * r + 7] -= d3[1] * sc; }
                        *(v4u*)(ws + WS_H4D + (row * H4_NT + t) * 512 + lane * 16) = (v4u){w[0], w[1], w[2], w[3]};
                        *(ws + WS_H4S + (row * H4_NT + t) * 32 + (lane & 3) * 8 + (lane >> 2)) = (unsigned char)(e + 127);
                    }
                }
                LDS_WAIT(); __builtin_amdgcn_wave_barrier();
            }
        }
    }
    __syncthreads();
}

constexpr int HGL_QT = 0, HGL_KT = 17408, HGL_QE = 34816, HGL_KLT = 52224, HGL_VT = 70656, HGL_AM = 89088, HGL_DEC = 98304, HGL_TOT = 98816, HGL_SSQ = 100864;
constexpr int HG_LDR = 136;
constexpr int HG_LDC = 72;
template <int half>
__device__ __forceinline__ void hgrn_item(const Params& p, unsigned char* lds, int item) {
    const int b = item >> 2, h = item & 3;
    const int tid = threadIdx.x, w = tid >> 6, lane = tid & 63, fr = lane & 15, fq = lane >> 4;
    unsigned char* ws = p.ws;
    const bf16* HG = (const bf16*)(ws + WS_HG);
    bf16* YA = (bf16*)(ws + WS_H);
    bf16* QT = (bf16*)(lds + HGL_QT); bf16* KT = (bf16*)(lds + HGL_KT); bf16* QE = (bf16*)(lds + HGL_QE);
    bf16* KLT = (bf16*)(lds + HGL_KLT); bf16* VT = (bf16*)(lds + HGL_VT); bf16* AM = (bf16*)(lds + HGL_AM);
    float* DEC = (float*)(lds + HGL_DEC); float* TOT = (float*)(lds + HGL_TOT); float* SSQ = (float*)(lds + HGL_SSQ);
    const int pd = tid & 127, pq = tid >> 7;
    float lbv; { const float a0 = p.hg_lb[h * 128 + pd], a1 = p.hg_lb[512 + h * 128 + pd]; lbv = 1.f / (1.f + __expf(a1 - a0)); }
    const int e0 = w * 16;
    const float ogv = p.hg_onorm_g[e0 + fr];
    pg8::f32x4 S[8];
#pragma unroll
    for (int i = 0; i < 8; ++i) S[i] = (pg8::f32x4){0.f, 0.f, 0.f, 0.f};
    const size_t rowb = (size_t)b * SEQ;
    const int c0 = half * 32;
    bf16* QCg = (bf16*)(ws + WS_HQC) + (size_t)item * 2048 * 128; float* OLg = (float*)(ws + WS_HOL) + (size_t)item * 32 * 8 * 4 * 256;
    float cum = 1.f;
    unsigned short rq[16], rf[16], rv[16];
    { const bf16* gp = HG + (rowb + (size_t)c0 * 64 + pq * 16) * LD_HG + h * 128 + pd;
#pragma unroll
      for (int i = 0; i < 16; ++i) { rq[i] = gp[(size_t)i * LD_HG]; rf[i] = gp[(size_t)i * LD_HG + 512]; rv[i] = gp[(size_t)i * LD_HG + 1024]; } }
    for (int chunk = c0; chunk < c0 + 32; ++chunk) {
        const size_t row0 = rowb + (size_t)chunk * 64;
        float fq_[16], kq_[16], cs[16];
        float run = 0.f;
#pragma unroll
        for (int i = 0; i < 16; ++i) { const float f = lbv + (1.f - lbv) * sigmoidf_(bf2f(rf[i])); kq_[i] = 1.f - f; run += __logf(f); cs[i] = run; fq_[i] = siluf_(bf2f(rq[i])); }
        TOT[pq * 128 + pd] = run;
        { v4u v0, v1;
          v0.x = rv[0] | ((unsigned)rv[1] << 16); v0.y = rv[2] | ((unsigned)rv[3] << 16); v0.z = rv[4] | ((unsigned)rv[5] << 16); v0.w = rv[6] | ((unsigned)rv[7] << 16);
          v1.x = rv[8] | ((unsigned)rv[9] << 16); v1.y = rv[10] | ((unsigned)rv[11] << 16); v1.z = rv[12] | ((unsigned)rv[13] << 16); v1.w = rv[14] | ((unsigned)rv[15] << 16);
          *(v4u*)(VT + pd * HG_LDC + pq * 16) = v0; *(v4u*)(VT + pd * HG_LDC + pq * 16 + 8) = v1; }
        unsigned short rg[16];
#pragma unroll
        for (int i = 0; i < 16; ++i) rg[i] = half ? (unsigned short)0 : HG[(row0 + (i >> 2) * 16 + fq * 4 + (i & 3)) * LD_HG + 1536 + h * 128 + e0 + fr];
        if (chunk + 1 < c0 + 32) { const bf16* gp = HG + (row0 + 64 + pq * 16) * LD_HG + h * 128 + pd;
#pragma unroll
            for (int i = 0; i < 16; ++i) { rq[i] = gp[(size_t)i * LD_HG]; rf[i] = gp[(size_t)i * LD_HG + 512]; rv[i] = gp[(size_t)i * LD_HG + 1024]; } }
        __syncthreads();
        const float t0 = TOT[pd], t1 = TOT[128 + pd], t2 = TOT[256 + pd], t3 = TOT[384 + pd];
        const float base = (pq > 0 ? t0 : 0.f) + (pq > 1 ? t1 : 0.f) + (pq > 2 ? t2 : 0.f);
        const float bmid = t0 + t1, blast = (t0 + t1) + (t2 + t3);
        const float emid = __expf(bmid), elm = __expf(blast - bmid);
        if (pq == 0) DEC[pd] = __expf(blast);
        { unsigned klp[8];
#pragma unroll
          for (int i = 0; i < 16; ++i) { const float bb = base + cs[i]; const float E1 = __expf(bb - bmid), R1 = __builtin_amdgcn_rcpf(E1);
              const float qtv = fq_[i] * E1, ktv = kq_[i] * R1, qev = qtv * emid, klv = ktv * elm;
              const int srow = pq * 16 + i;
              QT[srow * HG_LDR + pd] = (bf16)f2bf(qtv); KT[srow * HG_LDR + pd] = (bf16)f2bf(ktv); QE[srow * HG_LDR + pd] = (bf16)f2bf(qev);
              if (half) QCg[((size_t)(chunk - 32) * 64 + srow) * 128 + pd] = (bf16)f2bf(qev * cum);
              if (i & 1) klp[i >> 1] |= f2bf(klv) << 16; else klp[i >> 1] = f2bf(klv); }
          *(v4u*)(KLT + pd * HG_LDC + pq * 16) = (v4u){klp[0], klp[1], klp[2], klp[3]}; *(v4u*)(KLT + pd * HG_LDC + pq * 16 + 8) = (v4u){klp[4], klp[5], klp[6], klp[7]}; }
        cum *= __expf(blast);
        __syncthreads();
#pragma unroll
        for (int tt = 0; tt < 2; ++tt) { const int id = w + 8 * tt, rt = id >> 2, ct = id & 3;
            pg8::f32x4 a = {0.f, 0.f, 0.f, 0.f};
            if (ct <= rt) {
#pragma unroll
                for (int ks = 0; ks < 4; ++ks) { const bf16x8 af = *(const bf16x8*)(QT + (rt * 16 + fr) * HG_LDR + ks * 32 + fq * 8), bfv = *(const bf16x8*)(KT + (ct * 16 + fr) * HG_LDR + ks * 32 + fq * 8);
                    a = __builtin_amdgcn_mfma_f32_16x16x32_bf16(af, bfv, a, 0, 0, 0); } }
#pragma unroll
            for (int r = 0; r < 4; ++r) { const int c = rt * 16 + fq * 4 + r, sidx = ct * 16 + fr; AM[c * HG_LDC + sidx] = (bf16)((sidx <= c) ? f2bf(a[r]) : 0u); } }
        __syncthreads();
        const bf16x8 vb0 = *(const bf16x8*)(VT + (e0 + fr) * HG_LDC + fq * 8), vb1 = *(const bf16x8*)(VT + (e0 + fr) * HG_LDC + 32 + fq * 8);
        bf16x8 sb[4];
#pragma unroll
        for (int ks = 0; ks < 4; ++ks) { v4u t; t.x = pk2(S[2 * ks][0], S[2 * ks][1]); t.y = pk2(S[2 * ks][2], S[2 * ks][3]); t.z = pk2(S[2 * ks + 1][0], S[2 * ks + 1][1]); t.w = pk2(S[2 * ks + 1][2], S[2 * ks + 1][3]); sb[ks] = __builtin_bit_cast(bf16x8, t); }
        pg8::f32x4 o[4];
#pragma unroll
        for (int rt = 0; rt < 4; ++rt) { pg8::f32x4 a = {0.f, 0.f, 0.f, 0.f};
            a = __builtin_amdgcn_mfma_f32_16x16x32_bf16(*(const bf16x8*)(AM + (rt * 16 + fr) * HG_LDC + fq * 8), vb0, a, 0, 0, 0);
            a = __builtin_amdgcn_mfma_f32_16x16x32_bf16(*(const bf16x8*)(AM + (rt * 16 + fr) * HG_LDC + 32 + fq * 8), vb1, a, 0, 0, 0);
#pragma unroll
            for (int ks = 0; ks < 4; ++ks) { const v2u lo = *(const v2u*)(QE + (rt * 16 + fr) * HG_LDR + ks * 32 + fq * 4), hi = *(const v2u*)(QE + (rt * 16 + fr) * HG_LDR + ks * 32 + 16 + fq * 4);
                const v4u t = {lo.x, lo.y, hi.x, hi.y};
                a = __builtin_amdgcn_mfma_f32_16x16x32_bf16(__builtin_bit_cast(bf16x8, t), sb[ks], a, 0, 0, 0); }
            o[rt] = a; }
#pragma unroll
        for (int dt = 0; dt < 8; ++dt) { const f32x4 dc = *(const f32x4*)(DEC + dt * 16 + fq * 4);
            pg8::f32x4 a = S[dt]; a[0] *= dc[0]; a[1] *= dc[1]; a[2] *= dc[2]; a[3] *= dc[3];
            a = __builtin_amdgcn_mfma_f32_16x16x32_bf16(*(const bf16x8*)(KLT + (dt * 16 + fr) * HG_LDC + fq * 8), vb0, a, 0, 0, 0);
            a = __builtin_amdgcn_mfma_f32_16x16x32_bf16(*(const bf16x8*)(KLT + (dt * 16 + fr) * HG_LDC + 32 + fq * 8), vb1, a, 0, 0, 0);
            S[dt] = a; }
        if (half) {
#pragma unroll
            for (int rt = 0; rt < 4; ++rt) *(pg8::f32x4*)(OLg + ((((size_t)(chunk - 32)) * 8 + w) * 4 + rt) * 256 + lane * 4) = o[rt];
            __syncthreads();
            continue;
        }
#pragma unroll
        for (int rt = 0; rt < 4; ++rt)
#pragma unroll
            for (int r = 0; r < 4; ++r) { float x = o[rt][r] * o[rt][r];
                x += __shfl_xor(x, 1); x += __shfl_xor(x, 2); x += __shfl_xor(x, 4); x += __shfl_xor(x, 8);
                if (fr == 0) SSQ[w * 64 + rt * 16 + fq * 4 + r] = x; }
        __syncthreads();
        float tot = 0.f;
#pragma unroll
        for (int ww = 0; ww < 8; ++ww) tot += SSQ[ww * 64 + lane];
        const float rstd_l = rsqrtf(tot * (1.f / 128.f) + RMS_EPS);
#pragma unroll
        for (int rt = 0; rt < 4; ++rt)
#pragma unroll
            for (int r = 0; r < 4; ++r) { const int c = rt * 16 + fq * 4 + r; const float rs = __shfl(rstd_l, c);
                const float y = o[rt][r] * rs * ogv * siluf_(bf2f(rg[rt * 4 + r]));
                ((unsigned char*)YA)[(row0 + c) * 1024 + h * 128 + e0 + fr] = (unsigned char)(__builtin_amdgcn_cvt_pk_fp8_f32(y, 0.f, 0, false) & 0xff); }
    }
    if (!half) {
#pragma unroll
        for (int ks = 0; ks < 4; ++ks) { v4u t; t.x = pk2(S[2 * ks][0], S[2 * ks][1]); t.y = pk2(S[2 * ks][2], S[2 * ks][3]); t.z = pk2(S[2 * ks + 1][0], S[2 * ks + 1][1]); t.w = pk2(S[2 * ks + 1][2], S[2 * ks + 1][3]);
            *(v4u*)(ws + WS_HSB + ((((size_t)item * 8 + w) * 4 + ks) * 64 + lane) * 16) = t; }
    }
    __syncthreads();
}
__device__ __forceinline__ void hgrn_fix(const Params& p, unsigned char* lds, int item, int c) {
    const int b = item >> 2, h = item & 3;
    const int tid = threadIdx.x, w = tid >> 6, lane = tid & 63, fr = lane & 15, fq = lane >> 4;
    unsigned char* ws = p.ws;
    const bf16* HG = (const bf16*)(ws + WS_HG);
    bf16* YA = (bf16*)(ws + WS_H);
    float* SSQ = (float*)(lds + HGL_SSQ);
    const bf16* QCg = (const bf16*)(ws + WS_HQC) + (size_t)item * 2048 * 128; const float* OLg = (const float*)(ws + WS_HOL) + (size_t)item * 32 * 8 * 4 * 256;
    const int e0 = w * 16;
    const float ogv = p.hg_onorm_g[e0 + fr];
    const size_t row0 = (size_t)b * SEQ + (size_t)(32 + c) * 64;
    bf16x8 sb[4];
#pragma unroll
    for (int ks = 0; ks < 4; ++ks) sb[ks] = __builtin_bit_cast(bf16x8, *(const v4u*)(ws + WS_HSB + ((((size_t)item * 8 + w) * 4 + ks) * 64 + lane) * 16));
    unsigned short rg[16];
#pragma unroll
    for (int i = 0; i < 16; ++i) rg[i] = HG[(row0 + (i >> 2) * 16 + fq * 4 + (i & 3)) * LD_HG + 1536 + h * 128 + e0 + fr];
    pg8::f32x4 o[4];
#pragma unroll
    for (int rt = 0; rt < 4; ++rt) { pg8::f32x4 a = *(const pg8::f32x4*)(OLg + ((((size_t)c) * 8 + w) * 4 + rt) * 256 + lane * 4);
#pragma unroll
        for (int ks = 0; ks < 4; ++ks) { const bf16* qr = QCg + ((size_t)c * 64 + rt * 16 + fr) * 128 + ks * 32;
            const v2u lo = *(const v2u*)(qr + fq * 4), hi = *(const v2u*)(qr + 16 + fq * 4);
            const v4u t = {lo.x, lo.y, hi.x, hi.y};
            a = __builtin_amdgcn_mfma_f32_16x16x32_bf16(__builtin_bit_cast(bf16x8, t), sb[ks], a, 0, 0, 0); }
        o[rt] = a; }
#pragma unroll
    for (int rt = 0; rt < 4; ++rt)
#pragma unroll
        for (int r = 0; r < 4; ++r) { float x = o[rt][r] * o[rt][r];
            x += __shfl_xor(x, 1); x += __shfl_xor(x, 2); x += __shfl_xor(x, 4); x += __shfl_xor(x, 8);
            if (fr == 0) SSQ[w * 64 + rt * 16 + fq * 4 + r] = x; }
    __syncthreads();
    float tot = 0.f;
#pragma unroll
    for (int ww = 0; ww < 8; ++ww) tot += SSQ[ww * 64 + lane];
    const float rstd_l = rsqrtf(tot * (1.f / 128.f) + RMS_EPS);
#pragma unroll
    for (int rt = 0; rt < 4; ++rt)
#pragma unroll
        for (int r = 0; r < 4; ++r) { const int cc = rt * 16 + fq * 4 + r; const float rs = __shfl(rstd_l, cc);
            const float y = o[rt][r] * rs * ogv * siluf_(bf2f(rg[rt * 4 + r]));
            ((unsigned char*)YA)[(row0 + cc) * 1024 + h * 128 + e0 + fr] = (unsigned char)(__builtin_amdgcn_cvt_pk_fp8_f32(y, 0.f, 0, false) & 0xff); }
    __syncthreads();
}

__device__ __forceinline__ unsigned f16key(float x) {
    x = x + 0.f;
    const _Float16 hx = (_Float16)x; const unsigned short bits = __builtin_bit_cast(unsigned short, hx);
    return (bits & 0x8000u) ? (unsigned)(unsigned short)(~bits) : (unsigned)(bits | 0x8000u);
}
__device__ __forceinline__ void find_bin(const unsigned* hist, int K, int lane, int& bin, int& rem) {
    const v4u hv = *(const v4u*)(hist + 4 * lane);
    const unsigned c = hv.x + hv.y + hv.z + hv.w;
    unsigned suf = c;
#pragma unroll
    for (int o = 1; o < 64; o <<= 1) { const unsigned t = __shfl_down(suf, o); if (lane + o < 64) suf += t; }
    const unsigned above = suf - c;
    const bool mine = (above < (unsigned)K) && ((unsigned)K <= suf);
    int mybin = 0, myrem = 0;
    if (mine) { unsigned ca = above; const unsigned hh[4] = {hv.x, hv.y, hv.z, hv.w}; bool found = false;
#pragma unroll
        for (int i = 3; i >= 0; --i) { if (!found) { if (ca + hh[i] >= (unsigned)K) { mybin = 4 * lane + i; myrem = K - (int)ca; found = true; } else ca += hh[i]; } } }
    const unsigned long long m = __ballot(mine);
    const int src = (int)__builtin_ctzll(m | (1ull << 63));
    bin = __shfl(mybin, src); rem = __shfl(myrem, src);
}
__device__ __forceinline__ void dsa1_item(const Params& p, unsigned char* lds, int item) {
    const int b = item >> 8, q0 = (item & 255) * 16;
    const int tid = threadIdx.x, w = tid >> 6, lane = tid & 63, fr = lane & 15, fq = lane >> 4;
    unsigned char* ws = p.ws;
    const bf16* IDX = (const bf16*)(ws + WS_IDX);
    unsigned short* Ik = (unsigned short*)lds;
    unsigned* hist1 = (unsigned*)(lds + 131072);
    unsigned* hist = (unsigned*)(lds + 131072 + 16384) + w * 256;
    const size_t rowb = (size_t)b * SEQ;
    *(v4u*)(hist1 + tid * 4) = (v4u){0u, 0u, 0u, 0u}; *(v4u*)(hist1 + 2048 + tid * 4) = (v4u){0u, 0u, 0u, 0u};
    bf16x8 Af[8][2];
    { const bf16* rp = IDX + (rowb + q0 + fr) * LD_IDX + fq * 8;
#pragma unroll
      for (int h = 0; h < 8; ++h) { Af[h][0] = *(const bf16x8*)(rp + h * 64); Af[h][1] = *(const bf16x8*)(rp + h * 64 + 32); } }
    const float idx_scale = 0.5f * 0.125f * 0.35355339059327373f;
    bf16x8 Aw[2];
    { float wa[8];
      { const v4u wq = *(const v4u*)(IDX + (rowb + q0 + fr) * LD_IDX + 576);
#pragma unroll
        for (int i = 0; i < 4; ++i) { wa[2 * i] = bflo(wq[i]) * idx_scale; wa[2 * i + 1] = bfhi(wq[i]) * idx_scale; } }
#pragma unroll
      for (int ks = 0; ks < 2; ++ks) { float cq[8];
#pragma unroll
          for (int j = 0; j < 8; ++j) cq[j] = 0.f;
#pragma unroll
          for (int h = 0; h < 8; ++h)
#pragma unroll
              for (int j = 0; j < 8; ++j) cq[j] += wa[h] * bf2f((unsigned)(unsigned short)Af[h][ks][j]);
          const v4u t = {pk2(cq[0], cq[1]), pk2(cq[2], cq[3]), pk2(cq[4], cq[5]), pk2(cq[6], cq[7])};
          Aw[ks] = __builtin_bit_cast(bf16x8, t); } }
    float wv[4][8];
#pragma unroll
    for (int r = 0; r < 4; ++r) { const v4u wq = *(const v4u*)(IDX + (rowb + q0 + fq * 4 + r) * LD_IDX + 576);
#pragma unroll
        for (int i = 0; i < 4; ++i) { wv[r][2 * i] = bflo(wq[i]) * idx_scale; wv[r][2 * i + 1] = bfhi(wq[i]) * idx_scale; } }
    const int ntiles = (q0 >> 4) + 1;
    __syncthreads();
    bf16x8 B0 = Aw[0], B1 = Aw[1];
    if (w < ntiles) { const bf16* kp = IDX + (rowb + w * 16 + fr) * LD_IDX + 512 + fq * 8; B0 = *(const bf16x8*)kp; B1 = *(const bf16x8*)(kp + 32); }
    for (int kt = w; kt < ntiles; kt += NWAVES) {
        bf16x8 nB0 = B0, nB1 = B1;
        if (kt + NWAVES < ntiles) { const bf16* kp = IDX + (rowb + (kt + NWAVES) * 16 + fr) * LD_IDX + 512 + fq * 8; nB0 = *(const bf16x8*)kp; nB1 = *(const bf16x8*)(kp + 32); }
        pg8::f32x4 lin = {0.f, 0.f, 0.f, 0.f};
        lin = __builtin_amdgcn_mfma_f32_16x16x32_bf16(Aw[0], B0, lin, 0, 0, 0);
        lin = __builtin_amdgcn_mfma_f32_16x16x32_bf16(Aw[1], B1, lin, 0, 0, 0);
        float I[4] = {lin[0], lin[1], lin[2], lin[3]};
#pragma unroll
        for (int h = 0; h < 8; ++h) { pg8::f32x4 a = {0.f, 0.f, 0.f, 0.f};
            a = __builtin_amdgcn_mfma_f32_16x16x32_bf16(Af[h][0], B0, a, 0, 0, 0);
            a = __builtin_amdgcn_mfma_f32_16x16x32_bf16(Af[h][1], B1, a, 0, 0, 0);
#pragma unroll
            for (int r = 0; r < 4; ++r) I[r] = __builtin_fmaf(wv[r][h], __builtin_fabsf(a[r]), I[r]); }
        const int kidx = kt * 16 + fr;
#pragma unroll
        for (int r = 0; r < 4; ++r) { const unsigned key = f16key(I[r]); Ik[(fq * 4 + r) * 4096 + kidx] = (unsigned short)key;
            if (kidx <= q0 + fq * 4 + r) atomicAdd(&hist1[(fq * 4 + r) * 256 + (key >> 8)], 1u); }
        B0 = nB0; B1 = nB1;
    }
    __syncthreads();
    for (int qq = w; qq < 16; qq += NWAVES) {
        const int t = q0 + qq, n = t + 1;
        unsigned short* so = (unsigned short*)(hist1 + qq * 256);
        const unsigned short* keys = Ik + qq * 4096;
        if (n <= TOPK) { for (int j = lane; j < n; j += 64) so[j] = (unsigned short)j; }
        else {
            int b1, rem1, b2, rem2;
            find_bin(hist1 + qq * 256, TOPK, lane, b1, rem1);
            *(v4u*)(hist + 4 * lane) = (v4u){0u, 0u, 0u, 0u};
            LDS_WAIT(); __builtin_amdgcn_wave_barrier();
            for (int j = lane; j < n; j += 64) { const unsigned k = keys[j]; if ((int)(k >> 8) == b1) atomicAdd(&hist[k & 255u], 1u); }
            LDS_WAIT(); __builtin_amdgcn_wave_barrier();
            find_bin(hist, rem1, lane, b2, rem2);
            const unsigned thr = ((unsigned)b1 << 8) | (unsigned)b2;
            int base = 0, eqtaken = 0;
            const unsigned long long lt = (lane == 0) ? 0ull : (~0ull >> (64 - lane));
            for (int j0 = 0; j0 < n; j0 += 64) {
                const int j = j0 + lane; const bool valid = j < n; const unsigned k = valid ? (unsigned)keys[j] : 0u;
                const bool gt = valid && k > thr, eq = valid && k == thr;
                const unsigned long long meq = __ballot(eq);
                const int erank = __popcll(meq & lt) + eqtaken;
                const bool take = gt || (eq && erank < rem2);
                const unsigned long long mt = __ballot(take);
                if (take) so[base + __popcll(mt & lt)] = (unsigned short)j;
                base += __popcll(mt); eqtaken += __popcll(meq);
            }
        }
    }
    __syncthreads();
}

__device__ __forceinline__ void qknorm_token(const Params& p, int tok, int lane) {
    const bf16* row = (const bf16*)(p.ws + WS_ATT) + (size_t)tok * LD_ATT;
    const int c8 = (lane & 7) * 8;
    { const v4u qv = *(const v4u*)(row + lane * 8);
      float x[8]; float ss = 0.f;
#pragma unroll
      for (int i = 0; i < 4; ++i) { x[2 * i] = bflo(qv[i]); x[2 * i + 1] = bfhi(qv[i]); ss += x[2 * i] * x[2 * i] + x[2 * i + 1] * x[2 * i + 1]; }
      ss += __shfl_xor(ss, 1); ss += __shfl_xor(ss, 2); ss += __shfl_xor(ss, 4);
      const float rs = rsqrtf(ss * (1.f / 64.f) + RMS_EPS) * (0.125f * 1.4426950408889634f);
#pragma unroll
      for (int i = 0; i < 8; ++i) x[i] = x[i] * rs * p.q_norm_g[c8 + i];
      v2u hw, lw;
      hw.x = pk4_fp8(x[0], x[1], x[2], x[3]); hw.y = pk4_fp8(x[4], x[5], x[6], x[7]);
      { const f32x2 d0 = __builtin_amdgcn_cvt_pk_f32_fp8((int)hw.x, false), d1 = __builtin_amdgcn_cvt_pk_f32_fp8((int)hw.x, true), d2 = __builtin_amdgcn_cvt_pk_f32_fp8((int)hw.y, false), d3 = __builtin_amdgcn_cvt_pk_f32_fp8((int)hw.y, true);
        lw.x = pk4_fp8(x[0] - d0[0], x[1] - d0[1], x[2] - d1[0], x[3] - d1[1]); lw.y = pk4_fp8(x[4] - d2[0], x[5] - d2[1], x[6] - d3[0], x[7] - d3[1]); }
      *(v2u*)(p.ws + WS_QHI + (size_t)tok * 512 + lane * 8) = hw; *(v2u*)(p.ws + WS_QLO + (size_t)tok * 512 + lane * 8) = lw; }
    { const v4u kv = *(const v4u*)(row + 512 + (lane & 15) * 8);
      float x[8]; float ss = 0.f;
#pragma unroll
      for (int i = 0; i < 4; ++i) { x[2 * i] = bflo(kv[i]); x[2 * i + 1] = bfhi(kv[i]); ss += x[2 * i] * x[2 * i] + x[2 * i + 1] * x[2 * i + 1]; }
      ss += __shfl_xor(ss, 1); ss += __shfl_xor(ss, 2); ss += __shfl_xor(ss, 4);
      const float rs = rsqrtf(ss * (1.f / 64.f) + RMS_EPS);
#pragma unroll
      for (int i = 0; i < 8; ++i) x[i] = x[i] * rs * p.k_norm_g[c8 + i];
      v2u o; o.x = pk4_fp8(x[0], x[1], x[2], x[3]); o.y = pk4_fp8(x[4], x[5], x[6], x[7]);
      if (lane < 16) *(v2u*)(p.ws + WS_K8 + (size_t)tok * 128 + lane * 8) = o; }
}

typedef short v4i16_t __attribute__((ext_vector_type(4)));
__device__ __forceinline__ v4i16_t vtr16(const bf16* ldsp) { return __builtin_amdgcn_ds_read_tr16_b64_v4i16((LAS v4i16_t*)ldsp); }
__device__ __forceinline__ void dsa2_query(const Params& p, unsigned char* ldsw, const unsigned short* sel, int b, int t, int lane) {
    unsigned char* ws = p.ws;
    const bf16* ATT = (const bf16*)(ws + WS_ATT);
    bf16* YB = (bf16*)(ws + WS_H);
    unsigned short* sl = (unsigned short*)ldsw;
    float* df = (float*)(ldsw + 512);
    bf16* Vl = (bf16*)(ldsw + 1536);
    const int fr = lane & 15, fq = lane >> 4;
    const size_t rowb = (size_t)b * SEQ;
    const int cnt = (t + 1 < TOPK) ? (t + 1) : TOPK;
    { v2u sv = *(const v2u*)(sel + lane * 4);
      const int j0 = lane * 4;
      if (j0 >= cnt) sv.x = 0u; else if (j0 + 1 >= cnt) sv.x &= 0xffffu;
      if (j0 + 2 >= cnt) sv.y = 0u; else if (j0 + 3 >= cnt) sv.y &= 0xffffu;
      *(v2u*)(sl + lane * 4) = sv;
      f32x4 d4; d4[0] = (j0 < cnt) ? (float)(t - (int)(sv.x & 0xffffu)) : INFINITY; d4[1] = (j0 + 1 < cnt) ? (float)(t - (int)(sv.x >> 16)) : INFINITY;
      d4[2] = (j0 + 2 < cnt) ? (float)(t - (int)(sv.y & 0xffffu)) : INFINITY; d4[3] = (j0 + 3 < cnt) ? (float)(t - (int)(sv.y >> 16)) : INFINITY;
      *(f32x4*)(df + lane * 4) = d4; }
    LDS_WAIT(); __builtin_amdgcn_wave_barrier();
    const unsigned char* K8 = ws + WS_K8;
    long qhA[2] = {0, 0}, qhB[2] = {0, 0}, qlA[2] = {0, 0}, qlB[2] = {0, 0};
    if (fr < 8) { const v4u qh = *(const v4u*)(ws + WS_QHI + (rowb + t) * 512 + fr * 64 + fq * 16), ql = *(const v4u*)(ws + WS_QLO + (rowb + t) * 512 + fr * 64 + fq * 16);
        const long hA = (long)(((unsigned long long)qh.y << 32) | qh.x), hB = (long)(((unsigned long long)qh.w << 32) | qh.z), lA = (long)(((unsigned long long)ql.y << 32) | ql.x), lB = (long)(((unsigned long long)ql.w << 32) | ql.z);
        if (fr < 4) { qhA[0] = hA; qhB[0] = hB; qlA[0] = lA; qlB[0] = lB; } else { qhA[1] = hA; qhB[1] = hB; qlA[1] = lA; qlB[1] = lB; } }
    pg8::f32x4 sc[16];
    v4u vv[16];
    { v4u kf[16];
#pragma unroll
      for (int half = 0; half < 2; ++half) {
#pragma unroll
          for (int kt = 0; kt < 8; ++kt) { const int s = sl[(half * 8 + kt) * 16 + fr]; const unsigned char* kp = K8 + (rowb + s) * 128 + fq * 16;
              kf[2 * kt] = *(const v4u*)kp; kf[2 * kt + 1] = *(const v4u*)(kp + 64); }
          if (half == 1) {
#pragma unroll
              for (int i = 0; i < 8; ++i) { const int s = sl[i * 8 + (lane >> 3)]; vv[i] = *(const v4u*)(ATT + (rowb + s) * LD_ATT + 640 + (lane & 7) * 8); } }
          __builtin_amdgcn_sched_barrier(0);
#pragma unroll
          for (int kt = 0; kt < 8; ++kt) { pg8::f32x4 a = {0.f, 0.f, 0.f, 0.f};
#pragma unroll
              for (int gg = 0; gg < 2; ++gg) { const v4u kv = kf[2 * kt + gg];
                  const long kA = (long)(((unsigned long long)kv.y << 32) | kv.x), kB = (long)(((unsigned long long)kv.w << 32) | kv.z);
                  a = __builtin_amdgcn_mfma_f32_16x16x32_fp8_fp8(kA, qhA[gg], a, 0, 0, 0); a = __builtin_amdgcn_mfma_f32_16x16x32_fp8_fp8(kB, qhB[gg], a, 0, 0, 0);
                  a = __builtin_amdgcn_mfma_f32_16x16x32_fp8_fp8(kA, qlA[gg], a, 0, 0, 0); a = __builtin_amdgcn_mfma_f32_16x16x32_fp8_fp8(kB, qlB[gg], a, 0, 0, 0); }
              sc[half * 8 + kt] = a; }
          __builtin_amdgcn_sched_barrier(0);
      } }
    const float slope = exp2f(-(float)((fr & 7) + 1)) * 1.4426950408889634f;
    float m = -INFINITY;
#pragma unroll
    for (int kt = 0; kt < 16; ++kt) { const f32x4 d4 = *(const f32x4*)(df + kt * 16 + fq * 4);
#pragma unroll
        for (int r = 0; r < 4; ++r) { const float x = sc[kt][r] - slope * d4[r]; sc[kt][r] = x; m = fmaxf(m, x); } }
    m = fmaxf(m, __shfl_xor(m, 16)); m = fmaxf(m, __shfl_xor(m, 32));
    float l = 0.f;
#pragma unroll
    for (int kt = 0; kt < 16; ++kt)
#pragma unroll
        for (int r = 0; r < 4; ++r) { const float e = __builtin_amdgcn_exp2f(sc[kt][r] - m); sc[kt][r] = e; l += e; }
    l += __shfl_xor(l, 16); l += __shfl_xor(l, 32);
    const float inv = 1.f / l;
#pragma unroll 1
    for (int g = 0; g < 2; ++g) {
        if (g == 1) {
#pragma unroll
            for (int i = 0; i < 8; ++i) { const int s = sl[i * 8 + (lane >> 3)]; vv[i] = *(const v4u*)(ATT + (rowb + s) * LD_ATT + 640 + 64 + (lane & 7) * 8); } }
#pragma unroll
        for (int i = 8; i < 16; ++i) { const int s = sl[i * 8 + (lane >> 3)]; vv[i] = *(const v4u*)(ATT + (rowb + s) * LD_ATT + 640 + g * 64 + (lane & 7) * 8); }
        pg8::f32x4 o[4];
#pragma unroll
        for (int dt = 0; dt < 4; ++dt) o[dt] = (pg8::f32x4){0.f, 0.f, 0.f, 0.f};
#pragma unroll
        for (int ch = 0; ch < 4; ++ch) {
            LDS_WAIT(); __builtin_amdgcn_wave_barrier();
#pragma unroll
            for (int i = 0; i < 8; ++i) *(v4u*)(Vl + (i * 8 + (lane >> 3)) * 80 + (lane & 7) * 8) = vv[(ch & 1) * 8 + i];
            if (ch < 2) {
#pragma unroll
                for (int i = 0; i < 8; ++i) { const int s = sl[((ch + 2) * 8 + i) * 8 + (lane >> 3)]; vv[(ch & 1) * 8 + i] = *(const v4u*)(ATT + (rowb + s) * LD_ATT + 640 + g * 64 + (lane & 7) * 8); } }
            LDS_WAIT(); __builtin_amdgcn_wave_barrier();
#pragma unroll
            for (int k2 = 0; k2 < 2; ++k2) { const int kt0 = ch * 4 + 2 * k2;
                v4u pw; pw.x = pk2(sc[kt0][0], sc[kt0][1]); pw.y = pk2(sc[kt0][2], sc[kt0][3]); pw.z = pk2(sc[kt0 + 1][0], sc[kt0 + 1][1]); pw.w = pk2(sc[kt0 + 1][2], sc[kt0 + 1][3]);
                const bf16x8 pb = __builtin_bit_cast(bf16x8, pw);
#pragma unroll
                for (int dt = 0; dt < 4; ++dt) { const bf16* vp = Vl + ((2 * k2) * 16 + fq * 4 + (fr >> 2)) * 80 + dt * 16 + (fr & 3) * 4;
                    const v4i16_t lo = vtr16(vp), hi = vtr16(vp + 16 * 80);
                    const bf16x8 af = {lo[0], lo[1], lo[2], lo[3], hi[0], hi[1], hi[2], hi[3]};
                    o[dt] = __builtin_amdgcn_mfma_f32_16x16x32_bf16(af, pb, o[dt], 0, 0, 0); } }
        }
        if (fr < 8 && (fr >> 2) == g) {
#pragma unroll
            for (int dt = 0; dt < 4; ++dt) { const float i8 = inv * 8.f;
                *(unsigned*)((unsigned char*)YB + (rowb + t) * 1024 + 512 + fr * 64 + dt * 16 + fq * 4) = pk4_fp8(o[dt][0] * i8, o[dt][1] * i8, o[dt][2] * i8, o[dt][3] * i8); } }
    }
    LDS_WAIT(); __builtin_amdgcn_wave_barrier();
}

#define INS16(L, x) do { _Pragma("unroll") for (int _i = 15; _i >= 1; --_i) L[_i] = __builtin_amdgcn_fmed3f(L[_i - 1], L[_i], (x)); L[0] = fmaxf(L[0], (x)); } while (0)
__device__ __forceinline__ float f_andor(float v, unsigned keepmask, unsigned orv) { return __builtin_bit_cast(float, (__builtin_bit_cast(unsigned, v) & keepmask) | orv); }
__device__ __forceinline__ void peer_select(const Params& p, unsigned char* ldsw, int tg, int h, int lane, int* EIDX, float* GATES) {
    float* sc = (float*)ldsw;
    LDS_WAIT(); __builtin_amdgcn_wave_barrier();
    float L[16];
#pragma unroll
    for (int i = 0; i < 16; ++i) L[i] = -INFINITY;
    { const float* sp = sc + (lane & 31) * 132 + (lane >> 5) * 64;
#pragma unroll 4
      for (int i = 0; i < 16; ++i) { const f32x4 x = *(const f32x4*)(sp + 4 * i); INS16(L, x[0]); INS16(L, x[1]); INS16(L, x[2]); INS16(L, x[3]); } }
    { float O[16];
#pragma unroll
      for (int i = 0; i < 16; ++i) O[i] = __shfl_xor(L[i], 32);
#pragma unroll
      for (int i = 0; i < 16; ++i) INS16(L, O[i]); }
    LDS_WAIT(); __builtin_amdgcn_wave_barrier();
    float* lst = sc;
    if (lane < 32) {
#pragma unroll
        for (int i = 0; i < 4; ++i) *(f32x4*)(lst + lane * 16 + 4 * i) = (f32x4){L[4 * i], L[4 * i + 1], L[4 * i + 2], L[4 * i + 3]}; }
    LDS_WAIT(); __builtin_amdgcn_wave_barrier();
    const int tok = lane & 15;
    float s1[16], s2[16];
#pragma unroll
    for (int i = 0; i < 4; ++i) { const f32x4 a = *(const f32x4*)(lst + tok * 16 + 4 * i), b = *(const f32x4*)(lst + (16 + tok) * 16 + 4 * i);
#pragma unroll
        for (int c = 0; c < 4; ++c) { s1[4 * i + c] = f_andor(a[c], ~127u, 0u); s2[4 * i + c] = f_andor(b[c], ~127u, 0u); } }
    float M[16];
#pragma unroll
    for (int i = 0; i < 16; ++i) M[i] = -INFINITY;
#pragma unroll
    for (int a = 0; a < 16; ++a)
#pragma unroll
        for (int b = 0; b < 16; ++b)
            if ((a + 1) * (b + 1) <= 16) { const float key = f_andor(s1[a] + s2[b], ~255u, (unsigned)(a * 16 + b)); INS16(M, key); }
    const float mx = f_andor(M[0], ~255u, 0u);
    float e[16], sum = 0.f; int ei[16];
    const unsigned* lb = (const unsigned*)lst;
#pragma unroll
    for (int i = 0; i < 16; ++i) { const unsigned bits = __builtin_bit_cast(unsigned, M[i]); const int flat = bits & 255u;
        e[i] = __expf(f_andor(M[i], ~255u, 0u) - mx); sum += e[i];
        ei[i] = (int)(lb[tok * 16 + (flat >> 4)] & 127u) * 128 + (int)(lb[(16 + tok) * 16 + (flat & 15)] & 127u); }
    const float inv = 1.f / sum;
    if (lane < 16) {
        const size_t ob = ((size_t)tok * 8 + h) * 16;
#pragma unroll
        for (int i = 0; i < 4; ++i) { *(v4u*)(EIDX + ob + 4 * i) = (v4u){(unsigned)ei[4 * i], (unsigned)ei[4 * i + 1], (unsigned)ei[4 * i + 2], (unsigned)ei[4 * i + 3]};
            *(f32x4*)(GATES + ob + 4 * i) = (f32x4){e[4 * i] * inv, e[4 * i + 1] * inv, e[4 * i + 2] * inv, e[4 * i + 3] * inv}; }
    }
    LDS_WAIT(); __builtin_amdgcn_wave_barrier();
}

__device__ __forceinline__ void peer_route_block(const Params& p, unsigned char* lds, int* eG, float* gG) {
    const int tid = threadIdx.x, wave = tid >> 6, lane = tid & 63, fr = lane & 15, fq = lane >> 4, G = gridDim.x;
    unsigned char* ws = p.ws;
    const bf16* Q = (const bf16*)(ws + WS_Q);
    const unsigned char* SKb = ws + WS_SK;
    unsigned char* tile = lds + 8 * 16896;
    float* sc = (float*)(lds + wave * 16896);
    int ngrp = 0;
    for (int tg = blockIdx.x; tg < T / 16; tg += G) ++ngrp;
#pragma unroll 1
    for (int k0 = 0; k0 < ngrp; k0 += 8) {
        const bool valid = k0 + wave < ngrp;
        const int tg = (int)blockIdx.x + (valid ? k0 + wave : k0) * G;
        v4u t0, t1;
        { const unsigned char* sp = SKb + tid * 32; t0 = *(const v4u*)sp; t1 = *(const v4u*)(sp + 16); }
#pragma unroll 1
        for (int h = 0; h < 8; ++h) {
            bf16x8 Af[4];
#pragma unroll
            for (int sub = 0; sub < 4; ++sub) {
                const int pp = sub >> 1, half = sub & 1;
                __syncthreads();
                { unsigned char* wp = tile + (tid >> 3) * 272 + (tid & 7) * 32; *(v4u*)wp = t0; *(v4u*)(wp + 16) = t1; }
                { const int nt_ = (h * 4 + sub + 1) & 31;
                  const unsigned char* sp = SKb + (size_t)nt_ * 16384 + tid * 32; t0 = *(const v4u*)sp; t1 = *(const v4u*)(sp + 16); }
                if (half == 0) { const bf16* rp = Q + (size_t)(tg * 16 + fr) * 2048 + h * 256 + pp * 128 + fq * 8;
#pragma unroll
                    for (int ks = 0; ks < 4; ++ks) Af[ks] = *(const bf16x8*)(rp + ks * 32); }
                __syncthreads();
#pragma unroll
                for (int kt = 0; kt < 4; ++kt) {
                    pg8::f32x4 a = {0.f, 0.f, 0.f, 0.f};
#pragma unroll
                    for (int ks = 0; ks < 4; ++ks) { const bf16x8 bv = *(const bf16x8*)(tile + (kt * 16 + fr) * 272 + ks * 64 + fq * 16); a = __builtin_amdgcn_mfma_f32_16x16x32_bf16(Af[ks], bv, a, 0, 0, 0); }
                    const int kg = (half * 4 + kt) * 16 + fr;
#pragma unroll
                    for (int r = 0; r < 4; ++r) sc[(pp * 16 + fq * 4 + r) * 132 + kg] = f_andor(a[r], ~127u, (unsigned)kg);
                }
            }
            if (valid) peer_select(p, (unsigned char*)sc, tg, h, lane, eG + (size_t)tg * 2048, gG + (size_t)tg * 2048);
        }
    }
}

__device__ __forceinline__ float gelu_erf(float x) { return 0.5f * x * (1.f + erff(x * 0.70710678118654752f)); }
typedef int v8i_t __attribute__((ext_vector_type(8)));
template <int OPSEL> __device__ __forceinline__ pg8::f32x4 mx_dot(v8i_t a, int sa, v8i_t b, int sb, pg8::f32x4 c) {
    return __builtin_amdgcn_mfma_scale_f32_16x16x128_f8f6f4(a, b, c, 4  , 4  , OPSEL, sa, OPSEL, sb);
}
__device__ __forceinline__ void peer_token(const Params& p, unsigned char* ldsw, const _Float16* usL, const _Float16* vsL, unsigned char* tile, int tok, int lane, const v2u nxt_e, const v2u nxt_g, int buf) {
    unsigned char* ws = p.ws;
    const unsigned char* V8 = ws + WS_V;
    const float* MOD = (const float*)(ws + WS_MOD);
    const int fr = lane & 15, fq = lane >> 4;
    typedef v8i_t v8i;
    const int* EIDX = (const int*)(ldsw + buf * 1024); const float* GATES = (const float*)(ldsw + buf * 1024 + 512);
    v4u A4[H4_NT][8]; v2u As[H4_NT];
#pragma unroll
    for (int t = 0; t < H4_NT; ++t) { const unsigned char* hp = ws + WS_H4D + ((size_t)tok * H4_NT + t) * 512 + fq * 16;
        As[t] = *(const v2u*)(ws + WS_H4S + ((size_t)tok * H4_NT + t) * 32 + fq * 8);
#pragma unroll
        for (int kk = 0; kk < 8; ++kk) A4[t][kk] = *(const v4u*)(hp + kk * 64); }
    int* pe = (int*)(ldsw + 2048); float* pa = (float*)(ldsw + 2048 + 512);
    const unsigned char* U4 = ws + WS_U;
    const int gr = lane >> 3, gs = lane & 7;
    const int rdbase = (fr >> 3) * 1024 + (fr & 7) * 128, slotA = (fq ^ (fr & 7) ^ (fr >> 3)) & 7;
    v4u G[8];
#define U_LOADS(CT) do { const int e0_ = EIDX[(CT) * 16 + gr], e1_ = EIDX[(CT) * 16 + 8 + gr]; \
        const unsigned char* p0_ = U4 + (size_t)e0_ * 512 + ((gs ^ gr) & 7) * 16; const unsigned char* p1_ = U4 + (size_t)e1_ * 512 + ((gs ^ gr ^ 1) & 7) * 16; \
        _Pragma("unroll") for (int kk = 0; kk < 8; ++kk) G[kk] = *(const v4u*)(((kk & 1) ? p1_ : p0_) + (kk >> 1) * 128); } while (0)
    U_LOADS(0);
#pragma unroll 1
    for (int ct = 0; ct < 8; ++ct) {
        const int eic = EIDX[ct * 16 + fr]; const float gt = GATES[ct * 16 + fr];
#pragma unroll
        for (int kk = 0; kk < 8; ++kk) *(v4u*)(tile + kk * 1024 + lane * 16) = G[kk];
        __builtin_amdgcn_sched_barrier(0);
        U_LOADS((ct + 1) & 7);
        __builtin_amdgcn_sched_barrier(0);
        LDS_WAIT(); __builtin_amdgcn_wave_barrier();
        v4u Bt[8];
#pragma unroll
        for (int j = 0; j < 8; ++j) Bt[j] = *(const v4u*)(tile + (j >> 1) * 2048 + rdbase + (((j & 1) ? (slotA ^ 4) : slotA) * 16));
        LDS_WAIT(); __builtin_amdgcn_wave_barrier();
        pg8::f32x4 ah = {0.f, 0.f, 0.f, 0.f};
#pragma unroll
        for (int kk = 0; kk < 8; ++kk) { const v4u bu = Bt[kk];
            const v8i bb = {(int)bu.x, (int)bu.y, (int)bu.z, (int)bu.w, 0, 0, 0, 0};
            const int sb = 0x7f7f7f7f;
#pragma unroll
            for (int t = 0; t < H4_NT; ++t) { const v8i aa = {(int)A4[t][kk].x, (int)A4[t][kk].y, (int)A4[t][kk].z, (int)A4[t][kk].w, 0, 0, 0, 0}; const int sa = (int)((kk < 4) ? As[t].x : As[t].y);
                if ((kk & 3) == 0) ah = mx_dot<0>(aa, sa, bb, sb, ah); else if ((kk & 3) == 1) ah = mx_dot<1>(aa, sa, bb, sb, ah); else if ((kk & 3) == 2) ah = mx_dot<2>(aa, sa, bb, sb, ah); else ah = mx_dot<3>(aa, sa, bb, sb, ah); } }
        const float dot = ah[0] * (float)usL[eic];
        if (fq == 0) { pe[ct * 16 + fr] = eic; pa[ct * 16 + fr] = gelu_erf(dot) * gt * (float)vsL[eic]; }
    }
    asm volatile("" :: "v"(G[0]), "v"(G[1]), "v"(G[2]), "v"(G[3]), "v"(G[4]), "v"(G[5]), "v"(G[6]), "v"(G[7]));
#undef U_LOADS
    __builtin_amdgcn_sched_barrier(0);
    { int* ne = (int*)(ldsw + (buf ^ 1) * 1024); float* ng = (float*)(ldsw + (buf ^ 1) * 1024 + 512);
      *(v2u*)(ne + 2 * lane) = nxt_e; *(v2u*)(ng + 2 * lane) = nxt_g; }
    const int hl = lane >> 5, bl = lane & 31;
    float acc[32];
#pragma unroll
    for (int i = 0; i < 32; ++i) acc[i] = 0.f;
    LDS_WAIT(); __builtin_amdgcn_wave_barrier();
#pragma unroll 1
    for (int ct = 0; ct < 16; ++ct)
#pragma unroll
        for (int jp = 0; jp < 4; ++jp) {
            const int idx = pe[ct * 8 + 2 * jp + hl]; const float as = pa[ct * 8 + 2 * jp + hl];
            const v4u vv = *(const v4u*)(V8 + (size_t)idx * 512 + bl * 16);
#pragma unroll
            for (int w4 = 0; w4 < 4; ++w4) { const unsigned wd = vv[w4];
                const f32x2 d0 = __builtin_amdgcn_cvt_scalef32_pk_f32_fp4(wd, 1.0f, 0), d1 = __builtin_amdgcn_cvt_scalef32_pk_f32_fp4(wd, 1.0f, 1), d2 = __builtin_amdgcn_cvt_scalef32_pk_f32_fp4(wd, 1.0f, 2), d3 = __builtin_amdgcn_cvt_scalef32_pk_f32_fp4(wd, 1.0f, 3);
                acc[8 * w4] += as * d0[0]; acc[8 * w4 + 1] += as * d0[1]; acc[8 * w4 + 2] += as * d1[0]; acc[8 * w4 + 3] += as * d1[1];
                acc[8 * w4 + 4] += as * d2[0]; acc[8 * w4 + 5] += as * d2[1]; acc[8 * w4 + 6] += as * d3[0]; acc[8 * w4 + 7] += as * d3[1]; }
        }
    LDS_WAIT(); __builtin_amdgcn_wave_barrier();
    float accs[16];
#pragma unroll
    for (int i = 0; i < 16; ++i) { const float lo = acc[i] + __shfl_xor(acc[i], 32), hi2 = acc[16 + i] + __shfl_xor(acc[16 + i], 32); accs[i] = hl ? hi2 : lo; }
    const int b = tok / SEQ;
    const int col0 = bl * 32 + hl * 16;
    const float* g2 = MOD + (size_t)b * 6144 + 5 * 1024 + col0;
    float* orow = p.out + (size_t)tok * DM + col0;
#pragma unroll
    for (int q4 = 0; q4 < 4; ++q4) { const f32x4 xv = *(const f32x4*)(orow + 4 * q4), gv = *(const f32x4*)(g2 + 4 * q4);
        f32x4 o;
#pragma unroll
        for (int i = 0; i < 4; ++i) o[i] = xv[i] + gv[i] * accs[4 * q4 + i];
        *(f32x4*)(orow + 4 * q4) = o; }
}

#define XB_TMO      128
#define XB_XCNT(j)  (256  + 64 * (j))
#define XB_XSUB(j)  (1280 + 64 * (j))
#define XB_XGEN(j)  (2304 + 64 * (j))
#define XB_TOP      3328
#define XB_TOPGEN   3392
#define XCD_BAR_WORDS 3456
#define XB_SPIN_CAP (1u << 18)

__device__ __forceinline__ unsigned xb_ld(unsigned* p)              { return __hip_atomic_load(p, __ATOMIC_RELAXED, __HIP_MEMORY_SCOPE_AGENT); }
__device__ __forceinline__ unsigned xb_add(unsigned* p, unsigned v) { return __hip_atomic_fetch_add(p, v, __ATOMIC_RELAXED, __HIP_MEMORY_SCOPE_AGENT); }
__device__ __forceinline__ unsigned xb_xcc_id() { return (unsigned)__builtin_amdgcn_s_getreg((3 << 11) | 20) & 0xFu; }
#define XB_SPIN(cond, bar) do { unsigned _sp = 0; while (cond) { __builtin_amdgcn_s_sleep(1); \
    if ((++_sp & 255u) == 0u) { if (xb_ld(&(bar)[XB_TMO])) break; if (_sp > XB_SPIN_CAP) { atomicAdd(&(bar)[XB_TMO], 1u); break; } } } } while (0)

struct XcdBarrier {
    unsigned* bar; unsigned x;
    volatile LAS unsigned* st;
};

__device__ __forceinline__ XcdBarrier xcd_barrier_post(unsigned* bar, volatile LAS unsigned* st) {
    XcdBarrier b; b.bar = bar; b.x = xb_xcc_id(); b.st = st;
    if (threadIdx.x == 0) (void)xb_add(&bar[XB_XCNT(b.x)], 1u);
    return b;
}
__device__ __forceinline__ void xcd_barrier_complete(unsigned* bar, unsigned x, unsigned& nloc, unsigned& nx) {
    const unsigned G = gridDim.x * gridDim.y * gridDim.z;
    unsigned sum, cnt, mine, sp = 0u;
    for (;;) {
        sum = 0u; cnt = 0u; mine = 0u;
#pragma unroll
        for (unsigned j = 0; j < 16; ++j) { const unsigned c = xb_ld(&bar[XB_XCNT(j)]); sum += c; cnt += (c > 0u) ? 1u : 0u; mine = (j == x) ? c : mine; }
        if (sum == G) break;
        __builtin_amdgcn_s_sleep(1);
        if ((++sp & 255u) == 0u) { if (xb_ld(&bar[XB_TMO])) break; if (sp > XB_SPIN_CAP) { atomicAdd(&bar[XB_TMO], 1u); break; } }
    }
    nloc = mine > 0u ? mine : 1u; nx = cnt > 0u ? cnt : 1u;
}

__device__ __forceinline__ void xcd_barrier(const XcdBarrier& b) {
    asm volatile("s_waitcnt vmcnt(0)" ::: "memory");
    __syncthreads();
    if (threadIdx.x == 0) {
        unsigned* bar = b.bar;
        __builtin_amdgcn_s_waitcnt(0);
        unsigned nloc = b.st[0], nx = b.st[1];
        if (nloc == 0u) { xcd_barrier_complete(bar, b.x, nloc, nx); b.st[0] = nloc; b.st[1] = nx; }
        const unsigned old = xb_add(&bar[XB_XSUB(b.x)], 1u);
        const unsigned gen = old / nloc;
        if (old + 1u == (gen + 1u) * nloc) {
            __builtin_amdgcn_fence(__ATOMIC_RELEASE, "agent");
            asm volatile("s_waitcnt vmcnt(0)" ::: "memory");
            const unsigned og = xb_add(&bar[XB_TOP], 1u);
            const unsigned tg = og / nx;
            if (og + 1u == (tg + 1u) * nx) xb_add(&bar[XB_TOPGEN], 1u);
            else XB_SPIN(xb_ld(&bar[XB_TOPGEN]) == tg, bar);
            __builtin_amdgcn_fence(__ATOMIC_ACQUIRE, "agent");
            xb_add(&bar[XB_XGEN(b.x)], 1u);
            asm volatile("s_waitcnt vmcnt(0)" ::: "memory");
        } else {
            XB_SPIN(xb_ld(&bar[XB_XGEN(b.x)]) == gen, bar);
            __builtin_amdgcn_fence(__ATOMIC_ACQUIRE, "agent");
            asm volatile("s_waitcnt vmcnt(0)" ::: "memory");
        }
    }
    __syncthreads();
}

constexpr int NPHASE = 11;
__global__ void __launch_bounds__(NTHREADS, 2) mega(Params p) {
    extern __shared__ __attribute__((aligned(16))) unsigned char lds[];
    cg::grid_group grid = cg::this_grid();
    const int lo = p.ph_lo, hi = p.ph_hi;
    const int tid = threadIdx.x, wave = tid >> 6, lane = tid & 63, G = gridDim.x;
    unsigned char* ws = p.ws;
#ifndef ONLYPH
#define IN(k) (lo <= (k) && (k) < hi)
#else
#define IN(k) ((k) == ONLYPH && lo <= (k) && (k) < hi)
#endif
    volatile LAS unsigned* xb_st = (volatile LAS unsigned*)((LAS unsigned char*)lds + (LDS_BYTES - 16));
    if (tid < 4) xb_st[tid] = 0u;
    __syncthreads();
    XcdBarrier xbar; xbar.bar = (unsigned*)(ws + WS_CTL); xbar.x = 0; xbar.st = xb_st;
    if (hi - lo > 1) xbar = xcd_barrier_post((unsigned*)(ws + WS_CTL), xb_st);
    if (lo < -1) grid.sync();
#define SEAM(k) do { if (IN((k) + 1)) xcd_barrier(xbar); } while (0)
#ifndef REPMASK
#define REPMASK 0
#endif
#define NREP(k) (((REPMASK >> (k)) & 1) ? 2 : 1)
    if (IN(0)) { for (int rep = 0; rep < NREP(0); ++rep) phase0(p, lds); SEAM(0); }
    if (IN(1)) { for (int rep = 0; rep < NREP(1); ++rep) normmod_phase<true>(p, lds, p.x, (bf16*)(ws + WS_H), p.norm1_g, 0, 1024); SEAM(1); }
    if (IN(2)) {
        { pg8::Gemm g{(const bf16*)(ws + WS_H8), (const bf16*)(ws + WS_WIN8), T, 3584, 512, 512, 512}; pg8::StaticOrder S; S.init(T, 3584, G, (int)blockIdx.x);
          EpiProj E{(bf16*)(ws + WS_HG), (bf16*)(ws + WS_ATT), (bf16*)(ws + WS_IDX), (bf16*)(ws + WS_GATE), 1};
          pg8::gemm_phase<EpiProj, pg8::StaticOrder, true, true, 122>((PG8_LAS unsigned char*)lds, g, S, E); }
        { pg8::Gemm g{(const bf16*)(ws + WS_H), (const bf16*)(ws + WS_WIN), T, 2048, 1024, 1024, 1024}; pg8::StaticOrder S; S.init(T, 2048, G, (int)blockIdx.x);
          EpiProj E{(bf16*)(ws + WS_HG), (bf16*)(ws + WS_ATT), (bf16*)(ws + WS_IDX), (bf16*)(ws + WS_GATE), 0};
          pg8::gemm_phase<EpiProj, pg8::StaticOrder, true, true>((PG8_LAS unsigned char*)lds, g, S, E); }
        SEAM(2);
    }
    if (IN(3)) {
        for (int tok = (int)blockIdx.x * NWAVES + wave; tok < T; tok += G * NWAVES) qknorm_token(p, tok, lane);
        SEAM(3);
    }
    if (IN(4)) {
        if ((int)blockIdx.x < 32) hgrn_item<0>(p, lds, (int)blockIdx.x); else if ((int)blockIdx.x < 64) hgrn_item<1>(p, lds, (int)blockIdx.x - 32);
        {
            unsigned* qctr = (unsigned*)(ws + WS_CTL + 32768);
            volatile LAS unsigned* qslot = (volatile LAS unsigned*)((LAS unsigned char*)lds + (LDS_BYTES - 32));
            int qsel = (int)(blockIdx.x & 7u), tried = 0;
            for (;;) {
                if (tid == 0) { unsigned c;
                    for (;;) { c = __hip_atomic_fetch_add(qctr + qsel * 64, 1u, __ATOMIC_RELAXED, __HIP_MEMORY_SCOPE_AGENT); if (c < (unsigned)(SEQ / 16) || tried >= 7) break; qsel = (qsel + 1) & 7; ++tried; }
                    *qslot = (c < (unsigned)(SEQ / 16)) ? (((unsigned)qsel << 16) | c) : 0xffffffffu; }
                __syncthreads();
                const unsigned c = *qslot;
                __syncthreads();
                if (c == 0xffffffffu) break;
                const int b = (int)(c >> 16), qblk = (SEQ / 16 - 1) - (int)(c & 0xffffu), it = b * (SEQ / 16) + qblk, q0 = qblk * 16;
                dsa1_item(p, lds, it);
#pragma unroll 1
                for (int k2 = 0; k2 < 2; ++k2) dsa2_query(p, lds + wave * 16384, (const unsigned short*)(lds + 131072 + (wave + 8 * k2) * 1024), b, q0 + wave + 8 * k2, lane);
                __syncthreads();
            }
        }
        if (hi - lo > 1) xcd_barrier(xbar);
        for (int u = blockIdx.x; u < 32 * 32; u += G) hgrn_fix(p, lds, u >> 5, u & 31);
        SEAM(4);
    }
    if (IN(5)) {
        pg8::Gemm g{(const bf16*)(ws + WS_H), (const bf16*)(ws + WS_WAB8), T, 1024, 256, 512, 512}; pg8::StaticOrderT<true> S; S.init(T, 1024, G, (int)blockIdx.x, 256);
        EpiMerged E{(const bf16*)(ws + WS_GATE), (bf16*)(ws + WS_MERGED)};
        for (int rep = 0; rep < NREP(5); ++rep) pg8::gemm_phase<EpiMerged, pg8::StaticOrderT<true>, true, true, 122>((PG8_LAS unsigned char*)lds, g, S, E);
        SEAM(5);
    }
    if (IN(6)) {
        pg8::Gemm g{(const bf16*)(ws + WS_MERGED), (const bf16*)(ws + WS_WOUT8), T, 1024, 512, 512, 512}; pg8::StaticOrder S; S.init(T, 1024, G, (int)blockIdx.x);
        EpiResid E{p.x, (const float*)(ws + WS_MOD) + 2048, p.out};
        for (int rep = 0; rep < NREP(6); ++rep) pg8::gemm_phase<EpiResid, pg8::StaticOrder, true, true, 120>((PG8_LAS unsigned char*)lds, g, S, E);
        SEAM(6);
    }
    if (IN(7)) { for (int rep = 0; rep < NREP(7); ++rep) normmod_phase<false>(p, lds, p.out, (bf16*)(ws + WS_H), p.norm2_g, 3 * 1024, 4 * 1024); SEAM(7); }
    if (IN(8)) {
        pg8::Gemm g{(const bf16*)(ws + WS_H), (const bf16*)(ws + WS_WQ), T, 2048, 1024, 1024, 1024}; pg8::StaticOrder S; S.init(T, 2048, G, (int)blockIdx.x);
        EpiStore E{(bf16*)(ws + WS_Q), 2048};
        for (int rep = 0; rep < NREP(8); ++rep) pg8::gemm_phase<EpiStore, pg8::StaticOrder, true, true>((PG8_LAS unsigned char*)lds, g, S, E);
        SEAM(8);
    }
    if (IN(9)) {
        int* eG = (int*)(ws + WS_EIDX); float* gG = (float*)(ws + WS_PGATE);
        peer_route_block(p, lds, eG, gG);
        asm volatile("s_waitcnt vmcnt(0)" ::: "memory");
        __syncthreads();
        _Float16* usL = (_Float16*)lds; _Float16* vsL = (_Float16*)(lds + 32768);
        for (int i = tid; i < NEXP / 8; i += NTHREADS) { ((v4u*)usL)[i] = ((const v4u*)(ws + WS_US))[i]; ((v4u*)vsL)[i] = ((const v4u*)(ws + WS_VS))[i]; }
        unsigned char* ldsw = lds + 65536 + wave * 3072;
        int ntok = 0;
        for (int tg = blockIdx.x; tg < T / 16; tg += G) ntok += 2;
        auto tok_of = [&](int j) { return ((int)blockIdx.x + (j >> 1) * G) * 16 + wave + 8 * (j & 1); };
        auto ld_lists = [&](int tok, v2u& e, v2u& g) {
            const unsigned* ep = (const unsigned*)(eG + (size_t)tok * 128 + 2 * lane); const unsigned* gp = (const unsigned*)(gG + (size_t)tok * 128 + 2 * lane);
            e.x = __hip_atomic_load(ep, __ATOMIC_RELAXED, __HIP_MEMORY_SCOPE_AGENT); e.y = __hip_atomic_load(ep + 1, __ATOMIC_RELAXED, __HIP_MEMORY_SCOPE_AGENT);
            g.x = __hip_atomic_load(gp, __ATOMIC_RELAXED, __HIP_MEMORY_SCOPE_AGENT); g.y = __hip_atomic_load(gp + 1, __ATOMIC_RELAXED, __HIP_MEMORY_SCOPE_AGENT); };
        if (ntok > 0) { v2u e0, g0; ld_lists(tok_of(0), e0, g0); *(v2u*)((int*)ldsw + 2 * lane) = e0; *(v2u*)((float*)(ldsw + 512) + 2 * lane) = g0; }
        __syncthreads();
#pragma unroll 1
        for (int j = 0; j < ntok; ++j) {
            v2u ne = {0u, 0u}, ng = {0u, 0u};
            if (j + 1 < ntok) ld_lists(tok_of(j + 1), ne, ng);
            peer_token(p, ldsw, usL, vsL, lds + 90112 + wave * 8192, tok_of(j), lane, ne, ng, j & 1);
            LDS_WAIT(); __builtin_amdgcn_wave_barrier();
        }
    }
#undef IN
#undef SEAM
}

#ifndef ONE_LAUNCH
#define ONE_LAUNCH 1
#endif
extern "C" void kernel_launch(void* const* d_in, const int* in_sizes, int n_in, void* d_out, int out_size, void* d_ws, size_t ws_size, hipStream_t stream) {
    static int grid = 0;
    if (grid == 0) {
        if (n_in != 18 || out_size != T * DM || ws_size < WS_END) { fprintf(stderr, "kernel_launch: unexpected shapes (n_in %d, out %d, ws %zu)\n", n_in, out_size, ws_size); grid = -1; return; }
        int dev = 0, cus = 0, per_cu = 0;
        if (hipGetDevice(&dev) != hipSuccess || hipDeviceGetAttribute(&cus, hipDeviceAttributeMultiprocessorCount, dev) != hipSuccess) { grid = -1; return; }
        if (hipFuncSetAttribute((const void*)mega, hipFuncAttributeMaxDynamicSharedMemorySize, LDS_BYTES) != hipSuccess) { fprintf(stderr, "kernel_launch: hipFuncSetAttribute failed\n"); grid = -1; return; }
        if (hipOccupancyMaxActiveBlocksPerMultiprocessor(&per_cu, (const void*)mega, NTHREADS, LDS_BYTES) != hipSuccess || per_cu < 1) { fprintf(stderr, "kernel_launch: occupancy query says %d\n", per_cu); grid = -1; return; }
        (void)hipGetLastError();
        grid = cus;
        if (grid < 64) { grid = -1; return; }
    }
    if (grid < 0) return;
    Params p{};
    const float** pp = (const float**)&p;
    for (int i = 0; i < 18; ++i) pp[i] = (const float*)d_in[i];
    p.out = (float*)d_out; p.ws = (unsigned char*)d_ws;
#if ONE_LAUNCH
    if (hipMemsetAsync((char*)d_ws + WS_CTL, 0, 65536, stream) != hipSuccess) { fprintf(stderr, "kernel_launch: memset failed\n"); return; }
    p.ph_lo = 0; p.ph_hi = NPHASE;
    void* args[] = {&p};
    hipError_t e = hipLaunchCooperativeKernel((const void*)mega, dim3(grid), dim3(NTHREADS), args, LDS_BYTES, stream);
    if (e != hipSuccess) fprintf(stderr, "cooperative launch failed: %s (grid %d)\n", hipGetErrorString(e), grid);
#else
    for (int k = 0; k < NPHASE; ++k) { p.ph_lo = k; p.ph_hi = k + 1; hipLaunchKernelGGL(mega, dim3(grid), dim3(NTHREADS), LDS_BYTES, stream, p); }
#endif
}
```

```cpp
#include <hip/hip_runtime.h>
#include <hip/hip_cooperative_groups.h>
#include <cstdio>
#include <cstdint>
namespace cg = cooperative_groups;

namespace pg8 {
#define PG8_LAS __attribute__((address_space(3)))
typedef unsigned short bf16_t;
typedef short bf16x8 __attribute__((ext_vector_type(8)));
typedef float f32x4 __attribute__((ext_vector_type(4)));
typedef unsigned u32x4 __attribute__((ext_vector_type(4)));
constexpr int BM = 256, BK = 64, HALF = 128, HTB = HALF * BK * 2  , STAGE_BYTES = 8 * HTB, NXCD = 8, WGM = 8;

__host__ __device__ __forceinline__ int lds_byte(int r, int c) { const int st = (r >> 4) * 2 + (c >> 5), rr = r & 15, cc = c & 31, ob = rr * 64 + cc * 2; return st * 1024 + (ob ^ (((ob >> 9) & 1) << 5)); }
__host__ __device__ __forceinline__ void stage_rc(int b, int& R, int& C) { const int st = b / 1024, sb = b % 1024, swz = sb ^ (((sb >> 9) & 1) << 5); R = (st >> 1) * 16 + swz / 64; C = (st & 1) * 32 + (swz % 64) / 2; }
__host__ __device__ __forceinline__ int perm32(int rho) { const int n = rho >> 4, i = rho & 15; return 8 * (i >> 2) + 4 * n + (i & 3); }

struct Unit { int pm, pn, ko, pass; };
struct Gemm { const bf16_t* A; const bf16_t* Bt; int M, N, K, lda, ldb; };
typedef float f32x16 __attribute__((ext_vector_type(16)));
typedef f32x16 AccW[2][2][2];
__device__ __forceinline__ f32x4 acc_get(const AccW& A, int ai, int bj, int m, int n) { const int s_ = ((m & 1) * 2 + n) * 4; const f32x16& w = A[ai][bj][m >> 1]; return (f32x4){w[s_], w[s_ + 1], w[s_ + 2], w[s_ + 3]}; }
__device__ __forceinline__ void acc_set(AccW& A, int ai, int bj, int m, int n, f32x4 v) { const int s_ = ((m & 1) * 2 + n) * 4; f32x16& w = A[ai][bj][m >> 1]; w[s_] = v[0]; w[s_ + 1] = v[1]; w[s_ + 2] = v[2]; w[s_ + 3] = v[3]; }

template <bool TWOPASS_ORDER = false>
struct StaticOrderT {
    int nM, nN, nwg, G, c, kpass;
    __host__ __device__ void init(int M, int N, int G_, int c_, int kpass_ = 512) { nM = M / BM; nN = N / BM; nwg = nM * nN; G = G_; c = c_; kpass = kpass_; }
    __host__ __device__ bool next(int i, Unit& u) const {
        const long L = (long)(TWOPASS_ORDER ? (i >> 1) : i) * G + c; if (L >= nwg) return false;
        u.pass = TWOPASS_ORDER ? (i & 1) : 0; u.ko = TWOPASS_ORDER ? (i & 1) * kpass : 0;
        int wgid = (int)L; { const int q = nwg / NXCD, r = nwg % NXCD, xcd = wgid % NXCD, off = wgid / NXCD; wgid = (xcd < r ? xcd * (q + 1) : r * (q + 1) + (xcd - r) * q) + off; }
        const int nig = WGM * nN, gid = wgid / nig, fm = gid * WGM, gsz = (nM - fm) < WGM ? (nM - fm) : WGM;
        u.pm = fm + ((wgid % nig) % gsz); u.pn = (wgid % nig) / gsz; return true;
    }
    __device__ __forceinline__ void a_ready(const Unit&) const {}
    __device__ __forceinline__ void done(const Unit&) const {}
};
typedef StaticOrderT<false> StaticOrder;

__device__ __forceinline__ unsigned cvt_pk_bf16(float lo, float hi) { unsigned r; asm volatile("v_cvt_pk_bf16_f32 %0, %1, %2" : "=v"(r) : "v"(lo), "v"(hi)); return r; }

template <class Epi, class Sched, bool ALIGN_EPI = false, bool SP2 = false, int F8SCALE = 0>
__device__ __forceinline__ void gemm_phase(PG8_LAS unsigned char* lds, const Gemm g, const Sched& S, const Epi& E) {
    const int tid = threadIdx.x, wid = __builtin_amdgcn_readfirstlane(tid >> 6), lane = tid & 63, wr = wid >> 2, wc = wid & 3, fr = lane & 15, fq = lane >> 4;
    const int K = g.K, nt = K / BK;
    unsigned voffA[2], voffB[2];
#pragma unroll
    for (int i = 0; i < 2; ++i) { int R, C; stage_rc(tid * 16 + i * 8192, R, C); const int Rb = Epi::PERM ? ((R & ~31) + perm32(R & 31)) : R;
        voffA[i] = (unsigned)(R * g.lda + C) * 2u; voffB[i] = (unsigned)(Rb * g.ldb + C) * 2u; }
    const size_t kstep = (size_t)(BK * 2);
    const size_t hstepA = (size_t)HALF * g.lda * 2, hstepB = (size_t)HALF * g.ldb * 2;
    const size_t tstepA = 2 * hstepA, tstepB = 2 * hstepB;
    const unsigned ldsw = (unsigned)wid * 1024u;
    const int aoff = lds_byte(wr * 64 + fr, fq * 8), boff = lds_byte(wc * 32 + fr, fq * 8);
#define PG8_SA(b, h) (((b) * 2 + (h)) * HTB)
#define PG8_SB(b, h) ((4 + (b) * 2 + (h)) * HTB)
#define PG8_STAGE(bufoff, gbase, voff) do { _Pragma("unroll") for (int _i = 0; _i < 2; ++_i) \
        __builtin_amdgcn_global_load_lds((const unsigned*)((const char*)(gbase) + (voff)[_i]), (PG8_LAS unsigned*)(lds + (bufoff) + ldsw + _i * 8192), 16, 0, 0); } while (0)
#define PG8_LDA(dst, b, h) do { _Pragma("unroll") for (int m = 0; m < 4; ++m) { if constexpr (F8SCALE != 0) { \
        PG8_F8(dst)[m].lo = *(const PG8_LAS v4i_f*)(lds + PG8_SA(b, h) + aoff + m * 2048); PG8_F8(dst)[m].hi = *(const PG8_LAS v4i_f*)(lds + PG8_SA(b, h) + aoff + m * 2048 + 1024); } \
        else { _Pragma("unroll") for (int k = 0; k < 2; ++k) dst[m][k] = *(const PG8_LAS bf16x8*)(lds + PG8_SA(b, h) + aoff + m * 2048 + k * 1024); } } } while (0)
#define PG8_LDB(dst, b, h) do { _Pragma("unroll") for (int n = 0; n < 2; ++n) { if constexpr (F8SCALE != 0) { \
        PG8_F8(dst)[n].lo = *(const PG8_LAS v4i_f*)(lds + PG8_SB(b, h) + boff + n * 2048); PG8_F8(dst)[n].hi = *(const PG8_LAS v4i_f*)(lds + PG8_SB(b, h) + boff + n * 2048 + 1024); } \
        else { _Pragma("unroll") for (int k = 0; k < 2; ++k) dst[n][k] = *(const PG8_LAS bf16x8*)(lds + PG8_SB(b, h) + boff + n * 2048 + k * 1024); } } } while (0)
#define PG8_MMA(ai, bj, At, Bt) do { __builtin_amdgcn_s_setprio(1); _Pragma("unroll") for (int m = 0; m < 4; ++m) _Pragma("unroll") for (int n = 0; n < 2; ++n) { \
        f32x4 _c = acc_get(accw, ai, bj, m, n); \
        if constexpr (F8SCALE != 0) { _c = __builtin_amdgcn_mfma_scale_f32_16x16x128_f8f6f4(PG8_F8(Bt)[n], PG8_F8(At)[m], _c, 0, 0, 0, 0x7f7f7f7f, 0, F8SCALE * 0x01010101); } \
        else { _Pragma("unroll") for (int k = 0; k < 2; ++k) _c = __builtin_amdgcn_mfma_f32_16x16x32_bf16(Bt[n][k], At[m][k], _c, 0, 0, 0); } \
        acc_set(accw, ai, bj, m, n, _c); } \
        __builtin_amdgcn_s_setprio(0); } while (0)
#define PG8_WAIT_V(n) asm volatile("s_waitcnt vmcnt(" #n ")" ::: "memory")
#define PG8_WAIT_L(n) asm volatile("s_waitcnt lgkmcnt(" #n ")" ::: "memory")
#define PG8_BAR __builtin_amdgcn_s_barrier()
#define PG8_SCHED __builtin_amdgcn_sched_barrier(0)
    Unit cur, nxt; int ui = 0;
    if (!S.next(0, cur)) return;
    typedef int v4i_f __attribute__((ext_vector_type(4))); typedef int v8i_f __attribute__((ext_vector_type(8))); typedef f32x16 f32x16_f;
    AccW accw;
#pragma unroll
    for (int a = 0; a < 2; ++a)
#pragma unroll
        for (int b = 0; b < 2; ++b)
#pragma unroll
            for (int mp = 0; mp < 2; ++mp)
#pragma unroll
                for (int i = 0; i < 16; ++i) accw[a][b][mp][i] = 0.f;
    bf16x8 At[4][2], B0[2][2], B1[2][2];
    v8i_f At8[4], B08[2], B18[2];
#define PG8_F8(x) x##8
    const char* cA = (const char*)g.A + (size_t)cur.pm * tstepA + (size_t)cur.ko * 2; const char* cB = (const char*)g.Bt + (size_t)cur.pn * tstepB + (size_t)cur.ko * 2;
    S.a_ready(cur);
    if constexpr (SP2) {
        PG8_STAGE(PG8_SB(0, 0), cB, voffB); PG8_STAGE(PG8_SB(0, 1), cB + hstepB, voffB); PG8_STAGE(PG8_SA(0, 0), cA, voffA); PG8_STAGE(PG8_SA(0, 1), cA + hstepA, voffA);
        if (wr == 1) PG8_BAR;
        PG8_WAIT_V(2); PG8_BAR;
        PG8_STAGE(PG8_SB(1, 0), cB + kstep, voffB); PG8_STAGE(PG8_SA(1, 0), cA + kstep, voffA); PG8_STAGE(PG8_SB(1, 1), cB + hstepB + kstep, voffB);
        PG8_WAIT_V(6); PG8_BAR;
    } else {
        PG8_STAGE(PG8_SB(0, 0), cB, voffB); PG8_STAGE(PG8_SA(0, 0), cA, voffA); PG8_STAGE(PG8_SB(0, 1), cB + hstepB, voffB); PG8_STAGE(PG8_SA(0, 1), cA + hstepA, voffA);
        if (wr == 1) PG8_BAR;
        PG8_WAIT_V(4); PG8_BAR;
        PG8_STAGE(PG8_SB(1, 0), cB + kstep, voffB); PG8_STAGE(PG8_SA(1, 0), cA + kstep, voffA); PG8_STAGE(PG8_SB(1, 1), cB + hstepB + kstep, voffB);
        PG8_WAIT_V(6); PG8_BAR;
    }
    for (;;) {
        const bool has_next = S.next(ui + 1, nxt);
        const char* nA = has_next ? (const char*)g.A + (size_t)nxt.pm * tstepA + (size_t)nxt.ko * 2 : cA; const char* nB = has_next ? (const char*)g.Bt + (size_t)nxt.pn * tstepB + (size_t)nxt.ko * 2 : cB;
        for (int t = 0; t < nt; t += 2) {
            const bool last = (t == nt - 2);
            const char* a1 = cA + (size_t)(t + 1) * kstep;
            const char* a2 = last ? nA : cA + (size_t)(t + 2) * kstep; const char* b2 = last ? nB : cB + (size_t)(t + 2) * kstep;
            const char* a3 = a2 + kstep; const char* b3 = b2 + kstep;
            if (last && has_next) S.a_ready(nxt);
            if constexpr (SP2) {
            PG8_LDB(B0, 0, 0); PG8_LDB(B1, 0, 1); PG8_SCHED; PG8_LDA(At, 0, 0); PG8_STAGE(PG8_SA(1, 1), a1 + hstepA, voffA);
            PG8_WAIT_V(8); PG8_WAIT_L(0); PG8_BAR; PG8_MMA(0, 0, At, B0); PG8_MMA(0, 1, At, B1); PG8_BAR; PG8_SCHED;
            PG8_LDA(At, 0, 1); PG8_STAGE(PG8_SB(0, 0), b2, voffB); PG8_STAGE(PG8_SB(0, 1), b2 + hstepB, voffB); PG8_STAGE(PG8_SA(0, 0), a2, voffA);
            PG8_WAIT_V(8); PG8_WAIT_L(0); PG8_BAR; PG8_MMA(1, 0, At, B0); PG8_MMA(1, 1, At, B1); PG8_BAR; PG8_SCHED;
            PG8_LDB(B0, 1, 0); PG8_LDB(B1, 1, 1); PG8_SCHED; PG8_LDA(At, 1, 0); PG8_STAGE(PG8_SA(0, 1), a2 + hstepA, voffA);
            PG8_WAIT_V(8); PG8_WAIT_L(0); PG8_BAR; PG8_MMA(0, 0, At, B0); PG8_MMA(0, 1, At, B1); PG8_BAR; PG8_SCHED;
            PG8_LDA(At, 1, 1); PG8_STAGE(PG8_SB(1, 0), b3, voffB); PG8_STAGE(PG8_SB(1, 1), b3 + hstepB, voffB); PG8_STAGE(PG8_SA(1, 0), a3, voffA);
            PG8_WAIT_V(8); PG8_WAIT_L(0); PG8_BAR; PG8_MMA(1, 0, At, B0); PG8_MMA(1, 1, At, B1); PG8_BAR; PG8_SCHED;
            } else {
            PG8_LDB(B0, 0, 0); PG8_SCHED; PG8_LDA(At, 0, 0); PG8_STAGE(PG8_SA(1, 1), a1 + hstepA, voffA);
            PG8_WAIT_L(8); PG8_BAR; PG8_WAIT_L(0); PG8_MMA(0, 0, At, B0); PG8_BAR; PG8_SCHED;
            PG8_LDB(B1, 0, 1); PG8_STAGE(PG8_SB(0, 0), b2, voffB);
            PG8_BAR; PG8_WAIT_L(0); PG8_MMA(0, 1, At, B1); PG8_BAR;
            PG8_LDA(At, 0, 1); PG8_STAGE(PG8_SA(0, 0), a2, voffA);
            PG8_BAR; PG8_WAIT_L(0); PG8_MMA(1, 0, At, B0); PG8_BAR; PG8_SCHED;
            PG8_STAGE(PG8_SB(0, 1), b2 + hstepB, voffB);
            PG8_WAIT_V(6); PG8_BAR; PG8_MMA(1, 1, At, B1); PG8_BAR;
            PG8_LDB(B0, 1, 0); PG8_SCHED; PG8_LDA(At, 1, 0); PG8_STAGE(PG8_SA(0, 1), a2 + hstepA, voffA);
            PG8_WAIT_L(8); PG8_BAR; PG8_WAIT_L(0); PG8_MMA(0, 0, At, B0); PG8_BAR; PG8_SCHED;
            PG8_LDB(B1, 1, 1); PG8_STAGE(PG8_SB(1, 0), b3, voffB);
            PG8_BAR; PG8_WAIT_L(0); PG8_MMA(0, 1, At, B1); PG8_BAR;
            PG8_LDA(At, 1, 1); PG8_STAGE(PG8_SA(1, 0), a3, voffA);
            PG8_BAR; PG8_WAIT_L(0); PG8_MMA(1, 0, At, B0); PG8_BAR; PG8_SCHED;
            PG8_STAGE(PG8_SB(1, 1), b3 + hstepB, voffB);
            PG8_WAIT_V(6); PG8_BAR; PG8_MMA(1, 1, At, B1); PG8_BAR;
            }
        }
        if constexpr (ALIGN_EPI) { if (wr == 0) PG8_BAR; }
        if constexpr (!Epi::AFTER_DRAIN) { E(accw, cur, wr, wc, fr, fq); S.done(cur); }
        const bool keep_acc = Epi::TWOPASS && (cur.pass == 0);
        if (!has_next) break;
        if (!keep_acc) {
#pragma unroll
            for (int a = 0; a < 2; ++a)
#pragma unroll
                for (int b = 0; b < 2; ++b)
#pragma unroll
                    for (int mp = 0; mp < 2; ++mp)
#pragma unroll
                        for (int i = 0; i < 16; ++i) accw[a][b][mp][i] = 0.f;
        }
        cur = nxt; cA = nA; cB = nB; ++ui;
        if constexpr (ALIGN_EPI) { if (wr == 1) PG8_BAR; }
    }
    PG8_WAIT_V(0);
    if constexpr (!ALIGN_EPI) { if (wr == 0) PG8_BAR; }
    PG8_BAR;

#undef PG8_SA
#undef PG8_SB
#undef PG8_STAGE
#undef PG8_LDA
#undef PG8_LDB
#undef PG8_MMA
#undef PG8_F8
#undef PG8_WAIT_V
#undef PG8_WAIT_L
#undef PG8_BAR
#undef PG8_SCHED
}
}


constexpr int NWAVES = 8, NTHREADS = 512;
constexpr int BATCH = 8, SEQ = 4096, T = BATCH * SEQ, DM = 1024;
constexpr int INW = 5448;
constexpr int NPROJ = 5632;
constexpr int LD_HG = 2048, LD_ATT = 768, LD_IDX = 640, LD_GATE = 2048;
constexpr int TOPK = 256;
constexpr int NEXP = 16384;
constexpr float RMS_EPS = 1e-6f;

constexpr size_t MiB = 1u << 20;
constexpr size_t WS_CTL = 0;
constexpr size_t WS_MOD = MiB / 4;
constexpr size_t WS_MODP = MiB / 2;
constexpr size_t WS_WIN = 2 * MiB;
constexpr size_t WS_WQ = 17 * MiB;
constexpr size_t WS_SK = 21 * MiB;
constexpr size_t WS_U = 22 * MiB;
constexpr size_t WS_US = 30 * MiB;
constexpr size_t WS_V = 38 * MiB;
constexpr size_t WS_VS = 46 * MiB;
constexpr size_t WS_K8 = 48 * MiB;
constexpr size_t WS_QHI = 52 * MiB;
constexpr size_t WS_QLO = 68 * MiB;
constexpr size_t WS_WAB8 = 31 * MiB;
constexpr size_t WS_WOUT8 = 32 * MiB;
constexpr size_t WS_WIN8 = 33 * MiB;
constexpr size_t WS_H8 = 48 * MiB;
constexpr size_t WS_H = 86 * MiB;
constexpr size_t WS_HG = 150 * MiB;
constexpr size_t WS_ATT = 278 * MiB;
constexpr size_t WS_IDX = 326 * MiB;
constexpr size_t WS_GATE = 366 * MiB;
constexpr size_t WS_SEL = 494 * MiB;
constexpr size_t WS_EIDX = 48 * MiB;
constexpr size_t WS_PGATE = 64 * MiB;
constexpr size_t WS_END = 510 * MiB;
constexpr size_t WS_HQC = 494 * MiB;
constexpr size_t WS_HOL = 118 * MiB;
constexpr size_t WS_HSB = 2 * MiB;
constexpr size_t WS_MERGED = WS_HG;
constexpr size_t WS_Q = 214 * MiB;
constexpr int H4_NT = 2;
constexpr size_t WS_H4D = 366 * MiB;
constexpr size_t WS_H4S = 416 * MiB;

constexpr int LDS_BYTES = 163840;

typedef unsigned short bf16;
typedef unsigned v4u __attribute__((ext_vector_type(4)));
typedef unsigned v2u __attribute__((ext_vector_type(2)));
typedef float f32x4 __attribute__((ext_vector_type(4)));
typedef float f32x2 __attribute__((ext_vector_type(2)));
typedef short bf16x8 __attribute__((ext_vector_type(8)));
#define LAS __attribute__((address_space(3)))

struct Params {
    const float *x, *c, *w_ada, *b_ada, *norm1_g, *norm2_g, *w_in, *hg_lb, *hg_onorm_g, *q_norm_g, *k_norm_g,
                *w_a, *w_b, *w_out, *peer_wq, *peer_subkeys, *peer_u, *peer_v;
    float* out; unsigned char* ws; int ph_lo, ph_hi;
};

typedef __bf16 bf16x2_hw __attribute__((ext_vector_type(2)));
__device__ __forceinline__ unsigned pk2(float lo, float hi) { const f32x2 v = {lo, hi}; const bf16x2_hw b = __builtin_convertvector(v, bf16x2_hw); return __builtin_bit_cast(unsigned, b); }
__device__ __forceinline__ unsigned f2bf(float f) { return pk2(f, 0.f) & 0xffffu; }
__device__ __forceinline__ float bf2f(unsigned u16v) { return __builtin_bit_cast(float, u16v << 16); }
__device__ __forceinline__ float bflo(unsigned w) { return __builtin_bit_cast(float, w << 16); }
__device__ __forceinline__ float bfhi(unsigned w) { return __builtin_bit_cast(float, w & 0xffff0000u); }
__device__ __forceinline__ float sigmoidf_(float x) { return __builtin_amdgcn_rcpf(1.f + __expf(-x)); }
__device__ __forceinline__ float siluf_(float x) { return x * __builtin_amdgcn_rcpf(1.f + __expf(-x)); }
__device__ __forceinline__ float wave_sum(float v) {
#pragma unroll
    for (int o = 1; o < 64; o <<= 1) v += __shfl_xor(v, o);
    return v;
}
__device__ __forceinline__ float wave_max(float v) {
#pragma unroll
    for (int o = 1; o < 64; o <<= 1) v = fmaxf(v, __shfl_xor(v, o));
    return v;
}
#define LDS_WAIT() asm volatile("s_waitcnt lgkmcnt(0)" ::: "memory")
__device__ __forceinline__ unsigned pk4_fp8(float a, float b, float c, float d) { int w = __builtin_amdgcn_cvt_pk_fp8_f32(a, b, 0, false); w = __builtin_amdgcn_cvt_pk_fp8_f32(c, d, w, true); return (unsigned)w; }

__host__ __device__ __forceinline__ int proj_tile_bf16(int i) { return i < 2 ? i + 2 : i + 6; }
__host__ __device__ __forceinline__ int proj_tile_fp8(int i) { return i < 2 ? i : (i < 6 ? i + 2 : i + 8); }
struct EpiProj {
    static constexpr bool PERM = true, AFTER_DRAIN = false, TWOPASS = false;
    bf16 *HG, *ATT, *IDX, *GATE; int f8;
    __device__ __forceinline__ void operator()(pg8::AccW& acc, const pg8::Unit& u, int wr, int wc, int fr, int fq) const {
        const int pn = f8 ? proj_tile_fp8(u.pn) : proj_tile_bf16(u.pn); bf16* base; int ldc, colt, ncols;
        if (pn < 8) { base = HG; ldc = LD_HG; colt = pn * 256; ncols = LD_HG; }
        else if (pn < 11) { base = ATT; ldc = LD_ATT; colt = (pn - 8) * 256; ncols = LD_ATT; }
        else if (pn < 14) { base = IDX; ldc = LD_IDX; colt = (pn - 11) * 256; ncols = LD_IDX; }
        else { base = GATE; ldc = LD_GATE; colt = (pn - 14) * 256; ncols = LD_GATE; }
        const int row0 = u.pm * 256 + wr * 64 + fr, col0 = colt + wc * 32 + 8 * fq;
#pragma unroll
        for (int ai = 0; ai < 2; ++ai)
#pragma unroll
            for (int m = 0; m < 4; ++m) { bf16* rowp = base + (size_t)(row0 + ai * 128 + m * 16) * ldc + col0;
#pragma unroll
                for (int bj = 0; bj < 2; ++bj) { const pg8::f32x4 v0 = pg8::acc_get(acc, ai, bj, m, 0), v1 = pg8::acc_get(acc, ai, bj, m, 1);
                    v4u w; w.x = pk2(v0[0], v0[1]); w.y = pk2(v0[2], v0[3]); w.z = pk2(v1[0], v1[1]); w.w = pk2(v1[2], v1[3]);
                    if (col0 + bj * 128 < ncols) *(v4u*)(rowp + bj * 128) = w; } }
    }
};
struct EpiMerged {
    static constexpr bool PERM = true, AFTER_DRAIN = false, TWOPASS = true;
    const bf16* GATE; bf16* O;
    __device__ __forceinline__ void operator()(pg8::AccW& acc, const pg8::Unit& u, int wr, int wc, int fr, int fq) const {
        const int row0 = u.pm * 256 + wr * 64 + fr, col0 = u.pn * 256 + wc * 32 + 8 * fq;
        if (u.pass == 0) {
#pragma unroll
            for (int ai = 0; ai < 2; ++ai)
#pragma unroll
                for (int m = 0; m < 4; ++m) { const bf16* rowp = GATE + (size_t)(row0 + ai * 128 + m * 16) * LD_GATE + col0;
#pragma unroll
                    for (int bj = 0; bj < 2; ++bj) { const v4u a = *(const v4u*)(rowp + bj * 128), b = *(const v4u*)(rowp + 1024 + bj * 128);
                        float r[8];
#pragma unroll
                        for (int i = 0; i < 4; ++i) { const float a0 = bflo(a[i]), a1 = bfhi(a[i]), b0 = bflo(b[i]), b1 = bfhi(b[i]);
                            r[2 * i] = (1.f + __expf(-b0)) * __builtin_amdgcn_rcpf(1.f + __expf(-a0)); r[2 * i + 1] = (1.f + __expf(-b1)) * __builtin_amdgcn_rcpf(1.f + __expf(-a1)); }
                        { pg8::f32x4 c0 = pg8::acc_get(acc, ai, bj, m, 0), c1 = pg8::acc_get(acc, ai, bj, m, 1);
#pragma unroll
                          for (int i = 0; i < 4; ++i) { c0[i] *= r[i]; c1[i] *= r[4 + i]; }
                          pg8::acc_set(acc, ai, bj, m, 0, c0); pg8::acc_set(acc, ai, bj, m, 1, c1); } } }
        } else {
#pragma unroll
            for (int ai = 0; ai < 2; ++ai)
#pragma unroll
                for (int m = 0; m < 4; ++m) { const size_t ro = (size_t)(row0 + ai * 128 + m * 16);
#pragma unroll
                    for (int bj = 0; bj < 2; ++bj) { const v4u b = *(const v4u*)(GATE + ro * LD_GATE + 1024 + col0 + bj * 128);
                        const pg8::f32x4 v0 = pg8::acc_get(acc, ai, bj, m, 0), v1 = pg8::acc_get(acc, ai, bj, m, 1);
                        float s[8];
#pragma unroll
                        for (int i = 0; i < 4; ++i) { s[2 * i] = sigmoidf_(bflo(b[i])); s[2 * i + 1] = sigmoidf_(bfhi(b[i])); }
                        v2u w; w.x = pk4_fp8(4.f * v0[0] * s[0], 4.f * v0[1] * s[1], 4.f * v0[2] * s[2], 4.f * v0[3] * s[3]); w.y = pk4_fp8(4.f * v1[0] * s[4], 4.f * v1[1] * s[5], 4.f * v1[2] * s[6], 4.f * v1[3] * s[7]);
                        *(v2u*)((unsigned char*)O + ro * 1024 + col0 + bj * 128) = w; } }
        }
    }
};
struct EpiResid {
    static constexpr bool PERM = true, AFTER_DRAIN = false, TWOPASS = false;
    const float* X; const float* G1  ; float* O;
    __device__ __forceinline__ void operator()(pg8::AccW& acc, const pg8::Unit& u, int wr, int wc, int fr, int fq) const {
        const int row0 = u.pm * 256 + wr * 64 + fr, col0 = u.pn * 256 + wc * 32 + 8 * fq;
        const int b = (u.pm * 256) / SEQ;
        f32x4 g[2][2];
#pragma unroll
        for (int bj = 0; bj < 2; ++bj)
#pragma unroll
            for (int n = 0; n < 2; ++n) g[bj][n] = *(const f32x4*)(G1 + (size_t)b * 6144 + col0 + bj * 128 + 4 * n);
#pragma unroll
        for (int ai = 0; ai < 2; ++ai)
#pragma unroll
            for (int m = 0; m < 4; ++m) { const size_t ro = (size_t)(row0 + ai * 128 + m * 16) * DM + col0;
#pragma unroll
                for (int bj = 0; bj < 2; ++bj)
#pragma unroll
                    for (int n = 0; n < 2; ++n) { const f32x4 xv = *(const f32x4*)(X + ro + bj * 128 + 4 * n);
                        *(f32x4*)(O + ro + bj * 128 + 4 * n) = xv + g[bj][n] * pg8::acc_get(acc, ai, bj, m, n); } }
    }
};
struct EpiStore {
    static constexpr bool PERM = true, AFTER_DRAIN = false, TWOPASS = false;
    bf16* O; int ldc;
    __device__ __forceinline__ void operator()(pg8::AccW& acc, const pg8::Unit& u, int wr, int wc, int fr, int fq) const {
        const int row0 = u.pm * 256 + wr * 64 + fr, col0 = u.pn * 256 + wc * 32 + 8 * fq;
#pragma unroll
        for (int ai = 0; ai < 2; ++ai)
#pragma unroll
            for (int m = 0; m < 4; ++m) { bf16* rowp = O + (size_t)(row0 + ai * 128 + m * 16) * ldc + col0;
#pragma unroll
                for (int bj = 0; bj < 2; ++bj) { const pg8::f32x4 v0 = pg8::acc_get(acc, ai, bj, m, 0), v1 = pg8::acc_get(acc, ai, bj, m, 1);
                    v4u w; w.x = pk2(v0[0], v0[1]); w.y = pk2(v0[2], v0[3]); w.z = pk2(v1[0], v1[1]); w.w = pk2(v1[2], v1[3]);
                    *(v4u*)(rowp + bj * 128) = w; } }
    }
};

template <int MODE> __device__ __forceinline__ int srcmap(int np) {
    if (MODE == 2) np = proj_tile_bf16(np >> 8) * 256 + (np & 255);
    if (MODE == 3) np = proj_tile_fp8(np >> 8) * 256 + (np & 255);
    if (MODE >= 1) return np < 3400 ? np : (np >= 3584 ? np - 184 : -1);
    return np; }
template <int MODE>
__device__ __forceinline__ void transpose_item(const float* W, int N, bf16* WT, int ldw, int koff, float* scr, int kb, int nb, int lane) {
    const int k0 = 64 * kb, n0 = 32 * nb;
    const int sc = srcmap<MODE>(n0 + (lane & 31));
#pragma unroll 8
    for (int i = 0; i < 32; ++i) { const int kk = 2 * i + (lane >> 5); scr[kk * 33 + (lane & 31)] = (sc >= 0) ? W[(size_t)(k0 + kk) * N + sc] : 0.f; }
    LDS_WAIT(); __builtin_amdgcn_wave_barrier();
    const int c = lane & 7;
#pragma unroll
    for (int j = 0; j < 4; ++j) { const int n = (lane >> 3) + 8 * j; const float* s = scr + (8 * c) * 33 + n;
        v4u o; o.x = pk2(s[0 * 33], s[1 * 33]); o.y = pk2(s[2 * 33], s[3 * 33]); o.z = pk2(s[4 * 33], s[5 * 33]); o.w = pk2(s[6 * 33], s[7 * 33]);
        *(v4u*)(WT + (size_t)(n0 + n) * ldw + koff + k0 + 8 * c) = o; }
    LDS_WAIT(); __builtin_amdgcn_wave_barrier();
}
template <int MODE> __device__ __forceinline__ int srcmap(int np);
template <int MODE = 0>
__device__ __forceinline__ void transpose_item8(const float* W, int N, unsigned char* WT, int ldw, int koff, float scale, float* scr, int kb, int nb, int lane) {
    const int k0 = 64 * kb, n0 = 32 * nb;
    const int sc = srcmap<MODE>(n0 + (lane & 31));
#pragma unroll 8
    for (int i = 0; i < 32; ++i) { const int kk = 2 * i + (lane >> 5); scr[kk * 33 + (lane & 31)] = (sc >= 0) ? W[(size_t)(k0 + kk) * N + sc] * scale : 0.f; }
    LDS_WAIT(); __builtin_amdgcn_wave_barrier();
    const int c = lane & 3;
#pragma unroll
    for (int j = 0; j < 2; ++j) { const int n = (lane >> 2) + 16 * j; const float* sp = scr + (16 * c) * 33 + n;
        v4u o;
#pragma unroll
        for (int q = 0; q < 4; ++q) o[q] = pk4_fp8(sp[(4 * q) * 33], sp[(4 * q + 1) * 33], sp[(4 * q + 2) * 33], sp[(4 * q + 3) * 33]);
        *(v4u*)(WT + (size_t)(n0 + n) * ldw + koff + k0 + 16 * c) = o; }
    LDS_WAIT(); __builtin_amdgcn_wave_barrier();
}
__device__ __forceinline__ void convert_plain(const float* src, bf16* dst, size_t n, size_t gtid, size_t nth) {
    const size_t n8 = n / 8;
    for (size_t i = gtid; i < n8; i += nth) { const f32x4 a = ((const f32x4*)src)[2 * i], b = ((const f32x4*)src)[2 * i + 1];
        v4u o; o.x = pk2(a[0], a[1]); o.y = pk2(a[2], a[3]); o.z = pk2(b[0], b[1]); o.w = pk2(b[2], b[3]); ((v4u*)dst)[i] = o; }
}
__device__ __forceinline__ void convert_fp8(const float* src, unsigned char* dst, size_t n, float scale, size_t gtid, size_t nth) {
    const size_t n16 = n / 16;
    for (size_t i = gtid; i < n16; i += nth) { const f32x4* sp = (const f32x4*)src + 4 * i; const f32x4 a = sp[0] * scale, b = sp[1] * scale, c = sp[2] * scale, d = sp[3] * scale;
        v4u o; o.x = pk4_fp8(a[0], a[1], a[2], a[3]); o.y = pk4_fp8(b[0], b[1], b[2], b[3]); o.z = pk4_fp8(c[0], c[1], c[2], c[3]); o.w = pk4_fp8(d[0], d[1], d[2], d[3]); ((v4u*)dst)[i] = o; }
}
template <bool KKMAJOR>
__device__ __forceinline__ void convert_mxfp4(const float* src, unsigned char* dst, unsigned char* scl, size_t nrows, size_t gtid, size_t nth) {
    const size_t nblk = nrows * 32;
    for (size_t i = gtid; i < nblk; i += nth) {
        const size_t row = i >> 5; const int blk = (int)(i & 31);
        const f32x4* sp = (const f32x4*)(src + row * 1024 + blk * 32);
        f32x4 v[8]; float amax = 0.f;
#pragma unroll
        for (int j = 0; j < 8; ++j) { v[j] = sp[j]; amax = fmaxf(fmaxf(fmaxf(fabsf(v[j][0]), fabsf(v[j][1])), fmaxf(fabsf(v[j][2]), fabsf(v[j][3]))), amax); }
        int e = (int)((__builtin_bit_cast(unsigned, amax) >> 23) & 0xffu) - 127 - 2;
        if (e < -126) e = -126;
        const float inv = __builtin_bit_cast(float, (unsigned)(127 - e) << 23);
        unsigned w[4] = {0u, 0u, 0u, 0u};
#pragma unroll
        for (int j = 0; j < 8; j += 2) { unsigned t = 0u;
            t = __builtin_amdgcn_cvt_scalef32_pk_fp4_f32(t, v[j][0] * inv, v[j][1] * inv, 1.0f, 0);
            t = __builtin_amdgcn_cvt_scalef32_pk_fp4_f32(t, v[j][2] * inv, v[j][3] * inv, 1.0f, 1);
            t = __builtin_amdgcn_cvt_scalef32_pk_fp4_f32(t, v[j + 1][0] * inv, v[j + 1][1] * inv, 1.0f, 2);
            t = __builtin_amdgcn_cvt_scalef32_pk_fp4_f32(t, v[j + 1][2] * inv, v[j + 1][3] * inv, 1.0f, 3);
            w[j >> 1] = t; }
        *(v4u*)(dst + row * 512 + blk * 16) = (v4u){w[0], w[1], w[2], w[3]};
        scl[row * 32 + (KKMAJOR ? ((blk & 3) * 8 + (blk >> 2)) : blk)] = (unsigned char)(e + 127);
    }
}
__device__ __forceinline__ void convert_rowfp4(const float* src, unsigned char* dst, _Float16* scl, int row, int lane) {
    const f32x4* sp = (const f32x4*)(src + (size_t)row * 1024 + lane * 16);
    f32x4 v[4]; float amax = 0.f;
#pragma unroll
    for (int j = 0; j < 4; ++j) { v[j] = sp[j]; amax = fmaxf(fmaxf(fmaxf(fabsf(v[j][0]), fabsf(v[j][1])), fmaxf(fabsf(v[j][2]), fabsf(v[j][3]))), amax); }
    amax = wave_max(amax);
    _Float16 sh = (_Float16)(amax * (1.f / 6.f));
    float sf = (float)sh; if (!(sf > 0.f)) { sf = 1.f; sh = (_Float16)1.f; }
    const float inv = 1.f / sf;
    unsigned w[2];
#pragma unroll
    for (int j = 0; j < 2; ++j) { unsigned t = 0u;
        t = __builtin_amdgcn_cvt_scalef32_pk_fp4_f32(t, v[2 * j][0] * inv, v[2 * j][1] * inv, 1.0f, 0);
        t = __builtin_amdgcn_cvt_scalef32_pk_fp4_f32(t, v[2 * j][2] * inv, v[2 * j][3] * inv, 1.0f, 1);
        t = __builtin_amdgcn_cvt_scalef32_pk_fp4_f32(t, v[2 * j + 1][0] * inv, v[2 * j + 1][1] * inv, 1.0f, 2);
        t = __builtin_amdgcn_cvt_scalef32_pk_fp4_f32(t, v[2 * j + 1][2] * inv, v[2 * j + 1][3] * inv, 1.0f, 3);
        w[j] = t; }
    *(v2u*)(dst + (size_t)row * 512 + lane * 8) = (v2u){w[0], w[1]};
    if (lane == 0) scl[row] = sh;
}
__device__ __forceinline__ void phase0(const Params& p, unsigned char* lds) {
    const int tid = threadIdx.x, wave = tid >> 6, lane = tid & 63, G = gridDim.x;
    const int gw = blockIdx.x * NWAVES + wave, NGW = G * NWAVES;
    float* scr = (float*)(lds + wave * 16384);
    unsigned char* ws = p.ws;
    constexpr int I_IN = 16 * (2048 / 32), I_IN8 = 16 * (3584 / 32), I_A = 8 * 32, I_O = 16 * 32, I_Q = 16 * 64;
    constexpr int NT = I_IN + I_IN8 + 2 * I_A + I_O + I_Q;
    for (int it = gw; it < NT; it += NGW) {
        int r = it;
        if (r < I_IN) { transpose_item<2>(p.w_in, INW, (bf16*)(ws + WS_WIN), 1024, 0, scr, r / 64, r % 64, lane); continue; } r -= I_IN;
        if (r < I_IN8) { transpose_item8<3>(p.w_in, INW, ws + WS_WIN8, 1024, 0, 32.f, scr, r / 112, r % 112, lane); continue; } r -= I_IN8;
        if (r < I_A) { transpose_item8(p.w_a, 1024, ws + WS_WAB8, 1024, 0, 32.f, scr, r / 32, r % 32, lane); continue; } r -= I_A;
        if (r < I_A) { transpose_item8(p.w_b, 1024, ws + WS_WAB8, 1024, 512, 4.f, scr, r / 32, r % 32, lane); continue; } r -= I_A;
        if (r < I_O) { transpose_item8(p.w_out, 1024, ws + WS_WOUT8, 1024, 0, 32.f, scr, r / 32, r % 32, lane); continue; } r -= I_O;
        transpose_item<0>(p.peer_wq, 2048, (bf16*)(ws + WS_WQ), 1024, 0, scr, r / 64, r % 64, lane);
    }
    for (int it = gw; it < 96 * 8; it += NGW) {
        const int cgp = it % 96, ks = it / 96, col = cgp * 64 + lane, k0 = ks * 128;
#pragma unroll
        for (int i = 0; i < 16; ++i) { const int e = i * 64 + lane, b = e >> 7, k = e & 127; scr[e] = siluf_(p.c[b * 1024 + k0 + k]); }
        LDS_WAIT(); __builtin_amdgcn_wave_barrier();
        float acc[8];
#pragma unroll
        for (int b = 0; b < 8; ++b) acc[b] = 0.f;
#pragma unroll 4
        for (int k = 0; k < 128; ++k) { const float w = p.w_ada[(size_t)(k0 + k) * 6144 + col];
#pragma unroll
            for (int b = 0; b < 8; ++b) acc[b] += scr[b * 128 + k] * w; }
        float* mp = (float*)(ws + WS_MODP) + (size_t)ks * 8 * 6144 + col;
#pragma unroll
        for (int b = 0; b < 8; ++b) mp[b * 6144] = acc[b];
        LDS_WAIT(); __builtin_amdgcn_wave_barrier();
    }
    const size_t gtid = (size_t)blockIdx.x * NTHREADS + tid, nth = (size_t)G * NTHREADS;
    convert_plain(p.peer_subkeys, (bf16*)(ws + WS_SK), (size_t)16 * 128 * 128, gtid, nth);
    for (int it = gw; it < 2 * NEXP; it += NGW) {
        if (it < NEXP) convert_rowfp4(p.peer_u, ws + WS_U, (_Float16*)(ws + WS_US), it, lane);
        else convert_rowfp4(p.peer_v, ws + WS_V, (_Float16*)(ws + WS_VS), it - NEXP, lane);
    }
}

template <bool FIRST>
__device__ __forceinline__ void normmod_phase(const Params& p, unsigned char* lds, const float* src, bf16* dst, const float* gvec, int shift_off, int scale_off) {
    const int tid = threadIdx.x, wave = tid >> 6, lane = tid & 63, G = gridDim.x;
    unsigned char* ws = p.ws;
    float* A = (float*)lds;
    float* Bv = A + 1024;
    const float* MODP = (const float*)(ws + WS_MODP);
    float* MOD = (float*)(ws + WS_MOD);
    if (FIRST) {
        for (int e = blockIdx.x * NTHREADS + tid; e < 8 * 6144; e += G * NTHREADS) { const int col = e % 6144; float s = p.b_ada[col];
#pragma unroll
            for (int ks = 0; ks < 8; ++ks) s += MODP[(size_t)ks * 8 * 6144 + e];
            MOD[e] = s; }
    }
    int curb = -1;
    for (int chunk = blockIdx.x; chunk < T / 128; chunk += G) {
        const int b = (chunk * 128) / SEQ;
        if (b != curb) {
            __syncthreads();
            for (int col = tid; col < 1024; col += NTHREADS) {
                float sc, sh;
                if (FIRST) { sc = p.b_ada[scale_off + col]; sh = p.b_ada[shift_off + col];
#pragma unroll
                    for (int ks = 0; ks < 8; ++ks) { sc += MODP[(size_t)(ks * 8 + b) * 6144 + scale_off + col]; sh += MODP[(size_t)(ks * 8 + b) * 6144 + shift_off + col]; } }
                else { sc = MOD[b * 6144 + scale_off + col]; sh = MOD[b * 6144 + shift_off + col]; }
                A[col] = gvec[col] * (1.f + sc); Bv[col] = sh; }
            __syncthreads(); curb = b;
        }
        for (int r = wave; r < 128; r += NWAVES) {
            const size_t row = (size_t)chunk * 128 + r;
            const f32x4* xr = (const f32x4*)(src + row * DM) + lane;
            f32x4 v[4]; float s = 0.f;
#pragma unroll
            for (int j = 0; j < 4; ++j) { v[j] = xr[64 * j]; s += (v[j][0] * v[j][0] + v[j][1] * v[j][1]) + (v[j][2] * v[j][2] + v[j][3] * v[j][3]); }
            const float rstd = rsqrtf(wave_sum(s) * (1.f / DM) + RMS_EPS);
            v2u* o8 = (v2u*)(dst + row * DM) + lane;
#pragma unroll
            for (int j = 0; j < 4; ++j) { const int c0 = 4 * lane + 256 * j; const f32x4 a = *(const f32x4*)(A + c0), sh = *(const f32x4*)(Bv + c0);
                v2u o; o.x = pk2(v[j][0] * rstd * a[0] + sh[0], v[j][1] * rstd * a[1] + sh[1]); o.y = pk2(v[j][2] * rstd * a[2] + sh[2], v[j][3] * rstd * a[3] + sh[3]);
                o8[64 * j] = o;
                if (FIRST) *(unsigned*)(ws + WS_H8 + row * DM + c0) = pk4_fp8(v[j][0] * rstd * a[0] + sh[0], v[j][1] * rstd * a[1] + sh[1], v[j][2] * rstd * a[2] + sh[2], v[j][3] * rstd * a[3] + sh[3]);
                if (!FIRST) { float* st = (float*)(lds + 8192) + wave * 1056;
                    const float y0 = v[j][0] * rstd * a[0] + sh[0], y1 = v[j][1] * rstd * a[1] + sh[1], y2 = v[j][2] * rstd * a[2] + sh[2], y3 = v[j][3] * rstd * a[3] + sh[3];
                    const int pc = c0 + (c0 >> 5); st[pc] = y0; st[pc + 1] = y1; st[pc + 2] = y2; st[pc + 3] = y3; } }
            if (!FIRST) {
                const float* st = (const float*)(lds + 8192) + wave * 1056;
                LDS_WAIT(); __builtin_amdgcn_wave_barrier();
                if (lane < 32) {
                    float x[32];
#pragma unroll
                    for (int k = 0; k < 32; ++k) x[k] = st[lane * 33 + k];
#pragma unroll
                    for (int t = 0; t < H4_NT; ++t) {
                        float amax = 0.f;
#pragma unroll
                        for (int k = 0; k < 32; ++k) amax = fmaxf(amax, fabsf(x[k]));
                        int e = (int)((__builtin_bit_cast(unsigned, amax) >> 23) & 0xffu) - 127 - 2; if (e < -126) e = -126;
                        const float inv = __builtin_bit_cast(float, (unsigned)(127 - e) << 23), sc = __builtin_bit_cast(float, (unsigned)(127 + e) << 23);
                        unsigned w[4];
#pragma unroll
                        for (int r = 0; r < 4; ++r) { unsigned tw = 0u;
                            tw = __builtin_amdgcn_cvt_scalef32_pk_fp4_f32(tw, x[8 * r] * inv, x[8 * r + 1] * inv, 1.0f, 0);
                            tw = __builtin_amdgcn_cvt_scalef32_pk_fp4_f32(tw, x[8 * r + 2] * inv, x[8 * r + 3] * inv, 1.0f, 1);
                            tw = __builtin_amdgcn_cvt_scalef32_pk_fp4_f32(tw, x[8 * r + 4] * inv, x[8 * r + 5] * inv, 1.0f, 2);
                            tw = __builtin_amdgcn_cvt_scalef32_pk_fp4_f32(tw, x[8 * r + 6] * inv, x[8 * r + 7] * inv, 1.0f, 3);
                            w[r] = tw;
                            const f32x2 d0 = __builtin_amdgcn_cvt_scalef32_pk_f32_fp4(tw, 1.0f, 0), d1 = __builtin_amdgcn_cvt_scalef32_pk_f32_fp4(tw, 1.0f, 1), d2 = __builtin_amdgcn_cvt_scalef32_pk_f32_fp4(tw, 1.0f, 2), d3 = __builtin_amdgcn_cvt_scalef32_pk_f32_fp4(tw, 1.0f, 3);
                            x[8 * r] -= d0[0] * sc; x[8 * r + 1] -= d0[1] * sc; x[8 * r + 2] -= d1[0] * sc; x[8 * r + 3] -= d1[1] * sc;
                            x[8 * r + 4] -= d2[0] * sc; x[8 * r + 5] -= d2[1] * sc; x[8 * r + 6] -= d3[0] * sc; x[8 * r + 7] -= d3[1] * sc; }
                        *(v4u*)(ws + WS_H4D + (row * H4_NT + t) * 512 + lane * 16) = (v4u){w[0], w[1], w[2], w[3]};
                        *(ws + WS_H4S + (row * H4_NT + t) * 32 + (lane & 3) * 8 + (lane >> 2)) = (unsigned char)(e + 127);
                    }
                }
                LDS_WAIT(); __builtin_amdgcn_wave_barrier();
            }
        }
    }
    __syncthreads();
}

constexpr int HGL_QT = 0, HGL_KT = 17408, HGL_QE = 34816, HGL_KLT = 52224, HGL_VT = 70656, HGL_AM = 89088, HGL_DEC = 98304, HGL_TOT = 98816, HGL_SSQ = 100864;
constexpr int HG_LDR = 136;
constexpr int HG_LDC = 72;
template <int half>
__device__ __forceinline__ void hgrn_item(const Params& p, unsigned char* lds, int item) {
    const int b = item >> 2, h = item & 3;
    const int tid = threadIdx.x, w = tid >> 6, lane = tid & 63, fr = lane & 15, fq = lane >> 4;
    unsigned char* ws = p.ws;
    const bf16* HG = (const bf16*)(ws + WS_HG);
    bf16* YA = (bf16*)(ws + WS_H);
    bf16* QT = (bf16*)(lds + HGL_QT); bf16* KT = (bf16*)(lds + HGL_KT); bf16* QE = (bf16*)(lds + HGL_QE);
    bf16* KLT = (bf16*)(lds + HGL_KLT); bf16* VT = (bf16*)(lds + HGL_VT); bf16* AM = (bf16*)(lds + HGL_AM);
    float* DEC = (float*)(lds + HGL_DEC); float* TOT = (float*)(lds + HGL_TOT); float* SSQ = (float*)(lds + HGL_SSQ);
    const int pd = tid & 127, pq = tid >> 7;
    float lbv; { const float a0 = p.hg_lb[h * 128 + pd], a1 = p.hg_lb[512 + h * 128 + pd]; lbv = 1.f / (1.f + __expf(a1 - a0)); }
    const int e0 = w * 16;
    const float ogv = p.hg_onorm_g[e0 + fr];
    pg8::f32x4 S[8];
#pragma unroll
    for (int i = 0; i < 8; ++i) S[i] = (pg8::f32x4){0.f, 0.f, 0.f, 0.f};
    const size_t rowb = (size_t)b * SEQ;
    const int c0 = half * 32;
    bf16* QCg = (bf16*)(ws + WS_HQC) + (size_t)item * 2048 * 128; float* OLg = (float*)(ws + WS_HOL) + (size_t)item * 32 * 8 * 4 * 256;
    float cum = 1.f;
    unsigned short rq[16], rf[16], rv[16];
    { const bf16* gp = HG + (rowb + (size_t)c0 * 64 + pq * 16) * LD_HG + h * 128 + pd;
#pragma unroll
      for (int i = 0; i < 16; ++i) { rq[i] = gp[(size_t)i * LD_HG]; rf[i] = gp[(size_t)i * LD_HG + 512]; rv[i] = gp[(size_t)i * LD_HG + 1024]; } }
    for (int chunk = c0; chunk < c0 + 32; ++chunk) {
        const size_t row0 = rowb + (size_t)chunk * 64;
        float fq_[16], kq_[16], cs[16];
        float run = 0.f;
#pragma unroll
        for (int i = 0; i < 16; ++i) { const float f = lbv + (1.f - lbv) * sigmoidf_(bf2f(rf[i])); kq_[i] = 1.f - f; run += __logf(f); cs[i] = run; fq_[i] = siluf_(bf2f(rq[i])); }
        TOT[pq * 128 + pd] = run;
        { v4u v0, v1;
          v0.x = rv[0] | ((unsigned)rv[1] << 16); v0.y = rv[2] | ((unsigned)rv[3] << 16); v0.z = rv[4] | ((unsigned)rv[5] << 16); v0.w = rv[6] | ((unsigned)rv[7] << 16);
          v1.x = rv[8] | ((unsigned)rv[9] << 16); v1.y = rv[10] | ((unsigned)rv[11] << 16); v1.z = rv[12] | ((unsigned)rv[13] << 16); v1.w = rv[14] | ((unsigned)rv[15] << 16);
          *(v4u*)(VT + pd * HG_LDC + pq * 16) = v0; *(v4u*)(VT + pd * HG_LDC + pq * 16 + 8) = v1; }
        unsigned short rg[16];
#pragma unroll
        for (int i = 0; i < 16; ++i) rg[i] = half ? (unsigned short)0 : HG[(row0 + (i >> 2) * 16 + fq * 4 + (i & 3)) * LD_HG + 1536 + h * 128 + e0 + fr];
        if (chunk + 1 < c0 + 32) { const bf16* gp = HG + (row0 + 64 + pq * 16) * LD_HG + h * 128 + pd;
#pragma unroll
            for (int i = 0; i < 16; ++i) { rq[i] = gp[(size_t)i * LD_HG]; rf[i] = gp[(size_t)i * LD_HG + 512]; rv[i] = gp[(size_t)i * LD_HG + 1024]; } }
        __syncthreads();
        const float t0 = TOT[pd], t1 = TOT[128 + pd], t2 = TOT[256 + pd], t3 = TOT[384 + pd];
        const float base = (pq > 0 ? t0 : 0.f) + (pq > 1 ? t1 : 0.f) + (pq > 2 ? t2 : 0.f);
        const float bmid = t0 + t1, blast = (t0 + t1) + (t2 + t3);
        const float emid = __expf(bmid), elm = __expf(blast - bmid);
        if (pq == 0) DEC[pd] = __expf(blast);
        { unsigned klp[8];
#pragma unroll
          for (int i = 0; i < 16; ++i) { const float bb = base + cs[i]; const float E1 = __expf(bb - bmid), R1 = __builtin_amdgcn_rcpf(E1);
              const float qtv = fq_[i] * E1, ktv = kq_[i] * R1, qev = qtv * emid, klv = ktv * elm;
              const int srow = pq * 16 + i;
              QT[srow * HG_LDR + pd] = (bf16)f2bf(qtv); KT[srow * HG_LDR + pd] = (bf16)f2bf(ktv); QE[srow * HG_LDR + pd] = (bf16)f2bf(qev);
              if (half) QCg[((size_t)(chunk - 32) * 64 + srow) * 128 + pd] = (bf16)f2bf(qev * cum);
              if (i & 1) klp[i >> 1] |= f2bf(klv) << 16; else klp[i >> 1] = f2bf(klv); }
          *(v4u*)(KLT + pd * HG_LDC + pq * 16) = (v4u){klp[0], klp[1], klp[2], klp[3]}; *(v4u*)(KLT + pd * HG_LDC + pq * 16 + 8) = (v4u){klp[4], klp[5], klp[6], klp[7]}; }
        cum *= __expf(blast);
        __syncthreads();
#pragma unroll
        for (int tt = 0; tt < 2; ++tt) { const int id = w + 8 * tt, rt = id >> 2, ct = id & 3;
            pg8::f32x4 a = {0.f, 0.f, 0.f, 0.f};
            if (ct <= rt) {
#pragma unroll
                for (int ks = 0; ks < 4; ++ks) { const bf16x8 af = *(const bf16x8*)(QT + (rt * 16 + fr) * HG_LDR + ks * 32 + fq * 8), bfv = *(const bf16x8*)(KT + (ct * 16 + fr) * HG_LDR + ks * 32 + fq * 8);
                    a = __builtin_amdgcn_mfma_f32_16x16x32_bf16(af, bfv, a, 0, 0, 0); } }
#pragma unroll
            for (int r = 0; r < 4; ++r) { const int c = rt * 16 + fq * 4 + r, sidx = ct * 16 + fr; AM[c * HG_LDC + sidx] = (bf16)((sidx <= c) ? f2bf(a[r]) : 0u); } }
        __syncthreads();
        const bf16x8 vb0 = *(const bf16x8*)(VT + (e0 + fr) * HG_LDC + fq * 8), vb1 = *(const bf16x8*)(VT + (e0 + fr) * HG_LDC + 32 + fq * 8);
        bf16x8 sb[4];
#pragma unroll
        for (int ks = 0; ks < 4; ++ks) { v4u t; t.x = pk2(S[2 * ks][0], S[2 * ks][1]); t.y = pk2(S[2 * ks][2], S[2 * ks][3]); t.z = pk2(S[2 * ks + 1][0], S[2 * ks + 1][1]); t.w = pk2(S[2 * ks + 1][2], S[2 * ks + 1][3]); sb[ks] = __builtin_bit_cast(bf16x8, t); }
        pg8::f32x4 o[4];
#pragma unroll
        for (int rt = 0; rt < 4; ++rt) { pg8::f32x4 a = {0.f, 0.f, 0.f, 0.f};
            a = __builtin_amdgcn_mfma_f32_16x16x32_bf16(*(const bf16x8*)(AM + (rt * 16 + fr) * HG_LDC + fq * 8), vb0, a, 0, 0, 0);
            a = __builtin_amdgcn_mfma_f32_16x16x32_bf16(*(const bf16x8*)(AM + (rt * 16 + fr) * HG_LDC + 32 + fq * 8), vb1, a, 0, 0, 0);
#pragma unroll
            for (int ks = 0; ks < 4; ++ks) { const v2u lo = *(const v2u*)(QE + (rt * 16 + fr) * HG_LDR + ks * 32 + fq * 4), hi = *(const v2u*)(QE + (rt * 16 + fr) * HG_LDR + ks * 32 + 16 + fq * 4);
                const v4u t = {lo.x, lo.y, hi.x, hi.y};
                a = __builtin_amdgcn_mfma_f32_16x16x32_bf16(__builtin_bit_cast(bf16x8, t), sb[ks], a, 0, 0, 0); }
            o[rt] = a; }
#pragma unroll
        for (int dt = 0; dt < 8; ++dt) { const f32x4 dc = *(const f32x4*)(DEC + dt * 16 + fq * 4);
            pg8::f32x4 a = S[dt]; a[0] *= dc[0]; a[1] *= dc[1]; a[2] *= dc[2]; a[3] *= dc[3];
            a = __builtin_amdgcn_mfma_f32_16x16x32_bf16(*(const bf16x8*)(KLT + (dt * 16 + fr) * HG_LDC + fq * 8), vb0, a, 0, 0, 0);
            a = __builtin_amdgcn_mfma_f32_16x16x32_bf16(*(const bf16x8*)(KLT + (dt * 16 + fr) * HG_LDC + 32 + fq * 8), vb1, a, 0, 0, 0);
            S[dt] = a; }
        if (half) {
#pragma unroll
            for (int rt = 0; rt < 4; ++rt) *(pg8::f32x4*)(OLg + ((((size_t)(chunk - 32)) * 8 + w) * 4 + rt) * 256 + lane * 4) = o[rt];
            __syncthreads();
            continue;
        }
#pragma unroll
        for (int rt = 0; rt < 4; ++rt)
#pragma unroll
            for (int r = 0; r < 4; ++r) { float x = o[rt][r] * o[rt][r];
                x += __shfl_xor(x, 1); x += __shfl_xor(x, 2); x += __shfl_xor(x, 4); x += __shfl_xor(x, 8);
                if (fr == 0) SSQ[w * 64 + rt * 16 + fq * 4 + r] = x; }
        __syncthreads();
        float tot = 0.f;
#pragma unroll
        for (int ww = 0; ww < 8; ++ww) tot += SSQ[ww * 64 + lane];
        const float rstd_l = rsqrtf(tot * (1.f / 128.f) + RMS_EPS);
#pragma unroll
        for (int rt = 0; rt < 4; ++rt)
#pragma unroll
            for (int r = 0; r < 4; ++r) { const int c = rt * 16 + fq * 4 + r; const float rs = __shfl(rstd_l, c);
                const float y = o[rt][r] * rs * ogv * siluf_(bf2f(rg[rt * 4 + r]));
                ((unsigned char*)YA)[(row0 + c) * 1024 + h * 128 + e0 + fr] = (unsigned char)(__builtin_amdgcn_cvt_pk_fp8_f32(y, 0.f, 0, false) & 0xff); }
    }
    if (!half) {
#pragma unroll
        for (int ks = 0; ks < 4; ++ks) { v4u t; t.x = pk2(S[2 * ks][0], S[2 * ks][1]); t.y = pk2(S[2 * ks][2], S[2 * ks][3]); t.z = pk2(S[2 * ks + 1][0], S[2 * ks + 1][1]); t.w = pk2(S[2 * ks + 1][2], S[2 * ks + 1][3]);
            *(v4u*)(ws + WS_HSB + ((((size_t)item * 8 + w) * 4 + ks) * 64 + lane) * 16) = t; }
    }
    __syncthreads();
}
__device__ __forceinline__ void hgrn_fix(const Params& p, unsigned char* lds, int item, int c) {
    const int b = item >> 2, h = item & 3;
    const int tid = threadIdx.x, w = tid >> 6, lane = tid & 63, fr = lane & 15, fq = lane >> 4;
    unsigned char* ws = p.ws;
    const bf16* HG = (const bf16*)(ws + WS_HG);
    bf16* YA = (bf16*)(ws + WS_H);
    float* SSQ = (float*)(lds + HGL_SSQ);
    const bf16* QCg = (const bf16*)(ws + WS_HQC) + (size_t)item * 2048 * 128; const float* OLg = (const float*)(ws + WS_HOL) + (size_t)item * 32 * 8 * 4 * 256;
    const int e0 = w * 16;
    const float ogv = p.hg_onorm_g[e0 + fr];
    const size_t row0 = (size_t)b * SEQ + (size_t)(32 + c) * 64;
    bf16x8 sb[4];
#pragma unroll
    for (int ks = 0; ks < 4; ++ks) sb[ks] = __builtin_bit_cast(bf16x8, *(const v4u*)(ws + WS_HSB + ((((size_t)item * 8 + w) * 4 + ks) * 64 + lane) * 16));
    unsigned short rg[16];
#pragma unroll
    for (int i = 0; i < 16; ++i) rg[i] = HG[(row0 + (i >> 2) * 16 + fq * 4 + (i & 3)) * LD_HG + 1536 + h * 128 + e0 + fr];
    pg8::f32x4 o[4];
#pragma unroll
    for (int rt = 0; rt < 4; ++rt) { pg8::f32x4 a = *(const pg8::f32x4*)(OLg + ((((size_t)c) * 8 + w) * 4 + rt) * 256 + lane * 4);
#pragma unroll
        for (int ks = 0; ks < 4; ++ks) { const bf16* qr = QCg + ((size_t)c * 64 + rt * 16 + fr) * 128 + ks * 32;
            const v2u lo = *(const v2u*)(qr + fq * 4), hi = *(const v2u*)(qr + 16 + fq * 4);
            const v4u t = {lo.x, lo.y, hi.x, hi.y};
            a = __builtin_amdgcn_mfma_f32_16x16x32_bf16(__builtin_bit_cast(bf16x8, t), sb[ks], a, 0, 0, 0); }
        o[rt] = a; }
#pragma unroll
    for (int rt = 0; rt < 4; ++rt)
#pragma unroll
        for (int r = 0; r < 4; ++r) { float x = o[rt][r] * o[rt][r];
            x += __shfl_xor(x, 1); x += __shfl_xor(x, 2); x += __shfl_xor(x, 4); x += __shfl_xor(x, 8);
            if (fr == 0) SSQ[w * 64 + rt * 16 + fq * 4 + r] = x; }
    __syncthreads();
    float tot = 0.f;
#pragma unroll
    for (int ww = 0; ww < 8; ++ww) tot += SSQ[ww * 64 + lane];
    const float rstd_l = rsqrtf(tot * (1.f / 128.f) + RMS_EPS);
#pragma unroll
    for (int rt = 0; rt < 4; ++rt)
#pragma unroll
        for (int r = 0; r < 4; ++r) { const int cc = rt * 16 + fq * 4 + r; const float rs = __shfl(rstd_l, cc);
            const float y = o[rt][r] * rs * ogv * siluf_(bf2f(rg[rt * 4 + r]));
            ((unsigned char*)YA)[(row0 + cc) * 1024 + h * 128 + e0 + fr] = (unsigned char)(__builtin_amdgcn_cvt_pk_fp8_f32(y, 0.f, 0, false) & 0xff); }
    __syncthreads();
}

__device__ __forceinline__ unsigned f16key(float x) {
    x = x + 0.f;
    const _Float16 hx = (_Float16)x; const unsigned short bits = __builtin_bit_cast(unsigned short, hx);
    return (bits & 0x8000u) ? (unsigned)(unsigned short)(~bits) : (unsigned)(bits | 0x8000u);
}
__device__ __forceinline__ void find_bin(const unsigned* hist, int K, int lane, int& bin, int& rem) {
    const v4u hv = *(const v4u*)(hist + 4 * lane);
    const unsigned c = hv.x + hv.y + hv.z + hv.w;
    unsigned suf = c;
#pragma unroll
    for (int o = 1; o < 64; o <<= 1) { const unsigned t = __shfl_down(suf, o); if (lane + o < 64) suf += t; }
    const unsigned above = suf - c;
    const bool mine = (above < (unsigned)K) && ((unsigned)K <= suf);
    int mybin = 0, myrem = 0;
    if (mine) { unsigned ca = above; const unsigned hh[4] = {hv.x, hv.y, hv.z, hv.w}; bool found = false;
#pragma unroll
        for (int i = 3; i >= 0; --i) { if (!found) { if (ca + hh[i] >= (unsigned)K) { mybin = 4 * lane + i; myrem = K - (int)ca; found = true; } else ca += hh[i]; } } }
    const unsigned long long m = __ballot(mine);
    const int src = (int)__builtin_ctzll(m | (1ull << 63));
    bin = __shfl(mybin, src); rem = __shfl(myrem, src);
}
__device__ __forceinline__ void dsa1_item(const Params& p, unsigned char* lds, int item) {
    const int b = item >> 8, q0 = (item & 255) * 16;
    const int tid = threadIdx.x, w = tid >> 6, lane = tid & 63, fr = lane & 15, fq = lane >> 4;
    unsigned char* ws = p.ws;
    const bf16* IDX = (const bf16*)(ws + WS_IDX);
    unsigned short* Ik = (unsigned short*)lds;
    unsigned* hist1 = (unsigned*)(lds + 131072);
    unsigned* hist = (unsigned*)(lds + 131072 + 16384) + w * 256;
    const size_t rowb = (size_t)b * SEQ;
    *(v4u*)(hist1 + tid * 4) = (v4u){0u, 0u, 0u, 0u}; *(v4u*)(hist1 + 2048 + tid * 4) = (v4u){0u, 0u, 0u, 0u};
    bf16x8 Af[8][2];
    { const bf16* rp = IDX + (rowb + q0 + fr) * LD_IDX + fq * 8;
#pragma unroll
      for (int h = 0; h < 8; ++h) { Af[h][0] = *(const bf16x8*)(rp + h * 64); Af[h][1] = *(const bf16x8*)(rp + h * 64 + 32); } }
    const float idx_scale = 0.5f * 0.125f * 0.35355339059327373f;
    bf16x8 Aw[2];
    { float wa[8];
      { const v4u wq = *(const v4u*)(IDX + (rowb + q0 + fr) * LD_IDX + 576);
#pragma unroll
        for (int i = 0; i < 4; ++i) { wa[2 * i] = bflo(wq[i]) * idx_scale; wa[2 * i + 1] = bfhi(wq[i]) * idx_scale; } }
#pragma unroll
      for (int ks = 0; ks < 2; ++ks) { float cq[8];
#pragma unroll
          for (int j = 0; j < 8; ++j) cq[j] = 0.f;
#pragma unroll
          for (int h = 0; h < 8; ++h)
#pragma unroll
              for (int j = 0; j < 8; ++j) cq[j] += wa[h] * bf2f((unsigned)(unsigned short)Af[h][ks][j]);
          const v4u t = {pk2(cq[0], cq[1]), pk2(cq[2], cq[3]), pk2(cq[4], cq[5]), pk2(cq[6], cq[7])};
          Aw[ks] = __builtin_bit_cast(bf16x8, t); } }
    float wv[4][8];
#pragma unroll
    for (int r = 0; r < 4; ++r) { const v4u wq = *(const v4u*)(IDX + (rowb + q0 + fq * 4 + r) * LD_IDX + 576);
#pragma unroll
        for (int i = 0; i < 4; ++i) { wv[r][2 * i] = bflo(wq[i]) * idx_scale; wv[r][2 * i + 1] = bfhi(wq[i]) * idx_scale; } }
    const int ntiles = (q0 >> 4) + 1;
    __syncthreads();
    bf16x8 B0 = Aw[0], B1 = Aw[1];
    if (w < ntiles) { const bf16* kp = IDX + (rowb + w * 16 + fr) * LD_IDX + 512 + fq * 8; B0 = *(const bf16x8*)kp; B1 = *(const bf16x8*)(kp + 32); }
    for (int kt = w; kt < ntiles; kt += NWAVES) {
        bf16x8 nB0 = B0, nB1 = B1;
        if (kt + NWAVES < ntiles) { const bf16* kp = IDX + (rowb + (kt + NWAVES) * 16 + fr) * LD_IDX + 512 + fq * 8; nB0 = *(const bf16x8*)kp; nB1 = *(const bf16x8*)(kp + 32); }
        pg8::f32x4 lin = {0.f, 0.f, 0.f, 0.f};
        lin = __builtin_amdgcn_mfma_f32_16x16x32_bf16(Aw[0], B0, lin, 0, 0, 0);
        lin = __builtin_amdgcn_mfma_f32_16x16x32_bf16(Aw[1], B1, lin, 0, 0, 0);
        float I[4] = {lin[0], lin[1], lin[2], lin[3]};
#pragma unroll
        for (int h = 0; h < 8; ++h) { pg8::f32x4 a = {0.f, 0.f, 0.f, 0.f};
            a = __builtin_amdgcn_mfma_f32_16x16x32_bf16(Af[h][0], B0, a, 0, 0, 0);
            a = __builtin_amdgcn_mfma_f32_16x16x32_bf16(Af[h][1], B1, a, 0, 0, 0);
#pragma unroll
            for (int r = 0; r < 4; ++r) I[r] = __builtin_fmaf(wv[r][h], __builtin_fabsf(a[r]), I[r]); }
        const int kidx = kt * 16 + fr;
#pragma unroll
        for (int r = 0; r < 4; ++r) { const unsigned key = f16key(I[r]); Ik[(fq * 4 + r) * 4096 + kidx] = (unsigned short)key;
            if (kidx <= q0 + fq * 4 + r) atomicAdd(&hist1[(fq * 4 + r) * 256 + (key >> 8)], 1u); }
        B0 = nB0; B1 = nB1;
    }
    __syncthreads();
    for (int qq = w; qq < 16; qq += NWAVES) {
        const int t = q0 + qq, n = t + 1;
        unsigned short* so = (unsigned short*)(hist1 + qq * 256);
        const unsigned short* keys = Ik + qq * 4096;
        if (n <= TOPK) { for (int j = lane; j < n; j += 64) so[j] = (unsigned short)j; }
        else {
            int b1, rem1, b2, rem2;
            find_bin(hist1 + qq * 256, TOPK, lane, b1, rem1);
            *(v4u*)(hist + 4 * lane) = (v4u){0u, 0u, 0u, 0u};
            LDS_WAIT(); __builtin_amdgcn_wave_barrier();
            for (int j = lane; j < n; j += 64) { const unsigned k = keys[j]; if ((int)(k >> 8) == b1) atomicAdd(&hist[k & 255u], 1u); }
            LDS_WAIT(); __builtin_amdgcn_wave_barrier();
            find_bin(hist, rem1, lane, b2, rem2);
            const unsigned thr = ((unsigned)b1 << 8) | (unsigned)b2;
            int base = 0, eqtaken = 0;
            const unsigned long long lt = (lane == 0) ? 0ull : (~0ull >> (64 - lane));
            for (int j0 = 0; j0 < n; j0 += 64) {
                const int j = j0 + lane; const bool valid = j < n; const unsigned k = valid ? (unsigned)keys[j] : 0u;
                const bool gt = valid && k > thr, eq = valid && k == thr;
                const unsigned long long meq = __ballot(eq);
                const int erank = __popcll(meq & lt) + eqtaken;
                const bool take = gt || (eq && erank < rem2);
                const unsigned long long mt = __ballot(take);
                if (take) so[base + __popcll(mt & lt)] = (unsigned short)j;
                base += __popcll(mt); eqtaken += __popcll(meq);
            }
        }
    }
    __syncthreads();
}

__device__ __forceinline__ void qknorm_token(const Params& p, int tok, int lane) {
    const bf16* row = (const bf16*)(p.ws + WS_ATT) + (size_t)tok * LD_ATT;
    const int c8 = (lane & 7) * 8;
    { const v4u qv = *(const v4u*)(row + lane * 8);
      float x[8]; float ss = 0.f;
#pragma unroll
      for (int i = 0; i < 4; ++i) { x[2 * i] = bflo(qv[i]); x[2 * i + 1] = bfhi(qv[i]); ss += x[2 * i] * x[2 * i] + x[2 * i + 1] * x[2 * i + 1]; }
      ss += __shfl_xor(ss, 1); ss += __shfl_xor(ss, 2); ss += __shfl_xor(ss, 4);
      const float rs = rsqrtf(ss * (1.f / 64.f) + RMS_EPS) * (0.125f * 1.4426950408889634f);
#pragma unroll
      for (int i = 0; i < 8; ++i) x[i] = x[i] * rs * p.q_norm_g[c8 + i];
      v2u hw, lw;
      hw.x = pk4_fp8(x[0], x[1], x[2], x[3]); hw.y = pk4_fp8(x[4], x[5], x[6], x[7]);
      { const f32x2 d0 = __builtin_amdgcn_cvt_pk_f32_fp8((int)hw.x, false), d1 = __builtin_amdgcn_cvt_pk_f32_fp8((int)hw.x, true), d2 = __builtin_amdgcn_cvt_pk_f32_fp8((int)hw.y, false), d3 = __builtin_amdgcn_cvt_pk_f32_fp8((int)hw.y, true);
        lw.x = pk4_fp8(x[0] - d0[0], x[1] - d0[1], x[2] - d1[0], x[3] - d1[1]); lw.y = pk4_fp8(x[4] - d2[0], x[5] - d2[1], x[6] - d3[0], x[7] - d3[1]); }
      *(v2u*)(p.ws + WS_QHI + (size_t)tok * 512 + lane * 8) = hw; *(v2u*)(p.ws + WS_QLO + (size_t)tok * 512 + lane * 8) = lw; }
    { const v4u kv = *(const v4u*)(row + 512 + (lane & 15) * 8);
      float x[8]; float ss = 0.f;
#pragma unroll
      for (int i = 0; i < 4; ++i) { x[2 * i] = bflo(kv[i]); x[2 * i + 1] = bfhi(kv[i]); ss += x[2 * i] * x[2 * i] + x[2 * i + 1] * x[2 * i + 1]; }
      ss += __shfl_xor(ss, 1); ss += __shfl_xor(ss, 2); ss += __shfl_xor(ss, 4);
      const float rs = rsqrtf(ss * (1.f / 64.f) + RMS_EPS);
#pragma unroll
      for (int i = 0; i < 8; ++i) x[i] = x[i] * rs * p.k_norm_g[c8 + i];
      v2u o; o.x = pk4_fp8(x[0], x[1], x[2], x[3]); o.y = pk4_fp8(x[4], x[5], x[6], x[7]);
      if (lane < 16) *(v2u*)(p.ws + WS_K8 + (size_t)tok * 128 + lane * 8) = o; }
}

typedef short v4i16_t __attribute__((ext_vector_type(4)));
__device__ __forceinline__ v4i16_t vtr16(const bf16* ldsp) { return __builtin_amdgcn_ds_read_tr16_b64_v4i16((LAS v4i16_t*)ldsp); }
__device__ __forceinline__ void dsa2_query(const Params& p, unsigned char* ldsw, const unsigned short* sel, int b, int t, int lane) {
    unsigned char* ws = p.ws;
    const bf16* ATT = (const bf16*)(ws + WS_ATT);
    bf16* YB = (bf16*)(ws + WS_H);
    unsigned short* sl = (unsigned short*)ldsw;
    float* df = (float*)(ldsw + 512);
    bf16* Vl = (bf16*)(ldsw + 1536);
    const int fr = lane & 15, fq = lane >> 4;
    const size_t rowb = (size_t)b * SEQ;
    const int cnt = (t + 1 < TOPK) ? (t + 1) : TOPK;
    { v2u sv = *(const v2u*)(sel + lane * 4);
      const int j0 = lane * 4;
      if (j0 >= cnt) sv.x = 0u; else if (j0 + 1 >= cnt) sv.x &= 0xffffu;
      if (j0 + 2 >= cnt) sv.y = 0u; else if (j0 + 3 >= cnt) sv.y &= 0xffffu;
      *(v2u*)(sl + lane * 4) = sv;
      f32x4 d4; d4[0] = (j0 < cnt) ? (float)(t - (int)(sv.x & 0xffffu)) : INFINITY; d4[1] = (j0 + 1 < cnt) ? (float)(t - (int)(sv.x >> 16)) : INFINITY;
      d4[2] = (j0 + 2 < cnt) ? (float)(t - (int)(sv.y & 0xffffu)) : INFINITY; d4[3] = (j0 + 3 < cnt) ? (float)(t - (int)(sv.y >> 16)) : INFINITY;
      *(f32x4*)(df + lane * 4) = d4; }
    LDS_WAIT(); __builtin_amdgcn_wave_barrier();
    const unsigned char* K8 = ws + WS_K8;
    long qhA[2] = {0, 0}, qhB[2] = {0, 0}, qlA[2] = {0, 0}, qlB[2] = {0, 0};
    if (fr < 8) { const v4u qh = *(const v4u*)(ws + WS_QHI + (rowb + t) * 512 + fr * 64 + fq * 16), ql = *(const v4u*)(ws + WS_QLO + (rowb + t) * 512 + fr * 64 + fq * 16);
        const long hA = (long)(((unsigned long long)qh.y << 32) | qh.x), hB = (long)(((unsigned long long)qh.w << 32) | qh.z), lA = (long)(((unsigned long long)ql.y << 32) | ql.x), lB = (long)(((unsigned long long)ql.w << 32) | ql.z);
        if (fr < 4) { qhA[0] = hA; qhB[0] = hB; qlA[0] = lA; qlB[0] = lB; } else { qhA[1] = hA; qhB[1] = hB; qlA[1] = lA; qlB[1] = lB; } }
    pg8::f32x4 sc[16];
    v4u vv[16];
    { v4u kf[16];
#pragma unroll
      for (int half = 0; half < 2; ++half) {
#pragma unroll
          for (int kt = 0; kt < 8; ++kt) { const int s = sl[(half * 8 + kt) * 16 + fr]; const unsigned char* kp = K8 + (rowb + s) * 128 + fq * 16;
              kf[2 * kt] = *(const v4u*)kp; kf[2 * kt + 1] = *(const v4u*)(kp + 64); }
          if (half == 1) {
#pragma unroll
              for (int i = 0; i < 8; ++i) { const int s = sl[i * 8 + (lane >> 3)]; vv[i] = *(const v4u*)(ATT + (rowb + s) * LD_ATT + 640 + (lane & 7) * 8); } }
          __builtin_amdgcn_sched_barrier(0);
#pragma unroll
          for (int kt = 0; kt < 8; ++kt) { pg8::f32x4 a = {0.f, 0.f, 0.f, 0.f};
#pragma unroll
              for (int gg = 0; gg < 2; ++gg) { const v4u kv = kf[2 * kt + gg];
                  const long kA = (long)(((unsigned long long)kv.y << 32) | kv.x), kB = (long)(((unsigned long long)kv.w << 32) | kv.z);
                  a = __builtin_amdgcn_mfma_f32_16x16x32_fp8_fp8(kA, qhA[gg], a, 0, 0, 0); a = __builtin_amdgcn_mfma_f32_16x16x32_fp8_fp8(kB, qhB[gg], a, 0, 0, 0);
                  a = __builtin_amdgcn_mfma_f32_16x16x32_fp8_fp8(kA, qlA[gg], a, 0, 0, 0); a = __builtin_amdgcn_mfma_f32_16x16x32_fp8_fp8(kB, qlB[gg], a, 0, 0, 0); }
              sc[half * 8 + kt] = a; }
          __builtin_amdgcn_sched_barrier(0);
      } }
    const float slope = exp2f(-(float)((fr & 7) + 1)) * 1.4426950408889634f;
    float m = -INFINITY;
#pragma unroll
    for (int kt = 0; kt < 16; ++kt) { const f32x4 d4 = *(const f32x4*)(df + kt * 16 + fq * 4);
#pragma unroll
        for (int r = 0; r < 4; ++r) { const float x = sc[kt][r] - slope * d4[r]; sc[kt][r] = x; m = fmaxf(m, x); } }
    m = fmaxf(m, __shfl_xor(m, 16)); m = fmaxf(m, __shfl_xor(m, 32));
    float l = 0.f;
#pragma unroll
    for (int kt = 0; kt < 16; ++kt)
#pragma unroll
        for (int r = 0; r < 4; ++r) { const float e = __builtin_amdgcn_exp2f(sc[kt][r] - m); sc[kt][r] = e; l += e; }
    l += __shfl_xor(l, 16); l += __shfl_xor(l, 32);
    const float inv = 1.f / l;
#pragma unroll 1
    for (int g = 0; g < 2; ++g) {
        if (g == 1) {
#pragma unroll
            for (int i = 0; i < 8; ++i) { const int s = sl[i * 8 + (lane >> 3)]; vv[i] = *(const v4u*)(ATT + (rowb + s) * LD_ATT + 640 + 64 + (lane & 7) * 8); } }
#pragma unroll
        for (int i = 8; i < 16; ++i) { const int s = sl[i * 8 + (lane >> 3)]; vv[i] = *(const v4u*)(ATT + (rowb + s) * LD_ATT + 640 + g * 64 + (lane & 7) * 8); }
        pg8::f32x4 o[4];
#pragma unroll
        for (int dt = 0; dt < 4; ++dt) o[dt] = (pg8::f32x4){0.f, 0.f, 0.f, 0.f};
#pragma unroll
        for (int ch = 0; ch < 4; ++ch) {
            LDS_WAIT(); __builtin_amdgcn_wave_barrier();
#pragma unroll
            for (int i = 0; i < 8; ++i) *(v4u*)(Vl + (i * 8 + (lane >> 3)) * 80 + (lane & 7) * 8) = vv[(ch & 1) * 8 + i];
            if (ch < 2) {
#pragma unroll
                for (int i = 0; i < 8; ++i) { const int s = sl[((ch + 2) * 8 + i) * 8 + (lane >> 3)]; vv[(ch & 1) * 8 + i] = *(const v4u*)(ATT + (rowb + s) * LD_ATT + 640 + g * 64 + (lane & 7) * 8); } }
            LDS_WAIT(); __builtin_amdgcn_wave_barrier();
#pragma unroll
            for (int k2 = 0; k2 < 2; ++k2) { const int kt0 = ch * 4 + 2 * k2;
                v4u pw; pw.x = pk2(sc[kt0][0], sc[kt0][1]); pw.y = pk2(sc[kt0][2], sc[kt0][3]); pw.z = pk2(sc[kt0 + 1][0], sc[kt0 + 1][1]); pw.w = pk2(sc[kt0 + 1][2], sc[kt0 + 1][3]);
                const bf16x8 pb = __builtin_bit_cast(bf16x8, pw);
#pragma unroll
                for (int dt = 0; dt < 4; ++dt) { const bf16* vp = Vl + ((2 * k2) * 16 + fq * 4 + (fr >> 2)) * 80 + dt * 16 + (fr & 3) * 4;
                    const v4i16_t lo = vtr16(vp), hi = vtr16(vp + 16 * 80);
                    const bf16x8 af = {lo[0], lo[1], lo[2], lo[3], hi[0], hi[1], hi[2], hi[3]};
                    o[dt] = __builtin_amdgcn_mfma_f32_16x16x32_bf16(af, pb, o[dt], 0, 0, 0); } }
        }
        if (fr < 8 && (fr >> 2) == g) {
#pragma unroll
            for (int dt = 0; dt < 4; ++dt) { const float i8 = inv * 8.f;
                *(unsigned*)((unsigned char*)YB + (rowb + t) * 1024 + 512 + fr * 64 + dt * 16 + fq * 4) = pk4_fp8(o[dt][0] * i8, o[dt][1] * i8, o[dt][2] * i8, o[dt][3] * i8); } }
    }
    LDS_WAIT(); __builtin_amdgcn_wave_barrier();
}

#define INS16(L, x) do { _Pragma("unroll") for (int _i = 15; _i >= 1; --_i) L[_i] = __builtin_amdgcn_fmed3f(L[_i - 1], L[_i], (x)); L[0] = fmaxf(L[0], (x)); } while (0)
__device__ __forceinline__ float f_andor(float v, unsigned keepmask, unsigned orv) { return __builtin_bit_cast(float, (__builtin_bit_cast(unsigned, v) & keepmask) | orv); }
__device__ __forceinline__ void peer_select(const Params& p, unsigned char* ldsw, int tg, int h, int lane, int* EIDX, float* GATES) {
    float* sc = (float*)ldsw;
    LDS_WAIT(); __builtin_amdgcn_wave_barrier();
    float L[16];
#pragma unroll
    for (int i = 0; i < 16; ++i) L[i] = -INFINITY;
    { const float* sp = sc + (lane & 31) * 132 + (lane >> 5) * 64;
#pragma unroll 4
      for (int i = 0; i < 16; ++i) { const f32x4 x = *(const f32x4*)(sp + 4 * i); INS16(L, x[0]); INS16(L, x[1]); INS16(L, x[2]); INS16(L, x[3]); } }
    { float O[16];
#pragma unroll
      for (int i = 0; i < 16; ++i) O[i] = __shfl_xor(L[i], 32);
#pragma unroll
      for (int i = 0; i < 16; ++i) INS16(L, O[i]); }
    LDS_WAIT(); __builtin_amdgcn_wave_barrier();
    float* lst = sc;
    if (lane < 32) {
#pragma unroll
        for (int i = 0; i < 4; ++i) *(f32x4*)(lst + lane * 16 + 4 * i) = (f32x4){L[4 * i], L[4 * i + 1], L[4 * i + 2], L[4 * i + 3]}; }
    LDS_WAIT(); __builtin_amdgcn_wave_barrier();
    const int tok = lane & 15;
    float s1[16], s2[16];
#pragma unroll
    for (int i = 0; i < 4; ++i) { const f32x4 a = *(const f32x4*)(lst + tok * 16 + 4 * i), b = *(const f32x4*)(lst + (16 + tok) * 16 + 4 * i);
#pragma unroll
        for (int c = 0; c < 4; ++c) { s1[4 * i + c] = f_andor(a[c], ~127u, 0u); s2[4 * i + c] = f_andor(b[c], ~127u, 0u); } }
    float M[16];
#pragma unroll
    for (int i = 0; i < 16; ++i) M[i] = -INFINITY;
#pragma unroll
    for (int a = 0; a < 16; ++a)
#pragma unroll
        for (int b = 0; b < 16; ++b)
            if ((a + 1) * (b + 1) <= 16) { const float key = f_andor(s1[a] + s2[b], ~255u, (unsigned)(a * 16 + b)); INS16(M, key); }
    const float mx = f_andor(M[0], ~255u, 0u);
    float e[16], sum = 0.f; int ei[16];
    const unsigned* lb = (const unsigned*)lst;
#pragma unroll
    for (int i = 0; i < 16; ++i) { const unsigned bits = __builtin_bit_cast(unsigned, M[i]); const int flat = bits & 255u;
        e[i] = __expf(f_andor(M[i], ~255u, 0u) - mx); sum += e[i];
        ei[i] = (int)(lb[tok * 16 + (flat >> 4)] & 127u) * 128 + (int)(lb[(16 + tok) * 16 + (flat & 15)] & 127u); }
    const float inv = 1.f / sum;
    if (lane < 16) {
        const size_t ob = ((size_t)tok * 8 + h) * 16;
#pragma unroll
        for (int i = 0; i < 4; ++i) { *(v4u*)(EIDX + ob + 4 * i) = (v4u){(unsigned)ei[4 * i], (unsigned)ei[4 * i + 1], (unsigned)ei[4 * i + 2], (unsigned)ei[4 * i + 3]};
            *(f32x4*)(GATES + ob + 4 * i) = (f32x4){e[4 * i] * inv, e[4 * i + 1] * inv, e[4 * i + 2] * inv, e[4 * i + 3] * inv}; }
    }
    LDS_WAIT(); __builtin_amdgcn_wave_barrier();
}

__device__ __forceinline__ void peer_route_block(const Params& p, unsigned char* lds, int* eG, float* gG) {
    const int tid = threadIdx.x, wave = tid >> 6, lane = tid & 63, fr = lane & 15, fq = lane >> 4, G = gridDim.x;
    unsigned char* ws = p.ws;
    const bf16* Q = (const bf16*)(ws + WS_Q);
    const unsigned char* SKb = ws + WS_SK;
    unsigned char* tile = lds + 8 * 16896;
    float* sc = (float*)(lds + wave * 16896);
    int ngrp = 0;
    for (int tg = blockIdx.x; tg < T / 16; tg += G) ++ngrp;
#pragma unroll 1
    for (int k0 = 0; k0 < ngrp; k0 += 8) {
        const bool valid = k0 + wave < ngrp;
        const int tg = (int)blockIdx.x + (valid ? k0 + wave : k0) * G;
        v4u t[4][2];
        bf16x8 An[2][4];
#pragma unroll
        for (int sub = 0; sub < 4; ++sub) { const unsigned char* sp = SKb + (size_t)sub * 16384 + tid * 32; t[sub][0] = *(const v4u*)sp; t[sub][1] = *(const v4u*)(sp + 16); }
#pragma unroll
        for (int pp = 0; pp < 2; ++pp) { const bf16* rp = Q + (size_t)(tg * 16 + fr) * 2048 + pp * 128 + fq * 8;
#pragma unroll
            for (int ks = 0; ks < 4; ++ks) An[pp][ks] = *(const bf16x8*)(rp + ks * 32); }
#pragma unroll 1
        for (int h = 0; h < 8; ++h) {
            bf16x8 Af[2][4];
#pragma unroll
            for (int pp = 0; pp < 2; ++pp)
#pragma unroll
                for (int ks = 0; ks < 4; ++ks) Af[pp][ks] = An[pp][ks];
            const int hn = (h + 1) & 7;
#pragma unroll
            for (int sub = 0; sub < 4; ++sub) {
                const int pp = sub >> 1, half = sub & 1;
                __syncthreads();
                { unsigned char* wp = tile + (tid >> 3) * 272 + (tid & 7) * 32; *(v4u*)wp = t[sub][0]; *(v4u*)(wp + 16) = t[sub][1]; }
                { const unsigned char* sp = SKb + (size_t)(hn * 4 + sub) * 16384 + tid * 32; t[sub][0] = *(const v4u*)sp; t[sub][1] = *(const v4u*)(sp + 16); }
                __syncthreads();
#pragma unroll
                for (int kt = 0; kt < 4; ++kt) {
                    pg8::f32x4 a = {0.f, 0.f, 0.f, 0.f};
#pragma unroll
                    for (int ks = 0; ks < 4; ++ks) { const bf16x8 bv = *(const bf16x8*)(tile + (kt * 16 + fr) * 272 + ks * 64 + fq * 16); a = __builtin_amdgcn_mfma_f32_16x16x32_bf16(Af[pp][ks], bv, a, 0, 0, 0); }
                    const int kg = (half * 4 + kt) * 16 + fr;
#pragma unroll
                    for (int r = 0; r < 4; ++r) sc[(pp * 16 + fq * 4 + r) * 132 + kg] = f_andor(a[r], ~127u, (unsigned)kg);
                }
            }
#pragma unroll
            for (int pp = 0; pp < 2; ++pp) { const bf16* rp = Q + (size_t)(tg * 16 + fr) * 2048 + hn * 256 + pp * 128 + fq * 8;
#pragma unroll
                for (int ks = 0; ks < 4; ++ks) An[pp][ks] = *(const bf16x8*)(rp + ks * 32); }
            if (valid) peer_select(p, (unsigned char*)sc, tg, h, lane, eG + (size_t)tg * 2048, gG + (size_t)tg * 2048);
        }
    }
}

__device__ __forceinline__ float gelu_erf(float x) { return 0.5f * x * (1.f + erff(x * 0.70710678118654752f)); }
typedef int v8i_t __attribute__((ext_vector_type(8)));
template <int OPSEL> __device__ __forceinline__ pg8::f32x4 mx_dot(v8i_t a, int sa, v8i_t b, int sb, pg8::f32x4 c) {
    return __builtin_amdgcn_mfma_scale_f32_16x16x128_f8f6f4(a, b, c, 4  , 4  , OPSEL, sa, OPSEL, sb);
}
__device__ __forceinline__ void peer_token(const Params& p, unsigned char* ldsw, const _Float16* usL, const _Float16* vsL, unsigned char* tile, int tok, int lane, const v2u nxt_e, const v2u nxt_g, int buf) {
    unsigned char* ws = p.ws;
    const unsigned char* V8 = ws + WS_V;
    const float* MOD = (const float*)(ws + WS_MOD);
    const int fr = lane & 15, fq = lane >> 4;
    typedef v8i_t v8i;
    const int* EIDX = (const int*)(ldsw + buf * 1024); const float* GATES = (const float*)(ldsw + buf * 1024 + 512);
    v4u A4[H4_NT][8]; v2u As[H4_NT];
#pragma unroll
    for (int t = 0; t < H4_NT; ++t) { const unsigned char* hp = ws + WS_H4D + ((size_t)tok * H4_NT + t) * 512 + fq * 16;
        As[t] = *(const v2u*)(ws + WS_H4S + ((size_t)tok * H4_NT + t) * 32 + fq * 8);
#pragma unroll
        for (int kk = 0; kk < 8; ++kk) A4[t][kk] = *(const v4u*)(hp + kk * 64); }
    int* pe = (int*)(ldsw + 2048); float* pa = (float*)(ldsw + 2048 + 512);
    const unsigned char* U4 = ws + WS_U;
    const int gr = lane >> 3, gs = lane & 7;
    const int rdbase = (fr >> 3) * 1024 + (fr & 7) * 128, slotA = (fq ^ (fr & 7) ^ (fr >> 3)) & 7;
    v4u G[8];
#define U_LOADS(CT) do { const int e0_ = EIDX[(CT) * 16 + gr], e1_ = EIDX[(CT) * 16 + 8 + gr]; \
        const unsigned char* p0_ = U4 + (size_t)e0_ * 512 + ((gs ^ gr) & 7) * 16; const unsigned char* p1_ = U4 + (size_t)e1_ * 512 + ((gs ^ gr ^ 1) & 7) * 16; \
        _Pragma("unroll") for (int kk = 0; kk < 8; ++kk) G[kk] = *(const v4u*)(((kk & 1) ? p1_ : p0_) + (kk >> 1) * 128); } while (0)
    U_LOADS(0);
#pragma unroll 1
    for (int ct = 0; ct < 8; ++ct) {
        const int eic = EIDX[ct * 16 + fr]; const float gt = GATES[ct * 16 + fr];
#pragma unroll
        for (int kk = 0; kk < 8; ++kk) *(v4u*)(tile + kk * 1024 + lane * 16) = G[kk];
        __builtin_amdgcn_sched_barrier(0);
        U_LOADS((ct + 1) & 7);
        __builtin_amdgcn_sched_barrier(0);
        LDS_WAIT(); __builtin_amdgcn_wave_barrier();
        v4u Bt[8];
#pragma unroll
        for (int j = 0; j < 8; ++j) Bt[j] = *(const v4u*)(tile + (j >> 1) * 2048 + rdbase + (((j & 1) ? (slotA ^ 4) : slotA) * 16));
        LDS_WAIT(); __builtin_amdgcn_wave_barrier();
        pg8::f32x4 ah = {0.f, 0.f, 0.f, 0.f};
#pragma unroll
        for (int kk = 0; kk < 8; ++kk) { const v4u bu = Bt[kk];
            const v8i bb = {(int)bu.x, (int)bu.y, (int)bu.z, (int)bu.w, 0, 0, 0, 0};
            const int sb = 0x7f7f7f7f;
#pragma unroll
            for (int t = 0; t < H4_NT; ++t) { const v8i aa = {(int)A4[t][kk].x, (int)A4[t][kk].y, (int)A4[t][kk].z, (int)A4[t][kk].w, 0, 0, 0, 0}; const int sa = (int)((kk < 4) ? As[t].x : As[t].y);
                if ((kk & 3) == 0) ah = mx_dot<0>(aa, sa, bb, sb, ah); else if ((kk & 3) == 1) ah = mx_dot<1>(aa, sa, bb, sb, ah); else if ((kk & 3) == 2) ah = mx_dot<2>(aa, sa, bb, sb, ah); else ah = mx_dot<3>(aa, sa, bb, sb, ah); } }
        const float dot = ah[0] * (float)usL[eic];
        if (fq == 0) { pe[ct * 16 + fr] = eic; pa[ct * 16 + fr] = gelu_erf(dot) * gt * (float)vsL[eic]; }
    }
    asm volatile("" :: "v"(G[0]), "v"(G[1]), "v"(G[2]), "v"(G[3]), "v"(G[4]), "v"(G[5]), "v"(G[6]), "v"(G[7]));
#undef U_LOADS
    __builtin_amdgcn_sched_barrier(0);
    { int* ne = (int*)(ldsw + (buf ^ 1) * 1024); float* ng = (float*)(ldsw + (buf ^ 1) * 1024 + 512);
      *(v2u*)(ne + 2 * lane) = nxt_e; *(v2u*)(ng + 2 * lane) = nxt_g; }
    const int hl = lane >> 5, bl = lane & 31;
    float acc[32];
#pragma unroll
    for (int i = 0; i < 32; ++i) acc[i] = 0.f;
    LDS_WAIT(); __builtin_amdgcn_wave_barrier();
#pragma unroll 1
    for (int ct = 0; ct < 16; ++ct)
#pragma unroll
        for (int jp = 0; jp < 4; ++jp) {
            const int idx = pe[ct * 8 + 2 * jp + hl]; const float as = pa[ct * 8 + 2 * jp + hl];
            const v4u vv = *(const v4u*)(V8 + (size_t)idx * 512 + bl * 16);
#pragma unroll
            for (int w4 = 0; w4 < 4; ++w4) { const unsigned wd = vv[w4];
                const f32x2 d0 = __builtin_amdgcn_cvt_scalef32_pk_f32_fp4(wd, 1.0f, 0), d1 = __builtin_amdgcn_cvt_scalef32_pk_f32_fp4(wd, 1.0f, 1), d2 = __builtin_amdgcn_cvt_scalef32_pk_f32_fp4(wd, 1.0f, 2), d3 = __builtin_amdgcn_cvt_scalef32_pk_f32_fp4(wd, 1.0f, 3);
                acc[8 * w4] += as * d0[0]; acc[8 * w4 + 1] += as * d0[1]; acc[8 * w4 + 2] += as * d1[0]; acc[8 * w4 + 3] += as * d1[1];
                acc[8 * w4 + 4] += as * d2[0]; acc[8 * w4 + 5] += as * d2[1]; acc[8 * w4 + 6] += as * d3[0]; acc[8 * w4 + 7] += as * d3[1]; }
        }
    LDS_WAIT(); __builtin_amdgcn_wave_barrier();
    float accs[16];
#pragma unroll
    for (int i = 0; i < 16; ++i) { const float lo = acc[i] + __shfl_xor(acc[i], 32), hi2 = acc[16 + i] + __shfl_xor(acc[16 + i], 32); accs[i] = hl ? hi2 : lo; }
    const int b = tok / SEQ;
    const int col0 = bl * 32 + hl * 16;
    const float* g2 = MOD + (size_t)b * 6144 + 5 * 1024 + col0;
    float* orow = p.out + (size_t)tok * DM + col0;
#pragma unroll
    for (int q4 = 0; q4 < 4; ++q4) { const f32x4 xv = *(const f32x4*)(orow + 4 * q4), gv = *(const f32x4*)(g2 + 4 * q4);
        f32x4 o;
#pragma unroll
        for (int i = 0; i < 4; ++i) o[i] = xv[i] + gv[i] * accs[4 * q4 + i];
        *(f32x4*)(orow + 4 * q4) = o; }
}

#define XB_TMO      128
#define XB_XCNT(j)  (256  + 64 * (j))
#define XB_XSUB(j)  (1280 + 64 * (j))
#define XB_XGEN(j)  (2304 + 64 * (j))
#define XB_TOP      3328
#define XB_TOPGEN   3392
#define XCD_BAR_WORDS 3456
#define XB_SPIN_CAP (1u << 18)

__device__ __forceinline__ unsigned xb_ld(unsigned* p)              { return __hip_atomic_load(p, __ATOMIC_RELAXED, __HIP_MEMORY_SCOPE_AGENT); }
__device__ __forceinline__ unsigned xb_add(unsigned* p, unsigned v) { return __hip_atomic_fetch_add(p, v, __ATOMIC_RELAXED, __HIP_MEMORY_SCOPE_AGENT); }
__device__ __forceinline__ unsigned xb_xcc_id() { return (unsigned)__builtin_amdgcn_s_getreg((3 << 11) | 20) & 0xFu; }
#define XB_SPIN(cond, bar) do { unsigned _sp = 0; while (cond) { __builtin_amdgcn_s_sleep(1); \
    if ((++_sp & 255u) == 0u) { if (xb_ld(&(bar)[XB_TMO])) break; if (_sp > XB_SPIN_CAP) { atomicAdd(&(bar)[XB_TMO], 1u); break; } } } } while (0)

struct XcdBarrier {
    unsigned* bar; unsigned x;
    volatile LAS unsigned* st;
};

__device__ __forceinline__ XcdBarrier xcd_barrier_post(unsigned* bar, volatile LAS unsigned* st) {
    XcdBarrier b; b.bar = bar; b.x = xb_xcc_id(); b.st = st;
    if (threadIdx.x == 0) (void)xb_add(&bar[XB_XCNT(b.x)], 1u);
    return b;
}
__device__ __forceinline__ void xcd_barrier_complete(unsigned* bar, unsigned x, unsigned& nloc, unsigned& nx) {
    const unsigned G = gridDim.x * gridDim.y * gridDim.z;
    unsigned sum, cnt, mine, sp = 0u;
    for (;;) {
        sum = 0u; cnt = 0u; mine = 0u;
#pragma unroll
        for (unsigned j = 0; j < 16; ++j) { const unsigned c = xb_ld(&bar[XB_XCNT(j)]); sum += c; cnt += (c > 0u) ? 1u : 0u; mine = (j == x) ? c : mine; }
        if (sum == G) break;
        __builtin_amdgcn_s_sleep(1);
        if ((++sp & 255u) == 0u) { if (xb_ld(&bar[XB_TMO])) break; if (sp > XB_SPIN_CAP) { atomicAdd(&bar[XB_TMO], 1u); break; } }
    }
    nloc = mine > 0u ? mine : 1u; nx = cnt > 0u ? cnt : 1u;
}

__device__ __forceinline__ void xcd_barrier(const XcdBarrier& b) {
    asm volatile("s_waitcnt vmcnt(0)" ::: "memory");
    __syncthreads();
    if (threadIdx.x == 0) {
        unsigned* bar = b.bar;
        __builtin_amdgcn_s_waitcnt(0);
        unsigned nloc = b.st[0], nx = b.st[1];
        if (nloc == 0u) { xcd_barrier_complete(bar, b.x, nloc, nx); b.st[0] = nloc; b.st[1] = nx; }
        const unsigned old = xb_add(&bar[XB_XSUB(b.x)], 1u);
        const unsigned gen = old / nloc;
        if (old + 1u == (gen + 1u) * nloc) {
            __builtin_amdgcn_fence(__ATOMIC_RELEASE, "agent");
            asm volatile("s_waitcnt vmcnt(0)" ::: "memory");
            const unsigned og = xb_add(&bar[XB_TOP], 1u);
            const unsigned tg = og / nx;
            if (og + 1u == (tg + 1u) * nx) xb_add(&bar[XB_TOPGEN], 1u);
            else XB_SPIN(xb_ld(&bar[XB_TOPGEN]) == tg, bar);
            __builtin_amdgcn_fence(__ATOMIC_ACQUIRE, "agent");
            xb_add(&bar[XB_XGEN(b.x)], 1u);
            asm volatile("s_waitcnt vmcnt(0)" ::: "memory");
        } else {
            XB_SPIN(xb_ld(&bar[XB_XGEN(b.x)]) == gen, bar);
            __builtin_amdgcn_fence(__ATOMIC_ACQUIRE, "agent");
            asm volatile("s_waitcnt vmcnt(0)" ::: "memory");
        }
    }
    __syncthreads();
}

constexpr int NPHASE = 11;
__global__ void __launch_bounds__(NTHREADS, 2) mega(Params p) {
    extern __shared__ __attribute__((aligned(16))) unsigned char lds[];
    cg::grid_group grid = cg::this_grid();
    const int lo = p.ph_lo, hi = p.ph_hi;
    const int tid = threadIdx.x, wave = tid >> 6, lane = tid & 63, G = gridDim.x;
    unsigned char* ws = p.ws;
#ifndef ONLYPH
#define IN(k) (lo <= (k) && (k) < hi)
#else
#define IN(k) ((k) == ONLYPH && lo <= (k) && (k) < hi)
#endif
    volatile LAS unsigned* xb_st = (volatile LAS unsigned*)((LAS unsigned char*)lds + (LDS_BYTES - 16));
    if (tid < 4) xb_st[tid] = 0u;
    __syncthreads();
    XcdBarrier xbar; xbar.bar = (unsigned*)(ws + WS_CTL); xbar.x = 0; xbar.st = xb_st;
    if (hi - lo > 1) xbar = xcd_barrier_post((unsigned*)(ws + WS_CTL), xb_st);
    if (lo < -1) grid.sync();
#define SEAM(k) do { if (IN((k) + 1)) xcd_barrier(xbar); } while (0)
#ifndef REPMASK
#define REPMASK 0
#endif
#define NREP(k) (((REPMASK >> (k)) & 1) ? 2 : 1)
    if (IN(0)) { for (int rep = 0; rep < NREP(0); ++rep) phase0(p, lds); SEAM(0); }
    if (IN(1)) { for (int rep = 0; rep < NREP(1); ++rep) normmod_phase<true>(p, lds, p.x, (bf16*)(ws + WS_H), p.norm1_g, 0, 1024); SEAM(1); }
    if (IN(2)) {
        { pg8::Gemm g{(const bf16*)(ws + WS_H8), (const bf16*)(ws + WS_WIN8), T, 3584, 512, 512, 512}; pg8::StaticOrder S; S.init(T, 3584, G, (int)blockIdx.x);
          EpiProj E{(bf16*)(ws + WS_HG), (bf16*)(ws + WS_ATT), (bf16*)(ws + WS_IDX), (bf16*)(ws + WS_GATE), 1};
          pg8::gemm_phase<EpiProj, pg8::StaticOrder, true, true, 122>((PG8_LAS unsigned char*)lds, g, S, E); }
        { pg8::Gemm g{(const bf16*)(ws + WS_H), (const bf16*)(ws + WS_WIN), T, 2048, 1024, 1024, 1024}; pg8::StaticOrder S; S.init(T, 2048, G, (int)blockIdx.x);
          EpiProj E{(bf16*)(ws + WS_HG), (bf16*)(ws + WS_ATT), (bf16*)(ws + WS_IDX), (bf16*)(ws + WS_GATE), 0};
          pg8::gemm_phase<EpiProj, pg8::StaticOrder, true, true>((PG8_LAS unsigned char*)lds, g, S, E); }
        SEAM(2);
    }
    if (IN(3)) {
        for (int tok = (int)blockIdx.x * NWAVES + wave; tok < T; tok += G * NWAVES) qknorm_token(p, tok, lane);
        SEAM(3);
    }
    if (IN(4)) {
        if ((int)blockIdx.x < 32) hgrn_item<0>(p, lds, (int)blockIdx.x); else if ((int)blockIdx.x < 64) hgrn_item<1>(p, lds, (int)blockIdx.x - 32);
        {
            unsigned* qctr = (unsigned*)(ws + WS_CTL + 32768);
            volatile LAS unsigned* qslot = (volatile LAS unsigned*)((LAS unsigned char*)lds + (LDS_BYTES - 32));
            int qsel = (int)(blockIdx.x & 7u), tried = 0;
            for (;;) {
                if (tid == 0) { unsigned c;
                    for (;;) { c = __hip_atomic_fetch_add(qctr + qsel * 64, 1u, __ATOMIC_RELAXED, __HIP_MEMORY_SCOPE_AGENT); if (c < (unsigned)(SEQ / 16) || tried >= 7) break; qsel = (qsel + 1) & 7; ++tried; }
                    *qslot = (c < (unsigned)(SEQ / 16)) ? (((unsigned)qsel << 16) | c) : 0xffffffffu; }
                __syncthreads();
                const unsigned c = *qslot;
                __syncthreads();
                if (c == 0xffffffffu) break;
                const int b = (int)(c >> 16), qblk = (SEQ / 16 - 1) - (int)(c & 0xffffu), it = b * (SEQ / 16) + qblk, q0 = qblk * 16;
                dsa1_item(p, lds, it);
#pragma unroll 1
                for (int k2 = 0; k2 < 2; ++k2) dsa2_query(p, lds + wave * 16384, (const unsigned short*)(lds + 131072 + (wave + 8 * k2) * 1024), b, q0 + wave + 8 * k2, lane);
                __syncthreads();
            }
        }
        if (hi - lo > 1) xcd_barrier(xbar);
        for (int u = blockIdx.x; u < 32 * 32; u += G) hgrn_fix(p, lds, u >> 5, u & 31);
        SEAM(4);
    }
    if (IN(5)) {
        pg8::Gemm g{(const bf16*)(ws + WS_H), (const bf16*)(ws + WS_WAB8), T, 1024, 256, 512, 512}; pg8::StaticOrderT<true> S; S.init(T, 1024, G, (int)blockIdx.x, 256);
        EpiMerged E{(const bf16*)(ws + WS_GATE), (bf16*)(ws + WS_MERGED)};
        for (int rep = 0; rep < NREP(5); ++rep) pg8::gemm_phase<EpiMerged, pg8::StaticOrderT<true>, true, true, 122>((PG8_LAS unsigned char*)lds, g, S, E);
        SEAM(5);
    }
    if (IN(6)) {
        pg8::Gemm g{(const bf16*)(ws + WS_MERGED), (const bf16*)(ws + WS_WOUT8), T, 1024, 512, 512, 512}; pg8::StaticOrder S; S.init(T, 1024, G, (int)blockIdx.x);
        EpiResid E{p.x, (const float*)(ws + WS_MOD) + 2048, p.out};
        for (int rep = 0; rep < NREP(6); ++rep) pg8::gemm_phase<EpiResid, pg8::StaticOrder, true, true, 120>((PG8_LAS unsigned char*)lds, g, S, E);
        SEAM(6);
    }
    if (IN(7)) { for (int rep = 0; rep < NREP(7); ++rep) normmod_phase<false>(p, lds, p.out, (bf16*)(ws + WS_H), p.norm2_g, 3 * 1024, 4 * 1024); SEAM(7); }
    if (IN(8)) {
        pg8::Gemm g{(const bf16*)(ws + WS_H), (const bf16*)(ws + WS_WQ), T, 2048, 1024, 1024, 1024}; pg8::StaticOrder S; S.init(T, 2048, G, (int)blockIdx.x);
        EpiStore E{(bf16*)(ws + WS_Q), 2048};
        for (int rep = 0; rep < NREP(8); ++rep) pg8::gemm_phase<EpiStore, pg8::StaticOrder, true, true>((PG8_LAS unsigned char*)lds, g, S, E);
        SEAM(8);
    }
    if (IN(9)) {
        int* eG = (int*)(ws + WS_EIDX); float* gG = (float*)(ws + WS_PGATE);
        peer_route_block(p, lds, eG, gG);
        asm volatile("s_waitcnt vmcnt(0)" ::: "memory");
        __syncthreads();
        _Float16* usL = (_Float16*)lds; _Float16* vsL = (_Float16*)(lds + 32768);
        for (int i = tid; i < NEXP / 8; i += NTHREADS) { ((v4u*)usL)[i] = ((const v4u*)(ws + WS_US))[i]; ((v4u*)vsL)[i] = ((const v4u*)(ws + WS_VS))[i]; }
        unsigned char* ldsw = lds + 65536 + wave * 3072;
        int ntok = 0;
        for (int tg = blockIdx.x; tg < T / 16; tg += G) ntok += 2;
        auto tok_of = [&](int j) { return ((int)blockIdx.x + (j >> 1) * G) * 16 + wave + 8 * (j & 1); };
        auto ld_lists = [&](int tok, v2u& e, v2u& g) {
            const unsigned* ep = (const unsigned*)(eG + (size_t)tok * 128 + 2 * lane); const unsigned* gp = (const unsigned*)(gG + (size_t)tok * 128 + 2 * lane);
            e.x = __hip_atomic_load(ep, __ATOMIC_RELAXED, __HIP_MEMORY_SCOPE_AGENT); e.y = __hip_atomic_load(ep + 1, __ATOMIC_RELAXED, __HIP_MEMORY_SCOPE_AGENT);
            g.x = __hip_atomic_load(gp, __ATOMIC_RELAXED, __HIP_MEMORY_SCOPE_AGENT); g.y = __hip_atomic_load(gp + 1, __ATOMIC_RELAXED, __HIP_MEMORY_SCOPE_AGENT); };
        if (ntok > 0) { v2u e0, g0; ld_lists(tok_of(0), e0, g0); *(v2u*)((int*)ldsw + 2 * lane) = e0; *(v2u*)((float*)(ldsw + 512) + 2 * lane) = g0; }
        __syncthreads();
#pragma unroll 1
        for (int j = 0; j < ntok; ++j) {
            v2u ne = {0u, 0u}, ng = {0u, 0u};
            if (j + 1 < ntok) ld_lists(tok_of(j + 1), ne, ng);
            peer_token(p, ldsw, usL, vsL, lds + 90112 + wave * 8192, tok_of(j), lane, ne, ng, j & 1);
            LDS_WAIT(); __builtin_amdgcn_wave_barrier();
        }
    }
#undef IN
#undef SEAM
}

#ifndef ONE_LAUNCH
#define ONE_LAUNCH 1
#endif
extern "C" void kernel_launch(void* const* d_in, const int* in_sizes, int n_in, void* d_out, int out_size, void* d_ws, size_t ws_size, hipStream_t stream) {
    static int grid = 0;
    if (grid == 0) {
        if (n_in != 18 || out_size != T * DM || ws_size < WS_END) { fprintf(stderr, "kernel_launch: unexpected shapes (n_in %d, out %d, ws %zu)\n", n_in, out_size, ws_size); grid = -1; return; }
        int dev = 0, cus = 0, per_cu = 0;
        if (hipGetDevice(&dev) != hipSuccess || hipDeviceGetAttribute(&cus, hipDeviceAttributeMultiprocessorCount, dev) != hipSuccess) { grid = -1; return; }
        if (hipFuncSetAttribute((const void*)mega, hipFuncAttributeMaxDynamicSharedMemorySize, LDS_BYTES) != hipSuccess) { fprintf(stderr, "kernel_launch: hipFuncSetAttribute failed\n"); grid = -1; return; }
        if (hipOccupancyMaxActiveBlocksPerMultiprocessor(&per_cu, (const void*)mega, NTHREADS, LDS_BYTES) != hipSuccess || per_cu < 1) { fprintf(stderr, "kernel_launch: occupancy query says %d\n", per_cu); grid = -1; return; }
        (void)hipGetLastError();
        grid = cus;
        if (grid < 64) { grid = -1; return; }
    }
    if (grid < 0) return;
    Params p{};
    const float** pp = (const float**)&p;
    for (int i = 0; i < 18; ++i) pp[i] = (const float*)d_in[i];
    p.out = (float*)d_out; p.ws = (unsigned char*)d_ws;
#if ONE_LAUNCH
    if (hipMemsetAsync((char*)d_ws + WS_CTL, 0, 65536, stream) != hipSuccess) { fprintf(stderr, "kernel_launch: memset failed\n"); return; }
    p.ph_lo = 0; p.ph_hi = NPHASE;
    void* args[] = {&p};
    hipError_t e = hipLaunchCooperativeKernel((const void*)mega, dim3(grid), dim3(NTHREADS), args, LDS_BYTES, stream);
    if (e != hipSuccess) fprintf(stderr, "cooperative launch failed: %s (grid %d)\n", hipGetErrorString(e), grid);
#else
    for (int k = 0; k < NPHASE; ++k) { p.ph_lo = k; p.ph_hi = k + 1; hipLaunchKernelGGL(mega, dim3(grid), dim3(NTHREADS), LDS_BYTES, stream, p); }
#endif
}
```

```cpp
#include <hip/hip_runtime.h>
#include <hip/hip_cooperative_groups.h>
#include <cstdio>
#include <cstdint>
namespace cg = cooperative_groups;

namespace pg8 {
#define PG8_LAS __attribute__((address_space(3)))
typedef unsigned short bf16_t;
typedef short bf16x8 __attribute__((ext_vector_type(8)));
typedef float f32x4 __attribute__((ext_vector_type(4)));
typedef unsigned u32x4 __attribute__((ext_vector_type(4)));
constexpr int BM = 256, BK = 64, HALF = 128, HTB = HALF * BK * 2  , STAGE_BYTES = 8 * HTB, NXCD = 8, WGM = 8;

__host__ __device__ __forceinline__ int lds_byte(int r, int c) { const int st = (r >> 4) * 2 + (c >> 5), rr = r & 15, cc = c & 31, ob = rr * 64 + cc * 2; return st * 1024 + (ob ^ (((ob >> 9) & 1) << 5)); }
__host__ __device__ __forceinline__ void stage_rc(int b, int& R, int& C) { const int st = b / 1024, sb = b % 1024, swz = sb ^ (((sb >> 9) & 1) << 5); R = (st >> 1) * 16 + swz / 64; C = (st & 1) * 32 + (swz % 64) / 2; }
__host__ __device__ __forceinline__ int perm32(int rho) { const int n = rho >> 4, i = rho & 15; return 8 * (i >> 2) + 4 * n + (i & 3); }

struct Unit { int pm, pn, ko, pass; };
struct Gemm { const bf16_t* A; const bf16_t* Bt; int M, N, K, lda, ldb; };
typedef float f32x16 __attribute__((ext_vector_type(16)));
typedef f32x16 AccW[2][2][2];
__device__ __forceinline__ f32x4 acc_get(const AccW& A, int ai, int bj, int m, int n) { const int s_ = ((m & 1) * 2 + n) * 4; const f32x16& w = A[ai][bj][m >> 1]; return (f32x4){w[s_], w[s_ + 1], w[s_ + 2], w[s_ + 3]}; }
__device__ __forceinline__ void acc_set(AccW& A, int ai, int bj, int m, int n, f32x4 v) { const int s_ = ((m & 1) * 2 + n) * 4; f32x16& w = A[ai][bj][m >> 1]; w[s_] = v[0]; w[s_ + 1] = v[1]; w[s_ + 2] = v[2]; w[s_ + 3] = v[3]; }

template <bool TWOPASS_ORDER = false>
struct StaticOrderT {
    int nM, nN, nwg, G, c, kpass;
    __host__ __device__ void init(int M, int N, int G_, int c_, int kpass_ = 512) { nM = M / BM; nN = N / BM; nwg = nM * nN; G = G_; c = c_; kpass = kpass_; }
    __host__ __device__ bool next(int i, Unit& u) const {
        const long L = (long)(TWOPASS_ORDER ? (i >> 1) : i) * G + c; if (L >= nwg) return false;
        u.pass = TWOPASS_ORDER ? (i & 1) : 0; u.ko = TWOPASS_ORDER ? (i & 1) * kpass : 0;
        int wgid = (int)L; { const int q = nwg / NXCD, r = nwg % NXCD, xcd = wgid % NXCD, off = wgid / NXCD; wgid = (xcd < r ? xcd * (q + 1) : r * (q + 1) + (xcd - r) * q) + off; }
        const int nig = WGM * nN, gid = wgid / nig, fm = gid * WGM, gsz = (nM - fm) < WGM ? (nM - fm) : WGM;
        u.pm = fm + ((wgid % nig) % gsz); u.pn = (wgid % nig) / gsz; return true;
    }
    __device__ __forceinline__ void a_ready(const Unit&) const {}
    __device__ __forceinline__ void done(const Unit&) const {}
};
typedef StaticOrderT<false> StaticOrder;

__device__ __forceinline__ unsigned cvt_pk_bf16(float lo, float hi) { unsigned r; asm volatile("v_cvt_pk_bf16_f32 %0, %1, %2" : "=v"(r) : "v"(lo), "v"(hi)); return r; }

template <class Epi, class Sched, bool ALIGN_EPI = false, bool SP2 = false, int F8SCALE = 0>
__device__ __forceinline__ void gemm_phase(PG8_LAS unsigned char* lds, const Gemm g, const Sched& S, const Epi& E) {
    const int tid = threadIdx.x, wid = __builtin_amdgcn_readfirstlane(tid >> 6), lane = tid & 63, wr = wid >> 2, wc = wid & 3, fr = lane & 15, fq = lane >> 4;
    const int K = g.K, nt = K / BK;
    unsigned voffA[2], voffB[2];
#pragma unroll
    for (int i = 0; i < 2; ++i) { int R, C; stage_rc(tid * 16 + i * 8192, R, C); const int Rb = Epi::PERM ? ((R & ~31) + perm32(R & 31)) : R;
        voffA[i] = (unsigned)(R * g.lda + C) * 2u; voffB[i] = (unsigned)(Rb * g.ldb + C) * 2u; }
    const size_t kstep = (size_t)(BK * 2);
    const size_t hstepA = (size_t)HALF * g.lda * 2, hstepB = (size_t)HALF * g.ldb * 2;
    const size_t tstepA = 2 * hstepA, tstepB = 2 * hstepB;
    const unsigned ldsw = (unsigned)wid * 1024u;
    const int aoff = lds_byte(wr * 64 + fr, fq * 8), boff = lds_byte(wc * 32 + fr, fq * 8);
#define PG8_SA(b, h) (((b) * 2 + (h)) * HTB)
#define PG8_SB(b, h) ((4 + (b) * 2 + (h)) * HTB)
#define PG8_STAGE(bufoff, gbase, voff) do { _Pragma("unroll") for (int _i = 0; _i < 2; ++_i) \
        __builtin_amdgcn_global_load_lds((const unsigned*)((const char*)(gbase) + (voff)[_i]), (PG8_LAS unsigned*)(lds + (bufoff) + ldsw + _i * 8192), 16, 0, 0); } while (0)
#define PG8_LDA(dst, b, h) do { _Pragma("unroll") for (int m = 0; m < 4; ++m) { if constexpr (F8SCALE != 0) { \
        PG8_F8(dst)[m].lo = *(const PG8_LAS v4i_f*)(lds + PG8_SA(b, h) + aoff + m * 2048); PG8_F8(dst)[m].hi = *(const PG8_LAS v4i_f*)(lds + PG8_SA(b, h) + aoff + m * 2048 + 1024); } \
        else { _Pragma("unroll") for (int k = 0; k < 2; ++k) dst[m][k] = *(const PG8_LAS bf16x8*)(lds + PG8_SA(b, h) + aoff + m * 2048 + k * 1024); } } } while (0)
#define PG8_LDB(dst, b, h) do { _Pragma("unroll") for (int n = 0; n < 2; ++n) { if constexpr (F8SCALE != 0) { \
        PG8_F8(dst)[n].lo = *(const PG8_LAS v4i_f*)(lds + PG8_SB(b, h) + boff + n * 2048); PG8_F8(dst)[n].hi = *(const PG8_LAS v4i_f*)(lds + PG8_SB(b, h) + boff + n * 2048 + 1024); } \
        else { _Pragma("unroll") for (int k = 0; k < 2; ++k) dst[n][k] = *(const PG8_LAS bf16x8*)(lds + PG8_SB(b, h) + boff + n * 2048 + k * 1024); } } } while (0)
#define PG8_MMA(ai, bj, At, Bt) do { __builtin_amdgcn_s_setprio(1); _Pragma("unroll") for (int m = 0; m < 4; ++m) _Pragma("unroll") for (int n = 0; n < 2; ++n) { \
        f32x4 _c = acc_get(accw, ai, bj, m, n); \
        if constexpr (F8SCALE != 0) { _c = __builtin_amdgcn_mfma_scale_f32_16x16x128_f8f6f4(PG8_F8(Bt)[n], PG8_F8(At)[m], _c, 0, 0, 0, 0x7f7f7f7f, 0, F8SCALE * 0x01010101); } \
        else { _Pragma("unroll") for (int k = 0; k < 2; ++k) _c = __builtin_amdgcn_mfma_f32_16x16x32_bf16(Bt[n][k], At[m][k], _c, 0, 0, 0); } \
        acc_set(accw, ai, bj, m, n, _c); } \
        __builtin_amdgcn_s_setprio(0); } while (0)
#define PG8_WAIT_V(n) asm volatile("s_waitcnt vmcnt(" #n ")" ::: "memory")
#define PG8_WAIT_L(n) asm volatile("s_waitcnt lgkmcnt(" #n ")" ::: "memory")
#define PG8_BAR __builtin_amdgcn_s_barrier()
#define PG8_SCHED __builtin_amdgcn_sched_barrier(0)
    Unit cur, nxt; int ui = 0;
    if (!S.next(0, cur)) return;
    typedef int v4i_f __attribute__((ext_vector_type(4))); typedef int v8i_f __attribute__((ext_vector_type(8))); typedef f32x16 f32x16_f;
    AccW accw;
#pragma unroll
    for (int a = 0; a < 2; ++a)
#pragma unroll
        for (int b = 0; b < 2; ++b)
#pragma unroll
            for (int mp = 0; mp < 2; ++mp)
#pragma unroll
                for (int i = 0; i < 16; ++i) accw[a][b][mp][i] = 0.f;
    bf16x8 At[4][2], B0[2][2], B1[2][2];
    v8i_f At8[4], B08[2], B18[2];
#define PG8_F8(x) x##8
    const char* cA = (const char*)g.A + (size_t)cur.pm * tstepA + (size_t)cur.ko * 2; const char* cB = (const char*)g.Bt + (size_t)cur.pn * tstepB + (size_t)cur.ko * 2;
    S.a_ready(cur);
    if constexpr (SP2) {
        PG8_STAGE(PG8_SB(0, 0), cB, voffB); PG8_STAGE(PG8_SB(0, 1), cB + hstepB, voffB); PG8_STAGE(PG8_SA(0, 0), cA, voffA); PG8_STAGE(PG8_SA(0, 1), cA + hstepA, voffA);
        if (wr == 1) PG8_BAR;
        PG8_WAIT_V(2); PG8_BAR;
        PG8_STAGE(PG8_SB(1, 0), cB + kstep, voffB); PG8_STAGE(PG8_SA(1, 0), cA + kstep, voffA); PG8_STAGE(PG8_SB(1, 1), cB + hstepB + kstep, voffB);
        PG8_WAIT_V(6); PG8_BAR;
    } else {
        PG8_STAGE(PG8_SB(0, 0), cB, voffB); PG8_STAGE(PG8_SA(0, 0), cA, voffA); PG8_STAGE(PG8_SB(0, 1), cB + hstepB, voffB); PG8_STAGE(PG8_SA(0, 1), cA + hstepA, voffA);
        if (wr == 1) PG8_BAR;
        PG8_WAIT_V(4); PG8_BAR;
        PG8_STAGE(PG8_SB(1, 0), cB + kstep, voffB); PG8_STAGE(PG8_SA(1, 0), cA + kstep, voffA); PG8_STAGE(PG8_SB(1, 1), cB + hstepB + kstep, voffB);
        PG8_WAIT_V(6); PG8_BAR;
    }
    for (;;) {
        const bool has_next = S.next(ui + 1, nxt);
        const char* nA = has_next ? (const char*)g.A + (size_t)nxt.pm * tstepA + (size_t)nxt.ko * 2 : cA; const char* nB = has_next ? (const char*)g.Bt + (size_t)nxt.pn * tstepB + (size_t)nxt.ko * 2 : cB;
        for (int t = 0; t < nt; t += 2) {
            const bool last = (t == nt - 2);
            const char* a1 = cA + (size_t)(t + 1) * kstep;
            const char* a2 = last ? nA : cA + (size_t)(t + 2) * kstep; const char* b2 = last ? nB : cB + (size_t)(t + 2) * kstep;
            const char* a3 = a2 + kstep; const char* b3 = b2 + kstep;
            if (last && has_next) S.a_ready(nxt);
            if constexpr (SP2) {
            PG8_LDB(B0, 0, 0); PG8_LDB(B1, 0, 1); PG8_SCHED; PG8_LDA(At, 0, 0); PG8_STAGE(PG8_SA(1, 1), a1 + hstepA, voffA);
            PG8_WAIT_V(8); PG8_WAIT_L(0); PG8_BAR; PG8_MMA(0, 0, At, B0); PG8_MMA(0, 1, At, B1); PG8_BAR; PG8_SCHED;
            PG8_LDA(At, 0, 1); PG8_STAGE(PG8_SB(0, 0), b2, voffB); PG8_STAGE(PG8_SB(0, 1), b2 + hstepB, voffB); PG8_STAGE(PG8_SA(0, 0), a2, voffA);
            PG8_WAIT_V(8); PG8_WAIT_L(0); PG8_BAR; PG8_MMA(1, 0, At, B0); PG8_MMA(1, 1, At, B1); PG8_BAR; PG8_SCHED;
            PG8_LDB(B0, 1, 0); PG8_LDB(B1, 1, 1); PG8_SCHED; PG8_LDA(At, 1, 0); PG8_STAGE(PG8_SA(0, 1), a2 + hstepA, voffA);
            PG8_WAIT_V(8); PG8_WAIT_L(0); PG8_BAR; PG8_MMA(0, 0, At, B0); PG8_MMA(0, 1, At, B1); PG8_BAR; PG8_SCHED;
            PG8_LDA(At, 1, 1); PG8_STAGE(PG8_SB(1, 0), b3, voffB); PG8_STAGE(PG8_SB(1, 1), b3 + hstepB, voffB); PG8_STAGE(PG8_SA(1, 0), a3, voffA);
            PG8_WAIT_V(8); PG8_WAIT_L(0); PG8_BAR; PG8_MMA(1, 0, At, B0); PG8_MMA(1, 1, At, B1); PG8_BAR; PG8_SCHED;
            } else {
            PG8_LDB(B0, 0, 0); PG8_SCHED; PG8_LDA(At, 0, 0); PG8_STAGE(PG8_SA(1, 1), a1 + hstepA, voffA);
            PG8_WAIT_L(8); PG8_BAR; PG8_WAIT_L(0); PG8_MMA(0, 0, At, B0); PG8_BAR; PG8_SCHED;
            PG8_LDB(B1, 0, 1); PG8_STAGE(PG8_SB(0, 0), b2, voffB);
            PG8_BAR; PG8_WAIT_L(0); PG8_MMA(0, 1, At, B1); PG8_BAR;
            PG8_LDA(At, 0, 1); PG8_STAGE(PG8_SA(0, 0), a2, voffA);
            PG8_BAR; PG8_WAIT_L(0); PG8_MMA(1, 0, At, B0); PG8_BAR; PG8_SCHED;
            PG8_STAGE(PG8_SB(0, 1), b2 + hstepB, voffB);
            PG8_WAIT_V(6); PG8_BAR; PG8_MMA(1, 1, At, B1); PG8_BAR;
            PG8_LDB(B0, 1, 0); PG8_SCHED; PG8_LDA(At, 1, 0); PG8_STAGE(PG8_SA(0, 1), a2 + hstepA, voffA);
            PG8_WAIT_L(8); PG8_BAR; PG8_WAIT_L(0); PG8_MMA(0, 0, At, B0); PG8_BAR; PG8_SCHED;
            PG8_LDB(B1, 1, 1); PG8_STAGE(PG8_SB(1, 0), b3, voffB);
            PG8_BAR; PG8_WAIT_L(0); PG8_MMA(0, 1, At, B1); PG8_BAR;
            PG8_LDA(At, 1, 1); PG8_STAGE(PG8_SA(1, 0), a3, voffA);
            PG8_BAR; PG8_WAIT_L(0); PG8_MMA(1, 0, At, B0); PG8_BAR; PG8_SCHED;
            PG8_STAGE(PG8_SB(1, 1), b3 + hstepB, voffB);
            PG8_WAIT_V(6); PG8_BAR; PG8_MMA(1, 1, At, B1); PG8_BAR;
            }
        }
        if constexpr (ALIGN_EPI) { if (wr == 0) PG8_BAR; }
        if constexpr (!Epi::AFTER_DRAIN) { E(accw, cur, wr, wc, fr, fq); S.done(cur); }
        const bool keep_acc = Epi::TWOPASS && (cur.pass == 0);
        if (!has_next) break;
        if (!keep_acc) {
#pragma unroll
            for (int a = 0; a < 2; ++a)
#pragma unroll
                for (int b = 0; b < 2; ++b)
#pragma unroll
                    for (int mp = 0; mp < 2; ++mp)
#pragma unroll
                        for (int i = 0; i < 16; ++i) accw[a][b][mp][i] = 0.f;
        }
        cur = nxt; cA = nA; cB = nB; ++ui;
        if constexpr (ALIGN_EPI) { if (wr == 1) PG8_BAR; }
    }
    PG8_WAIT_V(0);
    if constexpr (!ALIGN_EPI) { if (wr == 0) PG8_BAR; }
    PG8_BAR;

#undef PG8_SA
#undef PG8_SB
#undef PG8_STAGE
#undef PG8_LDA
#undef PG8_LDB
#undef PG8_MMA
#undef PG8_F8
#undef PG8_WAIT_V
#undef PG8_WAIT_L
#undef PG8_BAR
#undef PG8_SCHED
}
}


constexpr int NWAVES = 8, NTHREADS = 512;
constexpr int BATCH = 8, SEQ = 4096, T = BATCH * SEQ, DM = 1024;
constexpr int INW = 5448;
constexpr int NPROJ = 5632;
constexpr int LD_HG = 2048, LD_ATT = 768, LD_IDX = 640, LD_GATE = 2048;
constexpr int TOPK = 256;
constexpr int NEXP = 16384;
constexpr float RMS_EPS = 1e-6f;

constexpr size_t MiB = 1u << 20;
constexpr size_t WS_CTL = 0;
constexpr size_t WS_MOD = MiB / 4;
constexpr size_t WS_MODP = MiB / 2;
constexpr size_t WS_WIN = 2 * MiB;
constexpr size_t WS_WQ = 17 * MiB;
constexpr size_t WS_SK = 21 * MiB;
constexpr size_t WS_U = 22 * MiB;
constexpr size_t WS_US = 30 * MiB;
constexpr size_t WS_V = 38 * MiB;
constexpr size_t WS_VS = 46 * MiB;
constexpr size_t WS_V8 = 8 * MiB;
constexpr size_t WS_K8 = 48 * MiB;
constexpr size_t WS_QHI = 52 * MiB;
constexpr size_t WS_QLO = 68 * MiB;
constexpr size_t WS_WAB8 = 31 * MiB;
constexpr size_t WS_WOUT8 = 32 * MiB;
constexpr size_t WS_WIN8 = 33 * MiB;
constexpr size_t WS_H8 = 48 * MiB;
constexpr size_t WS_H = 86 * MiB;
constexpr size_t WS_HG = 150 * MiB;
constexpr size_t WS_ATT = 278 * MiB;
constexpr size_t WS_IDX = 326 * MiB;
constexpr size_t WS_GATE = 366 * MiB;
constexpr size_t WS_SEL = 494 * MiB;
constexpr size_t WS_EIDX = 48 * MiB;
constexpr size_t WS_PGATE = 64 * MiB;
constexpr size_t WS_END = 510 * MiB;
constexpr size_t WS_HQC = 494 * MiB;
constexpr size_t WS_HOL = 118 * MiB;
constexpr size_t WS_HSB = 2 * MiB;
constexpr size_t WS_MERGED = WS_HG;
constexpr size_t WS_Q = 214 * MiB;
constexpr int H4_NT = 2;
constexpr size_t WS_H4D = 366 * MiB;
constexpr size_t WS_H4S = 416 * MiB;

constexpr int LDS_BYTES = 163840;

typedef unsigned short bf16;
typedef unsigned v4u __attribute__((ext_vector_type(4)));
typedef unsigned v2u __attribute__((ext_vector_type(2)));
typedef float f32x4 __attribute__((ext_vector_type(4)));
typedef float f32x2 __attribute__((ext_vector_type(2)));
typedef short bf16x8 __attribute__((ext_vector_type(8)));
#define LAS __attribute__((address_space(3)))

struct Params {
    const float *x, *c, *w_ada, *b_ada, *norm1_g, *norm2_g, *w_in, *hg_lb, *hg_onorm_g, *q_norm_g, *k_norm_g,
                *w_a, *w_b, *w_out, *peer_wq, *peer_subkeys, *peer_u, *peer_v;
    float* out; unsigned char* ws; int ph_lo, ph_hi;
};

typedef __bf16 bf16x2_hw __attribute__((ext_vector_type(2)));
__device__ __forceinline__ unsigned pk2(float lo, float hi) { const f32x2 v = {lo, hi}; const bf16x2_hw b = __builtin_convertvector(v, bf16x2_hw); return __builtin_bit_cast(unsigned, b); }
__device__ __forceinline__ unsigned f2bf(float f) { return pk2(f, 0.f) & 0xffffu; }
__device__ __forceinline__ float bf2f(unsigned u16v) { return __builtin_bit_cast(float, u16v << 16); }
__device__ __forceinline__ float bflo(unsigned w) { return __builtin_bit_cast(float, w << 16); }
__device__ __forceinline__ float bfhi(unsigned w) { return __builtin_bit_cast(float, w & 0xffff0000u); }
__device__ __forceinline__ float sigmoidf_(float x) { return __builtin_amdgcn_rcpf(1.f + __expf(-x)); }
__device__ __forceinline__ float siluf_(float x) { return x * __builtin_amdgcn_rcpf(1.f + __expf(-x)); }
__device__ __forceinline__ float wave_sum(float v) {
#pragma unroll
    for (int o = 1; o < 64; o <<= 1) v += __shfl_xor(v, o);
    return v;
}
__device__ __forceinline__ float wave_max(float v) {
#pragma unroll
    for (int o = 1; o < 64; o <<= 1) v = fmaxf(v, __shfl_xor(v, o));
    return v;
}
#define LDS_WAIT() asm volatile("s_waitcnt lgkmcnt(0)" ::: "memory")
__device__ __forceinline__ unsigned pk4_fp8(float a, float b, float c, float d) { int w = __builtin_amdgcn_cvt_pk_fp8_f32(a, b, 0, false); w = __builtin_amdgcn_cvt_pk_fp8_f32(c, d, w, true); return (unsigned)w; }

__host__ __device__ __forceinline__ int proj_tile_bf16(int i) { return i < 2 ? i + 2 : i + 6; }
__host__ __device__ __forceinline__ int proj_tile_fp8(int i) { return i < 2 ? i : (i < 6 ? i + 2 : i + 8); }
struct EpiProj {
    static constexpr bool PERM = true, AFTER_DRAIN = false, TWOPASS = false;
    bf16 *HG, *ATT, *IDX, *GATE; int f8;
    __device__ __forceinline__ void operator()(pg8::AccW& acc, const pg8::Unit& u, int wr, int wc, int fr, int fq) const {
        const int pn = f8 ? proj_tile_fp8(u.pn) : proj_tile_bf16(u.pn); bf16* base; int ldc, colt, ncols;
        if (pn < 8) { base = HG; ldc = LD_HG; colt = pn * 256; ncols = LD_HG; }
        else if (pn < 11) { base = ATT; ldc = LD_ATT; colt = (pn - 8) * 256; ncols = LD_ATT; }
        else if (pn < 14) { base = IDX; ldc = LD_IDX; colt = (pn - 11) * 256; ncols = LD_IDX; }
        else { base = GATE; ldc = LD_GATE; colt = (pn - 14) * 256; ncols = LD_GATE; }
        const int row0 = u.pm * 256 + wr * 64 + fr, col0 = colt + wc * 32 + 8 * fq;
#pragma unroll
        for (int ai = 0; ai < 2; ++ai)
#pragma unroll
            for (int m = 0; m < 4; ++m) { bf16* rowp = base + (size_t)(row0 + ai * 128 + m * 16) * ldc + col0;
#pragma unroll
                for (int bj = 0; bj < 2; ++bj) { const pg8::f32x4 v0 = pg8::acc_get(acc, ai, bj, m, 0), v1 = pg8::acc_get(acc, ai, bj, m, 1);
                    v4u w; w.x = pk2(v0[0], v0[1]); w.y = pk2(v0[2], v0[3]); w.z = pk2(v1[0], v1[1]); w.w = pk2(v1[2], v1[3]);
                    if (col0 + bj * 128 < ncols) *(v4u*)(rowp + bj * 128) = w; } }
    }
};
struct EpiMerged {
    static constexpr bool PERM = true, AFTER_DRAIN = false, TWOPASS = true;
    const bf16* GATE; bf16* O;
    __device__ __forceinline__ void operator()(pg8::AccW& acc, const pg8::Unit& u, int wr, int wc, int fr, int fq) const {
        const int row0 = u.pm * 256 + wr * 64 + fr, col0 = u.pn * 256 + wc * 32 + 8 * fq;
        if (u.pass == 0) {
#pragma unroll
            for (int ai = 0; ai < 2; ++ai)
#pragma unroll
                for (int m = 0; m < 4; ++m) { const bf16* rowp = GATE + (size_t)(row0 + ai * 128 + m * 16) * LD_GATE + col0;
#pragma unroll
                    for (int bj = 0; bj < 2; ++bj) { const v4u a = *(const v4u*)(rowp + bj * 128), b = *(const v4u*)(rowp + 1024 + bj * 128);
                        float r[8];
#pragma unroll
                        for (int i = 0; i < 4; ++i) { const float a0 = bflo(a[i]), a1 = bfhi(a[i]), b0 = bflo(b[i]), b1 = bfhi(b[i]);
                            r[2 * i] = (1.f + __expf(-b0)) * __builtin_amdgcn_rcpf(1.f + __expf(-a0)); r[2 * i + 1] = (1.f + __expf(-b1)) * __builtin_amdgcn_rcpf(1.f + __expf(-a1)); }
                        { pg8::f32x4 c0 = pg8::acc_get(acc, ai, bj, m, 0), c1 = pg8::acc_get(acc, ai, bj, m, 1);
#pragma unroll
                          for (int i = 0; i < 4; ++i) { c0[i] *= r[i]; c1[i] *= r[4 + i]; }
                          pg8::acc_set(acc, ai, bj, m, 0, c0); pg8::acc_set(acc, ai, bj, m, 1, c1); } } }
        } else {
#pragma unroll
            for (int ai = 0; ai < 2; ++ai)
#pragma unroll
                for (int m = 0; m < 4; ++m) { const size_t ro = (size_t)(row0 + ai * 128 + m * 16);
#pragma unroll
                    for (int bj = 0; bj < 2; ++bj) { const v4u b = *(const v4u*)(GATE + ro * LD_GATE + 1024 + col0 + bj * 128);
                        const pg8::f32x4 v0 = pg8::acc_get(acc, ai, bj, m, 0), v1 = pg8::acc_get(acc, ai, bj, m, 1);
                        float s[8];
#pragma unroll
                        for (int i = 0; i < 4; ++i) { s[2 * i] = sigmoidf_(bflo(b[i])); s[2 * i + 1] = sigmoidf_(bfhi(b[i])); }
                        v2u w; w.x = pk4_fp8(4.f * v0[0] * s[0], 4.f * v0[1] * s[1], 4.f * v0[2] * s[2], 4.f * v0[3] * s[3]); w.y = pk4_fp8(4.f * v1[0] * s[4], 4.f * v1[1] * s[5], 4.f * v1[2] * s[6], 4.f * v1[3] * s[7]);
                        *(v2u*)((unsigned char*)O + ro * 1024 + col0 + bj * 128) = w; } }
        }
    }
};
struct EpiResid {
    static constexpr bool PERM = true, AFTER_DRAIN = false, TWOPASS = false;
    const float* X; const float* G1  ; float* O;
    __device__ __forceinline__ void operator()(pg8::AccW& acc, const pg8::Unit& u, int wr, int wc, int fr, int fq) const {
        const int row0 = u.pm * 256 + wr * 64 + fr, col0 = u.pn * 256 + wc * 32 + 8 * fq;
        const int b = (u.pm * 256) / SEQ;
        f32x4 g[2][2];
#pragma unroll
        for (int bj = 0; bj < 2; ++bj)
#pragma unroll
            for (int n = 0; n < 2; ++n) g[bj][n] = *(const f32x4*)(G1 + (size_t)b * 6144 + col0 + bj * 128 + 4 * n);
#pragma unroll
        for (int ai = 0; ai < 2; ++ai)
#pragma unroll
            for (int m = 0; m < 4; ++m) { const size_t ro = (size_t)(row0 + ai * 128 + m * 16) * DM + col0;
#pragma unroll
                for (int bj = 0; bj < 2; ++bj)
#pragma unroll
                    for (int n = 0; n < 2; ++n) { const f32x4 xv = *(const f32x4*)(X + ro + bj * 128 + 4 * n);
                        *(f32x4*)(O + ro + bj * 128 + 4 * n) = xv + g[bj][n] * pg8::acc_get(acc, ai, bj, m, n); } }
    }
};
struct EpiStore {
    static constexpr bool PERM = true, AFTER_DRAIN = false, TWOPASS = false;
    bf16* O; int ldc;
    __device__ __forceinline__ void operator()(pg8::AccW& acc, const pg8::Unit& u, int wr, int wc, int fr, int fq) const {
        const int row0 = u.pm * 256 + wr * 64 + fr, col0 = u.pn * 256 + wc * 32 + 8 * fq;
#pragma unroll
        for (int ai = 0; ai < 2; ++ai)
#pragma unroll
            for (int m = 0; m < 4; ++m) { bf16* rowp = O + (size_t)(row0 + ai * 128 + m * 16) * ldc + col0;
#pragma unroll
                for (int bj = 0; bj < 2; ++bj) { const pg8::f32x4 v0 = pg8::acc_get(acc, ai, bj, m, 0), v1 = pg8::acc_get(acc, ai, bj, m, 1);
                    v4u w; w.x = pk2(v0[0], v0[1]); w.y = pk2(v0[2], v0[3]); w.z = pk2(v1[0], v1[1]); w.w = pk2(v1[2], v1[3]);
                    *(v4u*)(rowp + bj * 128) = w; } }
    }
};

template <int MODE> __device__ __forceinline__ int srcmap(int np) {
    if (MODE == 2) np = proj_tile_bf16(np >> 8) * 256 + (np & 255);
    if (MODE == 3) np = proj_tile_fp8(np >> 8) * 256 + (np & 255);
    if (MODE >= 1) return np < 3400 ? np : (np >= 3584 ? np - 184 : -1);
    return np; }
template <int MODE>
__device__ __forceinline__ void transpose_item(const float* W, int N, bf16* WT, int ldw, int koff, float* scr, int kb, int nb, int lane) {
    const int k0 = 64 * kb, n0 = 32 * nb;
    const int sc = srcmap<MODE>(n0 + (lane & 31));
#pragma unroll 8
    for (int i = 0; i < 32; ++i) { const int kk = 2 * i + (lane >> 5); scr[kk * 33 + (lane & 31)] = (sc >= 0) ? W[(size_t)(k0 + kk) * N + sc] : 0.f; }
    LDS_WAIT(); __builtin_amdgcn_wave_barrier();
    const int c = lane & 7;
#pragma unroll
    for (int j = 0; j < 4; ++j) { const int n = (lane >> 3) + 8 * j; const float* s = scr + (8 * c) * 33 + n;
        v4u o; o.x = pk2(s[0 * 33], s[1 * 33]); o.y = pk2(s[2 * 33], s[3 * 33]); o.z = pk2(s[4 * 33], s[5 * 33]); o.w = pk2(s[6 * 33], s[7 * 33]);
        *(v4u*)(WT + (size_t)(n0 + n) * ldw + koff + k0 + 8 * c) = o; }
    LDS_WAIT(); __builtin_amdgcn_wave_barrier();
}
template <int MODE> __device__ __forceinline__ int srcmap(int np);
template <int MODE = 0>
__device__ __forceinline__ void transpose_item8(const float* W, int N, unsigned char* WT, int ldw, int koff, float scale, float* scr, int kb, int nb, int lane) {
    const int k0 = 64 * kb, n0 = 32 * nb;
    const int sc = srcmap<MODE>(n0 + (lane & 31));
#pragma unroll 8
    for (int i = 0; i < 32; ++i) { const int kk = 2 * i + (lane >> 5); scr[kk * 33 + (lane & 31)] = (sc >= 0) ? W[(size_t)(k0 + kk) * N + sc] * scale : 0.f; }
    LDS_WAIT(); __builtin_amdgcn_wave_barrier();
    const int c = lane & 3;
#pragma unroll
    for (int j = 0; j < 2; ++j) { const int n = (lane >> 2) + 16 * j; const float* sp = scr + (16 * c) * 33 + n;
        v4u o;
#pragma unroll
        for (int q = 0; q < 4; ++q) o[q] = pk4_fp8(sp[(4 * q) * 33], sp[(4 * q + 1) * 33], sp[(4 * q + 2) * 33], sp[(4 * q + 3) * 33]);
        *(v4u*)(WT + (size_t)(n0 + n) * ldw + koff + k0 + 16 * c) = o; }
    LDS_WAIT(); __builtin_amdgcn_wave_barrier();
}
__device__ __forceinline__ void convert_plain(const float* src, bf16* dst, size_t n, size_t gtid, size_t nth) {
    const size_t n8 = n / 8;
    for (size_t i = gtid; i < n8; i += nth) { const f32x4 a = ((const f32x4*)src)[2 * i], b = ((const f32x4*)src)[2 * i + 1];
        v4u o; o.x = pk2(a[0], a[1]); o.y = pk2(a[2], a[3]); o.z = pk2(b[0], b[1]); o.w = pk2(b[2], b[3]); ((v4u*)dst)[i] = o; }
}
__device__ __forceinline__ void convert_fp8(const float* src, unsigned char* dst, size_t n, float scale, size_t gtid, size_t nth) {
    const size_t n16 = n / 16;
    for (size_t i = gtid; i < n16; i += nth) { const f32x4* sp = (const f32x4*)src + 4 * i; const f32x4 a = sp[0] * scale, b = sp[1] * scale, c = sp[2] * scale, d = sp[3] * scale;
        v4u o; o.x = pk4_fp8(a[0], a[1], a[2], a[3]); o.y = pk4_fp8(b[0], b[1], b[2], b[3]); o.z = pk4_fp8(c[0], c[1], c[2], c[3]); o.w = pk4_fp8(d[0], d[1], d[2], d[3]); ((v4u*)dst)[i] = o; }
}
template <bool KKMAJOR>
__device__ __forceinline__ void convert_mxfp4(const float* src, unsigned char* dst, unsigned char* scl, size_t nrows, size_t gtid, size_t nth) {
    const size_t nblk = nrows * 32;
    for (size_t i = gtid; i < nblk; i += nth) {
        const size_t row = i >> 5; const int blk = (int)(i & 31);
        const f32x4* sp = (const f32x4*)(src + row * 1024 + blk * 32);
        f32x4 v[8]; float amax = 0.f;
#pragma unroll
        for (int j = 0; j < 8; ++j) { v[j] = sp[j]; amax = fmaxf(fmaxf(fmaxf(fabsf(v[j][0]), fabsf(v[j][1])), fmaxf(fabsf(v[j][2]), fabsf(v[j][3]))), amax); }
        int e = (int)((__builtin_bit_cast(unsigned, amax) >> 23) & 0xffu) - 127 - 2;
        if (e < -126) e = -126;
        const float inv = __builtin_bit_cast(float, (unsigned)(127 - e) << 23);
        unsigned w[4] = {0u, 0u, 0u, 0u};
#pragma unroll
        for (int j = 0; j < 8; j += 2) { unsigned t = 0u;
            t = __builtin_amdgcn_cvt_scalef32_pk_fp4_f32(t, v[j][0] * inv, v[j][1] * inv, 1.0f, 0);
            t = __builtin_amdgcn_cvt_scalef32_pk_fp4_f32(t, v[j][2] * inv, v[j][3] * inv, 1.0f, 1);
            t = __builtin_amdgcn_cvt_scalef32_pk_fp4_f32(t, v[j + 1][0] * inv, v[j + 1][1] * inv, 1.0f, 2);
            t = __builtin_amdgcn_cvt_scalef32_pk_fp4_f32(t, v[j + 1][2] * inv, v[j + 1][3] * inv, 1.0f, 3);
            w[j >> 1] = t; }
        *(v4u*)(dst + row * 512 + blk * 16) = (v4u){w[0], w[1], w[2], w[3]};
        scl[row * 32 + (KKMAJOR ? ((blk & 3) * 8 + (blk >> 2)) : blk)] = (unsigned char)(e + 127);
    }
}
__device__ __forceinline__ void convert_rowfp4(const float* src, unsigned char* dst, _Float16* scl, int row, int lane) {
    const f32x4* sp = (const f32x4*)(src + (size_t)row * 1024 + lane * 16);
    f32x4 v[4]; float amax = 0.f;
#pragma unroll
    for (int j = 0; j < 4; ++j) { v[j] = sp[j]; amax = fmaxf(fmaxf(fmaxf(fabsf(v[j][0]), fabsf(v[j][1])), fmaxf(fabsf(v[j][2]), fabsf(v[j][3]))), amax); }
    amax = wave_max(amax);
    _Float16 sh = (_Float16)(amax * (1.f / 6.f));
    float sf = (float)sh; if (!(sf > 0.f)) { sf = 1.f; sh = (_Float16)1.f; }
    const float inv = 1.f / sf;
    unsigned w[2];
#pragma unroll
    for (int j = 0; j < 2; ++j) { unsigned t = 0u;
        t = __builtin_amdgcn_cvt_scalef32_pk_fp4_f32(t, v[2 * j][0] * inv, v[2 * j][1] * inv, 1.0f, 0);
        t = __builtin_amdgcn_cvt_scalef32_pk_fp4_f32(t, v[2 * j][2] * inv, v[2 * j][3] * inv, 1.0f, 1);
        t = __builtin_amdgcn_cvt_scalef32_pk_fp4_f32(t, v[2 * j + 1][0] * inv, v[2 * j + 1][1] * inv, 1.0f, 2);
        t = __builtin_amdgcn_cvt_scalef32_pk_fp4_f32(t, v[2 * j + 1][2] * inv, v[2 * j + 1][3] * inv, 1.0f, 3);
        w[j] = t; }
    *(v2u*)(dst + (size_t)row * 512 + lane * 8) = (v2u){w[0], w[1]};
    if (lane == 0) scl[row] = sh;
}
__device__ __forceinline__ void phase0(const Params& p, unsigned char* lds) {
    const int tid = threadIdx.x, wave = tid >> 6, lane = tid & 63, G = gridDim.x;
    const int gw = blockIdx.x * NWAVES + wave, NGW = G * NWAVES;
    float* scr = (float*)(lds + wave * 16384);
    unsigned char* ws = p.ws;
    constexpr int I_IN = 16 * (2048 / 32), I_IN8 = 16 * (3584 / 32), I_A = 8 * 32, I_O = 16 * 32, I_Q = 16 * 64;
    constexpr int NT = I_IN + I_IN8 + 2 * I_A + I_O + I_Q;
    for (int it = gw; it < NT; it += NGW) {
        int r = it;
        if (r < I_IN) { transpose_item<2>(p.w_in, INW, (bf16*)(ws + WS_WIN), 1024, 0, scr, r / 64, r % 64, lane); continue; } r -= I_IN;
        if (r < I_IN8) { transpose_item8<3>(p.w_in, INW, ws + WS_WIN8, 1024, 0, 32.f, scr, r / 112, r % 112, lane); continue; } r -= I_IN8;
        if (r < I_A) { transpose_item8(p.w_a, 1024, ws + WS_WAB8, 1024, 0, 32.f, scr, r / 32, r % 32, lane); continue; } r -= I_A;
        if (r < I_A) { transpose_item8(p.w_b, 1024, ws + WS_WAB8, 1024, 512, 4.f, scr, r / 32, r % 32, lane); continue; } r -= I_A;
        if (r < I_O) { transpose_item8(p.w_out, 1024, ws + WS_WOUT8, 1024, 0, 32.f, scr, r / 32, r % 32, lane); continue; } r -= I_O;
        transpose_item<0>(p.peer_wq, 2048, (bf16*)(ws + WS_WQ), 1024, 0, scr, r / 64, r % 64, lane);
    }
    for (int it = gw; it < 96 * 8; it += NGW) {
        const int cgp = it % 96, ks = it / 96, col = cgp * 64 + lane, k0 = ks * 128;
#pragma unroll
        for (int i = 0; i < 16; ++i) { const int e = i * 64 + lane, b = e >> 7, k = e & 127; scr[e] = siluf_(p.c[b * 1024 + k0 + k]); }
        LDS_WAIT(); __builtin_amdgcn_wave_barrier();
        float acc[8];
#pragma unroll
        for (int b = 0; b < 8; ++b) acc[b] = 0.f;
#pragma unroll 4
        for (int k = 0; k < 128; ++k) { const float w = p.w_ada[(size_t)(k0 + k) * 6144 + col];
#pragma unroll
            for (int b = 0; b < 8; ++b) acc[b] += scr[b * 128 + k] * w; }
        float* mp = (float*)(ws + WS_MODP) + (size_t)ks * 8 * 6144 + col;
#pragma unroll
        for (int b = 0; b < 8; ++b) mp[b * 6144] = acc[b];
        LDS_WAIT(); __builtin_amdgcn_wave_barrier();
    }
    const size_t gtid = (size_t)blockIdx.x * NTHREADS + tid, nth = (size_t)G * NTHREADS;
    convert_plain(p.peer_subkeys, (bf16*)(ws + WS_SK), (size_t)16 * 128 * 128, gtid, nth);
    for (int it = gw; it < 2 * NEXP; it += NGW) {
        if (it < NEXP) convert_rowfp4(p.peer_u, ws + WS_U, (_Float16*)(ws + WS_US), it, lane);
        else convert_rowfp4(p.peer_v, ws + WS_V, (_Float16*)(ws + WS_VS), it - NEXP, lane);
    }
}

template <bool FIRST>
__device__ __forceinline__ void normmod_phase(const Params& p, unsigned char* lds, const float* src, bf16* dst, const float* gvec, int shift_off, int scale_off) {
    const int tid = threadIdx.x, wave = tid >> 6, lane = tid & 63, G = gridDim.x;
    unsigned char* ws = p.ws;
    float* A = (float*)lds;
    float* Bv = A + 1024;
    const float* MODP = (const float*)(ws + WS_MODP);
    float* MOD = (float*)(ws + WS_MOD);
    if (FIRST) {
        for (int e = blockIdx.x * NTHREADS + tid; e < 8 * 6144; e += G * NTHREADS) { const int col = e % 6144; float s = p.b_ada[col];
#pragma unroll
            for (int ks = 0; ks < 8; ++ks) s += MODP[(size_t)ks * 8 * 6144 + e];
            MOD[e] = s; }
    }
    int curb = -1;
    for (int chunk = blockIdx.x; chunk < T / 128; chunk += G) {
        const int b = (chunk * 128) / SEQ;
        if (b != curb) {
            __syncthreads();
            for (int col = tid; col < 1024; col += NTHREADS) {
                float sc, sh;
                if (FIRST) { sc = p.b_ada[scale_off + col]; sh = p.b_ada[shift_off + col];
#pragma unroll
                    for (int ks = 0; ks < 8; ++ks) { sc += MODP[(size_t)(ks * 8 + b) * 6144 + scale_off + col]; sh += MODP[(size_t)(ks * 8 + b) * 6144 + shift_off + col]; } }
                else { sc = MOD[b * 6144 + scale_off + col]; sh = MOD[b * 6144 + shift_off + col]; }
                A[col] = gvec[col] * (1.f + sc); Bv[col] = sh; }
            __syncthreads(); curb = b;
        }
        for (int r = wave; r < 128; r += NWAVES) {
            const size_t row = (size_t)chunk * 128 + r;
            const f32x4* xr = (const f32x4*)(src + row * DM) + lane;
            f32x4 v[4]; float s = 0.f;
#pragma unroll
            for (int j = 0; j < 4; ++j) { v[j] = xr[64 * j]; s += (v[j][0] * v[j][0] + v[j][1] * v[j][1]) + (v[j][2] * v[j][2] + v[j][3] * v[j][3]); }
            const float rstd = rsqrtf(wave_sum(s) * (1.f / DM) + RMS_EPS);
            v2u* o8 = (v2u*)(dst + row * DM) + lane;
#pragma unroll
            for (int j = 0; j < 4; ++j) { const int c0 = 4 * lane + 256 * j; const f32x4 a = *(const f32x4*)(A + c0), sh = *(const f32x4*)(Bv + c0);
                v2u o; o.x = pk2(v[j][0] * rstd * a[0] + sh[0], v[j][1] * rstd * a[1] + sh[1]); o.y = pk2(v[j][2] * rstd * a[2] + sh[2], v[j][3] * rstd * a[3] + sh[3]);
                o8[64 * j] = o;
                if (FIRST) *(unsigned*)(ws + WS_H8 + row * DM + c0) = pk4_fp8(v[j][0] * rstd * a[0] + sh[0], v[j][1] * rstd * a[1] + sh[1], v[j][2] * rstd * a[2] + sh[2], v[j][3] * rstd * a[3] + sh[3]);
                if (!FIRST) { float* st = (float*)(lds + 8192) + wave * 1056;
                    const float y0 = v[j][0] * rstd * a[0] + sh[0], y1 = v[j][1] * rstd * a[1] + sh[1], y2 = v[j][2] * rstd * a[2] + sh[2], y3 = v[j][3] * rstd * a[3] + sh[3];
                    const int pc = c0 + (c0 >> 5); st[pc] = y0; st[pc + 1] = y1; st[pc + 2] = y2; st[pc + 3] = y3; } }
            if (!FIRST) {
                const float* st = (const float*)(lds + 8192) + wave * 1056;
                LDS_WAIT(); __builtin_amdgcn_wave_barrier();
                if (lane < 32) {
                    float x[32];
#pragma unroll
                    for (int k = 0; k < 32; ++k) x[k] = st[lane * 33 + k];
#pragma unroll
                    for (int t = 0; t < H4_NT; ++t) {
                        float amax = 0.f;
#pragma unroll
                        for (int k = 0; k < 32; ++k) amax = fmaxf(amax, fabsf(x[k]));
                        int e = (int)((__builtin_bit_cast(unsigned, amax) >> 23) & 0xffu) - 127 - 2; if (e < -126) e = -126;
                        const float inv = __builtin_bit_cast(float, (unsigned)(127 - e) << 23), sc = __builtin_bit_cast(float, (unsigned)(127 + e) << 23);
                        unsigned w[4];
#pragma unroll
                        for (int r = 0; r < 4; ++r) { unsigned tw = 0u;
                            tw = __builtin_amdgcn_cvt_scalef32_pk_fp4_f32(tw, x[8 * r] * inv, x[8 * r + 1] * inv, 1.0f, 0);
                            tw = __builtin_amdgcn_cvt_scalef32_pk_fp4_f32(tw, x[8 * r + 2] * inv, x[8 * r + 3] * inv, 1.0f, 1);
                            tw = __builtin_amdgcn_cvt_scalef32_pk_fp4_f32(tw, x[8 * r + 4] * inv, x[8 * r + 5] * inv, 1.0f, 2);
                            tw = __builtin_amdgcn_cvt_scalef32_pk_fp4_f32(tw, x[8 * r + 6] * inv, x[8 * r + 7] * inv, 1.0f, 3);
                            w[r] = tw;
                            const f32x2 d0 = __builtin_amdgcn_cvt_scalef32_pk_f32_fp4(tw, 1.0f, 0), d1 = __builtin_amdgcn_cvt_scalef32_pk_f32_fp4(tw, 1.0f, 1), d2 = __builtin_amdgcn_cvt_scalef32_pk_f32_fp4(tw, 1.0f, 2), d3 = __builtin_amdgcn_cvt_scalef32_pk_f32_fp4(tw, 1.0f, 3);
                            x[8 * r] -= d0[0] * sc; x[8 * r + 1] -= d0[1] * sc; x[8 * r + 2] -= d1[0] * sc; x[8 * r + 3] -= d1[1] * sc;
                            x[8 * r + 4] -= d2[0] * sc; x[8 * r + 5] -= d2[1] * sc; x[8 * r + 6] -= d3[0] * sc; x[8 * r + 7] -= d3[1] * sc; }
                        *(v4u*)(ws + WS_H4D + (row * H4_NT + t) * 512 + lane * 16) = (v4u){w[0], w[1], w[2], w[3]};
                        *(ws + WS_H4S + (row * H4_NT + t) * 32 + (lane & 3) * 8 + (lane >> 2)) = (unsigned char)(e + 127);
                    }
                }
                LDS_WAIT(); __builtin_amdgcn_wave_barrier();
            }
        }
    }
    __syncthreads();
}

constexpr int HGL_QT = 0, HGL_KT = 17408, HGL_QE = 34816, HGL_KLT = 52224, HGL_VT = 70656, HGL_AM = 89088, HGL_DEC = 98304, HGL_TOT = 98816, HGL_SSQ = 100864;
constexpr int HG_LDR = 136;
constexpr int HG_LDC = 72;
template <int half>
__device__ __forceinline__ void hgrn_item(const Params& p, unsigned char* lds, int item) {
    const int b = item >> 2, h = item & 3;
    const int tid = threadIdx.x, w = tid >> 6, lane = tid & 63, fr = lane & 15, fq = lane >> 4;
    unsigned char* ws = p.ws;
    const bf16* HG = (const bf16*)(ws + WS_HG);
    bf16* YA = (bf16*)(ws + WS_H);
    bf16* QT = (bf16*)(lds + HGL_QT); bf16* KT = (bf16*)(lds + HGL_KT); bf16* QE = (bf16*)(lds + HGL_QE);
    bf16* KLT = (bf16*)(lds + HGL_KLT); bf16* VT = (bf16*)(lds + HGL_VT); bf16* AM = (bf16*)(lds + HGL_AM);
    float* DEC = (float*)(lds + HGL_DEC); float* TOT = (float*)(lds + HGL_TOT); float* SSQ = (float*)(lds + HGL_SSQ);
    const int pd = tid & 127, pq = tid >> 7;
    float lbv; { const float a0 = p.hg_lb[h * 128 + pd], a1 = p.hg_lb[512 + h * 128 + pd]; lbv = 1.f / (1.f + __expf(a1 - a0)); }
    const int e0 = w * 16;
    const float ogv = p.hg_onorm_g[e0 + fr];
    pg8::f32x4 S[8];
#pragma unroll
    for (int i = 0; i < 8; ++i) S[i] = (pg8::f32x4){0.f, 0.f, 0.f, 0.f};
    const size_t rowb = (size_t)b * SEQ;
    const int c0 = half * 32;
    bf16* QCg = (bf16*)(ws + WS_HQC) + (size_t)item * 2048 * 128; float* OLg = (float*)(ws + WS_HOL) + (size_t)item * 32 * 8 * 4 * 256;
    float cum = 1.f;
    unsigned short rq[16], rf[16], rv[16];
    { const bf16* gp = HG + (rowb + (size_t)c0 * 64 + pq * 16) * LD_HG + h * 128 + pd;
#pragma unroll
      for (int i = 0; i < 16; ++i) { rq[i] = gp[(size_t)i * LD_HG]; rf[i] = gp[(size_t)i * LD_HG + 512]; rv[i] = gp[(size_t)i * LD_HG + 1024]; } }
    for (int chunk = c0; chunk < c0 + 32; ++chunk) {
        const size_t row0 = rowb + (size_t)chunk * 64;
        float fq_[16], kq_[16], cs[16];
        float run = 0.f;
#pragma unroll
        for (int i = 0; i < 16; ++i) { const float f = lbv + (1.f - lbv) * sigmoidf_(bf2f(rf[i])); kq_[i] = 1.f - f; run += __logf(f); cs[i] = run; fq_[i] = siluf_(bf2f(rq[i])); }
        TOT[pq * 128 + pd] = run;
        { v4u v0, v1;
          v0.x = rv[0] | ((unsigned)rv[1] << 16); v0.y = rv[2] | ((unsigned)rv[3] << 16); v0.z = rv[4] | ((unsigned)rv[5] << 16); v0.w = rv[6] | ((unsigned)rv[7] << 16);
          v1.x = rv[8] | ((unsigned)rv[9] << 16); v1.y = rv[10] | ((unsigned)rv[11] << 16); v1.z = rv[12] | ((unsigned)rv[13] << 16); v1.w = rv[14] | ((unsigned)rv[15] << 16);
          *(v4u*)(VT + pd * HG_LDC + pq * 16) = v0; *(v4u*)(VT + pd * HG_LDC + pq * 16 + 8) = v1; }
        unsigned short rg[16];
#pragma unroll
        for (int i = 0; i < 16; ++i) rg[i] = half ? (unsigned short)0 : HG[(row0 + (i >> 2) * 16 + fq * 4 + (i & 3)) * LD_HG + 1536 + h * 128 + e0 + fr];
        if (chunk + 1 < c0 + 32) { const bf16* gp = HG + (row0 + 64 + pq * 16) * LD_HG + h * 128 + pd;
#pragma unroll
            for (int i = 0; i < 16; ++i) { rq[i] = gp[(size_t)i * LD_HG]; rf[i] = gp[(size_t)i * LD_HG + 512]; rv[i] = gp[(size_t)i * LD_HG + 1024]; } }
        __syncthreads();
        const float t0 = TOT[pd], t1 = TOT[128 + pd], t2 = TOT[256 + pd], t3 = TOT[384 + pd];
        const float base = (pq > 0 ? t0 : 0.f) + (pq > 1 ? t1 : 0.f) + (pq > 2 ? t2 : 0.f);
        const float bmid = t0 + t1, blast = (t0 + t1) + (t2 + t3);
        const float emid = __expf(bmid), elm = __expf(blast - bmid);
        if (pq == 0) DEC[pd] = __expf(blast);
        { unsigned klp[8];
#pragma unroll
          for (int i = 0; i < 16; ++i) { const float bb = base + cs[i]; const float E1 = __expf(bb - bmid), R1 = __builtin_amdgcn_rcpf(E1);
              const float qtv = fq_[i] * E1, ktv = kq_[i] * R1, qev = qtv * emid, klv = ktv * elm;
              const int srow = pq * 16 + i;
              QT[srow * HG_LDR + pd] = (bf16)f2bf(qtv); KT[srow * HG_LDR + pd] = (bf16)f2bf(ktv); QE[srow * HG_LDR + pd] = (bf16)f2bf(qev);
              if (half) QCg[((size_t)(chunk - 32) * 64 + srow) * 128 + pd] = (bf16)f2bf(qev * cum);
              if (i & 1) klp[i >> 1] |= f2bf(klv) << 16; else klp[i >> 1] = f2bf(klv); }
          *(v4u*)(KLT + pd * HG_LDC + pq * 16) = (v4u){klp[0], klp[1], klp[2], klp[3]}; *(v4u*)(KLT + pd * HG_LDC + pq * 16 + 8) = (v4u){klp[4], klp[5], klp[6], klp[7]}; }
        cum *= __expf(blast);
        __syncthreads();
#pragma unroll
        for (int tt = 0; tt < 2; ++tt) { const int id = w + 8 * tt, rt = id >> 2, ct = id & 3;
            pg8::f32x4 a = {0.f, 0.f, 0.f, 0.f};
            if (ct <= rt) {
#pragma unroll
                for (int ks = 0; ks < 4; ++ks) { const bf16x8 af = *(const bf16x8*)(QT + (rt * 16 + fr) * HG_LDR + ks * 32 + fq * 8), bfv = *(const bf16x8*)(KT + (ct * 16 + fr) * HG_LDR + ks * 32 + fq * 8);
                    a = __builtin_amdgcn_mfma_f32_16x16x32_bf16(af, bfv, a, 0, 0, 0); } }
#pragma unroll
            for (int r = 0; r < 4; ++r) { const int c = rt * 16 + fq * 4 + r, sidx = ct * 16 + fr; AM[c * HG_LDC + sidx] = (bf16)((sidx <= c) ? f2bf(a[r]) : 0u); } }
        __syncthreads();
        const bf16x8 vb0 = *(const bf16x8*)(VT + (e0 + fr) * HG_LDC + fq * 8), vb1 = *(const bf16x8*)(VT + (e0 + fr) * HG_LDC + 32 + fq * 8);
        bf16x8 sb[4];
#pragma unroll
        for (int ks = 0; ks < 4; ++ks) { v4u t; t.x = pk2(S[2 * ks][0], S[2 * ks][1]); t.y = pk2(S[2 * ks][2], S[2 * ks][3]); t.z = pk2(S[2 * ks + 1][0], S[2 * ks + 1][1]); t.w = pk2(S[2 * ks + 1][2], S[2 * ks + 1][3]); sb[ks] = __builtin_bit_cast(bf16x8, t); }
        pg8::f32x4 o[4];
#pragma unroll
        for (int rt = 0; rt < 4; ++rt) { pg8::f32x4 a = {0.f, 0.f, 0.f, 0.f};
            a = __builtin_amdgcn_mfma_f32_16x16x32_bf16(*(const bf16x8*)(AM + (rt * 16 + fr) * HG_LDC + fq * 8), vb0, a, 0, 0, 0);
            a = __builtin_amdgcn_mfma_f32_16x16x32_bf16(*(const bf16x8*)(AM + (rt * 16 + fr) * HG_LDC + 32 + fq * 8), vb1, a, 0, 0, 0);
#pragma unroll
            for (int ks = 0; ks < 4; ++ks) { const v2u lo = *(const v2u*)(QE + (rt * 16 + fr) * HG_LDR + ks * 32 + fq * 4), hi = *(const v2u*)(QE + (rt * 16 + fr) * HG_LDR + ks * 32 + 16 + fq * 4);
                const v4u t = {lo.x, lo.y, hi.x, hi.y};
                a = __builtin_amdgcn_mfma_f32_16x16x32_bf16(__builtin_bit_cast(bf16x8, t), sb[ks], a, 0, 0, 0); }
            o[rt] = a; }
#pragma unroll
        for (int dt = 0; dt < 8; ++dt) { const f32x4 dc = *(const f32x4*)(DEC + dt * 16 + fq * 4);
            pg8::f32x4 a = S[dt]; a[0] *= dc[0]; a[1] *= dc[1]; a[2] *= dc[2]; a[3] *= dc[3];
            a = __builtin_amdgcn_mfma_f32_16x16x32_bf16(*(const bf16x8*)(KLT + (dt * 16 + fr) * HG_LDC + fq * 8), vb0, a, 0, 0, 0);
            a = __builtin_amdgcn_mfma_f32_16x16x32_bf16(*(const bf16x8*)(KLT + (dt * 16 + fr) * HG_LDC + 32 + fq * 8), vb1, a, 0, 0, 0);
            S[dt] = a; }
        if (half) {
#pragma unroll
            for (int rt = 0; rt < 4; ++rt) *(pg8::f32x4*)(OLg + ((((size_t)(chunk - 32)) * 8 + w) * 4 + rt) * 256 + lane * 4) = o[rt];
            __syncthreads();
            continue;
        }
#pragma unroll
        for (int rt = 0; rt < 4; ++rt)
#pragma unroll
            for (int r = 0; r < 4; ++r) { float x = o[rt][r] * o[rt][r];
                x += __shfl_xor(x, 1); x += __shfl_xor(x, 2); x += __shfl_xor(x, 4); x += __shfl_xor(x, 8);
                if (fr == 0) SSQ[w * 64 + rt * 16 + fq * 4 + r] = x; }
        __syncthreads();
        float tot = 0.f;
#pragma unroll
        for (int ww = 0; ww < 8; ++ww) tot += SSQ[ww * 64 + lane];
        const float rstd_l = rsqrtf(tot * (1.f / 128.f) + RMS_EPS);
#pragma unroll
        for (int rt = 0; rt < 4; ++rt)
#pragma unroll
            for (int r = 0; r < 4; ++r) { const int c = rt * 16 + fq * 4 + r; const float rs = __shfl(rstd_l, c);
                const float y = o[rt][r] * rs * ogv * siluf_(bf2f(rg[rt * 4 + r]));
                ((unsigned char*)YA)[(row0 + c) * 1024 + h * 128 + e0 + fr] = (unsigned char)(__builtin_amdgcn_cvt_pk_fp8_f32(y, 0.f, 0, false) & 0xff); }
    }
    if (!half) {
#pragma unroll
        for (int ks = 0; ks < 4; ++ks) { v4u t; t.x = pk2(S[2 * ks][0], S[2 * ks][1]); t.y = pk2(S[2 * ks][2], S[2 * ks][3]); t.z = pk2(S[2 * ks + 1][0], S[2 * ks + 1][1]); t.w = pk2(S[2 * ks + 1][2], S[2 * ks + 1][3]);
            *(v4u*)(ws + WS_HSB + ((((size_t)item * 8 + w) * 4 + ks) * 64 + lane) * 16) = t; }
    }
    __syncthreads();
}
__device__ __forceinline__ void hgrn_fix(const Params& p, unsigned char* lds, int item, int c) {
    const int b = item >> 2, h = item & 3;
    const int tid = threadIdx.x, w = tid >> 6, lane = tid & 63, fr = lane & 15, fq = lane >> 4;
    unsigned char* ws = p.ws;
    const bf16* HG = (const bf16*)(ws + WS_HG);
    bf16* YA = (bf16*)(ws + WS_H);
    float* SSQ = (float*)(lds + HGL_SSQ);
    const bf16* QCg = (const bf16*)(ws + WS_HQC) + (size_t)item * 2048 * 128; const float* OLg = (const float*)(ws + WS_HOL) + (size_t)item * 32 * 8 * 4 * 256;
    const int e0 = w * 16;
    const float ogv = p.hg_onorm_g[e0 + fr];
    const size_t row0 = (size_t)b * SEQ + (size_t)(32 + c) * 64;
    bf16x8 sb[4];
#pragma unroll
    for (int ks = 0; ks < 4; ++ks) sb[ks] = __builtin_bit_cast(bf16x8, *(const v4u*)(ws + WS_HSB + ((((size_t)item * 8 + w) * 4 + ks) * 64 + lane) * 16));
    unsigned short rg[16];
#pragma unroll
    for (int i = 0; i < 16; ++i) rg[i] = HG[(row0 + (i >> 2) * 16 + fq * 4 + (i & 3)) * LD_HG + 1536 + h * 128 + e0 + fr];
    pg8::f32x4 o[4];
#pragma unroll
    for (int rt = 0; rt < 4; ++rt) { pg8::f32x4 a = *(const pg8::f32x4*)(OLg + ((((size_t)c) * 8 + w) * 4 + rt) * 256 + lane * 4);
#pragma unroll
        for (int ks = 0; ks < 4; ++ks) { const bf16* qr = QCg + ((size_t)c * 64 + rt * 16 + fr) * 128 + ks * 32;
            const v2u lo = *(const v2u*)(qr + fq * 4), hi = *(const v2u*)(qr + 16 + fq * 4);
            const v4u t = {lo.x, lo.y, hi.x, hi.y};
            a = __builtin_amdgcn_mfma_f32_16x16x32_bf16(__builtin_bit_cast(bf16x8, t), sb[ks], a, 0, 0, 0); }
        o[rt] = a; }
#pragma unroll
    for (int rt = 0; rt < 4; ++rt)
#pragma unroll
        for (int r = 0; r < 4; ++r) { float x = o[rt][r] * o[rt][r];
            x += __shfl_xor(x, 1); x += __shfl_xor(x, 2); x += __shfl_xor(x, 4); x += __shfl_xor(x, 8);
            if (fr == 0) SSQ[w * 64 + rt * 16 + fq * 4 + r] = x; }
    __syncthreads();
    float tot = 0.f;
#pragma unroll
    for (int ww = 0; ww < 8; ++ww) tot += SSQ[ww * 64 + lane];
    const float rstd_l = rsqrtf(tot * (1.f / 128.f) + RMS_EPS);
#pragma unroll
    for (int rt = 0; rt < 4; ++rt)
#pragma unroll
        for (int r = 0; r < 4; ++r) { const int cc = rt * 16 + fq * 4 + r; const float rs = __shfl(rstd_l, cc);
            const float y = o[rt][r] * rs * ogv * siluf_(bf2f(rg[rt * 4 + r]));
            ((unsigned char*)YA)[(row0 + cc) * 1024 + h * 128 + e0 + fr] = (unsigned char)(__builtin_amdgcn_cvt_pk_fp8_f32(y, 0.f, 0, false) & 0xff); }
    __syncthreads();
}

__device__ __forceinline__ unsigned f16key(float x) {
    x = x + 0.f;
    const _Float16 hx = (_Float16)x; const unsigned short bits = __builtin_bit_cast(unsigned short, hx);
    return (bits & 0x8000u) ? (unsigned)(unsigned short)(~bits) : (unsigned)(bits | 0x8000u);
}
__device__ __forceinline__ void find_bin(const unsigned* hist, int K, int lane, int& bin, int& rem) {
    const v4u hv = *(const v4u*)(hist + 4 * lane);
    const unsigned c = hv.x + hv.y + hv.z + hv.w;
    unsigned suf = c;
#pragma unroll
    for (int o = 1; o < 64; o <<= 1) { const unsigned t = __shfl_down(suf, o); if (lane + o < 64) suf += t; }
    const unsigned above = suf - c;
    const bool mine = (above < (unsigned)K) && ((unsigned)K <= suf);
    int mybin = 0, myrem = 0;
    if (mine) { unsigned ca = above; const unsigned hh[4] = {hv.x, hv.y, hv.z, hv.w}; bool found = false;
#pragma unroll
        for (int i = 3; i >= 0; --i) { if (!found) { if (ca + hh[i] >= (unsigned)K) { mybin = 4 * lane + i; myrem = K - (int)ca; found = true; } else ca += hh[i]; } } }
    const unsigned long long m = __ballot(mine);
    const int src = (int)__builtin_ctzll(m | (1ull << 63));
    bin = __shfl(mybin, src); rem = __shfl(myrem, src);
}
__device__ __forceinline__ void dsa1_item(const Params& p, unsigned char* lds, int item) {
    const int b = item >> 8, q0 = (item & 255) * 16;
    const int tid = threadIdx.x, w = tid >> 6, lane = tid & 63, fr = lane & 15, fq = lane >> 4;
    unsigned char* ws = p.ws;
    const bf16* IDX = (const bf16*)(ws + WS_IDX);
    unsigned short* Ik = (unsigned short*)lds;
    unsigned* hist1 = (unsigned*)(lds + 131072);
    unsigned* hist = (unsigned*)(lds + 131072 + 16384) + w * 256;
    const size_t rowb = (size_t)b * SEQ;
    *(v4u*)(hist1 + tid * 4) = (v4u){0u, 0u, 0u, 0u}; *(v4u*)(hist1 + 2048 + tid * 4) = (v4u){0u, 0u, 0u, 0u};
    bf16x8 Af[8][2];
    { const bf16* rp = IDX + (rowb + q0 + fr) * LD_IDX + fq * 8;
#pragma unroll
      for (int h = 0; h < 8; ++h) { Af[h][0] = *(const bf16x8*)(rp + h * 64); Af[h][1] = *(const bf16x8*)(rp + h * 64 + 32); } }
    const float idx_scale = 0.5f * 0.125f * 0.35355339059327373f;
    bf16x8 Aw[2];
    { float wa[8];
      { const v4u wq = *(const v4u*)(IDX + (rowb + q0 + fr) * LD_IDX + 576);
#pragma unroll
        for (int i = 0; i < 4; ++i) { wa[2 * i] = bflo(wq[i]) * idx_scale; wa[2 * i + 1] = bfhi(wq[i]) * idx_scale; } }
#pragma unroll
      for (int ks = 0; ks < 2; ++ks) { float cq[8];
#pragma unroll
          for (int j = 0; j < 8; ++j) cq[j] = 0.f;
#pragma unroll
          for (int h = 0; h < 8; ++h)
#pragma unroll
              for (int j = 0; j < 8; ++j) cq[j] += wa[h] * bf2f((unsigned)(unsigned short)Af[h][ks][j]);
          const v4u t = {pk2(cq[0], cq[1]), pk2(cq[2], cq[3]), pk2(cq[4], cq[5]), pk2(cq[6], cq[7])};
          Aw[ks] = __builtin_bit_cast(bf16x8, t); } }
    float wv[4][8];
#pragma unroll
    for (int r = 0; r < 4; ++r) { const v4u wq = *(const v4u*)(IDX + (rowb + q0 + fq * 4 + r) * LD_IDX + 576);
#pragma unroll
        for (int i = 0; i < 4; ++i) { wv[r][2 * i] = bflo(wq[i]) * idx_scale; wv[r][2 * i + 1] = bfhi(wq[i]) * idx_scale; } }
    const int ntiles = (q0 >> 4) + 1;
    __syncthreads();
    bf16x8 B0 = Aw[0], B1 = Aw[1];
    if (w < ntiles) { const bf16* kp = IDX + (rowb + w * 16 + fr) * LD_IDX + 512 + fq * 8; B0 = *(const bf16x8*)kp; B1 = *(const bf16x8*)(kp + 32); }
    for (int kt = w; kt < ntiles; kt += NWAVES) {
        bf16x8 nB0 = B0, nB1 = B1;
        if (kt + NWAVES < ntiles) { const bf16* kp = IDX + (rowb + (kt + NWAVES) * 16 + fr) * LD_IDX + 512 + fq * 8; nB0 = *(const bf16x8*)kp; nB1 = *(const bf16x8*)(kp + 32); }
        pg8::f32x4 lin = {0.f, 0.f, 0.f, 0.f};
        lin = __builtin_amdgcn_mfma_f32_16x16x32_bf16(Aw[0], B0, lin, 0, 0, 0);
        lin = __builtin_amdgcn_mfma_f32_16x16x32_bf16(Aw[1], B1, lin, 0, 0, 0);
        float I[4] = {lin[0], lin[1], lin[2], lin[3]};
#pragma unroll
        for (int h = 0; h < 8; ++h) { pg8::f32x4 a = {0.f, 0.f, 0.f, 0.f};
            a = __builtin_amdgcn_mfma_f32_16x16x32_bf16(Af[h][0], B0, a, 0, 0, 0);
            a = __builtin_amdgcn_mfma_f32_16x16x32_bf16(Af[h][1], B1, a, 0, 0, 0);
#pragma unroll
            for (int r = 0; r < 4; ++r) I[r] = __builtin_fmaf(wv[r][h], __builtin_fabsf(a[r]), I[r]); }
        const int kidx = kt * 16 + fr;
#pragma unroll
        for (int r = 0; r < 4; ++r) { const unsigned key = f16key(I[r]); Ik[(fq * 4 + r) * 4096 + kidx] = (unsigned short)key;
            if (kidx <= q0 + fq * 4 + r) atomicAdd(&hist1[(fq * 4 + r) * 256 + (key >> 8)], 1u); }
        B0 = nB0; B1 = nB1;
    }
    __syncthreads();
    for (int qq = w; qq < 16; qq += NWAVES) {
        const int t = q0 + qq, n = t + 1;
        unsigned short* so = (unsigned short*)(hist1 + qq * 256);
        const unsigned short* keys = Ik + qq * 4096;
        if (n <= TOPK) { for (int j = lane; j < n; j += 64) so[j] = (unsigned short)j; }
        else {
            int b1, rem1, b2, rem2;
            find_bin(hist1 + qq * 256, TOPK, lane, b1, rem1);
            *(v4u*)(hist + 4 * lane) = (v4u){0u, 0u, 0u, 0u};
            LDS_WAIT(); __builtin_amdgcn_wave_barrier();
            for (int j = lane; j < n; j += 64) { const unsigned k = keys[j]; if ((int)(k >> 8) == b1) atomicAdd(&hist[k & 255u], 1u); }
            LDS_WAIT(); __builtin_amdgcn_wave_barrier();
            find_bin(hist, rem1, lane, b2, rem2);
            const unsigned thr = ((unsigned)b1 << 8) | (unsigned)b2;
            int base = 0, eqtaken = 0;
            const unsigned long long lt = (lane == 0) ? 0ull : (~0ull >> (64 - lane));
            for (int j0 = 0; j0 < n; j0 += 64) {
                const int j = j0 + lane; const bool valid = j < n; const unsigned k = valid ? (unsigned)keys[j] : 0u;
                const bool gt = valid && k > thr, eq = valid && k == thr;
                const unsigned long long meq = __ballot(eq);
                const int erank = __popcll(meq & lt) + eqtaken;
                const bool take = gt || (eq && erank < rem2);
                const unsigned long long mt = __ballot(take);
                if (take) so[base + __popcll(mt & lt)] = (unsigned short)j;
                base += __popcll(mt); eqtaken += __popcll(meq);
            }
        }
    }
    __syncthreads();
}

__device__ __forceinline__ void qknorm_token(const Params& p, int tok, int lane) {
    const bf16* row = (const bf16*)(p.ws + WS_ATT) + (size_t)tok * LD_ATT;
    const int c8 = (lane & 7) * 8;
    { const v4u qv = *(const v4u*)(row + lane * 8);
      float x[8]; float ss = 0.f;
#pragma unroll
      for (int i = 0; i < 4; ++i) { x[2 * i] = bflo(qv[i]); x[2 * i + 1] = bfhi(qv[i]); ss += x[2 * i] * x[2 * i] + x[2 * i + 1] * x[2 * i + 1]; }
      ss += __shfl_xor(ss, 1); ss += __shfl_xor(ss, 2); ss += __shfl_xor(ss, 4);
      const float rs = rsqrtf(ss * (1.f / 64.f) + RMS_EPS) * (0.125f * 1.4426950408889634f);
#pragma unroll
      for (int i = 0; i < 8; ++i) x[i] = x[i] * rs * p.q_norm_g[c8 + i];
      v2u hw, lw;
      hw.x = pk4_fp8(x[0], x[1], x[2], x[3]); hw.y = pk4_fp8(x[4], x[5], x[6], x[7]);
      { const f32x2 d0 = __builtin_amdgcn_cvt_pk_f32_fp8((int)hw.x, false), d1 = __builtin_amdgcn_cvt_pk_f32_fp8((int)hw.x, true), d2 = __builtin_amdgcn_cvt_pk_f32_fp8((int)hw.y, false), d3 = __builtin_amdgcn_cvt_pk_f32_fp8((int)hw.y, true);
        lw.x = pk4_fp8(x[0] - d0[0], x[1] - d0[1], x[2] - d1[0], x[3] - d1[1]); lw.y = pk4_fp8(x[4] - d2[0], x[5] - d2[1], x[6] - d3[0], x[7] - d3[1]); }
      *(v2u*)(p.ws + WS_QHI + (size_t)tok * 512 + lane * 8) = hw; *(v2u*)(p.ws + WS_QLO + (size_t)tok * 512 + lane * 8) = lw; }
    { const v4u kv = *(const v4u*)(row + 512 + (lane & 15) * 8);
      float x[8]; float ss = 0.f;
#pragma unroll
      for (int i = 0; i < 4; ++i) { x[2 * i] = bflo(kv[i]); x[2 * i + 1] = bfhi(kv[i]); ss += x[2 * i] * x[2 * i] + x[2 * i + 1] * x[2 * i + 1]; }
      ss += __shfl_xor(ss, 1); ss += __shfl_xor(ss, 2); ss += __shfl_xor(ss, 4);
      const float rs = rsqrtf(ss * (1.f / 64.f) + RMS_EPS);
#pragma unroll
      for (int i = 0; i < 8; ++i) x[i] = x[i] * rs * p.k_norm_g[c8 + i];
      v2u o; o.x = pk4_fp8(x[0], x[1], x[2], x[3]); o.y = pk4_fp8(x[4], x[5], x[6], x[7]);
      if (lane < 16) *(v2u*)(p.ws + WS_K8 + (size_t)tok * 128 + lane * 8) = o; }
    { const v4u vv = *(const v4u*)(row + 640 + (lane & 15) * 8);
      v2u o; o.x = pk4_fp8(bflo(vv[0]), bfhi(vv[0]), bflo(vv[1]), bfhi(vv[1])); o.y = pk4_fp8(bflo(vv[2]), bfhi(vv[2]), bflo(vv[3]), bfhi(vv[3]));
      if (lane < 16) *(v2u*)(p.ws + WS_V8 + (size_t)tok * 128 + lane * 8) = o; }
}

typedef short v4i16_t __attribute__((ext_vector_type(4)));
__device__ __forceinline__ v4i16_t vtr16(const bf16* ldsp) { return __builtin_amdgcn_ds_read_tr16_b64_v4i16((LAS v4i16_t*)ldsp); }
typedef int v2i_t __attribute__((ext_vector_type(2)));
__device__ __forceinline__ long vtr8(const unsigned char* ldsp) { const v2i_t r = __builtin_amdgcn_ds_read_tr8_b64_v2i32((LAS v2i_t*)ldsp); return (long)(((unsigned long long)(unsigned)r[1] << 32) | (unsigned)r[0]); }
__device__ __forceinline__ void dsa2_query(const Params& p, unsigned char* ldsw, const unsigned short* sel, int b, int t, int lane) {
    unsigned char* ws = p.ws;
    const bf16* ATT = (const bf16*)(ws + WS_ATT);
    bf16* YB = (bf16*)(ws + WS_H);
    unsigned short* sl = (unsigned short*)ldsw;
    float* df = (float*)(ldsw + 512);
    unsigned char* Vl = ldsw + 1536;
    const unsigned char* V8 = ws + WS_V8;
    const int fr = lane & 15, fq = lane >> 4;
    const size_t rowb = (size_t)b * SEQ;
    const int cnt = (t + 1 < TOPK) ? (t + 1) : TOPK;
    { v2u sv = *(const v2u*)(sel + lane * 4);
      const int j0 = lane * 4;
      if (j0 >= cnt) sv.x = 0u; else if (j0 + 1 >= cnt) sv.x &= 0xffffu;
      if (j0 + 2 >= cnt) sv.y = 0u; else if (j0 + 3 >= cnt) sv.y &= 0xffffu;
      *(v2u*)(sl + lane * 4) = sv;
      f32x4 d4; d4[0] = (j0 < cnt) ? (float)(t - (int)(sv.x & 0xffffu)) : INFINITY; d4[1] = (j0 + 1 < cnt) ? (float)(t - (int)(sv.x >> 16)) : INFINITY;
      d4[2] = (j0 + 2 < cnt) ? (float)(t - (int)(sv.y & 0xffffu)) : INFINITY; d4[3] = (j0 + 3 < cnt) ? (float)(t - (int)(sv.y >> 16)) : INFINITY;
      *(f32x4*)(df + lane * 4) = d4; }
    LDS_WAIT(); __builtin_amdgcn_wave_barrier();
    const unsigned char* K8 = ws + WS_K8;
    long qhA[2] = {0, 0}, qhB[2] = {0, 0}, qlA[2] = {0, 0}, qlB[2] = {0, 0};
    if (fr < 8) { const v4u qh = *(const v4u*)(ws + WS_QHI + (rowb + t) * 512 + fr * 64 + fq * 16), ql = *(const v4u*)(ws + WS_QLO + (rowb + t) * 512 + fr * 64 + fq * 16);
        const long hA = (long)(((unsigned long long)qh.y << 32) | qh.x), hB = (long)(((unsigned long long)qh.w << 32) | qh.z), lA = (long)(((unsigned long long)ql.y << 32) | ql.x), lB = (long)(((unsigned long long)ql.w << 32) | ql.z);
        if (fr < 4) { qhA[0] = hA; qhB[0] = hB; qlA[0] = lA; qlB[0] = lB; } else { qhA[1] = hA; qhB[1] = hB; qlA[1] = lA; qlB[1] = lB; } }
    pg8::f32x4 sc[16];
    v4u vv[8];
    { v4u kf[16];
#pragma unroll
      for (int half = 0; half < 2; ++half) {
#pragma unroll
          for (int kt = 0; kt < 8; ++kt) { const int s = sl[(half * 8 + kt) * 16 + fr]; const unsigned char* kp = K8 + (rowb + s) * 128 + fq * 16;
              kf[2 * kt] = *(const v4u*)kp; kf[2 * kt + 1] = *(const v4u*)(kp + 64); }
          if (half == 1) {
#pragma unroll
              for (int j = 0; j < 8; ++j) { const int s = sl[j * 8 + (lane >> 3)]; vv[j] = *(const v4u*)(V8 + (rowb + s) * 128 + (lane & 7) * 16); } }
          __builtin_amdgcn_sched_barrier(0);
#pragma unroll
          for (int kt = 0; kt < 8; ++kt) { pg8::f32x4 a = {0.f, 0.f, 0.f, 0.f};
#pragma unroll
              for (int gg = 0; gg < 2; ++gg) { const v4u kv = kf[2 * kt + gg];
                  const long kA = (long)(((unsigned long long)kv.y << 32) | kv.x), kB = (long)(((unsigned long long)kv.w << 32) | kv.z);
                  a = __builtin_amdgcn_mfma_f32_16x16x32_fp8_fp8(kA, qhA[gg], a, 0, 0, 0); a = __builtin_amdgcn_mfma_f32_16x16x32_fp8_fp8(kB, qhB[gg], a, 0, 0, 0);
                  a = __builtin_amdgcn_mfma_f32_16x16x32_fp8_fp8(kA, qlA[gg], a, 0, 0, 0); a = __builtin_amdgcn_mfma_f32_16x16x32_fp8_fp8(kB, qlB[gg], a, 0, 0, 0); }
              sc[half * 8 + kt] = a; }
          __builtin_amdgcn_sched_barrier(0);
      } }
    const float slope = exp2f(-(float)((fr & 7) + 1)) * 1.4426950408889634f;
    float m = -INFINITY;
#pragma unroll
    for (int kt = 0; kt < 16; ++kt) { const f32x4 d4 = *(const f32x4*)(df + kt * 16 + fq * 4);
#pragma unroll
        for (int r = 0; r < 4; ++r) { const float x = sc[kt][r] - slope * d4[r]; sc[kt][r] = x; m = fmaxf(m, x); } }
    m = fmaxf(m, __shfl_xor(m, 16)); m = fmaxf(m, __shfl_xor(m, 32));
    float l = 0.f;
#pragma unroll
    for (int kt = 0; kt < 16; ++kt)
#pragma unroll
        for (int r = 0; r < 4; ++r) { const float e = __builtin_amdgcn_exp2f(sc[kt][r] - m); sc[kt][r] = e; l += e; }
    l += __shfl_xor(l, 16); l += __shfl_xor(l, 32);
    const float inv = 1.f / l;
    pg8::f32x4 o[2][4];
#pragma unroll
    for (int g2 = 0; g2 < 2; ++g2)
#pragma unroll
        for (int dt = 0; dt < 4; ++dt) o[g2][dt] = (pg8::f32x4){0.f, 0.f, 0.f, 0.f};
    unsigned char* vdst = Vl + ((lane & 7) >> 2) * 6400 + (lane >> 3) * 80 + (lane & 3) * 16;
#pragma unroll
    for (int ch = 0; ch < 4; ++ch) {
        LDS_WAIT(); __builtin_amdgcn_wave_barrier();
#pragma unroll
        for (int j = 0; j < 8; ++j) *(v4u*)(vdst + ((j >> 2) * 40 + ((j >> 1) & 1) * 24 + (j & 1) * 8) * 80) = vv[j];
        if (ch < 3) {
#pragma unroll
            for (int j = 0; j < 8; ++j) { const int s = sl[(ch + 1) * 64 + j * 8 + (lane >> 3)]; vv[j] = *(const v4u*)(V8 + (rowb + s) * 128 + (lane & 7) * 16); } }
        LDS_WAIT(); __builtin_amdgcn_wave_barrier();
#pragma unroll
        for (int k2 = 0; k2 < 2; ++k2) { const int kt0 = ch * 4 + 2 * k2;
            const long pb = (long)(((unsigned long long)pk4_fp8(sc[kt0 + 1][0], sc[kt0 + 1][1], sc[kt0 + 1][2], sc[kt0 + 1][3]) << 32) | pk4_fp8(sc[kt0][0], sc[kt0][1], sc[kt0][2], sc[kt0][3]));
            const int q = fr >> 1, prow = k2 * 40 + ((q < 4) ? (fq * 4 + q) : (24 + fq * 4 + (q - 4)));
#pragma unroll
            for (int g2 = 0; g2 < 2; ++g2)
#pragma unroll
                for (int dt = 0; dt < 4; ++dt) o[g2][dt] = __builtin_amdgcn_mfma_f32_16x16x32_fp8_fp8(vtr8(Vl + g2 * 6400 + prow * 80 + dt * 16 + (fr & 1) * 8), pb, o[g2][dt], 0, 0, 0); }
    }
    { const float i8 = inv * 8.f; unsigned char* yp = (unsigned char*)YB + (rowb + t) * 1024 + 512 + fr * 64 + fq * 4;
      if (fr < 4) {
#pragma unroll
          for (int dt = 0; dt < 4; ++dt) *(unsigned*)(yp + dt * 16) = pk4_fp8(o[0][dt][0] * i8, o[0][dt][1] * i8, o[0][dt][2] * i8, o[0][dt][3] * i8); }
      else if (fr < 8) {
#pragma unroll
          for (int dt = 0; dt < 4; ++dt) *(unsigned*)(yp + dt * 16) = pk4_fp8(o[1][dt][0] * i8, o[1][dt][1] * i8, o[1][dt][2] * i8, o[1][dt][3] * i8); } }
    LDS_WAIT(); __builtin_amdgcn_wave_barrier();
}

#define INS16(L, x) do { _Pragma("unroll") for (int _i = 15; _i >= 1; --_i) L[_i] = __builtin_amdgcn_fmed3f(L[_i - 1], L[_i], (x)); L[0] = fmaxf(L[0], (x)); } while (0)
__device__ __forceinline__ float f_andor(float v, unsigned keepmask, unsigned orv) { return __builtin_bit_cast(float, (__builtin_bit_cast(unsigned, v) & keepmask) | orv); }
__device__ __forceinline__ void peer_select(const Params& p, unsigned char* ldsw, int tg, int h, int lane, int* EIDX, float* GATES) {
    float* sc = (float*)ldsw;
    LDS_WAIT(); __builtin_amdgcn_wave_barrier();
    float L[16];
#pragma unroll
    for (int i = 0; i < 16; ++i) L[i] = -INFINITY;
    { const float* sp = sc + (lane & 31) * 132 + (lane >> 5) * 64;
#pragma unroll 4
      for (int i = 0; i < 16; ++i) { const f32x4 x = *(const f32x4*)(sp + 4 * i); INS16(L, x[0]); INS16(L, x[1]); INS16(L, x[2]); INS16(L, x[3]); } }
    { float O[16];
#pragma unroll
      for (int i = 0; i < 16; ++i) O[i] = __shfl_xor(L[i], 32);
#pragma unroll
      for (int i = 0; i < 16; ++i) INS16(L, O[i]); }
    LDS_WAIT(); __builtin_amdgcn_wave_barrier();
    float* lst = sc;
    if (lane < 32) {
#pragma unroll
        for (int i = 0; i < 4; ++i) *(f32x4*)(lst + lane * 16 + 4 * i) = (f32x4){L[4 * i], L[4 * i + 1], L[4 * i + 2], L[4 * i + 3]}; }
    LDS_WAIT(); __builtin_amdgcn_wave_barrier();
    const int tok = lane & 15;
    float s1[16], s2[16];
#pragma unroll
    for (int i = 0; i < 4; ++i) { const f32x4 a = *(const f32x4*)(lst + tok * 16 + 4 * i), b = *(const f32x4*)(lst + (16 + tok) * 16 + 4 * i);
#pragma unroll
        for (int c = 0; c < 4; ++c) { s1[4 * i + c] = f_andor(a[c], ~127u, 0u); s2[4 * i + c] = f_andor(b[c], ~127u, 0u); } }
    float M[16];
#pragma unroll
    for (int i = 0; i < 16; ++i) M[i] = -INFINITY;
#pragma unroll
    for (int a = 0; a < 16; ++a)
#pragma unroll
        for (int b = 0; b < 16; ++b)
            if ((a + 1) * (b + 1) <= 16) { const float key = f_andor(s1[a] + s2[b], ~255u, (unsigned)(a * 16 + b)); INS16(M, key); }
    const float mx = f_andor(M[0], ~255u, 0u);
    float e[16], sum = 0.f; int ei[16];
    const unsigned* lb = (const unsigned*)lst;
#pragma unroll
    for (int i = 0; i < 16; ++i) { const unsigned bits = __builtin_bit_cast(unsigned, M[i]); const int flat = bits & 255u;
        e[i] = __expf(f_andor(M[i], ~255u, 0u) - mx); sum += e[i];
        ei[i] = (int)(lb[tok * 16 + (flat >> 4)] & 127u) * 128 + (int)(lb[(16 + tok) * 16 + (flat & 15)] & 127u); }
    const float inv = 1.f / sum;
    if (lane < 16) {
        const size_t ob = ((size_t)tok * 8 + h) * 16;
#pragma unroll
        for (int i = 0; i < 4; ++i) { *(v4u*)(EIDX + ob + 4 * i) = (v4u){(unsigned)ei[4 * i], (unsigned)ei[4 * i + 1], (unsigned)ei[4 * i + 2], (unsigned)ei[4 * i + 3]};
            *(f32x4*)(GATES + ob + 4 * i) = (f32x4){e[4 * i] * inv, e[4 * i + 1] * inv, e[4 * i + 2] * inv, e[4 * i + 3] * inv}; }
    }
    LDS_WAIT(); __builtin_amdgcn_wave_barrier();
}

__device__ __forceinline__ void peer_route_block(const Params& p, unsigned char* lds, int* eG, float* gG) {
    const int tid = threadIdx.x, wave = tid >> 6, lane = tid & 63, fr = lane & 15, fq = lane >> 4, G = gridDim.x;
    unsigned char* ws = p.ws;
    const bf16* Q = (const bf16*)(ws + WS_Q);
    const unsigned char* SKb = ws + WS_SK;
    unsigned char* tile = lds + 8 * 16896;
    float* sc = (float*)(lds + wave * 16896);
    int ngrp = 0;
    for (int tg = blockIdx.x; tg < T / 16; tg += G) ++ngrp;
#pragma unroll 1
    for (int k0 = 0; k0 < ngrp; k0 += 8) {
        const bool valid = k0 + wave < ngrp;
        const int tg = (int)blockIdx.x + (valid ? k0 + wave : k0) * G;
        v4u t[4][2];
        bf16x8 An[2][4];
#pragma unroll
        for (int sub = 0; sub < 4; ++sub) { const unsigned char* sp = SKb + (size_t)sub * 16384 + tid * 32; t[sub][0] = *(const v4u*)sp; t[sub][1] = *(const v4u*)(sp + 16); }
#pragma unroll
        for (int pp = 0; pp < 2; ++pp) { const bf16* rp = Q + (size_t)(tg * 16 + fr) * 2048 + pp * 128 + fq * 8;
#pragma unroll
            for (int ks = 0; ks < 4; ++ks) An[pp][ks] = *(const bf16x8*)(rp + ks * 32); }
#pragma unroll 1
        for (int h = 0; h < 8; ++h) {
            bf16x8 Af[2][4];
#pragma unroll
            for (int pp = 0; pp < 2; ++pp)
#pragma unroll
                for (int ks = 0; ks < 4; ++ks) Af[pp][ks] = An[pp][ks];
            const int hn = (h + 1) & 7;
#pragma unroll
            for (int sub = 0; sub < 4; ++sub) {
                const int pp = sub >> 1, half = sub & 1;
                __syncthreads();
                { unsigned char* wp = tile + (tid >> 3) * 272 + (tid & 7) * 32; *(v4u*)wp = t[sub][0]; *(v4u*)(wp + 16) = t[sub][1]; }
                { const unsigned char* sp = SKb + (size_t)(hn * 4 + sub) * 16384 + tid * 32; t[sub][0] = *(const v4u*)sp; t[sub][1] = *(const v4u*)(sp + 16); }
                __syncthreads();
#pragma unroll
                for (int kt = 0; kt < 4; ++kt) {
                    pg8::f32x4 a = {0.f, 0.f, 0.f, 0.f};
#pragma unroll
                    for (int ks = 0; ks < 4; ++ks) { const bf16x8 bv = *(const bf16x8*)(tile + (kt * 16 + fr) * 272 + ks * 64 + fq * 16); a = __builtin_amdgcn_mfma_f32_16x16x32_bf16(Af[pp][ks], bv, a, 0, 0, 0); }
                    const int kg = (half * 4 + kt) * 16 + fr;
#pragma unroll
                    for (int r = 0; r < 4; ++r) sc[(pp * 16 + fq * 4 + r) * 132 + kg] = f_andor(a[r], ~127u, (unsigned)kg);
                }
            }
#pragma unroll
            for (int pp = 0; pp < 2; ++pp) { const bf16* rp = Q + (size_t)(tg * 16 + fr) * 2048 + hn * 256 + pp * 128 + fq * 8;
#pragma unroll
                for (int ks = 0; ks < 4; ++ks) An[pp][ks] = *(const bf16x8*)(rp + ks * 32); }
            if (valid) peer_select(p, (unsigned char*)sc, tg, h, lane, eG + (size_t)tg * 2048, gG + (size_t)tg * 2048);
        }
    }
}

__device__ __forceinline__ float gelu_erf(float x) { return 0.5f * x * (1.f + erff(x * 0.70710678118654752f)); }
typedef int v8i_t __attribute__((ext_vector_type(8)));
template <int OPSEL> __device__ __forceinline__ pg8::f32x4 mx_dot(v8i_t a, int sa, v8i_t b, int sb, pg8::f32x4 c) {
    return __builtin_amdgcn_mfma_scale_f32_16x16x128_f8f6f4(a, b, c, 4  , 4  , OPSEL, sa, OPSEL, sb);
}
__device__ __forceinline__ void peer_token(const Params& p, unsigned char* ldsw, const _Float16* usL, const _Float16* vsL, unsigned char* tile, int tok, int lane, const v2u nxt_e, const v2u nxt_g, int buf) {
    unsigned char* ws = p.ws;
    const unsigned char* V8 = ws + WS_V;
    const float* MOD = (const float*)(ws + WS_MOD);
    const int fr = lane & 15, fq = lane >> 4;
    typedef v8i_t v8i;
    const int* EIDX = (const int*)(ldsw + buf * 1024); const float* GATES = (const float*)(ldsw + buf * 1024 + 512);
    v4u A4[H4_NT][8]; v2u As[H4_NT];
#pragma unroll
    for (int t = 0; t < H4_NT; ++t) { const unsigned char* hp = ws + WS_H4D + ((size_t)tok * H4_NT + t) * 512 + fq * 16;
        As[t] = *(const v2u*)(ws + WS_H4S + ((size_t)tok * H4_NT + t) * 32 + fq * 8);
#pragma unroll
        for (int kk = 0; kk < 8; ++kk) A4[t][kk] = *(const v4u*)(hp + kk * 64); }
    int* pe = (int*)(ldsw + 2048); float* pa = (float*)(ldsw + 2048 + 512);
    const unsigned char* U4 = ws + WS_U;
    const int gr = lane >> 3, gs = lane & 7;
    const int rdbase = (fr >> 3) * 1024 + (fr & 7) * 128, slotA = (fq ^ (fr & 7) ^ (fr >> 3)) & 7;
    v4u G[8];
#define U_LOADS(CT) do { const int e0_ = EIDX[(CT) * 16 + gr], e1_ = EIDX[(CT) * 16 + 8 + gr]; \
        const unsigned char* p0_ = U4 + (size_t)e0_ * 512 + ((gs ^ gr) & 7) * 16; const unsigned char* p1_ = U4 + (size_t)e1_ * 512 + ((gs ^ gr ^ 1) & 7) * 16; \
        _Pragma("unroll") for (int kk = 0; kk < 8; ++kk) G[kk] = *(const v4u*)(((kk & 1) ? p1_ : p0_) + (kk >> 1) * 128); } while (0)
    U_LOADS(0);
#pragma unroll 1
    for (int ct = 0; ct < 8; ++ct) {
        const int eic = EIDX[ct * 16 + fr]; const float gt = GATES[ct * 16 + fr];
#pragma unroll
        for (int kk = 0; kk < 8; ++kk) *(v4u*)(tile + kk * 1024 + lane * 16) = G[kk];
        __builtin_amdgcn_sched_barrier(0);
        U_LOADS((ct + 1) & 7);
        __builtin_amdgcn_sched_barrier(0);
        LDS_WAIT(); __builtin_amdgcn_wave_barrier();
        v4u Bt[8];
#pragma unroll
        for (int j = 0; j < 8; ++j) Bt[j] = *(const v4u*)(tile + (j >> 1) * 2048 + rdbase + (((j & 1) ? (slotA ^ 4) : slotA) * 16));
        LDS_WAIT(); __builtin_amdgcn_wave_barrier();
        pg8::f32x4 ah = {0.f, 0.f, 0.f, 0.f};
#pragma unroll
        for (int kk = 0; kk < 8; ++kk) { const v4u bu = Bt[kk];
            const v8i bb = {(int)bu.x, (int)bu.y, (int)bu.z, (int)bu.w, 0, 0, 0, 0};
            const int sb = 0x7f7f7f7f;
#pragma unroll
            for (int t = 0; t < H4_NT; ++t) { const v8i aa = {(int)A4[t][kk].x, (int)A4[t][kk].y, (int)A4[t][kk].z, (int)A4[t][kk].w, 0, 0, 0, 0}; const int sa = (int)((kk < 4) ? As[t].x : As[t].y);
                if ((kk & 3) == 0) ah = mx_dot<0>(aa, sa, bb, sb, ah); else if ((kk & 3) == 1) ah = mx_dot<1>(aa, sa, bb, sb, ah); else if ((kk & 3) == 2) ah = mx_dot<2>(aa, sa, bb, sb, ah); else ah = mx_dot<3>(aa, sa, bb, sb, ah); } }
        const float dot = ah[0] * (float)usL[eic];
        if (fq == 0) { pe[ct * 16 + fr] = eic; pa[ct * 16 + fr] = gelu_erf(dot) * gt * (float)vsL[eic]; }
    }
    asm volatile("" :: "v"(G[0]), "v"(G[1]), "v"(G[2]), "v"(G[3]), "v"(G[4]), "v"(G[5]), "v"(G[6]), "v"(G[7]));
#undef U_LOADS
    __builtin_amdgcn_sched_barrier(0);
    { int* ne = (int*)(ldsw + (buf ^ 1) * 1024); float* ng = (float*)(ldsw + (buf ^ 1) * 1024 + 512);
      *(v2u*)(ne + 2 * lane) = nxt_e; *(v2u*)(ng + 2 * lane) = nxt_g; }
    const int hl = lane >> 5, bl = lane & 31;
    float acc[32];
#pragma unroll
    for (int i = 0; i < 32; ++i) acc[i] = 0.f;
    LDS_WAIT(); __builtin_amdgcn_wave_barrier();
#pragma unroll 1
    for (int ct = 0; ct < 16; ++ct)
#pragma unroll
        for (int jp = 0; jp < 4; ++jp) {
            const int idx = pe[ct * 8 + 2 * jp + hl]; const float as = pa[ct * 8 + 2 * jp + hl];
            const v4u vv = *(const v4u*)(V8 + (size_t)idx * 512 + bl * 16);
#pragma unroll
            for (int w4 = 0; w4 < 4; ++w4) { const unsigned wd = vv[w4];
                const f32x2 d0 = __builtin_amdgcn_cvt_scalef32_pk_f32_fp4(wd, 1.0f, 0), d1 = __builtin_amdgcn_cvt_scalef32_pk_f32_fp4(wd, 1.0f, 1), d2 = __builtin_amdgcn_cvt_scalef32_pk_f32_fp4(wd, 1.0f, 2), d3 = __builtin_amdgcn_cvt_scalef32_pk_f32_fp4(wd, 1.0f, 3);
                acc[8 * w4] += as * d0[0]; acc[8 * w4 + 1] += as * d0[1]; acc[8 * w4 + 2] += as * d1[0]; acc[8 * w4 + 3] += as * d1[1];
                acc[8 * w4 + 4] += as * d2[0]; acc[8 * w4 + 5] += as * d2[1]; acc[8 * w4 + 6] += as * d3[0]; acc[8 * w4 + 7] += as * d3[1]; }
        }
    LDS_WAIT(); __builtin_amdgcn_wave_barrier();
    float accs[16];
#pragma unroll
    for (int i = 0; i < 16; ++i) { const float lo = acc[i] + __shfl_xor(acc[i], 32), hi2 = acc[16 + i] + __shfl_xor(acc[16 + i], 32); accs[i] = hl ? hi2 : lo; }
    const int b = tok / SEQ;
    const int col0 = bl * 32 + hl * 16;
    const float* g2 = MOD + (size_t)b * 6144 + 5 * 1024 + col0;
    float* orow = p.out + (size_t)tok * DM + col0;
#pragma unroll
    for (int q4 = 0; q4 < 4; ++q4) { const f32x4 xv = *(const f32x4*)(orow + 4 * q4), gv = *(const f32x4*)(g2 + 4 * q4);
        f32x4 o;
#pragma unroll
        for (int i = 0; i < 4; ++i) o[i] = xv[i] + gv[i] * accs[4 * q4 + i];
        *(f32x4*)(orow + 4 * q4) = o; }
}

#define XB_TMO      128
#define XB_XCNT(j)  (256  + 64 * (j))
#define XB_XSUB(j)  (1280 + 64 * (j))
#define XB_XGEN(j)  (2304 + 64 * (j))
#define XB_TOP      3328
#define XB_TOPGEN   3392
#define XCD_BAR_WORDS 3456
#define XB_SPIN_CAP (1u << 18)

__device__ __forceinline__ unsigned xb_ld(unsigned* p)              { return __hip_atomic_load(p, __ATOMIC_RELAXED, __HIP_MEMORY_SCOPE_AGENT); }
__device__ __forceinline__ unsigned xb_add(unsigned* p, unsigned v) { return __hip_atomic_fetch_add(p, v, __ATOMIC_RELAXED, __HIP_MEMORY_SCOPE_AGENT); }
__device__ __forceinline__ unsigned xb_xcc_id() { return (unsigned)__builtin_amdgcn_s_getreg((3 << 11) | 20) & 0xFu; }
#define XB_SPIN(cond, bar) do { unsigned _sp = 0; while (cond) { __builtin_amdgcn_s_sleep(1); \
    if ((++_sp & 255u) == 0u) { if (xb_ld(&(bar)[XB_TMO])) break; if (_sp > XB_SPIN_CAP) { atomicAdd(&(bar)[XB_TMO], 1u); break; } } } } while (0)

struct XcdBarrier {
    unsigned* bar; unsigned x;
    volatile LAS unsigned* st;
};

__device__ __forceinline__ XcdBarrier xcd_barrier_post(unsigned* bar, volatile LAS unsigned* st) {
    XcdBarrier b; b.bar = bar; b.x = xb_xcc_id(); b.st = st;
    if (threadIdx.x == 0) (void)xb_add(&bar[XB_XCNT(b.x)], 1u);
    return b;
}
__device__ __forceinline__ void xcd_barrier_complete(unsigned* bar, unsigned x, unsigned& nloc, unsigned& nx) {
    const unsigned G = gridDim.x * gridDim.y * gridDim.z;
    unsigned sum, cnt, mine, sp = 0u;
    for (;;) {
        sum = 0u; cnt = 0u; mine = 0u;
#pragma unroll
        for (unsigned j = 0; j < 16; ++j) { const unsigned c = xb_ld(&bar[XB_XCNT(j)]); sum += c; cnt += (c > 0u) ? 1u : 0u; mine = (j == x) ? c : mine; }
        if (sum == G) break;
        __builtin_amdgcn_s_sleep(1);
        if ((++sp & 255u) == 0u) { if (xb_ld(&bar[XB_TMO])) break; if (sp > XB_SPIN_CAP) { atomicAdd(&bar[XB_TMO], 1u); break; } }
    }
    nloc = mine > 0u ? mine : 1u; nx = cnt > 0u ? cnt : 1u;
}

__device__ __forceinline__ void xcd_barrier(const XcdBarrier& b) {
    asm volatile("s_waitcnt vmcnt(0)" ::: "memory");
    __syncthreads();
    if (threadIdx.x == 0) {
        unsigned* bar = b.bar;
        __builtin_amdgcn_s_waitcnt(0);
        unsigned nloc = b.st[0], nx = b.st[1];
        if (nloc == 0u) { xcd_barrier_complete(bar, b.x, nloc, nx); b.st[0] = nloc; b.st[1] = nx; }
        const unsigned old = xb_add(&bar[XB_XSUB(b.x)], 1u);
        const unsigned gen = old / nloc;
        if (old + 1u == (gen + 1u) * nloc) {
            __builtin_amdgcn_fence(__ATOMIC_RELEASE, "agent");
            asm volatile("s_waitcnt vmcnt(0)" ::: "memory");
            const unsigned og = xb_add(&bar[XB_TOP], 1u);
            const unsigned tg = og / nx;
            if (og + 1u == (tg + 1u) * nx) xb_add(&bar[XB_TOPGEN], 1u);
            else XB_SPIN(xb_ld(&bar[XB_TOPGEN]) == tg, bar);
            __builtin_amdgcn_fence(__ATOMIC_ACQUIRE, "agent");
            xb_add(&bar[XB_XGEN(b.x)], 1u);
            asm volatile("s_waitcnt vmcnt(0)" ::: "memory");
        } else {
            XB_SPIN(xb_ld(&bar[XB_XGEN(b.x)]) == gen, bar);
            __builtin_amdgcn_fence(__ATOMIC_ACQUIRE, "agent");
            asm volatile("s_waitcnt vmcnt(0)" ::: "memory");
        }
    }
    __syncthreads();
}

constexpr int NPHASE = 11;
__global__ void __launch_bounds__(NTHREADS, 2) mega(Params p) {
    extern __shared__ __attribute__((aligned(16))) unsigned char lds[];
    cg::grid_group grid = cg::this_grid();
    const int lo = p.ph_lo, hi = p.ph_hi;
    const int tid = threadIdx.x, wave = tid >> 6, lane = tid & 63, G = gridDim.x;
    unsigned char* ws = p.ws;
#ifndef ONLYPH
#define IN(k) (lo <= (k) && (k) < hi)
#else
#define IN(k) ((k) == ONLYPH && lo <= (k) && (k) < hi)
#endif
    volatile LAS unsigned* xb_st = (volatile LAS unsigned*)((LAS unsigned char*)lds + (LDS_BYTES - 16));
    if (tid < 4) xb_st[tid] = 0u;
    __syncthreads();
    XcdBarrier xbar; xbar.bar = (unsigned*)(ws + WS_CTL); xbar.x = 0; xbar.st = xb_st;
    if (hi - lo > 1) xbar = xcd_barrier_post((unsigned*)(ws + WS_CTL), xb_st);
    if (lo < -1) grid.sync();
#define SEAM(k) do { if (IN((k) + 1)) xcd_barrier(xbar); } while (0)
#ifndef REPMASK
#define REPMASK 0
#endif
#define NREP(k) (((REPMASK >> (k)) & 1) ? 2 : 1)
    if (IN(0)) { for (int rep = 0; rep < NREP(0); ++rep) phase0(p, lds); SEAM(0); }
    if (IN(1)) { for (int rep = 0; rep < NREP(1); ++rep) normmod_phase<true>(p, lds, p.x, (bf16*)(ws + WS_H), p.norm1_g, 0, 1024); SEAM(1); }
    if (IN(2)) {
        { pg8::Gemm g{(const bf16*)(ws + WS_H8), (const bf16*)(ws + WS_WIN8), T, 3584, 512, 512, 512}; pg8::StaticOrder S; S.init(T, 3584, G, (int)blockIdx.x);
          EpiProj E{(bf16*)(ws + WS_HG), (bf16*)(ws + WS_ATT), (bf16*)(ws + WS_IDX), (bf16*)(ws + WS_GATE), 1};
          pg8::gemm_phase<EpiProj, pg8::StaticOrder, true, true, 122>((PG8_LAS unsigned char*)lds, g, S, E); }
        { pg8::Gemm g{(const bf16*)(ws + WS_H), (const bf16*)(ws + WS_WIN), T, 2048, 1024, 1024, 1024}; pg8::StaticOrder S; S.init(T, 2048, G, (int)blockIdx.x);
          EpiProj E{(bf16*)(ws + WS_HG), (bf16*)(ws + WS_ATT), (bf16*)(ws + WS_IDX), (bf16*)(ws + WS_GATE), 0};
          pg8::gemm_phase<EpiProj, pg8::StaticOrder, true, true>((PG8_LAS unsigned char*)lds, g, S, E); }
        SEAM(2);
    }
    if (IN(3)) {
        for (int tok = (int)blockIdx.x * NWAVES + wave; tok < T; tok += G * NWAVES) qknorm_token(p, tok, lane);
        SEAM(3);
    }
    if (IN(4)) {
        if ((int)blockIdx.x < 32) hgrn_item<0>(p, lds, (int)blockIdx.x); else if ((int)blockIdx.x < 64) hgrn_item<1>(p, lds, (int)blockIdx.x - 32);
        {
            unsigned* qctr = (unsigned*)(ws + WS_CTL + 32768);
            volatile LAS unsigned* qslot = (volatile LAS unsigned*)((LAS unsigned char*)lds + (LDS_BYTES - 32));
            int qsel = (int)(blockIdx.x & 7u), tried = 0;
            for (;;) {
                if (tid == 0) { unsigned c;
                    for (;;) { c = __hip_atomic_fetch_add(qctr + qsel * 64, 1u, __ATOMIC_RELAXED, __HIP_MEMORY_SCOPE_AGENT); if (c < (unsigned)(SEQ / 16) || tried >= 7) break; qsel = (qsel + 1) & 7; ++tried; }
                    *qslot = (c < (unsigned)(SEQ / 16)) ? (((unsigned)qsel << 16) | c) : 0xffffffffu; }
                __syncthreads();
                const unsigned c = *qslot;
                __syncthreads();
                if (c == 0xffffffffu) break;
                const int b = (int)(c >> 16), qblk = (SEQ / 16 - 1) - (int)(c & 0xffffu), it = b * (SEQ / 16) + qblk, q0 = qblk * 16;
                dsa1_item(p, lds, it);
#pragma unroll 1
                for (int k2 = 0; k2 < 2; ++k2) dsa2_query(p, lds + wave * 16384, (const unsigned short*)(lds + 131072 + (wave + 8 * k2) * 1024), b, q0 + wave + 8 * k2, lane);
                __syncthreads();
            }
        }
        if (hi - lo > 1) xcd_barrier(xbar);
        for (int u = blockIdx.x; u < 32 * 32; u += G) hgrn_fix(p, lds, u >> 5, u & 31);
        SEAM(4);
    }
    if (IN(5)) {
        pg8::Gemm g{(const bf16*)(ws + WS_H), (const bf16*)(ws + WS_WAB8), T, 1024, 256, 512, 512}; pg8::StaticOrderT<true> S; S.init(T, 1024, G, (int)blockIdx.x, 256);
        EpiMerged E{(const bf16*)(ws + WS_GATE), (bf16*)(ws + WS_MERGED)};
        for (int rep = 0; rep < NREP(5); ++rep) pg8::gemm_phase<EpiMerged, pg8::StaticOrderT<true>, true, true, 122>((PG8_LAS unsigned char*)lds, g, S, E);
        SEAM(5);
    }
    if (IN(6)) {
        pg8::Gemm g{(const bf16*)(ws + WS_MERGED), (const bf16*)(ws + WS_WOUT8), T, 1024, 512, 512, 512}; pg8::StaticOrder S; S.init(T, 1024, G, (int)blockIdx.x);
        EpiResid E{p.x, (const float*)(ws + WS_MOD) + 2048, p.out};
        for (int rep = 0; rep < NREP(6); ++rep) pg8::gemm_phase<EpiResid, pg8::StaticOrder, true, true, 120>((PG8_LAS unsigned char*)lds, g, S, E);
        SEAM(6);
    }
    if (IN(7)) { for (int rep = 0; rep < NREP(7); ++rep) normmod_phase<false>(p, lds, p.out, (bf16*)(ws + WS_H), p.norm2_g, 3 * 1024, 4 * 1024); SEAM(7); }
    if (IN(8)) {
        pg8::Gemm g{(const bf16*)(ws + WS_H), (const bf16*)(ws + WS_WQ), T, 2048, 1024, 1024, 1024}; pg8::StaticOrder S; S.init(T, 2048, G, (int)blockIdx.x);
        EpiStore E{(bf16*)(ws + WS_Q), 2048};
        for (int rep = 0; rep < NREP(8); ++rep) pg8::gemm_phase<EpiStore, pg8::StaticOrder, true, true>((PG8_LAS unsigned char*)lds, g, S, E);
        SEAM(8);
    }
    if (IN(9)) {
        int* eG = (int*)(ws + WS_EIDX); float* gG = (float*)(ws + WS_PGATE);
        peer_route_block(p, lds, eG, gG);
        asm volatile("s_waitcnt vmcnt(0)" ::: "memory");
        __syncthreads();
        _Float16* usL = (_Float16*)lds; _Float16* vsL = (_Float16*)(lds + 32768);
        for (int i = tid; i < NEXP / 8; i += NTHREADS) { ((v4u*)usL)[i] = ((const v4u*)(ws + WS_US))[i]; ((v4u*)vsL)[i] = ((const v4u*)(ws + WS_VS))[i]; }
        unsigned char* ldsw = lds + 65536 + wave * 3072;
        int ntok = 0;
        for (int tg = blockIdx.x; tg < T / 16; tg += G) ntok += 2;
        auto tok_of = [&](int j) { return ((int)blockIdx.x + (j >> 1) * G) * 16 + wave + 8 * (j & 1); };
        auto ld_lists = [&](int tok, v2u& e, v2u& g) {
            const unsigned* ep = (const unsigned*)(eG + (size_t)tok * 128 + 2 * lane); const unsigned* gp = (const unsigned*)(gG + (size_t)tok * 128 + 2 * lane);
            e.x = __hip_atomic_load(ep, __ATOMIC_RELAXED, __HIP_MEMORY_SCOPE_AGENT); e.y = __hip_atomic_load(ep + 1, __ATOMIC_RELAXED, __HIP_MEMORY_SCOPE_AGENT);
            g.x = __hip_atomic_load(gp, __ATOMIC_RELAXED, __HIP_MEMORY_SCOPE_AGENT); g.y = __hip_atomic_load(gp + 1, __ATOMIC_RELAXED, __HIP_MEMORY_SCOPE_AGENT); };
        if (ntok > 0) { v2u e0, g0; ld_lists(tok_of(0), e0, g0); *(v2u*)((int*)ldsw + 2 * lane) = e0; *(v2u*)((float*)(ldsw + 512) + 2 * lane) = g0; }
        __syncthreads();
#pragma unroll 1
        for (int j = 0; j < ntok; ++j) {
            v2u ne = {0u, 0u}, ng = {0u, 0u};
            if (j + 1 < ntok) ld_lists(tok_of(j + 1), ne, ng);
            peer_token(p, ldsw, usL, vsL, lds + 90112 + wave * 8192, tok_of(j), lane, ne, ng, j & 1);
            LDS_WAIT(); __builtin_amdgcn_wave_barrier();
        }
    }
#undef IN
#undef SEAM
}

#ifndef ONE_LAUNCH
#define ONE_LAUNCH 1
#endif
extern "C" void kernel_launch(void* const* d_in, const int* in_sizes, int n_in, void* d_out, int out_size, void* d_ws, size_t ws_size, hipStream_t stream) {
    static int grid = 0;
    if (grid == 0) {
        if (n_in != 18 || out_size != T * DM || ws_size < WS_END) { fprintf(stderr, "kernel_launch: unexpected shapes (n_in %d, out %d, ws %zu)\n", n_in, out_size, ws_size); grid = -1; return; }
        int dev = 0, cus = 0, per_cu = 0;
        if (hipGetDevice(&dev) != hipSuccess || hipDeviceGetAttribute(&cus, hipDeviceAttributeMultiprocessorCount, dev) != hipSuccess) { grid = -1; return; }
        if (hipFuncSetAttribute((const void*)mega, hipFuncAttributeMaxDynamicSharedMemorySize, LDS_BYTES) != hipSuccess) { fprintf(stderr, "kernel_launch: hipFuncSetAttribute failed\n"); grid = -1; return; }
        if (hipOccupancyMaxActiveBlocksPerMultiprocessor(&per_cu, (const void*)mega, NTHREADS, LDS_BYTES) != hipSuccess || per_cu < 1) { fprintf(stderr, "kernel_launch: occupancy query says %d\n", per_cu); grid = -1; return; }
        (void)hipGetLastError();
        grid = cus;
        if (grid < 64) { grid = -1; return; }
    }
    if (grid < 0) return;
    Params p{};
    const float** pp = (const float**)&p;
    for (int i = 0; i < 18; ++i) pp[i] = (const float*)d_in[i];
    p.out = (float*)d_out; p.ws = (unsigned char*)d_ws;
#if ONE_LAUNCH
    if (hipMemsetAsync((char*)d_ws + WS_CTL, 0, 65536, stream) != hipSuccess) { fprintf(stderr, "kernel_launch: memset failed\n"); return; }
    p.ph_lo = 0; p.ph_hi = NPHASE;
    void* args[] = {&p};
    hipError_t e = hipLaunchCooperativeKernel((const void*)mega, dim3(grid), dim3(NTHREADS), args, LDS_BYTES, stream);
    if (e != hipSuccess) fprintf(stderr, "cooperative launch failed: %s (grid %d)\n", hipGetErrorString(e), grid);
#else
    for (int k = 0; k < NPHASE; ++k) { p.ph_lo = k; p.ph_hi = k + 1; hipLaunchKernelGGL(mega, dim3(grid), dim3(NTHREADS), LDS_BYTES, stream, p); }
#endif
}
```

```cpp
#include <hip/hip_runtime.h>
#include <hip/hip_cooperative_groups.h>
#include <cstdio>
#include <cstdint>
namespace cg = cooperative_groups;

namespace pg8 {
#define PG8_LAS __attribute__((address_space(3)))
typedef unsigned short bf16_t;
typedef short bf16x8 __attribute__((ext_vector_type(8)));
typedef float f32x4 __attribute__((ext_vector_type(4)));
typedef unsigned u32x4 __attribute__((ext_vector_type(4)));
constexpr int BM = 256, BK = 64, HALF = 128, HTB = HALF * BK * 2  , STAGE_BYTES = 8 * HTB, NXCD = 8, WGM = 8;

__host__ __device__ __forceinline__ int lds_byte(int r, int c) { const int st = (r >> 4) * 2 + (c >> 5), rr = r & 15, cc = c & 31, ob = rr * 64 + cc * 2; return st * 1024 + (ob ^ (((ob >> 9) & 1) << 5)); }
__host__ __device__ __forceinline__ void stage_rc(int b, int& R, int& C) { const int st = b / 1024, sb = b % 1024, swz = sb ^ (((sb >> 9) & 1) << 5); R = (st >> 1) * 16 + swz / 64; C = (st & 1) * 32 + (swz % 64) / 2; }
__host__ __device__ __forceinline__ int perm32(int rho) { const int n = rho >> 4, i = rho & 15; return 8 * (i >> 2) + 4 * n + (i & 3); }

struct Unit { int pm, pn, ko, pass; };
struct Gemm { const bf16_t* A; const bf16_t* Bt; int M, N, K, lda, ldb; };
typedef float f32x16 __attribute__((ext_vector_type(16)));
typedef f32x16 AccW[2][2][2];
__device__ __forceinline__ f32x4 acc_get(const AccW& A, int ai, int bj, int m, int n) { const int s_ = ((m & 1) * 2 + n) * 4; const f32x16& w = A[ai][bj][m >> 1]; return (f32x4){w[s_], w[s_ + 1], w[s_ + 2], w[s_ + 3]}; }
__device__ __forceinline__ void acc_set(AccW& A, int ai, int bj, int m, int n, f32x4 v) { const int s_ = ((m & 1) * 2 + n) * 4; f32x16& w = A[ai][bj][m >> 1]; w[s_] = v[0]; w[s_ + 1] = v[1]; w[s_ + 2] = v[2]; w[s_ + 3] = v[3]; }

template <bool TWOPASS_ORDER = false>
struct StaticOrderT {
    int nM, nN, nwg, G, c, kpass;
    __host__ __device__ void init(int M, int N, int G_, int c_, int kpass_ = 512) { nM = M / BM; nN = N / BM; nwg = nM * nN; G = G_; c = c_; kpass = kpass_; }
    __host__ __device__ bool next(int i, Unit& u) const {
        const long L = (long)(TWOPASS_ORDER ? (i >> 1) : i) * G + c; if (L >= nwg) return false;
        u.pass = TWOPASS_ORDER ? (i & 1) : 0; u.ko = TWOPASS_ORDER ? (i & 1) * kpass : 0;
        int wgid = (int)L; { const int q = nwg / NXCD, r = nwg % NXCD, xcd = wgid % NXCD, off = wgid / NXCD; wgid = (xcd < r ? xcd * (q + 1) : r * (q + 1) + (xcd - r) * q) + off; }
        const int nig = WGM * nN, gid = wgid / nig, fm = gid * WGM, gsz = (nM - fm) < WGM ? (nM - fm) : WGM;
        u.pm = fm + ((wgid % nig) % gsz); u.pn = (wgid % nig) / gsz; return true;
    }
    __device__ __forceinline__ void a_ready(const Unit&) const {}
    __device__ __forceinline__ void done(const Unit&) const {}
};
typedef StaticOrderT<false> StaticOrder;

__device__ __forceinline__ unsigned cvt_pk_bf16(float lo, float hi) { unsigned r; asm volatile("v_cvt_pk_bf16_f32 %0, %1, %2" : "=v"(r) : "v"(lo), "v"(hi)); return r; }

template <class Epi, class Sched, bool ALIGN_EPI = false, bool SP2 = false, int F8SCALE = 0>
__device__ __forceinline__ void gemm_phase(PG8_LAS unsigned char* lds, const Gemm g, const Sched& S, const Epi& E) {
    const int tid = threadIdx.x, wid = __builtin_amdgcn_readfirstlane(tid >> 6), lane = tid & 63, wr = wid >> 2, wc = wid & 3, fr = lane & 15, fq = lane >> 4;
    const int K = g.K, nt = K / BK;
    unsigned voffA[2], voffB[2];
#pragma unroll
    for (int i = 0; i < 2; ++i) { int R, C; stage_rc(tid * 16 + i * 8192, R, C); const int Rb = Epi::PERM ? ((R & ~31) + perm32(R & 31)) : R;
        voffA[i] = (unsigned)(R * g.lda + C) * 2u; voffB[i] = (unsigned)(Rb * g.ldb + C) * 2u; }
    const size_t kstep = (size_t)(BK * 2);
    const size_t hstepA = (size_t)HALF * g.lda * 2, hstepB = (size_t)HALF * g.ldb * 2;
    const size_t tstepA = 2 * hstepA, tstepB = 2 * hstepB;
    const unsigned ldsw = (unsigned)wid * 1024u;
    const int aoff = lds_byte(wr * 64 + fr, fq * 8), boff = lds_byte(wc * 32 + fr, fq * 8);
#define PG8_SA(b, h) (((b) * 2 + (h)) * HTB)
#define PG8_SB(b, h) ((4 + (b) * 2 + (h)) * HTB)
#define PG8_STAGE(bufoff, gbase, voff) do { _Pragma("unroll") for (int _i = 0; _i < 2; ++_i) \
        __builtin_amdgcn_global_load_lds((const unsigned*)((const char*)(gbase) + (voff)[_i]), (PG8_LAS unsigned*)(lds + (bufoff) + ldsw + _i * 8192), 16, 0, 0); } while (0)
#define PG8_LDA(dst, b, h) do { _Pragma("unroll") for (int m = 0; m < 4; ++m) { if constexpr (F8SCALE != 0) { \
        PG8_F8(dst)[m].lo = *(const PG8_LAS v4i_f*)(lds + PG8_SA(b, h) + aoff + m * 2048); PG8_F8(dst)[m].hi = *(const PG8_LAS v4i_f*)(lds + PG8_SA(b, h) + aoff + m * 2048 + 1024); } \
        else { _Pragma("unroll") for (int k = 0; k < 2; ++k) dst[m][k] = *(const PG8_LAS bf16x8*)(lds + PG8_SA(b, h) + aoff + m * 2048 + k * 1024); } } } while (0)
#define PG8_LDB(dst, b, h) do { _Pragma("unroll") for (int n = 0; n < 2; ++n) { if constexpr (F8SCALE != 0) { \
        PG8_F8(dst)[n].lo = *(const PG8_LAS v4i_f*)(lds + PG8_SB(b, h) + boff + n * 2048); PG8_F8(dst)[n].hi = *(const PG8_LAS v4i_f*)(lds + PG8_SB(b, h) + boff + n * 2048 + 1024); } \
        else { _Pragma("unroll") for (int k = 0; k < 2; ++k) dst[n][k] = *(const PG8_LAS bf16x8*)(lds + PG8_SB(b, h) + boff + n * 2048 + k * 1024); } } } while (0)
#define PG8_MMA(ai, bj, At, Bt) do { __builtin_amdgcn_s_setprio(1); _Pragma("unroll") for (int m = 0; m < 4; ++m) _Pragma("unroll") for (int n = 0; n < 2; ++n) { \
        f32x4 _c = acc_get(accw, ai, bj, m, n); \
        if constexpr (F8SCALE != 0) { _c = __builtin_amdgcn_mfma_scale_f32_16x16x128_f8f6f4(PG8_F8(Bt)[n], PG8_F8(At)[m], _c, 0, 0, 0, 0x7f7f7f7f, 0, F8SCALE * 0x01010101); } \
        else { _Pragma("unroll") for (int k = 0; k < 2; ++k) _c = __builtin_amdgcn_mfma_f32_16x16x32_bf16(Bt[n][k], At[m][k], _c, 0, 0, 0); } \
        acc_set(accw, ai, bj, m, n, _c); } \
        __builtin_amdgcn_s_setprio(0); } while (0)
#define PG8_WAIT_V(n) asm volatile("s_waitcnt vmcnt(" #n ")" ::: "memory")
#define PG8_WAIT_L(n) asm volatile("s_waitcnt lgkmcnt(" #n ")" ::: "memory")
#define PG8_BAR __builtin_amdgcn_s_barrier()
#define PG8_SCHED __builtin_amdgcn_sched_barrier(0)
    Unit cur, nxt; int ui = 0;
    if (!S.next(0, cur)) return;
    typedef int v4i_f __attribute__((ext_vector_type(4))); typedef int v8i_f __attribute__((ext_vector_type(8))); typedef f32x16 f32x16_f;
    AccW accw;
#pragma unroll
    for (int a = 0; a < 2; ++a)
#pragma unroll
        for (int b = 0; b < 2; ++b)
#pragma unroll
            for (int mp = 0; mp < 2; ++mp)
#pragma unroll
                for (int i = 0; i < 16; ++i) accw[a][b][mp][i] = 0.f;
    bf16x8 At[4][2], B0[2][2], B1[2][2];
    v8i_f At8[4], B08[2], B18[2];
#define PG8_F8(x) x##8
    const char* cA = (const char*)g.A + (size_t)cur.pm * tstepA + (size_t)cur.ko * 2; const char* cB = (const char*)g.Bt + (size_t)cur.pn * tstepB + (size_t)cur.ko * 2;
    S.a_ready(cur);
    if constexpr (SP2) {
        PG8_STAGE(PG8_SB(0, 0), cB, voffB); PG8_STAGE(PG8_SB(0, 1), cB + hstepB, voffB); PG8_STAGE(PG8_SA(0, 0), cA, voffA); PG8_STAGE(PG8_SA(0, 1), cA + hstepA, voffA);
        if (wr == 1) PG8_BAR;
        PG8_WAIT_V(2); PG8_BAR;
        PG8_STAGE(PG8_SB(1, 0), cB + kstep, voffB); PG8_STAGE(PG8_SA(1, 0), cA + kstep, voffA); PG8_STAGE(PG8_SB(1, 1), cB + hstepB + kstep, voffB);
        PG8_WAIT_V(6); PG8_BAR;
    } else {
        PG8_STAGE(PG8_SB(0, 0), cB, voffB); PG8_STAGE(PG8_SA(0, 0), cA, voffA); PG8_STAGE(PG8_SB(0, 1), cB + hstepB, voffB); PG8_STAGE(PG8_SA(0, 1), cA + hstepA, voffA);
        if (wr == 1) PG8_BAR;
        PG8_WAIT_V(4); PG8_BAR;
        PG8_STAGE(PG8_SB(1, 0), cB + kstep, voffB); PG8_STAGE(PG8_SA(1, 0), cA + kstep, voffA); PG8_STAGE(PG8_SB(1, 1), cB + hstepB + kstep, voffB);
        PG8_WAIT_V(6); PG8_BAR;
    }
    for (;;) {
        const bool has_next = S.next(ui + 1, nxt);
        const char* nA = has_next ? (const char*)g.A + (size_t)nxt.pm * tstepA + (size_t)nxt.ko * 2 : cA; const char* nB = has_next ? (const char*)g.Bt + (size_t)nxt.pn * tstepB + (size_t)nxt.ko * 2 : cB;
        for (int t = 0; t < nt; t += 2) {
            const bool last = (t == nt - 2);
            const char* a1 = cA + (size_t)(t + 1) * kstep;
            const char* a2 = last ? nA : cA + (size_t)(t + 2) * kstep; const char* b2 = last ? nB : cB + (size_t)(t + 2) * kstep;
            const char* a3 = a2 + kstep; const char* b3 = b2 + kstep;
            if (last && has_next) S.a_ready(nxt);
            if constexpr (SP2) {
            PG8_LDB(B0, 0, 0); PG8_LDB(B1, 0, 1); PG8_SCHED; PG8_LDA(At, 0, 0); PG8_STAGE(PG8_SA(1, 1), a1 + hstepA, voffA);
            PG8_WAIT_V(8); PG8_WAIT_L(0); PG8_BAR; PG8_MMA(0, 0, At, B0); PG8_MMA(0, 1, At, B1); PG8_BAR; PG8_SCHED;
            PG8_LDA(At, 0, 1); PG8_STAGE(PG8_SB(0, 0), b2, voffB); PG8_STAGE(PG8_SB(0, 1), b2 + hstepB, voffB); PG8_STAGE(PG8_SA(0, 0), a2, voffA);
            PG8_WAIT_V(8); PG8_WAIT_L(0); PG8_BAR; PG8_MMA(1, 0, At, B0); PG8_MMA(1, 1, At, B1); PG8_BAR; PG8_SCHED;
            PG8_LDB(B0, 1, 0); PG8_LDB(B1, 1, 1); PG8_SCHED; PG8_LDA(At, 1, 0); PG8_STAGE(PG8_SA(0, 1), a2 + hstepA, voffA);
            PG8_WAIT_V(8); PG8_WAIT_L(0); PG8_BAR; PG8_MMA(0, 0, At, B0); PG8_MMA(0, 1, At, B1); PG8_BAR; PG8_SCHED;
            PG8_LDA(At, 1, 1); PG8_STAGE(PG8_SB(1, 0), b3, voffB); PG8_STAGE(PG8_SB(1, 1), b3 + hstepB, voffB); PG8_STAGE(PG8_SA(1, 0), a3, voffA);
            PG8_WAIT_V(8); PG8_WAIT_L(0); PG8_BAR; PG8_MMA(1, 0, At, B0); PG8_MMA(1, 1, At, B1); PG8_BAR; PG8_SCHED;
            } else {
            PG8_LDB(B0, 0, 0); PG8_SCHED; PG8_LDA(At, 0, 0); PG8_STAGE(PG8_SA(1, 1), a1 + hstepA, voffA);
            PG8_WAIT_L(8); PG8_BAR; PG8_WAIT_L(0); PG8_MMA(0, 0, At, B0); PG8_BAR; PG8_SCHED;
            PG8_LDB(B1, 0, 1); PG8_STAGE(PG8_SB(0, 0), b2, voffB);
            PG8_BAR; PG8_WAIT_L(0); PG8_MMA(0, 1, At, B1); PG8_BAR;
            PG8_LDA(At, 0, 1); PG8_STAGE(PG8_SA(0, 0), a2, voffA);
            PG8_BAR; PG8_WAIT_L(0); PG8_MMA(1, 0, At, B0); PG8_BAR; PG8_SCHED;
            PG8_STAGE(PG8_SB(0, 1), b2 + hstepB, voffB);
            PG8_WAIT_V(6); PG8_BAR; PG8_MMA(1, 1, At, B1); PG8_BAR;
            PG8_LDB(B0, 1, 0); PG8_SCHED; PG8_LDA(At, 1, 0); PG8_STAGE(PG8_SA(0, 1), a2 + hstepA, voffA);
            PG8_WAIT_L(8); PG8_BAR; PG8_WAIT_L(0); PG8_MMA(0, 0, At, B0); PG8_BAR; PG8_SCHED;
            PG8_LDB(B1, 1, 1); PG8_STAGE(PG8_SB(1, 0), b3, voffB);
            PG8_BAR; PG8_WAIT_L(0); PG8_MMA(0, 1, At, B1); PG8_BAR;
            PG8_LDA(At, 1, 1); PG8_STAGE(PG8_SA(1, 0), a3, voffA);
            PG8_BAR; PG8_WAIT_L(0); PG8_MMA(1, 0, At, B0); PG8_BAR; PG8_SCHED;
            PG8_STAGE(PG8_SB(1, 1), b3 + hstepB, voffB);
            PG8_WAIT_V(6); PG8_BAR; PG8_MMA(1, 1, At, B1); PG8_BAR;
            }
        }
        if constexpr (ALIGN_EPI) { if (wr == 0) PG8_BAR; }
        if constexpr (!Epi::AFTER_DRAIN) { E(accw, cur, wr, wc, fr, fq); S.done(cur); }
        const bool keep_acc = Epi::TWOPASS && (cur.pass == 0);
        if (!has_next) break;
        if (!keep_acc) {
#pragma unroll
            for (int a = 0; a < 2; ++a)
#pragma unroll
                for (int b = 0; b < 2; ++b)
#pragma unroll
                    for (int mp = 0; mp < 2; ++mp)
#pragma unroll
                        for (int i = 0; i < 16; ++i) accw[a][b][mp][i] = 0.f;
        }
        cur = nxt; cA = nA; cB = nB; ++ui;
        if constexpr (ALIGN_EPI) { if (wr == 1) PG8_BAR; }
    }
    PG8_WAIT_V(0);
    if constexpr (!ALIGN_EPI) { if (wr == 0) PG8_BAR; }
    PG8_BAR;

#undef PG8_SA
#undef PG8_SB
#undef PG8_STAGE
#undef PG8_LDA
#undef PG8_LDB
#undef PG8_MMA
#undef PG8_F8
#undef PG8_WAIT_V
#undef PG8_WAIT_L
#undef PG8_BAR
#undef PG8_SCHED
}
}


constexpr int NWAVES = 8, NTHREADS = 512;
constexpr int BATCH = 8, SEQ = 4096, T = BATCH * SEQ, DM = 1024;
constexpr int INW = 5448;
constexpr int NPROJ = 5632;
constexpr int LD_HG = 2048, LD_ATT = 768, LD_IDX = 640, LD_GATE = 2048;
constexpr int TOPK = 256;
constexpr int NEXP = 16384;
constexpr float RMS_EPS = 1e-6f;

constexpr size_t MiB = 1u << 20;
constexpr size_t WS_CTL = 0;
constexpr size_t WS_MOD = MiB / 4;
constexpr size_t WS_MODP = MiB / 2;
constexpr size_t WS_WIN = 2 * MiB;
constexpr size_t WS_WQ = 17 * MiB;
constexpr size_t WS_SK = 21 * MiB;
constexpr size_t WS_U = 22 * MiB;
constexpr size_t WS_US = 30 * MiB;
constexpr size_t WS_V = 38 * MiB;
constexpr size_t WS_VS = 46 * MiB;
constexpr size_t WS_V8 = 8 * MiB;
constexpr size_t WS_K8 = 48 * MiB;
constexpr size_t WS_QHI = 52 * MiB;
constexpr size_t WS_QLO = 68 * MiB;
constexpr size_t WS_WAB8 = 31 * MiB;
constexpr size_t WS_WOUT8 = 32 * MiB;
constexpr size_t WS_WIN8 = 33 * MiB;
constexpr size_t WS_H8 = 48 * MiB;
constexpr size_t WS_H = 86 * MiB;
constexpr size_t WS_HG = 150 * MiB;
constexpr size_t WS_ATT = 278 * MiB;
constexpr size_t WS_IDX = 326 * MiB;
constexpr size_t WS_GATE = 366 * MiB;
constexpr size_t WS_SEL = 494 * MiB;
constexpr size_t WS_EIDX = 48 * MiB;
constexpr size_t WS_PGATE = 64 * MiB;
constexpr size_t WS_END = 510 * MiB;
constexpr size_t WS_HQC = 494 * MiB;
constexpr size_t WS_HOL = 118 * MiB;
constexpr size_t WS_HSB = 2 * MiB;
constexpr size_t WS_MERGED = WS_HG;
constexpr size_t WS_Q = 214 * MiB;
constexpr int H4_NT = 2;
constexpr size_t WS_H4D = 366 * MiB;
constexpr size_t WS_H4S = 416 * MiB;

constexpr int LDS_BYTES = 163840;

typedef unsigned short bf16;
typedef unsigned v4u __attribute__((ext_vector_type(4)));
typedef unsigned v2u __attribute__((ext_vector_type(2)));
typedef float f32x4 __attribute__((ext_vector_type(4)));
typedef float f32x2 __attribute__((ext_vector_type(2)));
typedef short bf16x8 __attribute__((ext_vector_type(8)));
#define LAS __attribute__((address_space(3)))

struct Params {
    const float *x, *c, *w_ada, *b_ada, *norm1_g, *norm2_g, *w_in, *hg_lb, *hg_onorm_g, *q_norm_g, *k_norm_g,
                *w_a, *w_b, *w_out, *peer_wq, *peer_subkeys, *peer_u, *peer_v;
    float* out; unsigned char* ws; int ph_lo, ph_hi;
};

typedef __bf16 bf16x2_hw __attribute__((ext_vector_type(2)));
__device__ __forceinline__ unsigned pk2(float lo, float hi) { const f32x2 v = {lo, hi}; const bf16x2_hw b = __builtin_convertvector(v, bf16x2_hw); return __builtin_bit_cast(unsigned, b); }
__device__ __forceinline__ unsigned f2bf(float f) { return pk2(f, 0.f) & 0xffffu; }
__device__ __forceinline__ float bf2f(unsigned u16v) { return __builtin_bit_cast(float, u16v << 16); }
__device__ __forceinline__ float bflo(unsigned w) { return __builtin_bit_cast(float, w << 16); }
__device__ __forceinline__ float bfhi(unsigned w) { return __builtin_bit_cast(float, w & 0xffff0000u); }
__device__ __forceinline__ float sigmoidf_(float x) { return __builtin_amdgcn_rcpf(1.f + __expf(-x)); }
__device__ __forceinline__ float siluf_(float x) { return x * __builtin_amdgcn_rcpf(1.f + __expf(-x)); }
__device__ __forceinline__ float wave_sum(float v) {
#pragma unroll
    for (int o = 1; o < 64; o <<= 1) v += __shfl_xor(v, o);
    return v;
}
__device__ __forceinline__ float wave_max(float v) {
#pragma unroll
    for (int o = 1; o < 64; o <<= 1) v = fmaxf(v, __shfl_xor(v, o));
    return v;
}
#define LDS_WAIT() asm volatile("s_waitcnt lgkmcnt(0)" ::: "memory")
__device__ __forceinline__ unsigned pk4_fp8(float a, float b, float c, float d) { int w = __builtin_amdgcn_cvt_pk_fp8_f32(a, b, 0, false); w = __builtin_amdgcn_cvt_pk_fp8_f32(c, d, w, true); return (unsigned)w; }

__host__ __device__ __forceinline__ int proj_tile_bf16(int i) { return i < 2 ? i + 2 : i + 6; }
__host__ __device__ __forceinline__ int proj_tile_fp8(int i) { return i < 2 ? i : (i < 6 ? i + 2 : i + 8); }
struct EpiProj {
    static constexpr bool PERM = true, AFTER_DRAIN = false, TWOPASS = false;
    bf16 *HG, *ATT, *IDX, *GATE; int f8;
    __device__ __forceinline__ void operator()(pg8::AccW& acc, const pg8::Unit& u, int wr, int wc, int fr, int fq) const {
        const int pn = f8 ? proj_tile_fp8(u.pn) : proj_tile_bf16(u.pn); bf16* base; int ldc, colt, ncols;
        if (pn < 8) { base = HG; ldc = LD_HG; colt = pn * 256; ncols = LD_HG; }
        else if (pn < 11) { base = ATT; ldc = LD_ATT; colt = (pn - 8) * 256; ncols = LD_ATT; }
        else if (pn < 14) { base = IDX; ldc = LD_IDX; colt = (pn - 11) * 256; ncols = LD_IDX; }
        else { base = GATE; ldc = LD_GATE; colt = (pn - 14) * 256; ncols = LD_GATE; }
        const int row0 = u.pm * 256 + wr * 64 + fr, col0 = colt + wc * 32 + 8 * fq;
#pragma unroll
        for (int ai = 0; ai < 2; ++ai)
#pragma unroll
            for (int m = 0; m < 4; ++m) { bf16* rowp = base + (size_t)(row0 + ai * 128 + m * 16) * ldc + col0;
#pragma unroll
                for (int bj = 0; bj < 2; ++bj) { const pg8::f32x4 v0 = pg8::acc_get(acc, ai, bj, m, 0), v1 = pg8::acc_get(acc, ai, bj, m, 1);
                    v4u w; w.x = pk2(v0[0], v0[1]); w.y = pk2(v0[2], v0[3]); w.z = pk2(v1[0], v1[1]); w.w = pk2(v1[2], v1[3]);
                    if (col0 + bj * 128 < ncols) *(v4u*)(rowp + bj * 128) = w; } }
    }
};
struct EpiMerged {
    static constexpr bool PERM = true, AFTER_DRAIN = false, TWOPASS = true;
    const bf16* GATE; bf16* O;
    __device__ __forceinline__ void operator()(pg8::AccW& acc, const pg8::Unit& u, int wr, int wc, int fr, int fq) const {
        const int row0 = u.pm * 256 + wr * 64 + fr, col0 = u.pn * 256 + wc * 32 + 8 * fq;
        if (u.pass == 0) {
#pragma unroll
            for (int ai = 0; ai < 2; ++ai)
#pragma unroll
                for (int m = 0; m < 4; ++m) { const bf16* rowp = GATE + (size_t)(row0 + ai * 128 + m * 16) * LD_GATE + col0;
#pragma unroll
                    for (int bj = 0; bj < 2; ++bj) { const v4u a = *(const v4u*)(rowp + bj * 128), b = *(const v4u*)(rowp + 1024 + bj * 128);
                        float r[8];
#pragma unroll
                        for (int i = 0; i < 4; ++i) { const float a0 = bflo(a[i]), a1 = bfhi(a[i]), b0 = bflo(b[i]), b1 = bfhi(b[i]);
                            r[2 * i] = (1.f + __expf(-b0)) * __builtin_amdgcn_rcpf(1.f + __expf(-a0)); r[2 * i + 1] = (1.f + __expf(-b1)) * __builtin_amdgcn_rcpf(1.f + __expf(-a1)); }
                        { pg8::f32x4 c0 = pg8::acc_get(acc, ai, bj, m, 0), c1 = pg8::acc_get(acc, ai, bj, m, 1);
#pragma unroll
                          for (int i = 0; i < 4; ++i) { c0[i] *= r[i]; c1[i] *= r[4 + i]; }
                          pg8::acc_set(acc, ai, bj, m, 0, c0); pg8::acc_set(acc, ai, bj, m, 1, c1); } } }
        } else {
#pragma unroll
            for (int ai = 0; ai < 2; ++ai)
#pragma unroll
                for (int m = 0; m < 4; ++m) { const size_t ro = (size_t)(row0 + ai * 128 + m * 16);
#pragma unroll
                    for (int bj = 0; bj < 2; ++bj) { const v4u b = *(const v4u*)(GATE + ro * LD_GATE + 1024 + col0 + bj * 128);
                        const pg8::f32x4 v0 = pg8::acc_get(acc, ai, bj, m, 0), v1 = pg8::acc_get(acc, ai, bj, m, 1);
                        float s[8];
#pragma unroll
                        for (int i = 0; i < 4; ++i) { s[2 * i] = sigmoidf_(bflo(b[i])); s[2 * i + 1] = sigmoidf_(bfhi(b[i])); }
                        v2u w; w.x = pk4_fp8(4.f * v0[0] * s[0], 4.f * v0[1] * s[1], 4.f * v0[2] * s[2], 4.f * v0[3] * s[3]); w.y = pk4_fp8(4.f * v1[0] * s[4], 4.f * v1[1] * s[5], 4.f * v1[2] * s[6], 4.f * v1[3] * s[7]);
                        *(v2u*)((unsigned char*)O + ro * 1024 + col0 + bj * 128) = w; } }
        }
    }
};
struct EpiResid {
    static constexpr bool PERM = true, AFTER_DRAIN = false, TWOPASS = false;
    const float* X; const float* G1  ; float* O;
    __device__ __forceinline__ void operator()(pg8::AccW& acc, const pg8::Unit& u, int wr, int wc, int fr, int fq) const {
        const int row0 = u.pm * 256 + wr * 64 + fr, col0 = u.pn * 256 + wc * 32 + 8 * fq;
        const int b = (u.pm * 256) / SEQ;
        f32x4 g[2][2];
#pragma unroll
        for (int bj = 0; bj < 2; ++bj)
#pragma unroll
            for (int n = 0; n < 2; ++n) g[bj][n] = *(const f32x4*)(G1 + (size_t)b * 6144 + col0 + bj * 128 + 4 * n);
#pragma unroll
        for (int ai = 0; ai < 2; ++ai)
#pragma unroll
            for (int m = 0; m < 4; ++m) { const size_t ro = (size_t)(row0 + ai * 128 + m * 16) * DM + col0;
#pragma unroll
                for (int bj = 0; bj < 2; ++bj)
#pragma unroll
                    for (int n = 0; n < 2; ++n) { const f32x4 xv = *(const f32x4*)(X + ro + bj * 128 + 4 * n);
                        *(f32x4*)(O + ro + bj * 128 + 4 * n) = xv + g[bj][n] * pg8::acc_get(acc, ai, bj, m, n); } }
    }
};
struct EpiStore {
    static constexpr bool PERM = true, AFTER_DRAIN = false, TWOPASS = false;
    bf16* O; int ldc;
    __device__ __forceinline__ void operator()(pg8::AccW& acc, const pg8::Unit& u, int wr, int wc, int fr, int fq) const {
        const int row0 = u.pm * 256 + wr * 64 + fr, col0 = u.pn * 256 + wc * 32 + 8 * fq;
#pragma unroll
        for (int ai = 0; ai < 2; ++ai)
#pragma unroll
            for (int m = 0; m < 4; ++m) { bf16* rowp = O + (size_t)(row0 + ai * 128 + m * 16) * ldc + col0;
#pragma unroll
                for (int bj = 0; bj < 2; ++bj) { const pg8::f32x4 v0 = pg8::acc_get(acc, ai, bj, m, 0), v1 = pg8::acc_get(acc, ai, bj, m, 1);
                    v4u w; w.x = pk2(v0[0], v0[1]); w.y = pk2(v0[2], v0[3]); w.z = pk2(v1[0], v1[1]); w.w = pk2(v1[2], v1[3]);
                    *(v4u*)(rowp + bj * 128) = w; } }
    }
};

template <int MODE> __device__ __forceinline__ int srcmap(int np) {
    if (MODE == 2) np = proj_tile_bf16(np >> 8) * 256 + (np & 255);
    if (MODE == 3) np = proj_tile_fp8(np >> 8) * 256 + (np & 255);
    if (MODE >= 1) return np < 3400 ? np : (np >= 3584 ? np - 184 : -1);
    return np; }
template <int MODE>
__device__ __forceinline__ void transpose_item(const float* W, int N, bf16* WT, int ldw, int koff, float* scr, int kb, int nb, int lane) {
    const int k0 = 64 * kb, n0 = 32 * nb;
    const int sc = srcmap<MODE>(n0 + (lane & 31));
#pragma unroll 8
    for (int i = 0; i < 32; ++i) { const int kk = 2 * i + (lane >> 5); scr[kk * 33 + (lane & 31)] = (sc >= 0) ? W[(size_t)(k0 + kk) * N + sc] : 0.f; }
    LDS_WAIT(); __builtin_amdgcn_wave_barrier();
    const int c = lane & 7;
#pragma unroll
    for (int j = 0; j < 4; ++j) { const int n = (lane >> 3) + 8 * j; const float* s = scr + (8 * c) * 33 + n;
        v4u o; o.x = pk2(s[0 * 33], s[1 * 33]); o.y = pk2(s[2 * 33], s[3 * 33]); o.z = pk2(s[4 * 33], s[5 * 33]); o.w = pk2(s[6 * 33], s[7 * 33]);
        *(v4u*)(WT + (size_t)(n0 + n) * ldw + koff + k0 + 8 * c) = o; }
    LDS_WAIT(); __builtin_amdgcn_wave_barrier();
}
template <int MODE> __device__ __forceinline__ int srcmap(int np);
template <int MODE = 0>
__device__ __forceinline__ void transpose_item8(const float* W, int N, unsigned char* WT, int ldw, int koff, float scale, float* scr, int kb, int nb, int lane) {
    const int k0 = 64 * kb, n0 = 32 * nb;
    const int sc = srcmap<MODE>(n0 + (lane & 31));
#pragma unroll 8
    for (int i = 0; i < 32; ++i) { const int kk = 2 * i + (lane >> 5); scr[kk * 33 + (lane & 31)] = (sc >= 0) ? W[(size_t)(k0 + kk) * N + sc] * scale : 0.f; }
    LDS_WAIT(); __builtin_amdgcn_wave_barrier();
    const int c = lane & 3;
#pragma unroll
    for (int j = 0; j < 2; ++j) { const int n = (lane >> 2) + 16 * j; const float* sp = scr + (16 * c) * 33 + n;
        v4u o;
#pragma unroll
        for (int q = 0; q < 4; ++q) o[q] = pk4_fp8(sp[(4 * q) * 33], sp[(4 * q + 1) * 33], sp[(4 * q + 2) * 33], sp[(4 * q + 3) * 33]);
        *(v4u*)(WT + (size_t)(n0 + n) * ldw + koff + k0 + 16 * c) = o; }
    LDS_WAIT(); __builtin_amdgcn_wave_barrier();
}
__device__ __forceinline__ void convert_plain(const float* src, bf16* dst, size_t n, size_t gtid, size_t nth) {
    const size_t n8 = n / 8;
    for (size_t i = gtid; i < n8; i += nth) { const f32x4 a = ((const f32x4*)src)[2 * i], b = ((const f32x4*)src)[2 * i + 1];
        v4u o; o.x = pk2(a[0], a[1]); o.y = pk2(a[2], a[3]); o.z = pk2(b[0], b[1]); o.w = pk2(b[2], b[3]); ((v4u*)dst)[i] = o; }
}
__device__ __forceinline__ void convert_fp8(const float* src, unsigned char* dst, size_t n, float scale, size_t gtid, size_t nth) {
    const size_t n16 = n / 16;
    for (size_t i = gtid; i < n16; i += nth) { const f32x4* sp = (const f32x4*)src + 4 * i; const f32x4 a = sp[0] * scale, b = sp[1] * scale, c = sp[2] * scale, d = sp[3] * scale;
        v4u o; o.x = pk4_fp8(a[0], a[1], a[2], a[3]); o.y = pk4_fp8(b[0], b[1], b[2], b[3]); o.z = pk4_fp8(c[0], c[1], c[2], c[3]); o.w = pk4_fp8(d[0], d[1], d[2], d[3]); ((v4u*)dst)[i] = o; }
}
template <bool KKMAJOR>
__device__ __forceinline__ void convert_mxfp4(const float* src, unsigned char* dst, unsigned char* scl, size_t nrows, size_t gtid, size_t nth) {
    const size_t nblk = nrows * 32;
    for (size_t i = gtid; i < nblk; i += nth) {
        const size_t row = i >> 5; const int blk = (int)(i & 31);
        const f32x4* sp = (const f32x4*)(src + row * 1024 + blk * 32);
        f32x4 v[8]; float amax = 0.f;
#pragma unroll
        for (int j = 0; j < 8; ++j) { v[j] = sp[j]; amax = fmaxf(fmaxf(fmaxf(fabsf(v[j][0]), fabsf(v[j][1])), fmaxf(fabsf(v[j][2]), fabsf(v[j][3]))), amax); }
        int e = (int)((__builtin_bit_cast(unsigned, amax) >> 23) & 0xffu) - 127 - 2;
        if (e < -126) e = -126;
        const float inv = __builtin_bit_cast(float, (unsigned)(127 - e) << 23);
        unsigned w[4] = {0u, 0u, 0u, 0u};
#pragma unroll
        for (int j = 0; j < 8; j += 2) { unsigned t = 0u;
            t = __builtin_amdgcn_cvt_scalef32_pk_fp4_f32(t, v[j][0] * inv, v[j][1] * inv, 1.0f, 0);
            t = __builtin_amdgcn_cvt_scalef32_pk_fp4_f32(t, v[j][2] * inv, v[j][3] * inv, 1.0f, 1);
            t = __builtin_amdgcn_cvt_scalef32_pk_fp4_f32(t, v[j + 1][0] * inv, v[j + 1][1] * inv, 1.0f, 2);
            t = __builtin_amdgcn_cvt_scalef32_pk_fp4_f32(t, v[j + 1][2] * inv, v[j + 1][3] * inv, 1.0f, 3);
            w[j >> 1] = t; }
        *(v4u*)(dst + row * 512 + blk * 16) = (v4u){w[0], w[1], w[2], w[3]};
        scl[row * 32 + (KKMAJOR ? ((blk & 3) * 8 + (blk >> 2)) : blk)] = (unsigned char)(e + 127);
    }
}
__device__ __forceinline__ void convert_rowfp4(const float* src, unsigned char* dst, _Float16* scl, int row, int lane) {
    const f32x4* sp = (const f32x4*)(src + (size_t)row * 1024 + lane * 16);
    f32x4 v[4]; float amax = 0.f;
#pragma unroll
    for (int j = 0; j < 4; ++j) { v[j] = sp[j]; amax = fmaxf(fmaxf(fmaxf(fabsf(v[j][0]), fabsf(v[j][1])), fmaxf(fabsf(v[j][2]), fabsf(v[j][3]))), amax); }
    amax = wave_max(amax);
    _Float16 sh = (_Float16)(amax * (1.f / 6.f));
    float sf = (float)sh; if (!(sf > 0.f)) { sf = 1.f; sh = (_Float16)1.f; }
    const float inv = 1.f / sf;
    unsigned w[2];
#pragma unroll
    for (int j = 0; j < 2; ++j) { unsigned t = 0u;
        t = __builtin_amdgcn_cvt_scalef32_pk_fp4_f32(t, v[2 * j][0] * inv, v[2 * j][1] * inv, 1.0f, 0);
        t = __builtin_amdgcn_cvt_scalef32_pk_fp4_f32(t, v[2 * j][2] * inv, v[2 * j][3] * inv, 1.0f, 1);
        t = __builtin_amdgcn_cvt_scalef32_pk_fp4_f32(t, v[2 * j + 1][0] * inv, v[2 * j + 1][1] * inv, 1.0f, 2);
        t = __builtin_amdgcn_cvt_scalef32_pk_fp4_f32(t, v[2 * j + 1][2] * inv, v[2 * j + 1][3] * inv, 1.0f, 3);
        w[j] = t; }
    *(v2u*)(dst + (size_t)row * 512 + lane * 8) = (v2u){w[0], w[1]};
    if (lane == 0) scl[row] = sh;
}
__device__ __forceinline__ void phase0(const Params& p, unsigned char* lds) {
    const int tid = threadIdx.x, wave = tid >> 6, lane = tid & 63, G = gridDim.x;
    const int gw = blockIdx.x * NWAVES + wave, NGW = G * NWAVES;
    float* scr = (float*)(lds + wave * 16384);
    unsigned char* ws = p.ws;
    constexpr int I_IN = 16 * (2048 / 32), I_IN8 = 16 * (3584 / 32), I_A = 8 * 32, I_O = 16 * 32, I_Q = 16 * 64;
    constexpr int NT = I_IN + I_IN8 + 2 * I_A + I_O + I_Q;
    for (int it = gw; it < NT; it += NGW) {
        int r = it;
        if (r < I_IN) { transpose_item<2>(p.w_in, INW, (bf16*)(ws + WS_WIN), 1024, 0, scr, r / 64, r % 64, lane); continue; } r -= I_IN;
        if (r < I_IN8) { transpose_item8<3>(p.w_in, INW, ws + WS_WIN8, 1024, 0, 32.f, scr, r / 112, r % 112, lane); continue; } r -= I_IN8;
        if (r < I_A) { transpose_item8(p.w_a, 1024, ws + WS_WAB8, 1024, 0, 32.f, scr, r / 32, r % 32, lane); continue; } r -= I_A;
        if (r < I_A) { transpose_item8(p.w_b, 1024, ws + WS_WAB8, 1024, 512, 4.f, scr, r / 32, r % 32, lane); continue; } r -= I_A;
        if (r < I_O) { transpose_item8(p.w_out, 1024, ws + WS_WOUT8, 1024, 0, 32.f, scr, r / 32, r % 32, lane); continue; } r -= I_O;
        transpose_item<0>(p.peer_wq, 2048, (bf16*)(ws + WS_WQ), 1024, 0, scr, r / 64, r % 64, lane);
    }
    for (int it = gw; it < 96 * 8; it += NGW) {
        const int cgp = it % 96, ks = it / 96, col = cgp * 64 + lane, k0 = ks * 128;
#pragma unroll
        for (int i = 0; i < 16; ++i) { const int e = i * 64 + lane, b = e >> 7, k = e & 127; scr[e] = siluf_(p.c[b * 1024 + k0 + k]); }
        LDS_WAIT(); __builtin_amdgcn_wave_barrier();
        float acc[8];
#pragma unroll
        for (int b = 0; b < 8; ++b) acc[b] = 0.f;
#pragma unroll 4
        for (int k = 0; k < 128; ++k) { const float w = p.w_ada[(size_t)(k0 + k) * 6144 + col];
#pragma unroll
            for (int b = 0; b < 8; ++b) acc[b] += scr[b * 128 + k] * w; }
        float* mp = (float*)(ws + WS_MODP) + (size_t)ks * 8 * 6144 + col;
#pragma unroll
        for (int b = 0; b < 8; ++b) mp[b * 6144] = acc[b];
        LDS_WAIT(); __builtin_amdgcn_wave_barrier();
    }
    const size_t gtid = (size_t)blockIdx.x * NTHREADS + tid, nth = (size_t)G * NTHREADS;
    convert_plain(p.peer_subkeys, (bf16*)(ws + WS_SK), (size_t)16 * 128 * 128, gtid, nth);
    for (int it = gw; it < 2 * NEXP; it += NGW) {
        if (it < NEXP) convert_rowfp4(p.peer_u, ws + WS_U, (_Float16*)(ws + WS_US), it, lane);
        else convert_rowfp4(p.peer_v, ws + WS_V, (_Float16*)(ws + WS_VS), it - NEXP, lane);
    }
}

template <bool FIRST>
__device__ __forceinline__ void normmod_phase(const Params& p, unsigned char* lds, const float* src, bf16* dst, const float* gvec, int shift_off, int scale_off) {
    const int tid = threadIdx.x, wave = tid >> 6, lane = tid & 63, G = gridDim.x;
    unsigned char* ws = p.ws;
    float* A = (float*)lds;
    float* Bv = A + 1024;
    const float* MODP = (const float*)(ws + WS_MODP);
    float* MOD = (float*)(ws + WS_MOD);
    if (FIRST) {
        for (int e = blockIdx.x * NTHREADS + tid; e < 8 * 6144; e += G * NTHREADS) { const int col = e % 6144; float s = p.b_ada[col];
#pragma unroll
            for (int ks = 0; ks < 8; ++ks) s += MODP[(size_t)ks * 8 * 6144 + e];
            MOD[e] = s; }
    }
    int curb = -1;
    for (int chunk = blockIdx.x; chunk < T / 128; chunk += G) {
        const int b = (chunk * 128) / SEQ;
        if (b != curb) {
            __syncthreads();
            for (int col = tid; col < 1024; col += NTHREADS) {
                float sc, sh;
                if (FIRST) { sc = p.b_ada[scale_off + col]; sh = p.b_ada[shift_off + col];
#pragma unroll
                    for (int ks = 0; ks < 8; ++ks) { sc += MODP[(size_t)(ks * 8 + b) * 6144 + scale_off + col]; sh += MODP[(size_t)(ks * 8 + b) * 6144 + shift_off + col]; } }
                else { sc = MOD[b * 6144 + scale_off + col]; sh = MOD[b * 6144 + shift_off + col]; }
                A[col] = gvec[col] * (1.f + sc); Bv[col] = sh; }
            __syncthreads(); curb = b;
        }
        for (int r = wave; r < 128; r += NWAVES) {
            const size_t row = (size_t)chunk * 128 + r;
            const f32x4* xr = (const f32x4*)(src + row * DM) + lane;
            f32x4 v[4]; float s = 0.f;
#pragma unroll
            for (int j = 0; j < 4; ++j) { v[j] = xr[64 * j]; s += (v[j][0] * v[j][0] + v[j][1] * v[j][1]) + (v[j][2] * v[j][2] + v[j][3] * v[j][3]); }
            const float rstd = rsqrtf(wave_sum(s) * (1.f / DM) + RMS_EPS);
            v2u* o8 = (v2u*)(dst + row * DM) + lane;
#pragma unroll
            for (int j = 0; j < 4; ++j) { const int c0 = 4 * lane + 256 * j; const f32x4 a = *(const f32x4*)(A + c0), sh = *(const f32x4*)(Bv + c0);
                v2u o; o.x = pk2(v[j][0] * rstd * a[0] + sh[0], v[j][1] * rstd * a[1] + sh[1]); o.y = pk2(v[j][2] * rstd * a[2] + sh[2], v[j][3] * rstd * a[3] + sh[3]);
                o8[64 * j] = o;
                if (FIRST) *(unsigned*)(ws + WS_H8 + row * DM + c0) = pk4_fp8(v[j][0] * rstd * a[0] + sh[0], v[j][1] * rstd * a[1] + sh[1], v[j][2] * rstd * a[2] + sh[2], v[j][3] * rstd * a[3] + sh[3]);
                if (!FIRST) { float* st = (float*)(lds + 8192) + wave * 1056;
                    const float y0 = v[j][0] * rstd * a[0] + sh[0], y1 = v[j][1] * rstd * a[1] + sh[1], y2 = v[j][2] * rstd * a[2] + sh[2], y3 = v[j][3] * rstd * a[3] + sh[3];
                    const int pc = c0 + (c0 >> 5); st[pc] = y0; st[pc + 1] = y1; st[pc + 2] = y2; st[pc + 3] = y3; } }
            if (!FIRST) {
                const float* st = (const float*)(lds + 8192) + wave * 1056;
                LDS_WAIT(); __builtin_amdgcn_wave_barrier();
                if (lane < 32) {
                    float x[32];
#pragma unroll
                    for (int k = 0; k < 32; ++k) x[k] = st[lane * 33 + k];
#pragma unroll
                    for (int t = 0; t < H4_NT; ++t) {
                        float amax = 0.f;
#pragma unroll
                        for (int k = 0; k < 32; ++k) amax = fmaxf(amax, fabsf(x[k]));
                        int e = (int)((__builtin_bit_cast(unsigned, amax) >> 23) & 0xffu) - 127 - 2; if (e < -126) e = -126;
                        const float inv = __builtin_bit_cast(float, (unsigned)(127 - e) << 23), sc = __builtin_bit_cast(float, (unsigned)(127 + e) << 23);
                        unsigned w[4];
#pragma unroll
                        for (int r = 0; r < 4; ++r) { unsigned tw = 0u;
                            tw = __builtin_amdgcn_cvt_scalef32_pk_fp4_f32(tw, x[8 * r] * inv, x[8 * r + 1] * inv, 1.0f, 0);
                            tw = __builtin_amdgcn_cvt_scalef32_pk_fp4_f32(tw, x[8 * r + 2] * inv, x[8 * r + 3] * inv, 1.0f, 1);
                            tw = __builtin_amdgcn_cvt_scalef32_pk_fp4_f32(tw, x[8 * r + 4] * inv, x[8 * r + 5] * inv, 1.0f, 2);
                            tw = __builtin_amdgcn_cvt_scalef32_pk_fp4_f32(tw, x[8 * r + 6] * inv, x[8 * r + 7] * inv, 1.0f, 3);
                            w[r] = tw;
                            const f32x2 d0 = __builtin_amdgcn_cvt_scalef32_pk_f32_fp4(tw, 1.0f, 0), d1 = __builtin_amdgcn_cvt_scalef32_pk_f32_fp4(tw, 1.0f, 1), d2 = __builtin_amdgcn_cvt_scalef32_pk_f32_fp4(tw, 1.0f, 2), d3 = __builtin_amdgcn_cvt_scalef32_pk_f32_fp4(tw, 1.0f, 3);
                            x[8 * r] -= d0[0] * sc; x[8 * r + 1] -= d0[1] * sc; x[8 * r + 2] -= d1[0] * sc; x[8 * r + 3] -= d1[1] * sc;
                            x[8 * r + 4] -= d2[0] * sc; x[8 * r + 5] -= d2[1] * sc; x[8 * r + 6] -= d3[0] * sc; x[8 * r + 7] -= d3[1] * sc; }
                        *(v4u*)(ws + WS_H4D + (row * H4_NT + t) * 512 + lane * 16) = (v4u){w[0], w[1], w[2], w[3]};
                        *(ws + WS_H4S + (row * H4_NT + t) * 32 + (lane & 3) * 8 + (lane >> 2)) = (unsigned char)(e + 127);
                    }
                }
                LDS_WAIT(); __builtin_amdgcn_wave_barrier();
            }
        }
    }
    __syncthreads();
}

constexpr int HGL_QT = 0, HGL_KT = 17408, HGL_QE = 34816, HGL_KLT = 52224, HGL_VT = 70656, HGL_AM = 89088, HGL_DEC = 98304, HGL_TOT = 98816, HGL_SSQ = 100864;
constexpr int HG_LDR = 136;
constexpr int HG_LDC = 72;
template <int half>
__device__ __forceinline__ void hgrn_item(const Params& p, unsigned char* lds, int item) {
    const int b = item >> 2, h = item & 3;
    const int tid = threadIdx.x, w = tid >> 6, lane = tid & 63, fr = lane & 15, fq = lane >> 4;
    unsigned char* ws = p.ws;
    const bf16* HG = (const bf16*)(ws + WS_HG);
    bf16* YA = (bf16*)(ws + WS_H);
    bf16* QT = (bf16*)(lds + HGL_QT); bf16* KT = (bf16*)(lds + HGL_KT); bf16* QE = (bf16*)(lds + HGL_QE);
    bf16* KLT = (bf16*)(lds + HGL_KLT); bf16* VT = (bf16*)(lds + HGL_VT); bf16* AM = (bf16*)(lds + HGL_AM);
    float* DEC = (float*)(lds + HGL_DEC); float* TOT = (float*)(lds + HGL_TOT); float* SSQ = (float*)(lds + HGL_SSQ);
    const int pd = tid & 127, pq = tid >> 7;
    float lbv; { const float a0 = p.hg_lb[h * 128 + pd], a1 = p.hg_lb[512 + h * 128 + pd]; lbv = 1.f / (1.f + __expf(a1 - a0)); }
    const int e0 = w * 16;
    const float ogv = p.hg_onorm_g[e0 + fr];
    pg8::f32x4 S[8];
#pragma unroll
    for (int i = 0; i < 8; ++i) S[i] = (pg8::f32x4){0.f, 0.f, 0.f, 0.f};
    const size_t rowb = (size_t)b * SEQ;
    const int c0 = half * 32;
    bf16* QCg = (bf16*)(ws + WS_HQC) + (size_t)item * 2048 * 128; float* OLg = (float*)(ws + WS_HOL) + (size_t)item * 32 * 8 * 4 * 256;
    float cum = 1.f;
    unsigned short rq[16], rf[16], rv[16];
    { const bf16* gp = HG + (rowb + (size_t)c0 * 64 + pq * 16) * LD_HG + h * 128 + pd;
#pragma unroll
      for (int i = 0; i < 16; ++i) { rq[i] = gp[(size_t)i * LD_HG]; rf[i] = gp[(size_t)i * LD_HG + 512]; rv[i] = gp[(size_t)i * LD_HG + 1024]; } }
    for (int chunk = c0; chunk < c0 + 32; ++chunk) {
        const size_t row0 = rowb + (size_t)chunk * 64;
        float fq_[16], kq_[16], cs[16];
        float run = 0.f;
#pragma unroll
        for (int i = 0; i < 16; ++i) { const float f = lbv + (1.f - lbv) * sigmoidf_(bf2f(rf[i])); kq_[i] = 1.f - f; run += __logf(f); cs[i] = run; fq_[i] = siluf_(bf2f(rq[i])); }
        TOT[pq * 128 + pd] = run;
        { v4u v0, v1;
          v0.x = rv[0] | ((unsigned)rv[1] << 16); v0.y = rv[2] | ((unsigned)rv[3] << 16); v0.z = rv[4] | ((unsigned)rv[5] << 16); v0.w = rv[6] | ((unsigned)rv[7] << 16);
          v1.x = rv[8] | ((unsigned)rv[9] << 16); v1.y = rv[10] | ((unsigned)rv[11] << 16); v1.z = rv[12] | ((unsigned)rv[13] << 16); v1.w = rv[14] | ((unsigned)rv[15] << 16);
          *(v4u*)(VT + pd * HG_LDC + pq * 16) = v0; *(v4u*)(VT + pd * HG_LDC + pq * 16 + 8) = v1; }
        unsigned short rg[16];
#pragma unroll
        for (int i = 0; i < 16; ++i) rg[i] = half ? (unsigned short)0 : HG[(row0 + (i >> 2) * 16 + fq * 4 + (i & 3)) * LD_HG + 1536 + h * 128 + e0 + fr];
        if (chunk + 1 < c0 + 32) { const bf16* gp = HG + (row0 + 64 + pq * 16) * LD_HG + h * 128 + pd;
#pragma unroll
            for (int i = 0; i < 16; ++i) { rq[i] = gp[(size_t)i * LD_HG]; rf[i] = gp[(size_t)i * LD_HG + 512]; rv[i] = gp[(size_t)i * LD_HG + 1024]; } }
        __syncthreads();
        const float t0 = TOT[pd], t1 = TOT[128 + pd], t2 = TOT[256 + pd], t3 = TOT[384 + pd];
        const float base = (pq > 0 ? t0 : 0.f) + (pq > 1 ? t1 : 0.f) + (pq > 2 ? t2 : 0.f);
        const float bmid = t0 + t1, blast = (t0 + t1) + (t2 + t3);
        const float emid = __expf(bmid), elm = __expf(blast - bmid);
        if (pq == 0) DEC[pd] = __expf(blast);
        { unsigned klp[8];
#pragma unroll
          for (int i = 0; i < 16; ++i) { const float bb = base + cs[i]; const float E1 = __expf(bb - bmid), R1 = __builtin_amdgcn_rcpf(E1);
              const float qtv = fq_[i] * E1, ktv = kq_[i] * R1, qev = qtv * emid, klv = ktv * elm;
              const int srow = pq * 16 + i;
              QT[srow * HG_LDR + pd] = (bf16)f2bf(qtv); KT[srow * HG_LDR + pd] = (bf16)f2bf(ktv); QE[srow * HG_LDR + pd] = (bf16)f2bf(qev);
              if (half) QCg[((size_t)(chunk - 32) * 64 + srow) * 128 + pd] = (bf16)f2bf(qev * cum);
              if (i & 1) klp[i >> 1] |= f2bf(klv) << 16; else klp[i >> 1] = f2bf(klv); }
          *(v4u*)(KLT + pd * HG_LDC + pq * 16) = (v4u){klp[0], klp[1], klp[2], klp[3]}; *(v4u*)(KLT + pd * HG_LDC + pq * 16 + 8) = (v4u){klp[4], klp[5], klp[6], klp[7]}; }
        cum *= __expf(blast);
        __syncthreads();
#pragma unroll
        for (int tt = 0; tt < 2; ++tt) { const int id = w + 8 * tt, rt = id >> 2, ct = id & 3;
            pg8::f32x4 a = {0.f, 0.f, 0.f, 0.f};
            if (ct <= rt) {
#pragma unroll
                for (int ks = 0; ks < 4; ++ks) { const bf16x8 af = *(const bf16x8*)(QT + (rt * 16 + fr) * HG_LDR + ks * 32 + fq * 8), bfv = *(const bf16x8*)(KT + (ct * 16 + fr) * HG_LDR + ks * 32 + fq * 8);
                    a = __builtin_amdgcn_mfma_f32_16x16x32_bf16(af, bfv, a, 0, 0, 0); } }
#pragma unroll
            for (int r = 0; r < 4; ++r) { const int c = rt * 16 + fq * 4 + r, sidx = ct * 16 + fr; AM[c * HG_LDC + sidx] = (bf16)((sidx <= c) ? f2bf(a[r]) : 0u); } }
        __syncthreads();
        const bf16x8 vb0 = *(const bf16x8*)(VT + (e0 + fr) * HG_LDC + fq * 8), vb1 = *(const bf16x8*)(VT + (e0 + fr) * HG_LDC + 32 + fq * 8);
        bf16x8 sb[4];
#pragma unroll
        for (int ks = 0; ks < 4; ++ks) { v4u t; t.x = pk2(S[2 * ks][0], S[2 * ks][1]); t.y = pk2(S[2 * ks][2], S[2 * ks][3]); t.z = pk2(S[2 * ks + 1][0], S[2 * ks + 1][1]); t.w = pk2(S[2 * ks + 1][2], S[2 * ks + 1][3]); sb[ks] = __builtin_bit_cast(bf16x8, t); }
        pg8::f32x4 o[4];
#pragma unroll
        for (int rt = 0; rt < 4; ++rt) { pg8::f32x4 a = {0.f, 0.f, 0.f, 0.f};
            a = __builtin_amdgcn_mfma_f32_16x16x32_bf16(*(const bf16x8*)(AM + (rt * 16 + fr) * HG_LDC + fq * 8), vb0, a, 0, 0, 0);
            a = __builtin_amdgcn_mfma_f32_16x16x32_bf16(*(const bf16x8*)(AM + (rt * 16 + fr) * HG_LDC + 32 + fq * 8), vb1, a, 0, 0, 0);
#pragma unroll
            for (int ks = 0; ks < 4; ++ks) { const v2u lo = *(const v2u*)(QE + (rt * 16 + fr) * HG_LDR + ks * 32 + fq * 4), hi = *(const v2u*)(QE + (rt * 16 + fr) * HG_LDR + ks * 32 + 16 + fq * 4);
                const v4u t = {lo.x, lo.y, hi.x, hi.y};
                a = __builtin_amdgcn_mfma_f32_16x16x32_bf16(__builtin_bit_cast(bf16x8, t), sb[ks], a, 0, 0, 0); }
            o[rt] = a; }
#pragma unroll
        for (int dt = 0; dt < 8; ++dt) { const f32x4 dc = *(const f32x4*)(DEC + dt * 16 + fq * 4);
            pg8::f32x4 a = S[dt]; a[0] *= dc[0]; a[1] *= dc[1]; a[2] *= dc[2]; a[3] *= dc[3];
            a = __builtin_amdgcn_mfma_f32_16x16x32_bf16(*(const bf16x8*)(KLT + (dt * 16 + fr) * HG_LDC + fq * 8), vb0, a, 0, 0, 0);
            a = __builtin_amdgcn_mfma_f32_16x16x32_bf16(*(const bf16x8*)(KLT + (dt * 16 + fr) * HG_LDC + 32 + fq * 8), vb1, a, 0, 0, 0);
            S[dt] = a; }
        if (half) {
#pragma unroll
            for (int rt = 0; rt < 4; ++rt) *(pg8::f32x4*)(OLg + ((((size_t)(chunk - 32)) * 8 + w) * 4 + rt) * 256 + lane * 4) = o[rt];
            __syncthreads();
            continue;
        }
#pragma unroll
        for (int rt = 0; rt < 4; ++rt)
#pragma unroll
            for (int r = 0; r < 4; ++r) { float x = o[rt][r] * o[rt][r];
                x += __shfl_xor(x, 1); x += __shfl_xor(x, 2); x += __shfl_xor(x, 4); x += __shfl_xor(x, 8);
                if (fr == 0) SSQ[w * 64 + rt * 16 + fq * 4 + r] = x; }
        __syncthreads();
        float tot = 0.f;
#pragma unroll
        for (int ww = 0; ww < 8; ++ww) tot += SSQ[ww * 64 + lane];
        const float rstd_l = rsqrtf(tot * (1.f / 128.f) + RMS_EPS);
#pragma unroll
        for (int rt = 0; rt < 4; ++rt)
#pragma unroll
            for (int r = 0; r < 4; ++r) { const int c = rt * 16 + fq * 4 + r; const float rs = __shfl(rstd_l, c);
                const float y = o[rt][r] * rs * ogv * siluf_(bf2f(rg[rt * 4 + r]));
                ((unsigned char*)YA)[(row0 + c) * 1024 + h * 128 + e0 + fr] = (unsigned char)(__builtin_amdgcn_cvt_pk_fp8_f32(y, 0.f, 0, false) & 0xff); }
    }
    if (!half) {
#pragma unroll
        for (int ks = 0; ks < 4; ++ks) { v4u t; t.x = pk2(S[2 * ks][0], S[2 * ks][1]); t.y = pk2(S[2 * ks][2], S[2 * ks][3]); t.z = pk2(S[2 * ks + 1][0], S[2 * ks + 1][1]); t.w = pk2(S[2 * ks + 1][2], S[2 * ks + 1][3]);
            *(v4u*)(ws + WS_HSB + ((((size_t)item * 8 + w) * 4 + ks) * 64 + lane) * 16) = t; }
    }
    __syncthreads();
}
__device__ __forceinline__ void hgrn_fix(const Params& p, unsigned char* lds, int item, int c) {
    const int b = item >> 2, h = item & 3;
    const int tid = threadIdx.x, w = tid >> 6, lane = tid & 63, fr = lane & 15, fq = lane >> 4;
    unsigned char* ws = p.ws;
    const bf16* HG = (const bf16*)(ws + WS_HG);
    bf16* YA = (bf16*)(ws + WS_H);
    float* SSQ = (float*)(lds + HGL_SSQ);
    const bf16* QCg = (const bf16*)(ws + WS_HQC) + (size_t)item * 2048 * 128; const float* OLg = (const float*)(ws + WS_HOL) + (size_t)item * 32 * 8 * 4 * 256;
    const int e0 = w * 16;
    const float ogv = p.hg_onorm_g[e0 + fr];
    const size_t row0 = (size_t)b * SEQ + (size_t)(32 + c) * 64;
    bf16x8 sb[4];
#pragma unroll
    for (int ks = 0; ks < 4; ++ks) sb[ks] = __builtin_bit_cast(bf16x8, *(const v4u*)(ws + WS_HSB + ((((size_t)item * 8 + w) * 4 + ks) * 64 + lane) * 16));
    unsigned short rg[16];
#pragma unroll
    for (int i = 0; i < 16; ++i) rg[i] = HG[(row0 + (i >> 2) * 16 + fq * 4 + (i & 3)) * LD_HG + 1536 + h * 128 + e0 + fr];
    pg8::f32x4 o[4];
#pragma unroll
    for (int rt = 0; rt < 4; ++rt) { pg8::f32x4 a = *(const pg8::f32x4*)(OLg + ((((size_t)c) * 8 + w) * 4 + rt) * 256 + lane * 4);
#pragma unroll
        for (int ks = 0; ks < 4; ++ks) { const bf16* qr = QCg + ((size_t)c * 64 + rt * 16 + fr) * 128 + ks * 32;
            const v2u lo = *(const v2u*)(qr + fq * 4), hi = *(const v2u*)(qr + 16 + fq * 4);
            const v4u t = {lo.x, lo.y, hi.x, hi.y};
            a = __builtin_amdgcn_mfma_f32_16x16x32_bf16(__builtin_bit_cast(bf16x8, t), sb[ks], a, 0, 0, 0); }
        o[rt] = a; }
#pragma unroll
    for (int rt = 0; rt < 4; ++rt)
#pragma unroll
        for (int r = 0; r < 4; ++r) { float x = o[rt][r] * o[rt][r];
            x += __shfl_xor(x, 1); x += __shfl_xor(x, 2); x += __shfl_xor(x, 4); x += __shfl_xor(x, 8);
            if (fr == 0) SSQ[w * 64 + rt * 16 + fq * 4 + r] = x; }
    __syncthreads();
    float tot = 0.f;
#pragma unroll
    for (int ww = 0; ww < 8; ++ww) tot += SSQ[ww * 64 + lane];
    const float rstd_l = rsqrtf(tot * (1.f / 128.f) + RMS_EPS);
#pragma unroll
    for (int rt = 0; rt < 4; ++rt)
#pragma unroll
        for (int r = 0; r < 4; ++r) { const int cc = rt * 16 + fq * 4 + r; const float rs = __shfl(rstd_l, cc);
            const float y = o[rt][r] * rs * ogv * siluf_(bf2f(rg[rt * 4 + r]));
            ((unsigned char*)YA)[(row0 + cc) * 1024 + h * 128 + e0 + fr] = (unsigned char)(__builtin_amdgcn_cvt_pk_fp8_f32(y, 0.f, 0, false) & 0xff); }
    __syncthreads();
}

__device__ __forceinline__ unsigned f16key(float x) {
    x = x + 0.f;
    const _Float16 hx = (_Float16)x; const unsigned short bits = __builtin_bit_cast(unsigned short, hx);
    return (bits & 0x8000u) ? (unsigned)(unsigned short)(~bits) : (unsigned)(bits | 0x8000u);
}
__device__ __forceinline__ void find_bin(const unsigned* hist, int K, int lane, int& bin, int& rem) {
    const v4u hv = *(const v4u*)(hist + 4 * lane);
    const unsigned c = hv.x + hv.y + hv.z + hv.w;
    unsigned suf = c;
#pragma unroll
    for (int o = 1; o < 64; o <<= 1) { const unsigned t = __shfl_down(suf, o); if (lane + o < 64) suf += t; }
    const unsigned above = suf - c;
    const bool mine = (above < (unsigned)K) && ((unsigned)K <= suf);
    int mybin = 0, myrem = 0;
    if (mine) { unsigned ca = above; const unsigned hh[4] = {hv.x, hv.y, hv.z, hv.w}; bool found = false;
#pragma unroll
        for (int i = 3; i >= 0; --i) { if (!found) { if (ca + hh[i] >= (unsigned)K) { mybin = 4 * lane + i; myrem = K - (int)ca; found = true; } else ca += hh[i]; } } }
    const unsigned long long m = __ballot(mine);
    const int src = (int)__builtin_ctzll(m | (1ull << 63));
    bin = __shfl(mybin, src); rem = __shfl(myrem, src);
}
__device__ __forceinline__ void dsa1_item(const Params& p, unsigned char* lds, int item) {
    const int b = item >> 8, q0 = (item & 255) * 16;
    const int tid = threadIdx.x, w = tid >> 6, lane = tid & 63, fr = lane & 15, fq = lane >> 4;
    unsigned char* ws = p.ws;
    const bf16* IDX = (const bf16*)(ws + WS_IDX);
    unsigned short* Ik = (unsigned short*)lds;
    unsigned* hist1 = (unsigned*)(lds + 131072);
    unsigned* hist = (unsigned*)(lds + 131072 + 16384) + w * 256;
    const size_t rowb = (size_t)b * SEQ;
    *(v4u*)(hist1 + tid * 4) = (v4u){0u, 0u, 0u, 0u}; *(v4u*)(hist1 + 2048 + tid * 4) = (v4u){0u, 0u, 0u, 0u};
    bf16x8 Af[8][2];
    { const bf16* rp = IDX + (rowb + q0 + fr) * LD_IDX + fq * 8;
#pragma unroll
      for (int h = 0; h < 8; ++h) { Af[h][0] = *(const bf16x8*)(rp + h * 64); Af[h][1] = *(const bf16x8*)(rp + h * 64 + 32); } }
    const float idx_scale = 0.5f * 0.125f * 0.35355339059327373f;
    bf16x8 Aw[2];
    { float wa[8];
      { const v4u wq = *(const v4u*)(IDX + (rowb + q0 + fr) * LD_IDX + 576);
#pragma unroll
        for (int i = 0; i < 4; ++i) { wa[2 * i] = bflo(wq[i]) * idx_scale; wa[2 * i + 1] = bfhi(wq[i]) * idx_scale; } }
#pragma unroll
      for (int ks = 0; ks < 2; ++ks) { float cq[8];
#pragma unroll
          for (int j = 0; j < 8; ++j) cq[j] = 0.f;
#pragma unroll
          for (int h = 0; h < 8; ++h)
#pragma unroll
              for (int j = 0; j < 8; ++j) cq[j] += wa[h] * bf2f((unsigned)(unsigned short)Af[h][ks][j]);
          const v4u t = {pk2(cq[0], cq[1]), pk2(cq[2], cq[3]), pk2(cq[4], cq[5]), pk2(cq[6], cq[7])};
          Aw[ks] = __builtin_bit_cast(bf16x8, t); } }
    float wv[4][8];
#pragma unroll
    for (int r = 0; r < 4; ++r) { const v4u wq = *(const v4u*)(IDX + (rowb + q0 + fq * 4 + r) * LD_IDX + 576);
#pragma unroll
        for (int i = 0; i < 4; ++i) { wv[r][2 * i] = bflo(wq[i]) * idx_scale; wv[r][2 * i + 1] = bfhi(wq[i]) * idx_scale; } }
    const int ntiles = (q0 >> 4) + 1;
    __syncthreads();
    bf16x8 B0 = Aw[0], B1 = Aw[1];
    if (w < ntiles) { const bf16* kp = IDX + (rowb + w * 16 + fr) * LD_IDX + 512 + fq * 8; B0 = *(const bf16x8*)kp; B1 = *(const bf16x8*)(kp + 32); }
    for (int kt = w; kt < ntiles; kt += NWAVES) {
        bf16x8 nB0 = B0, nB1 = B1;
        if (kt + NWAVES < ntiles) { const bf16* kp = IDX + (rowb + (kt + NWAVES) * 16 + fr) * LD_IDX + 512 + fq * 8; nB0 = *(const bf16x8*)kp; nB1 = *(const bf16x8*)(kp + 32); }
        pg8::f32x4 lin = {0.f, 0.f, 0.f, 0.f};
        lin = __builtin_amdgcn_mfma_f32_16x16x32_bf16(Aw[0], B0, lin, 0, 0, 0);
        lin = __builtin_amdgcn_mfma_f32_16x16x32_bf16(Aw[1], B1, lin, 0, 0, 0);
        float I[4] = {lin[0], lin[1], lin[2], lin[3]};
#pragma unroll
        for (int h = 0; h < 8; ++h) { pg8::f32x4 a = {0.f, 0.f, 0.f, 0.f};
            a = __builtin_amdgcn_mfma_f32_16x16x32_bf16(Af[h][0], B0, a, 0, 0, 0);
            a = __builtin_amdgcn_mfma_f32_16x16x32_bf16(Af[h][1], B1, a, 0, 0, 0);
#pragma unroll
            for (int r = 0; r < 4; ++r) I[r] = __builtin_fmaf(wv[r][h], __builtin_fabsf(a[r]), I[r]); }
        const int kidx = kt * 16 + fr;
#pragma unroll
        for (int r = 0; r < 4; ++r) { const unsigned key = f16key(I[r]); Ik[(fq * 4 + r) * 4096 + kidx] = (unsigned short)key;
            if (kidx <= q0 + fq * 4 + r) atomicAdd(&hist1[(fq * 4 + r) * 256 + (key >> 8)], 1u); }
        B0 = nB0; B1 = nB1;
    }
    __syncthreads();
    for (int qq = w; qq < 16; qq += NWAVES) {
        const int t = q0 + qq, n = t + 1;
        unsigned short* so = (unsigned short*)(hist1 + qq * 256);
        const unsigned short* keys = Ik + qq * 4096;
        if (n <= TOPK) { for (int j = lane; j < n; j += 64) so[j] = (unsigned short)j; }
        else {
            int b1, rem1, b2, rem2;
            find_bin(hist1 + qq * 256, TOPK, lane, b1, rem1);
            *(v4u*)(hist + 4 * lane) = (v4u){0u, 0u, 0u, 0u};
            LDS_WAIT(); __builtin_amdgcn_wave_barrier();
            for (int j = lane; j < n; j += 64) { const unsigned k = keys[j]; if ((int)(k >> 8) == b1) atomicAdd(&hist[k & 255u], 1u); }
            LDS_WAIT(); __builtin_amdgcn_wave_barrier();
            find_bin(hist, rem1, lane, b2, rem2);
            const unsigned thr = ((unsigned)b1 << 8) | (unsigned)b2;
            int base = 0, eqtaken = 0;
            const unsigned long long lt = (lane == 0) ? 0ull : (~0ull >> (64 - lane));
            for (int j0 = 0; j0 < n; j0 += 64) {
                const int j = j0 + lane; const bool valid = j < n; const unsigned k = valid ? (unsigned)keys[j] : 0u;
                const bool gt = valid && k > thr, eq = valid && k == thr;
                const unsigned long long meq = __ballot(eq);
                const int erank = __popcll(meq & lt) + eqtaken;
                const bool take = gt || (eq && erank < rem2);
                const unsigned long long mt = __ballot(take);
                if (take) so[base + __popcll(mt & lt)] = (unsigned short)j;
                base += __popcll(mt); eqtaken += __popcll(meq);
            }
        }
    }
    __syncthreads();
}

__device__ __forceinline__ void qknorm_token(const Params& p, int tok, int lane) {
    const bf16* row = (const bf16*)(p.ws + WS_ATT) + (size_t)tok * LD_ATT;
    const int c8 = (lane & 7) * 8;
    { const v4u qv = *(const v4u*)(row + lane * 8);
      float x[8]; float ss = 0.f;
#pragma unroll
      for (int i = 0; i < 4; ++i) { x[2 * i] = bflo(qv[i]); x[2 * i + 1] = bfhi(qv[i]); ss += x[2 * i] * x[2 * i] + x[2 * i + 1] * x[2 * i + 1]; }
      ss += __shfl_xor(ss, 1); ss += __shfl_xor(ss, 2); ss += __shfl_xor(ss, 4);
      const float rs = rsqrtf(ss * (1.f / 64.f) + RMS_EPS) * (0.125f * 1.4426950408889634f);
#pragma unroll
      for (int i = 0; i < 8; ++i) x[i] = x[i] * rs * p.q_norm_g[c8 + i];
      v2u hw, lw;
      hw.x = pk4_fp8(x[0], x[1], x[2], x[3]); hw.y = pk4_fp8(x[4], x[5], x[6], x[7]);
      { const f32x2 d0 = __builtin_amdgcn_cvt_pk_f32_fp8((int)hw.x, false), d1 = __builtin_amdgcn_cvt_pk_f32_fp8((int)hw.x, true), d2 = __builtin_amdgcn_cvt_pk_f32_fp8((int)hw.y, false), d3 = __builtin_amdgcn_cvt_pk_f32_fp8((int)hw.y, true);
        lw.x = pk4_fp8(x[0] - d0[0], x[1] - d0[1], x[2] - d1[0], x[3] - d1[1]); lw.y = pk4_fp8(x[4] - d2[0], x[5] - d2[1], x[6] - d3[0], x[7] - d3[1]); }
      *(v2u*)(p.ws + WS_QHI + (size_t)tok * 512 + lane * 8) = hw; *(v2u*)(p.ws + WS_QLO + (size_t)tok * 512 + lane * 8) = lw; }
    { const v4u kv = *(const v4u*)(row + 512 + (lane & 15) * 8);
      float x[8]; float ss = 0.f;
#pragma unroll
      for (int i = 0; i < 4; ++i) { x[2 * i] = bflo(kv[i]); x[2 * i + 1] = bfhi(kv[i]); ss += x[2 * i] * x[2 * i] + x[2 * i + 1] * x[2 * i + 1]; }
      ss += __shfl_xor(ss, 1); ss += __shfl_xor(ss, 2); ss += __shfl_xor(ss, 4);
      const float rs = rsqrtf(ss * (1.f / 64.f) + RMS_EPS);
#pragma unroll
      for (int i = 0; i < 8; ++i) x[i] = x[i] * rs * p.k_norm_g[c8 + i];
      v2u o; o.x = pk4_fp8(x[0], x[1], x[2], x[3]); o.y = pk4_fp8(x[4], x[5], x[6], x[7]);
      if (lane < 16) *(v2u*)(p.ws + WS_K8 + (size_t)tok * 128 + lane * 8) = o; }
    { const v4u vv = *(const v4u*)(row + 640 + (lane & 15) * 8);
      v2u o; o.x = pk4_fp8(bflo(vv[0]), bfhi(vv[0]), bflo(vv[1]), bfhi(vv[1])); o.y = pk4_fp8(bflo(vv[2]), bfhi(vv[2]), bflo(vv[3]), bfhi(vv[3]));
      if (lane < 16) *(v2u*)(p.ws + WS_V8 + (size_t)tok * 128 + lane * 8) = o; }
}

typedef short v4i16_t __attribute__((ext_vector_type(4)));
__device__ __forceinline__ v4i16_t vtr16(const bf16* ldsp) { return __builtin_amdgcn_ds_read_tr16_b64_v4i16((LAS v4i16_t*)ldsp); }
typedef int v2i_t __attribute__((ext_vector_type(2)));
__device__ __forceinline__ long vtr8(const unsigned char* ldsp) { const v2i_t r = __builtin_amdgcn_ds_read_tr8_b64_v2i32((LAS v2i_t*)ldsp); return (long)(((unsigned long long)(unsigned)r[1] << 32) | (unsigned)r[0]); }
__device__ __forceinline__ void dsa2_query(const Params& p, unsigned char* ldsw, const unsigned short* sel, int b, int t, int lane) {
    unsigned char* ws = p.ws;
    const bf16* ATT = (const bf16*)(ws + WS_ATT);
    bf16* YB = (bf16*)(ws + WS_H);
    unsigned short* sl = (unsigned short*)ldsw;
    float* df = (float*)(ldsw + 512);
    unsigned char* Vl = ldsw + 1536;
    const unsigned char* V8 = ws + WS_V8;
    const int fr = lane & 15, fq = lane >> 4;
    const size_t rowb = (size_t)b * SEQ;
    const int cnt = (t + 1 < TOPK) ? (t + 1) : TOPK;
    { v2u sv = *(const v2u*)(sel + lane * 4);
      const int j0 = lane * 4;
      if (j0 >= cnt) sv.x = 0u; else if (j0 + 1 >= cnt) sv.x &= 0xffffu;
      if (j0 + 2 >= cnt) sv.y = 0u; else if (j0 + 3 >= cnt) sv.y &= 0xffffu;
      *(v2u*)(sl + lane * 4) = sv;
      f32x4 d4; d4[0] = (j0 < cnt) ? (float)(t - (int)(sv.x & 0xffffu)) : INFINITY; d4[1] = (j0 + 1 < cnt) ? (float)(t - (int)(sv.x >> 16)) : INFINITY;
      d4[2] = (j0 + 2 < cnt) ? (float)(t - (int)(sv.y & 0xffffu)) : INFINITY; d4[3] = (j0 + 3 < cnt) ? (float)(t - (int)(sv.y >> 16)) : INFINITY;
      *(f32x4*)(df + lane * 4) = d4; }
    LDS_WAIT(); __builtin_amdgcn_wave_barrier();
    const unsigned char* K8 = ws + WS_K8;
    long qhA[2] = {0, 0}, qhB[2] = {0, 0}, qlA[2] = {0, 0}, qlB[2] = {0, 0};
    if (fr < 8) { const v4u qh = *(const v4u*)(ws + WS_QHI + (rowb + t) * 512 + fr * 64 + fq * 16), ql = *(const v4u*)(ws + WS_QLO + (rowb + t) * 512 + fr * 64 + fq * 16);
        const long hA = (long)(((unsigned long long)qh.y << 32) | qh.x), hB = (long)(((unsigned long long)qh.w << 32) | qh.z), lA = (long)(((unsigned long long)ql.y << 32) | ql.x), lB = (long)(((unsigned long long)ql.w << 32) | ql.z);
        if (fr < 4) { qhA[0] = hA; qhB[0] = hB; qlA[0] = lA; qlB[0] = lB; } else { qhA[1] = hA; qhB[1] = hB; qlA[1] = lA; qlB[1] = lB; } }
    pg8::f32x4 sc[16];
    v4u vv[8];
    {
        v4u G[8];
        unsigned char* kst = Vl;
        const int ksw = ((lane & 7) ^ (lane >> 3)) & 7;
#define K_LOADS(STEP) do { _Pragma("unroll") for (int j = 0; j < 8; ++j) { const int s_ = sl[(STEP) * 64 + j * 8 + (lane >> 3)]; G[j] = *(const v4u*)(K8 + (rowb + s_) * 128 + ((ksw ^ (j & 1)) & 7) * 16); } } while (0)
        K_LOADS(0);
#pragma unroll
        for (int step = 0; step < 4; ++step) {
            LDS_WAIT(); __builtin_amdgcn_wave_barrier();
#pragma unroll
            for (int j = 0; j < 8; ++j) *(v4u*)(kst + j * 1024 + lane * 16) = G[j];
            __builtin_amdgcn_sched_barrier(0);
            if (step < 3) K_LOADS(step + 1);
            else {
#pragma unroll
                for (int j = 0; j < 8; ++j) { const int s = sl[j * 8 + (lane >> 3)]; vv[j] = *(const v4u*)(V8 + (rowb + s) * 128 + (lane & 7) * 16); } }
            __builtin_amdgcn_sched_barrier(0);
            LDS_WAIT(); __builtin_amdgcn_wave_barrier();
#pragma unroll
            for (int kt = 0; kt < 4; ++kt) { pg8::f32x4 a = {0.f, 0.f, 0.f, 0.f};
#pragma unroll
                for (int gg = 0; gg < 2; ++gg) { const v4u kv = *(const v4u*)(kst + (kt * 16 + fr) * 128 + (((gg * 4 + fq) ^ (fr & 7) ^ (fr >> 3)) & 7) * 16);
                    const long kA = (long)(((unsigned long long)kv.y << 32) | kv.x), kB = (long)(((unsigned long long)kv.w << 32) | kv.z);
                    a = __builtin_amdgcn_mfma_f32_16x16x32_fp8_fp8(kA, qhA[gg], a, 0, 0, 0); a = __builtin_amdgcn_mfma_f32_16x16x32_fp8_fp8(kB, qhB[gg], a, 0, 0, 0);
                    a = __builtin_amdgcn_mfma_f32_16x16x32_fp8_fp8(kA, qlA[gg], a, 0, 0, 0); a = __builtin_amdgcn_mfma_f32_16x16x32_fp8_fp8(kB, qlB[gg], a, 0, 0, 0); }
                sc[step * 4 + kt] = a; }
        }
#undef K_LOADS
    }
    const float slope = exp2f(-(float)((fr & 7) + 1)) * 1.4426950408889634f;
    float m = -INFINITY;
#pragma unroll
    for (int kt = 0; kt < 16; ++kt) { const f32x4 d4 = *(const f32x4*)(df + kt * 16 + fq * 4);
#pragma unroll
        for (int r = 0; r < 4; ++r) { const float x = sc[kt][r] - slope * d4[r]; sc[kt][r] = x; m = fmaxf(m, x); } }
    m = fmaxf(m, __shfl_xor(m, 16)); m = fmaxf(m, __shfl_xor(m, 32));
    float l = 0.f;
#pragma unroll
    for (int kt = 0; kt < 16; ++kt)
#pragma unroll
        for (int r = 0; r < 4; ++r) { const float e = __builtin_amdgcn_exp2f(sc[kt][r] - m); sc[kt][r] = e; l += e; }
    l += __shfl_xor(l, 16); l += __shfl_xor(l, 32);
    const float inv = 1.f / l;
    pg8::f32x4 o[2][4];
#pragma unroll
    for (int g2 = 0; g2 < 2; ++g2)
#pragma unroll
        for (int dt = 0; dt < 4; ++dt) o[g2][dt] = (pg8::f32x4){0.f, 0.f, 0.f, 0.f};
    unsigned char* vdst = Vl + ((lane & 7) >> 2) * 6400 + (lane >> 3) * 80 + (lane & 3) * 16;
#pragma unroll
    for (int ch = 0; ch < 4; ++ch) {
        LDS_WAIT(); __builtin_amdgcn_wave_barrier();
#pragma unroll
        for (int j = 0; j < 8; ++j) *(v4u*)(vdst + ((j >> 2) * 40 + ((j >> 1) & 1) * 24 + (j & 1) * 8) * 80) = vv[j];
        if (ch < 3) {
#pragma unroll
            for (int j = 0; j < 8; ++j) { const int s = sl[(ch + 1) * 64 + j * 8 + (lane >> 3)]; vv[j] = *(const v4u*)(V8 + (rowb + s) * 128 + (lane & 7) * 16); } }
        LDS_WAIT(); __builtin_amdgcn_wave_barrier();
#pragma unroll
        for (int k2 = 0; k2 < 2; ++k2) { const int kt0 = ch * 4 + 2 * k2;
            const long pb = (long)(((unsigned long long)pk4_fp8(sc[kt0 + 1][0], sc[kt0 + 1][1], sc[kt0 + 1][2], sc[kt0 + 1][3]) << 32) | pk4_fp8(sc[kt0][0], sc[kt0][1], sc[kt0][2], sc[kt0][3]));
            const int q = fr >> 1, prow = k2 * 40 + ((q < 4) ? (fq * 4 + q) : (24 + fq * 4 + (q - 4)));
#pragma unroll
            for (int g2 = 0; g2 < 2; ++g2)
#pragma unroll
                for (int dt = 0; dt < 4; ++dt) o[g2][dt] = __builtin_amdgcn_mfma_f32_16x16x32_fp8_fp8(vtr8(Vl + g2 * 6400 + prow * 80 + dt * 16 + (fr & 1) * 8), pb, o[g2][dt], 0, 0, 0); }
    }
    { const float i8 = inv * 8.f; unsigned char* yp = (unsigned char*)YB + (rowb + t) * 1024 + 512 + fr * 64 + fq * 4;
      if (fr < 4) {
#pragma unroll
          for (int dt = 0; dt < 4; ++dt) *(unsigned*)(yp + dt * 16) = pk4_fp8(o[0][dt][0] * i8, o[0][dt][1] * i8, o[0][dt][2] * i8, o[0][dt][3] * i8); }
      else if (fr < 8) {
#pragma unroll
          for (int dt = 0; dt < 4; ++dt) *(unsigned*)(yp + dt * 16) = pk4_fp8(o[1][dt][0] * i8, o[1][dt][1] * i8, o[1][dt][2] * i8, o[1][dt][3] * i8); } }
    LDS_WAIT(); __builtin_amdgcn_wave_barrier();
}

#define INS16(L, x) do { _Pragma("unroll") for (int _i = 15; _i >= 1; --_i) L[_i] = __builtin_amdgcn_fmed3f(L[_i - 1], L[_i], (x)); L[0] = fmaxf(L[0], (x)); } while (0)
__device__ __forceinline__ float f_andor(float v, unsigned keepmask, unsigned orv) { return __builtin_bit_cast(float, (__builtin_bit_cast(unsigned, v) & keepmask) | orv); }
__device__ __forceinline__ void peer_select(const Params& p, unsigned char* ldsw, int tg, int h, int lane, int* EIDX, float* GATES) {
    float* sc = (float*)ldsw;
    LDS_WAIT(); __builtin_amdgcn_wave_barrier();
    float L[16];
#pragma unroll
    for (int i = 0; i < 16; ++i) L[i] = -INFINITY;
    { const float* sp = sc + (lane & 31) * 132 + (lane >> 5) * 64;
#pragma unroll 4
      for (int i = 0; i < 16; ++i) { const f32x4 x = *(const f32x4*)(sp + 4 * i); INS16(L, x[0]); INS16(L, x[1]); INS16(L, x[2]); INS16(L, x[3]); } }
    { float O[16];
#pragma unroll
      for (int i = 0; i < 16; ++i) O[i] = __shfl_xor(L[i], 32);
#pragma unroll
      for (int i = 0; i < 16; ++i) INS16(L, O[i]); }
    LDS_WAIT(); __builtin_amdgcn_wave_barrier();
    float* lst = sc;
    if (lane < 32) {
#pragma unroll
        for (int i = 0; i < 4; ++i) *(f32x4*)(lst + lane * 16 + 4 * i) = (f32x4){L[4 * i], L[4 * i + 1], L[4 * i + 2], L[4 * i + 3]}; }
    LDS_WAIT(); __builtin_amdgcn_wave_barrier();
    const int tok = lane & 15;
    float s1[16], s2[16];
#pragma unroll
    for (int i = 0; i < 4; ++i) { const f32x4 a = *(const f32x4*)(lst + tok * 16 + 4 * i), b = *(const f32x4*)(lst + (16 + tok) * 16 + 4 * i);
#pragma unroll
        for (int c = 0; c < 4; ++c) { s1[4 * i + c] = f_andor(a[c], ~127u, 0u); s2[4 * i + c] = f_andor(b[c], ~127u, 0u); } }
    float M[16];
#pragma unroll
    for (int i = 0; i < 16; ++i) M[i] = -INFINITY;
#pragma unroll
    for (int a = 0; a < 16; ++a)
#pragma unroll
        for (int b = 0; b < 16; ++b)
            if ((a + 1) * (b + 1) <= 16) { const float key = f_andor(s1[a] + s2[b], ~255u, (unsigned)(a * 16 + b)); INS16(M, key); }
    const float mx = f_andor(M[0], ~255u, 0u);
    float e[16], sum = 0.f; int ei[16];
    const unsigned* lb = (const unsigned*)lst;
#pragma unroll
    for (int i = 0; i < 16; ++i) { const unsigned bits = __builtin_bit_cast(unsigned, M[i]); const int flat = bits & 255u;
        e[i] = __expf(f_andor(M[i], ~255u, 0u) - mx); sum += e[i];
        ei[i] = (int)(lb[tok * 16 + (flat >> 4)] & 127u) * 128 + (int)(lb[(16 + tok) * 16 + (flat & 15)] & 127u); }
    const float inv = 1.f / sum;
    if (lane < 16) {
        const size_t ob = ((size_t)tok * 8 + h) * 16;
#pragma unroll
        for (int i = 0; i < 4; ++i) { *(v4u*)(EIDX + ob + 4 * i) = (v4u){(unsigned)ei[4 * i], (unsigned)ei[4 * i + 1], (unsigned)ei[4 * i + 2], (unsigned)ei[4 * i + 3]};
            *(f32x4*)(GATES + ob + 4 * i) = (f32x4){e[4 * i] * inv, e[4 * i + 1] * inv, e[4 * i + 2] * inv, e[4 * i + 3] * inv}; }
    }
    LDS_WAIT(); __builtin_amdgcn_wave_barrier();
}

__device__ __forceinline__ void peer_route_block(const Params& p, unsigned char* lds, int* eG, float* gG) {
    const int tid = threadIdx.x, wave = tid >> 6, lane = tid & 63, fr = lane & 15, fq = lane >> 4, G = gridDim.x;
    unsigned char* ws = p.ws;
    const bf16* Q = (const bf16*)(ws + WS_Q);
    const unsigned char* SKb = ws + WS_SK;
    unsigned char* tile = lds + 8 * 16896;
    float* sc = (float*)(lds + wave * 16896);
    int ngrp = 0;
    for (int tg = blockIdx.x; tg < T / 16; tg += G) ++ngrp;
#pragma unroll 1
    for (int k0 = 0; k0 < ngrp; k0 += 8) {
        const bool valid = k0 + wave < ngrp;
        const int tg = (int)blockIdx.x + (valid ? k0 + wave : k0) * G;
        v4u t[4][2];
        bf16x8 An[2][4];
#pragma unroll
        for (int sub = 0; sub < 4; ++sub) { const unsigned char* sp = SKb + (size_t)sub * 16384 + tid * 32; t[sub][0] = *(const v4u*)sp; t[sub][1] = *(const v4u*)(sp + 16); }
#pragma unroll
        for (int pp = 0; pp < 2; ++pp) { const bf16* rp = Q + (size_t)(tg * 16 + fr) * 2048 + pp * 128 + fq * 8;
#pragma unroll
            for (int ks = 0; ks < 4; ++ks) An[pp][ks] = *(const bf16x8*)(rp + ks * 32); }
#pragma unroll 1
        for (int h = 0; h < 8; ++h) {
            bf16x8 Af[2][4];
#pragma unroll
            for (int pp = 0; pp < 2; ++pp)
#pragma unroll
                for (int ks = 0; ks < 4; ++ks) Af[pp][ks] = An[pp][ks];
            const int hn = (h + 1) & 7;
#pragma unroll
            for (int sub = 0; sub < 4; ++sub) {
                const int pp = sub >> 1, half = sub & 1;
                __syncthreads();
                { unsigned char* wp = tile + (tid >> 3) * 272 + (tid & 7) * 32; *(v4u*)wp = t[sub][0]; *(v4u*)(wp + 16) = t[sub][1]; }
                { const unsigned char* sp = SKb + (size_t)(hn * 4 + sub) * 16384 + tid * 32; t[sub][0] = *(const v4u*)sp; t[sub][1] = *(const v4u*)(sp + 16); }
                __syncthreads();
#pragma unroll
                for (int kt = 0; kt < 4; ++kt) {
                    pg8::f32x4 a = {0.f, 0.f, 0.f, 0.f};
#pragma unroll
                    for (int ks = 0; ks < 4; ++ks) { const bf16x8 bv = *(const bf16x8*)(tile + (kt * 16 + fr) * 272 + ks * 64 + fq * 16); a = __builtin_amdgcn_mfma_f32_16x16x32_bf16(Af[pp][ks], bv, a, 0, 0, 0); }
                    const int kg = (half * 4 + kt) * 16 + fr;
#pragma unroll
                    for (int r = 0; r < 4; ++r) sc[(pp * 16 + fq * 4 + r) * 132 + kg] = f_andor(a[r], ~127u, (unsigned)kg);
                }
            }
#pragma unroll
            for (int pp = 0; pp < 2; ++pp) { const bf16* rp = Q + (size_t)(tg * 16 + fr) * 2048 + hn * 256 + pp * 128 + fq * 8;
#pragma unroll
                for (int ks = 0; ks < 4; ++ks) An[pp][ks] = *(const bf16x8*)(rp + ks * 32); }
            if (valid) peer_select(p, (unsigned char*)sc, tg, h, lane, eG + (size_t)tg * 2048, gG + (size_t)tg * 2048);
        }
    }
}

__device__ __forceinline__ float gelu_erf(float x) { return 0.5f * x * (1.f + erff(x * 0.70710678118654752f)); }
typedef int v8i_t __attribute__((ext_vector_type(8)));
template <int OPSEL> __device__ __forceinline__ pg8::f32x4 mx_dot(v8i_t a, int sa, v8i_t b, int sb, pg8::f32x4 c) {
    return __builtin_amdgcn_mfma_scale_f32_16x16x128_f8f6f4(a, b, c, 4  , 4  , OPSEL, sa, OPSEL, sb);
}
__device__ __forceinline__ void peer_token(const Params& p, unsigned char* ldsw, const _Float16* usL, const _Float16* vsL, unsigned char* tile, int tok, int lane, const v2u nxt_e, const v2u nxt_g, int buf) {
    unsigned char* ws = p.ws;
    const unsigned char* V8 = ws + WS_V;
    const float* MOD = (const float*)(ws + WS_MOD);
    const int fr = lane & 15, fq = lane >> 4;
    typedef v8i_t v8i;
    const int* EIDX = (const int*)(ldsw + buf * 1024); const float* GATES = (const float*)(ldsw + buf * 1024 + 512);
    v4u A4[H4_NT][8]; v2u As[H4_NT];
#pragma unroll
    for (int t = 0; t < H4_NT; ++t) { const unsigned char* hp = ws + WS_H4D + ((size_t)tok * H4_NT + t) * 512 + fq * 16;
        As[t] = *(const v2u*)(ws + WS_H4S + ((size_t)tok * H4_NT + t) * 32 + fq * 8);
#pragma unroll
        for (int kk = 0; kk < 8; ++kk) A4[t][kk] = *(const v4u*)(hp + kk * 64); }
    int* pe = (int*)(ldsw + 2048); float* pa = (float*)(ldsw + 2048 + 512);
    const unsigned char* U4 = ws + WS_U;
    const int gr = lane >> 3, gs = lane & 7;
    const int rdbase = (fr >> 3) * 1024 + (fr & 7) * 128, slotA = (fq ^ (fr & 7) ^ (fr >> 3)) & 7;
    v4u G[8];
#define U_LOADS(CT) do { const int e0_ = EIDX[(CT) * 16 + gr], e1_ = EIDX[(CT) * 16 + 8 + gr]; \
        const unsigned char* p0_ = U4 + (size_t)e0_ * 512 + ((gs ^ gr) & 7) * 16; const unsigned char* p1_ = U4 + (size_t)e1_ * 512 + ((gs ^ gr ^ 1) & 7) * 16; \
        _Pragma("unroll") for (int kk = 0; kk < 8; ++kk) G[kk] = *(const v4u*)(((kk & 1) ? p1_ : p0_) + (kk >> 1) * 128); } while (0)
    U_LOADS(0);
#pragma unroll 1
    for (int ct = 0; ct < 8; ++ct) {
        const int eic = EIDX[ct * 16 + fr]; const float gt = GATES[ct * 16 + fr];
#pragma unroll
        for (int kk = 0; kk < 8; ++kk) *(v4u*)(tile + kk * 1024 + lane * 16) = G[kk];
        __builtin_amdgcn_sched_barrier(0);
        U_LOADS((ct + 1) & 7);
        __builtin_amdgcn_sched_barrier(0);
        LDS_WAIT(); __builtin_amdgcn_wave_barrier();
        v4u Bt[8];
#pragma unroll
        for (int j = 0; j < 8; ++j) Bt[j] = *(const v4u*)(tile + (j >> 1) * 2048 + rdbase + (((j & 1) ? (slotA ^ 4) : slotA) * 16));
        LDS_WAIT(); __builtin_amdgcn_wave_barrier();
        pg8::f32x4 ah = {0.f, 0.f, 0.f, 0.f};
#pragma unroll
        for (int kk = 0; kk < 8; ++kk) { const v4u bu = Bt[kk];
            const v8i bb = {(int)bu.x, (int)bu.y, (int)bu.z, (int)bu.w, 0, 0, 0, 0};
            const int sb = 0x7f7f7f7f;
#pragma unroll
            for (int t = 0; t < H4_NT; ++t) { const v8i aa = {(int)A4[t][kk].x, (int)A4[t][kk].y, (int)A4[t][kk].z, (int)A4[t][kk].w, 0, 0, 0, 0}; const int sa = (int)((kk < 4) ? As[t].x : As[t].y);
                if ((kk & 3) == 0) ah = mx_dot<0>(aa, sa, bb, sb, ah); else if ((kk & 3) == 1) ah = mx_dot<1>(aa, sa, bb, sb, ah); else if ((kk & 3) == 2) ah = mx_dot<2>(aa, sa, bb, sb, ah); else ah = mx_dot<3>(aa, sa, bb, sb, ah); } }
        const float dot = ah[0] * (float)usL[eic];
        if (fq == 0) { pe[ct * 16 + fr] = eic; pa[ct * 16 + fr] = gelu_erf(dot) * gt * (float)vsL[eic]; }
    }
    asm volatile("" :: "v"(G[0]), "v"(G[1]), "v"(G[2]), "v"(G[3]), "v"(G[4]), "v"(G[5]), "v"(G[6]), "v"(G[7]));
#undef U_LOADS
    __builtin_amdgcn_sched_barrier(0);
    { int* ne = (int*)(ldsw + (buf ^ 1) * 1024); float* ng = (float*)(ldsw + (buf ^ 1) * 1024 + 512);
      *(v2u*)(ne + 2 * lane) = nxt_e; *(v2u*)(ng + 2 * lane) = nxt_g; }
    const int hl = lane >> 5, bl = lane & 31;
    float acc[32];
#pragma unroll
    for (int i = 0; i < 32; ++i) acc[i] = 0.f;
    LDS_WAIT(); __builtin_amdgcn_wave_barrier();
#pragma unroll 1
    for (int ct = 0; ct < 16; ++ct)
#pragma unroll
        for (int jp = 0; jp < 4; ++jp) {
            const int idx = pe[ct * 8 + 2 * jp + hl]; const float as = pa[ct * 8 + 2 * jp + hl];
            const v4u vv = *(const v4u*)(V8 + (size_t)idx * 512 + bl * 16);
#pragma unroll
            for (int w4 = 0; w4 < 4; ++w4) { const unsigned wd = vv[w4];
                const f32x2 d0 = __builtin_amdgcn_cvt_scalef32_pk_f32_fp4(wd, 1.0f, 0), d1 = __builtin_amdgcn_cvt_scalef32_pk_f32_fp4(wd, 1.0f, 1), d2 = __builtin_amdgcn_cvt_scalef32_pk_f32_fp4(wd, 1.0f, 2), d3 = __builtin_amdgcn_cvt_scalef32_pk_f32_fp4(wd, 1.0f, 3);
                acc[8 * w4] += as * d0[0]; acc[8 * w4 + 1] += as * d0[1]; acc[8 * w4 + 2] += as * d1[0]; acc[8 * w4 + 3] += as * d1[1];
                acc[8 * w4 + 4] += as * d2[0]; acc[8 * w4 + 5] += as * d2[1]; acc[8 * w4 + 6] += as * d3[0]; acc[8 * w4 + 7] += as * d3[1]; }
        }
    LDS_WAIT(); __builtin_amdgcn_wave_barrier();
    float accs[16];
#pragma unroll
    for (int i = 0; i < 16; ++i) { const float lo = acc[i] + __shfl_xor(acc[i], 32), hi2 = acc[16 + i] + __shfl_xor(acc[16 + i], 32); accs[i] = hl ? hi2 : lo; }
    const int b = tok / SEQ;
    const int col0 = bl * 32 + hl * 16;
    const float* g2 = MOD + (size_t)b * 6144 + 5 * 1024 + col0;
    float* orow = p.out + (size_t)tok * DM + col0;
#pragma unroll
    for (int q4 = 0; q4 < 4; ++q4) { const f32x4 xv = *(const f32x4*)(orow + 4 * q4), gv = *(const f32x4*)(g2 + 4 * q4);
        f32x4 o;
#pragma unroll
        for (int i = 0; i < 4; ++i) o[i] = xv[i] + gv[i] * accs[4 * q4 + i];
        *(f32x4*)(orow + 4 * q4) = o; }
}

#define XB_TMO      128
#define XB_XCNT(j)  (256  + 64 * (j))
#define XB_XSUB(j)  (1280 + 64 * (j))
#define XB_XGEN(j)  (2304 + 64 * (j))
#define XB_TOP      3328
#define XB_TOPGEN   3392
#define XCD_BAR_WORDS 3456
#define XB_SPIN_CAP (1u << 18)

__device__ __forceinline__ unsigned xb_ld(unsigned* p)              { return __hip_atomic_load(p, __ATOMIC_RELAXED, __HIP_MEMORY_SCOPE_AGENT); }
__device__ __forceinline__ unsigned xb_add(unsigned* p, unsigned v) { return __hip_atomic_fetch_add(p, v, __ATOMIC_RELAXED, __HIP_MEMORY_SCOPE_AGENT); }
__device__ __forceinline__ unsigned xb_xcc_id() { return (unsigned)__builtin_amdgcn_s_getreg((3 << 11) | 20) & 0xFu; }
#define XB_SPIN(cond, bar) do { unsigned _sp = 0; while (cond) { __builtin_amdgcn_s_sleep(1); \
    if ((++_sp & 255u) == 0u) { if (xb_ld(&(bar)[XB_TMO])) break; if (_sp > XB_SPIN_CAP) { atomicAdd(&(bar)[XB_TMO], 1u); break; } } } } while (0)

struct XcdBarrier {
    unsigned* bar; unsigned x;
    volatile LAS unsigned* st;
};

__device__ __forceinline__ XcdBarrier xcd_barrier_post(unsigned* bar, volatile LAS unsigned* st) {
    XcdBarrier b; b.bar = bar; b.x = xb_xcc_id(); b.st = st;
    if (threadIdx.x == 0) (void)xb_add(&bar[XB_XCNT(b.x)], 1u);
    return b;
}
__device__ __forceinline__ void xcd_barrier_complete(unsigned* bar, unsigned x, unsigned& nloc, unsigned& nx) {
    const unsigned G = gridDim.x * gridDim.y * gridDim.z;
    unsigned sum, cnt, mine, sp = 0u;
    for (;;) {
        sum = 0u; cnt = 0u; mine = 0u;
#pragma unroll
        for (unsigned j = 0; j < 16; ++j) { const unsigned c = xb_ld(&bar[XB_XCNT(j)]); sum += c; cnt += (c > 0u) ? 1u : 0u; mine = (j == x) ? c : mine; }
        if (sum == G) break;
        __builtin_amdgcn_s_sleep(1);
        if ((++sp & 255u) == 0u) { if (xb_ld(&bar[XB_TMO])) break; if (sp > XB_SPIN_CAP) { atomicAdd(&bar[XB_TMO], 1u); break; } }
    }
    nloc = mine > 0u ? mine : 1u; nx = cnt > 0u ? cnt : 1u;
}

__device__ __forceinline__ void xcd_barrier(const XcdBarrier& b) {
    asm volatile("s_waitcnt vmcnt(0)" ::: "memory");
    __syncthreads();
    if (threadIdx.x == 0) {
        unsigned* bar = b.bar;
        __builtin_amdgcn_s_waitcnt(0);
        unsigned nloc = b.st[0], nx = b.st[1];
        if (nloc == 0u) { xcd_barrier_complete(bar, b.x, nloc, nx); b.st[0] = nloc; b.st[1] = nx; }
        const unsigned old = xb_add(&bar[XB_XSUB(b.x)], 1u);
        const unsigned gen = old / nloc;
        if (old + 1u == (gen + 1u) * nloc) {
            __builtin_amdgcn_fence(__ATOMIC_RELEASE, "agent");
            asm volatile("s_waitcnt vmcnt(0)" ::: "memory");
            const unsigned og = xb_add(&bar[XB_TOP], 1u);
            const unsigned tg = og / nx;
            if (og + 1u == (tg + 1u) * nx) xb_add(&bar[XB_TOPGEN], 1u);
            else XB_SPIN(xb_ld(&bar[XB_TOPGEN]) == tg, bar);
            __builtin_amdgcn_fence(__ATOMIC_ACQUIRE, "agent");
            xb_add(&bar[XB_XGEN(b.x)], 1u);
            asm volatile("s_waitcnt vmcnt(0)" ::: "memory");
        } else {
            XB_SPIN(xb_ld(&bar[XB_XGEN(b.x)]) == gen, bar);
            __builtin_amdgcn_fence(__ATOMIC_ACQUIRE, "agent");
            asm volatile("s_waitcnt vmcnt(0)" ::: "memory");
        }
    }
    __syncthreads();
}

constexpr int NPHASE = 11;
__global__ void __launch_bounds__(NTHREADS, 2) mega(Params p) {
    extern __shared__ __attribute__((aligned(16))) unsigned char lds[];
    cg::grid_group grid = cg::this_grid();
    const int lo = p.ph_lo, hi = p.ph_hi;
    const int tid = threadIdx.x, wave = tid >> 6, lane = tid & 63, G = gridDim.x;
    unsigned char* ws = p.ws;
#ifndef ONLYPH
#define IN(k) (lo <= (k) && (k) < hi)
#else
#define IN(k) ((k) == ONLYPH && lo <= (k) && (k) < hi)
#endif
    volatile LAS unsigned* xb_st = (volatile LAS unsigned*)((LAS unsigned char*)lds + (LDS_BYTES - 16));
    if (tid < 4) xb_st[tid] = 0u;
    __syncthreads();
    XcdBarrier xbar; xbar.bar = (unsigned*)(ws + WS_CTL); xbar.x = 0; xbar.st = xb_st;
    if (hi - lo > 1) xbar = xcd_barrier_post((unsigned*)(ws + WS_CTL), xb_st);
    if (lo < -1) grid.sync();
#define SEAM(k) do { if (IN((k) + 1)) xcd_barrier(xbar); } while (0)
#ifndef REPMASK
#define REPMASK 0
#endif
#define NREP(k) (((REPMASK >> (k)) & 1) ? 2 : 1)
    if (IN(0)) { for (int rep = 0; rep < NREP(0); ++rep) phase0(p, lds); SEAM(0); }
    if (IN(1)) { for (int rep = 0; rep < NREP(1); ++rep) normmod_phase<true>(p, lds, p.x, (bf16*)(ws + WS_H), p.norm1_g, 0, 1024); SEAM(1); }
    if (IN(2)) {
        { pg8::Gemm g{(const bf16*)(ws + WS_H8), (const bf16*)(ws + WS_WIN8), T, 3584, 512, 512, 512}; pg8::StaticOrder S; S.init(T, 3584, G, (int)blockIdx.x);
          EpiProj E{(bf16*)(ws + WS_HG), (bf16*)(ws + WS_ATT), (bf16*)(ws + WS_IDX), (bf16*)(ws + WS_GATE), 1};
          pg8::gemm_phase<EpiProj, pg8::StaticOrder, true, true, 122>((PG8_LAS unsigned char*)lds, g, S, E); }
        { pg8::Gemm g{(const bf16*)(ws + WS_H), (const bf16*)(ws + WS_WIN), T, 2048, 1024, 1024, 1024}; pg8::StaticOrder S; S.init(T, 2048, G, (int)blockIdx.x);
          EpiProj E{(bf16*)(ws + WS_HG), (bf16*)(ws + WS_ATT), (bf16*)(ws + WS_IDX), (bf16*)(ws + WS_GATE), 0};
          pg8::gemm_phase<EpiProj, pg8::StaticOrder, true, true>((PG8_LAS unsigned char*)lds, g, S, E); }
        SEAM(2);
    }
    if (IN(3)) {
        for (int tok = (int)blockIdx.x * NWAVES + wave; tok < T; tok += G * NWAVES) qknorm_token(p, tok, lane);
        SEAM(3);
    }
    if (IN(4)) {
        if ((int)blockIdx.x < 32) hgrn_item<0>(p, lds, (int)blockIdx.x); else if ((int)blockIdx.x < 64) hgrn_item<1>(p, lds, (int)blockIdx.x - 32);
        {
            unsigned* qctr = (unsigned*)(ws + WS_CTL + 32768);
            volatile LAS unsigned* qslot = (volatile LAS unsigned*)((LAS unsigned char*)lds + (LDS_BYTES - 32));
            int qsel = (int)(blockIdx.x & 7u), tried = 0;
            for (;;) {
                if (tid == 0) { unsigned c;
                    for (;;) { c = __hip_atomic_fetch_add(qctr + qsel * 64, 1u, __ATOMIC_RELAXED, __HIP_MEMORY_SCOPE_AGENT); if (c < (unsigned)(SEQ / 16) || tried >= 7) break; qsel = (qsel + 1) & 7; ++tried; }
                    *qslot = (c < (unsigned)(SEQ / 16)) ? (((unsigned)qsel << 16) | c) : 0xffffffffu; }
                __syncthreads();
                const unsigned c = *qslot;
                __syncthreads();
                if (c == 0xffffffffu) break;
                const int b = (int)(c >> 16), qblk = (SEQ / 16 - 1) - (int)(c & 0xffffu), it = b * (SEQ / 16) + qblk, q0 = qblk * 16;
                dsa1_item(p, lds, it);
#pragma unroll 1
                for (int k2 = 0; k2 < 2; ++k2) dsa2_query(p, lds + wave * 16384, (const unsigned short*)(lds + 131072 + (wave + 8 * k2) * 1024), b, q0 + wave + 8 * k2, lane);
                __syncthreads();
            }
        }
        if (hi - lo > 1) xcd_barrier(xbar);
        for (int u = blockIdx.x; u < 32 * 32; u += G) hgrn_fix(p, lds, u >> 5, u & 31);
        SEAM(4);
    }
    if (IN(5)) {
        pg8::Gemm g{(const bf16*)(ws + WS_H), (const bf16*)(ws + WS_WAB8), T, 1024, 256, 512, 512}; pg8::StaticOrderT<true> S; S.init(T, 1024, G, (int)blockIdx.x, 256);
        EpiMerged E{(const bf16*)(ws + WS_GATE), (bf16*)(ws + WS_MERGED)};
        for (int rep = 0; rep < NREP(5); ++rep) pg8::gemm_phase<EpiMerged, pg8::StaticOrderT<true>, true, true, 122>((PG8_LAS unsigned char*)lds, g, S, E);
        SEAM(5);
    }
    if (IN(6)) {
        pg8::Gemm g{(const bf16*)(ws + WS_MERGED), (const bf16*)(ws + WS_WOUT8), T, 1024, 512, 512, 512}; pg8::StaticOrder S; S.init(T, 1024, G, (int)blockIdx.x);
        EpiResid E{p.x, (const float*)(ws + WS_MOD) + 2048, p.out};
        for (int rep = 0; rep < NREP(6); ++rep) pg8::gemm_phase<EpiResid, pg8::StaticOrder, true, true, 120>((PG8_LAS unsigned char*)lds, g, S, E);
        SEAM(6);
    }
    if (IN(7)) { for (int rep = 0; rep < NREP(7); ++rep) normmod_phase<false>(p, lds, p.out, (bf16*)(ws + WS_H), p.norm2_g, 3 * 1024, 4 * 1024); SEAM(7); }
    if (IN(8)) {
        pg8::Gemm g{(const bf16*)(ws + WS_H), (const bf16*)(ws + WS_WQ), T, 2048, 1024, 1024, 1024}; pg8::StaticOrder S; S.init(T, 2048, G, (int)blockIdx.x);
        EpiStore E{(bf16*)(ws + WS_Q), 2048};
        for (int rep = 0; rep < NREP(8); ++rep) pg8::gemm_phase<EpiStore, pg8::StaticOrder, true, true>((PG8_LAS unsigned char*)lds, g, S, E);
        SEAM(8);
    }
    if (IN(9)) {
        int* eG = (int*)(ws + WS_EIDX); float* gG = (float*)(ws + WS_PGATE);
        peer_route_block(p, lds, eG, gG);
        asm volatile("s_waitcnt vmcnt(0)" ::: "memory");
        __syncthreads();
        _Float16* usL = (_Float16*)lds; _Float16* vsL = (_Float16*)(lds + 32768);
        for (int i = tid; i < NEXP / 8; i += NTHREADS) { ((v4u*)usL)[i] = ((const v4u*)(ws + WS_US))[i]; ((v4u*)vsL)[i] = ((const v4u*)(ws + WS_VS))[i]; }
        unsigned char* ldsw = lds + 65536 + wave * 3072;
        int ntok = 0;
        for (int tg = blockIdx.x; tg < T / 16; tg += G) ntok += 2;
        auto tok_of = [&](int j) { return ((int)blockIdx.x + (j >> 1) * G) * 16 + wave + 8 * (j & 1); };
        auto ld_lists = [&](int tok, v2u& e, v2u& g) {
            const unsigned* ep = (const unsigned*)(eG + (size_t)tok * 128 + 2 * lane); const unsigned* gp = (const unsigned*)(gG + (size_t)tok * 128 + 2 * lane);
            e.x = __hip_atomic_load(ep, __ATOMIC_RELAXED, __HIP_MEMORY_SCOPE_AGENT); e.y = __hip_atomic_load(ep + 1, __ATOMIC_RELAXED, __HIP_MEMORY_SCOPE_AGENT);
            g.x = __hip_atomic_load(gp, __ATOMIC_RELAXED, __HIP_MEMORY_SCOPE_AGENT); g.y = __hip_atomic_load(gp + 1, __ATOMIC_RELAXED, __HIP_MEMORY_SCOPE_AGENT); };
        if (ntok > 0) { v2u e0, g0; ld_lists(tok_of(0), e0, g0); *(v2u*)((int*)ldsw + 2 * lane) = e0; *(v2u*)((float*)(ldsw + 512) + 2 * lane) = g0; }
        __syncthreads();
#pragma unroll 1
        for (int j = 0; j < ntok; ++j) {
            v2u ne = {0u, 0u}, ng = {0u, 0u};
            if (j + 1 < ntok) ld_lists(tok_of(j + 1), ne, ng);
            peer_token(p, ldsw, usL, vsL, lds + 90112 + wave * 8192, tok_of(j), lane, ne, ng, j & 1);
            LDS_WAIT(); __builtin_amdgcn_wave_barrier();
        }
    }
#undef IN
#undef SEAM
}

#ifndef ONE_LAUNCH
#define ONE_LAUNCH 1
#endif
extern "C" void kernel_launch(void* const* d_in, const int* in_sizes, int n_in, void* d_out, int out_size, void* d_ws, size_t ws_size, hipStream_t stream) {
    static int grid = 0;
    if (grid == 0) {
        if (n_in != 18 || out_size != T * DM || ws_size < WS_END) { fprintf(stderr, "kernel_launch: unexpected shapes (n_in %d, out %d, ws %zu)\n", n_in, out_size, ws_size); grid = -1; return; }
        int dev = 0, cus = 0, per_cu = 0;
        if (hipGetDevice(&dev) != hipSuccess || hipDeviceGetAttribute(&cus, hipDeviceAttributeMultiprocessorCount, dev) != hipSuccess) { grid = -1; return; }
        if (hipFuncSetAttribute((const void*)mega, hipFuncAttributeMaxDynamicSharedMemorySize, LDS_BYTES) != hipSuccess) { fprintf(stderr, "kernel_launch: hipFuncSetAttribute failed\n"); grid = -1; return; }
        if (hipOccupancyMaxActiveBlocksPerMultiprocessor(&per_cu, (const void*)mega, NTHREADS, LDS_BYTES) != hipSuccess || per_cu < 1) { fprintf(stderr, "kernel_launch: occupancy query says %d\n", per_cu); grid = -1; return; }
        (void)hipGetLastError();
        grid = cus;
        if (grid < 64) { grid = -1; return; }
    }
    if (grid < 0) return;
    Params p{};
    const float** pp = (const float**)&p;
    for (int i = 0; i < 18; ++i) pp[i] = (const float*)d_in[i];
    p.out = (float*)d_out; p.ws = (unsigned char*)d_ws;
#if ONE_LAUNCH
    if (hipMemsetAsync((char*)d_ws + WS_CTL, 0, 65536, stream) != hipSuccess) { fprintf(stderr, "kernel_launch: memset failed\n"); return; }
    p.ph_lo = 0; p.ph_hi = NPHASE;
    void* args[] = {&p};
    hipError_t e = hipLaunchCooperativeKernel((const void*)mega, dim3(grid), dim3(NTHREADS), args, LDS_BYTES, stream);
    if (e != hipSuccess) fprintf(stderr, "cooperative launch failed: %s (grid %d)\n", hipGetErrorString(e), grid);
#else
    for (int k = 0; k < NPHASE; ++k) { p.ph_lo = k; p.ph_hi = k + 1; hipLaunchKernelGGL(mega, dim3(grid), dim3(NTHREADS), LDS_BYTES, stream, p); }
#endif
}
```

```cpp
#include <hip/hip_runtime.h>
#include <hip/hip_cooperative_groups.h>
#include <cstdio>
#include <cstdint>
namespace cg = cooperative_groups;

namespace pg8 {
#define PG8_LAS __attribute__((address_space(3)))
typedef unsigned short bf16_t;
typedef short bf16x8 __attribute__((ext_vector_type(8)));
typedef float f32x4 __attribute__((ext_vector_type(4)));
typedef unsigned u32x4 __attribute__((ext_vector_type(4)));
constexpr int BM = 256, BK = 64, HALF = 128, HTB = HALF * BK * 2  , STAGE_BYTES = 8 * HTB, NXCD = 8, WGM = 8;

__host__ __device__ __forceinline__ int lds_byte(int r, int c) { const int st = (r >> 4) * 2 + (c >> 5), rr = r & 15, cc = c & 31, ob = rr * 64 + cc * 2; return st * 1024 + (ob ^ (((ob >> 9) & 1) << 5)); }
__host__ __device__ __forceinline__ void stage_rc(int b, int& R, int& C) { const int st = b / 1024, sb = b % 1024, swz = sb ^ (((sb >> 9) & 1) << 5); R = (st >> 1) * 16 + swz / 64; C = (st & 1) * 32 + (swz % 64) / 2; }
__host__ __device__ __forceinline__ int perm32(int rho) { const int n = rho >> 4, i = rho & 15; return 8 * (i >> 2) + 4 * n + (i & 3); }

struct Unit { int pm, pn, ko, pass; };
struct Gemm { const bf16_t* A; const bf16_t* Bt; int M, N, K, lda, ldb; };
typedef float f32x16 __attribute__((ext_vector_type(16)));
typedef f32x16 AccW[2][2][2];
__device__ __forceinline__ f32x4 acc_get(const AccW& A, int ai, int bj, int m, int n) { const int s_ = ((m & 1) * 2 + n) * 4; const f32x16& w = A[ai][bj][m >> 1]; return (f32x4){w[s_], w[s_ + 1], w[s_ + 2], w[s_ + 3]}; }
__device__ __forceinline__ void acc_set(AccW& A, int ai, int bj, int m, int n, f32x4 v) { const int s_ = ((m & 1) * 2 + n) * 4; f32x16& w = A[ai][bj][m >> 1]; w[s_] = v[0]; w[s_ + 1] = v[1]; w[s_ + 2] = v[2]; w[s_ + 3] = v[3]; }

template <bool TWOPASS_ORDER = false>
struct StaticOrderT {
    int nM, nN, nwg, G, c, kpass;
    __host__ __device__ void init(int M, int N, int G_, int c_, int kpass_ = 512) { nM = M / BM; nN = N / BM; nwg = nM * nN; G = G_; c = c_; kpass = kpass_; }
    __host__ __device__ bool next(int i, Unit& u) const {
        const long L = (long)(TWOPASS_ORDER ? (i >> 1) : i) * G + c; if (L >= nwg) return false;
        u.pass = TWOPASS_ORDER ? (i & 1) : 0; u.ko = TWOPASS_ORDER ? (i & 1) * kpass : 0;
        int wgid = (int)L; { const int q = nwg / NXCD, r = nwg % NXCD, xcd = wgid % NXCD, off = wgid / NXCD; wgid = (xcd < r ? xcd * (q + 1) : r * (q + 1) + (xcd - r) * q) + off; }
        const int nig = WGM * nN, gid = wgid / nig, fm = gid * WGM, gsz = (nM - fm) < WGM ? (nM - fm) : WGM;
        u.pm = fm + ((wgid % nig) % gsz); u.pn = (wgid % nig) / gsz; return true;
    }
    __device__ __forceinline__ void a_ready(const Unit&) const {}
    __device__ __forceinline__ void done(const Unit&) const {}
};
typedef StaticOrderT<false> StaticOrder;

__device__ __forceinline__ unsigned cvt_pk_bf16(float lo, float hi) { unsigned r; asm volatile("v_cvt_pk_bf16_f32 %0, %1, %2" : "=v"(r) : "v"(lo), "v"(hi)); return r; }

template <class Epi, class Sched, bool ALIGN_EPI = false, bool SP2 = false, int F8SCALE = 0>
__device__ __forceinline__ void gemm_phase(PG8_LAS unsigned char* lds, const Gemm g, const Sched& S, const Epi& E) {
    const int tid = threadIdx.x, wid = __builtin_amdgcn_readfirstlane(tid >> 6), lane = tid & 63, wr = wid >> 2, wc = wid & 3, fr = lane & 15, fq = lane >> 4;
    const int K = g.K, nt = K / BK;
    unsigned voffA[2], voffB[2];
#pragma unroll
    for (int i = 0; i < 2; ++i) { int R, C; stage_rc(tid * 16 + i * 8192, R, C); const int Rb = Epi::PERM ? ((R & ~31) + perm32(R & 31)) : R;
        voffA[i] = (unsigned)(R * g.lda + C) * 2u; voffB[i] = (unsigned)(Rb * g.ldb + C) * 2u; }
    const size_t kstep = (size_t)(BK * 2);
    const size_t hstepA = (size_t)HALF * g.lda * 2, hstepB = (size_t)HALF * g.ldb * 2;
    const size_t tstepA = 2 * hstepA, tstepB = 2 * hstepB;
    const unsigned ldsw = (unsigned)wid * 1024u;
    const int aoff = lds_byte(wr * 64 + fr, fq * 8), boff = lds_byte(wc * 32 + fr, fq * 8);
#define PG8_SA(b, h) (((b) * 2 + (h)) * HTB)
#define PG8_SB(b, h) ((4 + (b) * 2 + (h)) * HTB)
#define PG8_STAGE(bufoff, gbase, voff) do { _Pragma("unroll") for (int _i = 0; _i < 2; ++_i) \
        __builtin_amdgcn_global_load_lds((const unsigned*)((const char*)(gbase) + (voff)[_i]), (PG8_LAS unsigned*)(lds + (bufoff) + ldsw + _i * 8192), 16, 0, 0); } while (0)
#define PG8_LDA(dst, b, h) do { _Pragma("unroll") for (int m = 0; m < 4; ++m) { if constexpr (F8SCALE != 0) { \
        PG8_F8(dst)[m].lo = *(const PG8_LAS v4i_f*)(lds + PG8_SA(b, h) + aoff + m * 2048); PG8_F8(dst)[m].hi = *(const PG8_LAS v4i_f*)(lds + PG8_SA(b, h) + aoff + m * 2048 + 1024); } \
        else { _Pragma("unroll") for (int k = 0; k < 2; ++k) dst[m][k] = *(const PG8_LAS bf16x8*)(lds + PG8_SA(b, h) + aoff + m * 2048 + k * 1024); } } } while (0)
#define PG8_LDB(dst, b, h) do { _Pragma("unroll") for (int n = 0; n < 2; ++n) { if constexpr (F8SCALE != 0) { \
        PG8_F8(dst)[n].lo = *(const PG8_LAS v4i_f*)(lds + PG8_SB(b, h) + boff + n * 2048); PG8_F8(dst)[n].hi = *(const PG8_LAS v4i_f*)(lds + PG8_SB(b, h) + boff + n * 2048 + 1024); } \
        else { _Pragma("unroll") for (int k = 0; k < 2; ++k) dst[n][k] = *(const PG8_LAS bf16x8*)(lds + PG8_SB(b, h) + boff + n * 2048 + k * 1024); } } } while (0)
#define PG8_MMA(ai, bj, At, Bt) do { __builtin_amdgcn_s_setprio(1); _Pragma("unroll") for (int m = 0; m < 4; ++m) _Pragma("unroll") for (int n = 0; n < 2; ++n) { \
        f32x4 _c = acc_get(accw, ai, bj, m, n); \
        if constexpr (F8SCALE != 0) { _c = __builtin_amdgcn_mfma_scale_f32_16x16x128_f8f6f4(PG8_F8(Bt)[n], PG8_F8(At)[m], _c, 0, 0, 0, 0x7f7f7f7f, 0, F8SCALE * 0x01010101); } \
        else { _Pragma("unroll") for (int k = 0; k < 2; ++k) _c = __builtin_amdgcn_mfma_f32_16x16x32_bf16(Bt[n][k], At[m][k], _c, 0, 0, 0); } \
        acc_set(accw, ai, bj, m, n, _c); } \
        __builtin_amdgcn_s_setprio(0); } while (0)
#define PG8_WAIT_V(n) asm volatile("s_waitcnt vmcnt(" #n ")" ::: "memory")
#define PG8_WAIT_L(n) asm volatile("s_waitcnt lgkmcnt(" #n ")" ::: "memory")
#define PG8_BAR __builtin_amdgcn_s_barrier()
#define PG8_SCHED __builtin_amdgcn_sched_barrier(0)
    Unit cur, nxt; int ui = 0;
    if (!S.next(0, cur)) return;
    typedef int v4i_f __attribute__((ext_vector_type(4))); typedef int v8i_f __attribute__((ext_vector_type(8))); typedef f32x16 f32x16_f;
    AccW accw;
#pragma unroll
    for (int a = 0; a < 2; ++a)
#pragma unroll
        for (int b = 0; b < 2; ++b)
#pragma unroll
            for (int mp = 0; mp < 2; ++mp)
#pragma unroll
                for (int i = 0; i < 16; ++i) accw[a][b][mp][i] = 0.f;
    bf16x8 At[4][2], B0[2][2], B1[2][2];
    v8i_f At8[4], B08[2], B18[2];
#define PG8_F8(x) x##8
    const char* cA = (const char*)g.A + (size_t)cur.pm * tstepA + (size_t)cur.ko * 2; const char* cB = (const char*)g.Bt + (size_t)cur.pn * tstepB + (size_t)cur.ko * 2;
    S.a_ready(cur);
    if constexpr (SP2) {
        PG8_STAGE(PG8_SB(0, 0), cB, voffB); PG8_STAGE(PG8_SB(0, 1), cB + hstepB, voffB); PG8_STAGE(PG8_SA(0, 0), cA, voffA); PG8_STAGE(PG8_SA(0, 1), cA + hstepA, voffA);
        if (wr == 1) PG8_BAR;
        PG8_WAIT_V(2); PG8_BAR;
        PG8_STAGE(PG8_SB(1, 0), cB + kstep, voffB); PG8_STAGE(PG8_SA(1, 0), cA + kstep, voffA); PG8_STAGE(PG8_SB(1, 1), cB + hstepB + kstep, voffB);
        PG8_WAIT_V(6); PG8_BAR;
    } else {
        PG8_STAGE(PG8_SB(0, 0), cB, voffB); PG8_STAGE(PG8_SA(0, 0), cA, voffA); PG8_STAGE(PG8_SB(0, 1), cB + hstepB, voffB); PG8_STAGE(PG8_SA(0, 1), cA + hstepA, voffA);
        if (wr == 1) PG8_BAR;
        PG8_WAIT_V(4); PG8_BAR;
        PG8_STAGE(PG8_SB(1, 0), cB + kstep, voffB); PG8_STAGE(PG8_SA(1, 0), cA + kstep, voffA); PG8_STAGE(PG8_SB(1, 1), cB + hstepB + kstep, voffB);
        PG8_WAIT_V(6); PG8_BAR;
    }
    for (;;) {
        const bool has_next = S.next(ui + 1, nxt);
        const char* nA = has_next ? (const char*)g.A + (size_t)nxt.pm * tstepA + (size_t)nxt.ko * 2 : cA; const char* nB = has_next ? (const char*)g.Bt + (size_t)nxt.pn * tstepB + (size_t)nxt.ko * 2 : cB;
        for (int t = 0; t < nt; t += 2) {
            const bool last = (t == nt - 2);
            const char* a1 = cA + (size_t)(t + 1) * kstep;
            const char* a2 = last ? nA : cA + (size_t)(t + 2) * kstep; const char* b2 = last ? nB : cB + (size_t)(t + 2) * kstep;
            const char* a3 = a2 + kstep; const char* b3 = b2 + kstep;
            if (last && has_next) S.a_ready(nxt);
            if constexpr (SP2) {
            PG8_LDB(B0, 0, 0); PG8_LDB(B1, 0, 1); PG8_SCHED; PG8_LDA(At, 0, 0); PG8_STAGE(PG8_SA(1, 1), a1 + hstepA, voffA);
            PG8_WAIT_V(8); PG8_WAIT_L(0); PG8_BAR; PG8_MMA(0, 0, At, B0); PG8_MMA(0, 1, At, B1); PG8_BAR; PG8_SCHED;
            PG8_LDA(At, 0, 1); PG8_STAGE(PG8_SB(0, 0), b2, voffB); PG8_STAGE(PG8_SB(0, 1), b2 + hstepB, voffB); PG8_STAGE(PG8_SA(0, 0), a2, voffA);
            PG8_WAIT_V(8); PG8_WAIT_L(0); PG8_BAR; PG8_MMA(1, 0, At, B0); PG8_MMA(1, 1, At, B1); PG8_BAR; PG8_SCHED;
            PG8_LDB(B0, 1, 0); PG8_LDB(B1, 1, 1); PG8_SCHED; PG8_LDA(At, 1, 0); PG8_STAGE(PG8_SA(0, 1), a2 + hstepA, voffA);
            PG8_WAIT_V(8); PG8_WAIT_L(0); PG8_BAR; PG8_MMA(0, 0, At, B0); PG8_MMA(0, 1, At, B1); PG8_BAR; PG8_SCHED;
            PG8_LDA(At, 1, 1); PG8_STAGE(PG8_SB(1, 0), b3, voffB); PG8_STAGE(PG8_SB(1, 1), b3 + hstepB, voffB); PG8_STAGE(PG8_SA(1, 0), a3, voffA);
            PG8_WAIT_V(8); PG8_WAIT_L(0); PG8_BAR; PG8_MMA(1, 0, At, B0); PG8_MMA(1, 1, At, B1); PG8_BAR; PG8_SCHED;
            } else {
            PG8_LDB(B0, 0, 0); PG8_SCHED; PG8_LDA(At, 0, 0); PG8_STAGE(PG8_SA(1, 1), a1 + hstepA, voffA);
            PG8_WAIT_L(8); PG8_BAR; PG8_WAIT_L(0); PG8_MMA(0, 0, At, B0); PG8_BAR; PG8_SCHED;
            PG8_LDB(B1, 0, 1); PG8_STAGE(PG8_SB(0, 0), b2, voffB);
            PG8_BAR; PG8_WAIT_L(0); PG8_MMA(0, 1, At, B1); PG8_BAR;
            PG8_LDA(At, 0, 1); PG8_STAGE(PG8_SA(0, 0), a2, voffA);
            PG8_BAR; PG8_WAIT_L(0); PG8_MMA(1, 0, At, B0); PG8_BAR; PG8_SCHED;
            PG8_STAGE(PG8_SB(0, 1), b2 + hstepB, voffB);
            PG8_WAIT_V(6); PG8_BAR; PG8_MMA(1, 1, At, B1); PG8_BAR;
            PG8_LDB(B0, 1, 0); PG8_SCHED; PG8_LDA(At, 1, 0); PG8_STAGE(PG8_SA(0, 1), a2 + hstepA, voffA);
            PG8_WAIT_L(8); PG8_BAR; PG8_WAIT_L(0); PG8_MMA(0, 0, At, B0); PG8_BAR; PG8_SCHED;
            PG8_LDB(B1, 1, 1); PG8_STAGE(PG8_SB(1, 0), b3, voffB);
            PG8_BAR; PG8_WAIT_L(0); PG8_MMA(0, 1, At, B1); PG8_BAR;
            PG8_LDA(At, 1, 1); PG8_STAGE(PG8_SA(1, 0), a3, voffA);
            PG8_BAR; PG8_WAIT_L(0); PG8_MMA(1, 0, At, B0); PG8_BAR; PG8_SCHED;
            PG8_STAGE(PG8_SB(1, 1), b3 + hstepB, voffB);
            PG8_WAIT_V(6); PG8_BAR; PG8_MMA(1, 1, At, B1); PG8_BAR;
            }
        }
        if constexpr (ALIGN_EPI) { if (wr == 0) PG8_BAR; }
        if constexpr (!Epi::AFTER_DRAIN) { E(accw, cur, wr, wc, fr, fq); S.done(cur); }
        const bool keep_acc = Epi::TWOPASS && (cur.pass == 0);
        if (!has_next) break;
        if (!keep_acc) {
#pragma unroll
            for (int a = 0; a < 2; ++a)
#pragma unroll
                for (int b = 0; b < 2; ++b)
#pragma unroll
                    for (int mp = 0; mp < 2; ++mp)
#pragma unroll
                        for (int i = 0; i < 16; ++i) accw[a][b][mp][i] = 0.f;
        }
        cur = nxt; cA = nA; cB = nB; ++ui;
        if constexpr (ALIGN_EPI) { if (wr == 1) PG8_BAR; }
    }
    PG8_WAIT_V(0);
    if constexpr (!ALIGN_EPI) { if (wr == 0) PG8_BAR; }
    PG8_BAR;

#undef PG8_SA
#undef PG8_SB
#undef PG8_STAGE
#undef PG8_LDA
#undef PG8_LDB
#undef PG8_MMA
#undef PG8_F8
#undef PG8_WAIT_V
#undef PG8_WAIT_L
#undef PG8_BAR
#undef PG8_SCHED
}
}


constexpr int NWAVES = 8, NTHREADS = 512;
constexpr int BATCH = 8, SEQ = 4096, T = BATCH * SEQ, DM = 1024;
constexpr int INW = 5448;
constexpr int NPROJ = 5632;
constexpr int LD_HG = 2048, LD_ATT = 768, LD_IDX = 640, LD_GATE = 2048;
constexpr int TOPK = 256;
constexpr int NEXP = 16384;
constexpr float RMS_EPS = 1e-6f;

constexpr size_t MiB = 1u << 20;
constexpr size_t WS_CTL = 0;
constexpr size_t WS_MOD = MiB / 4;
constexpr size_t WS_MODP = MiB / 2;
constexpr size_t WS_WIN = 2 * MiB;
constexpr size_t WS_WQ = 17 * MiB;
constexpr size_t WS_SK = 21 * MiB;
constexpr size_t WS_U = 22 * MiB;
constexpr size_t WS_US = 30 * MiB;
constexpr size_t WS_V = 38 * MiB;
constexpr size_t WS_VS = 46 * MiB;
constexpr size_t WS_V8 = 8 * MiB;
constexpr size_t WS_K8 = 48 * MiB;
constexpr size_t WS_QHI = 52 * MiB;
constexpr size_t WS_QLO = 68 * MiB;
constexpr size_t WS_WAB8 = 31 * MiB;
constexpr size_t WS_WOUT8 = 32 * MiB;
constexpr size_t WS_WIN8 = 33 * MiB;
constexpr size_t WS_H8 = 48 * MiB;
constexpr size_t WS_H = 86 * MiB;
constexpr size_t WS_HG = 150 * MiB;
constexpr size_t WS_ATT = 278 * MiB;
constexpr size_t WS_IDX = 326 * MiB;
constexpr size_t WS_GATE = 366 * MiB;
constexpr size_t WS_SEL = 494 * MiB;
constexpr size_t WS_EIDX = 48 * MiB;
constexpr size_t WS_PGATE = 64 * MiB;
constexpr size_t WS_END = 510 * MiB;
constexpr size_t WS_HQC = 494 * MiB;
constexpr size_t WS_HOL = 118 * MiB;
constexpr size_t WS_HSB = 2 * MiB;
constexpr size_t WS_MERGED = WS_HG;
constexpr size_t WS_Q = 214 * MiB;
constexpr int H4_NT = 2;
constexpr size_t WS_H4D = 366 * MiB;
constexpr size_t WS_H4S = 416 * MiB;

constexpr int LDS_BYTES = 163840;

typedef unsigned short bf16;
typedef unsigned v4u __attribute__((ext_vector_type(4)));
typedef unsigned v2u __attribute__((ext_vector_type(2)));
typedef float f32x4 __attribute__((ext_vector_type(4)));
typedef float f32x2 __attribute__((ext_vector_type(2)));
typedef short bf16x8 __attribute__((ext_vector_type(8)));
#define LAS __attribute__((address_space(3)))

struct Params {
    const float *x, *c, *w_ada, *b_ada, *norm1_g, *norm2_g, *w_in, *hg_lb, *hg_onorm_g, *q_norm_g, *k_norm_g,
                *w_a, *w_b, *w_out, *peer_wq, *peer_subkeys, *peer_u, *peer_v;
    float* out; unsigned char* ws; int ph_lo, ph_hi;
};

typedef __bf16 bf16x2_hw __attribute__((ext_vector_type(2)));
__device__ __forceinline__ unsigned pk2(float lo, float hi) { const f32x2 v = {lo, hi}; const bf16x2_hw b = __builtin_convertvector(v, bf16x2_hw); return __builtin_bit_cast(unsigned, b); }
__device__ __forceinline__ unsigned f2bf(float f) { return pk2(f, 0.f) & 0xffffu; }
__device__ __forceinline__ float bf2f(unsigned u16v) { return __builtin_bit_cast(float, u16v << 16); }
__device__ __forceinline__ float bflo(unsigned w) { return __builtin_bit_cast(float, w << 16); }
__device__ __forceinline__ float bfhi(unsigned w) { return __builtin_bit_cast(float, w & 0xffff0000u); }
__device__ __forceinline__ float sigmoidf_(float x) { return __builtin_amdgcn_rcpf(1.f + __expf(-x)); }
__device__ __forceinline__ float siluf_(float x) { return x * __builtin_amdgcn_rcpf(1.f + __expf(-x)); }
__device__ __forceinline__ float wave_sum(float v) {
#pragma unroll
    for (int o = 1; o < 64; o <<= 1) v += __shfl_xor(v, o);
    return v;
}
__device__ __forceinline__ float wave_max(float v) {
#pragma unroll
    for (int o = 1; o < 64; o <<= 1) v = fmaxf(v, __shfl_xor(v, o));
    return v;
}
#define LDS_WAIT() asm volatile("s_waitcnt lgkmcnt(0)" ::: "memory")
__device__ __forceinline__ unsigned pk4_fp8(float a, float b, float c, float d) { int w = __builtin_amdgcn_cvt_pk_fp8_f32(a, b, 0, false); w = __builtin_amdgcn_cvt_pk_fp8_f32(c, d, w, true); return (unsigned)w; }

__host__ __device__ __forceinline__ int proj_tile_bf16(int i) { return i < 2 ? i + 2 : i + 6; }
__host__ __device__ __forceinline__ int proj_tile_fp8(int i) { return i < 2 ? i : (i < 6 ? i + 2 : i + 8); }
struct EpiProj {
    static constexpr bool PERM = true, AFTER_DRAIN = false, TWOPASS = false;
    bf16 *HG, *ATT, *IDX, *GATE; int f8;
    __device__ __forceinline__ void operator()(pg8::AccW& acc, const pg8::Unit& u, int wr, int wc, int fr, int fq) const {
        const int pn = f8 ? proj_tile_fp8(u.pn) : proj_tile_bf16(u.pn); bf16* base; int ldc, colt, ncols;
        if (pn < 8) { base = HG; ldc = LD_HG; colt = pn * 256; ncols = LD_HG; }
        else if (pn < 11) { base = ATT; ldc = LD_ATT; colt = (pn - 8) * 256; ncols = LD_ATT; }
        else if (pn < 14) { base = IDX; ldc = LD_IDX; colt = (pn - 11) * 256; ncols = LD_IDX; }
        else { base = GATE; ldc = LD_GATE; colt = (pn - 14) * 256; ncols = LD_GATE; }
        const int row0 = u.pm * 256 + wr * 64 + fr, col0 = colt + wc * 32 + 8 * fq;
#pragma unroll
        for (int ai = 0; ai < 2; ++ai)
#pragma unroll
            for (int m = 0; m < 4; ++m) { bf16* rowp = base + (size_t)(row0 + ai * 128 + m * 16) * ldc + col0;
#pragma unroll
                for (int bj = 0; bj < 2; ++bj) { const pg8::f32x4 v0 = pg8::acc_get(acc, ai, bj, m, 0), v1 = pg8::acc_get(acc, ai, bj, m, 1);
                    v4u w; w.x = pk2(v0[0], v0[1]); w.y = pk2(v0[2], v0[3]); w.z = pk2(v1[0], v1[1]); w.w = pk2(v1[2], v1[3]);
                    if (col0 + bj * 128 < ncols) *(v4u*)(rowp + bj * 128) = w; } }
    }
};
struct EpiMerged {
    static constexpr bool PERM = true, AFTER_DRAIN = false, TWOPASS = true;
    const bf16* GATE; bf16* O;
    __device__ __forceinline__ void operator()(pg8::AccW& acc, const pg8::Unit& u, int wr, int wc, int fr, int fq) const {
        const int row0 = u.pm * 256 + wr * 64 + fr, col0 = u.pn * 256 + wc * 32 + 8 * fq;
        if (u.pass == 0) {
#pragma unroll
            for (int ai = 0; ai < 2; ++ai)
#pragma unroll
                for (int m = 0; m < 4; ++m) { const bf16* rowp = GATE + (size_t)(row0 + ai * 128 + m * 16) * LD_GATE + col0;
#pragma unroll
                    for (int bj = 0; bj < 2; ++bj) { const v4u a = *(const v4u*)(rowp + bj * 128), b = *(const v4u*)(rowp + 1024 + bj * 128);
                        float r[8];
#pragma unroll
                        for (int i = 0; i < 4; ++i) { const float a0 = bflo(a[i]), a1 = bfhi(a[i]), b0 = bflo(b[i]), b1 = bfhi(b[i]);
                            r[2 * i] = (1.f + __expf(-b0)) * __builtin_amdgcn_rcpf(1.f + __expf(-a0)); r[2 * i + 1] = (1.f + __expf(-b1)) * __builtin_amdgcn_rcpf(1.f + __expf(-a1)); }
                        { pg8::f32x4 c0 = pg8::acc_get(acc, ai, bj, m, 0), c1 = pg8::acc_get(acc, ai, bj, m, 1);
#pragma unroll
                          for (int i = 0; i < 4; ++i) { c0[i] *= r[i]; c1[i] *= r[4 + i]; }
                          pg8::acc_set(acc, ai, bj, m, 0, c0); pg8::acc_set(acc, ai, bj, m, 1, c1); } } }
        } else {
#pragma unroll
            for (int ai = 0; ai < 2; ++ai)
#pragma unroll
                for (int m = 0; m < 4; ++m) { const size_t ro = (size_t)(row0 + ai * 128 + m * 16);
#pragma unroll
                    for (int bj = 0; bj < 2; ++bj) { const v4u b = *(const v4u*)(GATE + ro * LD_GATE + 1024 + col0 + bj * 128);
                        const pg8::f32x4 v0 = pg8::acc_get(acc, ai, bj, m, 0), v1 = pg8::acc_get(acc, ai, bj, m, 1);
                        float s[8];
#pragma unroll
                        for (int i = 0; i < 4; ++i) { s[2 * i] = sigmoidf_(bflo(b[i])); s[2 * i + 1] = sigmoidf_(bfhi(b[i])); }
                        v2u w; w.x = pk4_fp8(4.f * v0[0] * s[0], 4.f * v0[1] * s[1], 4.f * v0[2] * s[2], 4.f * v0[3] * s[3]); w.y = pk4_fp8(4.f * v1[0] * s[4], 4.f * v1[1] * s[5], 4.f * v1[2] * s[6], 4.f * v1[3] * s[7]);
                        *(v2u*)((unsigned char*)O + ro * 1024 + col0 + bj * 128) = w; } }
        }
    }
};
struct EpiResid {
    static constexpr bool PERM = true, AFTER_DRAIN = false, TWOPASS = false;
    const float* X; const float* G1  ; float* O;
    __device__ __forceinline__ void operator()(pg8::AccW& acc, const pg8::Unit& u, int wr, int wc, int fr, int fq) const {
        const int row0 = u.pm * 256 + wr * 64 + fr, col0 = u.pn * 256 + wc * 32 + 8 * fq;
        const int b = (u.pm * 256) / SEQ;
        f32x4 g[2][2];
#pragma unroll
        for (int bj = 0; bj < 2; ++bj)
#pragma unroll
            for (int n = 0; n < 2; ++n) g[bj][n] = *(const f32x4*)(G1 + (size_t)b * 6144 + col0 + bj * 128 + 4 * n);
#pragma unroll
        for (int ai = 0; ai < 2; ++ai)
#pragma unroll
            for (int m = 0; m < 4; ++m) { const size_t ro = (size_t)(row0 + ai * 128 + m * 16) * DM + col0;
#pragma unroll
                for (int bj = 0; bj < 2; ++bj)
#pragma unroll
                    for (int n = 0; n < 2; ++n) { const f32x4 xv = *(const f32x4*)(X + ro + bj * 128 + 4 * n);
                        *(f32x4*)(O + ro + bj * 128 + 4 * n) = xv + g[bj][n] * pg8::acc_get(acc, ai, bj, m, n); } }
    }
};
struct EpiStore {
    static constexpr bool PERM = true, AFTER_DRAIN = false, TWOPASS = false;
    bf16* O; int ldc;
    __device__ __forceinline__ void operator()(pg8::AccW& acc, const pg8::Unit& u, int wr, int wc, int fr, int fq) const {
        const int row0 = u.pm * 256 + wr * 64 + fr, col0 = u.pn * 256 + wc * 32 + 8 * fq;
#pragma unroll
        for (int ai = 0; ai < 2; ++ai)
#pragma unroll
            for (int m = 0; m < 4; ++m) { bf16* rowp = O + (size_t)(row0 + ai * 128 + m * 16) * ldc + col0;
#pragma unroll
                for (int bj = 0; bj < 2; ++bj) { const pg8::f32x4 v0 = pg8::acc_get(acc, ai, bj, m, 0), v1 = pg8::acc_get(acc, ai, bj, m, 1);
                    v4u w; w.x = pk2(v0[0], v0[1]); w.y = pk2(v0[2], v0[3]); w.z = pk2(v1[0], v1[1]); w.w = pk2(v1[2], v1[3]);
                    *(v4u*)(rowp + bj * 128) = w; } }
    }
};

template <int MODE> __device__ __forceinline__ int srcmap(int np) {
    if (MODE == 2) np = proj_tile_bf16(np >> 8) * 256 + (np & 255);
    if (MODE == 3) np = proj_tile_fp8(np >> 8) * 256 + (np & 255);
    if (MODE >= 1) return np < 3400 ? np : (np >= 3584 ? np - 184 : -1);
    return np; }
template <int MODE>
__device__ __forceinline__ void transpose_item(const float* W, int N, bf16* WT, int ldw, int koff, float* scr, int kb, int nb, int lane) {
    const int k0 = 64 * kb, n0 = 32 * nb;
    const int sc = srcmap<MODE>(n0 + (lane & 31));
#pragma unroll 8
    for (int i = 0; i < 32; ++i) { const int kk = 2 * i + (lane >> 5); scr[kk * 33 + (lane & 31)] = (sc >= 0) ? W[(size_t)(k0 + kk) * N + sc] : 0.f; }
    LDS_WAIT(); __builtin_amdgcn_wave_barrier();
    const int c = lane & 7;
#pragma unroll
    for (int j = 0; j < 4; ++j) { const int n = (lane >> 3) + 8 * j; const float* s = scr + (8 * c) * 33 + n;
        v4u o; o.x = pk2(s[0 * 33], s[1 * 33]); o.y = pk2(s[2 * 33], s[3 * 33]); o.z = pk2(s[4 * 33], s[5 * 33]); o.w = pk2(s[6 * 33], s[7 * 33]);
        *(v4u*)(WT + (size_t)(n0 + n) * ldw + koff + k0 + 8 * c) = o; }
    LDS_WAIT(); __builtin_amdgcn_wave_barrier();
}
template <int MODE> __device__ __forceinline__ int srcmap(int np);
template <int MODE = 0>
__device__ __forceinline__ void transpose_item8(const float* W, int N, unsigned char* WT, int ldw, int koff, float scale, float* scr, int kb, int nb, int lane) {
    const int k0 = 64 * kb, n0 = 32 * nb;
    const int sc = srcmap<MODE>(n0 + (lane & 31));
#pragma unroll 8
    for (int i = 0; i < 32; ++i) { const int kk = 2 * i + (lane >> 5); scr[kk * 33 + (lane & 31)] = (sc >= 0) ? W[(size_t)(k0 + kk) * N + sc] * scale : 0.f; }
    LDS_WAIT(); __builtin_amdgcn_wave_barrier();
    const int c = lane & 3;
#pragma unroll
    for (int j = 0; j < 2; ++j) { const int n = (lane >> 2) + 16 * j; const float* sp = scr + (16 * c) * 33 + n;
        v4u o;
#pragma unroll
        for (int q = 0; q < 4; ++q) o[q] = pk4_fp8(sp[(4 * q) * 33], sp[(4 * q + 1) * 33], sp[(4 * q + 2) * 33], sp[(4 * q + 3) * 33]);
        *(v4u*)(WT + (size_t)(n0 + n) * ldw + koff + k0 + 16 * c) = o; }
    LDS_WAIT(); __builtin_amdgcn_wave_barrier();
}
__device__ __forceinline__ void convert_plain(const float* src, bf16* dst, size_t n, size_t gtid, size_t nth) {
    const size_t n8 = n / 8;
    for (size_t i = gtid; i < n8; i += nth) { const f32x4 a = ((const f32x4*)src)[2 * i], b = ((const f32x4*)src)[2 * i + 1];
        v4u o; o.x = pk2(a[0], a[1]); o.y = pk2(a[2], a[3]); o.z = pk2(b[0], b[1]); o.w = pk2(b[2], b[3]); ((v4u*)dst)[i] = o; }
}
__device__ __forceinline__ void convert_fp8(const float* src, unsigned char* dst, size_t n, float scale, size_t gtid, size_t nth) {
    const size_t n16 = n / 16;
    for (size_t i = gtid; i < n16; i += nth) { const f32x4* sp = (const f32x4*)src + 4 * i; const f32x4 a = sp[0] * scale, b = sp[1] * scale, c = sp[2] * scale, d = sp[3] * scale;
        v4u o; o.x = pk4_fp8(a[0], a[1], a[2], a[3]); o.y = pk4_fp8(b[0], b[1], b[2], b[3]); o.z = pk4_fp8(c[0], c[1], c[2], c[3]); o.w = pk4_fp8(d[0], d[1], d[2], d[3]); ((v4u*)dst)[i] = o; }
}
template <bool KKMAJOR>
__device__ __forceinline__ void convert_mxfp4(const float* src, unsigned char* dst, unsigned char* scl, size_t nrows, size_t gtid, size_t nth) {
    const size_t nblk = nrows * 32;
    for (size_t i = gtid; i < nblk; i += nth) {
        const size_t row = i >> 5; const int blk = (int)(i & 31);
        const f32x4* sp = (const f32x4*)(src + row * 1024 + blk * 32);
        f32x4 v[8]; float amax = 0.f;
#pragma unroll
        for (int j = 0; j < 8; ++j) { v[j] = sp[j]; amax = fmaxf(fmaxf(fmaxf(fabsf(v[j][0]), fabsf(v[j][1])), fmaxf(fabsf(v[j][2]), fabsf(v[j][3]))), amax); }
        int e = (int)((__builtin_bit_cast(unsigned, amax) >> 23) & 0xffu) - 127 - 2;
        if (e < -126) e = -126;
        const float inv = __builtin_bit_cast(float, (unsigned)(127 - e) << 23);
        unsigned w[4] = {0u, 0u, 0u, 0u};
#pragma unroll
        for (int j = 0; j < 8; j += 2) { unsigned t = 0u;
            t = __builtin_amdgcn_cvt_scalef32_pk_fp4_f32(t, v[j][0] * inv, v[j][1] * inv, 1.0f, 0);
            t = __builtin_amdgcn_cvt_scalef32_pk_fp4_f32(t, v[j][2] * inv, v[j][3] * inv, 1.0f, 1);
            t = __builtin_amdgcn_cvt_scalef32_pk_fp4_f32(t, v[j + 1][0] * inv, v[j + 1][1] * inv, 1.0f, 2);
            t = __builtin_amdgcn_cvt_scalef32_pk_fp4_f32(t, v[j + 1][2] * inv, v[j + 1][3] * inv, 1.0f, 3);
            w[j >> 1] = t; }
        *(v4u*)(dst + row * 512 + blk * 16) = (v4u){w[0], w[1], w[2], w[3]};
        scl[row * 32 + (KKMAJOR ? ((blk & 3) * 8 + (blk >> 2)) : blk)] = (unsigned char)(e + 127);
    }
}
__device__ __forceinline__ void convert_rowfp4(const float* src, unsigned char* dst, _Float16* scl, int row, int lane) {
    const f32x4* sp = (const f32x4*)(src + (size_t)row * 1024 + lane * 16);
    f32x4 v[4]; float amax = 0.f;
#pragma unroll
    for (int j = 0; j < 4; ++j) { v[j] = sp[j]; amax = fmaxf(fmaxf(fmaxf(fabsf(v[j][0]), fabsf(v[j][1])), fmaxf(fabsf(v[j][2]), fabsf(v[j][3]))), amax); }
    amax = wave_max(amax);
    _Float16 sh = (_Float16)(amax * (1.f / 6.f));
    float sf = (float)sh; if (!(sf > 0.f)) { sf = 1.f; sh = (_Float16)1.f; }
    const float inv = 1.f / sf;
    unsigned w[2];
#pragma unroll
    for (int j = 0; j < 2; ++j) { unsigned t = 0u;
        t = __builtin_amdgcn_cvt_scalef32_pk_fp4_f32(t, v[2 * j][0] * inv, v[2 * j][1] * inv, 1.0f, 0);
        t = __builtin_amdgcn_cvt_scalef32_pk_fp4_f32(t, v[2 * j][2] * inv, v[2 * j][3] * inv, 1.0f, 1);
        t = __builtin_amdgcn_cvt_scalef32_pk_fp4_f32(t, v[2 * j + 1][0] * inv, v[2 * j + 1][1] * inv, 1.0f, 2);
        t = __builtin_amdgcn_cvt_scalef32_pk_fp4_f32(t, v[2 * j + 1][2] * inv, v[2 * j + 1][3] * inv, 1.0f, 3);
        w[j] = t; }
    *(v2u*)(dst + (size_t)row * 512 + lane * 8) = (v2u){w[0], w[1]};
    if (lane == 0) scl[row] = sh;
}
__device__ __forceinline__ void phase0(const Params& p, unsigned char* lds) {
    const int tid = threadIdx.x, wave = tid >> 6, lane = tid & 63, G = gridDim.x;
    const int gw = blockIdx.x * NWAVES + wave, NGW = G * NWAVES;
    float* scr = (float*)(lds + wave * 16384);
    unsigned char* ws = p.ws;
    constexpr int I_IN = 16 * (2048 / 32), I_IN8 = 16 * (3584 / 32), I_A = 8 * 32, I_O = 16 * 32, I_Q = 16 * 64;
    constexpr int NT = I_IN + I_IN8 + 2 * I_A + I_O + I_Q;
    for (int it = gw; it < NT; it += NGW) {
        int r = it;
        if (r < I_IN) { transpose_item<2>(p.w_in, INW, (bf16*)(ws + WS_WIN), 1024, 0, scr, r / 64, r % 64, lane); continue; } r -= I_IN;
        if (r < I_IN8) { transpose_item8<3>(p.w_in, INW, ws + WS_WIN8, 1024, 0, 32.f, scr, r / 112, r % 112, lane); continue; } r -= I_IN8;
        if (r < I_A) { transpose_item8(p.w_a, 1024, ws + WS_WAB8, 1024, 0, 32.f, scr, r / 32, r % 32, lane); continue; } r -= I_A;
        if (r < I_A) { transpose_item8(p.w_b, 1024, ws + WS_WAB8, 1024, 512, 4.f, scr, r / 32, r % 32, lane); continue; } r -= I_A;
        if (r < I_O) { transpose_item8(p.w_out, 1024, ws + WS_WOUT8, 1024, 0, 32.f, scr, r / 32, r % 32, lane); continue; } r -= I_O;
        transpose_item<0>(p.peer_wq, 2048, (bf16*)(ws + WS_WQ), 1024, 0, scr, r / 64, r % 64, lane);
    }
    for (int it = gw; it < 96 * 8; it += NGW) {
        const int cgp = it % 96, ks = it / 96, col = cgp * 64 + lane, k0 = ks * 128;
#pragma unroll
        for (int i = 0; i < 16; ++i) { const int e = i * 64 + lane, b = e >> 7, k = e & 127; scr[e] = siluf_(p.c[b * 1024 + k0 + k]); }
        LDS_WAIT(); __builtin_amdgcn_wave_barrier();
        float acc[8];
#pragma unroll
        for (int b = 0; b < 8; ++b) acc[b] = 0.f;
#pragma unroll 4
        for (int k = 0; k < 128; ++k) { const float w = p.w_ada[(size_t)(k0 + k) * 6144 + col];
#pragma unroll
            for (int b = 0; b < 8; ++b) acc[b] += scr[b * 128 + k] * w; }
        float* mp = (float*)(ws + WS_MODP) + (size_t)ks * 8 * 6144 + col;
#pragma unroll
        for (int b = 0; b < 8; ++b) mp[b * 6144] = acc[b];
        LDS_WAIT(); __builtin_amdgcn_wave_barrier();
    }
    const size_t gtid = (size_t)blockIdx.x * NTHREADS + tid, nth = (size_t)G * NTHREADS;
    convert_plain(p.peer_subkeys, (bf16*)(ws + WS_SK), (size_t)16 * 128 * 128, gtid, nth);
    for (int it = gw; it < 2 * NEXP; it += NGW) {
        if (it < NEXP) convert_rowfp4(p.peer_u, ws + WS_U, (_Float16*)(ws + WS_US), it, lane);
        else convert_rowfp4(p.peer_v, ws + WS_V, (_Float16*)(ws + WS_VS), it - NEXP, lane);
    }
}

template <bool FIRST>
__device__ __forceinline__ void normmod_phase(const Params& p, unsigned char* lds, const float* src, bf16* dst, const float* gvec, int shift_off, int scale_off) {
    const int tid = threadIdx.x, wave = tid >> 6, lane = tid & 63, G = gridDim.x;
    unsigned char* ws = p.ws;
    float* A = (float*)lds;
    float* Bv = A + 1024;
    const float* MODP = (const float*)(ws + WS_MODP);
    float* MOD = (float*)(ws + WS_MOD);
    if (FIRST) {
        for (int e = blockIdx.x * NTHREADS + tid; e < 8 * 6144; e += G * NTHREADS) { const int col = e % 6144; float s = p.b_ada[col];
#pragma unroll
            for (int ks = 0; ks < 8; ++ks) s += MODP[(size_t)ks * 8 * 6144 + e];
            MOD[e] = s; }
    }
    int curb = -1;
    for (int chunk = blockIdx.x; chunk < T / 128; chunk += G) {
        const int b = (chunk * 128) / SEQ;
        if (b != curb) {
            __syncthreads();
            for (int col = tid; col < 1024; col += NTHREADS) {
                float sc, sh;
                if (FIRST) { sc = p.b_ada[scale_off + col]; sh = p.b_ada[shift_off + col];
#pragma unroll
                    for (int ks = 0; ks < 8; ++ks) { sc += MODP[(size_t)(ks * 8 + b) * 6144 + scale_off + col]; sh += MODP[(size_t)(ks * 8 + b) * 6144 + shift_off + col]; } }
                else { sc = MOD[b * 6144 + scale_off + col]; sh = MOD[b * 6144 + shift_off + col]; }
                A[col] = gvec[col] * (1.f + sc); Bv[col] = sh; }
            __syncthreads(); curb = b;
        }
        for (int r = wave; r < 128; r += NWAVES) {
            const size_t row = (size_t)chunk * 128 + r;
            const f32x4* xr = (const f32x4*)(src + row * DM) + lane;
            f32x4 v[4]; float s = 0.f;
#pragma unroll
            for (int j = 0; j < 4; ++j) { v[j] = xr[64 * j]; s += (v[j][0] * v[j][0] + v[j][1] * v[j][1]) + (v[j][2] * v[j][2] + v[j][3] * v[j][3]); }
            const float rstd = rsqrtf(wave_sum(s) * (1.f / DM) + RMS_EPS);
            v2u* o8 = (v2u*)(dst + row * DM) + lane;
#pragma unroll
            for (int j = 0; j < 4; ++j) { const int c0 = 4 * lane + 256 * j; const f32x4 a = *(const f32x4*)(A + c0), sh = *(const f32x4*)(Bv + c0);
                v2u o; o.x = pk2(v[j][0] * rstd * a[0] + sh[0], v[j][1] * rstd * a[1] + sh[1]); o.y = pk2(v[j][2] * rstd * a[2] + sh[2], v[j][3] * rstd * a[3] + sh[3]);
                o8[64 * j] = o;
                if (FIRST) *(unsigned*)(ws + WS_H8 + row * DM + c0) = pk4_fp8(v[j][0] * rstd * a[0] + sh[0], v[j][1] * rstd * a[1] + sh[1], v[j][2] * rstd * a[2] + sh[2], v[j][3] * rstd * a[3] + sh[3]);
                if (!FIRST) { float* st = (float*)(lds + 8192) + wave * 1056;
                    const float y0 = v[j][0] * rstd * a[0] + sh[0], y1 = v[j][1] * rstd * a[1] + sh[1], y2 = v[j][2] * rstd * a[2] + sh[2], y3 = v[j][3] * rstd * a[3] + sh[3];
                    const int pc = c0 + (c0 >> 5); st[pc] = y0; st[pc + 1] = y1; st[pc + 2] = y2; st[pc + 3] = y3; } }
            if (!FIRST) {
                const float* st = (const float*)(lds + 8192) + wave * 1056;
                LDS_WAIT(); __builtin_amdgcn_wave_barrier();
                if (lane < 32) {
                    float x[32];
#pragma unroll
                    for (int k = 0; k < 32; ++k) x[k] = st[lane * 33 + k];
#pragma unroll
                    for (int t = 0; t < H4_NT; ++t) {
                        float amax = 0.f;
#pragma unroll
                        for (int k = 0; k < 32; ++k) amax = fmaxf(amax, fabsf(x[k]));
                        int e = (int)((__builtin_bit_cast(unsigned, amax) >> 23) & 0xffu) - 127 - 2; if (e < -126) e = -126;
                        const float inv = __builtin_bit_cast(float, (unsigned)(127 - e) << 23), sc = __builtin_bit_cast(float, (unsigned)(127 + e) << 23);
                        unsigned w[4];
#pragma unroll
                        for (int r = 0; r < 4; ++r) { unsigned tw = 0u;
                            tw = __builtin_amdgcn_cvt_scalef32_pk_fp4_f32(tw, x[8 * r] * inv, x[8 * r + 1] * inv, 1.0f, 0);
                            tw = __builtin_amdgcn_cvt_scalef32_pk_fp4_f32(tw, x[8 * r + 2] * inv, x[8 * r + 3] * inv, 1.0f, 1);
                            tw = __builtin_amdgcn_cvt_scalef32_pk_fp4_f32(tw, x[8 * r + 4] * inv, x[8 * r + 5] * inv, 1.0f, 2);
                            tw = __builtin_amdgcn_cvt_scalef32_pk_fp4_f32(tw, x[8 * r + 6] * inv, x[8 * r + 7] * inv, 1.0f, 3);
                            w[r] = tw;
                            const f32x2 d0 = __builtin_amdgcn_cvt_scalef32_pk_f32_fp4(tw, 1.0f, 0), d1 = __builtin_amdgcn_cvt_scalef32_pk_f32_fp4(tw, 1.0f, 1), d2 = __builtin_amdgcn_cvt_scalef32_pk_f32_fp4(tw, 1.0f, 2), d3 = __builtin_amdgcn_cvt_scalef32_pk_f32_fp4(tw, 1.0f, 3);
                            x[8 * r] -= d0[0] * sc; x[8 * r + 1] -= d0[1] * sc; x[8 * r + 2] -= d1[0] * sc; x[8 * r + 3] -= d1[1] * sc;
                            x[8 * r + 4] -= d2[0] * sc; x[8 * r + 5] -= d2[1] * sc; x[8 * r + 6] -= d3[0] * sc; x[8 * r + 7] -= d3[1] * sc; }
                        *(v4u*)(ws + WS_H4D + (row * H4_NT + t) * 512 + lane * 16) = (v4u){w[0], w[1], w[2], w[3]};
                        *(ws + WS_H4S + (row * H4_NT + t) * 32 + (lane & 3) * 8 + (lane >> 2)) = (unsigned char)(e + 127);
                    }
                }
                LDS_WAIT(); __builtin_amdgcn_wave_barrier();
            }
        }
    }
    __syncthreads();
}

constexpr int HGL_QT = 0, HGL_KT = 17408, HGL_QE = 34816, HGL_KLT = 52224, HGL_VT = 70656, HGL_AM = 89088, HGL_DEC = 98304, HGL_TOT = 98816, HGL_SSQ = 100864;
constexpr int HG_LDR = 136;
constexpr int HG_LDC = 72;
template <int half>
__device__ __forceinline__ void hgrn_item(const Params& p, unsigned char* lds, int item) {
    const int b = item >> 2, h = item & 3;
    const int tid = threadIdx.x, w = tid >> 6, lane = tid & 63, fr = lane & 15, fq = lane >> 4;
    unsigned char* ws = p.ws;
    const bf16* HG = (const bf16*)(ws + WS_HG);
    bf16* YA = (bf16*)(ws + WS_H);
    bf16* QT = (bf16*)(lds + HGL_QT); bf16* KT = (bf16*)(lds + HGL_KT); bf16* QE = (bf16*)(lds + HGL_QE);
    bf16* KLT = (bf16*)(lds + HGL_KLT); bf16* VT = (bf16*)(lds + HGL_VT); bf16* AM = (bf16*)(lds + HGL_AM);
    float* DEC = (float*)(lds + HGL_DEC); float* TOT = (float*)(lds + HGL_TOT); float* SSQ = (float*)(lds + HGL_SSQ);
    const int pd = tid & 127, pq = tid >> 7;
    float lbv; { const float a0 = p.hg_lb[h * 128 + pd], a1 = p.hg_lb[512 + h * 128 + pd]; lbv = 1.f / (1.f + __expf(a1 - a0)); }
    const int e0 = w * 16;
    const float ogv = p.hg_onorm_g[e0 + fr];
    pg8::f32x4 S[8];
#pragma unroll
    for (int i = 0; i < 8; ++i) S[i] = (pg8::f32x4){0.f, 0.f, 0.f, 0.f};
    const size_t rowb = (size_t)b * SEQ;
    const int c0 = half * 32;
    bf16* QCg = (bf16*)(ws + WS_HQC) + (size_t)item * 2048 * 128; float* OLg = (float*)(ws + WS_HOL) + (size_t)item * 32 * 8 * 4 * 256;
    float cum = 1.f;
    unsigned short rq[16], rf[16], rv[16];
    { const bf16* gp = HG + (rowb + (size_t)c0 * 64 + pq * 16) * LD_HG + h * 128 + pd;
#pragma unroll
      for (int i = 0; i < 16; ++i) { rq[i] = gp[(size_t)i * LD_HG]; rf[i] = gp[(size_t)i * LD_HG + 512]; rv[i] = gp[(size_t)i * LD_HG + 1024]; } }
    for (int chunk = c0; chunk < c0 + 32; ++chunk) {
        const size_t row0 = rowb + (size_t)chunk * 64;
        float fq_[16], kq_[16], cs[16];
        float run = 0.f;
#pragma unroll
        for (int i = 0; i < 16; ++i) { const float f = lbv + (1.f - lbv) * sigmoidf_(bf2f(rf[i])); kq_[i] = 1.f - f; run += __logf(f); cs[i] = run; fq_[i] = siluf_(bf2f(rq[i])); }
        TOT[pq * 128 + pd] = run;
        { v4u v0, v1;
          v0.x = rv[0] | ((unsigned)rv[1] << 16); v0.y = rv[2] | ((unsigned)rv[3] << 16); v0.z = rv[4] | ((unsigned)rv[5] << 16); v0.w = rv[6] | ((unsigned)rv[7] << 16);
          v1.x = rv[8] | ((unsigned)rv[9] << 16); v1.y = rv[10] | ((unsigned)rv[11] << 16); v1.z = rv[12] | ((unsigned)rv[13] << 16); v1.w = rv[14] | ((unsigned)rv[15] << 16);
          *(v4u*)(VT + pd * HG_LDC + pq * 16) = v0; *(v4u*)(VT + pd * HG_LDC + pq * 16 + 8) = v1; }
        unsigned short rg[16];
#pragma unroll
        for (int i = 0; i < 16; ++i) rg[i] = half ? (unsigned short)0 : HG[(row0 + (i >> 2) * 16 + fq * 4 + (i & 3)) * LD_HG + 1536 + h * 128 + e0 + fr];
        if (chunk + 1 < c0 + 32) { const bf16* gp = HG + (row0 + 64 + pq * 16) * LD_HG + h * 128 + pd;
#pragma unroll
            for (int i = 0; i < 16; ++i) { rq[i] = gp[(size_t)i * LD_HG]; rf[i] = gp[(size_t)i * LD_HG + 512]; rv[i] = gp[(size_t)i * LD_HG + 1024]; } }
        __syncthreads();
        const float t0 = TOT[pd], t1 = TOT[128 + pd], t2 = TOT[256 + pd], t3 = TOT[384 + pd];
        const float base = (pq > 0 ? t0 : 0.f) + (pq > 1 ? t1 : 0.f) + (pq > 2 ? t2 : 0.f);
        const float bmid = t0 + t1, blast = (t0 + t1) + (t2 + t3);
        const float emid = __expf(bmid), elm = __expf(blast - bmid);
        if (pq == 0) DEC[pd] = __expf(blast);
        { unsigned klp[8];
#pragma unroll
          for (int i = 0; i < 16; ++i) { const float bb = base + cs[i]; const float E1 = __expf(bb - bmid), R1 = __builtin_amdgcn_rcpf(E1);
              const float qtv = fq_[i] * E1, ktv = kq_[i] * R1, qev = qtv * emid, klv = ktv * elm;
              const int srow = pq * 16 + i;
              QT[srow * HG_LDR + pd] = (bf16)f2bf(qtv); KT[srow * HG_LDR + pd] = (bf16)f2bf(ktv); QE[srow * HG_LDR + pd] = (bf16)f2bf(qev);
              if (half) QCg[((size_t)(chunk - 32) * 64 + srow) * 128 + pd] = (bf16)f2bf(qev * cum);
              if (i & 1) klp[i >> 1] |= f2bf(klv) << 16; else klp[i >> 1] = f2bf(klv); }
          *(v4u*)(KLT + pd * HG_LDC + pq * 16) = (v4u){klp[0], klp[1], klp[2], klp[3]}; *(v4u*)(KLT + pd * HG_LDC + pq * 16 + 8) = (v4u){klp[4], klp[5], klp[6], klp[7]}; }
        cum *= __expf(blast);
        __syncthreads();
#pragma unroll
        for (int tt = 0; tt < 2; ++tt) { const int id = w + 8 * tt, rt = id >> 2, ct = id & 3;
            pg8::f32x4 a = {0.f, 0.f, 0.f, 0.f};
            if (ct <= rt) {
#pragma unroll
                for (int ks = 0; ks < 4; ++ks) { const bf16x8 af = *(const bf16x8*)(QT + (rt * 16 + fr) * HG_LDR + ks * 32 + fq * 8), bfv = *(const bf16x8*)(KT + (ct * 16 + fr) * HG_LDR + ks * 32 + fq * 8);
                    a = __builtin_amdgcn_mfma_f32_16x16x32_bf16(af, bfv, a, 0, 0, 0); } }
#pragma unroll
            for (int r = 0; r < 4; ++r) { const int c = rt * 16 + fq * 4 + r, sidx = ct * 16 + fr; AM[c * HG_LDC + sidx] = (bf16)((sidx <= c) ? f2bf(a[r]) : 0u); } }
        __syncthreads();
        const bf16x8 vb0 = *(const bf16x8*)(VT + (e0 + fr) * HG_LDC + fq * 8), vb1 = *(const bf16x8*)(VT + (e0 + fr) * HG_LDC + 32 + fq * 8);
        bf16x8 sb[4];
#pragma unroll
        for (int ks = 0; ks < 4; ++ks) { v4u t; t.x = pk2(S[2 * ks][0], S[2 * ks][1]); t.y = pk2(S[2 * ks][2], S[2 * ks][3]); t.z = pk2(S[2 * ks + 1][0], S[2 * ks + 1][1]); t.w = pk2(S[2 * ks + 1][2], S[2 * ks + 1][3]); sb[ks] = __builtin_bit_cast(bf16x8, t); }
        pg8::f32x4 o[4];
#pragma unroll
        for (int rt = 0; rt < 4; ++rt) { pg8::f32x4 a = {0.f, 0.f, 0.f, 0.f};
            a = __builtin_amdgcn_mfma_f32_16x16x32_bf16(*(const bf16x8*)(AM + (rt * 16 + fr) * HG_LDC + fq * 8), vb0, a, 0, 0, 0);
            a = __builtin_amdgcn_mfma_f32_16x16x32_bf16(*(const bf16x8*)(AM + (rt * 16 + fr) * HG_LDC + 32 + fq * 8), vb1, a, 0, 0, 0);
#pragma unroll
            for (int ks = 0; ks < 4; ++ks) { const v2u lo = *(const v2u*)(QE + (rt * 16 + fr) * HG_LDR + ks * 32 + fq * 4), hi = *(const v2u*)(QE + (rt * 16 + fr) * HG_LDR + ks * 32 + 16 + fq * 4);
                const v4u t = {lo.x, lo.y, hi.x, hi.y};
                a = __builtin_amdgcn_mfma_f32_16x16x32_bf16(__builtin_bit_cast(bf16x8, t), sb[ks], a, 0, 0, 0); }
            o[rt] = a; }
#pragma unroll
        for (int dt = 0; dt < 8; ++dt) { const f32x4 dc = *(const f32x4*)(DEC + dt * 16 + fq * 4);
            pg8::f32x4 a = S[dt]; a[0] *= dc[0]; a[1] *= dc[1]; a[2] *= dc[2]; a[3] *= dc[3];
            a = __builtin_amdgcn_mfma_f32_16x16x32_bf16(*(const bf16x8*)(KLT + (dt * 16 + fr) * HG_LDC + fq * 8), vb0, a, 0, 0, 0);
            a = __builtin_amdgcn_mfma_f32_16x16x32_bf16(*(const bf16x8*)(KLT + (dt * 16 + fr) * HG_LDC + 32 + fq * 8), vb1, a, 0, 0, 0);
            S[dt] = a; }
        if (half) {
#pragma unroll
            for (int rt = 0; rt < 4; ++rt) *(pg8::f32x4*)(OLg + ((((size_t)(chunk - 32)) * 8 + w) * 4 + rt) * 256 + lane * 4) = o[rt];
            __syncthreads();
            continue;
        }
#pragma unroll
        for (int rt = 0; rt < 4; ++rt)
#pragma unroll
            for (int r = 0; r < 4; ++r) { float x = o[rt][r] * o[rt][r];
                x += __shfl_xor(x, 1); x += __shfl_xor(x, 2); x += __shfl_xor(x, 4); x += __shfl_xor(x, 8);
                if (fr == 0) SSQ[w * 64 + rt * 16 + fq * 4 + r] = x; }
        __syncthreads();
        float tot = 0.f;
#pragma unroll
        for (int ww = 0; ww < 8; ++ww) tot += SSQ[ww * 64 + lane];
        const float rstd_l = rsqrtf(tot * (1.f / 128.f) + RMS_EPS);
#pragma unroll
        for (int rt = 0; rt < 4; ++rt)
#pragma unroll
            for (int r = 0; r < 4; ++r) { const int c = rt * 16 + fq * 4 + r; const float rs = __shfl(rstd_l, c);
                const float y = o[rt][r] * rs * ogv * siluf_(bf2f(rg[rt * 4 + r]));
                ((unsigned char*)YA)[(row0 + c) * 1024 + h * 128 + e0 + fr] = (unsigned char)(__builtin_amdgcn_cvt_pk_fp8_f32(y, 0.f, 0, false) & 0xff); }
    }
    if (!half) {
#pragma unroll
        for (int ks = 0; ks < 4; ++ks) { v4u t; t.x = pk2(S[2 * ks][0], S[2 * ks][1]); t.y = pk2(S[2 * ks][2], S[2 * ks][3]); t.z = pk2(S[2 * ks + 1][0], S[2 * ks + 1][1]); t.w = pk2(S[2 * ks + 1][2], S[2 * ks + 1][3]);
            *(v4u*)(ws + WS_HSB + ((((size_t)item * 8 + w) * 4 + ks) * 64 + lane) * 16) = t; }
    }
    __syncthreads();
}
__device__ __forceinline__ void hgrn_fix(const Params& p, unsigned char* lds, int item, int c) {
    const int b = item >> 2, h = item & 3;
    const int tid = threadIdx.x, w = tid >> 6, lane = tid & 63, fr = lane & 15, fq = lane >> 4;
    unsigned char* ws = p.ws;
    const bf16* HG = (const bf16*)(ws + WS_HG);
    bf16* YA = (bf16*)(ws + WS_H);
    float* SSQ = (float*)(lds + HGL_SSQ);
    const bf16* QCg = (const bf16*)(ws + WS_HQC) + (size_t)item * 2048 * 128; const float* OLg = (const float*)(ws + WS_HOL) + (size_t)item * 32 * 8 * 4 * 256;
    const int e0 = w * 16;
    const float ogv = p.hg_onorm_g[e0 + fr];
    const size_t row0 = (size_t)b * SEQ + (size_t)(32 + c) * 64;
    bf16x8 sb[4];
#pragma unroll
    for (int ks = 0; ks < 4; ++ks) sb[ks] = __builtin_bit_cast(bf16x8, *(const v4u*)(ws + WS_HSB + ((((size_t)item * 8 + w) * 4 + ks) * 64 + lane) * 16));
    unsigned short rg[16];
#pragma unroll
    for (int i = 0; i < 16; ++i) rg[i] = HG[(row0 + (i >> 2) * 16 + fq * 4 + (i & 3)) * LD_HG + 1536 + h * 128 + e0 + fr];
    pg8::f32x4 o[4];
#pragma unroll
    for (int rt = 0; rt < 4; ++rt) { pg8::f32x4 a = *(const pg8::f32x4*)(OLg + ((((size_t)c) * 8 + w) * 4 + rt) * 256 + lane * 4);
#pragma unroll
        for (int ks = 0; ks < 4; ++ks) { const bf16* qr = QCg + ((size_t)c * 64 + rt * 16 + fr) * 128 + ks * 32;
            const v2u lo = *(const v2u*)(qr + fq * 4), hi = *(const v2u*)(qr + 16 + fq * 4);
            const v4u t = {lo.x, lo.y, hi.x, hi.y};
            a = __builtin_amdgcn_mfma_f32_16x16x32_bf16(__builtin_bit_cast(bf16x8, t), sb[ks], a, 0, 0, 0); }
        o[rt] = a; }
#pragma unroll
    for (int rt = 0; rt < 4; ++rt)
#pragma unroll
        for (int r = 0; r < 4; ++r) { float x = o[rt][r] * o[rt][r];
            x += __shfl_xor(x, 1); x += __shfl_xor(x, 2); x += __shfl_xor(x, 4); x += __shfl_xor(x, 8);
            if (fr == 0) SSQ[w * 64 + rt * 16 + fq * 4 + r] = x; }
    __syncthreads();
    float tot = 0.f;
#pragma unroll
    for (int ww = 0; ww < 8; ++ww) tot += SSQ[ww * 64 + lane];
    const float rstd_l = rsqrtf(tot * (1.f / 128.f) + RMS_EPS);
#pragma unroll
    for (int rt = 0; rt < 4; ++rt)
#pragma unroll
        for (int r = 0; r < 4; ++r) { const int cc = rt * 16 + fq * 4 + r; const float rs = __shfl(rstd_l, cc);
            const float y = o[rt][r] * rs * ogv * siluf_(bf2f(rg[rt * 4 + r]));
            ((unsigned char*)YA)[(row0 + cc) * 1024 + h * 128 + e0 + fr] = (unsigned char)(__builtin_amdgcn_cvt_pk_fp8_f32(y, 0.f, 0, false) & 0xff); }
    __syncthreads();
}

__device__ __forceinline__ unsigned f16key(float x) {
    x = x + 0.f;
    const _Float16 hx = (_Float16)x; const unsigned short bits = __builtin_bit_cast(unsigned short, hx);
    return (bits & 0x8000u) ? (unsigned)(unsigned short)(~bits) : (unsigned)(bits | 0x8000u);
}
__device__ __forceinline__ void find_bin(const unsigned* hist, int K, int lane, int& bin, int& rem) {
    const v4u hv = *(const v4u*)(hist + 4 * lane);
    const unsigned c = hv.x + hv.y + hv.z + hv.w;
    unsigned suf = c;
#pragma unroll
    for (int o = 1; o < 64; o <<= 1) { const unsigned t = __shfl_down(suf, o); if (lane + o < 64) suf += t; }
    const unsigned above = suf - c;
    const bool mine = (above < (unsigned)K) && ((unsigned)K <= suf);
    int mybin = 0, myrem = 0;
    if (mine) { unsigned ca = above; const unsigned hh[4] = {hv.x, hv.y, hv.z, hv.w}; bool found = false;
#pragma unroll
        for (int i = 3; i >= 0; --i) { if (!found) { if (ca + hh[i] >= (unsigned)K) { mybin = 4 * lane + i; myrem = K - (int)ca; found = true; } else ca += hh[i]; } } }
    const unsigned long long m = __ballot(mine);
    const int src = (int)__builtin_ctzll(m | (1ull << 63));
    bin = __shfl(mybin, src); rem = __shfl(myrem, src);
}
__device__ __forceinline__ void dsa1_item(const Params& p, unsigned char* lds, int item) {
    const int b = item >> 8, q0 = (item & 255) * 16;
    const int tid = threadIdx.x, w = tid >> 6, lane = tid & 63, fr = lane & 15, fq = lane >> 4;
    unsigned char* ws = p.ws;
    const bf16* IDX = (const bf16*)(ws + WS_IDX);
    unsigned short* Ik = (unsigned short*)lds;
    unsigned* hist1 = (unsigned*)(lds + 131072);
    unsigned* hist = (unsigned*)(lds + 131072 + 16384) + w * 256;
    const size_t rowb = (size_t)b * SEQ;
    *(v4u*)(hist1 + tid * 4) = (v4u){0u, 0u, 0u, 0u}; *(v4u*)(hist1 + 2048 + tid * 4) = (v4u){0u, 0u, 0u, 0u};
    bf16x8 Af[8][2];
    { const bf16* rp = IDX + (rowb + q0 + fr) * LD_IDX + fq * 8;
#pragma unroll
      for (int h = 0; h < 8; ++h) { Af[h][0] = *(const bf16x8*)(rp + h * 64); Af[h][1] = *(const bf16x8*)(rp + h * 64 + 32); } }
    const float idx_scale = 0.5f * 0.125f * 0.35355339059327373f;
    bf16x8 Aw[2];
    { float wa[8];
      { const v4u wq = *(const v4u*)(IDX + (rowb + q0 + fr) * LD_IDX + 576);
#pragma unroll
        for (int i = 0; i < 4; ++i) { wa[2 * i] = bflo(wq[i]) * idx_scale; wa[2 * i + 1] = bfhi(wq[i]) * idx_scale; } }
#pragma unroll
      for (int ks = 0; ks < 2; ++ks) { float cq[8];
#pragma unroll
          for (int j = 0; j < 8; ++j) cq[j] = 0.f;
#pragma unroll
          for (int h = 0; h < 8; ++h)
#pragma unroll
              for (int j = 0; j < 8; ++j) cq[j] += wa[h] * bf2f((unsigned)(unsigned short)Af[h][ks][j]);
          const v4u t = {pk2(cq[0], cq[1]), pk2(cq[2], cq[3]), pk2(cq[4], cq[5]), pk2(cq[6], cq[7])};
          Aw[ks] = __builtin_bit_cast(bf16x8, t); } }
    float wv[4][8];
#pragma unroll
    for (int r = 0; r < 4; ++r) { const v4u wq = *(const v4u*)(IDX + (rowb + q0 + fq * 4 + r) * LD_IDX + 576);
#pragma unroll
        for (int i = 0; i < 4; ++i) { wv[r][2 * i] = bflo(wq[i]) * idx_scale; wv[r][2 * i + 1] = bfhi(wq[i]) * idx_scale; } }
    const int ntiles = (q0 >> 4) + 1;
    __syncthreads();
    bf16x8 B0 = Aw[0], B1 = Aw[1];
    if (w < ntiles) { const bf16* kp = IDX + (rowb + w * 16 + fr) * LD_IDX + 512 + fq * 8; B0 = *(const bf16x8*)kp; B1 = *(const bf16x8*)(kp + 32); }
    for (int kt = w; kt < ntiles; kt += NWAVES) {
        bf16x8 nB0 = B0, nB1 = B1;
        if (kt + NWAVES < ntiles) { const bf16* kp = IDX + (rowb + (kt + NWAVES) * 16 + fr) * LD_IDX + 512 + fq * 8; nB0 = *(const bf16x8*)kp; nB1 = *(const bf16x8*)(kp + 32); }
        pg8::f32x4 lin = {0.f, 0.f, 0.f, 0.f};
        lin = __builtin_amdgcn_mfma_f32_16x16x32_bf16(Aw[0], B0, lin, 0, 0, 0);
        lin = __builtin_amdgcn_mfma_f32_16x16x32_bf16(Aw[1], B1, lin, 0, 0, 0);
        float I[4] = {lin[0], lin[1], lin[2], lin[3]};
#pragma unroll
        for (int h = 0; h < 8; ++h) { pg8::f32x4 a = {0.f, 0.f, 0.f, 0.f};
            a = __builtin_amdgcn_mfma_f32_16x16x32_bf16(Af[h][0], B0, a, 0, 0, 0);
            a = __builtin_amdgcn_mfma_f32_16x16x32_bf16(Af[h][1], B1, a, 0, 0, 0);
#pragma unroll
            for (int r = 0; r < 4; ++r) I[r] = __builtin_fmaf(wv[r][h], __builtin_fabsf(a[r]), I[r]); }
        const int kidx = kt * 16 + fr;
#pragma unroll
        for (int r = 0; r < 4; ++r) { const unsigned key = f16key(I[r]); Ik[(fq * 4 + r) * 4096 + kidx] = (unsigned short)key;
            if (kidx <= q0 + fq * 4 + r) atomicAdd(&hist1[(fq * 4 + r) * 256 + (key >> 8)], 1u); }
        B0 = nB0; B1 = nB1;
    }
    __syncthreads();
    for (int qq = w; qq < 16; qq += NWAVES) {
        const int t = q0 + qq, n = t + 1;
        unsigned short* so = (unsigned short*)(hist1 + qq * 256);
        const unsigned short* keys = Ik + qq * 4096;
        if (n <= TOPK) { for (int j = lane; j < n; j += 64) so[j] = (unsigned short)j; }
        else {
            int b1, rem1, b2, rem2;
            find_bin(hist1 + qq * 256, TOPK, lane, b1, rem1);
            *(v4u*)(hist + 4 * lane) = (v4u){0u, 0u, 0u, 0u};
            LDS_WAIT(); __builtin_amdgcn_wave_barrier();
            for (int j0 = 0; j0 < n; j0 += 256) { unsigned k4[4];
#pragma unroll
                for (int u = 0; u < 4; ++u) { const int j = j0 + u * 64 + lane; k4[u] = keys[j < 4095 ? j : 4095]; }
#pragma unroll
                for (int u = 0; u < 4; ++u) { const int j = j0 + u * 64 + lane; if (j < n && (int)(k4[u] >> 8) == b1) atomicAdd(&hist[k4[u] & 255u], 1u); } }
            LDS_WAIT(); __builtin_amdgcn_wave_barrier();
            find_bin(hist, rem1, lane, b2, rem2);
            const unsigned thr = ((unsigned)b1 << 8) | (unsigned)b2;
            int base = 0, eqtaken = 0;
            const unsigned long long lt = (lane == 0) ? 0ull : (~0ull >> (64 - lane));
            for (int j0 = 0; j0 < n; j0 += 256) { unsigned k4[4];
#pragma unroll
                for (int u = 0; u < 4; ++u) { const int j = j0 + u * 64 + lane; k4[u] = keys[j < 4095 ? j : 4095]; }
#pragma unroll
                for (int u = 0; u < 4; ++u) {
                    const int j = j0 + u * 64 + lane; const bool valid = j < n; const unsigned k = valid ? k4[u] : 0u;
                    const bool gt = valid && k > thr, eq = valid && k == thr;
                    const unsigned long long meq = __ballot(eq);
                    const int erank = __popcll(meq & lt) + eqtaken;
                    const bool take = gt || (eq && erank < rem2);
                    const unsigned long long mt = __ballot(take);
                    if (take) so[base + __popcll(mt & lt)] = (unsigned short)j;
                    base += __popcll(mt); eqtaken += __popcll(meq);
                }
            }
        }
    }
    __syncthreads();
}

__device__ __forceinline__ void qknorm_token(const Params& p, int tok, int lane) {
    const bf16* row = (const bf16*)(p.ws + WS_ATT) + (size_t)tok * LD_ATT;
    const int c8 = (lane & 7) * 8;
    { const v4u qv = *(const v4u*)(row + lane * 8);
      float x[8]; float ss = 0.f;
#pragma unroll
      for (int i = 0; i < 4; ++i) { x[2 * i] = bflo(qv[i]); x[2 * i + 1] = bfhi(qv[i]); ss += x[2 * i] * x[2 * i] + x[2 * i + 1] * x[2 * i + 1]; }
      ss += __shfl_xor(ss, 1); ss += __shfl_xor(ss, 2); ss += __shfl_xor(ss, 4);
      const float rs = rsqrtf(ss * (1.f / 64.f) + RMS_EPS) * (0.125f * 1.4426950408889634f);
#pragma unroll
      for (int i = 0; i < 8; ++i) x[i] = x[i] * rs * p.q_norm_g[c8 + i];
      v2u hw, lw;
      hw.x = pk4_fp8(x[0], x[1], x[2], x[3]); hw.y = pk4_fp8(x[4], x[5], x[6], x[7]);
      { const f32x2 d0 = __builtin_amdgcn_cvt_pk_f32_fp8((int)hw.x, false), d1 = __builtin_amdgcn_cvt_pk_f32_fp8((int)hw.x, true), d2 = __builtin_amdgcn_cvt_pk_f32_fp8((int)hw.y, false), d3 = __builtin_amdgcn_cvt_pk_f32_fp8((int)hw.y, true);
        lw.x = pk4_fp8(x[0] - d0[0], x[1] - d0[1], x[2] - d1[0], x[3] - d1[1]); lw.y = pk4_fp8(x[4] - d2[0], x[5] - d2[1], x[6] - d3[0], x[7] - d3[1]); }
      *(v2u*)(p.ws + WS_QHI + (size_t)tok * 512 + lane * 8) = hw; *(v2u*)(p.ws + WS_QLO + (size_t)tok * 512 + lane * 8) = lw; }
    { const v4u kv = *(const v4u*)(row + 512 + (lane & 15) * 8);
      float x[8]; float ss = 0.f;
#pragma unroll
      for (int i = 0; i < 4; ++i) { x[2 * i] = bflo(kv[i]); x[2 * i + 1] = bfhi(kv[i]); ss += x[2 * i] * x[2 * i] + x[2 * i + 1] * x[2 * i + 1]; }
      ss += __shfl_xor(ss, 1); ss += __shfl_xor(ss, 2); ss += __shfl_xor(ss, 4);
      const float rs = rsqrtf(ss * (1.f / 64.f) + RMS_EPS);
#pragma unroll
      for (int i = 0; i < 8; ++i) x[i] = x[i] * rs * p.k_norm_g[c8 + i];
      v2u o; o.x = pk4_fp8(x[0], x[1], x[2], x[3]); o.y = pk4_fp8(x[4], x[5], x[6], x[7]);
      if (lane < 16) *(v2u*)(p.ws + WS_K8 + (size_t)tok * 128 + lane * 8) = o; }
    { const v4u vv = *(const v4u*)(row + 640 + (lane & 15) * 8);
      v2u o; o.x = pk4_fp8(bflo(vv[0]), bfhi(vv[0]), bflo(vv[1]), bfhi(vv[1])); o.y = pk4_fp8(bflo(vv[2]), bfhi(vv[2]), bflo(vv[3]), bfhi(vv[3]));
      if (lane < 16) *(v2u*)(p.ws + WS_V8 + (size_t)tok * 128 + lane * 8) = o; }
}

typedef short v4i16_t __attribute__((ext_vector_type(4)));
__device__ __forceinline__ v4i16_t vtr16(const bf16* ldsp) { return __builtin_amdgcn_ds_read_tr16_b64_v4i16((LAS v4i16_t*)ldsp); }
typedef int v2i_t __attribute__((ext_vector_type(2)));
__device__ __forceinline__ long vtr8(const unsigned char* ldsp) { const v2i_t r = __builtin_amdgcn_ds_read_tr8_b64_v2i32((LAS v2i_t*)ldsp); return (long)(((unsigned long long)(unsigned)r[1] << 32) | (unsigned)r[0]); }
__device__ __forceinline__ void dsa2_query(const Params& p, unsigned char* ldsw, const unsigned short* sel, int b, int t, int lane) {
    unsigned char* ws = p.ws;
    const bf16* ATT = (const bf16*)(ws + WS_ATT);
    bf16* YB = (bf16*)(ws + WS_H);
    unsigned short* sl = (unsigned short*)ldsw;
    float* df = (float*)(ldsw + 512);
    unsigned char* Vl = ldsw + 1536;
    const unsigned char* V8 = ws + WS_V8;
    const int fr = lane & 15, fq = lane >> 4;
    const size_t rowb = (size_t)b * SEQ;
    const int cnt = (t + 1 < TOPK) ? (t + 1) : TOPK;
    { v2u sv = *(const v2u*)(sel + lane * 4);
      const int j0 = lane * 4;
      if (j0 >= cnt) sv.x = 0u; else if (j0 + 1 >= cnt) sv.x &= 0xffffu;
      if (j0 + 2 >= cnt) sv.y = 0u; else if (j0 + 3 >= cnt) sv.y &= 0xffffu;
      *(v2u*)(sl + lane * 4) = sv;
      f32x4 d4; d4[0] = (j0 < cnt) ? (float)(t - (int)(sv.x & 0xffffu)) : INFINITY; d4[1] = (j0 + 1 < cnt) ? (float)(t - (int)(sv.x >> 16)) : INFINITY;
      d4[2] = (j0 + 2 < cnt) ? (float)(t - (int)(sv.y & 0xffffu)) : INFINITY; d4[3] = (j0 + 3 < cnt) ? (float)(t - (int)(sv.y >> 16)) : INFINITY;
      *(f32x4*)(df + lane * 4) = d4; }
    LDS_WAIT(); __builtin_amdgcn_wave_barrier();
    const unsigned char* K8 = ws + WS_K8;
    long qhA[2] = {0, 0}, qhB[2] = {0, 0}, qlA[2] = {0, 0}, qlB[2] = {0, 0};
    if (fr < 8) { const v4u qh = *(const v4u*)(ws + WS_QHI + (rowb + t) * 512 + fr * 64 + fq * 16), ql = *(const v4u*)(ws + WS_QLO + (rowb + t) * 512 + fr * 64 + fq * 16);
        const long hA = (long)(((unsigned long long)qh.y << 32) | qh.x), hB = (long)(((unsigned long long)qh.w << 32) | qh.z), lA = (long)(((unsigned long long)ql.y << 32) | ql.x), lB = (long)(((unsigned long long)ql.w << 32) | ql.z);
        if (fr < 4) { qhA[0] = hA; qhB[0] = hB; qlA[0] = lA; qlB[0] = lB; } else { qhA[1] = hA; qhB[1] = hB; qlA[1] = lA; qlB[1] = lB; } }
    pg8::f32x4 sc[16];
    v4u vv[8];
    {
        v4u G[8];
        unsigned char* kst = Vl;
        const int ksw = ((lane & 7) ^ (lane >> 3)) & 7;
#define K_LOADS(STEP) do { _Pragma("unroll") for (int j = 0; j < 8; ++j) { const int s_ = sl[(STEP) * 64 + j * 8 + (lane >> 3)]; G[j] = *(const v4u*)(K8 + (rowb + s_) * 128 + ((ksw ^ (j & 1)) & 7) * 16); } } while (0)
        K_LOADS(0);
#pragma unroll
        for (int step = 0; step < 4; ++step) {
            LDS_WAIT(); __builtin_amdgcn_wave_barrier();
#pragma unroll
            for (int j = 0; j < 8; ++j) *(v4u*)(kst + j * 1024 + lane * 16) = G[j];
            __builtin_amdgcn_sched_barrier(0);
            if (step < 3) K_LOADS(step + 1);
            else {
#pragma unroll
                for (int j = 0; j < 8; ++j) { const int s = sl[j * 8 + (lane >> 3)]; vv[j] = *(const v4u*)(V8 + (rowb + s) * 128 + (lane & 7) * 16); } }
            __builtin_amdgcn_sched_barrier(0);
            LDS_WAIT(); __builtin_amdgcn_wave_barrier();
#pragma unroll
            for (int kt = 0; kt < 4; ++kt) { pg8::f32x4 a = {0.f, 0.f, 0.f, 0.f};
#pragma unroll
                for (int gg = 0; gg < 2; ++gg) { const v4u kv = *(const v4u*)(kst + (kt * 16 + fr) * 128 + (((gg * 4 + fq) ^ (fr & 7) ^ (fr >> 3)) & 7) * 16);
                    const long kA = (long)(((unsigned long long)kv.y << 32) | kv.x), kB = (long)(((unsigned long long)kv.w << 32) | kv.z);
                    a = __builtin_amdgcn_mfma_f32_16x16x32_fp8_fp8(kA, qhA[gg], a, 0, 0, 0); a = __builtin_amdgcn_mfma_f32_16x16x32_fp8_fp8(kB, qhB[gg], a, 0, 0, 0);
                    a = __builtin_amdgcn_mfma_f32_16x16x32_fp8_fp8(kA, qlA[gg], a, 0, 0, 0); a = __builtin_amdgcn_mfma_f32_16x16x32_fp8_fp8(kB, qlB[gg], a, 0, 0, 0); }
                sc[step * 4 + kt] = a; }
        }
#undef K_LOADS
    }
    const float slope = exp2f(-(float)((fr & 7) + 1)) * 1.4426950408889634f;
    float m = -INFINITY;
#pragma unroll
    for (int kt = 0; kt < 16; ++kt) { const f32x4 d4 = *(const f32x4*)(df + kt * 16 + fq * 4);
#pragma unroll
        for (int r = 0; r < 4; ++r) { const float x = sc[kt][r] - slope * d4[r]; sc[kt][r] = x; m = fmaxf(m, x); } }
    m = fmaxf(m, __shfl_xor(m, 16)); m = fmaxf(m, __shfl_xor(m, 32));
    float l = 0.f;
#pragma unroll
    for (int kt = 0; kt < 16; ++kt)
#pragma unroll
        for (int r = 0; r < 4; ++r) { const float e = __builtin_amdgcn_exp2f(sc[kt][r] - m); sc[kt][r] = e; l += e; }
    l += __shfl_xor(l, 16); l += __shfl_xor(l, 32);
    const float inv = 1.f / l;
    pg8::f32x4 o[2][4];
#pragma unroll
    for (int g2 = 0; g2 < 2; ++g2)
#pragma unroll
        for (int dt = 0; dt < 4; ++dt) o[g2][dt] = (pg8::f32x4){0.f, 0.f, 0.f, 0.f};
    unsigned char* vdst = Vl + ((lane & 7) >> 2) * 6400 + (lane >> 3) * 80 + (lane & 3) * 16;
#pragma unroll
    for (int ch = 0; ch < 4; ++ch) {
        LDS_WAIT(); __builtin_amdgcn_wave_barrier();
#pragma unroll
        for (int j = 0; j < 8; ++j) *(v4u*)(vdst + ((j >> 2) * 40 + ((j >> 1) & 1) * 24 + (j & 1) * 8) * 80) = vv[j];
        if (ch < 3) {
#pragma unroll
            for (int j = 0; j < 8; ++j) { const int s = sl[(ch + 1) * 64 + j * 8 + (lane >> 3)]; vv[j] = *(const v4u*)(V8 + (rowb + s) * 128 + (lane & 7) * 16); } }
        LDS_WAIT(); __builtin_amdgcn_wave_barrier();
#pragma unroll
        for (int k2 = 0; k2 < 2; ++k2) { const int kt0 = ch * 4 + 2 * k2;
            const long pb = (long)(((unsigned long long)pk4_fp8(sc[kt0 + 1][0], sc[kt0 + 1][1], sc[kt0 + 1][2], sc[kt0 + 1][3]) << 32) | pk4_fp8(sc[kt0][0], sc[kt0][1], sc[kt0][2], sc[kt0][3]));
            const int q = fr >> 1, prow = k2 * 40 + ((q < 4) ? (fq * 4 + q) : (24 + fq * 4 + (q - 4)));
#pragma unroll
            for (int g2 = 0; g2 < 2; ++g2)
#pragma unroll
                for (int dt = 0; dt < 4; ++dt) o[g2][dt] = __builtin_amdgcn_mfma_f32_16x16x32_fp8_fp8(vtr8(Vl + g2 * 6400 + prow * 80 + dt * 16 + (fr & 1) * 8), pb, o[g2][dt], 0, 0, 0); }
    }
    { const float i8 = inv * 8.f; unsigned char* yp = (unsigned char*)YB + (rowb + t) * 1024 + 512 + fr * 64 + fq * 4;
      if (fr < 4) {
#pragma unroll
          for (int dt = 0; dt < 4; ++dt) *(unsigned*)(yp + dt * 16) = pk4_fp8(o[0][dt][0] * i8, o[0][dt][1] * i8, o[0][dt][2] * i8, o[0][dt][3] * i8); }
      else if (fr < 8) {
#pragma unroll
          for (int dt = 0; dt < 4; ++dt) *(unsigned*)(yp + dt * 16) = pk4_fp8(o[1][dt][0] * i8, o[1][dt][1] * i8, o[1][dt][2] * i8, o[1][dt][3] * i8); } }
    LDS_WAIT(); __builtin_amdgcn_wave_barrier();
}

#define INS16(L, x) do { _Pragma("unroll") for (int _i = 15; _i >= 1; --_i) L[_i] = __builtin_amdgcn_fmed3f(L[_i - 1], L[_i], (x)); L[0] = fmaxf(L[0], (x)); } while (0)
__device__ __forceinline__ float f_andor(float v, unsigned keepmask, unsigned orv) { return __builtin_bit_cast(float, (__builtin_bit_cast(unsigned, v) & keepmask) | orv); }
__device__ __forceinline__ void peer_select(const Params& p, unsigned char* ldsw, int tg, int h, int lane, int* EIDX, float* GATES) {
    float* sc = (float*)ldsw;
    LDS_WAIT(); __builtin_amdgcn_wave_barrier();
    float L[16];
#pragma unroll
    for (int i = 0; i < 16; ++i) L[i] = -INFINITY;
    { const float* sp = sc + (lane & 31) * 132 + (lane >> 5) * 64;
#pragma unroll 4
      for (int i = 0; i < 16; ++i) { const f32x4 x = *(const f32x4*)(sp + 4 * i); INS16(L, x[0]); INS16(L, x[1]); INS16(L, x[2]); INS16(L, x[3]); } }
    { float O[16];
#pragma unroll
      for (int i = 0; i < 16; ++i) O[i] = __shfl_xor(L[i], 32);
#pragma unroll
      for (int i = 0; i < 16; ++i) INS16(L, O[i]); }
    LDS_WAIT(); __builtin_amdgcn_wave_barrier();
    float* lst = sc;
    if (lane < 32) {
#pragma unroll
        for (int i = 0; i < 4; ++i) *(f32x4*)(lst + lane * 16 + 4 * i) = (f32x4){L[4 * i], L[4 * i + 1], L[4 * i + 2], L[4 * i + 3]}; }
    LDS_WAIT(); __builtin_amdgcn_wave_barrier();
    const int tok = lane & 15;
    float s1[16], s2[16];
#pragma unroll
    for (int i = 0; i < 4; ++i) { const f32x4 a = *(const f32x4*)(lst + tok * 16 + 4 * i), b = *(const f32x4*)(lst + (16 + tok) * 16 + 4 * i);
#pragma unroll
        for (int c = 0; c < 4; ++c) { s1[4 * i + c] = f_andor(a[c], ~127u, 0u); s2[4 * i + c] = f_andor(b[c], ~127u, 0u); } }
    float M[16];
#pragma unroll
    for (int i = 0; i < 16; ++i) M[i] = -INFINITY;
#pragma unroll
    for (int a = 0; a < 16; ++a)
#pragma unroll
        for (int b = 0; b < 16; ++b)
            if ((a + 1) * (b + 1) <= 16) { const float key = f_andor(s1[a] + s2[b], ~255u, (unsigned)(a * 16 + b)); INS16(M, key); }
    const float mx = f_andor(M[0], ~255u, 0u);
    float e[16], sum = 0.f; int ei[16];
    const unsigned* lb = (const unsigned*)lst;
#pragma unroll
    for (int i = 0; i < 16; ++i) { const unsigned bits = __builtin_bit_cast(unsigned, M[i]); const int flat = bits & 255u;
        e[i] = __expf(f_andor(M[i], ~255u, 0u) - mx); sum += e[i];
        ei[i] = (int)(lb[tok * 16 + (flat >> 4)] & 127u) * 128 + (int)(lb[(16 + tok) * 16 + (flat & 15)] & 127u); }
    const float inv = 1.f / sum;
    if (lane < 16) {
        const size_t ob = ((size_t)tok * 8 + h) * 16;
#pragma unroll
        for (int i = 0; i < 4; ++i) { *(v4u*)(EIDX + ob + 4 * i) = (v4u){(unsigned)ei[4 * i], (unsigned)ei[4 * i + 1], (unsigned)ei[4 * i + 2], (unsigned)ei[4 * i + 3]};
            *(f32x4*)(GATES + ob + 4 * i) = (f32x4){e[4 * i] * inv, e[4 * i + 1] * inv, e[4 * i + 2] * inv, e[4 * i + 3] * inv}; }
    }
    LDS_WAIT(); __builtin_amdgcn_wave_barrier();
}

__device__ __forceinline__ void peer_route_block(const Params& p, unsigned char* lds, int* eG, float* gG) {
    const int tid = threadIdx.x, wave = tid >> 6, lane = tid & 63, fr = lane & 15, fq = lane >> 4, G = gridDim.x;
    unsigned char* ws = p.ws;
    const bf16* Q = (const bf16*)(ws + WS_Q);
    const unsigned char* SKb = ws + WS_SK;
    unsigned char* tile = lds + 8 * 16896;
    float* sc = (float*)(lds + wave * 16896);
    int ngrp = 0;
    for (int tg = blockIdx.x; tg < T / 16; tg += G) ++ngrp;
#pragma unroll 1
    for (int k0 = 0; k0 < ngrp; k0 += 8) {
        const bool valid = k0 + wave < ngrp;
        const int tg = (int)blockIdx.x + (valid ? k0 + wave : k0) * G;
        v4u t[4][2];
        bf16x8 An[2][4];
#pragma unroll
        for (int sub = 0; sub < 4; ++sub) { const unsigned char* sp = SKb + (size_t)sub * 16384 + tid * 32; t[sub][0] = *(const v4u*)sp; t[sub][1] = *(const v4u*)(sp + 16); }
#pragma unroll
        for (int pp = 0; pp < 2; ++pp) { const bf16* rp = Q + (size_t)(tg * 16 + fr) * 2048 + pp * 128 + fq * 8;
#pragma unroll
            for (int ks = 0; ks < 4; ++ks) An[pp][ks] = *(const bf16x8*)(rp + ks * 32); }
#pragma unroll 1
        for (int h = 0; h < 8; ++h) {
            bf16x8 Af[2][4];
#pragma unroll
            for (int pp = 0; pp < 2; ++pp)
#pragma unroll
                for (int ks = 0; ks < 4; ++ks) Af[pp][ks] = An[pp][ks];
            const int hn = (h + 1) & 7;
#pragma unroll
            for (int sub = 0; sub < 4; ++sub) {
                const int pp = sub >> 1, half = sub & 1;
                __syncthreads();
                { unsigned char* wp = tile + (tid >> 3) * 272 + (tid & 7) * 32; *(v4u*)wp = t[sub][0]; *(v4u*)(wp + 16) = t[sub][1]; }
                { const unsigned char* sp = SKb + (size_t)(hn * 4 + sub) * 16384 + tid * 32; t[sub][0] = *(const v4u*)sp; t[sub][1] = *(const v4u*)(sp + 16); }
                __syncthreads();
#pragma unroll
                for (int kt = 0; kt < 4; ++kt) {
                    pg8::f32x4 a = {0.f, 0.f, 0.f, 0.f};
#pragma unroll
                    for (int ks = 0; ks < 4; ++ks) { const bf16x8 bv = *(const bf16x8*)(tile + (kt * 16 + fr) * 272 + ks * 64 + fq * 16); a = __builtin_amdgcn_mfma_f32_16x16x32_bf16(Af[pp][ks], bv, a, 0, 0, 0); }
                    const int kg = (half * 4 + kt) * 16 + fr;
#pragma unroll
                    for (int r = 0; r < 4; ++r) sc[(pp * 16 + fq * 4 + r) * 132 + kg] = f_andor(a[r], ~127u, (unsigned)kg);
                }
            }
#pragma unroll
            for (int pp = 0; pp < 2; ++pp) { const bf16* rp = Q + (size_t)(tg * 16 + fr) * 2048 + hn * 256 + pp * 128 + fq * 8;
#pragma unroll
                for (int ks = 0; ks < 4; ++ks) An[pp][ks] = *(const bf16x8*)(rp + ks * 32); }
            if (valid) peer_select(p, (unsigned char*)sc, tg, h, lane, eG + (size_t)tg * 2048, gG + (size_t)tg * 2048);
        }
    }
}

__device__ __forceinline__ float gelu_erf(float x) { return 0.5f * x * (1.f + erff(x * 0.70710678118654752f)); }
typedef int v8i_t __attribute__((ext_vector_type(8)));
template <int OPSEL> __device__ __forceinline__ pg8::f32x4 mx_dot(v8i_t a, int sa, v8i_t b, int sb, pg8::f32x4 c) {
    return __builtin_amdgcn_mfma_scale_f32_16x16x128_f8f6f4(a, b, c, 4  , 4  , OPSEL, sa, OPSEL, sb);
}
__device__ __forceinline__ void peer_token(const Params& p, unsigned char* ldsw, const _Float16* usL, const _Float16* vsL, unsigned char* tile, int tok, int lane, const v2u nxt_e, const v2u nxt_g, int buf) {
    unsigned char* ws = p.ws;
    const unsigned char* V8 = ws + WS_V;
    const float* MOD = (const float*)(ws + WS_MOD);
    const int fr = lane & 15, fq = lane >> 4;
    typedef v8i_t v8i;
    const int* EIDX = (const int*)(ldsw + buf * 1024); const float* GATES = (const float*)(ldsw + buf * 1024 + 512);
    v4u A4[H4_NT][8]; v2u As[H4_NT];
#pragma unroll
    for (int t = 0; t < H4_NT; ++t) { const unsigned char* hp = ws + WS_H4D + ((size_t)tok * H4_NT + t) * 512 + fq * 16;
        As[t] = *(const v2u*)(ws + WS_H4S + ((size_t)tok * H4_NT + t) * 32 + fq * 8);
#pragma unroll
        for (int kk = 0; kk < 8; ++kk) A4[t][kk] = *(const v4u*)(hp + kk * 64); }
    int* pe = (int*)(ldsw + 2048); float* pa = (float*)(ldsw + 2048 + 512);
    const unsigned char* U4 = ws + WS_U;
    const int gr = lane >> 3, gs = lane & 7;
    const int rdbase = (fr >> 3) * 1024 + (fr & 7) * 128, slotA = (fq ^ (fr & 7) ^ (fr >> 3)) & 7;
    v4u G[8];
#define U_LOADS(CT) do { const int e0_ = EIDX[(CT) * 16 + gr], e1_ = EIDX[(CT) * 16 + 8 + gr]; \
        const unsigned char* p0_ = U4 + (size_t)e0_ * 512 + ((gs ^ gr) & 7) * 16; const unsigned char* p1_ = U4 + (size_t)e1_ * 512 + ((gs ^ gr ^ 1) & 7) * 16; \
        _Pragma("unroll") for (int kk = 0; kk < 8; ++kk) G[kk] = *(const v4u*)(((kk & 1) ? p1_ : p0_) + (kk >> 1) * 128); } while (0)
    U_LOADS(0);
#pragma unroll 1
    for (int ct = 0; ct < 8; ++ct) {
        const int eic = EIDX[ct * 16 + fr]; const float gt = GATES[ct * 16 + fr];
#pragma unroll
        for (int kk = 0; kk < 8; ++kk) *(v4u*)(tile + kk * 1024 + lane * 16) = G[kk];
        __builtin_amdgcn_sched_barrier(0);
        U_LOADS((ct + 1) & 7);
        __builtin_amdgcn_sched_barrier(0);
        LDS_WAIT(); __builtin_amdgcn_wave_barrier();
        v4u Bt[8];
#pragma unroll
        for (int j = 0; j < 8; ++j) Bt[j] = *(const v4u*)(tile + (j >> 1) * 2048 + rdbase + (((j & 1) ? (slotA ^ 4) : slotA) * 16));
        LDS_WAIT(); __builtin_amdgcn_wave_barrier();
        pg8::f32x4 ah = {0.f, 0.f, 0.f, 0.f};
#pragma unroll
        for (int kk = 0; kk < 8; ++kk) { const v4u bu = Bt[kk];
            const v8i bb = {(int)bu.x, (int)bu.y, (int)bu.z, (int)bu.w, 0, 0, 0, 0};
            const int sb = 0x7f7f7f7f;
#pragma unroll
            for (int t = 0; t < H4_NT; ++t) { const v8i aa = {(int)A4[t][kk].x, (int)A4[t][kk].y, (int)A4[t][kk].z, (int)A4[t][kk].w, 0, 0, 0, 0}; const int sa = (int)((kk < 4) ? As[t].x : As[t].y);
                if ((kk & 3) == 0) ah = mx_dot<0>(aa, sa, bb, sb, ah); else if ((kk & 3) == 1) ah = mx_dot<1>(aa, sa, bb, sb, ah); else if ((kk & 3) == 2) ah = mx_dot<2>(aa, sa, bb, sb, ah); else ah = mx_dot<3>(aa, sa, bb, sb, ah); } }
        const float dot = ah[0] * (float)usL[eic];
        if (fq == 0) { pe[ct * 16 + fr] = eic; pa[ct * 16 + fr] = gelu_erf(dot) * gt * (float)vsL[eic]; }
    }
    asm volatile("" :: "v"(G[0]), "v"(G[1]), "v"(G[2]), "v"(G[3]), "v"(G[4]), "v"(G[5]), "v"(G[6]), "v"(G[7]));
#undef U_LOADS
    __builtin_amdgcn_sched_barrier(0);
    { int* ne = (int*)(ldsw + (buf ^ 1) * 1024); float* ng = (float*)(ldsw + (buf ^ 1) * 1024 + 512);
      *(v2u*)(ne + 2 * lane) = nxt_e; *(v2u*)(ng + 2 * lane) = nxt_g; }
    const int hl = lane >> 5, bl = lane & 31;
    float acc[32];
#pragma unroll
    for (int i = 0; i < 32; ++i) acc[i] = 0.f;
    LDS_WAIT(); __builtin_amdgcn_wave_barrier();
#pragma unroll 1
    for (int ct = 0; ct < 16; ++ct)
#pragma unroll
        for (int jp = 0; jp < 4; ++jp) {
            const int idx = pe[ct * 8 + 2 * jp + hl]; const float as = pa[ct * 8 + 2 * jp + hl];
            const v4u vv = *(const v4u*)(V8 + (size_t)idx * 512 + bl * 16);
#pragma unroll
            for (int w4 = 0; w4 < 4; ++w4) { const unsigned wd = vv[w4];
                const f32x2 d0 = __builtin_amdgcn_cvt_scalef32_pk_f32_fp4(wd, 1.0f, 0), d1 = __builtin_amdgcn_cvt_scalef32_pk_f32_fp4(wd, 1.0f, 1), d2 = __builtin_amdgcn_cvt_scalef32_pk_f32_fp4(wd, 1.0f, 2), d3 = __builtin_amdgcn_cvt_scalef32_pk_f32_fp4(wd, 1.0f, 3);
                acc[8 * w4] += as * d0[0]; acc[8 * w4 + 1] += as * d0[1]; acc[8 * w4 + 2] += as * d1[0]; acc[8 * w4 + 3] += as * d1[1];
                acc[8 * w4 + 4] += as * d2[0]; acc[8 * w4 + 5] += as * d2[1]; acc[8 * w4 + 6] += as * d3[0]; acc[8 * w4 + 7] += as * d3[1]; }
        }
    LDS_WAIT(); __builtin_amdgcn_wave_barrier();
    float accs[16];
#pragma unroll
    for (int i = 0; i < 16; ++i) { const float lo = acc[i] + __shfl_xor(acc[i], 32), hi2 = acc[16 + i] + __shfl_xor(acc[16 + i], 32); accs[i] = hl ? hi2 : lo; }
    const int b = tok / SEQ;
    const int col0 = bl * 32 + hl * 16;
    const float* g2 = MOD + (size_t)b * 6144 + 5 * 1024 + col0;
    float* orow = p.out + (size_t)tok * DM + col0;
#pragma unroll
    for (int q4 = 0; q4 < 4; ++q4) { const f32x4 xv = *(const f32x4*)(orow + 4 * q4), gv = *(const f32x4*)(g2 + 4 * q4);
        f32x4 o;
#pragma unroll
        for (int i = 0; i < 4; ++i) o[i] = xv[i] + gv[i] * accs[4 * q4 + i];
        *(f32x4*)(orow + 4 * q4) = o; }
}

#define XB_TMO      128
#define XB_XCNT(j)  (256  + 64 * (j))
#define XB_XSUB(j)  (1280 + 64 * (j))
#define XB_XGEN(j)  (2304 + 64 * (j))
#define XB_TOP      3328
#define XB_TOPGEN   3392
#define XCD_BAR_WORDS 3456
#define XB_SPIN_CAP (1u << 18)

__device__ __forceinline__ unsigned xb_ld(unsigned* p)              { return __hip_atomic_load(p, __ATOMIC_RELAXED, __HIP_MEMORY_SCOPE_AGENT); }
__device__ __forceinline__ unsigned xb_add(unsigned* p, unsigned v) { return __hip_atomic_fetch_add(p, v, __ATOMIC_RELAXED, __HIP_MEMORY_SCOPE_AGENT); }
__device__ __forceinline__ unsigned xb_xcc_id() { return (unsigned)__builtin_amdgcn_s_getreg((3 << 11) | 20) & 0xFu; }
#define XB_SPIN(cond, bar) do { unsigned _sp = 0; while (cond) { __builtin_amdgcn_s_sleep(1); \
    if ((++_sp & 255u) == 0u) { if (xb_ld(&(bar)[XB_TMO])) break; if (_sp > XB_SPIN_CAP) { atomicAdd(&(bar)[XB_TMO], 1u); break; } } } } while (0)

struct XcdBarrier {
    unsigned* bar; unsigned x;
    volatile LAS unsigned* st;
};

__device__ __forceinline__ XcdBarrier xcd_barrier_post(unsigned* bar, volatile LAS unsigned* st) {
    XcdBarrier b; b.bar = bar; b.x = xb_xcc_id(); b.st = st;
    if (threadIdx.x == 0) (void)xb_add(&bar[XB_XCNT(b.x)], 1u);
    return b;
}
__device__ __forceinline__ void xcd_barrier_complete(unsigned* bar, unsigned x, unsigned& nloc, unsigned& nx) {
    const unsigned G = gridDim.x * gridDim.y * gridDim.z;
    unsigned sum, cnt, mine, sp = 0u;
    for (;;) {
        sum = 0u; cnt = 0u; mine = 0u;
#pragma unroll
        for (unsigned j = 0; j < 16; ++j) { const unsigned c = xb_ld(&bar[XB_XCNT(j)]); sum += c; cnt += (c > 0u) ? 1u : 0u; mine = (j == x) ? c : mine; }
        if (sum == G) break;
        __builtin_amdgcn_s_sleep(1);
        if ((++sp & 255u) == 0u) { if (xb_ld(&bar[XB_TMO])) break; if (sp > XB_SPIN_CAP) { atomicAdd(&bar[XB_TMO], 1u); break; } }
    }
    nloc = mine > 0u ? mine : 1u; nx = cnt > 0u ? cnt : 1u;
}

__device__ __forceinline__ void xcd_barrier(const XcdBarrier& b) {
    asm volatile("s_waitcnt vmcnt(0)" ::: "memory");
    __syncthreads();
    if (threadIdx.x == 0) {
        unsigned* bar = b.bar;
        __builtin_amdgcn_s_waitcnt(0);
        unsigned nloc = b.st[0], nx = b.st[1];
        if (nloc == 0u) { xcd_barrier_complete(bar, b.x, nloc, nx); b.st[0] = nloc; b.st[1] = nx; }
        const unsigned old = xb_add(&bar[XB_XSUB(b.x)], 1u);
        const unsigned gen = old / nloc;
        if (old + 1u == (gen + 1u) * nloc) {
            __builtin_amdgcn_fence(__ATOMIC_RELEASE, "agent");
            asm volatile("s_waitcnt vmcnt(0)" ::: "memory");
            const unsigned og = xb_add(&bar[XB_TOP], 1u);
            const unsigned tg = og / nx;
            if (og + 1u == (tg + 1u) * nx) xb_add(&bar[XB_TOPGEN], 1u);
            else XB_SPIN(xb_ld(&bar[XB_TOPGEN]) == tg, bar);
            __builtin_amdgcn_fence(__ATOMIC_ACQUIRE, "agent");
            xb_add(&bar[XB_XGEN(b.x)], 1u);
            asm volatile("s_waitcnt vmcnt(0)" ::: "memory");
        } else {
            XB_SPIN(xb_ld(&bar[XB_XGEN(b.x)]) == gen, bar);
            __builtin_amdgcn_fence(__ATOMIC_ACQUIRE, "agent");
            asm volatile("s_waitcnt vmcnt(0)" ::: "memory");
        }
    }
    __syncthreads();
}

constexpr int NPHASE = 11;
__global__ void __launch_bounds__(NTHREADS, 2) mega(Params p) {
    extern __shared__ __attribute__((aligned(16))) unsigned char lds[];
    cg::grid_group grid = cg::this_grid();
    const int lo = p.ph_lo, hi = p.ph_hi;
    const int tid = threadIdx.x, wave = tid >> 6, lane = tid & 63, G = gridDim.x;
    unsigned char* ws = p.ws;
#ifndef ONLYPH
#define IN(k) (lo <= (k) && (k) < hi)
#else
#define IN(k) ((k) == ONLYPH && lo <= (k) && (k) < hi)
#endif
    volatile LAS unsigned* xb_st = (volatile LAS unsigned*)((LAS unsigned char*)lds + (LDS_BYTES - 16));
    if (tid < 4) xb_st[tid] = 0u;
    __syncthreads();
    XcdBarrier xbar; xbar.bar = (unsigned*)(ws + WS_CTL); xbar.x = 0; xbar.st = xb_st;
    if (hi - lo > 1) xbar = xcd_barrier_post((unsigned*)(ws + WS_CTL), xb_st);
    if (lo < -1) grid.sync();
#define SEAM(k) do { if (IN((k) + 1)) xcd_barrier(xbar); } while (0)
#ifndef REPMASK
#define REPMASK 0
#endif
#define NREP(k) (((REPMASK >> (k)) & 1) ? 2 : 1)
    if (IN(0)) { for (int rep = 0; rep < NREP(0); ++rep) phase0(p, lds); SEAM(0); }
    if (IN(1)) { for (int rep = 0; rep < NREP(1); ++rep) normmod_phase<true>(p, lds, p.x, (bf16*)(ws + WS_H), p.norm1_g, 0, 1024); SEAM(1); }
    if (IN(2)) {
        { pg8::Gemm g{(const bf16*)(ws + WS_H8), (const bf16*)(ws + WS_WIN8), T, 3584, 512, 512, 512}; pg8::StaticOrder S; S.init(T, 3584, G, (int)blockIdx.x);
          EpiProj E{(bf16*)(ws + WS_HG), (bf16*)(ws + WS_ATT), (bf16*)(ws + WS_IDX), (bf16*)(ws + WS_GATE), 1};
          pg8::gemm_phase<EpiProj, pg8::StaticOrder, true, true, 122>((PG8_LAS unsigned char*)lds, g, S, E); }
        { pg8::Gemm g{(const bf16*)(ws + WS_H), (const bf16*)(ws + WS_WIN), T, 2048, 1024, 1024, 1024}; pg8::StaticOrder S; S.init(T, 2048, G, (int)blockIdx.x);
          EpiProj E{(bf16*)(ws + WS_HG), (bf16*)(ws + WS_ATT), (bf16*)(ws + WS_IDX), (bf16*)(ws + WS_GATE), 0};
          pg8::gemm_phase<EpiProj, pg8::StaticOrder, true, true>((PG8_LAS unsigned char*)lds, g, S, E); }
        SEAM(2);
    }
    if (IN(3)) {
        for (int tok = (int)blockIdx.x * NWAVES + wave; tok < T; tok += G * NWAVES) qknorm_token(p, tok, lane);
        SEAM(3);
    }
    if (IN(4)) {
        if ((int)blockIdx.x < 32) hgrn_item<0>(p, lds, (int)blockIdx.x); else if ((int)blockIdx.x < 64) hgrn_item<1>(p, lds, (int)blockIdx.x - 32);
        {
            unsigned* qctr = (unsigned*)(ws + WS_CTL + 32768);
            volatile LAS unsigned* qslot = (volatile LAS unsigned*)((LAS unsigned char*)lds + (LDS_BYTES - 32));
            int qsel = (int)(blockIdx.x & 7u), tried = 0;
            for (;;) {
                if (tid == 0) { unsigned c;
                    for (;;) { c = __hip_atomic_fetch_add(qctr + qsel * 64, 1u, __ATOMIC_RELAXED, __HIP_MEMORY_SCOPE_AGENT); if (c < (unsigned)(SEQ / 16) || tried >= 7) break; qsel = (qsel + 1) & 7; ++tried; }
                    *qslot = (c < (unsigned)(SEQ / 16)) ? (((unsigned)qsel << 16) | c) : 0xffffffffu; }
                __syncthreads();
                const unsigned c = *qslot;
                __syncthreads();
                if (c == 0xffffffffu) break;
                const int b = (int)(c >> 16), qblk = (SEQ / 16 - 1) - (int)(c & 0xffffu), it = b * (SEQ / 16) + qblk, q0 = qblk * 16;
                dsa1_item(p, lds, it);
#pragma unroll 1
                for (int k2 = 0; k2 < 2; ++k2) dsa2_query(p, lds + wave * 16384, (const unsigned short*)(lds + 131072 + (wave + 8 * k2) * 1024), b, q0 + wave + 8 * k2, lane);
                __syncthreads();
            }
        }
        if (hi - lo > 1) xcd_barrier(xbar);
        for (int u = blockIdx.x; u < 32 * 32; u += G) hgrn_fix(p, lds, u >> 5, u & 31);
        SEAM(4);
    }
    if (IN(5)) {
        pg8::Gemm g{(const bf16*)(ws + WS_H), (const bf16*)(ws + WS_WAB8), T, 1024, 256, 512, 512}; pg8::StaticOrderT<true> S; S.init(T, 1024, G, (int)blockIdx.x, 256);
        EpiMerged E{(const bf16*)(ws + WS_GATE), (bf16*)(ws + WS_MERGED)};
        for (int rep = 0; rep < NREP(5); ++rep) pg8::gemm_phase<EpiMerged, pg8::StaticOrderT<true>, true, true, 122>((PG8_LAS unsigned char*)lds, g, S, E);
        SEAM(5);
    }
    if (IN(6)) {
        pg8::Gemm g{(const bf16*)(ws + WS_MERGED), (const bf16*)(ws + WS_WOUT8), T, 1024, 512, 512, 512}; pg8::StaticOrder S; S.init(T, 1024, G, (int)blockIdx.x);
        EpiResid E{p.x, (const float*)(ws + WS_MOD) + 2048, p.out};
        for (int rep = 0; rep < NREP(6); ++rep) pg8::gemm_phase<EpiResid, pg8::StaticOrder, true, true, 120>((PG8_LAS unsigned char*)lds, g, S, E);
        SEAM(6);
    }
    if (IN(7)) { for (int rep = 0; rep < NREP(7); ++rep) normmod_phase<false>(p, lds, p.out, (bf16*)(ws + WS_H), p.norm2_g, 3 * 1024, 4 * 1024); SEAM(7); }
    if (IN(8)) {
        pg8::Gemm g{(const bf16*)(ws + WS_H), (const bf16*)(ws + WS_WQ), T, 2048, 1024, 1024, 1024}; pg8::StaticOrder S; S.init(T, 2048, G, (int)blockIdx.x);
        EpiStore E{(bf16*)(ws + WS_Q), 2048};
        for (int rep = 0; rep < NREP(8); ++rep) pg8::gemm_phase<EpiStore, pg8::StaticOrder, true, true>((PG8_LAS unsigned char*)lds, g, S, E);
        SEAM(8);
    }
    if (IN(9)) {
        int* eG = (int*)(ws + WS_EIDX); float* gG = (float*)(ws + WS_PGATE);
        peer_route_block(p, lds, eG, gG);
        asm volatile("s_waitcnt vmcnt(0)" ::: "memory");
        __syncthreads();
        _Float16* usL = (_Float16*)lds; _Float16* vsL = (_Float16*)(lds + 32768);
        for (int i = tid; i < NEXP / 8; i += NTHREADS) { ((v4u*)usL)[i] = ((const v4u*)(ws + WS_US))[i]; ((v4u*)vsL)[i] = ((const v4u*)(ws + WS_VS))[i]; }
        unsigned char* ldsw = lds + 65536 + wave * 3072;
        int ntok = 0;
        for (int tg = blockIdx.x; tg < T / 16; tg += G) ntok += 2;
        auto tok_of = [&](int j) { return ((int)blockIdx.x + (j >> 1) * G) * 16 + wave + 8 * (j & 1); };
        auto ld_lists = [&](int tok, v2u& e, v2u& g) {
            const unsigned* ep = (const unsigned*)(eG + (size_t)tok * 128 + 2 * lane); const unsigned* gp = (const unsigned*)(gG + (size_t)tok * 128 + 2 * lane);
            e.x = __hip_atomic_load(ep, __ATOMIC_RELAXED, __HIP_MEMORY_SCOPE_AGENT); e.y = __hip_atomic_load(ep + 1, __ATOMIC_RELAXED, __HIP_MEMORY_SCOPE_AGENT);
            g.x = __hip_atomic_load(gp, __ATOMIC_RELAXED, __HIP_MEMORY_SCOPE_AGENT); g.y = __hip_atomic_load(gp + 1, __ATOMIC_RELAXED, __HIP_MEMORY_SCOPE_AGENT); };
        if (ntok > 0) { v2u e0, g0; ld_lists(tok_of(0), e0, g0); *(v2u*)((int*)ldsw + 2 * lane) = e0; *(v2u*)((float*)(ldsw + 512) + 2 * lane) = g0; }
        __syncthreads();
#pragma unroll 1
        for (int j = 0; j < ntok; ++j) {
            v2u ne = {0u, 0u}, ng = {0u, 0u};
            if (j + 1 < ntok) ld_lists(tok_of(j + 1), ne, ng);
            peer_token(p, ldsw, usL, vsL, lds + 90112 + wave * 8192, tok_of(j), lane, ne, ng, j & 1);
            LDS_WAIT(); __builtin_amdgcn_wave_barrier();
        }
    }
#undef IN
#undef SEAM
}

#ifndef ONE_LAUNCH
#define ONE_LAUNCH 1
#endif
extern "C" void kernel_launch(void* const* d_in, const int* in_sizes, int n_in, void* d_out, int out_size, void* d_ws, size_t ws_size, hipStream_t stream) {
    static int grid = 0;
    if (grid == 0) {
        if (n_in != 18 || out_size != T * DM || ws_size < WS_END) { fprintf(stderr, "kernel_launch: unexpected shapes (n_in %d, out %d, ws %zu)\n", n_in, out_size, ws_size); grid = -1; return; }
        int dev = 0, cus = 0, per_cu = 0;
        if (hipGetDevice(&dev) != hipSuccess || hipDeviceGetAttribute(&cus, hipDeviceAttributeMultiprocessorCount, dev) != hipSuccess) { grid = -1; return; }
        if (hipFuncSetAttribute((const void*)mega, hipFuncAttributeMaxDynamicSharedMemorySize, LDS_BYTES) != hipSuccess) { fprintf(stderr, "kernel_launch: hipFuncSetAttribute failed\n"); grid = -1; return; }
        if (hipOccupancyMaxActiveBlocksPerMultiprocessor(&per_cu, (const void*)mega, NTHREADS, LDS_BYTES) != hipSuccess || per_cu < 1) { fprintf(stderr, "kernel_launch: occupancy query says %d\n", per_cu); grid = -1; return; }
        (void)hipGetLastError();
        grid = cus;
        if (grid < 64) { grid = -1; return; }
    }
    if (grid < 0) return;
    Params p{};
    const float** pp = (const float**)&p;
    for (int i = 0; i < 18; ++i) pp[i] = (const float*)d_in[i];
    p.out = (float*)d_out; p.ws = (unsigned char*)d_ws;
#if ONE_LAUNCH
    if (hipMemsetAsync((char*)d_ws + WS_CTL, 0, 65536, stream) != hipSuccess) { fprintf(stderr, "kernel_launch: memset failed\n"); return; }
    p.ph_lo = 0; p.ph_hi = NPHASE;
    void* args[] = {&p};
    hipError_t e = hipLaunchCooperativeKernel((const void*)mega, dim3(grid), dim3(NTHREADS), args, LDS_BYTES, stream);
    if (e != hipSuccess) fprintf(stderr, "cooperative launch failed: %s (grid %d)\n", hipGetErrorString(e), grid);
#else
    for (int k = 0; k < NPHASE; ++k) { p.ph_lo = k; p.ph_hi = k + 1; hipLaunchKernelGGL(mega, dim3(grid), dim3(NTHREADS), LDS_BYTES, stream, p); }
#endif
}
```

```cpp
#include <hip/hip_runtime.h>
#include <hip/hip_cooperative_groups.h>
#include <cstdio>
#include <cstdint>
namespace cg = cooperative_groups;

namespace pg8 {
#define PG8_LAS __attribute__((address_space(3)))
typedef unsigned short bf16_t;
typedef short bf16x8 __attribute__((ext_vector_type(8)));
typedef float f32x4 __attribute__((ext_vector_type(4)));
typedef unsigned u32x4 __attribute__((ext_vector_type(4)));
constexpr int BM = 256, BK = 64, HALF = 128, HTB = HALF * BK * 2  , STAGE_BYTES = 8 * HTB, NXCD = 8, WGM = 8;

__host__ __device__ __forceinline__ int lds_byte(int r, int c) { const int st = (r >> 4) * 2 + (c >> 5), rr = r & 15, cc = c & 31, ob = rr * 64 + cc * 2; return st * 1024 + (ob ^ (((ob >> 9) & 1) << 5)); }
__host__ __device__ __forceinline__ void stage_rc(int b, int& R, int& C) { const int st = b / 1024, sb = b % 1024, swz = sb ^ (((sb >> 9) & 1) << 5); R = (st >> 1) * 16 + swz / 64; C = (st & 1) * 32 + (swz % 64) / 2; }
__host__ __device__ __forceinline__ int perm32(int rho) { const int n = rho >> 4, i = rho & 15; return 8 * (i >> 2) + 4 * n + (i & 3); }

struct Unit { int pm, pn, ko, pass; };
struct Gemm { const bf16_t* A; const bf16_t* Bt; int M, N, K, lda, ldb; };
typedef float f32x16 __attribute__((ext_vector_type(16)));
typedef f32x16 AccW[2][2][2];
__device__ __forceinline__ f32x4 acc_get(const AccW& A, int ai, int bj, int m, int n) { const int s_ = ((m & 1) * 2 + n) * 4; const f32x16& w = A[ai][bj][m >> 1]; return (f32x4){w[s_], w[s_ + 1], w[s_ + 2], w[s_ + 3]}; }
__device__ __forceinline__ void acc_set(AccW& A, int ai, int bj, int m, int n, f32x4 v) { const int s_ = ((m & 1) * 2 + n) * 4; f32x16& w = A[ai][bj][m >> 1]; w[s_] = v[0]; w[s_ + 1] = v[1]; w[s_ + 2] = v[2]; w[s_ + 3] = v[3]; }

template <bool TWOPASS_ORDER = false>
struct StaticOrderT {
    int nM, nN, nwg, G, c, kpass;
    __host__ __device__ void init(int M, int N, int G_, int c_, int kpass_ = 512) { nM = M / BM; nN = N / BM; nwg = nM * nN; G = G_; c = c_; kpass = kpass_; }
    __host__ __device__ bool next(int i, Unit& u) const {
        const long L = (long)(TWOPASS_ORDER ? (i >> 1) : i) * G + c; if (L >= nwg) return false;
        u.pass = TWOPASS_ORDER ? (i & 1) : 0; u.ko = TWOPASS_ORDER ? (i & 1) * kpass : 0;
        int wgid = (int)L; { const int q = nwg / NXCD, r = nwg % NXCD, xcd = wgid % NXCD, off = wgid / NXCD; wgid = (xcd < r ? xcd * (q + 1) : r * (q + 1) + (xcd - r) * q) + off; }
        const int nig = WGM * nN, gid = wgid / nig, fm = gid * WGM, gsz = (nM - fm) < WGM ? (nM - fm) : WGM;
        u.pm = fm + ((wgid % nig) % gsz); u.pn = (wgid % nig) / gsz; return true;
    }
    __device__ __forceinline__ void a_ready(const Unit&) const {}
    __device__ __forceinline__ void done(const Unit&) const {}
};
typedef StaticOrderT<false> StaticOrder;

__device__ __forceinline__ unsigned cvt_pk_bf16(float lo, float hi) { unsigned r; asm volatile("v_cvt_pk_bf16_f32 %0, %1, %2" : "=v"(r) : "v"(lo), "v"(hi)); return r; }

template <class Epi, class Sched, bool ALIGN_EPI = false, bool SP2 = false, int F8SCALE = 0>
__device__ __forceinline__ void gemm_phase(PG8_LAS unsigned char* lds, const Gemm g, const Sched& S, const Epi& E) {
    const int tid = threadIdx.x, wid = __builtin_amdgcn_readfirstlane(tid >> 6), lane = tid & 63, wr = wid >> 2, wc = wid & 3, fr = lane & 15, fq = lane >> 4;
    const int K = g.K, nt = K / BK;
    unsigned voffA[2], voffB[2];
#pragma unroll
    for (int i = 0; i < 2; ++i) { int R, C; stage_rc(tid * 16 + i * 8192, R, C); const int Rb = Epi::PERM ? ((R & ~31) + perm32(R & 31)) : R;
        voffA[i] = (unsigned)(R * g.lda + C) * 2u; voffB[i] = (unsigned)(Rb * g.ldb + C) * 2u; }
    const size_t kstep = (size_t)(BK * 2);
    const size_t hstepA = (size_t)HALF * g.lda * 2, hstepB = (size_t)HALF * g.ldb * 2;
    const size_t tstepA = 2 * hstepA, tstepB = 2 * hstepB;
    const unsigned ldsw = (unsigned)wid * 1024u;
    const int aoff = lds_byte(wr * 64 + fr, fq * 8), boff = lds_byte(wc * 32 + fr, fq * 8);
#define PG8_SA(b, h) (((b) * 2 + (h)) * HTB)
#define PG8_SB(b, h) ((4 + (b) * 2 + (h)) * HTB)
#define PG8_STAGE(bufoff, gbase, voff) do { _Pragma("unroll") for (int _i = 0; _i < 2; ++_i) \
        __builtin_amdgcn_global_load_lds((const unsigned*)((const char*)(gbase) + (voff)[_i]), (PG8_LAS unsigned*)(lds + (bufoff) + ldsw + _i * 8192), 16, 0, 0); } while (0)
#define PG8_LDA(dst, b, h) do { _Pragma("unroll") for (int m = 0; m < 4; ++m) { if constexpr (F8SCALE != 0) { \
        PG8_F8(dst)[m].lo = *(const PG8_LAS v4i_f*)(lds + PG8_SA(b, h) + aoff + m * 2048); PG8_F8(dst)[m].hi = *(const PG8_LAS v4i_f*)(lds + PG8_SA(b, h) + aoff + m * 2048 + 1024); } \
        else { _Pragma("unroll") for (int k = 0; k < 2; ++k) dst[m][k] = *(const PG8_LAS bf16x8*)(lds + PG8_SA(b, h) + aoff + m * 2048 + k * 1024); } } } while (0)
#define PG8_LDB(dst, b, h) do { _Pragma("unroll") for (int n = 0; n < 2; ++n) { if constexpr (F8SCALE != 0) { \
        PG8_F8(dst)[n].lo = *(const PG8_LAS v4i_f*)(lds + PG8_SB(b, h) + boff + n * 2048); PG8_F8(dst)[n].hi = *(const PG8_LAS v4i_f*)(lds + PG8_SB(b, h) + boff + n * 2048 + 1024); } \
        else { _Pragma("unroll") for (int k = 0; k < 2; ++k) dst[n][k] = *(const PG8_LAS bf16x8*)(lds + PG8_SB(b, h) + boff + n * 2048 + k * 1024); } } } while (0)
#define PG8_MMA(ai, bj, At, Bt) do { __builtin_amdgcn_s_setprio(1); _Pragma("unroll") for (int m = 0; m < 4; ++m) _Pragma("unroll") for (int n = 0; n < 2; ++n) { \
        f32x4 _c = acc_get(accw, ai, bj, m, n); \
        if constexpr (F8SCALE != 0) { _c = __builtin_amdgcn_mfma_scale_f32_16x16x128_f8f6f4(PG8_F8(Bt)[n], PG8_F8(At)[m], _c, 0, 0, 0, 0x7f7f7f7f, 0, F8SCALE * 0x01010101); } \
        else { _Pragma("unroll") for (int k = 0; k < 2; ++k) _c = __builtin_amdgcn_mfma_f32_16x16x32_bf16(Bt[n][k], At[m][k], _c, 0, 0, 0); } \
        acc_set(accw, ai, bj, m, n, _c); } \
        __builtin_amdgcn_s_setprio(0); } while (0)
#define PG8_WAIT_V(n) asm volatile("s_waitcnt vmcnt(" #n ")" ::: "memory")
#define PG8_WAIT_L(n) asm volatile("s_waitcnt lgkmcnt(" #n ")" ::: "memory")
#define PG8_BAR __builtin_amdgcn_s_barrier()
#define PG8_SCHED __builtin_amdgcn_sched_barrier(0)
    Unit cur, nxt; int ui = 0;
    if (!S.next(0, cur)) return;
    typedef int v4i_f __attribute__((ext_vector_type(4))); typedef int v8i_f __attribute__((ext_vector_type(8))); typedef f32x16 f32x16_f;
    AccW accw;
#pragma unroll
    for (int a = 0; a < 2; ++a)
#pragma unroll
        for (int b = 0; b < 2; ++b)
#pragma unroll
            for (int mp = 0; mp < 2; ++mp)
#pragma unroll
                for (int i = 0; i < 16; ++i) accw[a][b][mp][i] = 0.f;
    bf16x8 At[4][2], B0[2][2], B1[2][2];
    v8i_f At8[4], B08[2], B18[2];
#define PG8_F8(x) x##8
    const char* cA = (const char*)g.A + (size_t)cur.pm * tstepA + (size_t)cur.ko * 2; const char* cB = (const char*)g.Bt + (size_t)cur.pn * tstepB + (size_t)cur.ko * 2;
    S.a_ready(cur);
    if constexpr (SP2) {
        PG8_STAGE(PG8_SB(0, 0), cB, voffB); PG8_STAGE(PG8_SB(0, 1), cB + hstepB, voffB); PG8_STAGE(PG8_SA(0, 0), cA, voffA); PG8_STAGE(PG8_SA(0, 1), cA + hstepA, voffA);
        if (wr == 1) PG8_BAR;
        PG8_WAIT_V(2); PG8_BAR;
        PG8_STAGE(PG8_SB(1, 0), cB + kstep, voffB); PG8_STAGE(PG8_SA(1, 0), cA + kstep, voffA); PG8_STAGE(PG8_SB(1, 1), cB + hstepB + kstep, voffB);
        PG8_WAIT_V(6); PG8_BAR;
    } else {
        PG8_STAGE(PG8_SB(0, 0), cB, voffB); PG8_STAGE(PG8_SA(0, 0), cA, voffA); PG8_STAGE(PG8_SB(0, 1), cB + hstepB, voffB); PG8_STAGE(PG8_SA(0, 1), cA + hstepA, voffA);
        if (wr == 1) PG8_BAR;
        PG8_WAIT_V(4); PG8_BAR;
        PG8_STAGE(PG8_SB(1, 0), cB + kstep, voffB); PG8_STAGE(PG8_SA(1, 0), cA + kstep, voffA); PG8_STAGE(PG8_SB(1, 1), cB + hstepB + kstep, voffB);
        PG8_WAIT_V(6); PG8_BAR;
    }
    for (;;) {
        const bool has_next = S.next(ui + 1, nxt);
        const char* nA = has_next ? (const char*)g.A + (size_t)nxt.pm * tstepA + (size_t)nxt.ko * 2 : cA; const char* nB = has_next ? (const char*)g.Bt + (size_t)nxt.pn * tstepB + (size_t)nxt.ko * 2 : cB;
        for (int t = 0; t < nt; t += 2) {
            const bool last = (t == nt - 2);
            const char* a1 = cA + (size_t)(t + 1) * kstep;
            const char* a2 = last ? nA : cA + (size_t)(t + 2) * kstep; const char* b2 = last ? nB : cB + (size_t)(t + 2) * kstep;
            const char* a3 = a2 + kstep; const char* b3 = b2 + kstep;
            if (last && has_next) S.a_ready(nxt);
            if constexpr (SP2) {
            PG8_LDB(B0, 0, 0); PG8_LDB(B1, 0, 1); PG8_SCHED; PG8_LDA(At, 0, 0); PG8_STAGE(PG8_SA(1, 1), a1 + hstepA, voffA);
            PG8_WAIT_V(8); PG8_WAIT_L(0); PG8_BAR; PG8_MMA(0, 0, At, B0); PG8_MMA(0, 1, At, B1); PG8_BAR; PG8_SCHED;
            PG8_LDA(At, 0, 1); PG8_STAGE(PG8_SB(0, 0), b2, voffB); PG8_STAGE(PG8_SB(0, 1), b2 + hstepB, voffB); PG8_STAGE(PG8_SA(0, 0), a2, voffA);
            PG8_WAIT_V(8); PG8_WAIT_L(0); PG8_BAR; PG8_MMA(1, 0, At, B0); PG8_MMA(1, 1, At, B1); PG8_BAR; PG8_SCHED;
            PG8_LDB(B0, 1, 0); PG8_LDB(B1, 1, 1); PG8_SCHED; PG8_LDA(At, 1, 0); PG8_STAGE(PG8_SA(0, 1), a2 + hstepA, voffA);
            PG8_WAIT_V(8); PG8_WAIT_L(0); PG8_BAR; PG8_MMA(0, 0, At, B0); PG8_MMA(0, 1, At, B1); PG8_BAR; PG8_SCHED;
            PG8_LDA(At, 1, 1); PG8_STAGE(PG8_SB(1, 0), b3, voffB); PG8_STAGE(PG8_SB(1, 1), b3 + hstepB, voffB); PG8_STAGE(PG8_SA(1, 0), a3, voffA);
            PG8_WAIT_V(8); PG8_WAIT_L(0); PG8_BAR; PG8_MMA(1, 0, At, B0); PG8_MMA(1, 1, At, B1); PG8_BAR; PG8_SCHED;
            } else {
            PG8_LDB(B0, 0, 0); PG8_SCHED; PG8_LDA(At, 0, 0); PG8_STAGE(PG8_SA(1, 1), a1 + hstepA, voffA);
            PG8_WAIT_L(8); PG8_BAR; PG8_WAIT_L(0); PG8_MMA(0, 0, At, B0); PG8_BAR; PG8_SCHED;
            PG8_LDB(B1, 0, 1); PG8_STAGE(PG8_SB(0, 0), b2, voffB);
            PG8_BAR; PG8_WAIT_L(0); PG8_MMA(0, 1, At, B1); PG8_BAR;
            PG8_LDA(At, 0, 1); PG8_STAGE(PG8_SA(0, 0), a2, voffA);
            PG8_BAR; PG8_WAIT_L(0); PG8_MMA(1, 0, At, B0); PG8_BAR; PG8_SCHED;
            PG8_STAGE(PG8_SB(0, 1), b2 + hstepB, voffB);
            PG8_WAIT_V(6); PG8_BAR; PG8_MMA(1, 1, At, B1); PG8_BAR;
            PG8_LDB(B0, 1, 0); PG8_SCHED; PG8_LDA(At, 1, 0); PG8_STAGE(PG8_SA(0, 1), a2 + hstepA, voffA);
            PG8_WAIT_L(8); PG8_BAR; PG8_WAIT_L(0); PG8_MMA(0, 0, At, B0); PG8_BAR; PG8_SCHED;
            PG8_LDB(B1, 1, 1); PG8_STAGE(PG8_SB(1, 0), b3, voffB);
            PG8_BAR; PG8_WAIT_L(0); PG8_MMA(0, 1, At, B1); PG8_BAR;
            PG8_LDA(At, 1, 1); PG8_STAGE(PG8_SA(1, 0), a3, voffA);
            PG8_BAR; PG8_WAIT_L(0); PG8_MMA(1, 0, At, B0); PG8_BAR; PG8_SCHED;
            PG8_STAGE(PG8_SB(1, 1), b3 + hstepB, voffB);
            PG8_WAIT_V(6); PG8_BAR; PG8_MMA(1, 1, At, B1); PG8_BAR;
            }
        }
        if constexpr (ALIGN_EPI) { if (wr == 0) PG8_BAR; }
        if constexpr (!Epi::AFTER_DRAIN) { E(accw, cur, wr, wc, fr, fq); S.done(cur); }
        const bool keep_acc = Epi::TWOPASS && (cur.pass == 0);
        if (!has_next) break;
        if (!keep_acc) {
#pragma unroll
            for (int a = 0; a < 2; ++a)
#pragma unroll
                for (int b = 0; b < 2; ++b)
#pragma unroll
                    for (int mp = 0; mp < 2; ++mp)
#pragma unroll
                        for (int i = 0; i < 16; ++i) accw[a][b][mp][i] = 0.f;
        }
        cur = nxt; cA = nA; cB = nB; ++ui;
        if constexpr (ALIGN_EPI) { if (wr == 1) PG8_BAR; }
    }
    PG8_WAIT_V(0);
    if constexpr (!ALIGN_EPI) { if (wr == 0) PG8_BAR; }
    PG8_BAR;

#undef PG8_SA
#undef PG8_SB
#undef PG8_STAGE
#undef PG8_LDA
#undef PG8_LDB
#undef PG8_MMA
#undef PG8_F8
#undef PG8_WAIT_V
#undef PG8_WAIT_L
#undef PG8_BAR
#undef PG8_SCHED
}
}


constexpr int NWAVES = 8, NTHREADS = 512;
constexpr int BATCH = 8, SEQ = 4096, T = BATCH * SEQ, DM = 1024;
constexpr int INW = 5448;
constexpr int NPROJ = 5632;
constexpr int LD_HG = 2048, LD_ATT = 768, LD_IDX = 640, LD_GATE = 2048;
constexpr int TOPK = 256;
constexpr int NEXP = 16384;
constexpr float RMS_EPS = 1e-6f;

constexpr size_t MiB = 1u << 20;
constexpr size_t WS_CTL = 0;
constexpr size_t WS_MOD = MiB / 4;
constexpr size_t WS_MODP = MiB / 2;
constexpr size_t WS_WIN = 2 * MiB;
constexpr size_t WS_WQ = 17 * MiB;
constexpr size_t WS_SK = 21 * MiB;
constexpr size_t WS_U = 22 * MiB;
constexpr size_t WS_US = 30 * MiB;
constexpr size_t WS_V = 38 * MiB;
constexpr size_t WS_VS = 46 * MiB;
constexpr size_t WS_V8 = 8 * MiB;
constexpr size_t WS_K8 = 48 * MiB;
constexpr size_t WS_QHI = 52 * MiB;
constexpr size_t WS_QLO = 68 * MiB;
constexpr size_t WS_WAB8 = 31 * MiB;
constexpr size_t WS_WOUT8 = 32 * MiB;
constexpr size_t WS_WIN8 = 33 * MiB;
constexpr size_t WS_H8 = 48 * MiB;
constexpr size_t WS_H = 86 * MiB;
constexpr size_t WS_HG = 150 * MiB;
constexpr size_t WS_ATT = 278 * MiB;
constexpr size_t WS_IDX = 326 * MiB;
constexpr size_t WS_GATE = 366 * MiB;
constexpr size_t WS_SEL = 494 * MiB;
constexpr size_t WS_EIDX = 48 * MiB;
constexpr size_t WS_PGATE = 64 * MiB;
constexpr size_t WS_END = 510 * MiB;
constexpr size_t WS_HQC = 494 * MiB;
constexpr size_t WS_HOL = 118 * MiB;
constexpr size_t WS_HSB = 2 * MiB;
constexpr size_t WS_MERGED = WS_HG;
constexpr size_t WS_Q = 214 * MiB;
constexpr int H4_NT = 2;
constexpr size_t WS_H4D = 366 * MiB;
constexpr size_t WS_H4S = 416 * MiB;

constexpr int LDS_BYTES = 163840;

typedef unsigned short bf16;
typedef unsigned v4u __attribute__((ext_vector_type(4)));
typedef unsigned v2u __attribute__((ext_vector_type(2)));
typedef float f32x4 __attribute__((ext_vector_type(4)));
typedef float f32x2 __attribute__((ext_vector_type(2)));
typedef short bf16x8 __attribute__((ext_vector_type(8)));
#define LAS __attribute__((address_space(3)))

struct Params {
    const float *x, *c, *w_ada, *b_ada, *norm1_g, *norm2_g, *w_in, *hg_lb, *hg_onorm_g, *q_norm_g, *k_norm_g,
                *w_a, *w_b, *w_out, *peer_wq, *peer_subkeys, *peer_u, *peer_v;
    float* out; unsigned char* ws; int ph_lo, ph_hi;
};

typedef __bf16 bf16x2_hw __attribute__((ext_vector_type(2)));
__device__ __forceinline__ unsigned pk2(float lo, float hi) { const f32x2 v = {lo, hi}; const bf16x2_hw b = __builtin_convertvector(v, bf16x2_hw); return __builtin_bit_cast(unsigned, b); }
__device__ __forceinline__ unsigned f2bf(float f) { return pk2(f, 0.f) & 0xffffu; }
__device__ __forceinline__ float bf2f(unsigned u16v) { return __builtin_bit_cast(float, u16v << 16); }
__device__ __forceinline__ float bflo(unsigned w) { return __builtin_bit_cast(float, w << 16); }
__device__ __forceinline__ float bfhi(unsigned w) { return __builtin_bit_cast(float, w & 0xffff0000u); }
__device__ __forceinline__ float sigmoidf_(float x) { return __builtin_amdgcn_rcpf(1.f + __expf(-x)); }
__device__ __forceinline__ float siluf_(float x) { return x * __builtin_amdgcn_rcpf(1.f + __expf(-x)); }
__device__ __forceinline__ float wave_sum(float v) {
#pragma unroll
    for (int o = 1; o < 64; o <<= 1) v += __shfl_xor(v, o);
    return v;
}
__device__ __forceinline__ float wave_max(float v) {
#pragma unroll
    for (int o = 1; o < 64; o <<= 1) v = fmaxf(v, __shfl_xor(v, o));
    return v;
}
#define LDS_WAIT() asm volatile("s_waitcnt lgkmcnt(0)" ::: "memory")
__device__ __forceinline__ unsigned pk4_fp8(float a, float b, float c, float d) { int w = __builtin_amdgcn_cvt_pk_fp8_f32(a, b, 0, false); w = __builtin_amdgcn_cvt_pk_fp8_f32(c, d, w, true); return (unsigned)w; }

__host__ __device__ __forceinline__ int proj_tile_bf16(int i) { return i < 2 ? i + 2 : i + 6; }
__host__ __device__ __forceinline__ int proj_tile_fp8(int i) { return i < 2 ? i : (i < 6 ? i + 2 : i + 8); }
struct EpiProj {
    static constexpr bool PERM = true, AFTER_DRAIN = false, TWOPASS = false;
    bf16 *HG, *ATT, *IDX, *GATE; int f8;
    __device__ __forceinline__ void operator()(pg8::AccW& acc, const pg8::Unit& u, int wr, int wc, int fr, int fq) const {
        const int pn = f8 ? proj_tile_fp8(u.pn) : proj_tile_bf16(u.pn); bf16* base; int ldc, colt, ncols;
        if (pn < 8) { base = HG; ldc = LD_HG; colt = pn * 256; ncols = LD_HG; }
        else if (pn < 11) { base = ATT; ldc = LD_ATT; colt = (pn - 8) * 256; ncols = LD_ATT; }
        else if (pn < 14) { base = IDX; ldc = LD_IDX; colt = (pn - 11) * 256; ncols = LD_IDX; }
        else { base = GATE; ldc = LD_GATE; colt = (pn - 14) * 256; ncols = LD_GATE; }
        const int row0 = u.pm * 256 + wr * 64 + fr, col0 = colt + wc * 32 + 8 * fq;
#pragma unroll
        for (int ai = 0; ai < 2; ++ai)
#pragma unroll
            for (int m = 0; m < 4; ++m) { bf16* rowp = base + (size_t)(row0 + ai * 128 + m * 16) * ldc + col0;
#pragma unroll
                for (int bj = 0; bj < 2; ++bj) { const pg8::f32x4 v0 = pg8::acc_get(acc, ai, bj, m, 0), v1 = pg8::acc_get(acc, ai, bj, m, 1);
                    v4u w; w.x = pk2(v0[0], v0[1]); w.y = pk2(v0[2], v0[3]); w.z = pk2(v1[0], v1[1]); w.w = pk2(v1[2], v1[3]);
                    if (col0 + bj * 128 < ncols) *(v4u*)(rowp + bj * 128) = w; } }
    }
};
struct EpiMerged {
    static constexpr bool PERM = true, AFTER_DRAIN = false, TWOPASS = true;
    const bf16* GATE; bf16* O;
    __device__ __forceinline__ void operator()(pg8::AccW& acc, const pg8::Unit& u, int wr, int wc, int fr, int fq) const {
        const int row0 = u.pm * 256 + wr * 64 + fr, col0 = u.pn * 256 + wc * 32 + 8 * fq;
        if (u.pass == 0) {
#pragma unroll
            for (int ai = 0; ai < 2; ++ai)
#pragma unroll
                for (int m = 0; m < 4; ++m) { const bf16* rowp = GATE + (size_t)(row0 + ai * 128 + m * 16) * LD_GATE + col0;
#pragma unroll
                    for (int bj = 0; bj < 2; ++bj) { const v4u a = *(const v4u*)(rowp + bj * 128), b = *(const v4u*)(rowp + 1024 + bj * 128);
                        float r[8];
#pragma unroll
                        for (int i = 0; i < 4; ++i) { const float a0 = bflo(a[i]), a1 = bfhi(a[i]), b0 = bflo(b[i]), b1 = bfhi(b[i]);
                            r[2 * i] = (1.f + __expf(-b0)) * __builtin_amdgcn_rcpf(1.f + __expf(-a0)); r[2 * i + 1] = (1.f + __expf(-b1)) * __builtin_amdgcn_rcpf(1.f + __expf(-a1)); }
                        { pg8::f32x4 c0 = pg8::acc_get(acc, ai, bj, m, 0), c1 = pg8::acc_get(acc, ai, bj, m, 1);
#pragma unroll
                          for (int i = 0; i < 4; ++i) { c0[i] *= r[i]; c1[i] *= r[4 + i]; }
                          pg8::acc_set(acc, ai, bj, m, 0, c0); pg8::acc_set(acc, ai, bj, m, 1, c1); } } }
        } else {
#pragma unroll
            for (int ai = 0; ai < 2; ++ai)
#pragma unroll
                for (int m = 0; m < 4; ++m) { const size_t ro = (size_t)(row0 + ai * 128 + m * 16);
#pragma unroll
                    for (int bj = 0; bj < 2; ++bj) { const v4u b = *(const v4u*)(GATE + ro * LD_GATE + 1024 + col0 + bj * 128);
                        const pg8::f32x4 v0 = pg8::acc_get(acc, ai, bj, m, 0), v1 = pg8::acc_get(acc, ai, bj, m, 1);
                        float s[8];
#pragma unroll
                        for (int i = 0; i < 4; ++i) { s[2 * i] = sigmoidf_(bflo(b[i])); s[2 * i + 1] = sigmoidf_(bfhi(b[i])); }
                        v2u w; w.x = pk4_fp8(4.f * v0[0] * s[0], 4.f * v0[1] * s[1], 4.f * v0[2] * s[2], 4.f * v0[3] * s[3]); w.y = pk4_fp8(4.f * v1[0] * s[4], 4.f * v1[1] * s[5], 4.f * v1[2] * s[6], 4.f * v1[3] * s[7]);
                        *(v2u*)((unsigned char*)O + ro * 1024 + col0 + bj * 128) = w; } }
        }
    }
};
struct EpiResid {
    static constexpr bool PERM = true, AFTER_DRAIN = false, TWOPASS = false;
    const float* X; const float* G1  ; float* O;
    __device__ __forceinline__ void operator()(pg8::AccW& acc, const pg8::Unit& u, int wr, int wc, int fr, int fq) const {
        const int row0 = u.pm * 256 + wr * 64 + fr, col0 = u.pn * 256 + wc * 32 + 8 * fq;
        const int b = (u.pm * 256) / SEQ;
        f32x4 g[2][2];
#pragma unroll
        for (int bj = 0; bj < 2; ++bj)
#pragma unroll
            for (int n = 0; n < 2; ++n) g[bj][n] = *(const f32x4*)(G1 + (size_t)b * 6144 + col0 + bj * 128 + 4 * n);
#pragma unroll
        for (int ai = 0; ai < 2; ++ai)
#pragma unroll
            for (int m = 0; m < 4; ++m) { const size_t ro = (size_t)(row0 + ai * 128 + m * 16) * DM + col0;
#pragma unroll
                for (int bj = 0; bj < 2; ++bj)
#pragma unroll
                    for (int n = 0; n < 2; ++n) { const f32x4 xv = *(const f32x4*)(X + ro + bj * 128 + 4 * n);
                        *(f32x4*)(O + ro + bj * 128 + 4 * n) = xv + g[bj][n] * pg8::acc_get(acc, ai, bj, m, n); } }
    }
};
struct EpiStore {
    static constexpr bool PERM = true, AFTER_DRAIN = false, TWOPASS = false;
    bf16* O; int ldc;
    __device__ __forceinline__ void operator()(pg8::AccW& acc, const pg8::Unit& u, int wr, int wc, int fr, int fq) const {
        const int row0 = u.pm * 256 + wr * 64 + fr, col0 = u.pn * 256 + wc * 32 + 8 * fq;
#pragma unroll
        for (int ai = 0; ai < 2; ++ai)
#pragma unroll
            for (int m = 0; m < 4; ++m) { bf16* rowp = O + (size_t)(row0 + ai * 128 + m * 16) * ldc + col0;
#pragma unroll
                for (int bj = 0; bj < 2; ++bj) { const pg8::f32x4 v0 = pg8::acc_get(acc, ai, bj, m, 0), v1 = pg8::acc_get(acc, ai, bj, m, 1);
                    v4u w; w.x = pk2(v0[0], v0[1]); w.y = pk2(v0[2], v0[3]); w.z = pk2(v1[0], v1[1]); w.w = pk2(v1[2], v1[3]);
                    *(v4u*)(rowp + bj * 128) = w; } }
    }
};

template <int MODE> __device__ __forceinline__ int srcmap(int np) {
    if (MODE == 2) np = proj_tile_bf16(np >> 8) * 256 + (np & 255);
    if (MODE == 3) np = proj_tile_fp8(np >> 8) * 256 + (np & 255);
    if (MODE >= 1) return np < 3400 ? np : (np >= 3584 ? np - 184 : -1);
    return np; }
template <int MODE>
__device__ __forceinline__ void transpose_item(const float* W, int N, bf16* WT, int ldw, int koff, float* scr, int kb, int nb, int lane) {
    const int k0 = 64 * kb, n0 = 32 * nb;
    const int sc = srcmap<MODE>(n0 + (lane & 31));
#pragma unroll 8
    for (int i = 0; i < 32; ++i) { const int kk = 2 * i + (lane >> 5); scr[kk * 33 + (lane & 31)] = (sc >= 0) ? W[(size_t)(k0 + kk) * N + sc] : 0.f; }
    LDS_WAIT(); __builtin_amdgcn_wave_barrier();
    const int c = lane & 7;
#pragma unroll
    for (int j = 0; j < 4; ++j) { const int n = (lane >> 3) + 8 * j; const float* s = scr + (8 * c) * 33 + n;
        v4u o; o.x = pk2(s[0 * 33], s[1 * 33]); o.y = pk2(s[2 * 33], s[3 * 33]); o.z = pk2(s[4 * 33], s[5 * 33]); o.w = pk2(s[6 * 33], s[7 * 33]);
        *(v4u*)(WT + (size_t)(n0 + n) * ldw + koff + k0 + 8 * c) = o; }
    LDS_WAIT(); __builtin_amdgcn_wave_barrier();
}
template <int MODE> __device__ __forceinline__ int srcmap(int np);
template <int MODE = 0>
__device__ __forceinline__ void transpose_item8(const float* W, int N, unsigned char* WT, int ldw, int koff, float scale, float* scr, int kb, int nb, int lane) {
    const int k0 = 64 * kb, n0 = 32 * nb;
    const int sc = srcmap<MODE>(n0 + (lane & 31));
#pragma unroll 8
    for (int i = 0; i < 32; ++i) { const int kk = 2 * i + (lane >> 5); scr[kk * 33 + (lane & 31)] = (sc >= 0) ? W[(size_t)(k0 + kk) * N + sc] * scale : 0.f; }
    LDS_WAIT(); __builtin_amdgcn_wave_barrier();
    const int c = lane & 3;
#pragma unroll
    for (int j = 0; j < 2; ++j) { const int n = (lane >> 2) + 16 * j; const float* sp = scr + (16 * c) * 33 + n;
        v4u o;
#pragma unroll
        for (int q = 0; q < 4; ++q) o[q] = pk4_fp8(sp[(4 * q) * 33], sp[(4 * q + 1) * 33], sp[(4 * q + 2) * 33], sp[(4 * q + 3) * 33]);
        *(v4u*)(WT + (size_t)(n0 + n) * ldw + koff + k0 + 16 * c) = o; }
    LDS_WAIT(); __builtin_amdgcn_wave_barrier();
}
__device__ __forceinline__ void convert_plain(const float* src, bf16* dst, size_t n, size_t gtid, size_t nth) {
    const size_t n8 = n / 8;
    for (size_t i = gtid; i < n8; i += nth) { const f32x4 a = ((const f32x4*)src)[2 * i], b = ((const f32x4*)src)[2 * i + 1];
        v4u o; o.x = pk2(a[0], a[1]); o.y = pk2(a[2], a[3]); o.z = pk2(b[0], b[1]); o.w = pk2(b[2], b[3]); ((v4u*)dst)[i] = o; }
}
__device__ __forceinline__ void convert_fp8(const float* src, unsigned char* dst, size_t n, float scale, size_t gtid, size_t nth) {
    const size_t n16 = n / 16;
    for (size_t i = gtid; i < n16; i += nth) { const f32x4* sp = (const f32x4*)src + 4 * i; const f32x4 a = sp[0] * scale, b = sp[1] * scale, c = sp[2] * scale, d = sp[3] * scale;
        v4u o; o.x = pk4_fp8(a[0], a[1], a[2], a[3]); o.y = pk4_fp8(b[0], b[1], b[2], b[3]); o.z = pk4_fp8(c[0], c[1], c[2], c[3]); o.w = pk4_fp8(d[0], d[1], d[2], d[3]); ((v4u*)dst)[i] = o; }
}
template <bool KKMAJOR>
__device__ __forceinline__ void convert_mxfp4(const float* src, unsigned char* dst, unsigned char* scl, size_t nrows, size_t gtid, size_t nth) {
    const size_t nblk = nrows * 32;
    for (size_t i = gtid; i < nblk; i += nth) {
        const size_t row = i >> 5; const int blk = (int)(i & 31);
        const f32x4* sp = (const f32x4*)(src + row * 1024 + blk * 32);
        f32x4 v[8]; float amax = 0.f;
#pragma unroll
        for (int j = 0; j < 8; ++j) { v[j] = sp[j]; amax = fmaxf(fmaxf(fmaxf(fabsf(v[j][0]), fabsf(v[j][1])), fmaxf(fabsf(v[j][2]), fabsf(v[j][3]))), amax); }
        int e = (int)((__builtin_bit_cast(unsigned, amax) >> 23) & 0xffu) - 127 - 2;
        if (e < -126) e = -126;
        const float inv = __builtin_bit_cast(float, (unsigned)(127 - e) << 23);
        unsigned w[4] = {0u, 0u, 0u, 0u};
#pragma unroll
        for (int j = 0; j < 8; j += 2) { unsigned t = 0u;
            t = __builtin_amdgcn_cvt_scalef32_pk_fp4_f32(t, v[j][0] * inv, v[j][1] * inv, 1.0f, 0);
            t = __builtin_amdgcn_cvt_scalef32_pk_fp4_f32(t, v[j][2] * inv, v[j][3] * inv, 1.0f, 1);
            t = __builtin_amdgcn_cvt_scalef32_pk_fp4_f32(t, v[j + 1][0] * inv, v[j + 1][1] * inv, 1.0f, 2);
            t = __builtin_amdgcn_cvt_scalef32_pk_fp4_f32(t, v[j + 1][2] * inv, v[j + 1][3] * inv, 1.0f, 3);
            w[j >> 1] = t; }
        *(v4u*)(dst + row * 512 + blk * 16) = (v4u){w[0], w[1], w[2], w[3]};
        scl[row * 32 + (KKMAJOR ? ((blk & 3) * 8 + (blk >> 2)) : blk)] = (unsigned char)(e + 127);
    }
}
__device__ __forceinline__ void convert_rowfp4(const float* src, unsigned char* dst, _Float16* scl, int row, int lane) {
    const f32x4* sp = (const f32x4*)(src + (size_t)row * 1024 + lane * 16);
    f32x4 v[4]; float amax = 0.f;
#pragma unroll
    for (int j = 0; j < 4; ++j) { v[j] = sp[j]; amax = fmaxf(fmaxf(fmaxf(fabsf(v[j][0]), fabsf(v[j][1])), fmaxf(fabsf(v[j][2]), fabsf(v[j][3]))), amax); }
    amax = wave_max(amax);
    _Float16 sh = (_Float16)(amax * (1.f / 6.f));
    float sf = (float)sh; if (!(sf > 0.f)) { sf = 1.f; sh = (_Float16)1.f; }
    const float inv = 1.f / sf;
    unsigned w[2];
#pragma unroll
    for (int j = 0; j < 2; ++j) { unsigned t = 0u;
        t = __builtin_amdgcn_cvt_scalef32_pk_fp4_f32(t, v[2 * j][0] * inv, v[2 * j][1] * inv, 1.0f, 0);
        t = __builtin_amdgcn_cvt_scalef32_pk_fp4_f32(t, v[2 * j][2] * inv, v[2 * j][3] * inv, 1.0f, 1);
        t = __builtin_amdgcn_cvt_scalef32_pk_fp4_f32(t, v[2 * j + 1][0] * inv, v[2 * j + 1][1] * inv, 1.0f, 2);
        t = __builtin_amdgcn_cvt_scalef32_pk_fp4_f32(t, v[2 * j + 1][2] * inv, v[2 * j + 1][3] * inv, 1.0f, 3);
        w[j] = t; }
    *(v2u*)(dst + (size_t)row * 512 + lane * 8) = (v2u){w[0], w[1]};
    if (lane == 0) scl[row] = sh;
}
__device__ __forceinline__ void phase0(const Params& p, unsigned char* lds) {
    const int tid = threadIdx.x, wave = tid >> 6, lane = tid & 63, G = gridDim.x;
    const int gw = blockIdx.x * NWAVES + wave, NGW = G * NWAVES;
    float* scr = (float*)(lds + wave * 16384);
    unsigned char* ws = p.ws;
    constexpr int I_IN = 16 * (2048 / 32), I_IN8 = 16 * (3584 / 32), I_A = 8 * 32, I_O = 16 * 32, I_Q = 16 * 64;
    constexpr int NT = I_IN + I_IN8 + 2 * I_A + I_O + I_Q;
    for (int it = gw; it < NT; it += NGW) {
        int r = it;
        if (r < I_IN) { transpose_item<2>(p.w_in, INW, (bf16*)(ws + WS_WIN), 1024, 0, scr, r / 64, r % 64, lane); continue; } r -= I_IN;
        if (r < I_IN8) { transpose_item8<3>(p.w_in, INW, ws + WS_WIN8, 1024, 0, 32.f, scr, r / 112, r % 112, lane); continue; } r -= I_IN8;
        if (r < I_A) { transpose_item8(p.w_a, 1024, ws + WS_WAB8, 1024, 0, 32.f, scr, r / 32, r % 32, lane); continue; } r -= I_A;
        if (r < I_A) { transpose_item8(p.w_b, 1024, ws + WS_WAB8, 1024, 512, 4.f, scr, r / 32, r % 32, lane); continue; } r -= I_A;
        if (r < I_O) { transpose_item8(p.w_out, 1024, ws + WS_WOUT8, 1024, 0, 32.f, scr, r / 32, r % 32, lane); continue; } r -= I_O;
        transpose_item<0>(p.peer_wq, 2048, (bf16*)(ws + WS_WQ), 1024, 0, scr, r / 64, r % 64, lane);
    }
    for (int it = gw; it < 96 * 8; it += NGW) {
        const int cgp = it % 96, ks = it / 96, col = cgp * 64 + lane, k0 = ks * 128;
#pragma unroll
        for (int i = 0; i < 16; ++i) { const int e = i * 64 + lane, b = e >> 7, k = e & 127; scr[e] = siluf_(p.c[b * 1024 + k0 + k]); }
        LDS_WAIT(); __builtin_amdgcn_wave_barrier();
        float acc[8];
#pragma unroll
        for (int b = 0; b < 8; ++b) acc[b] = 0.f;
#pragma unroll 4
        for (int k = 0; k < 128; ++k) { const float w = p.w_ada[(size_t)(k0 + k) * 6144 + col];
#pragma unroll
            for (int b = 0; b < 8; ++b) acc[b] += scr[b * 128 + k] * w; }
        float* mp = (float*)(ws + WS_MODP) + (size_t)ks * 8 * 6144 + col;
#pragma unroll
        for (int b = 0; b < 8; ++b) mp[b * 6144] = acc[b];
        LDS_WAIT(); __builtin_amdgcn_wave_barrier();
    }
    const size_t gtid = (size_t)blockIdx.x * NTHREADS + tid, nth = (size_t)G * NTHREADS;
    convert_plain(p.peer_subkeys, (bf16*)(ws + WS_SK), (size_t)16 * 128 * 128, gtid, nth);
    for (int it = gw; it < 2 * NEXP; it += NGW) {
        if (it < NEXP) convert_rowfp4(p.peer_u, ws + WS_U, (_Float16*)(ws + WS_US), it, lane);
        else convert_rowfp4(p.peer_v, ws + WS_V, (_Float16*)(ws + WS_VS), it - NEXP, lane);
    }
}

template <bool FIRST>
__device__ __forceinline__ void normmod_phase(const Params& p, unsigned char* lds, const float* src, bf16* dst, const float* gvec, int shift_off, int scale_off) {
    const int tid = threadIdx.x, wave = tid >> 6, lane = tid & 63, G = gridDim.x;
    unsigned char* ws = p.ws;
    float* A = (float*)lds;
    float* Bv = A + 1024;
    const float* MODP = (const float*)(ws + WS_MODP);
    float* MOD = (float*)(ws + WS_MOD);
    if (FIRST) {
        for (int e = blockIdx.x * NTHREADS + tid; e < 8 * 6144; e += G * NTHREADS) { const int col = e % 6144; float s = p.b_ada[col];
#pragma unroll
            for (int ks = 0; ks < 8; ++ks) s += MODP[(size_t)ks * 8 * 6144 + e];
            MOD[e] = s; }
    }
    int curb = -1;
    for (int chunk = blockIdx.x; chunk < T / 128; chunk += G) {
        const int b = (chunk * 128) / SEQ;
        if (b != curb) {
            __syncthreads();
            for (int col = tid; col < 1024; col += NTHREADS) {
                float sc, sh;
                if (FIRST) { sc = p.b_ada[scale_off + col]; sh = p.b_ada[shift_off + col];
#pragma unroll
                    for (int ks = 0; ks < 8; ++ks) { sc += MODP[(size_t)(ks * 8 + b) * 6144 + scale_off + col]; sh += MODP[(size_t)(ks * 8 + b) * 6144 + shift_off + col]; } }
                else { sc = MOD[b * 6144 + scale_off + col]; sh = MOD[b * 6144 + shift_off + col]; }
                A[col] = gvec[col] * (1.f + sc); Bv[col] = sh; }
            __syncthreads(); curb = b;
        }
        for (int r = wave; r < 128; r += NWAVES) {
            const size_t row = (size_t)chunk * 128 + r;
            const f32x4* xr = (const f32x4*)(src + row * DM) + lane;
            f32x4 v[4]; float s = 0.f;
#pragma unroll
            for (int j = 0; j < 4; ++j) { v[j] = xr[64 * j]; s += (v[j][0] * v[j][0] + v[j][1] * v[j][1]) + (v[j][2] * v[j][2] + v[j][3] * v[j][3]); }
            const float rstd = rsqrtf(wave_sum(s) * (1.f / DM) + RMS_EPS);
            v2u* o8 = (v2u*)(dst + row * DM) + lane;
#pragma unroll
            for (int j = 0; j < 4; ++j) { const int c0 = 4 * lane + 256 * j; const f32x4 a = *(const f32x4*)(A + c0), sh = *(const f32x4*)(Bv + c0);
                v2u o; o.x = pk2(v[j][0] * rstd * a[0] + sh[0], v[j][1] * rstd * a[1] + sh[1]); o.y = pk2(v[j][2] * rstd * a[2] + sh[2], v[j][3] * rstd * a[3] + sh[3]);
                o8[64 * j] = o;
                if (FIRST) *(unsigned*)(ws + WS_H8 + row * DM + c0) = pk4_fp8(v[j][0] * rstd * a[0] + sh[0], v[j][1] * rstd * a[1] + sh[1], v[j][2] * rstd * a[2] + sh[2], v[j][3] * rstd * a[3] + sh[3]);
                if (!FIRST) { float* st = (float*)(lds + 8192) + wave * 1056;
                    const float y0 = v[j][0] * rstd * a[0] + sh[0], y1 = v[j][1] * rstd * a[1] + sh[1], y2 = v[j][2] * rstd * a[2] + sh[2], y3 = v[j][3] * rstd * a[3] + sh[3];
                    const int pc = c0 + (c0 >> 5); st[pc] = y0; st[pc + 1] = y1; st[pc + 2] = y2; st[pc + 3] = y3; } }
            if (!FIRST) {
                const float* st = (const float*)(lds + 8192) + wave * 1056;
                LDS_WAIT(); __builtin_amdgcn_wave_barrier();
                if (lane < 32) {
                    float x[32];
#pragma unroll
                    for (int k = 0; k < 32; ++k) x[k] = st[lane * 33 + k];
#pragma unroll
                    for (int t = 0; t < H4_NT; ++t) {
                        float amax = 0.f;
#pragma unroll
                        for (int k = 0; k < 32; ++k) amax = fmaxf(amax, fabsf(x[k]));
                        int e = (int)((__builtin_bit_cast(unsigned, amax) >> 23) & 0xffu) - 127 - 2; if (e < -126) e = -126;
                        const float inv = __builtin_bit_cast(float, (unsigned)(127 - e) << 23), sc = __builtin_bit_cast(float, (unsigned)(127 + e) << 23);
                        unsigned w[4];
#pragma unroll
                        for (int r = 0; r < 4; ++r) { unsigned tw = 0u;
                            tw = __builtin_amdgcn_cvt_scalef32_pk_fp4_f32(tw, x[8 * r] * inv, x[8 * r + 1] * inv, 1.0f, 0);
                            tw = __builtin_amdgcn_cvt_scalef32_pk_fp4_f32(tw, x[8 * r + 2] * inv, x[8 * r + 3] * inv, 1.0f, 1);
                            tw = __builtin_amdgcn_cvt_scalef32_pk_fp4_f32(tw, x[8 * r + 4] * inv, x[8 * r + 5] * inv, 1.0f, 2);
                            tw = __builtin_amdgcn_cvt_scalef32_pk_fp4_f32(tw, x[8 * r + 6] * inv, x[8 * r + 7] * inv, 1.0f, 3);
                            w[r] = tw;
                            const f32x2 d0 = __builtin_amdgcn_cvt_scalef32_pk_f32_fp4(tw, 1.0f, 0), d1 = __builtin_amdgcn_cvt_scalef32_pk_f32_fp4(tw, 1.0f, 1), d2 = __builtin_amdgcn_cvt_scalef32_pk_f32_fp4(tw, 1.0f, 2), d3 = __builtin_amdgcn_cvt_scalef32_pk_f32_fp4(tw, 1.0f, 3);
                            x[8 * r] -= d0[0] * sc; x[8 * r + 1] -= d0[1] * sc; x[8 * r + 2] -= d1[0] * sc; x[8 * r + 3] -= d1[1] * sc;
                            x[8 * r + 4] -= d2[0] * sc; x[8 * r + 5] -= d2[1] * sc; x[8 * r + 6] -= d3[0] * sc; x[8 * r + 7] -= d3[1] * sc; }
                        *(v4u*)(ws + WS_H4D + (row * H4_NT + t) * 512 + lane * 16) = (v4u){w[0], w[1], w[2], w[3]};
                        *(ws + WS_H4S + (row * H4_NT + t) * 32 + (lane & 3) * 8 + (lane >> 2)) = (unsigned char)(e + 127);
                    }
                }
                LDS_WAIT(); __builtin_amdgcn_wave_barrier();
            }
        }
    }
    __syncthreads();
}

constexpr int HGL_QT = 0, HGL_KT = 17408, HGL_QE = 34816, HGL_KLT = 52224, HGL_VT = 70656, HGL_AM = 89088, HGL_DEC = 98304, HGL_TOT = 98816, HGL_SSQ = 100864;
constexpr int HG_LDR = 136;
constexpr int HG_LDC = 72;
template <int half>
__device__ __forceinline__ void hgrn_item(const Params& p, unsigned char* lds, int item) {
    const int b = item >> 2, h = item & 3;
    const int tid = threadIdx.x, w = tid >> 6, lane = tid & 63, fr = lane & 15, fq = lane >> 4;
    unsigned char* ws = p.ws;
    const bf16* HG = (const bf16*)(ws + WS_HG);
    bf16* YA = (bf16*)(ws + WS_H);
    bf16* QT = (bf16*)(lds + HGL_QT); bf16* KT = (bf16*)(lds + HGL_KT); bf16* QE = (bf16*)(lds + HGL_QE);
    bf16* KLT = (bf16*)(lds + HGL_KLT); bf16* VT = (bf16*)(lds + HGL_VT); bf16* AM = (bf16*)(lds + HGL_AM);
    float* DEC = (float*)(lds + HGL_DEC); float* TOT = (float*)(lds + HGL_TOT); float* SSQ = (float*)(lds + HGL_SSQ);
    const int pd = tid & 127, pq = tid >> 7;
    float lbv; { const float a0 = p.hg_lb[h * 128 + pd], a1 = p.hg_lb[512 + h * 128 + pd]; lbv = 1.f / (1.f + __expf(a1 - a0)); }
    const int e0 = w * 16;
    const float ogv = p.hg_onorm_g[e0 + fr];
    pg8::f32x4 S[8];
#pragma unroll
    for (int i = 0; i < 8; ++i) S[i] = (pg8::f32x4){0.f, 0.f, 0.f, 0.f};
    const size_t rowb = (size_t)b * SEQ;
    const int c0 = half * 32;
    bf16* QCg = (bf16*)(ws + WS_HQC) + (size_t)item * 2048 * 128; float* OLg = (float*)(ws + WS_HOL) + (size_t)item * 32 * 8 * 4 * 256;
    float cum = 1.f;
    unsigned short rq[16], rf[16], rv[16];
    { const bf16* gp = HG + (rowb + (size_t)c0 * 64 + pq * 16) * LD_HG + h * 128 + pd;
#pragma unroll
      for (int i = 0; i < 16; ++i) { rq[i] = gp[(size_t)i * LD_HG]; rf[i] = gp[(size_t)i * LD_HG + 512]; rv[i] = gp[(size_t)i * LD_HG + 1024]; } }
    for (int chunk = c0; chunk < c0 + 32; ++chunk) {
        const size_t row0 = rowb + (size_t)chunk * 64;
        float fq_[16], kq_[16], cs[16];
        float run = 0.f;
#pragma unroll
        for (int i = 0; i < 16; ++i) { const float f = lbv + (1.f - lbv) * sigmoidf_(bf2f(rf[i])); kq_[i] = 1.f - f; run += __logf(f); cs[i] = run; fq_[i] = siluf_(bf2f(rq[i])); }
        TOT[pq * 128 + pd] = run;
        { v4u v0, v1;
          v0.x = rv[0] | ((unsigned)rv[1] << 16); v0.y = rv[2] | ((unsigned)rv[3] << 16); v0.z = rv[4] | ((unsigned)rv[5] << 16); v0.w = rv[6] | ((unsigned)rv[7] << 16);
          v1.x = rv[8] | ((unsigned)rv[9] << 16); v1.y = rv[10] | ((unsigned)rv[11] << 16); v1.z = rv[12] | ((unsigned)rv[13] << 16); v1.w = rv[14] | ((unsigned)rv[15] << 16);
          *(v4u*)(VT + pd * HG_LDC + pq * 16) = v0; *(v4u*)(VT + pd * HG_LDC + pq * 16 + 8) = v1; }
        unsigned short rg[16];
#pragma unroll
        for (int i = 0; i < 16; ++i) rg[i] = half ? (unsigned short)0 : HG[(row0 + (i >> 2) * 16 + fq * 4 + (i & 3)) * LD_HG + 1536 + h * 128 + e0 + fr];
        if (chunk + 1 < c0 + 32) { const bf16* gp = HG + (row0 + 64 + pq * 16) * LD_HG + h * 128 + pd;
#pragma unroll
            for (int i = 0; i < 16; ++i) { rq[i] = gp[(size_t)i * LD_HG]; rf[i] = gp[(size_t)i * LD_HG + 512]; rv[i] = gp[(size_t)i * LD_HG + 1024]; } }
        __syncthreads();
        const float t0 = TOT[pd], t1 = TOT[128 + pd], t2 = TOT[256 + pd], t3 = TOT[384 + pd];
        const float base = (pq > 0 ? t0 : 0.f) + (pq > 1 ? t1 : 0.f) + (pq > 2 ? t2 : 0.f);
        const float bmid = t0 + t1, blast = (t0 + t1) + (t2 + t3);
        const float emid = __expf(bmid), elm = __expf(blast - bmid);
        if (pq == 0) DEC[pd] = __expf(blast);
        { unsigned klp[8];
#pragma unroll
          for (int i = 0; i < 16; ++i) { const float bb = base + cs[i]; const float E1 = __expf(bb - bmid), R1 = __builtin_amdgcn_rcpf(E1);
              const float qtv = fq_[i] * E1, ktv = kq_[i] * R1, qev = qtv * emid, klv = ktv * elm;
              const int srow = pq * 16 + i;
              QT[srow * HG_LDR + pd] = (bf16)f2bf(qtv); KT[srow * HG_LDR + pd] = (bf16)f2bf(ktv); QE[srow * HG_LDR + pd] = (bf16)f2bf(qev);
              if (half) QCg[((size_t)(chunk - 32) * 64 + srow) * 128 + pd] = (bf16)f2bf(qev * cum);
              if (i & 1) klp[i >> 1] |= f2bf(klv) << 16; else klp[i >> 1] = f2bf(klv); }
          *(v4u*)(KLT + pd * HG_LDC + pq * 16) = (v4u){klp[0], klp[1], klp[2], klp[3]}; *(v4u*)(KLT + pd * HG_LDC + pq * 16 + 8) = (v4u){klp[4], klp[5], klp[6], klp[7]}; }
        cum *= __expf(blast);
        __syncthreads();
#pragma unroll
        for (int tt = 0; tt < 2; ++tt) { const int id = w + 8 * tt, rt = id >> 2, ct = id & 3;
            pg8::f32x4 a = {0.f, 0.f, 0.f, 0.f};
            if (ct <= rt) {
#pragma unroll
                for (int ks = 0; ks < 4; ++ks) { const bf16x8 af = *(const bf16x8*)(QT + (rt * 16 + fr) * HG_LDR + ks * 32 + fq * 8), bfv = *(const bf16x8*)(KT + (ct * 16 + fr) * HG_LDR + ks * 32 + fq * 8);
                    a = __builtin_amdgcn_mfma_f32_16x16x32_bf16(af, bfv, a, 0, 0, 0); } }
#pragma unroll
            for (int r = 0; r < 4; ++r) { const int c = rt * 16 + fq * 4 + r, sidx = ct * 16 + fr; AM[c * HG_LDC + sidx] = (bf16)((sidx <= c) ? f2bf(a[r]) : 0u); } }
        __syncthreads();
        const bf16x8 vb0 = *(const bf16x8*)(VT + (e0 + fr) * HG_LDC + fq * 8), vb1 = *(const bf16x8*)(VT + (e0 + fr) * HG_LDC + 32 + fq * 8);
        bf16x8 sb[4];
#pragma unroll
        for (int ks = 0; ks < 4; ++ks) { v4u t; t.x = pk2(S[2 * ks][0], S[2 * ks][1]); t.y = pk2(S[2 * ks][2], S[2 * ks][3]); t.z = pk2(S[2 * ks + 1][0], S[2 * ks + 1][1]); t.w = pk2(S[2 * ks + 1][2], S[2 * ks + 1][3]); sb[ks] = __builtin_bit_cast(bf16x8, t); }
        pg8::f32x4 o[4];
#pragma unroll
        for (int rt = 0; rt < 4; ++rt) { pg8::f32x4 a = {0.f, 0.f, 0.f, 0.f};
            a = __builtin_amdgcn_mfma_f32_16x16x32_bf16(*(const bf16x8*)(AM + (rt * 16 + fr) * HG_LDC + fq * 8), vb0, a, 0, 0, 0);
            a = __builtin_amdgcn_mfma_f32_16x16x32_bf16(*(const bf16x8*)(AM + (rt * 16 + fr) * HG_LDC + 32 + fq * 8), vb1, a, 0, 0, 0);
#pragma unroll
            for (int ks = 0; ks < 4; ++ks) { const v2u lo = *(const v2u*)(QE + (rt * 16 + fr) * HG_LDR + ks * 32 + fq * 4), hi = *(const v2u*)(QE + (rt * 16 + fr) * HG_LDR + ks * 32 + 16 + fq * 4);
                const v4u t = {lo.x, lo.y, hi.x, hi.y};
                a = __builtin_amdgcn_mfma_f32_16x16x32_bf16(__builtin_bit_cast(bf16x8, t), sb[ks], a, 0, 0, 0); }
            o[rt] = a; }
#pragma unroll
        for (int dt = 0; dt < 8; ++dt) { const f32x4 dc = *(const f32x4*)(DEC + dt * 16 + fq * 4);
            pg8::f32x4 a = S[dt]; a[0] *= dc[0]; a[1] *= dc[1]; a[2] *= dc[2]; a[3] *= dc[3];
            a = __builtin_amdgcn_mfma_f32_16x16x32_bf16(*(const bf16x8*)(KLT + (dt * 16 + fr) * HG_LDC + fq * 8), vb0, a, 0, 0, 0);
            a = __builtin_amdgcn_mfma_f32_16x16x32_bf16(*(const bf16x8*)(KLT + (dt * 16 + fr) * HG_LDC + 32 + fq * 8), vb1, a, 0, 0, 0);
            S[dt] = a; }
        if (half) {
#pragma unroll
            for (int rt = 0; rt < 4; ++rt) *(pg8::f32x4*)(OLg + ((((size_t)(chunk - 32)) * 8 + w) * 4 + rt) * 256 + lane * 4) = o[rt];
            __syncthreads();
            continue;
        }
#pragma unroll
        for (int rt = 0; rt < 4; ++rt)
#pragma unroll
            for (int r = 0; r < 4; ++r) { float x = o[rt][r] * o[rt][r];
                x += __shfl_xor(x, 1); x += __shfl_xor(x, 2); x += __shfl_xor(x, 4); x += __shfl_xor(x, 8);
                if (fr == 0) SSQ[w * 64 + rt * 16 + fq * 4 + r] = x; }
        __syncthreads();
        float tot = 0.f;
#pragma unroll
        for (int ww = 0; ww < 8; ++ww) tot += SSQ[ww * 64 + lane];
        const float rstd_l = rsqrtf(tot * (1.f / 128.f) + RMS_EPS);
#pragma unroll
        for (int rt = 0; rt < 4; ++rt)
#pragma unroll
            for (int r = 0; r < 4; ++r) { const int c = rt * 16 + fq * 4 + r; const float rs = __shfl(rstd_l, c);
                const float y = o[rt][r] * rs * ogv * siluf_(bf2f(rg[rt * 4 + r]));
                ((unsigned char*)YA)[(row0 + c) * 1024 + h * 128 + e0 + fr] = (unsigned char)(__builtin_amdgcn_cvt_pk_fp8_f32(y, 0.f, 0, false) & 0xff); }
    }
    if (!half) {
#pragma unroll
        for (int ks = 0; ks < 4; ++ks) { v4u t; t.x = pk2(S[2 * ks][0], S[2 * ks][1]); t.y = pk2(S[2 * ks][2], S[2 * ks][3]); t.z = pk2(S[2 * ks + 1][0], S[2 * ks + 1][1]); t.w = pk2(S[2 * ks + 1][2], S[2 * ks + 1][3]);
            *(v4u*)(ws + WS_HSB + ((((size_t)item * 8 + w) * 4 + ks) * 64 + lane) * 16) = t; }
    }
    __syncthreads();
}
__device__ __forceinline__ void hgrn_fix(const Params& p, unsigned char* lds, int item, int c) {
    const int b = item >> 2, h = item & 3;
    const int tid = threadIdx.x, w = tid >> 6, lane = tid & 63, fr = lane & 15, fq = lane >> 4;
    unsigned char* ws = p.ws;
    const bf16* HG = (const bf16*)(ws + WS_HG);
    bf16* YA = (bf16*)(ws + WS_H);
    float* SSQ = (float*)(lds + HGL_SSQ);
    const bf16* QCg = (const bf16*)(ws + WS_HQC) + (size_t)item * 2048 * 128; const float* OLg = (const float*)(ws + WS_HOL) + (size_t)item * 32 * 8 * 4 * 256;
    const int e0 = w * 16;
    const float ogv = p.hg_onorm_g[e0 + fr];
    const size_t row0 = (size_t)b * SEQ + (size_t)(32 + c) * 64;
    bf16x8 sb[4];
#pragma unroll
    for (int ks = 0; ks < 4; ++ks) sb[ks] = __builtin_bit_cast(bf16x8, *(const v4u*)(ws + WS_HSB + ((((size_t)item * 8 + w) * 4 + ks) * 64 + lane) * 16));
    unsigned short rg[16];
#pragma unroll
    for (int i = 0; i < 16; ++i) rg[i] = HG[(row0 + (i >> 2) * 16 + fq * 4 + (i & 3)) * LD_HG + 1536 + h * 128 + e0 + fr];
    pg8::f32x4 o[4];
#pragma unroll
    for (int rt = 0; rt < 4; ++rt) { pg8::f32x4 a = *(const pg8::f32x4*)(OLg + ((((size_t)c) * 8 + w) * 4 + rt) * 256 + lane * 4);
#pragma unroll
        for (int ks = 0; ks < 4; ++ks) { const bf16* qr = QCg + ((size_t)c * 64 + rt * 16 + fr) * 128 + ks * 32;
            const v2u lo = *(const v2u*)(qr + fq * 4), hi = *(const v2u*)(qr + 16 + fq * 4);
            const v4u t = {lo.x, lo.y, hi.x, hi.y};
            a = __builtin_amdgcn_mfma_f32_16x16x32_bf16(__builtin_bit_cast(bf16x8, t), sb[ks], a, 0, 0, 0); }
        o[rt] = a; }
#pragma unroll
    for (int rt = 0; rt < 4; ++rt)
#pragma unroll
        for (int r = 0; r < 4; ++r) { float x = o[rt][r] * o[rt][r];
            x += __shfl_xor(x, 1); x += __shfl_xor(x, 2); x += __shfl_xor(x, 4); x += __shfl_xor(x, 8);
            if (fr == 0) SSQ[w * 64 + rt * 16 + fq * 4 + r] = x; }
    __syncthreads();
    float tot = 0.f;
#pragma unroll
    for (int ww = 0; ww < 8; ++ww) tot += SSQ[ww * 64 + lane];
    const float rstd_l = rsqrtf(tot * (1.f / 128.f) + RMS_EPS);
#pragma unroll
    for (int rt = 0; rt < 4; ++rt)
#pragma unroll
        for (int r = 0; r < 4; ++r) { const int cc = rt * 16 + fq * 4 + r; const float rs = __shfl(rstd_l, cc);
            const float y = o[rt][r] * rs * ogv * siluf_(bf2f(rg[rt * 4 + r]));
            ((unsigned char*)YA)[(row0 + cc) * 1024 + h * 128 + e0 + fr] = (unsigned char)(__builtin_amdgcn_cvt_pk_fp8_f32(y, 0.f, 0, false) & 0xff); }
    __syncthreads();
}

__device__ __forceinline__ unsigned f16key(float x) {
    x = x + 0.f;
    const _Float16 hx = (_Float16)x; const unsigned short bits = __builtin_bit_cast(unsigned short, hx);
    return (bits & 0x8000u) ? (unsigned)(unsigned short)(~bits) : (unsigned)(bits | 0x8000u);
}
__device__ __forceinline__ void find_bin(const unsigned* hist, int K, int lane, int& bin, int& rem) {
    const v4u hv = *(const v4u*)(hist + 4 * lane);
    const unsigned c = hv.x + hv.y + hv.z + hv.w;
    unsigned suf = c;
#pragma unroll
    for (int o = 1; o < 64; o <<= 1) { const unsigned t = __shfl_down(suf, o); if (lane + o < 64) suf += t; }
    const unsigned above = suf - c;
    const bool mine = (above < (unsigned)K) && ((unsigned)K <= suf);
    int mybin = 0, myrem = 0;
    if (mine) { unsigned ca = above; const unsigned hh[4] = {hv.x, hv.y, hv.z, hv.w}; bool found = false;
#pragma unroll
        for (int i = 3; i >= 0; --i) { if (!found) { if (ca + hh[i] >= (unsigned)K) { mybin = 4 * lane + i; myrem = K - (int)ca; found = true; } else ca += hh[i]; } } }
    const unsigned long long m = __ballot(mine);
    const int src = (int)__builtin_ctzll(m | (1ull << 63));
    bin = __shfl(mybin, src); rem = __shfl(myrem, src);
}
__device__ __forceinline__ void dsa1_item(const Params& p, unsigned char* lds, int item) {
    const int b = item >> 8, q0 = (item & 255) * 16;
    const int tid = threadIdx.x, w = tid >> 6, lane = tid & 63, fr = lane & 15, fq = lane >> 4;
    unsigned char* ws = p.ws;
    const bf16* IDX = (const bf16*)(ws + WS_IDX);
    unsigned short* Ik = (unsigned short*)lds;
    unsigned* hist1 = (unsigned*)(lds + 131072);
    unsigned* hist = (unsigned*)(lds + 131072 + 16384) + w * 256;
    const size_t rowb = (size_t)b * SEQ;
    *(v4u*)(hist1 + tid * 4) = (v4u){0u, 0u, 0u, 0u}; *(v4u*)(hist1 + 2048 + tid * 4) = (v4u){0u, 0u, 0u, 0u};
    bf16x8 Af[8][2];
    { const bf16* rp = IDX + (rowb + q0 + fr) * LD_IDX + fq * 8;
#pragma unroll
      for (int h = 0; h < 8; ++h) { Af[h][0] = *(const bf16x8*)(rp + h * 64); Af[h][1] = *(const bf16x8*)(rp + h * 64 + 32); } }
    const float idx_scale = 0.5f * 0.125f * 0.35355339059327373f;
    bf16x8 Aw[2];
    { float wa[8];
      { const v4u wq = *(const v4u*)(IDX + (rowb + q0 + fr) * LD_IDX + 576);
#pragma unroll
        for (int i = 0; i < 4; ++i) { wa[2 * i] = bflo(wq[i]) * idx_scale; wa[2 * i + 1] = bfhi(wq[i]) * idx_scale; } }
#pragma unroll
      for (int ks = 0; ks < 2; ++ks) { float cq[8];
#pragma unroll
          for (int j = 0; j < 8; ++j) cq[j] = 0.f;
#pragma unroll
          for (int h = 0; h < 8; ++h)
#pragma unroll
              for (int j = 0; j < 8; ++j) cq[j] += wa[h] * bf2f((unsigned)(unsigned short)Af[h][ks][j]);
          const v4u t = {pk2(cq[0], cq[1]), pk2(cq[2], cq[3]), pk2(cq[4], cq[5]), pk2(cq[6], cq[7])};
          Aw[ks] = __builtin_bit_cast(bf16x8, t); } }
    float wv[4][8];
#pragma unroll
    for (int r = 0; r < 4; ++r) { const v4u wq = *(const v4u*)(IDX + (rowb + q0 + fq * 4 + r) * LD_IDX + 576);
#pragma unroll
        for (int i = 0; i < 4; ++i) { wv[r][2 * i] = bflo(wq[i]) * idx_scale; wv[r][2 * i + 1] = bfhi(wq[i]) * idx_scale; } }
    const int ntiles = (q0 >> 4) + 1;
    __syncthreads();
    bf16x8 B0 = Aw[0], B1 = Aw[1];
    if (w < ntiles) { const bf16* kp = IDX + (rowb + w * 16 + fr) * LD_IDX + 512 + fq * 8; B0 = *(const bf16x8*)kp; B1 = *(const bf16x8*)(kp + 32); }
    for (int kt = w; kt < ntiles; kt += NWAVES) {
        bf16x8 nB0 = B0, nB1 = B1;
        if (kt + NWAVES < ntiles) { const bf16* kp = IDX + (rowb + (kt + NWAVES) * 16 + fr) * LD_IDX + 512 + fq * 8; nB0 = *(const bf16x8*)kp; nB1 = *(const bf16x8*)(kp + 32); }
        pg8::f32x4 lin = {0.f, 0.f, 0.f, 0.f};
        lin = __builtin_amdgcn_mfma_f32_16x16x32_bf16(Aw[0], B0, lin, 0, 0, 0);
        lin = __builtin_amdgcn_mfma_f32_16x16x32_bf16(Aw[1], B1, lin, 0, 0, 0);
        float I[4] = {lin[0], lin[1], lin[2], lin[3]};
#pragma unroll
        for (int h = 0; h < 8; ++h) { pg8::f32x4 a = {0.f, 0.f, 0.f, 0.f};
            a = __builtin_amdgcn_mfma_f32_16x16x32_bf16(Af[h][0], B0, a, 0, 0, 0);
            a = __builtin_amdgcn_mfma_f32_16x16x32_bf16(Af[h][1], B1, a, 0, 0, 0);
#pragma unroll
            for (int r = 0; r < 4; ++r) I[r] = __builtin_fmaf(wv[r][h], __builtin_fabsf(a[r]), I[r]); }
        const int kidx = kt * 16 + fr;
#pragma unroll
        for (int r = 0; r < 4; ++r) { const unsigned key = f16key(I[r]); Ik[(fq * 4 + r) * 4096 + kidx] = (unsigned short)key;
            if (kidx <= q0 + fq * 4 + r) atomicAdd(&hist1[(fq * 4 + r) * 256 + (key >> 8)], 1u); }
        B0 = nB0; B1 = nB1;
    }
    __syncthreads();
    for (int qq = w; qq < 16; qq += NWAVES) {
        const int t = q0 + qq, n = t + 1;
        unsigned short* so = (unsigned short*)(hist1 + qq * 256);
        const unsigned short* keys = Ik + qq * 4096;
        if (n <= TOPK) { for (int j = lane; j < n; j += 64) so[j] = (unsigned short)j; }
        else {
            int b1, rem1, b2, rem2;
            find_bin(hist1 + qq * 256, TOPK, lane, b1, rem1);
            *(v4u*)(hist + 4 * lane) = (v4u){0u, 0u, 0u, 0u};
            LDS_WAIT(); __builtin_amdgcn_wave_barrier();
            for (int j0 = 0; j0 < n; j0 += 512) { unsigned k4[8];
#pragma unroll
                for (int u = 0; u < 8; ++u) { const int j = j0 + u * 64 + lane; k4[u] = keys[j < 4095 ? j : 4095]; }
#pragma unroll
                for (int u = 0; u < 8; ++u) { const int j = j0 + u * 64 + lane; if (j < n && (int)(k4[u] >> 8) == b1) atomicAdd(&hist[k4[u] & 255u], 1u); } }
            LDS_WAIT(); __builtin_amdgcn_wave_barrier();
            find_bin(hist, rem1, lane, b2, rem2);
            const unsigned thr = ((unsigned)b1 << 8) | (unsigned)b2;
            int base = 0, eqtaken = 0;
            const unsigned long long lt = (lane == 0) ? 0ull : (~0ull >> (64 - lane));
            for (int j0 = 0; j0 < n; j0 += 512) { unsigned k4[8];
#pragma unroll
                for (int u = 0; u < 8; ++u) { const int j = j0 + u * 64 + lane; k4[u] = keys[j < 4095 ? j : 4095]; }
#pragma unroll
                for (int u = 0; u < 8; ++u) {
                    const int j = j0 + u * 64 + lane; const bool valid = j < n; const unsigned k = valid ? k4[u] : 0u;
                    const bool gt = valid && k > thr, eq = valid && k == thr;
                    const unsigned long long meq = __ballot(eq);
                    const int erank = __popcll(meq & lt) + eqtaken;
                    const bool take = gt || (eq && erank < rem2);
                    const unsigned long long mt = __ballot(take);
                    if (take) so[base + __popcll(mt & lt)] = (unsigned short)j;
                    base += __popcll(mt); eqtaken += __popcll(meq);
                }
            }
        }
    }
    __syncthreads();
}

template <int NB>
__device__ __forceinline__ void qknorm_tokens(const Params& p, const int (&toks)[NB], int lane, const float (&qg)[8], const float (&kg)[8]) {
    v4u qv[NB], kv[NB], vv[NB];
#pragma unroll
    for (int n = 0; n < NB; ++n) { const bf16* row = (const bf16*)(p.ws + WS_ATT) + (size_t)toks[n] * LD_ATT;
        qv[n] = *(const v4u*)(row + lane * 8); kv[n] = *(const v4u*)(row + 512 + (lane & 15) * 8); vv[n] = *(const v4u*)(row + 640 + (lane & 15) * 8); }
#pragma unroll
    for (int n = 0; n < NB; ++n) { const int tok = toks[n];
        { float x[8]; float ss = 0.f;
#pragma unroll
          for (int i = 0; i < 4; ++i) { x[2 * i] = bflo(qv[n][i]); x[2 * i + 1] = bfhi(qv[n][i]); ss += x[2 * i] * x[2 * i] + x[2 * i + 1] * x[2 * i + 1]; }
          ss += __shfl_xor(ss, 1); ss += __shfl_xor(ss, 2); ss += __shfl_xor(ss, 4);
          const float rs = rsqrtf(ss * (1.f / 64.f) + RMS_EPS) * (0.125f * 1.4426950408889634f);
#pragma unroll
          for (int i = 0; i < 8; ++i) x[i] = x[i] * rs * qg[i];
          v2u hw, lw;
          hw.x = pk4_fp8(x[0], x[1], x[2], x[3]); hw.y = pk4_fp8(x[4], x[5], x[6], x[7]);
          { const f32x2 d0 = __builtin_amdgcn_cvt_pk_f32_fp8((int)hw.x, false), d1 = __builtin_amdgcn_cvt_pk_f32_fp8((int)hw.x, true), d2 = __builtin_amdgcn_cvt_pk_f32_fp8((int)hw.y, false), d3 = __builtin_amdgcn_cvt_pk_f32_fp8((int)hw.y, true);
            lw.x = pk4_fp8(x[0] - d0[0], x[1] - d0[1], x[2] - d1[0], x[3] - d1[1]); lw.y = pk4_fp8(x[4] - d2[0], x[5] - d2[1], x[6] - d3[0], x[7] - d3[1]); }
          *(v2u*)(p.ws + WS_QHI + (size_t)tok * 512 + lane * 8) = hw; *(v2u*)(p.ws + WS_QLO + (size_t)tok * 512 + lane * 8) = lw; }
        { float x[8]; float ss = 0.f;
#pragma unroll
          for (int i = 0; i < 4; ++i) { x[2 * i] = bflo(kv[n][i]); x[2 * i + 1] = bfhi(kv[n][i]); ss += x[2 * i] * x[2 * i] + x[2 * i + 1] * x[2 * i + 1]; }
          ss += __shfl_xor(ss, 1); ss += __shfl_xor(ss, 2); ss += __shfl_xor(ss, 4);
          const float rs = rsqrtf(ss * (1.f / 64.f) + RMS_EPS);
#pragma unroll
          for (int i = 0; i < 8; ++i) x[i] = x[i] * rs * kg[i];
          v2u o; o.x = pk4_fp8(x[0], x[1], x[2], x[3]); o.y = pk4_fp8(x[4], x[5], x[6], x[7]);
          if (lane < 16) *(v2u*)(p.ws + WS_K8 + (size_t)tok * 128 + lane * 8) = o; }
        { v2u o; o.x = pk4_fp8(bflo(vv[n][0]), bfhi(vv[n][0]), bflo(vv[n][1]), bfhi(vv[n][1])); o.y = pk4_fp8(bflo(vv[n][2]), bfhi(vv[n][2]), bflo(vv[n][3]), bfhi(vv[n][3]));
          if (lane < 16) *(v2u*)(p.ws + WS_V8 + (size_t)tok * 128 + lane * 8) = o; }
    }
}

typedef short v4i16_t __attribute__((ext_vector_type(4)));
__device__ __forceinline__ v4i16_t vtr16(const bf16* ldsp) { return __builtin_amdgcn_ds_read_tr16_b64_v4i16((LAS v4i16_t*)ldsp); }
typedef int v2i_t __attribute__((ext_vector_type(2)));
__device__ __forceinline__ long vtr8(const unsigned char* ldsp) { const v2i_t r = __builtin_amdgcn_ds_read_tr8_b64_v2i32((LAS v2i_t*)ldsp); return (long)(((unsigned long long)(unsigned)r[1] << 32) | (unsigned)r[0]); }
__device__ __forceinline__ void dsa2_query(const Params& p, unsigned char* ldsw, const unsigned short* sel, int b, int t, int lane) {
    unsigned char* ws = p.ws;
    const bf16* ATT = (const bf16*)(ws + WS_ATT);
    bf16* YB = (bf16*)(ws + WS_H);
    unsigned short* sl = (unsigned short*)ldsw;
    float* df = (float*)(ldsw + 512);
    unsigned char* Vl = ldsw + 1536;
    const unsigned char* V8 = ws + WS_V8;
    const int fr = lane & 15, fq = lane >> 4;
    const size_t rowb = (size_t)b * SEQ;
    const int cnt = (t + 1 < TOPK) ? (t + 1) : TOPK;
    { v2u sv = *(const v2u*)(sel + lane * 4);
      const int j0 = lane * 4;
      if (j0 >= cnt) sv.x = 0u; else if (j0 + 1 >= cnt) sv.x &= 0xffffu;
      if (j0 + 2 >= cnt) sv.y = 0u; else if (j0 + 3 >= cnt) sv.y &= 0xffffu;
      *(v2u*)(sl + lane * 4) = sv;
      f32x4 d4; d4[0] = (j0 < cnt) ? (float)(t - (int)(sv.x & 0xffffu)) : INFINITY; d4[1] = (j0 + 1 < cnt) ? (float)(t - (int)(sv.x >> 16)) : INFINITY;
      d4[2] = (j0 + 2 < cnt) ? (float)(t - (int)(sv.y & 0xffffu)) : INFINITY; d4[3] = (j0 + 3 < cnt) ? (float)(t - (int)(sv.y >> 16)) : INFINITY;
      *(f32x4*)(df + lane * 4) = d4; }
    LDS_WAIT(); __builtin_amdgcn_wave_barrier();
    const unsigned char* K8 = ws + WS_K8;
    long qhA[2] = {0, 0}, qhB[2] = {0, 0}, qlA[2] = {0, 0}, qlB[2] = {0, 0};
    if (fr < 8) { const v4u qh = *(const v4u*)(ws + WS_QHI + (rowb + t) * 512 + fr * 64 + fq * 16), ql = *(const v4u*)(ws + WS_QLO + (rowb + t) * 512 + fr * 64 + fq * 16);
        const long hA = (long)(((unsigned long long)qh.y << 32) | qh.x), hB = (long)(((unsigned long long)qh.w << 32) | qh.z), lA = (long)(((unsigned long long)ql.y << 32) | ql.x), lB = (long)(((unsigned long long)ql.w << 32) | ql.z);
        if (fr < 4) { qhA[0] = hA; qhB[0] = hB; qlA[0] = lA; qlB[0] = lB; } else { qhA[1] = hA; qhB[1] = hB; qlA[1] = lA; qlB[1] = lB; } }
    pg8::f32x4 sc[16];
    v4u vv[8];
    {
        v4u G[8];
        unsigned char* kst = Vl;
        const int ksw = ((lane & 7) ^ (lane >> 3)) & 7;
#define K_LOADS(STEP) do { _Pragma("unroll") for (int j = 0; j < 8; ++j) { const int s_ = sl[(STEP) * 64 + j * 8 + (lane >> 3)]; G[j] = *(const v4u*)(K8 + (rowb + s_) * 128 + ((ksw ^ (j & 1)) & 7) * 16); } } while (0)
        K_LOADS(0);
#pragma unroll
        for (int step = 0; step < 4; ++step) {
            LDS_WAIT(); __builtin_amdgcn_wave_barrier();
#pragma unroll
            for (int j = 0; j < 8; ++j) *(v4u*)(kst + j * 1024 + lane * 16) = G[j];
            __builtin_amdgcn_sched_barrier(0);
            if (step < 3) K_LOADS(step + 1);
            else {
#pragma unroll
                for (int j = 0; j < 8; ++j) { const int s = sl[j * 8 + (lane >> 3)]; vv[j] = *(const v4u*)(V8 + (rowb + s) * 128 + (lane & 7) * 16); } }
            __builtin_amdgcn_sched_barrier(0);
            LDS_WAIT(); __builtin_amdgcn_wave_barrier();
#pragma unroll
            for (int kt = 0; kt < 4; ++kt) { pg8::f32x4 a = {0.f, 0.f, 0.f, 0.f};
#pragma unroll
                for (int gg = 0; gg < 2; ++gg) { const v4u kv = *(const v4u*)(kst + (kt * 16 + fr) * 128 + (((gg * 4 + fq) ^ (fr & 7) ^ (fr >> 3)) & 7) * 16);
                    const long kA = (long)(((unsigned long long)kv.y << 32) | kv.x), kB = (long)(((unsigned long long)kv.w << 32) | kv.z);
                    a = __builtin_amdgcn_mfma_f32_16x16x32_fp8_fp8(kA, qhA[gg], a, 0, 0, 0); a = __builtin_amdgcn_mfma_f32_16x16x32_fp8_fp8(kB, qhB[gg], a, 0, 0, 0);
                    a = __builtin_amdgcn_mfma_f32_16x16x32_fp8_fp8(kA, qlA[gg], a, 0, 0, 0); a = __builtin_amdgcn_mfma_f32_16x16x32_fp8_fp8(kB, qlB[gg], a, 0, 0, 0); }
                sc[step * 4 + kt] = a; }
        }
#undef K_LOADS
    }
    const float slope = exp2f(-(float)((fr & 7) + 1)) * 1.4426950408889634f;
    float m = -INFINITY;
#pragma unroll
    for (int kt = 0; kt < 16; ++kt) { const f32x4 d4 = *(const f32x4*)(df + kt * 16 + fq * 4);
#pragma unroll
        for (int r = 0; r < 4; ++r) { const float x = sc[kt][r] - slope * d4[r]; sc[kt][r] = x; m = fmaxf(m, x); } }
    m = fmaxf(m, __shfl_xor(m, 16)); m = fmaxf(m, __shfl_xor(m, 32));
    float l = 0.f;
#pragma unroll
    for (int kt = 0; kt < 16; ++kt)
#pragma unroll
        for (int r = 0; r < 4; ++r) { const float e = __builtin_amdgcn_exp2f(sc[kt][r] - m); sc[kt][r] = e; l += e; }
    l += __shfl_xor(l, 16); l += __shfl_xor(l, 32);
    const float inv = 1.f / l;
    pg8::f32x4 o[2][4];
#pragma unroll
    for (int g2 = 0; g2 < 2; ++g2)
#pragma unroll
        for (int dt = 0; dt < 4; ++dt) o[g2][dt] = (pg8::f32x4){0.f, 0.f, 0.f, 0.f};
    unsigned char* vdst = Vl + ((lane & 7) >> 2) * 6400 + (lane >> 3) * 80 + (lane & 3) * 16;
#pragma unroll
    for (int ch = 0; ch < 4; ++ch) {
        LDS_WAIT(); __builtin_amdgcn_wave_barrier();
#pragma unroll
        for (int j = 0; j < 8; ++j) *(v4u*)(vdst + ((j >> 2) * 40 + ((j >> 1) & 1) * 24 + (j & 1) * 8) * 80) = vv[j];
        if (ch < 3) {
#pragma unroll
            for (int j = 0; j < 8; ++j) { const int s = sl[(ch + 1) * 64 + j * 8 + (lane >> 3)]; vv[j] = *(const v4u*)(V8 + (rowb + s) * 128 + (lane & 7) * 16); } }
        LDS_WAIT(); __builtin_amdgcn_wave_barrier();
#pragma unroll
        for (int k2 = 0; k2 < 2; ++k2) { const int kt0 = ch * 4 + 2 * k2;
            const long pb = (long)(((unsigned long long)pk4_fp8(sc[kt0 + 1][0], sc[kt0 + 1][1], sc[kt0 + 1][2], sc[kt0 + 1][3]) << 32) | pk4_fp8(sc[kt0][0], sc[kt0][1], sc[kt0][2], sc[kt0][3]));
            const int q = fr >> 1, prow = k2 * 40 + ((q < 4) ? (fq * 4 + q) : (24 + fq * 4 + (q - 4)));
#pragma unroll
            for (int g2 = 0; g2 < 2; ++g2)
#pragma unroll
                for (int dt = 0; dt < 4; ++dt) o[g2][dt] = __builtin_amdgcn_mfma_f32_16x16x32_fp8_fp8(vtr8(Vl + g2 * 6400 + prow * 80 + dt * 16 + (fr & 1) * 8), pb, o[g2][dt], 0, 0, 0); }
    }
    { const float i8 = inv * 8.f; unsigned char* yp = (unsigned char*)YB + (rowb + t) * 1024 + 512 + fr * 64 + fq * 4;
      if (fr < 4) {
#pragma unroll
          for (int dt = 0; dt < 4; ++dt) *(unsigned*)(yp + dt * 16) = pk4_fp8(o[0][dt][0] * i8, o[0][dt][1] * i8, o[0][dt][2] * i8, o[0][dt][3] * i8); }
      else if (fr < 8) {
#pragma unroll
          for (int dt = 0; dt < 4; ++dt) *(unsigned*)(yp + dt * 16) = pk4_fp8(o[1][dt][0] * i8, o[1][dt][1] * i8, o[1][dt][2] * i8, o[1][dt][3] * i8); } }
    LDS_WAIT(); __builtin_amdgcn_wave_barrier();
}

#define INS16(L, x) do { _Pragma("unroll") for (int _i = 15; _i >= 1; --_i) L[_i] = __builtin_amdgcn_fmed3f(L[_i - 1], L[_i], (x)); L[0] = fmaxf(L[0], (x)); } while (0)
__device__ __forceinline__ float f_andor(float v, unsigned keepmask, unsigned orv) { return __builtin_bit_cast(float, (__builtin_bit_cast(unsigned, v) & keepmask) | orv); }
__device__ __forceinline__ void peer_select(const Params& p, unsigned char* ldsw, int tg, int h, int lane, int* EIDX, float* GATES) {
    float* sc = (float*)ldsw;
    LDS_WAIT(); __builtin_amdgcn_wave_barrier();
    float L[16];
#pragma unroll
    for (int i = 0; i < 16; ++i) L[i] = -INFINITY;
    { const float* sp = sc + (lane & 31) * 132 + (lane >> 5) * 64;
#pragma unroll 4
      for (int i = 0; i < 16; ++i) { const f32x4 x = *(const f32x4*)(sp + 4 * i); INS16(L, x[0]); INS16(L, x[1]); INS16(L, x[2]); INS16(L, x[3]); } }
    { float O[16];
#pragma unroll
      for (int i = 0; i < 16; ++i) O[i] = __shfl_xor(L[i], 32);
#pragma unroll
      for (int i = 0; i < 16; ++i) INS16(L, O[i]); }
    LDS_WAIT(); __builtin_amdgcn_wave_barrier();
    float* lst = sc;
    if (lane < 32) {
#pragma unroll
        for (int i = 0; i < 4; ++i) *(f32x4*)(lst + lane * 16 + 4 * i) = (f32x4){L[4 * i], L[4 * i + 1], L[4 * i + 2], L[4 * i + 3]}; }
    LDS_WAIT(); __builtin_amdgcn_wave_barrier();
    const int tok = lane & 15;
    float s1[16], s2[16];
#pragma unroll
    for (int i = 0; i < 4; ++i) { const f32x4 a = *(const f32x4*)(lst + tok * 16 + 4 * i), b = *(const f32x4*)(lst + (16 + tok) * 16 + 4 * i);
#pragma unroll
        for (int c = 0; c < 4; ++c) { s1[4 * i + c] = f_andor(a[c], ~127u, 0u); s2[4 * i + c] = f_andor(b[c], ~127u, 0u); } }
    float M[16];
#pragma unroll
    for (int i = 0; i < 16; ++i) M[i] = -INFINITY;
#pragma unroll
    for (int a = 0; a < 16; ++a)
#pragma unroll
        for (int b = 0; b < 16; ++b)
            if ((a + 1) * (b + 1) <= 16) { const float key = f_andor(s1[a] + s2[b], ~255u, (unsigned)(a * 16 + b)); INS16(M, key); }
    const float mx = f_andor(M[0], ~255u, 0u);
    float e[16], sum = 0.f; int ei[16];
    const unsigned* lb = (const unsigned*)lst;
#pragma unroll
    for (int i = 0; i < 16; ++i) { const unsigned bits = __builtin_bit_cast(unsigned, M[i]); const int flat = bits & 255u;
        e[i] = __expf(f_andor(M[i], ~255u, 0u) - mx); sum += e[i];
        ei[i] = (int)(lb[tok * 16 + (flat >> 4)] & 127u) * 128 + (int)(lb[(16 + tok) * 16 + (flat & 15)] & 127u); }
    const float inv = 1.f / sum;
    if (lane < 16) {
        const size_t ob = ((size_t)tok * 8 + h) * 16;
#pragma unroll
        for (int i = 0; i < 4; ++i) { *(v4u*)(EIDX + ob + 4 * i) = (v4u){(unsigned)ei[4 * i], (unsigned)ei[4 * i + 1], (unsigned)ei[4 * i + 2], (unsigned)ei[4 * i + 3]};
            *(f32x4*)(GATES + ob + 4 * i) = (f32x4){e[4 * i] * inv, e[4 * i + 1] * inv, e[4 * i + 2] * inv, e[4 * i + 3] * inv}; }
    }
    LDS_WAIT(); __builtin_amdgcn_wave_barrier();
}

__device__ __forceinline__ void peer_route_block(const Params& p, unsigned char* lds, int* eG, float* gG) {
    const int tid = threadIdx.x, wave = tid >> 6, lane = tid & 63, fr = lane & 15, fq = lane >> 4, G = gridDim.x;
    unsigned char* ws = p.ws;
    const bf16* Q = (const bf16*)(ws + WS_Q);
    const unsigned char* SKb = ws + WS_SK;
    unsigned char* tile = lds + 8 * 16896;
    float* sc = (float*)(lds + wave * 16896);
    int ngrp = 0;
    for (int tg = blockIdx.x; tg < T / 16; tg += G) ++ngrp;
#pragma unroll 1
    for (int k0 = 0; k0 < ngrp; k0 += 8) {
        const bool valid = k0 + wave < ngrp;
        const int tg = (int)blockIdx.x + (valid ? k0 + wave : k0) * G;
        v4u t[4][2];
        bf16x8 An[2][4];
#pragma unroll
        for (int sub = 0; sub < 4; ++sub) { const unsigned char* sp = SKb + (size_t)sub * 16384 + tid * 32; t[sub][0] = *(const v4u*)sp; t[sub][1] = *(const v4u*)(sp + 16); }
#pragma unroll
        for (int pp = 0; pp < 2; ++pp) { const bf16* rp = Q + (size_t)(tg * 16 + fr) * 2048 + pp * 128 + fq * 8;
#pragma unroll
            for (int ks = 0; ks < 4; ++ks) An[pp][ks] = *(const bf16x8*)(rp + ks * 32); }
#pragma unroll 1
        for (int h = 0; h < 8; ++h) {
            bf16x8 Af[2][4];
#pragma unroll
            for (int pp = 0; pp < 2; ++pp)
#pragma unroll
                for (int ks = 0; ks < 4; ++ks) Af[pp][ks] = An[pp][ks];
            const int hn = (h + 1) & 7;
#pragma unroll
            for (int sub = 0; sub < 4; ++sub) {
                const int pp = sub >> 1, half = sub & 1;
                __syncthreads();
                { unsigned char* wp = tile + (tid >> 3) * 272 + (tid & 7) * 32; *(v4u*)wp = t[sub][0]; *(v4u*)(wp + 16) = t[sub][1]; }
                { const unsigned char* sp = SKb + (size_t)(hn * 4 + sub) * 16384 + tid * 32; t[sub][0] = *(const v4u*)sp; t[sub][1] = *(const v4u*)(sp + 16); }
                __syncthreads();
#pragma unroll
                for (int kt = 0; kt < 4; ++kt) {
                    pg8::f32x4 a = {0.f, 0.f, 0.f, 0.f};
#pragma unroll
                    for (int ks = 0; ks < 4; ++ks) { const bf16x8 bv = *(const bf16x8*)(tile + (kt * 16 + fr) * 272 + ks * 64 + fq * 16); a = __builtin_amdgcn_mfma_f32_16x16x32_bf16(Af[pp][ks], bv, a, 0, 0, 0); }
                    const int kg = (half * 4 + kt) * 16 + fr;
#pragma unroll
                    for (int r = 0; r < 4; ++r) sc[(pp * 16 + fq * 4 + r) * 132 + kg] = f_andor(a[r], ~127u, (unsigned)kg);
                }
            }
#pragma unroll
            for (int pp = 0; pp < 2; ++pp) { const bf16* rp = Q + (size_t)(tg * 16 + fr) * 2048 + hn * 256 + pp * 128 + fq * 8;
#pragma unroll
                for (int ks = 0; ks < 4; ++ks) An[pp][ks] = *(const bf16x8*)(rp + ks * 32); }
            if (valid) peer_select(p, (unsigned char*)sc, tg, h, lane, eG + (size_t)tg * 2048, gG + (size_t)tg * 2048);
        }
    }
}

__device__ __forceinline__ float gelu_erf(float x) { return 0.5f * x * (1.f + erff(x * 0.70710678118654752f)); }
typedef int v8i_t __attribute__((ext_vector_type(8)));
template <int OPSEL> __device__ __forceinline__ pg8::f32x4 mx_dot(v8i_t a, int sa, v8i_t b, int sb, pg8::f32x4 c) {
    return __builtin_amdgcn_mfma_scale_f32_16x16x128_f8f6f4(a, b, c, 4  , 4  , OPSEL, sa, OPSEL, sb);
}
__device__ __forceinline__ void peer_token(const Params& p, unsigned char* ldsw, const _Float16* usL, const _Float16* vsL, unsigned char* tile, int tok, int lane, const v2u nxt_e, const v2u nxt_g, int buf) {
    unsigned char* ws = p.ws;
    const unsigned char* V8 = ws + WS_V;
    const float* MOD = (const float*)(ws + WS_MOD);
    const int fr = lane & 15, fq = lane >> 4;
    typedef v8i_t v8i;
    const int* EIDX = (const int*)(ldsw + buf * 1024); const float* GATES = (const float*)(ldsw + buf * 1024 + 512);
    v4u A4[H4_NT][8]; v2u As[H4_NT];
#pragma unroll
    for (int t = 0; t < H4_NT; ++t) { const unsigned char* hp = ws + WS_H4D + ((size_t)tok * H4_NT + t) * 512 + fq * 16;
        As[t] = *(const v2u*)(ws + WS_H4S + ((size_t)tok * H4_NT + t) * 32 + fq * 8);
#pragma unroll
        for (int kk = 0; kk < 8; ++kk) A4[t][kk] = *(const v4u*)(hp + kk * 64); }
    int* pe = (int*)(ldsw + 2048); float* pa = (float*)(ldsw + 2048 + 512);
    const unsigned char* U4 = ws + WS_U;
    const int gr = lane >> 3, gs = lane & 7;
    const int rdbase = (fr >> 3) * 1024 + (fr & 7) * 128, slotA = (fq ^ (fr & 7) ^ (fr >> 3)) & 7;
    v4u G[8];
#define U_LOADS(CT) do { const int e0_ = EIDX[(CT) * 16 + gr], e1_ = EIDX[(CT) * 16 + 8 + gr]; \
        const unsigned char* p0_ = U4 + (size_t)e0_ * 512 + ((gs ^ gr) & 7) * 16; const unsigned char* p1_ = U4 + (size_t)e1_ * 512 + ((gs ^ gr ^ 1) & 7) * 16; \
        _Pragma("unroll") for (int kk = 0; kk < 8; ++kk) G[kk] = *(const v4u*)(((kk & 1) ? p1_ : p0_) + (kk >> 1) * 128); } while (0)
    U_LOADS(0);
#pragma unroll 1
    for (int ct = 0; ct < 8; ++ct) {
        const int eic = EIDX[ct * 16 + fr]; const float gt = GATES[ct * 16 + fr];
#pragma unroll
        for (int kk = 0; kk < 8; ++kk) *(v4u*)(tile + kk * 1024 + lane * 16) = G[kk];
        __builtin_amdgcn_sched_barrier(0);
        U_LOADS((ct + 1) & 7);
        __builtin_amdgcn_sched_barrier(0);
        LDS_WAIT(); __builtin_amdgcn_wave_barrier();
        v4u Bt[8];
#pragma unroll
        for (int j = 0; j < 8; ++j) Bt[j] = *(const v4u*)(tile + (j >> 1) * 2048 + rdbase + (((j & 1) ? (slotA ^ 4) : slotA) * 16));
        LDS_WAIT(); __builtin_amdgcn_wave_barrier();
        pg8::f32x4 ah = {0.f, 0.f, 0.f, 0.f};
#pragma unroll
        for (int kk = 0; kk < 8; ++kk) { const v4u bu = Bt[kk];
            const v8i bb = {(int)bu.x, (int)bu.y, (int)bu.z, (int)bu.w, 0, 0, 0, 0};
            const int sb = 0x7f7f7f7f;
#pragma unroll
            for (int t = 0; t < H4_NT; ++t) { const v8i aa = {(int)A4[t][kk].x, (int)A4[t][kk].y, (int)A4[t][kk].z, (int)A4[t][kk].w, 0, 0, 0, 0}; const int sa = (int)((kk < 4) ? As[t].x : As[t].y);
                if ((kk & 3) == 0) ah = mx_dot<0>(aa, sa, bb, sb, ah); else if ((kk & 3) == 1) ah = mx_dot<1>(aa, sa, bb, sb, ah); else if ((kk & 3) == 2) ah = mx_dot<2>(aa, sa, bb, sb, ah); else ah = mx_dot<3>(aa, sa, bb, sb, ah); } }
        const float dot = ah[0] * (float)usL[eic];
        if (fq == 0) { pe[ct * 16 + fr] = eic; pa[ct * 16 + fr] = gelu_erf(dot) * gt * (float)vsL[eic]; }
    }
    asm volatile("" :: "v"(G[0]), "v"(G[1]), "v"(G[2]), "v"(G[3]), "v"(G[4]), "v"(G[5]), "v"(G[6]), "v"(G[7]));
#undef U_LOADS
    __builtin_amdgcn_sched_barrier(0);
    { int* ne = (int*)(ldsw + (buf ^ 1) * 1024); float* ng = (float*)(ldsw + (buf ^ 1) * 1024 + 512);
      *(v2u*)(ne + 2 * lane) = nxt_e; *(v2u*)(ng + 2 * lane) = nxt_g; }
    const int hl = lane >> 5, bl = lane & 31;
    float acc[32];
#pragma unroll
    for (int i = 0; i < 32; ++i) acc[i] = 0.f;
    LDS_WAIT(); __builtin_amdgcn_wave_barrier();
#pragma unroll 1
    for (int ct = 0; ct < 16; ++ct)
#pragma unroll
        for (int jp = 0; jp < 4; ++jp) {
            const int idx = pe[ct * 8 + 2 * jp + hl]; const float as = pa[ct * 8 + 2 * jp + hl];
            const v4u vv = *(const v4u*)(V8 + (size_t)idx * 512 + bl * 16);
#pragma unroll
            for (int w4 = 0; w4 < 4; ++w4) { const unsigned wd = vv[w4];
                const f32x2 d0 = __builtin_amdgcn_cvt_scalef32_pk_f32_fp4(wd, 1.0f, 0), d1 = __builtin_amdgcn_cvt_scalef32_pk_f32_fp4(wd, 1.0f, 1), d2 = __builtin_amdgcn_cvt_scalef32_pk_f32_fp4(wd, 1.0f, 2), d3 = __builtin_amdgcn_cvt_scalef32_pk_f32_fp4(wd, 1.0f, 3);
                acc[8 * w4] += as * d0[0]; acc[8 * w4 + 1] += as * d0[1]; acc[8 * w4 + 2] += as * d1[0]; acc[8 * w4 + 3] += as * d1[1];
                acc[8 * w4 + 4] += as * d2[0]; acc[8 * w4 + 5] += as * d2[1]; acc[8 * w4 + 6] += as * d3[0]; acc[8 * w4 + 7] += as * d3[1]; }
        }
    LDS_WAIT(); __builtin_amdgcn_wave_barrier();
    float accs[16];
#pragma unroll
    for (int i = 0; i < 16; ++i) { const float lo = acc[i] + __shfl_xor(acc[i], 32), hi2 = acc[16 + i] + __shfl_xor(acc[16 + i], 32); accs[i] = hl ? hi2 : lo; }
    const int b = tok / SEQ;
    const int col0 = bl * 32 + hl * 16;
    const float* g2 = MOD + (size_t)b * 6144 + 5 * 1024 + col0;
    float* orow = p.out + (size_t)tok * DM + col0;
#pragma unroll
    for (int q4 = 0; q4 < 4; ++q4) { const f32x4 xv = *(const f32x4*)(orow + 4 * q4), gv = *(const f32x4*)(g2 + 4 * q4);
        f32x4 o;
#pragma unroll
        for (int i = 0; i < 4; ++i) o[i] = xv[i] + gv[i] * accs[4 * q4 + i];
        *(f32x4*)(orow + 4 * q4) = o; }
}

#define XB_TMO      128
#define XB_XCNT(j)  (256  + 64 * (j))
#define XB_XSUB(j)  (1280 + 64 * (j))
#define XB_XGEN(j)  (2304 + 64 * (j))
#define XB_TOP      3328
#define XB_TOPGEN   3392
#define XCD_BAR_WORDS 3456
#define XB_SPIN_CAP (1u << 18)

__device__ __forceinline__ unsigned xb_ld(unsigned* p)              { return __hip_atomic_load(p, __ATOMIC_RELAXED, __HIP_MEMORY_SCOPE_AGENT); }
__device__ __forceinline__ unsigned xb_add(unsigned* p, unsigned v) { return __hip_atomic_fetch_add(p, v, __ATOMIC_RELAXED, __HIP_MEMORY_SCOPE_AGENT); }
__device__ __forceinline__ unsigned xb_xcc_id() { return (unsigned)__builtin_amdgcn_s_getreg((3 << 11) | 20) & 0xFu; }
#define XB_SPIN(cond, bar) do { unsigned _sp = 0; while (cond) { __builtin_amdgcn_s_sleep(1); \
    if ((++_sp & 255u) == 0u) { if (xb_ld(&(bar)[XB_TMO])) break; if (_sp > XB_SPIN_CAP) { atomicAdd(&(bar)[XB_TMO], 1u); break; } } } } while (0)

struct XcdBarrier {
    unsigned* bar; unsigned x;
    volatile LAS unsigned* st;
};

__device__ __forceinline__ XcdBarrier xcd_barrier_post(unsigned* bar, volatile LAS unsigned* st) {
    XcdBarrier b; b.bar = bar; b.x = xb_xcc_id(); b.st = st;
    if (threadIdx.x == 0) (void)xb_add(&bar[XB_XCNT(b.x)], 1u);
    return b;
}
__device__ __forceinline__ void xcd_barrier_complete(unsigned* bar, unsigned x, unsigned& nloc, unsigned& nx) {
    const unsigned G = gridDim.x * gridDim.y * gridDim.z;
    unsigned sum, cnt, mine, sp = 0u;
    for (;;) {
        sum = 0u; cnt = 0u; mine = 0u;
#pragma unroll
        for (unsigned j = 0; j < 16; ++j) { const unsigned c = xb_ld(&bar[XB_XCNT(j)]); sum += c; cnt += (c > 0u) ? 1u : 0u; mine = (j == x) ? c : mine; }
        if (sum == G) break;
        __builtin_amdgcn_s_sleep(1);
        if ((++sp & 255u) == 0u) { if (xb_ld(&bar[XB_TMO])) break; if (sp > XB_SPIN_CAP) { atomicAdd(&bar[XB_TMO], 1u); break; } }
    }
    nloc = mine > 0u ? mine : 1u; nx = cnt > 0u ? cnt : 1u;
}

__device__ __forceinline__ void xcd_barrier(const XcdBarrier& b) {
    asm volatile("s_waitcnt vmcnt(0)" ::: "memory");
    __syncthreads();
    if (threadIdx.x == 0) {
        unsigned* bar = b.bar;
        __builtin_amdgcn_s_waitcnt(0);
        unsigned nloc = b.st[0], nx = b.st[1];
        if (nloc == 0u) { xcd_barrier_complete(bar, b.x, nloc, nx); b.st[0] = nloc; b.st[1] = nx; }
        const unsigned old = xb_add(&bar[XB_XSUB(b.x)], 1u);
        const unsigned gen = old / nloc;
        if (old + 1u == (gen + 1u) * nloc) {
            __builtin_amdgcn_fence(__ATOMIC_RELEASE, "agent");
            asm volatile("s_waitcnt vmcnt(0)" ::: "memory");
            const unsigned og = xb_add(&bar[XB_TOP], 1u);
            const unsigned tg = og / nx;
            if (og + 1u == (tg + 1u) * nx) xb_add(&bar[XB_TOPGEN], 1u);
            else XB_SPIN(xb_ld(&bar[XB_TOPGEN]) == tg, bar);
            __builtin_amdgcn_fence(__ATOMIC_ACQUIRE, "agent");
            xb_add(&bar[XB_XGEN(b.x)], 1u);
            asm volatile("s_waitcnt vmcnt(0)" ::: "memory");
        } else {
            XB_SPIN(xb_ld(&bar[XB_XGEN(b.x)]) == gen, bar);
            __builtin_amdgcn_fence(__ATOMIC_ACQUIRE, "agent");
            asm volatile("s_waitcnt vmcnt(0)" ::: "memory");
        }
    }
    __syncthreads();
}

constexpr int NPHASE = 11;
__global__ void __launch_bounds__(NTHREADS, 2) mega(Params p) {
    extern __shared__ __attribute__((aligned(16))) unsigned char lds[];
    cg::grid_group grid = cg::this_grid();
    const int lo = p.ph_lo, hi = p.ph_hi;
    const int tid = threadIdx.x, wave = tid >> 6, lane = tid & 63, G = gridDim.x;
    unsigned char* ws = p.ws;
#ifndef ONLYPH
#define IN(k) (lo <= (k) && (k) < hi)
#else
#define IN(k) ((k) == ONLYPH && lo <= (k) && (k) < hi)
#endif
    volatile LAS unsigned* xb_st = (volatile LAS unsigned*)((LAS unsigned char*)lds + (LDS_BYTES - 16));
    if (tid < 4) xb_st[tid] = 0u;
    __syncthreads();
    XcdBarrier xbar; xbar.bar = (unsigned*)(ws + WS_CTL); xbar.x = 0; xbar.st = xb_st;
    if (hi - lo > 1) xbar = xcd_barrier_post((unsigned*)(ws + WS_CTL), xb_st);
    if (lo < -1) grid.sync();
#define SEAM(k) do { if (IN((k) + 1)) xcd_barrier(xbar); } while (0)
#ifndef REPMASK
#define REPMASK 0
#endif
#define NREP(k) (((REPMASK >> (k)) & 1) ? 2 : 1)
    if (IN(0)) { for (int rep = 0; rep < NREP(0); ++rep) phase0(p, lds); SEAM(0); }
    if (IN(1)) { for (int rep = 0; rep < NREP(1); ++rep) normmod_phase<true>(p, lds, p.x, (bf16*)(ws + WS_H), p.norm1_g, 0, 1024); SEAM(1); }
    if (IN(2)) {
        { pg8::Gemm g{(const bf16*)(ws + WS_H8), (const bf16*)(ws + WS_WIN8), T, 3584, 512, 512, 512}; pg8::StaticOrder S; S.init(T, 3584, G, (int)blockIdx.x);
          EpiProj E{(bf16*)(ws + WS_HG), (bf16*)(ws + WS_ATT), (bf16*)(ws + WS_IDX), (bf16*)(ws + WS_GATE), 1};
          pg8::gemm_phase<EpiProj, pg8::StaticOrder, true, true, 122>((PG8_LAS unsigned char*)lds, g, S, E); }
        { pg8::Gemm g{(const bf16*)(ws + WS_H), (const bf16*)(ws + WS_WIN), T, 2048, 1024, 1024, 1024}; pg8::StaticOrder S; S.init(T, 2048, G, (int)blockIdx.x);
          EpiProj E{(bf16*)(ws + WS_HG), (bf16*)(ws + WS_ATT), (bf16*)(ws + WS_IDX), (bf16*)(ws + WS_GATE), 0};
          pg8::gemm_phase<EpiProj, pg8::StaticOrder, true, true>((PG8_LAS unsigned char*)lds, g, S, E); }
        SEAM(2);
    }
    if (IN(3)) {
        { float qg[8], kg[8];
#pragma unroll
          for (int i = 0; i < 8; ++i) { qg[i] = p.q_norm_g[(lane & 7) * 8 + i]; kg[i] = p.k_norm_g[(lane & 7) * 8 + i]; }
          int tok = (int)blockIdx.x * NWAVES + wave; const int st = G * NWAVES;
          for (; tok + 3 * st < T; tok += 4 * st) { const int tk[4] = {tok, tok + st, tok + 2 * st, tok + 3 * st}; qknorm_tokens<4>(p, tk, lane, qg, kg); }
          for (; tok < T; tok += st) { const int tk[1] = {tok}; qknorm_tokens<1>(p, tk, lane, qg, kg); } }
        SEAM(3);
    }
    if (IN(4)) {
        if ((int)blockIdx.x < 32) hgrn_item<0>(p, lds, (int)blockIdx.x); else if ((int)blockIdx.x < 64) hgrn_item<1>(p, lds, (int)blockIdx.x - 32);
        {
            unsigned* qctr = (unsigned*)(ws + WS_CTL + 32768);
            volatile LAS unsigned* qslot = (volatile LAS unsigned*)((LAS unsigned char*)lds + (LDS_BYTES - 32));
            int qsel = (int)(blockIdx.x & 7u), tried = 0;
            for (;;) {
                if (tid == 0) { unsigned c;
                    for (;;) { c = __hip_atomic_fetch_add(qctr + qsel * 64, 1u, __ATOMIC_RELAXED, __HIP_MEMORY_SCOPE_AGENT); if (c < (unsigned)(SEQ / 16) || tried >= 7) break; qsel = (qsel + 1) & 7; ++tried; }
                    *qslot = (c < (unsigned)(SEQ / 16)) ? (((unsigned)qsel << 16) | c) : 0xffffffffu; }
                __syncthreads();
                const unsigned c = *qslot;
                __syncthreads();
                if (c == 0xffffffffu) break;
                const int b = (int)(c >> 16), qblk = (SEQ / 16 - 1) - (int)(c & 0xffffu), it = b * (SEQ / 16) + qblk, q0 = qblk * 16;
                dsa1_item(p, lds, it);
#pragma unroll 1
                for (int k2 = 0; k2 < 2; ++k2) dsa2_query(p, lds + wave * 16384, (const unsigned short*)(lds + 131072 + (wave + 8 * k2) * 1024), b, q0 + wave + 8 * k2, lane);
                __syncthreads();
            }
        }
        if (hi - lo > 1) xcd_barrier(xbar);
        for (int u = blockIdx.x; u < 32 * 32; u += G) hgrn_fix(p, lds, u >> 5, u & 31);
        SEAM(4);
    }
    if (IN(5)) {
        pg8::Gemm g{(const bf16*)(ws + WS_H), (const bf16*)(ws + WS_WAB8), T, 1024, 256, 512, 512}; pg8::StaticOrderT<true> S; S.init(T, 1024, G, (int)blockIdx.x, 256);
        EpiMerged E{(const bf16*)(ws + WS_GATE), (bf16*)(ws + WS_MERGED)};
        for (int rep = 0; rep < NREP(5); ++rep) pg8::gemm_phase<EpiMerged, pg8::StaticOrderT<true>, true, true, 122>((PG8_LAS unsigned char*)lds, g, S, E);
        SEAM(5);
    }
    if (IN(6)) {
        pg8::Gemm g{(const bf16*)(ws + WS_MERGED), (const bf16*)(ws + WS_WOUT8), T, 1024, 512, 512, 512}; pg8::StaticOrder S; S.init(T, 1024, G, (int)blockIdx.x);
        EpiResid E{p.x, (const float*)(ws + WS_MOD) + 2048, p.out};
        for (int rep = 0; rep < NREP(6); ++rep) pg8::gemm_phase<EpiResid, pg8::StaticOrder, true, true, 120>((PG8_LAS unsigned char*)lds, g, S, E);
        SEAM(6);
    }
    if (IN(7)) { for (int rep = 0; rep < NREP(7); ++rep) normmod_phase<false>(p, lds, p.out, (bf16*)(ws + WS_H), p.norm2_g, 3 * 1024, 4 * 1024); SEAM(7); }
    if (IN(8)) {
        pg8::Gemm g{(const bf16*)(ws + WS_H), (const bf16*)(ws + WS_WQ), T, 2048, 1024, 1024, 1024}; pg8::StaticOrder S; S.init(T, 2048, G, (int)blockIdx.x);
        EpiStore E{(bf16*)(ws + WS_Q), 2048};
        for (int rep = 0; rep < NREP(8); ++rep) pg8::gemm_phase<EpiStore, pg8::StaticOrder, true, true>((PG8_LAS unsigned char*)lds, g, S, E);
        SEAM(8);
    }
    if (IN(9)) {
        int* eG = (int*)(ws + WS_EIDX); float* gG = (float*)(ws + WS_PGATE);
        peer_route_block(p, lds, eG, gG);
        asm volatile("s_waitcnt vmcnt(0)" ::: "memory");
        __syncthreads();
        _Float16* usL = (_Float16*)lds; _Float16* vsL = (_Float16*)(lds + 32768);
        for (int i = tid; i < NEXP / 8; i += NTHREADS) { ((v4u*)usL)[i] = ((const v4u*)(ws + WS_US))[i]; ((v4u*)vsL)[i] = ((const v4u*)(ws + WS_VS))[i]; }
        unsigned char* ldsw = lds + 65536 + wave * 3072;
        int ntok = 0;
        for (int tg = blockIdx.x; tg < T / 16; tg += G) ntok += 2;
        auto tok_of = [&](int j) { return ((int)blockIdx.x + (j >> 1) * G) * 16 + wave + 8 * (j & 1); };
        auto ld_lists = [&](int tok, v2u& e, v2u& g) {
            const unsigned* ep = (const unsigned*)(eG + (size_t)tok * 128 + 2 * lane); const unsigned* gp = (const unsigned*)(gG + (size_t)tok * 128 + 2 * lane);
            e.x = __hip_atomic_load(ep, __ATOMIC_RELAXED, __HIP_MEMORY_SCOPE_AGENT); e.y = __hip_atomic_load(ep + 1, __ATOMIC_RELAXED, __HIP_MEMORY_SCOPE_AGENT);
            g.x = __hip_atomic_load(gp, __ATOMIC_RELAXED, __HIP_MEMORY_SCOPE_AGENT); g.y = __hip_atomic_load(gp + 1, __ATOMIC_RELAXED, __HIP_MEMORY_SCOPE_AGENT); };
        if (ntok > 0) { v2u e0, g0; ld_lists(tok_of(0), e0, g0); *(v2u*)((int*)ldsw + 2 * lane) = e0; *(v2u*)((float*)(ldsw + 512) + 2 * lane) = g0; }
        __syncthreads();
#pragma unroll 1
        for (int j = 0; j < ntok; ++j) {
            v2u ne = {0u, 0u}, ng = {0u, 0u};
            if (j + 1 < ntok) ld_lists(tok_of(j + 1), ne, ng);
            peer_token(p, ldsw, usL, vsL, lds + 90112 + wave * 8192, tok_of(j), lane, ne, ng, j & 1);
            LDS_WAIT(); __builtin_amdgcn_wave_barrier();
        }
    }
#undef IN
#undef SEAM
}

#ifndef ONE_LAUNCH
#define ONE_LAUNCH 1
#endif
extern "C" void kernel_launch(void* const* d_in, const int* in_sizes, int n_in, void* d_out, int out_size, void* d_ws, size_t ws_size, hipStream_t stream) {
    static int grid = 0;
    if (grid == 0) {
        if (n_in != 18 || out_size != T * DM || ws_size < WS_END) { fprintf(stderr, "kernel_launch: unexpected shapes (n_in %d, out %d, ws %zu)\n", n_in, out_size, ws_size); grid = -1; return; }
        int dev = 0, cus = 0, per_cu = 0;
        if (hipGetDevice(&dev) != hipSuccess || hipDeviceGetAttribute(&cus, hipDeviceAttributeMultiprocessorCount, dev) != hipSuccess) { grid = -1; return; }
        if (hipFuncSetAttribute((const void*)mega, hipFuncAttributeMaxDynamicSharedMemorySize, LDS_BYTES) != hipSuccess) { fprintf(stderr, "kernel_launch: hipFuncSetAttribute failed\n"); grid = -1; return; }
        if (hipOccupancyMaxActiveBlocksPerMultiprocessor(&per_cu, (const void*)mega, NTHREADS, LDS_BYTES) != hipSuccess || per_cu < 1) { fprintf(stderr, "kernel_launch: occupancy query says %d\n", per_cu); grid = -1; return; }
        (void)hipGetLastError();
        grid = cus;
        if (grid < 64) { grid = -1; return; }
    }
    if (grid < 0) return;
    Params p{};
    const float** pp = (const float**)&p;
    for (int i = 0; i < 18; ++i) pp[i] = (const float*)d_in[i];
    p.out = (float*)d_out; p.ws = (unsigned char*)d_ws;
#if ONE_LAUNCH
    if (hipMemsetAsync((char*)d_ws + WS_CTL, 0, 65536, stream) != hipSuccess) { fprintf(stderr, "kernel_launch: memset failed\n"); return; }
    p.ph_lo = 0; p.ph_hi = NPHASE;
    void* args[] = {&p};
    hipError_t e = hipLaunchCooperativeKernel((const void*)mega, dim3(grid), dim3(NTHREADS), args, LDS_BYTES, stream);
    if (e != hipSuccess) fprintf(stderr, "cooperative launch failed: %s (grid %d)\n", hipGetErrorString(e), grid);
#else
    for (int k = 0; k < NPHASE; ++k) { p.ph_lo = k; p.ph_hi = k + 1; hipLaunchKernelGGL(mega, dim3(grid), dim3(NTHREADS), LDS_BYTES, stream, p); }
#endif
}
```

```cpp
#include <hip/hip_runtime.h>
#include <hip/hip_cooperative_groups.h>
#include <cstdio>
#include <cstdint>
namespace cg = cooperative_groups;

namespace pg8 {
#define PG8_LAS __attribute__((address_space(3)))
typedef unsigned short bf16_t;
typedef short bf16x8 __attribute__((ext_vector_type(8)));
typedef float f32x4 __attribute__((ext_vector_type(4)));
typedef unsigned u32x4 __attribute__((ext_vector_type(4)));
constexpr int BM = 256, BK = 64, HALF = 128, HTB = HALF * BK * 2  , STAGE_BYTES = 8 * HTB, NXCD = 8, WGM = 8;

__host__ __device__ __forceinline__ int lds_byte(int r, int c) { const int st = (r >> 4) * 2 + (c >> 5), rr = r & 15, cc = c & 31, ob = rr * 64 + cc * 2; return st * 1024 + (ob ^ (((ob >> 9) & 1) << 5)); }
__host__ __device__ __forceinline__ void stage_rc(int b, int& R, int& C) { const int st = b / 1024, sb = b % 1024, swz = sb ^ (((sb >> 9) & 1) << 5); R = (st >> 1) * 16 + swz / 64; C = (st & 1) * 32 + (swz % 64) / 2; }
__host__ __device__ __forceinline__ int perm32(int rho) { const int n = rho >> 4, i = rho & 15; return 8 * (i >> 2) + 4 * n + (i & 3); }

struct Unit { int pm, pn, ko, pass; };
struct Gemm { const bf16_t* A; const bf16_t* Bt; int M, N, K, lda, ldb; };
typedef float f32x16 __attribute__((ext_vector_type(16)));
typedef f32x16 AccW[2][2][2];
__device__ __forceinline__ f32x4 acc_get(const AccW& A, int ai, int bj, int m, int n) { const int s_ = ((m & 1) * 2 + n) * 4; const f32x16& w = A[ai][bj][m >> 1]; return (f32x4){w[s_], w[s_ + 1], w[s_ + 2], w[s_ + 3]}; }
__device__ __forceinline__ void acc_set(AccW& A, int ai, int bj, int m, int n, f32x4 v) { const int s_ = ((m & 1) * 2 + n) * 4; f32x16& w = A[ai][bj][m >> 1]; w[s_] = v[0]; w[s_ + 1] = v[1]; w[s_ + 2] = v[2]; w[s_ + 3] = v[3]; }

template <bool TWOPASS_ORDER = false>
struct StaticOrderT {
    int nM, nN, nwg, G, c, kpass;
    __host__ __device__ void init(int M, int N, int G_, int c_, int kpass_ = 512) { nM = M / BM; nN = N / BM; nwg = nM * nN; G = G_; c = c_; kpass = kpass_; }
    __host__ __device__ bool next(int i, Unit& u) const {
        const long L = (long)(TWOPASS_ORDER ? (i >> 1) : i) * G + c; if (L >= nwg) return false;
        u.pass = TWOPASS_ORDER ? (i & 1) : 0; u.ko = TWOPASS_ORDER ? (i & 1) * kpass : 0;
        int wgid = (int)L; { const int q = nwg / NXCD, r = nwg % NXCD, xcd = wgid % NXCD, off = wgid / NXCD; wgid = (xcd < r ? xcd * (q + 1) : r * (q + 1) + (xcd - r) * q) + off; }
        const int nig = WGM * nN, gid = wgid / nig, fm = gid * WGM, gsz = (nM - fm) < WGM ? (nM - fm) : WGM;
        u.pm = fm + ((wgid % nig) % gsz); u.pn = (wgid % nig) / gsz; return true;
    }
    __device__ __forceinline__ void a_ready(const Unit&) const {}
    __device__ __forceinline__ void done(const Unit&) const {}
};
typedef StaticOrderT<false> StaticOrder;

__device__ __forceinline__ unsigned cvt_pk_bf16(float lo, float hi) { unsigned r; asm volatile("v_cvt_pk_bf16_f32 %0, %1, %2" : "=v"(r) : "v"(lo), "v"(hi)); return r; }

template <class Epi, class Sched, bool ALIGN_EPI = false, bool SP2 = false, int F8SCALE = 0>
__device__ __forceinline__ void gemm_phase(PG8_LAS unsigned char* lds, const Gemm g, const Sched& S, const Epi& E) {
    const int tid = threadIdx.x, wid = __builtin_amdgcn_readfirstlane(tid >> 6), lane = tid & 63, wr = wid >> 2, wc = wid & 3, fr = lane & 15, fq = lane >> 4;
    const int K = g.K, nt = K / BK;
    unsigned voffA[2], voffB[2];
#pragma unroll
    for (int i = 0; i < 2; ++i) { int R, C; stage_rc(tid * 16 + i * 8192, R, C); const int Rb = Epi::PERM ? ((R & ~31) + perm32(R & 31)) : R;
        voffA[i] = (unsigned)(R * g.lda + C) * 2u; voffB[i] = (unsigned)(Rb * g.ldb + C) * 2u; }
    const size_t kstep = (size_t)(BK * 2);
    const size_t hstepA = (size_t)HALF * g.lda * 2, hstepB = (size_t)HALF * g.ldb * 2;
    const size_t tstepA = 2 * hstepA, tstepB = 2 * hstepB;
    const unsigned ldsw = (unsigned)wid * 1024u;
    const int aoff = lds_byte(wr * 64 + fr, fq * 8), boff = lds_byte(wc * 32 + fr, fq * 8);
#define PG8_SA(b, h) (((b) * 2 + (h)) * HTB)
#define PG8_SB(b, h) ((4 + (b) * 2 + (h)) * HTB)
#define PG8_STAGE(bufoff, gbase, voff) do { _Pragma("unroll") for (int _i = 0; _i < 2; ++_i) \
        __builtin_amdgcn_global_load_lds((const unsigned*)((const char*)(gbase) + (voff)[_i]), (PG8_LAS unsigned*)(lds + (bufoff) + ldsw + _i * 8192), 16, 0, 0); } while (0)
#define PG8_LDA(dst, b, h) do { _Pragma("unroll") for (int m = 0; m < 4; ++m) { if constexpr (F8SCALE != 0) { \
        PG8_F8(dst)[m].lo = *(const PG8_LAS v4i_f*)(lds + PG8_SA(b, h) + aoff + m * 2048); PG8_F8(dst)[m].hi = *(const PG8_LAS v4i_f*)(lds + PG8_SA(b, h) + aoff + m * 2048 + 1024); } \
        else { _Pragma("unroll") for (int k = 0; k < 2; ++k) dst[m][k] = *(const PG8_LAS bf16x8*)(lds + PG8_SA(b, h) + aoff + m * 2048 + k * 1024); } } } while (0)
#define PG8_LDB(dst, b, h) do { _Pragma("unroll") for (int n = 0; n < 2; ++n) { if constexpr (F8SCALE != 0) { \
        PG8_F8(dst)[n].lo = *(const PG8_LAS v4i_f*)(lds + PG8_SB(b, h) + boff + n * 2048); PG8_F8(dst)[n].hi = *(const PG8_LAS v4i_f*)(lds + PG8_SB(b, h) + boff + n * 2048 + 1024); } \
        else { _Pragma("unroll") for (int k = 0; k < 2; ++k) dst[n][k] = *(const PG8_LAS bf16x8*)(lds + PG8_SB(b, h) + boff + n * 2048 + k * 1024); } } } while (0)
#define PG8_MMA(ai, bj, At, Bt) do { __builtin_amdgcn_s_setprio(1); _Pragma("unroll") for (int m = 0; m < 4; ++m) _Pragma("unroll") for (int n = 0; n < 2; ++n) { \
        f32x4 _c = acc_get(accw, ai, bj, m, n); \
        if constexpr (F8SCALE != 0) { _c = __builtin_amdgcn_mfma_scale_f32_16x16x128_f8f6f4(PG8_F8(Bt)[n], PG8_F8(At)[m], _c, 0, 0, 0, 0x7f7f7f7f, 0, F8SCALE * 0x01010101); } \
        else { _Pragma("unroll") for (int k = 0; k < 2; ++k) _c = __builtin_amdgcn_mfma_f32_16x16x32_bf16(Bt[n][k], At[m][k], _c, 0, 0, 0); } \
        acc_set(accw, ai, bj, m, n, _c); } \
        __builtin_amdgcn_s_setprio(0); } while (0)
#define PG8_WAIT_V(n) asm volatile("s_waitcnt vmcnt(" #n ")" ::: "memory")
#define PG8_WAIT_L(n) asm volatile("s_waitcnt lgkmcnt(" #n ")" ::: "memory")
#define PG8_BAR __builtin_amdgcn_s_barrier()
#define PG8_SCHED __builtin_amdgcn_sched_barrier(0)
    Unit cur, nxt; int ui = 0;
    if (!S.next(0, cur)) return;
    typedef int v4i_f __attribute__((ext_vector_type(4))); typedef int v8i_f __attribute__((ext_vector_type(8))); typedef f32x16 f32x16_f;
    AccW accw;
#pragma unroll
    for (int a = 0; a < 2; ++a)
#pragma unroll
        for (int b = 0; b < 2; ++b)
#pragma unroll
            for (int mp = 0; mp < 2; ++mp)
#pragma unroll
                for (int i = 0; i < 16; ++i) accw[a][b][mp][i] = 0.f;
    bf16x8 At[4][2], B0[2][2], B1[2][2];
    v8i_f At8[4], B08[2], B18[2];
#define PG8_F8(x) x##8
    const char* cA = (const char*)g.A + (size_t)cur.pm * tstepA + (size_t)cur.ko * 2; const char* cB = (const char*)g.Bt + (size_t)cur.pn * tstepB + (size_t)cur.ko * 2;
    S.a_ready(cur);
    if constexpr (SP2) {
        PG8_STAGE(PG8_SB(0, 0), cB, voffB); PG8_STAGE(PG8_SB(0, 1), cB + hstepB, voffB); PG8_STAGE(PG8_SA(0, 0), cA, voffA); PG8_STAGE(PG8_SA(0, 1), cA + hstepA, voffA);
        if (wr == 1) PG8_BAR;
        PG8_WAIT_V(2); PG8_BAR;
        PG8_STAGE(PG8_SB(1, 0), cB + kstep, voffB); PG8_STAGE(PG8_SA(1, 0), cA + kstep, voffA); PG8_STAGE(PG8_SB(1, 1), cB + hstepB + kstep, voffB);
        PG8_WAIT_V(6); PG8_BAR;
    } else {
        PG8_STAGE(PG8_SB(0, 0), cB, voffB); PG8_STAGE(PG8_SA(0, 0), cA, voffA); PG8_STAGE(PG8_SB(0, 1), cB + hstepB, voffB); PG8_STAGE(PG8_SA(0, 1), cA + hstepA, voffA);
        if (wr == 1) PG8_BAR;
        PG8_WAIT_V(4); PG8_BAR;
        PG8_STAGE(PG8_SB(1, 0), cB + kstep, voffB); PG8_STAGE(PG8_SA(1, 0), cA + kstep, voffA); PG8_STAGE(PG8_SB(1, 1), cB + hstepB + kstep, voffB);
        PG8_WAIT_V(6); PG8_BAR;
    }
    for (;;) {
        const bool has_next = S.next(ui + 1, nxt);
        const char* nA = has_next ? (const char*)g.A + (size_t)nxt.pm * tstepA + (size_t)nxt.ko * 2 : cA; const char* nB = has_next ? (const char*)g.Bt + (size_t)nxt.pn * tstepB + (size_t)nxt.ko * 2 : cB;
        for (int t = 0; t < nt; t += 2) {
            const bool last = (t == nt - 2);
            const char* a1 = cA + (size_t)(t + 1) * kstep;
            const char* a2 = last ? nA : cA + (size_t)(t + 2) * kstep; const char* b2 = last ? nB : cB + (size_t)(t + 2) * kstep;
            const char* a3 = a2 + kstep; const char* b3 = b2 + kstep;
            if (last && has_next) S.a_ready(nxt);
            if constexpr (SP2) {
            PG8_LDB(B0, 0, 0); PG8_LDB(B1, 0, 1); PG8_SCHED; PG8_LDA(At, 0, 0); PG8_STAGE(PG8_SA(1, 1), a1 + hstepA, voffA);
            PG8_WAIT_V(8); PG8_WAIT_L(0); PG8_BAR; PG8_MMA(0, 0, At, B0); PG8_MMA(0, 1, At, B1); PG8_BAR; PG8_SCHED;
            PG8_LDA(At, 0, 1); PG8_STAGE(PG8_SB(0, 0), b2, voffB); PG8_STAGE(PG8_SB(0, 1), b2 + hstepB, voffB); PG8_STAGE(PG8_SA(0, 0), a2, voffA);
            PG8_WAIT_V(8); PG8_WAIT_L(0); PG8_BAR; PG8_MMA(1, 0, At, B0); PG8_MMA(1, 1, At, B1); PG8_BAR; PG8_SCHED;
            PG8_LDB(B0, 1, 0); PG8_LDB(B1, 1, 1); PG8_SCHED; PG8_LDA(At, 1, 0); PG8_STAGE(PG8_SA(0, 1), a2 + hstepA, voffA);
            PG8_WAIT_V(8); PG8_WAIT_L(0); PG8_BAR; PG8_MMA(0, 0, At, B0); PG8_MMA(0, 1, At, B1); PG8_BAR; PG8_SCHED;
            PG8_LDA(At, 1, 1); PG8_STAGE(PG8_SB(1, 0), b3, voffB); PG8_STAGE(PG8_SB(1, 1), b3 + hstepB, voffB); PG8_STAGE(PG8_SA(1, 0), a3, voffA);
            PG8_WAIT_V(8); PG8_WAIT_L(0); PG8_BAR; PG8_MMA(1, 0, At, B0); PG8_MMA(1, 1, At, B1); PG8_BAR; PG8_SCHED;
            } else {
            PG8_LDB(B0, 0, 0); PG8_SCHED; PG8_LDA(At, 0, 0); PG8_STAGE(PG8_SA(1, 1), a1 + hstepA, voffA);
            PG8_WAIT_L(8); PG8_BAR; PG8_WAIT_L(0); PG8_MMA(0, 0, At, B0); PG8_BAR; PG8_SCHED;
            PG8_LDB(B1, 0, 1); PG8_STAGE(PG8_SB(0, 0), b2, voffB);
            PG8_BAR; PG8_WAIT_L(0); PG8_MMA(0, 1, At, B1); PG8_BAR;
            PG8_LDA(At, 0, 1); PG8_STAGE(PG8_SA(0, 0), a2, voffA);
            PG8_BAR; PG8_WAIT_L(0); PG8_MMA(1, 0, At, B0); PG8_BAR; PG8_SCHED;
            PG8_STAGE(PG8_SB(0, 1), b2 + hstepB, voffB);
            PG8_WAIT_V(6); PG8_BAR; PG8_MMA(1, 1, At, B1); PG8_BAR;
            PG8_LDB(B0, 1, 0); PG8_SCHED; PG8_LDA(At, 1, 0); PG8_STAGE(PG8_SA(0, 1), a2 + hstepA, voffA);
            PG8_WAIT_L(8); PG8_BAR; PG8_WAIT_L(0); PG8_MMA(0, 0, At, B0); PG8_BAR; PG8_SCHED;
            PG8_LDB(B1, 1, 1); PG8_STAGE(PG8_SB(1, 0), b3, voffB);
            PG8_BAR; PG8_WAIT_L(0); PG8_MMA(0, 1, At, B1); PG8_BAR;
            PG8_LDA(At, 1, 1); PG8_STAGE(PG8_SA(1, 0), a3, voffA);
            PG8_BAR; PG8_WAIT_L(0); PG8_MMA(1, 0, At, B0); PG8_BAR; PG8_SCHED;
            PG8_STAGE(PG8_SB(1, 1), b3 + hstepB, voffB);
            PG8_WAIT_V(6); PG8_BAR; PG8_MMA(1, 1, At, B1); PG8_BAR;
            }
        }
        if constexpr (ALIGN_EPI) { if (wr == 0) PG8_BAR; }
        if constexpr (!Epi::AFTER_DRAIN) { E(accw, cur, wr, wc, fr, fq); S.done(cur); }
        const bool keep_acc = Epi::TWOPASS && (cur.pass == 0);
        if (!has_next) break;
        if (!keep_acc) {
#pragma unroll
            for (int a = 0; a < 2; ++a)
#pragma unroll
                for (int b = 0; b < 2; ++b)
#pragma unroll
                    for (int mp = 0; mp < 2; ++mp)
#pragma unroll
                        for (int i = 0; i < 16; ++i) accw[a][b][mp][i] = 0.f;
        }
        cur = nxt; cA = nA; cB = nB; ++ui;
        if constexpr (ALIGN_EPI) { if (wr == 1) PG8_BAR; }
    }
    PG8_WAIT_V(0);
    if constexpr (!ALIGN_EPI) { if (wr == 0) PG8_BAR; }
    PG8_BAR;

#undef PG8_SA
#undef PG8_SB
#undef PG8_STAGE
#undef PG8_LDA
#undef PG8_LDB
#undef PG8_MMA
#undef PG8_F8
#undef PG8_WAIT_V
#undef PG8_WAIT_L
#undef PG8_BAR
#undef PG8_SCHED
}
}


constexpr int NWAVES = 8, NTHREADS = 512;
constexpr int BATCH = 8, SEQ = 4096, T = BATCH * SEQ, DM = 1024;
constexpr int INW = 5448;
constexpr int NPROJ = 5632;
constexpr int LD_HG = 2048, LD_ATT = 768, LD_IDX = 640, LD_GATE = 2048;
constexpr int TOPK = 256;
constexpr int NEXP = 16384;
constexpr float RMS_EPS = 1e-6f;

constexpr size_t MiB = 1u << 20;
constexpr size_t WS_CTL = 0;
constexpr size_t WS_MOD = MiB / 4;
constexpr size_t WS_MODP = MiB / 2;
constexpr size_t WS_WIN = 2 * MiB;
constexpr size_t WS_WQ = 17 * MiB;
constexpr size_t WS_SK = 21 * MiB;
constexpr size_t WS_U = 22 * MiB;
constexpr size_t WS_US = 30 * MiB;
constexpr size_t WS_V = 38 * MiB;
constexpr size_t WS_VS = 46 * MiB;
constexpr size_t WS_V8 = 8 * MiB;
constexpr size_t WS_K8 = 48 * MiB;
constexpr size_t WS_QHI = 52 * MiB;
constexpr size_t WS_QLO = 68 * MiB;
constexpr size_t WS_WAB8 = 31 * MiB;
constexpr size_t WS_WOUT8 = 32 * MiB;
constexpr size_t WS_WIN8 = 33 * MiB;
constexpr size_t WS_H8 = 48 * MiB;
constexpr size_t WS_H = 86 * MiB;
constexpr size_t WS_HG = 150 * MiB;
constexpr size_t WS_ATT = 278 * MiB;
constexpr size_t WS_IDX = 326 * MiB;
constexpr size_t WS_GATE = 366 * MiB;
constexpr size_t WS_SEL = 494 * MiB;
constexpr size_t WS_EIDX = 48 * MiB;
constexpr size_t WS_PGATE = 64 * MiB;
constexpr size_t WS_END = 510 * MiB;
constexpr size_t WS_HQC = 494 * MiB;
constexpr size_t WS_HOL = 118 * MiB;
constexpr size_t WS_HSB = 2 * MiB;
constexpr size_t WS_MERGED = WS_HG;
constexpr size_t WS_Q = 214 * MiB;
constexpr int H4_NT = 2;
constexpr size_t WS_H4D = 366 * MiB;
constexpr size_t WS_H4S = 416 * MiB;

constexpr int LDS_BYTES = 163840;

typedef unsigned short bf16;
typedef unsigned v4u __attribute__((ext_vector_type(4)));
typedef unsigned v2u __attribute__((ext_vector_type(2)));
typedef float f32x4 __attribute__((ext_vector_type(4)));
typedef float f32x2 __attribute__((ext_vector_type(2)));
typedef short bf16x8 __attribute__((ext_vector_type(8)));
#define LAS __attribute__((address_space(3)))

struct Params {
    const float *x, *c, *w_ada, *b_ada, *norm1_g, *norm2_g, *w_in, *hg_lb, *hg_onorm_g, *q_norm_g, *k_norm_g,
                *w_a, *w_b, *w_out, *peer_wq, *peer_subkeys, *peer_u, *peer_v;
    float* out; unsigned char* ws; int ph_lo, ph_hi;
};

typedef __bf16 bf16x2_hw __attribute__((ext_vector_type(2)));
__device__ __forceinline__ unsigned pk2(float lo, float hi) { const f32x2 v = {lo, hi}; const bf16x2_hw b = __builtin_convertvector(v, bf16x2_hw); return __builtin_bit_cast(unsigned, b); }
__device__ __forceinline__ unsigned f2bf(float f) { return pk2(f, 0.f) & 0xffffu; }
__device__ __forceinline__ float bf2f(unsigned u16v) { return __builtin_bit_cast(float, u16v << 16); }
__device__ __forceinline__ float bflo(unsigned w) { return __builtin_bit_cast(float, w << 16); }
__device__ __forceinline__ float bfhi(unsigned w) { return __builtin_bit_cast(float, w & 0xffff0000u); }
__device__ __forceinline__ float sigmoidf_(float x) { return __builtin_amdgcn_rcpf(1.f + __expf(-x)); }
__device__ __forceinline__ float siluf_(float x) { return x * __builtin_amdgcn_rcpf(1.f + __expf(-x)); }
__device__ __forceinline__ float wave_sum(float v) {
#pragma unroll
    for (int o = 1; o < 64; o <<= 1) v += __shfl_xor(v, o);
    return v;
}
__device__ __forceinline__ float wave_max(float v) {
#pragma unroll
    for (int o = 1; o < 64; o <<= 1) v = fmaxf(v, __shfl_xor(v, o));
    return v;
}
#define LDS_WAIT() asm volatile("s_waitcnt lgkmcnt(0)" ::: "memory")
__device__ __forceinline__ unsigned pk4_fp8(float a, float b, float c, float d) { int w = __builtin_amdgcn_cvt_pk_fp8_f32(a, b, 0, false); w = __builtin_amdgcn_cvt_pk_fp8_f32(c, d, w, true); return (unsigned)w; }

__host__ __device__ __forceinline__ int proj_tile_bf16(int i) { return i < 2 ? i + 2 : i + 6; }
__host__ __device__ __forceinline__ int proj_tile_fp8(int i) { return i < 2 ? i : (i < 6 ? i + 2 : i + 8); }
struct EpiProj {
    static constexpr bool PERM = true, AFTER_DRAIN = false, TWOPASS = false;
    bf16 *HG, *ATT, *IDX, *GATE; int f8;
    __device__ __forceinline__ void operator()(pg8::AccW& acc, const pg8::Unit& u, int wr, int wc, int fr, int fq) const {
        const int pn = f8 ? proj_tile_fp8(u.pn) : proj_tile_bf16(u.pn); bf16* base; int ldc, colt, ncols;
        if (pn < 8) { base = HG; ldc = LD_HG; colt = pn * 256; ncols = LD_HG; }
        else if (pn < 11) { base = ATT; ldc = LD_ATT; colt = (pn - 8) * 256; ncols = LD_ATT; }
        else if (pn < 14) { base = IDX; ldc = LD_IDX; colt = (pn - 11) * 256; ncols = LD_IDX; }
        else { base = GATE; ldc = LD_GATE; colt = (pn - 14) * 256; ncols = LD_GATE; }
        const int row0 = u.pm * 256 + wr * 64 + fr, col0 = colt + wc * 32 + 8 * fq;
#pragma unroll
        for (int ai = 0; ai < 2; ++ai)
#pragma unroll
            for (int m = 0; m < 4; ++m) { bf16* rowp = base + (size_t)(row0 + ai * 128 + m * 16) * ldc + col0;
#pragma unroll
                for (int bj = 0; bj < 2; ++bj) { const pg8::f32x4 v0 = pg8::acc_get(acc, ai, bj, m, 0), v1 = pg8::acc_get(acc, ai, bj, m, 1);
                    v4u w; w.x = pk2(v0[0], v0[1]); w.y = pk2(v0[2], v0[3]); w.z = pk2(v1[0], v1[1]); w.w = pk2(v1[2], v1[3]);
                    if (col0 + bj * 128 < ncols) *(v4u*)(rowp + bj * 128) = w; } }
    }
};
struct EpiMerged {
    static constexpr bool PERM = true, AFTER_DRAIN = false, TWOPASS = true;
    const bf16* GATE; bf16* O;
    __device__ __forceinline__ void operator()(pg8::AccW& acc, const pg8::Unit& u, int wr, int wc, int fr, int fq) const {
        const int row0 = u.pm * 256 + wr * 64 + fr, col0 = u.pn * 256 + wc * 32 + 8 * fq;
        if (u.pass == 0) {
#pragma unroll
            for (int ai = 0; ai < 2; ++ai)
#pragma unroll
                for (int m = 0; m < 4; ++m) { const bf16* rowp = GATE + (size_t)(row0 + ai * 128 + m * 16) * LD_GATE + col0;
#pragma unroll
                    for (int bj = 0; bj < 2; ++bj) { const v4u a = *(const v4u*)(rowp + bj * 128), b = *(const v4u*)(rowp + 1024 + bj * 128);
                        float r[8];
#pragma unroll
                        for (int i = 0; i < 4; ++i) { const float a0 = bflo(a[i]), a1 = bfhi(a[i]), b0 = bflo(b[i]), b1 = bfhi(b[i]);
                            r[2 * i] = (1.f + __expf(-b0)) * __builtin_amdgcn_rcpf(1.f + __expf(-a0)); r[2 * i + 1] = (1.f + __expf(-b1)) * __builtin_amdgcn_rcpf(1.f + __expf(-a1)); }
                        { pg8::f32x4 c0 = pg8::acc_get(acc, ai, bj, m, 0), c1 = pg8::acc_get(acc, ai, bj, m, 1);
#pragma unroll
                          for (int i = 0; i < 4; ++i) { c0[i] *= r[i]; c1[i] *= r[4 + i]; }
                          pg8::acc_set(acc, ai, bj, m, 0, c0); pg8::acc_set(acc, ai, bj, m, 1, c1); } } }
        } else {
#pragma unroll
            for (int ai = 0; ai < 2; ++ai)
#pragma unroll
                for (int m = 0; m < 4; ++m) { const size_t ro = (size_t)(row0 + ai * 128 + m * 16);
#pragma unroll
                    for (int bj = 0; bj < 2; ++bj) { const v4u b = *(const v4u*)(GATE + ro * LD_GATE + 1024 + col0 + bj * 128);
                        const pg8::f32x4 v0 = pg8::acc_get(acc, ai, bj, m, 0), v1 = pg8::acc_get(acc, ai, bj, m, 1);
                        float s[8];
#pragma unroll
                        for (int i = 0; i < 4; ++i) { s[2 * i] = sigmoidf_(bflo(b[i])); s[2 * i + 1] = sigmoidf_(bfhi(b[i])); }
                        v2u w; w.x = pk4_fp8(4.f * v0[0] * s[0], 4.f * v0[1] * s[1], 4.f * v0[2] * s[2], 4.f * v0[3] * s[3]); w.y = pk4_fp8(4.f * v1[0] * s[4], 4.f * v1[1] * s[5], 4.f * v1[2] * s[6], 4.f * v1[3] * s[7]);
                        *(v2u*)((unsigned char*)O + ro * 1024 + col0 + bj * 128) = w; } }
        }
    }
};
struct EpiResid {
    static constexpr bool PERM = true, AFTER_DRAIN = false, TWOPASS = false;
    const float* X; const float* G1  ; float* O;
    __device__ __forceinline__ void operator()(pg8::AccW& acc, const pg8::Unit& u, int wr, int wc, int fr, int fq) const {
        const int row0 = u.pm * 256 + wr * 64 + fr, col0 = u.pn * 256 + wc * 32 + 8 * fq;
        const int b = (u.pm * 256) / SEQ;
        f32x4 g[2][2];
#pragma unroll
        for (int bj = 0; bj < 2; ++bj)
#pragma unroll
            for (int n = 0; n < 2; ++n) g[bj][n] = *(const f32x4*)(G1 + (size_t)b * 6144 + col0 + bj * 128 + 4 * n);
#pragma unroll
        for (int ai = 0; ai < 2; ++ai)
#pragma unroll
            for (int m = 0; m < 4; ++m) { const size_t ro = (size_t)(row0 + ai * 128 + m * 16) * DM + col0;
#pragma unroll
                for (int bj = 0; bj < 2; ++bj)
#pragma unroll
                    for (int n = 0; n < 2; ++n) { const f32x4 xv = *(const f32x4*)(X + ro + bj * 128 + 4 * n);
                        *(f32x4*)(O + ro + bj * 128 + 4 * n) = xv + g[bj][n] * pg8::acc_get(acc, ai, bj, m, n); } }
    }
};
struct EpiStore {
    static constexpr bool PERM = true, AFTER_DRAIN = false, TWOPASS = false;
    bf16* O; int ldc;
    __device__ __forceinline__ void operator()(pg8::AccW& acc, const pg8::Unit& u, int wr, int wc, int fr, int fq) const {
        const int row0 = u.pm * 256 + wr * 64 + fr, col0 = u.pn * 256 + wc * 32 + 8 * fq;
#pragma unroll
        for (int ai = 0; ai < 2; ++ai)
#pragma unroll
            for (int m = 0; m < 4; ++m) { bf16* rowp = O + (size_t)(row0 + ai * 128 + m * 16) * ldc + col0;
#pragma unroll
                for (int bj = 0; bj < 2; ++bj) { const pg8::f32x4 v0 = pg8::acc_get(acc, ai, bj, m, 0), v1 = pg8::acc_get(acc, ai, bj, m, 1);
                    v4u w; w.x = pk2(v0[0], v0[1]); w.y = pk2(v0[2], v0[3]); w.z = pk2(v1[0], v1[1]); w.w = pk2(v1[2], v1[3]);
                    *(v4u*)(rowp + bj * 128) = w; } }
    }
};

template <int MODE> __device__ __forceinline__ int srcmap(int np) {
    if (MODE == 2) np = proj_tile_bf16(np >> 8) * 256 + (np & 255);
    if (MODE == 3) np = proj_tile_fp8(np >> 8) * 256 + (np & 255);
    if (MODE >= 1) return np < 3400 ? np : (np >= 3584 ? np - 184 : -1);
    return np; }
template <int MODE>
__device__ __forceinline__ void transpose_item(const float* W, int N, bf16* WT, int ldw, int koff, float* scr, int kb, int nb, int lane) {
    const int k0 = 64 * kb, n0 = 32 * nb;
    const int sc = srcmap<MODE>(n0 + (lane & 31));
#pragma unroll 8
    for (int i = 0; i < 32; ++i) { const int kk = 2 * i + (lane >> 5); scr[kk * 33 + (lane & 31)] = (sc >= 0) ? W[(size_t)(k0 + kk) * N + sc] : 0.f; }
    LDS_WAIT(); __builtin_amdgcn_wave_barrier();
    const int c = lane & 7;
#pragma unroll
    for (int j = 0; j < 4; ++j) { const int n = (lane >> 3) + 8 * j; const float* s = scr + (8 * c) * 33 + n;
        v4u o; o.x = pk2(s[0 * 33], s[1 * 33]); o.y = pk2(s[2 * 33], s[3 * 33]); o.z = pk2(s[4 * 33], s[5 * 33]); o.w = pk2(s[6 * 33], s[7 * 33]);
        *(v4u*)(WT + (size_t)(n0 + n) * ldw + koff + k0 + 8 * c) = o; }
    LDS_WAIT(); __builtin_amdgcn_wave_barrier();
}
template <int MODE> __device__ __forceinline__ int srcmap(int np);
template <int MODE = 0>
__device__ __forceinline__ void transpose_item8(const float* W, int N, unsigned char* WT, int ldw, int koff, float scale, float* scr, int kb, int nb, int lane) {
    const int k0 = 64 * kb, n0 = 32 * nb;
    const int sc = srcmap<MODE>(n0 + (lane & 31));
#pragma unroll 8
    for (int i = 0; i < 32; ++i) { const int kk = 2 * i + (lane >> 5); scr[kk * 33 + (lane & 31)] = (sc >= 0) ? W[(size_t)(k0 + kk) * N + sc] * scale : 0.f; }
    LDS_WAIT(); __builtin_amdgcn_wave_barrier();
    const int c = lane & 3;
#pragma unroll
    for (int j = 0; j < 2; ++j) { const int n = (lane >> 2) + 16 * j; const float* sp = scr + (16 * c) * 33 + n;
        v4u o;
#pragma unroll
        for (int q = 0; q < 4; ++q) o[q] = pk4_fp8(sp[(4 * q) * 33], sp[(4 * q + 1) * 33], sp[(4 * q + 2) * 33], sp[(4 * q + 3) * 33]);
        *(v4u*)(WT + (size_t)(n0 + n) * ldw + koff + k0 + 16 * c) = o; }
    LDS_WAIT(); __builtin_amdgcn_wave_barrier();
}
__device__ __forceinline__ void convert_plain(const float* src, bf16* dst, size_t n, size_t gtid, size_t nth) {
    const size_t n8 = n / 8;
    for (size_t i = gtid; i < n8; i += nth) { const f32x4 a = ((const f32x4*)src)[2 * i], b = ((const f32x4*)src)[2 * i + 1];
        v4u o; o.x = pk2(a[0], a[1]); o.y = pk2(a[2], a[3]); o.z = pk2(b[0], b[1]); o.w = pk2(b[2], b[3]); ((v4u*)dst)[i] = o; }
}
__device__ __forceinline__ void convert_fp8(const float* src, unsigned char* dst, size_t n, float scale, size_t gtid, size_t nth) {
    const size_t n16 = n / 16;
    for (size_t i = gtid; i < n16; i += nth) { const f32x4* sp = (const f32x4*)src + 4 * i; const f32x4 a = sp[0] * scale, b = sp[1] * scale, c = sp[2] * scale, d = sp[3] * scale;
        v4u o; o.x = pk4_fp8(a[0], a[1], a[2], a[3]); o.y = pk4_fp8(b[0], b[1], b[2], b[3]); o.z = pk4_fp8(c[0], c[1], c[2], c[3]); o.w = pk4_fp8(d[0], d[1], d[2], d[3]); ((v4u*)dst)[i] = o; }
}
template <bool KKMAJOR>
__device__ __forceinline__ void convert_mxfp4(const float* src, unsigned char* dst, unsigned char* scl, size_t nrows, size_t gtid, size_t nth) {
    const size_t nblk = nrows * 32;
    for (size_t i = gtid; i < nblk; i += nth) {
        const size_t row = i >> 5; const int blk = (int)(i & 31);
        const f32x4* sp = (const f32x4*)(src + row * 1024 + blk * 32);
        f32x4 v[8]; float amax = 0.f;
#pragma unroll
        for (int j = 0; j < 8; ++j) { v[j] = sp[j]; amax = fmaxf(fmaxf(fmaxf(fabsf(v[j][0]), fabsf(v[j][1])), fmaxf(fabsf(v[j][2]), fabsf(v[j][3]))), amax); }
        int e = (int)((__builtin_bit_cast(unsigned, amax) >> 23) & 0xffu) - 127 - 2;
        if (e < -126) e = -126;
        const float inv = __builtin_bit_cast(float, (unsigned)(127 - e) << 23);
        unsigned w[4] = {0u, 0u, 0u, 0u};
#pragma unroll
        for (int j = 0; j < 8; j += 2) { unsigned t = 0u;
            t = __builtin_amdgcn_cvt_scalef32_pk_fp4_f32(t, v[j][0] * inv, v[j][1] * inv, 1.0f, 0);
            t = __builtin_amdgcn_cvt_scalef32_pk_fp4_f32(t, v[j][2] * inv, v[j][3] * inv, 1.0f, 1);
            t = __builtin_amdgcn_cvt_scalef32_pk_fp4_f32(t, v[j + 1][0] * inv, v[j + 1][1] * inv, 1.0f, 2);
            t = __builtin_amdgcn_cvt_scalef32_pk_fp4_f32(t, v[j + 1][2] * inv, v[j + 1][3] * inv, 1.0f, 3);
            w[j >> 1] = t; }
        *(v4u*)(dst + row * 512 + blk * 16) = (v4u){w[0], w[1], w[2], w[3]};
        scl[row * 32 + (KKMAJOR ? ((blk & 3) * 8 + (blk >> 2)) : blk)] = (unsigned char)(e + 127);
    }
}
__device__ __forceinline__ void convert_rowfp4(const float* src, unsigned char* dst, _Float16* scl, int row, int lane) {
    const f32x4* sp = (const f32x4*)(src + (size_t)row * 1024 + lane * 16);
    f32x4 v[4]; float amax = 0.f;
#pragma unroll
    for (int j = 0; j < 4; ++j) { v[j] = sp[j]; amax = fmaxf(fmaxf(fmaxf(fabsf(v[j][0]), fabsf(v[j][1])), fmaxf(fabsf(v[j][2]), fabsf(v[j][3]))), amax); }
    amax = wave_max(amax);
    _Float16 sh = (_Float16)(amax * (1.f / 6.f));
    float sf = (float)sh; if (!(sf > 0.f)) { sf = 1.f; sh = (_Float16)1.f; }
    const float inv = 1.f / sf;
    unsigned w[2];
#pragma unroll
    for (int j = 0; j < 2; ++j) { unsigned t = 0u;
        t = __builtin_amdgcn_cvt_scalef32_pk_fp4_f32(t, v[2 * j][0] * inv, v[2 * j][1] * inv, 1.0f, 0);
        t = __builtin_amdgcn_cvt_scalef32_pk_fp4_f32(t, v[2 * j][2] * inv, v[2 * j][3] * inv, 1.0f, 1);
        t = __builtin_amdgcn_cvt_scalef32_pk_fp4_f32(t, v[2 * j + 1][0] * inv, v[2 * j + 1][1] * inv, 1.0f, 2);
        t = __builtin_amdgcn_cvt_scalef32_pk_fp4_f32(t, v[2 * j + 1][2] * inv, v[2 * j + 1][3] * inv, 1.0f, 3);
        w[j] = t; }
    *(v2u*)(dst + (size_t)row * 512 + lane * 8) = (v2u){w[0], w[1]};
    if (lane == 0) scl[row] = sh;
}
__device__ __forceinline__ void phase0(const Params& p, unsigned char* lds) {
    const int tid = threadIdx.x, wave = tid >> 6, lane = tid & 63, G = gridDim.x;
    const int gw = blockIdx.x * NWAVES + wave, NGW = G * NWAVES;
    float* scr = (float*)(lds + wave * 16384);
    unsigned char* ws = p.ws;
    constexpr int I_IN = 16 * (2048 / 32), I_IN8 = 16 * (3584 / 32), I_A = 8 * 32, I_O = 16 * 32, I_Q = 16 * 64;
    constexpr int NT = I_IN + I_IN8 + 2 * I_A + I_O + I_Q;
    for (int it = gw; it < NT; it += NGW) {
        int r = it;
        if (r < I_IN) { transpose_item<2>(p.w_in, INW, (bf16*)(ws + WS_WIN), 1024, 0, scr, r / 64, r % 64, lane); continue; } r -= I_IN;
        if (r < I_IN8) { transpose_item8<3>(p.w_in, INW, ws + WS_WIN8, 1024, 0, 32.f, scr, r / 112, r % 112, lane); continue; } r -= I_IN8;
        if (r < I_A) { transpose_item8(p.w_a, 1024, ws + WS_WAB8, 1024, 0, 32.f, scr, r / 32, r % 32, lane); continue; } r -= I_A;
        if (r < I_A) { transpose_item8(p.w_b, 1024, ws + WS_WAB8, 1024, 512, 4.f, scr, r / 32, r % 32, lane); continue; } r -= I_A;
        if (r < I_O) { transpose_item8(p.w_out, 1024, ws + WS_WOUT8, 1024, 0, 32.f, scr, r / 32, r % 32, lane); continue; } r -= I_O;
        transpose_item<0>(p.peer_wq, 2048, (bf16*)(ws + WS_WQ), 1024, 0, scr, r / 64, r % 64, lane);
    }
    for (int it = gw; it < 96 * 8; it += NGW) {
        const int cgp = it % 96, ks = it / 96, col = cgp * 64 + lane, k0 = ks * 128;
#pragma unroll
        for (int i = 0; i < 16; ++i) { const int e = i * 64 + lane, b = e >> 7, k = e & 127; scr[e] = siluf_(p.c[b * 1024 + k0 + k]); }
        LDS_WAIT(); __builtin_amdgcn_wave_barrier();
        float acc[8];
#pragma unroll
        for (int b = 0; b < 8; ++b) acc[b] = 0.f;
#pragma unroll 4
        for (int k = 0; k < 128; ++k) { const float w = p.w_ada[(size_t)(k0 + k) * 6144 + col];
#pragma unroll
            for (int b = 0; b < 8; ++b) acc[b] += scr[b * 128 + k] * w; }
        float* mp = (float*)(ws + WS_MODP) + (size_t)ks * 8 * 6144 + col;
#pragma unroll
        for (int b = 0; b < 8; ++b) mp[b * 6144] = acc[b];
        LDS_WAIT(); __builtin_amdgcn_wave_barrier();
    }
    const size_t gtid = (size_t)blockIdx.x * NTHREADS + tid, nth = (size_t)G * NTHREADS;
    convert_plain(p.peer_subkeys, (bf16*)(ws + WS_SK), (size_t)16 * 128 * 128, gtid, nth);
    for (int it = gw; it < 2 * NEXP; it += NGW) {
        if (it < NEXP) convert_rowfp4(p.peer_u, ws + WS_U, (_Float16*)(ws + WS_US), it, lane);
        else convert_rowfp4(p.peer_v, ws + WS_V, (_Float16*)(ws + WS_VS), it - NEXP, lane);
    }
}

template <bool FIRST>
__device__ __forceinline__ void normmod_phase(const Params& p, unsigned char* lds, const float* src, bf16* dst, const float* gvec, int shift_off, int scale_off) {
    const int tid = threadIdx.x, wave = tid >> 6, lane = tid & 63, G = gridDim.x;
    unsigned char* ws = p.ws;
    float* A = (float*)lds;
    float* Bv = A + 1024;
    const float* MODP = (const float*)(ws + WS_MODP);
    float* MOD = (float*)(ws + WS_MOD);
    if (FIRST) {
        for (int e = blockIdx.x * NTHREADS + tid; e < 8 * 6144; e += G * NTHREADS) { const int col = e % 6144; float s = p.b_ada[col];
#pragma unroll
            for (int ks = 0; ks < 8; ++ks) s += MODP[(size_t)ks * 8 * 6144 + e];
            MOD[e] = s; }
    }
    int curb = -1;
    for (int chunk = blockIdx.x; chunk < T / 128; chunk += G) {
        const int b = (chunk * 128) / SEQ;
        if (b != curb) {
            __syncthreads();
            for (int col = tid; col < 1024; col += NTHREADS) {
                float sc, sh;
                if (FIRST) { sc = p.b_ada[scale_off + col]; sh = p.b_ada[shift_off + col];
#pragma unroll
                    for (int ks = 0; ks < 8; ++ks) { sc += MODP[(size_t)(ks * 8 + b) * 6144 + scale_off + col]; sh += MODP[(size_t)(ks * 8 + b) * 6144 + shift_off + col]; } }
                else { sc = MOD[b * 6144 + scale_off + col]; sh = MOD[b * 6144 + shift_off + col]; }
                A[col] = gvec[col] * (1.f + sc); Bv[col] = sh; }
            __syncthreads(); curb = b;
        }
        for (int r = wave; r < 128; r += NWAVES) {
            const size_t row = (size_t)chunk * 128 + r;
            const f32x4* xr = (const f32x4*)(src + row * DM) + lane;
            f32x4 v[4]; float s = 0.f;
#pragma unroll
            for (int j = 0; j < 4; ++j) { v[j] = xr[64 * j]; s += (v[j][0] * v[j][0] + v[j][1] * v[j][1]) + (v[j][2] * v[j][2] + v[j][3] * v[j][3]); }
            const float rstd = rsqrtf(wave_sum(s) * (1.f / DM) + RMS_EPS);
            v2u* o8 = (v2u*)(dst + row * DM) + lane;
#pragma unroll
            for (int j = 0; j < 4; ++j) { const int c0 = 4 * lane + 256 * j; const f32x4 a = *(const f32x4*)(A + c0), sh = *(const f32x4*)(Bv + c0);
                v2u o; o.x = pk2(v[j][0] * rstd * a[0] + sh[0], v[j][1] * rstd * a[1] + sh[1]); o.y = pk2(v[j][2] * rstd * a[2] + sh[2], v[j][3] * rstd * a[3] + sh[3]);
                o8[64 * j] = o;
                if (FIRST) *(unsigned*)(ws + WS_H8 + row * DM + c0) = pk4_fp8(v[j][0] * rstd * a[0] + sh[0], v[j][1] * rstd * a[1] + sh[1], v[j][2] * rstd * a[2] + sh[2], v[j][3] * rstd * a[3] + sh[3]);
                if (!FIRST) { float* st = (float*)(lds + 8192) + wave * 1056;
                    const float y0 = v[j][0] * rstd * a[0] + sh[0], y1 = v[j][1] * rstd * a[1] + sh[1], y2 = v[j][2] * rstd * a[2] + sh[2], y3 = v[j][3] * rstd * a[3] + sh[3];
                    const int pc = c0 + (c0 >> 5); st[pc] = y0; st[pc + 1] = y1; st[pc + 2] = y2; st[pc + 3] = y3; } }
            if (!FIRST) {
                const float* st = (const float*)(lds + 8192) + wave * 1056;
                LDS_WAIT(); __builtin_amdgcn_wave_barrier();
                if (lane < 32) {
                    float x[32];
#pragma unroll
                    for (int k = 0; k < 32; ++k) x[k] = st[lane * 33 + k];
#pragma unroll
                    for (int t = 0; t < H4_NT; ++t) {
                        float amax = 0.f;
#pragma unroll
                        for (int k = 0; k < 32; ++k) amax = fmaxf(amax, fabsf(x[k]));
                        int e = (int)((__builtin_bit_cast(unsigned, amax) >> 23) & 0xffu) - 127 - 2; if (e < -126) e = -126;
                        const float inv = __builtin_bit_cast(float, (unsigned)(127 - e) << 23), sc = __builtin_bit_cast(float, (unsigned)(127 + e) << 23);
                        unsigned w[4];
#pragma unroll
                        for (int r = 0; r < 4; ++r) { unsigned tw = 0u;
                            tw = __builtin_amdgcn_cvt_scalef32_pk_fp4_f32(tw, x[8 * r] * inv, x[8 * r + 1] * inv, 1.0f, 0);
                            tw = __builtin_amdgcn_cvt_scalef32_pk_fp4_f32(tw, x[8 * r + 2] * inv, x[8 * r + 3] * inv, 1.0f, 1);
                            tw = __builtin_amdgcn_cvt_scalef32_pk_fp4_f32(tw, x[8 * r + 4] * inv, x[8 * r + 5] * inv, 1.0f, 2);
                            tw = __builtin_amdgcn_cvt_scalef32_pk_fp4_f32(tw, x[8 * r + 6] * inv, x[8 * r + 7] * inv, 1.0f, 3);
                            w[r] = tw;
                            const f32x2 d0 = __builtin_amdgcn_cvt_scalef32_pk_f32_fp4(tw, 1.0f, 0), d1 = __builtin_amdgcn_cvt_scalef32_pk_f32_fp4(tw, 1.0f, 1), d2 = __builtin_amdgcn_cvt_scalef32_pk_f32_fp4(tw, 1.0f, 2), d3 = __builtin_amdgcn_cvt_scalef32_pk_f32_fp4(tw, 1.0f, 3);
                            x[8 * r] -= d0[0] * sc; x[8 * r + 1] -= d0[1] * sc; x[8 * r + 2] -= d1[0] * sc; x[8 * r + 3] -= d1[1] * sc;
                            x[8 * r + 4] -= d2[0] * sc; x[8 * r + 5] -= d2[1] * sc; x[8 * r + 6] -= d3[0] * sc; x[8 * r + 7] -= d3[1] * sc; }
                        *(v4u*)(ws + WS_H4D + (row * H4_NT + t) * 512 + lane * 16) = (v4u){w[0], w[1], w[2], w[3]};
                        *(ws + WS_H4S + (row * H4_NT + t) * 32 + (lane & 3) * 8 + (lane >> 2)) = (unsigned char)(e + 127);
                    }
                }
                LDS_WAIT(); __builtin_amdgcn_wave_barrier();
            }
        }
    }
    __syncthreads();
}

constexpr int HGL_QT = 0, HGL_KT = 17408, HGL_QE = 34816, HGL_KLT = 52224, HGL_VT = 70656, HGL_AM = 89088, HGL_DEC = 98304, HGL_TOT = 98816, HGL_SSQ = 100864;
constexpr int HG_LDR = 136;
constexpr int HG_LDC = 72;
template <int half>
__device__ __forceinline__ void hgrn_item(const Params& p, unsigned char* lds, int item) {
    const int b = item >> 2, h = item & 3;
    const int tid = threadIdx.x, w = tid >> 6, lane = tid & 63, fr = lane & 15, fq = lane >> 4;
    unsigned char* ws = p.ws;
    const bf16* HG = (const bf16*)(ws + WS_HG);
    bf16* YA = (bf16*)(ws + WS_H);
    bf16* QT = (bf16*)(lds + HGL_QT); bf16* KT = (bf16*)(lds + HGL_KT); bf16* QE = (bf16*)(lds + HGL_QE);
    bf16* KLT = (bf16*)(lds + HGL_KLT); bf16* VT = (bf16*)(lds + HGL_VT); bf16* AM = (bf16*)(lds + HGL_AM);
    float* DEC = (float*)(lds + HGL_DEC); float* TOT = (float*)(lds + HGL_TOT); float* SSQ = (float*)(lds + HGL_SSQ);
    const int pd = tid & 127, pq = tid >> 7;
    float lbv; { const float a0 = p.hg_lb[h * 128 + pd], a1 = p.hg_lb[512 + h * 128 + pd]; lbv = 1.f / (1.f + __expf(a1 - a0)); }
    const int e0 = w * 16;
    const float ogv = p.hg_onorm_g[e0 + fr];
    pg8::f32x4 S[8];
#pragma unroll
    for (int i = 0; i < 8; ++i) S[i] = (pg8::f32x4){0.f, 0.f, 0.f, 0.f};
    const size_t rowb = (size_t)b * SEQ;
    const int c0 = half * 32;
    bf16* QCg = (bf16*)(ws + WS_HQC) + (size_t)item * 2048 * 128; float* OLg = (float*)(ws + WS_HOL) + (size_t)item * 32 * 8 * 4 * 256;
    float cum = 1.f;
    unsigned short rq[16], rf[16], rv[16];
    { const bf16* gp = HG + (rowb + (size_t)c0 * 64 + pq * 16) * LD_HG + h * 128 + pd;
#pragma unroll
      for (int i = 0; i < 16; ++i) { rq[i] = gp[(size_t)i * LD_HG]; rf[i] = gp[(size_t)i * LD_HG + 512]; rv[i] = gp[(size_t)i * LD_HG + 1024]; } }
    for (int chunk = c0; chunk < c0 + 32; ++chunk) {
        const size_t row0 = rowb + (size_t)chunk * 64;
        float fq_[16], kq_[16], cs[16];
        float run = 0.f;
#pragma unroll
        for (int i = 0; i < 16; ++i) { const float f = lbv + (1.f - lbv) * sigmoidf_(bf2f(rf[i])); kq_[i] = 1.f - f; run += __logf(f); cs[i] = run; fq_[i] = siluf_(bf2f(rq[i])); }
        TOT[pq * 128 + pd] = run;
        { v4u v0, v1;
          v0.x = rv[0] | ((unsigned)rv[1] << 16); v0.y = rv[2] | ((unsigned)rv[3] << 16); v0.z = rv[4] | ((unsigned)rv[5] << 16); v0.w = rv[6] | ((unsigned)rv[7] << 16);
          v1.x = rv[8] | ((unsigned)rv[9] << 16); v1.y = rv[10] | ((unsigned)rv[11] << 16); v1.z = rv[12] | ((unsigned)rv[13] << 16); v1.w = rv[14] | ((unsigned)rv[15] << 16);
          *(v4u*)(VT + pd * HG_LDC + pq * 16) = v0; *(v4u*)(VT + pd * HG_LDC + pq * 16 + 8) = v1; }
        unsigned short rg[16];
#pragma unroll
        for (int i = 0; i < 16; ++i) rg[i] = half ? (unsigned short)0 : HG[(row0 + (i >> 2) * 16 + fq * 4 + (i & 3)) * LD_HG + 1536 + h * 128 + e0 + fr];
        if (chunk + 1 < c0 + 32) { const bf16* gp = HG + (row0 + 64 + pq * 16) * LD_HG + h * 128 + pd;
#pragma unroll
            for (int i = 0; i < 16; ++i) { rq[i] = gp[(size_t)i * LD_HG]; rf[i] = gp[(size_t)i * LD_HG + 512]; rv[i] = gp[(size_t)i * LD_HG + 1024]; } }
        __syncthreads();
        const float t0 = TOT[pd], t1 = TOT[128 + pd], t2 = TOT[256 + pd], t3 = TOT[384 + pd];
        const float base = (pq > 0 ? t0 : 0.f) + (pq > 1 ? t1 : 0.f) + (pq > 2 ? t2 : 0.f);
        const float bmid = t0 + t1, blast = (t0 + t1) + (t2 + t3);
        const float emid = __expf(bmid), elm = __expf(blast - bmid);
        if (pq == 0) DEC[pd] = __expf(blast);
        { unsigned klp[8];
#pragma unroll
          for (int i = 0; i < 16; ++i) { const float bb = base + cs[i]; const float E1 = __expf(bb - bmid), R1 = __builtin_amdgcn_rcpf(E1);
              const float qtv = fq_[i] * E1, ktv = kq_[i] * R1, qev = qtv * emid, klv = ktv * elm;
              const int srow = pq * 16 + i;
              QT[srow * HG_LDR + pd] = (bf16)f2bf(qtv); KT[srow * HG_LDR + pd] = (bf16)f2bf(ktv); QE[srow * HG_LDR + pd] = (bf16)f2bf(qev);
              if (half) QCg[((size_t)(chunk - 32) * 64 + srow) * 128 + pd] = (bf16)f2bf(qev * cum);
              if (i & 1) klp[i >> 1] |= f2bf(klv) << 16; else klp[i >> 1] = f2bf(klv); }
          *(v4u*)(KLT + pd * HG_LDC + pq * 16) = (v4u){klp[0], klp[1], klp[2], klp[3]}; *(v4u*)(KLT + pd * HG_LDC + pq * 16 + 8) = (v4u){klp[4], klp[5], klp[6], klp[7]}; }
        cum *= __expf(blast);
        __syncthreads();
#pragma unroll
        for (int tt = 0; tt < 2; ++tt) { const int id = w + 8 * tt, rt = id >> 2, ct = id & 3;
            pg8::f32x4 a = {0.f, 0.f, 0.f, 0.f};
            if (ct <= rt) {
#pragma unroll
                for (int ks = 0; ks < 4; ++ks) { const bf16x8 af = *(const bf16x8*)(QT + (rt * 16 + fr) * HG_LDR + ks * 32 + fq * 8), bfv = *(const bf16x8*)(KT + (ct * 16 + fr) * HG_LDR + ks * 32 + fq * 8);
                    a = __builtin_amdgcn_mfma_f32_16x16x32_bf16(af, bfv, a, 0, 0, 0); } }
#pragma unroll
            for (int r = 0; r < 4; ++r) { const int c = rt * 16 + fq * 4 + r, sidx = ct * 16 + fr; AM[c * HG_LDC + sidx] = (bf16)((sidx <= c) ? f2bf(a[r]) : 0u); } }
        __syncthreads();
        const bf16x8 vb0 = *(const bf16x8*)(VT + (e0 + fr) * HG_LDC + fq * 8), vb1 = *(const bf16x8*)(VT + (e0 + fr) * HG_LDC + 32 + fq * 8);
        bf16x8 sb[4];
#pragma unroll
        for (int ks = 0; ks < 4; ++ks) { v4u t; t.x = pk2(S[2 * ks][0], S[2 * ks][1]); t.y = pk2(S[2 * ks][2], S[2 * ks][3]); t.z = pk2(S[2 * ks + 1][0], S[2 * ks + 1][1]); t.w = pk2(S[2 * ks + 1][2], S[2 * ks + 1][3]); sb[ks] = __builtin_bit_cast(bf16x8, t); }
        pg8::f32x4 o[4];
#pragma unroll
        for (int rt = 0; rt < 4; ++rt) { pg8::f32x4 a = {0.f, 0.f, 0.f, 0.f};
            a = __builtin_amdgcn_mfma_f32_16x16x32_bf16(*(const bf16x8*)(AM + (rt * 16 + fr) * HG_LDC + fq * 8), vb0, a, 0, 0, 0);
            a = __builtin_amdgcn_mfma_f32_16x16x32_bf16(*(const bf16x8*)(AM + (rt * 16 + fr) * HG_LDC + 32 + fq * 8), vb1, a, 0, 0, 0);
#pragma unroll
            for (int ks = 0; ks < 4; ++ks) { const v2u lo = *(const v2u*)(QE + (rt * 16 + fr) * HG_LDR + ks * 32 + fq * 4), hi = *(const v2u*)(QE + (rt * 16 + fr) * HG_LDR + ks * 32 + 16 + fq * 4);
                const v4u t = {lo.x, lo.y, hi.x, hi.y};
                a = __builtin_amdgcn_mfma_f32_16x16x32_bf16(__builtin_bit_cast(bf16x8, t), sb[ks], a, 0, 0, 0); }
            o[rt] = a; }
#pragma unroll
        for (int dt = 0; dt < 8; ++dt) { const f32x4 dc = *(const f32x4*)(DEC + dt * 16 + fq * 4);
            pg8::f32x4 a = S[dt]; a[0] *= dc[0]; a[1] *= dc[1]; a[2] *= dc[2]; a[3] *= dc[3];
            a = __builtin_amdgcn_mfma_f32_16x16x32_bf16(*(const bf16x8*)(KLT + (dt * 16 + fr) * HG_LDC + fq * 8), vb0, a, 0, 0, 0);
            a = __builtin_amdgcn_mfma_f32_16x16x32_bf16(*(const bf16x8*)(KLT + (dt * 16 + fr) * HG_LDC + 32 + fq * 8), vb1, a, 0, 0, 0);
            S[dt] = a; }
        if (half) {
#pragma unroll
            for (int rt = 0; rt < 4; ++rt) *(pg8::f32x4*)(OLg + ((((size_t)(chunk - 32)) * 8 + w) * 4 + rt) * 256 + lane * 4) = o[rt];
            __syncthreads();
            continue;
        }
#pragma unroll
        for (int rt = 0; rt < 4; ++rt)
#pragma unroll
            for (int r = 0; r < 4; ++r) { float x = o[rt][r] * o[rt][r];
                x += __shfl_xor(x, 1); x += __shfl_xor(x, 2); x += __shfl_xor(x, 4); x += __shfl_xor(x, 8);
                if (fr == 0) SSQ[w * 64 + rt * 16 + fq * 4 + r] = x; }
        __syncthreads();
        float tot = 0.f;
#pragma unroll
        for (int ww = 0; ww < 8; ++ww) tot += SSQ[ww * 64 + lane];
        const float rstd_l = rsqrtf(tot * (1.f / 128.f) + RMS_EPS);
#pragma unroll
        for (int rt = 0; rt < 4; ++rt)
#pragma unroll
            for (int r = 0; r < 4; ++r) { const int c = rt * 16 + fq * 4 + r; const float rs = __shfl(rstd_l, c);
                const float y = o[rt][r] * rs * ogv * siluf_(bf2f(rg[rt * 4 + r]));
                ((unsigned char*)YA)[(row0 + c) * 1024 + h * 128 + e0 + fr] = (unsigned char)(__builtin_amdgcn_cvt_pk_fp8_f32(y, 0.f, 0, false) & 0xff); }
    }
    if (!half) {
#pragma unroll
        for (int ks = 0; ks < 4; ++ks) { v4u t; t.x = pk2(S[2 * ks][0], S[2 * ks][1]); t.y = pk2(S[2 * ks][2], S[2 * ks][3]); t.z = pk2(S[2 * ks + 1][0], S[2 * ks + 1][1]); t.w = pk2(S[2 * ks + 1][2], S[2 * ks + 1][3]);
            *(v4u*)(ws + WS_HSB + ((((size_t)item * 8 + w) * 4 + ks) * 64 + lane) * 16) = t; }
    }
    __syncthreads();
}
__device__ __forceinline__ void hgrn_fix(const Params& p, int item, int c, int rt, int lane) {
    const int b = item >> 2, h = item & 3, fr = lane & 15, fq = lane >> 4;
    unsigned char* ws = p.ws;
    const bf16* HG = (const bf16*)(ws + WS_HG);
    bf16* YA = (bf16*)(ws + WS_H);
    const bf16* QCg = (const bf16*)(ws + WS_HQC) + (size_t)item * 2048 * 128; const float* OLg = (const float*)(ws + WS_HOL) + (size_t)item * 32 * 8 * 4 * 256;
    const size_t row0 = (size_t)b * SEQ + (size_t)(32 + c) * 64 + rt * 16;
    bf16x8 Aq[4];
    { const bf16* qr = QCg + ((size_t)c * 64 + rt * 16 + fr) * 128;
#pragma unroll
      for (int ks = 0; ks < 4; ++ks) { const v2u lo = *(const v2u*)(qr + ks * 32 + fq * 4), hi = *(const v2u*)(qr + ks * 32 + 16 + fq * 4); const v4u t = {lo.x, lo.y, hi.x, hi.y}; Aq[ks] = __builtin_bit_cast(bf16x8, t); } }
    pg8::f32x4 o[8];
#pragma unroll
    for (int w2 = 0; w2 < 8; ++w2) { pg8::f32x4 a = *(const pg8::f32x4*)(OLg + ((((size_t)c) * 8 + w2) * 4 + rt) * 256 + lane * 4);
#pragma unroll
        for (int ks = 0; ks < 4; ++ks) { const bf16x8 sbv = __builtin_bit_cast(bf16x8, *(const v4u*)(ws + WS_HSB + ((((size_t)item * 8 + w2) * 4 + ks) * 64 + lane) * 16));
            a = __builtin_amdgcn_mfma_f32_16x16x32_bf16(Aq[ks], sbv, a, 0, 0, 0); }
        o[w2] = a; }
    float rs[4];
#pragma unroll
    for (int r = 0; r < 4; ++r) { float x = 0.f;
#pragma unroll
        for (int w2 = 0; w2 < 8; ++w2) x += o[w2][r] * o[w2][r];
        x += __shfl_xor(x, 1); x += __shfl_xor(x, 2); x += __shfl_xor(x, 4); x += __shfl_xor(x, 8);
        rs[r] = rsqrtf(x * (1.f / 128.f) + RMS_EPS); }
#pragma unroll
    for (int w2 = 0; w2 < 8; ++w2) { const float ogv = p.hg_onorm_g[w2 * 16 + fr];
#pragma unroll
        for (int r = 0; r < 4; ++r) { const size_t row = row0 + fq * 4 + r;
            const float g = bf2f((unsigned)(unsigned short)HG[row * LD_HG + 1536 + h * 128 + w2 * 16 + fr]);
            const float y = o[w2][r] * rs[r] * ogv * siluf_(g);
            ((unsigned char*)YA)[row * 1024 + h * 128 + w2 * 16 + fr] = (unsigned char)(__builtin_amdgcn_cvt_pk_fp8_f32(y, 0.f, 0, false) & 0xff); } }
}

__device__ __forceinline__ unsigned f16key(float x) {
    x = x + 0.f;
    const _Float16 hx = (_Float16)x; const unsigned short bits = __builtin_bit_cast(unsigned short, hx);
    return (bits & 0x8000u) ? (unsigned)(unsigned short)(~bits) : (unsigned)(bits | 0x8000u);
}
__device__ __forceinline__ void find_bin(const unsigned* hist, int K, int lane, int& bin, int& rem) {
    const v4u hv = *(const v4u*)(hist + 4 * lane);
    const unsigned c = hv.x + hv.y + hv.z + hv.w;
    unsigned suf = c;
#pragma unroll
    for (int o = 1; o < 64; o <<= 1) { const unsigned t = __shfl_down(suf, o); if (lane + o < 64) suf += t; }
    const unsigned above = suf - c;
    const bool mine = (above < (unsigned)K) && ((unsigned)K <= suf);
    int mybin = 0, myrem = 0;
    if (mine) { unsigned ca = above; const unsigned hh[4] = {hv.x, hv.y, hv.z, hv.w}; bool found = false;
#pragma unroll
        for (int i = 3; i >= 0; --i) { if (!found) { if (ca + hh[i] >= (unsigned)K) { mybin = 4 * lane + i; myrem = K - (int)ca; found = true; } else ca += hh[i]; } } }
    const unsigned long long m = __ballot(mine);
    const int src = (int)__builtin_ctzll(m | (1ull << 63));
    bin = __shfl(mybin, src); rem = __shfl(myrem, src);
}
__device__ __forceinline__ void dsa1_item(const Params& p, unsigned char* lds, int item) {
    const int b = item >> 8, q0 = (item & 255) * 16;
    const int tid = threadIdx.x, w = tid >> 6, lane = tid & 63, fr = lane & 15, fq = lane >> 4;
    unsigned char* ws = p.ws;
    const bf16* IDX = (const bf16*)(ws + WS_IDX);
    unsigned short* Ik = (unsigned short*)lds;
    unsigned* hist1 = (unsigned*)(lds + 131072);
    unsigned* hist = (unsigned*)(lds + 131072 + 16384) + w * 256;
    const size_t rowb = (size_t)b * SEQ;
    *(v4u*)(hist1 + tid * 4) = (v4u){0u, 0u, 0u, 0u}; *(v4u*)(hist1 + 2048 + tid * 4) = (v4u){0u, 0u, 0u, 0u};
    bf16x8 Af[8][2];
    { const bf16* rp = IDX + (rowb + q0 + fr) * LD_IDX + fq * 8;
#pragma unroll
      for (int h = 0; h < 8; ++h) { Af[h][0] = *(const bf16x8*)(rp + h * 64); Af[h][1] = *(const bf16x8*)(rp + h * 64 + 32); } }
    const float idx_scale = 0.5f * 0.125f * 0.35355339059327373f;
    bf16x8 Aw[2];
    { float wa[8];
      { const v4u wq = *(const v4u*)(IDX + (rowb + q0 + fr) * LD_IDX + 576);
#pragma unroll
        for (int i = 0; i < 4; ++i) { wa[2 * i] = bflo(wq[i]) * idx_scale; wa[2 * i + 1] = bfhi(wq[i]) * idx_scale; } }
#pragma unroll
      for (int ks = 0; ks < 2; ++ks) { float cq[8];
#pragma unroll
          for (int j = 0; j < 8; ++j) cq[j] = 0.f;
#pragma unroll
          for (int h = 0; h < 8; ++h)
#pragma unroll
              for (int j = 0; j < 8; ++j) cq[j] += wa[h] * bf2f((unsigned)(unsigned short)Af[h][ks][j]);
          const v4u t = {pk2(cq[0], cq[1]), pk2(cq[2], cq[3]), pk2(cq[4], cq[5]), pk2(cq[6], cq[7])};
          Aw[ks] = __builtin_bit_cast(bf16x8, t); } }
    float wv[4][8];
#pragma unroll
    for (int r = 0; r < 4; ++r) { const v4u wq = *(const v4u*)(IDX + (rowb + q0 + fq * 4 + r) * LD_IDX + 576);
#pragma unroll
        for (int i = 0; i < 4; ++i) { wv[r][2 * i] = bflo(wq[i]) * idx_scale; wv[r][2 * i + 1] = bfhi(wq[i]) * idx_scale; } }
    const int ntiles = (q0 >> 4) + 1;
    __syncthreads();
    bf16x8 B0 = Aw[0], B1 = Aw[1];
    if (w < ntiles) { const bf16* kp = IDX + (rowb + w * 16 + fr) * LD_IDX + 512 + fq * 8; B0 = *(const bf16x8*)kp; B1 = *(const bf16x8*)(kp + 32); }
    for (int kt = w; kt < ntiles; kt += NWAVES) {
        bf16x8 nB0 = B0, nB1 = B1;
        if (kt + NWAVES < ntiles) { const bf16* kp = IDX + (rowb + (kt + NWAVES) * 16 + fr) * LD_IDX + 512 + fq * 8; nB0 = *(const bf16x8*)kp; nB1 = *(const bf16x8*)(kp + 32); }
        pg8::f32x4 lin = {0.f, 0.f, 0.f, 0.f};
        lin = __builtin_amdgcn_mfma_f32_16x16x32_bf16(Aw[0], B0, lin, 0, 0, 0);
        lin = __builtin_amdgcn_mfma_f32_16x16x32_bf16(Aw[1], B1, lin, 0, 0, 0);
        float I[4] = {lin[0], lin[1], lin[2], lin[3]};
#pragma unroll
        for (int h = 0; h < 8; ++h) { pg8::f32x4 a = {0.f, 0.f, 0.f, 0.f};
            a = __builtin_amdgcn_mfma_f32_16x16x32_bf16(Af[h][0], B0, a, 0, 0, 0);
            a = __builtin_amdgcn_mfma_f32_16x16x32_bf16(Af[h][1], B1, a, 0, 0, 0);
#pragma unroll
            for (int r = 0; r < 4; ++r) I[r] = __builtin_fmaf(wv[r][h], __builtin_fabsf(a[r]), I[r]); }
        const int kidx = kt * 16 + fr;
#pragma unroll
        for (int r = 0; r < 4; ++r) { const unsigned key = f16key(I[r]); Ik[(fq * 4 + r) * 4096 + kidx] = (unsigned short)key;
            if (kidx <= q0 + fq * 4 + r) atomicAdd(&hist1[(fq * 4 + r) * 256 + (key >> 8)], 1u); }
        B0 = nB0; B1 = nB1;
    }
    __syncthreads();
    for (int qq = w; qq < 16; qq += NWAVES) {
        const int t = q0 + qq, n = t + 1;
        unsigned short* so = (unsigned short*)(hist1 + qq * 256);
        const unsigned short* keys = Ik + qq * 4096;
        if (n <= TOPK) { for (int j = lane; j < n; j += 64) so[j] = (unsigned short)j; }
        else {
            int b1, rem1, b2, rem2;
            find_bin(hist1 + qq * 256, TOPK, lane, b1, rem1);
            *(v4u*)(hist + 4 * lane) = (v4u){0u, 0u, 0u, 0u};
            LDS_WAIT(); __builtin_amdgcn_wave_barrier();
            for (int j0 = 0; j0 < n; j0 += 512) { unsigned k4[8];
#pragma unroll
                for (int u = 0; u < 8; ++u) { const int j = j0 + u * 64 + lane; k4[u] = keys[j < 4095 ? j : 4095]; }
#pragma unroll
                for (int u = 0; u < 8; ++u) { const int j = j0 + u * 64 + lane; if (j < n && (int)(k4[u] >> 8) == b1) atomicAdd(&hist[k4[u] & 255u], 1u); } }
            LDS_WAIT(); __builtin_amdgcn_wave_barrier();
            find_bin(hist, rem1, lane, b2, rem2);
            const unsigned thr = ((unsigned)b1 << 8) | (unsigned)b2;
            int base = 0, eqtaken = 0;
            const unsigned long long lt = (lane == 0) ? 0ull : (~0ull >> (64 - lane));
            for (int j0 = 0; j0 < n; j0 += 512) { unsigned k4[8];
#pragma unroll
                for (int u = 0; u < 8; ++u) { const int j = j0 + u * 64 + lane; k4[u] = keys[j < 4095 ? j : 4095]; }
#pragma unroll
                for (int u = 0; u < 8; ++u) {
                    const int j = j0 + u * 64 + lane; const bool valid = j < n; const unsigned k = valid ? k4[u] : 0u;
                    const bool gt = valid && k > thr, eq = valid && k == thr;
                    const unsigned long long meq = __ballot(eq);
                    const int erank = __popcll(meq & lt) + eqtaken;
                    const bool take = gt || (eq && erank < rem2);
                    const unsigned long long mt = __ballot(take);
                    if (take) so[base + __popcll(mt & lt)] = (unsigned short)j;
                    base += __popcll(mt); eqtaken += __popcll(meq);
                }
            }
        }
    }
    __syncthreads();
}

template <int NB>
__device__ __forceinline__ void qknorm_tokens(const Params& p, const int (&toks)[NB], int lane, const float (&qg)[8], const float (&kg)[8]) {
    v4u qv[NB], kv[NB], vv[NB];
#pragma unroll
    for (int n = 0; n < NB; ++n) { const bf16* row = (const bf16*)(p.ws + WS_ATT) + (size_t)toks[n] * LD_ATT;
        qv[n] = *(const v4u*)(row + lane * 8); kv[n] = *(const v4u*)(row + 512 + (lane & 15) * 8); vv[n] = *(const v4u*)(row + 640 + (lane & 15) * 8); }
#pragma unroll
    for (int n = 0; n < NB; ++n) { const int tok = toks[n];
        { float x[8]; float ss = 0.f;
#pragma unroll
          for (int i = 0; i < 4; ++i) { x[2 * i] = bflo(qv[n][i]); x[2 * i + 1] = bfhi(qv[n][i]); ss += x[2 * i] * x[2 * i] + x[2 * i + 1] * x[2 * i + 1]; }
          ss += __shfl_xor(ss, 1); ss += __shfl_xor(ss, 2); ss += __shfl_xor(ss, 4);
          const float rs = rsqrtf(ss * (1.f / 64.f) + RMS_EPS) * (0.125f * 1.4426950408889634f);
#pragma unroll
          for (int i = 0; i < 8; ++i) x[i] = x[i] * rs * qg[i];
          v2u hw, lw;
          hw.x = pk4_fp8(x[0], x[1], x[2], x[3]); hw.y = pk4_fp8(x[4], x[5], x[6], x[7]);
          { const f32x2 d0 = __builtin_amdgcn_cvt_pk_f32_fp8((int)hw.x, false), d1 = __builtin_amdgcn_cvt_pk_f32_fp8((int)hw.x, true), d2 = __builtin_amdgcn_cvt_pk_f32_fp8((int)hw.y, false), d3 = __builtin_amdgcn_cvt_pk_f32_fp8((int)hw.y, true);
            lw.x = pk4_fp8(x[0] - d0[0], x[1] - d0[1], x[2] - d1[0], x[3] - d1[1]); lw.y = pk4_fp8(x[4] - d2[0], x[5] - d2[1], x[6] - d3[0], x[7] - d3[1]); }
          *(v2u*)(p.ws + WS_QHI + (size_t)tok * 512 + lane * 8) = hw; *(v2u*)(p.ws + WS_QLO + (size_t)tok * 512 + lane * 8) = lw; }
        { float x[8]; float ss = 0.f;
#pragma unroll
          for (int i = 0; i < 4; ++i) { x[2 * i] = bflo(kv[n][i]); x[2 * i + 1] = bfhi(kv[n][i]); ss += x[2 * i] * x[2 * i] + x[2 * i + 1] * x[2 * i + 1]; }
          ss += __shfl_xor(ss, 1); ss += __shfl_xor(ss, 2); ss += __shfl_xor(ss, 4);
          const float rs = rsqrtf(ss * (1.f / 64.f) + RMS_EPS);
#pragma unroll
          for (int i = 0; i < 8; ++i) x[i] = x[i] * rs * kg[i];
          v2u o; o.x = pk4_fp8(x[0], x[1], x[2], x[3]); o.y = pk4_fp8(x[4], x[5], x[6], x[7]);
          if (lane < 16) *(v2u*)(p.ws + WS_K8 + (size_t)tok * 128 + lane * 8) = o; }
        { v2u o; o.x = pk4_fp8(bflo(vv[n][0]), bfhi(vv[n][0]), bflo(vv[n][1]), bfhi(vv[n][1])); o.y = pk4_fp8(bflo(vv[n][2]), bfhi(vv[n][2]), bflo(vv[n][3]), bfhi(vv[n][3]));
          if (lane < 16) *(v2u*)(p.ws + WS_V8 + (size_t)tok * 128 + lane * 8) = o; }
    }
}

typedef short v4i16_t __attribute__((ext_vector_type(4)));
__device__ __forceinline__ v4i16_t vtr16(const bf16* ldsp) { return __builtin_amdgcn_ds_read_tr16_b64_v4i16((LAS v4i16_t*)ldsp); }
typedef int v2i_t __attribute__((ext_vector_type(2)));
__device__ __forceinline__ long vtr8(const unsigned char* ldsp) { const v2i_t r = __builtin_amdgcn_ds_read_tr8_b64_v2i32((LAS v2i_t*)ldsp); return (long)(((unsigned long long)(unsigned)r[1] << 32) | (unsigned)r[0]); }
__device__ __forceinline__ void dsa2_query(const Params& p, unsigned char* ldsw, const unsigned short* sel, int b, int t, int lane) {
    unsigned char* ws = p.ws;
    const bf16* ATT = (const bf16*)(ws + WS_ATT);
    bf16* YB = (bf16*)(ws + WS_H);
    unsigned short* sl = (unsigned short*)ldsw;
    float* df = (float*)(ldsw + 512);
    unsigned char* Vl = ldsw + 1536;
    const unsigned char* V8 = ws + WS_V8;
    const int fr = lane & 15, fq = lane >> 4;
    const size_t rowb = (size_t)b * SEQ;
    const int cnt = (t + 1 < TOPK) ? (t + 1) : TOPK;
    { v2u sv = *(const v2u*)(sel + lane * 4);
      const int j0 = lane * 4;
      if (j0 >= cnt) sv.x = 0u; else if (j0 + 1 >= cnt) sv.x &= 0xffffu;
      if (j0 + 2 >= cnt) sv.y = 0u; else if (j0 + 3 >= cnt) sv.y &= 0xffffu;
      *(v2u*)(sl + lane * 4) = sv;
      f32x4 d4; d4[0] = (j0 < cnt) ? (float)(t - (int)(sv.x & 0xffffu)) : INFINITY; d4[1] = (j0 + 1 < cnt) ? (float)(t - (int)(sv.x >> 16)) : INFINITY;
      d4[2] = (j0 + 2 < cnt) ? (float)(t - (int)(sv.y & 0xffffu)) : INFINITY; d4[3] = (j0 + 3 < cnt) ? (float)(t - (int)(sv.y >> 16)) : INFINITY;
      *(f32x4*)(df + lane * 4) = d4; }
    LDS_WAIT(); __builtin_amdgcn_wave_barrier();
    const unsigned char* K8 = ws + WS_K8;
    long qhA[2] = {0, 0}, qhB[2] = {0, 0}, qlA[2] = {0, 0}, qlB[2] = {0, 0};
    if (fr < 8) { const v4u qh = *(const v4u*)(ws + WS_QHI + (rowb + t) * 512 + fr * 64 + fq * 16), ql = *(const v4u*)(ws + WS_QLO + (rowb + t) * 512 + fr * 64 + fq * 16);
        const long hA = (long)(((unsigned long long)qh.y << 32) | qh.x), hB = (long)(((unsigned long long)qh.w << 32) | qh.z), lA = (long)(((unsigned long long)ql.y << 32) | ql.x), lB = (long)(((unsigned long long)ql.w << 32) | ql.z);
        if (fr < 4) { qhA[0] = hA; qhB[0] = hB; qlA[0] = lA; qlB[0] = lB; } else { qhA[1] = hA; qhB[1] = hB; qlA[1] = lA; qlB[1] = lB; } }
    pg8::f32x4 sc[16];
    v4u vv[8];
    {
        v4u G[8];
        unsigned char* kst = Vl;
        const int ksw = ((lane & 7) ^ (lane >> 3)) & 7;
#define K_LOADS(STEP) do { _Pragma("unroll") for (int j = 0; j < 8; ++j) { const int s_ = sl[(STEP) * 64 + j * 8 + (lane >> 3)]; G[j] = *(const v4u*)(K8 + (rowb + s_) * 128 + ((ksw ^ (j & 1)) & 7) * 16); } } while (0)
        K_LOADS(0);
#pragma unroll
        for (int step = 0; step < 4; ++step) {
            LDS_WAIT(); __builtin_amdgcn_wave_barrier();
#pragma unroll
            for (int j = 0; j < 8; ++j) *(v4u*)(kst + j * 1024 + lane * 16) = G[j];
            __builtin_amdgcn_sched_barrier(0);
            if (step < 3) K_LOADS(step + 1);
            else {
#pragma unroll
                for (int j = 0; j < 8; ++j) { const int s = sl[j * 8 + (lane >> 3)]; vv[j] = *(const v4u*)(V8 + (rowb + s) * 128 + (lane & 7) * 16); } }
            __builtin_amdgcn_sched_barrier(0);
            LDS_WAIT(); __builtin_amdgcn_wave_barrier();
#pragma unroll
            for (int kt = 0; kt < 4; ++kt) { pg8::f32x4 a = {0.f, 0.f, 0.f, 0.f};
#pragma unroll
                for (int gg = 0; gg < 2; ++gg) { const v4u kv = *(const v4u*)(kst + (kt * 16 + fr) * 128 + (((gg * 4 + fq) ^ (fr & 7) ^ (fr >> 3)) & 7) * 16);
                    const long kA = (long)(((unsigned long long)kv.y << 32) | kv.x), kB = (long)(((unsigned long long)kv.w << 32) | kv.z);
                    a = __builtin_amdgcn_mfma_f32_16x16x32_fp8_fp8(kA, qhA[gg], a, 0, 0, 0); a = __builtin_amdgcn_mfma_f32_16x16x32_fp8_fp8(kB, qhB[gg], a, 0, 0, 0);
                    a = __builtin_amdgcn_mfma_f32_16x16x32_fp8_fp8(kA, qlA[gg], a, 0, 0, 0); a = __builtin_amdgcn_mfma_f32_16x16x32_fp8_fp8(kB, qlB[gg], a, 0, 0, 0); }
                sc[step * 4 + kt] = a; }
        }
#undef K_LOADS
    }
    const float slope = exp2f(-(float)((fr & 7) + 1)) * 1.4426950408889634f;
    float m = -INFINITY;
#pragma unroll
    for (int kt = 0; kt < 16; ++kt) { const f32x4 d4 = *(const f32x4*)(df + kt * 16 + fq * 4);
#pragma unroll
        for (int r = 0; r < 4; ++r) { const float x = sc[kt][r] - slope * d4[r]; sc[kt][r] = x; m = fmaxf(m, x); } }
    m = fmaxf(m, __shfl_xor(m, 16)); m = fmaxf(m, __shfl_xor(m, 32));
    float l = 0.f;
#pragma unroll
    for (int kt = 0; kt < 16; ++kt)
#pragma unroll
        for (int r = 0; r < 4; ++r) { const float e = __builtin_amdgcn_exp2f(sc[kt][r] - m); sc[kt][r] = e; l += e; }
    l += __shfl_xor(l, 16); l += __shfl_xor(l, 32);
    const float inv = 1.f / l;
    pg8::f32x4 o[2][4];
#pragma unroll
    for (int g2 = 0; g2 < 2; ++g2)
#pragma unroll
        for (int dt = 0; dt < 4; ++dt) o[g2][dt] = (pg8::f32x4){0.f, 0.f, 0.f, 0.f};
    unsigned char* vdst = Vl + ((lane & 7) >> 2) * 6400 + (lane >> 3) * 80 + (lane & 3) * 16;
#pragma unroll
    for (int ch = 0; ch < 4; ++ch) {
        LDS_WAIT(); __builtin_amdgcn_wave_barrier();
#pragma unroll
        for (int j = 0; j < 8; ++j) *(v4u*)(vdst + ((j >> 2) * 40 + ((j >> 1) & 1) * 24 + (j & 1) * 8) * 80) = vv[j];
        if (ch < 3) {
#pragma unroll
            for (int j = 0; j < 8; ++j) { const int s = sl[(ch + 1) * 64 + j * 8 + (lane >> 3)]; vv[j] = *(const v4u*)(V8 + (rowb + s) * 128 + (lane & 7) * 16); } }
        LDS_WAIT(); __builtin_amdgcn_wave_barrier();
#pragma unroll
        for (int k2 = 0; k2 < 2; ++k2) { const int kt0 = ch * 4 + 2 * k2;
            const long pb = (long)(((unsigned long long)pk4_fp8(sc[kt0 + 1][0], sc[kt0 + 1][1], sc[kt0 + 1][2], sc[kt0 + 1][3]) << 32) | pk4_fp8(sc[kt0][0], sc[kt0][1], sc[kt0][2], sc[kt0][3]));
            const int q = fr >> 1, prow = k2 * 40 + ((q < 4) ? (fq * 4 + q) : (24 + fq * 4 + (q - 4)));
#pragma unroll
            for (int g2 = 0; g2 < 2; ++g2)
#pragma unroll
                for (int dt = 0; dt < 4; ++dt) o[g2][dt] = __builtin_amdgcn_mfma_f32_16x16x32_fp8_fp8(vtr8(Vl + g2 * 6400 + prow * 80 + dt * 16 + (fr & 1) * 8), pb, o[g2][dt], 0, 0, 0); }
    }
    { const float i8 = inv * 8.f; unsigned char* yp = (unsigned char*)YB + (rowb + t) * 1024 + 512 + fr * 64 + fq * 4;
      if (fr < 4) {
#pragma unroll
          for (int dt = 0; dt < 4; ++dt) *(unsigned*)(yp + dt * 16) = pk4_fp8(o[0][dt][0] * i8, o[0][dt][1] * i8, o[0][dt][2] * i8, o[0][dt][3] * i8); }
      else if (fr < 8) {
#pragma unroll
          for (int dt = 0; dt < 4; ++dt) *(unsigned*)(yp + dt * 16) = pk4_fp8(o[1][dt][0] * i8, o[1][dt][1] * i8, o[1][dt][2] * i8, o[1][dt][3] * i8); } }
    LDS_WAIT(); __builtin_amdgcn_wave_barrier();
}

#define INS16(L, x) do { _Pragma("unroll") for (int _i = 15; _i >= 1; --_i) L[_i] = __builtin_amdgcn_fmed3f(L[_i - 1], L[_i], (x)); L[0] = fmaxf(L[0], (x)); } while (0)
__device__ __forceinline__ float f_andor(float v, unsigned keepmask, unsigned orv) { return __builtin_bit_cast(float, (__builtin_bit_cast(unsigned, v) & keepmask) | orv); }
__device__ __forceinline__ void peer_select(const Params& p, unsigned char* ldsw, int tg, int h, int lane, int* EIDX, float* GATES) {
    float* sc = (float*)ldsw;
    LDS_WAIT(); __builtin_amdgcn_wave_barrier();
    float L[16];
#pragma unroll
    for (int i = 0; i < 16; ++i) L[i] = -INFINITY;
    { const float* sp = sc + (lane & 31) * 132 + (lane >> 5) * 64;
#pragma unroll 4
      for (int i = 0; i < 16; ++i) { const f32x4 x = *(const f32x4*)(sp + 4 * i); INS16(L, x[0]); INS16(L, x[1]); INS16(L, x[2]); INS16(L, x[3]); } }
    { float O[16];
#pragma unroll
      for (int i = 0; i < 16; ++i) O[i] = __shfl_xor(L[i], 32);
#pragma unroll
      for (int i = 0; i < 16; ++i) INS16(L, O[i]); }
    LDS_WAIT(); __builtin_amdgcn_wave_barrier();
    float* lst = sc;
    if (lane < 32) {
#pragma unroll
        for (int i = 0; i < 4; ++i) *(f32x4*)(lst + lane * 16 + 4 * i) = (f32x4){L[4 * i], L[4 * i + 1], L[4 * i + 2], L[4 * i + 3]}; }
    LDS_WAIT(); __builtin_amdgcn_wave_barrier();
    const int tok = lane & 15;
    float s1[16], s2[16];
#pragma unroll
    for (int i = 0; i < 4; ++i) { const f32x4 a = *(const f32x4*)(lst + tok * 16 + 4 * i), b = *(const f32x4*)(lst + (16 + tok) * 16 + 4 * i);
#pragma unroll
        for (int c = 0; c < 4; ++c) { s1[4 * i + c] = f_andor(a[c], ~127u, 0u); s2[4 * i + c] = f_andor(b[c], ~127u, 0u); } }
    float M[16];
#pragma unroll
    for (int i = 0; i < 16; ++i) M[i] = -INFINITY;
#pragma unroll
    for (int a = 0; a < 16; ++a)
#pragma unroll
        for (int b = 0; b < 16; ++b)
            if ((a + 1) * (b + 1) <= 16) { const float key = f_andor(s1[a] + s2[b], ~255u, (unsigned)(a * 16 + b)); INS16(M, key); }
    const float mx = f_andor(M[0], ~255u, 0u);
    float e[16], sum = 0.f; int ei[16];
    const unsigned* lb = (const unsigned*)lst;
#pragma unroll
    for (int i = 0; i < 16; ++i) { const unsigned bits = __builtin_bit_cast(unsigned, M[i]); const int flat = bits & 255u;
        e[i] = __expf(f_andor(M[i], ~255u, 0u) - mx); sum += e[i];
        ei[i] = (int)(lb[tok * 16 + (flat >> 4)] & 127u) * 128 + (int)(lb[(16 + tok) * 16 + (flat & 15)] & 127u); }
    const float inv = 1.f / sum;
    if (lane < 16) {
        const size_t ob = ((size_t)tok * 8 + h) * 16;
#pragma unroll
        for (int i = 0; i < 4; ++i) { *(v4u*)(EIDX + ob + 4 * i) = (v4u){(unsigned)ei[4 * i], (unsigned)ei[4 * i + 1], (unsigned)ei[4 * i + 2], (unsigned)ei[4 * i + 3]};
            *(f32x4*)(GATES + ob + 4 * i) = (f32x4){e[4 * i] * inv, e[4 * i + 1] * inv, e[4 * i + 2] * inv, e[4 * i + 3] * inv}; }
    }
    LDS_WAIT(); __builtin_amdgcn_wave_barrier();
}

__device__ __forceinline__ void peer_route_block(const Params& p, unsigned char* lds, int* eG, float* gG) {
    const int tid = threadIdx.x, wave = tid >> 6, lane = tid & 63, fr = lane & 15, fq = lane >> 4, G = gridDim.x;
    unsigned char* ws = p.ws;
    const bf16* Q = (const bf16*)(ws + WS_Q);
    const unsigned char* SKb = ws + WS_SK;
    unsigned char* tile = lds + 8 * 16896;
    float* sc = (float*)(lds + wave * 16896);
    int ngrp = 0;
    for (int tg = blockIdx.x; tg < T / 16; tg += G) ++ngrp;
#pragma unroll 1
    for (int k0 = 0; k0 < ngrp; k0 += 8) {
        const bool valid = k0 + wave < ngrp;
        const int tg = (int)blockIdx.x + (valid ? k0 + wave : k0) * G;
        v4u t[4][2];
        bf16x8 An[2][4];
#pragma unroll
        for (int sub = 0; sub < 4; ++sub) { const unsigned char* sp = SKb + (size_t)sub * 16384 + tid * 32; t[sub][0] = *(const v4u*)sp; t[sub][1] = *(const v4u*)(sp + 16); }
#pragma unroll
        for (int pp = 0; pp < 2; ++pp) { const bf16* rp = Q + (size_t)(tg * 16 + fr) * 2048 + pp * 128 + fq * 8;
#pragma unroll
            for (int ks = 0; ks < 4; ++ks) An[pp][ks] = *(const bf16x8*)(rp + ks * 32); }
#pragma unroll 1
        for (int h = 0; h < 8; ++h) {
            bf16x8 Af[2][4];
#pragma unroll
            for (int pp = 0; pp < 2; ++pp)
#pragma unroll
                for (int ks = 0; ks < 4; ++ks) Af[pp][ks] = An[pp][ks];
            const int hn = (h + 1) & 7;
#pragma unroll
            for (int sub = 0; sub < 4; ++sub) {
                const int pp = sub >> 1, half = sub & 1;
                __syncthreads();
                { unsigned char* wp = tile + (tid >> 3) * 272 + (tid & 7) * 32; *(v4u*)wp = t[sub][0]; *(v4u*)(wp + 16) = t[sub][1]; }
                { const unsigned char* sp = SKb + (size_t)(hn * 4 + sub) * 16384 + tid * 32; t[sub][0] = *(const v4u*)sp; t[sub][1] = *(const v4u*)(sp + 16); }
                __syncthreads();
#pragma unroll
                for (int kt = 0; kt < 4; ++kt) {
                    pg8::f32x4 a = {0.f, 0.f, 0.f, 0.f};
#pragma unroll
                    for (int ks = 0; ks < 4; ++ks) { const bf16x8 bv = *(const bf16x8*)(tile + (kt * 16 + fr) * 272 + ks * 64 + fq * 16); a = __builtin_amdgcn_mfma_f32_16x16x32_bf16(Af[pp][ks], bv, a, 0, 0, 0); }
                    const int kg = (half * 4 + kt) * 16 + fr;
#pragma unroll
                    for (int r = 0; r < 4; ++r) sc[(pp * 16 + fq * 4 + r) * 132 + kg] = f_andor(a[r], ~127u, (unsigned)kg);
                }
            }
#pragma unroll
            for (int pp = 0; pp < 2; ++pp) { const bf16* rp = Q + (size_t)(tg * 16 + fr) * 2048 + hn * 256 + pp * 128 + fq * 8;
#pragma unroll
                for (int ks = 0; ks < 4; ++ks) An[pp][ks] = *(const bf16x8*)(rp + ks * 32); }
            if (valid) peer_select(p, (unsigned char*)sc, tg, h, lane, eG + (size_t)tg * 2048, gG + (size_t)tg * 2048);
        }
    }
}

__device__ __forceinline__ float gelu_erf(float x) { return 0.5f * x * (1.f + erff(x * 0.70710678118654752f)); }
typedef int v8i_t __attribute__((ext_vector_type(8)));
template <int OPSEL> __device__ __forceinline__ pg8::f32x4 mx_dot(v8i_t a, int sa, v8i_t b, int sb, pg8::f32x4 c) {
    return __builtin_amdgcn_mfma_scale_f32_16x16x128_f8f6f4(a, b, c, 4  , 4  , OPSEL, sa, OPSEL, sb);
}
__device__ __forceinline__ void peer_token(const Params& p, unsigned char* ldsw, const _Float16* usL, const _Float16* vsL, unsigned char* tile, int tok, int lane, const v2u nxt_e, const v2u nxt_g, int buf) {
    unsigned char* ws = p.ws;
    const unsigned char* V8 = ws + WS_V;
    const float* MOD = (const float*)(ws + WS_MOD);
    const int fr = lane & 15, fq = lane >> 4;
    typedef v8i_t v8i;
    const int* EIDX = (const int*)(ldsw + buf * 1024); const float* GATES = (const float*)(ldsw + buf * 1024 + 512);
    v4u A4[H4_NT][8]; v2u As[H4_NT];
#pragma unroll
    for (int t = 0; t < H4_NT; ++t) { const unsigned char* hp = ws + WS_H4D + ((size_t)tok * H4_NT + t) * 512 + fq * 16;
        As[t] = *(const v2u*)(ws + WS_H4S + ((size_t)tok * H4_NT + t) * 32 + fq * 8);
#pragma unroll
        for (int kk = 0; kk < 8; ++kk) A4[t][kk] = *(const v4u*)(hp + kk * 64); }
    int* pe = (int*)(ldsw + 2048); float* pa = (float*)(ldsw + 2048 + 512);
    const unsigned char* U4 = ws + WS_U;
    const int gr = lane >> 3, gs = lane & 7;
    const int rdbase = (fr >> 3) * 1024 + (fr & 7) * 128, slotA = (fq ^ (fr & 7) ^ (fr >> 3)) & 7;
    v4u G[8];
#define U_LOADS(CT) do { const int e0_ = EIDX[(CT) * 16 + gr], e1_ = EIDX[(CT) * 16 + 8 + gr]; \
        const unsigned char* p0_ = U4 + (size_t)e0_ * 512 + ((gs ^ gr) & 7) * 16; const unsigned char* p1_ = U4 + (size_t)e1_ * 512 + ((gs ^ gr ^ 1) & 7) * 16; \
        _Pragma("unroll") for (int kk = 0; kk < 8; ++kk) G[kk] = *(const v4u*)(((kk & 1) ? p1_ : p0_) + (kk >> 1) * 128); } while (0)
    U_LOADS(0);
#pragma unroll 1
    for (int ct = 0; ct < 8; ++ct) {
        const int eic = EIDX[ct * 16 + fr]; const float gt = GATES[ct * 16 + fr];
#pragma unroll
        for (int kk = 0; kk < 8; ++kk) *(v4u*)(tile + kk * 1024 + lane * 16) = G[kk];
        __builtin_amdgcn_sched_barrier(0);
        U_LOADS((ct + 1) & 7);
        __builtin_amdgcn_sched_barrier(0);
        LDS_WAIT(); __builtin_amdgcn_wave_barrier();
        v4u Bt[8];
#pragma unroll
        for (int j = 0; j < 8; ++j) Bt[j] = *(const v4u*)(tile + (j >> 1) * 2048 + rdbase + (((j & 1) ? (slotA ^ 4) : slotA) * 16));
        LDS_WAIT(); __builtin_amdgcn_wave_barrier();
        pg8::f32x4 ah = {0.f, 0.f, 0.f, 0.f};
#pragma unroll
        for (int kk = 0; kk < 8; ++kk) { const v4u bu = Bt[kk];
            const v8i bb = {(int)bu.x, (int)bu.y, (int)bu.z, (int)bu.w, 0, 0, 0, 0};
            const int sb = 0x7f7f7f7f;
#pragma unroll
            for (int t = 0; t < H4_NT; ++t) { const v8i aa = {(int)A4[t][kk].x, (int)A4[t][kk].y, (int)A4[t][kk].z, (int)A4[t][kk].w, 0, 0, 0, 0}; const int sa = (int)((kk < 4) ? As[t].x : As[t].y);
                if ((kk & 3) == 0) ah = mx_dot<0>(aa, sa, bb, sb, ah); else if ((kk & 3) == 1) ah = mx_dot<1>(aa, sa, bb, sb, ah); else if ((kk & 3) == 2) ah = mx_dot<2>(aa, sa, bb, sb, ah); else ah = mx_dot<3>(aa, sa, bb, sb, ah); } }
        const float dot = ah[0] * (float)usL[eic];
        if (fq == 0) { pe[ct * 16 + fr] = eic; pa[ct * 16 + fr] = gelu_erf(dot) * gt * (float)vsL[eic]; }
    }
    asm volatile("" :: "v"(G[0]), "v"(G[1]), "v"(G[2]), "v"(G[3]), "v"(G[4]), "v"(G[5]), "v"(G[6]), "v"(G[7]));
#undef U_LOADS
    __builtin_amdgcn_sched_barrier(0);
    { int* ne = (int*)(ldsw + (buf ^ 1) * 1024); float* ng = (float*)(ldsw + (buf ^ 1) * 1024 + 512);
      *(v2u*)(ne + 2 * lane) = nxt_e; *(v2u*)(ng + 2 * lane) = nxt_g; }
    const int hl = lane >> 5, bl = lane & 31;
    float acc[32];
#pragma unroll
    for (int i = 0; i < 32; ++i) acc[i] = 0.f;
    LDS_WAIT(); __builtin_amdgcn_wave_barrier();
#pragma unroll 1
    for (int ct = 0; ct < 16; ++ct)
#pragma unroll
        for (int jp = 0; jp < 4; ++jp) {
            const int idx = pe[ct * 8 + 2 * jp + hl]; const float as = pa[ct * 8 + 2 * jp + hl];
            const v4u vv = *(const v4u*)(V8 + (size_t)idx * 512 + bl * 16);
#pragma unroll
            for (int w4 = 0; w4 < 4; ++w4) { const unsigned wd = vv[w4];
                const f32x2 d0 = __builtin_amdgcn_cvt_scalef32_pk_f32_fp4(wd, 1.0f, 0), d1 = __builtin_amdgcn_cvt_scalef32_pk_f32_fp4(wd, 1.0f, 1), d2 = __builtin_amdgcn_cvt_scalef32_pk_f32_fp4(wd, 1.0f, 2), d3 = __builtin_amdgcn_cvt_scalef32_pk_f32_fp4(wd, 1.0f, 3);
                acc[8 * w4] += as * d0[0]; acc[8 * w4 + 1] += as * d0[1]; acc[8 * w4 + 2] += as * d1[0]; acc[8 * w4 + 3] += as * d1[1];
                acc[8 * w4 + 4] += as * d2[0]; acc[8 * w4 + 5] += as * d2[1]; acc[8 * w4 + 6] += as * d3[0]; acc[8 * w4 + 7] += as * d3[1]; }
        }
    LDS_WAIT(); __builtin_amdgcn_wave_barrier();
    float accs[16];
#pragma unroll
    for (int i = 0; i < 16; ++i) { const float lo = acc[i] + __shfl_xor(acc[i], 32), hi2 = acc[16 + i] + __shfl_xor(acc[16 + i], 32); accs[i] = hl ? hi2 : lo; }
    const int b = tok / SEQ;
    const int col0 = bl * 32 + hl * 16;
    const float* g2 = MOD + (size_t)b * 6144 + 5 * 1024 + col0;
    float* orow = p.out + (size_t)tok * DM + col0;
#pragma unroll
    for (int q4 = 0; q4 < 4; ++q4) { const f32x4 xv = *(const f32x4*)(orow + 4 * q4), gv = *(const f32x4*)(g2 + 4 * q4);
        f32x4 o;
#pragma unroll
        for (int i = 0; i < 4; ++i) o[i] = xv[i] + gv[i] * accs[4 * q4 + i];
        *(f32x4*)(orow + 4 * q4) = o; }
}

#define XB_TMO      128
#define XB_XCNT(j)  (256  + 64 * (j))
#define XB_XSUB(j)  (1280 + 64 * (j))
#define XB_XGEN(j)  (2304 + 64 * (j))
#define XB_TOP      3328
#define XB_TOPGEN   3392
#define XCD_BAR_WORDS 3456
#define XB_SPIN_CAP (1u << 18)

__device__ __forceinline__ unsigned xb_ld(unsigned* p)              { return __hip_atomic_load(p, __ATOMIC_RELAXED, __HIP_MEMORY_SCOPE_AGENT); }
__device__ __forceinline__ unsigned xb_add(unsigned* p, unsigned v) { return __hip_atomic_fetch_add(p, v, __ATOMIC_RELAXED, __HIP_MEMORY_SCOPE_AGENT); }
__device__ __forceinline__ unsigned xb_xcc_id() { return (unsigned)__builtin_amdgcn_s_getreg((3 << 11) | 20) & 0xFu; }
#define XB_SPIN(cond, bar) do { unsigned _sp = 0; while (cond) { __builtin_amdgcn_s_sleep(1); \
    if ((++_sp & 255u) == 0u) { if (xb_ld(&(bar)[XB_TMO])) break; if (_sp > XB_SPIN_CAP) { atomicAdd(&(bar)[XB_TMO], 1u); break; } } } } while (0)

struct XcdBarrier {
    unsigned* bar; unsigned x;
    volatile LAS unsigned* st;
};

__device__ __forceinline__ XcdBarrier xcd_barrier_post(unsigned* bar, volatile LAS unsigned* st) {
    XcdBarrier b; b.bar = bar; b.x = xb_xcc_id(); b.st = st;
    if (threadIdx.x == 0) (void)xb_add(&bar[XB_XCNT(b.x)], 1u);
    return b;
}
__device__ __forceinline__ void xcd_barrier_complete(unsigned* bar, unsigned x, unsigned& nloc, unsigned& nx) {
    const unsigned G = gridDim.x * gridDim.y * gridDim.z;
    unsigned sum, cnt, mine, sp = 0u;
    for (;;) {
        sum = 0u; cnt = 0u; mine = 0u;
#pragma unroll
        for (unsigned j = 0; j < 16; ++j) { const unsigned c = xb_ld(&bar[XB_XCNT(j)]); sum += c; cnt += (c > 0u) ? 1u : 0u; mine = (j == x) ? c : mine; }
        if (sum == G) break;
        __builtin_amdgcn_s_sleep(1);
        if ((++sp & 255u) == 0u) { if (xb_ld(&bar[XB_TMO])) break; if (sp > XB_SPIN_CAP) { atomicAdd(&bar[XB_TMO], 1u); break; } }
    }
    nloc = mine > 0u ? mine : 1u; nx = cnt > 0u ? cnt : 1u;
}

__device__ __forceinline__ void xcd_barrier(const XcdBarrier& b) {
    asm volatile("s_waitcnt vmcnt(0)" ::: "memory");
    __syncthreads();
    if (threadIdx.x == 0) {
        unsigned* bar = b.bar;
        __builtin_amdgcn_s_waitcnt(0);
        unsigned nloc = b.st[0], nx = b.st[1];
        if (nloc == 0u) { xcd_barrier_complete(bar, b.x, nloc, nx); b.st[0] = nloc; b.st[1] = nx; }
        const unsigned old = xb_add(&bar[XB_XSUB(b.x)], 1u);
        const unsigned gen = old / nloc;
        if (old + 1u == (gen + 1u) * nloc) {
            __builtin_amdgcn_fence(__ATOMIC_RELEASE, "agent");
            asm volatile("s_waitcnt vmcnt(0)" ::: "memory");
            const unsigned og = xb_add(&bar[XB_TOP], 1u);
            const unsigned tg = og / nx;
            if (og + 1u == (tg + 1u) * nx) xb_add(&bar[XB_TOPGEN], 1u);
            else XB_SPIN(xb_ld(&bar[XB_TOPGEN]) == tg, bar);
            __builtin_amdgcn_fence(__ATOMIC_ACQUIRE, "agent");
            xb_add(&bar[XB_XGEN(b.x)], 1u);
            asm volatile("s_waitcnt vmcnt(0)" ::: "memory");
        } else {
            XB_SPIN(xb_ld(&bar[XB_XGEN(b.x)]) == gen, bar);
            __builtin_amdgcn_fence(__ATOMIC_ACQUIRE, "agent");
            asm volatile("s_waitcnt vmcnt(0)" ::: "memory");
        }
    }
    __syncthreads();
}

constexpr int NPHASE = 11;
__global__ void __launch_bounds__(NTHREADS, 2) mega(Params p) {
    extern __shared__ __attribute__((aligned(16))) unsigned char lds[];
    cg::grid_group grid = cg::this_grid();
    const int lo = p.ph_lo, hi = p.ph_hi;
    const int tid = threadIdx.x, wave = tid >> 6, lane = tid & 63, G = gridDim.x;
    unsigned char* ws = p.ws;
#ifndef ONLYPH
#define IN(k) (lo <= (k) && (k) < hi)
#else
#define IN(k) ((k) == ONLYPH && lo <= (k) && (k) < hi)
#endif
    volatile LAS unsigned* xb_st = (volatile LAS unsigned*)((LAS unsigned char*)lds + (LDS_BYTES - 16));
    if (tid < 4) xb_st[tid] = 0u;
    __syncthreads();
    XcdBarrier xbar; xbar.bar = (unsigned*)(ws + WS_CTL); xbar.x = 0; xbar.st = xb_st;
    if (hi - lo > 1) xbar = xcd_barrier_post((unsigned*)(ws + WS_CTL), xb_st);
    if (lo < -1) grid.sync();
#define SEAM(k) do { if (IN((k) + 1)) xcd_barrier(xbar); } while (0)
#ifndef REPMASK
#define REPMASK 0
#endif
#define NREP(k) (((REPMASK >> (k)) & 1) ? 2 : 1)
    if (IN(0)) { for (int rep = 0; rep < NREP(0); ++rep) phase0(p, lds); SEAM(0); }
    if (IN(1)) { for (int rep = 0; rep < NREP(1); ++rep) normmod_phase<true>(p, lds, p.x, (bf16*)(ws + WS_H), p.norm1_g, 0, 1024); SEAM(1); }
    if (IN(2)) {
        { pg8::Gemm g{(const bf16*)(ws + WS_H8), (const bf16*)(ws + WS_WIN8), T, 3584, 512, 512, 512}; pg8::StaticOrder S; S.init(T, 3584, G, (int)blockIdx.x);
          EpiProj E{(bf16*)(ws + WS_HG), (bf16*)(ws + WS_ATT), (bf16*)(ws + WS_IDX), (bf16*)(ws + WS_GATE), 1};
          pg8::gemm_phase<EpiProj, pg8::StaticOrder, true, true, 122>((PG8_LAS unsigned char*)lds, g, S, E); }
        { pg8::Gemm g{(const bf16*)(ws + WS_H), (const bf16*)(ws + WS_WIN), T, 2048, 1024, 1024, 1024}; pg8::StaticOrder S; S.init(T, 2048, G, (int)blockIdx.x);
          EpiProj E{(bf16*)(ws + WS_HG), (bf16*)(ws + WS_ATT), (bf16*)(ws + WS_IDX), (bf16*)(ws + WS_GATE), 0};
          pg8::gemm_phase<EpiProj, pg8::StaticOrder, true, true>((PG8_LAS unsigned char*)lds, g, S, E); }
        SEAM(2);
    }
    if (IN(3)) {
        { float qg[8], kg[8];
#pragma unroll
          for (int i = 0; i < 8; ++i) { qg[i] = p.q_norm_g[(lane & 7) * 8 + i]; kg[i] = p.k_norm_g[(lane & 7) * 8 + i]; }
          int tok = (int)blockIdx.x * NWAVES + wave; const int st = G * NWAVES;
          for (; tok + 3 * st < T; tok += 4 * st) { const int tk[4] = {tok, tok + st, tok + 2 * st, tok + 3 * st}; qknorm_tokens<4>(p, tk, lane, qg, kg); }
          for (; tok < T; tok += st) { const int tk[1] = {tok}; qknorm_tokens<1>(p, tk, lane, qg, kg); } }
        SEAM(3);
    }
    if (IN(4)) {
        if ((int)blockIdx.x < 32) hgrn_item<0>(p, lds, (int)blockIdx.x); else if ((int)blockIdx.x < 64) hgrn_item<1>(p, lds, (int)blockIdx.x - 32);
        {
            unsigned* qctr = (unsigned*)(ws + WS_CTL + 32768);
            volatile LAS unsigned* qslot = (volatile LAS unsigned*)((LAS unsigned char*)lds + (LDS_BYTES - 32));
            int qsel = (int)(blockIdx.x & 7u), tried = 0;
            for (;;) {
                if (tid == 0) { unsigned c;
                    for (;;) { c = __hip_atomic_fetch_add(qctr + qsel * 64, 1u, __ATOMIC_RELAXED, __HIP_MEMORY_SCOPE_AGENT); if (c < (unsigned)(SEQ / 16) || tried >= 7) break; qsel = (qsel + 1) & 7; ++tried; }
                    *qslot = (c < (unsigned)(SEQ / 16)) ? (((unsigned)qsel << 16) | c) : 0xffffffffu; }
                __syncthreads();
                const unsigned c = *qslot;
                __syncthreads();
                if (c == 0xffffffffu) break;
                const int b = (int)(c >> 16), qblk = (SEQ / 16 - 1) - (int)(c & 0xffffu), it = b * (SEQ / 16) + qblk, q0 = qblk * 16;
                dsa1_item(p, lds, it);
#pragma unroll 1
                for (int k2 = 0; k2 < 2; ++k2) dsa2_query(p, lds + wave * 16384, (const unsigned short*)(lds + 131072 + (wave + 8 * k2) * 1024), b, q0 + wave + 8 * k2, lane);
                __syncthreads();
            }
        }
        if (hi - lo > 1) xcd_barrier(xbar);
        for (int wu = (int)blockIdx.x * NWAVES + wave; wu < 32 * 32 * 4; wu += G * NWAVES) { const int u = wu >> 2; hgrn_fix(p, u >> 5, u & 31, wu & 3, lane); }
        SEAM(4);
    }
    if (IN(5)) {
        pg8::Gemm g{(const bf16*)(ws + WS_H), (const bf16*)(ws + WS_WAB8), T, 1024, 256, 512, 512}; pg8::StaticOrderT<true> S; S.init(T, 1024, G, (int)blockIdx.x, 256);
        EpiMerged E{(const bf16*)(ws + WS_GATE), (bf16*)(ws + WS_MERGED)};
        for (int rep = 0; rep < NREP(5); ++rep) pg8::gemm_phase<EpiMerged, pg8::StaticOrderT<true>, true, true, 122>((PG8_LAS unsigned char*)lds, g, S, E);
        SEAM(5);
    }
    if (IN(6)) {
        pg8::Gemm g{(const bf16*)(ws + WS_MERGED), (const bf16*)(ws + WS_WOUT8), T, 1024, 512, 512, 512}; pg8::StaticOrder S; S.init(T, 1024, G, (int)blockIdx.x);
        EpiResid E{p.x, (const float*)(ws + WS_MOD) + 2048, p.out};
        for (int rep = 0; rep < NREP(6); ++rep) pg8::gemm_phase<EpiResid, pg8::StaticOrder, true, true, 120>((PG8_LAS unsigned char*)lds, g, S, E);
        SEAM(6);
    }
    if (IN(7)) { for (int rep = 0; rep < NREP(7); ++rep) normmod_phase<false>(p, lds, p.out, (bf16*)(ws + WS_H), p.norm2_g, 3 * 1024, 4 * 1024); SEAM(7); }
    if (IN(8)) {
        pg8::Gemm g{(const bf16*)(ws + WS_H), (const bf16*)(ws + WS_WQ), T, 2048, 1024, 1024, 1024}; pg8::StaticOrder S; S.init(T, 2048, G, (int)blockIdx.x);
        EpiStore E{(bf16*)(ws + WS_Q), 2048};
        for (int rep = 0; rep < NREP(8); ++rep) pg8::gemm_phase<EpiStore, pg8::StaticOrder, true, true>((PG8_LAS unsigned char*)lds, g, S, E);
        SEAM(8);
    }
    if (IN(9)) {
        int* eG = (int*)(ws + WS_EIDX); float* gG = (float*)(ws + WS_PGATE);
        peer_route_block(p, lds, eG, gG);
        asm volatile("s_waitcnt vmcnt(0)" ::: "memory");
        __syncthreads();
        _Float16* usL = (_Float16*)lds; _Float16* vsL = (_Float16*)(lds + 32768);
        for (int i = tid; i < NEXP / 8; i += NTHREADS) { ((v4u*)usL)[i] = ((const v4u*)(ws + WS_US))[i]; ((v4u*)vsL)[i] = ((const v4u*)(ws + WS_VS))[i]; }
        unsigned char* ldsw = lds + 65536 + wave * 3072;
        int ntok = 0;
        for (int tg = blockIdx.x; tg < T / 16; tg += G) ntok += 2;
        auto tok_of = [&](int j) { return ((int)blockIdx.x + (j >> 1) * G) * 16 + wave + 8 * (j & 1); };
        auto ld_lists = [&](int tok, v2u& e, v2u& g) {
            const unsigned* ep = (const unsigned*)(eG + (size_t)tok * 128 + 2 * lane); const unsigned* gp = (const unsigned*)(gG + (size_t)tok * 128 + 2 * lane);
            e.x = __hip_atomic_load(ep, __ATOMIC_RELAXED, __HIP_MEMORY_SCOPE_AGENT); e.y = __hip_atomic_load(ep + 1, __ATOMIC_RELAXED, __HIP_MEMORY_SCOPE_AGENT);
            g.x = __hip_atomic_load(gp, __ATOMIC_RELAXED, __HIP_MEMORY_SCOPE_AGENT); g.y = __hip_atomic_load(gp + 1, __ATOMIC_RELAXED, __HIP_MEMORY_SCOPE_AGENT); };
        if (ntok > 0) { v2u e0, g0; ld_lists(tok_of(0), e0, g0); *(v2u*)((int*)ldsw + 2 * lane) = e0; *(v2u*)((float*)(ldsw + 512) + 2 * lane) = g0; }
        __syncthreads();
#pragma unroll 1
        for (int j = 0; j < ntok; ++j) {
            v2u ne = {0u, 0u}, ng = {0u, 0u};
            if (j + 1 < ntok) ld_lists(tok_of(j + 1), ne, ng);
            peer_token(p, ldsw, usL, vsL, lds + 90112 + wave * 8192, tok_of(j), lane, ne, ng, j & 1);
            LDS_WAIT(); __builtin_amdgcn_wave_barrier();
        }
    }
#undef IN
#undef SEAM
}

#ifndef ONE_LAUNCH
#define ONE_LAUNCH 1
#endif
extern "C" void kernel_launch(void* const* d_in, const int* in_sizes, int n_in, void* d_out, int out_size, void* d_ws, size_t ws_size, hipStream_t stream) {
    static int grid = 0;
    if (grid == 0) {
        if (n_in != 18 || out_size != T * DM || ws_size < WS_END) { fprintf(stderr, "kernel_launch: unexpected shapes (n_in %d, out %d, ws %zu)\n", n_in, out_size, ws_size); grid = -1; return; }
        int dev = 0, cus = 0, per_cu = 0;
        if (hipGetDevice(&dev) != hipSuccess || hipDeviceGetAttribute(&cus, hipDeviceAttributeMultiprocessorCount, dev) != hipSuccess) { grid = -1; return; }
        if (hipFuncSetAttribute((const void*)mega, hipFuncAttributeMaxDynamicSharedMemorySize, LDS_BYTES) != hipSuccess) { fprintf(stderr, "kernel_launch: hipFuncSetAttribute failed\n"); grid = -1; return; }
        if (hipOccupancyMaxActiveBlocksPerMultiprocessor(&per_cu, (const void*)mega, NTHREADS, LDS_BYTES) != hipSuccess || per_cu < 1) { fprintf(stderr, "kernel_launch: occupancy query says %d\n", per_cu); grid = -1; return; }
        (void)hipGetLastError();
        grid = cus;
        if (grid < 64) { grid = -1; return; }
    }
    if (grid < 0) return;
    Params p{};
    const float** pp = (const float**)&p;
    for (int i = 0; i < 18; ++i) pp[i] = (const float*)d_in[i];
    p.out = (float*)d_out; p.ws = (unsigned char*)d_ws;
#if ONE_LAUNCH
    if (hipMemsetAsync((char*)d_ws + WS_CTL, 0, 65536, stream) != hipSuccess) { fprintf(stderr, "kernel_launch: memset failed\n"); return; }
    p.ph_lo = 0; p.ph_hi = NPHASE;
    void* args[] = {&p};
    hipError_t e = hipLaunchCooperativeKernel((const void*)mega, dim3(grid), dim3(NTHREADS), args, LDS_BYTES, stream);
    if (e != hipSuccess) fprintf(stderr, "cooperative launch failed: %s (grid %d)\n", hipGetErrorString(e), grid);
#else
    for (int k = 0; k < NPHASE; ++k) { p.ph_lo = k; p.ph_hi = k + 1; hipLaunchKernelGGL(mega, dim3(grid), dim3(NTHREADS), LDS_BYTES, stream, p); }
#endif
}
```

```cpp
#include <hip/hip_runtime.h>
#include <hip/hip_cooperative_groups.h>
#include <cstdio>
#include <cstdint>
namespace cg = cooperative_groups;

namespace pg8 {
#define PG8_LAS __attribute__((address_space(3)))
typedef unsigned short bf16_t;
typedef short bf16x8 __attribute__((ext_vector_type(8)));
typedef float f32x4 __attribute__((ext_vector_type(4)));
typedef unsigned u32x4 __attribute__((ext_vector_type(4)));
constexpr int BM = 256, BK = 64, HALF = 128, HTB = HALF * BK * 2  , STAGE_BYTES = 8 * HTB, NXCD = 8, WGM = 8;

__host__ __device__ __forceinline__ int lds_byte(int r, int c) { const int st = (r >> 4) * 2 + (c >> 5), rr = r & 15, cc = c & 31, ob = rr * 64 + cc * 2; return st * 1024 + (ob ^ (((ob >> 9) & 1) << 5)); }
__host__ __device__ __forceinline__ void stage_rc(int b, int& R, int& C) { const int st = b / 1024, sb = b % 1024, swz = sb ^ (((sb >> 9) & 1) << 5); R = (st >> 1) * 16 + swz / 64; C = (st & 1) * 32 + (swz % 64) / 2; }
__host__ __device__ __forceinline__ int perm32(int rho) { const int n = rho >> 4, i = rho & 15; return 8 * (i >> 2) + 4 * n + (i & 3); }

struct Unit { int pm, pn, ko, pass; };
struct Gemm { const bf16_t* A; const bf16_t* Bt; int M, N, K, lda, ldb; };
typedef float f32x16 __attribute__((ext_vector_type(16)));
typedef f32x16 AccW[2][2][2];
__device__ __forceinline__ f32x4 acc_get(const AccW& A, int ai, int bj, int m, int n) { const int s_ = ((m & 1) * 2 + n) * 4; const f32x16& w = A[ai][bj][m >> 1]; return (f32x4){w[s_], w[s_ + 1], w[s_ + 2], w[s_ + 3]}; }
__device__ __forceinline__ void acc_set(AccW& A, int ai, int bj, int m, int n, f32x4 v) { const int s_ = ((m & 1) * 2 + n) * 4; f32x16& w = A[ai][bj][m >> 1]; w[s_] = v[0]; w[s_ + 1] = v[1]; w[s_ + 2] = v[2]; w[s_ + 3] = v[3]; }

template <bool TWOPASS_ORDER = false>
struct StaticOrderT {
    int nM, nN, nwg, G, c, kpass;
    __host__ __device__ void init(int M, int N, int G_, int c_, int kpass_ = 512) { nM = M / BM; nN = N / BM; nwg = nM * nN; G = G_; c = c_; kpass = kpass_; }
    __host__ __device__ bool next(int i, Unit& u) const {
        const long L = (long)(TWOPASS_ORDER ? (i >> 1) : i) * G + c; if (L >= nwg) return false;
        u.pass = TWOPASS_ORDER ? (i & 1) : 0; u.ko = TWOPASS_ORDER ? (i & 1) * kpass : 0;
        int wgid = (int)L; { const int q = nwg / NXCD, r = nwg % NXCD, xcd = wgid % NXCD, off = wgid / NXCD; wgid = (xcd < r ? xcd * (q + 1) : r * (q + 1) + (xcd - r) * q) + off; }
        const int nig = WGM * nN, gid = wgid / nig, fm = gid * WGM, gsz = (nM - fm) < WGM ? (nM - fm) : WGM;
        u.pm = fm + ((wgid % nig) % gsz); u.pn = (wgid % nig) / gsz; return true;
    }
    __device__ __forceinline__ void a_ready(const Unit&) const {}
    __device__ __forceinline__ void done(const Unit&) const {}
};
typedef StaticOrderT<false> StaticOrder;

__device__ __forceinline__ unsigned cvt_pk_bf16(float lo, float hi) { unsigned r; asm volatile("v_cvt_pk_bf16_f32 %0, %1, %2" : "=v"(r) : "v"(lo), "v"(hi)); return r; }

template <class Epi, class Sched, bool ALIGN_EPI = false, bool SP2 = false, int F8SCALE = 0>
__device__ __forceinline__ void gemm_phase(PG8_LAS unsigned char* lds, const Gemm g, const Sched& S, const Epi& E) {
    const int tid = threadIdx.x, wid = __builtin_amdgcn_readfirstlane(tid >> 6), lane = tid & 63, wr = wid >> 2, wc = wid & 3, fr = lane & 15, fq = lane >> 4;
    const int K = g.K, nt = K / BK;
    unsigned voffA[2], voffB[2];
#pragma unroll
    for (int i = 0; i < 2; ++i) { int R, C; stage_rc(tid * 16 + i * 8192, R, C); const int Rb = Epi::PERM ? ((R & ~31) + perm32(R & 31)) : R;
        voffA[i] = (unsigned)(R * g.lda + C) * 2u; voffB[i] = (unsigned)(Rb * g.ldb + C) * 2u; }
    const size_t kstep = (size_t)(BK * 2);
    const size_t hstepA = (size_t)HALF * g.lda * 2, hstepB = (size_t)HALF * g.ldb * 2;
    const size_t tstepA = 2 * hstepA, tstepB = 2 * hstepB;
    const unsigned ldsw = (unsigned)wid * 1024u;
    const int aoff = lds_byte(wr * 64 + fr, fq * 8), boff = lds_byte(wc * 32 + fr, fq * 8);
#define PG8_SA(b, h) (((b) * 2 + (h)) * HTB)
#define PG8_SB(b, h) ((4 + (b) * 2 + (h)) * HTB)
#define PG8_STAGE(bufoff, gbase, voff) do { _Pragma("unroll") for (int _i = 0; _i < 2; ++_i) \
        __builtin_amdgcn_global_load_lds((const unsigned*)((const char*)(gbase) + (voff)[_i]), (PG8_LAS unsigned*)(lds + (bufoff) + ldsw + _i * 8192), 16, 0, 0); } while (0)
#define PG8_LDA(dst, b, h) do { _Pragma("unroll") for (int m = 0; m < 4; ++m) { if constexpr (F8SCALE != 0) { \
        PG8_F8(dst)[m].lo = *(const PG8_LAS v4i_f*)(lds + PG8_SA(b, h) + aoff + m * 2048); PG8_F8(dst)[m].hi = *(const PG8_LAS v4i_f*)(lds + PG8_SA(b, h) + aoff + m * 2048 + 1024); } \
        else { _Pragma("unroll") for (int k = 0; k < 2; ++k) dst[m][k] = *(const PG8_LAS bf16x8*)(lds + PG8_SA(b, h) + aoff + m * 2048 + k * 1024); } } } while (0)
#define PG8_LDB(dst, b, h) do { _Pragma("unroll") for (int n = 0; n < 2; ++n) { if constexpr (F8SCALE != 0) { \
        PG8_F8(dst)[n].lo = *(const PG8_LAS v4i_f*)(lds + PG8_SB(b, h) + boff + n * 2048); PG8_F8(dst)[n].hi = *(const PG8_LAS v4i_f*)(lds + PG8_SB(b, h) + boff + n * 2048 + 1024); } \
        else { _Pragma("unroll") for (int k = 0; k < 2; ++k) dst[n][k] = *(const PG8_LAS bf16x8*)(lds + PG8_SB(b, h) + boff + n * 2048 + k * 1024); } } } while (0)
#define PG8_MMA(ai, bj, At, Bt) do { __builtin_amdgcn_s_setprio(1); _Pragma("unroll") for (int m = 0; m < 4; ++m) _Pragma("unroll") for (int n = 0; n < 2; ++n) { \
        f32x4 _c = acc_get(accw, ai, bj, m, n); \
        if constexpr (F8SCALE != 0) { _c = __builtin_amdgcn_mfma_scale_f32_16x16x128_f8f6f4(PG8_F8(Bt)[n], PG8_F8(At)[m], _c, 0, 0, 0, 0x7f7f7f7f, 0, F8SCALE * 0x01010101); } \
        else { _Pragma("unroll") for (int k = 0; k < 2; ++k) _c = __builtin_amdgcn_mfma_f32_16x16x32_bf16(Bt[n][k], At[m][k], _c, 0, 0, 0); } \
        acc_set(accw, ai, bj, m, n, _c); } \
        __builtin_amdgcn_s_setprio(0); } while (0)
#define PG8_WAIT_V(n) asm volatile("s_waitcnt vmcnt(" #n ")" ::: "memory")
#define PG8_WAIT_L(n) asm volatile("s_waitcnt lgkmcnt(" #n ")" ::: "memory")
#define PG8_BAR __builtin_amdgcn_s_barrier()
#define PG8_SCHED __builtin_amdgcn_sched_barrier(0)
    Unit cur, nxt; int ui = 0;
    if (!S.next(0, cur)) return;
    typedef int v4i_f __attribute__((ext_vector_type(4))); typedef int v8i_f __attribute__((ext_vector_type(8))); typedef f32x16 f32x16_f;
    AccW accw;
#pragma unroll
    for (int a = 0; a < 2; ++a)
#pragma unroll
        for (int b = 0; b < 2; ++b)
#pragma unroll
            for (int mp = 0; mp < 2; ++mp)
#pragma unroll
                for (int i = 0; i < 16; ++i) accw[a][b][mp][i] = 0.f;
    bf16x8 At[4][2], B0[2][2], B1[2][2];
    v8i_f At8[4], B08[2], B18[2];
#define PG8_F8(x) x##8
    const char* cA = (const char*)g.A + (size_t)cur.pm * tstepA + (size_t)cur.ko * 2; const char* cB = (const char*)g.Bt + (size_t)cur.pn * tstepB + (size_t)cur.ko * 2;
    S.a_ready(cur);
    if constexpr (SP2) {
        PG8_STAGE(PG8_SB(0, 0), cB, voffB); PG8_STAGE(PG8_SB(0, 1), cB + hstepB, voffB); PG8_STAGE(PG8_SA(0, 0), cA, voffA); PG8_STAGE(PG8_SA(0, 1), cA + hstepA, voffA);
        if (wr == 1) PG8_BAR;
        PG8_WAIT_V(2); PG8_BAR;
        PG8_STAGE(PG8_SB(1, 0), cB + kstep, voffB); PG8_STAGE(PG8_SA(1, 0), cA + kstep, voffA); PG8_STAGE(PG8_SB(1, 1), cB + hstepB + kstep, voffB);
        PG8_WAIT_V(6); PG8_BAR;
    } else {
        PG8_STAGE(PG8_SB(0, 0), cB, voffB); PG8_STAGE(PG8_SA(0, 0), cA, voffA); PG8_STAGE(PG8_SB(0, 1), cB + hstepB, voffB); PG8_STAGE(PG8_SA(0, 1), cA + hstepA, voffA);
        if (wr == 1) PG8_BAR;
        PG8_WAIT_V(4); PG8_BAR;
        PG8_STAGE(PG8_SB(1, 0), cB + kstep, voffB); PG8_STAGE(PG8_SA(1, 0), cA + kstep, voffA); PG8_STAGE(PG8_SB(1, 1), cB + hstepB + kstep, voffB);
        PG8_WAIT_V(6); PG8_BAR;
    }
    for (;;) {
        const bool has_next = S.next(ui + 1, nxt);
        const char* nA = has_next ? (const char*)g.A + (size_t)nxt.pm * tstepA + (size_t)nxt.ko * 2 : cA; const char* nB = has_next ? (const char*)g.Bt + (size_t)nxt.pn * tstepB + (size_t)nxt.ko * 2 : cB;
        for (int t = 0; t < nt; t += 2) {
            const bool last = (t == nt - 2);
            const char* a1 = cA + (size_t)(t + 1) * kstep;
            const char* a2 = last ? nA : cA + (size_t)(t + 2) * kstep; const char* b2 = last ? nB : cB + (size_t)(t + 2) * kstep;
            const char* a3 = a2 + kstep; const char* b3 = b2 + kstep;
            if (last && has_next) S.a_ready(nxt);
            if constexpr (SP2) {
            PG8_LDB(B0, 0, 0); PG8_LDB(B1, 0, 1); PG8_SCHED; PG8_LDA(At, 0, 0); PG8_STAGE(PG8_SA(1, 1), a1 + hstepA, voffA);
            PG8_WAIT_V(8); PG8_WAIT_L(0); PG8_BAR; PG8_MMA(0, 0, At, B0); PG8_MMA(0, 1, At, B1); PG8_BAR; PG8_SCHED;
            PG8_LDA(At, 0, 1); PG8_STAGE(PG8_SB(0, 0), b2, voffB); PG8_STAGE(PG8_SB(0, 1), b2 + hstepB, voffB); PG8_STAGE(PG8_SA(0, 0), a2, voffA);
            PG8_WAIT_V(8); PG8_WAIT_L(0); PG8_BAR; PG8_MMA(1, 0, At, B0); PG8_MMA(1, 1, At, B1); PG8_BAR; PG8_SCHED;
            PG8_LDB(B0, 1, 0); PG8_LDB(B1, 1, 1); PG8_SCHED; PG8_LDA(At, 1, 0); PG8_STAGE(PG8_SA(0, 1), a2 + hstepA, voffA);
            PG8_WAIT_V(8); PG8_WAIT_L(0); PG8_BAR; PG8_MMA(0, 0, At, B0); PG8_MMA(0, 1, At, B1); PG8_BAR; PG8_SCHED;
            PG8_LDA(At, 1, 1); PG8_STAGE(PG8_SB(1, 0), b3, voffB); PG8_STAGE(PG8_SB(1, 1), b3 + hstepB, voffB); PG8_STAGE(PG8_SA(1, 0), a3, voffA);
            PG8_WAIT_V(8); PG8_WAIT_L(0); PG8_BAR; PG8_MMA(1, 0, At, B0); PG8_MMA(1, 1, At, B1); PG8_BAR; PG8_SCHED;
            } else {
            PG8_LDB(B0, 0, 0); PG8_SCHED; PG8_LDA(At, 0, 0); PG8_STAGE(PG8_SA(1, 1), a1 + hstepA, voffA);
            PG8_WAIT_L(8); PG8_BAR; PG8_WAIT_L(0); PG8_MMA(0, 0, At, B0); PG8_BAR; PG8_SCHED;
            PG8_LDB(B1, 0, 1); PG8_STAGE(PG8_SB(0, 0), b2, voffB);
            PG8_BAR; PG8_WAIT_L(0); PG8_MMA(0, 1, At, B1); PG8_BAR;
            PG8_LDA(At, 0, 1); PG8_STAGE(PG8_SA(0, 0), a2, voffA);
            PG8_BAR; PG8_WAIT_L(0); PG8_MMA(1, 0, At, B0); PG8_BAR; PG8_SCHED;
            PG8_STAGE(PG8_SB(0, 1), b2 + hstepB, voffB);
            PG8_WAIT_V(6); PG8_BAR; PG8_MMA(1, 1, At, B1); PG8_BAR;
            PG8_LDB(B0, 1, 0); PG8_SCHED; PG8_LDA(At, 1, 0); PG8_STAGE(PG8_SA(0, 1), a2 + hstepA, voffA);
            PG8_WAIT_L(8); PG8_BAR; PG8_WAIT_L(0); PG8_MMA(0, 0, At, B0); PG8_BAR; PG8_SCHED;
            PG8_LDB(B1, 1, 1); PG8_STAGE(PG8_SB(1, 0), b3, voffB);
            PG8_BAR; PG8_WAIT_L(0); PG8_MMA(0, 1, At, B1); PG8_BAR;
            PG8_LDA(At, 1, 1); PG8_STAGE(PG8_SA(1, 0), a3, voffA);
            PG8_BAR; PG8_WAIT_L(0); PG8_MMA(1, 0, At, B0); PG8_BAR; PG8_SCHED;
            PG8_STAGE(PG8_SB(1, 1), b3 + hstepB, voffB);
            PG8_WAIT_V(6); PG8_BAR; PG8_MMA(1, 1, At, B1); PG8_BAR;
            }
        }
        if constexpr (ALIGN_EPI) { if (wr == 0) PG8_BAR; }
        if constexpr (!Epi::AFTER_DRAIN) { E(accw, cur, wr, wc, fr, fq); S.done(cur); }
        const bool keep_acc = Epi::TWOPASS && (cur.pass == 0);
        if (!has_next) break;
        if (!keep_acc) {
#pragma unroll
            for (int a = 0; a < 2; ++a)
#pragma unroll
                for (int b = 0; b < 2; ++b)
#pragma unroll
                    for (int mp = 0; mp < 2; ++mp)
#pragma unroll
                        for (int i = 0; i < 16; ++i) accw[a][b][mp][i] = 0.f;
        }
        cur = nxt; cA = nA; cB = nB; ++ui;
        if constexpr (ALIGN_EPI) { if (wr == 1) PG8_BAR; }
    }
    PG8_WAIT_V(0);
    if constexpr (!ALIGN_EPI) { if (wr == 0) PG8_BAR; }
    PG8_BAR;

#undef PG8_SA
#undef PG8_SB
#undef PG8_STAGE
#undef PG8_LDA
#undef PG8_LDB
#undef PG8_MMA
#undef PG8_F8
#undef PG8_WAIT_V
#undef PG8_WAIT_L
#undef PG8_BAR
#undef PG8_SCHED
}
}


constexpr int NWAVES = 8, NTHREADS = 512;
constexpr int BATCH = 8, SEQ = 4096, T = BATCH * SEQ, DM = 1024;
constexpr int INW = 5448;
constexpr int NPROJ = 5632;
constexpr int LD_HG = 2048, LD_ATT = 768, LD_IDX = 640, LD_GATE = 2048;
constexpr int TOPK = 256;
constexpr int NEXP = 16384;
constexpr float RMS_EPS = 1e-6f;

constexpr size_t MiB = 1u << 20;
constexpr size_t WS_CTL = 0;
constexpr size_t WS_MOD = MiB / 4;
constexpr size_t WS_MODP = MiB / 2;
constexpr size_t WS_WIN = 2 * MiB;
constexpr size_t WS_WQ = 17 * MiB;
constexpr size_t WS_SK = 21 * MiB;
constexpr size_t WS_U = 22 * MiB;
constexpr size_t WS_US = 30 * MiB;
constexpr size_t WS_V = 38 * MiB;
constexpr size_t WS_VS = 46 * MiB;
constexpr size_t WS_V8 = 8 * MiB;
constexpr size_t WS_K8 = 48 * MiB;
constexpr size_t WS_QHI = 52 * MiB;
constexpr size_t WS_QLO = 68 * MiB;
constexpr size_t WS_WAB8 = 31 * MiB;
constexpr size_t WS_WOUT8 = 32 * MiB;
constexpr size_t WS_WIN8 = 33 * MiB;
constexpr size_t WS_H8 = 48 * MiB;
constexpr size_t WS_H = 86 * MiB;
constexpr size_t WS_HG = 150 * MiB;
constexpr size_t WS_ATT = 278 * MiB;
constexpr size_t WS_IDX = 326 * MiB;
constexpr size_t WS_GATE = 366 * MiB;
constexpr size_t WS_SEL = 494 * MiB;
constexpr size_t WS_EIDX = 48 * MiB;
constexpr size_t WS_PGATE = 64 * MiB;
constexpr size_t WS_END = 510 * MiB;
constexpr size_t WS_HQC = 494 * MiB;
constexpr size_t WS_HOL = 118 * MiB;
constexpr size_t WS_HSB = 2 * MiB;
constexpr size_t WS_MERGED = WS_HG;
constexpr size_t WS_Q = 214 * MiB;
constexpr int H4_NT = 2;
constexpr size_t WS_H4D = 366 * MiB;
constexpr size_t WS_H4S = 416 * MiB;

constexpr int LDS_BYTES = 163840;

typedef unsigned short bf16;
typedef unsigned v4u __attribute__((ext_vector_type(4)));
typedef unsigned v2u __attribute__((ext_vector_type(2)));
typedef float f32x4 __attribute__((ext_vector_type(4)));
typedef float f32x2 __attribute__((ext_vector_type(2)));
typedef short bf16x8 __attribute__((ext_vector_type(8)));
#define LAS __attribute__((address_space(3)))

struct Params {
    const float *x, *c, *w_ada, *b_ada, *norm1_g, *norm2_g, *w_in, *hg_lb, *hg_onorm_g, *q_norm_g, *k_norm_g,
                *w_a, *w_b, *w_out, *peer_wq, *peer_subkeys, *peer_u, *peer_v;
    float* out; unsigned char* ws; int ph_lo, ph_hi;
};

typedef __bf16 bf16x2_hw __attribute__((ext_vector_type(2)));
__device__ __forceinline__ unsigned pk2(float lo, float hi) { const f32x2 v = {lo, hi}; const bf16x2_hw b = __builtin_convertvector(v, bf16x2_hw); return __builtin_bit_cast(unsigned, b); }
__device__ __forceinline__ unsigned f2bf(float f) { return pk2(f, 0.f) & 0xffffu; }
__device__ __forceinline__ float bf2f(unsigned u16v) { return __builtin_bit_cast(float, u16v << 16); }
__device__ __forceinline__ float bflo(unsigned w) { return __builtin_bit_cast(float, w << 16); }
__device__ __forceinline__ float bfhi(unsigned w) { return __builtin_bit_cast(float, w & 0xffff0000u); }
__device__ __forceinline__ float sigmoidf_(float x) { return __builtin_amdgcn_rcpf(1.f + __expf(-x)); }
__device__ __forceinline__ float siluf_(float x) { return x * __builtin_amdgcn_rcpf(1.f + __expf(-x)); }
__device__ __forceinline__ float wave_sum(float v) {
#pragma unroll
    for (int o = 1; o < 64; o <<= 1) v += __shfl_xor(v, o);
    return v;
}
__device__ __forceinline__ float wave_max(float v) {
#pragma unroll
    for (int o = 1; o < 64; o <<= 1) v = fmaxf(v, __shfl_xor(v, o));
    return v;
}
#define LDS_WAIT() asm volatile("s_waitcnt lgkmcnt(0)" ::: "memory")
__device__ __forceinline__ unsigned pk4_fp8(float a, float b, float c, float d) { int w = __builtin_amdgcn_cvt_pk_fp8_f32(a, b, 0, false); w = __builtin_amdgcn_cvt_pk_fp8_f32(c, d, w, true); return (unsigned)w; }

__host__ __device__ __forceinline__ int proj_tile_bf16(int i) { return i < 2 ? i + 2 : i + 6; }
__host__ __device__ __forceinline__ int proj_tile_fp8(int i) { return i < 2 ? i : (i < 6 ? i + 2 : i + 8); }
struct EpiProj {
    static constexpr bool PERM = true, AFTER_DRAIN = false, TWOPASS = false;
    bf16 *HG, *ATT, *IDX, *GATE; int f8;
    __device__ __forceinline__ void operator()(pg8::AccW& acc, const pg8::Unit& u, int wr, int wc, int fr, int fq) const {
        const int pn = f8 ? proj_tile_fp8(u.pn) : proj_tile_bf16(u.pn); bf16* base; int ldc, colt, ncols;
        if (pn < 8) { base = HG; ldc = LD_HG; colt = pn * 256; ncols = LD_HG; }
        else if (pn < 11) { base = ATT; ldc = LD_ATT; colt = (pn - 8) * 256; ncols = LD_ATT; }
        else if (pn < 14) { base = IDX; ldc = LD_IDX; colt = (pn - 11) * 256; ncols = LD_IDX; }
        else { base = GATE; ldc = LD_GATE; colt = (pn - 14) * 256; ncols = LD_GATE; }
        const int row0 = u.pm * 256 + wr * 64 + fr, col0 = colt + wc * 32 + 8 * fq;
#pragma unroll
        for (int ai = 0; ai < 2; ++ai)
#pragma unroll
            for (int m = 0; m < 4; ++m) { bf16* rowp = base + (size_t)(row0 + ai * 128 + m * 16) * ldc + col0;
#pragma unroll
                for (int bj = 0; bj < 2; ++bj) { const pg8::f32x4 v0 = pg8::acc_get(acc, ai, bj, m, 0), v1 = pg8::acc_get(acc, ai, bj, m, 1);
                    v4u w; w.x = pk2(v0[0], v0[1]); w.y = pk2(v0[2], v0[3]); w.z = pk2(v1[0], v1[1]); w.w = pk2(v1[2], v1[3]);
                    if (col0 + bj * 128 < ncols) *(v4u*)(rowp + bj * 128) = w; } }
    }
};
struct EpiMerged {
    static constexpr bool PERM = true, AFTER_DRAIN = false, TWOPASS = true;
    const bf16* GATE; bf16* O;
    __device__ __forceinline__ void operator()(pg8::AccW& acc, const pg8::Unit& u, int wr, int wc, int fr, int fq) const {
        const int row0 = u.pm * 256 + wr * 64 + fr, col0 = u.pn * 256 + wc * 32 + 8 * fq;
        if (u.pass == 0) {
#pragma unroll
            for (int ai = 0; ai < 2; ++ai)
#pragma unroll
                for (int m = 0; m < 4; ++m) { const bf16* rowp = GATE + (size_t)(row0 + ai * 128 + m * 16) * LD_GATE + col0;
#pragma unroll
                    for (int bj = 0; bj < 2; ++bj) { const v4u a = *(const v4u*)(rowp + bj * 128), b = *(const v4u*)(rowp + 1024 + bj * 128);
                        float r[8];
#pragma unroll
                        for (int i = 0; i < 4; ++i) { const float a0 = bflo(a[i]), a1 = bfhi(a[i]), b0 = bflo(b[i]), b1 = bfhi(b[i]);
                            r[2 * i] = (1.f + __expf(-b0)) * __builtin_amdgcn_rcpf(1.f + __expf(-a0)); r[2 * i + 1] = (1.f + __expf(-b1)) * __builtin_amdgcn_rcpf(1.f + __expf(-a1)); }
                        { pg8::f32x4 c0 = pg8::acc_get(acc, ai, bj, m, 0), c1 = pg8::acc_get(acc, ai, bj, m, 1);
#pragma unroll
                          for (int i = 0; i < 4; ++i) { c0[i] *= r[i]; c1[i] *= r[4 + i]; }
                          pg8::acc_set(acc, ai, bj, m, 0, c0); pg8::acc_set(acc, ai, bj, m, 1, c1); } } }
        } else {
#pragma unroll
            for (int ai = 0; ai < 2; ++ai)
#pragma unroll
                for (int m = 0; m < 4; ++m) { const size_t ro = (size_t)(row0 + ai * 128 + m * 16);
#pragma unroll
                    for (int bj = 0; bj < 2; ++bj) { const v4u b = *(const v4u*)(GATE + ro * LD_GATE + 1024 + col0 + bj * 128);
                        const pg8::f32x4 v0 = pg8::acc_get(acc, ai, bj, m, 0), v1 = pg8::acc_get(acc, ai, bj, m, 1);
                        float s[8];
#pragma unroll
                        for (int i = 0; i < 4; ++i) { s[2 * i] = sigmoidf_(bflo(b[i])); s[2 * i + 1] = sigmoidf_(bfhi(b[i])); }
                        v2u w; w.x = pk4_fp8(4.f * v0[0] * s[0], 4.f * v0[1] * s[1], 4.f * v0[2] * s[2], 4.f * v0[3] * s[3]); w.y = pk4_fp8(4.f * v1[0] * s[4], 4.f * v1[1] * s[5], 4.f * v1[2] * s[6], 4.f * v1[3] * s[7]);
                        *(v2u*)((unsigned char*)O + ro * 1024 + col0 + bj * 128) = w; } }
        }
    }
};
struct EpiResid {
    static constexpr bool PERM = true, AFTER_DRAIN = false, TWOPASS = false;
    const float* X; const float* G1  ; float* O;
    __device__ __forceinline__ void operator()(pg8::AccW& acc, const pg8::Unit& u, int wr, int wc, int fr, int fq) const {
        const int row0 = u.pm * 256 + wr * 64 + fr, col0 = u.pn * 256 + wc * 32 + 8 * fq;
        const int b = (u.pm * 256) / SEQ;
        f32x4 g[2][2];
#pragma unroll
        for (int bj = 0; bj < 2; ++bj)
#pragma unroll
            for (int n = 0; n < 2; ++n) g[bj][n] = *(const f32x4*)(G1 + (size_t)b * 6144 + col0 + bj * 128 + 4 * n);
#pragma unroll
        for (int ai = 0; ai < 2; ++ai)
#pragma unroll
            for (int m = 0; m < 4; ++m) { const size_t ro = (size_t)(row0 + ai * 128 + m * 16) * DM + col0;
#pragma unroll
                for (int bj = 0; bj < 2; ++bj)
#pragma unroll
                    for (int n = 0; n < 2; ++n) { const f32x4 xv = *(const f32x4*)(X + ro + bj * 128 + 4 * n);
                        *(f32x4*)(O + ro + bj * 128 + 4 * n) = xv + g[bj][n] * pg8::acc_get(acc, ai, bj, m, n); } }
    }
};
struct EpiStore {
    static constexpr bool PERM = true, AFTER_DRAIN = false, TWOPASS = false;
    bf16* O; int ldc;
    __device__ __forceinline__ void operator()(pg8::AccW& acc, const pg8::Unit& u, int wr, int wc, int fr, int fq) const {
        const int row0 = u.pm * 256 + wr * 64 + fr, col0 = u.pn * 256 + wc * 32 + 8 * fq;
#pragma unroll
        for (int ai = 0; ai < 2; ++ai)
#pragma unroll
            for (int m = 0; m < 4; ++m) { bf16* rowp = O + (size_t)(row0 + ai * 128 + m * 16) * ldc + col0;
#pragma unroll
                for (int bj = 0; bj < 2; ++bj) { const pg8::f32x4 v0 = pg8::acc_get(acc, ai, bj, m, 0), v1 = pg8::acc_get(acc, ai, bj, m, 1);
                    v4u w; w.x = pk2(v0[0], v0[1]); w.y = pk2(v0[2], v0[3]); w.z = pk2(v1[0], v1[1]); w.w = pk2(v1[2], v1[3]);
                    *(v4u*)(rowp + bj * 128) = w; } }
    }
};

template <int MODE> __device__ __forceinline__ int srcmap(int np) {
    if (MODE == 2) np = proj_tile_bf16(np >> 8) * 256 + (np & 255);
    if (MODE == 3) np = proj_tile_fp8(np >> 8) * 256 + (np & 255);
    if (MODE >= 1) return np < 3400 ? np : (np >= 3584 ? np - 184 : -1);
    return np; }
template <int MODE>
__device__ __forceinline__ void transpose_item(const float* W, int N, bf16* WT, int ldw, int koff, float* scr, int kb, int nb, int lane) {
    const int k0 = 64 * kb, n0 = 32 * nb;
    const int sc = srcmap<MODE>(n0 + (lane & 31));
#pragma unroll 8
    for (int i = 0; i < 32; ++i) { const int kk = 2 * i + (lane >> 5); scr[kk * 33 + (lane & 31)] = (sc >= 0) ? W[(size_t)(k0 + kk) * N + sc] : 0.f; }
    LDS_WAIT(); __builtin_amdgcn_wave_barrier();
    const int c = lane & 7;
#pragma unroll
    for (int j = 0; j < 4; ++j) { const int n = (lane >> 3) + 8 * j; const float* s = scr + (8 * c) * 33 + n;
        v4u o; o.x = pk2(s[0 * 33], s[1 * 33]); o.y = pk2(s[2 * 33], s[3 * 33]); o.z = pk2(s[4 * 33], s[5 * 33]); o.w = pk2(s[6 * 33], s[7 * 33]);
        *(v4u*)(WT + (size_t)(n0 + n) * ldw + koff + k0 + 8 * c) = o; }
    LDS_WAIT(); __builtin_amdgcn_wave_barrier();
}
template <int MODE> __device__ __forceinline__ int srcmap(int np);
template <int MODE = 0>
__device__ __forceinline__ void transpose_item8(const float* W, int N, unsigned char* WT, int ldw, int koff, float scale, float* scr, int kb, int nb, int lane) {
    const int k0 = 64 * kb, n0 = 32 * nb;
    const int sc = srcmap<MODE>(n0 + (lane & 31));
#pragma unroll 8
    for (int i = 0; i < 32; ++i) { const int kk = 2 * i + (lane >> 5); scr[kk * 33 + (lane & 31)] = (sc >= 0) ? W[(size_t)(k0 + kk) * N + sc] * scale : 0.f; }
    LDS_WAIT(); __builtin_amdgcn_wave_barrier();
    const int c = lane & 3;
#pragma unroll
    for (int j = 0; j < 2; ++j) { const int n = (lane >> 2) + 16 * j; const float* sp = scr + (16 * c) * 33 + n;
        v4u o;
#pragma unroll
        for (int q = 0; q < 4; ++q) o[q] = pk4_fp8(sp[(4 * q) * 33], sp[(4 * q + 1) * 33], sp[(4 * q + 2) * 33], sp[(4 * q + 3) * 33]);
        *(v4u*)(WT + (size_t)(n0 + n) * ldw + koff + k0 + 16 * c) = o; }
    LDS_WAIT(); __builtin_amdgcn_wave_barrier();
}
__device__ __forceinline__ void convert_plain(const float* src, bf16* dst, size_t n, size_t gtid, size_t nth) {
    const size_t n8 = n / 8;
    for (size_t i = gtid; i < n8; i += nth) { const f32x4 a = ((const f32x4*)src)[2 * i], b = ((const f32x4*)src)[2 * i + 1];
        v4u o; o.x = pk2(a[0], a[1]); o.y = pk2(a[2], a[3]); o.z = pk2(b[0], b[1]); o.w = pk2(b[2], b[3]); ((v4u*)dst)[i] = o; }
}
__device__ __forceinline__ void convert_fp8(const float* src, unsigned char* dst, size_t n, float scale, size_t gtid, size_t nth) {
    const size_t n16 = n / 16;
    for (size_t i = gtid; i < n16; i += nth) { const f32x4* sp = (const f32x4*)src + 4 * i; const f32x4 a = sp[0] * scale, b = sp[1] * scale, c = sp[2] * scale, d = sp[3] * scale;
        v4u o; o.x = pk4_fp8(a[0], a[1], a[2], a[3]); o.y = pk4_fp8(b[0], b[1], b[2], b[3]); o.z = pk4_fp8(c[0], c[1], c[2], c[3]); o.w = pk4_fp8(d[0], d[1], d[2], d[3]); ((v4u*)dst)[i] = o; }
}
template <bool KKMAJOR>
__device__ __forceinline__ void convert_mxfp4(const float* src, unsigned char* dst, unsigned char* scl, size_t nrows, size_t gtid, size_t nth) {
    const size_t nblk = nrows * 32;
    for (size_t i = gtid; i < nblk; i += nth) {
        const size_t row = i >> 5; const int blk = (int)(i & 31);
        const f32x4* sp = (const f32x4*)(src + row * 1024 + blk * 32);
        f32x4 v[8]; float amax = 0.f;
#pragma unroll
        for (int j = 0; j < 8; ++j) { v[j] = sp[j]; amax = fmaxf(fmaxf(fmaxf(fabsf(v[j][0]), fabsf(v[j][1])), fmaxf(fabsf(v[j][2]), fabsf(v[j][3]))), amax); }
        int e = (int)((__builtin_bit_cast(unsigned, amax) >> 23) & 0xffu) - 127 - 2;
        if (e < -126) e = -126;
        const float inv = __builtin_bit_cast(float, (unsigned)(127 - e) << 23);
        unsigned w[4] = {0u, 0u, 0u, 0u};
#pragma unroll
        for (int j = 0; j < 8; j += 2) { unsigned t = 0u;
            t = __builtin_amdgcn_cvt_scalef32_pk_fp4_f32(t, v[j][0] * inv, v[j][1] * inv, 1.0f, 0);
            t = __builtin_amdgcn_cvt_scalef32_pk_fp4_f32(t, v[j][2] * inv, v[j][3] * inv, 1.0f, 1);
            t = __builtin_amdgcn_cvt_scalef32_pk_fp4_f32(t, v[j + 1][0] * inv, v[j + 1][1] * inv, 1.0f, 2);
            t = __builtin_amdgcn_cvt_scalef32_pk_fp4_f32(t, v[j + 1][2] * inv, v[j + 1][3] * inv, 1.0f, 3);
            w[j >> 1] = t; }
        *(v4u*)(dst + row * 512 + blk * 16) = (v4u){w[0], w[1], w[2], w[3]};
        scl[row * 32 + (KKMAJOR ? ((blk & 3) * 8 + (blk >> 2)) : blk)] = (unsigned char)(e + 127);
    }
}
__device__ __forceinline__ void convert_rowfp4(const float* src, unsigned char* dst, _Float16* scl, int row, int lane) {
    const f32x4* sp = (const f32x4*)(src + (size_t)row * 1024 + lane * 16);
    f32x4 v[4]; float amax = 0.f;
#pragma unroll
    for (int j = 0; j < 4; ++j) { v[j] = sp[j]; amax = fmaxf(fmaxf(fmaxf(fabsf(v[j][0]), fabsf(v[j][1])), fmaxf(fabsf(v[j][2]), fabsf(v[j][3]))), amax); }
    amax = wave_max(amax);
    _Float16 sh = (_Float16)(amax * (1.f / 6.f));
    float sf = (float)sh; if (!(sf > 0.f)) { sf = 1.f; sh = (_Float16)1.f; }
    const float inv = 1.f / sf;
    unsigned w[2];
#pragma unroll
    for (int j = 0; j < 2; ++j) { unsigned t = 0u;
        t = __builtin_amdgcn_cvt_scalef32_pk_fp4_f32(t, v[2 * j][0] * inv, v[2 * j][1] * inv, 1.0f, 0);
        t = __builtin_amdgcn_cvt_scalef32_pk_fp4_f32(t, v[2 * j][2] * inv, v[2 * j][3] * inv, 1.0f, 1);
        t = __builtin_amdgcn_cvt_scalef32_pk_fp4_f32(t, v[2 * j + 1][0] * inv, v[2 * j + 1][1] * inv, 1.0f, 2);
        t = __builtin_amdgcn_cvt_scalef32_pk_fp4_f32(t, v[2 * j + 1][2] * inv, v[2 * j + 1][3] * inv, 1.0f, 3);
        w[j] = t; }
    *(v2u*)(dst + (size_t)row * 512 + lane * 8) = (v2u){w[0], w[1]};
    if (lane == 0) scl[row] = sh;
}
__device__ __forceinline__ void phase0(const Params& p, unsigned char* lds) {
    const int tid = threadIdx.x, wave = tid >> 6, lane = tid & 63, G = gridDim.x;
    const int gw = blockIdx.x * NWAVES + wave, NGW = G * NWAVES;
    float* scr = (float*)(lds + wave * 16384);
    unsigned char* ws = p.ws;
    constexpr int I_IN = 16 * (2048 / 32), I_IN8 = 16 * (3584 / 32), I_A = 8 * 32, I_O = 16 * 32, I_Q = 16 * 64;
    constexpr int NT = I_IN + I_IN8 + 2 * I_A + I_O + I_Q;
    for (int it = gw; it < NT; it += NGW) {
        int r = it;
        if (r < I_IN) { transpose_item<2>(p.w_in, INW, (bf16*)(ws + WS_WIN), 1024, 0, scr, r / 64, r % 64, lane); continue; } r -= I_IN;
        if (r < I_IN8) { transpose_item8<3>(p.w_in, INW, ws + WS_WIN8, 1024, 0, 32.f, scr, r / 112, r % 112, lane); continue; } r -= I_IN8;
        if (r < I_A) { transpose_item8(p.w_a, 1024, ws + WS_WAB8, 1024, 0, 32.f, scr, r / 32, r % 32, lane); continue; } r -= I_A;
        if (r < I_A) { transpose_item8(p.w_b, 1024, ws + WS_WAB8, 1024, 512, 4.f, scr, r / 32, r % 32, lane); continue; } r -= I_A;
        if (r < I_O) { transpose_item8(p.w_out, 1024, ws + WS_WOUT8, 1024, 0, 32.f, scr, r / 32, r % 32, lane); continue; } r -= I_O;
        transpose_item<0>(p.peer_wq, 2048, (bf16*)(ws + WS_WQ), 1024, 0, scr, r / 64, r % 64, lane);
    }
    for (int it = gw; it < 96 * 8; it += NGW) {
        const int cgp = it % 96, ks = it / 96, col = cgp * 64 + lane, k0 = ks * 128;
#pragma unroll
        for (int i = 0; i < 16; ++i) { const int e = i * 64 + lane, b = e >> 7, k = e & 127; scr[e] = siluf_(p.c[b * 1024 + k0 + k]); }
        LDS_WAIT(); __builtin_amdgcn_wave_barrier();
        float acc[8];
#pragma unroll
        for (int b = 0; b < 8; ++b) acc[b] = 0.f;
#pragma unroll 4
        for (int k = 0; k < 128; ++k) { const float w = p.w_ada[(size_t)(k0 + k) * 6144 + col];
#pragma unroll
            for (int b = 0; b < 8; ++b) acc[b] += scr[b * 128 + k] * w; }
        float* mp = (float*)(ws + WS_MODP) + (size_t)ks * 8 * 6144 + col;
#pragma unroll
        for (int b = 0; b < 8; ++b) mp[b * 6144] = acc[b];
        LDS_WAIT(); __builtin_amdgcn_wave_barrier();
    }
    const size_t gtid = (size_t)blockIdx.x * NTHREADS + tid, nth = (size_t)G * NTHREADS;
    convert_plain(p.peer_subkeys, (bf16*)(ws + WS_SK), (size_t)16 * 128 * 128, gtid, nth);
    for (int it = gw; it < 2 * NEXP; it += NGW) {
        if (it < NEXP) convert_rowfp4(p.peer_u, ws + WS_U, (_Float16*)(ws + WS_US), it, lane);
        else convert_rowfp4(p.peer_v, ws + WS_V, (_Float16*)(ws + WS_VS), it - NEXP, lane);
    }
}

template <bool FIRST>
__device__ __forceinline__ void normmod_phase(const Params& p, unsigned char* lds, const float* src, bf16* dst, const float* gvec, int shift_off, int scale_off) {
    const int tid = threadIdx.x, wave = tid >> 6, lane = tid & 63, G = gridDim.x;
    unsigned char* ws = p.ws;
    float* A = (float*)lds;
    float* Bv = A + 1024;
    const float* MODP = (const float*)(ws + WS_MODP);
    float* MOD = (float*)(ws + WS_MOD);
    if (FIRST) {
        for (int e = blockIdx.x * NTHREADS + tid; e < 8 * 6144; e += G * NTHREADS) { const int col = e % 6144; float s = p.b_ada[col];
#pragma unroll
            for (int ks = 0; ks < 8; ++ks) s += MODP[(size_t)ks * 8 * 6144 + e];
            MOD[e] = s; }
    }
    int curb = -1;
    for (int chunk = blockIdx.x; chunk < T / 128; chunk += G) {
        const int b = (chunk * 128) / SEQ;
        if (b != curb) {
            __syncthreads();
            for (int col = tid; col < 1024; col += NTHREADS) {
                float sc, sh;
                if (FIRST) { sc = p.b_ada[scale_off + col]; sh = p.b_ada[shift_off + col];
#pragma unroll
                    for (int ks = 0; ks < 8; ++ks) { sc += MODP[(size_t)(ks * 8 + b) * 6144 + scale_off + col]; sh += MODP[(size_t)(ks * 8 + b) * 6144 + shift_off + col]; } }
                else { sc = MOD[b * 6144 + scale_off + col]; sh = MOD[b * 6144 + shift_off + col]; }
                A[col] = gvec[col] * (1.f + sc); Bv[col] = sh; }
            __syncthreads(); curb = b;
        }
        for (int r = wave; r < 128; r += NWAVES) {
            const size_t row = (size_t)chunk * 128 + r;
            const f32x4* xr = (const f32x4*)(src + row * DM) + lane;
            f32x4 v[4]; float s = 0.f;
#pragma unroll
            for (int j = 0; j < 4; ++j) { v[j] = xr[64 * j]; s += (v[j][0] * v[j][0] + v[j][1] * v[j][1]) + (v[j][2] * v[j][2] + v[j][3] * v[j][3]); }
            const float rstd = rsqrtf(wave_sum(s) * (1.f / DM) + RMS_EPS);
            v2u* o8 = (v2u*)(dst + row * DM) + lane;
#pragma unroll
            for (int j = 0; j < 4; ++j) { const int c0 = 4 * lane + 256 * j; const f32x4 a = *(const f32x4*)(A + c0), sh = *(const f32x4*)(Bv + c0);
                v2u o; o.x = pk2(v[j][0] * rstd * a[0] + sh[0], v[j][1] * rstd * a[1] + sh[1]); o.y = pk2(v[j][2] * rstd * a[2] + sh[2], v[j][3] * rstd * a[3] + sh[3]);
                o8[64 * j] = o;
                if (FIRST) *(unsigned*)(ws + WS_H8 + row * DM + c0) = pk4_fp8(v[j][0] * rstd * a[0] + sh[0], v[j][1] * rstd * a[1] + sh[1], v[j][2] * rstd * a[2] + sh[2], v[j][3] * rstd * a[3] + sh[3]);
                if (!FIRST) { float* st = (float*)(lds + 8192) + wave * 1056;
                    const float y0 = v[j][0] * rstd * a[0] + sh[0], y1 = v[j][1] * rstd * a[1] + sh[1], y2 = v[j][2] * rstd * a[2] + sh[2], y3 = v[j][3] * rstd * a[3] + sh[3];
                    const int pc = c0 + (c0 >> 5); st[pc] = y0; st[pc + 1] = y1; st[pc + 2] = y2; st[pc + 3] = y3; } }
            if (!FIRST) {
                const float* st = (const float*)(lds + 8192) + wave * 1056;
                LDS_WAIT(); __builtin_amdgcn_wave_barrier();
                if (lane < 32) {
                    float x[32];
#pragma unroll
                    for (int k = 0; k < 32; ++k) x[k] = st[lane * 33 + k];
#pragma unroll
                    for (int t = 0; t < H4_NT; ++t) {
                        float amax = 0.f;
#pragma unroll
                        for (int k = 0; k < 32; ++k) amax = fmaxf(amax, fabsf(x[k]));
                        int e = (int)((__builtin_bit_cast(unsigned, amax) >> 23) & 0xffu) - 127 - 2; if (e < -126) e = -126;
                        const float inv = __builtin_bit_cast(float, (unsigned)(127 - e) << 23), sc = __builtin_bit_cast(float, (unsigned)(127 + e) << 23);
                        unsigned w[4];
#pragma unroll
                        for (int r = 0; r < 4; ++r) { unsigned tw = 0u;
                            tw = __builtin_amdgcn_cvt_scalef32_pk_fp4_f32(tw, x[8 * r] * inv, x[8 * r + 1] * inv, 1.0f, 0);
                            tw = __builtin_amdgcn_cvt_scalef32_pk_fp4_f32(tw, x[8 * r + 2] * inv, x[8 * r + 3] * inv, 1.0f, 1);
                            tw = __builtin_amdgcn_cvt_scalef32_pk_fp4_f32(tw, x[8 * r + 4] * inv, x[8 * r + 5] * inv, 1.0f, 2);
                            tw = __builtin_amdgcn_cvt_scalef32_pk_fp4_f32(tw, x[8 * r + 6] * inv, x[8 * r + 7] * inv, 1.0f, 3);
                            w[r] = tw;
                            const f32x2 d0 = __builtin_amdgcn_cvt_scalef32_pk_f32_fp4(tw, 1.0f, 0), d1 = __builtin_amdgcn_cvt_scalef32_pk_f32_fp4(tw, 1.0f, 1), d2 = __builtin_amdgcn_cvt_scalef32_pk_f32_fp4(tw, 1.0f, 2), d3 = __builtin_amdgcn_cvt_scalef32_pk_f32_fp4(tw, 1.0f, 3);
                            x[8 * r] -= d0[0] * sc; x[8 * r + 1] -= d0[1] * sc; x[8 * r + 2] -= d1[0] * sc; x[8 * r + 3] -= d1[1] * sc;
                            x[8 * r + 4] -= d2[0] * sc; x[8 * r + 5] -= d2[1] * sc; x[8 * r + 6] -= d3[0] * sc; x[8 * r + 7] -= d3[1] * sc; }
                        *(v4u*)(ws + WS_H4D + (row * H4_NT + t) * 512 + lane * 16) = (v4u){w[0], w[1], w[2], w[3]};
                        *(ws + WS_H4S + (row * H4_NT + t) * 32 + (lane & 3) * 8 + (lane >> 2)) = (unsigned char)(e + 127);
                    }
                }
                LDS_WAIT(); __builtin_amdgcn_wave_barrier();
            }
        }
    }
    __syncthreads();
}

constexpr int HGL_QT = 0, HGL_KT = 17408, HGL_QE = 34816, HGL_KLT = 52224, HGL_VT = 70656, HGL_AM = 89088, HGL_DEC = 98304, HGL_TOT = 98816, HGL_SSQ = 100864;
constexpr int HG_LDR = 136;
constexpr int HG_LDC = 72;
template <int half>
__device__ __forceinline__ void hgrn_item(const Params& p, unsigned char* lds, int item) {
    const int b = item >> 2, h = item & 3;
    const int tid = threadIdx.x, w = tid >> 6, lane = tid & 63, fr = lane & 15, fq = lane >> 4;
    unsigned char* ws = p.ws;
    const bf16* HG = (const bf16*)(ws + WS_HG);
    bf16* YA = (bf16*)(ws + WS_H);
    bf16* QT = (bf16*)(lds + HGL_QT); bf16* KT = (bf16*)(lds + HGL_KT); bf16* QE = (bf16*)(lds + HGL_QE);
    bf16* KLT = (bf16*)(lds + HGL_KLT); bf16* VT = (bf16*)(lds + HGL_VT); bf16* AM = (bf16*)(lds + HGL_AM);
    float* DEC = (float*)(lds + HGL_DEC); float* TOT = (float*)(lds + HGL_TOT); float* SSQ = (float*)(lds + HGL_SSQ);
    const int pd = tid & 127, pq = tid >> 7;
    float lbv; { const float a0 = p.hg_lb[h * 128 + pd], a1 = p.hg_lb[512 + h * 128 + pd]; lbv = 1.f / (1.f + __expf(a1 - a0)); }
    const int e0 = w * 16;
    const float ogv = p.hg_onorm_g[e0 + fr];
    pg8::f32x4 S[8];
#pragma unroll
    for (int i = 0; i < 8; ++i) S[i] = (pg8::f32x4){0.f, 0.f, 0.f, 0.f};
    const size_t rowb = (size_t)b * SEQ;
    const int c0 = half * 32;
    bf16* QCg = (bf16*)(ws + WS_HQC) + (size_t)item * 2048 * 128; float* OLg = (float*)(ws + WS_HOL) + (size_t)item * 32 * 8 * 4 * 256;
    float cum = 1.f;
    unsigned short rq[16], rf[16], rv[16];
    { const bf16* gp = HG + (rowb + (size_t)c0 * 64 + pq * 16) * LD_HG + h * 128 + pd;
#pragma unroll
      for (int i = 0; i < 16; ++i) { rq[i] = gp[(size_t)i * LD_HG]; rf[i] = gp[(size_t)i * LD_HG + 512]; rv[i] = gp[(size_t)i * LD_HG + 1024]; } }
    for (int chunk = c0; chunk < c0 + 32; ++chunk) {
        const size_t row0 = rowb + (size_t)chunk * 64;
        float fq_[16], kq_[16], cs[16];
        float run = 0.f;
#pragma unroll
        for (int i = 0; i < 16; ++i) { const float f = lbv + (1.f - lbv) * sigmoidf_(bf2f(rf[i])); kq_[i] = 1.f - f; run += __logf(f); cs[i] = run; fq_[i] = siluf_(bf2f(rq[i])); }
        TOT[pq * 128 + pd] = run;
        { v4u v0, v1;
          v0.x = rv[0] | ((unsigned)rv[1] << 16); v0.y = rv[2] | ((unsigned)rv[3] << 16); v0.z = rv[4] | ((unsigned)rv[5] << 16); v0.w = rv[6] | ((unsigned)rv[7] << 16);
          v1.x = rv[8] | ((unsigned)rv[9] << 16); v1.y = rv[10] | ((unsigned)rv[11] << 16); v1.z = rv[12] | ((unsigned)rv[13] << 16); v1.w = rv[14] | ((unsigned)rv[15] << 16);
          *(v4u*)(VT + pd * HG_LDC + pq * 16) = v0; *(v4u*)(VT + pd * HG_LDC + pq * 16 + 8) = v1; }
        unsigned short rg[16];
#pragma unroll
        for (int i = 0; i < 16; ++i) rg[i] = half ? (unsigned short)0 : HG[(row0 + (i >> 2) * 16 + fq * 4 + (i & 3)) * LD_HG + 1536 + h * 128 + e0 + fr];
        if (chunk + 1 < c0 + 32) { const bf16* gp = HG + (row0 + 64 + pq * 16) * LD_HG + h * 128 + pd;
#pragma unroll
            for (int i = 0; i < 16; ++i) { rq[i] = gp[(size_t)i * LD_HG]; rf[i] = gp[(size_t)i * LD_HG + 512]; rv[i] = gp[(size_t)i * LD_HG + 1024]; } }
        __syncthreads();
        const float t0 = TOT[pd], t1 = TOT[128 + pd], t2 = TOT[256 + pd], t3 = TOT[384 + pd];
        const float base = (pq > 0 ? t0 : 0.f) + (pq > 1 ? t1 : 0.f) + (pq > 2 ? t2 : 0.f);
        const float bmid = t0 + t1, blast = (t0 + t1) + (t2 + t3);
        const float emid = __expf(bmid), elm = __expf(blast - bmid);
        if (pq == 0) DEC[pd] = __expf(blast);
        { unsigned klp[8];
#pragma unroll
          for (int i = 0; i < 16; ++i) { const float bb = base + cs[i]; const float E1 = __expf(bb - bmid), R1 = __builtin_amdgcn_rcpf(E1);
              const float qtv = fq_[i] * E1, ktv = kq_[i] * R1, qev = qtv * emid, klv = ktv * elm;
              const int srow = pq * 16 + i;
              QT[srow * HG_LDR + pd] = (bf16)f2bf(qtv); KT[srow * HG_LDR + pd] = (bf16)f2bf(ktv); QE[srow * HG_LDR + pd] = (bf16)f2bf(qev);
              if (half) QCg[((size_t)(chunk - 32) * 64 + srow) * 128 + pd] = (bf16)f2bf(qev * cum);
              if (i & 1) klp[i >> 1] |= f2bf(klv) << 16; else klp[i >> 1] = f2bf(klv); }
          *(v4u*)(KLT + pd * HG_LDC + pq * 16) = (v4u){klp[0], klp[1], klp[2], klp[3]}; *(v4u*)(KLT + pd * HG_LDC + pq * 16 + 8) = (v4u){klp[4], klp[5], klp[6], klp[7]}; }
        cum *= __expf(blast);
        __syncthreads();
#pragma unroll
        for (int tt = 0; tt < 2; ++tt) { const int id = w + 8 * tt, rt = id >> 2, ct = id & 3;
            pg8::f32x4 a = {0.f, 0.f, 0.f, 0.f};
            if (ct <= rt) {
#pragma unroll
                for (int ks = 0; ks < 4; ++ks) { const bf16x8 af = *(const bf16x8*)(QT + (rt * 16 + fr) * HG_LDR + ks * 32 + fq * 8), bfv = *(const bf16x8*)(KT + (ct * 16 + fr) * HG_LDR + ks * 32 + fq * 8);
                    a = __builtin_amdgcn_mfma_f32_16x16x32_bf16(af, bfv, a, 0, 0, 0); } }
#pragma unroll
            for (int r = 0; r < 4; ++r) { const int c = rt * 16 + fq * 4 + r, sidx = ct * 16 + fr; AM[c * HG_LDC + sidx] = (bf16)((sidx <= c) ? f2bf(a[r]) : 0u); } }
        __syncthreads();
        const bf16x8 vb0 = *(const bf16x8*)(VT + (e0 + fr) * HG_LDC + fq * 8), vb1 = *(const bf16x8*)(VT + (e0 + fr) * HG_LDC + 32 + fq * 8);
        bf16x8 sb[4];
#pragma unroll
        for (int ks = 0; ks < 4; ++ks) { v4u t; t.x = pk2(S[2 * ks][0], S[2 * ks][1]); t.y = pk2(S[2 * ks][2], S[2 * ks][3]); t.z = pk2(S[2 * ks + 1][0], S[2 * ks + 1][1]); t.w = pk2(S[2 * ks + 1][2], S[2 * ks + 1][3]); sb[ks] = __builtin_bit_cast(bf16x8, t); }
        pg8::f32x4 o[4];
#pragma unroll
        for (int rt = 0; rt < 4; ++rt) { pg8::f32x4 a = {0.f, 0.f, 0.f, 0.f};
            a = __builtin_amdgcn_mfma_f32_16x16x32_bf16(*(const bf16x8*)(AM + (rt * 16 + fr) * HG_LDC + fq * 8), vb0, a, 0, 0, 0);
            a = __builtin_amdgcn_mfma_f32_16x16x32_bf16(*(const bf16x8*)(AM + (rt * 16 + fr) * HG_LDC + 32 + fq * 8), vb1, a, 0, 0, 0);
#pragma unroll
            for (int ks = 0; ks < 4; ++ks) { const v2u lo = *(const v2u*)(QE + (rt * 16 + fr) * HG_LDR + ks * 32 + fq * 4), hi = *(const v2u*)(QE + (rt * 16 + fr) * HG_LDR + ks * 32 + 16 + fq * 4);
                const v4u t = {lo.x, lo.y, hi.x, hi.y};
                a = __builtin_amdgcn_mfma_f32_16x16x32_bf16(__builtin_bit_cast(bf16x8, t), sb[ks], a, 0, 0, 0); }
            o[rt] = a; }
#pragma unroll
        for (int dt = 0; dt < 8; ++dt) { const f32x4 dc = *(const f32x4*)(DEC + dt * 16 + fq * 4);
            pg8::f32x4 a = S[dt]; a[0] *= dc[0]; a[1] *= dc[1]; a[2] *= dc[2]; a[3] *= dc[3];
            a = __builtin_amdgcn_mfma_f32_16x16x32_bf16(*(const bf16x8*)(KLT + (dt * 16 + fr) * HG_LDC + fq * 8), vb0, a, 0, 0, 0);
            a = __builtin_amdgcn_mfma_f32_16x16x32_bf16(*(const bf16x8*)(KLT + (dt * 16 + fr) * HG_LDC + 32 + fq * 8), vb1, a, 0, 0, 0);
            S[dt] = a; }
        if (half) {
#pragma unroll
            for (int rt = 0; rt < 4; ++rt) *(pg8::f32x4*)(OLg + ((((size_t)(chunk - 32)) * 8 + w) * 4 + rt) * 256 + lane * 4) = o[rt];
            __syncthreads();
            continue;
        }
#pragma unroll
        for (int rt = 0; rt < 4; ++rt)
#pragma unroll
            for (int r = 0; r < 4; ++r) { float x = o[rt][r] * o[rt][r];
                x += __shfl_xor(x, 1); x += __shfl_xor(x, 2); x += __shfl_xor(x, 4); x += __shfl_xor(x, 8);
                if (fr == 0) SSQ[w * 64 + rt * 16 + fq * 4 + r] = x; }
        __syncthreads();
        float tot = 0.f;
#pragma unroll
        for (int ww = 0; ww < 8; ++ww) tot += SSQ[ww * 64 + lane];
        const float rstd_l = rsqrtf(tot * (1.f / 128.f) + RMS_EPS);
#pragma unroll
        for (int rt = 0; rt < 4; ++rt)
#pragma unroll
            for (int r = 0; r < 4; ++r) { const int c = rt * 16 + fq * 4 + r; const float rs = __shfl(rstd_l, c);
                const float y = o[rt][r] * rs * ogv * siluf_(bf2f(rg[rt * 4 + r]));
                ((unsigned char*)YA)[(row0 + c) * 1024 + h * 128 + e0 + fr] = (unsigned char)(__builtin_amdgcn_cvt_pk_fp8_f32(y, 0.f, 0, false) & 0xff); }
    }
    if (!half) {
#pragma unroll
        for (int ks = 0; ks < 4; ++ks) { v4u t; t.x = pk2(S[2 * ks][0], S[2 * ks][1]); t.y = pk2(S[2 * ks][2], S[2 * ks][3]); t.z = pk2(S[2 * ks + 1][0], S[2 * ks + 1][1]); t.w = pk2(S[2 * ks + 1][2], S[2 * ks + 1][3]);
            *(v4u*)(ws + WS_HSB + ((((size_t)item * 8 + w) * 4 + ks) * 64 + lane) * 16) = t; }
    }
    __syncthreads();
}
__device__ __forceinline__ void hgrn_fix(const Params& p, int item, int c, int rt, int lane) {
    const int b = item >> 2, h = item & 3, fr = lane & 15, fq = lane >> 4;
    unsigned char* ws = p.ws;
    const bf16* HG = (const bf16*)(ws + WS_HG);
    bf16* YA = (bf16*)(ws + WS_H);
    const bf16* QCg = (const bf16*)(ws + WS_HQC) + (size_t)item * 2048 * 128; const float* OLg = (const float*)(ws + WS_HOL) + (size_t)item * 32 * 8 * 4 * 256;
    const size_t row0 = (size_t)b * SEQ + (size_t)(32 + c) * 64 + rt * 16;
    bf16x8 Aq[4];
    { const bf16* qr = QCg + ((size_t)c * 64 + rt * 16 + fr) * 128;
#pragma unroll
      for (int ks = 0; ks < 4; ++ks) { const v2u lo = *(const v2u*)(qr + ks * 32 + fq * 4), hi = *(const v2u*)(qr + ks * 32 + 16 + fq * 4); const v4u t = {lo.x, lo.y, hi.x, hi.y}; Aq[ks] = __builtin_bit_cast(bf16x8, t); } }
    pg8::f32x4 o[8];
#pragma unroll
    for (int w2 = 0; w2 < 8; ++w2) { pg8::f32x4 a = *(const pg8::f32x4*)(OLg + ((((size_t)c) * 8 + w2) * 4 + rt) * 256 + lane * 4);
#pragma unroll
        for (int ks = 0; ks < 4; ++ks) { const bf16x8 sbv = __builtin_bit_cast(bf16x8, *(const v4u*)(ws + WS_HSB + ((((size_t)item * 8 + w2) * 4 + ks) * 64 + lane) * 16));
            a = __builtin_amdgcn_mfma_f32_16x16x32_bf16(Aq[ks], sbv, a, 0, 0, 0); }
        o[w2] = a; }
    float rs[4];
#pragma unroll
    for (int r = 0; r < 4; ++r) { float x = 0.f;
#pragma unroll
        for (int w2 = 0; w2 < 8; ++w2) x += o[w2][r] * o[w2][r];
        x += __shfl_xor(x, 1); x += __shfl_xor(x, 2); x += __shfl_xor(x, 4); x += __shfl_xor(x, 8);
        rs[r] = rsqrtf(x * (1.f / 128.f) + RMS_EPS); }
#pragma unroll
    for (int w2 = 0; w2 < 8; ++w2) { const float ogv = p.hg_onorm_g[w2 * 16 + fr];
#pragma unroll
        for (int r = 0; r < 4; ++r) { const size_t row = row0 + fq * 4 + r;
            const float g = bf2f((unsigned)(unsigned short)HG[row * LD_HG + 1536 + h * 128 + w2 * 16 + fr]);
            const float y = o[w2][r] * rs[r] * ogv * siluf_(g);
            ((unsigned char*)YA)[row * 1024 + h * 128 + w2 * 16 + fr] = (unsigned char)(__builtin_amdgcn_cvt_pk_fp8_f32(y, 0.f, 0, false) & 0xff); } }
}

__device__ __forceinline__ unsigned f16key(float x) {
    x = x + 0.f;
    const _Float16 hx = (_Float16)x; const unsigned short bits = __builtin_bit_cast(unsigned short, hx);
    return (bits & 0x8000u) ? (unsigned)(unsigned short)(~bits) : (unsigned)(bits | 0x8000u);
}
__device__ __forceinline__ void find_bin(const unsigned* hist, int K, int lane, int& bin, int& rem) {
    const v4u hv = *(const v4u*)(hist + 4 * lane);
    const unsigned c = hv.x + hv.y + hv.z + hv.w;
    unsigned suf = c;
#pragma unroll
    for (int o = 1; o < 64; o <<= 1) { const unsigned t = __shfl_down(suf, o); if (lane + o < 64) suf += t; }
    const unsigned above = suf - c;
    const bool mine = (above < (unsigned)K) && ((unsigned)K <= suf);
    int mybin = 0, myrem = 0;
    if (mine) { unsigned ca = above; const unsigned hh[4] = {hv.x, hv.y, hv.z, hv.w}; bool found = false;
#pragma unroll
        for (int i = 3; i >= 0; --i) { if (!found) { if (ca + hh[i] >= (unsigned)K) { mybin = 4 * lane + i; myrem = K - (int)ca; found = true; } else ca += hh[i]; } } }
    const unsigned long long m = __ballot(mine);
    const int src = (int)__builtin_ctzll(m | (1ull << 63));
    bin = __shfl(mybin, src); rem = __shfl(myrem, src);
}
__device__ __forceinline__ void dsa1_item(const Params& p, unsigned char* lds, int item) {
    const int b = item >> 8, q0 = (item & 255) * 16;
    const int tid = threadIdx.x, w = tid >> 6, lane = tid & 63, fr = lane & 15, fq = lane >> 4;
    unsigned char* ws = p.ws;
    const bf16* IDX = (const bf16*)(ws + WS_IDX);
    unsigned short* Ik = (unsigned short*)lds;
    unsigned* hist1 = (unsigned*)(lds + 131072);
    unsigned* hist = (unsigned*)(lds + 131072 + 16384) + w * 256;
    const size_t rowb = (size_t)b * SEQ;
    *(v4u*)(hist1 + tid * 4) = (v4u){0u, 0u, 0u, 0u}; *(v4u*)(hist1 + 2048 + tid * 4) = (v4u){0u, 0u, 0u, 0u};
    bf16x8 Af[8][2];
    { const bf16* rp = IDX + (rowb + q0 + fr) * LD_IDX + fq * 8;
#pragma unroll
      for (int h = 0; h < 8; ++h) { Af[h][0] = *(const bf16x8*)(rp + h * 64); Af[h][1] = *(const bf16x8*)(rp + h * 64 + 32); } }
    const float idx_scale = 0.5f * 0.125f * 0.35355339059327373f;
    bf16x8 Aw[2];
    { float wa[8];
      { const v4u wq = *(const v4u*)(IDX + (rowb + q0 + fr) * LD_IDX + 576);
#pragma unroll
        for (int i = 0; i < 4; ++i) { wa[2 * i] = bflo(wq[i]) * idx_scale; wa[2 * i + 1] = bfhi(wq[i]) * idx_scale; } }
#pragma unroll
      for (int ks = 0; ks < 2; ++ks) { float cq[8];
#pragma unroll
          for (int j = 0; j < 8; ++j) cq[j] = 0.f;
#pragma unroll
          for (int h = 0; h < 8; ++h)
#pragma unroll
              for (int j = 0; j < 8; ++j) cq[j] += wa[h] * bf2f((unsigned)(unsigned short)Af[h][ks][j]);
          const v4u t = {pk2(cq[0], cq[1]), pk2(cq[2], cq[3]), pk2(cq[4], cq[5]), pk2(cq[6], cq[7])};
          Aw[ks] = __builtin_bit_cast(bf16x8, t); } }
    float wv[4][8];
#pragma unroll
    for (int r = 0; r < 4; ++r) { const v4u wq = *(const v4u*)(IDX + (rowb + q0 + fq * 4 + r) * LD_IDX + 576);
#pragma unroll
        for (int i = 0; i < 4; ++i) { wv[r][2 * i] = bflo(wq[i]) * idx_scale; wv[r][2 * i + 1] = bfhi(wq[i]) * idx_scale; } }
    const int ntiles = (q0 >> 4) + 1;
    __syncthreads();
    bf16x8 B0 = Aw[0], B1 = Aw[1];
    if (w < ntiles) { const bf16* kp = IDX + (rowb + w * 16 + fr) * LD_IDX + 512 + fq * 8; B0 = *(const bf16x8*)kp; B1 = *(const bf16x8*)(kp + 32); }
    for (int kt = w; kt < ntiles; kt += NWAVES) {
        bf16x8 nB0 = B0, nB1 = B1;
        if (kt + NWAVES < ntiles) { const bf16* kp = IDX + (rowb + (kt + NWAVES) * 16 + fr) * LD_IDX + 512 + fq * 8; nB0 = *(const bf16x8*)kp; nB1 = *(const bf16x8*)(kp + 32); }
        pg8::f32x4 lin = {0.f, 0.f, 0.f, 0.f};
        lin = __builtin_amdgcn_mfma_f32_16x16x32_bf16(Aw[0], B0, lin, 0, 0, 0);
        lin = __builtin_amdgcn_mfma_f32_16x16x32_bf16(Aw[1], B1, lin, 0, 0, 0);
        float I[4] = {lin[0], lin[1], lin[2], lin[3]};
#pragma unroll
        for (int h = 0; h < 8; ++h) { pg8::f32x4 a = {0.f, 0.f, 0.f, 0.f};
            a = __builtin_amdgcn_mfma_f32_16x16x32_bf16(Af[h][0], B0, a, 0, 0, 0);
            a = __builtin_amdgcn_mfma_f32_16x16x32_bf16(Af[h][1], B1, a, 0, 0, 0);
#pragma unroll
            for (int r = 0; r < 4; ++r) I[r] = __builtin_fmaf(wv[r][h], __builtin_fabsf(a[r]), I[r]); }
        const int kidx = kt * 16 + fr;
#pragma unroll
        for (int r = 0; r < 4; ++r) { const unsigned key = f16key(I[r]); Ik[(fq * 4 + r) * 4096 + kidx] = (unsigned short)key;
            if (kidx <= q0 + fq * 4 + r) atomicAdd(&hist1[(fq * 4 + r) * 256 + (key >> 8)], 1u); }
        B0 = nB0; B1 = nB1;
    }
    __syncthreads();
    for (int qq = w; qq < 16; qq += NWAVES) {
        const int t = q0 + qq, n = t + 1;
        unsigned short* so = (unsigned short*)(hist1 + qq * 256);
        const unsigned short* keys = Ik + qq * 4096;
        if (n <= TOPK) { for (int j = lane; j < n; j += 64) so[j] = (unsigned short)j; }
        else {
            int b1, rem1, b2, rem2;
            find_bin(hist1 + qq * 256, TOPK, lane, b1, rem1);
            *(v4u*)(hist + 4 * lane) = (v4u){0u, 0u, 0u, 0u};
            LDS_WAIT(); __builtin_amdgcn_wave_barrier();
            for (int j0 = 0; j0 < n; j0 += 512) { unsigned k4[8];
#pragma unroll
                for (int u = 0; u < 8; ++u) { const int j = j0 + u * 64 + lane; k4[u] = keys[j < 4095 ? j : 4095]; }
#pragma unroll
                for (int u = 0; u < 8; ++u) { const int j = j0 + u * 64 + lane; if (j < n && (int)(k4[u] >> 8) == b1) atomicAdd(&hist[k4[u] & 255u], 1u); } }
            LDS_WAIT(); __builtin_amdgcn_wave_barrier();
            find_bin(hist, rem1, lane, b2, rem2);
            const unsigned thr = ((unsigned)b1 << 8) | (unsigned)b2;
            int base = 0, eqtaken = 0;
            const unsigned long long lt = (lane == 0) ? 0ull : (~0ull >> (64 - lane));
            for (int j0 = 0; j0 < n; j0 += 512) { unsigned k4[8];
#pragma unroll
                for (int u = 0; u < 8; ++u) { const int j = j0 + u * 64 + lane; k4[u] = keys[j < 4095 ? j : 4095]; }
#pragma unroll
                for (int u = 0; u < 8; ++u) {
                    const int j = j0 + u * 64 + lane; const bool valid = j < n; const unsigned k = valid ? k4[u] : 0u;
                    const bool gt = valid && k > thr, eq = valid && k == thr;
                    const unsigned long long meq = __ballot(eq);
                    const int erank = __popcll(meq & lt) + eqtaken;
                    const bool take = gt || (eq && erank < rem2);
                    const unsigned long long mt = __ballot(take);
                    if (take) so[base + __popcll(mt & lt)] = (unsigned short)j;
                    base += __popcll(mt); eqtaken += __popcll(meq);
                }
            }
        }
    }
    __syncthreads();
}

template <int NB>
__device__ __forceinline__ void qknorm_tokens(const Params& p, const int (&toks)[NB], int lane, const float (&qg)[8], const float (&kg)[8]) {
    v4u qv[NB], kv[NB], vv[NB];
#pragma unroll
    for (int n = 0; n < NB; ++n) { const bf16* row = (const bf16*)(p.ws + WS_ATT) + (size_t)toks[n] * LD_ATT;
        qv[n] = *(const v4u*)(row + lane * 8); kv[n] = *(const v4u*)(row + 512 + (lane & 15) * 8); vv[n] = *(const v4u*)(row + 640 + (lane & 15) * 8); }
#pragma unroll
    for (int n = 0; n < NB; ++n) { const int tok = toks[n];
        { float x[8]; float ss = 0.f;
#pragma unroll
          for (int i = 0; i < 4; ++i) { x[2 * i] = bflo(qv[n][i]); x[2 * i + 1] = bfhi(qv[n][i]); ss += x[2 * i] * x[2 * i] + x[2 * i + 1] * x[2 * i + 1]; }
          ss += __shfl_xor(ss, 1); ss += __shfl_xor(ss, 2); ss += __shfl_xor(ss, 4);
          const float rs = rsqrtf(ss * (1.f / 64.f) + RMS_EPS) * (0.125f * 1.4426950408889634f);
#pragma unroll
          for (int i = 0; i < 8; ++i) x[i] = x[i] * rs * qg[i];
          v2u hw, lw;
          hw.x = pk4_fp8(x[0], x[1], x[2], x[3]); hw.y = pk4_fp8(x[4], x[5], x[6], x[7]);
          { const f32x2 d0 = __builtin_amdgcn_cvt_pk_f32_fp8((int)hw.x, false), d1 = __builtin_amdgcn_cvt_pk_f32_fp8((int)hw.x, true), d2 = __builtin_amdgcn_cvt_pk_f32_fp8((int)hw.y, false), d3 = __builtin_amdgcn_cvt_pk_f32_fp8((int)hw.y, true);
            lw.x = pk4_fp8(x[0] - d0[0], x[1] - d0[1], x[2] - d1[0], x[3] - d1[1]); lw.y = pk4_fp8(x[4] - d2[0], x[5] - d2[1], x[6] - d3[0], x[7] - d3[1]); }
          *(v2u*)(p.ws + WS_QHI + (size_t)tok * 512 + lane * 8) = hw; *(v2u*)(p.ws + WS_QLO + (size_t)tok * 512 + lane * 8) = lw; }
        { float x[8]; float ss = 0.f;
#pragma unroll
          for (int i = 0; i < 4; ++i) { x[2 * i] = bflo(kv[n][i]); x[2 * i + 1] = bfhi(kv[n][i]); ss += x[2 * i] * x[2 * i] + x[2 * i + 1] * x[2 * i + 1]; }
          ss += __shfl_xor(ss, 1); ss += __shfl_xor(ss, 2); ss += __shfl_xor(ss, 4);
          const float rs = rsqrtf(ss * (1.f / 64.f) + RMS_EPS);
#pragma unroll
          for (int i = 0; i < 8; ++i) x[i] = x[i] * rs * kg[i];
          v2u o; o.x = pk4_fp8(x[0], x[1], x[2], x[3]); o.y = pk4_fp8(x[4], x[5], x[6], x[7]);
          if (lane < 16) *(v2u*)(p.ws + WS_K8 + (size_t)tok * 128 + lane * 8) = o; }
        { v2u o; o.x = pk4_fp8(bflo(vv[n][0]), bfhi(vv[n][0]), bflo(vv[n][1]), bfhi(vv[n][1])); o.y = pk4_fp8(bflo(vv[n][2]), bfhi(vv[n][2]), bflo(vv[n][3]), bfhi(vv[n][3]));
          if (lane < 16) *(v2u*)(p.ws + WS_V8 + (size_t)tok * 128 + lane * 8) = o; }
    }
}

typedef short v4i16_t __attribute__((ext_vector_type(4)));
__device__ __forceinline__ v4i16_t vtr16(const bf16* ldsp) { return __builtin_amdgcn_ds_read_tr16_b64_v4i16((LAS v4i16_t*)ldsp); }
typedef int v2i_t __attribute__((ext_vector_type(2)));
__device__ __forceinline__ long vtr8(const unsigned char* ldsp) { const v2i_t r = __builtin_amdgcn_ds_read_tr8_b64_v2i32((LAS v2i_t*)ldsp); return (long)(((unsigned long long)(unsigned)r[1] << 32) | (unsigned)r[0]); }
__device__ __forceinline__ void dsa2_query(const Params& p, unsigned char* ldsw, const unsigned short* sel, int b, int t, int lane) {
    unsigned char* ws = p.ws;
    const bf16* ATT = (const bf16*)(ws + WS_ATT);
    bf16* YB = (bf16*)(ws + WS_H);
    unsigned short* sl = (unsigned short*)ldsw;
    float* df = (float*)(ldsw + 512);
    unsigned char* Vl = ldsw + 1536;
    const unsigned char* V8 = ws + WS_V8;
    const int fr = lane & 15, fq = lane >> 4;
    const size_t rowb = (size_t)b * SEQ;
    const int cnt = (t + 1 < TOPK) ? (t + 1) : TOPK;
    { v2u sv = *(const v2u*)(sel + lane * 4);
      const int j0 = lane * 4;
      if (j0 >= cnt) sv.x = 0u; else if (j0 + 1 >= cnt) sv.x &= 0xffffu;
      if (j0 + 2 >= cnt) sv.y = 0u; else if (j0 + 3 >= cnt) sv.y &= 0xffffu;
      *(v2u*)(sl + lane * 4) = sv;
      f32x4 d4; d4[0] = (j0 < cnt) ? (float)(t - (int)(sv.x & 0xffffu)) : INFINITY; d4[1] = (j0 + 1 < cnt) ? (float)(t - (int)(sv.x >> 16)) : INFINITY;
      d4[2] = (j0 + 2 < cnt) ? (float)(t - (int)(sv.y & 0xffffu)) : INFINITY; d4[3] = (j0 + 3 < cnt) ? (float)(t - (int)(sv.y >> 16)) : INFINITY;
      *(f32x4*)(df + lane * 4) = d4; }
    LDS_WAIT(); __builtin_amdgcn_wave_barrier();
    const unsigned char* K8 = ws + WS_K8;
    long qhA[2] = {0, 0}, qhB[2] = {0, 0}, qlA[2] = {0, 0}, qlB[2] = {0, 0};
    if (fr < 8) { const v4u qh = *(const v4u*)(ws + WS_QHI + (rowb + t) * 512 + fr * 64 + fq * 16), ql = *(const v4u*)(ws + WS_QLO + (rowb + t) * 512 + fr * 64 + fq * 16);
        const long hA = (long)(((unsigned long long)qh.y << 32) | qh.x), hB = (long)(((unsigned long long)qh.w << 32) | qh.z), lA = (long)(((unsigned long long)ql.y << 32) | ql.x), lB = (long)(((unsigned long long)ql.w << 32) | ql.z);
        if (fr < 4) { qhA[0] = hA; qhB[0] = hB; qlA[0] = lA; qlB[0] = lB; } else { qhA[1] = hA; qhB[1] = hB; qlA[1] = lA; qlB[1] = lB; } }
    pg8::f32x4 sc[16];
    v4u vv[8];
    {
        v4u G[8];
        unsigned char* kst = Vl;
        const int ksw = ((lane & 7) ^ (lane >> 3)) & 7;
#define K_LOADS(STEP) do { _Pragma("unroll") for (int j = 0; j < 8; ++j) { const int s_ = sl[(STEP) * 64 + j * 8 + (lane >> 3)]; G[j] = *(const v4u*)(K8 + (rowb + s_) * 128 + ((ksw ^ (j & 1)) & 7) * 16); } } while (0)
        K_LOADS(0);
#pragma unroll
        for (int step = 0; step < 4; ++step) {
            LDS_WAIT(); __builtin_amdgcn_wave_barrier();
#pragma unroll
            for (int j = 0; j < 8; ++j) *(v4u*)(kst + j * 1024 + lane * 16) = G[j];
            __builtin_amdgcn_sched_barrier(0);
            if (step < 3) K_LOADS(step + 1);
            else {
#pragma unroll
                for (int j = 0; j < 8; ++j) { const int s = sl[j * 8 + (lane >> 3)]; vv[j] = *(const v4u*)(V8 + (rowb + s) * 128 + (lane & 7) * 16); } }
            __builtin_amdgcn_sched_barrier(0);
            LDS_WAIT(); __builtin_amdgcn_wave_barrier();
#pragma unroll
            for (int kt = 0; kt < 4; ++kt) { pg8::f32x4 a = {0.f, 0.f, 0.f, 0.f};
#pragma unroll
                for (int gg = 0; gg < 2; ++gg) { const v4u kv = *(const v4u*)(kst + (kt * 16 + fr) * 128 + (((gg * 4 + fq) ^ (fr & 7) ^ (fr >> 3)) & 7) * 16);
                    const long kA = (long)(((unsigned long long)kv.y << 32) | kv.x), kB = (long)(((unsigned long long)kv.w << 32) | kv.z);
                    a = __builtin_amdgcn_mfma_f32_16x16x32_fp8_fp8(kA, qhA[gg], a, 0, 0, 0); a = __builtin_amdgcn_mfma_f32_16x16x32_fp8_fp8(kB, qhB[gg], a, 0, 0, 0);
                    a = __builtin_amdgcn_mfma_f32_16x16x32_fp8_fp8(kA, qlA[gg], a, 0, 0, 0); a = __builtin_amdgcn_mfma_f32_16x16x32_fp8_fp8(kB, qlB[gg], a, 0, 0, 0); }
                sc[step * 4 + kt] = a; }
        }
#undef K_LOADS
    }
    const float slope = exp2f(-(float)((fr & 7) + 1)) * 1.4426950408889634f;
    float m = -INFINITY;
#pragma unroll
    for (int kt = 0; kt < 16; ++kt) { const f32x4 d4 = *(const f32x4*)(df + kt * 16 + fq * 4);
#pragma unroll
        for (int r = 0; r < 4; ++r) { const float x = sc[kt][r] - slope * d4[r]; sc[kt][r] = x; m = fmaxf(m, x); } }
    m = fmaxf(m, __shfl_xor(m, 16)); m = fmaxf(m, __shfl_xor(m, 32));
    float l = 0.f;
#pragma unroll
    for (int kt = 0; kt < 16; ++kt)
#pragma unroll
        for (int r = 0; r < 4; ++r) { const float e = __builtin_amdgcn_exp2f(sc[kt][r] - m); sc[kt][r] = e; l += e; }
    l += __shfl_xor(l, 16); l += __shfl_xor(l, 32);
    const float inv = 1.f / l;
    pg8::f32x4 o[2][4];
#pragma unroll
    for (int g2 = 0; g2 < 2; ++g2)
#pragma unroll
        for (int dt = 0; dt < 4; ++dt) o[g2][dt] = (pg8::f32x4){0.f, 0.f, 0.f, 0.f};
    unsigned char* vdst = Vl + ((lane & 7) >> 2) * 6400 + (lane >> 3) * 80 + (lane & 3) * 16;
#pragma unroll
    for (int ch = 0; ch < 4; ++ch) {
        LDS_WAIT(); __builtin_amdgcn_wave_barrier();
#pragma unroll
        for (int j = 0; j < 8; ++j) *(v4u*)(vdst + ((j >> 2) * 40 + ((j >> 1) & 1) * 24 + (j & 1) * 8) * 80) = vv[j];
        if (ch < 3) {
#pragma unroll
            for (int j = 0; j < 8; ++j) { const int s = sl[(ch + 1) * 64 + j * 8 + (lane >> 3)]; vv[j] = *(const v4u*)(V8 + (rowb + s) * 128 + (lane & 7) * 16); } }
        LDS_WAIT(); __builtin_amdgcn_wave_barrier();
#pragma unroll
        for (int k2 = 0; k2 < 2; ++k2) { const int kt0 = ch * 4 + 2 * k2;
            const long pb = (long)(((unsigned long long)pk4_fp8(sc[kt0 + 1][0], sc[kt0 + 1][1], sc[kt0 + 1][2], sc[kt0 + 1][3]) << 32) | pk4_fp8(sc[kt0][0], sc[kt0][1], sc[kt0][2], sc[kt0][3]));
            const int q = fr >> 1, prow = k2 * 40 + ((q < 4) ? (fq * 4 + q) : (24 + fq * 4 + (q - 4)));
#pragma unroll
            for (int g2 = 0; g2 < 2; ++g2)
#pragma unroll
                for (int dt = 0; dt < 4; ++dt) o[g2][dt] = __builtin_amdgcn_mfma_f32_16x16x32_fp8_fp8(vtr8(Vl + g2 * 6400 + prow * 80 + dt * 16 + (fr & 1) * 8), pb, o[g2][dt], 0, 0, 0); }
    }
    { const float i8 = inv * 8.f; unsigned char* yp = (unsigned char*)YB + (rowb + t) * 1024 + 512 + fr * 64 + fq * 4;
      if (fr < 4) {
#pragma unroll
          for (int dt = 0; dt < 4; ++dt) *(unsigned*)(yp + dt * 16) = pk4_fp8(o[0][dt][0] * i8, o[0][dt][1] * i8, o[0][dt][2] * i8, o[0][dt][3] * i8); }
      else if (fr < 8) {
#pragma unroll
          for (int dt = 0; dt < 4; ++dt) *(unsigned*)(yp + dt * 16) = pk4_fp8(o[1][dt][0] * i8, o[1][dt][1] * i8, o[1][dt][2] * i8, o[1][dt][3] * i8); } }
    LDS_WAIT(); __builtin_amdgcn_wave_barrier();
}

#define INS16(L, x) do { _Pragma("unroll") for (int _i = 15; _i >= 1; --_i) L[_i] = __builtin_amdgcn_fmed3f(L[_i - 1], L[_i], (x)); L[0] = fmaxf(L[0], (x)); } while (0)
__device__ __forceinline__ float f_andor(float v, unsigned keepmask, unsigned orv) { return __builtin_bit_cast(float, (__builtin_bit_cast(unsigned, v) & keepmask) | orv); }
__device__ __forceinline__ void peer_select(const Params& p, unsigned char* ldsw, int tg, int h, int lane, int* EIDX, float* GATES) {
    float* sc = (float*)ldsw;
    LDS_WAIT(); __builtin_amdgcn_wave_barrier();
    float L[16];
#pragma unroll
    for (int i = 0; i < 16; ++i) L[i] = -INFINITY;
    { const float* sp = sc + (lane & 31) * 132 + (lane >> 5) * 64;
#pragma unroll 4
      for (int i = 0; i < 16; ++i) { const f32x4 x = *(const f32x4*)(sp + 4 * i); INS16(L, x[0]); INS16(L, x[1]); INS16(L, x[2]); INS16(L, x[3]); } }
    { float O[16];
#pragma unroll
      for (int i = 0; i < 16; ++i) O[i] = __shfl_xor(L[i], 32);
#pragma unroll
      for (int i = 0; i < 16; ++i) INS16(L, O[i]); }
    LDS_WAIT(); __builtin_amdgcn_wave_barrier();
    float* lst = sc;
    if (lane < 32) {
#pragma unroll
        for (int i = 0; i < 4; ++i) *(f32x4*)(lst + lane * 16 + 4 * i) = (f32x4){L[4 * i], L[4 * i + 1], L[4 * i + 2], L[4 * i + 3]}; }
    LDS_WAIT(); __builtin_amdgcn_wave_barrier();
    const int tok = lane & 15;
    float s1[16], s2[16];
#pragma unroll
    for (int i = 0; i < 4; ++i) { const f32x4 a = *(const f32x4*)(lst + tok * 16 + 4 * i), b = *(const f32x4*)(lst + (16 + tok) * 16 + 4 * i);
#pragma unroll
        for (int c = 0; c < 4; ++c) { s1[4 * i + c] = f_andor(a[c], ~127u, 0u); s2[4 * i + c] = f_andor(b[c], ~127u, 0u); } }
    float M[16];
#pragma unroll
    for (int i = 0; i < 16; ++i) M[i] = -INFINITY;
#pragma unroll
    for (int a = 0; a < 16; ++a)
#pragma unroll
        for (int b = 0; b < 16; ++b)
            if ((a + 1) * (b + 1) <= 16) { const float key = f_andor(s1[a] + s2[b], ~255u, (unsigned)(a * 16 + b)); INS16(M, key); }
    const float mx = f_andor(M[0], ~255u, 0u);
    float e[16], sum = 0.f; int ei[16];
    const unsigned* lb = (const unsigned*)lst;
#pragma unroll
    for (int i = 0; i < 16; ++i) { const unsigned bits = __builtin_bit_cast(unsigned, M[i]); const int flat = bits & 255u;
        e[i] = __expf(f_andor(M[i], ~255u, 0u) - mx); sum += e[i];
        ei[i] = (int)(lb[tok * 16 + (flat >> 4)] & 127u) * 128 + (int)(lb[(16 + tok) * 16 + (flat & 15)] & 127u); }
    const float inv = 1.f / sum;
    if (lane < 16) {
        const size_t ob = ((size_t)tok * 8 + h) * 16;
#pragma unroll
        for (int i = 0; i < 4; ++i) { *(v4u*)(EIDX + ob + 4 * i) = (v4u){(unsigned)ei[4 * i], (unsigned)ei[4 * i + 1], (unsigned)ei[4 * i + 2], (unsigned)ei[4 * i + 3]};
            *(f32x4*)(GATES + ob + 4 * i) = (f32x4){e[4 * i] * inv, e[4 * i + 1] * inv, e[4 * i + 2] * inv, e[4 * i + 3] * inv}; }
    }
    LDS_WAIT(); __builtin_amdgcn_wave_barrier();
}

__device__ __forceinline__ void peer_route_block(const Params& p, unsigned char* lds, int* eG, float* gG) {
    const int tid = threadIdx.x, wave = tid >> 6, lane = tid & 63, fr = lane & 15, fq = lane >> 4, G = gridDim.x;
    unsigned char* ws = p.ws;
    const bf16* Q = (const bf16*)(ws + WS_Q);
    const unsigned char* SKb = ws + WS_SK;
    unsigned char* tile = lds + 8 * 16896;
    float* sc = (float*)(lds + wave * 16896);
    int ngrp = 0;
    for (int tg = blockIdx.x; tg < T / 16; tg += G) ++ngrp;
#pragma unroll 1
    for (int k0 = 0; k0 < ngrp; k0 += 8) {
        const bool valid = k0 + wave < ngrp;
        const int tg = (int)blockIdx.x + (valid ? k0 + wave : k0) * G;
        v4u t[4][2];
        bf16x8 An[2][4];
#pragma unroll
        for (int sub = 0; sub < 4; ++sub) { const unsigned char* sp = SKb + (size_t)sub * 16384 + tid * 32; t[sub][0] = *(const v4u*)sp; t[sub][1] = *(const v4u*)(sp + 16); }
#pragma unroll
        for (int pp = 0; pp < 2; ++pp) { const bf16* rp = Q + (size_t)(tg * 16 + fr) * 2048 + pp * 128 + fq * 8;
#pragma unroll
            for (int ks = 0; ks < 4; ++ks) An[pp][ks] = *(const bf16x8*)(rp + ks * 32); }
#pragma unroll 1
        for (int h = 0; h < 8; ++h) {
            bf16x8 Af[2][4];
#pragma unroll
            for (int pp = 0; pp < 2; ++pp)
#pragma unroll
                for (int ks = 0; ks < 4; ++ks) Af[pp][ks] = An[pp][ks];
            const int hn = (h + 1) & 7;
#pragma unroll
            for (int sub = 0; sub < 4; ++sub) {
                const int pp = sub >> 1, half = sub & 1;
                __syncthreads();
                { unsigned char* wp = tile + (tid >> 3) * 272 + (tid & 7) * 32; *(v4u*)wp = t[sub][0]; *(v4u*)(wp + 16) = t[sub][1]; }
                { const unsigned char* sp = SKb + (size_t)(hn * 4 + sub) * 16384 + tid * 32; t[sub][0] = *(const v4u*)sp; t[sub][1] = *(const v4u*)(sp + 16); }
                __syncthreads();
#pragma unroll
                for (int kt = 0; kt < 4; ++kt) {
                    pg8::f32x4 a = {0.f, 0.f, 0.f, 0.f};
#pragma unroll
                    for (int ks = 0; ks < 4; ++ks) { const bf16x8 bv = *(const bf16x8*)(tile + (kt * 16 + fr) * 272 + ks * 64 + fq * 16); a = __builtin_amdgcn_mfma_f32_16x16x32_bf16(Af[pp][ks], bv, a, 0, 0, 0); }
                    const int kg = (half * 4 + kt) * 16 + fr;
#pragma unroll
                    for (int r = 0; r < 4; ++r) sc[(pp * 16 + fq * 4 + r) * 132 + kg] = f_andor(a[r], ~127u, (unsigned)kg);
                }
            }
#pragma unroll
            for (int pp = 0; pp < 2; ++pp) { const bf16* rp = Q + (size_t)(tg * 16 + fr) * 2048 + hn * 256 + pp * 128 + fq * 8;
#pragma unroll
                for (int ks = 0; ks < 4; ++ks) An[pp][ks] = *(const bf16x8*)(rp + ks * 32); }
            if (valid) peer_select(p, (unsigned char*)sc, tg, h, lane, eG + (size_t)tg * 2048, gG + (size_t)tg * 2048);
        }
    }
}

__device__ __forceinline__ float gelu_erf(float x) { return 0.5f * x * (1.f + erff(x * 0.70710678118654752f)); }
typedef int v8i_t __attribute__((ext_vector_type(8)));
template <int OPSEL> __device__ __forceinline__ pg8::f32x4 mx_dot(v8i_t a, int sa, v8i_t b, int sb, pg8::f32x4 c) {
    return __builtin_amdgcn_mfma_scale_f32_16x16x128_f8f6f4(a, b, c, 4  , 4  , OPSEL, sa, OPSEL, sb);
}
template <int MODE>
__device__ __forceinline__ void peer_token(const Params& p, unsigned char* ldsw, const _Float16* usL, const _Float16* vsL, unsigned char* tile, int tok, int lane, const v2u nxt_e, const v2u nxt_g, int buf) {
    unsigned char* ws = p.ws;
    const unsigned char* V8 = ws + WS_V;
    const float* MOD = (const float*)(ws + WS_MOD);
    const int fr = lane & 15, fq = lane >> 4;
    typedef v8i_t v8i;
    const int* EIDX = (const int*)(ldsw + buf * 1024); const float* GATES = (const float*)(ldsw + buf * 1024 + 512);
    int* pe = (int*)(ldsw + buf * 1024); float* pa = (float*)(ldsw + buf * 1024 + 512);
    if (MODE == 1) {
    float* gGp = (float*)(ws + WS_PGATE) + (size_t)tok * 128;
    v4u A4[H4_NT][8]; v2u As[H4_NT];
#pragma unroll
    for (int t = 0; t < H4_NT; ++t) { const unsigned char* hp = ws + WS_H4D + ((size_t)tok * H4_NT + t) * 512 + fq * 16;
        As[t] = *(const v2u*)(ws + WS_H4S + ((size_t)tok * H4_NT + t) * 32 + fq * 8);
#pragma unroll
        for (int kk = 0; kk < 8; ++kk) A4[t][kk] = *(const v4u*)(hp + kk * 64); }
    const unsigned char* U4 = ws + WS_U;
    const int gr = lane >> 3, gs = lane & 7;
    const int rdbase = (fr >> 3) * 1024 + (fr & 7) * 128, slotA = (fq ^ (fr & 7) ^ (fr >> 3)) & 7;
    v4u G[8];
#define U_LOADS(CT) do { const int e0_ = EIDX[(CT) * 16 + gr], e1_ = EIDX[(CT) * 16 + 8 + gr]; \
        const unsigned char* p0_ = U4 + (size_t)e0_ * 512 + ((gs ^ gr) & 7) * 16; const unsigned char* p1_ = U4 + (size_t)e1_ * 512 + ((gs ^ gr ^ 1) & 7) * 16; \
        _Pragma("unroll") for (int kk = 0; kk < 8; ++kk) G[kk] = *(const v4u*)(((kk & 1) ? p1_ : p0_) + (kk >> 1) * 128); } while (0)
    U_LOADS(0);
#pragma unroll 1
    for (int ct = 0; ct < 8; ++ct) {
        const int eic = EIDX[ct * 16 + fr]; const float gt = GATES[ct * 16 + fr];
#pragma unroll
        for (int kk = 0; kk < 8; ++kk) *(v4u*)(tile + kk * 1024 + lane * 16) = G[kk];
        __builtin_amdgcn_sched_barrier(0);
        U_LOADS((ct + 1) & 7);
        __builtin_amdgcn_sched_barrier(0);
        LDS_WAIT(); __builtin_amdgcn_wave_barrier();
        v4u Bt[8];
#pragma unroll
        for (int j = 0; j < 8; ++j) Bt[j] = *(const v4u*)(tile + (j >> 1) * 2048 + rdbase + (((j & 1) ? (slotA ^ 4) : slotA) * 16));
        LDS_WAIT(); __builtin_amdgcn_wave_barrier();
        pg8::f32x4 ah = {0.f, 0.f, 0.f, 0.f};
#pragma unroll
        for (int kk = 0; kk < 8; ++kk) { const v4u bu = Bt[kk];
            const v8i bb = {(int)bu.x, (int)bu.y, (int)bu.z, (int)bu.w, 0, 0, 0, 0};
            const int sb = 0x7f7f7f7f;
#pragma unroll
            for (int t = 0; t < H4_NT; ++t) { const v8i aa = {(int)A4[t][kk].x, (int)A4[t][kk].y, (int)A4[t][kk].z, (int)A4[t][kk].w, 0, 0, 0, 0}; const int sa = (int)((kk < 4) ? As[t].x : As[t].y);
                if ((kk & 3) == 0) ah = mx_dot<0>(aa, sa, bb, sb, ah); else if ((kk & 3) == 1) ah = mx_dot<1>(aa, sa, bb, sb, ah); else if ((kk & 3) == 2) ah = mx_dot<2>(aa, sa, bb, sb, ah); else ah = mx_dot<3>(aa, sa, bb, sb, ah); } }
        const float dot = ah[0] * (float)usL[eic];
        if (fq == 0) gGp[ct * 16 + fr] = gelu_erf(dot) * gt * (float)vsL[eic];
    }
    asm volatile("" :: "v"(G[0]), "v"(G[1]), "v"(G[2]), "v"(G[3]), "v"(G[4]), "v"(G[5]), "v"(G[6]), "v"(G[7]));
#undef U_LOADS
    }
    __builtin_amdgcn_sched_barrier(0);
    { int* ne = (int*)(ldsw + (buf ^ 1) * 1024); float* ng = (float*)(ldsw + (buf ^ 1) * 1024 + 512);
      *(v2u*)(ne + 2 * lane) = nxt_e; *(v2u*)(ng + 2 * lane) = nxt_g; }
    if (MODE == 1) { LDS_WAIT(); __builtin_amdgcn_wave_barrier(); return; }
    const int hl = lane >> 5, bl = lane & 31;
    float acc[32];
#pragma unroll
    for (int i = 0; i < 32; ++i) acc[i] = 0.f;
    LDS_WAIT(); __builtin_amdgcn_wave_barrier();
#pragma unroll 1
    for (int ct = 0; ct < 16; ++ct)
#pragma unroll
        for (int jp = 0; jp < 4; ++jp) {
            const int idx = pe[ct * 8 + 2 * jp + hl]; const float as = pa[ct * 8 + 2 * jp + hl];
            const v4u vv = *(const v4u*)(V8 + (size_t)idx * 512 + bl * 16);
#pragma unroll
            for (int w4 = 0; w4 < 4; ++w4) { const unsigned wd = vv[w4];
                const f32x2 d0 = __builtin_amdgcn_cvt_scalef32_pk_f32_fp4(wd, 1.0f, 0), d1 = __builtin_amdgcn_cvt_scalef32_pk_f32_fp4(wd, 1.0f, 1), d2 = __builtin_amdgcn_cvt_scalef32_pk_f32_fp4(wd, 1.0f, 2), d3 = __builtin_amdgcn_cvt_scalef32_pk_f32_fp4(wd, 1.0f, 3);
                acc[8 * w4] += as * d0[0]; acc[8 * w4 + 1] += as * d0[1]; acc[8 * w4 + 2] += as * d1[0]; acc[8 * w4 + 3] += as * d1[1];
                acc[8 * w4 + 4] += as * d2[0]; acc[8 * w4 + 5] += as * d2[1]; acc[8 * w4 + 6] += as * d3[0]; acc[8 * w4 + 7] += as * d3[1]; }
        }
    LDS_WAIT(); __builtin_amdgcn_wave_barrier();
    float accs[16];
#pragma unroll
    for (int i = 0; i < 16; ++i) { const float lo = acc[i] + __shfl_xor(acc[i], 32), hi2 = acc[16 + i] + __shfl_xor(acc[16 + i], 32); accs[i] = hl ? hi2 : lo; }
    const int b = tok / SEQ;
    const int col0 = bl * 32 + hl * 16;
    const float* g2 = MOD + (size_t)b * 6144 + 5 * 1024 + col0;
    float* orow = p.out + (size_t)tok * DM + col0;
#pragma unroll
    for (int q4 = 0; q4 < 4; ++q4) { const f32x4 xv = *(const f32x4*)(orow + 4 * q4), gv = *(const f32x4*)(g2 + 4 * q4);
        f32x4 o;
#pragma unroll
        for (int i = 0; i < 4; ++i) o[i] = xv[i] + gv[i] * accs[4 * q4 + i];
        *(f32x4*)(orow + 4 * q4) = o; }
}

#define XB_TMO      128
#define XB_XCNT(j)  (256  + 64 * (j))
#define XB_XSUB(j)  (1280 + 64 * (j))
#define XB_XGEN(j)  (2304 + 64 * (j))
#define XB_TOP      3328
#define XB_TOPGEN   3392
#define XCD_BAR_WORDS 3456
#define XB_SPIN_CAP (1u << 18)

__device__ __forceinline__ unsigned xb_ld(unsigned* p)              { return __hip_atomic_load(p, __ATOMIC_RELAXED, __HIP_MEMORY_SCOPE_AGENT); }
__device__ __forceinline__ unsigned xb_add(unsigned* p, unsigned v) { return __hip_atomic_fetch_add(p, v, __ATOMIC_RELAXED, __HIP_MEMORY_SCOPE_AGENT); }
__device__ __forceinline__ unsigned xb_xcc_id() { return (unsigned)__builtin_amdgcn_s_getreg((3 << 11) | 20) & 0xFu; }
#define XB_SPIN(cond, bar) do { unsigned _sp = 0; while (cond) { __builtin_amdgcn_s_sleep(1); \
    if ((++_sp & 255u) == 0u) { if (xb_ld(&(bar)[XB_TMO])) break; if (_sp > XB_SPIN_CAP) { atomicAdd(&(bar)[XB_TMO], 1u); break; } } } } while (0)

struct XcdBarrier {
    unsigned* bar; unsigned x;
    volatile LAS unsigned* st;
};

__device__ __forceinline__ XcdBarrier xcd_barrier_post(unsigned* bar, volatile LAS unsigned* st) {
    XcdBarrier b; b.bar = bar; b.x = xb_xcc_id(); b.st = st;
    if (threadIdx.x == 0) (void)xb_add(&bar[XB_XCNT(b.x)], 1u);
    return b;
}
__device__ __forceinline__ void xcd_barrier_complete(unsigned* bar, unsigned x, unsigned& nloc, unsigned& nx) {
    const unsigned G = gridDim.x * gridDim.y * gridDim.z;
    unsigned sum, cnt, mine, sp = 0u;
    for (;;) {
        sum = 0u; cnt = 0u; mine = 0u;
#pragma unroll
        for (unsigned j = 0; j < 16; ++j) { const unsigned c = xb_ld(&bar[XB_XCNT(j)]); sum += c; cnt += (c > 0u) ? 1u : 0u; mine = (j == x) ? c : mine; }
        if (sum == G) break;
        __builtin_amdgcn_s_sleep(1);
        if ((++sp & 255u) == 0u) { if (xb_ld(&bar[XB_TMO])) break; if (sp > XB_SPIN_CAP) { atomicAdd(&bar[XB_TMO], 1u); break; } }
    }
    nloc = mine > 0u ? mine : 1u; nx = cnt > 0u ? cnt : 1u;
}

__device__ __forceinline__ void xcd_barrier(const XcdBarrier& b) {
    asm volatile("s_waitcnt vmcnt(0)" ::: "memory");
    __syncthreads();
    if (threadIdx.x == 0) {
        unsigned* bar = b.bar;
        __builtin_amdgcn_s_waitcnt(0);
        unsigned nloc = b.st[0], nx = b.st[1];
        if (nloc == 0u) { xcd_barrier_complete(bar, b.x, nloc, nx); b.st[0] = nloc; b.st[1] = nx; }
        const unsigned old = xb_add(&bar[XB_XSUB(b.x)], 1u);
        const unsigned gen = old / nloc;
        if (old + 1u == (gen + 1u) * nloc) {
            __builtin_amdgcn_fence(__ATOMIC_RELEASE, "agent");
            asm volatile("s_waitcnt vmcnt(0)" ::: "memory");
            const unsigned og = xb_add(&bar[XB_TOP], 1u);
            const unsigned tg = og / nx;
            if (og + 1u == (tg + 1u) * nx) xb_add(&bar[XB_TOPGEN], 1u);
            else XB_SPIN(xb_ld(&bar[XB_TOPGEN]) == tg, bar);
            __builtin_amdgcn_fence(__ATOMIC_ACQUIRE, "agent");
            xb_add(&bar[XB_XGEN(b.x)], 1u);
            asm volatile("s_waitcnt vmcnt(0)" ::: "memory");
        } else {
            XB_SPIN(xb_ld(&bar[XB_XGEN(b.x)]) == gen, bar);
            __builtin_amdgcn_fence(__ATOMIC_ACQUIRE, "agent");
            asm volatile("s_waitcnt vmcnt(0)" ::: "memory");
        }
    }
    __syncthreads();
}

constexpr int NPHASE = 11;
__global__ void __launch_bounds__(NTHREADS, 2) mega(Params p) {
    extern __shared__ __attribute__((aligned(16))) unsigned char lds[];
    cg::grid_group grid = cg::this_grid();
    const int lo = p.ph_lo, hi = p.ph_hi;
    const int tid = threadIdx.x, wave = tid >> 6, lane = tid & 63, G = gridDim.x;
    unsigned char* ws = p.ws;
#ifndef ONLYPH
#define IN(k) (lo <= (k) && (k) < hi)
#else
#define IN(k) ((k) == ONLYPH && lo <= (k) && (k) < hi)
#endif
    volatile LAS unsigned* xb_st = (volatile LAS unsigned*)((LAS unsigned char*)lds + (LDS_BYTES - 16));
    if (tid < 4) xb_st[tid] = 0u;
    __syncthreads();
    XcdBarrier xbar; xbar.bar = (unsigned*)(ws + WS_CTL); xbar.x = 0; xbar.st = xb_st;
    if (hi - lo > 1) xbar = xcd_barrier_post((unsigned*)(ws + WS_CTL), xb_st);
    if (lo < -1) grid.sync();
#define SEAM(k) do { if (IN((k) + 1)) xcd_barrier(xbar); } while (0)
#ifndef REPMASK
#define REPMASK 0
#endif
#define NREP(k) (((REPMASK >> (k)) & 1) ? 2 : 1)
    if (IN(0)) { for (int rep = 0; rep < NREP(0); ++rep) phase0(p, lds); SEAM(0); }
    if (IN(1)) { for (int rep = 0; rep < NREP(1); ++rep) normmod_phase<true>(p, lds, p.x, (bf16*)(ws + WS_H), p.norm1_g, 0, 1024); SEAM(1); }
    if (IN(2)) {
        { pg8::Gemm g{(const bf16*)(ws + WS_H8), (const bf16*)(ws + WS_WIN8), T, 3584, 512, 512, 512}; pg8::StaticOrder S; S.init(T, 3584, G, (int)blockIdx.x);
          EpiProj E{(bf16*)(ws + WS_HG), (bf16*)(ws + WS_ATT), (bf16*)(ws + WS_IDX), (bf16*)(ws + WS_GATE), 1};
          pg8::gemm_phase<EpiProj, pg8::StaticOrder, true, true, 122>((PG8_LAS unsigned char*)lds, g, S, E); }
        { pg8::Gemm g{(const bf16*)(ws + WS_H), (const bf16*)(ws + WS_WIN), T, 2048, 1024, 1024, 1024}; pg8::StaticOrder S; S.init(T, 2048, G, (int)blockIdx.x);
          EpiProj E{(bf16*)(ws + WS_HG), (bf16*)(ws + WS_ATT), (bf16*)(ws + WS_IDX), (bf16*)(ws + WS_GATE), 0};
          pg8::gemm_phase<EpiProj, pg8::StaticOrder, true, true>((PG8_LAS unsigned char*)lds, g, S, E); }
        SEAM(2);
    }
    if (IN(3)) {
        { float qg[8], kg[8];
#pragma unroll
          for (int i = 0; i < 8; ++i) { qg[i] = p.q_norm_g[(lane & 7) * 8 + i]; kg[i] = p.k_norm_g[(lane & 7) * 8 + i]; }
          int tok = (int)blockIdx.x * NWAVES + wave; const int st = G * NWAVES;
          for (; tok + 3 * st < T; tok += 4 * st) { const int tk[4] = {tok, tok + st, tok + 2 * st, tok + 3 * st}; qknorm_tokens<4>(p, tk, lane, qg, kg); }
          for (; tok < T; tok += st) { const int tk[1] = {tok}; qknorm_tokens<1>(p, tk, lane, qg, kg); } }
        SEAM(3);
    }
    if (IN(4)) {
        if ((int)blockIdx.x < 32) hgrn_item<0>(p, lds, (int)blockIdx.x); else if ((int)blockIdx.x < 64) hgrn_item<1>(p, lds, (int)blockIdx.x - 32);
        {
            unsigned* qctr = (unsigned*)(ws + WS_CTL + 32768);
            volatile LAS unsigned* qslot = (volatile LAS unsigned*)((LAS unsigned char*)lds + (LDS_BYTES - 32));
            int qsel = (int)(blockIdx.x & 7u), tried = 0;
            for (;;) {
                if (tid == 0) { unsigned c;
                    for (;;) { c = __hip_atomic_fetch_add(qctr + qsel * 64, 1u, __ATOMIC_RELAXED, __HIP_MEMORY_SCOPE_AGENT); if (c < (unsigned)(SEQ / 16) || tried >= 7) break; qsel = (qsel + 1) & 7; ++tried; }
                    *qslot = (c < (unsigned)(SEQ / 16)) ? (((unsigned)qsel << 16) | c) : 0xffffffffu; }
                __syncthreads();
                const unsigned c = *qslot;
                __syncthreads();
                if (c == 0xffffffffu) break;
                const int b = (int)(c >> 16), qblk = (SEQ / 16 - 1) - (int)(c & 0xffffu), it = b * (SEQ / 16) + qblk, q0 = qblk * 16;
                dsa1_item(p, lds, it);
#pragma unroll 1
                for (int k2 = 0; k2 < 2; ++k2) dsa2_query(p, lds + wave * 16384, (const unsigned short*)(lds + 131072 + (wave + 8 * k2) * 1024), b, q0 + wave + 8 * k2, lane);
                __syncthreads();
            }
        }
        if (hi - lo > 1) xcd_barrier(xbar);
        for (int wu = (int)blockIdx.x * NWAVES + wave; wu < 32 * 32 * 4; wu += G * NWAVES) { const int u = wu >> 2; hgrn_fix(p, u >> 5, u & 31, wu & 3, lane); }
        SEAM(4);
    }
    if (IN(5)) {
        pg8::Gemm g{(const bf16*)(ws + WS_H), (const bf16*)(ws + WS_WAB8), T, 1024, 256, 512, 512}; pg8::StaticOrderT<true> S; S.init(T, 1024, G, (int)blockIdx.x, 256);
        EpiMerged E{(const bf16*)(ws + WS_GATE), (bf16*)(ws + WS_MERGED)};
        for (int rep = 0; rep < NREP(5); ++rep) pg8::gemm_phase<EpiMerged, pg8::StaticOrderT<true>, true, true, 122>((PG8_LAS unsigned char*)lds, g, S, E);
        SEAM(5);
    }
    if (IN(6)) {
        pg8::Gemm g{(const bf16*)(ws + WS_MERGED), (const bf16*)(ws + WS_WOUT8), T, 1024, 512, 512, 512}; pg8::StaticOrder S; S.init(T, 1024, G, (int)blockIdx.x);
        EpiResid E{p.x, (const float*)(ws + WS_MOD) + 2048, p.out};
        for (int rep = 0; rep < NREP(6); ++rep) pg8::gemm_phase<EpiResid, pg8::StaticOrder, true, true, 120>((PG8_LAS unsigned char*)lds, g, S, E);
        SEAM(6);
    }
    if (IN(7)) { for (int rep = 0; rep < NREP(7); ++rep) normmod_phase<false>(p, lds, p.out, (bf16*)(ws + WS_H), p.norm2_g, 3 * 1024, 4 * 1024); SEAM(7); }
    if (IN(8)) {
        pg8::Gemm g{(const bf16*)(ws + WS_H), (const bf16*)(ws + WS_WQ), T, 2048, 1024, 1024, 1024}; pg8::StaticOrder S; S.init(T, 2048, G, (int)blockIdx.x);
        EpiStore E{(bf16*)(ws + WS_Q), 2048};
        for (int rep = 0; rep < NREP(8); ++rep) pg8::gemm_phase<EpiStore, pg8::StaticOrder, true, true>((PG8_LAS unsigned char*)lds, g, S, E);
        SEAM(8);
    }
    if (IN(9)) {
        int* eG = (int*)(ws + WS_EIDX); float* gG = (float*)(ws + WS_PGATE);
        peer_route_block(p, lds, eG, gG);
        asm volatile("s_waitcnt vmcnt(0)" ::: "memory");
        __syncthreads();
        _Float16* usL = (_Float16*)lds; _Float16* vsL = (_Float16*)(lds + 32768);
        for (int i = tid; i < NEXP / 8; i += NTHREADS) { ((v4u*)usL)[i] = ((const v4u*)(ws + WS_US))[i]; ((v4u*)vsL)[i] = ((const v4u*)(ws + WS_VS))[i]; }
        unsigned char* ldsw = lds + 65536 + wave * 3072;
        int ntok = 0;
        for (int tg = blockIdx.x; tg < T / 16; tg += G) ntok += 2;
        auto tok_of = [&](int j) { return ((int)blockIdx.x + (j >> 1) * G) * 16 + wave + 8 * (j & 1); };
        auto ld_lists = [&](int tok, v2u& e, v2u& g) {
            const unsigned* ep = (const unsigned*)(eG + (size_t)tok * 128 + 2 * lane); const unsigned* gp = (const unsigned*)(gG + (size_t)tok * 128 + 2 * lane);
            e.x = __hip_atomic_load(ep, __ATOMIC_RELAXED, __HIP_MEMORY_SCOPE_AGENT); e.y = __hip_atomic_load(ep + 1, __ATOMIC_RELAXED, __HIP_MEMORY_SCOPE_AGENT);
            g.x = __hip_atomic_load(gp, __ATOMIC_RELAXED, __HIP_MEMORY_SCOPE_AGENT); g.y = __hip_atomic_load(gp + 1, __ATOMIC_RELAXED, __HIP_MEMORY_SCOPE_AGENT); };
        if (ntok > 0) { v2u e0, g0; ld_lists(tok_of(0), e0, g0); *(v2u*)((int*)ldsw + 2 * lane) = e0; *(v2u*)((float*)(ldsw + 512) + 2 * lane) = g0; }
        __syncthreads();
#pragma unroll 1
        for (int j = 0; j < ntok; ++j) {
            v2u ne = {0u, 0u}, ng = {0u, 0u};
            if (j + 1 < ntok) ld_lists(tok_of(j + 1), ne, ng);
            peer_token<1>(p, ldsw, usL, vsL, lds + 90112 + wave * 8192, tok_of(j), lane, ne, ng, j & 1);
        }
        asm volatile("s_waitcnt vmcnt(0)" ::: "memory");
        __syncthreads();
        if (ntok > 0) { v2u e0, g0; ld_lists(tok_of(0), e0, g0); *(v2u*)((int*)ldsw + 2 * lane) = e0; *(v2u*)((float*)(ldsw + 512) + 2 * lane) = g0; }
        LDS_WAIT(); __builtin_amdgcn_wave_barrier();
#pragma unroll 1
        for (int j = 0; j < ntok; ++j) {
            v2u ne = {0u, 0u}, ng = {0u, 0u};
            if (j + 1 < ntok) ld_lists(tok_of(j + 1), ne, ng);
            peer_token<2>(p, ldsw, usL, vsL, lds + 90112 + wave * 8192, tok_of(j), lane, ne, ng, j & 1);
            LDS_WAIT(); __builtin_amdgcn_wave_barrier();
        }
    }
#undef IN
#undef SEAM
}

#ifndef ONE_LAUNCH
#define ONE_LAUNCH 1
#endif
extern "C" void kernel_launch(void* const* d_in, const int* in_sizes, int n_in, void* d_out, int out_size, void* d_ws, size_t ws_size, hipStream_t stream) {
    static int grid = 0;
    if (grid == 0) {
        if (n_in != 18 || out_size != T * DM || ws_size < WS_END) { fprintf(stderr, "kernel_launch: unexpected shapes (n_in %d, out %d, ws %zu)\n", n_in, out_size, ws_size); grid = -1; return; }
        int dev = 0, cus = 0, per_cu = 0;
        if (hipGetDevice(&dev) != hipSuccess || hipDeviceGetAttribute(&cus, hipDeviceAttributeMultiprocessorCount, dev) != hipSuccess) { grid = -1; return; }
        if (hipFuncSetAttribute((const void*)mega, hipFuncAttributeMaxDynamicSharedMemorySize, LDS_BYTES) != hipSuccess) { fprintf(stderr, "kernel_launch: hipFuncSetAttribute failed\n"); grid = -1; return; }
        if (hipOccupancyMaxActiveBlocksPerMultiprocessor(&per_cu, (const void*)mega, NTHREADS, LDS_BYTES) != hipSuccess || per_cu < 1) { fprintf(stderr, "kernel_launch: occupancy query says %d\n", per_cu); grid = -1; return; }
        (void)hipGetLastError();
        grid = cus;
        if (grid < 64) { grid = -1; return; }
    }
    if (grid < 0) return;
    Params p{};
    const float** pp = (const float**)&p;
    for (int i = 0; i < 18; ++i) pp[i] = (const float*)d_in[i];
    p.out = (float*)d_out; p.ws = (unsigned char*)d_ws;
#if ONE_LAUNCH
    if (hipMemsetAsync((char*)d_ws + WS_CTL, 0, 65536, stream) != hipSuccess) { fprintf(stderr, "kernel_launch: memset failed\n"); return; }
    p.ph_lo = 0; p.ph_hi = NPHASE;
    void* args[] = {&p};
    hipError_t e = hipLaunchCooperativeKernel((const void*)mega, dim3(grid), dim3(NTHREADS), args, LDS_BYTES, stream);
    if (e != hipSuccess) fprintf(stderr, "cooperative launch failed: %s (grid %d)\n", hipGetErrorString(e), grid);
#else
    for (int k = 0; k < NPHASE; ++k) { p.ph_lo = k; p.ph_hi = k + 1; hipLaunchKernelGGL(mega, dim3(grid), dim3(NTHREADS), LDS_BYTES, stream, p); }
#endif
}
```

```cpp
#include <hip/hip_runtime.h>
#include <hip/hip_cooperative_groups.h>
#include <cstdio>
#include <cstdint>
namespace cg = cooperative_groups;

namespace pg8 {
#define PG8_LAS __attribute__((address_space(3)))
typedef unsigned short bf16_t;
typedef short bf16x8 __attribute__((ext_vector_type(8)));
typedef float f32x4 __attribute__((ext_vector_type(4)));
typedef unsigned u32x4 __attribute__((ext_vector_type(4)));
constexpr int BM = 256, BK = 64, HALF = 128, HTB = HALF * BK * 2  , STAGE_BYTES = 8 * HTB, NXCD = 8, WGM = 8;

__host__ __device__ __forceinline__ int lds_byte(int r, int c) { const int st = (r >> 4) * 2 + (c >> 5), rr = r & 15, cc = c & 31, ob = rr * 64 + cc * 2; return st * 1024 + (ob ^ (((ob >> 9) & 1) << 5)); }
__host__ __device__ __forceinline__ void stage_rc(int b, int& R, int& C) { const int st = b / 1024, sb = b % 1024, swz = sb ^ (((sb >> 9) & 1) << 5); R = (st >> 1) * 16 + swz / 64; C = (st & 1) * 32 + (swz % 64) / 2; }
__host__ __device__ __forceinline__ int perm32(int rho) { const int n = rho >> 4, i = rho & 15; return 8 * (i >> 2) + 4 * n + (i & 3); }

struct Unit { int pm, pn, ko, pass; };
struct Gemm { const bf16_t* A; const bf16_t* Bt; int M, N, K, lda, ldb; };
typedef float f32x16 __attribute__((ext_vector_type(16)));
typedef f32x16 AccW[2][2][2];
__device__ __forceinline__ f32x4 acc_get(const AccW& A, int ai, int bj, int m, int n) { const int s_ = ((m & 1) * 2 + n) * 4; const f32x16& w = A[ai][bj][m >> 1]; return (f32x4){w[s_], w[s_ + 1], w[s_ + 2], w[s_ + 3]}; }
__device__ __forceinline__ void acc_set(AccW& A, int ai, int bj, int m, int n, f32x4 v) { const int s_ = ((m & 1) * 2 + n) * 4; f32x16& w = A[ai][bj][m >> 1]; w[s_] = v[0]; w[s_ + 1] = v[1]; w[s_ + 2] = v[2]; w[s_ + 3] = v[3]; }

template <bool TWOPASS_ORDER = false>
struct StaticOrderT {
    int nM, nN, nwg, G, c, kpass;
    __host__ __device__ void init(int M, int N, int G_, int c_, int kpass_ = 512) { nM = M / BM; nN = N / BM; nwg = nM * nN; G = G_; c = c_; kpass = kpass_; }
    __host__ __device__ bool next(int i, Unit& u) const {
        const long L = (long)(TWOPASS_ORDER ? (i >> 1) : i) * G + c; if (L >= nwg) return false;
        u.pass = TWOPASS_ORDER ? (i & 1) : 0; u.ko = TWOPASS_ORDER ? (i & 1) * kpass : 0;
        int wgid = (int)L; { const int q = nwg / NXCD, r = nwg % NXCD, xcd = wgid % NXCD, off = wgid / NXCD; wgid = (xcd < r ? xcd * (q + 1) : r * (q + 1) + (xcd - r) * q) + off; }
        const int nig = WGM * nN, gid = wgid / nig, fm = gid * WGM, gsz = (nM - fm) < WGM ? (nM - fm) : WGM;
        u.pm = fm + ((wgid % nig) % gsz); u.pn = (wgid % nig) / gsz; return true;
    }
    __device__ __forceinline__ void a_ready(const Unit&) const {}
    __device__ __forceinline__ void done(const Unit&) const {}
};
typedef StaticOrderT<false> StaticOrder;

__device__ __forceinline__ unsigned cvt_pk_bf16(float lo, float hi) { unsigned r; asm volatile("v_cvt_pk_bf16_f32 %0, %1, %2" : "=v"(r) : "v"(lo), "v"(hi)); return r; }

template <class Epi, class Sched, bool ALIGN_EPI = false, bool SP2 = false, int F8SCALE = 0>
__device__ __forceinline__ void gemm_phase(PG8_LAS unsigned char* lds, const Gemm g, const Sched& S, const Epi& E) {
    const int tid = threadIdx.x, wid = __builtin_amdgcn_readfirstlane(tid >> 6), lane = tid & 63, wr = wid >> 2, wc = wid & 3, fr = lane & 15, fq = lane >> 4;
    const int K = g.K, nt = K / BK;
    unsigned voffA[2], voffB[2];
#pragma unroll
    for (int i = 0; i < 2; ++i) { int R, C; stage_rc(tid * 16 + i * 8192, R, C); const int Rb = Epi::PERM ? ((R & ~31) + perm32(R & 31)) : R;
        voffA[i] = (unsigned)(R * g.lda + C) * 2u; voffB[i] = (unsigned)(Rb * g.ldb + C) * 2u; }
    const size_t kstep = (size_t)(BK * 2);
    const size_t hstepA = (size_t)HALF * g.lda * 2, hstepB = (size_t)HALF * g.ldb * 2;
    const size_t tstepA = 2 * hstepA, tstepB = 2 * hstepB;
    const unsigned ldsw = (unsigned)wid * 1024u;
    const int aoff = lds_byte(wr * 64 + fr, fq * 8), boff = lds_byte(wc * 32 + fr, fq * 8);
#define PG8_SA(b, h) (((b) * 2 + (h)) * HTB)
#define PG8_SB(b, h) ((4 + (b) * 2 + (h)) * HTB)
#define PG8_STAGE(bufoff, gbase, voff) do { _Pragma("unroll") for (int _i = 0; _i < 2; ++_i) \
        __builtin_amdgcn_global_load_lds((const unsigned*)((const char*)(gbase) + (voff)[_i]), (PG8_LAS unsigned*)(lds + (bufoff) + ldsw + _i * 8192), 16, 0, 0); } while (0)
#define PG8_LDA(dst, b, h) do { _Pragma("unroll") for (int m = 0; m < 4; ++m) { if constexpr (F8SCALE != 0) { \
        PG8_F8(dst)[m].lo = *(const PG8_LAS v4i_f*)(lds + PG8_SA(b, h) + aoff + m * 2048); PG8_F8(dst)[m].hi = *(const PG8_LAS v4i_f*)(lds + PG8_SA(b, h) + aoff + m * 2048 + 1024); } \
        else { _Pragma("unroll") for (int k = 0; k < 2; ++k) dst[m][k] = *(const PG8_LAS bf16x8*)(lds + PG8_SA(b, h) + aoff + m * 2048 + k * 1024); } } } while (0)
#define PG8_LDB(dst, b, h) do { _Pragma("unroll") for (int n = 0; n < 2; ++n) { if constexpr (F8SCALE != 0) { \
        PG8_F8(dst)[n].lo = *(const PG8_LAS v4i_f*)(lds + PG8_SB(b, h) + boff + n * 2048); PG8_F8(dst)[n].hi = *(const PG8_LAS v4i_f*)(lds + PG8_SB(b, h) + boff + n * 2048 + 1024); } \
        else { _Pragma("unroll") for (int k = 0; k < 2; ++k) dst[n][k] = *(const PG8_LAS bf16x8*)(lds + PG8_SB(b, h) + boff + n * 2048 + k * 1024); } } } while (0)
#define PG8_MMA(ai, bj, At, Bt) do { __builtin_amdgcn_s_setprio(1); _Pragma("unroll") for (int m = 0; m < 4; ++m) _Pragma("unroll") for (int n = 0; n < 2; ++n) { \
        f32x4 _c = acc_get(accw, ai, bj, m, n); \
        if constexpr (F8SCALE != 0) { _c = __builtin_amdgcn_mfma_scale_f32_16x16x128_f8f6f4(PG8_F8(Bt)[n], PG8_F8(At)[m], _c, 0, 0, 0, 0x7f7f7f7f, 0, F8SCALE * 0x01010101); } \
        else { _Pragma("unroll") for (int k = 0; k < 2; ++k) _c = __builtin_amdgcn_mfma_f32_16x16x32_bf16(Bt[n][k], At[m][k], _c, 0, 0, 0); } \
        acc_set(accw, ai, bj, m, n, _c); } \
        __builtin_amdgcn_s_setprio(0); } while (0)
#define PG8_WAIT_V(n) asm volatile("s_waitcnt vmcnt(" #n ")" ::: "memory")
#define PG8_WAIT_L(n) asm volatile("s_waitcnt lgkmcnt(" #n ")" ::: "memory")
#define PG8_BAR __builtin_amdgcn_s_barrier()
#define PG8_SCHED __builtin_amdgcn_sched_barrier(0)
    Unit cur, nxt; int ui = 0;
    if (!S.next(0, cur)) return;
    typedef int v4i_f __attribute__((ext_vector_type(4))); typedef int v8i_f __attribute__((ext_vector_type(8))); typedef f32x16 f32x16_f;
    AccW accw;
#pragma unroll
    for (int a = 0; a < 2; ++a)
#pragma unroll
        for (int b = 0; b < 2; ++b)
#pragma unroll
            for (int mp = 0; mp < 2; ++mp)
#pragma unroll
                for (int i = 0; i < 16; ++i) accw[a][b][mp][i] = 0.f;
    bf16x8 At[4][2], B0[2][2], B1[2][2];
    v8i_f At8[4], B08[2], B18[2];
#define PG8_F8(x) x##8
    const char* cA = (const char*)g.A + (size_t)cur.pm * tstepA + (size_t)cur.ko * 2; const char* cB = (const char*)g.Bt + (size_t)cur.pn * tstepB + (size_t)cur.ko * 2;
    S.a_ready(cur);
    if constexpr (SP2) {
        PG8_STAGE(PG8_SB(0, 0), cB, voffB); PG8_STAGE(PG8_SB(0, 1), cB + hstepB, voffB); PG8_STAGE(PG8_SA(0, 0), cA, voffA); PG8_STAGE(PG8_SA(0, 1), cA + hstepA, voffA);
        if (wr == 1) PG8_BAR;
        PG8_WAIT_V(2); PG8_BAR;
        PG8_STAGE(PG8_SB(1, 0), cB + kstep, voffB); PG8_STAGE(PG8_SA(1, 0), cA + kstep, voffA); PG8_STAGE(PG8_SB(1, 1), cB + hstepB + kstep, voffB);
        PG8_WAIT_V(6); PG8_BAR;
    } else {
        PG8_STAGE(PG8_SB(0, 0), cB, voffB); PG8_STAGE(PG8_SA(0, 0), cA, voffA); PG8_STAGE(PG8_SB(0, 1), cB + hstepB, voffB); PG8_STAGE(PG8_SA(0, 1), cA + hstepA, voffA);
        if (wr == 1) PG8_BAR;
        PG8_WAIT_V(4); PG8_BAR;
        PG8_STAGE(PG8_SB(1, 0), cB + kstep, voffB); PG8_STAGE(PG8_SA(1, 0), cA + kstep, voffA); PG8_STAGE(PG8_SB(1, 1), cB + hstepB + kstep, voffB);
        PG8_WAIT_V(6); PG8_BAR;
    }
    for (;;) {
        const bool has_next = S.next(ui + 1, nxt);
        const char* nA = has_next ? (const char*)g.A + (size_t)nxt.pm * tstepA + (size_t)nxt.ko * 2 : cA; const char* nB = has_next ? (const char*)g.Bt + (size_t)nxt.pn * tstepB + (size_t)nxt.ko * 2 : cB;
        for (int t = 0; t < nt; t += 2) {
            const bool last = (t == nt - 2);
            const char* a1 = cA + (size_t)(t + 1) * kstep;
            const char* a2 = last ? nA : cA + (size_t)(t + 2) * kstep; const char* b2 = last ? nB : cB + (size_t)(t + 2) * kstep;
            const char* a3 = a2 + kstep; const char* b3 = b2 + kstep;
            if (last && has_next) S.a_ready(nxt);
            if constexpr (SP2) {
            PG8_LDB(B0, 0, 0); PG8_LDB(B1, 0, 1); PG8_SCHED; PG8_LDA(At, 0, 0); PG8_STAGE(PG8_SA(1, 1), a1 + hstepA, voffA);
            PG8_WAIT_V(8); PG8_WAIT_L(0); PG8_BAR; PG8_MMA(0, 0, At, B0); PG8_MMA(0, 1, At, B1); PG8_BAR; PG8_SCHED;
            PG8_LDA(At, 0, 1); PG8_STAGE(PG8_SB(0, 0), b2, voffB); PG8_STAGE(PG8_SB(0, 1), b2 + hstepB, voffB); PG8_STAGE(PG8_SA(0, 0), a2, voffA);
            PG8_WAIT_V(8); PG8_WAIT_L(0); PG8_BAR; PG8_MMA(1, 0, At, B0); PG8_MMA(1, 1, At, B1); PG8_BAR; PG8_SCHED;
            PG8_LDB(B0, 1, 0); PG8_LDB(B1, 1, 1); PG8_SCHED; PG8_LDA(At, 1, 0); PG8_STAGE(PG8_SA(0, 1), a2 + hstepA, voffA);
            PG8_WAIT_V(8); PG8_WAIT_L(0); PG8_BAR; PG8_MMA(0, 0, At, B0); PG8_MMA(0, 1, At, B1); PG8_BAR; PG8_SCHED;
            PG8_LDA(At, 1, 1); PG8_STAGE(PG8_SB(1, 0), b3, voffB); PG8_STAGE(PG8_SB(1, 1), b3 + hstepB, voffB); PG8_STAGE(PG8_SA(1, 0), a3, voffA);
            PG8_WAIT_V(8); PG8_WAIT_L(0); PG8_BAR; PG8_MMA(1, 0, At, B0); PG8_MMA(1, 1, At, B1); PG8_BAR; PG8_SCHED;
            } else {
            PG8_LDB(B0, 0, 0); PG8_SCHED; PG8_LDA(At, 0, 0); PG8_STAGE(PG8_SA(1, 1), a1 + hstepA, voffA);
            PG8_WAIT_L(8); PG8_BAR; PG8_WAIT_L(0); PG8_MMA(0, 0, At, B0); PG8_BAR; PG8_SCHED;
            PG8_LDB(B1, 0, 1); PG8_STAGE(PG8_SB(0, 0), b2, voffB);
            PG8_BAR; PG8_WAIT_L(0); PG8_MMA(0, 1, At, B1); PG8_BAR;
            PG8_LDA(At, 0, 1); PG8_STAGE(PG8_SA(0, 0), a2, voffA);
            PG8_BAR; PG8_WAIT_L(0); PG8_MMA(1, 0, At, B0); PG8_BAR; PG8_SCHED;
            PG8_STAGE(PG8_SB(0, 1), b2 + hstepB, voffB);
            PG8_WAIT_V(6); PG8_BAR; PG8_MMA(1, 1, At, B1); PG8_BAR;
            PG8_LDB(B0, 1, 0); PG8_SCHED; PG8_LDA(At, 1, 0); PG8_STAGE(PG8_SA(0, 1), a2 + hstepA, voffA);
            PG8_WAIT_L(8); PG8_BAR; PG8_WAIT_L(0); PG8_MMA(0, 0, At, B0); PG8_BAR; PG8_SCHED;
            PG8_LDB(B1, 1, 1); PG8_STAGE(PG8_SB(1, 0), b3, voffB);
            PG8_BAR; PG8_WAIT_L(0); PG8_MMA(0, 1, At, B1); PG8_BAR;
            PG8_LDA(At, 1, 1); PG8_STAGE(PG8_SA(1, 0), a3, voffA);
            PG8_BAR; PG8_WAIT_L(0); PG8_MMA(1, 0, At, B0); PG8_BAR; PG8_SCHED;
            PG8_STAGE(PG8_SB(1, 1), b3 + hstepB, voffB);
            PG8_WAIT_V(6); PG8_BAR; PG8_MMA(1, 1, At, B1); PG8_BAR;
            }
        }
        if constexpr (ALIGN_EPI) { if (wr == 0) PG8_BAR; }
        if constexpr (!Epi::AFTER_DRAIN) { E(accw, cur, wr, wc, fr, fq); S.done(cur); }
        const bool keep_acc = Epi::TWOPASS && (cur.pass == 0);
        if (!has_next) break;
        if (!keep_acc) {
#pragma unroll
            for (int a = 0; a < 2; ++a)
#pragma unroll
                for (int b = 0; b < 2; ++b)
#pragma unroll
                    for (int mp = 0; mp < 2; ++mp)
#pragma unroll
                        for (int i = 0; i < 16; ++i) accw[a][b][mp][i] = 0.f;
        }
        cur = nxt; cA = nA; cB = nB; ++ui;
        if constexpr (ALIGN_EPI) { if (wr == 1) PG8_BAR; }
    }
    PG8_WAIT_V(0);
    if constexpr (!ALIGN_EPI) { if (wr == 0) PG8_BAR; }
    PG8_BAR;

#undef PG8_SA
#undef PG8_SB
#undef PG8_STAGE
#undef PG8_LDA
#undef PG8_LDB
#undef PG8_MMA
#undef PG8_F8
#undef PG8_WAIT_V
#undef PG8_WAIT_L
#undef PG8_BAR
#undef PG8_SCHED
}
}


constexpr int NWAVES = 8, NTHREADS = 512;
constexpr int BATCH = 8, SEQ = 4096, T = BATCH * SEQ, DM = 1024;
constexpr int INW = 5448;
constexpr int NPROJ = 5632;
constexpr int LD_HG = 2048, LD_ATT = 768, LD_IDX = 640, LD_GATE = 2048;
constexpr int TOPK = 256;
constexpr int NEXP = 16384;
constexpr float RMS_EPS = 1e-6f;

constexpr size_t MiB = 1u << 20;
constexpr size_t WS_CTL = 0;
constexpr size_t WS_MOD = MiB / 4;
constexpr size_t WS_MODP = MiB / 2;
constexpr size_t WS_WIN = 2 * MiB;
constexpr size_t WS_WQ = 17 * MiB;
constexpr size_t WS_SK = 21 * MiB;
constexpr size_t WS_U = 22 * MiB;
constexpr size_t WS_US = 30 * MiB;
constexpr size_t WS_V = 38 * MiB;
constexpr size_t WS_VS = 46 * MiB;
constexpr size_t WS_V8 = 8 * MiB;
constexpr size_t WS_K8 = 48 * MiB;
constexpr size_t WS_QHI = 52 * MiB;
constexpr size_t WS_QLO = 68 * MiB;
constexpr size_t WS_WAB8 = 31 * MiB;
constexpr size_t WS_WOUT8 = 32 * MiB;
constexpr size_t WS_WIN8 = 33 * MiB;
constexpr size_t WS_H8 = 48 * MiB;
constexpr size_t WS_H = 86 * MiB;
constexpr size_t WS_HG = 150 * MiB;
constexpr size_t WS_ATT = 278 * MiB;
constexpr size_t WS_IDX = 326 * MiB;
constexpr size_t WS_GATE = 366 * MiB;
constexpr size_t WS_SEL = 494 * MiB;
constexpr size_t WS_EIDX = 48 * MiB;
constexpr size_t WS_PGATE = 64 * MiB;
constexpr size_t WS_END = 510 * MiB;
constexpr size_t WS_HQC = 494 * MiB;
constexpr size_t WS_HOL = 118 * MiB;
constexpr size_t WS_HSB = 2 * MiB;
constexpr size_t WS_MERGED = WS_HG;
constexpr size_t WS_Q = 214 * MiB;
constexpr int H4_NT = 2;
constexpr size_t WS_H4D = 366 * MiB;
constexpr size_t WS_H4S = 416 * MiB;

constexpr int LDS_BYTES = 163840;

typedef unsigned short bf16;
typedef unsigned v4u __attribute__((ext_vector_type(4)));
typedef unsigned v2u __attribute__((ext_vector_type(2)));
typedef float f32x4 __attribute__((ext_vector_type(4)));
typedef float f32x2 __attribute__((ext_vector_type(2)));
typedef short bf16x8 __attribute__((ext_vector_type(8)));
#define LAS __attribute__((address_space(3)))

struct Params {
    const float *x, *c, *w_ada, *b_ada, *norm1_g, *norm2_g, *w_in, *hg_lb, *hg_onorm_g, *q_norm_g, *k_norm_g,
                *w_a, *w_b, *w_out, *peer_wq, *peer_subkeys, *peer_u, *peer_v;
    float* out; unsigned char* ws; int ph_lo, ph_hi;
};

typedef __bf16 bf16x2_hw __attribute__((ext_vector_type(2)));
__device__ __forceinline__ unsigned pk2(float lo, float hi) { const f32x2 v = {lo, hi}; const bf16x2_hw b = __builtin_convertvector(v, bf16x2_hw); return __builtin_bit_cast(unsigned, b); }
__device__ __forceinline__ unsigned f2bf(float f) { return pk2(f, 0.f) & 0xffffu; }
__device__ __forceinline__ float bf2f(unsigned u16v) { return __builtin_bit_cast(float, u16v << 16); }
__device__ __forceinline__ float bflo(unsigned w) { return __builtin_bit_cast(float, w << 16); }
__device__ __forceinline__ float bfhi(unsigned w) { return __builtin_bit_cast(float, w & 0xffff0000u); }
__device__ __forceinline__ float sigmoidf_(float x) { return __builtin_amdgcn_rcpf(1.f + __expf(-x)); }
__device__ __forceinline__ float siluf_(float x) { return x * __builtin_amdgcn_rcpf(1.f + __expf(-x)); }
__device__ __forceinline__ float wave_sum(float v) {
#pragma unroll
    for (int o = 1; o < 64; o <<= 1) v += __shfl_xor(v, o);
    return v;
}
__device__ __forceinline__ float wave_max(float v) {
#pragma unroll
    for (int o = 1; o < 64; o <<= 1) v = fmaxf(v, __shfl_xor(v, o));
    return v;
}
#define LDS_WAIT() asm volatile("s_waitcnt lgkmcnt(0)" ::: "memory")
__device__ __forceinline__ unsigned pk4_fp8(float a, float b, float c, float d) { int w = __builtin_amdgcn_cvt_pk_fp8_f32(a, b, 0, false); w = __builtin_amdgcn_cvt_pk_fp8_f32(c, d, w, true); return (unsigned)w; }

__host__ __device__ __forceinline__ int proj_tile_bf16(int i) { return i < 2 ? i + 2 : i + 6; }
__host__ __device__ __forceinline__ int proj_tile_fp8(int i) { return i < 2 ? i : (i < 6 ? i + 2 : i + 8); }
struct EpiProj {
    static constexpr bool PERM = true, AFTER_DRAIN = false, TWOPASS = false;
    bf16 *HG, *ATT, *IDX, *GATE; int f8;
    __device__ __forceinline__ void operator()(pg8::AccW& acc, const pg8::Unit& u, int wr, int wc, int fr, int fq) const {
        const int pn = f8 ? proj_tile_fp8(u.pn) : proj_tile_bf16(u.pn); bf16* base; int ldc, colt, ncols;
        if (pn < 8) { base = HG; ldc = LD_HG; colt = pn * 256; ncols = LD_HG; }
        else if (pn < 11) { base = ATT; ldc = LD_ATT; colt = (pn - 8) * 256; ncols = LD_ATT; }
        else if (pn < 14) { base = IDX; ldc = LD_IDX; colt = (pn - 11) * 256; ncols = LD_IDX; }
        else { base = GATE; ldc = LD_GATE; colt = (pn - 14) * 256; ncols = LD_GATE; }
        const int row0 = u.pm * 256 + wr * 64 + fr, col0 = colt + wc * 32 + 8 * fq;
#pragma unroll
        for (int ai = 0; ai < 2; ++ai)
#pragma unroll
            for (int m = 0; m < 4; ++m) { bf16* rowp = base + (size_t)(row0 + ai * 128 + m * 16) * ldc + col0;
#pragma unroll
                for (int bj = 0; bj < 2; ++bj) { const pg8::f32x4 v0 = pg8::acc_get(acc, ai, bj, m, 0), v1 = pg8::acc_get(acc, ai, bj, m, 1);
                    v4u w; w.x = pk2(v0[0], v0[1]); w.y = pk2(v0[2], v0[3]); w.z = pk2(v1[0], v1[1]); w.w = pk2(v1[2], v1[3]);
                    if (col0 + bj * 128 < ncols) *(v4u*)(rowp + bj * 128) = w; } }
    }
};
struct EpiMerged {
    static constexpr bool PERM = true, AFTER_DRAIN = false, TWOPASS = true;
    const bf16* GATE; bf16* O;
    __device__ __forceinline__ void operator()(pg8::AccW& acc, const pg8::Unit& u, int wr, int wc, int fr, int fq) const {
        const int row0 = u.pm * 256 + wr * 64 + fr, col0 = u.pn * 256 + wc * 32 + 8 * fq;
        if (u.pass == 0) {
#pragma unroll
            for (int ai = 0; ai < 2; ++ai)
#pragma unroll
                for (int m = 0; m < 4; ++m) { const bf16* rowp = GATE + (size_t)(row0 + ai * 128 + m * 16) * LD_GATE + col0;
#pragma unroll
                    for (int bj = 0; bj < 2; ++bj) { const v4u a = *(const v4u*)(rowp + bj * 128), b = *(const v4u*)(rowp + 1024 + bj * 128);
                        float r[8];
#pragma unroll
                        for (int i = 0; i < 4; ++i) { const float a0 = bflo(a[i]), a1 = bfhi(a[i]), b0 = bflo(b[i]), b1 = bfhi(b[i]);
                            r[2 * i] = (1.f + __expf(-b0)) * __builtin_amdgcn_rcpf(1.f + __expf(-a0)); r[2 * i + 1] = (1.f + __expf(-b1)) * __builtin_amdgcn_rcpf(1.f + __expf(-a1)); }
                        { pg8::f32x4 c0 = pg8::acc_get(acc, ai, bj, m, 0), c1 = pg8::acc_get(acc, ai, bj, m, 1);
#pragma unroll
                          for (int i = 0; i < 4; ++i) { c0[i] *= r[i]; c1[i] *= r[4 + i]; }
                          pg8::acc_set(acc, ai, bj, m, 0, c0); pg8::acc_set(acc, ai, bj, m, 1, c1); } } }
        } else {
#pragma unroll
            for (int ai = 0; ai < 2; ++ai)
#pragma unroll
                for (int m = 0; m < 4; ++m) { const size_t ro = (size_t)(row0 + ai * 128 + m * 16);
#pragma unroll
                    for (int bj = 0; bj < 2; ++bj) { const v4u b = *(const v4u*)(GATE + ro * LD_GATE + 1024 + col0 + bj * 128);
                        const pg8::f32x4 v0 = pg8::acc_get(acc, ai, bj, m, 0), v1 = pg8::acc_get(acc, ai, bj, m, 1);
                        float s[8];
#pragma unroll
                        for (int i = 0; i < 4; ++i) { s[2 * i] = sigmoidf_(bflo(b[i])); s[2 * i + 1] = sigmoidf_(bfhi(b[i])); }
                        v2u w; w.x = pk4_fp8(4.f * v0[0] * s[0], 4.f * v0[1] * s[1], 4.f * v0[2] * s[2], 4.f * v0[3] * s[3]); w.y = pk4_fp8(4.f * v1[0] * s[4], 4.f * v1[1] * s[5], 4.f * v1[2] * s[6], 4.f * v1[3] * s[7]);
                        *(v2u*)((unsigned char*)O + ro * 1024 + col0 + bj * 128) = w; } }
        }
    }
};
struct EpiResid {
    static constexpr bool PERM = true, AFTER_DRAIN = false, TWOPASS = false;
    const float* X; const float* G1  ; float* O;
    __device__ __forceinline__ void operator()(pg8::AccW& acc, const pg8::Unit& u, int wr, int wc, int fr, int fq) const {
        const int row0 = u.pm * 256 + wr * 64 + fr, col0 = u.pn * 256 + wc * 32 + 8 * fq;
        const int b = (u.pm * 256) / SEQ;
        f32x4 g[2][2];
#pragma unroll
        for (int bj = 0; bj < 2; ++bj)
#pragma unroll
            for (int n = 0; n < 2; ++n) g[bj][n] = *(const f32x4*)(G1 + (size_t)b * 6144 + col0 + bj * 128 + 4 * n);
#pragma unroll
        for (int ai = 0; ai < 2; ++ai)
#pragma unroll
            for (int m = 0; m < 4; ++m) { const size_t ro = (size_t)(row0 + ai * 128 + m * 16) * DM + col0;
#pragma unroll
                for (int bj = 0; bj < 2; ++bj)
#pragma unroll
                    for (int n = 0; n < 2; ++n) { const f32x4 xv = *(const f32x4*)(X + ro + bj * 128 + 4 * n);
                        *(f32x4*)(O + ro + bj * 128 + 4 * n) = xv + g[bj][n] * pg8::acc_get(acc, ai, bj, m, n); } }
    }
};
struct EpiStore {
    static constexpr bool PERM = true, AFTER_DRAIN = false, TWOPASS = false;
    bf16* O; int ldc;
    __device__ __forceinline__ void operator()(pg8::AccW& acc, const pg8::Unit& u, int wr, int wc, int fr, int fq) const {
        const int row0 = u.pm * 256 + wr * 64 + fr, col0 = u.pn * 256 + wc * 32 + 8 * fq;
#pragma unroll
        for (int ai = 0; ai < 2; ++ai)
#pragma unroll
            for (int m = 0; m < 4; ++m) { bf16* rowp = O + (size_t)(row0 + ai * 128 + m * 16) * ldc + col0;
#pragma unroll
                for (int bj = 0; bj < 2; ++bj) { const pg8::f32x4 v0 = pg8::acc_get(acc, ai, bj, m, 0), v1 = pg8::acc_get(acc, ai, bj, m, 1);
                    v4u w; w.x = pk2(v0[0], v0[1]); w.y = pk2(v0[2], v0[3]); w.z = pk2(v1[0], v1[1]); w.w = pk2(v1[2], v1[3]);
                    *(v4u*)(rowp + bj * 128) = w; } }
    }
};

template <int MODE> __device__ __forceinline__ int srcmap(int np) {
    if (MODE == 2) np = proj_tile_bf16(np >> 8) * 256 + (np & 255);
    if (MODE == 3) np = proj_tile_fp8(np >> 8) * 256 + (np & 255);
    if (MODE >= 1) return np < 3400 ? np : (np >= 3584 ? np - 184 : -1);
    return np; }
template <int MODE>
__device__ __forceinline__ void transpose_item(const float* W, int N, bf16* WT, int ldw, int koff, float* scr, int kb, int nb, int lane) {
    const int k0 = 64 * kb, n0 = 32 * nb;
    const int sc = srcmap<MODE>(n0 + (lane & 31));
#pragma unroll 8
    for (int i = 0; i < 32; ++i) { const int kk = 2 * i + (lane >> 5); scr[kk * 33 + (lane & 31)] = (sc >= 0) ? W[(size_t)(k0 + kk) * N + sc] : 0.f; }
    LDS_WAIT(); __builtin_amdgcn_wave_barrier();
    const int c = lane & 7;
#pragma unroll
    for (int j = 0; j < 4; ++j) { const int n = (lane >> 3) + 8 * j; const float* s = scr + (8 * c) * 33 + n;
        v4u o; o.x = pk2(s[0 * 33], s[1 * 33]); o.y = pk2(s[2 * 33], s[3 * 33]); o.z = pk2(s[4 * 33], s[5 * 33]); o.w = pk2(s[6 * 33], s[7 * 33]);
        *(v4u*)(WT + (size_t)(n0 + n) * ldw + koff + k0 + 8 * c) = o; }
    LDS_WAIT(); __builtin_amdgcn_wave_barrier();
}
template <int MODE> __device__ __forceinline__ int srcmap(int np);
template <int MODE = 0>
__device__ __forceinline__ void transpose_item8(const float* W, int N, unsigned char* WT, int ldw, int koff, float scale, float* scr, int kb, int nb, int lane) {
    const int k0 = 64 * kb, n0 = 32 * nb;
    const int sc = srcmap<MODE>(n0 + (lane & 31));
#pragma unroll 8
    for (int i = 0; i < 32; ++i) { const int kk = 2 * i + (lane >> 5); scr[kk * 33 + (lane & 31)] = (sc >= 0) ? W[(size_t)(k0 + kk) * N + sc] * scale : 0.f; }
    LDS_WAIT(); __builtin_amdgcn_wave_barrier();
    const int c = lane & 3;
#pragma unroll
    for (int j = 0; j < 2; ++j) { const int n = (lane >> 2) + 16 * j; const float* sp = scr + (16 * c) * 33 + n;
        v4u o;
#pragma unroll
        for (int q = 0; q < 4; ++q) o[q] = pk4_fp8(sp[(4 * q) * 33], sp[(4 * q + 1) * 33], sp[(4 * q + 2) * 33], sp[(4 * q + 3) * 33]);
        *(v4u*)(WT + (size_t)(n0 + n) * ldw + koff + k0 + 16 * c) = o; }
    LDS_WAIT(); __builtin_amdgcn_wave_barrier();
}
__device__ __forceinline__ void convert_plain(const float* src, bf16* dst, size_t n, size_t gtid, size_t nth) {
    const size_t n8 = n / 8;
    for (size_t i = gtid; i < n8; i += nth) { const f32x4 a = ((const f32x4*)src)[2 * i], b = ((const f32x4*)src)[2 * i + 1];
        v4u o; o.x = pk2(a[0], a[1]); o.y = pk2(a[2], a[3]); o.z = pk2(b[0], b[1]); o.w = pk2(b[2], b[3]); ((v4u*)dst)[i] = o; }
}
__device__ __forceinline__ void convert_fp8(const float* src, unsigned char* dst, size_t n, float scale, size_t gtid, size_t nth) {
    const size_t n16 = n / 16;
    for (size_t i = gtid; i < n16; i += nth) { const f32x4* sp = (const f32x4*)src + 4 * i; const f32x4 a = sp[0] * scale, b = sp[1] * scale, c = sp[2] * scale, d = sp[3] * scale;
        v4u o; o.x = pk4_fp8(a[0], a[1], a[2], a[3]); o.y = pk4_fp8(b[0], b[1], b[2], b[3]); o.z = pk4_fp8(c[0], c[1], c[2], c[3]); o.w = pk4_fp8(d[0], d[1], d[2], d[3]); ((v4u*)dst)[i] = o; }
}
template <bool KKMAJOR>
__device__ __forceinline__ void convert_mxfp4(const float* src, unsigned char* dst, unsigned char* scl, size_t nrows, size_t gtid, size_t nth) {
    const size_t nblk = nrows * 32;
    for (size_t i = gtid; i < nblk; i += nth) {
        const size_t row = i >> 5; const int blk = (int)(i & 31);
        const f32x4* sp = (const f32x4*)(src + row * 1024 + blk * 32);
        f32x4 v[8]; float amax = 0.f;
#pragma unroll
        for (int j = 0; j < 8; ++j) { v[j] = sp[j]; amax = fmaxf(fmaxf(fmaxf(fabsf(v[j][0]), fabsf(v[j][1])), fmaxf(fabsf(v[j][2]), fabsf(v[j][3]))), amax); }
        int e = (int)((__builtin_bit_cast(unsigned, amax) >> 23) & 0xffu) - 127 - 2;
        if (e < -126) e = -126;
        const float inv = __builtin_bit_cast(float, (unsigned)(127 - e) << 23);
        unsigned w[4] = {0u, 0u, 0u, 0u};
#pragma unroll
        for (int j = 0; j < 8; j += 2) { unsigned t = 0u;
            t = __builtin_amdgcn_cvt_scalef32_pk_fp4_f32(t, v[j][0] * inv, v[j][1] * inv, 1.0f, 0);
            t = __builtin_amdgcn_cvt_scalef32_pk_fp4_f32(t, v[j][2] * inv, v[j][3] * inv, 1.0f, 1);
            t = __builtin_amdgcn_cvt_scalef32_pk_fp4_f32(t, v[j + 1][0] * inv, v[j + 1][1] * inv, 1.0f, 2);
            t = __builtin_amdgcn_cvt_scalef32_pk_fp4_f32(t, v[j + 1][2] * inv, v[j + 1][3] * inv, 1.0f, 3);
            w[j >> 1] = t; }
        *(v4u*)(dst + row * 512 + blk * 16) = (v4u){w[0], w[1], w[2], w[3]};
        scl[row * 32 + (KKMAJOR ? ((blk & 3) * 8 + (blk >> 2)) : blk)] = (unsigned char)(e + 127);
    }
}
__device__ __forceinline__ void convert_rowfp4(const float* src, unsigned char* dst, _Float16* scl, int row, int lane) {
    const f32x4* sp = (const f32x4*)(src + (size_t)row * 1024 + lane * 16);
    f32x4 v[4]; float amax = 0.f;
#pragma unroll
    for (int j = 0; j < 4; ++j) { v[j] = sp[j]; amax = fmaxf(fmaxf(fmaxf(fabsf(v[j][0]), fabsf(v[j][1])), fmaxf(fabsf(v[j][2]), fabsf(v[j][3]))), amax); }
    amax = wave_max(amax);
    _Float16 sh = (_Float16)(amax * (1.f / 6.f));
    float sf = (float)sh; if (!(sf > 0.f)) { sf = 1.f; sh = (_Float16)1.f; }
    const float inv = 1.f / sf;
    unsigned w[2];
#pragma unroll
    for (int j = 0; j < 2; ++j) { unsigned t = 0u;
        t = __builtin_amdgcn_cvt_scalef32_pk_fp4_f32(t, v[2 * j][0] * inv, v[2 * j][1] * inv, 1.0f, 0);
        t = __builtin_amdgcn_cvt_scalef32_pk_fp4_f32(t, v[2 * j][2] * inv, v[2 * j][3] * inv, 1.0f, 1);
        t = __builtin_amdgcn_cvt_scalef32_pk_fp4_f32(t, v[2 * j + 1][0] * inv, v[2 * j + 1][1] * inv, 1.0f, 2);
        t = __builtin_amdgcn_cvt_scalef32_pk_fp4_f32(t, v[2 * j + 1][2] * inv, v[2 * j + 1][3] * inv, 1.0f, 3);
        w[j] = t; }
    *(v2u*)(dst + (size_t)row * 512 + lane * 8) = (v2u){w[0], w[1]};
    if (lane == 0) scl[row] = sh;
}
__device__ __forceinline__ void phase0(const Params& p, unsigned char* lds) {
    const int tid = threadIdx.x, wave = tid >> 6, lane = tid & 63, G = gridDim.x;
    const int gw = blockIdx.x * NWAVES + wave, NGW = G * NWAVES;
    float* scr = (float*)(lds + wave * 16384);
    unsigned char* ws = p.ws;
    constexpr int I_IN = 16 * (2048 / 32), I_IN8 = 16 * (3584 / 32), I_A = 8 * 32, I_O = 16 * 32, I_Q = 16 * 64;
    constexpr int NT = I_IN + I_IN8 + 2 * I_A + I_O + I_Q;
    for (int it = gw; it < NT; it += NGW) {
        int r = it;
        if (r < I_IN) { transpose_item<2>(p.w_in, INW, (bf16*)(ws + WS_WIN), 1024, 0, scr, r / 64, r % 64, lane); continue; } r -= I_IN;
        if (r < I_IN8) { transpose_item8<3>(p.w_in, INW, ws + WS_WIN8, 1024, 0, 32.f, scr, r / 112, r % 112, lane); continue; } r -= I_IN8;
        if (r < I_A) { transpose_item8(p.w_a, 1024, ws + WS_WAB8, 1024, 0, 32.f, scr, r / 32, r % 32, lane); continue; } r -= I_A;
        if (r < I_A) { transpose_item8(p.w_b, 1024, ws + WS_WAB8, 1024, 512, 4.f, scr, r / 32, r % 32, lane); continue; } r -= I_A;
        if (r < I_O) { transpose_item8(p.w_out, 1024, ws + WS_WOUT8, 1024, 0, 32.f, scr, r / 32, r % 32, lane); continue; } r -= I_O;
        transpose_item<0>(p.peer_wq, 2048, (bf16*)(ws + WS_WQ), 1024, 0, scr, r / 64, r % 64, lane);
    }
    for (int it = gw; it < 96 * 8; it += NGW) {
        const int cgp = it % 96, ks = it / 96, col = cgp * 64 + lane, k0 = ks * 128;
#pragma unroll
        for (int i = 0; i < 16; ++i) { const int e = i * 64 + lane, b = e >> 7, k = e & 127; scr[e] = siluf_(p.c[b * 1024 + k0 + k]); }
        LDS_WAIT(); __builtin_amdgcn_wave_barrier();
        float acc[8];
#pragma unroll
        for (int b = 0; b < 8; ++b) acc[b] = 0.f;
#pragma unroll 4
        for (int k = 0; k < 128; ++k) { const float w = p.w_ada[(size_t)(k0 + k) * 6144 + col];
#pragma unroll
            for (int b = 0; b < 8; ++b) acc[b] += scr[b * 128 + k] * w; }
        float* mp = (float*)(ws + WS_MODP) + (size_t)ks * 8 * 6144 + col;
#pragma unroll
        for (int b = 0; b < 8; ++b) mp[b * 6144] = acc[b];
        LDS_WAIT(); __builtin_amdgcn_wave_barrier();
    }
    const size_t gtid = (size_t)blockIdx.x * NTHREADS + tid, nth = (size_t)G * NTHREADS;
    convert_plain(p.peer_subkeys, (bf16*)(ws + WS_SK), (size_t)16 * 128 * 128, gtid, nth);
    for (int it = gw; it < 2 * NEXP; it += NGW) {
        if (it < NEXP) convert_rowfp4(p.peer_u, ws + WS_U, (_Float16*)(ws + WS_US), it, lane);
        else convert_rowfp4(p.peer_v, ws + WS_V, (_Float16*)(ws + WS_VS), it - NEXP, lane);
    }
}

template <bool FIRST>
__device__ __forceinline__ void normmod_phase(const Params& p, unsigned char* lds, const float* src, bf16* dst, const float* gvec, int shift_off, int scale_off) {
    const int tid = threadIdx.x, wave = tid >> 6, lane = tid & 63, G = gridDim.x;
    unsigned char* ws = p.ws;
    float* A = (float*)lds;
    float* Bv = A + 1024;
    const float* MODP = (const float*)(ws + WS_MODP);
    float* MOD = (float*)(ws + WS_MOD);
    if (FIRST) {
        for (int e = blockIdx.x * NTHREADS + tid; e < 8 * 6144; e += G * NTHREADS) { const int col = e % 6144; float s = p.b_ada[col];
#pragma unroll
            for (int ks = 0; ks < 8; ++ks) s += MODP[(size_t)ks * 8 * 6144 + e];
            MOD[e] = s; }
    }
    int curb = -1;
    for (int chunk = blockIdx.x; chunk < T / 128; chunk += G) {
        const int b = (chunk * 128) / SEQ;
        if (b != curb) {
            __syncthreads();
            for (int col = tid; col < 1024; col += NTHREADS) {
                float sc, sh;
                if (FIRST) { sc = p.b_ada[scale_off + col]; sh = p.b_ada[shift_off + col];
#pragma unroll
                    for (int ks = 0; ks < 8; ++ks) { sc += MODP[(size_t)(ks * 8 + b) * 6144 + scale_off + col]; sh += MODP[(size_t)(ks * 8 + b) * 6144 + shift_off + col]; } }
                else { sc = MOD[b * 6144 + scale_off + col]; sh = MOD[b * 6144 + shift_off + col]; }
                A[col] = gvec[col] * (1.f + sc); Bv[col] = sh; }
            __syncthreads(); curb = b;
        }
        for (int r = wave; r < 128; r += NWAVES) {
            const size_t row = (size_t)chunk * 128 + r;
            const f32x4* xr = (const f32x4*)(src + row * DM) + lane;
            f32x4 v[4]; float s = 0.f;
#pragma unroll
            for (int j = 0; j < 4; ++j) { v[j] = xr[64 * j]; s += (v[j][0] * v[j][0] + v[j][1] * v[j][1]) + (v[j][2] * v[j][2] + v[j][3] * v[j][3]); }
            const float rstd = rsqrtf(wave_sum(s) * (1.f / DM) + RMS_EPS);
            v2u* o8 = (v2u*)(dst + row * DM) + lane;
#pragma unroll
            for (int j = 0; j < 4; ++j) { const int c0 = 4 * lane + 256 * j; const f32x4 a = *(const f32x4*)(A + c0), sh = *(const f32x4*)(Bv + c0);
                v2u o; o.x = pk2(v[j][0] * rstd * a[0] + sh[0], v[j][1] * rstd * a[1] + sh[1]); o.y = pk2(v[j][2] * rstd * a[2] + sh[2], v[j][3] * rstd * a[3] + sh[3]);
                o8[64 * j] = o;
                if (FIRST) *(unsigned*)(ws + WS_H8 + row * DM + c0) = pk4_fp8(v[j][0] * rstd * a[0] + sh[0], v[j][1] * rstd * a[1] + sh[1], v[j][2] * rstd * a[2] + sh[2], v[j][3] * rstd * a[3] + sh[3]);
                if (!FIRST) { float* st = (float*)(lds + 8192) + wave * 1056;
                    const float y0 = v[j][0] * rstd * a[0] + sh[0], y1 = v[j][1] * rstd * a[1] + sh[1], y2 = v[j][2] * rstd * a[2] + sh[2], y3 = v[j][3] * rstd * a[3] + sh[3];
                    const int pc = c0 + (c0 >> 5); st[pc] = y0; st[pc + 1] = y1; st[pc + 2] = y2; st[pc + 3] = y3; } }
            if (!FIRST) {
                const float* st = (const float*)(lds + 8192) + wave * 1056;
                LDS_WAIT(); __builtin_amdgcn_wave_barrier();
                if (lane < 32) {
                    float x[32];
#pragma unroll
                    for (int k = 0; k < 32; ++k) x[k] = st[lane * 33 + k];
#pragma unroll
                    for (int t = 0; t < H4_NT; ++t) {
                        float amax = 0.f;
#pragma unroll
                        for (int k = 0; k < 32; ++k) amax = fmaxf(amax, fabsf(x[k]));
                        int e = (int)((__builtin_bit_cast(unsigned, amax) >> 23) & 0xffu) - 127 - 2; if (e < -126) e = -126;
                        const float inv = __builtin_bit_cast(float, (unsigned)(127 - e) << 23), sc = __builtin_bit_cast(float, (unsigned)(127 + e) << 23);
                        unsigned w[4];
#pragma unroll
                        for (int r = 0; r < 4; ++r) { unsigned tw = 0u;
                            tw = __builtin_amdgcn_cvt_scalef32_pk_fp4_f32(tw, x[8 * r] * inv, x[8 * r + 1] * inv, 1.0f, 0);
                            tw = __builtin_amdgcn_cvt_scalef32_pk_fp4_f32(tw, x[8 * r + 2] * inv, x[8 * r + 3] * inv, 1.0f, 1);
                            tw = __builtin_amdgcn_cvt_scalef32_pk_fp4_f32(tw, x[8 * r + 4] * inv, x[8 * r + 5] * inv, 1.0f, 2);
                            tw = __builtin_amdgcn_cvt_scalef32_pk_fp4_f32(tw, x[8 * r + 6] * inv, x[8 * r + 7] * inv, 1.0f, 3);
                            w[r] = tw;
                            const f32x2 d0 = __builtin_amdgcn_cvt_scalef32_pk_f32_fp4(tw, 1.0f, 0), d1 = __builtin_amdgcn_cvt_scalef32_pk_f32_fp4(tw, 1.0f, 1), d2 = __builtin_amdgcn_cvt_scalef32_pk_f32_fp4(tw, 1.0f, 2), d3 = __builtin_amdgcn_cvt_scalef32_pk_f32_fp4(tw, 1.0f, 3);
                            x[8 * r] -= d0[0] * sc; x[8 * r + 1] -= d0[1] * sc; x[8 * r + 2] -= d1[0] * sc; x[8 * r + 3] -= d1[1] * sc;
                            x[8 * r + 4] -= d2[0] * sc; x[8 * r + 5] -= d2[1] * sc; x[8 * r + 6] -= d3[0] * sc; x[8 * r + 7] -= d3[1] * sc; }
                        *(v4u*)(ws + WS_H4D + (row * H4_NT + t) * 512 + lane * 16) = (v4u){w[0], w[1], w[2], w[3]};
                        *(ws + WS_H4S + (row * H4_NT + t) * 32 + (lane & 3) * 8 + (lane >> 2)) = (unsigned char)(e + 127);
                    }
                }
                LDS_WAIT(); __builtin_amdgcn_wave_barrier();
            }
        }
    }
    __syncthreads();
}

constexpr int HGL_QT = 0, HGL_KT = 17408, HGL_QE = 34816, HGL_KLT = 52224, HGL_VT = 70656, HGL_AM = 89088, HGL_DEC = 98304, HGL_TOT = 98816, HGL_SSQ = 100864;
constexpr int HG_LDR = 136;
constexpr int HG_LDC = 72;
template <int half>
__device__ __forceinline__ void hgrn_item(const Params& p, unsigned char* lds, int item) {
    const int b = item >> 2, h = item & 3;
    const int tid = threadIdx.x, w = tid >> 6, lane = tid & 63, fr = lane & 15, fq = lane >> 4;
    unsigned char* ws = p.ws;
    const bf16* HG = (const bf16*)(ws + WS_HG);
    bf16* YA = (bf16*)(ws + WS_H);
    bf16* QT = (bf16*)(lds + HGL_QT); bf16* KT = (bf16*)(lds + HGL_KT); bf16* QE = (bf16*)(lds + HGL_QE);
    bf16* KLT = (bf16*)(lds + HGL_KLT); bf16* VT = (bf16*)(lds + HGL_VT); bf16* AM = (bf16*)(lds + HGL_AM);
    float* DEC = (float*)(lds + HGL_DEC); float* TOT = (float*)(lds + HGL_TOT); float* SSQ = (float*)(lds + HGL_SSQ);
    const int pd = tid & 127, pq = tid >> 7;
    float lbv; { const float a0 = p.hg_lb[h * 128 + pd], a1 = p.hg_lb[512 + h * 128 + pd]; lbv = 1.f / (1.f + __expf(a1 - a0)); }
    const int e0 = w * 16;
    const float ogv = p.hg_onorm_g[e0 + fr];
    pg8::f32x4 S[8];
#pragma unroll
    for (int i = 0; i < 8; ++i) S[i] = (pg8::f32x4){0.f, 0.f, 0.f, 0.f};
    const size_t rowb = (size_t)b * SEQ;
    const int c0 = half * 32;
    bf16* QCg = (bf16*)(ws + WS_HQC) + (size_t)item * 2048 * 128; float* OLg = (float*)(ws + WS_HOL) + (size_t)item * 32 * 8 * 4 * 256;
    float cum = 1.f;
    unsigned short rq[16], rf[16], rv[16];
    { const bf16* gp = HG + (rowb + (size_t)c0 * 64 + pq * 16) * LD_HG + h * 128 + pd;
#pragma unroll
      for (int i = 0; i < 16; ++i) { rq[i] = gp[(size_t)i * LD_HG]; rf[i] = gp[(size_t)i * LD_HG + 512]; rv[i] = gp[(size_t)i * LD_HG + 1024]; } }
    for (int chunk = c0; chunk < c0 + 32; ++chunk) {
        const size_t row0 = rowb + (size_t)chunk * 64;
        float fq_[16], kq_[16], cs[16];
        float run = 0.f;
#pragma unroll
        for (int i = 0; i < 16; ++i) { const float f = lbv + (1.f - lbv) * sigmoidf_(bf2f(rf[i])); kq_[i] = 1.f - f; run += __logf(f); cs[i] = run; fq_[i] = siluf_(bf2f(rq[i])); }
        TOT[pq * 128 + pd] = run;
        { v4u v0, v1;
          v0.x = rv[0] | ((unsigned)rv[1] << 16); v0.y = rv[2] | ((unsigned)rv[3] << 16); v0.z = rv[4] | ((unsigned)rv[5] << 16); v0.w = rv[6] | ((unsigned)rv[7] << 16);
          v1.x = rv[8] | ((unsigned)rv[9] << 16); v1.y = rv[10] | ((unsigned)rv[11] << 16); v1.z = rv[12] | ((unsigned)rv[13] << 16); v1.w = rv[14] | ((unsigned)rv[15] << 16);
          *(v4u*)(VT + pd * HG_LDC + pq * 16) = v0; *(v4u*)(VT + pd * HG_LDC + pq * 16 + 8) = v1; }
        unsigned short rg[16];
#pragma unroll
        for (int i = 0; i < 16; ++i) rg[i] = half ? (unsigned short)0 : HG[(row0 + (i >> 2) * 16 + fq * 4 + (i & 3)) * LD_HG + 1536 + h * 128 + e0 + fr];
        if (chunk + 1 < c0 + 32) { const bf16* gp = HG + (row0 + 64 + pq * 16) * LD_HG + h * 128 + pd;
#pragma unroll
            for (int i = 0; i < 16; ++i) { rq[i] = gp[(size_t)i * LD_HG]; rf[i] = gp[(size_t)i * LD_HG + 512]; rv[i] = gp[(size_t)i * LD_HG + 1024]; } }
        __syncthreads();
        const float t0 = TOT[pd], t1 = TOT[128 + pd], t2 = TOT[256 + pd], t3 = TOT[384 + pd];
        const float base = (pq > 0 ? t0 : 0.f) + (pq > 1 ? t1 : 0.f) + (pq > 2 ? t2 : 0.f);
        const float bmid = t0 + t1, blast = (t0 + t1) + (t2 + t3);
        const float emid = __expf(bmid), elm = __expf(blast - bmid);
        if (pq == 0) DEC[pd] = __expf(blast);
        { unsigned klp[8];
#pragma unroll
          for (int i = 0; i < 16; ++i) { const float bb = base + cs[i]; const float E1 = __expf(bb - bmid), R1 = __builtin_amdgcn_rcpf(E1);
              const float qtv = fq_[i] * E1, ktv = kq_[i] * R1, qev = qtv * emid, klv = ktv * elm;
              const int srow = pq * 16 + i;
              QT[srow * HG_LDR + pd] = (bf16)f2bf(qtv); KT[srow * HG_LDR + pd] = (bf16)f2bf(ktv); QE[srow * HG_LDR + pd] = (bf16)f2bf(qev);
              if (half) QCg[((size_t)(chunk - 32) * 64 + srow) * 128 + pd] = (bf16)f2bf(qev * cum);
              if (i & 1) klp[i >> 1] |= f2bf(klv) << 16; else klp[i >> 1] = f2bf(klv); }
          *(v4u*)(KLT + pd * HG_LDC + pq * 16) = (v4u){klp[0], klp[1], klp[2], klp[3]}; *(v4u*)(KLT + pd * HG_LDC + pq * 16 + 8) = (v4u){klp[4], klp[5], klp[6], klp[7]}; }
        cum *= __expf(blast);
        __syncthreads();
#pragma unroll
        for (int tt = 0; tt < 2; ++tt) { const int id = w + 8 * tt, rt = id >> 2, ct = id & 3;
            pg8::f32x4 a = {0.f, 0.f, 0.f, 0.f};
            if (ct <= rt) {
#pragma unroll
                for (int ks = 0; ks < 4; ++ks) { const bf16x8 af = *(const bf16x8*)(QT + (rt * 16 + fr) * HG_LDR + ks * 32 + fq * 8), bfv = *(const bf16x8*)(KT + (ct * 16 + fr) * HG_LDR + ks * 32 + fq * 8);
                    a = __builtin_amdgcn_mfma_f32_16x16x32_bf16(af, bfv, a, 0, 0, 0); } }
#pragma unroll
            for (int r = 0; r < 4; ++r) { const int c = rt * 16 + fq * 4 + r, sidx = ct * 16 + fr; AM[c * HG_LDC + sidx] = (bf16)((sidx <= c) ? f2bf(a[r]) : 0u); } }
        __syncthreads();
        const bf16x8 vb0 = *(const bf16x8*)(VT + (e0 + fr) * HG_LDC + fq * 8), vb1 = *(const bf16x8*)(VT + (e0 + fr) * HG_LDC + 32 + fq * 8);
        bf16x8 sb[4];
#pragma unroll
        for (int ks = 0; ks < 4; ++ks) { v4u t; t.x = pk2(S[2 * ks][0], S[2 * ks][1]); t.y = pk2(S[2 * ks][2], S[2 * ks][3]); t.z = pk2(S[2 * ks + 1][0], S[2 * ks + 1][1]); t.w = pk2(S[2 * ks + 1][2], S[2 * ks + 1][3]); sb[ks] = __builtin_bit_cast(bf16x8, t); }
        pg8::f32x4 o[4];
#pragma unroll
        for (int rt = 0; rt < 4; ++rt) { pg8::f32x4 a = {0.f, 0.f, 0.f, 0.f};
            a = __builtin_amdgcn_mfma_f32_16x16x32_bf16(*(const bf16x8*)(AM + (rt * 16 + fr) * HG_LDC + fq * 8), vb0, a, 0, 0, 0);
            a = __builtin_amdgcn_mfma_f32_16x16x32_bf16(*(const bf16x8*)(AM + (rt * 16 + fr) * HG_LDC + 32 + fq * 8), vb1, a, 0, 0, 0);
#pragma unroll
            for (int ks = 0; ks < 4; ++ks) { const v2u lo = *(const v2u*)(QE + (rt * 16 + fr) * HG_LDR + ks * 32 + fq * 4), hi = *(const v2u*)(QE + (rt * 16 + fr) * HG_LDR + ks * 32 + 16 + fq * 4);
                const v4u t = {lo.x, lo.y, hi.x, hi.y};
                a = __builtin_amdgcn_mfma_f32_16x16x32_bf16(__builtin_bit_cast(bf16x8, t), sb[ks], a, 0, 0, 0); }
            o[rt] = a; }
#pragma unroll
        for (int dt = 0; dt < 8; ++dt) { const f32x4 dc = *(const f32x4*)(DEC + dt * 16 + fq * 4);
            pg8::f32x4 a = S[dt]; a[0] *= dc[0]; a[1] *= dc[1]; a[2] *= dc[2]; a[3] *= dc[3];
            a = __builtin_amdgcn_mfma_f32_16x16x32_bf16(*(const bf16x8*)(KLT + (dt * 16 + fr) * HG_LDC + fq * 8), vb0, a, 0, 0, 0);
            a = __builtin_amdgcn_mfma_f32_16x16x32_bf16(*(const bf16x8*)(KLT + (dt * 16 + fr) * HG_LDC + 32 + fq * 8), vb1, a, 0, 0, 0);
            S[dt] = a; }
        if (half) {
#pragma unroll
            for (int rt = 0; rt < 4; ++rt) *(pg8::f32x4*)(OLg + ((((size_t)(chunk - 32)) * 8 + w) * 4 + rt) * 256 + lane * 4) = o[rt];
            __syncthreads();
            continue;
        }
#pragma unroll
        for (int rt = 0; rt < 4; ++rt)
#pragma unroll
            for (int r = 0; r < 4; ++r) { float x = o[rt][r] * o[rt][r];
                x += __shfl_xor(x, 1); x += __shfl_xor(x, 2); x += __shfl_xor(x, 4); x += __shfl_xor(x, 8);
                if (fr == 0) SSQ[w * 64 + rt * 16 + fq * 4 + r] = x; }
        __syncthreads();
        float tot = 0.f;
#pragma unroll
        for (int ww = 0; ww < 8; ++ww) tot += SSQ[ww * 64 + lane];
        const float rstd_l = rsqrtf(tot * (1.f / 128.f) + RMS_EPS);
#pragma unroll
        for (int rt = 0; rt < 4; ++rt)
#pragma unroll
            for (int r = 0; r < 4; ++r) { const int c = rt * 16 + fq * 4 + r; const float rs = __shfl(rstd_l, c);
                const float y = o[rt][r] * rs * ogv * siluf_(bf2f(rg[rt * 4 + r]));
                ((unsigned char*)YA)[(row0 + c) * 1024 + h * 128 + e0 + fr] = (unsigned char)(__builtin_amdgcn_cvt_pk_fp8_f32(y, 0.f, 0, false) & 0xff); }
    }
    if (!half) {
#pragma unroll
        for (int ks = 0; ks < 4; ++ks) { v4u t; t.x = pk2(S[2 * ks][0], S[2 * ks][1]); t.y = pk2(S[2 * ks][2], S[2 * ks][3]); t.z = pk2(S[2 * ks + 1][0], S[2 * ks + 1][1]); t.w = pk2(S[2 * ks + 1][2], S[2 * ks + 1][3]);
            *(v4u*)(ws + WS_HSB + ((((size_t)item * 8 + w) * 4 + ks) * 64 + lane) * 16) = t; }
    }
    __syncthreads();
}
__device__ __forceinline__ void hgrn_fix(const Params& p, int item, int c, int rt, int lane) {
    const int b = item >> 2, h = item & 3, fr = lane & 15, fq = lane >> 4;
    unsigned char* ws = p.ws;
    const bf16* HG = (const bf16*)(ws + WS_HG);
    bf16* YA = (bf16*)(ws + WS_H);
    const bf16* QCg = (const bf16*)(ws + WS_HQC) + (size_t)item * 2048 * 128; const float* OLg = (const float*)(ws + WS_HOL) + (size_t)item * 32 * 8 * 4 * 256;
    const size_t row0 = (size_t)b * SEQ + (size_t)(32 + c) * 64 + rt * 16;
    bf16x8 Aq[4];
    { const bf16* qr = QCg + ((size_t)c * 64 + rt * 16 + fr) * 128;
#pragma unroll
      for (int ks = 0; ks < 4; ++ks) { const v2u lo = *(const v2u*)(qr + ks * 32 + fq * 4), hi = *(const v2u*)(qr + ks * 32 + 16 + fq * 4); const v4u t = {lo.x, lo.y, hi.x, hi.y}; Aq[ks] = __builtin_bit_cast(bf16x8, t); } }
    pg8::f32x4 o[8];
#pragma unroll
    for (int w2 = 0; w2 < 8; ++w2) { pg8::f32x4 a = *(const pg8::f32x4*)(OLg + ((((size_t)c) * 8 + w2) * 4 + rt) * 256 + lane * 4);
#pragma unroll
        for (int ks = 0; ks < 4; ++ks) { const bf16x8 sbv = __builtin_bit_cast(bf16x8, *(const v4u*)(ws + WS_HSB + ((((size_t)item * 8 + w2) * 4 + ks) * 64 + lane) * 16));
            a = __builtin_amdgcn_mfma_f32_16x16x32_bf16(Aq[ks], sbv, a, 0, 0, 0); }
        o[w2] = a; }
    float rs[4];
#pragma unroll
    for (int r = 0; r < 4; ++r) { float x = 0.f;
#pragma unroll
        for (int w2 = 0; w2 < 8; ++w2) x += o[w2][r] * o[w2][r];
        x += __shfl_xor(x, 1); x += __shfl_xor(x, 2); x += __shfl_xor(x, 4); x += __shfl_xor(x, 8);
        rs[r] = rsqrtf(x * (1.f / 128.f) + RMS_EPS); }
#pragma unroll
    for (int w2 = 0; w2 < 8; ++w2) { const float ogv = p.hg_onorm_g[w2 * 16 + fr];
#pragma unroll
        for (int r = 0; r < 4; ++r) { const size_t row = row0 + fq * 4 + r;
            const float g = bf2f((unsigned)(unsigned short)HG[row * LD_HG + 1536 + h * 128 + w2 * 16 + fr]);
            const float y = o[w2][r] * rs[r] * ogv * siluf_(g);
            ((unsigned char*)YA)[row * 1024 + h * 128 + w2 * 16 + fr] = (unsigned char)(__builtin_amdgcn_cvt_pk_fp8_f32(y, 0.f, 0, false) & 0xff); } }
}

__device__ __forceinline__ unsigned f16key(float x) {
    x = x + 0.f;
    const _Float16 hx = (_Float16)x; const unsigned short bits = __builtin_bit_cast(unsigned short, hx);
    return (bits & 0x8000u) ? (unsigned)(unsigned short)(~bits) : (unsigned)(bits | 0x8000u);
}
__device__ __forceinline__ void find_bin(const unsigned* hist, int K, int lane, int& bin, int& rem) {
    const int rl = 63 - lane;
    const v4u hv = *(const v4u*)(hist + 4 * rl);
    const unsigned c = hv.x + hv.y + hv.z + hv.w;
    unsigned x = c;
#define DPP_ADD(CTRL, RM) x += (unsigned)__builtin_amdgcn_update_dpp(0, (int)x, CTRL, RM, 0xf, false)
    DPP_ADD(0x111, 0xf); DPP_ADD(0x112, 0xf); DPP_ADD(0x114, 0xf); DPP_ADD(0x118, 0xf);
    DPP_ADD(0x142, 0xa); DPP_ADD(0x143, 0xc);
#undef DPP_ADD
    const unsigned above = x - c;
    const bool mine = (above < (unsigned)K) && ((unsigned)K <= x);
    int mybin = 0, myrem = 0;
    if (mine) { unsigned ca = above; const unsigned hh[4] = {hv.x, hv.y, hv.z, hv.w}; bool found = false;
#pragma unroll
        for (int i = 3; i >= 0; --i) { if (!found) { if (ca + hh[i] >= (unsigned)K) { mybin = 4 * rl + i; myrem = K - (int)ca; found = true; } else ca += hh[i]; } } }
    const unsigned long long m = __ballot(mine);
    const int src = (int)__builtin_ctzll(m | (1ull << 63));
    bin = __builtin_amdgcn_readlane(mybin, src); rem = __builtin_amdgcn_readlane(myrem, src);
}
__device__ __forceinline__ void dsa1_item(const Params& p, unsigned char* lds, int item) {
    const int b = item >> 8, q0 = (item & 255) * 16;
    const int tid = threadIdx.x, w = tid >> 6, lane = tid & 63, fr = lane & 15, fq = lane >> 4;
    unsigned char* ws = p.ws;
    const bf16* IDX = (const bf16*)(ws + WS_IDX);
    unsigned short* Ik = (unsigned short*)lds;
    unsigned* hist1 = (unsigned*)(lds + 131072);
    unsigned* hist = (unsigned*)(lds + 131072 + 16384) + w * 256;
    const size_t rowb = (size_t)b * SEQ;
    *(v4u*)(hist1 + tid * 4) = (v4u){0u, 0u, 0u, 0u}; *(v4u*)(hist1 + 2048 + tid * 4) = (v4u){0u, 0u, 0u, 0u};
    bf16x8 Af[8][2];
    { const bf16* rp = IDX + (rowb + q0 + fr) * LD_IDX + fq * 8;
#pragma unroll
      for (int h = 0; h < 8; ++h) { Af[h][0] = *(const bf16x8*)(rp + h * 64); Af[h][1] = *(const bf16x8*)(rp + h * 64 + 32); } }
    const float idx_scale = 0.5f * 0.125f * 0.35355339059327373f;
    bf16x8 Aw[2];
    { float wa[8];
      { const v4u wq = *(const v4u*)(IDX + (rowb + q0 + fr) * LD_IDX + 576);
#pragma unroll
        for (int i = 0; i < 4; ++i) { wa[2 * i] = bflo(wq[i]) * idx_scale; wa[2 * i + 1] = bfhi(wq[i]) * idx_scale; } }
#pragma unroll
      for (int ks = 0; ks < 2; ++ks) { float cq[8];
#pragma unroll
          for (int j = 0; j < 8; ++j) cq[j] = 0.f;
#pragma unroll
          for (int h = 0; h < 8; ++h)
#pragma unroll
              for (int j = 0; j < 8; ++j) cq[j] += wa[h] * bf2f((unsigned)(unsigned short)Af[h][ks][j]);
          const v4u t = {pk2(cq[0], cq[1]), pk2(cq[2], cq[3]), pk2(cq[4], cq[5]), pk2(cq[6], cq[7])};
          Aw[ks] = __builtin_bit_cast(bf16x8, t); } }
    float wv[4][8];
#pragma unroll
    for (int r = 0; r < 4; ++r) { const v4u wq = *(const v4u*)(IDX + (rowb + q0 + fq * 4 + r) * LD_IDX + 576);
#pragma unroll
        for (int i = 0; i < 4; ++i) { wv[r][2 * i] = bflo(wq[i]) * idx_scale; wv[r][2 * i + 1] = bfhi(wq[i]) * idx_scale; } }
    const int ntiles = (q0 >> 4) + 1;
    __syncthreads();
    bf16x8 B0 = Aw[0], B1 = Aw[1];
    if (w < ntiles) { const bf16* kp = IDX + (rowb + w * 16 + fr) * LD_IDX + 512 + fq * 8; B0 = *(const bf16x8*)kp; B1 = *(const bf16x8*)(kp + 32); }
    for (int kt = w; kt < ntiles; kt += NWAVES) {
        bf16x8 nB0 = B0, nB1 = B1;
        if (kt + NWAVES < ntiles) { const bf16* kp = IDX + (rowb + (kt + NWAVES) * 16 + fr) * LD_IDX + 512 + fq * 8; nB0 = *(const bf16x8*)kp; nB1 = *(const bf16x8*)(kp + 32); }
        pg8::f32x4 lin = {0.f, 0.f, 0.f, 0.f};
        lin = __builtin_amdgcn_mfma_f32_16x16x32_bf16(Aw[0], B0, lin, 0, 0, 0);
        lin = __builtin_amdgcn_mfma_f32_16x16x32_bf16(Aw[1], B1, lin, 0, 0, 0);
        float I[4] = {lin[0], lin[1], lin[2], lin[3]};
#pragma unroll
        for (int h = 0; h < 8; ++h) { pg8::f32x4 a = {0.f, 0.f, 0.f, 0.f};
            a = __builtin_amdgcn_mfma_f32_16x16x32_bf16(Af[h][0], B0, a, 0, 0, 0);
            a = __builtin_amdgcn_mfma_f32_16x16x32_bf16(Af[h][1], B1, a, 0, 0, 0);
#pragma unroll
            for (int r = 0; r < 4; ++r) I[r] = __builtin_fmaf(wv[r][h], __builtin_fabsf(a[r]), I[r]); }
        const int kidx = kt * 16 + fr;
#pragma unroll
        for (int r = 0; r < 4; ++r) { const unsigned key = f16key(I[r]); Ik[(fq * 4 + r) * 4096 + kidx] = (unsigned short)key;
            if (kidx <= q0 + fq * 4 + r) atomicAdd(&hist1[(fq * 4 + r) * 256 + (key >> 8)], 1u); }
        B0 = nB0; B1 = nB1;
    }
    __syncthreads();
    for (int qq = w; qq < 16; qq += NWAVES) {
        const int t = q0 + qq, n = t + 1;
        unsigned short* so = (unsigned short*)(hist1 + qq * 256);
        const unsigned short* keys = Ik + qq * 4096;
        if (n <= TOPK) { for (int j = lane; j < n; j += 64) so[j] = (unsigned short)j; }
        else {
            int b1, rem1, b2, rem2;
            find_bin(hist1 + qq * 256, TOPK, lane, b1, rem1);
            *(v4u*)(hist + 4 * lane) = (v4u){0u, 0u, 0u, 0u};
            LDS_WAIT(); __builtin_amdgcn_wave_barrier();
            for (int j0 = 0; j0 < n; j0 += 512) { unsigned k4[8];
#pragma unroll
                for (int u = 0; u < 8; ++u) { const int j = j0 + u * 64 + lane; k4[u] = keys[j < 4095 ? j : 4095]; }
#pragma unroll
                for (int u = 0; u < 8; ++u) { const int j = j0 + u * 64 + lane; if (j < n && (int)(k4[u] >> 8) == b1) atomicAdd(&hist[k4[u] & 255u], 1u); } }
            LDS_WAIT(); __builtin_amdgcn_wave_barrier();
            find_bin(hist, rem1, lane, b2, rem2);
            const unsigned thr = ((unsigned)b1 << 8) | (unsigned)b2;
            int base = 0, eqtaken = 0;
            const unsigned long long lt = (lane == 0) ? 0ull : (~0ull >> (64 - lane));
            for (int j0 = 0; j0 < n; j0 += 512) { unsigned k4[8];
#pragma unroll
                for (int u = 0; u < 8; ++u) { const int j = j0 + u * 64 + lane; k4[u] = keys[j < 4095 ? j : 4095]; }
#pragma unroll
                for (int u = 0; u < 8; ++u) {
                    const int j = j0 + u * 64 + lane; const bool valid = j < n; const unsigned k = valid ? k4[u] : 0u;
                    const bool gt = valid && k > thr, eq = valid && k == thr;
                    const unsigned long long meq = __ballot(eq);
                    const int erank = __popcll(meq & lt) + eqtaken;
                    const bool take = gt || (eq && erank < rem2);
                    const unsigned long long mt = __ballot(take);
                    if (take) so[base + __popcll(mt & lt)] = (unsigned short)j;
                    base += __popcll(mt); eqtaken += __popcll(meq);
                }
            }
        }
    }
    __syncthreads();
}

template <int NB>
__device__ __forceinline__ void qknorm_tokens(const Params& p, const int (&toks)[NB], int lane, const float (&qg)[8], const float (&kg)[8]) {
    v4u qv[NB], kv[NB], vv[NB];
#pragma unroll
    for (int n = 0; n < NB; ++n) { const bf16* row = (const bf16*)(p.ws + WS_ATT) + (size_t)toks[n] * LD_ATT;
        qv[n] = *(const v4u*)(row + lane * 8); kv[n] = *(const v4u*)(row + 512 + (lane & 15) * 8); vv[n] = *(const v4u*)(row + 640 + (lane & 15) * 8); }
#pragma unroll
    for (int n = 0; n < NB; ++n) { const int tok = toks[n];
        { float x[8]; float ss = 0.f;
#pragma unroll
          for (int i = 0; i < 4; ++i) { x[2 * i] = bflo(qv[n][i]); x[2 * i + 1] = bfhi(qv[n][i]); ss += x[2 * i] * x[2 * i] + x[2 * i + 1] * x[2 * i + 1]; }
          ss += __shfl_xor(ss, 1); ss += __shfl_xor(ss, 2); ss += __shfl_xor(ss, 4);
          const float rs = rsqrtf(ss * (1.f / 64.f) + RMS_EPS) * (0.125f * 1.4426950408889634f);
#pragma unroll
          for (int i = 0; i < 8; ++i) x[i] = x[i] * rs * qg[i];
          v2u hw, lw;
          hw.x = pk4_fp8(x[0], x[1], x[2], x[3]); hw.y = pk4_fp8(x[4], x[5], x[6], x[7]);
          { const f32x2 d0 = __builtin_amdgcn_cvt_pk_f32_fp8((int)hw.x, false), d1 = __builtin_amdgcn_cvt_pk_f32_fp8((int)hw.x, true), d2 = __builtin_amdgcn_cvt_pk_f32_fp8((int)hw.y, false), d3 = __builtin_amdgcn_cvt_pk_f32_fp8((int)hw.y, true);
            lw.x = pk4_fp8(x[0] - d0[0], x[1] - d0[1], x[2] - d1[0], x[3] - d1[1]); lw.y = pk4_fp8(x[4] - d2[0], x[5] - d2[1], x[6] - d3[0], x[7] - d3[1]); }
          *(v2u*)(p.ws + WS_QHI + (size_t)tok * 512 + lane * 8) = hw; *(v2u*)(p.ws + WS_QLO + (size_t)tok * 512 + lane * 8) = lw; }
        { float x[8]; float ss = 0.f;
#pragma unroll
          for (int i = 0; i < 4; ++i) { x[2 * i] = bflo(kv[n][i]); x[2 * i + 1] = bfhi(kv[n][i]); ss += x[2 * i] * x[2 * i] + x[2 * i + 1] * x[2 * i + 1]; }
          ss += __shfl_xor(ss, 1); ss += __shfl_xor(ss, 2); ss += __shfl_xor(ss, 4);
          const float rs = rsqrtf(ss * (1.f / 64.f) + RMS_EPS);
#pragma unroll
          for (int i = 0; i < 8; ++i) x[i] = x[i] * rs * kg[i];
          v2u o; o.x = pk4_fp8(x[0], x[1], x[2], x[3]); o.y = pk4_fp8(x[4], x[5], x[6], x[7]);
          if (lane < 16) *(v2u*)(p.ws + WS_K8 + (size_t)tok * 128 + lane * 8) = o; }
        { v2u o; o.x = pk4_fp8(bflo(vv[n][0]), bfhi(vv[n][0]), bflo(vv[n][1]), bfhi(vv[n][1])); o.y = pk4_fp8(bflo(vv[n][2]), bfhi(vv[n][2]), bflo(vv[n][3]), bfhi(vv[n][3]));
          if (lane < 16) *(v2u*)(p.ws + WS_V8 + (size_t)tok * 128 + lane * 8) = o; }
    }
}

typedef short v4i16_t __attribute__((ext_vector_type(4)));
__device__ __forceinline__ v4i16_t vtr16(const bf16* ldsp) { return __builtin_amdgcn_ds_read_tr16_b64_v4i16((LAS v4i16_t*)ldsp); }
typedef int v2i_t __attribute__((ext_vector_type(2)));
__device__ __forceinline__ long vtr8(const unsigned char* ldsp) { const v2i_t r = __builtin_amdgcn_ds_read_tr8_b64_v2i32((LAS v2i_t*)ldsp); return (long)(((unsigned long long)(unsigned)r[1] << 32) | (unsigned)r[0]); }
__device__ __forceinline__ void dsa2_query(const Params& p, unsigned char* ldsw, const unsigned short* sel, int b, int t, int lane) {
    unsigned char* ws = p.ws;
    const bf16* ATT = (const bf16*)(ws + WS_ATT);
    bf16* YB = (bf16*)(ws + WS_H);
    unsigned short* sl = (unsigned short*)ldsw;
    float* df = (float*)(ldsw + 512);
    unsigned char* Vl = ldsw + 1536;
    const unsigned char* V8 = ws + WS_V8;
    const int fr = lane & 15, fq = lane >> 4;
    const size_t rowb = (size_t)b * SEQ;
    const int cnt = (t + 1 < TOPK) ? (t + 1) : TOPK;
    { v2u sv = *(const v2u*)(sel + lane * 4);
      const int j0 = lane * 4;
      if (j0 >= cnt) sv.x = 0u; else if (j0 + 1 >= cnt) sv.x &= 0xffffu;
      if (j0 + 2 >= cnt) sv.y = 0u; else if (j0 + 3 >= cnt) sv.y &= 0xffffu;
      *(v2u*)(sl + lane * 4) = sv;
      f32x4 d4; d4[0] = (j0 < cnt) ? (float)(t - (int)(sv.x & 0xffffu)) : INFINITY; d4[1] = (j0 + 1 < cnt) ? (float)(t - (int)(sv.x >> 16)) : INFINITY;
      d4[2] = (j0 + 2 < cnt) ? (float)(t - (int)(sv.y & 0xffffu)) : INFINITY; d4[3] = (j0 + 3 < cnt) ? (float)(t - (int)(sv.y >> 16)) : INFINITY;
      *(f32x4*)(df + lane * 4) = d4; }
    LDS_WAIT(); __builtin_amdgcn_wave_barrier();
    const unsigned char* K8 = ws + WS_K8;
    long qhA[2] = {0, 0}, qhB[2] = {0, 0}, qlA[2] = {0, 0}, qlB[2] = {0, 0};
    if (fr < 8) { const v4u qh = *(const v4u*)(ws + WS_QHI + (rowb + t) * 512 + fr * 64 + fq * 16), ql = *(const v4u*)(ws + WS_QLO + (rowb + t) * 512 + fr * 64 + fq * 16);
        const long hA = (long)(((unsigned long long)qh.y << 32) | qh.x), hB = (long)(((unsigned long long)qh.w << 32) | qh.z), lA = (long)(((unsigned long long)ql.y << 32) | ql.x), lB = (long)(((unsigned long long)ql.w << 32) | ql.z);
        if (fr < 4) { qhA[0] = hA; qhB[0] = hB; qlA[0] = lA; qlB[0] = lB; } else { qhA[1] = hA; qhB[1] = hB; qlA[1] = lA; qlB[1] = lB; } }
    pg8::f32x4 sc[16];
    v4u vv[8];
    {
        v4u G[8];
        unsigned char* kst = Vl;
        const int ksw = ((lane & 7) ^ (lane >> 3)) & 7;
#define K_LOADS(STEP) do { _Pragma("unroll") for (int j = 0; j < 8; ++j) { const int s_ = sl[(STEP) * 64 + j * 8 + (lane >> 3)]; G[j] = *(const v4u*)(K8 + (rowb + s_) * 128 + ((ksw ^ (j & 1)) & 7) * 16); } } while (0)
        K_LOADS(0);
#pragma unroll
        for (int step = 0; step < 4; ++step) {
            LDS_WAIT(); __builtin_amdgcn_wave_barrier();
#pragma unroll
            for (int j = 0; j < 8; ++j) *(v4u*)(kst + j * 1024 + lane * 16) = G[j];
            __builtin_amdgcn_sched_barrier(0);
            if (step < 3) K_LOADS(step + 1);
            else {
#pragma unroll
                for (int j = 0; j < 8; ++j) { const int s = sl[j * 8 + (lane >> 3)]; vv[j] = *(const v4u*)(V8 + (rowb + s) * 128 + (lane & 7) * 16); } }
            __builtin_amdgcn_sched_barrier(0);
            LDS_WAIT(); __builtin_amdgcn_wave_barrier();
#pragma unroll
            for (int kt = 0; kt < 4; ++kt) { pg8::f32x4 a = {0.f, 0.f, 0.f, 0.f};
#pragma unroll
                for (int gg = 0; gg < 2; ++gg) { const v4u kv = *(const v4u*)(kst + (kt * 16 + fr) * 128 + (((gg * 4 + fq) ^ (fr & 7) ^ (fr >> 3)) & 7) * 16);
                    const long kA = (long)(((unsigned long long)kv.y << 32) | kv.x), kB = (long)(((unsigned long long)kv.w << 32) | kv.z);
                    a = __builtin_amdgcn_mfma_f32_16x16x32_fp8_fp8(kA, qhA[gg], a, 0, 0, 0); a = __builtin_amdgcn_mfma_f32_16x16x32_fp8_fp8(kB, qhB[gg], a, 0, 0, 0);
                    a = __builtin_amdgcn_mfma_f32_16x16x32_fp8_fp8(kA, qlA[gg], a, 0, 0, 0); a = __builtin_amdgcn_mfma_f32_16x16x32_fp8_fp8(kB, qlB[gg], a, 0, 0, 0); }
                sc[step * 4 + kt] = a; }
        }
#undef K_LOADS
    }
    const float slope = exp2f(-(float)((fr & 7) + 1)) * 1.4426950408889634f;
    float m = -INFINITY;
#pragma unroll
    for (int kt = 0; kt < 16; ++kt) { const f32x4 d4 = *(const f32x4*)(df + kt * 16 + fq * 4);
#pragma unroll
        for (int r = 0; r < 4; ++r) { const float x = sc[kt][r] - slope * d4[r]; sc[kt][r] = x; m = fmaxf(m, x); } }
    m = fmaxf(m, __shfl_xor(m, 16)); m = fmaxf(m, __shfl_xor(m, 32));
    float l = 0.f;
#pragma unroll
    for (int kt = 0; kt < 16; ++kt)
#pragma unroll
        for (int r = 0; r < 4; ++r) { const float e = __builtin_amdgcn_exp2f(sc[kt][r] - m); sc[kt][r] = e; l += e; }
    l += __shfl_xor(l, 16); l += __shfl_xor(l, 32);
    const float inv = 1.f / l;
    pg8::f32x4 o[2][4];
#pragma unroll
    for (int g2 = 0; g2 < 2; ++g2)
#pragma unroll
        for (int dt = 0; dt < 4; ++dt) o[g2][dt] = (pg8::f32x4){0.f, 0.f, 0.f, 0.f};
    unsigned char* vdst = Vl + ((lane & 7) >> 2) * 6400 + (lane >> 3) * 80 + (lane & 3) * 16;
#pragma unroll
    for (int ch = 0; ch < 4; ++ch) {
        LDS_WAIT(); __builtin_amdgcn_wave_barrier();
#pragma unroll
        for (int j = 0; j < 8; ++j) *(v4u*)(vdst + ((j >> 2) * 40 + ((j >> 1) & 1) * 24 + (j & 1) * 8) * 80) = vv[j];
        if (ch < 3) {
#pragma unroll
            for (int j = 0; j < 8; ++j) { const int s = sl[(ch + 1) * 64 + j * 8 + (lane >> 3)]; vv[j] = *(const v4u*)(V8 + (rowb + s) * 128 + (lane & 7) * 16); } }
        LDS_WAIT(); __builtin_amdgcn_wave_barrier();
#pragma unroll
        for (int k2 = 0; k2 < 2; ++k2) { const int kt0 = ch * 4 + 2 * k2;
            const long pb = (long)(((unsigned long long)pk4_fp8(sc[kt0 + 1][0], sc[kt0 + 1][1], sc[kt0 + 1][2], sc[kt0 + 1][3]) << 32) | pk4_fp8(sc[kt0][0], sc[kt0][1], sc[kt0][2], sc[kt0][3]));
            const int q = fr >> 1, prow = k2 * 40 + ((q < 4) ? (fq * 4 + q) : (24 + fq * 4 + (q - 4)));
#pragma unroll
            for (int g2 = 0; g2 < 2; ++g2)
#pragma unroll
                for (int dt = 0; dt < 4; ++dt) o[g2][dt] = __builtin_amdgcn_mfma_f32_16x16x32_fp8_fp8(vtr8(Vl + g2 * 6400 + prow * 80 + dt * 16 + (fr & 1) * 8), pb, o[g2][dt], 0, 0, 0); }
    }
    { const float i8 = inv * 8.f; unsigned char* yp = (unsigned char*)YB + (rowb + t) * 1024 + 512 + fr * 64 + fq * 4;
      if (fr < 4) {
#pragma unroll
          for (int dt = 0; dt < 4; ++dt) *(unsigned*)(yp + dt * 16) = pk4_fp8(o[0][dt][0] * i8, o[0][dt][1] * i8, o[0][dt][2] * i8, o[0][dt][3] * i8); }
      else if (fr < 8) {
#pragma unroll
          for (int dt = 0; dt < 4; ++dt) *(unsigned*)(yp + dt * 16) = pk4_fp8(o[1][dt][0] * i8, o[1][dt][1] * i8, o[1][dt][2] * i8, o[1][dt][3] * i8); } }
    LDS_WAIT(); __builtin_amdgcn_wave_barrier();
}

#define INS16(L, x) do { _Pragma("unroll") for (int _i = 15; _i >= 1; --_i) L[_i] = __builtin_amdgcn_fmed3f(L[_i - 1], L[_i], (x)); L[0] = fmaxf(L[0], (x)); } while (0)
__device__ __forceinline__ float f_andor(float v, unsigned keepmask, unsigned orv) { return __builtin_bit_cast(float, (__builtin_bit_cast(unsigned, v) & keepmask) | orv); }
__device__ __forceinline__ void peer_select(const Params& p, unsigned char* ldsw, int tg, int h, int lane, int* EIDX, float* GATES) {
    float* sc = (float*)ldsw;
    LDS_WAIT(); __builtin_amdgcn_wave_barrier();
    float L[16];
#pragma unroll
    for (int i = 0; i < 16; ++i) L[i] = -INFINITY;
    { const float* sp = sc + (lane & 31) * 132 + (lane >> 5) * 64;
#pragma unroll 4
      for (int i = 0; i < 16; ++i) { const f32x4 x = *(const f32x4*)(sp + 4 * i); INS16(L, x[0]); INS16(L, x[1]); INS16(L, x[2]); INS16(L, x[3]); } }
    { float O[16];
#pragma unroll
      for (int i = 0; i < 16; ++i) O[i] = __shfl_xor(L[i], 32);
#pragma unroll
      for (int i = 0; i < 16; ++i) INS16(L, O[i]); }
    LDS_WAIT(); __builtin_amdgcn_wave_barrier();
    float* lst = sc;
    if (lane < 32) {
#pragma unroll
        for (int i = 0; i < 4; ++i) *(f32x4*)(lst + lane * 16 + 4 * i) = (f32x4){L[4 * i], L[4 * i + 1], L[4 * i + 2], L[4 * i + 3]}; }
    LDS_WAIT(); __builtin_amdgcn_wave_barrier();
    const int tok = lane & 15;
    float s1[16], s2[16];
#pragma unroll
    for (int i = 0; i < 4; ++i) { const f32x4 a = *(const f32x4*)(lst + tok * 16 + 4 * i), b = *(const f32x4*)(lst + (16 + tok) * 16 + 4 * i);
#pragma unroll
        for (int c = 0; c < 4; ++c) { s1[4 * i + c] = f_andor(a[c], ~127u, 0u); s2[4 * i + c] = f_andor(b[c], ~127u, 0u); } }
    float M[16];
#pragma unroll
    for (int i = 0; i < 16; ++i) M[i] = -INFINITY;
#pragma unroll
    for (int a = 0; a < 16; ++a)
#pragma unroll
        for (int b = 0; b < 16; ++b)
            if ((a + 1) * (b + 1) <= 16) { const float key = f_andor(s1[a] + s2[b], ~255u, (unsigned)(a * 16 + b)); INS16(M, key); }
    const float mx = f_andor(M[0], ~255u, 0u);
    float e[16], sum = 0.f; int ei[16];
    const unsigned* lb = (const unsigned*)lst;
#pragma unroll
    for (int i = 0; i < 16; ++i) { const unsigned bits = __builtin_bit_cast(unsigned, M[i]); const int flat = bits & 255u;
        e[i] = __expf(f_andor(M[i], ~255u, 0u) - mx); sum += e[i];
        ei[i] = (int)(lb[tok * 16 + (flat >> 4)] & 127u) * 128 + (int)(lb[(16 + tok) * 16 + (flat & 15)] & 127u); }
    const float inv = 1.f / sum;
    if (lane < 16) {
        const size_t ob = ((size_t)tok * 8 + h) * 16;
#pragma unroll
        for (int i = 0; i < 4; ++i) { *(v4u*)(EIDX + ob + 4 * i) = (v4u){(unsigned)ei[4 * i], (unsigned)ei[4 * i + 1], (unsigned)ei[4 * i + 2], (unsigned)ei[4 * i + 3]};
            *(f32x4*)(GATES + ob + 4 * i) = (f32x4){e[4 * i] * inv, e[4 * i + 1] * inv, e[4 * i + 2] * inv, e[4 * i + 3] * inv}; }
    }
    LDS_WAIT(); __builtin_amdgcn_wave_barrier();
}

__device__ __forceinline__ void peer_route_block(const Params& p, unsigned char* lds, int* eG, float* gG) {
    const int tid = threadIdx.x, wave = tid >> 6, lane = tid & 63, fr = lane & 15, fq = lane >> 4, G = gridDim.x;
    unsigned char* ws = p.ws;
    const bf16* Q = (const bf16*)(ws + WS_Q);
    const unsigned char* SKb = ws + WS_SK;
    unsigned char* tile = lds + 8 * 16896;
    float* sc = (float*)(lds + wave * 16896);
    int ngrp = 0;
    for (int tg = blockIdx.x; tg < T / 16; tg += G) ++ngrp;
#pragma unroll 1
    for (int k0 = 0; k0 < ngrp; k0 += 8) {
        const bool valid = k0 + wave < ngrp;
        const int tg = (int)blockIdx.x + (valid ? k0 + wave : k0) * G;
        v4u t[4][2];
        bf16x8 An[2][4];
#pragma unroll
        for (int sub = 0; sub < 4; ++sub) { const unsigned char* sp = SKb + (size_t)sub * 16384 + tid * 32; t[sub][0] = *(const v4u*)sp; t[sub][1] = *(const v4u*)(sp + 16); }
#pragma unroll
        for (int pp = 0; pp < 2; ++pp) { const bf16* rp = Q + (size_t)(tg * 16 + fr) * 2048 + pp * 128 + fq * 8;
#pragma unroll
            for (int ks = 0; ks < 4; ++ks) An[pp][ks] = *(const bf16x8*)(rp + ks * 32); }
#pragma unroll 1
        for (int h = 0; h < 8; ++h) {
            bf16x8 Af[2][4];
#pragma unroll
            for (int pp = 0; pp < 2; ++pp)
#pragma unroll
                for (int ks = 0; ks < 4; ++ks) Af[pp][ks] = An[pp][ks];
            const int hn = (h + 1) & 7;
#pragma unroll
            for (int sub = 0; sub < 4; ++sub) {
                const int pp = sub >> 1, half = sub & 1;
                __syncthreads();
                { unsigned char* wp = tile + (tid >> 3) * 272 + (tid & 7) * 32; *(v4u*)wp = t[sub][0]; *(v4u*)(wp + 16) = t[sub][1]; }
                { const unsigned char* sp = SKb + (size_t)(hn * 4 + sub) * 16384 + tid * 32; t[sub][0] = *(const v4u*)sp; t[sub][1] = *(const v4u*)(sp + 16); }
                __syncthreads();
#pragma unroll
                for (int kt = 0; kt < 4; ++kt) {
                    pg8::f32x4 a = {0.f, 0.f, 0.f, 0.f};
#pragma unroll
                    for (int ks = 0; ks < 4; ++ks) { const bf16x8 bv = *(const bf16x8*)(tile + (kt * 16 + fr) * 272 + ks * 64 + fq * 16); a = __builtin_amdgcn_mfma_f32_16x16x32_bf16(Af[pp][ks], bv, a, 0, 0, 0); }
                    const int kg = (half * 4 + kt) * 16 + fr;
#pragma unroll
                    for (int r = 0; r < 4; ++r) sc[(pp * 16 + fq * 4 + r) * 132 + kg] = f_andor(a[r], ~127u, (unsigned)kg);
                }
            }
#pragma unroll
            for (int pp = 0; pp < 2; ++pp) { const bf16* rp = Q + (size_t)(tg * 16 + fr) * 2048 + hn * 256 + pp * 128 + fq * 8;
#pragma unroll
                for (int ks = 0; ks < 4; ++ks) An[pp][ks] = *(const bf16x8*)(rp + ks * 32); }
            if (valid) peer_select(p, (unsigned char*)sc, tg, h, lane, eG + (size_t)tg * 2048, gG + (size_t)tg * 2048);
        }
    }
}

__device__ __forceinline__ float gelu_erf(float x) { return 0.5f * x * (1.f + erff(x * 0.70710678118654752f)); }
typedef int v8i_t __attribute__((ext_vector_type(8)));
template <int OPSEL> __device__ __forceinline__ pg8::f32x4 mx_dot(v8i_t a, int sa, v8i_t b, int sb, pg8::f32x4 c) {
    return __builtin_amdgcn_mfma_scale_f32_16x16x128_f8f6f4(a, b, c, 4  , 4  , OPSEL, sa, OPSEL, sb);
}
template <int MODE>
__device__ __forceinline__ void peer_token(const Params& p, unsigned char* ldsw, const _Float16* usL, const _Float16* vsL, unsigned char* tile, int tok, int lane, const v2u nxt_e, const v2u nxt_g, int buf) {
    unsigned char* ws = p.ws;
    const unsigned char* V8 = ws + WS_V;
    const float* MOD = (const float*)(ws + WS_MOD);
    const int fr = lane & 15, fq = lane >> 4;
    typedef v8i_t v8i;
    const int* EIDX = (const int*)(ldsw + buf * 1024); const float* GATES = (const float*)(ldsw + buf * 1024 + 512);
    int* pe = (int*)(ldsw + buf * 1024); float* pa = (float*)(ldsw + buf * 1024 + 512);
    if (MODE == 1) {
    float* gGp = (float*)(ws + WS_PGATE) + (size_t)tok * 128;
    v4u A4[H4_NT][8]; v2u As[H4_NT];
#pragma unroll
    for (int t = 0; t < H4_NT; ++t) { const unsigned char* hp = ws + WS_H4D + ((size_t)tok * H4_NT + t) * 512 + fq * 16;
        As[t] = *(const v2u*)(ws + WS_H4S + ((size_t)tok * H4_NT + t) * 32 + fq * 8);
#pragma unroll
        for (int kk = 0; kk < 8; ++kk) A4[t][kk] = *(const v4u*)(hp + kk * 64); }
    const unsigned char* U4 = ws + WS_U;
    const int gr = lane >> 3, gs = lane & 7;
    const int rdbase = (fr >> 3) * 1024 + (fr & 7) * 128, slotA = (fq ^ (fr & 7) ^ (fr >> 3)) & 7;
    v4u G[8];
#define U_LOADS(CT) do { const int e0_ = EIDX[(CT) * 16 + gr], e1_ = EIDX[(CT) * 16 + 8 + gr]; \
        const unsigned char* p0_ = U4 + (size_t)e0_ * 512 + ((gs ^ gr) & 7) * 16; const unsigned char* p1_ = U4 + (size_t)e1_ * 512 + ((gs ^ gr ^ 1) & 7) * 16; \
        _Pragma("unroll") for (int kk = 0; kk < 8; ++kk) G[kk] = *(const v4u*)(((kk & 1) ? p1_ : p0_) + (kk >> 1) * 128); } while (0)
    U_LOADS(0);
#pragma unroll 1
    for (int ct = 0; ct < 8; ++ct) {
        const int eic = EIDX[ct * 16 + fr]; const float gt = GATES[ct * 16 + fr];
#pragma unroll
        for (int kk = 0; kk < 8; ++kk) *(v4u*)(tile + kk * 1024 + lane * 16) = G[kk];
        __builtin_amdgcn_sched_barrier(0);
        U_LOADS((ct + 1) & 7);
        __builtin_amdgcn_sched_barrier(0);
        LDS_WAIT(); __builtin_amdgcn_wave_barrier();
        v4u Bt[8];
#pragma unroll
        for (int j = 0; j < 8; ++j) Bt[j] = *(const v4u*)(tile + (j >> 1) * 2048 + rdbase + (((j & 1) ? (slotA ^ 4) : slotA) * 16));
        LDS_WAIT(); __builtin_amdgcn_wave_barrier();
        pg8::f32x4 ah = {0.f, 0.f, 0.f, 0.f};
#pragma unroll
        for (int kk = 0; kk < 8; ++kk) { const v4u bu = Bt[kk];
            const v8i bb = {(int)bu.x, (int)bu.y, (int)bu.z, (int)bu.w, 0, 0, 0, 0};
            const int sb = 0x7f7f7f7f;
#pragma unroll
            for (int t = 0; t < H4_NT; ++t) { const v8i aa = {(int)A4[t][kk].x, (int)A4[t][kk].y, (int)A4[t][kk].z, (int)A4[t][kk].w, 0, 0, 0, 0}; const int sa = (int)((kk < 4) ? As[t].x : As[t].y);
                if ((kk & 3) == 0) ah = mx_dot<0>(aa, sa, bb, sb, ah); else if ((kk & 3) == 1) ah = mx_dot<1>(aa, sa, bb, sb, ah); else if ((kk & 3) == 2) ah = mx_dot<2>(aa, sa, bb, sb, ah); else ah = mx_dot<3>(aa, sa, bb, sb, ah); } }
        const float dot = ah[0] * (float)usL[eic];
        if (fq == 0) gGp[ct * 16 + fr] = gelu_erf(dot) * gt * (float)vsL[eic];
    }
    asm volatile("" :: "v"(G[0]), "v"(G[1]), "v"(G[2]), "v"(G[3]), "v"(G[4]), "v"(G[5]), "v"(G[6]), "v"(G[7]));
#undef U_LOADS
    }
    __builtin_amdgcn_sched_barrier(0);
    { int* ne = (int*)(ldsw + (buf ^ 1) * 1024); float* ng = (float*)(ldsw + (buf ^ 1) * 1024 + 512);
      *(v2u*)(ne + 2 * lane) = nxt_e; *(v2u*)(ng + 2 * lane) = nxt_g; }
    if (MODE == 1) { LDS_WAIT(); __builtin_amdgcn_wave_barrier(); return; }
    const int hl = lane >> 5, bl = lane & 31;
    float acc[32];
#pragma unroll
    for (int i = 0; i < 32; ++i) acc[i] = 0.f;
    LDS_WAIT(); __builtin_amdgcn_wave_barrier();
#pragma unroll 1
    for (int ct = 0; ct < 16; ++ct)
#pragma unroll
        for (int jp = 0; jp < 4; ++jp) {
            const int idx = pe[ct * 8 + 2 * jp + hl]; const float as = pa[ct * 8 + 2 * jp + hl];
            const v4u vv = *(const v4u*)(V8 + (size_t)idx * 512 + bl * 16);
#pragma unroll
            for (int w4 = 0; w4 < 4; ++w4) { const unsigned wd = vv[w4];
                const f32x2 d0 = __builtin_amdgcn_cvt_scalef32_pk_f32_fp4(wd, 1.0f, 0), d1 = __builtin_amdgcn_cvt_scalef32_pk_f32_fp4(wd, 1.0f, 1), d2 = __builtin_amdgcn_cvt_scalef32_pk_f32_fp4(wd, 1.0f, 2), d3 = __builtin_amdgcn_cvt_scalef32_pk_f32_fp4(wd, 1.0f, 3);
                acc[8 * w4] += as * d0[0]; acc[8 * w4 + 1] += as * d0[1]; acc[8 * w4 + 2] += as * d1[0]; acc[8 * w4 + 3] += as * d1[1];
                acc[8 * w4 + 4] += as * d2[0]; acc[8 * w4 + 5] += as * d2[1]; acc[8 * w4 + 6] += as * d3[0]; acc[8 * w4 + 7] += as * d3[1]; }
        }
    LDS_WAIT(); __builtin_amdgcn_wave_barrier();
    float accs[16];
#pragma unroll
    for (int i = 0; i < 16; ++i) { const float lo = acc[i] + __shfl_xor(acc[i], 32), hi2 = acc[16 + i] + __shfl_xor(acc[16 + i], 32); accs[i] = hl ? hi2 : lo; }
    const int b = tok / SEQ;
    const int col0 = bl * 32 + hl * 16;
    const float* g2 = MOD + (size_t)b * 6144 + 5 * 1024 + col0;
    float* orow = p.out + (size_t)tok * DM + col0;
#pragma unroll
    for (int q4 = 0; q4 < 4; ++q4) { const f32x4 xv = *(const f32x4*)(orow + 4 * q4), gv = *(const f32x4*)(g2 + 4 * q4);
        f32x4 o;
#pragma unroll
        for (int i = 0; i < 4; ++i) o[i] = xv[i] + gv[i] * accs[4 * q4 + i];
        *(f32x4*)(orow + 4 * q4) = o; }
}

#define XB_TMO      128
#define XB_XCNT(j)  (256  + 64 * (j))
#define XB_XSUB(j)  (1280 + 64 * (j))
#define XB_XGEN(j)  (2304 + 64 * (j))
#define XB_TOP      3328
#define XB_TOPGEN   3392
#define XCD_BAR_WORDS 3456
#define XB_SPIN_CAP (1u << 18)

__device__ __forceinline__ unsigned xb_ld(unsigned* p)              { return __hip_atomic_load(p, __ATOMIC_RELAXED, __HIP_MEMORY_SCOPE_AGENT); }
__device__ __forceinline__ unsigned xb_add(unsigned* p, unsigned v) { return __hip_atomic_fetch_add(p, v, __ATOMIC_RELAXED, __HIP_MEMORY_SCOPE_AGENT); }
__device__ __forceinline__ unsigned xb_xcc_id() { return (unsigned)__builtin_amdgcn_s_getreg((3 << 11) | 20) & 0xFu; }
#define XB_SPIN(cond, bar) do { unsigned _sp = 0; while (cond) { __builtin_amdgcn_s_sleep(1); \
    if ((++_sp & 255u) == 0u) { if (xb_ld(&(bar)[XB_TMO])) break; if (_sp > XB_SPIN_CAP) { atomicAdd(&(bar)[XB_TMO], 1u); break; } } } } while (0)

struct XcdBarrier {
    unsigned* bar; unsigned x;
    volatile LAS unsigned* st;
};

__device__ __forceinline__ XcdBarrier xcd_barrier_post(unsigned* bar, volatile LAS unsigned* st) {
    XcdBarrier b; b.bar = bar; b.x = xb_xcc_id(); b.st = st;
    if (threadIdx.x == 0) (void)xb_add(&bar[XB_XCNT(b.x)], 1u);
    return b;
}
__device__ __forceinline__ void xcd_barrier_complete(unsigned* bar, unsigned x, unsigned& nloc, unsigned& nx) {
    const unsigned G = gridDim.x * gridDim.y * gridDim.z;
    unsigned sum, cnt, mine, sp = 0u;
    for (;;) {
        sum = 0u; cnt = 0u; mine = 0u;
#pragma unroll
        for (unsigned j = 0; j < 16; ++j) { const unsigned c = xb_ld(&bar[XB_XCNT(j)]); sum += c; cnt += (c > 0u) ? 1u : 0u; mine = (j == x) ? c : mine; }
        if (sum == G) break;
        __builtin_amdgcn_s_sleep(1);
        if ((++sp & 255u) == 0u) { if (xb_ld(&bar[XB_TMO])) break; if (sp > XB_SPIN_CAP) { atomicAdd(&bar[XB_TMO], 1u); break; } }
    }
    nloc = mine > 0u ? mine : 1u; nx = cnt > 0u ? cnt : 1u;
}

__device__ __forceinline__ void xcd_barrier(const XcdBarrier& b) {
    asm volatile("s_waitcnt vmcnt(0)" ::: "memory");
    __syncthreads();
    if (threadIdx.x == 0) {
        unsigned* bar = b.bar;
        __builtin_amdgcn_s_waitcnt(0);
        unsigned nloc = b.st[0], nx = b.st[1];
        if (nloc == 0u) { xcd_barrier_complete(bar, b.x, nloc, nx); b.st[0] = nloc; b.st[1] = nx; }
        const unsigned old = xb_add(&bar[XB_XSUB(b.x)], 1u);
        const unsigned gen = old / nloc;
        if (old + 1u == (gen + 1u) * nloc) {
            __builtin_amdgcn_fence(__ATOMIC_RELEASE, "agent");
            asm volatile("s_waitcnt vmcnt(0)" ::: "memory");
            const unsigned og = xb_add(&bar[XB_TOP], 1u);
            const unsigned tg = og / nx;
            if (og + 1u == (tg + 1u) * nx) xb_add(&bar[XB_TOPGEN], 1u);
            else XB_SPIN(xb_ld(&bar[XB_TOPGEN]) == tg, bar);
            __builtin_amdgcn_fence(__ATOMIC_ACQUIRE, "agent");
            xb_add(&bar[XB_XGEN(b.x)], 1u);
            asm volatile("s_waitcnt vmcnt(0)" ::: "memory");
        } else {
            XB_SPIN(xb_ld(&bar[XB_XGEN(b.x)]) == gen, bar);
            __builtin_amdgcn_fence(__ATOMIC_ACQUIRE, "agent");
            asm volatile("s_waitcnt vmcnt(0)" ::: "memory");
        }
    }
    __syncthreads();
}

constexpr int NPHASE = 11;
__global__ void __launch_bounds__(NTHREADS, 2) mega(Params p) {
    extern __shared__ __attribute__((aligned(16))) unsigned char lds[];
    cg::grid_group grid = cg::this_grid();
    const int lo = p.ph_lo, hi = p.ph_hi;
    const int tid = threadIdx.x, wave = tid >> 6, lane = tid & 63, G = gridDim.x;
    unsigned char* ws = p.ws;
#ifndef ONLYPH
#define IN(k) (lo <= (k) && (k) < hi)
#else
#define IN(k) ((k) == ONLYPH && lo <= (k) && (k) < hi)
#endif
    volatile LAS unsigned* xb_st = (volatile LAS unsigned*)((LAS unsigned char*)lds + (LDS_BYTES - 16));
    if (tid < 4) xb_st[tid] = 0u;
    __syncthreads();
    XcdBarrier xbar; xbar.bar = (unsigned*)(ws + WS_CTL); xbar.x = 0; xbar.st = xb_st;
    if (hi - lo > 1) xbar = xcd_barrier_post((unsigned*)(ws + WS_CTL), xb_st);
    if (lo < -1) grid.sync();
#define SEAM(k) do { if (IN((k) + 1)) xcd_barrier(xbar); } while (0)
#ifndef REPMASK
#define REPMASK 0
#endif
#define NREP(k) (((REPMASK >> (k)) & 1) ? 2 : 1)
    if (IN(0)) { for (int rep = 0; rep < NREP(0); ++rep) phase0(p, lds); SEAM(0); }
    if (IN(1)) { for (int rep = 0; rep < NREP(1); ++rep) normmod_phase<true>(p, lds, p.x, (bf16*)(ws + WS_H), p.norm1_g, 0, 1024); SEAM(1); }
    if (IN(2)) {
        { pg8::Gemm g{(const bf16*)(ws + WS_H8), (const bf16*)(ws + WS_WIN8), T, 3584, 512, 512, 512}; pg8::StaticOrder S; S.init(T, 3584, G, (int)blockIdx.x);
          EpiProj E{(bf16*)(ws + WS_HG), (bf16*)(ws + WS_ATT), (bf16*)(ws + WS_IDX), (bf16*)(ws + WS_GATE), 1};
          pg8::gemm_phase<EpiProj, pg8::StaticOrder, true, true, 122>((PG8_LAS unsigned char*)lds, g, S, E); }
        { pg8::Gemm g{(const bf16*)(ws + WS_H), (const bf16*)(ws + WS_WIN), T, 2048, 1024, 1024, 1024}; pg8::StaticOrder S; S.init(T, 2048, G, (int)blockIdx.x);
          EpiProj E{(bf16*)(ws + WS_HG), (bf16*)(ws + WS_ATT), (bf16*)(ws + WS_IDX), (bf16*)(ws + WS_GATE), 0};
          pg8::gemm_phase<EpiProj, pg8::StaticOrder, true, true>((PG8_LAS unsigned char*)lds, g, S, E); }
        SEAM(2);
    }
    if (IN(3)) {
        { float qg[8], kg[8];
#pragma unroll
          for (int i = 0; i < 8; ++i) { qg[i] = p.q_norm_g[(lane & 7) * 8 + i]; kg[i] = p.k_norm_g[(lane & 7) * 8 + i]; }
          int tok = (int)blockIdx.x * NWAVES + wave; const int st = G * NWAVES;
          for (; tok + 3 * st < T; tok += 4 * st) { const int tk[4] = {tok, tok + st, tok + 2 * st, tok + 3 * st}; qknorm_tokens<4>(p, tk, lane, qg, kg); }
          for (; tok < T; tok += st) { const int tk[1] = {tok}; qknorm_tokens<1>(p, tk, lane, qg, kg); } }
        SEAM(3);
    }
    if (IN(4)) {
        if ((int)blockIdx.x < 32) hgrn_item<0>(p, lds, (int)blockIdx.x); else if ((int)blockIdx.x < 64) hgrn_item<1>(p, lds, (int)blockIdx.x - 32);
        {
            unsigned* qctr = (unsigned*)(ws + WS_CTL + 32768);
            volatile LAS unsigned* qslot = (volatile LAS unsigned*)((LAS unsigned char*)lds + (LDS_BYTES - 32));
            int qsel = (int)(blockIdx.x & 7u), tried = 0;
            for (;;) {
                if (tid == 0) { unsigned c;
                    for (;;) { c = __hip_atomic_fetch_add(qctr + qsel * 64, 1u, __ATOMIC_RELAXED, __HIP_MEMORY_SCOPE_AGENT); if (c < (unsigned)(SEQ / 16) || tried >= 7) break; qsel = (qsel + 1) & 7; ++tried; }
                    *qslot = (c < (unsigned)(SEQ / 16)) ? (((unsigned)qsel << 16) | c) : 0xffffffffu; }
                __syncthreads();
                const unsigned c = *qslot;
                __syncthreads();
                if (c == 0xffffffffu) break;
                const int b = (int)(c >> 16), qblk = (SEQ / 16 - 1) - (int)(c & 0xffffu), it = b * (SEQ / 16) + qblk, q0 = qblk * 16;
                dsa1_item(p, lds, it);
#pragma unroll 1
                for (int k2 = 0; k2 < 2; ++k2) dsa2_query(p, lds + wave * 16384, (const unsigned short*)(lds + 131072 + (wave + 8 * k2) * 1024), b, q0 + wave + 8 * k2, lane);
                __syncthreads();
            }
        }
        if (hi - lo > 1) xcd_barrier(xbar);
        for (int wu = (int)blockIdx.x * NWAVES + wave; wu < 32 * 32 * 4; wu += G * NWAVES) { const int u = wu >> 2; hgrn_fix(p, u >> 5, u & 31, wu & 3, lane); }
        SEAM(4);
    }
    if (IN(5)) {
        pg8::Gemm g{(const bf16*)(ws + WS_H), (const bf16*)(ws + WS_WAB8), T, 1024, 256, 512, 512}; pg8::StaticOrderT<true> S; S.init(T, 1024, G, (int)blockIdx.x, 256);
        EpiMerged E{(const bf16*)(ws + WS_GATE), (bf16*)(ws + WS_MERGED)};
        for (int rep = 0; rep < NREP(5); ++rep) pg8::gemm_phase<EpiMerged, pg8::StaticOrderT<true>, true, true, 122>((PG8_LAS unsigned char*)lds, g, S, E);
        SEAM(5);
    }
    if (IN(6)) {
        pg8::Gemm g{(const bf16*)(ws + WS_MERGED), (const bf16*)(ws + WS_WOUT8), T, 1024, 512, 512, 512}; pg8::StaticOrder S; S.init(T, 1024, G, (int)blockIdx.x);
        EpiResid E{p.x, (const float*)(ws + WS_MOD) + 2048, p.out};
        for (int rep = 0; rep < NREP(6); ++rep) pg8::gemm_phase<EpiResid, pg8::StaticOrder, true, true, 120>((PG8_LAS unsigned char*)lds, g, S, E);
        SEAM(6);
    }
    if (IN(7)) { for (int rep = 0; rep < NREP(7); ++rep) normmod_phase<false>(p, lds, p.out, (bf16*)(ws + WS_H), p.norm2_g, 3 * 1024, 4 * 1024); SEAM(7); }
    if (IN(8)) {
        pg8::Gemm g{(const bf16*)(ws + WS_H), (const bf16*)(ws + WS_WQ), T, 2048, 1024, 1024, 1024}; pg8::StaticOrder S; S.init(T, 2048, G, (int)blockIdx.x);
        EpiStore E{(bf16*)(ws + WS_Q), 2048};
        for (int rep = 0; rep < NREP(8); ++rep) pg8::gemm_phase<EpiStore, pg8::StaticOrder, true, true>((PG8_LAS unsigned char*)lds, g, S, E);
        SEAM(8);
    }
    if (IN(9)) {
        int* eG = (int*)(ws + WS_EIDX); float* gG = (float*)(ws + WS_PGATE);
        peer_route_block(p, lds, eG, gG);
        asm volatile("s_waitcnt vmcnt(0)" ::: "memory");
        __syncthreads();
        _Float16* usL = (_Float16*)lds; _Float16* vsL = (_Float16*)(lds + 32768);
        for (int i = tid; i < NEXP / 8; i += NTHREADS) { ((v4u*)usL)[i] = ((const v4u*)(ws + WS_US))[i]; ((v4u*)vsL)[i] = ((const v4u*)(ws + WS_VS))[i]; }
        unsigned char* ldsw = lds + 65536 + wave * 3072;
        int ntok = 0;
        for (int tg = blockIdx.x; tg < T / 16; tg += G) ntok += 2;
        auto tok_of = [&](int j) { return ((int)blockIdx.x + (j >> 1) * G) * 16 + wave + 8 * (j & 1); };
        auto ld_lists = [&](int tok, v2u& e, v2u& g) {
            const unsigned* ep = (const unsigned*)(eG + (size_t)tok * 128 + 2 * lane); const unsigned* gp = (const unsigned*)(gG + (size_t)tok * 128 + 2 * lane);
            e.x = __hip_atomic_load(ep, __ATOMIC_RELAXED, __HIP_MEMORY_SCOPE_AGENT); e.y = __hip_atomic_load(ep + 1, __ATOMIC_RELAXED, __HIP_MEMORY_SCOPE_AGENT);
            g.x = __hip_atomic_load(gp, __ATOMIC_RELAXED, __HIP_MEMORY_SCOPE_AGENT); g.y = __hip_atomic_load(gp + 1, __ATOMIC_RELAXED, __HIP_MEMORY_SCOPE_AGENT); };
        if (ntok > 0) { v2u e0, g0; ld_lists(tok_of(0), e0, g0); *(v2u*)((int*)ldsw + 2 * lane) = e0; *(v2u*)((float*)(ldsw + 512) + 2 * lane) = g0; }
        __syncthreads();
#pragma unroll 1
        for (int j = 0; j < ntok; ++j) {
            v2u ne = {0u, 0u}, ng = {0u, 0u};
            if (j + 1 < ntok) ld_lists(tok_of(j + 1), ne, ng);
            peer_token<1>(p, ldsw, usL, vsL, lds + 90112 + wave * 8192, tok_of(j), lane, ne, ng, j & 1);
        }
        asm volatile("s_waitcnt vmcnt(0)" ::: "memory");
        __syncthreads();
        if (ntok > 0) { v2u e0, g0; ld_lists(tok_of(0), e0, g0); *(v2u*)((int*)ldsw + 2 * lane) = e0; *(v2u*)((float*)(ldsw + 512) + 2 * lane) = g0; }
        LDS_WAIT(); __builtin_amdgcn_wave_barrier();
#pragma unroll 1
        for (int j = 0; j < ntok; ++j) {
            v2u ne = {0u, 0u}, ng = {0u, 0u};
            if (j + 1 < ntok) ld_lists(tok_of(j + 1), ne, ng);
            peer_token<2>(p, ldsw, usL, vsL, lds + 90112 + wave * 8192, tok_of(j), lane, ne, ng, j & 1);
            LDS_WAIT(); __builtin_amdgcn_wave_barrier();
        }
    }
#undef IN
#undef SEAM
}

#ifndef ONE_LAUNCH
#define ONE_LAUNCH 1
#endif
extern "C" void kernel_launch(void* const* d_in, const int* in_sizes, int n_in, void* d_out, int out_size, void* d_ws, size_t ws_size, hipStream_t stream) {
    static int grid = 0;
    if (grid == 0) {
        if (n_in != 18 || out_size != T * DM || ws_size < WS_END) { fprintf(stderr, "kernel_launch: unexpected shapes (n_in %d, out %d, ws %zu)\n", n_in, out_size, ws_size); grid = -1; return; }
        int dev = 0, cus = 0, per_cu = 0;
        if (hipGetDevice(&dev) != hipSuccess || hipDeviceGetAttribute(&cus, hipDeviceAttributeMultiprocessorCount, dev) != hipSuccess) { grid = -1; return; }
        if (hipFuncSetAttribute((const void*)mega, hipFuncAttributeMaxDynamicSharedMemorySize, LDS_BYTES) != hipSuccess) { fprintf(stderr, "kernel_launch: hipFuncSetAttribute failed\n"); grid = -1; return; }
        if (hipOccupancyMaxActiveBlocksPerMultiprocessor(&per_cu, (const void*)mega, NTHREADS, LDS_BYTES) != hipSuccess || per_cu < 1) { fprintf(stderr, "kernel_launch: occupancy query says %d\n", per_cu); grid = -1; return; }
        (void)hipGetLastError();
        grid = cus;
        if (grid < 64) { grid = -1; return; }
    }
    if (grid < 0) return;
    Params p{};
    const float** pp = (const float**)&p;
    for (int i = 0; i < 18; ++i) pp[i] = (const float*)d_in[i];
    p.out = (float*)d_out; p.ws = (unsigned char*)d_ws;
#if ONE_LAUNCH
    if (hipMemsetAsync((char*)d_ws + WS_CTL, 0, 65536, stream) != hipSuccess) { fprintf(stderr, "kernel_launch: memset failed\n"); return; }
    p.ph_lo = 0; p.ph_hi = NPHASE;
    void* args[] = {&p};
    hipError_t e = hipLaunchCooperativeKernel((const void*)mega, dim3(grid), dim3(NTHREADS), args, LDS_BYTES, stream);
    if (e != hipSuccess) fprintf(stderr, "cooperative launch failed: %s (grid %d)\n", hipGetErrorString(e), grid);
#else
    for (int k = 0; k < NPHASE; ++k) { p.ph_lo = k; p.ph_hi = k + 1; hipLaunchKernelGGL(mega, dim3(grid), dim3(NTHREADS), LDS_BYTES, stream, p); }
#endif
}
```

```cpp
#include <hip/hip_runtime.h>
#include <hip/hip_cooperative_groups.h>
#include <cstdio>
#include <cstdint>
namespace cg = cooperative_groups;

namespace pg8 {
#define PG8_LAS __attribute__((address_space(3)))
typedef unsigned short bf16_t;
typedef short bf16x8 __attribute__((ext_vector_type(8)));
typedef float f32x4 __attribute__((ext_vector_type(4)));
typedef unsigned u32x4 __attribute__((ext_vector_type(4)));
constexpr int BM = 256, BK = 64, HALF = 128, HTB = HALF * BK * 2  , STAGE_BYTES = 8 * HTB, NXCD = 8, WGM = 8;

__host__ __device__ __forceinline__ int lds_byte(int r, int c) { const int st = (r >> 4) * 2 + (c >> 5), rr = r & 15, cc = c & 31, ob = rr * 64 + cc * 2; return st * 1024 + (ob ^ (((ob >> 9) & 1) << 5)); }
__host__ __device__ __forceinline__ void stage_rc(int b, int& R, int& C) { const int st = b / 1024, sb = b % 1024, swz = sb ^ (((sb >> 9) & 1) << 5); R = (st >> 1) * 16 + swz / 64; C = (st & 1) * 32 + (swz % 64) / 2; }
__host__ __device__ __forceinline__ int perm32(int rho) { const int n = rho >> 4, i = rho & 15; return 8 * (i >> 2) + 4 * n + (i & 3); }

struct Unit { int pm, pn, ko, pass; };
struct Gemm { const bf16_t* A; const bf16_t* Bt; int M, N, K, lda, ldb; };
typedef float f32x16 __attribute__((ext_vector_type(16)));
typedef f32x16 AccW[2][2][2];
__device__ __forceinline__ f32x4 acc_get(const AccW& A, int ai, int bj, int m, int n) { const int s_ = ((m & 1) * 2 + n) * 4; const f32x16& w = A[ai][bj][m >> 1]; return (f32x4){w[s_], w[s_ + 1], w[s_ + 2], w[s_ + 3]}; }
__device__ __forceinline__ void acc_set(AccW& A, int ai, int bj, int m, int n, f32x4 v) { const int s_ = ((m & 1) * 2 + n) * 4; f32x16& w = A[ai][bj][m >> 1]; w[s_] = v[0]; w[s_ + 1] = v[1]; w[s_ + 2] = v[2]; w[s_ + 3] = v[3]; }

template <bool TWOPASS_ORDER = false>
struct StaticOrderT {
    int nM, nN, nwg, G, c, kpass;
    __host__ __device__ void init(int M, int N, int G_, int c_, int kpass_ = 512) { nM = M / BM; nN = N / BM; nwg = nM * nN; G = G_; c = c_; kpass = kpass_; }
    __host__ __device__ bool next(int i, Unit& u) const {
        const long L = (long)(TWOPASS_ORDER ? (i >> 1) : i) * G + c; if (L >= nwg) return false;
        u.pass = TWOPASS_ORDER ? (i & 1) : 0; u.ko = TWOPASS_ORDER ? (i & 1) * kpass : 0;
        int wgid = (int)L; { const int q = nwg / NXCD, r = nwg % NXCD, xcd = wgid % NXCD, off = wgid / NXCD; wgid = (xcd < r ? xcd * (q + 1) : r * (q + 1) + (xcd - r) * q) + off; }
        const int nig = WGM * nN, gid = wgid / nig, fm = gid * WGM, gsz = (nM - fm) < WGM ? (nM - fm) : WGM;
        u.pm = fm + ((wgid % nig) % gsz); u.pn = (wgid % nig) / gsz; return true;
    }
    __device__ __forceinline__ void a_ready(const Unit&) const {}
    __device__ __forceinline__ void done(const Unit&) const {}
};
typedef StaticOrderT<false> StaticOrder;

__device__ __forceinline__ unsigned cvt_pk_bf16(float lo, float hi) { unsigned r; asm volatile("v_cvt_pk_bf16_f32 %0, %1, %2" : "=v"(r) : "v"(lo), "v"(hi)); return r; }

template <class Epi, class Sched, bool ALIGN_EPI = false, bool SP2 = false, int F8SCALE = 0>
__device__ __forceinline__ void gemm_phase(PG8_LAS unsigned char* lds, const Gemm g, const Sched& S, const Epi& E) {
    const int tid = threadIdx.x, wid = __builtin_amdgcn_readfirstlane(tid >> 6), lane = tid & 63, wr = wid >> 2, wc = wid & 3, fr = lane & 15, fq = lane >> 4;
    const int K = g.K, nt = K / BK;
    unsigned voffA[2], voffB[2];
#pragma unroll
    for (int i = 0; i < 2; ++i) { int R, C; stage_rc(tid * 16 + i * 8192, R, C); const int Rb = Epi::PERM ? ((R & ~31) + perm32(R & 31)) : R;
        voffA[i] = (unsigned)(R * g.lda + C) * 2u; voffB[i] = (unsigned)(Rb * g.ldb + C) * 2u; }
    const size_t kstep = (size_t)(BK * 2);
    const size_t hstepA = (size_t)HALF * g.lda * 2, hstepB = (size_t)HALF * g.ldb * 2;
    const size_t tstepA = 2 * hstepA, tstepB = 2 * hstepB;
    const unsigned ldsw = (unsigned)wid * 1024u;
    const int aoff = lds_byte(wr * 64 + fr, fq * 8), boff = lds_byte(wc * 32 + fr, fq * 8);
#define PG8_SA(b, h) (((b) * 2 + (h)) * HTB)
#define PG8_SB(b, h) ((4 + (b) * 2 + (h)) * HTB)
#define PG8_STAGE(bufoff, gbase, voff) do { _Pragma("unroll") for (int _i = 0; _i < 2; ++_i) \
        __builtin_amdgcn_global_load_lds((const unsigned*)((const char*)(gbase) + (voff)[_i]), (PG8_LAS unsigned*)(lds + (bufoff) + ldsw + _i * 8192), 16, 0, 0); } while (0)
#define PG8_LDA(dst, b, h) do { _Pragma("unroll") for (int m = 0; m < 4; ++m) { if constexpr (F8SCALE != 0) { \
        PG8_F8(dst)[m].lo = *(const PG8_LAS v4i_f*)(lds + PG8_SA(b, h) + aoff + m * 2048); PG8_F8(dst)[m].hi = *(const PG8_LAS v4i_f*)(lds + PG8_SA(b, h) + aoff + m * 2048 + 1024); } \
        else { _Pragma("unroll") for (int k = 0; k < 2; ++k) dst[m][k] = *(const PG8_LAS bf16x8*)(lds + PG8_SA(b, h) + aoff + m * 2048 + k * 1024); } } } while (0)
#define PG8_LDB(dst, b, h) do { _Pragma("unroll") for (int n = 0; n < 2; ++n) { if constexpr (F8SCALE != 0) { \
        PG8_F8(dst)[n].lo = *(const PG8_LAS v4i_f*)(lds + PG8_SB(b, h) + boff + n * 2048); PG8_F8(dst)[n].hi = *(const PG8_LAS v4i_f*)(lds + PG8_SB(b, h) + boff + n * 2048 + 1024); } \
        else { _Pragma("unroll") for (int k = 0; k < 2; ++k) dst[n][k] = *(const PG8_LAS bf16x8*)(lds + PG8_SB(b, h) + boff + n * 2048 + k * 1024); } } } while (0)
#define PG8_MMA(ai, bj, At, Bt) do { __builtin_amdgcn_s_setprio(1); _Pragma("unroll") for (int m = 0; m < 4; ++m) _Pragma("unroll") for (int n = 0; n < 2; ++n) { \
        f32x4 _c = acc_get(accw, ai, bj, m, n); \
        if constexpr (F8SCALE != 0) { _c = __builtin_amdgcn_mfma_scale_f32_16x16x128_f8f6f4(PG8_F8(Bt)[n], PG8_F8(At)[m], _c, 0, 0, 0, 0x7f7f7f7f, 0, F8SCALE * 0x01010101); } \
        else { _Pragma("unroll") for (int k = 0; k < 2; ++k) _c = __builtin_amdgcn_mfma_f32_16x16x32_bf16(Bt[n][k], At[m][k], _c, 0, 0, 0); } \
        acc_set(accw, ai, bj, m, n, _c); } \
        __builtin_amdgcn_s_setprio(0); } while (0)
#define PG8_WAIT_V(n) asm volatile("s_waitcnt vmcnt(" #n ")" ::: "memory")
#define PG8_WAIT_L(n) asm volatile("s_waitcnt lgkmcnt(" #n ")" ::: "memory")
#define PG8_BAR __builtin_amdgcn_s_barrier()
#define PG8_SCHED __builtin_amdgcn_sched_barrier(0)
    Unit cur, nxt; int ui = 0;
    if (!S.next(0, cur)) return;
    typedef int v4i_f __attribute__((ext_vector_type(4))); typedef int v8i_f __attribute__((ext_vector_type(8))); typedef f32x16 f32x16_f;
    AccW accw;
#pragma unroll
    for (int a = 0; a < 2; ++a)
#pragma unroll
        for (int b = 0; b < 2; ++b)
#pragma unroll
            for (int mp = 0; mp < 2; ++mp)
#pragma unroll
                for (int i = 0; i < 16; ++i) accw[a][b][mp][i] = 0.f;
    bf16x8 At[4][2], B0[2][2], B1[2][2];
    v8i_f At8[4], B08[2], B18[2];
#define PG8_F8(x) x##8
    const char* cA = (const char*)g.A + (size_t)cur.pm * tstepA + (size_t)cur.ko * 2; const char* cB = (const char*)g.Bt + (size_t)cur.pn * tstepB + (size_t)cur.ko * 2;
    S.a_ready(cur);
    if constexpr (SP2) {
        PG8_STAGE(PG8_SB(0, 0), cB, voffB); PG8_STAGE(PG8_SB(0, 1), cB + hstepB, voffB); PG8_STAGE(PG8_SA(0, 0), cA, voffA); PG8_STAGE(PG8_SA(0, 1), cA + hstepA, voffA);
        if (wr == 1) PG8_BAR;
        PG8_WAIT_V(2); PG8_BAR;
        PG8_STAGE(PG8_SB(1, 0), cB + kstep, voffB); PG8_STAGE(PG8_SA(1, 0), cA + kstep, voffA); PG8_STAGE(PG8_SB(1, 1), cB + hstepB + kstep, voffB);
        PG8_WAIT_V(6); PG8_BAR;
    } else {
        PG8_STAGE(PG8_SB(0, 0), cB, voffB); PG8_STAGE(PG8_SA(0, 0), cA, voffA); PG8_STAGE(PG8_SB(0, 1), cB + hstepB, voffB); PG8_STAGE(PG8_SA(0, 1), cA + hstepA, voffA);
        if (wr == 1) PG8_BAR;
        PG8_WAIT_V(4); PG8_BAR;
        PG8_STAGE(PG8_SB(1, 0), cB + kstep, voffB); PG8_STAGE(PG8_SA(1, 0), cA + kstep, voffA); PG8_STAGE(PG8_SB(1, 1), cB + hstepB + kstep, voffB);
        PG8_WAIT_V(6); PG8_BAR;
    }
    for (;;) {
        const bool has_next = S.next(ui + 1, nxt);
        const char* nA = has_next ? (const char*)g.A + (size_t)nxt.pm * tstepA + (size_t)nxt.ko * 2 : cA; const char* nB = has_next ? (const char*)g.Bt + (size_t)nxt.pn * tstepB + (size_t)nxt.ko * 2 : cB;
        for (int t = 0; t < nt; t += 2) {
            const bool last = (t == nt - 2);
            const char* a1 = cA + (size_t)(t + 1) * kstep;
            const char* a2 = last ? nA : cA + (size_t)(t + 2) * kstep; const char* b2 = last ? nB : cB + (size_t)(t + 2) * kstep;
            const char* a3 = a2 + kstep; const char* b3 = b2 + kstep;
            if (last && has_next) S.a_ready(nxt);
            if constexpr (SP2) {
            PG8_LDB(B0, 0, 0); PG8_LDB(B1, 0, 1); PG8_SCHED; PG8_LDA(At, 0, 0); PG8_STAGE(PG8_SA(1, 1), a1 + hstepA, voffA);
            PG8_WAIT_V(8); PG8_WAIT_L(0); PG8_BAR; PG8_MMA(0, 0, At, B0); PG8_MMA(0, 1, At, B1); PG8_BAR; PG8_SCHED;
            PG8_LDA(At, 0, 1); PG8_STAGE(PG8_SB(0, 0), b2, voffB); PG8_STAGE(PG8_SB(0, 1), b2 + hstepB, voffB); PG8_STAGE(PG8_SA(0, 0), a2, voffA);
            PG8_WAIT_V(8); PG8_WAIT_L(0); PG8_BAR; PG8_MMA(1, 0, At, B0); PG8_MMA(1, 1, At, B1); PG8_BAR; PG8_SCHED;
            PG8_LDB(B0, 1, 0); PG8_LDB(B1, 1, 1); PG8_SCHED; PG8_LDA(At, 1, 0); PG8_STAGE(PG8_SA(0, 1), a2 + hstepA, voffA);
            PG8_WAIT_V(8); PG8_WAIT_L(0); PG8_BAR; PG8_MMA(0, 0, At, B0); PG8_MMA(0, 1, At, B1); PG8_BAR; PG8_SCHED;
            PG8_LDA(At, 1, 1); PG8_STAGE(PG8_SB(1, 0), b3, voffB); PG8_STAGE(PG8_SB(1, 1), b3 + hstepB, voffB); PG8_STAGE(PG8_SA(1, 0), a3, voffA);
            PG8_WAIT_V(8); PG8_WAIT_L(0); PG8_BAR; PG8_MMA(1, 0, At, B0); PG8_MMA(1, 1, At, B1); PG8_BAR; PG8_SCHED;
            } else {
            PG8_LDB(B0, 0, 0); PG8_SCHED; PG8_LDA(At, 0, 0); PG8_STAGE(PG8_SA(1, 1), a1 + hstepA, voffA);
            PG8_WAIT_L(8); PG8_BAR; PG8_WAIT_L(0); PG8_MMA(0, 0, At, B0); PG8_BAR; PG8_SCHED;
            PG8_LDB(B1, 0, 1); PG8_STAGE(PG8_SB(0, 0), b2, voffB);
            PG8_BAR; PG8_WAIT_L(0); PG8_MMA(0, 1, At, B1); PG8_BAR;
            PG8_LDA(At, 0, 1); PG8_STAGE(PG8_SA(0, 0), a2, voffA);
            PG8_BAR; PG8_WAIT_L(0); PG8_MMA(1, 0, At, B0); PG8_BAR; PG8_SCHED;
            PG8_STAGE(PG8_SB(0, 1), b2 + hstepB, voffB);
            PG8_WAIT_V(6); PG8_BAR; PG8_MMA(1, 1, At, B1); PG8_BAR;
            PG8_LDB(B0, 1, 0); PG8_SCHED; PG8_LDA(At, 1, 0); PG8_STAGE(PG8_SA(0, 1), a2 + hstepA, voffA);
            PG8_WAIT_L(8); PG8_BAR; PG8_WAIT_L(0); PG8_MMA(0, 0, At, B0); PG8_BAR; PG8_SCHED;
            PG8_LDB(B1, 1, 1); PG8_STAGE(PG8_SB(1, 0), b3, voffB);
            PG8_BAR; PG8_WAIT_L(0); PG8_MMA(0, 1, At, B1); PG8_BAR;
            PG8_LDA(At, 1, 1); PG8_STAGE(PG8_SA(1, 0), a3, voffA);
            PG8_BAR; PG8_WAIT_L(0); PG8_MMA(1, 0, At, B0); PG8_BAR; PG8_SCHED;
            PG8_STAGE(PG8_SB(1, 1), b3 + hstepB, voffB);
            PG8_WAIT_V(6); PG8_BAR; PG8_MMA(1, 1, At, B1); PG8_BAR;
            }
        }
        if constexpr (ALIGN_EPI) { if (wr == 0) PG8_BAR; }
        if constexpr (!Epi::AFTER_DRAIN) { E(accw, cur, wr, wc, fr, fq); S.done(cur); }
        const bool keep_acc = Epi::TWOPASS && (cur.pass == 0);
        if (!has_next) break;
        if (!keep_acc) {
#pragma unroll
            for (int a = 0; a < 2; ++a)
#pragma unroll
                for (int b = 0; b < 2; ++b)
#pragma unroll
                    for (int mp = 0; mp < 2; ++mp)
#pragma unroll
                        for (int i = 0; i < 16; ++i) accw[a][b][mp][i] = 0.f;
        }
        cur = nxt; cA = nA; cB = nB; ++ui;
        if constexpr (ALIGN_EPI) { if (wr == 1) PG8_BAR; }
    }
    PG8_WAIT_V(0);
    if constexpr (!ALIGN_EPI) { if (wr == 0) PG8_BAR; }
    PG8_BAR;

#undef PG8_SA
#undef PG8_SB
#undef PG8_STAGE
#undef PG8_LDA
#undef PG8_LDB
#undef PG8_MMA
#undef PG8_F8
#undef PG8_WAIT_V
#undef PG8_WAIT_L
#undef PG8_BAR
#undef PG8_SCHED
}
}


constexpr int NWAVES = 8, NTHREADS = 512;
constexpr int BATCH = 8, SEQ = 4096, T = BATCH * SEQ, DM = 1024;
constexpr int INW = 5448;
constexpr int NPROJ = 5632;
constexpr int LD_HG = 2048, LD_ATT = 768, LD_IDX = 640, LD_GATE = 2048;
constexpr int TOPK = 256;
constexpr int NEXP = 16384;
constexpr float RMS_EPS = 1e-6f;

constexpr size_t MiB = 1u << 20;
constexpr size_t WS_CTL = 0;
constexpr size_t WS_MOD = MiB / 4;
constexpr size_t WS_MODP = MiB / 2;
constexpr size_t WS_WIN = 2 * MiB;
constexpr size_t WS_WQ = 17 * MiB;
constexpr size_t WS_SK = 21 * MiB;
constexpr size_t WS_U = 22 * MiB;
constexpr size_t WS_US = 30 * MiB;
constexpr size_t WS_V = 38 * MiB;
constexpr size_t WS_VS = 46 * MiB;
constexpr size_t WS_V8 = 8 * MiB;
constexpr size_t WS_K8 = 48 * MiB;
constexpr size_t WS_QHI = 52 * MiB;
constexpr size_t WS_QLO = 68 * MiB;
constexpr size_t WS_WAB8 = 31 * MiB;
constexpr size_t WS_WOUT8 = 32 * MiB;
constexpr size_t WS_WIN8 = 33 * MiB;
constexpr size_t WS_H8 = 48 * MiB;
constexpr size_t WS_H = 86 * MiB;
constexpr size_t WS_HG = 150 * MiB;
constexpr size_t WS_ATT = 278 * MiB;
constexpr size_t WS_IDX = 326 * MiB;
constexpr size_t WS_GATE = 366 * MiB;
constexpr size_t WS_SEL = 494 * MiB;
constexpr size_t WS_EIDX = 48 * MiB;
constexpr size_t WS_PGATE = 64 * MiB;
constexpr size_t WS_END = 510 * MiB;
constexpr size_t WS_HQC = 494 * MiB;
constexpr size_t WS_HOL = 118 * MiB;
constexpr size_t WS_HSB = 2 * MiB;
constexpr size_t WS_MERGED = WS_HG;
constexpr size_t WS_Q = 214 * MiB;
constexpr int H4_NT = 2;
constexpr size_t WS_H4D = 366 * MiB;
constexpr size_t WS_H4S = 416 * MiB;

constexpr int LDS_BYTES = 163840;

typedef unsigned short bf16;
typedef unsigned v4u __attribute__((ext_vector_type(4)));
typedef unsigned v2u __attribute__((ext_vector_type(2)));
typedef float f32x4 __attribute__((ext_vector_type(4)));
typedef float f32x2 __attribute__((ext_vector_type(2)));
typedef short bf16x8 __attribute__((ext_vector_type(8)));
#define LAS __attribute__((address_space(3)))

struct Params {
    const float *x, *c, *w_ada, *b_ada, *norm1_g, *norm2_g, *w_in, *hg_lb, *hg_onorm_g, *q_norm_g, *k_norm_g,
                *w_a, *w_b, *w_out, *peer_wq, *peer_subkeys, *peer_u, *peer_v;
    float* out; unsigned char* ws; int ph_lo, ph_hi;
};

typedef __bf16 bf16x2_hw __attribute__((ext_vector_type(2)));
__device__ __forceinline__ unsigned pk2(float lo, float hi) { const f32x2 v = {lo, hi}; const bf16x2_hw b = __builtin_convertvector(v, bf16x2_hw); return __builtin_bit_cast(unsigned, b); }
__device__ __forceinline__ unsigned f2bf(float f) { return pk2(f, 0.f) & 0xffffu; }
__device__ __forceinline__ float bf2f(unsigned u16v) { return __builtin_bit_cast(float, u16v << 16); }
__device__ __forceinline__ float bflo(unsigned w) { return __builtin_bit_cast(float, w << 16); }
__device__ __forceinline__ float bfhi(unsigned w) { return __builtin_bit_cast(float, w & 0xffff0000u); }
__device__ __forceinline__ float sigmoidf_(float x) { return __builtin_amdgcn_rcpf(1.f + __expf(-x)); }
__device__ __forceinline__ float siluf_(float x) { return x * __builtin_amdgcn_rcpf(1.f + __expf(-x)); }
__device__ __forceinline__ float wave_sum(float v) {
#pragma unroll
    for (int o = 1; o < 64; o <<= 1) v += __shfl_xor(v, o);
    return v;
}
__device__ __forceinline__ float wave_max(float v) {
#pragma unroll
    for (int o = 1; o < 64; o <<= 1) v = fmaxf(v, __shfl_xor(v, o));
    return v;
}
#define LDS_WAIT() asm volatile("s_waitcnt lgkmcnt(0)" ::: "memory")
__device__ __forceinline__ unsigned pk4_fp8(float a, float b, float c, float d) { int w = __builtin_amdgcn_cvt_pk_fp8_f32(a, b, 0, false); w = __builtin_amdgcn_cvt_pk_fp8_f32(c, d, w, true); return (unsigned)w; }

__host__ __device__ __forceinline__ int proj_tile_bf16(int i) { return i < 2 ? i + 2 : i + 6; }
__host__ __device__ __forceinline__ int proj_tile_fp8(int i) { return i < 2 ? i : (i < 6 ? i + 2 : i + 8); }
struct EpiProj {
    static constexpr bool PERM = true, AFTER_DRAIN = false, TWOPASS = false;
    bf16 *HG, *ATT, *IDX, *GATE; int f8;
    __device__ __forceinline__ void operator()(pg8::AccW& acc, const pg8::Unit& u, int wr, int wc, int fr, int fq) const {
        const int pn = f8 ? proj_tile_fp8(u.pn) : proj_tile_bf16(u.pn); bf16* base; int ldc, colt, ncols;
        if (pn < 8) { base = HG; ldc = LD_HG; colt = pn * 256; ncols = LD_HG; }
        else if (pn < 11) { base = ATT; ldc = LD_ATT; colt = (pn - 8) * 256; ncols = LD_ATT; }
        else if (pn < 14) { base = IDX; ldc = LD_IDX; colt = (pn - 11) * 256; ncols = LD_IDX; }
        else { base = GATE; ldc = LD_GATE; colt = (pn - 14) * 256; ncols = LD_GATE; }
        const int row0 = u.pm * 256 + wr * 64 + fr, col0 = colt + wc * 32 + 8 * fq;
#pragma unroll
        for (int ai = 0; ai < 2; ++ai)
#pragma unroll
            for (int m = 0; m < 4; ++m) { bf16* rowp = base + (size_t)(row0 + ai * 128 + m * 16) * ldc + col0;
#pragma unroll
                for (int bj = 0; bj < 2; ++bj) { const pg8::f32x4 v0 = pg8::acc_get(acc, ai, bj, m, 0), v1 = pg8::acc_get(acc, ai, bj, m, 1);
                    v4u w; w.x = pk2(v0[0], v0[1]); w.y = pk2(v0[2], v0[3]); w.z = pk2(v1[0], v1[1]); w.w = pk2(v1[2], v1[3]);
                    if (col0 + bj * 128 < ncols) *(v4u*)(rowp + bj * 128) = w; } }
    }
};
struct EpiMerged {
    static constexpr bool PERM = true, AFTER_DRAIN = false, TWOPASS = true;
    const bf16* GATE; bf16* O;
    __device__ __forceinline__ void operator()(pg8::AccW& acc, const pg8::Unit& u, int wr, int wc, int fr, int fq) const {
        const int row0 = u.pm * 256 + wr * 64 + fr, col0 = u.pn * 256 + wc * 32 + 8 * fq;
        if (u.pass == 0) {
#pragma unroll
            for (int ai = 0; ai < 2; ++ai)
#pragma unroll
                for (int m = 0; m < 4; ++m) { const bf16* rowp = GATE + (size_t)(row0 + ai * 128 + m * 16) * LD_GATE + col0;
#pragma unroll
                    for (int bj = 0; bj < 2; ++bj) { const v4u a = *(const v4u*)(rowp + bj * 128), b = *(const v4u*)(rowp + 1024 + bj * 128);
                        float r[8];
#pragma unroll
                        for (int i = 0; i < 4; ++i) { const float a0 = bflo(a[i]), a1 = bfhi(a[i]), b0 = bflo(b[i]), b1 = bfhi(b[i]);
                            r[2 * i] = (1.f + __expf(-b0)) * __builtin_amdgcn_rcpf(1.f + __expf(-a0)); r[2 * i + 1] = (1.f + __expf(-b1)) * __builtin_amdgcn_rcpf(1.f + __expf(-a1)); }
                        { pg8::f32x4 c0 = pg8::acc_get(acc, ai, bj, m, 0), c1 = pg8::acc_get(acc, ai, bj, m, 1);
#pragma unroll
                          for (int i = 0; i < 4; ++i) { c0[i] *= r[i]; c1[i] *= r[4 + i]; }
                          pg8::acc_set(acc, ai, bj, m, 0, c0); pg8::acc_set(acc, ai, bj, m, 1, c1); } } }
        } else {
#pragma unroll
            for (int ai = 0; ai < 2; ++ai)
#pragma unroll
                for (int m = 0; m < 4; ++m) { const size_t ro = (size_t)(row0 + ai * 128 + m * 16);
#pragma unroll
                    for (int bj = 0; bj < 2; ++bj) { const v4u b = *(const v4u*)(GATE + ro * LD_GATE + 1024 + col0 + bj * 128);
                        const pg8::f32x4 v0 = pg8::acc_get(acc, ai, bj, m, 0), v1 = pg8::acc_get(acc, ai, bj, m, 1);
                        float s[8];
#pragma unroll
                        for (int i = 0; i < 4; ++i) { s[2 * i] = sigmoidf_(bflo(b[i])); s[2 * i + 1] = sigmoidf_(bfhi(b[i])); }
                        v2u w; w.x = pk4_fp8(4.f * v0[0] * s[0], 4.f * v0[1] * s[1], 4.f * v0[2] * s[2], 4.f * v0[3] * s[3]); w.y = pk4_fp8(4.f * v1[0] * s[4], 4.f * v1[1] * s[5], 4.f * v1[2] * s[6], 4.f * v1[3] * s[7]);
                        *(v2u*)((unsigned char*)O + ro * 1024 + col0 + bj * 128) = w; } }
        }
    }
};
struct EpiResid {
    static constexpr bool PERM = true, AFTER_DRAIN = false, TWOPASS = false;
    const float* X; const float* G1  ; float* O;
    __device__ __forceinline__ void operator()(pg8::AccW& acc, const pg8::Unit& u, int wr, int wc, int fr, int fq) const {
        const int row0 = u.pm * 256 + wr * 64 + fr, col0 = u.pn * 256 + wc * 32 + 8 * fq;
        const int b = (u.pm * 256) / SEQ;
        f32x4 g[2][2];
#pragma unroll
        for (int bj = 0; bj < 2; ++bj)
#pragma unroll
            for (int n = 0; n < 2; ++n) g[bj][n] = *(const f32x4*)(G1 + (size_t)b * 6144 + col0 + bj * 128 + 4 * n);
#pragma unroll
        for (int ai = 0; ai < 2; ++ai)
#pragma unroll
            for (int m = 0; m < 4; ++m) { const size_t ro = (size_t)(row0 + ai * 128 + m * 16) * DM + col0;
#pragma unroll
                for (int bj = 0; bj < 2; ++bj)
#pragma unroll
                    for (int n = 0; n < 2; ++n) { const f32x4 xv = *(const f32x4*)(X + ro + bj * 128 + 4 * n);
                        *(f32x4*)(O + ro + bj * 128 + 4 * n) = xv + g[bj][n] * pg8::acc_get(acc, ai, bj, m, n); } }
    }
};
struct EpiStore {
    static constexpr bool PERM = true, AFTER_DRAIN = false, TWOPASS = false;
    bf16* O; int ldc;
    __device__ __forceinline__ void operator()(pg8::AccW& acc, const pg8::Unit& u, int wr, int wc, int fr, int fq) const {
        const int row0 = u.pm * 256 + wr * 64 + fr, col0 = u.pn * 256 + wc * 32 + 8 * fq;
#pragma unroll
        for (int ai = 0; ai < 2; ++ai)
#pragma unroll
            for (int m = 0; m < 4; ++m) { bf16* rowp = O + (size_t)(row0 + ai * 128 + m * 16) * ldc + col0;
#pragma unroll
                for (int bj = 0; bj < 2; ++bj) { const pg8::f32x4 v0 = pg8::acc_get(acc, ai, bj, m, 0), v1 = pg8::acc_get(acc, ai, bj, m, 1);
                    v4u w; w.x = pk2(v0[0], v0[1]); w.y = pk2(v0[2], v0[3]); w.z = pk2(v1[0], v1[1]); w.w = pk2(v1[2], v1[3]);
                    *(v4u*)(rowp + bj * 128) = w; } }
    }
};

template <int MODE> __device__ __forceinline__ int srcmap(int np) {
    if (MODE == 2) np = proj_tile_bf16(np >> 8) * 256 + (np & 255);
    if (MODE == 3) np = proj_tile_fp8(np >> 8) * 256 + (np & 255);
    if (MODE >= 1) return np < 3400 ? np : (np >= 3584 ? np - 184 : -1);
    return np; }
template <int MODE>
__device__ __forceinline__ void transpose_item(const float* W, int N, bf16* WT, int ldw, int koff, float* scr, int kb, int nb, int lane) {
    const int k0 = 64 * kb, n0 = 32 * nb;
    const int sc = srcmap<MODE>(n0 + (lane & 31));
#pragma unroll 8
    for (int i = 0; i < 32; ++i) { const int kk = 2 * i + (lane >> 5); scr[kk * 33 + (lane & 31)] = (sc >= 0) ? W[(size_t)(k0 + kk) * N + sc] : 0.f; }
    LDS_WAIT(); __builtin_amdgcn_wave_barrier();
    const int c = lane & 7;
#pragma unroll
    for (int j = 0; j < 4; ++j) { const int n = (lane >> 3) + 8 * j; const float* s = scr + (8 * c) * 33 + n;
        v4u o; o.x = pk2(s[0 * 33], s[1 * 33]); o.y = pk2(s[2 * 33], s[3 * 33]); o.z = pk2(s[4 * 33], s[5 * 33]); o.w = pk2(s[6 * 33], s[7 * 33]);
        *(v4u*)(WT + (size_t)(n0 + n) * ldw + koff + k0 + 8 * c) = o; }
    LDS_WAIT(); __builtin_amdgcn_wave_barrier();
}
template <int MODE> __device__ __forceinline__ int srcmap(int np);
template <int MODE = 0>
__device__ __forceinline__ void transpose_item8(const float* W, int N, unsigned char* WT, int ldw, int koff, float scale, float* scr, int kb, int nb, int lane) {
    const int k0 = 64 * kb, n0 = 32 * nb;
    const int sc = srcmap<MODE>(n0 + (lane & 31));
#pragma unroll 8
    for (int i = 0; i < 32; ++i) { const int kk = 2 * i + (lane >> 5); scr[kk * 33 + (lane & 31)] = (sc >= 0) ? W[(size_t)(k0 + kk) * N + sc] * scale : 0.f; }
    LDS_WAIT(); __builtin_amdgcn_wave_barrier();
    const int c = lane & 3;
#pragma unroll
    for (int j = 0; j < 2; ++j) { const int n = (lane >> 2) + 16 * j; const float* sp = scr + (16 * c) * 33 + n;
        v4u o;
#pragma unroll
        for (int q = 0; q < 4; ++q) o[q] = pk4_fp8(sp[(4 * q) * 33], sp[(4 * q + 1) * 33], sp[(4 * q + 2) * 33], sp[(4 * q + 3) * 33]);
        *(v4u*)(WT + (size_t)(n0 + n) * ldw + koff + k0 + 16 * c) = o; }
    LDS_WAIT(); __builtin_amdgcn_wave_barrier();
}
__device__ __forceinline__ void convert_plain(const float* src, bf16* dst, size_t n, size_t gtid, size_t nth) {
    const size_t n8 = n / 8;
    for (size_t i = gtid; i < n8; i += nth) { const f32x4 a = ((const f32x4*)src)[2 * i], b = ((const f32x4*)src)[2 * i + 1];
        v4u o; o.x = pk2(a[0], a[1]); o.y = pk2(a[2], a[3]); o.z = pk2(b[0], b[1]); o.w = pk2(b[2], b[3]); ((v4u*)dst)[i] = o; }
}
__device__ __forceinline__ void convert_fp8(const float* src, unsigned char* dst, size_t n, float scale, size_t gtid, size_t nth) {
    const size_t n16 = n / 16;
    for (size_t i = gtid; i < n16; i += nth) { const f32x4* sp = (const f32x4*)src + 4 * i; const f32x4 a = sp[0] * scale, b = sp[1] * scale, c = sp[2] * scale, d = sp[3] * scale;
        v4u o; o.x = pk4_fp8(a[0], a[1], a[2], a[3]); o.y = pk4_fp8(b[0], b[1], b[2], b[3]); o.z = pk4_fp8(c[0], c[1], c[2], c[3]); o.w = pk4_fp8(d[0], d[1], d[2], d[3]); ((v4u*)dst)[i] = o; }
}
template <bool KKMAJOR>
__device__ __forceinline__ void convert_mxfp4(const float* src, unsigned char* dst, unsigned char* scl, size_t nrows, size_t gtid, size_t nth) {
    const size_t nblk = nrows * 32;
    for (size_t i = gtid; i < nblk; i += nth) {
        const size_t row = i >> 5; const int blk = (int)(i & 31);
        const f32x4* sp = (const f32x4*)(src + row * 1024 + blk * 32);
        f32x4 v[8]; float amax = 0.f;
#pragma unroll
        for (int j = 0; j < 8; ++j) { v[j] = sp[j]; amax = fmaxf(fmaxf(fmaxf(fabsf(v[j][0]), fabsf(v[j][1])), fmaxf(fabsf(v[j][2]), fabsf(v[j][3]))), amax); }
        int e = (int)((__builtin_bit_cast(unsigned, amax) >> 23) & 0xffu) - 127 - 2;
        if (e < -126) e = -126;
        const float inv = __builtin_bit_cast(float, (unsigned)(127 - e) << 23);
        unsigned w[4] = {0u, 0u, 0u, 0u};
#pragma unroll
        for (int j = 0; j < 8; j += 2) { unsigned t = 0u;
            t = __builtin_amdgcn_cvt_scalef32_pk_fp4_f32(t, v[j][0] * inv, v[j][1] * inv, 1.0f, 0);
            t = __builtin_amdgcn_cvt_scalef32_pk_fp4_f32(t, v[j][2] * inv, v[j][3] * inv, 1.0f, 1);
            t = __builtin_amdgcn_cvt_scalef32_pk_fp4_f32(t, v[j + 1][0] * inv, v[j + 1][1] * inv, 1.0f, 2);
            t = __builtin_amdgcn_cvt_scalef32_pk_fp4_f32(t, v[j + 1][2] * inv, v[j + 1][3] * inv, 1.0f, 3);
            w[j >> 1] = t; }
        *(v4u*)(dst + row * 512 + blk * 16) = (v4u){w[0], w[1], w[2], w[3]};
        scl[row * 32 + (KKMAJOR ? ((blk & 3) * 8 + (blk >> 2)) : blk)] = (unsigned char)(e + 127);
    }
}
__device__ __forceinline__ void convert_rowfp4(const float* src, unsigned char* dst, _Float16* scl, int row, int lane) {
    const f32x4* sp = (const f32x4*)(src + (size_t)row * 1024 + lane * 16);
    f32x4 v[4]; float amax = 0.f;
#pragma unroll
    for (int j = 0; j < 4; ++j) { v[j] = sp[j]; amax = fmaxf(fmaxf(fmaxf(fabsf(v[j][0]), fabsf(v[j][1])), fmaxf(fabsf(v[j][2]), fabsf(v[j][3]))), amax); }
    amax = wave_max(amax);
    _Float16 sh = (_Float16)(amax * (1.f / 6.f));
    float sf = (float)sh; if (!(sf > 0.f)) { sf = 1.f; sh = (_Float16)1.f; }
    const float inv = 1.f / sf;
    unsigned w[2];
#pragma unroll
    for (int j = 0; j < 2; ++j) { unsigned t = 0u;
        t = __builtin_amdgcn_cvt_scalef32_pk_fp4_f32(t, v[2 * j][0] * inv, v[2 * j][1] * inv, 1.0f, 0);
        t = __builtin_amdgcn_cvt_scalef32_pk_fp4_f32(t, v[2 * j][2] * inv, v[2 * j][3] * inv, 1.0f, 1);
        t = __builtin_amdgcn_cvt_scalef32_pk_fp4_f32(t, v[2 * j + 1][0] * inv, v[2 * j + 1][1] * inv, 1.0f, 2);
        t = __builtin_amdgcn_cvt_scalef32_pk_fp4_f32(t, v[2 * j + 1][2] * inv, v[2 * j + 1][3] * inv, 1.0f, 3);
        w[j] = t; }
    *(v2u*)(dst + (size_t)row * 512 + lane * 8) = (v2u){w[0], w[1]};
    if (lane == 0) scl[row] = sh;
}
__device__ __forceinline__ void phase0(const Params& p, unsigned char* lds) {
    const int tid = threadIdx.x, wave = tid >> 6, lane = tid & 63, G = gridDim.x;
    const int gw = blockIdx.x * NWAVES + wave, NGW = G * NWAVES;
    float* scr = (float*)(lds + wave * 16384);
    unsigned char* ws = p.ws;
    constexpr int I_IN = 16 * (2048 / 32), I_IN8 = 16 * (3584 / 32), I_A = 8 * 32, I_O = 16 * 32, I_Q = 16 * 64;
    constexpr int NT = I_IN + I_IN8 + 2 * I_A + I_O + I_Q;
    for (int it = gw; it < NT; it += NGW) {
        int r = it;
        if (r < I_IN) { transpose_item<2>(p.w_in, INW, (bf16*)(ws + WS_WIN), 1024, 0, scr, r / 64, r % 64, lane); continue; } r -= I_IN;
        if (r < I_IN8) { transpose_item8<3>(p.w_in, INW, ws + WS_WIN8, 1024, 0, 32.f, scr, r / 112, r % 112, lane); continue; } r -= I_IN8;
        if (r < I_A) { transpose_item8(p.w_a, 1024, ws + WS_WAB8, 1024, 0, 32.f, scr, r / 32, r % 32, lane); continue; } r -= I_A;
        if (r < I_A) { transpose_item8(p.w_b, 1024, ws + WS_WAB8, 1024, 512, 4.f, scr, r / 32, r % 32, lane); continue; } r -= I_A;
        if (r < I_O) { transpose_item8(p.w_out, 1024, ws + WS_WOUT8, 1024, 0, 32.f, scr, r / 32, r % 32, lane); continue; } r -= I_O;
        transpose_item<0>(p.peer_wq, 2048, (bf16*)(ws + WS_WQ), 1024, 0, scr, r / 64, r % 64, lane);
    }
    for (int it = gw; it < 96 * 8; it += NGW) {
        const int cgp = it % 96, ks = it / 96, col = cgp * 64 + lane, k0 = ks * 128;
#pragma unroll
        for (int i = 0; i < 16; ++i) { const int e = i * 64 + lane, b = e >> 7, k = e & 127; scr[e] = siluf_(p.c[b * 1024 + k0 + k]); }
        LDS_WAIT(); __builtin_amdgcn_wave_barrier();
        float acc[8];
#pragma unroll
        for (int b = 0; b < 8; ++b) acc[b] = 0.f;
#pragma unroll 4
        for (int k = 0; k < 128; ++k) { const float w = p.w_ada[(size_t)(k0 + k) * 6144 + col];
#pragma unroll
            for (int b = 0; b < 8; ++b) acc[b] += scr[b * 128 + k] * w; }
        float* mp = (float*)(ws + WS_MODP) + (size_t)ks * 8 * 6144 + col;
#pragma unroll
        for (int b = 0; b < 8; ++b) mp[b * 6144] = acc[b];
        LDS_WAIT(); __builtin_amdgcn_wave_barrier();
    }
    const size_t gtid = (size_t)blockIdx.x * NTHREADS + tid, nth = (size_t)G * NTHREADS;
    convert_plain(p.peer_subkeys, (bf16*)(ws + WS_SK), (size_t)16 * 128 * 128, gtid, nth);
    for (int it = gw; it < 2 * NEXP; it += NGW) {
        if (it < NEXP) convert_rowfp4(p.peer_u, ws + WS_U, (_Float16*)(ws + WS_US), it, lane);
        else convert_rowfp4(p.peer_v, ws + WS_V, (_Float16*)(ws + WS_VS), it - NEXP, lane);
    }
}

template <bool FIRST>
__device__ __forceinline__ void normmod_phase(const Params& p, unsigned char* lds, const float* src, bf16* dst, const float* gvec, int shift_off, int scale_off) {
    const int tid = threadIdx.x, wave = tid >> 6, lane = tid & 63, G = gridDim.x;
    unsigned char* ws = p.ws;
    float* A = (float*)lds;
    float* Bv = A + 1024;
    const float* MODP = (const float*)(ws + WS_MODP);
    float* MOD = (float*)(ws + WS_MOD);
    if (FIRST) {
        for (int e = blockIdx.x * NTHREADS + tid; e < 8 * 6144; e += G * NTHREADS) { const int col = e % 6144; float s = p.b_ada[col];
#pragma unroll
            for (int ks = 0; ks < 8; ++ks) s += MODP[(size_t)ks * 8 * 6144 + e];
            MOD[e] = s; }
    }
    int curb = -1;
    for (int chunk = blockIdx.x; chunk < T / 128; chunk += G) {
        const int b = (chunk * 128) / SEQ;
        if (b != curb) {
            __syncthreads();
            for (int col = tid; col < 1024; col += NTHREADS) {
                float sc, sh;
                if (FIRST) { sc = p.b_ada[scale_off + col]; sh = p.b_ada[shift_off + col];
#pragma unroll
                    for (int ks = 0; ks < 8; ++ks) { sc += MODP[(size_t)(ks * 8 + b) * 6144 + scale_off + col]; sh += MODP[(size_t)(ks * 8 + b) * 6144 + shift_off + col]; } }
                else { sc = MOD[b * 6144 + scale_off + col]; sh = MOD[b * 6144 + shift_off + col]; }
                A[col] = gvec[col] * (1.f + sc); Bv[col] = sh; }
            __syncthreads(); curb = b;
        }
        for (int r = wave; r < 128; r += NWAVES) {
            const size_t row = (size_t)chunk * 128 + r;
            const f32x4* xr = (const f32x4*)(src + row * DM) + lane;
            f32x4 v[4]; float s = 0.f;
#pragma unroll
            for (int j = 0; j < 4; ++j) { v[j] = xr[64 * j]; s += (v[j][0] * v[j][0] + v[j][1] * v[j][1]) + (v[j][2] * v[j][2] + v[j][3] * v[j][3]); }
            const float rstd = rsqrtf(wave_sum(s) * (1.f / DM) + RMS_EPS);
            v2u* o8 = (v2u*)(dst + row * DM) + lane;
#pragma unroll
            for (int j = 0; j < 4; ++j) { const int c0 = 4 * lane + 256 * j; const f32x4 a = *(const f32x4*)(A + c0), sh = *(const f32x4*)(Bv + c0);
                v2u o; o.x = pk2(v[j][0] * rstd * a[0] + sh[0], v[j][1] * rstd * a[1] + sh[1]); o.y = pk2(v[j][2] * rstd * a[2] + sh[2], v[j][3] * rstd * a[3] + sh[3]);
                o8[64 * j] = o;
                if (FIRST) *(unsigned*)(ws + WS_H8 + row * DM + c0) = pk4_fp8(v[j][0] * rstd * a[0] + sh[0], v[j][1] * rstd * a[1] + sh[1], v[j][2] * rstd * a[2] + sh[2], v[j][3] * rstd * a[3] + sh[3]);
                if (!FIRST) { float* st = (float*)(lds + 8192) + wave * 1056;
                    const float y0 = v[j][0] * rstd * a[0] + sh[0], y1 = v[j][1] * rstd * a[1] + sh[1], y2 = v[j][2] * rstd * a[2] + sh[2], y3 = v[j][3] * rstd * a[3] + sh[3];
                    const int pc = c0 + (c0 >> 5); st[pc] = y0; st[pc + 1] = y1; st[pc + 2] = y2; st[pc + 3] = y3; } }
            if (!FIRST) {
                const float* st = (const float*)(lds + 8192) + wave * 1056;
                LDS_WAIT(); __builtin_amdgcn_wave_barrier();
                if (lane < 32) {
                    float x[32];
#pragma unroll
                    for (int k = 0; k < 32; ++k) x[k] = st[lane * 33 + k];
#pragma unroll
                    for (int t = 0; t < H4_NT; ++t) {
                        float amax = 0.f;
#pragma unroll
                        for (int k = 0; k < 32; ++k) amax = fmaxf(amax, fabsf(x[k]));
                        int e = (int)((__builtin_bit_cast(unsigned, amax) >> 23) & 0xffu) - 127 - 2; if (e < -126) e = -126;
                        const float inv = __builtin_bit_cast(float, (unsigned)(127 - e) << 23), sc = __builtin_bit_cast(float, (unsigned)(127 + e) << 23);
                        unsigned w[4];
#pragma unroll
                        for (int r = 0; r < 4; ++r) { unsigned tw = 0u;
                            tw = __builtin_amdgcn_cvt_scalef32_pk_fp4_f32(tw, x[8 * r] * inv, x[8 * r + 1] * inv, 1.0f, 0);
                            tw = __builtin_amdgcn_cvt_scalef32_pk_fp4_f32(tw, x[8 * r + 2] * inv, x[8 * r + 3] * inv, 1.0f, 1);
                            tw = __builtin_amdgcn_cvt_scalef32_pk_fp4_f32(tw, x[8 * r + 4] * inv, x[8 * r + 5] * inv, 1.0f, 2);
                            tw = __builtin_amdgcn_cvt_scalef32_pk_fp4_f32(tw, x[8 * r + 6] * inv, x[8 * r + 7] * inv, 1.0f, 3);
                            w[r] = tw;
                            const f32x2 d0 = __builtin_amdgcn_cvt_scalef32_pk_f32_fp4(tw, 1.0f, 0), d1 = __builtin_amdgcn_cvt_scalef32_pk_f32_fp4(tw, 1.0f, 1), d2 = __builtin_amdgcn_cvt_scalef32_pk_f32_fp4(tw, 1.0f, 2), d3 = __builtin_amdgcn_cvt_scalef32_pk_f32_fp4(tw, 1.0f, 3);
                            x[8 * r] -= d0[0] * sc; x[8 * r + 1] -= d0[1] * sc; x[8 * r + 2] -= d1[0] * sc; x[8 * r + 3] -= d1[1] * sc;
                            x[8 * r + 4] -= d2[0] * sc; x[8 * r + 5] -= d2[1] * sc; x[8 * r + 6] -= d3[0] * sc; x[8 * r + 7] -= d3[1] * sc; }
                        *(v4u*)(ws + WS_H4D + (row * H4_NT + t) * 512 + lane * 16) = (v4u){w[0], w[1], w[2], w[3]};
                        *(ws + WS_H4S + (row * H4_NT + t) * 32 + (lane & 3) * 8 + (lane >> 2)) = (unsigned char)(e + 127);
                    }
                }
                LDS_WAIT(); __builtin_amdgcn_wave_barrier();
            }
        }
    }
    __syncthreads();
}

constexpr int HGL_QT = 0, HGL_KT = 17408, HGL_QE = 34816, HGL_KLT = 52224, HGL_VT = 70656, HGL_AM = 89088, HGL_DEC = 98304, HGL_TOT = 98816, HGL_SSQ = 100864;
constexpr int HG_LDR = 136;
constexpr int HG_LDC = 72;
template <int half>
__device__ __forceinline__ void hgrn_item(const Params& p, unsigned char* lds, int item) {
    const int b = item >> 2, h = item & 3;
    const int tid = threadIdx.x, w = tid >> 6, lane = tid & 63, fr = lane & 15, fq = lane >> 4;
    unsigned char* ws = p.ws;
    const bf16* HG = (const bf16*)(ws + WS_HG);
    bf16* YA = (bf16*)(ws + WS_H);
    bf16* QT = (bf16*)(lds + HGL_QT); bf16* KT = (bf16*)(lds + HGL_KT); bf16* QE = (bf16*)(lds + HGL_QE);
    bf16* KLT = (bf16*)(lds + HGL_KLT); bf16* VT = (bf16*)(lds + HGL_VT); bf16* AM = (bf16*)(lds + HGL_AM);
    float* DEC = (float*)(lds + HGL_DEC); float* TOT = (float*)(lds + HGL_TOT); float* SSQ = (float*)(lds + HGL_SSQ);
    const int pd = tid & 127, pq = tid >> 7;
    float lbv; { const float a0 = p.hg_lb[h * 128 + pd], a1 = p.hg_lb[512 + h * 128 + pd]; lbv = 1.f / (1.f + __expf(a1 - a0)); }
    const int e0 = w * 16;
    const float ogv = p.hg_onorm_g[e0 + fr];
    pg8::f32x4 S[8];
#pragma unroll
    for (int i = 0; i < 8; ++i) S[i] = (pg8::f32x4){0.f, 0.f, 0.f, 0.f};
    const size_t rowb = (size_t)b * SEQ;
    const int c0 = half * 32;
    bf16* QCg = (bf16*)(ws + WS_HQC) + (size_t)item * 2048 * 128; float* OLg = (float*)(ws + WS_HOL) + (size_t)item * 32 * 8 * 4 * 256;
    float cum = 1.f;
    unsigned short rq[16], rf[16], rv[16];
    { const bf16* gp = HG + (rowb + (size_t)c0 * 64 + pq * 16) * LD_HG + h * 128 + pd;
#pragma unroll
      for (int i = 0; i < 16; ++i) { rq[i] = gp[(size_t)i * LD_HG]; rf[i] = gp[(size_t)i * LD_HG + 512]; rv[i] = gp[(size_t)i * LD_HG + 1024]; } }
    for (int chunk = c0; chunk < c0 + 32; ++chunk) {
        const size_t row0 = rowb + (size_t)chunk * 64;
        float fq_[16], kq_[16], cs[16];
        float run = 0.f;
#pragma unroll
        for (int i = 0; i < 16; ++i) { const float f = lbv + (1.f - lbv) * sigmoidf_(bf2f(rf[i])); kq_[i] = 1.f - f; run += __logf(f); cs[i] = run; fq_[i] = siluf_(bf2f(rq[i])); }
        TOT[pq * 128 + pd] = run;
        { v4u v0, v1;
          v0.x = rv[0] | ((unsigned)rv[1] << 16); v0.y = rv[2] | ((unsigned)rv[3] << 16); v0.z = rv[4] | ((unsigned)rv[5] << 16); v0.w = rv[6] | ((unsigned)rv[7] << 16);
          v1.x = rv[8] | ((unsigned)rv[9] << 16); v1.y = rv[10] | ((unsigned)rv[11] << 16); v1.z = rv[12] | ((unsigned)rv[13] << 16); v1.w = rv[14] | ((unsigned)rv[15] << 16);
          *(v4u*)(VT + pd * HG_LDC + pq * 16) = v0; *(v4u*)(VT + pd * HG_LDC + pq * 16 + 8) = v1; }
        unsigned short rg[16];
#pragma unroll
        for (int i = 0; i < 16; ++i) rg[i] = half ? (unsigned short)0 : HG[(row0 + (i >> 2) * 16 + fq * 4 + (i & 3)) * LD_HG + 1536 + h * 128 + e0 + fr];
        if (chunk + 1 < c0 + 32) { const bf16* gp = HG + (row0 + 64 + pq * 16) * LD_HG + h * 128 + pd;
#pragma unroll
            for (int i = 0; i < 16; ++i) { rq[i] = gp[(size_t)i * LD_HG]; rf[i] = gp[(size_t)i * LD_HG + 512]; rv[i] = gp[(size_t)i * LD_HG + 1024]; } }
        __syncthreads();
        const float t0 = TOT[pd], t1 = TOT[128 + pd], t2 = TOT[256 + pd], t3 = TOT[384 + pd];
        const float base = (pq > 0 ? t0 : 0.f) + (pq > 1 ? t1 : 0.f) + (pq > 2 ? t2 : 0.f);
        const float bmid = t0 + t1, blast = (t0 + t1) + (t2 + t3);
        const float emid = __expf(bmid), elm = __expf(blast - bmid);
        if (pq == 0) DEC[pd] = __expf(blast);
        { unsigned klp[8];
#pragma unroll
          for (int i = 0; i < 16; ++i) { const float bb = base + cs[i]; const float E1 = __expf(bb - bmid), R1 = __builtin_amdgcn_rcpf(E1);
              const float qtv = fq_[i] * E1, ktv = kq_[i] * R1, qev = qtv * emid, klv = ktv * elm;
              const int srow = pq * 16 + i;
              QT[srow * HG_LDR + pd] = (bf16)f2bf(qtv); KT[srow * HG_LDR + pd] = (bf16)f2bf(ktv); QE[srow * HG_LDR + pd] = (bf16)f2bf(qev);
              if (half) QCg[((size_t)(chunk - 32) * 64 + srow) * 128 + pd] = (bf16)f2bf(qev * cum);
              if (i & 1) klp[i >> 1] |= f2bf(klv) << 16; else klp[i >> 1] = f2bf(klv); }
          *(v4u*)(KLT + pd * HG_LDC + pq * 16) = (v4u){klp[0], klp[1], klp[2], klp[3]}; *(v4u*)(KLT + pd * HG_LDC + pq * 16 + 8) = (v4u){klp[4], klp[5], klp[6], klp[7]}; }
        cum *= __expf(blast);
        __syncthreads();
#pragma unroll
        for (int tt = 0; tt < 2; ++tt) { const int id = w + 8 * tt, rt = id >> 2, ct = id & 3;
            pg8::f32x4 a = {0.f, 0.f, 0.f, 0.f};
            if (ct <= rt) {
#pragma unroll
                for (int ks = 0; ks < 4; ++ks) { const bf16x8 af = *(const bf16x8*)(QT + (rt * 16 + fr) * HG_LDR + ks * 32 + fq * 8), bfv = *(const bf16x8*)(KT + (ct * 16 + fr) * HG_LDR + ks * 32 + fq * 8);
                    a = __builtin_amdgcn_mfma_f32_16x16x32_bf16(af, bfv, a, 0, 0, 0); } }
#pragma unroll
            for (int r = 0; r < 4; ++r) { const int c = rt * 16 + fq * 4 + r, sidx = ct * 16 + fr; AM[c * HG_LDC + sidx] = (bf16)((sidx <= c) ? f2bf(a[r]) : 0u); } }
        __syncthreads();
        const bf16x8 vb0 = *(const bf16x8*)(VT + (e0 + fr) * HG_LDC + fq * 8), vb1 = *(const bf16x8*)(VT + (e0 + fr) * HG_LDC + 32 + fq * 8);
        bf16x8 sb[4];
#pragma unroll
        for (int ks = 0; ks < 4; ++ks) { v4u t; t.x = pk2(S[2 * ks][0], S[2 * ks][1]); t.y = pk2(S[2 * ks][2], S[2 * ks][3]); t.z = pk2(S[2 * ks + 1][0], S[2 * ks + 1][1]); t.w = pk2(S[2 * ks + 1][2], S[2 * ks + 1][3]); sb[ks] = __builtin_bit_cast(bf16x8, t); }
        pg8::f32x4 o[4];
#pragma unroll
        for (int rt = 0; rt < 4; ++rt) { pg8::f32x4 a = {0.f, 0.f, 0.f, 0.f};
            a = __builtin_amdgcn_mfma_f32_16x16x32_bf16(*(const bf16x8*)(AM + (rt * 16 + fr) * HG_LDC + fq * 8), vb0, a, 0, 0, 0);
            a = __builtin_amdgcn_mfma_f32_16x16x32_bf16(*(const bf16x8*)(AM + (rt * 16 + fr) * HG_LDC + 32 + fq * 8), vb1, a, 0, 0, 0);
#pragma unroll
            for (int ks = 0; ks < 4; ++ks) { const v2u lo = *(const v2u*)(QE + (rt * 16 + fr) * HG_LDR + ks * 32 + fq * 4), hi = *(const v2u*)(QE + (rt * 16 + fr) * HG_LDR + ks * 32 + 16 + fq * 4);
                const v4u t = {lo.x, lo.y, hi.x, hi.y};
                a = __builtin_amdgcn_mfma_f32_16x16x32_bf16(__builtin_bit_cast(bf16x8, t), sb[ks], a, 0, 0, 0); }
            o[rt] = a; }
#pragma unroll
        for (int dt = 0; dt < 8; ++dt) { const f32x4 dc = *(const f32x4*)(DEC + dt * 16 + fq * 4);
            pg8::f32x4 a = S[dt]; a[0] *= dc[0]; a[1] *= dc[1]; a[2] *= dc[2]; a[3] *= dc[3];
            a = __builtin_amdgcn_mfma_f32_16x16x32_bf16(*(const bf16x8*)(KLT + (dt * 16 + fr) * HG_LDC + fq * 8), vb0, a, 0, 0, 0);
            a = __builtin_amdgcn_mfma_f32_16x16x32_bf16(*(const bf16x8*)(KLT + (dt * 16 + fr) * HG_LDC + 32 + fq * 8), vb1, a, 0, 0, 0);
            S[dt] = a; }
        if (half) {
#pragma unroll
            for (int rt = 0; rt < 4; ++rt) *(pg8::f32x4*)(OLg + ((((size_t)(chunk - 32)) * 8 + w) * 4 + rt) * 256 + lane * 4) = o[rt];
            __syncthreads();
            continue;
        }
#pragma unroll
        for (int rt = 0; rt < 4; ++rt)
#pragma unroll
            for (int r = 0; r < 4; ++r) { float x = o[rt][r] * o[rt][r];
                x += __shfl_xor(x, 1); x += __shfl_xor(x, 2); x += __shfl_xor(x, 4); x += __shfl_xor(x, 8);
                if (fr == 0) SSQ[w * 64 + rt * 16 + fq * 4 + r] = x; }
        __syncthreads();
        float tot = 0.f;
#pragma unroll
        for (int ww = 0; ww < 8; ++ww) tot += SSQ[ww * 64 + lane];
        const float rstd_l = rsqrtf(tot * (1.f / 128.f) + RMS_EPS);
#pragma unroll
        for (int rt = 0; rt < 4; ++rt)
#pragma unroll
            for (int r = 0; r < 4; ++r) { const int c = rt * 16 + fq * 4 + r; const float rs = __shfl(rstd_l, c);
                const float y = o[rt][r] * rs * ogv * siluf_(bf2f(rg[rt * 4 + r]));
                ((unsigned char*)YA)[(row0 + c) * 1024 + h * 128 + e0 + fr] = (unsigned char)(__builtin_amdgcn_cvt_pk_fp8_f32(y, 0.f, 0, false) & 0xff); }
    }
    if (!half) {
#pragma unroll
        for (int ks = 0; ks < 4; ++ks) { v4u t; t.x = pk2(S[2 * ks][0], S[2 * ks][1]); t.y = pk2(S[2 * ks][2], S[2 * ks][3]); t.z = pk2(S[2 * ks + 1][0], S[2 * ks + 1][1]); t.w = pk2(S[2 * ks + 1][2], S[2 * ks + 1][3]);
            *(v4u*)(ws + WS_HSB + ((((size_t)item * 8 + w) * 4 + ks) * 64 + lane) * 16) = t; }
    }
    __syncthreads();
}
__device__ __forceinline__ void hgrn_fix(const Params& p, int item, int c, int rt, int lane) {
    const int b = item >> 2, h = item & 3, fr = lane & 15, fq = lane >> 4;
    unsigned char* ws = p.ws;
    const bf16* HG = (const bf16*)(ws + WS_HG);
    bf16* YA = (bf16*)(ws + WS_H);
    const bf16* QCg = (const bf16*)(ws + WS_HQC) + (size_t)item * 2048 * 128; const float* OLg = (const float*)(ws + WS_HOL) + (size_t)item * 32 * 8 * 4 * 256;
    const size_t row0 = (size_t)b * SEQ + (size_t)(32 + c) * 64 + rt * 16;
    bf16x8 Aq[4];
    { const bf16* qr = QCg + ((size_t)c * 64 + rt * 16 + fr) * 128;
#pragma unroll
      for (int ks = 0; ks < 4; ++ks) { const v2u lo = *(const v2u*)(qr + ks * 32 + fq * 4), hi = *(const v2u*)(qr + ks * 32 + 16 + fq * 4); const v4u t = {lo.x, lo.y, hi.x, hi.y}; Aq[ks] = __builtin_bit_cast(bf16x8, t); } }
    pg8::f32x4 o[8];
#pragma unroll
    for (int w2 = 0; w2 < 8; ++w2) { pg8::f32x4 a = *(const pg8::f32x4*)(OLg + ((((size_t)c) * 8 + w2) * 4 + rt) * 256 + lane * 4);
#pragma unroll
        for (int ks = 0; ks < 4; ++ks) { const bf16x8 sbv = __builtin_bit_cast(bf16x8, *(const v4u*)(ws + WS_HSB + ((((size_t)item * 8 + w2) * 4 + ks) * 64 + lane) * 16));
            a = __builtin_amdgcn_mfma_f32_16x16x32_bf16(Aq[ks], sbv, a, 0, 0, 0); }
        o[w2] = a; }
    float rs[4];
#pragma unroll
    for (int r = 0; r < 4; ++r) { float x = 0.f;
#pragma unroll
        for (int w2 = 0; w2 < 8; ++w2) x += o[w2][r] * o[w2][r];
        x += __shfl_xor(x, 1); x += __shfl_xor(x, 2); x += __shfl_xor(x, 4); x += __shfl_xor(x, 8);
        rs[r] = rsqrtf(x * (1.f / 128.f) + RMS_EPS); }
#pragma unroll
    for (int w2 = 0; w2 < 8; ++w2) { const float ogv = p.hg_onorm_g[w2 * 16 + fr];
#pragma unroll
        for (int r = 0; r < 4; ++r) { const size_t row = row0 + fq * 4 + r;
            const float g = bf2f((unsigned)(unsigned short)HG[row * LD_HG + 1536 + h * 128 + w2 * 16 + fr]);
            const float y = o[w2][r] * rs[r] * ogv * siluf_(g);
            ((unsigned char*)YA)[row * 1024 + h * 128 + w2 * 16 + fr] = (unsigned char)(__builtin_amdgcn_cvt_pk_fp8_f32(y, 0.f, 0, false) & 0xff); } }
}

__device__ __forceinline__ unsigned f16key(float x) {
    x = x + 0.f;
    const _Float16 hx = (_Float16)x; const unsigned short bits = __builtin_bit_cast(unsigned short, hx);
    return (bits & 0x8000u) ? (unsigned)(unsigned short)(~bits) : (unsigned)(bits | 0x8000u);
}
__device__ __forceinline__ void find_bin(const unsigned* hist, int K, int lane, int& bin, int& rem) {
    const int rl = 63 - lane;
    const v4u hv = *(const v4u*)(hist + 4 * rl);
    const unsigned c = hv.x + hv.y + hv.z + hv.w;
    unsigned x = c;
#define DPP_ADD(CTRL, RM) x += (unsigned)__builtin_amdgcn_update_dpp(0, (int)x, CTRL, RM, 0xf, false)
    DPP_ADD(0x111, 0xf); DPP_ADD(0x112, 0xf); DPP_ADD(0x114, 0xf); DPP_ADD(0x118, 0xf);
    DPP_ADD(0x142, 0xa); DPP_ADD(0x143, 0xc);
#undef DPP_ADD
    const unsigned above = x - c;
    const bool mine = (above < (unsigned)K) && ((unsigned)K <= x);
    int mybin = 0, myrem = 0;
    if (mine) { unsigned ca = above; const unsigned hh[4] = {hv.x, hv.y, hv.z, hv.w}; bool found = false;
#pragma unroll
        for (int i = 3; i >= 0; --i) { if (!found) { if (ca + hh[i] >= (unsigned)K) { mybin = 4 * rl + i; myrem = K - (int)ca; found = true; } else ca += hh[i]; } } }
    const unsigned long long m = __ballot(mine);
    const int src = (int)__builtin_ctzll(m | (1ull << 63));
    bin = __builtin_amdgcn_readlane(mybin, src); rem = __builtin_amdgcn_readlane(myrem, src);
}
__device__ __forceinline__ void dsa1_item(const Params& p, unsigned char* lds, int item) {
    const int b = item >> 8, q0 = (item & 255) * 16;
    const int tid = threadIdx.x, w = tid >> 6, lane = tid & 63, fr = lane & 15, fq = lane >> 4;
    unsigned char* ws = p.ws;
    const bf16* IDX = (const bf16*)(ws + WS_IDX);
    unsigned short* Ik = (unsigned short*)lds;
    unsigned* hist1 = (unsigned*)(lds + 131072);
    unsigned* hist = (unsigned*)(lds + 131072 + 16384) + w * 256;
    const size_t rowb = (size_t)b * SEQ;
    *(v4u*)(hist1 + tid * 4) = (v4u){0u, 0u, 0u, 0u}; *(v4u*)(hist1 + 2048 + tid * 4) = (v4u){0u, 0u, 0u, 0u};
    bf16x8 Af[8][2];
    { const bf16* rp = IDX + (rowb + q0 + fr) * LD_IDX + fq * 8;
#pragma unroll
      for (int h = 0; h < 8; ++h) { Af[h][0] = *(const bf16x8*)(rp + h * 64); Af[h][1] = *(const bf16x8*)(rp + h * 64 + 32); } }
    const float idx_scale = 0.5f * 0.125f * 0.35355339059327373f;
    bf16x8 Aw[2];
    { float wa[8];
      { const v4u wq = *(const v4u*)(IDX + (rowb + q0 + fr) * LD_IDX + 576);
#pragma unroll
        for (int i = 0; i < 4; ++i) { wa[2 * i] = bflo(wq[i]) * idx_scale; wa[2 * i + 1] = bfhi(wq[i]) * idx_scale; } }
#pragma unroll
      for (int ks = 0; ks < 2; ++ks) { float cq[8];
#pragma unroll
          for (int j = 0; j < 8; ++j) cq[j] = 0.f;
#pragma unroll
          for (int h = 0; h < 8; ++h)
#pragma unroll
              for (int j = 0; j < 8; ++j) cq[j] += wa[h] * bf2f((unsigned)(unsigned short)Af[h][ks][j]);
          const v4u t = {pk2(cq[0], cq[1]), pk2(cq[2], cq[3]), pk2(cq[4], cq[5]), pk2(cq[6], cq[7])};
          Aw[ks] = __builtin_bit_cast(bf16x8, t); } }
    float wv[4][8];
#pragma unroll
    for (int r = 0; r < 4; ++r) { const v4u wq = *(const v4u*)(IDX + (rowb + q0 + fq * 4 + r) * LD_IDX + 576);
#pragma unroll
        for (int i = 0; i < 4; ++i) { wv[r][2 * i] = bflo(wq[i]) * idx_scale; wv[r][2 * i + 1] = bfhi(wq[i]) * idx_scale; } }
    const int ntiles = (q0 >> 4) + 1;
    __syncthreads();
    bf16x8 B0 = Aw[0], B1 = Aw[1];
    if (w < ntiles) { const bf16* kp = IDX + (rowb + w * 16 + fr) * LD_IDX + 512 + fq * 8; B0 = *(const bf16x8*)kp; B1 = *(const bf16x8*)(kp + 32); }
    for (int kt = w; kt < ntiles; kt += NWAVES) {
        bf16x8 nB0 = B0, nB1 = B1;
        if (kt + NWAVES < ntiles) { const bf16* kp = IDX + (rowb + (kt + NWAVES) * 16 + fr) * LD_IDX + 512 + fq * 8; nB0 = *(const bf16x8*)kp; nB1 = *(const bf16x8*)(kp + 32); }
        pg8::f32x4 lin = {0.f, 0.f, 0.f, 0.f};
        lin = __builtin_amdgcn_mfma_f32_16x16x32_bf16(Aw[0], B0, lin, 0, 0, 0);
        lin = __builtin_amdgcn_mfma_f32_16x16x32_bf16(Aw[1], B1, lin, 0, 0, 0);
        float I[4] = {lin[0], lin[1], lin[2], lin[3]};
#pragma unroll
        for (int h = 0; h < 8; ++h) { pg8::f32x4 a = {0.f, 0.f, 0.f, 0.f};
            a = __builtin_amdgcn_mfma_f32_16x16x32_bf16(Af[h][0], B0, a, 0, 0, 0);
            a = __builtin_amdgcn_mfma_f32_16x16x32_bf16(Af[h][1], B1, a, 0, 0, 0);
#pragma unroll
            for (int r = 0; r < 4; ++r) I[r] = __builtin_fmaf(wv[r][h], __builtin_fabsf(a[r]), I[r]); }
        const int kidx = kt * 16 + fr;
#pragma unroll
        for (int r = 0; r < 4; ++r) { const unsigned key = f16key(I[r]); Ik[(fq * 4 + r) * 4096 + kidx] = (unsigned short)key;
            if (kidx <= q0 + fq * 4 + r) atomicAdd(&hist1[(fq * 4 + r) * 256 + (key >> 8)], 1u); }
        B0 = nB0; B1 = nB1;
    }
    __syncthreads();
    for (int qq = w; qq < 16; qq += NWAVES) {
        const int t = q0 + qq, n = t + 1;
        unsigned short* so = (unsigned short*)(hist1 + qq * 256);
        const unsigned short* keys = Ik + qq * 4096;
        if (n <= TOPK) { for (int j = lane; j < n; j += 64) so[j] = (unsigned short)j; }
        else {
            int b1, rem1, b2, rem2;
            find_bin(hist1 + qq * 256, TOPK, lane, b1, rem1);
            *(v4u*)(hist + 4 * lane) = (v4u){0u, 0u, 0u, 0u};
            LDS_WAIT(); __builtin_amdgcn_wave_barrier();
            for (int j0 = 0; j0 < n; j0 += 512) { unsigned k4[8];
#pragma unroll
                for (int u = 0; u < 8; ++u) { const int j = j0 + u * 64 + lane; k4[u] = keys[j < 4095 ? j : 4095]; }
#pragma unroll
                for (int u = 0; u < 8; ++u) { const int j = j0 + u * 64 + lane; if (j < n && (int)(k4[u] >> 8) == b1) atomicAdd(&hist[k4[u] & 255u], 1u); } }
            LDS_WAIT(); __builtin_amdgcn_wave_barrier();
            find_bin(hist, rem1, lane, b2, rem2);
            const unsigned thr = ((unsigned)b1 << 8) | (unsigned)b2;
            int base = 0, eqtaken = 0;
            const unsigned long long lt = (lane == 0) ? 0ull : (~0ull >> (64 - lane));
            for (int j0 = 0; j0 < n; j0 += 512) { unsigned k4[8];
#pragma unroll
                for (int u = 0; u < 8; ++u) { const int j = j0 + u * 64 + lane; k4[u] = keys[j < 4095 ? j : 4095]; }
#pragma unroll
                for (int u = 0; u < 8; ++u) {
                    const int j = j0 + u * 64 + lane; const bool valid = j < n; const unsigned k = valid ? k4[u] : 0u;
                    const bool gt = valid && k > thr, eq = valid && k == thr;
                    const unsigned long long meq = __ballot(eq);
                    const int erank = __popcll(meq & lt) + eqtaken;
                    const bool take = gt || (eq && erank < rem2);
                    const unsigned long long mt = __ballot(take);
                    if (take) so[base + __popcll(mt & lt)] = (unsigned short)j;
                    base += __popcll(mt); eqtaken += __popcll(meq);
                }
            }
        }
    }
    __syncthreads();
}

template <int NB>
__device__ __forceinline__ void qknorm_tokens(const Params& p, const int (&toks)[NB], int lane, const float (&qg)[8], const float (&kg)[8]) {
    v4u qv[NB], kv[NB], vv[NB];
#pragma unroll
    for (int n = 0; n < NB; ++n) { const bf16* row = (const bf16*)(p.ws + WS_ATT) + (size_t)toks[n] * LD_ATT;
        qv[n] = *(const v4u*)(row + lane * 8); kv[n] = *(const v4u*)(row + 512 + (lane & 15) * 8); vv[n] = *(const v4u*)(row + 640 + (lane & 15) * 8); }
#pragma unroll
    for (int n = 0; n < NB; ++n) { const int tok = toks[n];
        { float x[8]; float ss = 0.f;
#pragma unroll
          for (int i = 0; i < 4; ++i) { x[2 * i] = bflo(qv[n][i]); x[2 * i + 1] = bfhi(qv[n][i]); ss += x[2 * i] * x[2 * i] + x[2 * i + 1] * x[2 * i + 1]; }
          ss += __shfl_xor(ss, 1); ss += __shfl_xor(ss, 2); ss += __shfl_xor(ss, 4);
          const float rs = rsqrtf(ss * (1.f / 64.f) + RMS_EPS) * (0.125f * 1.4426950408889634f);
#pragma unroll
          for (int i = 0; i < 8; ++i) x[i] = x[i] * rs * qg[i];
          v2u hw, lw;
          hw.x = pk4_fp8(x[0], x[1], x[2], x[3]); hw.y = pk4_fp8(x[4], x[5], x[6], x[7]);
          { const f32x2 d0 = __builtin_amdgcn_cvt_pk_f32_fp8((int)hw.x, false), d1 = __builtin_amdgcn_cvt_pk_f32_fp8((int)hw.x, true), d2 = __builtin_amdgcn_cvt_pk_f32_fp8((int)hw.y, false), d3 = __builtin_amdgcn_cvt_pk_f32_fp8((int)hw.y, true);
            lw.x = pk4_fp8(x[0] - d0[0], x[1] - d0[1], x[2] - d1[0], x[3] - d1[1]); lw.y = pk4_fp8(x[4] - d2[0], x[5] - d2[1], x[6] - d3[0], x[7] - d3[1]); }
          *(v2u*)(p.ws + WS_QHI + (size_t)tok * 512 + lane * 8) = hw; *(v2u*)(p.ws + WS_QLO + (size_t)tok * 512 + lane * 8) = lw; }
        { float x[8]; float ss = 0.f;
#pragma unroll
          for (int i = 0; i < 4; ++i) { x[2 * i] = bflo(kv[n][i]); x[2 * i + 1] = bfhi(kv[n][i]); ss += x[2 * i] * x[2 * i] + x[2 * i + 1] * x[2 * i + 1]; }
          ss += __shfl_xor(ss, 1); ss += __shfl_xor(ss, 2); ss += __shfl_xor(ss, 4);
          const float rs = rsqrtf(ss * (1.f / 64.f) + RMS_EPS);
#pragma unroll
          for (int i = 0; i < 8; ++i) x[i] = x[i] * rs * kg[i];
          v2u o; o.x = pk4_fp8(x[0], x[1], x[2], x[3]); o.y = pk4_fp8(x[4], x[5], x[6], x[7]);
          if (lane < 16) *(v2u*)(p.ws + WS_K8 + (size_t)tok * 128 + lane * 8) = o; }
        { v2u o; o.x = pk4_fp8(bflo(vv[n][0]), bfhi(vv[n][0]), bflo(vv[n][1]), bfhi(vv[n][1])); o.y = pk4_fp8(bflo(vv[n][2]), bfhi(vv[n][2]), bflo(vv[n][3]), bfhi(vv[n][3]));
          if (lane < 16) *(v2u*)(p.ws + WS_V8 + (size_t)tok * 128 + lane * 8) = o; }
    }
}

typedef short v4i16_t __attribute__((ext_vector_type(4)));
__device__ __forceinline__ v4i16_t vtr16(const bf16* ldsp) { return __builtin_amdgcn_ds_read_tr16_b64_v4i16((LAS v4i16_t*)ldsp); }
typedef int v2i_t __attribute__((ext_vector_type(2)));
__device__ __forceinline__ long vtr8(const unsigned char* ldsp) { const v2i_t r = __builtin_amdgcn_ds_read_tr8_b64_v2i32((LAS v2i_t*)ldsp); return (long)(((unsigned long long)(unsigned)r[1] << 32) | (unsigned)r[0]); }
__device__ __forceinline__ void dsa2_query(const Params& p, unsigned char* ldsw, const unsigned short* sel, int b, int t, int lane) {
    unsigned char* ws = p.ws;
    const bf16* ATT = (const bf16*)(ws + WS_ATT);
    bf16* YB = (bf16*)(ws + WS_H);
    unsigned short* sl = (unsigned short*)ldsw;
    float* df = (float*)(ldsw + 512);
    unsigned char* Vl = ldsw + 1536;
    const unsigned char* V8 = ws + WS_V8;
    const int fr = lane & 15, fq = lane >> 4;
    const size_t rowb = (size_t)b * SEQ;
    const int cnt = (t + 1 < TOPK) ? (t + 1) : TOPK;
    { v2u sv = *(const v2u*)(sel + lane * 4);
      const int j0 = lane * 4;
      if (j0 >= cnt) sv.x = 0u; else if (j0 + 1 >= cnt) sv.x &= 0xffffu;
      if (j0 + 2 >= cnt) sv.y = 0u; else if (j0 + 3 >= cnt) sv.y &= 0xffffu;
      *(v2u*)(sl + lane * 4) = sv;
      f32x4 d4; d4[0] = (j0 < cnt) ? (float)(t - (int)(sv.x & 0xffffu)) : INFINITY; d4[1] = (j0 + 1 < cnt) ? (float)(t - (int)(sv.x >> 16)) : INFINITY;
      d4[2] = (j0 + 2 < cnt) ? (float)(t - (int)(sv.y & 0xffffu)) : INFINITY; d4[3] = (j0 + 3 < cnt) ? (float)(t - (int)(sv.y >> 16)) : INFINITY;
      *(f32x4*)(df + lane * 4) = d4; }
    LDS_WAIT(); __builtin_amdgcn_wave_barrier();
    const unsigned char* K8 = ws + WS_K8;
    long qhA[2] = {0, 0}, qhB[2] = {0, 0}, qlA[2] = {0, 0}, qlB[2] = {0, 0};
    if (fr < 8) { const v4u qh = *(const v4u*)(ws + WS_QHI + (rowb + t) * 512 + fr * 64 + fq * 16), ql = *(const v4u*)(ws + WS_QLO + (rowb + t) * 512 + fr * 64 + fq * 16);
        const long hA = (long)(((unsigned long long)qh.y << 32) | qh.x), hB = (long)(((unsigned long long)qh.w << 32) | qh.z), lA = (long)(((unsigned long long)ql.y << 32) | ql.x), lB = (long)(((unsigned long long)ql.w << 32) | ql.z);
        if (fr < 4) { qhA[0] = hA; qhB[0] = hB; qlA[0] = lA; qlB[0] = lB; } else { qhA[1] = hA; qhB[1] = hB; qlA[1] = lA; qlB[1] = lB; } }
    pg8::f32x4 sc[16];
    v4u vv[8];
    {
        v4u G[8];
        unsigned char* kst = Vl;
        const int ksw = ((lane & 7) ^ (lane >> 3)) & 7;
#define K_LOADS(STEP) do { _Pragma("unroll") for (int j = 0; j < 8; ++j) { const int s_ = sl[(STEP) * 64 + j * 8 + (lane >> 3)]; G[j] = *(const v4u*)(K8 + (rowb + s_) * 128 + ((ksw ^ (j & 1)) & 7) * 16); } } while (0)
        K_LOADS(0);
#pragma unroll
        for (int step = 0; step < 4; ++step) {
            LDS_WAIT(); __builtin_amdgcn_wave_barrier();
#pragma unroll
            for (int j = 0; j < 8; ++j) *(v4u*)(kst + j * 1024 + lane * 16) = G[j];
            __builtin_amdgcn_sched_barrier(0);
            if (step < 3) K_LOADS(step + 1);
            else {
#pragma unroll
                for (int j = 0; j < 8; ++j) { const int s = sl[j * 8 + (lane >> 3)]; vv[j] = *(const v4u*)(V8 + (rowb + s) * 128 + (lane & 7) * 16); } }
            __builtin_amdgcn_sched_barrier(0);
            LDS_WAIT(); __builtin_amdgcn_wave_barrier();
#pragma unroll
            for (int kt = 0; kt < 4; ++kt) { pg8::f32x4 a = {0.f, 0.f, 0.f, 0.f};
#pragma unroll
                for (int gg = 0; gg < 2; ++gg) { const v4u kv = *(const v4u*)(kst + (kt * 16 + fr) * 128 + (((gg * 4 + fq) ^ (fr & 7) ^ (fr >> 3)) & 7) * 16);
                    const long kA = (long)(((unsigned long long)kv.y << 32) | kv.x), kB = (long)(((unsigned long long)kv.w << 32) | kv.z);
                    a = __builtin_amdgcn_mfma_f32_16x16x32_fp8_fp8(kA, qhA[gg], a, 0, 0, 0); a = __builtin_amdgcn_mfma_f32_16x16x32_fp8_fp8(kB, qhB[gg], a, 0, 0, 0);
                    a = __builtin_amdgcn_mfma_f32_16x16x32_fp8_fp8(kA, qlA[gg], a, 0, 0, 0); a = __builtin_amdgcn_mfma_f32_16x16x32_fp8_fp8(kB, qlB[gg], a, 0, 0, 0); }
                sc[step * 4 + kt] = a; }
        }
#undef K_LOADS
    }
    const float slope = exp2f(-(float)((fr & 7) + 1)) * 1.4426950408889634f;
    float m = -INFINITY;
#pragma unroll
    for (int kt = 0; kt < 16; ++kt) { const f32x4 d4 = *(const f32x4*)(df + kt * 16 + fq * 4);
#pragma unroll
        for (int r = 0; r < 4; ++r) { const float x = sc[kt][r] - slope * d4[r]; sc[kt][r] = x; m = fmaxf(m, x); } }
    m = fmaxf(m, __shfl_xor(m, 16)); m = fmaxf(m, __shfl_xor(m, 32));
    float l = 0.f;
#pragma unroll
    for (int kt = 0; kt < 16; ++kt)
#pragma unroll
        for (int r = 0; r < 4; ++r) { const float e = __builtin_amdgcn_exp2f(sc[kt][r] - m); sc[kt][r] = e; l += e; }
    l += __shfl_xor(l, 16); l += __shfl_xor(l, 32);
    const float inv = 1.f / l;
    pg8::f32x4 o[2][4];
#pragma unroll
    for (int g2 = 0; g2 < 2; ++g2)
#pragma unroll
        for (int dt = 0; dt < 4; ++dt) o[g2][dt] = (pg8::f32x4){0.f, 0.f, 0.f, 0.f};
    unsigned char* vdst = Vl + ((lane & 7) >> 2) * 6400 + (lane >> 3) * 80 + (lane & 3) * 16;
#pragma unroll
    for (int ch = 0; ch < 4; ++ch) {
        LDS_WAIT(); __builtin_amdgcn_wave_barrier();
#pragma unroll
        for (int j = 0; j < 8; ++j) *(v4u*)(vdst + ((j >> 2) * 40 + ((j >> 1) & 1) * 24 + (j & 1) * 8) * 80) = vv[j];
        if (ch < 3) {
#pragma unroll
            for (int j = 0; j < 8; ++j) { const int s = sl[(ch + 1) * 64 + j * 8 + (lane >> 3)]; vv[j] = *(const v4u*)(V8 + (rowb + s) * 128 + (lane & 7) * 16); } }
        LDS_WAIT(); __builtin_amdgcn_wave_barrier();
#pragma unroll
        for (int k2 = 0; k2 < 2; ++k2) { const int kt0 = ch * 4 + 2 * k2;
            const long pb = (long)(((unsigned long long)pk4_fp8(sc[kt0 + 1][0], sc[kt0 + 1][1], sc[kt0 + 1][2], sc[kt0 + 1][3]) << 32) | pk4_fp8(sc[kt0][0], sc[kt0][1], sc[kt0][2], sc[kt0][3]));
            const int q = fr >> 1, prow = k2 * 40 + ((q < 4) ? (fq * 4 + q) : (24 + fq * 4 + (q - 4)));
#pragma unroll
            for (int g2 = 0; g2 < 2; ++g2)
#pragma unroll
                for (int dt = 0; dt < 4; ++dt) o[g2][dt] = __builtin_amdgcn_mfma_f32_16x16x32_fp8_fp8(vtr8(Vl + g2 * 6400 + prow * 80 + dt * 16 + (fr & 1) * 8), pb, o[g2][dt], 0, 0, 0); }
    }
    { const float i8 = inv * 8.f; unsigned char* yp = (unsigned char*)YB + (rowb + t) * 1024 + 512 + fr * 64 + fq * 4;
      if (fr < 4) {
#pragma unroll
          for (int dt = 0; dt < 4; ++dt) *(unsigned*)(yp + dt * 16) = pk4_fp8(o[0][dt][0] * i8, o[0][dt][1] * i8, o[0][dt][2] * i8, o[0][dt][3] * i8); }
      else if (fr < 8) {
#pragma unroll
          for (int dt = 0; dt < 4; ++dt) *(unsigned*)(yp + dt * 16) = pk4_fp8(o[1][dt][0] * i8, o[1][dt][1] * i8, o[1][dt][2] * i8, o[1][dt][3] * i8); } }
    LDS_WAIT(); __builtin_amdgcn_wave_barrier();
}

#define INS16(L, x) do { _Pragma("unroll") for (int _i = 15; _i >= 1; --_i) L[_i] = __builtin_amdgcn_fmed3f(L[_i - 1], L[_i], (x)); L[0] = fmaxf(L[0], (x)); } while (0)
__device__ __forceinline__ float f_andor(float v, unsigned keepmask, unsigned orv) { return __builtin_bit_cast(float, (__builtin_bit_cast(unsigned, v) & keepmask) | orv); }
#define CE_D(a, b) do { const float _x = fmaxf(a, b), _y = fminf(a, b); a = _x; b = _y; } while (0)
#define CE_A(a, b) do { const float _x = fminf(a, b), _y = fmaxf(a, b); a = _x; b = _y; } while (0)
__device__ __forceinline__ void bitonic_merge16_desc(float (&x)[16]) {
#pragma unroll
    for (int s_ = 8; s_ >= 1; s_ >>= 1)
#pragma unroll
        for (int i = 0; i < 16; ++i) if ((i & s_) == 0) CE_D(x[i], x[i + s_]);
}
__device__ __forceinline__ void bitonic_sort16_desc(float (&x)[16]) {
#pragma unroll
    for (int k = 2; k <= 16; k <<= 1)
#pragma unroll
        for (int j = k >> 1; j >= 1; j >>= 1)
#pragma unroll
            for (int i = 0; i < 16; ++i) { const int l = i ^ j; if (l > i) { if ((i & k) == 0) CE_D(x[i], x[l]); else CE_A(x[i], x[l]); } }
}
__device__ __forceinline__ void top16_merge(float (&A)[16], const float (&B)[16]) {
#pragma unroll
    for (int i = 0; i < 16; ++i) A[i] = fmaxf(A[i], B[15 - i]);
    bitonic_merge16_desc(A);
}
__host__ __device__ constexpr int peer_pair(int n) { int c = 0; for (int a = 0; a < 16; ++a) for (int b = 0; b < 16; ++b) if ((a + 1) * (b + 1) <= 16) { if (c == n) return a * 16 + b; ++c; } return -1; }
template <int K> struct PeerPairs { static constexpr int p0 = peer_pair(4 * K), p1 = peer_pair(4 * K + 1), p2 = peer_pair(4 * K + 2), p3 = peer_pair(4 * K + 3); };
__device__ __forceinline__ void peer_select(const Params& p, unsigned char* ldsw, int tg, int h, int lane, int* EIDX, float* GATES) {
    float* sc = (float*)ldsw;
    LDS_WAIT(); __builtin_amdgcn_wave_barrier();
    float L[16];
#pragma unroll
    for (int i = 0; i < 16; ++i) L[i] = -INFINITY;
    { const float* sp = sc + (lane & 31) * 132 + (lane >> 5) * 64;
#pragma unroll 4
      for (int i = 0; i < 16; ++i) { const f32x4 x = *(const f32x4*)(sp + 4 * i); INS16(L, x[0]); INS16(L, x[1]); INS16(L, x[2]); INS16(L, x[3]); } }
    { float O[16];
#pragma unroll
      for (int i = 0; i < 16; ++i) O[i] = __shfl_xor(L[i], 32);
      top16_merge(L, O); }
    LDS_WAIT(); __builtin_amdgcn_wave_barrier();
    float* lst = sc;
    if (lane < 32) {
#pragma unroll
        for (int i = 0; i < 4; ++i) *(f32x4*)(lst + lane * 16 + 4 * i) = (f32x4){L[4 * i], L[4 * i + 1], L[4 * i + 2], L[4 * i + 3]}; }
    LDS_WAIT(); __builtin_amdgcn_wave_barrier();
    const int tok = lane & 15;
    const int q = lane >> 4;
    float M[16];
#define PEER_CAND(K) do { const int ab_ = q == 0 ? PeerPairs<K>::p0 : q == 1 ? PeerPairs<K>::p1 : q == 2 ? PeerPairs<K>::p2 : PeerPairs<K>::p3; const int abv_ = ab_ < 0 ? 0 : ab_; \
        const float v1_ = f_andor(lst[tok * 16 + (abv_ >> 4)], ~127u, 0u), v2_ = f_andor(lst[(16 + tok) * 16 + (abv_ & 15)], ~127u, 0u); \
        M[K] = ab_ < 0 ? -INFINITY : f_andor(v1_ + v2_, ~255u, (unsigned)abv_); } while (0)
    PEER_CAND(0); PEER_CAND(1); PEER_CAND(2); PEER_CAND(3); PEER_CAND(4); PEER_CAND(5); PEER_CAND(6); PEER_CAND(7); PEER_CAND(8); PEER_CAND(9); PEER_CAND(10); PEER_CAND(11); PEER_CAND(12);
#undef PEER_CAND
    M[13] = -INFINITY; M[14] = -INFINITY; M[15] = -INFINITY;
    bitonic_sort16_desc(M);
    { float O[16];
#pragma unroll
      for (int i = 0; i < 16; ++i) O[i] = __shfl_xor(M[i], 16);
      top16_merge(M, O);
#pragma unroll
      for (int i = 0; i < 16; ++i) O[i] = __shfl_xor(M[i], 32);
      top16_merge(M, O); }
    const float mx = f_andor(M[0], ~255u, 0u);
    float e[16], sum = 0.f; int ei[16];
    const unsigned* lb = (const unsigned*)lst;
#pragma unroll
    for (int i = 0; i < 16; ++i) { const unsigned bits = __builtin_bit_cast(unsigned, M[i]); const int flat = bits & 255u;
        e[i] = __expf(f_andor(M[i], ~255u, 0u) - mx); sum += e[i];
        ei[i] = (int)(lb[tok * 16 + (flat >> 4)] & 127u) * 128 + (int)(lb[(16 + tok) * 16 + (flat & 15)] & 127u); }
    const float inv = 1.f / sum;
    if (lane < 16) {
        const size_t ob = ((size_t)tok * 8 + h) * 16;
#pragma unroll
        for (int i = 0; i < 4; ++i) { *(v4u*)(EIDX + ob + 4 * i) = (v4u){(unsigned)ei[4 * i], (unsigned)ei[4 * i + 1], (unsigned)ei[4 * i + 2], (unsigned)ei[4 * i + 3]};
            *(f32x4*)(GATES + ob + 4 * i) = (f32x4){e[4 * i] * inv, e[4 * i + 1] * inv, e[4 * i + 2] * inv, e[4 * i + 3] * inv}; }
    }
    LDS_WAIT(); __builtin_amdgcn_wave_barrier();
}

__device__ __forceinline__ void peer_route_block(const Params& p, unsigned char* lds, int* eG, float* gG) {
    const int tid = threadIdx.x, wave = tid >> 6, lane = tid & 63, fr = lane & 15, fq = lane >> 4, G = gridDim.x;
    unsigned char* ws = p.ws;
    const bf16* Q = (const bf16*)(ws + WS_Q);
    const unsigned char* SKb = ws + WS_SK;
    unsigned char* tile = lds + 8 * 16896;
    float* sc = (float*)(lds + wave * 16896);
    int ngrp = 0;
    for (int tg = blockIdx.x; tg < T / 16; tg += G) ++ngrp;
#pragma unroll 1
    for (int k0 = 0; k0 < ngrp; k0 += 8) {
        const bool valid = k0 + wave < ngrp;
        const int tg = (int)blockIdx.x + (valid ? k0 + wave : k0) * G;
        v4u t[4][2];
        bf16x8 An[2][4];
#pragma unroll
        for (int sub = 0; sub < 4; ++sub) { const unsigned char* sp = SKb + (size_t)sub * 16384 + tid * 32; t[sub][0] = *(const v4u*)sp; t[sub][1] = *(const v4u*)(sp + 16); }
#pragma unroll
        for (int pp = 0; pp < 2; ++pp) { const bf16* rp = Q + (size_t)(tg * 16 + fr) * 2048 + pp * 128 + fq * 8;
#pragma unroll
            for (int ks = 0; ks < 4; ++ks) An[pp][ks] = *(const bf16x8*)(rp + ks * 32); }
#pragma unroll 1
        for (int h = 0; h < 8; ++h) {
            bf16x8 Af[2][4];
#pragma unroll
            for (int pp = 0; pp < 2; ++pp)
#pragma unroll
                for (int ks = 0; ks < 4; ++ks) Af[pp][ks] = An[pp][ks];
            const int hn = (h + 1) & 7;
#pragma unroll
            for (int sub = 0; sub < 4; ++sub) {
                const int pp = sub >> 1, half = sub & 1;
                __syncthreads();
                { unsigned char* wp = tile + (tid >> 3) * 272 + (tid & 7) * 32; *(v4u*)wp = t[sub][0]; *(v4u*)(wp + 16) = t[sub][1]; }
                { const unsigned char* sp = SKb + (size_t)(hn * 4 + sub) * 16384 + tid * 32; t[sub][0] = *(const v4u*)sp; t[sub][1] = *(const v4u*)(sp + 16); }
                __syncthreads();
#pragma unroll
                for (int kt = 0; kt < 4; ++kt) {
                    pg8::f32x4 a = {0.f, 0.f, 0.f, 0.f};
#pragma unroll
                    for (int ks = 0; ks < 4; ++ks) { const bf16x8 bv = *(const bf16x8*)(tile + (kt * 16 + fr) * 272 + ks * 64 + fq * 16); a = __builtin_amdgcn_mfma_f32_16x16x32_bf16(Af[pp][ks], bv, a, 0, 0, 0); }
                    const int kg = (half * 4 + kt) * 16 + fr;
#pragma unroll
                    for (int r = 0; r < 4; ++r) sc[(pp * 16 + fq * 4 + r) * 132 + kg] = f_andor(a[r], ~127u, (unsigned)kg);
                }
            }
#pragma unroll
            for (int pp = 0; pp < 2; ++pp) { const bf16* rp = Q + (size_t)(tg * 16 + fr) * 2048 + hn * 256 + pp * 128 + fq * 8;
#pragma unroll
                for (int ks = 0; ks < 4; ++ks) An[pp][ks] = *(const bf16x8*)(rp + ks * 32); }
            if (valid) peer_select(p, (unsigned char*)sc, tg, h, lane, eG + (size_t)tg * 2048, gG + (size_t)tg * 2048);
        }
    }
}

__device__ __forceinline__ float gelu_erf(float x) { return 0.5f * x * (1.f + erff(x * 0.70710678118654752f)); }
typedef int v8i_t __attribute__((ext_vector_type(8)));
template <int OPSEL> __device__ __forceinline__ pg8::f32x4 mx_dot(v8i_t a, int sa, v8i_t b, int sb, pg8::f32x4 c) {
    return __builtin_amdgcn_mfma_scale_f32_16x16x128_f8f6f4(a, b, c, 4  , 4  , OPSEL, sa, OPSEL, sb);
}
template <int MODE>
__device__ __forceinline__ void peer_token(const Params& p, unsigned char* ldsw, const _Float16* usL, const _Float16* vsL, unsigned char* tile, int tok, int lane, const v2u nxt_e, const v2u nxt_g, int buf) {
    unsigned char* ws = p.ws;
    const unsigned char* V8 = ws + WS_V;
    const float* MOD = (const float*)(ws + WS_MOD);
    const int fr = lane & 15, fq = lane >> 4;
    typedef v8i_t v8i;
    const int* EIDX = (const int*)(ldsw + buf * 1024); const float* GATES = (const float*)(ldsw + buf * 1024 + 512);
    int* pe = (int*)(ldsw + buf * 1024); float* pa = (float*)(ldsw + buf * 1024 + 512);
    if (MODE == 1) {
    float* gGp = (float*)(ws + WS_PGATE) + (size_t)tok * 128;
    v4u A4[H4_NT][8]; v2u As[H4_NT];
#pragma unroll
    for (int t = 0; t < H4_NT; ++t) { const unsigned char* hp = ws + WS_H4D + ((size_t)tok * H4_NT + t) * 512 + fq * 16;
        As[t] = *(const v2u*)(ws + WS_H4S + ((size_t)tok * H4_NT + t) * 32 + fq * 8);
#pragma unroll
        for (int kk = 0; kk < 8; ++kk) A4[t][kk] = *(const v4u*)(hp + kk * 64); }
    const unsigned char* U4 = ws + WS_U;
    const int gr = lane >> 3, gs = lane & 7;
    const int rdbase = (fr >> 3) * 1024 + (fr & 7) * 128, slotA = (fq ^ (fr & 7) ^ (fr >> 3)) & 7;
    v4u G[8];
#define U_LOADS(CT) do { const int e0_ = EIDX[(CT) * 16 + gr], e1_ = EIDX[(CT) * 16 + 8 + gr]; \
        const unsigned char* p0_ = U4 + (size_t)e0_ * 512 + ((gs ^ gr) & 7) * 16; const unsigned char* p1_ = U4 + (size_t)e1_ * 512 + ((gs ^ gr ^ 1) & 7) * 16; \
        _Pragma("unroll") for (int kk = 0; kk < 8; ++kk) G[kk] = *(const v4u*)(((kk & 1) ? p1_ : p0_) + (kk >> 1) * 128); } while (0)
    U_LOADS(0);
#pragma unroll 1
    for (int ct = 0; ct < 8; ++ct) {
        const int eic = EIDX[ct * 16 + fr]; const float gt = GATES[ct * 16 + fr];
#pragma unroll
        for (int kk = 0; kk < 8; ++kk) *(v4u*)(tile + kk * 1024 + lane * 16) = G[kk];
        __builtin_amdgcn_sched_barrier(0);
        U_LOADS((ct + 1) & 7);
        __builtin_amdgcn_sched_barrier(0);
        LDS_WAIT(); __builtin_amdgcn_wave_barrier();
        v4u Bt[8];
#pragma unroll
        for (int j = 0; j < 8; ++j) Bt[j] = *(const v4u*)(tile + (j >> 1) * 2048 + rdbase + (((j & 1) ? (slotA ^ 4) : slotA) * 16));
        LDS_WAIT(); __builtin_amdgcn_wave_barrier();
        pg8::f32x4 ah = {0.f, 0.f, 0.f, 0.f};
#pragma unroll
        for (int kk = 0; kk < 8; ++kk) { const v4u bu = Bt[kk];
            const v8i bb = {(int)bu.x, (int)bu.y, (int)bu.z, (int)bu.w, 0, 0, 0, 0};
            const int sb = 0x7f7f7f7f;
#pragma unroll
            for (int t = 0; t < H4_NT; ++t) { const v8i aa = {(int)A4[t][kk].x, (int)A4[t][kk].y, (int)A4[t][kk].z, (int)A4[t][kk].w, 0, 0, 0, 0}; const int sa = (int)((kk < 4) ? As[t].x : As[t].y);
                if ((kk & 3) == 0) ah = mx_dot<0>(aa, sa, bb, sb, ah); else if ((kk & 3) == 1) ah = mx_dot<1>(aa, sa, bb, sb, ah); else if ((kk & 3) == 2) ah = mx_dot<2>(aa, sa, bb, sb, ah); else ah = mx_dot<3>(aa, sa, bb, sb, ah); } }
        const float dot = ah[0] * (float)usL[eic];
        if (fq == 0) gGp[ct * 16 + fr] = gelu_erf(dot) * gt * (float)vsL[eic];
    }
    asm volatile("" :: "v"(G[0]), "v"(G[1]), "v"(G[2]), "v"(G[3]), "v"(G[4]), "v"(G[5]), "v"(G[6]), "v"(G[7]));
#undef U_LOADS
    }
    __builtin_amdgcn_sched_barrier(0);
    { int* ne = (int*)(ldsw + (buf ^ 1) * 1024); float* ng = (float*)(ldsw + (buf ^ 1) * 1024 + 512);
      *(v2u*)(ne + 2 * lane) = nxt_e; *(v2u*)(ng + 2 * lane) = nxt_g; }
    if (MODE == 1) { LDS_WAIT(); __builtin_amdgcn_wave_barrier(); return; }
    const int hl = lane >> 5, bl = lane & 31;
    float acc[32];
#pragma unroll
    for (int i = 0; i < 32; ++i) acc[i] = 0.f;
    LDS_WAIT(); __builtin_amdgcn_wave_barrier();
#pragma unroll 1
    for (int ct = 0; ct < 16; ++ct)
#pragma unroll
        for (int jp = 0; jp < 4; ++jp) {
            const int idx = pe[ct * 8 + 2 * jp + hl]; const float as = pa[ct * 8 + 2 * jp + hl];
            const v4u vv = *(const v4u*)(V8 + (size_t)idx * 512 + bl * 16);
#pragma unroll
            for (int w4 = 0; w4 < 4; ++w4) { const unsigned wd = vv[w4];
                const f32x2 d0 = __builtin_amdgcn_cvt_scalef32_pk_f32_fp4(wd, 1.0f, 0), d1 = __builtin_amdgcn_cvt_scalef32_pk_f32_fp4(wd, 1.0f, 1), d2 = __builtin_amdgcn_cvt_scalef32_pk_f32_fp4(wd, 1.0f, 2), d3 = __builtin_amdgcn_cvt_scalef32_pk_f32_fp4(wd, 1.0f, 3);
                acc[8 * w4] += as * d0[0]; acc[8 * w4 + 1] += as * d0[1]; acc[8 * w4 + 2] += as * d1[0]; acc[8 * w4 + 3] += as * d1[1];
                acc[8 * w4 + 4] += as * d2[0]; acc[8 * w4 + 5] += as * d2[1]; acc[8 * w4 + 6] += as * d3[0]; acc[8 * w4 + 7] += as * d3[1]; }
        }
    LDS_WAIT(); __builtin_amdgcn_wave_barrier();
    float accs[16];
#pragma unroll
    for (int i = 0; i < 16; ++i) { const float lo = acc[i] + __shfl_xor(acc[i], 32), hi2 = acc[16 + i] + __shfl_xor(acc[16 + i], 32); accs[i] = hl ? hi2 : lo; }
    const int b = tok / SEQ;
    const int col0 = bl * 32 + hl * 16;
    const float* g2 = MOD + (size_t)b * 6144 + 5 * 1024 + col0;
    float* orow = p.out + (size_t)tok * DM + col0;
#pragma unroll
    for (int q4 = 0; q4 < 4; ++q4) { const f32x4 xv = *(const f32x4*)(orow + 4 * q4), gv = *(const f32x4*)(g2 + 4 * q4);
        f32x4 o;
#pragma unroll
        for (int i = 0; i < 4; ++i) o[i] = xv[i] + gv[i] * accs[4 * q4 + i];
        *(f32x4*)(orow + 4 * q4) = o; }
}

#define XB_TMO      128
#define XB_XCNT(j)  (256  + 64 * (j))
#define XB_XSUB(j)  (1280 + 64 * (j))
#define XB_XGEN(j)  (2304 + 64 * (j))
#define XB_TOP      3328
#define XB_TOPGEN   3392
#define XCD_BAR_WORDS 3456
#define XB_SPIN_CAP (1u << 18)

__device__ __forceinline__ unsigned xb_ld(unsigned* p)              { return __hip_atomic_load(p, __ATOMIC_RELAXED, __HIP_MEMORY_SCOPE_AGENT); }
__device__ __forceinline__ unsigned xb_add(unsigned* p, unsigned v) { return __hip_atomic_fetch_add(p, v, __ATOMIC_RELAXED, __HIP_MEMORY_SCOPE_AGENT); }
__device__ __forceinline__ unsigned xb_xcc_id() { return (unsigned)__builtin_amdgcn_s_getreg((3 << 11) | 20) & 0xFu; }
#define XB_SPIN(cond, bar) do { unsigned _sp = 0; while (cond) { __builtin_amdgcn_s_sleep(1); \
    if ((++_sp & 255u) == 0u) { if (xb_ld(&(bar)[XB_TMO])) break; if (_sp > XB_SPIN_CAP) { atomicAdd(&(bar)[XB_TMO], 1u); break; } } } } while (0)

struct XcdBarrier {
    unsigned* bar; unsigned x;
    volatile LAS unsigned* st;
};

__device__ __forceinline__ XcdBarrier xcd_barrier_post(unsigned* bar, volatile LAS unsigned* st) {
    XcdBarrier b; b.bar = bar; b.x = xb_xcc_id(); b.st = st;
    if (threadIdx.x == 0) (void)xb_add(&bar[XB_XCNT(b.x)], 1u);
    return b;
}
__device__ __forceinline__ void xcd_barrier_complete(unsigned* bar, unsigned x, unsigned& nloc, unsigned& nx) {
    const unsigned G = gridDim.x * gridDim.y * gridDim.z;
    unsigned sum, cnt, mine, sp = 0u;
    for (;;) {
        sum = 0u; cnt = 0u; mine = 0u;
#pragma unroll
        for (unsigned j = 0; j < 16; ++j) { const unsigned c = xb_ld(&bar[XB_XCNT(j)]); sum += c; cnt += (c > 0u) ? 1u : 0u; mine = (j == x) ? c : mine; }
        if (sum == G) break;
        __builtin_amdgcn_s_sleep(1);
        if ((++sp & 255u) == 0u) { if (xb_ld(&bar[XB_TMO])) break; if (sp > XB_SPIN_CAP) { atomicAdd(&bar[XB_TMO], 1u); break; } }
    }
    nloc = mine > 0u ? mine : 1u; nx = cnt > 0u ? cnt : 1u;
}

__device__ __forceinline__ void xcd_barrier(const XcdBarrier& b) {
    asm volatile("s_waitcnt vmcnt(0)" ::: "memory");
    __syncthreads();
    if (threadIdx.x == 0) {
        unsigned* bar = b.bar;
        __builtin_amdgcn_s_waitcnt(0);
        unsigned nloc = b.st[0], nx = b.st[1];
        if (nloc == 0u) { xcd_barrier_complete(bar, b.x, nloc, nx); b.st[0] = nloc; b.st[1] = nx; }
        const unsigned old = xb_add(&bar[XB_XSUB(b.x)], 1u);
        const unsigned gen = old / nloc;
        if (old + 1u == (gen + 1u) * nloc) {
            __builtin_amdgcn_fence(__ATOMIC_RELEASE, "agent");
            asm volatile("s_waitcnt vmcnt(0)" ::: "memory");
            const unsigned og = xb_add(&bar[XB_TOP], 1u);
            const unsigned tg = og / nx;
            if (og + 1u == (tg + 1u) * nx) xb_add(&bar[XB_TOPGEN], 1u);
            else XB_SPIN(xb_ld(&bar[XB_TOPGEN]) == tg, bar);
            __builtin_amdgcn_fence(__ATOMIC_ACQUIRE, "agent");
            xb_add(&bar[XB_XGEN(b.x)], 1u);
            asm volatile("s_waitcnt vmcnt(0)" ::: "memory");
        } else {
            XB_SPIN(xb_ld(&bar[XB_XGEN(b.x)]) == gen, bar);
            __builtin_amdgcn_fence(__ATOMIC_ACQUIRE, "agent");
            asm volatile("s_waitcnt vmcnt(0)" ::: "memory");
        }
    }
    __syncthreads();
}

constexpr int NPHASE = 11;
__global__ void __launch_bounds__(NTHREADS, 2) mega(Params p) {
    extern __shared__ __attribute__((aligned(16))) unsigned char lds[];
    cg::grid_group grid = cg::this_grid();
    const int lo = p.ph_lo, hi = p.ph_hi;
    const int tid = threadIdx.x, wave = tid >> 6, lane = tid & 63, G = gridDim.x;
    unsigned char* ws = p.ws;
#ifndef ONLYPH
#define IN(k) (lo <= (k) && (k) < hi)
#else
#define IN(k) ((k) == ONLYPH && lo <= (k) && (k) < hi)
#endif
    volatile LAS unsigned* xb_st = (volatile LAS unsigned*)((LAS unsigned char*)lds + (LDS_BYTES - 16));
    if (tid < 4) xb_st[tid] = 0u;
    __syncthreads();
    XcdBarrier xbar; xbar.bar = (unsigned*)(ws + WS_CTL); xbar.x = 0; xbar.st = xb_st;
    if (hi - lo > 1) xbar = xcd_barrier_post((unsigned*)(ws + WS_CTL), xb_st);
    if (lo < -1) grid.sync();
#define SEAM(k) do { if (IN((k) + 1)) xcd_barrier(xbar); } while (0)
#ifndef REPMASK
#define REPMASK 0
#endif
#define NREP(k) (((REPMASK >> (k)) & 1) ? 2 : 1)
    if (IN(0)) { for (int rep = 0; rep < NREP(0); ++rep) phase0(p, lds); SEAM(0); }
    if (IN(1)) { for (int rep = 0; rep < NREP(1); ++rep) normmod_phase<true>(p, lds, p.x, (bf16*)(ws + WS_H), p.norm1_g, 0, 1024); SEAM(1); }
    if (IN(2)) {
        { pg8::Gemm g{(const bf16*)(ws + WS_H8), (const bf16*)(ws + WS_WIN8), T, 3584, 512, 512, 512}; pg8::StaticOrder S; S.init(T, 3584, G, (int)blockIdx.x);
          EpiProj E{(bf16*)(ws + WS_HG), (bf16*)(ws + WS_ATT), (bf16*)(ws + WS_IDX), (bf16*)(ws + WS_GATE), 1};
          pg8::gemm_phase<EpiProj, pg8::StaticOrder, true, true, 122>((PG8_LAS unsigned char*)lds, g, S, E); }
        { pg8::Gemm g{(const bf16*)(ws + WS_H), (const bf16*)(ws + WS_WIN), T, 2048, 1024, 1024, 1024}; pg8::StaticOrder S; S.init(T, 2048, G, (int)blockIdx.x);
          EpiProj E{(bf16*)(ws + WS_HG), (bf16*)(ws + WS_ATT), (bf16*)(ws + WS_IDX), (bf16*)(ws + WS_GATE), 0};
          pg8::gemm_phase<EpiProj, pg8::StaticOrder, true, true>((PG8_LAS unsigned char*)lds, g, S, E); }
        SEAM(2);
    }
    if (IN(3)) {
        { float qg[8], kg[8];
#pragma unroll
          for (int i = 0; i < 8; ++i) { qg[i] = p.q_norm_g[(lane & 7) * 8 + i]; kg[i] = p.k_norm_g[(lane & 7) * 8 + i]; }
          int tok = (int)blockIdx.x * NWAVES + wave; const int st = G * NWAVES;
          for (; tok + 3 * st < T; tok += 4 * st) { const int tk[4] = {tok, tok + st, tok + 2 * st, tok + 3 * st}; qknorm_tokens<4>(p, tk, lane, qg, kg); }
          for (; tok < T; tok += st) { const int tk[1] = {tok}; qknorm_tokens<1>(p, tk, lane, qg, kg); } }
        SEAM(3);
    }
    if (IN(4)) {
        if ((int)blockIdx.x < 32) hgrn_item<0>(p, lds, (int)blockIdx.x); else if ((int)blockIdx.x < 64) hgrn_item<1>(p, lds, (int)blockIdx.x - 32);
        {
            unsigned* qctr = (unsigned*)(ws + WS_CTL + 32768);
            volatile LAS unsigned* qslot = (volatile LAS unsigned*)((LAS unsigned char*)lds + (LDS_BYTES - 32));
            int qsel = (int)(blockIdx.x & 7u), tried = 0;
            for (;;) {
                if (tid == 0) { unsigned c;
                    for (;;) { c = __hip_atomic_fetch_add(qctr + qsel * 64, 1u, __ATOMIC_RELAXED, __HIP_MEMORY_SCOPE_AGENT); if (c < (unsigned)(SEQ / 16) || tried >= 7) break; qsel = (qsel + 1) & 7; ++tried; }
                    *qslot = (c < (unsigned)(SEQ / 16)) ? (((unsigned)qsel << 16) | c) : 0xffffffffu; }
                __syncthreads();
                const unsigned c = *qslot;
                __syncthreads();
                if (c == 0xffffffffu) break;
                const int b = (int)(c >> 16), qblk = (SEQ / 16 - 1) - (int)(c & 0xffffu), it = b * (SEQ / 16) + qblk, q0 = qblk * 16;
                dsa1_item(p, lds, it);
#pragma unroll 1
                for (int k2 = 0; k2 < 2; ++k2) dsa2_query(p, lds + wave * 16384, (const unsigned short*)(lds + 131072 + (wave + 8 * k2) * 1024), b, q0 + wave + 8 * k2, lane);
                __syncthreads();
            }
        }
        if (hi - lo > 1) xcd_barrier(xbar);
        for (int wu = (int)blockIdx.x * NWAVES + wave; wu < 32 * 32 * 4; wu += G * NWAVES) { const int u = wu >> 2; hgrn_fix(p, u >> 5, u & 31, wu & 3, lane); }
        SEAM(4);
    }
    if (IN(5)) {
        pg8::Gemm g{(const bf16*)(ws + WS_H), (const bf16*)(ws + WS_WAB8), T, 1024, 256, 512, 512}; pg8::StaticOrderT<true> S; S.init(T, 1024, G, (int)blockIdx.x, 256);
        EpiMerged E{(const bf16*)(ws + WS_GATE), (bf16*)(ws + WS_MERGED)};
        for (int rep = 0; rep < NREP(5); ++rep) pg8::gemm_phase<EpiMerged, pg8::StaticOrderT<true>, true, true, 122>((PG8_LAS unsigned char*)lds, g, S, E);
        SEAM(5);
    }
    if (IN(6)) {
        pg8::Gemm g{(const bf16*)(ws + WS_MERGED), (const bf16*)(ws + WS_WOUT8), T, 1024, 512, 512, 512}; pg8::StaticOrder S; S.init(T, 1024, G, (int)blockIdx.x);
        EpiResid E{p.x, (const float*)(ws + WS_MOD) + 2048, p.out};
        for (int rep = 0; rep < NREP(6); ++rep) pg8::gemm_phase<EpiResid, pg8::StaticOrder, true, true, 120>((PG8_LAS unsigned char*)lds, g, S, E);
        SEAM(6);
    }
    if (IN(7)) { for (int rep = 0; rep < NREP(7); ++rep) normmod_phase<false>(p, lds, p.out, (bf16*)(ws + WS_H), p.norm2_g, 3 * 1024, 4 * 1024); SEAM(7); }
    if (IN(8)) {
        pg8::Gemm g{(const bf16*)(ws + WS_H), (const bf16*)(ws + WS_WQ), T, 2048, 1024, 1024, 1024}; pg8::StaticOrder S; S.init(T, 2048, G, (int)blockIdx.x);
        EpiStore E{(bf16*)(ws + WS_Q), 2048};
        for (int rep = 0; rep < NREP(8); ++rep) pg8::gemm_phase<EpiStore, pg8::StaticOrder, true, true>((PG8_LAS unsigned char*)lds, g, S, E);
        SEAM(8);
    }
    if (IN(9)) {
        int* eG = (int*)(ws + WS_EIDX); float* gG = (float*)(ws + WS_PGATE);
        peer_route_block(p, lds, eG, gG);
        asm volatile("s_waitcnt vmcnt(0)" ::: "memory");
        __syncthreads();
        _Float16* usL = (_Float16*)lds; _Float16* vsL = (_Float16*)(lds + 32768);
        for (int i = tid; i < NEXP / 8; i += NTHREADS) { ((v4u*)usL)[i] = ((const v4u*)(ws + WS_US))[i]; ((v4u*)vsL)[i] = ((const v4u*)(ws + WS_VS))[i]; }
        unsigned char* ldsw = lds + 65536 + wave * 3072;
        int ntok = 0;
        for (int tg = blockIdx.x; tg < T / 16; tg += G) ntok += 2;
        auto tok_of = [&](int j) { return ((int)blockIdx.x + (j >> 1) * G) * 16 + wave + 8 * (j & 1); };
        auto ld_lists = [&](int tok, v2u& e, v2u& g) {
            const unsigned* ep = (const unsigned*)(eG + (size_t)tok * 128 + 2 * lane); const unsigned* gp = (const unsigned*)(gG + (size_t)tok * 128 + 2 * lane);
            e.x = __hip_atomic_load(ep, __ATOMIC_RELAXED, __HIP_MEMORY_SCOPE_AGENT); e.y = __hip_atomic_load(ep + 1, __ATOMIC_RELAXED, __HIP_MEMORY_SCOPE_AGENT);
            g.x = __hip_atomic_load(gp, __ATOMIC_RELAXED, __HIP_MEMORY_SCOPE_AGENT); g.y = __hip_atomic_load(gp + 1, __ATOMIC_RELAXED, __HIP_MEMORY_SCOPE_AGENT); };
        if (ntok > 0) { v2u e0, g0; ld_lists(tok_of(0), e0, g0); *(v2u*)((int*)ldsw + 2 * lane) = e0; *(v2u*)((float*)(ldsw + 512) + 2 * lane) = g0; }
        __syncthreads();
#pragma unroll 1
        for (int j = 0; j < ntok; ++j) {
            v2u ne = {0u, 0u}, ng = {0u, 0u};
            if (j + 1 < ntok) ld_lists(tok_of(j + 1), ne, ng);
            peer_token<1>(p, ldsw, usL, vsL, lds + 90112 + wave * 8192, tok_of(j), lane, ne, ng, j & 1);
        }
        asm volatile("s_waitcnt vmcnt(0)" ::: "memory");
        __syncthreads();
        if (ntok > 0) { v2u e0, g0; ld_lists(tok_of(0), e0, g0); *(v2u*)((int*)ldsw + 2 * lane) = e0; *(v2u*)((float*)(ldsw + 512) + 2 * lane) = g0; }
        LDS_WAIT(); __builtin_amdgcn_wave_barrier();
#pragma unroll 1
        for (int j = 0; j < ntok; ++j) {
            v2u ne = {0u, 0u}, ng = {0u, 0u};
            if (j + 1 < ntok) ld_lists(tok_of(j + 1), ne, ng);
            peer_token<2>(p, ldsw, usL, vsL, lds + 90112 + wave * 8192, tok_of(j), lane, ne, ng, j & 1);
            LDS_WAIT(); __builtin_amdgcn_wave_barrier();
        }
    }
#undef IN
#undef SEAM
}

#ifndef ONE_LAUNCH
#define ONE_LAUNCH 1
#endif
extern "C" void kernel_launch(void* const* d_in, const int* in_sizes, int n_in, void* d_out, int out_size, void* d_ws, size_t ws_size, hipStream_t stream) {
    static int grid = 0;
    if (grid == 0) {
        if (n_in != 18 || out_size != T * DM || ws_size < WS_END) { fprintf(stderr, "kernel_launch: unexpected shapes (n_in %d, out %d, ws %zu)\n", n_in, out_size, ws_size); grid = -1; return; }
        int dev = 0, cus = 0, per_cu = 0;
        if (hipGetDevice(&dev) != hipSuccess || hipDeviceGetAttribute(&cus, hipDeviceAttributeMultiprocessorCount, dev) != hipSuccess) { grid = -1; return; }
        if (hipFuncSetAttribute((const void*)mega, hipFuncAttributeMaxDynamicSharedMemorySize, LDS_BYTES) != hipSuccess) { fprintf(stderr, "kernel_launch: hipFuncSetAttribute failed\n"); grid = -1; return; }
        if (hipOccupancyMaxActiveBlocksPerMultiprocessor(&per_cu, (const void*)mega, NTHREADS, LDS_BYTES) != hipSuccess || per_cu < 1) { fprintf(stderr, "kernel_launch: occupancy query says %d\n", per_cu); grid = -1; return; }
        (void)hipGetLastError();
        grid = cus;
        if (grid < 64) { grid = -1; return; }
    }
    if (grid < 0) return;
    Params p{};
    const float** pp = (const float**)&p;
    for (int i = 0; i < 18; ++i) pp[i] = (const float*)d_in[i];
    p.out = (float*)d_out; p.ws = (unsigned char*)d_ws;
#if ONE_LAUNCH
    if (hipMemsetAsync((char*)d_ws + WS_CTL, 0, 65536, stream) != hipSuccess) { fprintf(stderr, "kernel_launch: memset failed\n"); return; }
    p.ph_lo = 0; p.ph_hi = NPHASE;
    void* args[] = {&p};
    hipError_t e = hipLaunchCooperativeKernel((const void*)mega, dim3(grid), dim3(NTHREADS), args, LDS_BYTES, stream);
    if (e != hipSuccess) fprintf(stderr, "cooperative launch failed: %s (grid %d)\n", hipGetErrorString(e), grid);
#else
    for (int k = 0; k < NPHASE; ++k) { p.ph_lo = k; p.ph_hi = k + 1; hipLaunchKernelGGL(mega, dim3(grid), dim3(NTHREADS), LDS_BYTES, stream, p); }
#endif
}
```

```cpp
#include <hip/hip_runtime.h>
#include <hip/hip_cooperative_groups.h>
#include <cstdio>
#include <cstdint>
namespace cg = cooperative_groups;

namespace pg8 {
#define PG8_LAS __attribute__((address_space(3)))
typedef unsigned short bf16_t;
typedef short bf16x8 __attribute__((ext_vector_type(8)));
typedef float f32x4 __attribute__((ext_vector_type(4)));
typedef unsigned u32x4 __attribute__((ext_vector_type(4)));
constexpr int BM = 256, BK = 64, HALF = 128, HTB = HALF * BK * 2  , STAGE_BYTES = 8 * HTB, NXCD = 8, WGM = 8;

__host__ __device__ __forceinline__ int lds_byte(int r, int c) { const int st = (r >> 4) * 2 + (c >> 5), rr = r & 15, cc = c & 31, ob = rr * 64 + cc * 2; return st * 1024 + (ob ^ (((ob >> 9) & 1) << 5)); }
__host__ __device__ __forceinline__ void stage_rc(int b, int& R, int& C) { const int st = b / 1024, sb = b % 1024, swz = sb ^ (((sb >> 9) & 1) << 5); R = (st >> 1) * 16 + swz / 64; C = (st & 1) * 32 + (swz % 64) / 2; }
__host__ __device__ __forceinline__ int perm32(int rho) { const int n = rho >> 4, i = rho & 15; return 8 * (i >> 2) + 4 * n + (i & 3); }

struct Unit { int pm, pn, ko, pass; };
struct Gemm { const bf16_t* A; const bf16_t* Bt; int M, N, K, lda, ldb; };
typedef float f32x16 __attribute__((ext_vector_type(16)));
typedef f32x16 AccW[2][2][2];
__device__ __forceinline__ f32x4 acc_get(const AccW& A, int ai, int bj, int m, int n) { const int s_ = ((m & 1) * 2 + n) * 4; const f32x16& w = A[ai][bj][m >> 1]; return (f32x4){w[s_], w[s_ + 1], w[s_ + 2], w[s_ + 3]}; }
__device__ __forceinline__ void acc_set(AccW& A, int ai, int bj, int m, int n, f32x4 v) { const int s_ = ((m & 1) * 2 + n) * 4; f32x16& w = A[ai][bj][m >> 1]; w[s_] = v[0]; w[s_ + 1] = v[1]; w[s_ + 2] = v[2]; w[s_ + 3] = v[3]; }

template <bool TWOPASS_ORDER = false>
struct StaticOrderT {
    int nM, nN, nwg, G, c, kpass;
    __host__ __device__ void init(int M, int N, int G_, int c_, int kpass_ = 512) { nM = M / BM; nN = N / BM; nwg = nM * nN; G = G_; c = c_; kpass = kpass_; }
    __host__ __device__ bool next(int i, Unit& u) const {
        const long L = (long)(TWOPASS_ORDER ? (i >> 1) : i) * G + c; if (L >= nwg) return false;
        u.pass = TWOPASS_ORDER ? (i & 1) : 0; u.ko = TWOPASS_ORDER ? (i & 1) * kpass : 0;
        int wgid = (int)L; { const int q = nwg / NXCD, r = nwg % NXCD, xcd = wgid % NXCD, off = wgid / NXCD; wgid = (xcd < r ? xcd * (q + 1) : r * (q + 1) + (xcd - r) * q) + off; }
        const int nig = WGM * nN, gid = wgid / nig, fm = gid * WGM, gsz = (nM - fm) < WGM ? (nM - fm) : WGM;
        u.pm = fm + ((wgid % nig) % gsz); u.pn = (wgid % nig) / gsz; return true;
    }
    __device__ __forceinline__ void a_ready(const Unit&) const {}
    __device__ __forceinline__ void done(const Unit&) const {}
};
typedef StaticOrderT<false> StaticOrder;

__device__ __forceinline__ unsigned cvt_pk_bf16(float lo, float hi) { unsigned r; asm volatile("v_cvt_pk_bf16_f32 %0, %1, %2" : "=v"(r) : "v"(lo), "v"(hi)); return r; }

template <class Epi, class Sched, bool ALIGN_EPI = false, bool SP2 = false, int F8SCALE = 0>
__device__ __forceinline__ void gemm_phase(PG8_LAS unsigned char* lds, const Gemm g, const Sched& S, const Epi& E) {
    const int tid = threadIdx.x, wid = __builtin_amdgcn_readfirstlane(tid >> 6), lane = tid & 63, wr = wid >> 2, wc = wid & 3, fr = lane & 15, fq = lane >> 4;
    const int K = g.K, nt = K / BK;
    unsigned voffA[2], voffB[2];
#pragma unroll
    for (int i = 0; i < 2; ++i) { int R, C; stage_rc(tid * 16 + i * 8192, R, C); const int Rb = Epi::PERM ? ((R & ~31) + perm32(R & 31)) : R;
        voffA[i] = (unsigned)(R * g.lda + C) * 2u; voffB[i] = (unsigned)(Rb * g.ldb + C) * 2u; }
    const size_t kstep = (size_t)(BK * 2);
    const size_t hstepA = (size_t)HALF * g.lda * 2, hstepB = (size_t)HALF * g.ldb * 2;
    const size_t tstepA = 2 * hstepA, tstepB = 2 * hstepB;
    const unsigned ldsw = (unsigned)wid * 1024u;
    const int aoff = lds_byte(wr * 64 + fr, fq * 8), boff = lds_byte(wc * 32 + fr, fq * 8);
#define PG8_SA(b, h) (((b) * 2 + (h)) * HTB)
#define PG8_SB(b, h) ((4 + (b) * 2 + (h)) * HTB)
#define PG8_STAGE(bufoff, gbase, voff) do { _Pragma("unroll") for (int _i = 0; _i < 2; ++_i) \
        __builtin_amdgcn_global_load_lds((const unsigned*)((const char*)(gbase) + (voff)[_i]), (PG8_LAS unsigned*)(lds + (bufoff) + ldsw + _i * 8192), 16, 0, 0); } while (0)
#define PG8_LDA(dst, b, h) do { _Pragma("unroll") for (int m = 0; m < 4; ++m) { if constexpr (F8SCALE != 0) { \
        PG8_F8(dst)[m].lo = *(const PG8_LAS v4i_f*)(lds + PG8_SA(b, h) + aoff + m * 2048); PG8_F8(dst)[m].hi = *(const PG8_LAS v4i_f*)(lds + PG8_SA(b, h) + aoff + m * 2048 + 1024); } \
        else { _Pragma("unroll") for (int k = 0; k < 2; ++k) dst[m][k] = *(const PG8_LAS bf16x8*)(lds + PG8_SA(b, h) + aoff + m * 2048 + k * 1024); } } } while (0)
#define PG8_LDB(dst, b, h) do { _Pragma("unroll") for (int n = 0; n < 2; ++n) { if constexpr (F8SCALE != 0) { \
        PG8_F8(dst)[n].lo = *(const PG8_LAS v4i_f*)(lds + PG8_SB(b, h) + boff + n * 2048); PG8_F8(dst)[n].hi = *(const PG8_LAS v4i_f*)(lds + PG8_SB(b, h) + boff + n * 2048 + 1024); } \
        else { _Pragma("unroll") for (int k = 0; k < 2; ++k) dst[n][k] = *(const PG8_LAS bf16x8*)(lds + PG8_SB(b, h) + boff + n * 2048 + k * 1024); } } } while (0)
#define PG8_MMA(ai, bj, At, Bt) do { __builtin_amdgcn_s_setprio(1); _Pragma("unroll") for (int m = 0; m < 4; ++m) _Pragma("unroll") for (int n = 0; n < 2; ++n) { \
        f32x4 _c = acc_get(accw, ai, bj, m, n); \
        if constexpr (F8SCALE != 0) { _c = __builtin_amdgcn_mfma_scale_f32_16x16x128_f8f6f4(PG8_F8(Bt)[n], PG8_F8(At)[m], _c, 0, 0, 0, 0x7f7f7f7f, 0, F8SCALE * 0x01010101); } \
        else { _Pragma("unroll") for (int k = 0; k < 2; ++k) _c = __builtin_amdgcn_mfma_f32_16x16x32_bf16(Bt[n][k], At[m][k], _c, 0, 0, 0); } \
        acc_set(accw, ai, bj, m, n, _c); } \
        __builtin_amdgcn_s_setprio(0); } while (0)
#define PG8_WAIT_V(n) asm volatile("s_waitcnt vmcnt(" #n ")" ::: "memory")
#define PG8_WAIT_L(n) asm volatile("s_waitcnt lgkmcnt(" #n ")" ::: "memory")
#define PG8_BAR __builtin_amdgcn_s_barrier()
#define PG8_SCHED __builtin_amdgcn_sched_barrier(0)
    Unit cur, nxt; int ui = 0;
    if (!S.next(0, cur)) return;
    typedef int v4i_f __attribute__((ext_vector_type(4))); typedef int v8i_f __attribute__((ext_vector_type(8))); typedef f32x16 f32x16_f;
    AccW accw;
#pragma unroll
    for (int a = 0; a < 2; ++a)
#pragma unroll
        for (int b = 0; b < 2; ++b)
#pragma unroll
            for (int mp = 0; mp < 2; ++mp)
#pragma unroll
                for (int i = 0; i < 16; ++i) accw[a][b][mp][i] = 0.f;
    bf16x8 At[4][2], B0[2][2], B1[2][2];
    v8i_f At8[4], B08[2], B18[2];
#define PG8_F8(x) x##8
    const char* cA = (const char*)g.A + (size_t)cur.pm * tstepA + (size_t)cur.ko * 2; const char* cB = (const char*)g.Bt + (size_t)cur.pn * tstepB + (size_t)cur.ko * 2;
    S.a_ready(cur);
    if constexpr (SP2) {
        PG8_STAGE(PG8_SB(0, 0), cB, voffB); PG8_STAGE(PG8_SB(0, 1), cB + hstepB, voffB); PG8_STAGE(PG8_SA(0, 0), cA, voffA); PG8_STAGE(PG8_SA(0, 1), cA + hstepA, voffA);
        if (wr == 1) PG8_BAR;
        PG8_WAIT_V(2); PG8_BAR;
        PG8_STAGE(PG8_SB(1, 0), cB + kstep, voffB); PG8_STAGE(PG8_SA(1, 0), cA + kstep, voffA); PG8_STAGE(PG8_SB(1, 1), cB + hstepB + kstep, voffB);
        PG8_WAIT_V(6); PG8_BAR;
    } else {
        PG8_STAGE(PG8_SB(0, 0), cB, voffB); PG8_STAGE(PG8_SA(0, 0), cA, voffA); PG8_STAGE(PG8_SB(0, 1), cB + hstepB, voffB); PG8_STAGE(PG8_SA(0, 1), cA + hstepA, voffA);
        if (wr == 1) PG8_BAR;
        PG8_WAIT_V(4); PG8_BAR;
        PG8_STAGE(PG8_SB(1, 0), cB + kstep, voffB); PG8_STAGE(PG8_SA(1, 0), cA + kstep, voffA); PG8_STAGE(PG8_SB(1, 1), cB + hstepB + kstep, voffB);
        PG8_WAIT_V(6); PG8_BAR;
    }
    for (;;) {
        const bool has_next = S.next(ui + 1, nxt);
        const char* nA = has_next ? (const char*)g.A + (size_t)nxt.pm * tstepA + (size_t)nxt.ko * 2 : cA; const char* nB = has_next ? (const char*)g.Bt + (size_t)nxt.pn * tstepB + (size_t)nxt.ko * 2 : cB;
        for (int t = 0; t < nt; t += 2) {
            const bool last = (t == nt - 2);
            const char* a1 = cA + (size_t)(t + 1) * kstep;
            const char* a2 = last ? nA : cA + (size_t)(t + 2) * kstep; const char* b2 = last ? nB : cB + (size_t)(t + 2) * kstep;
            const char* a3 = a2 + kstep; const char* b3 = b2 + kstep;
            if (last && has_next) S.a_ready(nxt);
            if constexpr (SP2) {
            PG8_LDB(B0, 0, 0); PG8_LDB(B1, 0, 1); PG8_SCHED; PG8_LDA(At, 0, 0); PG8_STAGE(PG8_SA(1, 1), a1 + hstepA, voffA);
            PG8_WAIT_V(8); PG8_WAIT_L(0); PG8_BAR; PG8_MMA(0, 0, At, B0); PG8_MMA(0, 1, At, B1); PG8_BAR; PG8_SCHED;
            PG8_LDA(At, 0, 1); PG8_STAGE(PG8_SB(0, 0), b2, voffB); PG8_STAGE(PG8_SB(0, 1), b2 + hstepB, voffB); PG8_STAGE(PG8_SA(0, 0), a2, voffA);
            PG8_WAIT_V(8); PG8_WAIT_L(0); PG8_BAR; PG8_MMA(1, 0, At, B0); PG8_MMA(1, 1, At, B1); PG8_BAR; PG8_SCHED;
            PG8_LDB(B0, 1, 0); PG8_LDB(B1, 1, 1); PG8_SCHED; PG8_LDA(At, 1, 0); PG8_STAGE(PG8_SA(0, 1), a2 + hstepA, voffA);
            PG8_WAIT_V(8); PG8_WAIT_L(0); PG8_BAR; PG8_MMA(0, 0, At, B0); PG8_MMA(0, 1, At, B1); PG8_BAR; PG8_SCHED;
            PG8_LDA(At, 1, 1); PG8_STAGE(PG8_SB(1, 0), b3, voffB); PG8_STAGE(PG8_SB(1, 1), b3 + hstepB, voffB); PG8_STAGE(PG8_SA(1, 0), a3, voffA);
            PG8_WAIT_V(8); PG8_WAIT_L(0); PG8_BAR; PG8_MMA(1, 0, At, B0); PG8_MMA(1, 1, At, B1); PG8_BAR; PG8_SCHED;
            } else {
            PG8_LDB(B0, 0, 0); PG8_SCHED; PG8_LDA(At, 0, 0); PG8_STAGE(PG8_SA(1, 1), a1 + hstepA, voffA);
            PG8_WAIT_L(8); PG8_BAR; PG8_WAIT_L(0); PG8_MMA(0, 0, At, B0); PG8_BAR; PG8_SCHED;
            PG8_LDB(B1, 0, 1); PG8_STAGE(PG8_SB(0, 0), b2, voffB);
            PG8_BAR; PG8_WAIT_L(0); PG8_MMA(0, 1, At, B1); PG8_BAR;
            PG8_LDA(At, 0, 1); PG8_STAGE(PG8_SA(0, 0), a2, voffA);
            PG8_BAR; PG8_WAIT_L(0); PG8_MMA(1, 0, At, B0); PG8_BAR; PG8_SCHED;
            PG8_STAGE(PG8_SB(0, 1), b2 + hstepB, voffB);
            PG8_WAIT_V(6); PG8_BAR; PG8_MMA(1, 1, At, B1); PG8_BAR;
            PG8_LDB(B0, 1, 0); PG8_SCHED; PG8_LDA(At, 1, 0); PG8_STAGE(PG8_SA(0, 1), a2 + hstepA, voffA);
            PG8_WAIT_L(8); PG8_BAR; PG8_WAIT_L(0); PG8_MMA(0, 0, At, B0); PG8_BAR; PG8_SCHED;
            PG8_LDB(B1, 1, 1); PG8_STAGE(PG8_SB(1, 0), b3, voffB);
            PG8_BAR; PG8_WAIT_L(0); PG8_MMA(0, 1, At, B1); PG8_BAR;
            PG8_LDA(At, 1, 1); PG8_STAGE(PG8_SA(1, 0), a3, voffA);
            PG8_BAR; PG8_WAIT_L(0); PG8_MMA(1, 0, At, B0); PG8_BAR; PG8_SCHED;
            PG8_STAGE(PG8_SB(1, 1), b3 + hstepB, voffB);
            PG8_WAIT_V(6); PG8_BAR; PG8_MMA(1, 1, At, B1); PG8_BAR;
            }
        }
        if constexpr (ALIGN_EPI) { if (wr == 0) PG8_BAR; }
        if constexpr (!Epi::AFTER_DRAIN) { E(accw, cur, wr, wc, fr, fq); S.done(cur); }
        const bool keep_acc = Epi::TWOPASS && (cur.pass == 0);
        if (!has_next) break;
        if (!keep_acc) {
#pragma unroll
            for (int a = 0; a < 2; ++a)
#pragma unroll
                for (int b = 0; b < 2; ++b)
#pragma unroll
                    for (int mp = 0; mp < 2; ++mp)
#pragma unroll
                        for (int i = 0; i < 16; ++i) accw[a][b][mp][i] = 0.f;
        }
        cur = nxt; cA = nA; cB = nB; ++ui;
        if constexpr (ALIGN_EPI) { if (wr == 1) PG8_BAR; }
    }
    PG8_WAIT_V(0);
    if constexpr (!ALIGN_EPI) { if (wr == 0) PG8_BAR; }
    PG8_BAR;

#undef PG8_SA
#undef PG8_SB
#undef PG8_STAGE
#undef PG8_LDA
#undef PG8_LDB
#undef PG8_MMA
#undef PG8_F8
#undef PG8_WAIT_V
#undef PG8_WAIT_L
#undef PG8_BAR
#undef PG8_SCHED
}
}


constexpr int NWAVES = 8, NTHREADS = 512;
constexpr int BATCH = 8, SEQ = 4096, T = BATCH * SEQ, DM = 1024;
constexpr int INW = 5448;
constexpr int NPROJ = 5632;
constexpr int LD_HG = 2048, LD_ATT = 768, LD_IDX = 640, LD_GATE = 2048;
constexpr int TOPK = 256;
constexpr int NEXP = 16384;
constexpr float RMS_EPS = 1e-6f;

constexpr size_t MiB = 1u << 20;
constexpr size_t WS_CTL = 0;
constexpr size_t WS_MOD = MiB / 4;
constexpr size_t WS_MODP = MiB / 2;
constexpr size_t WS_WIN = 2 * MiB;
constexpr size_t WS_WQ = 17 * MiB;
constexpr size_t WS_WQ8 = 12 * MiB;
constexpr size_t WS_H28 = 150 * MiB;
constexpr size_t WS_SK = 21 * MiB;
constexpr size_t WS_U = 22 * MiB;
constexpr size_t WS_US = 30 * MiB;
constexpr size_t WS_V = 38 * MiB;
constexpr size_t WS_VS = 46 * MiB;
constexpr size_t WS_V8 = 8 * MiB;
constexpr size_t WS_K8 = 48 * MiB;
constexpr size_t WS_QHI = 52 * MiB;
constexpr size_t WS_QLO = 68 * MiB;
constexpr size_t WS_WAB8 = 31 * MiB;
constexpr size_t WS_WOUT8 = 32 * MiB;
constexpr size_t WS_WIN8 = 33 * MiB;
constexpr size_t WS_H8 = 48 * MiB;
constexpr size_t WS_H = 86 * MiB;
constexpr size_t WS_HG = 150 * MiB;
constexpr size_t WS_ATT = 278 * MiB;
constexpr size_t WS_IDX = 326 * MiB;
constexpr size_t WS_GATE = 366 * MiB;
constexpr size_t WS_SEL = 494 * MiB;
constexpr size_t WS_EIDX = 48 * MiB;
constexpr size_t WS_PGATE = 64 * MiB;
constexpr size_t WS_END = 510 * MiB;
constexpr size_t WS_X1B = 430 * MiB;
constexpr size_t WS_HQC = 494 * MiB;
constexpr size_t WS_HOL = 118 * MiB;
constexpr size_t WS_HSB = 2 * MiB;
constexpr size_t WS_MERGED = WS_HG;
constexpr size_t WS_Q = 214 * MiB;
constexpr int H4_NT = 2;
constexpr size_t WS_H4D = 366 * MiB;
constexpr size_t WS_H4S = 416 * MiB;

constexpr int LDS_BYTES = 163840;

typedef unsigned short bf16;
typedef unsigned v4u __attribute__((ext_vector_type(4)));
typedef unsigned v2u __attribute__((ext_vector_type(2)));
typedef float f32x4 __attribute__((ext_vector_type(4)));
typedef float f32x2 __attribute__((ext_vector_type(2)));
typedef short bf16x8 __attribute__((ext_vector_type(8)));
#define LAS __attribute__((address_space(3)))

struct Params {
    const float *x, *c, *w_ada, *b_ada, *norm1_g, *norm2_g, *w_in, *hg_lb, *hg_onorm_g, *q_norm_g, *k_norm_g,
                *w_a, *w_b, *w_out, *peer_wq, *peer_subkeys, *peer_u, *peer_v;
    float* out; unsigned char* ws; int ph_lo, ph_hi;
};

typedef __bf16 bf16x2_hw __attribute__((ext_vector_type(2)));
__device__ __forceinline__ unsigned pk2(float lo, float hi) { const f32x2 v = {lo, hi}; const bf16x2_hw b = __builtin_convertvector(v, bf16x2_hw); return __builtin_bit_cast(unsigned, b); }
__device__ __forceinline__ unsigned f2bf(float f) { return pk2(f, 0.f) & 0xffffu; }
__device__ __forceinline__ float bf2f(unsigned u16v) { return __builtin_bit_cast(float, u16v << 16); }
__device__ __forceinline__ float bflo(unsigned w) { return __builtin_bit_cast(float, w << 16); }
__device__ __forceinline__ float bfhi(unsigned w) { return __builtin_bit_cast(float, w & 0xffff0000u); }
__device__ __forceinline__ unsigned pkh2(float lo, float hi) { return __builtin_bit_cast(unsigned, __builtin_amdgcn_cvt_pkrtz(lo, hi)); }
__device__ __forceinline__ float h2f(unsigned short u) { return (float)__builtin_bit_cast(_Float16, u); }
__device__ __forceinline__ float sigmoidf_(float x) { return __builtin_amdgcn_rcpf(1.f + __expf(-x)); }
__device__ __forceinline__ float siluf_(float x) { return x * __builtin_amdgcn_rcpf(1.f + __expf(-x)); }
__device__ __forceinline__ float wave_sum(float v) {
#pragma unroll
    for (int o = 1; o < 64; o <<= 1) v += __shfl_xor(v, o);
    return v;
}
__device__ __forceinline__ float wave_max(float v) {
#pragma unroll
    for (int o = 1; o < 64; o <<= 1) v = fmaxf(v, __shfl_xor(v, o));
    return v;
}
#define LDS_WAIT() asm volatile("s_waitcnt lgkmcnt(0)" ::: "memory")
__device__ __forceinline__ unsigned pk4_fp8(float a, float b, float c, float d) { int w = __builtin_amdgcn_cvt_pk_fp8_f32(a, b, 0, false); w = __builtin_amdgcn_cvt_pk_fp8_f32(c, d, w, true); return (unsigned)w; }

__host__ __device__ __forceinline__ int proj_tile_bf16(int i) { return i < 2 ? i + 2 : i + 6; }
__host__ __device__ __forceinline__ int proj_tile_fp8(int i) { return i < 2 ? i : (i < 6 ? i + 2 : i + 8); }
struct EpiProj {
    static constexpr bool PERM = true, AFTER_DRAIN = false, TWOPASS = false;
    bf16 *HG, *ATT, *IDX, *GATE; int f8;
    __device__ __forceinline__ void operator()(pg8::AccW& acc, const pg8::Unit& u, int wr, int wc, int fr, int fq) const {
        const int pn = f8 ? proj_tile_fp8(u.pn) : proj_tile_bf16(u.pn); bf16* base; int ldc, colt, ncols;
        if (pn < 8) { base = HG; ldc = LD_HG; colt = pn * 256; ncols = LD_HG; }
        else if (pn < 11) { base = ATT; ldc = LD_ATT; colt = (pn - 8) * 256; ncols = LD_ATT; }
        else if (pn < 14) { base = IDX; ldc = LD_IDX; colt = (pn - 11) * 256; ncols = LD_IDX; }
        else { base = GATE; ldc = LD_GATE; colt = (pn - 14) * 256; ncols = LD_GATE; }
        const int row0 = u.pm * 256 + wr * 64 + fr, col0 = colt + wc * 32 + 8 * fq;
#pragma unroll
        for (int ai = 0; ai < 2; ++ai)
#pragma unroll
            for (int m = 0; m < 4; ++m) { bf16* rowp = base + (size_t)(row0 + ai * 128 + m * 16) * ldc + col0;
#pragma unroll
                for (int bj = 0; bj < 2; ++bj) { const pg8::f32x4 v0 = pg8::acc_get(acc, ai, bj, m, 0), v1 = pg8::acc_get(acc, ai, bj, m, 1);
                    if (pn >= 14) {
                        unsigned qv[8];
#pragma unroll
                        for (int i = 0; i < 4; ++i) { const float s0 = sigmoidf_(v0[i]) * 255.f, s1 = sigmoidf_(v1[i]) * 255.f; const unsigned q0 = (unsigned)__builtin_rintf(s0), q1 = (unsigned)__builtin_rintf(s1); qv[i] = q0 < 1u ? 1u : q0; qv[4 + i] = q1 < 1u ? 1u : q1; }
                        v2u w8; w8.x = qv[0] | (qv[1] << 8) | (qv[2] << 16) | (qv[3] << 24); w8.y = qv[4] | (qv[5] << 8) | (qv[6] << 16) | (qv[7] << 24);
                        *(v2u*)((unsigned char*)GATE + (size_t)(row0 + ai * 128 + m * 16) * 2048 + col0 + bj * 128) = w8;
                    } else if (pn == 2 || pn == 3) {
                        v4u w; w.x = pkh2(sigmoidf_(v0[0]), sigmoidf_(v0[1])); w.y = pkh2(sigmoidf_(v0[2]), sigmoidf_(v0[3])); w.z = pkh2(sigmoidf_(v1[0]), sigmoidf_(v1[1])); w.w = pkh2(sigmoidf_(v1[2]), sigmoidf_(v1[3]));
                        *(v4u*)(rowp + bj * 128) = w;
                    } else if (pn < 2 || pn == 6 || pn == 7) {
                        v4u w; w.x = pk2(siluf_(v0[0]), siluf_(v0[1])); w.y = pk2(siluf_(v0[2]), siluf_(v0[3])); w.z = pk2(siluf_(v1[0]), siluf_(v1[1])); w.w = pk2(siluf_(v1[2]), siluf_(v1[3]));
                        *(v4u*)(rowp + bj * 128) = w;
                    } else {
                    v4u w; w.x = pk2(v0[0], v0[1]); w.y = pk2(v0[2], v0[3]); w.z = pk2(v1[0], v1[1]); w.w = pk2(v1[2], v1[3]);
                    if (col0 + bj * 128 < ncols) *(v4u*)(rowp + bj * 128) = w; } } }
    }
};
struct EpiMerged {
    static constexpr bool PERM = true, AFTER_DRAIN = false, TWOPASS = true;
    const bf16* GATE; bf16* O;
    __device__ __forceinline__ void operator()(pg8::AccW& acc, const pg8::Unit& u, int wr, int wc, int fr, int fq) const {
        const int row0 = u.pm * 256 + wr * 64 + fr, col0 = u.pn * 256 + wc * 32 + 8 * fq;
        if (u.pass == 0) {
#pragma unroll
            for (int ai = 0; ai < 2; ++ai)
#pragma unroll
                for (int m = 0; m < 4; ++m) { const unsigned char* rowp = (const unsigned char*)GATE + (size_t)(row0 + ai * 128 + m * 16) * 2048 + col0;
#pragma unroll
                    for (int bj = 0; bj < 2; ++bj) { const v2u a = *(const v2u*)(rowp + bj * 128), b = *(const v2u*)(rowp + 1024 + bj * 128);
                        float r[8];
#pragma unroll
                        for (int i = 0; i < 8; ++i) { const float fa = (float)((a[i >> 2] >> (8 * (i & 3))) & 255u), fb = (float)((b[i >> 2] >> (8 * (i & 3))) & 255u); r[i] = fa * __builtin_amdgcn_rcpf(fb); }
                        { pg8::f32x4 c0 = pg8::acc_get(acc, ai, bj, m, 0), c1 = pg8::acc_get(acc, ai, bj, m, 1);
#pragma unroll
                          for (int i = 0; i < 4; ++i) { c0[i] *= r[i]; c1[i] *= r[4 + i]; }
                          pg8::acc_set(acc, ai, bj, m, 0, c0); pg8::acc_set(acc, ai, bj, m, 1, c1); } } }
        } else {
#pragma unroll
            for (int ai = 0; ai < 2; ++ai)
#pragma unroll
                for (int m = 0; m < 4; ++m) { const size_t ro = (size_t)(row0 + ai * 128 + m * 16);
#pragma unroll
                    for (int bj = 0; bj < 2; ++bj) { const v2u b = *(const v2u*)((const unsigned char*)GATE + ro * 2048 + 1024 + col0 + bj * 128);
                        const pg8::f32x4 v0 = pg8::acc_get(acc, ai, bj, m, 0), v1 = pg8::acc_get(acc, ai, bj, m, 1);
                        float s[8];
#pragma unroll
                        for (int i = 0; i < 8; ++i) s[i] = (float)((b[i >> 2] >> (8 * (i & 3))) & 255u) * (1.f / 255.f);
                        v2u w; w.x = pk4_fp8(4.f * v0[0] * s[0], 4.f * v0[1] * s[1], 4.f * v0[2] * s[2], 4.f * v0[3] * s[3]); w.y = pk4_fp8(4.f * v1[0] * s[4], 4.f * v1[1] * s[5], 4.f * v1[2] * s[6], 4.f * v1[3] * s[7]);
                        *(v2u*)((unsigned char*)O + ro * 1024 + col0 + bj * 128) = w; } }
        }
    }
};
struct EpiResid {
    static constexpr bool PERM = true, AFTER_DRAIN = false, TWOPASS = false;
    const float* X; const float* G1  ; bf16* O;
    __device__ __forceinline__ void operator()(pg8::AccW& acc, const pg8::Unit& u, int wr, int wc, int fr, int fq) const {
        const int row0 = u.pm * 256 + wr * 64 + fr, col0 = u.pn * 256 + wc * 32 + 8 * fq;
        const int b = (u.pm * 256) / SEQ;
        f32x4 g[2][2];
#pragma unroll
        for (int bj = 0; bj < 2; ++bj)
#pragma unroll
            for (int n = 0; n < 2; ++n) g[bj][n] = *(const f32x4*)(G1 + (size_t)b * 6144 + col0 + bj * 128 + 4 * n);
#pragma unroll
        for (int ai = 0; ai < 2; ++ai)
#pragma unroll
            for (int m = 0; m < 4; ++m) { const size_t ro = (size_t)(row0 + ai * 128 + m * 16) * DM + col0;
#pragma unroll
                for (int bj = 0; bj < 2; ++bj) { f32x4 y[2];
#pragma unroll
                    for (int n = 0; n < 2; ++n) { const f32x4 xv = *(const f32x4*)(X + ro + bj * 128 + 4 * n); y[n] = xv + g[bj][n] * pg8::acc_get(acc, ai, bj, m, n); }
                    v4u w; w.x = pk2(y[0][0], y[0][1]); w.y = pk2(y[0][2], y[0][3]); w.z = pk2(y[1][0], y[1][1]); w.w = pk2(y[1][2], y[1][3]);
                    *(v4u*)(O + ro + bj * 128) = w; } }
    }
};
struct EpiStore {
    static constexpr bool PERM = true, AFTER_DRAIN = false, TWOPASS = false;
    bf16* O; int ldc;
    __device__ __forceinline__ void operator()(pg8::AccW& acc, const pg8::Unit& u, int wr, int wc, int fr, int fq) const {
        const int row0 = u.pm * 256 + wr * 64 + fr, col0 = u.pn * 256 + wc * 32 + 8 * fq;
#pragma unroll
        for (int ai = 0; ai < 2; ++ai)
#pragma unroll
            for (int m = 0; m < 4; ++m) { bf16* rowp = O + (size_t)(row0 + ai * 128 + m * 16) * ldc + col0;
#pragma unroll
                for (int bj = 0; bj < 2; ++bj) { const pg8::f32x4 v0 = pg8::acc_get(acc, ai, bj, m, 0), v1 = pg8::acc_get(acc, ai, bj, m, 1);
                    v4u w; w.x = pk2(v0[0], v0[1]); w.y = pk2(v0[2], v0[3]); w.z = pk2(v1[0], v1[1]); w.w = pk2(v1[2], v1[3]);
                    *(v4u*)(rowp + bj * 128) = w; } }
    }
};

template <int MODE> __device__ __forceinline__ int srcmap(int np) {
    if (MODE == 2) np = proj_tile_bf16(np >> 8) * 256 + (np & 255);
    if (MODE == 3) np = proj_tile_fp8(np >> 8) * 256 + (np & 255);
    if (MODE >= 1) return np < 3400 ? np : (np >= 3584 ? np - 184 : -1);
    return np; }
template <int MODE>
__device__ __forceinline__ void transpose_item(const float* W, int N, bf16* WT, int ldw, int koff, float* scr, int kb, int nb, int lane) {
    const int k0 = 64 * kb, n0 = 32 * nb;
    const int sc = srcmap<MODE>(n0 + (lane & 31));
    { float tv[32];
#pragma unroll
      for (int i = 0; i < 32; ++i) { const int kk = 2 * i + (lane >> 5); tv[i] = (sc >= 0) ? W[(size_t)(k0 + kk) * N + sc] : 0.f; }
#pragma unroll
      for (int i = 0; i < 32; ++i) { const int kk = 2 * i + (lane >> 5); scr[kk * 33 + (lane & 31)] = tv[i]; } }
    LDS_WAIT(); __builtin_amdgcn_wave_barrier();
    const int c = lane & 7;
#pragma unroll
    for (int j = 0; j < 4; ++j) { const int n = (lane >> 3) + 8 * j; const float* s = scr + (8 * c) * 33 + n;
        v4u o; o.x = pk2(s[0 * 33], s[1 * 33]); o.y = pk2(s[2 * 33], s[3 * 33]); o.z = pk2(s[4 * 33], s[5 * 33]); o.w = pk2(s[6 * 33], s[7 * 33]);
        *(v4u*)(WT + (size_t)(n0 + n) * ldw + koff + k0 + 8 * c) = o; }
    LDS_WAIT(); __builtin_amdgcn_wave_barrier();
}
template <int MODE> __device__ __forceinline__ int srcmap(int np);
template <int MODE = 0>
__device__ __forceinline__ void transpose_item8(const float* W, int N, unsigned char* WT, int ldw, int koff, float scale, float* scr, int kb, int nb, int lane) {
    const int k0 = 64 * kb, n0 = 32 * nb;
    const int sc = srcmap<MODE>(n0 + (lane & 31));
    { float tv[32];
#pragma unroll
      for (int i = 0; i < 32; ++i) { const int kk = 2 * i + (lane >> 5); tv[i] = (sc >= 0) ? W[(size_t)(k0 + kk) * N + sc] * scale : 0.f; }
#pragma unroll
      for (int i = 0; i < 32; ++i) { const int kk = 2 * i + (lane >> 5); scr[kk * 33 + (lane & 31)] = tv[i]; } }
    LDS_WAIT(); __builtin_amdgcn_wave_barrier();
    const int c = lane & 3;
#pragma unroll
    for (int j = 0; j < 2; ++j) { const int n = (lane >> 2) + 16 * j; const float* sp = scr + (16 * c) * 33 + n;
        v4u o;
#pragma unroll
        for (int q = 0; q < 4; ++q) o[q] = pk4_fp8(sp[(4 * q) * 33], sp[(4 * q + 1) * 33], sp[(4 * q + 2) * 33], sp[(4 * q + 3) * 33]);
        *(v4u*)(WT + (size_t)(n0 + n) * ldw + koff + k0 + 16 * c) = o; }
    LDS_WAIT(); __builtin_amdgcn_wave_barrier();
}
__device__ __forceinline__ void convert_plain(const float* src, bf16* dst, size_t n, size_t gtid, size_t nth) {
    const size_t n8 = n / 8;
    for (size_t i = gtid; i < n8; i += nth) { const f32x4 a = ((const f32x4*)src)[2 * i], b = ((const f32x4*)src)[2 * i + 1];
        v4u o; o.x = pk2(a[0], a[1]); o.y = pk2(a[2], a[3]); o.z = pk2(b[0], b[1]); o.w = pk2(b[2], b[3]); ((v4u*)dst)[i] = o; }
}
__device__ __forceinline__ void convert_fp8(const float* src, unsigned char* dst, size_t n, float scale, size_t gtid, size_t nth) {
    const size_t n16 = n / 16;
    for (size_t i = gtid; i < n16; i += nth) { const f32x4* sp = (const f32x4*)src + 4 * i; const f32x4 a = sp[0] * scale, b = sp[1] * scale, c = sp[2] * scale, d = sp[3] * scale;
        v4u o; o.x = pk4_fp8(a[0], a[1], a[2], a[3]); o.y = pk4_fp8(b[0], b[1], b[2], b[3]); o.z = pk4_fp8(c[0], c[1], c[2], c[3]); o.w = pk4_fp8(d[0], d[1], d[2], d[3]); ((v4u*)dst)[i] = o; }
}
template <bool KKMAJOR>
__device__ __forceinline__ void convert_mxfp4(const float* src, unsigned char* dst, unsigned char* scl, size_t nrows, size_t gtid, size_t nth) {
    const size_t nblk = nrows * 32;
    for (size_t i = gtid; i < nblk; i += nth) {
        const size_t row = i >> 5; const int blk = (int)(i & 31);
        const f32x4* sp = (const f32x4*)(src + row * 1024 + blk * 32);
        f32x4 v[8]; float amax = 0.f;
#pragma unroll
        for (int j = 0; j < 8; ++j) { v[j] = sp[j]; amax = fmaxf(fmaxf(fmaxf(fabsf(v[j][0]), fabsf(v[j][1])), fmaxf(fabsf(v[j][2]), fabsf(v[j][3]))), amax); }
        int e = (int)((__builtin_bit_cast(unsigned, amax) >> 23) & 0xffu) - 127 - 2;
        if (e < -126) e = -126;
        const float inv = __builtin_bit_cast(float, (unsigned)(127 - e) << 23);
        unsigned w[4] = {0u, 0u, 0u, 0u};
#pragma unroll
        for (int j = 0; j < 8; j += 2) { unsigned t = 0u;
            t = __builtin_amdgcn_cvt_scalef32_pk_fp4_f32(t, v[j][0] * inv, v[j][1] * inv, 1.0f, 0);
            t = __builtin_amdgcn_cvt_scalef32_pk_fp4_f32(t, v[j][2] * inv, v[j][3] * inv, 1.0f, 1);
            t = __builtin_amdgcn_cvt_scalef32_pk_fp4_f32(t, v[j + 1][0] * inv, v[j + 1][1] * inv, 1.0f, 2);
            t = __builtin_amdgcn_cvt_scalef32_pk_fp4_f32(t, v[j + 1][2] * inv, v[j + 1][3] * inv, 1.0f, 3);
            w[j >> 1] = t; }
        *(v4u*)(dst + row * 512 + blk * 16) = (v4u){w[0], w[1], w[2], w[3]};
        scl[row * 32 + (KKMAJOR ? ((blk & 3) * 8 + (blk >> 2)) : blk)] = (unsigned char)(e + 127);
    }
}
__device__ __forceinline__ void convert_rowfp4(const float* src, unsigned char* dst, _Float16* scl, int row, int lane) {
    const f32x4* sp = (const f32x4*)(src + (size_t)row * 1024 + lane * 16);
    f32x4 v[4]; float amax = 0.f;
#pragma unroll
    for (int j = 0; j < 4; ++j) { v[j] = sp[j]; amax = fmaxf(fmaxf(fmaxf(fabsf(v[j][0]), fabsf(v[j][1])), fmaxf(fabsf(v[j][2]), fabsf(v[j][3]))), amax); }
    amax = wave_max(amax);
    _Float16 sh = (_Float16)(amax * (1.f / 6.f));
    float sf = (float)sh; if (!(sf > 0.f)) { sf = 1.f; sh = (_Float16)1.f; }
    const float inv = 1.f / sf;
    unsigned w[2];
#pragma unroll
    for (int j = 0; j < 2; ++j) { unsigned t = 0u;
        t = __builtin_amdgcn_cvt_scalef32_pk_fp4_f32(t, v[2 * j][0] * inv, v[2 * j][1] * inv, 1.0f, 0);
        t = __builtin_amdgcn_cvt_scalef32_pk_fp4_f32(t, v[2 * j][2] * inv, v[2 * j][3] * inv, 1.0f, 1);
        t = __builtin_amdgcn_cvt_scalef32_pk_fp4_f32(t, v[2 * j + 1][0] * inv, v[2 * j + 1][1] * inv, 1.0f, 2);
        t = __builtin_amdgcn_cvt_scalef32_pk_fp4_f32(t, v[2 * j + 1][2] * inv, v[2 * j + 1][3] * inv, 1.0f, 3);
        w[j] = t; }
    *(v2u*)(dst + (size_t)row * 512 + lane * 8) = (v2u){w[0], w[1]};
    if (lane == 0) scl[row] = sh;
}
__device__ __forceinline__ void convert_rows_x4(const Params& p, int r0, int st, int lane) {
    unsigned char* ws = p.ws;
    f32x4 v[4][4];
#pragma unroll
    for (int n = 0; n < 4; ++n) { const int it = r0 + n * st; const float* src = (it < NEXP) ? p.peer_u : p.peer_v; const int row = (it < NEXP) ? it : it - NEXP;
        const f32x4* sp = (const f32x4*)(src + (size_t)row * 1024) + lane;
#pragma unroll
        for (int j = 0; j < 4; ++j) v[n][j] = sp[64 * j]; }
#pragma unroll
    for (int n = 0; n < 4; ++n) { const int it = r0 + n * st; const bool isu = it < NEXP; const int row = isu ? it : it - NEXP;
        unsigned char* dst = ws + (isu ? WS_U : WS_V); _Float16* scl = (_Float16*)(ws + (isu ? WS_US : WS_VS));
        float amax = 0.f;
#pragma unroll
        for (int j = 0; j < 4; ++j) amax = fmaxf(fmaxf(fmaxf(fabsf(v[n][j][0]), fabsf(v[n][j][1])), fmaxf(fabsf(v[n][j][2]), fabsf(v[n][j][3]))), amax);
        amax = wave_max(amax);
        _Float16 sh = (_Float16)(amax * (1.f / 6.f));
        float sf = (float)sh; if (!(sf > 0.f)) { sf = 1.f; sh = (_Float16)1.f; }
        const float inv = 1.f / sf;
#pragma unroll
        for (int j = 0; j < 4; ++j) { unsigned t = 0u;
            t = __builtin_amdgcn_cvt_scalef32_pk_fp4_f32(t, v[n][j][0] * inv, v[n][j][1] * inv, 1.0f, 0);
            t = __builtin_amdgcn_cvt_scalef32_pk_fp4_f32(t, v[n][j][2] * inv, v[n][j][3] * inv, 1.0f, 1);
            *(unsigned short*)(dst + (size_t)row * 512 + (lane + 64 * j) * 2) = (unsigned short)t; }
        if (lane == 0) scl[row] = sh; }
}
__device__ __forceinline__ void phase0(const Params& p, unsigned char* lds) {
    const int tid = threadIdx.x, wave = tid >> 6, lane = tid & 63, G = gridDim.x;
    const int gw = blockIdx.x * NWAVES + wave, NGW = G * NWAVES;
    float* scr = (float*)(lds + wave * 16384);
    unsigned char* ws = p.ws;
    constexpr int I_IN = 16 * (2048 / 32), I_IN8 = 16 * (3584 / 32), I_A = 8 * 32, I_O = 16 * 32, I_Q = 16 * 64;
    constexpr int NT = I_IN + I_IN8 + 2 * I_A + I_O + I_Q;
    for (int it = gw; it < NT; it += NGW) {
        int r = it;
        if (r < I_IN) { transpose_item<2>(p.w_in, INW, (bf16*)(ws + WS_WIN), 1024, 0, scr, r / 64, r % 64, lane); continue; } r -= I_IN;
        if (r < I_IN8) { transpose_item8<3>(p.w_in, INW, ws + WS_WIN8, 1024, 0, 32.f, scr, r / 112, r % 112, lane); continue; } r -= I_IN8;
        if (r < I_A) { transpose_item8(p.w_a, 1024, ws + WS_WAB8, 1024, 0, 32.f, scr, r / 32, r % 32, lane); continue; } r -= I_A;
        if (r < I_A) { transpose_item8(p.w_b, 1024, ws + WS_WAB8, 1024, 512, 4.f, scr, r / 32, r % 32, lane); continue; } r -= I_A;
        if (r < I_O) { transpose_item8(p.w_out, 1024, ws + WS_WOUT8, 1024, 0, 32.f, scr, r / 32, r % 32, lane); continue; } r -= I_O;
        transpose_item8(p.peer_wq, 2048, ws + WS_WQ8, 1024, 0, 32.f, scr, r / 64, r % 64, lane);
    }
    for (int it = NGW - 1 - gw; it < 96 * 8; it += NGW) {
        const int cgp = it % 96, ks = it / 96, col = cgp * 64 + lane, k0 = ks * 128;
#pragma unroll
        for (int i = 0; i < 16; ++i) { const int e = i * 64 + lane, b = e >> 7, k = e & 127; scr[e] = siluf_(p.c[b * 1024 + k0 + k]); }
        LDS_WAIT(); __builtin_amdgcn_wave_barrier();
        float acc[8];
#pragma unroll
        for (int b = 0; b < 8; ++b) acc[b] = 0.f;
#pragma unroll 1
        for (int kq = 0; kq < 128; kq += 32) { float wv_[32];
#pragma unroll
            for (int k = 0; k < 32; ++k) wv_[k] = p.w_ada[(size_t)(k0 + kq + k) * 6144 + col];
#pragma unroll
            for (int k = 0; k < 32; ++k)
#pragma unroll
                for (int b = 0; b < 8; ++b) acc[b] += scr[b * 128 + kq + k] * wv_[k]; }
        float* mp = (float*)(ws + WS_MODP) + (size_t)ks * 8 * 6144 + col;
#pragma unroll
        for (int b = 0; b < 8; ++b) mp[b * 6144] = acc[b];
        LDS_WAIT(); __builtin_amdgcn_wave_barrier();
    }
    const size_t gtid = (size_t)blockIdx.x * NTHREADS + tid, nth = (size_t)G * NTHREADS;
    convert_plain(p.peer_subkeys, (bf16*)(ws + WS_SK), (size_t)16 * 128 * 128, gtid, nth);
    {
        int it = gw;
        for (; it + 3 * NGW < 2 * NEXP; it += 4 * NGW) convert_rows_x4(p, it, NGW, lane);
        for (; it < 2 * NEXP; it += NGW) { if (it < NEXP) convert_rowfp4(p.peer_u, ws + WS_U, (_Float16*)(ws + WS_US), it, lane); else convert_rowfp4(p.peer_v, ws + WS_V, (_Float16*)(ws + WS_VS), it - NEXP, lane); }
    }
}

template <bool FIRST>
__device__ __forceinline__ void normmod_phase(const Params& p, unsigned char* lds, const float* src, bf16* dst, const float* gvec, int shift_off, int scale_off) {
    const int tid = threadIdx.x, wave = tid >> 6, lane = tid & 63, G = gridDim.x;
    unsigned char* ws = p.ws;
    float* A = (float*)lds;
    float* Bv = A + 1024;
    const float* MODP = (const float*)(ws + WS_MODP);
    float* MOD = (float*)(ws + WS_MOD);
    if (FIRST) {
        for (int e = blockIdx.x * NTHREADS + tid; e < 8 * 6144; e += G * NTHREADS) { const int col = e % 6144; float s = p.b_ada[col];
#pragma unroll
            for (int ks = 0; ks < 8; ++ks) s += MODP[(size_t)ks * 8 * 6144 + e];
            MOD[e] = s; }
    }
    int curb = -1;
    for (int chunk = blockIdx.x; chunk < T / 128; chunk += G) {
        const int b = (chunk * 128) / SEQ;
        if (b != curb) {
            __syncthreads();
            for (int col = tid; col < 1024; col += NTHREADS) {
                float sc, sh;
                if (FIRST) { sc = p.b_ada[scale_off + col]; sh = p.b_ada[shift_off + col];
#pragma unroll
                    for (int ks = 0; ks < 8; ++ks) { sc += MODP[(size_t)(ks * 8 + b) * 6144 + scale_off + col]; sh += MODP[(size_t)(ks * 8 + b) * 6144 + shift_off + col]; } }
                else { sc = MOD[b * 6144 + scale_off + col]; sh = MOD[b * 6144 + shift_off + col]; }
                A[col] = gvec[col] * (1.f + sc); Bv[col] = sh; }
            __syncthreads(); curb = b;
        }
        for (int r = wave; r < 128; r += NWAVES) {
            const size_t row = (size_t)chunk * 128 + r;
            f32x4 v[4]; float s = 0.f;
            if (FIRST) { const f32x4* xr = (const f32x4*)(src + row * DM) + lane;
#pragma unroll
                for (int j = 0; j < 4; ++j) v[j] = xr[64 * j]; }
            else { const v2u* xr = (const v2u*)((const bf16*)src + row * DM) + lane;
#pragma unroll
                for (int j = 0; j < 4; ++j) { const v2u t = xr[64 * j]; v[j] = (f32x4){bflo(t.x), bfhi(t.x), bflo(t.y), bfhi(t.y)}; } }
#pragma unroll
            for (int j = 0; j < 4; ++j) s += (v[j][0] * v[j][0] + v[j][1] * v[j][1]) + (v[j][2] * v[j][2] + v[j][3] * v[j][3]);
            const float rstd = rsqrtf(wave_sum(s) * (1.f / DM) + RMS_EPS);
            v2u* o8 = (v2u*)(dst + row * DM) + lane;
#pragma unroll
            for (int j = 0; j < 4; ++j) { const int c0 = 4 * lane + 256 * j; const f32x4 a = *(const f32x4*)(A + c0), sh = *(const f32x4*)(Bv + c0);
                v2u o; o.x = pk2(v[j][0] * rstd * a[0] + sh[0], v[j][1] * rstd * a[1] + sh[1]); o.y = pk2(v[j][2] * rstd * a[2] + sh[2], v[j][3] * rstd * a[3] + sh[3]);
                if (FIRST) o8[64 * j] = o;
                if (FIRST) *(unsigned*)(ws + WS_H8 + row * DM + c0) = pk4_fp8(v[j][0] * rstd * a[0] + sh[0], v[j][1] * rstd * a[1] + sh[1], v[j][2] * rstd * a[2] + sh[2], v[j][3] * rstd * a[3] + sh[3]);
                if (!FIRST) { float* st = (float*)(lds + 8192) + wave * 1056;
                    const float y0 = v[j][0] * rstd * a[0] + sh[0], y1 = v[j][1] * rstd * a[1] + sh[1], y2 = v[j][2] * rstd * a[2] + sh[2], y3 = v[j][3] * rstd * a[3] + sh[3];
                    *(unsigned*)(ws + WS_H28 + row * DM + c0) = pk4_fp8(y0, y1, y2, y3);
                    const int pc = c0 + (c0 >> 5); st[pc] = y0; st[pc + 1] = y1; st[pc + 2] = y2; st[pc + 3] = y3; } }
            if (!FIRST) {
                const float* st = (const float*)(lds + 8192) + wave * 1056;
                LDS_WAIT(); __builtin_amdgcn_wave_barrier();
                if (lane < 32) {
                    float x[32];
#pragma unroll
                    for (int k = 0; k < 32; ++k) x[k] = st[lane * 33 + k];
#pragma unroll
                    for (int t = 0; t < H4_NT; ++t) {
                        float amax = 0.f;
#pragma unroll
                        for (int k = 0; k < 32; ++k) amax = fmaxf(amax, fabsf(x[k]));
                        int e = (int)((__builtin_bit_cast(unsigned, amax) >> 23) & 0xffu) - 127 - 2; if (e < -126) e = -126;
                        const float inv = __builtin_bit_cast(float, (unsigned)(127 - e) << 23), sc = __builtin_bit_cast(float, (unsigned)(127 + e) << 23);
                        unsigned w[4];
#pragma unroll
                        for (int r = 0; r < 4; ++r) { unsigned tw = 0u;
                            tw = __builtin_amdgcn_cvt_scalef32_pk_fp4_f32(tw, x[8 * r] * inv, x[8 * r + 1] * inv, 1.0f, 0);
                            tw = __builtin_amdgcn_cvt_scalef32_pk_fp4_f32(tw, x[8 * r + 2] * inv, x[8 * r + 3] * inv, 1.0f, 1);
                            tw = __builtin_amdgcn_cvt_scalef32_pk_fp4_f32(tw, x[8 * r + 4] * inv, x[8 * r + 5] * inv, 1.0f, 2);
                            tw = __builtin_amdgcn_cvt_scalef32_pk_fp4_f32(tw, x[8 * r + 6] * inv, x[8 * r + 7] * inv, 1.0f, 3);
                            w[r] = tw;
                            const f32x2 d0 = __builtin_amdgcn_cvt_scalef32_pk_f32_fp4(tw, 1.0f, 0), d1 = __builtin_amdgcn_cvt_scalef32_pk_f32_fp4(tw, 1.0f, 1), d2 = __builtin_amdgcn_cvt_scalef32_pk_f32_fp4(tw, 1.0f, 2), d3 = __builtin_amdgcn_cvt_scalef32_pk_f32_fp4(tw, 1.0f, 3);
                            x[8 * r] -= d0[0] * sc; x[8 * r + 1] -= d0[1] * sc; x[8 * r + 2] -= d1[0] * sc; x[8 * r + 3] -= d1[1] * sc;
                            x[8 * r + 4] -= d2[0] * sc; x[8 * r + 5] -= d2[1] * sc; x[8 * r + 6] -= d3[0] * sc; x[8 * r + 7] -= d3[1] * sc; }
                        *(v4u*)(ws + WS_H4D + (row * H4_NT + t) * 512 + lane * 16) = (v4u){w[0], w[1], w[2], w[3]};
                        *(ws + WS_H4S + (row * H4_NT + t) * 32 + (lane & 3) * 8 + (lane >> 2)) = (unsigned char)(e + 127);
                    }
                }
                LDS_WAIT(); __builtin_amdgcn_wave_barrier();
            }
        }
    }
    __syncthreads();
}

constexpr int HGL_QT = 0, HGL_KT = 17408, HGL_QE = 34816, HGL_KLT = 52224, HGL_VT = 70656, HGL_AM = 89088, HGL_DEC = 98304, HGL_TOT = 98816, HGL_SSQ = 100864;
constexpr int HG_LDR = 136;
constexpr int HG_LDC = 72;
#define ROW_SUM16(x) do { x += __builtin_bit_cast(float, __builtin_amdgcn_update_dpp(0, __builtin_bit_cast(int, x), 0x128, 0xf, 0xf, false)); \
    x += __builtin_bit_cast(float, __builtin_amdgcn_update_dpp(0, __builtin_bit_cast(int, x), 0x124, 0xf, 0xf, false)); \
    x += __builtin_bit_cast(float, __builtin_amdgcn_update_dpp(0, __builtin_bit_cast(int, x), 0x122, 0xf, 0xf, false)); \
    x += __builtin_bit_cast(float, __builtin_amdgcn_update_dpp(0, __builtin_bit_cast(int, x), 0x121, 0xf, 0xf, false)); } while (0)
template <int half>
__device__ __forceinline__ void hgrn_item(const Params& p, unsigned char* lds, int item) {
    const int b = item >> 2, h = item & 3;
    const int tid = threadIdx.x, w = tid >> 6, lane = tid & 63, fr = lane & 15, fq = lane >> 4;
    unsigned char* ws = p.ws;
    const bf16* HG = (const bf16*)(ws + WS_HG);
    bf16* YA = (bf16*)(ws + WS_H);
    bf16* QT = (bf16*)(lds + HGL_QT); bf16* KT = (bf16*)(lds + HGL_KT); bf16* QE = (bf16*)(lds + HGL_QE);
    bf16* KLT = (bf16*)(lds + HGL_KLT); bf16* VT = (bf16*)(lds + HGL_VT); bf16* AM = (bf16*)(lds + HGL_AM);
    float* DEC = (float*)(lds + HGL_DEC); float* TOT = (float*)(lds + HGL_TOT); float* SSQ = (float*)(lds + HGL_SSQ);
    const int pd = tid & 127, pq = tid >> 7;
    float lbv; { const float a0 = p.hg_lb[h * 128 + pd], a1 = p.hg_lb[512 + h * 128 + pd]; lbv = 1.f / (1.f + __expf(a1 - a0)); }
    const int e0 = w * 16;
    const float ogv = p.hg_onorm_g[e0 + fr];
    pg8::f32x4 S[8];
#pragma unroll
    for (int i = 0; i < 8; ++i) S[i] = (pg8::f32x4){0.f, 0.f, 0.f, 0.f};
    const size_t rowb = (size_t)b * SEQ;
    const int c0 = half * 32;
    bf16* QCg = (bf16*)(ws + WS_HQC) + (size_t)item * 2048 * 128; float* OLg = (float*)(ws + WS_HOL) + (size_t)item * 32 * 8 * 4 * 256;
    float cum = 1.f;
    unsigned short rq[16], rf[16], rv[16];
    { const bf16* gp = HG + (rowb + (size_t)c0 * 64 + pq * 16) * LD_HG + h * 128 + pd;
#pragma unroll
      for (int i = 0; i < 16; ++i) { rq[i] = gp[(size_t)i * LD_HG]; rf[i] = gp[(size_t)i * LD_HG + 512]; rv[i] = gp[(size_t)i * LD_HG + 1024]; } }
    for (int chunk = c0; chunk < c0 + 32; ++chunk) {
        const size_t row0 = rowb + (size_t)chunk * 64;
        float fq_[16], kq_[16], cs[16];
        float run = 0.f;
#pragma unroll
        for (int i = 0; i < 16; ++i) { const float f = lbv + (1.f - lbv) * h2f(rf[i]); kq_[i] = 1.f - f; run += __builtin_amdgcn_logf(f); cs[i] = run; fq_[i] = bf2f(rq[i]); }
        TOT[pq * 128 + pd] = run;
        { v4u v0, v1;
          v0.x = rv[0] | ((unsigned)rv[1] << 16); v0.y = rv[2] | ((unsigned)rv[3] << 16); v0.z = rv[4] | ((unsigned)rv[5] << 16); v0.w = rv[6] | ((unsigned)rv[7] << 16);
          v1.x = rv[8] | ((unsigned)rv[9] << 16); v1.y = rv[10] | ((unsigned)rv[11] << 16); v1.z = rv[12] | ((unsigned)rv[13] << 16); v1.w = rv[14] | ((unsigned)rv[15] << 16);
          *(v4u*)(VT + pd * HG_LDC + pq * 16) = v0; *(v4u*)(VT + pd * HG_LDC + pq * 16 + 8) = v1; }
        unsigned short rg[16];
#pragma unroll
        for (int i = 0; i < 16; ++i) rg[i] = half ? (unsigned short)0 : HG[(row0 + (i >> 2) * 16 + fq * 4 + (i & 3)) * LD_HG + 1536 + h * 128 + e0 + fr];
        if (chunk + 1 < c0 + 32) { const bf16* gp = HG + (row0 + 64 + pq * 16) * LD_HG + h * 128 + pd;
#pragma unroll
            for (int i = 0; i < 16; ++i) { rq[i] = gp[(size_t)i * LD_HG]; rf[i] = gp[(size_t)i * LD_HG + 512]; rv[i] = gp[(size_t)i * LD_HG + 1024]; } }
        __syncthreads();
        const float t0 = TOT[pd], t1 = TOT[128 + pd], t2 = TOT[256 + pd], t3 = TOT[384 + pd];
        const float base = (pq > 0 ? t0 : 0.f) + (pq > 1 ? t1 : 0.f) + (pq > 2 ? t2 : 0.f);
        const float bmid = t0 + t1, blast = (t0 + t1) + (t2 + t3);
        const float emid = __builtin_amdgcn_exp2f(bmid), elm = __builtin_amdgcn_exp2f(blast - bmid);
        if (pq == 0) DEC[pd] = __builtin_amdgcn_exp2f(blast);
        { unsigned klp[8];
#pragma unroll
          for (int j = 0; j < 8; ++j) {
              float qtv[2], ktv[2], qev[2], klv[2];
#pragma unroll
              for (int u = 0; u < 2; ++u) { const int i = 2 * j + u; const float bb = base + cs[i]; const float E1 = __builtin_amdgcn_exp2f(bb - bmid), R1 = __builtin_amdgcn_rcpf(E1);
                  qtv[u] = fq_[i] * E1; ktv[u] = kq_[i] * R1; qev[u] = qtv[u] * emid; klv[u] = ktv[u] * elm; }
              const int a0 = (pq * 16 + 2 * j) * HG_LDR + pd;
              const unsigned w0 = pk2(qtv[0], ktv[0]), w1 = pk2(qtv[1], ktv[1]), w2 = pk2(qev[0], qev[1]);
              QT[a0] = (bf16)(w0 & 0xffffu); KT[a0] = (bf16)(w0 >> 16); QT[a0 + HG_LDR] = (bf16)(w1 & 0xffffu); KT[a0 + HG_LDR] = (bf16)(w1 >> 16);
              QE[a0] = (bf16)(w2 & 0xffffu); QE[a0 + HG_LDR] = (bf16)(w2 >> 16);
              if (half) { const unsigned w3 = pk2(qev[0] * cum, qev[1] * cum); bf16* qc = QCg + ((size_t)(chunk - 32) * 64 + pq * 16 + 2 * j) * 128 + pd; qc[0] = (bf16)(w3 & 0xffffu); qc[128] = (bf16)(w3 >> 16); }
              klp[j] = pk2(klv[0], klv[1]); }
          *(v4u*)(KLT + pd * HG_LDC + pq * 16) = (v4u){klp[0], klp[1], klp[2], klp[3]}; *(v4u*)(KLT + pd * HG_LDC + pq * 16 + 8) = (v4u){klp[4], klp[5], klp[6], klp[7]}; }
        cum *= __builtin_amdgcn_exp2f(blast);
        __syncthreads();
#pragma unroll
        for (int tt = 0; tt < 2; ++tt) { const int id = w + 8 * tt, rt = id >> 2, ct = id & 3;
            pg8::f32x4 a = {0.f, 0.f, 0.f, 0.f};
            if (ct <= rt) {
#pragma unroll
                for (int ks = 0; ks < 4; ++ks) { const bf16x8 af = *(const bf16x8*)(QT + (rt * 16 + fr) * HG_LDR + ks * 32 + fq * 8), bfv = *(const bf16x8*)(KT + (ct * 16 + fr) * HG_LDR + ks * 32 + fq * 8);
                    a = __builtin_amdgcn_mfma_f32_16x16x32_bf16(af, bfv, a, 0, 0, 0); } }
#pragma unroll
            for (int r = 0; r < 4; ++r) { const int c = rt * 16 + fq * 4 + r, sidx = ct * 16 + fr; AM[c * HG_LDC + sidx] = (bf16)((sidx <= c) ? f2bf(a[r]) : 0u); } }
        const bf16x8 vb0 = *(const bf16x8*)(VT + (e0 + fr) * HG_LDC + fq * 8), vb1 = *(const bf16x8*)(VT + (e0 + fr) * HG_LDC + 32 + fq * 8);
        bf16x8 sb[4];
#pragma unroll
        for (int ks = 0; ks < 4; ++ks) { v4u t; t.x = pk2(S[2 * ks][0], S[2 * ks][1]); t.y = pk2(S[2 * ks][2], S[2 * ks][3]); t.z = pk2(S[2 * ks + 1][0], S[2 * ks + 1][1]); t.w = pk2(S[2 * ks + 1][2], S[2 * ks + 1][3]); sb[ks] = __builtin_bit_cast(bf16x8, t); }
        pg8::f32x4 o[4];
#define HG_LDQ(RT, QV) do { _Pragma("unroll") for (int ks = 0; ks < 4; ++ks) { const v2u lo = *(const v2u*)(QE + ((RT) * 16 + fr) * HG_LDR + ks * 32 + fq * 4), hi = *(const v2u*)(QE + ((RT) * 16 + fr) * HG_LDR + ks * 32 + 16 + fq * 4); \
            const v4u t = {lo.x, lo.y, hi.x, hi.y}; QV[ks] = __builtin_bit_cast(bf16x8, t); } } while (0)
#define HG_QS(RT, QV) do { pg8::f32x4 a = {0.f, 0.f, 0.f, 0.f}; _Pragma("unroll") for (int ks = 0; ks < 4; ++ks) a = __builtin_amdgcn_mfma_f32_16x16x32_bf16(QV[ks], sb[ks], a, 0, 0, 0); o[RT] = a; } while (0)
        { bf16x8 qa[4], qb[4];
          HG_LDQ(0, qa); HG_LDQ(1, qb);
          __builtin_amdgcn_sched_barrier(0);
          HG_QS(0, qa); HG_LDQ(2, qa);
          __builtin_amdgcn_sched_barrier(0);
          HG_QS(1, qb); HG_LDQ(3, qb);
          __builtin_amdgcn_sched_barrier(0);
          HG_QS(2, qa); HG_QS(3, qb); }
#undef HG_LDQ
#undef HG_QS
        __syncthreads();
        { bf16x8 am[4][2];
#pragma unroll
          for (int rt = 0; rt < 4; ++rt) { am[rt][0] = *(const bf16x8*)(AM + (rt * 16 + fr) * HG_LDC + fq * 8); am[rt][1] = *(const bf16x8*)(AM + (rt * 16 + fr) * HG_LDC + 32 + fq * 8); }
          __builtin_amdgcn_sched_barrier(0);
#pragma unroll
          for (int rt = 0; rt < 4; ++rt) { o[rt] = __builtin_amdgcn_mfma_f32_16x16x32_bf16(am[rt][0], vb0, o[rt], 0, 0, 0); o[rt] = __builtin_amdgcn_mfma_f32_16x16x32_bf16(am[rt][1], vb1, o[rt], 0, 0, 0); } }
#pragma unroll
        for (int dh = 0; dh < 2; ++dh) {
            f32x4 dc[4]; bf16x8 kl[4][2];
#pragma unroll
            for (int j = 0; j < 4; ++j) { const int dt = dh * 4 + j; dc[j] = *(const f32x4*)(DEC + dt * 16 + fq * 4);
                kl[j][0] = *(const bf16x8*)(KLT + (dt * 16 + fr) * HG_LDC + fq * 8); kl[j][1] = *(const bf16x8*)(KLT + (dt * 16 + fr) * HG_LDC + 32 + fq * 8); }
            __builtin_amdgcn_sched_barrier(0);
#pragma unroll
            for (int j = 0; j < 4; ++j) { const int dt = dh * 4 + j;
                pg8::f32x4 a = S[dt]; a[0] *= dc[j][0]; a[1] *= dc[j][1]; a[2] *= dc[j][2]; a[3] *= dc[j][3];
                a = __builtin_amdgcn_mfma_f32_16x16x32_bf16(kl[j][0], vb0, a, 0, 0, 0);
                a = __builtin_amdgcn_mfma_f32_16x16x32_bf16(kl[j][1], vb1, a, 0, 0, 0);
                S[dt] = a; } }
        if (half) {
#pragma unroll
            for (int rt = 0; rt < 4; ++rt) *(pg8::f32x4*)(OLg + ((((size_t)(chunk - 32)) * 8 + w) * 4 + rt) * 256 + lane * 4) = o[rt];
            __syncthreads();
            continue;
        }
#pragma unroll
        for (int rt = 0; rt < 4; ++rt)
#pragma unroll
            for (int r = 0; r < 4; ++r) { float x = o[rt][r] * o[rt][r];
                ROW_SUM16(x);
                if (fr == 0) SSQ[w * 64 + rt * 16 + fq * 4 + r] = x; }
        __syncthreads();
        float tot = 0.f;
#pragma unroll
        for (int ww = 0; ww < 8; ++ww) tot += SSQ[ww * 64 + lane];
        const float rstd_l = rsqrtf(tot * (1.f / 128.f) + RMS_EPS);
        float* RSW = (float*)(lds + 102912) + w * 64;
        RSW[lane] = rstd_l;
        __builtin_amdgcn_wave_barrier();
#pragma unroll
        for (int rt = 0; rt < 4; ++rt) { const f32x4 rs4 = *(const f32x4*)(RSW + rt * 16 + fq * 4);
#pragma unroll
            for (int r = 0; r < 4; ++r) { const int c = rt * 16 + fq * 4 + r; const float rs = rs4[r];
                const float y = o[rt][r] * rs * ogv * bf2f(rg[rt * 4 + r]);
                ((unsigned char*)YA)[(row0 + c) * 1024 + h * 128 + e0 + fr] = (unsigned char)(__builtin_amdgcn_cvt_pk_fp8_f32(y, 0.f, 0, false) & 0xff); } }
    }
    if (!half) {
#pragma unroll
        for (int ks = 0; ks < 4; ++ks) { v4u t; t.x = pk2(S[2 * ks][0], S[2 * ks][1]); t.y = pk2(S[2 * ks][2], S[2 * ks][3]); t.z = pk2(S[2 * ks + 1][0], S[2 * ks + 1][1]); t.w = pk2(S[2 * ks + 1][2], S[2 * ks + 1][3]);
            *(v4u*)(ws + WS_HSB + ((((size_t)item * 8 + w) * 4 + ks) * 64 + lane) * 16) = t; }
    }
    __syncthreads();
}
__device__ __forceinline__ void hgrn_fix(const Params& p, int item, int c, int rt, int lane) {
    const int b = item >> 2, h = item & 3, fr = lane & 15, fq = lane >> 4;
    unsigned char* ws = p.ws;
    const bf16* HG = (const bf16*)(ws + WS_HG);
    bf16* YA = (bf16*)(ws + WS_H);
    const bf16* QCg = (const bf16*)(ws + WS_HQC) + (size_t)item * 2048 * 128; const float* OLg = (const float*)(ws + WS_HOL) + (size_t)item * 32 * 8 * 4 * 256;
    const size_t row0 = (size_t)b * SEQ + (size_t)(32 + c) * 64 + rt * 16;
    bf16x8 Aq[4];
    { const bf16* qr = QCg + ((size_t)c * 64 + rt * 16 + fr) * 128;
#pragma unroll
      for (int ks = 0; ks < 4; ++ks) { const v2u lo = *(const v2u*)(qr + ks * 32 + fq * 4), hi = *(const v2u*)(qr + ks * 32 + 16 + fq * 4); const v4u t = {lo.x, lo.y, hi.x, hi.y}; Aq[ks] = __builtin_bit_cast(bf16x8, t); } }
    float ogv[8]; unsigned short rg[8][4];
#pragma unroll
    for (int w2 = 0; w2 < 8; ++w2) { ogv[w2] = p.hg_onorm_g[w2 * 16 + fr];
#pragma unroll
        for (int r = 0; r < 4; ++r) rg[w2][r] = HG[(row0 + fq * 4 + r) * LD_HG + 1536 + h * 128 + w2 * 16 + fr]; }
    pg8::f32x4 o[8];
    pg8::f32x4 ol[2]; v4u sbr[2][4];
#define FX_LOAD(SLOT, W2) do { ol[SLOT] = *(const pg8::f32x4*)(OLg + ((((size_t)c) * 8 + (W2)) * 4 + rt) * 256 + lane * 4); \
        _Pragma("unroll") for (int ks = 0; ks < 4; ++ks) sbr[SLOT][ks] = *(const v4u*)(ws + WS_HSB + ((((size_t)item * 8 + (W2)) * 4 + ks) * 64 + lane) * 16); } while (0)
    FX_LOAD(0, 0);
#pragma unroll
    for (int w2 = 0; w2 < 8; ++w2) {
        if (w2 + 1 < 8) FX_LOAD((w2 + 1) & 1, w2 + 1);
        pg8::f32x4 a = ol[w2 & 1];
#pragma unroll
        for (int ks = 0; ks < 4; ++ks) a = __builtin_amdgcn_mfma_f32_16x16x32_bf16(Aq[ks], __builtin_bit_cast(bf16x8, sbr[w2 & 1][ks]), a, 0, 0, 0);
        o[w2] = a; }
#undef FX_LOAD
    float rs[4];
#pragma unroll
    for (int r = 0; r < 4; ++r) { float x = 0.f;
#pragma unroll
        for (int w2 = 0; w2 < 8; ++w2) x += o[w2][r] * o[w2][r];
        ROW_SUM16(x);
        rs[r] = rsqrtf(x * (1.f / 128.f) + RMS_EPS); }
#pragma unroll
    for (int w2 = 0; w2 < 8; ++w2) {
#pragma unroll
        for (int r = 0; r < 4; ++r) { const size_t row = row0 + fq * 4 + r;
            const float y = o[w2][r] * rs[r] * ogv[w2] * bf2f((unsigned)rg[w2][r]);
            ((unsigned char*)YA)[row * 1024 + h * 128 + w2 * 16 + fr] = (unsigned char)(__builtin_amdgcn_cvt_pk_fp8_f32(y, 0.f, 0, false) & 0xff); } }
}

__device__ __forceinline__ unsigned f16key(float x) {
    x = x + 0.f;
    const _Float16 hx = (_Float16)x; const unsigned short bits = __builtin_bit_cast(unsigned short, hx);
    const int m = ((int)(short)bits >> 15) | 0x8000;
    return (unsigned)((bits ^ (unsigned)m) & 0xffffu);
}
__device__ __forceinline__ unsigned wave_incl_scan(unsigned x) {
#define DPP_ADD(CTRL, RM) x += (unsigned)__builtin_amdgcn_update_dpp(0, (int)x, CTRL, RM, 0xf, false)
    DPP_ADD(0x111, 0xf); DPP_ADD(0x112, 0xf); DPP_ADD(0x114, 0xf); DPP_ADD(0x118, 0xf);
    DPP_ADD(0x142, 0xa); DPP_ADD(0x143, 0xc);
#undef DPP_ADD
    return x;
}
__device__ __forceinline__ void find_bin(const unsigned* hist, int K, int lane, int& bin, int& rem) {
    const int rl = 63 - lane;
    const v4u hv = *(const v4u*)(hist + 4 * rl);
    const unsigned c = hv.x + hv.y + hv.z + hv.w;
    unsigned x = c;
#define DPP_ADD(CTRL, RM) x += (unsigned)__builtin_amdgcn_update_dpp(0, (int)x, CTRL, RM, 0xf, false)
    DPP_ADD(0x111, 0xf); DPP_ADD(0x112, 0xf); DPP_ADD(0x114, 0xf); DPP_ADD(0x118, 0xf);
    DPP_ADD(0x142, 0xa); DPP_ADD(0x143, 0xc);
#undef DPP_ADD
    const unsigned above = x - c;
    const bool mine = (above < (unsigned)K) && ((unsigned)K <= x);
    int mybin = 0, myrem = 0;
    if (mine) { unsigned ca = above; const unsigned hh[4] = {hv.x, hv.y, hv.z, hv.w}; bool found = false;
#pragma unroll
        for (int i = 3; i >= 0; --i) { if (!found) { if (ca + hh[i] >= (unsigned)K) { mybin = 4 * rl + i; myrem = K - (int)ca; found = true; } else ca += hh[i]; } } }
    const unsigned long long m = __ballot(mine);
    const int src = (int)__builtin_ctzll(m | (1ull << 63));
    bin = __builtin_amdgcn_readlane(mybin, src); rem = __builtin_amdgcn_readlane(myrem, src);
}
__device__ __forceinline__ void dsa1_item(const Params& p, unsigned char* lds, int item) {
    const int b = item >> 8, q0 = (item & 255) * 16;
    const int tid = threadIdx.x, w = tid >> 6, lane = tid & 63, fr = lane & 15, fq = lane >> 4;
    unsigned char* ws = p.ws;
    const bf16* IDX = (const bf16*)(ws + WS_IDX);
    unsigned short* Ik = (unsigned short*)lds;
    unsigned* hist1 = (unsigned*)(lds + 131072);
    unsigned* hist = (unsigned*)(lds + 131072 + 16384) + w * 256;
    const size_t rowb = (size_t)b * SEQ;
    *(v4u*)(hist1 + tid * 4) = (v4u){0u, 0u, 0u, 0u}; *(v4u*)(hist1 + 2048 + tid * 4) = (v4u){0u, 0u, 0u, 0u};
    bf16x8 Af[8][2];
    { const bf16* rp = IDX + (rowb + q0 + fr) * LD_IDX + fq * 8;
#pragma unroll
      for (int h = 0; h < 8; ++h) { Af[h][0] = *(const bf16x8*)(rp + h * 64); Af[h][1] = *(const bf16x8*)(rp + h * 64 + 32); } }
    const float idx_scale = 0.5f * 0.125f * 0.35355339059327373f;
    bf16x8 Aw[2];
    { float wa[8];
      { const v4u wq = *(const v4u*)(IDX + (rowb + q0 + fr) * LD_IDX + 576);
#pragma unroll
        for (int i = 0; i < 4; ++i) { wa[2 * i] = bflo(wq[i]) * idx_scale; wa[2 * i + 1] = bfhi(wq[i]) * idx_scale; } }
#pragma unroll
      for (int ks = 0; ks < 2; ++ks) { float cq[8];
#pragma unroll
          for (int j = 0; j < 8; ++j) cq[j] = 0.f;
#pragma unroll
          for (int h = 0; h < 8; ++h)
#pragma unroll
              for (int j = 0; j < 8; ++j) cq[j] += wa[h] * bf2f((unsigned)(unsigned short)Af[h][ks][j]);
          const v4u t = {pk2(cq[0], cq[1]), pk2(cq[2], cq[3]), pk2(cq[4], cq[5]), pk2(cq[6], cq[7])};
          Aw[ks] = __builtin_bit_cast(bf16x8, t); } }
    float wv[4][8];
#pragma unroll
    for (int r = 0; r < 4; ++r) { const v4u wq = *(const v4u*)(IDX + (rowb + q0 + fq * 4 + r) * LD_IDX + 576);
#pragma unroll
        for (int i = 0; i < 4; ++i) { wv[r][2 * i] = bflo(wq[i]) * idx_scale; wv[r][2 * i + 1] = bfhi(wq[i]) * idx_scale; } }
    const int ntiles = (q0 >> 4) + 1;
    __syncthreads();
    bf16x8 B0 = Aw[0], B1 = Aw[1];
    if (w < ntiles) { const bf16* kp = IDX + (rowb + w * 16 + fr) * LD_IDX + 512 + fq * 8; B0 = *(const bf16x8*)kp; B1 = *(const bf16x8*)(kp + 32); }
    for (int kt = w; kt < ntiles; kt += NWAVES) {
        bf16x8 nB0 = B0, nB1 = B1;
        if (kt + NWAVES < ntiles) { const bf16* kp = IDX + (rowb + (kt + NWAVES) * 16 + fr) * LD_IDX + 512 + fq * 8; nB0 = *(const bf16x8*)kp; nB1 = *(const bf16x8*)(kp + 32); }
        __builtin_amdgcn_s_setprio(1);
        pg8::f32x4 lin = {0.f, 0.f, 0.f, 0.f};
        lin = __builtin_amdgcn_mfma_f32_16x16x32_bf16(Aw[0], B0, lin, 0, 0, 0);
        lin = __builtin_amdgcn_mfma_f32_16x16x32_bf16(Aw[1], B1, lin, 0, 0, 0);
        float I[4] = {lin[0], lin[1], lin[2], lin[3]};
#pragma unroll
        for (int h = 0; h < 8; ++h) { pg8::f32x4 a = {0.f, 0.f, 0.f, 0.f};
            a = __builtin_amdgcn_mfma_f32_16x16x32_bf16(Af[h][0], B0, a, 0, 0, 0);
            a = __builtin_amdgcn_mfma_f32_16x16x32_bf16(Af[h][1], B1, a, 0, 0, 0);
#pragma unroll
            for (int r = 0; r < 4; ++r) I[r] = __builtin_fmaf(wv[r][h], __builtin_fabsf(a[r]), I[r]); }
        __builtin_amdgcn_s_setprio(0);
        const int kidx = kt * 16 + fr;
        if (kt + 1 < ntiles) {
#pragma unroll
            for (int r = 0; r < 4; ++r) { const unsigned key = f16key(I[r]); Ik[(fq * 4 + r) * 4096 + kidx] = (unsigned short)key; atomicAdd(&hist1[(fq * 4 + r) * 256 + (key >> 8)], 1u); }
        } else {
#pragma unroll
        for (int r = 0; r < 4; ++r) { const unsigned key = f16key(I[r]); Ik[(fq * 4 + r) * 4096 + kidx] = (unsigned short)key;
            if (kidx <= q0 + fq * 4 + r) atomicAdd(&hist1[(fq * 4 + r) * 256 + (key >> 8)], 1u); } }
        B0 = nB0; B1 = nB1;
    }
    __syncthreads();
    for (int qq = w; qq < 16; qq += NWAVES) {
        const int t = q0 + qq, n = t + 1;
        unsigned short* so = (unsigned short*)(hist1 + qq * 256);
        const unsigned short* keys = Ik + qq * 4096;
        if (n <= TOPK) { for (int j = lane; j < n; j += 64) so[j] = (unsigned short)j; }
        else {
            int b1, rem1, b2, rem2;
            find_bin(hist1 + qq * 256, TOPK, lane, b1, rem1);
            *(v4u*)(hist + 4 * lane) = (v4u){0u, 0u, 0u, 0u};
            LDS_WAIT(); __builtin_amdgcn_wave_barrier();
            for (int j0 = 0; j0 < n; j0 += 512) { unsigned k4[8];
#pragma unroll
                for (int u = 0; u < 8; ++u) { const int j = j0 + u * 64 + lane; k4[u] = keys[j < 4095 ? j : 4095]; }
#pragma unroll
                for (int u = 0; u < 8; ++u) { const int j = j0 + u * 64 + lane; if (j < n && (int)(k4[u] >> 8) == b1) atomicAdd(&hist[k4[u] & 255u], 1u); } }
            LDS_WAIT(); __builtin_amdgcn_wave_barrier();
            find_bin(hist, rem1, lane, b2, rem2);
            const unsigned thr = ((unsigned)b1 << 8) | (unsigned)b2;
            int base = 0, eqtaken = 0;
            for (int j0 = 0; j0 < n; j0 += 512) { unsigned k4[8];
#pragma unroll
                for (int u = 0; u < 8; ++u) { const int j = j0 + u * 64 + lane; k4[u] = keys[j < 4095 ? j : 4095]; }
                unsigned eqm = 0u, gtm = 0u;
#pragma unroll
                for (int u = 0; u < 8; ++u) { const int j = j0 + u * 64 + lane; const bool valid = j < n; if (valid && k4[u] > thr) gtm |= 1u << u; if (valid && k4[u] == thr) eqm |= 1u << u; }
                const unsigned ne = (unsigned)__builtin_popcount(eqm);
                const unsigned sc1 = wave_incl_scan(ne);
                const int eqtot = (int)__builtin_amdgcn_readlane((int)sc1, 63);
                int allow = rem2 - (eqtaken + (int)(sc1 - ne));
                unsigned tm = gtm;
#pragma unroll
                for (int u = 0; u < 8; ++u) { const bool e = (eqm >> u) & 1u; if (e && allow > 0) tm |= 1u << u; allow -= e ? 1 : 0; }
                const unsigned nt = (unsigned)__builtin_popcount(tm);
                const unsigned sc2 = wave_incl_scan(nt);
                const int ttot = (int)__builtin_amdgcn_readlane((int)sc2, 63);
                int pos = base + (int)(sc2 - nt);
#pragma unroll
                for (int u = 0; u < 8; ++u) { if ((tm >> u) & 1u) { so[pos] = (unsigned short)(j0 + u * 64 + lane); ++pos; } }
                base += ttot; eqtaken += eqtot;
            }
        }
    }
    __syncthreads();
}

template <int NB>
__device__ __forceinline__ void qknorm_tokens(const Params& p, const int (&toks)[NB], int lane, const float (&qg)[8], const float (&kg)[8]) {
    v4u qv[NB], kv[NB], vv[NB];
#pragma unroll
    for (int n = 0; n < NB; ++n) { const bf16* row = (const bf16*)(p.ws + WS_ATT) + (size_t)toks[n] * LD_ATT;
        qv[n] = *(const v4u*)(row + lane * 8); kv[n] = *(const v4u*)(row + 512 + (lane & 15) * 8); vv[n] = *(const v4u*)(row + 640 + (lane & 15) * 8); }
#pragma unroll
    for (int n = 0; n < NB; ++n) { const int tok = toks[n];
        { float x[8]; float ss = 0.f;
#pragma unroll
          for (int i = 0; i < 4; ++i) { x[2 * i] = bflo(qv[n][i]); x[2 * i + 1] = bfhi(qv[n][i]); ss += x[2 * i] * x[2 * i] + x[2 * i + 1] * x[2 * i + 1]; }
          ss += __shfl_xor(ss, 1); ss += __shfl_xor(ss, 2); ss += __shfl_xor(ss, 4);
          const float rs = rsqrtf(ss * (1.f / 64.f) + RMS_EPS) * (0.125f * 1.4426950408889634f);
#pragma unroll
          for (int i = 0; i < 8; ++i) x[i] = x[i] * rs * qg[i];
          v2u hw, lw;
          hw.x = pk4_fp8(x[0], x[1], x[2], x[3]); hw.y = pk4_fp8(x[4], x[5], x[6], x[7]);
          { const f32x2 d0 = __builtin_amdgcn_cvt_pk_f32_fp8((int)hw.x, false), d1 = __builtin_amdgcn_cvt_pk_f32_fp8((int)hw.x, true), d2 = __builtin_amdgcn_cvt_pk_f32_fp8((int)hw.y, false), d3 = __builtin_amdgcn_cvt_pk_f32_fp8((int)hw.y, true);
            lw.x = pk4_fp8(x[0] - d0[0], x[1] - d0[1], x[2] - d1[0], x[3] - d1[1]); lw.y = pk4_fp8(x[4] - d2[0], x[5] - d2[1], x[6] - d3[0], x[7] - d3[1]); }
          *(v2u*)(p.ws + WS_QHI + (size_t)tok * 512 + lane * 8) = hw; *(v2u*)(p.ws + WS_QLO + (size_t)tok * 512 + lane * 8) = lw; }
        { float x[8]; float ss = 0.f;
#pragma unroll
          for (int i = 0; i < 4; ++i) { x[2 * i] = bflo(kv[n][i]); x[2 * i + 1] = bfhi(kv[n][i]); ss += x[2 * i] * x[2 * i] + x[2 * i + 1] * x[2 * i + 1]; }
          ss += __shfl_xor(ss, 1); ss += __shfl_xor(ss, 2); ss += __shfl_xor(ss, 4);
          const float rs = rsqrtf(ss * (1.f / 64.f) + RMS_EPS);
#pragma unroll
          for (int i = 0; i < 8; ++i) x[i] = x[i] * rs * kg[i];
          v2u o; o.x = pk4_fp8(x[0], x[1], x[2], x[3]); o.y = pk4_fp8(x[4], x[5], x[6], x[7]);
          if (lane < 16) *(v2u*)(p.ws + WS_K8 + (size_t)tok * 128 + lane * 8) = o; }
        { v2u o; o.x = pk4_fp8(bflo(vv[n][0]), bfhi(vv[n][0]), bflo(vv[n][1]), bfhi(vv[n][1])); o.y = pk4_fp8(bflo(vv[n][2]), bfhi(vv[n][2]), bflo(vv[n][3]), bfhi(vv[n][3]));
          if (lane < 16) *(v2u*)(p.ws + WS_V8 + (size_t)tok * 128 + lane * 8) = o; }
    }
}

typedef short v4i16_t __attribute__((ext_vector_type(4)));
__device__ __forceinline__ v4i16_t vtr16(const bf16* ldsp) { return __builtin_amdgcn_ds_read_tr16_b64_v4i16((LAS v4i16_t*)ldsp); }
typedef int v2i_t __attribute__((ext_vector_type(2)));
__device__ __forceinline__ long vtr8(const unsigned char* ldsp) { const v2i_t r = __builtin_amdgcn_ds_read_tr8_b64_v2i32((LAS v2i_t*)ldsp); return (long)(((unsigned long long)(unsigned)r[1] << 32) | (unsigned)r[0]); }
__device__ __forceinline__ void dsa2_query(const Params& p, unsigned char* ldsw, const unsigned short* sel, int b, int t, int lane) {
    unsigned char* ws = p.ws;
    const bf16* ATT = (const bf16*)(ws + WS_ATT);
    bf16* YB = (bf16*)(ws + WS_H);
    unsigned short* sl = (unsigned short*)ldsw;
    float* df = (float*)(ldsw + 512);
    unsigned char* Vl = ldsw + 1536;
    const unsigned char* V8 = ws + WS_V8;
    const int fr = lane & 15, fq = lane >> 4;
    const size_t rowb = (size_t)b * SEQ;
    const int cnt = (t + 1 < TOPK) ? (t + 1) : TOPK;
    { v2u sv = *(const v2u*)(sel + lane * 4);
      const int j0 = lane * 4;
      if (j0 >= cnt) sv.x = 0u; else if (j0 + 1 >= cnt) sv.x &= 0xffffu;
      if (j0 + 2 >= cnt) sv.y = 0u; else if (j0 + 3 >= cnt) sv.y &= 0xffffu;
      *(v2u*)(sl + lane * 4) = sv;
      f32x4 d4; d4[0] = (j0 < cnt) ? (float)(t - (int)(sv.x & 0xffffu)) : INFINITY; d4[1] = (j0 + 1 < cnt) ? (float)(t - (int)(sv.x >> 16)) : INFINITY;
      d4[2] = (j0 + 2 < cnt) ? (float)(t - (int)(sv.y & 0xffffu)) : INFINITY; d4[3] = (j0 + 3 < cnt) ? (float)(t - (int)(sv.y >> 16)) : INFINITY;
      *(f32x4*)(df + lane * 4) = d4; }
    LDS_WAIT(); __builtin_amdgcn_wave_barrier();
    const unsigned char* K8 = ws + WS_K8;
    long qhA[2] = {0, 0}, qhB[2] = {0, 0}, qlA[2] = {0, 0}, qlB[2] = {0, 0};
    if (fr < 8) { const v4u qh = *(const v4u*)(ws + WS_QHI + (rowb + t) * 512 + fr * 64 + fq * 16), ql = *(const v4u*)(ws + WS_QLO + (rowb + t) * 512 + fr * 64 + fq * 16);
        const long hA = (long)(((unsigned long long)qh.y << 32) | qh.x), hB = (long)(((unsigned long long)qh.w << 32) | qh.z), lA = (long)(((unsigned long long)ql.y << 32) | ql.x), lB = (long)(((unsigned long long)ql.w << 32) | ql.z);
        if (fr < 4) { qhA[0] = hA; qhB[0] = hB; qlA[0] = lA; qlB[0] = lB; } else { qhA[1] = hA; qhB[1] = hB; qlA[1] = lA; qlB[1] = lB; } }
    pg8::f32x4 sc[16];
    v4u vv[8];
    {
        v4u G[8];
        unsigned char* kst = Vl;
        const int ksw = ((lane & 7) ^ (lane >> 3)) & 7;
#define K_LOADS(STEP) do { _Pragma("unroll") for (int j = 0; j < 8; ++j) { const int s_ = sl[(STEP) * 64 + j * 8 + (lane >> 3)]; G[j] = *(const v4u*)(K8 + (unsigned)(((unsigned)(rowb + s_) << 7) | (unsigned)(((ksw ^ (j & 1)) & 7) << 4))); } } while (0)
        K_LOADS(0);
#pragma unroll
        for (int step = 0; step < 4; ++step) {
            LDS_WAIT(); __builtin_amdgcn_wave_barrier();
#pragma unroll
            for (int j = 0; j < 8; ++j) *(v4u*)(kst + j * 1024 + lane * 16) = G[j];
            __builtin_amdgcn_sched_barrier(0);
            if (step < 3) K_LOADS(step + 1);
            else {
#pragma unroll
                for (int j = 0; j < 8; ++j) { const int s = sl[j * 8 + (lane >> 3)]; vv[j] = *(const v4u*)(V8 + (unsigned)(((unsigned)(rowb + s) << 7) | (unsigned)((lane & 7) << 4))); } }
            __builtin_amdgcn_sched_barrier(0);
            LDS_WAIT(); __builtin_amdgcn_wave_barrier();
            __builtin_amdgcn_s_setprio(1);
            { v4u kv[4][2];
#pragma unroll
              for (int kt = 0; kt < 4; ++kt)
#pragma unroll
                  for (int gg = 0; gg < 2; ++gg) kv[kt][gg] = *(const v4u*)(kst + (kt * 16 + fr) * 128 + (((gg * 4 + fq) ^ (fr & 7) ^ (fr >> 3)) & 7) * 16);
              __builtin_amdgcn_sched_barrier(0);
              pg8::f32x4 a4[4];
#pragma unroll
              for (int kt = 0; kt < 4; ++kt) a4[kt] = (pg8::f32x4){0.f, 0.f, 0.f, 0.f};
#pragma unroll
              for (int gg = 0; gg < 2; ++gg) {
#pragma unroll
                  for (int kt = 0; kt < 4; ++kt) { const long kA = (long)(((unsigned long long)kv[kt][gg].y << 32) | kv[kt][gg].x);
                      a4[kt] = __builtin_amdgcn_mfma_f32_16x16x32_fp8_fp8(kA, qhA[gg], a4[kt], 0, 0, 0); }
#pragma unroll
                  for (int kt = 0; kt < 4; ++kt) { const long kB = (long)(((unsigned long long)kv[kt][gg].w << 32) | kv[kt][gg].z);
                      a4[kt] = __builtin_amdgcn_mfma_f32_16x16x32_fp8_fp8(kB, qhB[gg], a4[kt], 0, 0, 0); }
#pragma unroll
                  for (int kt = 0; kt < 4; ++kt) { const long kA = (long)(((unsigned long long)kv[kt][gg].y << 32) | kv[kt][gg].x);
                      a4[kt] = __builtin_amdgcn_mfma_f32_16x16x32_fp8_fp8(kA, qlA[gg], a4[kt], 0, 0, 0); }
#pragma unroll
                  for (int kt = 0; kt < 4; ++kt) { const long kB = (long)(((unsigned long long)kv[kt][gg].w << 32) | kv[kt][gg].z);
                      a4[kt] = __builtin_amdgcn_mfma_f32_16x16x32_fp8_fp8(kB, qlB[gg], a4[kt], 0, 0, 0); } }
#pragma unroll
              for (int kt = 0; kt < 4; ++kt) sc[step * 4 + kt] = a4[kt]; }
            __builtin_amdgcn_s_setprio(0);
        }
#undef K_LOADS
    }
    const float slope = exp2f(-(float)((fr & 7) + 1)) * 1.4426950408889634f;
    float m = -INFINITY;
#pragma unroll
    for (int kt = 0; kt < 16; ++kt) { const f32x4 d4 = *(const f32x4*)(df + kt * 16 + fq * 4);
#pragma unroll
        for (int r = 0; r < 4; ++r) { const float x = sc[kt][r] - slope * d4[r]; sc[kt][r] = x; m = fmaxf(m, x); } }
    m = fmaxf(m, __shfl_xor(m, 16)); m = fmaxf(m, __shfl_xor(m, 32));
    float l = 0.f;
#pragma unroll
    for (int kt = 0; kt < 16; ++kt)
#pragma unroll
        for (int r = 0; r < 4; ++r) { const float e = __builtin_amdgcn_exp2f(sc[kt][r] - m); sc[kt][r] = e; l += e; }
    l += __shfl_xor(l, 16); l += __shfl_xor(l, 32);
    const float inv = 1.f / l;
    pg8::f32x4 o[2][4];
#pragma unroll
    for (int g2 = 0; g2 < 2; ++g2)
#pragma unroll
        for (int dt = 0; dt < 4; ++dt) o[g2][dt] = (pg8::f32x4){0.f, 0.f, 0.f, 0.f};
    unsigned char* vdst = Vl + ((lane & 7) >> 2) * 6400 + (lane >> 3) * 80 + (lane & 3) * 16;
#pragma unroll
    for (int ch = 0; ch < 4; ++ch) {
        LDS_WAIT(); __builtin_amdgcn_wave_barrier();
#pragma unroll
        for (int j = 0; j < 8; ++j) *(v4u*)(vdst + ((j >> 2) * 40 + ((j >> 1) & 1) * 24 + (j & 1) * 8) * 80) = vv[j];
        if (ch < 3) {
#pragma unroll
            for (int j = 0; j < 8; ++j) { const int s = sl[(ch + 1) * 64 + j * 8 + (lane >> 3)]; vv[j] = *(const v4u*)(V8 + (unsigned)(((unsigned)(rowb + s) << 7) | (unsigned)((lane & 7) << 4))); } }
        LDS_WAIT(); __builtin_amdgcn_wave_barrier();
        __builtin_amdgcn_s_setprio(1);
        { long va[2][2][4];
#pragma unroll
          for (int k2 = 0; k2 < 2; ++k2) { const int q = fr >> 1, prow = k2 * 40 + ((q < 4) ? (fq * 4 + q) : (24 + fq * 4 + (q - 4)));
#pragma unroll
              for (int g2 = 0; g2 < 2; ++g2)
#pragma unroll
                  for (int dt = 0; dt < 4; ++dt) va[k2][g2][dt] = vtr8(Vl + g2 * 6400 + prow * 80 + dt * 16 + (fr & 1) * 8); }
          __builtin_amdgcn_sched_barrier(0);
#pragma unroll
          for (int k2 = 0; k2 < 2; ++k2) { const int kt0 = ch * 4 + 2 * k2;
              const long pb = (long)(((unsigned long long)pk4_fp8(sc[kt0 + 1][0], sc[kt0 + 1][1], sc[kt0 + 1][2], sc[kt0 + 1][3]) << 32) | pk4_fp8(sc[kt0][0], sc[kt0][1], sc[kt0][2], sc[kt0][3]));
#pragma unroll
              for (int g2 = 0; g2 < 2; ++g2)
#pragma unroll
                  for (int dt = 0; dt < 4; ++dt) o[g2][dt] = __builtin_amdgcn_mfma_f32_16x16x32_fp8_fp8(va[k2][g2][dt], pb, o[g2][dt], 0, 0, 0); } }
        __builtin_amdgcn_s_setprio(0);
    }
    { const float i8 = inv * 8.f; unsigned char* yp = (unsigned char*)YB + (rowb + t) * 1024 + 512 + fr * 64 + fq * 4;
      if (fr < 4) {
#pragma unroll
          for (int dt = 0; dt < 4; ++dt) *(unsigned*)(yp + dt * 16) = pk4_fp8(o[0][dt][0] * i8, o[0][dt][1] * i8, o[0][dt][2] * i8, o[0][dt][3] * i8); }
      else if (fr < 8) {
#pragma unroll
          for (int dt = 0; dt < 4; ++dt) *(unsigned*)(yp + dt * 16) = pk4_fp8(o[1][dt][0] * i8, o[1][dt][1] * i8, o[1][dt][2] * i8, o[1][dt][3] * i8); } }
    LDS_WAIT(); __builtin_amdgcn_wave_barrier();
}

#define INS16(L, x) do { _Pragma("unroll") for (int _i = 15; _i >= 1; --_i) L[_i] = __builtin_amdgcn_fmed3f(L[_i - 1], L[_i], (x)); L[0] = fmaxf(L[0], (x)); } while (0)
__device__ __forceinline__ float f_andor(float v, unsigned keepmask, unsigned orv) { return __builtin_bit_cast(float, (__builtin_bit_cast(unsigned, v) & keepmask) | orv); }
#define CE_D(a, b) do { const float _x = fmaxf(a, b), _y = fminf(a, b); a = _x; b = _y; } while (0)
#define CE_A(a, b) do { const float _x = fminf(a, b), _y = fmaxf(a, b); a = _x; b = _y; } while (0)
__device__ __forceinline__ void bitonic_merge16_desc(float (&x)[16]) {
#pragma unroll
    for (int s_ = 8; s_ >= 1; s_ >>= 1)
#pragma unroll
        for (int i = 0; i < 16; ++i) if ((i & s_) == 0) CE_D(x[i], x[i + s_]);
}
__device__ __forceinline__ void bitonic_sort16_desc(float (&x)[16]) {
#pragma unroll
    for (int k = 2; k <= 16; k <<= 1)
#pragma unroll
        for (int j = k >> 1; j >= 1; j >>= 1)
#pragma unroll
            for (int i = 0; i < 16; ++i) { const int l = i ^ j; if (l > i) { if ((i & k) == 0) CE_D(x[i], x[l]); else CE_A(x[i], x[l]); } }
}
__device__ __forceinline__ void top16_merge(float (&A)[16], const float (&B)[16]) {
#pragma unroll
    for (int i = 0; i < 16; ++i) A[i] = fmaxf(A[i], B[15 - i]);
    bitonic_merge16_desc(A);
}
__host__ __device__ constexpr int peer_pair(int n) { int c = 0; for (int a = 0; a < 16; ++a) for (int b = 0; b < 16; ++b) if ((a + 1) * (b + 1) <= 16) { if (c == n) return a * 16 + b; ++c; } return -1; }
template <int K> struct PeerPairs { static constexpr int p0 = peer_pair(4 * K), p1 = peer_pair(4 * K + 1), p2 = peer_pair(4 * K + 2), p3 = peer_pair(4 * K + 3); };
__device__ __forceinline__ void peer_select(const Params& p, unsigned char* ldsw, int tg, int h, int lane, int* EIDX, float* GATES) {
    float* sc = (float*)ldsw;
    LDS_WAIT(); __builtin_amdgcn_wave_barrier();
    float L[16];
    { const float* sp = sc + (lane & 31) * 132 + (lane >> 5) * 64;
#pragma unroll
      for (int i = 0; i < 4; ++i) { const f32x4 x = *(const f32x4*)(sp + 4 * i); L[4 * i] = x[0]; L[4 * i + 1] = x[1]; L[4 * i + 2] = x[2]; L[4 * i + 3] = x[3]; }
      bitonic_sort16_desc(L);
#pragma unroll 1
      for (int g = 1; g < 4; ++g) { float S[16];
#pragma unroll
          for (int i = 0; i < 4; ++i) { const f32x4 x = *(const f32x4*)(sp + 16 * g + 4 * i); S[4 * i] = x[0]; S[4 * i + 1] = x[1]; S[4 * i + 2] = x[2]; S[4 * i + 3] = x[3]; }
          bitonic_sort16_desc(S);
          top16_merge(L, S); } }
    { float O[16];
#pragma unroll
      for (int i = 0; i < 16; ++i) O[i] = __shfl_xor(L[i], 32);
      top16_merge(L, O); }
    LDS_WAIT(); __builtin_amdgcn_wave_barrier();
    float* lst = sc;
    if (lane < 32) {
#pragma unroll
        for (int i = 0; i < 4; ++i) *(f32x4*)(lst + lane * 16 + 4 * i) = (f32x4){L[4 * i], L[4 * i + 1], L[4 * i + 2], L[4 * i + 3]}; }
    LDS_WAIT(); __builtin_amdgcn_wave_barrier();
    const int tok = lane & 15;
    const int q = lane >> 4;
    float M[16];
#define PEER_CAND(K) do { const int ab_ = q == 0 ? PeerPairs<K>::p0 : q == 1 ? PeerPairs<K>::p1 : q == 2 ? PeerPairs<K>::p2 : PeerPairs<K>::p3; const int abv_ = ab_ < 0 ? 0 : ab_; \
        const float v1_ = f_andor(lst[tok * 16 + (abv_ >> 4)], ~127u, 0u), v2_ = f_andor(lst[(16 + tok) * 16 + (abv_ & 15)], ~127u, 0u); \
        M[K] = ab_ < 0 ? -INFINITY : f_andor(v1_ + v2_, ~255u, (unsigned)abv_); } while (0)
    PEER_CAND(0); PEER_CAND(1); PEER_CAND(2); PEER_CAND(3); PEER_CAND(4); PEER_CAND(5); PEER_CAND(6); PEER_CAND(7); PEER_CAND(8); PEER_CAND(9); PEER_CAND(10); PEER_CAND(11); PEER_CAND(12);
#undef PEER_CAND
    M[13] = -INFINITY; M[14] = -INFINITY; M[15] = -INFINITY;
    bitonic_sort16_desc(M);
    { float O[16];
#pragma unroll
      for (int i = 0; i < 16; ++i) O[i] = __shfl_xor(M[i], 16);
      top16_merge(M, O);
#pragma unroll
      for (int i = 0; i < 16; ++i) O[i] = __shfl_xor(M[i], 32);
      top16_merge(M, O); }
    const float mx = f_andor(M[0], ~255u, 0u);
    float e[16], sum = 0.f; int ei[16];
    const unsigned* lb = (const unsigned*)lst;
#pragma unroll
    for (int i = 0; i < 16; ++i) { const unsigned bits = __builtin_bit_cast(unsigned, M[i]); const int flat = bits & 255u;
        e[i] = __expf(f_andor(M[i], ~255u, 0u) - mx); sum += e[i];
        ei[i] = (int)(lb[tok * 16 + (flat >> 4)] & 127u) * 128 + (int)(lb[(16 + tok) * 16 + (flat & 15)] & 127u); }
    const float inv = 1.f / sum;
    if (lane < 16) {
        const size_t ob = ((size_t)tok * 8 + h) * 16;
#pragma unroll
        for (int i = 0; i < 4; ++i) { *(v4u*)(EIDX + ob + 4 * i) = (v4u){(unsigned)ei[4 * i], (unsigned)ei[4 * i + 1], (unsigned)ei[4 * i + 2], (unsigned)ei[4 * i + 3]};
            *(f32x4*)(GATES + ob + 4 * i) = (f32x4){e[4 * i] * inv, e[4 * i + 1] * inv, e[4 * i + 2] * inv, e[4 * i + 3] * inv}; }
    }
    LDS_WAIT(); __builtin_amdgcn_wave_barrier();
}

__device__ __forceinline__ void peer_route_block(const Params& p, unsigned char* lds, int* eG, float* gG) {
    const int tid = threadIdx.x, wave = tid >> 6, lane = tid & 63, fr = lane & 15, fq = lane >> 4, G = gridDim.x;
    unsigned char* ws = p.ws;
    const bf16* Q = (const bf16*)(ws + WS_Q);
    const unsigned char* SKb = ws + WS_SK;
    unsigned char* tile = lds + 8 * 16896;
    float* sc = (float*)(lds + wave * 16896);
    int ngrp = 0;
    for (int tg = blockIdx.x; tg < T / 16; tg += G) ++ngrp;
#pragma unroll 1
    for (int k0 = 0; k0 < ngrp; k0 += 8) {
        const bool valid = k0 + wave < ngrp;
        const int tg = (int)blockIdx.x + (valid ? k0 + wave : k0) * G;
        v4u t[4][2];
        bf16x8 An[2][4];
#pragma unroll
        for (int sub = 0; sub < 4; ++sub) { const unsigned char* sp = SKb + (size_t)sub * 16384 + tid * 32; t[sub][0] = *(const v4u*)sp; t[sub][1] = *(const v4u*)(sp + 16); }
#pragma unroll
        for (int pp = 0; pp < 2; ++pp) { const bf16* rp = Q + (size_t)(tg * 16 + fr) * 2048 + pp * 128 + fq * 8;
#pragma unroll
            for (int ks = 0; ks < 4; ++ks) An[pp][ks] = *(const bf16x8*)(rp + ks * 32); }
#pragma unroll 1
        for (int h = 0; h < 8; ++h) {
            bf16x8 Af[2][4];
#pragma unroll
            for (int pp = 0; pp < 2; ++pp)
#pragma unroll
                for (int ks = 0; ks < 4; ++ks) Af[pp][ks] = An[pp][ks];
            const int hn = (h + 1) & 7;
#pragma unroll
            for (int sub = 0; sub < 4; ++sub) {
                const int pp = sub >> 1, half = sub & 1;
                __syncthreads();
                { unsigned char* wp = tile + (tid >> 3) * 272 + (tid & 7) * 32; *(v4u*)wp = t[sub][0]; *(v4u*)(wp + 16) = t[sub][1]; }
                { const unsigned char* sp = SKb + (size_t)(hn * 4 + sub) * 16384 + tid * 32; t[sub][0] = *(const v4u*)sp; t[sub][1] = *(const v4u*)(sp + 16); }
                __syncthreads();
                {
                    bf16x8 bv[4][4];
#pragma unroll
                    for (int kt = 0; kt < 4; ++kt)
#pragma unroll
                        for (int ks = 0; ks < 4; ++ks) bv[kt][ks] = *(const bf16x8*)(tile + (kt * 16 + fr) * 272 + ks * 64 + fq * 16);
                    __builtin_amdgcn_sched_barrier(0);
                    pg8::f32x4 a4[4];
#pragma unroll
                    for (int kt = 0; kt < 4; ++kt) a4[kt] = (pg8::f32x4){0.f, 0.f, 0.f, 0.f};
#pragma unroll
                    for (int ks = 0; ks < 4; ++ks)
#pragma unroll
                        for (int kt = 0; kt < 4; ++kt) a4[kt] = __builtin_amdgcn_mfma_f32_16x16x32_bf16(Af[pp][ks], bv[kt][ks], a4[kt], 0, 0, 0);
#pragma unroll
                    for (int kt = 0; kt < 4; ++kt) { const int kg = (half * 4 + kt) * 16 + fr;
#pragma unroll
                        for (int r = 0; r < 4; ++r) sc[(pp * 16 + fq * 4 + r) * 132 + kg] = f_andor(a4[kt][r], ~127u, (unsigned)kg); }
                }
            }
#pragma unroll
            for (int pp = 0; pp < 2; ++pp) { const bf16* rp = Q + (size_t)(tg * 16 + fr) * 2048 + hn * 256 + pp * 128 + fq * 8;
#pragma unroll
                for (int ks = 0; ks < 4; ++ks) An[pp][ks] = *(const bf16x8*)(rp + ks * 32); }
            if (valid) peer_select(p, (unsigned char*)sc, tg, h, lane, eG + (size_t)tg * 2048, gG + (size_t)tg * 2048);
        }
    }
}

__device__ __forceinline__ float gelu_erf(float x) { return 0.5f * x * (1.f + erff(x * 0.70710678118654752f)); }
typedef int v8i_t __attribute__((ext_vector_type(8)));
template <int OPSEL> __device__ __forceinline__ pg8::f32x4 mx_dot(v8i_t a, int sa, v8i_t b, int sb, pg8::f32x4 c) {
    return __builtin_amdgcn_mfma_scale_f32_16x16x128_f8f6f4(a, b, c, 4  , 4  , OPSEL, sa, OPSEL, sb);
}
template <int MODE>
__device__ __forceinline__ void peer_token(const Params& p, unsigned char* ldsw, const _Float16* usL, const _Float16* vsL, unsigned char* tile, int tok, int lane, const v2u nxt_e, const v2u nxt_g, int buf) {
    unsigned char* ws = p.ws;
    const unsigned char* V8 = ws + WS_V;
    const float* MOD = (const float*)(ws + WS_MOD);
    const int fr = lane & 15, fq = lane >> 4;
    typedef v8i_t v8i;
    const int* EIDX = (const int*)(ldsw + buf * 1024); const float* GATES = (const float*)(ldsw + buf * 1024 + 512);
    int* pe = (int*)(ldsw + buf * 1024); float* pa = (float*)(ldsw + buf * 1024 + 512);
    if (MODE == 1) {
    float* gGp = (float*)(ws + WS_PGATE) + (size_t)tok * 128;
    v4u A4[H4_NT][8]; v2u As[H4_NT];
#pragma unroll
    for (int t = 0; t < H4_NT; ++t) { const unsigned char* hp = ws + WS_H4D + ((size_t)tok * H4_NT + t) * 512 + fq * 16;
        As[t] = *(const v2u*)(ws + WS_H4S + ((size_t)tok * H4_NT + t) * 32 + fq * 8);
#pragma unroll
        for (int kk = 0; kk < 8; ++kk) A4[t][kk] = *(const v4u*)(hp + kk * 64); }
    const unsigned char* U4 = ws + WS_U;
    const int gr = lane >> 3, gs = lane & 7;
    const int rdbase = (fr >> 3) * 1024 + (fr & 7) * 128, slotA = (fq ^ (fr & 7) ^ (fr >> 3)) & 7;
    v4u G[8];
#define U_LOADS(CT) do { const int e0_ = EIDX[(CT) * 16 + gr], e1_ = EIDX[(CT) * 16 + 8 + gr]; \
        const unsigned char* p0_ = U4 + (size_t)e0_ * 512 + ((gs ^ gr) & 7) * 16; const unsigned char* p1_ = U4 + (size_t)e1_ * 512 + ((gs ^ gr ^ 1) & 7) * 16; \
        _Pragma("unroll") for (int kk = 0; kk < 8; ++kk) G[kk] = *(const v4u*)(((kk & 1) ? p1_ : p0_) + (kk >> 1) * 128); } while (0)
    U_LOADS(0);
#pragma unroll 1
    for (int ct = 0; ct < 8; ++ct) {
        const int eic = EIDX[ct * 16 + fr]; const float gt = GATES[ct * 16 + fr];
#pragma unroll
        for (int kk = 0; kk < 8; ++kk) *(v4u*)(tile + kk * 1024 + lane * 16) = G[kk];
        __builtin_amdgcn_sched_barrier(0);
        U_LOADS((ct + 1) & 7);
        __builtin_amdgcn_sched_barrier(0);
        LDS_WAIT(); __builtin_amdgcn_wave_barrier();
        v4u Bt[8];
#pragma unroll
        for (int j = 0; j < 8; ++j) Bt[j] = *(const v4u*)(tile + (j >> 1) * 2048 + rdbase + (((j & 1) ? (slotA ^ 4) : slotA) * 16));
        LDS_WAIT(); __builtin_amdgcn_wave_barrier();
        pg8::f32x4 ah = {0.f, 0.f, 0.f, 0.f};
#pragma unroll
        for (int kk = 0; kk < 8; ++kk) { const v4u bu = Bt[kk];
            const v8i bb = {(int)bu.x, (int)bu.y, (int)bu.z, (int)bu.w, 0, 0, 0, 0};
            const int sb = 0x7f7f7f7f;
#pragma unroll
            for (int t = 0; t < H4_NT; ++t) { const v8i aa = {(int)A4[t][kk].x, (int)A4[t][kk].y, (int)A4[t][kk].z, (int)A4[t][kk].w, 0, 0, 0, 0}; const int sa = (int)((kk < 4) ? As[t].x : As[t].y);
                if ((kk & 3) == 0) ah = mx_dot<0>(aa, sa, bb, sb, ah); else if ((kk & 3) == 1) ah = mx_dot<1>(aa, sa, bb, sb, ah); else if ((kk & 3) == 2) ah = mx_dot<2>(aa, sa, bb, sb, ah); else ah = mx_dot<3>(aa, sa, bb, sb, ah); } }
        const float dot = ah[0] * (float)usL[eic];
        if (fq == 0) gGp[ct * 16 + fr] = gelu_erf(dot) * gt * (float)vsL[eic];
    }
    asm volatile("" :: "v"(G[0]), "v"(G[1]), "v"(G[2]), "v"(G[3]), "v"(G[4]), "v"(G[5]), "v"(G[6]), "v"(G[7]));
#undef U_LOADS
    }
    __builtin_amdgcn_sched_barrier(0);
    { int* ne = (int*)(ldsw + (buf ^ 1) * 1024); float* ng = (float*)(ldsw + (buf ^ 1) * 1024 + 512);
      *(v2u*)(ne + 2 * lane) = nxt_e; *(v2u*)(ng + 2 * lane) = nxt_g; }
    if (MODE == 1) { LDS_WAIT(); __builtin_amdgcn_wave_barrier(); return; }
    const int hl = lane >> 5, bl = lane & 31;
    float acc[32];
#pragma unroll
    for (int i = 0; i < 32; ++i) acc[i] = 0.f;
    LDS_WAIT(); __builtin_amdgcn_wave_barrier();
#pragma unroll 1
    for (int ct = 0; ct < 16; ++ct)
#pragma unroll
        for (int jp = 0; jp < 4; ++jp) {
            const int idx = pe[ct * 8 + 2 * jp + hl]; const float as = pa[ct * 8 + 2 * jp + hl];
            const v4u vv = *(const v4u*)(V8 + (size_t)idx * 512 + bl * 16);
#pragma unroll
            for (int w4 = 0; w4 < 4; ++w4) { const unsigned wd = vv[w4];
                const f32x2 d0 = __builtin_amdgcn_cvt_scalef32_pk_f32_fp4(wd, 1.0f, 0), d1 = __builtin_amdgcn_cvt_scalef32_pk_f32_fp4(wd, 1.0f, 1), d2 = __builtin_amdgcn_cvt_scalef32_pk_f32_fp4(wd, 1.0f, 2), d3 = __builtin_amdgcn_cvt_scalef32_pk_f32_fp4(wd, 1.0f, 3);
                acc[8 * w4] += as * d0[0]; acc[8 * w4 + 1] += as * d0[1]; acc[8 * w4 + 2] += as * d1[0]; acc[8 * w4 + 3] += as * d1[1];
                acc[8 * w4 + 4] += as * d2[0]; acc[8 * w4 + 5] += as * d2[1]; acc[8 * w4 + 6] += as * d3[0]; acc[8 * w4 + 7] += as * d3[1]; }
        }
    LDS_WAIT(); __builtin_amdgcn_wave_barrier();
    float accs[16];
#pragma unroll
    for (int i = 0; i < 16; ++i) { const float lo = acc[i] + __shfl_xor(acc[i], 32), hi2 = acc[16 + i] + __shfl_xor(acc[16 + i], 32); accs[i] = hl ? hi2 : lo; }
    const int b = tok / SEQ;
    const int col0 = bl * 32 + hl * 16;
    const float* g2 = MOD + (size_t)b * 6144 + 5 * 1024 + col0;
    float* orow = p.out + (size_t)tok * DM + col0;
#pragma unroll
    for (int q4 = 0; q4 < 4; ++q4) { const f32x4 xv = *(const f32x4*)(orow + 4 * q4), gv = *(const f32x4*)(g2 + 4 * q4);
        f32x4 o;
#pragma unroll
        for (int i = 0; i < 4; ++i) o[i] = xv[i] + gv[i] * accs[4 * q4 + i];
        *(f32x4*)(orow + 4 * q4) = o; }
}

template <class TokOf, class LdLists>
__device__ __forceinline__ void peer_u_sweep(const Params& p, unsigned char* ldsw, const _Float16* usL, const _Float16* vsL, unsigned char* tile, int ntok, int lane, const TokOf& tok_of, const LdLists& ld_lists) {
    unsigned char* ws = p.ws;
    const unsigned char* U4 = ws + WS_U;
    const int fr = lane & 15, fq = lane >> 4, gr = lane >> 3, gs = lane & 7;
    const int rdbase = (fr >> 3) * 1024 + (fr & 7) * 128, slotA = (fq ^ (fr & 7) ^ (fr >> 3)) & 7;
    typedef v8i_t v8i;
    float* pd = (float*)(ldsw + 2048);
    v4u Hc[8], Hn[8]; v2u Hsc, Hsn; v4u G[8];
#define PU_H2(HH, HS, TOK) do { const int t_ = fr & 1; const unsigned char* hp_ = ws + WS_H4D + ((size_t)(TOK) * H4_NT + t_) * 512 + fq * 16; HS = *(const v2u*)(ws + WS_H4S + ((size_t)(TOK) * H4_NT + t_) * 32 + fq * 8); \
        _Pragma("unroll") for (int kk = 0; kk < 8; ++kk) HH[kk] = *(const v4u*)(hp_ + kk * 64); } while (0)
#define PU_LOADS(JB, CT) do { const int* el_ = (const int*)(ldsw + ((JB) & 1) * 1024); const int e0_ = el_[(CT) * 16 + gr], e1_ = el_[(CT) * 16 + 8 + gr]; \
        const unsigned char* p0_ = U4 + (size_t)e0_ * 512 + ((gs ^ gr) & 7) * 16; const unsigned char* p1_ = U4 + (size_t)e1_ * 512 + ((gs ^ gr ^ 1) & 7) * 16; \
        _Pragma("unroll") for (int kk = 0; kk < 8; ++kk) G[kk] = *(const v4u*)(((kk & 1) ? p1_ : p0_) + (kk >> 1) * 128); } while (0)
#define PU_TILE(CT, NJB, NCT) do { const int eic_ = ((const int*)(ldsw + (j & 1) * 1024))[(CT) * 16 + fr]; \
        _Pragma("unroll") for (int kk = 0; kk < 8; ++kk) *(v4u*)(tile + kk * 1024 + lane * 16) = G[kk]; \
        __builtin_amdgcn_sched_barrier(0); \
        PU_LOADS(NJB, NCT); \
        __builtin_amdgcn_sched_barrier(0); \
        LDS_WAIT(); __builtin_amdgcn_wave_barrier(); \
        v4u Bt_[8]; \
        _Pragma("unroll") for (int q_ = 0; q_ < 8; ++q_) Bt_[q_] = *(const v4u*)(tile + (q_ >> 1) * 2048 + rdbase + (((q_ & 1) ? (slotA ^ 4) : slotA) * 16)); \
        LDS_WAIT(); __builtin_amdgcn_wave_barrier(); \
        __builtin_amdgcn_s_setprio(1); \
        pg8::f32x4 ah_ = {0.f, 0.f, 0.f, 0.f}; \
        _Pragma("unroll") for (int kk = 0; kk < 8; ++kk) { const v8i ua_ = {(int)Bt_[kk].x, (int)Bt_[kk].y, (int)Bt_[kk].z, (int)Bt_[kk].w, 0, 0, 0, 0}; \
            const v8i hb_ = {(int)Hc[kk].x, (int)Hc[kk].y, (int)Hc[kk].z, (int)Hc[kk].w, 0, 0, 0, 0}; const int sh_ = (int)((kk < 4) ? Hsc.x : Hsc.y); \
            if ((kk & 3) == 0) ah_ = mx_dot<0>(ua_, 0x7f7f7f7f, hb_, sh_, ah_); else if ((kk & 3) == 1) ah_ = mx_dot<1>(ua_, 0x7f7f7f7f, hb_, sh_, ah_); \
            else if ((kk & 3) == 2) ah_ = mx_dot<2>(ua_, 0x7f7f7f7f, hb_, sh_, ah_); else ah_ = mx_dot<3>(ua_, 0x7f7f7f7f, hb_, sh_, ah_); } \
        __builtin_amdgcn_s_setprio(0); \
        const int rs_ = fr >> 2; float val_ = rs_ == 0 ? ah_[0] : rs_ == 1 ? ah_[1] : rs_ == 2 ? ah_[2] : ah_[3]; \
        val_ += __shfl_xor(val_, 1); \
        const float d_ = __shfl(val_, (fr >> 2) * 16 + (fr & 3) * 4); \
        if (fq == 0) pd[(CT) * 16 + fr] = d_ * (float)usL[eic_]; } while (0)
    if (ntok <= 0) return;
    PU_H2(Hc, Hsc, tok_of(0));
    PU_LOADS(0, 0);
#pragma unroll 1
    for (int j = 0; j < ntok; ++j) {
        const int jn = j + 1 < ntok ? j + 1 : j;
        v2u ne, ng;
        ld_lists(tok_of(jn), ne, ng);
        PU_H2(Hn, Hsn, tok_of(jn));
        PU_TILE(0, j, 1); PU_TILE(1, j, 2); PU_TILE(2, j, 3); PU_TILE(3, j, 4);
        if (j + 1 < ntok) { int* nep = (int*)(ldsw + ((j + 1) & 1) * 1024); float* ngp = (float*)(ldsw + ((j + 1) & 1) * 1024 + 512); *(v2u*)(nep + 2 * lane) = ne; *(v2u*)(ngp + 2 * lane) = ng; }
        LDS_WAIT(); __builtin_amdgcn_wave_barrier();
        PU_TILE(4, j, 5); PU_TILE(5, j, 6); PU_TILE(6, j, 7);
        PU_TILE(7, jn, 0);
        LDS_WAIT(); __builtin_amdgcn_wave_barrier();
        { const int* EIDX = (const int*)(ldsw + (j & 1) * 1024); const float* GATES = (const float*)(ldsw + (j & 1) * 1024 + 512);
          float* gGp = (float*)(ws + WS_PGATE) + (size_t)tok_of(j) * 128;
          v2u av; const int e0_ = 2 * lane, e1_ = 2 * lane + 1;
          av.x = __builtin_bit_cast(unsigned, gelu_erf(pd[e0_]) * GATES[e0_] * (float)vsL[EIDX[e0_]]); av.y = __builtin_bit_cast(unsigned, gelu_erf(pd[e1_]) * GATES[e1_] * (float)vsL[EIDX[e1_]]);
          *(v2u*)((unsigned*)gGp + 2 * lane) = av; }
#pragma unroll
        for (int kk = 0; kk < 8; ++kk) Hc[kk] = Hn[kk];
        Hsc = Hsn;
        LDS_WAIT(); __builtin_amdgcn_wave_barrier();
    }
    asm volatile("" :: "v"(G[0]), "v"(G[7]));
#undef PU_H2
#undef PU_LOADS
#undef PU_TILE
}

template <class TokOf, class LdLists>
__device__ __forceinline__ void peer_v_sweep(const Params& p, unsigned char* ldsw, int ntok, int lane, const TokOf& tok_of, const LdLists& ld_lists) {
    unsigned char* ws = p.ws;
    const unsigned char* V8 = ws + WS_V;
    const float* MOD = (const float*)(ws + WS_MOD);
    const int hl = lane >> 5, bl = lane & 31;
    const int nstep = ntok * 16;
    v4u b0[4], b1[4], b2[4], b3[4]; float c0[4], c1[4], c2[4], c3[4];
#define PV_ISSUE(BB, CC, S_) do { const int sx_ = (S_) < nstep ? (S_) : 0; const unsigned char* lb_ = ldsw + ((sx_ >> 4) & 1) * 1024; const int o_ = (sx_ & 15) * 8 + hl; \
        _Pragma("unroll") for (int jp = 0; jp < 4; ++jp) { const int idx_ = ((const int*)lb_)[o_ + 2 * jp]; CC[jp] = ((const float*)(lb_ + 512))[o_ + 2 * jp]; BB[jp] = *(const v4u*)(V8 + (unsigned)(((unsigned)idx_ << 9) | ((unsigned)bl << 4))); } } while (0)
#define PV_PIN() do { asm volatile("" : "+v"(acc2[0]), "+v"(acc2[1]), "+v"(acc2[2]), "+v"(acc2[3]), "+v"(acc2[4]), "+v"(acc2[5]), "+v"(acc2[6]), "+v"(acc2[7]), "+v"(acc2[8]), "+v"(acc2[9]), "+v"(acc2[10]), "+v"(acc2[11]), "+v"(acc2[12]), "+v"(acc2[13]), "+v"(acc2[14]), "+v"(acc2[15])); } while (0)
#define PV_FMA(BB, CC) do { _Pragma("unroll") for (int jp = 0; jp < 4; ++jp) { v4u w_ = BB[jp]; float as_ = CC[jp]; asm volatile("" : "+v"(w_.x), "+v"(w_.y), "+v"(w_.z), "+v"(w_.w), "+v"(as_)); const f32x2 as2_ = {as_, as_}; \
        _Pragma("unroll") for (int w4 = 0; w4 < 4; ++w4) { const unsigned wd = w_[w4]; \
            const f32x2 d0 = __builtin_amdgcn_cvt_scalef32_pk_f32_fp4(wd, 1.0f, 0), d1 = __builtin_amdgcn_cvt_scalef32_pk_f32_fp4(wd, 1.0f, 1), d2 = __builtin_amdgcn_cvt_scalef32_pk_f32_fp4(wd, 1.0f, 2), d3 = __builtin_amdgcn_cvt_scalef32_pk_f32_fp4(wd, 1.0f, 3); \
            acc2[4 * w4] += as2_ * d0; acc2[4 * w4 + 1] += as2_ * d1; acc2[4 * w4 + 2] += as2_ * d2; acc2[4 * w4 + 3] += as2_ * d3; } \
        PV_PIN(); } } while (0)
    PV_ISSUE(b0, c0, 0); PV_ISSUE(b1, c1, 1); PV_ISSUE(b2, c2, 2);
#define PV_BLOCK(CT) do { PV_ISSUE(b3, c3, sb + (CT) + 3); PV_FMA(b0, c0); PV_ISSUE(b0, c0, sb + (CT) + 4); PV_FMA(b1, c1); PV_ISSUE(b1, c1, sb + (CT) + 5); PV_FMA(b2, c2); PV_ISSUE(b2, c2, sb + (CT) + 6); PV_FMA(b3, c3); } while (0)
#pragma unroll 1
    for (int j = 0; j < ntok; ++j) {
        v2u ne, ng;
        ld_lists(tok_of(j + 1 < ntok ? j + 1 : j), ne, ng);
        f32x2 acc2[16];
#pragma unroll
        for (int i = 0; i < 16; ++i) acc2[i] = (f32x2){0.f, 0.f};
        const int sb = j * 16;
        PV_BLOCK(0);
        PV_BLOCK(4);
        { int* nep = (int*)(ldsw + ((j + 1) & 1) * 1024); float* ngp = (float*)(ldsw + ((j + 1) & 1) * 1024 + 512); *(v2u*)(nep + 2 * lane) = ne; *(v2u*)(ngp + 2 * lane) = ng; }
        LDS_WAIT(); __builtin_amdgcn_wave_barrier();
        PV_BLOCK(8);
        const int tok = tok_of(j);
        const int b = tok / SEQ;
        const int col0 = bl * 32 + hl * 16;
        const float* g2 = MOD + (size_t)b * 6144 + 5 * 1024 + col0;
        float* orow = p.out + (size_t)tok * DM + col0;
        f32x4 xv[4], gv[4];
        { const v4u* xb = (const v4u*)((const bf16*)(ws + WS_X1B) + (size_t)tok * DM + col0); const v4u t0 = xb[0], t1 = xb[1];
          xv[0] = (f32x4){bflo(t0.x), bfhi(t0.x), bflo(t0.y), bfhi(t0.y)}; xv[1] = (f32x4){bflo(t0.z), bfhi(t0.z), bflo(t0.w), bfhi(t0.w)};
          xv[2] = (f32x4){bflo(t1.x), bfhi(t1.x), bflo(t1.y), bfhi(t1.y)}; xv[3] = (f32x4){bflo(t1.z), bfhi(t1.z), bflo(t1.w), bfhi(t1.w)}; }
#pragma unroll
        for (int q4 = 0; q4 < 4; ++q4) gv[q4] = *(const f32x4*)(g2 + 4 * q4);
        PV_BLOCK(12);
        float accs[16];
#pragma unroll
        for (int i = 0; i < 16; ++i) { const float a_lo = acc2[i >> 1][i & 1], a_hi = acc2[8 + (i >> 1)][i & 1]; const float lo = a_lo + __shfl_xor(a_lo, 32), hi2 = a_hi + __shfl_xor(a_hi, 32); accs[i] = hl ? hi2 : lo; }
#pragma unroll
        for (int q4 = 0; q4 < 4; ++q4) { f32x4 o;
#pragma unroll
            for (int i = 0; i < 4; ++i) o[i] = xv[q4][i] + gv[q4][i] * accs[4 * q4 + i];
            *(f32x4*)(orow + 4 * q4) = o; }
    }
#undef PV_BLOCK
#undef PV_ISSUE
#undef PV_PIN
#undef PV_FMA
}

#define XB_TMO      128
#define XB_XCNT(j)  (256  + 64 * (j))
#define XB_XSUB(j)  (1280 + 64 * (j))
#define XB_XGEN(j)  (2304 + 64 * (j))
#define XB_TOP      3328
#define XB_TOPGEN   3392
#define XCD_BAR_WORDS 3456
#define XB_SPIN_CAP (1u << 18)

__device__ __forceinline__ unsigned xb_ld(unsigned* p)              { return __hip_atomic_load(p, __ATOMIC_RELAXED, __HIP_MEMORY_SCOPE_AGENT); }
__device__ __forceinline__ unsigned xb_add(unsigned* p, unsigned v) { return __hip_atomic_fetch_add(p, v, __ATOMIC_RELAXED, __HIP_MEMORY_SCOPE_AGENT); }
__device__ __forceinline__ unsigned xb_xcc_id() { return (unsigned)__builtin_amdgcn_s_getreg((3 << 11) | 20) & 0xFu; }
#define XB_SPIN(cond, bar) do { unsigned _sp = 0; while (cond) { __builtin_amdgcn_s_sleep(1); \
    if ((++_sp & 255u) == 0u) { if (xb_ld(&(bar)[XB_TMO])) break; if (_sp > XB_SPIN_CAP) { atomicAdd(&(bar)[XB_TMO], 1u); break; } } } } while (0)

struct XcdBarrier {
    unsigned* bar; unsigned x;
    volatile LAS unsigned* st;
};

__device__ __forceinline__ XcdBarrier xcd_barrier_post(unsigned* bar, volatile LAS unsigned* st) {
    XcdBarrier b; b.bar = bar; b.x = xb_xcc_id(); b.st = st;
    if (threadIdx.x == 0) (void)xb_add(&bar[XB_XCNT(b.x)], 1u);
    return b;
}
__device__ __forceinline__ void xcd_barrier_complete(unsigned* bar, unsigned x, unsigned& nloc, unsigned& nx) {
    const unsigned G = gridDim.x * gridDim.y * gridDim.z;
    unsigned sum, cnt, mine, sp = 0u;
    for (;;) {
        sum = 0u; cnt = 0u; mine = 0u;
#pragma unroll
        for (unsigned j = 0; j < 16; ++j) { const unsigned c = xb_ld(&bar[XB_XCNT(j)]); sum += c; cnt += (c > 0u) ? 1u : 0u; mine = (j == x) ? c : mine; }
        if (sum == G) break;
        __builtin_amdgcn_s_sleep(1);
        if ((++sp & 255u) == 0u) { if (xb_ld(&bar[XB_TMO])) break; if (sp > XB_SPIN_CAP) { atomicAdd(&bar[XB_TMO], 1u); break; } }
    }
    nloc = mine > 0u ? mine : 1u; nx = cnt > 0u ? cnt : 1u;
}

__device__ __forceinline__ void xcd_barrier(const XcdBarrier& b) {
    asm volatile("s_waitcnt vmcnt(0)" ::: "memory");
    __syncthreads();
    if (threadIdx.x == 0) {
        unsigned* bar = b.bar;
        __builtin_amdgcn_s_waitcnt(0);
        unsigned nloc = b.st[0], nx = b.st[1];
        if (nloc == 0u) { xcd_barrier_complete(bar, b.x, nloc, nx); b.st[0] = nloc; b.st[1] = nx; }
        const unsigned old = xb_add(&bar[XB_XSUB(b.x)], 1u);
        const unsigned gen = old / nloc;
        if (old + 1u == (gen + 1u) * nloc) {
            __builtin_amdgcn_fence(__ATOMIC_RELEASE, "agent");
            asm volatile("s_waitcnt vmcnt(0)" ::: "memory");
            const unsigned og = xb_add(&bar[XB_TOP], 1u);
            const unsigned tg = og / nx;
            if (og + 1u == (tg + 1u) * nx) xb_add(&bar[XB_TOPGEN], 1u);
            else XB_SPIN(xb_ld(&bar[XB_TOPGEN]) == tg, bar);
            __builtin_amdgcn_fence(__ATOMIC_ACQUIRE, "agent");
            xb_add(&bar[XB_XGEN(b.x)], 1u);
            asm volatile("s_waitcnt vmcnt(0)" ::: "memory");
        } else {
            XB_SPIN(xb_ld(&bar[XB_XGEN(b.x)]) == gen, bar);
            __builtin_amdgcn_fence(__ATOMIC_ACQUIRE, "agent");
            asm volatile("s_waitcnt vmcnt(0)" ::: "memory");
        }
    }
    __syncthreads();
}

constexpr int NPHASE = 11;
__global__ void __launch_bounds__(NTHREADS, 2) mega(Params p) {
    extern __shared__ __attribute__((aligned(16))) unsigned char lds[];
    cg::grid_group grid = cg::this_grid();
    const int lo = p.ph_lo, hi = p.ph_hi;
    const int tid = threadIdx.x, wave = tid >> 6, lane = tid & 63, G = gridDim.x;
    unsigned char* ws = p.ws;
#ifndef ONLYPH
#define IN(k) (lo <= (k) && (k) < hi)
#else
#define IN(k) ((k) == ONLYPH && lo <= (k) && (k) < hi)
#endif
    volatile LAS unsigned* xb_st = (volatile LAS unsigned*)((LAS unsigned char*)lds + (LDS_BYTES - 16));
    if (tid < 4) xb_st[tid] = 0u;
    __syncthreads();
    XcdBarrier xbar; xbar.bar = (unsigned*)(ws + WS_CTL); xbar.x = 0; xbar.st = xb_st;
    if (hi - lo > 1) xbar = xcd_barrier_post((unsigned*)(ws + WS_CTL), xb_st);
    if (lo < -1) grid.sync();
#define SEAM(k) do { if (IN((k) + 1)) xcd_barrier(xbar); } while (0)
#ifndef REPMASK
#define REPMASK 0
#endif
#define NREP(k) (((REPMASK >> (k)) & 1) ? 2 : 1)
    if (IN(0)) { for (int rep = 0; rep < NREP(0); ++rep) phase0(p, lds); SEAM(0); }
    if (IN(1)) { for (int rep = 0; rep < NREP(1); ++rep) normmod_phase<true>(p, lds, p.x, (bf16*)(ws + WS_H), p.norm1_g, 0, 1024); SEAM(1); }
    if (IN(2)) {
        { pg8::Gemm g{(const bf16*)(ws + WS_H8), (const bf16*)(ws + WS_WIN8), T, 3584, 512, 512, 512}; pg8::StaticOrder S; S.init(T, 3584, G, (int)blockIdx.x);
          EpiProj E{(bf16*)(ws + WS_HG), (bf16*)(ws + WS_ATT), (bf16*)(ws + WS_IDX), (bf16*)(ws + WS_GATE), 1};
          pg8::gemm_phase<EpiProj, pg8::StaticOrder, true, true, 122>((PG8_LAS unsigned char*)lds, g, S, E); }
        { pg8::Gemm g{(const bf16*)(ws + WS_H), (const bf16*)(ws + WS_WIN), T, 2048, 1024, 1024, 1024}; pg8::StaticOrder S; S.init(T, 2048, G, (int)blockIdx.x);
          EpiProj E{(bf16*)(ws + WS_HG), (bf16*)(ws + WS_ATT), (bf16*)(ws + WS_IDX), (bf16*)(ws + WS_GATE), 0};
          pg8::gemm_phase<EpiProj, pg8::StaticOrder, true, true>((PG8_LAS unsigned char*)lds, g, S, E); }
        SEAM(2);
    }
    if (IN(3)) {
        { float qg[8], kg[8];
#pragma unroll
          for (int i = 0; i < 8; ++i) { qg[i] = p.q_norm_g[(lane & 7) * 8 + i]; kg[i] = p.k_norm_g[(lane & 7) * 8 + i]; }
          int tok = (int)blockIdx.x * NWAVES + wave; const int st = G * NWAVES;
          for (; tok + 3 * st < T; tok += 4 * st) { const int tk[4] = {tok, tok + st, tok + 2 * st, tok + 3 * st}; qknorm_tokens<4>(p, tk, lane, qg, kg); }
          for (; tok < T; tok += st) { const int tk[1] = {tok}; qknorm_tokens<1>(p, tk, lane, qg, kg); } }
        SEAM(3);
    }
    if (IN(4)) {
        if ((int)blockIdx.x < 32) hgrn_item<0>(p, lds, (int)blockIdx.x); else if ((int)blockIdx.x < 64) hgrn_item<1>(p, lds, (int)blockIdx.x - 32);
        {
            unsigned* qctr = (unsigned*)(ws + WS_CTL + 32768);
            volatile LAS unsigned* qslot = (volatile LAS unsigned*)((LAS unsigned char*)lds + (LDS_BYTES - 32));
            int qsel = (int)(blockIdx.x & 7u), tried = 0;
            for (;;) {
                if (tid == 0) { unsigned c;
                    for (;;) { c = __hip_atomic_fetch_add(qctr + qsel * 64, 1u, __ATOMIC_RELAXED, __HIP_MEMORY_SCOPE_AGENT); if (c < (unsigned)(SEQ / 16) || tried >= 7) break; qsel = (qsel + 1) & 7; ++tried; }
                    *qslot = (c < (unsigned)(SEQ / 16)) ? (((unsigned)qsel << 16) | c) : 0xffffffffu; }
                __syncthreads();
                const unsigned c = *qslot;
                __syncthreads();
                if (c == 0xffffffffu) break;
                const int b = (int)(c >> 16), qblk = (SEQ / 16 - 1) - (int)(c & 0xffffu), it = b * (SEQ / 16) + qblk, q0 = qblk * 16;
                dsa1_item(p, lds, it);
#pragma unroll 1
                for (int k2 = 0; k2 < 2; ++k2) dsa2_query(p, lds + wave * 16384, (const unsigned short*)(lds + 131072 + (wave + 8 * k2) * 1024), b, q0 + wave + 8 * k2, lane);
                __syncthreads();
            }
        }
        if (hi - lo > 1) xcd_barrier(xbar);
        for (int wu = (int)blockIdx.x * NWAVES + wave; wu < 32 * 32 * 4; wu += G * NWAVES) { const int u = wu >> 2; hgrn_fix(p, u >> 5, u & 31, wu & 3, lane); }
        SEAM(4);
    }
    if (IN(5)) {
        pg8::Gemm g{(const bf16*)(ws + WS_H), (const bf16*)(ws + WS_WAB8), T, 1024, 256, 512, 512}; pg8::StaticOrderT<true> S; S.init(T, 1024, G, (int)blockIdx.x, 256);
        EpiMerged E{(const bf16*)(ws + WS_GATE), (bf16*)(ws + WS_MERGED)};
        for (int rep = 0; rep < NREP(5); ++rep) pg8::gemm_phase<EpiMerged, pg8::StaticOrderT<true>, true, true, 122>((PG8_LAS unsigned char*)lds, g, S, E);
        SEAM(5);
    }
    if (IN(6)) {
        pg8::Gemm g{(const bf16*)(ws + WS_MERGED), (const bf16*)(ws + WS_WOUT8), T, 1024, 512, 512, 512}; pg8::StaticOrder S; S.init(T, 1024, G, (int)blockIdx.x);
        EpiResid E{p.x, (const float*)(ws + WS_MOD) + 2048, (bf16*)(ws + WS_X1B)};
        for (int rep = 0; rep < NREP(6); ++rep) pg8::gemm_phase<EpiResid, pg8::StaticOrder, true, true, 120>((PG8_LAS unsigned char*)lds, g, S, E);
        SEAM(6);
    }
    if (IN(7)) { for (int rep = 0; rep < NREP(7); ++rep) normmod_phase<false>(p, lds, (const float*)(ws + WS_X1B), (bf16*)(ws + WS_H), p.norm2_g, 3 * 1024, 4 * 1024); SEAM(7); }
    if (IN(8)) {
        pg8::Gemm g{(const bf16*)(ws + WS_H28), (const bf16*)(ws + WS_WQ8), T, 2048, 512, 512, 512}; pg8::StaticOrder S; S.init(T, 2048, G, (int)blockIdx.x);
        EpiStore E{(bf16*)(ws + WS_Q), 2048};
        for (int rep = 0; rep < NREP(8); ++rep) pg8::gemm_phase<EpiStore, pg8::StaticOrder, true, true, 122>((PG8_LAS unsigned char*)lds, g, S, E);
        SEAM(8);
    }
    if (IN(9)) {
        int* eG = (int*)(ws + WS_EIDX); float* gG = (float*)(ws + WS_PGATE);
        peer_route_block(p, lds, eG, gG);
        asm volatile("s_waitcnt vmcnt(0)" ::: "memory");
        __syncthreads();
        _Float16* usL = (_Float16*)lds; _Float16* vsL = (_Float16*)(lds + 32768);
        for (int i = tid; i < NEXP / 8; i += NTHREADS) { ((v4u*)usL)[i] = ((const v4u*)(ws + WS_US))[i]; ((v4u*)vsL)[i] = ((const v4u*)(ws + WS_VS))[i]; }
        unsigned char* ldsw = lds + 65536 + wave * 3072;
        int ntok = 0;
        for (int tg = blockIdx.x; tg < T / 16; tg += G) ntok += 2;
        auto tok_of = [&](int j) { return ((int)blockIdx.x + (j >> 1) * G) * 16 + wave + 8 * (j & 1); };
        auto ld_lists = [&](int tok, v2u& e, v2u& g) {
            const unsigned* ep = (const unsigned*)(eG + (size_t)tok * 128 + 2 * lane); const unsigned* gp = (const unsigned*)(gG + (size_t)tok * 128 + 2 * lane);
            e.x = __hip_atomic_load(ep, __ATOMIC_RELAXED, __HIP_MEMORY_SCOPE_AGENT); e.y = __hip_atomic_load(ep + 1, __ATOMIC_RELAXED, __HIP_MEMORY_SCOPE_AGENT);
            g.x = __hip_atomic_load(gp, __ATOMIC_RELAXED, __HIP_MEMORY_SCOPE_AGENT); g.y = __hip_atomic_load(gp + 1, __ATOMIC_RELAXED, __HIP_MEMORY_SCOPE_AGENT); };
        if (ntok > 0) { v2u e0, g0; ld_lists(tok_of(0), e0, g0); *(v2u*)((int*)ldsw + 2 * lane) = e0; *(v2u*)((float*)(ldsw + 512) + 2 * lane) = g0; }
        __syncthreads();
        peer_u_sweep(p, ldsw, usL, vsL, lds + 90112 + wave * 8192, ntok, lane, tok_of, ld_lists);
        asm volatile("s_waitcnt vmcnt(0)" ::: "memory");
        __syncthreads();
        if (ntok > 0) { v2u e0, g0; ld_lists(tok_of(0), e0, g0); *(v2u*)((int*)ldsw + 2 * lane) = e0; *(v2u*)((float*)(ldsw + 512) + 2 * lane) = g0; }
        LDS_WAIT(); __builtin_amdgcn_wave_barrier();
        peer_v_sweep(p, ldsw, ntok, lane, tok_of, ld_lists);
    }
#undef IN
#undef SEAM
}

#ifndef ONE_LAUNCH
#define ONE_LAUNCH 1
#endif
extern "C" void kernel_launch(void* const* d_in, const int* in_sizes, int n_in, void* d_out, int out_size, void* d_ws, size_t ws_size, hipStream_t stream) {
    static int grid = 0;
    if (grid == 0) {
        if (n_in != 18 || out_size != T * DM || ws_size < WS_END) { fprintf(stderr, "kernel_launch: unexpected shapes (n_in %d, out %d, ws %zu)\n", n_in, out_size, ws_size); grid = -1; return; }
        int dev = 0, cus = 0, per_cu = 0;
        if (hipGetDevice(&dev) != hipSuccess || hipDeviceGetAttribute(&cus, hipDeviceAttributeMultiprocessorCount, dev) != hipSuccess) { grid = -1; return; }
        if (hipFuncSetAttribute((const void*)mega, hipFuncAttributeMaxDynamicSharedMemorySize, LDS_BYTES) != hipSuccess) { fprintf(stderr, "kernel_launch: hipFuncSetAttribute failed\n"); grid = -1; return; }
        if (hipOccupancyMaxActiveBlocksPerMultiprocessor(&per_cu, (const void*)mega, NTHREADS, LDS_BYTES) != hipSuccess || per_cu < 1) { fprintf(stderr, "kernel_launch: occupancy query says %d\n", per_cu); grid = -1; return; }
        (void)hipGetLastError();
        grid = cus;
        if (grid < 64) { grid = -1; return; }
    }
    if (grid < 0) return;
    Params p{};
    const float** pp = (const float**)&p;
    for (int i = 0; i < 18; ++i) pp[i] = (const float*)d_in[i];
    p.out = (float*)d_out; p.ws = (unsigned char*)d_ws;
#if ONE_LAUNCH
    if (hipMemsetAsync((char*)d_ws + WS_CTL, 0, 65536, stream) != hipSuccess) { fprintf(stderr, "kernel_launch: memset failed\n"); return; }
    p.ph_lo = 0; p.ph_hi = NPHASE;
    void* args[] = {&p};
    hipError_t e = hipLaunchCooperativeKernel((const void*)mega, dim3(grid), dim3(NTHREADS), args, LDS_BYTES, stream);
    if (e != hipSuccess) fprintf(stderr, "cooperative launch failed: %s (grid %d)\n", hipGetErrorString(e), grid);
#else
    for (int k = 0; k < NPHASE; ++k) { p.ph_lo = k; p.ph_hi = k + 1; hipLaunchKernelGGL(mega, dim3(grid), dim3(NTHREADS), LDS_BYTES, stream, p); }
#endif
}
```
